# Optimizing an MI355X kernel written in HIP

```python
import math
import jax, jax.numpy as jnp
from jax import lax
import numpy as np

D_MODEL = 1024
BATCH = 4
SEQ = 8192
DEPTH = 2

GRID_W = 64
CTX_LEN = 256
HEAD_DIM = 64
ATT_WIDTH = D_MODEL // 2
ATT_HEADS = ATT_WIDTH // HEAD_DIM
ATT_KV_HEADS = ATT_HEADS // 4
KV_WIDTH = ATT_KV_HEADS * HEAD_DIM
ROPE_HALF = HEAD_DIM // 2
ROPE_AXIS_FREQS = HEAD_DIM // 4
ROPE_THETA = 10000.0
Q_BLOCK = 128
LRU_WIDTH = D_MODEL // 4
LRU_BLOCKS = 4
LRU_BLOCK_W = LRU_WIDTH // LRU_BLOCKS
LRU_C = 8.0
LRU_CONV = 4
LRU_CONV_LEFT = 2
HY_WIDTH = D_MODEL // 4
HY_CONV = 3
HY_CONV_LEFT = 1
HY_EMB = 33
HY_BANDS = (HY_EMB - 1) // 2
HY_FFN = 64
HY_FAST_DECAY = 0.3
HY_SLOW_DECAY = 1.5
HY_DECAY_TARGET = 1e-2
MIX_WIDTH = ATT_WIDTH + LRU_WIDTH + HY_WIDTH
IN_WIDTH = ATT_WIDTH + 2 * KV_WIDTH + 2 * LRU_WIDTH + 3 * HY_WIDTH
N_EXPERTS = 32
TOP_K = 4
D_FF = D_MODEL
SWIGLU_ALPHA = 1.702
SWIGLU_LIMIT = 7.0
EPS = 1e-6

kernel_name = 'hymba_gqa_rglru_hyena_moe_prefix_dit'

F32 = jnp.float32


def rmsnorm(x, g):
    xf = x.astype(F32)
    y = xf * lax.rsqrt(jnp.mean(xf * xf, axis=-1, keepdims=True) + EPS)
    return (y * g.astype(F32)).astype(x.dtype)


def modulate(h, shift, scale):
    return h * (1 + scale) + shift


def grid_rope(L):
    rows_n = L // GRID_W
    rows = jnp.repeat(jnp.arange(rows_n), GRID_W).astype(F32)
    cols = jnp.tile(jnp.arange(GRID_W), rows_n).astype(F32)
    inv = ROPE_THETA ** (-jnp.arange(ROPE_AXIS_FREQS, dtype=F32) / ROPE_AXIS_FREQS)
    ang = jnp.concatenate([rows[:, None] * inv, cols[:, None] * inv], axis=-1)
    return jnp.cos(ang)[:, None, :], jnp.sin(ang)[:, None, :]


def apply_rope(x, cos, sin):
    xf = x.astype(F32)
    x1, x2 = xf[..., :ROPE_HALF], xf[..., ROPE_HALF:]
    return jnp.concatenate([x1 * cos - x2 * sin, x2 * cos + x1 * sin], axis=-1).astype(x.dtype)


def dwconv(x, w, b, left):
    W, C = w.shape
    y = lax.conv_general_dilated(x, w[:, None, :].astype(x.dtype), window_strides=(1,),
                                 padding=[(left, W - 1 - left)],
                                 dimension_numbers=('NWC', 'WIO', 'NWC'), feature_group_count=C)
    return y + b.astype(x.dtype)


def split_proj(u):
    sizes = (ATT_WIDTH, KV_WIDTH, KV_WIDTH, LRU_WIDTH, LRU_WIDTH, 3 * HY_WIDTH)
    idx = np.cumsum(sizes)[:-1].tolist()
    return jnp.split(u, idx, axis=-1)


def gqa(q, k, v):
    s = jnp.einsum('bqkgd,bskd->bkgqs', q, k).astype(F32) * (HEAD_DIM ** -0.5)
    p = jax.nn.softmax(s, axis=-1).astype(v.dtype)
    return jnp.einsum('bkgqs,bskd->bqkgd', p, v)


def lru_coeffs(xc, w, b, lam):
    B, L, C = xc.shape
    xf = xc.astype(F32)
    g = jnp.einsum('blnd,jnde->jblne', xf.reshape(B, L, LRU_BLOCKS, LRU_BLOCK_W), w.astype(F32))
    g = g.reshape(2, B, L, C) + b.astype(F32)[:, None, None, :]
    r = jax.nn.sigmoid(g[0])
    i = jax.nn.sigmoid(g[1])
    log_a = -LRU_C * r * jax.nn.softplus(-lam.astype(F32))
    a = jnp.exp(log_a)
    bx = jnp.sqrt(-jnp.expm1(2.0 * log_a)) * (i * xf)
    return a, bx


def linear_scan(a, bx, h0, reverse):
    idx = -1 if reverse else 0
    bx = bx.at[:, idx].add(a[:, idx] * h0)

    def comb(left, right):
        a_l, b_l = left
        a_r, b_r = right
        return a_l * a_r, a_r * b_l + b_r

    _, h = lax.associative_scan(comb, (a, bx), axis=1, reverse=reverse)
    return h


def hyena_kernel(L, p):
    t01 = jnp.linspace(0.0, 1.0, L, dtype=F32)[:, None]
    bands = jnp.linspace(1e-4, HY_BANDS - 1, HY_BANDS, dtype=F32)
    ang = (2.0 * math.pi / L) * jnp.arange(L, dtype=F32)[:, None] * bands
    z = jnp.concatenate([t01, jnp.cos(ang), -jnp.sin(ang)], axis=-1)
    fr = p['hy_freq'].astype(F32)
    h = jnp.sin(fr * (z @ p['hy_w1'].astype(F32) + p['hy_b1'].astype(F32)))
    h = jnp.sin(fr * (h @ p['hy_w2'].astype(F32) + p['hy_b2'].astype(F32)))
    h = (h @ p['hy_w3'].astype(F32)) * jnp.exp(-t01 * jnp.abs(p['hy_decay'].astype(F32)))
    hf, hb = h[:, :HY_WIDTH], h[:, HY_WIDTH:]
    k = jnp.concatenate([hf, jnp.zeros((1, HY_WIDTH), F32), jnp.flip(hb[1:], axis=0)], axis=0)
    return k / jnp.sum(jnp.abs(k), axis=0, keepdims=True)


def hyena(u, p):
    L = u.shape[1]
    uc = dwconv(u, p['hy_cw'], p['hy_cb'], HY_CONV_LEFT)
    x0, x1, v = jnp.split(uc, 3, axis=-1)
    k = hyena_kernel(L, p)
    v = (v * x1).astype(F32)
    n = 2 * L
    y = jnp.fft.irfft(jnp.fft.rfft(v, n=n, axis=1) * jnp.fft.rfft(k, n=n, axis=0)[None], n=n, axis=1)[:, :L]
    y = y + v * p['hy_bias'].astype(F32)
    return y.astype(u.dtype) * x0


def merge_groups(att, lru, hyo, p):
    g = p['out_g']
    o = jnp.concatenate([rmsnorm(att, g[:ATT_WIDTH]),
                         rmsnorm(lru, g[ATT_WIDTH:ATT_WIDTH + LRU_WIDTH]),
                         rmsnorm(hyo, g[ATT_WIDTH + LRU_WIDTH:])], axis=-1)
    return o @ p['w_out']


def mixer(h_lat, h_ctx, p, ctx_out):
    B, S, _ = h_lat.shape
    Lc = h_ctx.shape[1]
    G = ATT_HEADS // ATT_KV_HEADS
    q, k, v, lx, lg, hy = split_proj(h_lat @ p['w_in'])
    qc, kc, vc, lxc, lgc, hyc = split_proj(h_ctx @ p['w_in'])
    cos, sin = grid_rope(S)
    q = apply_rope(rmsnorm(q.reshape(B, S, ATT_HEADS, HEAD_DIM), p['q_g']), cos, sin)
    k = apply_rope(rmsnorm(k.reshape(B, S, ATT_KV_HEADS, HEAD_DIM), p['k_g']), cos, sin)
    v = v.reshape(B, S, ATT_KV_HEADS, HEAD_DIM)
    kc = rmsnorm(kc.reshape(B, Lc, ATT_KV_HEADS, HEAD_DIM), p['k_g'])
    vc = vc.reshape(B, Lc, ATT_KV_HEADS, HEAD_DIM)
    k_all = jnp.concatenate([kc, k], axis=1)
    v_all = jnp.concatenate([vc, v], axis=1)
    qb = q.reshape(B, S // Q_BLOCK, Q_BLOCK, ATT_KV_HEADS, G, HEAD_DIM).transpose(1, 0, 2, 3, 4, 5)
    att = lax.map(lambda qi: gqa(qi, k_all, v_all), qb)
    att = att.transpose(1, 0, 2, 3, 4, 5).reshape(B, S, ATT_WIDTH)
    xl = dwconv(lx, p['lru_cw'], p['lru_cb'], LRU_CONV_LEFT)
    xcx = dwconv(lxc, p['lru_cw'], p['lru_cb'], LRU_CONV_LEFT)
    h_lat_dirs = []
    h_ctx_dirs = []
    for d, rev in enumerate((False, True)):
        a_c, b_c = lru_coeffs(xcx, p['lru_gw'][d], p['lru_gb'][d], p['lru_lam'][d])
        h_c = linear_scan(a_c, b_c, jnp.zeros_like(b_c[:, 0]), rev)
        h_end = h_c[:, 0] if rev else h_c[:, -1]
        a_l, b_l = lru_coeffs(xl, p['lru_gw'][d], p['lru_gb'][d], p['lru_lam'][d])
        h_lat_dirs.append(linear_scan(a_l, b_l, h_end, rev))
        h_ctx_dirs.append(h_c)
    lru = (h_lat_dirs[0] + h_lat_dirs[1]).astype(h_lat.dtype) * jax.nn.gelu(lg)
    hyo = hyena(hy, p)
    o_lat = merge_groups(att, lru, hyo, p)
    if not ctx_out:
        return o_lat, None
    qc = rmsnorm(qc.reshape(B, Lc, ATT_KV_HEADS, G, HEAD_DIM), p['q_g'])
    att_c = gqa(qc, kc, vc).reshape(B, Lc, ATT_WIDTH)
    lru_c = (h_ctx_dirs[0] + h_ctx_dirs[1]).astype(h_ctx.dtype) * jax.nn.gelu(lgc)
    o_ctx = merge_groups(att_c, lru_c, hyena(hyc, p), p)
    return o_lat, o_ctx


def moe(h, router_w, router_b, w1, b1, w2, b2):
    T = h.shape[0]
    logits = (h @ router_w).astype(F32) + router_b.astype(F32)
    top_v, top_i = lax.top_k(logits, TOP_K)
    gate = jax.nn.softmax(top_v, axis=-1)
    dense_gate = jnp.sum(jax.nn.one_hot(top_i, N_EXPERTS, dtype=F32) * gate[..., None], axis=1)
    out = jnp.zeros((T, h.shape[1]), F32)
    for e in range(N_EXPERTS):
        hu = (h @ w1[e] + b1[e]).astype(F32)
        glu = jnp.minimum(hu[:, ::2], SWIGLU_LIMIT)
        lin = jnp.clip(hu[:, 1::2], -SWIGLU_LIMIT, SWIGLU_LIMIT)
        act = (glu * jax.nn.sigmoid(SWIGLU_ALPHA * glu) * (lin + 1.0)).astype(h.dtype)
        out = out + dense_gate[:, e:e + 1] * (act @ w2[e] + b2[e]).astype(F32)
    return out.astype(h.dtype)


def setup_inputs(seed: int = 0) -> dict:
    key = jax.random.key(seed)
    ks = iter(list(jax.random.split(key, 40)))

    def nrm(shape, scale):
        return jax.random.normal(next(ks), shape, F32) * scale

    D = D_MODEL
    x = nrm((BATCH, SEQ, D), 1.0)
    c = nrm((BATCH, D), 1.0)
    ctx = nrm((BATCH, CTX_LEN, D), 1.0)
    c_ctx = nrm((D,), 1.0)
    w_mod = nrm((DEPTH, D, 6 * D), 0.5 * D ** -0.5)
    b_mod = nrm((DEPTH, 6 * D), 0.02)
    norm_mix_g = 1.0 + nrm((DEPTH, D), 0.05)
    norm_ffn_g = 1.0 + nrm((DEPTH, D), 0.05)
    w_in = nrm((DEPTH, D, IN_WIDTH), D ** -0.5)
    q_norm_g = 1.0 + nrm((DEPTH, HEAD_DIM), 0.05)
    k_norm_g = 1.0 + nrm((DEPTH, HEAD_DIM), 0.05)
    lru_conv_w = nrm((DEPTH, LRU_CONV, LRU_WIDTH), LRU_CONV ** -0.5)
    lru_conv_b = nrm((DEPTH, LRU_WIDTH), 0.02)
    lru_gate_w = nrm((DEPTH, 2, 2, LRU_BLOCKS, LRU_BLOCK_W, LRU_BLOCK_W), LRU_BLOCK_W ** -0.5)
    lru_gate_b = nrm((DEPTH, 2, 2, LRU_WIDTH), 0.02)
    a_pow = jax.random.uniform(next(ks), (DEPTH, 2, LRU_WIDTH), F32, minval=0.9, maxval=0.999)
    a_base = a_pow ** (1.0 / LRU_C)
    lru_lambda = jnp.log(a_base) - jnp.log1p(-a_base)
    hy_conv_w = nrm((DEPTH, HY_CONV, 3 * HY_WIDTH), HY_CONV ** -0.5)
    hy_conv_b = nrm((DEPTH, 3 * HY_WIDTH), 0.02)
    hy_w1 = nrm((DEPTH, HY_EMB, HY_FFN), HY_EMB ** -0.5)
    hy_b1 = nrm((DEPTH, HY_FFN), 0.02)
    hy_w2 = nrm((DEPTH, HY_FFN, HY_FFN), HY_FFN ** -0.5)
    hy_b2 = nrm((DEPTH, HY_FFN), 0.02)
    hy_w3 = nrm((DEPTH, HY_FFN, 2 * HY_WIDTH), HY_FFN ** -0.5)
    hy_freq = 1.0 + nrm((DEPTH, HY_FFN), 0.05)
    min_decay = math.log(HY_DECAY_TARGET) / HY_SLOW_DECAY
    max_decay = math.log(HY_DECAY_TARGET) / HY_FAST_DECAY
    base_decay = jnp.tile(jnp.linspace(min_decay, max_decay, HY_WIDTH, dtype=F32), 2)
    hy_decay = base_decay[None, :] + nrm((DEPTH, 2 * HY_WIDTH), 0.1)
    hy_bias = nrm((DEPTH, HY_WIDTH), 0.5)
    out_norm_g = 1.0 + nrm((DEPTH, MIX_WIDTH), 0.05)
    w_out = nrm((DEPTH, MIX_WIDTH, D), MIX_WIDTH ** -0.5)
    router_w = nrm((DEPTH, D, N_EXPERTS), D ** -0.5)
    router_b = nrm((DEPTH, N_EXPERTS), 0.01)
    moe_w1 = nrm((DEPTH, N_EXPERTS, D, 2 * D_FF), D ** -0.5)
    moe_b1 = nrm((DEPTH, N_EXPERTS, 2 * D_FF), 0.01)
    moe_w2 = nrm((DEPTH, N_EXPERTS, D_FF, D), D_FF ** -0.5)
    moe_b2 = nrm((DEPTH, N_EXPERTS, D), 0.01)
    return {'x': x, 'c': c, 'ctx': ctx, 'c_ctx': c_ctx, 'w_mod': w_mod, 'b_mod': b_mod,
            'norm_mix_g': norm_mix_g, 'norm_ffn_g': norm_ffn_g, 'w_in': w_in,
            'q_norm_g': q_norm_g, 'k_norm_g': k_norm_g, 'lru_conv_w': lru_conv_w, 'lru_conv_b': lru_conv_b,
            'lru_gate_w': lru_gate_w, 'lru_gate_b': lru_gate_b, 'lru_lambda': lru_lambda,
            'hy_conv_w': hy_conv_w, 'hy_conv_b': hy_conv_b, 'hy_w1': hy_w1, 'hy_b1': hy_b1,
            'hy_w2': hy_w2, 'hy_b2': hy_b2, 'hy_w3': hy_w3, 'hy_freq': hy_freq, 'hy_decay': hy_decay,
            'hy_bias': hy_bias, 'out_norm_g': out_norm_g, 'w_out': w_out, 'router_w': router_w,
            'router_b': router_b, 'moe_w1': moe_w1, 'moe_b1': moe_b1, 'moe_w2': moe_w2, 'moe_b2': moe_b2}


def reference(x, c, ctx, c_ctx, w_mod, b_mod, norm_mix_g, norm_ffn_g, w_in, q_norm_g, k_norm_g,
              lru_conv_w, lru_conv_b, lru_gate_w, lru_gate_b, lru_lambda, hy_conv_w, hy_conv_b,
              hy_w1, hy_b1, hy_w2, hy_b2, hy_w3, hy_freq, hy_decay, hy_bias, out_norm_g, w_out,
              router_w, router_b, moe_w1, moe_b1, moe_w2, moe_b2):
    B, S, D = x.shape
    Lc = ctx.shape[1]
    for l in range(DEPTH):
        last = l == DEPTH - 1
        mod = jax.nn.silu(c) @ w_mod[l] + b_mod[l]
        mod_c = jax.nn.silu(c_ctx) @ w_mod[l] + b_mod[l]
        sa, ca, ga, sf, cf, gf = jnp.split(mod[:, None, :], 6, axis=-1)
        sa_c, ca_c, ga_c, sf_c, cf_c, gf_c = jnp.split(mod_c, 6, axis=-1)
        p = {'w_in': w_in[l], 'q_g': q_norm_g[l], 'k_g': k_norm_g[l],
             'lru_cw': lru_conv_w[l], 'lru_cb': lru_conv_b[l], 'lru_gw': lru_gate_w[l],
             'lru_gb': lru_gate_b[l], 'lru_lam': lru_lambda[l],
             'hy_cw': hy_conv_w[l], 'hy_cb': hy_conv_b[l], 'hy_w1': hy_w1[l], 'hy_b1': hy_b1[l],
             'hy_w2': hy_w2[l], 'hy_b2': hy_b2[l], 'hy_w3': hy_w3[l], 'hy_freq': hy_freq[l],
             'hy_decay': hy_decay[l], 'hy_bias': hy_bias[l], 'out_g': out_norm_g[l], 'w_out': w_out[l]}
        h_lat = modulate(rmsnorm(x, norm_mix_g[l]), sa, ca)
        h_ctx = modulate(rmsnorm(ctx, norm_mix_g[l]), sa_c, ca_c)
        o_lat, o_ctx = mixer(h_lat, h_ctx, p, not last)
        x = x + ga * o_lat
        f_lat = modulate(rmsnorm(x, norm_ffn_g[l]), sf, cf).reshape(B * S, D)
        if last:
            y = moe(f_lat, router_w[l], router_b[l], moe_w1[l], moe_b1[l], moe_w2[l], moe_b2[l])
            x = x + gf * y.reshape(B, S, D)
        else:
            ctx = ctx + ga_c * o_ctx
            f_ctx = modulate(rmsnorm(ctx, norm_ffn_g[l]), sf_c, cf_c).reshape(B * Lc, D)
            y = moe(jnp.concatenate([f_lat, f_ctx], axis=0), router_w[l], router_b[l],
                    moe_w1[l], moe_b1[l], moe_w2[l], moe_b2[l])
            x = x + gf * y[:B * S].reshape(B, S, D)
            ctx = ctx + gf_c * y[B * S:].reshape(B, Lc, D)
    return x
```

```cpp
#include <hip/hip_runtime.h>
#include <hip/hip_bf16.h>
#include <cstdio>
#include <cstdint>
#include <cmath>
#ifndef MK_PER_PHASE
#define MK_PER_PHASE 0
#endif
namespace pg8 {
#define PG8_LAS __attribute__((address_space(3)))
typedef unsigned short bf16_t;
typedef short bf16x8 __attribute__((ext_vector_type(8)));
typedef float f32x4 __attribute__((ext_vector_type(4)));
typedef unsigned u32x4 __attribute__((ext_vector_type(4)));
constexpr int BM = 256, BK = 64, HALF = 128, HTB = HALF * BK * 2  , STAGE_BYTES = 8 * HTB, NXCD = 8, WGM = 8;

__host__ __device__ __forceinline__ int lds_byte(int r, int c) { const int st = (r >> 4) * 2 + (c >> 5), rr = r & 15, cc = c & 31, ob = rr * 64 + cc * 2; return st * 1024 + (ob ^ (((ob >> 9) & 1) << 5)); }
__host__ __device__ __forceinline__ void stage_rc(int b, int& R, int& C) { const int st = b / 1024, sb = b % 1024, swz = sb ^ (((sb >> 9) & 1) << 5); R = (st >> 1) * 16 + swz / 64; C = (st & 1) * 32 + (swz % 64) / 2; }
__host__ __device__ __forceinline__ int perm32(int rho) { const int n = rho >> 4, i = rho & 15; return 8 * (i >> 2) + 4 * n + (i & 3); }

struct Unit { int pm, pn, be, e; };
struct Gemm { const bf16_t* A; const bf16_t* Bt; int M, N, K; };

struct StaticOrder {
    int nM, nN, nwg, G, c;
    __host__ __device__ void init(int M, int N, int G_, int c_) { nM = M / BM; nN = N / BM; nwg = nM * nN; G = G_; c = c_; }
    __host__ __device__ bool next(int i, Unit& u) const {
        const long L = (long)i * G + c; if (L >= nwg) return false;
        int wgid = (int)L; { const int q = nwg / NXCD, r = nwg % NXCD, xcd = wgid % NXCD, off = wgid / NXCD; wgid = (xcd < r ? xcd * (q + 1) : r * (q + 1) + (xcd - r) * q) + off; }
        const int nig = WGM * nN, gid = wgid / nig, fm = gid * WGM, gsz = (nM - fm) < WGM ? (nM - fm) : WGM;
        u.pm = fm + ((wgid % nig) % gsz); u.pn = (wgid % nig) / gsz; u.be = u.pn; u.e = 0; return true;
    }
    __device__ __forceinline__ void a_ready(const Unit&) const {}
    __device__ __forceinline__ void done(const Unit&) const {}
};

__device__ __forceinline__ unsigned cvt_pk_bf16(float lo, float hi) { unsigned r; asm volatile("v_cvt_pk_bf16_f32 %0, %1, %2" : "=v"(r) : "v"(lo), "v"(hi)); return r; }
typedef float f32x2 __attribute__((ext_vector_type(2)));
__device__ __forceinline__ f32x2 gelu_pk(f32x2 v) {
    const f32x2 av = __builtin_elementwise_abs(v), d = av * 0.2316418882f + 1.0f;
    f32x2 t; t.x = __builtin_amdgcn_rcpf(d.x); t.y = __builtin_amdgcn_rcpf(d.y);
    f32x2 q = t * 0.5307027145f + (-0.7265760135f); q = q * t + 0.7107068705f; q = q * t + (-0.142248368f); q = q * t + 0.127414796f; q = q * t;
    const f32x2 s = (v * v) * (-0.72134752044f);
    f32x2 e; e.x = __builtin_amdgcn_exp2f(s.x); e.y = __builtin_amdgcn_exp2f(s.y);
    const f32x2 m = v * (q * e), r = v - m;
    f32x2 o; o.x = v.x < 0.f ? m.x : r.x; o.y = v.y < 0.f ? m.y : r.y; return o;
}

template <int ACT  > struct EpiBf16 {
    static constexpr bool PERM = true, AFTER_DRAIN = false; static_assert(ACT == 0 || ACT == 1, "EpiBf16: ACT is 0 (none) or 1 (gelu_pk)");
    bf16_t* O; int ldc; const float* bias; int split_cols; size_t split_stride; float scale0;
    __device__ __forceinline__ void operator()(const f32x4 (&acc)[2][2][4][2], const Unit& u, int wr, int wc, int fr, int fq) const {
        const int row0 = u.pm * BM + wr * 64 + fr; int colt = u.pn * BM; bf16_t* base = O;
        float sc = 1.f; if (split_cols) { const int t = colt / split_cols; base += (size_t)t * split_stride; colt -= t * split_cols; if (t == 0) sc = scale0; }
        const int col0 = colt + wc * 32 + 8 * fq, bcol0 = u.pn * BM + wc * 32 + 8 * fq;
        f32x4 bv[2][2];
#pragma unroll
        for (int bj = 0; bj < 2; ++bj)
#pragma unroll
            for (int n = 0; n < 2; ++n) bv[bj][n] = bias ? *(const f32x4*)(bias + bcol0 + bj * HALF + 4 * n) : (f32x4){0.f, 0.f, 0.f, 0.f};
#pragma unroll
        for (int ai = 0; ai < 2; ++ai)
#pragma unroll
            for (int m = 0; m < 4; ++m) { bf16_t* rowp = base + (size_t)(row0 + ai * HALF + m * 16) * ldc + col0;
#pragma unroll
                for (int bj = 0; bj < 2; ++bj) { f32x4 v0 = acc[ai][bj][m][0] + bv[bj][0], v1 = acc[ai][bj][m][1] + bv[bj][1];
                    if (ACT == 1) { f32x2 a = gelu_pk((f32x2){v0[0], v0[1]}), b = gelu_pk((f32x2){v0[2], v0[3]}), c = gelu_pk((f32x2){v1[0], v1[1]}), d = gelu_pk((f32x2){v1[2], v1[3]});
                        v0 = (f32x4){a.x, a.y, b.x, b.y}; v1 = (f32x4){c.x, c.y, d.x, d.y}; }
                    v0 = v0 * sc; v1 = v1 * sc; u32x4 w; w.x = cvt_pk_bf16(v0[0], v0[1]); w.y = cvt_pk_bf16(v0[2], v0[3]); w.z = cvt_pk_bf16(v1[0], v1[1]); w.w = cvt_pk_bf16(v1[2], v1[3]);
                    *(u32x4*)(rowp + bj * HALF) = w; } }
    }
};


struct EpiResid {
    static constexpr bool PERM = false, AFTER_DRAIN = false;
    const float* xin_lat; const float* xin_ctx; int nlat; float* XR; int ldc; const float* mod; int mod_stride; int seq;
    __device__ __forceinline__ void operator()(const f32x4 (&acc)[2][2][4][2], const Unit& u, int wr, int wc, int fr, int fq) const {
        const int row0 = u.pm * BM + wr * 64 + fr, col0 = u.pn * BM + wc * 32 + 4 * fq;
        const int rowt = u.pm * BM; const int bidx = rowt < nlat ? rowt / seq : 4;
        const float* gate = mod + (size_t)bidx * mod_stride;
        const float* xin = rowt < nlat ? xin_lat : (xin_ctx - (size_t)nlat * ldc);
        f32x4 gv[2][2];
#pragma unroll
        for (int bj = 0; bj < 2; ++bj)
#pragma unroll
            for (int n = 0; n < 2; ++n) gv[bj][n] = *(const f32x4*)(gate + col0 + bj * HALF + n * 16);
#pragma unroll
        for (int ai = 0; ai < 2; ++ai)
#pragma unroll
            for (int m = 0; m < 4; ++m) { const size_t ro = (size_t)(row0 + ai * HALF + m * 16) * ldc + col0;
#pragma unroll
                for (int bj = 0; bj < 2; ++bj)
#pragma unroll
                    for (int n = 0; n < 2; ++n) { const f32x4 xv = *(const f32x4*)(xin + ro + bj * HALF + n * 16);
                        *(f32x4*)(XR + ro + bj * HALF + n * 16) = xv + gv[bj][n] * acc[ai][bj][m][n]; } }
    }
};
struct EpiSwiglu {
    static constexpr bool PERM = true, AFTER_DRAIN = false;
    bf16_t* O; int ldc; const float* bias; int bias_stride;
    __device__ __forceinline__ void operator()(const f32x4 (&acc)[2][2][4][2], const Unit& u, int wr, int wc, int fr, int fq) const {
        const int row0 = u.pm * BM + wr * 64 + fr; const int bcol0 = u.pn * BM + wc * 32 + 8 * fq; const int ocol0 = bcol0 >> 1;
        const float* bb = bias + (size_t)u.e * bias_stride;
        f32x4 bv[2][2];
#pragma unroll
        for (int bj = 0; bj < 2; ++bj)
#pragma unroll
            for (int n = 0; n < 2; ++n) bv[bj][n] = *(const f32x4*)(bb + bcol0 + bj * HALF + 4 * n);
#pragma unroll
        for (int ai = 0; ai < 2; ++ai)
#pragma unroll
            for (int m = 0; m < 4; ++m) { bf16_t* rowp = O + (size_t)(row0 + ai * HALF + m * 16) * ldc + ocol0;
#pragma unroll
                for (int bj = 0; bj < 2; ++bj) { const f32x4 v0 = acc[ai][bj][m][0] + bv[bj][0], v1 = acc[ai][bj][m][1] + bv[bj][1];
                    float o[4];
#pragma unroll
                    for (int p = 0; p < 4; ++p) { const float hg = p < 2 ? v0[2 * p] : v1[2 * p - 4], hl = p < 2 ? v0[2 * p + 1] : v1[2 * p - 3];
                        const float glu = fminf(hg, 7.0f), lin = fminf(fmaxf(hl, -7.0f), 7.0f);
                        const float sg = __builtin_amdgcn_rcpf(1.0f + __builtin_amdgcn_exp2f(-1.702f * 1.4426950408889634f * glu));
                        o[p] = glu * sg * (lin + 1.0f); }
                    typedef unsigned u32x2 __attribute__((ext_vector_type(2)));
                    u32x2 w; w.x = cvt_pk_bf16(o[0], o[1]); w.y = cvt_pk_bf16(o[2], o[3]);
                    *(u32x2*)(rowp + bj * (HALF / 2)) = w; } }
    }
};
struct EpiBf16Bias {
    static constexpr bool PERM = true, AFTER_DRAIN = false;
    bf16_t* O; int ldc; const float* bias; int bias_stride;
    __device__ __forceinline__ void operator()(const f32x4 (&acc)[2][2][4][2], const Unit& u, int wr, int wc, int fr, int fq) const {
        const int row0 = u.pm * BM + wr * 64 + fr; const int col0 = u.pn * BM + wc * 32 + 8 * fq;
        const float* bb = bias + (size_t)u.e * bias_stride;
        f32x4 bv[2][2];
#pragma unroll
        for (int bj = 0; bj < 2; ++bj)
#pragma unroll
            for (int n = 0; n < 2; ++n) bv[bj][n] = *(const f32x4*)(bb + col0 + bj * HALF + 4 * n);
#pragma unroll
        for (int ai = 0; ai < 2; ++ai)
#pragma unroll
            for (int m = 0; m < 4; ++m) { bf16_t* rowp = O + (size_t)(row0 + ai * HALF + m * 16) * ldc + col0;
#pragma unroll
                for (int bj = 0; bj < 2; ++bj) { const f32x4 v0 = acc[ai][bj][m][0] + bv[bj][0], v1 = acc[ai][bj][m][1] + bv[bj][1];
                    u32x4 w; w.x = cvt_pk_bf16(v0[0], v0[1]); w.y = cvt_pk_bf16(v0[2], v0[3]); w.z = cvt_pk_bf16(v1[0], v1[1]); w.w = cvt_pk_bf16(v1[2], v1[3]);
                    *(u32x4*)(rowp + bj * HALF) = w; } }
    }
};
struct MoeOrder {
    const PG8_LAS int* tab; int ntiles, nN, G, c;
    __device__ __forceinline__ bool next(int i, Unit& u) const {
        const int L = i * G + c; if (L >= ntiles * nN) return false;
        u.pm = L / nN; u.pn = L - u.pm * nN; u.e = tab[u.pm]; u.be = u.e * nN + u.pn; return true;
    }
    __device__ __forceinline__ void a_ready(const Unit&) const {}
    __device__ __forceinline__ void done(const Unit&) const {}
};
template <class Epi, class Sched, bool ALIGN_EPI = false, bool SP2 = false>
__device__ __forceinline__ void gemm_phase(PG8_LAS unsigned char* lds, const Gemm g, const Sched& S, const Epi& E) {
    int tid_ = threadIdx.x; asm volatile("" : "+v"(tid_));
    const int tid = tid_, wid = __builtin_amdgcn_readfirstlane(tid >> 6), lane = tid & 63, wr = wid >> 2, wc = wid & 3, fr = lane & 15, fq = lane >> 4;
    const int K = g.K, nt = K / BK;
    unsigned voffA[2], voffB[2];
#pragma unroll
    for (int i = 0; i < 2; ++i) { int R, C; stage_rc(tid * 16 + i * 8192, R, C); const int Rb = Epi::PERM ? ((R & ~31) + perm32(R & 31)) : R;
        voffA[i] = (unsigned)(R * K + C) * 2u; voffB[i] = (unsigned)(Rb * K + C) * 2u; }
    const size_t kstep = (size_t)(BK * 2);
    const size_t hstep = (size_t)HALF * K * 2;
    const size_t tstep = 2 * hstep;
    const unsigned ldsw = (unsigned)wid * 1024u;
    const int aoff = lds_byte(wr * 64 + fr, fq * 8), boff = lds_byte(wc * 32 + fr, fq * 8);
#define PG8_SA(b, h) (((b) * 2 + (h)) * HTB)
#define PG8_SB(b, h) ((4 + (b) * 2 + (h)) * HTB)
#define PG8_STAGE(bufoff, gbase, voff) do { _Pragma("unroll") for (int _i = 0; _i < 2; ++_i) \
        __builtin_amdgcn_global_load_lds((const unsigned*)((const char*)(gbase) + (voff)[_i]), (PG8_LAS unsigned*)(lds + (bufoff) + ldsw + _i * 8192), 16, 0, 0); } while (0)
#define PG8_LDA(dst, b, h) do { _Pragma("unroll") for (int m = 0; m < 4; ++m) _Pragma("unroll") for (int k = 0; k < 2; ++k) dst[m][k] = *(const PG8_LAS bf16x8*)(lds + PG8_SA(b, h) + aoff + m * 2048 + k * 1024); } while (0)
#define PG8_LDB(dst, b, h) do { _Pragma("unroll") for (int n = 0; n < 2; ++n) _Pragma("unroll") for (int k = 0; k < 2; ++k) dst[n][k] = *(const PG8_LAS bf16x8*)(lds + PG8_SB(b, h) + boff + n * 2048 + k * 1024); } while (0)
#define PG8_MMA(ai, bj, At, Bt) do { __builtin_amdgcn_s_setprio(1); _Pragma("unroll") for (int m = 0; m < 4; ++m) _Pragma("unroll") for (int n = 0; n < 2; ++n) _Pragma("unroll") for (int k = 0; k < 2; ++k) \
        acc[ai][bj][m][n] = __builtin_amdgcn_mfma_f32_16x16x32_bf16(Bt[n][k], At[m][k], acc[ai][bj][m][n], 0, 0, 0); __builtin_amdgcn_s_setprio(0); } while (0)
#define PG8_WAIT_V(n) asm volatile("s_waitcnt vmcnt(" #n ")" ::: "memory")
#define PG8_WAIT_L(n) asm volatile("s_waitcnt lgkmcnt(" #n ")" ::: "memory")
#define PG8_BAR __builtin_amdgcn_s_barrier()
#define PG8_SCHED __builtin_amdgcn_sched_barrier(0)
    Unit cur, nxt; int ui = 0;
    if (!S.next(0, cur)) return;
    f32x4 acc[2][2][4][2];
#pragma unroll
    for (int a = 0; a < 2; ++a)
#pragma unroll
        for (int b = 0; b < 2; ++b)
#pragma unroll
            for (int m = 0; m < 4; ++m)
#pragma unroll
                for (int n = 0; n < 2; ++n) acc[a][b][m][n] = (f32x4){0.f, 0.f, 0.f, 0.f};
    bf16x8 At[4][2], B0[2][2], B1[2][2];
    const char* cA = (const char*)g.A + (size_t)cur.pm * tstep; const char* cB = (const char*)g.Bt + (size_t)cur.be * tstep;
    S.a_ready(cur);
    if constexpr (SP2) {
        PG8_STAGE(PG8_SB(0, 0), cB, voffB); PG8_STAGE(PG8_SB(0, 1), cB + hstep, voffB); PG8_STAGE(PG8_SA(0, 0), cA, voffA); PG8_STAGE(PG8_SA(0, 1), cA + hstep, voffA);
        if (wr == 1) PG8_BAR;
        PG8_WAIT_V(2); PG8_BAR;
        PG8_STAGE(PG8_SB(1, 0), cB + kstep, voffB); PG8_STAGE(PG8_SA(1, 0), cA + kstep, voffA); PG8_STAGE(PG8_SB(1, 1), cB + hstep + kstep, voffB);
        PG8_WAIT_V(6); PG8_BAR;
    } else {
        PG8_STAGE(PG8_SB(0, 0), cB, voffB); PG8_STAGE(PG8_SA(0, 0), cA, voffA); PG8_STAGE(PG8_SB(0, 1), cB + hstep, voffB); PG8_STAGE(PG8_SA(0, 1), cA + hstep, voffA);
        if (wr == 1) PG8_BAR;
        PG8_WAIT_V(4); PG8_BAR;
        PG8_STAGE(PG8_SB(1, 0), cB + kstep, voffB); PG8_STAGE(PG8_SA(1, 0), cA + kstep, voffA); PG8_STAGE(PG8_SB(1, 1), cB + hstep + kstep, voffB);
        PG8_WAIT_V(6); PG8_BAR;
    }
    for (;;) {
        const bool has_next = S.next(ui + 1, nxt);
        const char* nA = has_next ? (const char*)g.A + (size_t)nxt.pm * tstep : cA; const char* nB = has_next ? (const char*)g.Bt + (size_t)nxt.be * tstep : cB;
        for (int t = 0; t < nt; t += 2) {
            const bool last = (t == nt - 2);
            const char* a1 = cA + (size_t)(t + 1) * kstep;
            const char* a2 = last ? nA : cA + (size_t)(t + 2) * kstep; const char* b2 = last ? nB : cB + (size_t)(t + 2) * kstep;
            const char* a3 = a2 + kstep; const char* b3 = b2 + kstep;
            if (last && has_next) S.a_ready(nxt);
            if constexpr (SP2) {
            PG8_LDB(B0, 0, 0); PG8_LDB(B1, 0, 1); PG8_SCHED; PG8_LDA(At, 0, 0); PG8_STAGE(PG8_SA(1, 1), a1 + hstep, voffA);
            PG8_WAIT_V(8); PG8_WAIT_L(0); PG8_BAR; PG8_MMA(0, 0, At, B0); PG8_MMA(0, 1, At, B1); PG8_BAR; PG8_SCHED;
            PG8_LDA(At, 0, 1); PG8_STAGE(PG8_SB(0, 0), b2, voffB); PG8_STAGE(PG8_SB(0, 1), b2 + hstep, voffB); PG8_STAGE(PG8_SA(0, 0), a2, voffA);
            PG8_WAIT_V(8); PG8_WAIT_L(0); PG8_BAR; PG8_MMA(1, 0, At, B0); PG8_MMA(1, 1, At, B1); PG8_BAR; PG8_SCHED;
            PG8_LDB(B0, 1, 0); PG8_LDB(B1, 1, 1); PG8_SCHED; PG8_LDA(At, 1, 0); PG8_STAGE(PG8_SA(0, 1), a2 + hstep, voffA);
            PG8_WAIT_V(8); PG8_WAIT_L(0); PG8_BAR; PG8_MMA(0, 0, At, B0); PG8_MMA(0, 1, At, B1); PG8_BAR; PG8_SCHED;
            PG8_LDA(At, 1, 1); PG8_STAGE(PG8_SB(1, 0), b3, voffB); PG8_STAGE(PG8_SB(1, 1), b3 + hstep, voffB); PG8_STAGE(PG8_SA(1, 0), a3, voffA);
            PG8_WAIT_V(8); PG8_WAIT_L(0); PG8_BAR; PG8_MMA(1, 0, At, B0); PG8_MMA(1, 1, At, B1); PG8_BAR; PG8_SCHED;
            } else {
            PG8_LDB(B0, 0, 0); PG8_SCHED; PG8_LDA(At, 0, 0); PG8_STAGE(PG8_SA(1, 1), a1 + hstep, voffA);
            PG8_WAIT_L(8); PG8_BAR; PG8_WAIT_L(0); PG8_MMA(0, 0, At, B0); PG8_BAR; PG8_SCHED;
            PG8_LDB(B1, 0, 1); PG8_STAGE(PG8_SB(0, 0), b2, voffB);
            PG8_BAR; PG8_WAIT_L(0); PG8_MMA(0, 1, At, B1); PG8_BAR;
            PG8_LDA(At, 0, 1); PG8_STAGE(PG8_SA(0, 0), a2, voffA);
            PG8_BAR; PG8_WAIT_L(0); PG8_MMA(1, 0, At, B0); PG8_BAR; PG8_SCHED;
            PG8_STAGE(PG8_SB(0, 1), b2 + hstep, voffB);
            PG8_WAIT_V(6); PG8_BAR; PG8_MMA(1, 1, At, B1); PG8_BAR;
            PG8_LDB(B0, 1, 0); PG8_SCHED; PG8_LDA(At, 1, 0); PG8_STAGE(PG8_SA(0, 1), a2 + hstep, voffA);
            PG8_WAIT_L(8); PG8_BAR; PG8_WAIT_L(0); PG8_MMA(0, 0, At, B0); PG8_BAR; PG8_SCHED;
            PG8_LDB(B1, 1, 1); PG8_STAGE(PG8_SB(1, 0), b3, voffB);
            PG8_BAR; PG8_WAIT_L(0); PG8_MMA(0, 1, At, B1); PG8_BAR;
            PG8_LDA(At, 1, 1); PG8_STAGE(PG8_SA(1, 0), a3, voffA);
            PG8_BAR; PG8_WAIT_L(0); PG8_MMA(1, 0, At, B0); PG8_BAR; PG8_SCHED;
            PG8_STAGE(PG8_SB(1, 1), b3 + hstep, voffB);
            PG8_WAIT_V(6); PG8_BAR; PG8_MMA(1, 1, At, B1); PG8_BAR;
            }
        }
        if constexpr (ALIGN_EPI) { if (wr == 0) PG8_BAR; }
        if constexpr (!Epi::AFTER_DRAIN) { E(acc, cur, wr, wc, fr, fq); S.done(cur); }
        if (!has_next) break;
#pragma unroll
        for (int a = 0; a < 2; ++a)
#pragma unroll
            for (int b = 0; b < 2; ++b)
#pragma unroll
                for (int m = 0; m < 4; ++m)
#pragma unroll
                    for (int n = 0; n < 2; ++n) acc[a][b][m][n] = (f32x4){0.f, 0.f, 0.f, 0.f};
        cur = nxt; cA = nA; cB = nB; ++ui;
        if constexpr (ALIGN_EPI) { if (wr == 1) PG8_BAR; }
    }
    PG8_WAIT_V(0);
    if constexpr (!ALIGN_EPI) { if (wr == 0) PG8_BAR; }
    PG8_BAR;
    if constexpr (Epi::AFTER_DRAIN) { E.fused(acc, cur, wr, wc, fr, fq, lds, wid, lane); S.done(cur); }
#undef PG8_SA
#undef PG8_SB
#undef PG8_STAGE
#undef PG8_LDA
#undef PG8_LDB
#undef PG8_MMA
#undef PG8_WAIT_V
#undef PG8_WAIT_L
#undef PG8_BAR
#undef PG8_SCHED
}
}

#ifndef PG8_SP2
#define PG8_SP2 true
#endif
#ifndef PG8_ALIGN
#define PG8_ALIGN true
#endif
#include <cmath>
namespace attn_body {
using bf16=__hip_bfloat16;
using bf16x8=__attribute__((ext_vector_type(8)))short;
using s16x4=__attribute__((ext_vector_type(4)))short;
using f32x16=__attribute__((ext_vector_type(16)))float;
using u32x4=__attribute__((ext_vector_type(4)))unsigned;
constexpr int NHEAD=8,SEQQ=8192,SEQK=8448,D=64,QP=512,KP=128;
constexpr int NW=8,QBLK=32,QB=QBLK*NW,KVBLK=64,NQB=SEQQ/QB;
constexpr int ATTN_UNIT_ROWS=QB;
__device__ __forceinline__ int crow(int r,int hi){return (r&3)+8*(r>>2)+4*hi;}
#define SBAR() __builtin_amdgcn_sched_barrier(0)
__device__ __forceinline__ void cmask(f32x16&p0,f32x16&p1,int jb,int qrel,int hi){
  const float NEG=-INFINITY; int kb=64*jb+4*hi;
  #pragma unroll
  for(int r=0;r<16;++r){int kv=kb+(r&3)+8*(r>>2); if(kv>qrel)p0[r]=NEG; if(kv+32>qrel)p1[r]=NEG;}
}

constexpr int NSLOT=3, SLOTB=8192;
constexpr int LDS_K=0, LDS_V=NSLOT*SLOTB, LDS_WS=2*NSLOT*SLOTB, LDS_OST=LDS_WS+NW*64*4, LDS_BYTES=LDS_OST+NW*4096;
constexpr float C2=0.125f*1.4426950408889634f;
__device__ __forceinline__ void glds16(const void*gsrc,unsigned lds_dst){unsigned keep;
  asm volatile("s_mov_b32 %0, m0\n\ts_mov_b32 m0, %2\n\ts_nop 0\n\tglobal_load_lds_dwordx4 %1, off\n\ts_mov_b32 m0, %0":"=&s"(keep):"v"(gsrc),"s"(lds_dst):"memory");}
__device__ __forceinline__ float max3f(float a,float b,float c){float r;asm("v_max3_f32 %0, %1, %2, %3":"=v"(r):"v"(a),"v"(b),"v"(c));return r;}
__device__ __forceinline__ float max2f(float a,float b){float r;asm("v_max_f32_e32 %0, %1, %2":"=v"(r):"v"(a),"v"(b));return r;}
__device__ __forceinline__ float fadd_s(float a,float b){float r;asm("v_add_f32_e32 %0, %1, %2":"=v"(r):"v"(a),"v"(b));return r;}
__device__ __forceinline__ float fsub_s(float a,float b){float r;asm("v_sub_f32_e32 %0, %1, %2":"=v"(r):"v"(a),"v"(b));return r;}
typedef float f32x2_t __attribute__((ext_vector_type(2))); typedef __bf16 bf16x2_t __attribute__((ext_vector_type(2)));
__device__ __forceinline__ unsigned cvtpk_s(float lo,float hi){f32x2_t v={lo,hi};bf16x2_t b=__builtin_convertvector(v,bf16x2_t);return __builtin_bit_cast(unsigned,b);}
#define WAIT_BAR(N) asm volatile("s_waitcnt vmcnt(" #N ") lgkmcnt(0)\n\ts_barrier":::"memory")

__device__ __forceinline__ void qkt(f32x16&p0,f32x16&p1,const char*Kslot,const bf16x8*qr,const f32x16&negm,int r32,int hi){
  const char*kb=Kslot+hi*1024+r32*16;
  #pragma unroll
  for(int d0=0;d0<4;++d0){
    const bf16x8 b0=*reinterpret_cast<const bf16x8*>(kb+d0*2048);
    const bf16x8 b1=*reinterpret_cast<const bf16x8*>(kb+d0*2048+512);
    if(d0==0){p0=__builtin_amdgcn_mfma_f32_32x32x16_bf16(b0,qr[0],negm,0,0,0);p1=__builtin_amdgcn_mfma_f32_32x32x16_bf16(b1,qr[0],negm,0,0,0);}
    else{p0=__builtin_amdgcn_mfma_f32_32x32x16_bf16(b0,qr[d0],p0,0,0,0);p1=__builtin_amdgcn_mfma_f32_32x32x16_bf16(b1,qr[d0],p1,0,0,0);}}
}
typedef __attribute__((address_space(3))) const char* lds_cptr;
typedef short v4i16_t __attribute__((ext_vector_type(4)));
__device__ __forceinline__ void kload8(bf16x8*kf,lds_cptr kp){
  kf[0]=*(const __attribute__((address_space(3))) bf16x8*)(kp);      kf[1]=*(const __attribute__((address_space(3))) bf16x8*)(kp+512);
  kf[2]=*(const __attribute__((address_space(3))) bf16x8*)(kp+2048); kf[3]=*(const __attribute__((address_space(3))) bf16x8*)(kp+2560);
  kf[4]=*(const __attribute__((address_space(3))) bf16x8*)(kp+4096); kf[5]=*(const __attribute__((address_space(3))) bf16x8*)(kp+4608);
  kf[6]=*(const __attribute__((address_space(3))) bf16x8*)(kp+6144); kf[7]=*(const __attribute__((address_space(3))) bf16x8*)(kp+6656);
}
__device__ __forceinline__ void kload2(bf16x8*kf,lds_cptr kp,int j){ kf[2*j]=*(const __attribute__((address_space(3))) bf16x8*)(kp+j*2048); kf[2*j+1]=*(const __attribute__((address_space(3))) bf16x8*)(kp+j*2048+512); }
__device__ __forceinline__ s16x4 vtr(lds_cptr p){ return __builtin_bit_cast(s16x4,__builtin_amdgcn_ds_read_tr16_b64_v4i16((__attribute__((address_space(3))) v4i16_t*)p)); }
__device__ __forceinline__ float rowmax(const f32x16&p0,const f32x16&p1){
  float a=max3f(p0[0],p0[1],p1[0]),b=max3f(p0[2],p0[3],p1[1]);a=max3f(a,p1[2],p1[3]);
  #pragma unroll
  for(int r=4;r<16;r+=4){a=max3f(a,p0[r],p0[r+1]);b=max3f(b,p0[r+2],p0[r+3]);a=max3f(a,p1[r],p1[r+1]);b=max3f(b,p1[r+2],p1[r+3]);}
  const float m=max2f(a,b);
  auto rr=__builtin_amdgcn_permlane32_swap(__float_as_uint(m),__float_as_uint(m),false,false);
  return max2f(__uint_as_float(rr[0]),__uint_as_float(rr[1]));
}
__device__ __forceinline__ void pv(f32x16*o,int vb,bf16x8 pa0,bf16x8 pa1,bf16x8 pa2,bf16x8 pa3){
  #pragma unroll
  for(int d0=0;d0<2;++d0){s16x4 lo[4],hi[4];
    #pragma unroll
    for(int ks=0;ks<4;++ks){
      asm volatile("ds_read_b64_tr_b16 %0,%1 offset:%c2":"=&v"(lo[ks]):"v"(vb),"i"(d0*4096+ks*1024):"memory");
      asm volatile("ds_read_b64_tr_b16 %0,%1 offset:%c2":"=&v"(hi[ks]):"v"(vb),"i"(d0*4096+ks*1024+512):"memory");}
    asm volatile("s_waitcnt lgkmcnt(0)":::"memory");SBAR();
    #define PK(k) (bf16x8){lo[k][0],lo[k][1],lo[k][2],lo[k][3],hi[k][0],hi[k][1],hi[k][2],hi[k][3]}
    o[d0]=__builtin_amdgcn_mfma_f32_32x32x16_bf16(pa0,PK(0),o[d0],0,0,0);
    o[d0]=__builtin_amdgcn_mfma_f32_32x32x16_bf16(pa1,PK(1),o[d0],0,0,0);
    o[d0]=__builtin_amdgcn_mfma_f32_32x32x16_bf16(pa2,PK(2),o[d0],0,0,0);
    o[d0]=__builtin_amdgcn_mfma_f32_32x32x16_bf16(pa3,PK(3),o[d0],0,0,0);
    #undef PK
  }
}

#ifndef ATTN_STORE16
#define ATTN_STORE16(p,v) (*(u32x4*)(p)=(v))
#endif
template<int THRL> __device__ __forceinline__ void attn_unit(int b,int h,int qb,const bf16*Q,const bf16*__restrict__ K,const bf16*__restrict__ V,bf16*O,char*shm){
  int tid_=threadIdx.x; asm volatile("":"+v"(tid_)); const int tid=tid_,lane=tid&63,r32=lane&31,hi=lane>>5; const int wid=__builtin_amdgcn_readfirstlane(tid>>6);
  const long qrowbase=(long)b*SEQQ, krowbase=(long)b*SEQK; const int q0=qb*QB, kvh=h>>2;
  const bf16*Qw=Q+(qrowbase+q0+wid*QBLK)*QP+h*D;
  const bf16*Kh=K+krowbase*KP+kvh*D,*Vh=V+krowbase*KP+kvh*D;
  const unsigned lds0=(unsigned)(uintptr_t)shm;
  float*wsf=(float*)(shm+LDS_WS)+wid*64;
  const bf16*ksrc=Kh+(long)lane*KP+wid*8;
  const bf16*vsrc=Vh+(long)(16*(wid&3)+(lane>>2))*KP+(wid>>2)*32+(lane&3)*8;
  const unsigned kdst=lds0+LDS_K+wid*1024, vdst=lds0+LDS_V+wid*1024;
  #define DMA_K(t,slot) glds16(ksrc+(long)(t)*KVBLK*KP,(unsigned)__builtin_amdgcn_readfirstlane(kdst+(slot)))
  #define DMA_V(t,slot) glds16(vsrc+(long)(t)*KVBLK*KP,(unsigned)__builtin_amdgcn_readfirstlane(vdst+(slot)))
  const int vb0=(int)(lds0+LDS_V)+((lane>>4)&1)*32+(lane&3)*8+(4*hi+((lane&15)>>2))*64;
  const char*Kbase=shm+LDS_K; bf16x8 kf[8];
  const lds_cptr shm3=(lds_cptr)shm; const lds_cptr kp0=shm3+LDS_K+hi*1024+r32*16; const lds_cptr vp0=shm3+LDS_V+((lane>>4)&1)*32+(lane&3)*8+(4*hi+((lane&15)>>2))*64;
  const int NT=SEQK/KVBLK;
  DMA_K(0,0);DMA_V(0,0);DMA_K(1,SLOTB);
  bf16x8 qr[4];
  #pragma unroll
  for(int d0=0;d0<4;++d0)qr[d0]=*reinterpret_cast<const bf16x8*>(&Qw[(long)r32*QP+d0*16+hi*8]);
  float mhat=0.f,l_reg=0.f;f32x16 o[2];o[0]=f32x16{};o[1]=f32x16{};f32x16 negm=f32x16{};asm volatile("":"+v"(negm));
  const int qrel=wid*QBLK+r32;
  #define CMASK(P0,P1,t) do{}while(0)
  bool resc=false;
  #define START(P0,P1) do{ const float rm=rowmax(P0,P1); resc=false; \
    { const float dl=rm; mhat=fadd_s(mhat,dl); \
      _Pragma("unroll") for(int r=0;r<16;++r){P0[r]=fsub_s(P0[r],dl);P1[r]=fsub_s(P1[r],dl);} \
      _Pragma("unroll") for(int r=0;r<16;++r)negm[r]=-mhat; asm volatile("":"+v"(negm)); } \
    _Pragma("unroll") for(int r=0;r<16;++r)P0[r]=__builtin_amdgcn_exp2f(P0[r]); }while(0)
  #define RESC() do{ if(resc){ asm volatile("s_waitcnt lgkmcnt(0)":::"memory"); \
      _Pragma("unroll") for(int d_=0;d_<2;++d_) _Pragma("unroll") for(int r=0;r<16;++r)o[d_][r]*=wsf[crow(r,hi)]; } }while(0)
  f32x16 pA0,pA1,pB0,pB1;
  int sl_prev=0,sl_cur=0,sl_next=SLOTB;
  #define ROT() do{sl_prev=sl_cur;sl_cur=sl_next;sl_next=(sl_next==(NSLOT-1)*SLOTB)?0:sl_next+SLOTB;}while(0)
  DMA_K(2,2*SLOTB);
  WAIT_BAR(3);
  qkt(pA0,pA1,Kbase,qr,negm,r32,hi);asm volatile("s_nop 15\n\ts_nop 7":"+v"(pA0),"+v"(pA1));CMASK(pA0,pA1,0);
  START(pA0,pA1);
  _Pragma("unroll") for(int r=0;r<16;++r)pA1[r]=__builtin_amdgcn_exp2f(pA1[r]);
  WAIT_BAR(0);
  DMA_K(3,0);DMA_V(1,SLOTB);
  ROT();
  kload8(kf,kp0+sl_cur);
  WAIT_BAR(2);
  s16x4 vlo[8],vhi[8]; u32x4 pw0,pw1,pw2,pw3;
  #define PKW(P,B) cvtpk_s(P[B],P[B+1])
  #define PAF(k) __builtin_bit_cast(bf16x8,pw##k)
  #define VFR(i) (bf16x8){vlo[i][0],vlo[i][1],vlo[i][2],vlo[i][3],vhi[i][0],vhi[i][1],vhi[i][2],vhi[i][3]}
  #define PIN(x) asm volatile("":"+v"(x))
  #define MX3(a,b,c) __builtin_fmaxf(__builtin_fmaxf((a),(b)),(c))
  #define GAPA(MF,A0,A1,A2,A3,W0,W1,PW) do{ MF; sacc+=A0; sacc+=A1; sacc+=A2; sacc+=A3; PIN(sacc); W0; W1; PIN(PW); SBAR(); }while(0)
  #define EX(v) __builtin_amdgcn_exp2f(v)
  #define GAPB(MF,X,B) do{ MF; X[B]=EX(X[B]); X[B+1]=EX(X[B+1]); X[B+2]=EX(X[B+2]); X[B+3]=EX(X[B+3]); PIN(X); SBAR(); }while(0)
  #define VRD(i) do{ vlo[i]=vtr(vp_+(((i)>>2)*4096+((i)&3)*1024)); vhi[i]=vtr(vp_+(((i)>>2)*4096+((i)&3)*1024+512)); }while(0)
  #define KRD(G,j) do{ if(G){ kload2(kf,kp0+sl_next,j); SBAR(); } }while(0)
  #define STEP(C0,C1,P0,P1,t,GK,GV,GL) do{ SBAR(); \
    const lds_cptr vp_=vp0+sl_prev; \
    VRD(0); SBAR(); float sacc=(P0[0]+P0[1]); \
    GAPA(C0=__builtin_amdgcn_mfma_f32_32x32x16_bf16(kf[0],qr[0],negm,0,0,0), P0[2],P0[3],P0[4],P0[5],     pw0[0]=PKW(P0,0), pw0[1]=PKW(P0,2), pw0); \
    VRD(4); SBAR(); GAPA(C1=__builtin_amdgcn_mfma_f32_32x32x16_bf16(kf[1],qr[0],negm,0,0,0), P0[6],P0[7],P0[8],P0[9],     pw0[2]=PKW(P0,4), pw0[3]=PKW(P0,6), pw0); \
    VRD(1); SBAR(); GAPA(C0=__builtin_amdgcn_mfma_f32_32x32x16_bf16(kf[2],qr[1],C0,0,0,0),   P0[10],P0[11],P0[12],P0[13], pw1[0]=PKW(P0,8), pw1[1]=PKW(P0,10), pw1); \
    VRD(5); SBAR(); GAPA(C1=__builtin_amdgcn_mfma_f32_32x32x16_bf16(kf[3],qr[1],C1,0,0,0),   P0[14],P0[15],P1[0],P1[1],   pw1[2]=PKW(P0,12),pw1[3]=PKW(P0,14), pw1); \
    VRD(2); SBAR(); GAPA(C0=__builtin_amdgcn_mfma_f32_32x32x16_bf16(kf[4],qr[2],C0,0,0,0),   P1[2],P1[3],P1[4],P1[5],     pw2[0]=PKW(P1,0), pw2[1]=PKW(P1,2), pw2); \
    VRD(6); SBAR(); GAPA(C1=__builtin_amdgcn_mfma_f32_32x32x16_bf16(kf[5],qr[2],C1,0,0,0),   P1[6],P1[7],P1[8],P1[9],     pw2[2]=PKW(P1,4), pw2[3]=PKW(P1,6), pw2); \
    VRD(3); SBAR(); GAPA(C0=__builtin_amdgcn_mfma_f32_32x32x16_bf16(kf[6],qr[3],C0,0,0,0),   P1[10],P1[11],P1[12],P1[13], pw3[0]=PKW(P1,8), pw3[1]=PKW(P1,10), pw3); \
    VRD(7); SBAR(); GAPA(C1=__builtin_amdgcn_mfma_f32_32x32x16_bf16(kf[7],qr[3],C1,0,0,0),   P1[14],P1[15],0.f,0.f,       pw3[2]=PKW(P1,12),pw3[3]=PKW(P1,14), pw3); \
    l_reg+=sacc; \
    if(GK){DMA_K((t)+3,sl_cur);} if(GV){DMA_V((t)+1,sl_next);} \
    CMASK(C0,C1,t); \
    { float a=MX3(C0[0],C0[1],C1[0]),b=MX3(C0[2],C0[3],C1[1]); a=MX3(a,C1[2],C1[3]); \
      _Pragma("unroll") for(int r=4;r<16;r+=4){a=MX3(a,C0[r],C0[r+1]);b=MX3(b,C0[r+2],C0[r+3]);a=MX3(a,C1[r],C1[r+1]);b=MX3(b,C1[r+2],C1[r+3]);} \
      float rm=__builtin_fmaxf(a,b); { auto rr=__builtin_amdgcn_permlane32_swap(__float_as_uint(rm),__float_as_uint(rm),false,false); rm=__builtin_fmaxf(__uint_as_float(rr[0]),__uint_as_float(rr[1])); } \
      resc=false; \
      if(__builtin_expect(__any(rm>(float)THRL),0)){ const float dl=__builtin_fmaxf(rm,0.f); mhat+=dl; \
        _Pragma("unroll") for(int r=0;r<16;++r){C0[r]-=dl;C1[r]-=dl;} \
        _Pragma("unroll") for(int r=0;r<16;++r)negm[r]=-mhat; asm volatile("":"+v"(negm)); \
        const float f=__builtin_amdgcn_exp2f(-dl); l_reg*=f; if(hi==0)wsf[r32]=f; resc=true; } } \
    SBAR(); \
    GAPB(o[0]=__builtin_amdgcn_mfma_f32_32x32x16_bf16(PAF(0),VFR(0),o[0],0,0,0), C0,0); \
    GAPB(o[1]=__builtin_amdgcn_mfma_f32_32x32x16_bf16(PAF(0),VFR(4),o[1],0,0,0), C0,4); \
    KRD(GL,0); GAPB(o[0]=__builtin_amdgcn_mfma_f32_32x32x16_bf16(PAF(1),VFR(1),o[0],0,0,0), C0,8); \
    KRD(GL,1); GAPB(o[1]=__builtin_amdgcn_mfma_f32_32x32x16_bf16(PAF(1),VFR(5),o[1],0,0,0), C0,12); \
    KRD(GL,2); GAPB(o[0]=__builtin_amdgcn_mfma_f32_32x32x16_bf16(PAF(2),VFR(2),o[0],0,0,0), C1,0); \
    KRD(GL,3); GAPB(o[1]=__builtin_amdgcn_mfma_f32_32x32x16_bf16(PAF(2),VFR(6),o[1],0,0,0), C1,4); \
    GAPB(o[0]=__builtin_amdgcn_mfma_f32_32x32x16_bf16(PAF(3),VFR(3),o[0],0,0,0), C1,8); \
    GAPB(o[1]=__builtin_amdgcn_mfma_f32_32x32x16_bf16(PAF(3),VFR(7),o[1],0,0,0), C1,12); \
    }while(0)
  int t=1;
  #undef CMASK
  #define CMASK(P0,P1,t) do{}while(0)
  for(;t+5<NT;t+=2){
    STEP(pB0,pB1,pA0,pA1,t,true,true,true);     WAIT_BAR(2); RESC(); ROT();
    STEP(pA0,pA1,pB0,pB1,t+1,true,true,true);   WAIT_BAR(2); RESC(); ROT();
  }
  #undef CMASK
  #define CMASK(P0,P1,t) do{}while(0)
  #define ENDW(tt) do{ if((tt)+3<NT){WAIT_BAR(2);} else if((tt)+2<NT){WAIT_BAR(1);} else {WAIT_BAR(0);} }while(0)
  for(;t+1<NT;t+=2){
    STEP(pB0,pB1,pA0,pA1,t,(t+3<NT),(t+1<NT),(t+1<NT));       ENDW(t);   RESC(); ROT();
    STEP(pA0,pA1,pB0,pB1,t+1,(t+4<NT),(t+2<NT),(t+2<NT));     ENDW(t+1); RESC(); ROT();
  }
  STEP(pB0,pB1,pA0,pA1,NT-1,false,false,false); RESC();
  { float sacc=pB0[0]+pB0[1]; _Pragma("unroll") for(int r=2;r<16;++r)sacc+=pB0[r]; _Pragma("unroll") for(int r=0;r<16;++r)sacc+=pB1[r]; l_reg+=sacc;
    pw0=(u32x4){PKW(pB0,0),PKW(pB0,2),PKW(pB0,4),PKW(pB0,6)};pw1=(u32x4){PKW(pB0,8),PKW(pB0,10),PKW(pB0,12),PKW(pB0,14)};pw2=(u32x4){PKW(pB1,0),PKW(pB1,2),PKW(pB1,4),PKW(pB1,6)};pw3=(u32x4){PKW(pB1,8),PKW(pB1,10),PKW(pB1,12),PKW(pB1,14)};
    SBAR(); pv(o,vb0+sl_cur,PAF(0),PAF(1),PAF(2),PAF(3)); }
  #undef PKW
  #undef PAF
  #undef VFR
  #undef PIN
  #undef MX3
  #undef GAPA
  #undef GAPB
  #undef EX
  #undef VRD
  #undef KRD
  #undef STEP
  #undef ENDW
  {auto rr=__builtin_amdgcn_permlane32_swap(__float_as_uint(l_reg),__float_as_uint(l_reg),false,false);l_reg=__uint_as_float(rr[0])+__uint_as_float(rr[1]);}
  if(hi==0)wsf[32+r32]=l_reg;asm volatile("s_waitcnt lgkmcnt(0)":::"memory");
  float rli[16];
  #pragma unroll
  for(int r=0;r<16;++r)rli[r]=__builtin_amdgcn_rcpf(wsf[32+crow(r,hi)]);
  bf16*Ow=O+(qrowbase+q0+wid*QBLK)*QP+h*D;
  { bf16*stg=(bf16*)(shm+LDS_OST)+wid*2048;
    #pragma unroll
    for(int r=0;r<16;++r){const int orow=crow(r,hi);
      #pragma unroll
      for(int d0=0;d0<2;++d0)stg[orow*64+d0*32+r32]=__float2bfloat16(o[d0][r]*rli[r]);}
    asm volatile("s_waitcnt lgkmcnt(0)":::"memory");
    #pragma unroll
    for(int i=0;i<4;++i){const int row=i*8+(lane>>3),ch=lane&7; const u32x4 v=*(const u32x4*)(stg+row*64+ch*8); ATTN_STORE16(Ow+(long)row*QP+ch*8,v);} }
  asm volatile("s_waitcnt lgkmcnt(0)\n\ts_barrier":::"memory");
  #undef DMA_K
  #undef DMA_V
  #undef CMASK
  #undef START
  #undef RESC
  #undef ROT
}
constexpr int ATTN_LDS_BYTES=LDS_BYTES;
struct AttnTensors { const bf16* Q; const bf16* K; const bf16* V; bf16* O; };
template<int THRL=8> __device__ __forceinline__ void attn_phase(char*lds,const AttnTensors&T,int G,int vcu){
  const int total=4*NHEAD*NQB;
  for(int i=0;;++i){
    int x,n;
    if(G==256){ if(i>=4)break; x=vcu>>5; n=i*32+(vcu&31); }
    else { const int u=i*G+vcu; if(u>=total)break; x=u>>7; n=u&127; }
    const int b=x>>1,kvh=x&1,h=kvh*4+(n>>5),qb=n&31;
    attn_unit<THRL>(b,h,qb,T.Q,T.K,T.V,T.O,lds);
  }
}
#undef SBAR
#undef WAIT_BAR
}

constexpr int NWAVES = 8, NTHR = 512;
constexpr int DMODEL = 1024, NB = 4, SEQ = 8192, CTXL = 256, NLAT = NB * SEQ, NCTX = NB * CTXL, MT = NLAT + NCTX;
constexpr int INW = 2048, NE = 32, KEYS = SEQ + CTXL;
constexpr int SORT_TILES = 560, SORT_ROWS = SORT_TILES * 256;
constexpr float EPSN = 1e-6f;
constexpr int NCHUNK = 66, CHUNK = 128;
constexpr int NPH_LAYER = 14, NPH = 2 + 2 * NPH_LAYER;

constexpr size_t MiB = 1u << 20;
constexpr size_t WS_CTL = 0, CTL_ZERO_BYTES = 1 * MiB;
constexpr size_t WS_MOD = 1 * MiB, WS_ROPEC = 2 * MiB, WS_ROPES = 3 * MiB, WS_H2 = 4 * MiB, WS_KFC = 10 * MiB, WS_BLKCNT = 12 * MiB, WS_TILEE = 13 * MiB, WS_SCANS = 14 * MiB;
constexpr size_t WS_WINT = 16 * MiB, WS_WOUTT = 24 * MiB, WS_W1T = 32 * MiB, WS_W2T = 288 * MiB, WS_KF = 416 * MiB, WS_KHAT = 448 * MiB, WS_XR = 512 * MiB, WS_H = 644 * MiB;
constexpr size_t WS_U = 712 * MiB, WS_Q = 844 * MiB, WS_K = 877 * MiB, WS_V = 886 * MiB, WS_ATT = 895 * MiB, WS_LAB = 928 * MiB, WS_LRUO = 1060 * MiB, WS_VT = 1093 * MiB, WS_X0T = 1125 * MiB,
                 WS_HYO = 1157 * MiB, WS_MIXA = 1190 * MiB;
constexpr size_t WS_F = 712 * MiB, WS_ASORT = 778 * MiB, WS_ACT = 1058 * MiB, WS_YS = 1338 * MiB, WS_TOPI = 1618 * MiB, WS_GATE = 1619 * MiB, WS_POS = 1620 * MiB, WS_END = 1622 * MiB;
constexpr size_t LAB_STRIDE = (size_t)MT * 256;
constexpr int CW_BAR = 4096;
constexpr int CW_NTILES = 64;

constexpr int RING_OFF = 0, RING_BYTES = 131072, MOETAB_OFF = 131072, LDSCTL_OFF = 155648, LDS_BYTES = 156160;

#define GAS __attribute__((address_space(1)))
#define LAS __attribute__((address_space(3)))
typedef unsigned short bf16;
typedef unsigned v4u __attribute__((ext_vector_type(4)));
typedef unsigned v2u __attribute__((ext_vector_type(2)));
typedef float f32x4 __attribute__((ext_vector_type(4)));
#define LDS_WAIT() asm volatile("s_waitcnt lgkmcnt(0)" ::: "memory")
#define VM_WAIT() asm volatile("s_waitcnt vmcnt(0)" ::: "memory")
__device__ __forceinline__ unsigned f2bf(float f) { unsigned u = __builtin_bit_cast(unsigned, f); return (u + 0x7fffu + ((u >> 16) & 1u)) >> 16; }
__device__ __forceinline__ unsigned pk2(float lo, float hi) { return f2bf(lo) | (f2bf(hi) << 16); }
__device__ __forceinline__ float bf2f(unsigned short b) { return __builtin_bit_cast(float, (unsigned)b << 16); }
__device__ __forceinline__ float bflo(unsigned w) { return __builtin_bit_cast(float, w << 16); }
__device__ __forceinline__ float bfhi(unsigned w) { return __builtin_bit_cast(float, w & 0xffff0000u); }
__device__ __forceinline__ float wave_sum(float v) {
#pragma unroll
    for (int o = 1; o < 64; o <<= 1) v += __shfl_xor(v, o);
    return v;
}
__device__ __forceinline__ float sigmoidf_(float x) { return 1.0f / (1.0f + __expf(-x)); }
__device__ __forceinline__ void sincos_d(double x, double& s, double& c) {
    const double kd = __builtin_rint(x * 0.63661977236758134308);
    const int k = (int)kd;
    double r = __builtin_fma(-kd, 1.57079632673412561417e+00, x);
    r = __builtin_fma(-kd, 6.07710050650619224932e-11, r);
    const double z = r * r;
    const double ps = r + r * z * (-1.66666666666666324348e-01 + z * (8.33333333332248946124e-03 + z * (-1.98412698298579493134e-04 + z * (2.75573137070700676789e-06 + z * (-2.50507602534068634195e-08 + z * 1.58969099521155010221e-10)))));
    const double pc = 1.0 - 0.5 * z + z * z * (4.16666666666666019037e-02 + z * (-1.38888888888741095749e-03 + z * (2.48015872894767294178e-05 + z * (-2.75573143513906633035e-07 + z * (2.08757232129817482790e-09 + z * -1.13596475577881948265e-11)))));
    const int q = k & 3;
    s = (q == 0) ? ps : (q == 1) ? pc : (q == 2) ? -ps : -pc;
    c = (q == 0) ? pc : (q == 1) ? -ps : (q == 2) ? -pc : ps;
}
__device__ __forceinline__ float gelu_tanh(float x) {
    const float u = 0.7978845608028654f * (x + 0.044715f * x * x * x);
    const float t = 1.0f - 2.0f / (1.0f + __expf(2.0f * u));
    return 0.5f * x * (1.0f + t);
}
__device__ __forceinline__ int lds_add(LAS int* p, int v) { return __hip_atomic_fetch_add(p, v, __ATOMIC_RELAXED, __HIP_MEMORY_SCOPE_WORKGROUP); }
#define XB_TMO      128
#define XB_XCNT(j)  (256  + 64 * (j))
#define XB_XSUB(j)  (1280 + 64 * (j))
#define XB_XGEN(j)  (2304 + 64 * (j))
#define XB_TOP      3328
#define XB_TOPGEN   3392
#define XCD_BAR_WORDS 3456
#define XB_SPIN_CAP (1u << 22)

__device__ __forceinline__ unsigned xb_ld(unsigned* p)              { return __hip_atomic_load(p, __ATOMIC_RELAXED, __HIP_MEMORY_SCOPE_AGENT); }
__device__ __forceinline__ unsigned xb_add(unsigned* p, unsigned v) { return __hip_atomic_fetch_add(p, v, __ATOMIC_RELAXED, __HIP_MEMORY_SCOPE_AGENT); }
__device__ __forceinline__ unsigned xb_xcc_id() { return (unsigned)__builtin_amdgcn_s_getreg((3 << 11) | 20) & 0xFu; }
#define XB_SPIN(cond, bar) do { unsigned _sp = 0; while (cond) { __builtin_amdgcn_s_sleep(1); \
    if ((++_sp & 255u) == 0u) { if (xb_ld(&(bar)[XB_TMO])) break; if (_sp > XB_SPIN_CAP) { atomicAdd(&(bar)[XB_TMO], 1u); break; } } } } while (0)

struct XcdBarrier {
    unsigned* bar; unsigned x;
    volatile LAS unsigned* st;
};

__device__ __forceinline__ XcdBarrier xcd_barrier_post(unsigned* bar, volatile LAS unsigned* st) {
    XcdBarrier b; b.bar = bar; b.x = xb_xcc_id(); b.st = st;
    if (threadIdx.x == 0) (void)xb_add(&bar[XB_XCNT(b.x)], 1u);
    return b;
}
__device__ __forceinline__ void xcd_barrier_complete(unsigned* bar, unsigned x, unsigned& nloc, unsigned& nx) {
    const unsigned G = gridDim.x * gridDim.y * gridDim.z;
    unsigned sum, cnt, mine, sp = 0u;
    for (;;) {
        sum = 0u; cnt = 0u; mine = 0u;
#pragma unroll
        for (unsigned j = 0; j < 16; ++j) { const unsigned c = xb_ld(&bar[XB_XCNT(j)]); sum += c; cnt += (c > 0u) ? 1u : 0u; mine = (j == x) ? c : mine; }
        if (sum == G) break;
        __builtin_amdgcn_s_sleep(1);
        if ((++sp & 255u) == 0u) { if (xb_ld(&bar[XB_TMO])) break; if (sp > XB_SPIN_CAP) { atomicAdd(&bar[XB_TMO], 1u); break; } }
    }
    nloc = mine > 0u ? mine : 1u; nx = cnt > 0u ? cnt : 1u;
}

__device__ __forceinline__ void xcd_barrier(const XcdBarrier& b) {
    asm volatile("s_waitcnt vmcnt(0)" ::: "memory");
    __syncthreads();
    if (threadIdx.x == 0) {
        unsigned* bar = b.bar;
        __builtin_amdgcn_s_waitcnt(0);
        unsigned nloc = b.st[0], nx = b.st[1];
        if (nloc == 0u) { xcd_barrier_complete(bar, b.x, nloc, nx); b.st[0] = nloc; b.st[1] = nx; }
        const unsigned old = xb_add(&bar[XB_XSUB(b.x)], 1u);
        const unsigned gen = old / nloc;
        if (old + 1u == (gen + 1u) * nloc) {
            __builtin_amdgcn_fence(__ATOMIC_RELEASE, "agent");
            asm volatile("s_waitcnt vmcnt(0)" ::: "memory");
            const unsigned og = xb_add(&bar[XB_TOP], 1u);
            const unsigned tg = og / nx;
            if (og + 1u == (tg + 1u) * nx) xb_add(&bar[XB_TOPGEN], 1u);
            else XB_SPIN(xb_ld(&bar[XB_TOPGEN]) == tg, bar);
            __builtin_amdgcn_fence(__ATOMIC_ACQUIRE, "agent");
            xb_add(&bar[XB_XGEN(b.x)], 1u);
            asm volatile("s_waitcnt vmcnt(0)" ::: "memory");
        } else {
            XB_SPIN(xb_ld(&bar[XB_XGEN(b.x)]) == gen, bar);
            __builtin_amdgcn_fence(__ATOMIC_ACQUIRE, "agent");
            asm volatile("s_waitcnt vmcnt(0)" ::: "memory");
        }
    }
    __syncthreads();
}


struct Frame {
    LAS unsigned char* lds; unsigned* ctl; unsigned char* ws;
    int tid, lane, wave, vcu, G, gw, ngw;
};
__device__ const float ROPE_INV[16] = {1.0f, 0.5623413251903491f, 0.31622776601683794f, 0.1778279410038923f, 0.1f, 0.05623413251903491f, 0.03162277660168379f, 0.01778279410038923f,
                                       0.01f, 0.005623413251903491f, 0.0031622776601683794f, 0.001778279410038923f, 0.001f, 0.0005623413251903491f, 0.00031622776601683794f, 0.0001778279410038923f};

__device__ __forceinline__ void p0_transpose_item(const float* W, int K, int N, bf16* WT, LAS float* scr, int item, int lane) {
    const int nblk = N / 32, kb = item / nblk, nb = item % nblk, k0 = 64 * kb, n0 = 32 * nb;
#pragma unroll 8
    for (int i = 0; i < 32; ++i) { const int kk = 2 * i + (lane >> 5); scr[kk * 33 + (lane & 31)] = W[(size_t)(k0 + kk) * N + n0 + (lane & 31)]; }
    LDS_WAIT(); asm volatile("" ::: "memory");
    const int c = lane & 7;
#pragma unroll
    for (int j = 0; j < 4; ++j) { const int n = (lane >> 3) + 8 * j; const LAS float* s = scr + (8 * c) * 33 + n;
        v4u o; o.x = pk2(s[0 * 33], s[1 * 33]); o.y = pk2(s[2 * 33], s[3 * 33]); o.z = pk2(s[4 * 33], s[5 * 33]); o.w = pk2(s[6 * 33], s[7 * 33]);
        *(GAS v4u*)(WT + (size_t)(n0 + n) * K + k0 + 8 * c) = o; }
    LDS_WAIT(); asm volatile("" ::: "memory");
}

__device__ __forceinline__ void ph_prologue_a(const Frame& F, const float* c, const float* cctx, const float* w_mod, const float* b_mod, const float* w_in, const float* w_out,
                                              const float* moe_w1, const float* moe_w2, const float* hy_w1, const float* hy_b1, const float* hy_w2, const float* hy_b2, const float* hy_freq) {
    {
        LAS float* scr = (LAS float*)(F.lds + F.wave * 16384);
        constexpr int I_IN = 2 * 1024, I_OUT = 2 * 512, I_W1 = 64 * 1024, I_W2 = 64 * 512, NIT = I_IN + I_OUT + I_W1 + I_W2;
        bf16* WinT = (bf16*)(F.ws + WS_WINT); bf16* WoutT = (bf16*)(F.ws + WS_WOUTT); bf16* W1T = (bf16*)(F.ws + WS_W1T); bf16* W2T = (bf16*)(F.ws + WS_W2T);
        for (int it = F.gw; it < NIT; it += F.ngw) {
            int r = it;
            if (r < I_IN) { const int m = r >> 10; p0_transpose_item(w_in + (size_t)m * 1024 * 2048, 1024, 2048, WinT + (size_t)m * 2048 * 1024, scr, r & 1023, F.lane); continue; } r -= I_IN;
            if (r < I_OUT) { const int m = r >> 9; p0_transpose_item(w_out + (size_t)m * 1024 * 1024, 1024, 1024, WoutT + (size_t)m * 1024 * 1024, scr, r & 511, F.lane); continue; } r -= I_OUT;
            if (r < I_W1) { const int m = r >> 10; p0_transpose_item(moe_w1 + (size_t)m * 1024 * 2048, 1024, 2048, W1T + (size_t)m * 2048 * 1024, scr, r & 1023, F.lane); continue; } r -= I_W1;
            { const int m = r >> 9; p0_transpose_item(moe_w2 + (size_t)m * 1024 * 1024, 1024, 1024, W2T + (size_t)m * 1024 * 1024, scr, r & 511, F.lane); }
        }
    }
    __syncthreads();
    {
        LAS float* sl = (LAS float*)(F.lds);
        LAS float* red = (LAS float*)(F.lds + 20480);
        float* MOD = (float*)(F.ws + WS_MOD);
        if ((int)blockIdx.x < 192) {
            for (int i = F.tid; i < 5 * 1024; i += NTHR) { const int r = i >> 10, k = i & 1023; const float v = (r < 4) ? c[r * 1024 + k] : cctx[k]; sl[i] = v / (1.0f + __expf(-v)); }
        }
        __syncthreads();
        for (int it = blockIdx.x; it < 192; it += F.G) {
            const int l = it / 96, n = (it % 96) * 64 + F.lane;
            float a0 = 0.f, a1 = 0.f, a2 = 0.f, a3 = 0.f, a4 = 0.f;
            const float* wp = w_mod + ((size_t)l * 1024 + F.wave * 128) * 6144 + n;
#pragma unroll 8
            for (int k = 0; k < 128; ++k) { const float w = wp[(size_t)k * 6144]; const int kk = F.wave * 128 + k;
                a0 += sl[kk] * w; a1 += sl[1024 + kk] * w; a2 += sl[2048 + kk] * w; a3 += sl[3072 + kk] * w; a4 += sl[4096 + kk] * w; }
            red[(F.wave * 5 + 0) * 64 + F.lane] = a0; red[(F.wave * 5 + 1) * 64 + F.lane] = a1; red[(F.wave * 5 + 2) * 64 + F.lane] = a2; red[(F.wave * 5 + 3) * 64 + F.lane] = a3; red[(F.wave * 5 + 4) * 64 + F.lane] = a4;
            __syncthreads();
            if (F.tid < 320) { const int r = F.tid >> 6, ln = F.tid & 63; float s = 0.f;
#pragma unroll
                for (int w = 0; w < 8; ++w) s += red[(w * 5 + r) * 64 + ln];
                const int nn = (it % 96) * 64 + ln; MOD[(size_t)(l * 5 + r) * 6144 + nn] = s + b_mod[l * 6144 + nn]; }
            __syncthreads();
        }
    }
    {
        float* RC = (float*)(F.ws + WS_ROPEC); float* RS = (float*)(F.ws + WS_ROPES);
        for (int idx = blockIdx.x * NTHR + F.tid; idx < SEQ * 32; idx += F.G * NTHR) {
            const int t = idx >> 5, i = idx & 31; const int pos = (i < 16) ? (t >> 6) : (t & 63);
            const float ang = (float)pos * ROPE_INV[i & 15];
            double s, cc; sincos_d((double)ang, s, cc); RC[idx] = (float)cc; RS[idx] = (float)s; }
    }
    {
        float* H2 = (float*)(F.ws + WS_H2);
        for (int it = F.gw; it < 2 * SEQ + CTXL; it += F.ngw) {
            const int v = it >> 13, t = (v < 2) ? (it & (SEQ - 1)) : (it - 2 * SEQ), L = (v < 2) ? SEQ : CTXL, l = (v == 1) ? 1 : 0;
            const int j = F.lane;
            float z = 0.f;
            if (j == 0) z = (float)t / (float)(L - 1);
            else if (j <= 32) { const int b = (j - 1) & 15; const float band = 1e-4f + (float)b * ((15.0f - 1e-4f) / 15.0f);
                const float ang = ((6.283185307179586f / (float)L) * (float)t) * band;
                double s, cc; sincos_d((double)ang, s, cc); z = (j <= 16) ? (float)cc : -(float)s; }
            const float fr = hy_freq[l * 64 + j];
            float p1 = hy_b1[l * 64 + j];
            const float* w1 = hy_w1 + (size_t)l * 33 * 64;
#pragma unroll
            for (int i = 0; i < 33; ++i) p1 += __shfl(z, i) * w1[i * 64 + j];
            double s1, c1; sincos_d((double)(fr * p1), s1, c1); const float h1 = (float)s1;
            float p2 = hy_b2[l * 64 + j];
            const float* w2 = hy_w2 + (size_t)l * 64 * 64;
#pragma unroll 16
            for (int i = 0; i < 64; ++i) p2 += __shfl(h1, i) * w2[i * 64 + j];
            double s2, c2; sincos_d((double)(fr * p2), s2, c2);
            H2[((size_t)v * SEQ + t) * 64 + j] = (float)s2;
        }
    }
}

__device__ __forceinline__ void ph_prologue_b(const Frame& F, const float* hy_w3, const float* hy_decay) {
    LAS float* kt = (LAS float*)(F.lds);
    LAS float* w3c = (LAS float*)(F.lds + 65536);
    LAS float* red = (LAS float*)(F.lds + 65536 + 512);
    const float* H2 = (const float*)(F.ws + WS_H2);
    float* KF = (float*)(F.ws + WS_KF); float* KFC = (float*)(F.ws + WS_KFC);
    for (int it = blockIdx.x; it < 768; it += F.G) {
        const int v = it >> 8, c = it & 255, L = (v < 2) ? SEQ : CTXL, l = (v == 1) ? 1 : 0;
        if (F.tid < 128) w3c[F.tid] = hy_w3[(size_t)l * 64 * 512 + (F.tid & 63) * 512 + (F.tid >> 6) * 256 + c];
        if (F.tid == 0) kt[L] = 0.f;
        __syncthreads();
        const float df = fabsf(hy_decay[l * 512 + c]), db = fabsf(hy_decay[l * 512 + 256 + c]);
        float asum = 0.f;
        for (int t = F.tid; t < L; t += NTHR) {
            const f32x4* row = (const f32x4*)(H2 + ((size_t)v * SEQ + t) * 64);
            float hf = 0.f, hb = 0.f;
#pragma unroll
            for (int q = 0; q < 16; ++q) { const f32x4 h = row[q];
                hf += h.x * w3c[4 * q] + h.y * w3c[4 * q + 1] + h.z * w3c[4 * q + 2] + h.w * w3c[4 * q + 3];
                hb += h.x * w3c[64 + 4 * q] + h.y * w3c[64 + 4 * q + 1] + h.z * w3c[64 + 4 * q + 2] + h.w * w3c[64 + 4 * q + 3]; }
            const float t01 = (float)t / (float)(L - 1);
            hf *= expf(-t01 * df); hb *= expf(-t01 * db);
            kt[t] = hf; asum += fabsf(hf);
            if (t >= 1) { kt[2 * L - t] = hb; asum += fabsf(hb); }
        }
        asum = wave_sum(asum);
        if (F.lane == 0) red[F.wave] = asum;
        __syncthreads();
        float tot = 0.f;
#pragma unroll
        for (int w = 0; w < 8; ++w) tot += red[w];
        const float inv = 1.0f / tot;
        float* dst = (v < 2) ? (KF + (size_t)(v * 256 + c) * 16384) : (KFC + (size_t)c * 512);
        for (int j = F.tid; j < 2 * L; j += NTHR) dst[j] = kt[j] * inv;
        __syncthreads();
    }
}

__device__ __forceinline__ void ph_norm_mod(const Frame& F, int l, const float* x, const float* ctx, const float* gmix) {
    const float* XR = (const float*)(F.ws + WS_XR); const float* MOD = (const float*)(F.ws + WS_MOD); bf16* H = (bf16*)(F.ws + WS_H);
    for (int r = F.gw; r < MT; r += F.ngw) {
        const float* src = (l == 0) ? (r < NLAT ? x + (size_t)r * 1024 : ctx + (size_t)(r - NLAT) * 1024) : XR + (size_t)r * 1024;
        const int bidx = r < NLAT ? r / SEQ : 4;
        const float* shift = MOD + (size_t)(l * 5 + bidx) * 6144; const float* scale = shift + 1024; const float* g = gmix + l * 1024;
        f32x4 v[4]; float ss = 0.f;
#pragma unroll
        for (int j = 0; j < 4; ++j) { v[j] = ((const f32x4*)src)[64 * j + F.lane]; ss += (v[j].x * v[j].x + v[j].y * v[j].y) + (v[j].z * v[j].z + v[j].w * v[j].w); }
        const float rstd = 1.0f / sqrtf(wave_sum(ss) * (1.0f / 1024.0f) + EPSN);
#pragma unroll
        for (int j = 0; j < 4; ++j) { const int cb = 64 * j + F.lane; const f32x4 gg = ((const f32x4*)g)[cb], sc = ((const f32x4*)scale)[cb], sh = ((const f32x4*)shift)[cb];
            const f32x4 y = v[j] * rstd * gg * (sc + 1.0f) + sh;
            v2u o; o.x = pk2(y.x, y.y); o.y = pk2(y.z, y.w); ((v2u*)(H + (size_t)r * 1024))[cb] = o; }
    }
}

__device__ __forceinline__ void ph_post_proj(const Frame& F, int l, const float* qg_, const float* kg_, const float* lru_cw, const float* lru_cb, const float* lru_gw, const float* lru_gb,
                                             const float* lru_lam, const float* hy_cw, const float* hy_cb) {
    const bf16* U = (const bf16*)(F.ws + WS_U);
    {
        bf16* Q = (bf16*)(F.ws + WS_Q); bf16* K = (bf16*)(F.ws + WS_K); bf16* V = (bf16*)(F.ws + WS_V);
        const float* RC = (const float*)(F.ws + WS_ROPEC); const float* RS = (const float*)(F.ws + WS_ROPES);
        const float qg = qg_[l * 64 + F.lane], kg = kg_[l * 64 + F.lane];
        const float C2 = 0.125f * 1.4426950408889634f;
        for (int r = F.gw; r < MT; r += F.ngw) {
            const bool isctx = r >= NLAT; const int b = isctx ? (r - NLAT) / CTXL : r / SEQ; const int t = isctx ? (r - NLAT) % CTXL : r % SEQ;
            const bf16* ur = U + (size_t)r * INW;
            float cs = 1.f, sn = 0.f;
            if (!isctx) { cs = RC[t * 32 + (F.lane & 31)]; sn = RS[t * 32 + (F.lane & 31)]; }
            const size_t krow = (size_t)b * KEYS + (isctx ? t : CTXL + t);
#pragma unroll
            for (int hd = 0; hd < 10; ++hd) {
                const float v = bf2f(ur[hd * 64 + F.lane]);
                const float ss = wave_sum(v * v);
                float y = v * (1.0f / sqrtf(ss * (1.0f / 64.0f) + EPSN)) * (hd < 8 ? qg : kg);
                const float p = __shfl_xor(y, 32);
                if (!isctx) y = (F.lane < 32) ? (y * cs - p * sn) : (y * cs + p * sn);
                if (hd < 8) Q[(size_t)r * 512 + hd * 64 + F.lane] = (bf16)f2bf(y * C2);
                else K[krow * 128 + (hd - 8) * 64 + F.lane] = (bf16)f2bf(y);
            }
            V[krow * 128 + F.lane] = ur[640 + F.lane]; V[krow * 128 + 64 + F.lane] = ur[704 + F.lane];
        }
    }
    __syncthreads();
    {
        LAS float* lxs = (LAS float*)(F.lds);
        LAS float* xls = (LAS float*)(F.lds + 36864);
        float* LAB = (float*)(F.ws + WS_LAB);
        const int ch = F.tid & 255, half = F.tid >> 8, n = ch >> 6, e = ch & 63;
        const float cw0 = lru_cw[(l * 4 + 0) * 256 + ch], cw1 = lru_cw[(l * 4 + 1) * 256 + ch], cw2 = lru_cw[(l * 4 + 2) * 256 + ch], cw3 = lru_cw[(l * 4 + 3) * 256 + ch], cb = lru_cb[l * 256 + ch];
        for (int it = blockIdx.x; it < MT / 32; it += F.G) {
            const int r0 = it * 32; const bool isctx = r0 >= NLAT; const int Ls = isctx ? CTXL : SEQ;
            const int t0 = isctx ? (r0 - NLAT) % CTXL : r0 % SEQ; const int rbase = r0 - t0;
            for (int i = F.tid; i < 36 * 256; i += NTHR) { const int rr = i >> 8, cc = i & 255; const int t = t0 - 2 + rr;
                lxs[i] = (t >= 0 && t < Ls) ? bf2f(U[(size_t)(rbase + t) * INW + 768 + cc]) : 0.f; }
            __syncthreads();
            for (int i = F.tid; i < 32 * 256; i += NTHR) { const int tt = i >> 8;
                xls[i] = cw0 * lxs[i] + cw1 * lxs[i + 256] + cw2 * lxs[i + 512] + cw3 * lxs[i + 768] + cb; (void)tt; }
            __syncthreads();
#pragma unroll 1
            for (int d = 0; d < 2; ++d) {
                float aR[16], aI[16];
#pragma unroll
                for (int q = 0; q < 16; ++q) { aR[q] = 0.f; aI[q] = 0.f; }
                const float* wR = lru_gw + ((size_t)(((l * 2 + d) * 2 + 0) * 4 + n) * 64) * 64 + e;
                const float* wI = lru_gw + ((size_t)(((l * 2 + d) * 2 + 1) * 4 + n) * 64) * 64 + e;
#pragma unroll 2
                for (int d4 = 0; d4 < 16; ++d4) {
                    const float r0w = wR[(d4 * 4 + 0) * 64], r1w = wR[(d4 * 4 + 1) * 64], r2w = wR[(d4 * 4 + 2) * 64], r3w = wR[(d4 * 4 + 3) * 64];
                    const float i0w = wI[(d4 * 4 + 0) * 64], i1w = wI[(d4 * 4 + 1) * 64], i2w = wI[(d4 * 4 + 2) * 64], i3w = wI[(d4 * 4 + 3) * 64];
#pragma unroll
                    for (int q = 0; q < 16; ++q) { const f32x4 xv = *(const LAS f32x4*)(xls + (half * 16 + q) * 256 + n * 64 + d4 * 4);
                        aR[q] += xv.x * r0w + xv.y * r1w + xv.z * r2w + xv.w * r3w; aI[q] += xv.x * i0w + xv.y * i1w + xv.z * i2w + xv.w * i3w; }
                }
                const float bR = lru_gb[((l * 2 + d) * 2 + 0) * 256 + ch], bI = lru_gb[((l * 2 + d) * 2 + 1) * 256 + ch];
                const float lam = lru_lam[(l * 2 + d) * 256 + ch]; const float sp = log1pf(expf(-lam));
                float* LA = LAB + (size_t)(2 * d) * LAB_STRIDE; float* LB = LAB + (size_t)(2 * d + 1) * LAB_STRIDE;
#pragma unroll
                for (int q = 0; q < 16; ++q) { const int tt = half * 16 + q;
                    const float rg = sigmoidf_(aR[q] + bR), ig = sigmoidf_(aI[q] + bI);
                    const float log_a = -8.0f * rg * sp; const float a = expf(log_a);
                    const float bx = sqrtf(fmaxf(-expm1f(2.0f * log_a), 0.f)) * (ig * xls[tt * 256 + ch]);
                    LA[(size_t)(r0 + tt) * 256 + ch] = a; LB[(size_t)(r0 + tt) * 256 + ch] = bx; }
            }
            __syncthreads();
        }
    }
    {
        LAS bf16* hs = (LAS bf16*)(F.lds);
        float* VT = (float*)(F.ws + WS_VT); float* X0T = (float*)(F.ws + WS_X0T);
        const float* cw = hy_cw + (size_t)l * 3 * 768; const float* cbp = hy_cb + l * 768;
        for (int it = blockIdx.x; it < NLAT / 64; it += F.G) {
            const int b = it >> 7, t0 = (it & 127) * 64;
            for (int i = F.tid; i < 66 * 384; i += NTHR) { const int rr = i / 384, c2 = i - rr * 384; const int t = t0 - 1 + rr;
                unsigned w = 0u; if (t >= 0 && t < SEQ) w = *(const unsigned*)(U + (size_t)(b * SEQ + t) * INW + 1280 + 2 * c2);
                *(LAS unsigned*)(hs + rr * 770 + 2 * c2) = w; }
            __syncthreads();
            for (int c = F.wave; c < 256; c += NWAVES) {
                const int tt = F.lane;
                float o[3];
#pragma unroll
                for (int g = 0; g < 3; ++g) { const int cc = g * 256 + c;
                    o[g] = cw[cc] * bf2f(hs[tt * 770 + cc]) + cw[768 + cc] * bf2f(hs[(tt + 1) * 770 + cc]) + cw[1536 + cc] * bf2f(hs[(tt + 2) * 770 + cc]) + cbp[cc]; }
                const size_t oi = ((size_t)b * 256 + c) * SEQ + t0 + tt;
                VT[oi] = o[2] * o[1]; X0T[oi] = o[0];
            }
            __syncthreads();
        }
    }
}

__device__ __forceinline__ void ph_ctx_attn(const Frame& F) {
    const bf16* Q = (const bf16*)(F.ws + WS_Q); const bf16* K = (const bf16*)(F.ws + WS_K); const bf16* V = (const bf16*)(F.ws + WS_V); bf16* O = (bf16*)(F.ws + WS_ATT);
    LAS float* qs = (LAS float*)(F.lds + 90112 + F.wave * 1280);
    LAS float* ps = qs + 64;
    for (int it = F.gw; it < NCTX * 8; it += F.ngw) {
        const int rc = it >> 3, h = it & 7, b = rc / CTXL, kvh = h >> 2; const int r = NLAT + rc;
        qs[F.lane] = bf2f(Q[(size_t)r * 512 + h * 64 + F.lane]);
        LDS_WAIT();
        float sc[4]; float mx = -INFINITY;
#pragma unroll
        for (int i = 0; i < 4; ++i) { const int key = F.lane + 64 * i; const v4u* kp = (const v4u*)(K + ((size_t)b * KEYS + key) * 128 + kvh * 64);
            float s = 0.f;
#pragma unroll
            for (int q = 0; q < 8; ++q) { const v4u w = kp[q];
                s += qs[8 * q] * bflo(w.x) + qs[8 * q + 1] * bfhi(w.x) + qs[8 * q + 2] * bflo(w.y) + qs[8 * q + 3] * bfhi(w.y) + qs[8 * q + 4] * bflo(w.z) + qs[8 * q + 5] * bfhi(w.z) + qs[8 * q + 6] * bflo(w.w) + qs[8 * q + 7] * bfhi(w.w); }
            sc[i] = s; mx = fmaxf(mx, s); }
#pragma unroll
        for (int o = 1; o < 64; o <<= 1) mx = fmaxf(mx, __shfl_xor(mx, o));
        float sum = 0.f;
#pragma unroll
        for (int i = 0; i < 4; ++i) { const float p = exp2f(sc[i] - mx); sum += p; ps[F.lane + 64 * i] = p; }
        sum = wave_sum(sum);
        LDS_WAIT();
        float acc = 0.f;
        const bf16* vp = V + (size_t)b * KEYS * 128 + kvh * 64 + F.lane;
#pragma unroll 8
        for (int key = 0; key < CTXL; ++key) acc += ps[key] * bf2f(vp[(size_t)key * 128]);
        O[(size_t)r * 512 + h * 64 + F.lane] = (bf16)f2bf(acc / sum);
        LDS_WAIT();
    }
}

__device__ __forceinline__ int chunk_row0(int b, int d, int k) {
    if (k < 2) { const int cc = d ? 1 - k : k; return NLAT + b * CTXL + cc * CHUNK; }
    const int lc = d ? 63 - (k - 2) : (k - 2); return b * SEQ + lc * CHUNK;
}
__device__ __forceinline__ void ph_scan1(const Frame& F) {
    const float* LAB = (const float*)(F.ws + WS_LAB); float* SUMP = (float*)(F.ws + WS_SCANS); float* SUMH = SUMP + NB * 2 * NCHUNK * 256;
    for (int it = blockIdx.x * NTHR + F.tid; it < NB * 2 * NCHUNK * 256; it += F.G * NTHR) {
        const int ch = it & 255, k = (it >> 8) % NCHUNK, bd = (it >> 8) / NCHUNK, d = bd & 1, b = bd >> 1;
        const int r0 = chunk_row0(b, d, k);
        const float* LA = LAB + (size_t)(2 * d) * LAB_STRIDE + ch; const float* LB = LAB + (size_t)(2 * d + 1) * LAB_STRIDE + ch;
        float h = 0.f, P = 1.f;
#pragma unroll 8
        for (int i = 0; i < CHUNK; ++i) { const int r = d ? r0 + CHUNK - 1 - i : r0 + i; const float a = LA[(size_t)r * 256], bx = LB[(size_t)r * 256]; h = a * h + bx; P *= a; }
        SUMP[it] = P; SUMH[it] = h;
    }
}
__device__ __forceinline__ void ph_scan2(const Frame& F) {
    const float* LAB = (const float*)(F.ws + WS_LAB); const float* SUMP = (const float*)(F.ws + WS_SCANS); const float* SUMH = SUMP + NB * 2 * NCHUNK * 256;
    float* LRUO = (float*)(F.ws + WS_LRUO); const bf16* U = (const bf16*)(F.ws + WS_U);
    for (int it = blockIdx.x * NTHR + F.tid; it < NB * NCHUNK * 256; it += F.G * NTHR) {
        const int ch = it & 255, kc = (it >> 8) % NCHUNK, b = (it >> 8) / NCHUNK;
        const int r0 = chunk_row0(b, 0, kc);
#pragma unroll 1
        for (int d = 0; d < 2; ++d) {
            const int k = d ? ((kc < 2) ? 1 - kc : 2 + 63 - (kc - 2)) : kc;
            const size_t sb = (size_t)((b * 2 + d) * NCHUNK) * 256 + ch;
            float h = 0.f;
            for (int j = 0; j < k; ++j) h = SUMP[sb + (size_t)j * 256] * h + SUMH[sb + (size_t)j * 256];
            const float* LA = LAB + (size_t)(2 * d) * LAB_STRIDE + ch; const float* LB = LAB + (size_t)(2 * d + 1) * LAB_STRIDE + ch;
            if (d == 0) {
#pragma unroll 8
                for (int i = 0; i < CHUNK; ++i) { const int r = r0 + i; h = LA[(size_t)r * 256] * h + LB[(size_t)r * 256]; LRUO[(size_t)r * 256 + ch] = h; }
            } else {
#pragma unroll 8
                for (int i = 0; i < CHUNK; ++i) { const int r = r0 + CHUNK - 1 - i; h = LA[(size_t)r * 256] * h + LB[(size_t)r * 256];
                    const float lg = bf2f(U[(size_t)r * INW + 1024 + ch]);
                    LRUO[(size_t)r * 256 + ch] = (LRUO[(size_t)r * 256 + ch] + h) * gelu_tanh(lg); }
            }
        }
    }
}

__device__ __forceinline__ void ph_hyena_direct(const Frame& F, int l, const float* hy_bias, const float* hy_cw, const float* hy_cb) {
    LAS float* ks = (LAS float*)(F.lds);
    LAS float* vs = (LAS float*)(F.lds + 65536);
    const float* KF = (const float*)(F.ws + WS_KF) + (size_t)l * 256 * 16384;
    const float* VT = (const float*)(F.ws + WS_VT); const float* X0T = (const float*)(F.ws + WS_X0T); float* HYO = (float*)(F.ws + WS_HYO);
    for (int it = blockIdx.x; it < 512; it += F.G) {
        const int c = it >> 1, bp = it & 1;
        for (int i = F.tid; i < 4096; i += NTHR) ((LAS f32x4*)ks)[i] = ((const f32x4*)(KF + (size_t)c * 16384))[i];
        for (int i = F.tid; i < 4096; i += NTHR) { const int bb = i >> 11, q = i & 2047; ((LAS f32x4*)vs)[i] = ((const f32x4*)(VT + ((size_t)(bp * 2 + bb) * 256 + c) * SEQ))[q]; }
        __syncthreads();
        float y0[16], y1[16];
#pragma unroll
        for (int i = 0; i < 16; ++i) { y0[i] = 0.f; y1[i] = 0.f; }
#pragma unroll 2
        for (int s = 0; s < SEQ; ++s) {
            const float v0 = vs[s], v1 = vs[SEQ + s];
            const int base = (F.tid - s) & 16383;
#pragma unroll
            for (int i = 0; i < 16; ++i) { const float kk = ks[(base + 512 * i) & 16383]; y0[i] += kk * v0; y1[i] += kk * v1; }
        }
        const float bias = hy_bias[l * 256 + c];
#pragma unroll
        for (int i = 0; i < 16; ++i) { const int t = F.tid + 512 * i;
            { const int b = bp * 2; const size_t oi = ((size_t)b * 256 + c) * SEQ + t; HYO[((size_t)b * SEQ + t) * 256 + c] = (y0[i] + vs[t] * bias) * X0T[oi]; }
            { const int b = bp * 2 + 1; const size_t oi = ((size_t)b * 256 + c) * SEQ + t; HYO[((size_t)b * SEQ + t) * 256 + c] = (y1[i] + vs[SEQ + t] * bias) * X0T[oi]; } }
        __syncthreads();
    }
    if (l == 0) {
        const bf16* U = (const bf16*)(F.ws + WS_U); const float* KFC = (const float*)(F.ws + WS_KFC);
        LAS float* vw = (LAS float*)(F.lds + F.wave * 4096);
        LAS float* kw = vw + 256;
        const float* cw = hy_cw; const float* cbp = hy_cb;
        for (int it = F.gw; it < NB * 256; it += F.ngw) {
            const int b = it >> 8, c = it & 255;
            float x0v[4];
#pragma unroll
            for (int i = 0; i < 4; ++i) { const int t = F.lane + 64 * i;
                float o[3];
#pragma unroll
                for (int g = 0; g < 3; ++g) { const int cc = g * 256 + c; float a = cbp[cc];
#pragma unroll
                    for (int j = 0; j < 3; ++j) { const int tj = t + j - 1; if (tj >= 0 && tj < CTXL) a += cw[j * 768 + cc] * bf2f(U[(size_t)(NLAT + b * CTXL + tj) * INW + 1280 + cc]); }
                    o[g] = a; }
                vw[t] = o[2] * o[1]; x0v[i] = o[0]; }
#pragma unroll
            for (int i = 0; i < 8; ++i) kw[F.lane + 64 * i] = KFC[c * 512 + F.lane + 64 * i];
            LDS_WAIT();
            float y[4] = {0.f, 0.f, 0.f, 0.f};
#pragma unroll 4
            for (int s = 0; s < CTXL; ++s) { const float vv = vw[s];
#pragma unroll
                for (int i = 0; i < 4; ++i) y[i] += kw[(F.lane + 64 * i - s) & 511] * vv; }
            const float bias = hy_bias[c];
#pragma unroll
            for (int i = 0; i < 4; ++i) { const int t = F.lane + 64 * i; HYO[(size_t)(NLAT + b * CTXL + t) * 256 + c] = (y[i] + vw[t] * bias) * x0v[i]; }
            LDS_WAIT();
        }
    }
}

__device__ __forceinline__ void ph_merge(const Frame& F, int l, int nrows, const float* out_g) {
    const bf16* ATT = (const bf16*)(F.ws + WS_ATT); const float* LRUO = (const float*)(F.ws + WS_LRUO); const float* HYO = (const float*)(F.ws + WS_HYO); bf16* MIXA = (bf16*)(F.ws + WS_MIXA);
    const float* g = out_g + l * 1024;
    for (int r = F.gw; r < nrows; r += F.ngw) {
        const v4u aw = ((const v4u*)(ATT + (size_t)r * 512))[F.lane];
        float a[8] = {bflo(aw.x), bfhi(aw.x), bflo(aw.y), bfhi(aw.y), bflo(aw.z), bfhi(aw.z), bflo(aw.w), bfhi(aw.w)};
        float ss = 0.f;
#pragma unroll
        for (int i = 0; i < 8; ++i) ss += a[i] * a[i];
        const float ra = 1.0f / sqrtf(wave_sum(ss) * (1.0f / 512.0f) + EPSN);
        const f32x4 lv = ((const f32x4*)(LRUO + (size_t)r * 256))[F.lane];
        const float rl = 1.0f / sqrtf(wave_sum(lv.x * lv.x + lv.y * lv.y + lv.z * lv.z + lv.w * lv.w) * (1.0f / 256.0f) + EPSN);
        const f32x4 hv = ((const f32x4*)(HYO + (size_t)r * 256))[F.lane];
        const float rh = 1.0f / sqrtf(wave_sum(hv.x * hv.x + hv.y * hv.y + hv.z * hv.z + hv.w * hv.w) * (1.0f / 256.0f) + EPSN);
        bf16* orow = MIXA + (size_t)r * 1024;
        { const f32x4 g0 = ((const f32x4*)g)[2 * F.lane], g1 = ((const f32x4*)g)[2 * F.lane + 1];
          v4u o; o.x = pk2(a[0] * ra * g0.x, a[1] * ra * g0.y); o.y = pk2(a[2] * ra * g0.z, a[3] * ra * g0.w); o.z = pk2(a[4] * ra * g1.x, a[5] * ra * g1.y); o.w = pk2(a[6] * ra * g1.z, a[7] * ra * g1.w);
          ((v4u*)orow)[F.lane] = o; }
        { const f32x4 gg = ((const f32x4*)(g + 512))[F.lane]; v2u o; o.x = pk2(lv.x * rl * gg.x, lv.y * rl * gg.y); o.y = pk2(lv.z * rl * gg.z, lv.w * rl * gg.w); ((v2u*)(orow + 512))[F.lane] = o; }
        { const f32x4 gg = ((const f32x4*)(g + 768))[F.lane]; v2u o; o.x = pk2(hv.x * rh * gg.x, hv.y * rh * gg.y); o.y = pk2(hv.z * rh * gg.z, hv.w * rh * gg.w); ((v2u*)(orow + 768))[F.lane] = o; }
    }
}

__device__ __forceinline__ void ph_ffn_router(const Frame& F, int l, int nrows, const float* gffn, const float* router_w, const float* router_b) {
    LAS float* rwl = (LAS float*)(F.lds);
    LAS int* hist = (LAS int*)(F.lds + 135168);
    const float* XR = (const float*)(F.ws + WS_XR); const float* MOD = (const float*)(F.ws + WS_MOD); bf16* Fb = (bf16*)(F.ws + WS_F);
    int* TOPI = (int*)(F.ws + WS_TOPI); float* GATE = (float*)(F.ws + WS_GATE); int* BLKCNT = (int*)(F.ws + WS_BLKCNT);
    for (int i = F.tid; i < 1024 * 32; i += NTHR) rwl[(i >> 5) * 33 + (i & 31)] = router_w[(size_t)l * 32768 + i];
    if (F.tid < 32) hist[F.tid] = 0;
    __syncthreads();
    const float* g = gffn + l * 1024;
    for (int r = F.gw; r < nrows; r += F.ngw) {
        const int bidx = r < NLAT ? r / SEQ : 4;
        const float* sf = MOD + (size_t)(l * 5 + bidx) * 6144 + 3 * 1024; const float* cf = sf + 1024;
        float f[16]; float ss = 0.f;
#pragma unroll
        for (int j = 0; j < 16; ++j) { f[j] = XR[(size_t)r * 1024 + 64 * j + F.lane]; ss += f[j] * f[j]; }
        const float rstd = 1.0f / sqrtf(wave_sum(ss) * (1.0f / 1024.0f) + EPSN);
        float p[32];
#pragma unroll
        for (int e = 0; e < 32; ++e) p[e] = 0.f;
#pragma unroll
        for (int j = 0; j < 16; ++j) { const int c = 64 * j + F.lane; const float fv = f[j] * rstd * g[c] * (1.0f + cf[c]) + sf[c];
            Fb[(size_t)r * 1024 + c] = (bf16)f2bf(fv);
            const LAS float* wrow = rwl + c * 33;
#pragma unroll
            for (int e = 0; e < 32; ++e) p[e] += fv * wrow[e]; }
#pragma unroll
        for (int e = 0; e < 32; ++e) p[e] = wave_sum(p[e]) + router_b[l * 32 + e];
        unsigned taken = 0u; float tv[4]; int ti[4];
#pragma unroll
        for (int k = 0; k < 4; ++k) { float best = -INFINITY; int bi = 0;
#pragma unroll
            for (int e = 0; e < 32; ++e) { const bool ok = !((taken >> e) & 1u) && (p[e] > best); best = ok ? p[e] : best; bi = ok ? e : bi; }
            taken |= 1u << bi; tv[k] = best; ti[k] = bi; }
        const float e1 = __expf(tv[1] - tv[0]), e2 = __expf(tv[2] - tv[0]), e3 = __expf(tv[3] - tv[0]); const float inv = 1.0f / (1.0f + e1 + e2 + e3);
        if (F.lane == 0) {
            TOPI[r * 4 + 0] = ti[0]; TOPI[r * 4 + 1] = ti[1]; TOPI[r * 4 + 2] = ti[2]; TOPI[r * 4 + 3] = ti[3];
            GATE[r * 4 + 0] = inv; GATE[r * 4 + 1] = e1 * inv; GATE[r * 4 + 2] = e2 * inv; GATE[r * 4 + 3] = e3 * inv;
            lds_add(&hist[ti[0]], 1); lds_add(&hist[ti[1]], 1); lds_add(&hist[ti[2]], 1); lds_add(&hist[ti[3]], 1);
        }
    }
    __syncthreads();
    if (F.tid < 32) BLKCNT[blockIdx.x * 32 + F.tid] = hist[F.tid];
}

__device__ __forceinline__ void ph_route(const Frame& F, int nrows) {
    LAS int* cursor = (LAS int*)(F.lds);
    LAS int* tot = cursor + 32;
    LAS int* mine = cursor + 64;
    const int* BLKCNT = (const int*)(F.ws + WS_BLKCNT); const int* TOPI = (const int*)(F.ws + WS_TOPI); int* POS = (int*)(F.ws + WS_POS);
    const bf16* Fb = (const bf16*)(F.ws + WS_F); bf16* AS = (bf16*)(F.ws + WS_ASORT); int* TILEE = (int*)(F.ws + WS_TILEE);
    if (F.tid < 32) { int t = 0, m = 0; for (int b = 0; b < F.G; ++b) { const int v = BLKCNT[b * 32 + F.tid]; t += v; m += (b < (int)blockIdx.x) ? v : 0; } tot[F.tid] = t; mine[F.tid] = m; }
    __syncthreads();
    if (F.tid == 0) { int tb = 0;
        for (int e = 0; e < 32; ++e) { const int nt = (tot[e] + 255) >> 8; cursor[e] = tb * 256 + mine[e];
            if (blockIdx.x == 0) for (int j = 0; j < nt; ++j) TILEE[tb + j] = e;
            tb += nt; }
        if (blockIdx.x == 0) F.ctl[CW_NTILES] = (unsigned)tb; }
    __syncthreads();
    for (int r = F.gw; r < nrows; r += F.ngw) {
        int pos = 0;
        if (F.lane < 4) { const int e = TOPI[r * 4 + F.lane]; pos = lds_add(&cursor[e], 1); POS[r * 4 + F.lane] = pos; }
        const v4u a0 = ((const v4u*)(Fb + (size_t)r * 1024))[F.lane], a1 = ((const v4u*)(Fb + (size_t)r * 1024))[64 + F.lane];
#pragma unroll
        for (int k = 0; k < 4; ++k) { const int pk = __shfl(pos, k); v4u* dst = (v4u*)(AS + (size_t)pk * 1024); dst[F.lane] = a0; dst[64 + F.lane] = a1; }
    }
}

__device__ __forceinline__ void ph_combine(const Frame& F, int l, int nrows, float* out) {
    float* XR = (float*)(F.ws + WS_XR); const float* MOD = (const float*)(F.ws + WS_MOD); const bf16* YS = (const bf16*)(F.ws + WS_YS);
    const int* POS = (const int*)(F.ws + WS_POS); const float* GATE = (const float*)(F.ws + WS_GATE);
    for (int r = F.gw; r < nrows; r += F.ngw) {
        const int bidx = r < NLAT ? r / SEQ : 4;
        const float* gf = MOD + (size_t)(l * 5 + bidx) * 6144 + 5 * 1024;
        int pos = 0; float gt = 0.f;
        if (F.lane < 4) { pos = POS[r * 4 + F.lane]; gt = GATE[r * 4 + F.lane]; }
        f32x4 y[4];
#pragma unroll
        for (int j = 0; j < 4; ++j) y[j] = (f32x4){0.f, 0.f, 0.f, 0.f};
#pragma unroll
        for (int k = 0; k < 4; ++k) { const int pk = __shfl(pos, k); const float gk = __shfl(gt, k); const v2u* yr = (const v2u*)(YS + (size_t)pk * 1024);
#pragma unroll
            for (int j = 0; j < 4; ++j) { const v2u w = yr[64 * j + F.lane]; y[j].x += gk * bflo(w.x); y[j].y += gk * bfhi(w.x); y[j].z += gk * bflo(w.y); y[j].w += gk * bfhi(w.y); } }
        float* dst = (l == 0) ? XR + (size_t)r * 1024 : out + (size_t)r * 1024;
#pragma unroll
        for (int j = 0; j < 4; ++j) { const int cb = 64 * j + F.lane; const f32x4 xv = ((const f32x4*)(XR + (size_t)r * 1024))[cb]; const f32x4 gv = ((const f32x4*)gf)[cb];
            ((f32x4*)dst)[cb] = xv + gv * y[j]; }
    }
}

struct Args { const float* in[34]; float* out; unsigned char* ws; int ph_lo, ph_hi; };
enum { I_X = 0, I_C, I_CTX, I_CCTX, I_WMOD, I_BMOD, I_GMIX, I_GFFN, I_WIN, I_QG, I_KG, I_LCW, I_LCB, I_LGW, I_LGB, I_LLAM, I_HCW, I_HCB, I_HW1, I_HB1, I_HW2, I_HB2, I_HW3, I_HFREQ, I_HDEC, I_HBIAS,
       I_OUTG, I_WOUT, I_RW, I_RB, I_MW1, I_MB1, I_MW2, I_MB2 };

__global__ void __launch_bounds__(NTHR, 2) mk_fwd(Args args) {
    extern __shared__ __attribute__((aligned(16))) unsigned char lds[];
    Frame F;
    F.lds = (LAS unsigned char*)lds; F.ws = args.ws; F.ctl = (unsigned*)(args.ws + WS_CTL);
    F.tid = threadIdx.x; F.lane = F.tid & 63; F.wave = __builtin_amdgcn_readfirstlane(F.tid >> 6);
    F.G = gridDim.x; { const int bx = blockIdx.x; F.vcu = (F.G % 8 == 0) ? (bx % 8) * (F.G / 8) + bx / 8 : bx; }
    F.gw = (int)blockIdx.x * NWAVES + F.wave; F.ngw = F.G * NWAVES;
    for (int u = F.tid; u < (LDS_BYTES - LDSCTL_OFF) / 4; u += NTHR) ((LAS unsigned*)(F.lds + LDSCTL_OFF))[u] = 0u;
    __syncthreads();
#if !MK_PER_PHASE
    XcdBarrier bar = xcd_barrier_post(F.ctl + CW_BAR, (volatile LAS unsigned*)(F.lds + LDSCTL_OFF + 32));
#define GRID_BAR() xcd_barrier(bar)
#else
#define GRID_BAR() do { } while (0)
#endif
    const int lo = args.ph_lo, hi = args.ph_hi;
#ifndef ONLY_PHASE
#define ONLY_PHASE (-1)
#endif
#define ENABLED(id) (ONLY_PHASE < 0 || ONLY_PHASE == (id))
#define IN(k) (ENABLED(k) && lo <= (k) && (k) < hi)
#define INL(j) (ENABLED(2 + (j)) && lo <= pb + (j) && pb + (j) < hi)
#define SEAML(j) do { if (lo <= pb + (j) && pb + (j) + 1 < hi) { GRID_BAR(); } } while (0)
typedef const __attribute__((address_space(4))) Args* KArgs;
#define REFRAME() Frame Fp = F; KArgs ka = (KArgs)__builtin_amdgcn_kernarg_segment_ptr(); { int t_ = F.tid; asm volatile("" : "+v"(t_), "+s"(ka)); Fp.tid = t_; Fp.lane = t_ & 63; Fp.wave = __builtin_amdgcn_readfirstlane(t_ >> 6); \
    Fp.gw = (int)blockIdx.x * NWAVES + Fp.wave; Fp.ws = ka->ws; Fp.ctl = (unsigned*)(ka->ws + WS_CTL); }
#define SEAM(k) do { if (lo <= (k) && (k) + 1 < hi) { GRID_BAR(); } } while (0)

    if (IN(0)) ph_prologue_a(F, args.in[I_C], args.in[I_CCTX], args.in[I_WMOD], args.in[I_BMOD], args.in[I_WIN], args.in[I_WOUT], args.in[I_MW1], args.in[I_MW2],
                             args.in[I_HW1], args.in[I_HB1], args.in[I_HW2], args.in[I_HB2], args.in[I_HFREQ]);
    SEAM(0);
    if (IN(1)) ph_prologue_b(F, args.in[I_HW3], args.in[I_HDEC]);
    SEAM(1);

#define LAYER_BODY(l) { \
        const int pb = 2 + l * NPH_LAYER; \
        const int nrows = (l == 0) ? MT : NLAT; \
        if (INL(0)) { REFRAME(); ph_norm_mod(Fp, l, ka->in[I_X], ka->in[I_CTX], ka->in[I_GMIX]); } \
        SEAML(0); \
        if (INL(1)) { REFRAME(); \
            pg8::Gemm g{(const bf16*)(Fp.ws + WS_H), (const bf16*)(Fp.ws + WS_WINT) + (size_t)l * 2048 * 1024, MT, 2048, 1024}; \
            pg8::StaticOrder S; S.init(MT, 2048, Fp.G, (int)blockIdx.x); \
            pg8::EpiBf16<0> E{(bf16*)(Fp.ws + WS_U), 2048, nullptr, 0, 0, 1.f}; \
            pg8::gemm_phase<pg8::EpiBf16<0>, pg8::StaticOrder, PG8_ALIGN, PG8_SP2>(Fp.lds + RING_OFF, g, S, E); \
        } \
        SEAML(1); \
        if (INL(2)) { REFRAME(); ph_post_proj(Fp, l, ka->in[I_QG], ka->in[I_KG], ka->in[I_LCW], ka->in[I_LCB], ka->in[I_LGW], ka->in[I_LGB], ka->in[I_LLAM], ka->in[I_HCW], ka->in[I_HCB]); } \
        SEAML(2); \
        if (INL(3)) { { REFRAME(); \
            const attn_body::AttnTensors AT{(const attn_body::bf16*)(Fp.ws + WS_Q), (const attn_body::bf16*)(Fp.ws + WS_K), (const attn_body::bf16*)(Fp.ws + WS_V), (attn_body::bf16*)(Fp.ws + WS_ATT)}; \
            attn_body::attn_phase<8>((char*)lds + RING_OFF, AT, Fp.G, Fp.vcu); } \
            if (l == 0) { REFRAME(); ph_ctx_attn(Fp); } \
        } \
        SEAML(3); \
        if (INL(4)) { REFRAME(); ph_scan1(Fp); } \
        SEAML(4); \
        if (INL(5)) { REFRAME(); ph_scan2(Fp); } \
        SEAML(5); \
        if (INL(6)) { REFRAME(); ph_hyena_direct(Fp, l, ka->in[I_HBIAS], ka->in[I_HCW], ka->in[I_HCB]); } \
        SEAML(6); \
        if (INL(7)) { REFRAME(); ph_merge(Fp, l, nrows, ka->in[I_OUTG]); } \
        SEAML(7); \
        if (INL(8)) { REFRAME(); \
            pg8::Gemm g{(const bf16*)(Fp.ws + WS_MIXA), (const bf16*)(Fp.ws + WS_WOUTT) + (size_t)l * 1024 * 1024, nrows, 1024, 1024}; \
            pg8::StaticOrder S; S.init(nrows, 1024, Fp.G, (int)blockIdx.x); \
            float* XR = (float*)(Fp.ws + WS_XR); \
            pg8::EpiResid E{(l == 0) ? ka->in[I_X] : (const float*)XR, (l == 0) ? ka->in[I_CTX] : (const float*)(XR + (size_t)NLAT * 1024), NLAT, XR, 1024, \
                            (const float*)(Fp.ws + WS_MOD) + (size_t)(l * 5) * 6144 + 2 * 1024, 6144, SEQ}; \
            pg8::gemm_phase<pg8::EpiResid, pg8::StaticOrder, PG8_ALIGN, PG8_SP2>(Fp.lds + RING_OFF, g, S, E); \
        } \
        SEAML(8); \
        if (INL(9)) { REFRAME(); ph_ffn_router(Fp, l, nrows, ka->in[I_GFFN], ka->in[I_RW], ka->in[I_RB]); } \
        SEAML(9); \
        if (INL(10)) { REFRAME(); ph_route(Fp, nrows); } \
        SEAML(10); \
        if (INL(11) || INL(12)) { REFRAME(); \
            LAS int* tab = (LAS int*)(Fp.lds + MOETAB_OFF); \
            const int ntiles = (int)__hip_atomic_load(Fp.ctl + CW_NTILES, __ATOMIC_RELAXED, __HIP_MEMORY_SCOPE_AGENT); \
            const int* TILEE = (const int*)(Fp.ws + WS_TILEE); \
            for (int i = Fp.tid; i < ntiles && i < SORT_TILES; i += NTHR) tab[i] = TILEE[i]; \
            __syncthreads(); \
            if (INL(11)) { \
                pg8::Gemm g{(const bf16*)(Fp.ws + WS_ASORT), (const bf16*)(Fp.ws + WS_W1T) + (size_t)l * 32 * 2048 * 1024, 0, 2048, 1024}; \
                pg8::MoeOrder S{tab, ntiles, 8, Fp.G, (int)blockIdx.x}; \
                pg8::EpiSwiglu E{(bf16*)(Fp.ws + WS_ACT), 1024, ka->in[I_MB1] + (size_t)l * 32 * 2048, 2048}; \
                pg8::gemm_phase<pg8::EpiSwiglu, pg8::MoeOrder, PG8_ALIGN, PG8_SP2>(Fp.lds + RING_OFF, g, S, E); \
            } \
            SEAML(11); \
            if (INL(12)) { \
                pg8::Gemm g{(const bf16*)(Fp.ws + WS_ACT), (const bf16*)(Fp.ws + WS_W2T) + (size_t)l * 32 * 1024 * 1024, 0, 1024, 1024}; \
                pg8::MoeOrder S{tab, ntiles, 4, Fp.G, (int)blockIdx.x}; \
                pg8::EpiBf16Bias E{(bf16*)(Fp.ws + WS_YS), 1024, ka->in[I_MB2] + (size_t)l * 32 * 1024, 1024}; \
                pg8::gemm_phase<pg8::EpiBf16Bias, pg8::MoeOrder, PG8_ALIGN, PG8_SP2>(Fp.lds + RING_OFF, g, S, E); \
            } \
        } \
        SEAML(12); \
        if (INL(13)) { REFRAME(); ph_combine(Fp, l, nrows, ka->out); } \
        SEAML(13); \
    }
    LAYER_BODY(0)
    LAYER_BODY(1)
#undef LAYER_BODY
#undef IN
#undef SEAM
#undef INL
#undef SEAML
}

extern "C" void kernel_launch(void* const* d_in, const int* in_sizes, int n_in, void* d_out, int out_size, void* d_ws, size_t ws_size, hipStream_t stream) {
    static int grid = 0;
    if (grid == 0) {
        if (n_in != 34 || in_sizes[0] != NLAT * DMODEL || out_size != NLAT * DMODEL || ws_size < WS_END) {
            fprintf(stderr, "kernel_launch: unexpected shapes (n_in %d, in0 %d, out %d, ws %zu); nothing launched\n", n_in, n_in > 0 ? in_sizes[0] : -1, out_size, ws_size); grid = -1; return; }
        int dev = 0, cus = 0;
        if (hipGetDevice(&dev) != hipSuccess || hipDeviceGetAttribute(&cus, hipDeviceAttributeMultiprocessorCount, dev) != hipSuccess) { grid = -1; return; }
        if (hipFuncSetAttribute((const void*)mk_fwd, hipFuncAttributeMaxDynamicSharedMemorySize, LDS_BYTES) != hipSuccess) { fprintf(stderr, "kernel_launch: hipFuncSetAttribute failed\n"); grid = -1; return; }
        int per_cu = 0;
        if (hipOccupancyMaxActiveBlocksPerMultiprocessor(&per_cu, (const void*)mk_fwd, NTHR, LDS_BYTES) != hipSuccess || per_cu < 1) { fprintf(stderr, "kernel_launch: occupancy query says %d\n", per_cu); }
        (void)hipGetLastError();
        grid = cus;
    }
    if (grid < 0) return;
    if (hipMemsetAsync((char*)d_ws + WS_CTL, 0, CTL_ZERO_BYTES, stream) != hipSuccess) return;
    Args a{};
    for (int i = 0; i < 34; ++i) a.in[i] = (const float*)d_in[i];
    a.out = (float*)d_out; a.ws = (unsigned char*)d_ws;
#if MK_PER_PHASE
    for (int p = 0; p < NPH; ++p) { a.ph_lo = p; a.ph_hi = p + 1; hipLaunchKernelGGL(mk_fwd, dim3(grid), dim3(NTHR), LDS_BYTES, stream, a); }
#else
    a.ph_lo = 0; a.ph_hi = NPH;
    hipLaunchKernelGGL(mk_fwd, dim3(grid), dim3(NTHR), LDS_BYTES, stream, a);
#endif
}
```

```cpp
#include <hip/hip_runtime.h>
#include <hip/hip_bf16.h>
#include <cstdio>
#include <cstdint>
#include <cmath>
#ifndef MK_PER_PHASE
#define MK_PER_PHASE 0
#endif
namespace pg8 {
#define PG8_LAS __attribute__((address_space(3)))
typedef unsigned short bf16_t;
typedef short bf16x8 __attribute__((ext_vector_type(8)));
typedef float f32x4 __attribute__((ext_vector_type(4)));
typedef unsigned u32x4 __attribute__((ext_vector_type(4)));
constexpr int BM = 256, BK = 64, HALF = 128, HTB = HALF * BK * 2  , STAGE_BYTES = 8 * HTB, NXCD = 8, WGM = 8;

__host__ __device__ __forceinline__ int lds_byte(int r, int c) { const int st = (r >> 4) * 2 + (c >> 5), rr = r & 15, cc = c & 31, ob = rr * 64 + cc * 2; return st * 1024 + (ob ^ (((ob >> 9) & 1) << 5)); }
__host__ __device__ __forceinline__ void stage_rc(int b, int& R, int& C) { const int st = b / 1024, sb = b % 1024, swz = sb ^ (((sb >> 9) & 1) << 5); R = (st >> 1) * 16 + swz / 64; C = (st & 1) * 32 + (swz % 64) / 2; }
__host__ __device__ __forceinline__ int perm32(int rho) { const int n = rho >> 4, i = rho & 15; return 8 * (i >> 2) + 4 * n + (i & 3); }

struct Unit { int pm, pn, be, e; };
struct Gemm { const bf16_t* A; const bf16_t* Bt; int M, N, K; };

struct StaticOrder {
    int nM, nN, nwg, G, c;
    __host__ __device__ void init(int M, int N, int G_, int c_) { nM = M / BM; nN = N / BM; nwg = nM * nN; G = G_; c = c_; }
    __host__ __device__ bool next(int i, Unit& u) const {
        const long L = (long)i * G + c; if (L >= nwg) return false;
        int wgid = (int)L; { const int q = nwg / NXCD, r = nwg % NXCD, xcd = wgid % NXCD, off = wgid / NXCD; wgid = (xcd < r ? xcd * (q + 1) : r * (q + 1) + (xcd - r) * q) + off; }
        const int nig = WGM * nN, gid = wgid / nig, fm = gid * WGM, gsz = (nM - fm) < WGM ? (nM - fm) : WGM;
        u.pm = fm + ((wgid % nig) % gsz); u.pn = (wgid % nig) / gsz; u.be = u.pn; u.e = 0; return true;
    }
    __device__ __forceinline__ void a_ready(const Unit&) const {}
    __device__ __forceinline__ void done(const Unit&) const {}
};

__device__ __forceinline__ unsigned cvt_pk_bf16(float lo, float hi) { unsigned r; asm volatile("v_cvt_pk_bf16_f32 %0, %1, %2" : "=v"(r) : "v"(lo), "v"(hi)); return r; }
typedef float f32x2 __attribute__((ext_vector_type(2)));
__device__ __forceinline__ f32x2 gelu_pk(f32x2 v) {
    const f32x2 av = __builtin_elementwise_abs(v), d = av * 0.2316418882f + 1.0f;
    f32x2 t; t.x = __builtin_amdgcn_rcpf(d.x); t.y = __builtin_amdgcn_rcpf(d.y);
    f32x2 q = t * 0.5307027145f + (-0.7265760135f); q = q * t + 0.7107068705f; q = q * t + (-0.142248368f); q = q * t + 0.127414796f; q = q * t;
    const f32x2 s = (v * v) * (-0.72134752044f);
    f32x2 e; e.x = __builtin_amdgcn_exp2f(s.x); e.y = __builtin_amdgcn_exp2f(s.y);
    const f32x2 m = v * (q * e), r = v - m;
    f32x2 o; o.x = v.x < 0.f ? m.x : r.x; o.y = v.y < 0.f ? m.y : r.y; return o;
}

template <int ACT  > struct EpiBf16 {
    static constexpr bool PERM = true, AFTER_DRAIN = false; static_assert(ACT == 0 || ACT == 1, "EpiBf16: ACT is 0 (none) or 1 (gelu_pk)");
    bf16_t* O; int ldc; const float* bias; int split_cols; size_t split_stride; float scale0;
    __device__ __forceinline__ void operator()(const f32x4 (&acc)[2][2][4][2], const Unit& u, int wr, int wc, int fr, int fq) const {
        const int row0 = u.pm * BM + wr * 64 + fr; int colt = u.pn * BM; bf16_t* base = O;
        float sc = 1.f; if (split_cols) { const int t = colt / split_cols; base += (size_t)t * split_stride; colt -= t * split_cols; if (t == 0) sc = scale0; }
        const int col0 = colt + wc * 32 + 8 * fq, bcol0 = u.pn * BM + wc * 32 + 8 * fq;
        f32x4 bv[2][2];
#pragma unroll
        for (int bj = 0; bj < 2; ++bj)
#pragma unroll
            for (int n = 0; n < 2; ++n) bv[bj][n] = bias ? *(const f32x4*)(bias + bcol0 + bj * HALF + 4 * n) : (f32x4){0.f, 0.f, 0.f, 0.f};
#pragma unroll
        for (int ai = 0; ai < 2; ++ai)
#pragma unroll
            for (int m = 0; m < 4; ++m) { bf16_t* rowp = base + (size_t)(row0 + ai * HALF + m * 16) * ldc + col0;
#pragma unroll
                for (int bj = 0; bj < 2; ++bj) { f32x4 v0 = acc[ai][bj][m][0] + bv[bj][0], v1 = acc[ai][bj][m][1] + bv[bj][1];
                    if (ACT == 1) { f32x2 a = gelu_pk((f32x2){v0[0], v0[1]}), b = gelu_pk((f32x2){v0[2], v0[3]}), c = gelu_pk((f32x2){v1[0], v1[1]}), d = gelu_pk((f32x2){v1[2], v1[3]});
                        v0 = (f32x4){a.x, a.y, b.x, b.y}; v1 = (f32x4){c.x, c.y, d.x, d.y}; }
                    v0 = v0 * sc; v1 = v1 * sc; u32x4 w; w.x = cvt_pk_bf16(v0[0], v0[1]); w.y = cvt_pk_bf16(v0[2], v0[3]); w.z = cvt_pk_bf16(v1[0], v1[1]); w.w = cvt_pk_bf16(v1[2], v1[3]);
                    *(u32x4*)(rowp + bj * HALF) = w; } }
    }
};


struct EpiResid {
    static constexpr bool PERM = false, AFTER_DRAIN = false;
    const float* xin_lat; const float* xin_ctx; int nlat; float* XR; int ldc; const float* mod; int mod_stride; int seq;
    __device__ __forceinline__ void operator()(const f32x4 (&acc)[2][2][4][2], const Unit& u, int wr, int wc, int fr, int fq) const {
        const int row0 = u.pm * BM + wr * 64 + fr, col0 = u.pn * BM + wc * 32 + 4 * fq;
        const int rowt = u.pm * BM; const int bidx = rowt < nlat ? rowt / seq : 4;
        const float* gate = mod + (size_t)bidx * mod_stride;
        const float* xin = rowt < nlat ? xin_lat : (xin_ctx - (size_t)nlat * ldc);
        f32x4 gv[2][2];
#pragma unroll
        for (int bj = 0; bj < 2; ++bj)
#pragma unroll
            for (int n = 0; n < 2; ++n) gv[bj][n] = *(const f32x4*)(gate + col0 + bj * HALF + n * 16);
#pragma unroll
        for (int ai = 0; ai < 2; ++ai)
#pragma unroll
            for (int m = 0; m < 4; ++m) { const size_t ro = (size_t)(row0 + ai * HALF + m * 16) * ldc + col0;
#pragma unroll
                for (int bj = 0; bj < 2; ++bj)
#pragma unroll
                    for (int n = 0; n < 2; ++n) { const f32x4 xv = *(const f32x4*)(xin + ro + bj * HALF + n * 16);
                        *(f32x4*)(XR + ro + bj * HALF + n * 16) = xv + gv[bj][n] * acc[ai][bj][m][n]; } }
    }
};
struct EpiSwiglu {
    static constexpr bool PERM = true, AFTER_DRAIN = false;
    bf16_t* O; int ldc; const float* bias; int bias_stride;
    __device__ __forceinline__ void operator()(const f32x4 (&acc)[2][2][4][2], const Unit& u, int wr, int wc, int fr, int fq) const {
        const int row0 = u.pm * BM + wr * 64 + fr; const int bcol0 = u.pn * BM + wc * 32 + 8 * fq; const int ocol0 = bcol0 >> 1;
        const float* bb = bias + (size_t)u.e * bias_stride;
        f32x4 bv[2][2];
#pragma unroll
        for (int bj = 0; bj < 2; ++bj)
#pragma unroll
            for (int n = 0; n < 2; ++n) bv[bj][n] = *(const f32x4*)(bb + bcol0 + bj * HALF + 4 * n);
#pragma unroll
        for (int ai = 0; ai < 2; ++ai)
#pragma unroll
            for (int m = 0; m < 4; ++m) { bf16_t* rowp = O + (size_t)(row0 + ai * HALF + m * 16) * ldc + ocol0;
#pragma unroll
                for (int bj = 0; bj < 2; ++bj) { const f32x4 v0 = acc[ai][bj][m][0] + bv[bj][0], v1 = acc[ai][bj][m][1] + bv[bj][1];
                    float o[4];
#pragma unroll
                    for (int p = 0; p < 4; ++p) { const float hg = p < 2 ? v0[2 * p] : v1[2 * p - 4], hl = p < 2 ? v0[2 * p + 1] : v1[2 * p - 3];
                        const float glu = fminf(hg, 7.0f), lin = fminf(fmaxf(hl, -7.0f), 7.0f);
                        const float sg = __builtin_amdgcn_rcpf(1.0f + __builtin_amdgcn_exp2f(-1.702f * 1.4426950408889634f * glu));
                        o[p] = glu * sg * (lin + 1.0f); }
                    typedef unsigned u32x2 __attribute__((ext_vector_type(2)));
                    u32x2 w; w.x = cvt_pk_bf16(o[0], o[1]); w.y = cvt_pk_bf16(o[2], o[3]);
                    *(u32x2*)(rowp + bj * (HALF / 2)) = w; } }
    }
};
struct EpiBf16Bias {
    static constexpr bool PERM = true, AFTER_DRAIN = false;
    bf16_t* O; int ldc; const float* bias; int bias_stride;
    __device__ __forceinline__ void operator()(const f32x4 (&acc)[2][2][4][2], const Unit& u, int wr, int wc, int fr, int fq) const {
        const int row0 = u.pm * BM + wr * 64 + fr; const int col0 = u.pn * BM + wc * 32 + 8 * fq;
        const float* bb = bias + (size_t)u.e * bias_stride;
        f32x4 bv[2][2];
#pragma unroll
        for (int bj = 0; bj < 2; ++bj)
#pragma unroll
            for (int n = 0; n < 2; ++n) bv[bj][n] = *(const f32x4*)(bb + col0 + bj * HALF + 4 * n);
#pragma unroll
        for (int ai = 0; ai < 2; ++ai)
#pragma unroll
            for (int m = 0; m < 4; ++m) { bf16_t* rowp = O + (size_t)(row0 + ai * HALF + m * 16) * ldc + col0;
#pragma unroll
                for (int bj = 0; bj < 2; ++bj) { const f32x4 v0 = acc[ai][bj][m][0] + bv[bj][0], v1 = acc[ai][bj][m][1] + bv[bj][1];
                    u32x4 w; w.x = cvt_pk_bf16(v0[0], v0[1]); w.y = cvt_pk_bf16(v0[2], v0[3]); w.z = cvt_pk_bf16(v1[0], v1[1]); w.w = cvt_pk_bf16(v1[2], v1[3]);
                    *(u32x4*)(rowp + bj * HALF) = w; } }
    }
};
struct MoeOrder {
    const PG8_LAS int* tab; int ntiles, nN, G, c;
    __device__ __forceinline__ bool next(int i, Unit& u) const {
        const int L = i * G + c; if (L >= ntiles * nN) return false;
        u.pm = L / nN; u.pn = L - u.pm * nN; u.e = tab[u.pm]; u.be = u.e * nN + u.pn; return true;
    }
    __device__ __forceinline__ void a_ready(const Unit&) const {}
    __device__ __forceinline__ void done(const Unit&) const {}
};
template <class Epi, class Sched, bool ALIGN_EPI = false, bool SP2 = false>
__device__ __forceinline__ void gemm_phase(PG8_LAS unsigned char* lds, const Gemm g, const Sched& S, const Epi& E) {
    int tid_ = threadIdx.x; asm volatile("" : "+v"(tid_));
    const int tid = tid_, wid = __builtin_amdgcn_readfirstlane(tid >> 6), lane = tid & 63, wr = wid >> 2, wc = wid & 3, fr = lane & 15, fq = lane >> 4;
    const int K = g.K, nt = K / BK;
    unsigned voffA[2], voffB[2];
#pragma unroll
    for (int i = 0; i < 2; ++i) { int R, C; stage_rc(tid * 16 + i * 8192, R, C); const int Rb = Epi::PERM ? ((R & ~31) + perm32(R & 31)) : R;
        voffA[i] = (unsigned)(R * K + C) * 2u; voffB[i] = (unsigned)(Rb * K + C) * 2u; }
    const size_t kstep = (size_t)(BK * 2);
    const size_t hstep = (size_t)HALF * K * 2;
    const size_t tstep = 2 * hstep;
    const unsigned ldsw = (unsigned)wid * 1024u;
    const int aoff = lds_byte(wr * 64 + fr, fq * 8), boff = lds_byte(wc * 32 + fr, fq * 8);
#define PG8_SA(b, h) (((b) * 2 + (h)) * HTB)
#define PG8_SB(b, h) ((4 + (b) * 2 + (h)) * HTB)
#define PG8_STAGE(bufoff, gbase, voff) do { _Pragma("unroll") for (int _i = 0; _i < 2; ++_i) \
        __builtin_amdgcn_global_load_lds((const unsigned*)((const char*)(gbase) + (voff)[_i]), (PG8_LAS unsigned*)(lds + (bufoff) + ldsw + _i * 8192), 16, 0, 0); } while (0)
#define PG8_LDA(dst, b, h) do { _Pragma("unroll") for (int m = 0; m < 4; ++m) _Pragma("unroll") for (int k = 0; k < 2; ++k) dst[m][k] = *(const PG8_LAS bf16x8*)(lds + PG8_SA(b, h) + aoff + m * 2048 + k * 1024); } while (0)
#define PG8_LDB(dst, b, h) do { _Pragma("unroll") for (int n = 0; n < 2; ++n) _Pragma("unroll") for (int k = 0; k < 2; ++k) dst[n][k] = *(const PG8_LAS bf16x8*)(lds + PG8_SB(b, h) + boff + n * 2048 + k * 1024); } while (0)
#define PG8_MMA(ai, bj, At, Bt) do { __builtin_amdgcn_s_setprio(1); _Pragma("unroll") for (int m = 0; m < 4; ++m) _Pragma("unroll") for (int n = 0; n < 2; ++n) _Pragma("unroll") for (int k = 0; k < 2; ++k) \
        acc[ai][bj][m][n] = __builtin_amdgcn_mfma_f32_16x16x32_bf16(Bt[n][k], At[m][k], acc[ai][bj][m][n], 0, 0, 0); __builtin_amdgcn_s_setprio(0); } while (0)
#define PG8_WAIT_V(n) asm volatile("s_waitcnt vmcnt(" #n ")" ::: "memory")
#define PG8_WAIT_L(n) asm volatile("s_waitcnt lgkmcnt(" #n ")" ::: "memory")
#define PG8_BAR __builtin_amdgcn_s_barrier()
#define PG8_SCHED __builtin_amdgcn_sched_barrier(0)
    Unit cur, nxt; int ui = 0;
    if (!S.next(0, cur)) return;
    f32x4 acc[2][2][4][2];
#pragma unroll
    for (int a = 0; a < 2; ++a)
#pragma unroll
        for (int b = 0; b < 2; ++b)
#pragma unroll
            for (int m = 0; m < 4; ++m)
#pragma unroll
                for (int n = 0; n < 2; ++n) acc[a][b][m][n] = (f32x4){0.f, 0.f, 0.f, 0.f};
    bf16x8 At[4][2], B0[2][2], B1[2][2];
    const char* cA = (const char*)g.A + (size_t)cur.pm * tstep; const char* cB = (const char*)g.Bt + (size_t)cur.be * tstep;
    S.a_ready(cur);
    if constexpr (SP2) {
        PG8_STAGE(PG8_SB(0, 0), cB, voffB); PG8_STAGE(PG8_SB(0, 1), cB + hstep, voffB); PG8_STAGE(PG8_SA(0, 0), cA, voffA); PG8_STAGE(PG8_SA(0, 1), cA + hstep, voffA);
        if (wr == 1) PG8_BAR;
        PG8_WAIT_V(2); PG8_BAR;
        PG8_STAGE(PG8_SB(1, 0), cB + kstep, voffB); PG8_STAGE(PG8_SA(1, 0), cA + kstep, voffA); PG8_STAGE(PG8_SB(1, 1), cB + hstep + kstep, voffB);
        PG8_WAIT_V(6); PG8_BAR;
    } else {
        PG8_STAGE(PG8_SB(0, 0), cB, voffB); PG8_STAGE(PG8_SA(0, 0), cA, voffA); PG8_STAGE(PG8_SB(0, 1), cB + hstep, voffB); PG8_STAGE(PG8_SA(0, 1), cA + hstep, voffA);
        if (wr == 1) PG8_BAR;
        PG8_WAIT_V(4); PG8_BAR;
        PG8_STAGE(PG8_SB(1, 0), cB + kstep, voffB); PG8_STAGE(PG8_SA(1, 0), cA + kstep, voffA); PG8_STAGE(PG8_SB(1, 1), cB + hstep + kstep, voffB);
        PG8_WAIT_V(6); PG8_BAR;
    }
    for (;;) {
        const bool has_next = S.next(ui + 1, nxt);
        const char* nA = has_next ? (const char*)g.A + (size_t)nxt.pm * tstep : cA; const char* nB = has_next ? (const char*)g.Bt + (size_t)nxt.be * tstep : cB;
        for (int t = 0; t < nt; t += 2) {
            const bool last = (t == nt - 2);
            const char* a1 = cA + (size_t)(t + 1) * kstep;
            const char* a2 = last ? nA : cA + (size_t)(t + 2) * kstep; const char* b2 = last ? nB : cB + (size_t)(t + 2) * kstep;
            const char* a3 = a2 + kstep; const char* b3 = b2 + kstep;
            if (last && has_next) S.a_ready(nxt);
            if constexpr (SP2) {
            PG8_LDB(B0, 0, 0); PG8_LDB(B1, 0, 1); PG8_SCHED; PG8_LDA(At, 0, 0); PG8_STAGE(PG8_SA(1, 1), a1 + hstep, voffA);
            PG8_WAIT_V(8); PG8_WAIT_L(0); PG8_BAR; PG8_MMA(0, 0, At, B0); PG8_MMA(0, 1, At, B1); PG8_BAR; PG8_SCHED;
            PG8_LDA(At, 0, 1); PG8_STAGE(PG8_SB(0, 0), b2, voffB); PG8_STAGE(PG8_SB(0, 1), b2 + hstep, voffB); PG8_STAGE(PG8_SA(0, 0), a2, voffA);
            PG8_WAIT_V(8); PG8_WAIT_L(0); PG8_BAR; PG8_MMA(1, 0, At, B0); PG8_MMA(1, 1, At, B1); PG8_BAR; PG8_SCHED;
            PG8_LDB(B0, 1, 0); PG8_LDB(B1, 1, 1); PG8_SCHED; PG8_LDA(At, 1, 0); PG8_STAGE(PG8_SA(0, 1), a2 + hstep, voffA);
            PG8_WAIT_V(8); PG8_WAIT_L(0); PG8_BAR; PG8_MMA(0, 0, At, B0); PG8_MMA(0, 1, At, B1); PG8_BAR; PG8_SCHED;
            PG8_LDA(At, 1, 1); PG8_STAGE(PG8_SB(1, 0), b3, voffB); PG8_STAGE(PG8_SB(1, 1), b3 + hstep, voffB); PG8_STAGE(PG8_SA(1, 0), a3, voffA);
            PG8_WAIT_V(8); PG8_WAIT_L(0); PG8_BAR; PG8_MMA(1, 0, At, B0); PG8_MMA(1, 1, At, B1); PG8_BAR; PG8_SCHED;
            } else {
            PG8_LDB(B0, 0, 0); PG8_SCHED; PG8_LDA(At, 0, 0); PG8_STAGE(PG8_SA(1, 1), a1 + hstep, voffA);
            PG8_WAIT_L(8); PG8_BAR; PG8_WAIT_L(0); PG8_MMA(0, 0, At, B0); PG8_BAR; PG8_SCHED;
            PG8_LDB(B1, 0, 1); PG8_STAGE(PG8_SB(0, 0), b2, voffB);
            PG8_BAR; PG8_WAIT_L(0); PG8_MMA(0, 1, At, B1); PG8_BAR;
            PG8_LDA(At, 0, 1); PG8_STAGE(PG8_SA(0, 0), a2, voffA);
            PG8_BAR; PG8_WAIT_L(0); PG8_MMA(1, 0, At, B0); PG8_BAR; PG8_SCHED;
            PG8_STAGE(PG8_SB(0, 1), b2 + hstep, voffB);
            PG8_WAIT_V(6); PG8_BAR; PG8_MMA(1, 1, At, B1); PG8_BAR;
            PG8_LDB(B0, 1, 0); PG8_SCHED; PG8_LDA(At, 1, 0); PG8_STAGE(PG8_SA(0, 1), a2 + hstep, voffA);
            PG8_WAIT_L(8); PG8_BAR; PG8_WAIT_L(0); PG8_MMA(0, 0, At, B0); PG8_BAR; PG8_SCHED;
            PG8_LDB(B1, 1, 1); PG8_STAGE(PG8_SB(1, 0), b3, voffB);
            PG8_BAR; PG8_WAIT_L(0); PG8_MMA(0, 1, At, B1); PG8_BAR;
            PG8_LDA(At, 1, 1); PG8_STAGE(PG8_SA(1, 0), a3, voffA);
            PG8_BAR; PG8_WAIT_L(0); PG8_MMA(1, 0, At, B0); PG8_BAR; PG8_SCHED;
            PG8_STAGE(PG8_SB(1, 1), b3 + hstep, voffB);
            PG8_WAIT_V(6); PG8_BAR; PG8_MMA(1, 1, At, B1); PG8_BAR;
            }
        }
        if constexpr (ALIGN_EPI) { if (wr == 0) PG8_BAR; }
        if constexpr (!Epi::AFTER_DRAIN) { E(acc, cur, wr, wc, fr, fq); S.done(cur); }
        if (!has_next) break;
#pragma unroll
        for (int a = 0; a < 2; ++a)
#pragma unroll
            for (int b = 0; b < 2; ++b)
#pragma unroll
                for (int m = 0; m < 4; ++m)
#pragma unroll
                    for (int n = 0; n < 2; ++n) acc[a][b][m][n] = (f32x4){0.f, 0.f, 0.f, 0.f};
        cur = nxt; cA = nA; cB = nB; ++ui;
        if constexpr (ALIGN_EPI) { if (wr == 1) PG8_BAR; }
    }
    PG8_WAIT_V(0);
    if constexpr (!ALIGN_EPI) { if (wr == 0) PG8_BAR; }
    PG8_BAR;
    if constexpr (Epi::AFTER_DRAIN) { E.fused(acc, cur, wr, wc, fr, fq, lds, wid, lane); S.done(cur); }
#undef PG8_SA
#undef PG8_SB
#undef PG8_STAGE
#undef PG8_LDA
#undef PG8_LDB
#undef PG8_MMA
#undef PG8_WAIT_V
#undef PG8_WAIT_L
#undef PG8_BAR
#undef PG8_SCHED
}
}

#ifndef PG8_SP2
#define PG8_SP2 true
#endif
#ifndef PG8_ALIGN
#define PG8_ALIGN true
#endif
#include <cmath>
namespace attn_body {
using bf16=__hip_bfloat16;
using bf16x8=__attribute__((ext_vector_type(8)))short;
using s16x4=__attribute__((ext_vector_type(4)))short;
using f32x16=__attribute__((ext_vector_type(16)))float;
using u32x4=__attribute__((ext_vector_type(4)))unsigned;
constexpr int NHEAD=8,SEQQ=8192,SEQK=8448,D=64,QP=512,KP=128;
constexpr int NW=8,QBLK=32,QB=QBLK*NW,KVBLK=64,NQB=SEQQ/QB;
constexpr int ATTN_UNIT_ROWS=QB;
__device__ __forceinline__ int crow(int r,int hi){return (r&3)+8*(r>>2)+4*hi;}
#define SBAR() __builtin_amdgcn_sched_barrier(0)
__device__ __forceinline__ void cmask(f32x16&p0,f32x16&p1,int jb,int qrel,int hi){
  const float NEG=-INFINITY; int kb=64*jb+4*hi;
  #pragma unroll
  for(int r=0;r<16;++r){int kv=kb+(r&3)+8*(r>>2); if(kv>qrel)p0[r]=NEG; if(kv+32>qrel)p1[r]=NEG;}
}

constexpr int NSLOT=3, SLOTB=8192;
constexpr int LDS_K=0, LDS_V=NSLOT*SLOTB, LDS_WS=2*NSLOT*SLOTB, LDS_OST=LDS_WS+NW*64*4, LDS_BYTES=LDS_OST+NW*4096;
constexpr float C2=0.125f*1.4426950408889634f;
__device__ __forceinline__ void glds16(const void*gsrc,unsigned lds_dst){unsigned keep;
  asm volatile("s_mov_b32 %0, m0\n\ts_mov_b32 m0, %2\n\ts_nop 0\n\tglobal_load_lds_dwordx4 %1, off\n\ts_mov_b32 m0, %0":"=&s"(keep):"v"(gsrc),"s"(lds_dst):"memory");}
__device__ __forceinline__ float max3f(float a,float b,float c){float r;asm("v_max3_f32 %0, %1, %2, %3":"=v"(r):"v"(a),"v"(b),"v"(c));return r;}
__device__ __forceinline__ float max2f(float a,float b){float r;asm("v_max_f32_e32 %0, %1, %2":"=v"(r):"v"(a),"v"(b));return r;}
__device__ __forceinline__ float fadd_s(float a,float b){float r;asm("v_add_f32_e32 %0, %1, %2":"=v"(r):"v"(a),"v"(b));return r;}
__device__ __forceinline__ float fsub_s(float a,float b){float r;asm("v_sub_f32_e32 %0, %1, %2":"=v"(r):"v"(a),"v"(b));return r;}
typedef float f32x2_t __attribute__((ext_vector_type(2))); typedef __bf16 bf16x2_t __attribute__((ext_vector_type(2)));
__device__ __forceinline__ unsigned cvtpk_s(float lo,float hi){f32x2_t v={lo,hi};bf16x2_t b=__builtin_convertvector(v,bf16x2_t);return __builtin_bit_cast(unsigned,b);}
#define WAIT_BAR(N) asm volatile("s_waitcnt vmcnt(" #N ") lgkmcnt(0)\n\ts_barrier":::"memory")

__device__ __forceinline__ void qkt(f32x16&p0,f32x16&p1,const char*Kslot,const bf16x8*qr,const f32x16&negm,int r32,int hi){
  const char*kb=Kslot+hi*1024+r32*16;
  #pragma unroll
  for(int d0=0;d0<4;++d0){
    const bf16x8 b0=*reinterpret_cast<const bf16x8*>(kb+d0*2048);
    const bf16x8 b1=*reinterpret_cast<const bf16x8*>(kb+d0*2048+512);
    if(d0==0){p0=__builtin_amdgcn_mfma_f32_32x32x16_bf16(b0,qr[0],negm,0,0,0);p1=__builtin_amdgcn_mfma_f32_32x32x16_bf16(b1,qr[0],negm,0,0,0);}
    else{p0=__builtin_amdgcn_mfma_f32_32x32x16_bf16(b0,qr[d0],p0,0,0,0);p1=__builtin_amdgcn_mfma_f32_32x32x16_bf16(b1,qr[d0],p1,0,0,0);}}
}
typedef __attribute__((address_space(3))) const char* lds_cptr;
typedef short v4i16_t __attribute__((ext_vector_type(4)));
__device__ __forceinline__ void kload8(bf16x8*kf,lds_cptr kp){
  kf[0]=*(const __attribute__((address_space(3))) bf16x8*)(kp);      kf[1]=*(const __attribute__((address_space(3))) bf16x8*)(kp+512);
  kf[2]=*(const __attribute__((address_space(3))) bf16x8*)(kp+2048); kf[3]=*(const __attribute__((address_space(3))) bf16x8*)(kp+2560);
  kf[4]=*(const __attribute__((address_space(3))) bf16x8*)(kp+4096); kf[5]=*(const __attribute__((address_space(3))) bf16x8*)(kp+4608);
  kf[6]=*(const __attribute__((address_space(3))) bf16x8*)(kp+6144); kf[7]=*(const __attribute__((address_space(3))) bf16x8*)(kp+6656);
}
__device__ __forceinline__ void kload2(bf16x8*kf,lds_cptr kp,int j){ kf[2*j]=*(const __attribute__((address_space(3))) bf16x8*)(kp+j*2048); kf[2*j+1]=*(const __attribute__((address_space(3))) bf16x8*)(kp+j*2048+512); }
__device__ __forceinline__ s16x4 vtr(lds_cptr p){ return __builtin_bit_cast(s16x4,__builtin_amdgcn_ds_read_tr16_b64_v4i16((__attribute__((address_space(3))) v4i16_t*)p)); }
__device__ __forceinline__ float rowmax(const f32x16&p0,const f32x16&p1){
  float a=max3f(p0[0],p0[1],p1[0]),b=max3f(p0[2],p0[3],p1[1]);a=max3f(a,p1[2],p1[3]);
  #pragma unroll
  for(int r=4;r<16;r+=4){a=max3f(a,p0[r],p0[r+1]);b=max3f(b,p0[r+2],p0[r+3]);a=max3f(a,p1[r],p1[r+1]);b=max3f(b,p1[r+2],p1[r+3]);}
  const float m=max2f(a,b);
  auto rr=__builtin_amdgcn_permlane32_swap(__float_as_uint(m),__float_as_uint(m),false,false);
  return max2f(__uint_as_float(rr[0]),__uint_as_float(rr[1]));
}
__device__ __forceinline__ void pv(f32x16*o,int vb,bf16x8 pa0,bf16x8 pa1,bf16x8 pa2,bf16x8 pa3){
  #pragma unroll
  for(int d0=0;d0<2;++d0){s16x4 lo[4],hi[4];
    #pragma unroll
    for(int ks=0;ks<4;++ks){
      asm volatile("ds_read_b64_tr_b16 %0,%1 offset:%c2":"=&v"(lo[ks]):"v"(vb),"i"(d0*4096+ks*1024):"memory");
      asm volatile("ds_read_b64_tr_b16 %0,%1 offset:%c2":"=&v"(hi[ks]):"v"(vb),"i"(d0*4096+ks*1024+512):"memory");}
    asm volatile("s_waitcnt lgkmcnt(0)":::"memory");SBAR();
    #define PK(k) (bf16x8){lo[k][0],lo[k][1],lo[k][2],lo[k][3],hi[k][0],hi[k][1],hi[k][2],hi[k][3]}
    o[d0]=__builtin_amdgcn_mfma_f32_32x32x16_bf16(pa0,PK(0),o[d0],0,0,0);
    o[d0]=__builtin_amdgcn_mfma_f32_32x32x16_bf16(pa1,PK(1),o[d0],0,0,0);
    o[d0]=__builtin_amdgcn_mfma_f32_32x32x16_bf16(pa2,PK(2),o[d0],0,0,0);
    o[d0]=__builtin_amdgcn_mfma_f32_32x32x16_bf16(pa3,PK(3),o[d0],0,0,0);
    #undef PK
  }
}

#ifndef ATTN_STORE16
#define ATTN_STORE16(p,v) (*(u32x4*)(p)=(v))
#endif
template<int THRL> __device__ __forceinline__ void attn_unit(int b,int h,int qb,const bf16*Q,const bf16*__restrict__ K,const bf16*__restrict__ V,bf16*O,char*shm){
  int tid_=threadIdx.x; asm volatile("":"+v"(tid_)); const int tid=tid_,lane=tid&63,r32=lane&31,hi=lane>>5; const int wid=__builtin_amdgcn_readfirstlane(tid>>6);
  const long qrowbase=(long)b*SEQQ, krowbase=(long)b*SEQK; const int q0=qb*QB, kvh=h>>2;
  const bf16*Qw=Q+(qrowbase+q0+wid*QBLK)*QP+h*D;
  const bf16*Kh=K+krowbase*KP+kvh*D,*Vh=V+krowbase*KP+kvh*D;
  const unsigned lds0=(unsigned)(uintptr_t)shm;
  float*wsf=(float*)(shm+LDS_WS)+wid*64;
  const bf16*ksrc=Kh+(long)lane*KP+wid*8;
  const bf16*vsrc=Vh+(long)(16*(wid&3)+(lane>>2))*KP+(wid>>2)*32+(lane&3)*8;
  const unsigned kdst=lds0+LDS_K+wid*1024, vdst=lds0+LDS_V+wid*1024;
  #define DMA_K(t,slot) glds16(ksrc+(long)(t)*KVBLK*KP,(unsigned)__builtin_amdgcn_readfirstlane(kdst+(slot)))
  #define DMA_V(t,slot) glds16(vsrc+(long)(t)*KVBLK*KP,(unsigned)__builtin_amdgcn_readfirstlane(vdst+(slot)))
  const int vb0=(int)(lds0+LDS_V)+((lane>>4)&1)*32+(lane&3)*8+(4*hi+((lane&15)>>2))*64;
  const char*Kbase=shm+LDS_K; bf16x8 kf[8];
  const lds_cptr shm3=(lds_cptr)shm; const lds_cptr kp0=shm3+LDS_K+hi*1024+r32*16; const lds_cptr vp0=shm3+LDS_V+((lane>>4)&1)*32+(lane&3)*8+(4*hi+((lane&15)>>2))*64;
  const int NT=SEQK/KVBLK;
  DMA_K(0,0);DMA_V(0,0);DMA_K(1,SLOTB);
  bf16x8 qr[4];
  #pragma unroll
  for(int d0=0;d0<4;++d0)qr[d0]=*reinterpret_cast<const bf16x8*>(&Qw[(long)r32*QP+d0*16+hi*8]);
  float mhat=0.f,l_reg=0.f;f32x16 o[2];o[0]=f32x16{};o[1]=f32x16{};f32x16 negm=f32x16{};asm volatile("":"+v"(negm));
  const int qrel=wid*QBLK+r32;
  #define CMASK(P0,P1,t) do{}while(0)
  bool resc=false;
  #define START(P0,P1) do{ const float rm=rowmax(P0,P1); resc=false; \
    { const float dl=rm; mhat=fadd_s(mhat,dl); \
      _Pragma("unroll") for(int r=0;r<16;++r){P0[r]=fsub_s(P0[r],dl);P1[r]=fsub_s(P1[r],dl);} \
      _Pragma("unroll") for(int r=0;r<16;++r)negm[r]=-mhat; asm volatile("":"+v"(negm)); } \
    _Pragma("unroll") for(int r=0;r<16;++r)P0[r]=__builtin_amdgcn_exp2f(P0[r]); }while(0)
  #define RESC() do{ if(resc){ asm volatile("s_waitcnt lgkmcnt(0)":::"memory"); \
      _Pragma("unroll") for(int d_=0;d_<2;++d_) _Pragma("unroll") for(int r=0;r<16;++r)o[d_][r]*=wsf[crow(r,hi)]; } }while(0)
  f32x16 pA0,pA1,pB0,pB1;
  int sl_prev=0,sl_cur=0,sl_next=SLOTB;
  #define ROT() do{sl_prev=sl_cur;sl_cur=sl_next;sl_next=(sl_next==(NSLOT-1)*SLOTB)?0:sl_next+SLOTB;}while(0)
  DMA_K(2,2*SLOTB);
  WAIT_BAR(3);
  qkt(pA0,pA1,Kbase,qr,negm,r32,hi);asm volatile("s_nop 15\n\ts_nop 7":"+v"(pA0),"+v"(pA1));CMASK(pA0,pA1,0);
  START(pA0,pA1);
  _Pragma("unroll") for(int r=0;r<16;++r)pA1[r]=__builtin_amdgcn_exp2f(pA1[r]);
  WAIT_BAR(0);
  DMA_K(3,0);DMA_V(1,SLOTB);
  ROT();
  kload8(kf,kp0+sl_cur);
  WAIT_BAR(2);
  s16x4 vlo[8],vhi[8]; u32x4 pw0,pw1,pw2,pw3;
  #define PKW(P,B) cvtpk_s(P[B],P[B+1])
  #define PAF(k) __builtin_bit_cast(bf16x8,pw##k)
  #define VFR(i) (bf16x8){vlo[i][0],vlo[i][1],vlo[i][2],vlo[i][3],vhi[i][0],vhi[i][1],vhi[i][2],vhi[i][3]}
  #define PIN(x) asm volatile("":"+v"(x))
  #define MX3(a,b,c) __builtin_fmaxf(__builtin_fmaxf((a),(b)),(c))
  #define GAPA(MF,A0,A1,A2,A3,W0,W1,PW) do{ MF; sacc+=A0; sacc+=A1; sacc+=A2; sacc+=A3; PIN(sacc); W0; W1; PIN(PW); SBAR(); }while(0)
  #define EX(v) __builtin_amdgcn_exp2f(v)
  #define GAPB(MF,X,B) do{ MF; X[B]=EX(X[B]); X[B+1]=EX(X[B+1]); X[B+2]=EX(X[B+2]); X[B+3]=EX(X[B+3]); PIN(X); SBAR(); }while(0)
  #define VRD(i) do{ vlo[i]=vtr(vp_+(((i)>>2)*4096+((i)&3)*1024)); vhi[i]=vtr(vp_+(((i)>>2)*4096+((i)&3)*1024+512)); }while(0)
  #define KRD(G,j) do{ if(G){ kload2(kf,kp0+sl_next,j); SBAR(); } }while(0)
  #define STEP(C0,C1,P0,P1,t,GK,GV,GL) do{ SBAR(); \
    const lds_cptr vp_=vp0+sl_prev; \
    VRD(0); SBAR(); float sacc=(P0[0]+P0[1]); \
    GAPA(C0=__builtin_amdgcn_mfma_f32_32x32x16_bf16(kf[0],qr[0],negm,0,0,0), P0[2],P0[3],P0[4],P0[5],     pw0[0]=PKW(P0,0), pw0[1]=PKW(P0,2), pw0); \
    VRD(4); SBAR(); GAPA(C1=__builtin_amdgcn_mfma_f32_32x32x16_bf16(kf[1],qr[0],negm,0,0,0), P0[6],P0[7],P0[8],P0[9],     pw0[2]=PKW(P0,4), pw0[3]=PKW(P0,6), pw0); \
    VRD(1); SBAR(); GAPA(C0=__builtin_amdgcn_mfma_f32_32x32x16_bf16(kf[2],qr[1],C0,0,0,0),   P0[10],P0[11],P0[12],P0[13], pw1[0]=PKW(P0,8), pw1[1]=PKW(P0,10), pw1); \
    VRD(5); SBAR(); GAPA(C1=__builtin_amdgcn_mfma_f32_32x32x16_bf16(kf[3],qr[1],C1,0,0,0),   P0[14],P0[15],P1[0],P1[1],   pw1[2]=PKW(P0,12),pw1[3]=PKW(P0,14), pw1); \
    VRD(2); SBAR(); GAPA(C0=__builtin_amdgcn_mfma_f32_32x32x16_bf16(kf[4],qr[2],C0,0,0,0),   P1[2],P1[3],P1[4],P1[5],     pw2[0]=PKW(P1,0), pw2[1]=PKW(P1,2), pw2); \
    VRD(6); SBAR(); GAPA(C1=__builtin_amdgcn_mfma_f32_32x32x16_bf16(kf[5],qr[2],C1,0,0,0),   P1[6],P1[7],P1[8],P1[9],     pw2[2]=PKW(P1,4), pw2[3]=PKW(P1,6), pw2); \
    VRD(3); SBAR(); GAPA(C0=__builtin_amdgcn_mfma_f32_32x32x16_bf16(kf[6],qr[3],C0,0,0,0),   P1[10],P1[11],P1[12],P1[13], pw3[0]=PKW(P1,8), pw3[1]=PKW(P1,10), pw3); \
    VRD(7); SBAR(); GAPA(C1=__builtin_amdgcn_mfma_f32_32x32x16_bf16(kf[7],qr[3],C1,0,0,0),   P1[14],P1[15],0.f,0.f,       pw3[2]=PKW(P1,12),pw3[3]=PKW(P1,14), pw3); \
    l_reg+=sacc; \
    if(GK){DMA_K((t)+3,sl_cur);} if(GV){DMA_V((t)+1,sl_next);} \
    CMASK(C0,C1,t); \
    { float a=MX3(C0[0],C0[1],C1[0]),b=MX3(C0[2],C0[3],C1[1]); a=MX3(a,C1[2],C1[3]); \
      _Pragma("unroll") for(int r=4;r<16;r+=4){a=MX3(a,C0[r],C0[r+1]);b=MX3(b,C0[r+2],C0[r+3]);a=MX3(a,C1[r],C1[r+1]);b=MX3(b,C1[r+2],C1[r+3]);} \
      float rm=__builtin_fmaxf(a,b); { auto rr=__builtin_amdgcn_permlane32_swap(__float_as_uint(rm),__float_as_uint(rm),false,false); rm=__builtin_fmaxf(__uint_as_float(rr[0]),__uint_as_float(rr[1])); } \
      resc=false; \
      if(__builtin_expect(__any(rm>(float)THRL),0)){ const float dl=__builtin_fmaxf(rm,0.f); mhat+=dl; \
        _Pragma("unroll") for(int r=0;r<16;++r){C0[r]-=dl;C1[r]-=dl;} \
        _Pragma("unroll") for(int r=0;r<16;++r)negm[r]=-mhat; asm volatile("":"+v"(negm)); \
        const float f=__builtin_amdgcn_exp2f(-dl); l_reg*=f; if(hi==0)wsf[r32]=f; resc=true; } } \
    SBAR(); \
    GAPB(o[0]=__builtin_amdgcn_mfma_f32_32x32x16_bf16(PAF(0),VFR(0),o[0],0,0,0), C0,0); \
    GAPB(o[1]=__builtin_amdgcn_mfma_f32_32x32x16_bf16(PAF(0),VFR(4),o[1],0,0,0), C0,4); \
    KRD(GL,0); GAPB(o[0]=__builtin_amdgcn_mfma_f32_32x32x16_bf16(PAF(1),VFR(1),o[0],0,0,0), C0,8); \
    KRD(GL,1); GAPB(o[1]=__builtin_amdgcn_mfma_f32_32x32x16_bf16(PAF(1),VFR(5),o[1],0,0,0), C0,12); \
    KRD(GL,2); GAPB(o[0]=__builtin_amdgcn_mfma_f32_32x32x16_bf16(PAF(2),VFR(2),o[0],0,0,0), C1,0); \
    KRD(GL,3); GAPB(o[1]=__builtin_amdgcn_mfma_f32_32x32x16_bf16(PAF(2),VFR(6),o[1],0,0,0), C1,4); \
    GAPB(o[0]=__builtin_amdgcn_mfma_f32_32x32x16_bf16(PAF(3),VFR(3),o[0],0,0,0), C1,8); \
    GAPB(o[1]=__builtin_amdgcn_mfma_f32_32x32x16_bf16(PAF(3),VFR(7),o[1],0,0,0), C1,12); \
    }while(0)
  int t=1;
  #undef CMASK
  #define CMASK(P0,P1,t) do{}while(0)
  for(;t+5<NT;t+=2){
    STEP(pB0,pB1,pA0,pA1,t,true,true,true);     WAIT_BAR(2); RESC(); ROT();
    STEP(pA0,pA1,pB0,pB1,t+1,true,true,true);   WAIT_BAR(2); RESC(); ROT();
  }
  #undef CMASK
  #define CMASK(P0,P1,t) do{}while(0)
  #define ENDW(tt) do{ if((tt)+3<NT){WAIT_BAR(2);} else if((tt)+2<NT){WAIT_BAR(1);} else {WAIT_BAR(0);} }while(0)
  for(;t+1<NT;t+=2){
    STEP(pB0,pB1,pA0,pA1,t,(t+3<NT),(t+1<NT),(t+1<NT));       ENDW(t);   RESC(); ROT();
    STEP(pA0,pA1,pB0,pB1,t+1,(t+4<NT),(t+2<NT),(t+2<NT));     ENDW(t+1); RESC(); ROT();
  }
  STEP(pB0,pB1,pA0,pA1,NT-1,false,false,false); RESC();
  { float sacc=pB0[0]+pB0[1]; _Pragma("unroll") for(int r=2;r<16;++r)sacc+=pB0[r]; _Pragma("unroll") for(int r=0;r<16;++r)sacc+=pB1[r]; l_reg+=sacc;
    pw0=(u32x4){PKW(pB0,0),PKW(pB0,2),PKW(pB0,4),PKW(pB0,6)};pw1=(u32x4){PKW(pB0,8),PKW(pB0,10),PKW(pB0,12),PKW(pB0,14)};pw2=(u32x4){PKW(pB1,0),PKW(pB1,2),PKW(pB1,4),PKW(pB1,6)};pw3=(u32x4){PKW(pB1,8),PKW(pB1,10),PKW(pB1,12),PKW(pB1,14)};
    SBAR(); pv(o,vb0+sl_cur,PAF(0),PAF(1),PAF(2),PAF(3)); }
  #undef PKW
  #undef PAF
  #undef VFR
  #undef PIN
  #undef MX3
  #undef GAPA
  #undef GAPB
  #undef EX
  #undef VRD
  #undef KRD
  #undef STEP
  #undef ENDW
  {auto rr=__builtin_amdgcn_permlane32_swap(__float_as_uint(l_reg),__float_as_uint(l_reg),false,false);l_reg=__uint_as_float(rr[0])+__uint_as_float(rr[1]);}
  if(hi==0)wsf[32+r32]=l_reg;asm volatile("s_waitcnt lgkmcnt(0)":::"memory");
  float rli[16];
  #pragma unroll
  for(int r=0;r<16;++r)rli[r]=__builtin_amdgcn_rcpf(wsf[32+crow(r,hi)]);
  bf16*Ow=O+(qrowbase+q0+wid*QBLK)*QP+h*D;
  { bf16*stg=(bf16*)(shm+LDS_OST)+wid*2048;
    #pragma unroll
    for(int r=0;r<16;++r){const int orow=crow(r,hi);
      #pragma unroll
      for(int d0=0;d0<2;++d0)stg[orow*64+d0*32+r32]=__float2bfloat16(o[d0][r]*rli[r]);}
    asm volatile("s_waitcnt lgkmcnt(0)":::"memory");
    #pragma unroll
    for(int i=0;i<4;++i){const int row=i*8+(lane>>3),ch=lane&7; const u32x4 v=*(const u32x4*)(stg+row*64+ch*8); ATTN_STORE16(Ow+(long)row*QP+ch*8,v);} }
  asm volatile("s_waitcnt lgkmcnt(0)\n\ts_barrier":::"memory");
  #undef DMA_K
  #undef DMA_V
  #undef CMASK
  #undef START
  #undef RESC
  #undef ROT
}
constexpr int ATTN_LDS_BYTES=LDS_BYTES;
struct AttnTensors { const bf16* Q; const bf16* K; const bf16* V; bf16* O; };
template<int THRL=8> __device__ __forceinline__ void attn_phase(char*lds,const AttnTensors&T,int G,int vcu){
  const int total=4*NHEAD*NQB;
  for(int i=0;;++i){
    int x,n;
    if(G==256){ if(i>=4)break; x=vcu>>5; n=i*32+(vcu&31); }
    else { const int u=i*G+vcu; if(u>=total)break; x=u>>7; n=u&127; }
    const int b=x>>1,kvh=x&1,h=kvh*4+(n>>5),qb=n&31;
    attn_unit<THRL>(b,h,qb,T.Q,T.K,T.V,T.O,lds);
  }
}
#undef SBAR
#undef WAIT_BAR
}

constexpr int NWAVES = 8, NTHR = 512;
constexpr int DMODEL = 1024, NB = 4, SEQ = 8192, CTXL = 256, NLAT = NB * SEQ, NCTX = NB * CTXL, MT = NLAT + NCTX;
constexpr int INW = 2048, NE = 32, KEYS = SEQ + CTXL;
constexpr int SORT_TILES = 560, SORT_ROWS = SORT_TILES * 256;
constexpr float EPSN = 1e-6f;
constexpr int NCHUNK = 66, CHUNK = 128;
constexpr int NPH_PRO = 3, NPH_LAYER = 14, NPH = NPH_PRO + 2 * NPH_LAYER;

constexpr size_t MiB = 1u << 20;
constexpr size_t WS_CTL = 0, CTL_ZERO_BYTES = 1 * MiB;
constexpr size_t WS_MOD = 1 * MiB, WS_ROPEC = 2 * MiB, WS_ROPES = 3 * MiB, WS_H2 = 4 * MiB, WS_KFC = 10 * MiB, WS_BLKCNT = 12 * MiB, WS_TILEE = 13 * MiB, WS_SCANS = 14 * MiB;
constexpr size_t WS_WINT = 16 * MiB, WS_WOUTT = 24 * MiB, WS_W1T = 32 * MiB, WS_W2T = 288 * MiB, WS_KF = 416 * MiB, WS_KHAT = 448 * MiB, WS_XR = 512 * MiB, WS_H = 644 * MiB;
constexpr size_t WS_U = 712 * MiB, WS_Q = 844 * MiB, WS_K = 877 * MiB, WS_V = 886 * MiB, WS_ATT = 895 * MiB, WS_LAB = 928 * MiB, WS_LRUO = 1060 * MiB, WS_VT = 1093 * MiB, WS_X0T = 1125 * MiB,
                 WS_HYO = 1157 * MiB, WS_MIXA = 1190 * MiB;
constexpr size_t WS_F = 712 * MiB, WS_ASORT = 778 * MiB, WS_ACT = 1058 * MiB, WS_YS = 1338 * MiB, WS_TOPI = 1618 * MiB, WS_GATE = 1619 * MiB, WS_POS = 1620 * MiB, WS_END = 1622 * MiB;
constexpr size_t LAB_STRIDE = (size_t)MT * 256;
constexpr int CW_BAR = 4096;
constexpr int CW_NTILES = 64;

constexpr int RING_OFF = 0, RING_BYTES = 131072, MOETAB_OFF = 131072, LDSCTL_OFF = 155648, LDS_BYTES = 156160;

#define GAS __attribute__((address_space(1)))
#define LAS __attribute__((address_space(3)))
typedef unsigned short bf16;
typedef unsigned v4u __attribute__((ext_vector_type(4)));
typedef unsigned v2u __attribute__((ext_vector_type(2)));
typedef float f32x4 __attribute__((ext_vector_type(4)));
#define LDS_WAIT() asm volatile("s_waitcnt lgkmcnt(0)" ::: "memory")
#define VM_WAIT() asm volatile("s_waitcnt vmcnt(0)" ::: "memory")
__device__ __forceinline__ unsigned f2bf(float f) { unsigned u = __builtin_bit_cast(unsigned, f); return (u + 0x7fffu + ((u >> 16) & 1u)) >> 16; }
__device__ __forceinline__ unsigned pk2(float lo, float hi) { return f2bf(lo) | (f2bf(hi) << 16); }
__device__ __forceinline__ float bf2f(unsigned short b) { return __builtin_bit_cast(float, (unsigned)b << 16); }
__device__ __forceinline__ float bflo(unsigned w) { return __builtin_bit_cast(float, w << 16); }
__device__ __forceinline__ float bfhi(unsigned w) { return __builtin_bit_cast(float, w & 0xffff0000u); }
__device__ __forceinline__ float wave_sum(float v) {
#pragma unroll
    for (int o = 1; o < 64; o <<= 1) v += __shfl_xor(v, o);
    return v;
}
__device__ __forceinline__ float sigmoidf_(float x) { return 1.0f / (1.0f + __expf(-x)); }
__device__ __forceinline__ void sincos_d(double x, double& s, double& c) {
    const double kd = __builtin_rint(x * 0.63661977236758134308);
    const int k = (int)kd;
    double r = __builtin_fma(-kd, 1.57079632673412561417e+00, x);
    r = __builtin_fma(-kd, 6.07710050650619224932e-11, r);
    const double z = r * r;
    const double ps = r + r * z * (-1.66666666666666324348e-01 + z * (8.33333333332248946124e-03 + z * (-1.98412698298579493134e-04 + z * (2.75573137070700676789e-06 + z * (-2.50507602534068634195e-08 + z * 1.58969099521155010221e-10)))));
    const double pc = 1.0 - 0.5 * z + z * z * (4.16666666666666019037e-02 + z * (-1.38888888888741095749e-03 + z * (2.48015872894767294178e-05 + z * (-2.75573143513906633035e-07 + z * (2.08757232129817482790e-09 + z * -1.13596475577881948265e-11)))));
    const int q = k & 3;
    s = (q == 0) ? ps : (q == 1) ? pc : (q == 2) ? -ps : -pc;
    c = (q == 0) ? pc : (q == 1) ? -ps : (q == 2) ? -pc : ps;
}
__device__ __forceinline__ float gelu_tanh(float x) {
    const float u = 0.7978845608028654f * (x + 0.044715f * x * x * x);
    const float t = 1.0f - 2.0f / (1.0f + __expf(2.0f * u));
    return 0.5f * x * (1.0f + t);
}
__device__ __forceinline__ int lds_add(LAS int* p, int v) { return __hip_atomic_fetch_add(p, v, __ATOMIC_RELAXED, __HIP_MEMORY_SCOPE_WORKGROUP); }

#define FFT_FN __device__ __forceinline__
typedef float f32x2v __attribute__((ext_vector_type(2)));
#define FFT_VEC2 f32x2v
#define FFT_DPTR LAS f32x2v*
#define FFT_LD(D, i) c32_from((D)[i])
#define FFT_ST(D, i, v) ((D)[i] = c32_to(v))
struct __attribute__((aligned(8))) c32 { float x, y; };
FFT_FN c32 cmul(c32 a, c32 b) { c32 r; r.x = a.x * b.x - a.y * b.y; r.y = a.x * b.y + a.y * b.x; return r; }
FFT_FN c32 cadd(c32 a, c32 b) { c32 r; r.x = a.x + b.x; r.y = a.y + b.y; return r; }
FFT_FN c32 csub(c32 a, c32 b) { c32 r; r.x = a.x - b.x; r.y = a.y - b.y; return r; }
FFT_FN c32 cmuli_neg(c32 a) { c32 r; r.x = a.y; r.y = -a.x; return r; }
FFT_FN int fpad(int a) { return a + (a >> 4); }
#ifdef FFT_VEC2
FFT_FN c32 c32_from(FFT_VEC2 t) { c32 r; r.x = t.x; r.y = t.y; return r; }
FFT_FN FFT_VEC2 c32_to(c32 a) { FFT_VEC2 t; t.x = a.x; t.y = a.y; return t; }
#endif
FFT_FN void dft4(c32& a0, c32& a1, c32& a2, c32& a3) {
    const c32 s02 = cadd(a0, a2), d02 = csub(a0, a2), s13 = cadd(a1, a3), d13 = cmuli_neg(csub(a1, a3));
    a0 = cadd(s02, s13); a2 = csub(s02, s13); a1 = cadd(d02, d13); a3 = csub(d02, d13);
}
FFT_FN void dft16(c32 (&v)[16]) {
    const float C1 = 0.92387953251128674f, S1 = 0.38268343236508977f, C2 = 0.70710678118654752f;
#pragma unroll
    for (int q2 = 0; q2 < 4; ++q2) dft4(v[q2], v[4 + q2], v[8 + q2], v[12 + q2]);
    { c32 w;
      w.x = C1; w.y = -S1; v[4 * 1 + 1] = cmul(v[4 * 1 + 1], w);
      w.x = C2; w.y = -C2; v[4 * 2 + 1] = cmul(v[4 * 2 + 1], w);
      w.x = S1; w.y = -C1; v[4 * 3 + 1] = cmul(v[4 * 3 + 1], w);
      w.x = C2; w.y = -C2; v[4 * 1 + 2] = cmul(v[4 * 1 + 2], w);
      v[4 * 2 + 2] = cmuli_neg(v[4 * 2 + 2]);
      w.x = -C2; w.y = -C2; v[4 * 3 + 2] = cmul(v[4 * 3 + 2], w);
      w.x = S1; w.y = -C1; v[4 * 1 + 3] = cmul(v[4 * 1 + 3], w);
      w.x = -C2; w.y = -C2; v[4 * 2 + 3] = cmul(v[4 * 2 + 3], w);
      w.x = -C1; w.y = S1; v[4 * 3 + 3] = cmul(v[4 * 3 + 3], w); }
#pragma unroll
    for (int p1 = 0; p1 < 4; ++p1) dft4(v[4 * p1 + 0], v[4 * p1 + 1], v[4 * p1 + 2], v[4 * p1 + 3]);
#pragma unroll
    for (int a = 0; a < 4; ++a)
#pragma unroll
        for (int b = a + 1; b < 4; ++b) { const c32 t = v[4 * a + b]; v[4 * a + b] = v[4 * b + a]; v[4 * b + a] = t; }
}
FFT_FN c32 twid(int j, int n) { double s, c; sincos_d(-6.283185307179586476925 * (double)j / (double)n, s, c); c32 w; w.x = (float)c; w.y = (float)s; return w; }

FFT_FN void fft_fwd16(FFT_DPTR D, int g, int n) {
    const int s = n >> 4, blk = g / s, j = g - blk * s, base = blk * n + j;
    c32 v[16];
#pragma unroll
    for (int q = 0; q < 16; ++q) v[q] = FFT_LD(D, fpad(base + q * s));
    dft16(v);
    const c32 w = twid(j, n); c32 wp = w;
#pragma unroll
    for (int p = 1; p < 16; ++p) { v[p] = cmul(v[p], wp); wp = cmul(wp, w); }
#pragma unroll
    for (int p = 0; p < 16; ++p) FFT_ST(D, fpad(base + p * s), v[p]);
}
FFT_FN void fft_inv16(FFT_DPTR D, int g, int n) {
    const int s = n >> 4, blk = g / s, j = g - blk * s, base = blk * n + j;
    c32 v[16];
#pragma unroll
    for (int q = 0; q < 16; ++q) v[q] = FFT_LD(D, fpad(base + q * s));
    const c32 w = twid(j, n); c32 wp = w;
#pragma unroll
    for (int p = 1; p < 16; ++p) { v[p] = cmul(v[p], wp); wp = cmul(wp, w); }
    dft16(v);
#pragma unroll
    for (int p = 0; p < 16; ++p) FFT_ST(D, fpad(base + p * s), v[p]);
}
FFT_FN void fft_mid16(FFT_DPTR D, int g, const c32* KH) {
    c32 v[16];
#pragma unroll
    for (int q = 0; q < 16; ++q) v[q] = FFT_LD(D, 17 * g + q);
    dft16(v);
#pragma unroll
    for (int p = 0; p < 16; ++p) { const c32 k = KH[16 * g + p]; const c32 t = cmul(v[p], k); v[p].x = t.x; v[p].y = -t.y; }
    dft16(v);
#pragma unroll
    for (int p = 0; p < 16; ++p) FFT_ST(D, 17 * g + p, v[p]);
}
FFT_FN void fft_last16_out(FFT_DPTR D, int g, c32* OUT, float scale) {
    c32 v[16];
#pragma unroll
    for (int q = 0; q < 16; ++q) v[q] = FFT_LD(D, 17 * g + q);
    dft16(v);
#pragma unroll
    for (int p = 0; p < 16; ++p) { c32 t; t.x = v[p].x * scale; t.y = v[p].y * scale; OUT[16 * g + p] = t; }
}
FFT_FN void fft_first4(FFT_DPTR D, int j, c32 x0, c32 x1, c32 x2, c32 x3) {
    dft4(x0, x1, x2, x3);
    const c32 w = twid(j, 16384), w2 = cmul(w, w), w3 = cmul(w2, w);
    FFT_ST(D, fpad(j), x0); FFT_ST(D, fpad(j + 4096), cmul(x1, w)); FFT_ST(D, fpad(j + 8192), cmul(x2, w2)); FFT_ST(D, fpad(j + 12288), cmul(x3, w3));
}
FFT_FN void fft_final4(FFT_DPTR D, int j, c32& u0, c32& u1) {
    const c32 w = twid(j, 16384), w2 = cmul(w, w), w3 = cmul(w2, w);
    c32 a0 = FFT_LD(D, fpad(j)), a1 = cmul(FFT_LD(D, fpad(j + 4096)), w), a2 = cmul(FFT_LD(D, fpad(j + 8192)), w2), a3 = cmul(FFT_LD(D, fpad(j + 12288)), w3);
    dft4(a0, a1, a2, a3);
    u0 = a0; u1 = a1;
}
#define XB_TMO      128
#define XB_XCNT(j)  (256  + 64 * (j))
#define XB_XSUB(j)  (1280 + 64 * (j))
#define XB_XGEN(j)  (2304 + 64 * (j))
#define XB_TOP      3328
#define XB_TOPGEN   3392
#define XCD_BAR_WORDS 3456
#define XB_SPIN_CAP (1u << 22)

__device__ __forceinline__ unsigned xb_ld(unsigned* p)              { return __hip_atomic_load(p, __ATOMIC_RELAXED, __HIP_MEMORY_SCOPE_AGENT); }
__device__ __forceinline__ unsigned xb_add(unsigned* p, unsigned v) { return __hip_atomic_fetch_add(p, v, __ATOMIC_RELAXED, __HIP_MEMORY_SCOPE_AGENT); }
__device__ __forceinline__ unsigned xb_xcc_id() { return (unsigned)__builtin_amdgcn_s_getreg((3 << 11) | 20) & 0xFu; }
#define XB_SPIN(cond, bar) do { unsigned _sp = 0; while (cond) { __builtin_amdgcn_s_sleep(1); \
    if ((++_sp & 255u) == 0u) { if (xb_ld(&(bar)[XB_TMO])) break; if (_sp > XB_SPIN_CAP) { atomicAdd(&(bar)[XB_TMO], 1u); break; } } } } while (0)

struct XcdBarrier {
    unsigned* bar; unsigned x;
    volatile LAS unsigned* st;
};

__device__ __forceinline__ XcdBarrier xcd_barrier_post(unsigned* bar, volatile LAS unsigned* st) {
    XcdBarrier b; b.bar = bar; b.x = xb_xcc_id(); b.st = st;
    if (threadIdx.x == 0) (void)xb_add(&bar[XB_XCNT(b.x)], 1u);
    return b;
}
__device__ __forceinline__ void xcd_barrier_complete(unsigned* bar, unsigned x, unsigned& nloc, unsigned& nx) {
    const unsigned G = gridDim.x * gridDim.y * gridDim.z;
    unsigned sum, cnt, mine, sp = 0u;
    for (;;) {
        sum = 0u; cnt = 0u; mine = 0u;
#pragma unroll
        for (unsigned j = 0; j < 16; ++j) { const unsigned c = xb_ld(&bar[XB_XCNT(j)]); sum += c; cnt += (c > 0u) ? 1u : 0u; mine = (j == x) ? c : mine; }
        if (sum == G) break;
        __builtin_amdgcn_s_sleep(1);
        if ((++sp & 255u) == 0u) { if (xb_ld(&bar[XB_TMO])) break; if (sp > XB_SPIN_CAP) { atomicAdd(&bar[XB_TMO], 1u); break; } }
    }
    nloc = mine > 0u ? mine : 1u; nx = cnt > 0u ? cnt : 1u;
}

__device__ __forceinline__ void xcd_barrier(const XcdBarrier& b) {
    asm volatile("s_waitcnt vmcnt(0)" ::: "memory");
    __syncthreads();
    if (threadIdx.x == 0) {
        unsigned* bar = b.bar;
        __builtin_amdgcn_s_waitcnt(0);
        unsigned nloc = b.st[0], nx = b.st[1];
        if (nloc == 0u) { xcd_barrier_complete(bar, b.x, nloc, nx); b.st[0] = nloc; b.st[1] = nx; }
        const unsigned old = xb_add(&bar[XB_XSUB(b.x)], 1u);
        const unsigned gen = old / nloc;
        if (old + 1u == (gen + 1u) * nloc) {
            __builtin_amdgcn_fence(__ATOMIC_RELEASE, "agent");
            asm volatile("s_waitcnt vmcnt(0)" ::: "memory");
            const unsigned og = xb_add(&bar[XB_TOP], 1u);
            const unsigned tg = og / nx;
            if (og + 1u == (tg + 1u) * nx) xb_add(&bar[XB_TOPGEN], 1u);
            else XB_SPIN(xb_ld(&bar[XB_TOPGEN]) == tg, bar);
            __builtin_amdgcn_fence(__ATOMIC_ACQUIRE, "agent");
            xb_add(&bar[XB_XGEN(b.x)], 1u);
            asm volatile("s_waitcnt vmcnt(0)" ::: "memory");
        } else {
            XB_SPIN(xb_ld(&bar[XB_XGEN(b.x)]) == gen, bar);
            __builtin_amdgcn_fence(__ATOMIC_ACQUIRE, "agent");
            asm volatile("s_waitcnt vmcnt(0)" ::: "memory");
        }
    }
    __syncthreads();
}


struct Frame {
    LAS unsigned char* lds; unsigned* ctl; unsigned char* ws;
    int tid, lane, wave, vcu, G, gw, ngw;
};
__device__ const float ROPE_INV[16] = {1.0f, 0.5623413251903491f, 0.31622776601683794f, 0.1778279410038923f, 0.1f, 0.05623413251903491f, 0.03162277660168379f, 0.01778279410038923f,
                                       0.01f, 0.005623413251903491f, 0.0031622776601683794f, 0.001778279410038923f, 0.001f, 0.0005623413251903491f, 0.00031622776601683794f, 0.0001778279410038923f};

__device__ __forceinline__ void p0_transpose_item(const float* W, int K, int N, bf16* WT, LAS float* scr, int item, int lane) {
    const int nblk = N / 32, kb = item / nblk, nb = item % nblk, k0 = 64 * kb, n0 = 32 * nb;
#pragma unroll 8
    for (int i = 0; i < 32; ++i) { const int kk = 2 * i + (lane >> 5); scr[kk * 33 + (lane & 31)] = W[(size_t)(k0 + kk) * N + n0 + (lane & 31)]; }
    LDS_WAIT(); asm volatile("" ::: "memory");
    const int c = lane & 7;
#pragma unroll
    for (int j = 0; j < 4; ++j) { const int n = (lane >> 3) + 8 * j; const LAS float* s = scr + (8 * c) * 33 + n;
        v4u o; o.x = pk2(s[0 * 33], s[1 * 33]); o.y = pk2(s[2 * 33], s[3 * 33]); o.z = pk2(s[4 * 33], s[5 * 33]); o.w = pk2(s[6 * 33], s[7 * 33]);
        *(GAS v4u*)(WT + (size_t)(n0 + n) * K + k0 + 8 * c) = o; }
    LDS_WAIT(); asm volatile("" ::: "memory");
}

__device__ __forceinline__ void ph_prologue_a(const Frame& F, const float* c, const float* cctx, const float* w_mod, const float* b_mod, const float* w_in, const float* w_out,
                                              const float* moe_w1, const float* moe_w2, const float* hy_w1, const float* hy_b1, const float* hy_w2, const float* hy_b2, const float* hy_freq) {
    {
        LAS float* scr = (LAS float*)(F.lds + F.wave * 16384);
        constexpr int I_IN = 2 * 1024, I_OUT = 2 * 512, I_W1 = 64 * 1024, I_W2 = 64 * 512, NIT = I_IN + I_OUT + I_W1 + I_W2;
        bf16* WinT = (bf16*)(F.ws + WS_WINT); bf16* WoutT = (bf16*)(F.ws + WS_WOUTT); bf16* W1T = (bf16*)(F.ws + WS_W1T); bf16* W2T = (bf16*)(F.ws + WS_W2T);
        for (int it = F.gw; it < NIT; it += F.ngw) {
            int r = it;
            if (r < I_IN) { const int m = r >> 10; p0_transpose_item(w_in + (size_t)m * 1024 * 2048, 1024, 2048, WinT + (size_t)m * 2048 * 1024, scr, r & 1023, F.lane); continue; } r -= I_IN;
            if (r < I_OUT) { const int m = r >> 9; p0_transpose_item(w_out + (size_t)m * 1024 * 1024, 1024, 1024, WoutT + (size_t)m * 1024 * 1024, scr, r & 511, F.lane); continue; } r -= I_OUT;
            if (r < I_W1) { const int m = r >> 10; p0_transpose_item(moe_w1 + (size_t)m * 1024 * 2048, 1024, 2048, W1T + (size_t)m * 2048 * 1024, scr, r & 1023, F.lane); continue; } r -= I_W1;
            { const int m = r >> 9; p0_transpose_item(moe_w2 + (size_t)m * 1024 * 1024, 1024, 1024, W2T + (size_t)m * 1024 * 1024, scr, r & 511, F.lane); }
        }
    }
    __syncthreads();
    {
        LAS float* sl = (LAS float*)(F.lds);
        LAS float* red = (LAS float*)(F.lds + 20480);
        float* MOD = (float*)(F.ws + WS_MOD);
        if ((int)blockIdx.x < 192) {
            for (int i = F.tid; i < 5 * 1024; i += NTHR) { const int r = i >> 10, k = i & 1023; const float v = (r < 4) ? c[r * 1024 + k] : cctx[k]; sl[i] = v / (1.0f + __expf(-v)); }
        }
        __syncthreads();
        for (int it = blockIdx.x; it < 192; it += F.G) {
            const int l = it / 96, n = (it % 96) * 64 + F.lane;
            float a0 = 0.f, a1 = 0.f, a2 = 0.f, a3 = 0.f, a4 = 0.f;
            const float* wp = w_mod + ((size_t)l * 1024 + F.wave * 128) * 6144 + n;
#pragma unroll 8
            for (int k = 0; k < 128; ++k) { const float w = wp[(size_t)k * 6144]; const int kk = F.wave * 128 + k;
                a0 += sl[kk] * w; a1 += sl[1024 + kk] * w; a2 += sl[2048 + kk] * w; a3 += sl[3072 + kk] * w; a4 += sl[4096 + kk] * w; }
            red[(F.wave * 5 + 0) * 64 + F.lane] = a0; red[(F.wave * 5 + 1) * 64 + F.lane] = a1; red[(F.wave * 5 + 2) * 64 + F.lane] = a2; red[(F.wave * 5 + 3) * 64 + F.lane] = a3; red[(F.wave * 5 + 4) * 64 + F.lane] = a4;
            __syncthreads();
            if (F.tid < 320) { const int r = F.tid >> 6, ln = F.tid & 63; float s = 0.f;
#pragma unroll
                for (int w = 0; w < 8; ++w) s += red[(w * 5 + r) * 64 + ln];
                const int nn = (it % 96) * 64 + ln; MOD[(size_t)(l * 5 + r) * 6144 + nn] = s + b_mod[l * 6144 + nn]; }
            __syncthreads();
        }
    }
    {
        float* RC = (float*)(F.ws + WS_ROPEC); float* RS = (float*)(F.ws + WS_ROPES);
        for (int idx = blockIdx.x * NTHR + F.tid; idx < SEQ * 32; idx += F.G * NTHR) {
            const int t = idx >> 5, i = idx & 31; const int pos = (i < 16) ? (t >> 6) : (t & 63);
            const float ang = (float)pos * ROPE_INV[i & 15];
            double s, cc; sincos_d((double)ang, s, cc); RC[idx] = (float)cc; RS[idx] = (float)s; }
    }
    {
        float* H2 = (float*)(F.ws + WS_H2);
        for (int it = F.gw; it < 2 * SEQ + CTXL; it += F.ngw) {
            const int v = it >> 13, t = (v < 2) ? (it & (SEQ - 1)) : (it - 2 * SEQ), L = (v < 2) ? SEQ : CTXL, l = (v == 1) ? 1 : 0;
            const int j = F.lane;
            float z = 0.f;
            if (j == 0) z = (float)t / (float)(L - 1);
            else if (j <= 32) { const int b = (j - 1) & 15; const float band = 1e-4f + (float)b * ((15.0f - 1e-4f) / 15.0f);
                const float ang = ((6.283185307179586f / (float)L) * (float)t) * band;
                double s, cc; sincos_d((double)ang, s, cc); z = (j <= 16) ? (float)cc : -(float)s; }
            const float fr = hy_freq[l * 64 + j];
            float p1 = hy_b1[l * 64 + j];
            const float* w1 = hy_w1 + (size_t)l * 33 * 64;
#pragma unroll
            for (int i = 0; i < 33; ++i) p1 += __shfl(z, i) * w1[i * 64 + j];
            double s1, c1; sincos_d((double)(fr * p1), s1, c1); const float h1 = (float)s1;
            float p2 = hy_b2[l * 64 + j];
            const float* w2 = hy_w2 + (size_t)l * 64 * 64;
#pragma unroll 16
            for (int i = 0; i < 64; ++i) p2 += __shfl(h1, i) * w2[i * 64 + j];
            double s2, c2; sincos_d((double)(fr * p2), s2, c2);
            H2[((size_t)v * SEQ + t) * 64 + j] = (float)s2;
        }
    }
}

__device__ __forceinline__ void ph_prologue_b(const Frame& F, const float* hy_w3, const float* hy_decay) {
    LAS float* kt = (LAS float*)(F.lds);
    LAS float* w3c = (LAS float*)(F.lds + 65536);
    LAS float* red = (LAS float*)(F.lds + 65536 + 512);
    const float* H2 = (const float*)(F.ws + WS_H2);
    float* KF = (float*)(F.ws + WS_KF); float* KFC = (float*)(F.ws + WS_KFC);
    for (int it = blockIdx.x; it < 768; it += F.G) {
        const int v = it >> 8, c = it & 255, L = (v < 2) ? SEQ : CTXL, l = (v == 1) ? 1 : 0;
        if (F.tid < 128) w3c[F.tid] = hy_w3[(size_t)l * 64 * 512 + (F.tid & 63) * 512 + (F.tid >> 6) * 256 + c];
        if (F.tid == 0) kt[L] = 0.f;
        __syncthreads();
        const float df = fabsf(hy_decay[l * 512 + c]), db = fabsf(hy_decay[l * 512 + 256 + c]);
        float asum = 0.f;
        for (int t = F.tid; t < L; t += NTHR) {
            const f32x4* row = (const f32x4*)(H2 + ((size_t)v * SEQ + t) * 64);
            float hf = 0.f, hb = 0.f;
#pragma unroll
            for (int q = 0; q < 16; ++q) { const f32x4 h = row[q];
                hf += h.x * w3c[4 * q] + h.y * w3c[4 * q + 1] + h.z * w3c[4 * q + 2] + h.w * w3c[4 * q + 3];
                hb += h.x * w3c[64 + 4 * q] + h.y * w3c[64 + 4 * q + 1] + h.z * w3c[64 + 4 * q + 2] + h.w * w3c[64 + 4 * q + 3]; }
            const float t01 = (float)t / (float)(L - 1);
            hf *= expf(-t01 * df); hb *= expf(-t01 * db);
            kt[t] = hf; asum += fabsf(hf);
            if (t >= 1) { kt[2 * L - t] = hb; asum += fabsf(hb); }
        }
        asum = wave_sum(asum);
        if (F.lane == 0) red[F.wave] = asum;
        __syncthreads();
        float tot = 0.f;
#pragma unroll
        for (int w = 0; w < 8; ++w) tot += red[w];
        const float inv = 1.0f / tot;
        float* dst = (v < 2) ? (KF + (size_t)(v * 256 + c) * 16384) : (KFC + (size_t)c * 512);
        for (int j = F.tid; j < 2 * L; j += NTHR) dst[j] = kt[j] * inv;
        __syncthreads();
    }
}

__device__ __forceinline__ void ph_norm_mod(const Frame& F, int l, const float* x, const float* ctx, const float* gmix) {
    const float* XR = (const float*)(F.ws + WS_XR); const float* MOD = (const float*)(F.ws + WS_MOD); bf16* H = (bf16*)(F.ws + WS_H);
    for (int r = F.gw; r < MT; r += F.ngw) {
        const float* src = (l == 0) ? (r < NLAT ? x + (size_t)r * 1024 : ctx + (size_t)(r - NLAT) * 1024) : XR + (size_t)r * 1024;
        const int bidx = r < NLAT ? r / SEQ : 4;
        const float* shift = MOD + (size_t)(l * 5 + bidx) * 6144; const float* scale = shift + 1024; const float* g = gmix + l * 1024;
        f32x4 v[4]; float ss = 0.f;
#pragma unroll
        for (int j = 0; j < 4; ++j) { v[j] = ((const f32x4*)src)[64 * j + F.lane]; ss += (v[j].x * v[j].x + v[j].y * v[j].y) + (v[j].z * v[j].z + v[j].w * v[j].w); }
        const float rstd = 1.0f / sqrtf(wave_sum(ss) * (1.0f / 1024.0f) + EPSN);
#pragma unroll
        for (int j = 0; j < 4; ++j) { const int cb = 64 * j + F.lane; const f32x4 gg = ((const f32x4*)g)[cb], sc = ((const f32x4*)scale)[cb], sh = ((const f32x4*)shift)[cb];
            const f32x4 y = v[j] * rstd * gg * (sc + 1.0f) + sh;
            v2u o; o.x = pk2(y.x, y.y); o.y = pk2(y.z, y.w); ((v2u*)(H + (size_t)r * 1024))[cb] = o; }
    }
}

__device__ __forceinline__ void ph_post_proj(const Frame& F, int l, const float* qg_, const float* kg_, const float* lru_cw, const float* lru_cb, const float* lru_gw, const float* lru_gb,
                                             const float* lru_lam, const float* hy_cw, const float* hy_cb) {
    const bf16* U = (const bf16*)(F.ws + WS_U);
    {
        bf16* Q = (bf16*)(F.ws + WS_Q); bf16* K = (bf16*)(F.ws + WS_K); bf16* V = (bf16*)(F.ws + WS_V);
        const float* RC = (const float*)(F.ws + WS_ROPEC); const float* RS = (const float*)(F.ws + WS_ROPES);
        const float qg = qg_[l * 64 + F.lane], kg = kg_[l * 64 + F.lane];
        const float C2 = 0.125f * 1.4426950408889634f;
        for (int r = F.gw; r < MT; r += F.ngw) {
            const bool isctx = r >= NLAT; const int b = isctx ? (r - NLAT) / CTXL : r / SEQ; const int t = isctx ? (r - NLAT) % CTXL : r % SEQ;
            const bf16* ur = U + (size_t)r * INW;
            float cs = 1.f, sn = 0.f;
            if (!isctx) { cs = RC[t * 32 + (F.lane & 31)]; sn = RS[t * 32 + (F.lane & 31)]; }
            const size_t krow = (size_t)b * KEYS + (isctx ? t : CTXL + t);
#pragma unroll
            for (int hd = 0; hd < 10; ++hd) {
                const float v = bf2f(ur[hd * 64 + F.lane]);
                const float ss = wave_sum(v * v);
                float y = v * (1.0f / sqrtf(ss * (1.0f / 64.0f) + EPSN)) * (hd < 8 ? qg : kg);
                const float p = __shfl_xor(y, 32);
                if (!isctx) y = (F.lane < 32) ? (y * cs - p * sn) : (y * cs + p * sn);
                if (hd < 8) Q[(size_t)r * 512 + hd * 64 + F.lane] = (bf16)f2bf(y * C2);
                else K[krow * 128 + (hd - 8) * 64 + F.lane] = (bf16)f2bf(y);
            }
            V[krow * 128 + F.lane] = ur[640 + F.lane]; V[krow * 128 + 64 + F.lane] = ur[704 + F.lane];
        }
    }
    __syncthreads();
    {
        LAS float* lxs = (LAS float*)(F.lds);
        LAS float* xls = (LAS float*)(F.lds + 36864);
        float* LAB = (float*)(F.ws + WS_LAB);
        const int ch = F.tid & 255, half = F.tid >> 8, n = ch >> 6, e = ch & 63;
        const float cw0 = lru_cw[(l * 4 + 0) * 256 + ch], cw1 = lru_cw[(l * 4 + 1) * 256 + ch], cw2 = lru_cw[(l * 4 + 2) * 256 + ch], cw3 = lru_cw[(l * 4 + 3) * 256 + ch], cb = lru_cb[l * 256 + ch];
        for (int it = blockIdx.x; it < MT / 32; it += F.G) {
            const int r0 = it * 32; const bool isctx = r0 >= NLAT; const int Ls = isctx ? CTXL : SEQ;
            const int t0 = isctx ? (r0 - NLAT) % CTXL : r0 % SEQ; const int rbase = r0 - t0;
            for (int i = F.tid; i < 36 * 256; i += NTHR) { const int rr = i >> 8, cc = i & 255; const int t = t0 - 2 + rr;
                lxs[i] = (t >= 0 && t < Ls) ? bf2f(U[(size_t)(rbase + t) * INW + 768 + cc]) : 0.f; }
            __syncthreads();
            for (int i = F.tid; i < 32 * 256; i += NTHR) { const int tt = i >> 8;
                xls[i] = cw0 * lxs[i] + cw1 * lxs[i + 256] + cw2 * lxs[i + 512] + cw3 * lxs[i + 768] + cb; (void)tt; }
            __syncthreads();
#pragma unroll 1
            for (int d = 0; d < 2; ++d) {
                float aR[16], aI[16];
#pragma unroll
                for (int q = 0; q < 16; ++q) { aR[q] = 0.f; aI[q] = 0.f; }
                const float* wR = lru_gw + ((size_t)(((l * 2 + d) * 2 + 0) * 4 + n) * 64) * 64 + e;
                const float* wI = lru_gw + ((size_t)(((l * 2 + d) * 2 + 1) * 4 + n) * 64) * 64 + e;
#pragma unroll 2
                for (int d4 = 0; d4 < 16; ++d4) {
                    const float r0w = wR[(d4 * 4 + 0) * 64], r1w = wR[(d4 * 4 + 1) * 64], r2w = wR[(d4 * 4 + 2) * 64], r3w = wR[(d4 * 4 + 3) * 64];
                    const float i0w = wI[(d4 * 4 + 0) * 64], i1w = wI[(d4 * 4 + 1) * 64], i2w = wI[(d4 * 4 + 2) * 64], i3w = wI[(d4 * 4 + 3) * 64];
#pragma unroll
                    for (int q = 0; q < 16; ++q) { const f32x4 xv = *(const LAS f32x4*)(xls + (half * 16 + q) * 256 + n * 64 + d4 * 4);
                        aR[q] += xv.x * r0w + xv.y * r1w + xv.z * r2w + xv.w * r3w; aI[q] += xv.x * i0w + xv.y * i1w + xv.z * i2w + xv.w * i3w; }
                }
                const float bR = lru_gb[((l * 2 + d) * 2 + 0) * 256 + ch], bI = lru_gb[((l * 2 + d) * 2 + 1) * 256 + ch];
                const float lam = lru_lam[(l * 2 + d) * 256 + ch]; const float sp = log1pf(expf(-lam));
                float* LA = LAB + (size_t)(2 * d) * LAB_STRIDE; float* LB = LAB + (size_t)(2 * d + 1) * LAB_STRIDE;
#pragma unroll
                for (int q = 0; q < 16; ++q) { const int tt = half * 16 + q;
                    const float rg = sigmoidf_(aR[q] + bR), ig = sigmoidf_(aI[q] + bI);
                    const float log_a = -8.0f * rg * sp; const float a = expf(log_a);
                    const float bx = sqrtf(fmaxf(-expm1f(2.0f * log_a), 0.f)) * (ig * xls[tt * 256 + ch]);
                    LA[(size_t)(r0 + tt) * 256 + ch] = a; LB[(size_t)(r0 + tt) * 256 + ch] = bx; }
            }
            __syncthreads();
        }
    }
    {
        LAS bf16* hs = (LAS bf16*)(F.lds);
        float* VT = (float*)(F.ws + WS_VT); float* X0T = (float*)(F.ws + WS_X0T);
        const float* cw = hy_cw + (size_t)l * 3 * 768; const float* cbp = hy_cb + l * 768;
        for (int it = blockIdx.x; it < NLAT / 64; it += F.G) {
            const int b = it >> 7, t0 = (it & 127) * 64;
            for (int i = F.tid; i < 66 * 384; i += NTHR) { const int rr = i / 384, c2 = i - rr * 384; const int t = t0 - 1 + rr;
                unsigned w = 0u; if (t >= 0 && t < SEQ) w = *(const unsigned*)(U + (size_t)(b * SEQ + t) * INW + 1280 + 2 * c2);
                *(LAS unsigned*)(hs + rr * 770 + 2 * c2) = w; }
            __syncthreads();
            for (int c = F.wave; c < 256; c += NWAVES) {
                const int tt = F.lane;
                float o[3];
#pragma unroll
                for (int g = 0; g < 3; ++g) { const int cc = g * 256 + c;
                    o[g] = cw[cc] * bf2f(hs[tt * 770 + cc]) + cw[768 + cc] * bf2f(hs[(tt + 1) * 770 + cc]) + cw[1536 + cc] * bf2f(hs[(tt + 2) * 770 + cc]) + cbp[cc]; }
                const size_t oi = ((size_t)b * 256 + c) * SEQ + t0 + tt;
                VT[oi] = o[2] * o[1]; X0T[oi] = o[0];
            }
            __syncthreads();
        }
    }
}

__device__ __forceinline__ void ph_ctx_attn(const Frame& F) {
    const bf16* Q = (const bf16*)(F.ws + WS_Q); const bf16* K = (const bf16*)(F.ws + WS_K); const bf16* V = (const bf16*)(F.ws + WS_V); bf16* O = (bf16*)(F.ws + WS_ATT);
    LAS float* qs = (LAS float*)(F.lds + 90112 + F.wave * 1280);
    LAS float* ps = qs + 64;
    for (int it = F.gw; it < NCTX * 8; it += F.ngw) {
        const int rc = it >> 3, h = it & 7, b = rc / CTXL, kvh = h >> 2; const int r = NLAT + rc;
        qs[F.lane] = bf2f(Q[(size_t)r * 512 + h * 64 + F.lane]);
        LDS_WAIT();
        float sc[4]; float mx = -INFINITY;
#pragma unroll
        for (int i = 0; i < 4; ++i) { const int key = F.lane + 64 * i; const v4u* kp = (const v4u*)(K + ((size_t)b * KEYS + key) * 128 + kvh * 64);
            float s = 0.f;
#pragma unroll
            for (int q = 0; q < 8; ++q) { const v4u w = kp[q];
                s += qs[8 * q] * bflo(w.x) + qs[8 * q + 1] * bfhi(w.x) + qs[8 * q + 2] * bflo(w.y) + qs[8 * q + 3] * bfhi(w.y) + qs[8 * q + 4] * bflo(w.z) + qs[8 * q + 5] * bfhi(w.z) + qs[8 * q + 6] * bflo(w.w) + qs[8 * q + 7] * bfhi(w.w); }
            sc[i] = s; mx = fmaxf(mx, s); }
#pragma unroll
        for (int o = 1; o < 64; o <<= 1) mx = fmaxf(mx, __shfl_xor(mx, o));
        float sum = 0.f;
#pragma unroll
        for (int i = 0; i < 4; ++i) { const float p = exp2f(sc[i] - mx); sum += p; ps[F.lane + 64 * i] = p; }
        sum = wave_sum(sum);
        LDS_WAIT();
        float acc = 0.f;
        const bf16* vp = V + (size_t)b * KEYS * 128 + kvh * 64 + F.lane;
#pragma unroll 8
        for (int key = 0; key < CTXL; ++key) acc += ps[key] * bf2f(vp[(size_t)key * 128]);
        O[(size_t)r * 512 + h * 64 + F.lane] = (bf16)f2bf(acc / sum);
        LDS_WAIT();
    }
}

__device__ __forceinline__ int chunk_row0(int b, int d, int k) {
    if (k < 2) { const int cc = d ? 1 - k : k; return NLAT + b * CTXL + cc * CHUNK; }
    const int lc = d ? 63 - (k - 2) : (k - 2); return b * SEQ + lc * CHUNK;
}
__device__ __forceinline__ void ph_scan1(const Frame& F) {
    const float* LAB = (const float*)(F.ws + WS_LAB); float* SUMP = (float*)(F.ws + WS_SCANS); float* SUMH = SUMP + NB * 2 * NCHUNK * 256;
    for (int it = blockIdx.x * NTHR + F.tid; it < NB * 2 * NCHUNK * 256; it += F.G * NTHR) {
        const int ch = it & 255, k = (it >> 8) % NCHUNK, bd = (it >> 8) / NCHUNK, d = bd & 1, b = bd >> 1;
        const int r0 = chunk_row0(b, d, k);
        const float* LA = LAB + (size_t)(2 * d) * LAB_STRIDE + ch; const float* LB = LAB + (size_t)(2 * d + 1) * LAB_STRIDE + ch;
        float h = 0.f, P = 1.f;
#pragma unroll 8
        for (int i = 0; i < CHUNK; ++i) { const int r = d ? r0 + CHUNK - 1 - i : r0 + i; const float a = LA[(size_t)r * 256], bx = LB[(size_t)r * 256]; h = a * h + bx; P *= a; }
        SUMP[it] = P; SUMH[it] = h;
    }
}
__device__ __forceinline__ void ph_scan2(const Frame& F) {
    const float* LAB = (const float*)(F.ws + WS_LAB); const float* SUMP = (const float*)(F.ws + WS_SCANS); const float* SUMH = SUMP + NB * 2 * NCHUNK * 256;
    float* LRUO = (float*)(F.ws + WS_LRUO); const bf16* U = (const bf16*)(F.ws + WS_U);
    for (int it = blockIdx.x * NTHR + F.tid; it < NB * NCHUNK * 256; it += F.G * NTHR) {
        const int ch = it & 255, kc = (it >> 8) % NCHUNK, b = (it >> 8) / NCHUNK;
        const int r0 = chunk_row0(b, 0, kc);
#pragma unroll 1
        for (int d = 0; d < 2; ++d) {
            const int k = d ? ((kc < 2) ? 1 - kc : 2 + 63 - (kc - 2)) : kc;
            const size_t sb = (size_t)((b * 2 + d) * NCHUNK) * 256 + ch;
            float h = 0.f;
            for (int j = 0; j < k; ++j) h = SUMP[sb + (size_t)j * 256] * h + SUMH[sb + (size_t)j * 256];
            const float* LA = LAB + (size_t)(2 * d) * LAB_STRIDE + ch; const float* LB = LAB + (size_t)(2 * d + 1) * LAB_STRIDE + ch;
            if (d == 0) {
#pragma unroll 8
                for (int i = 0; i < CHUNK; ++i) { const int r = r0 + i; h = LA[(size_t)r * 256] * h + LB[(size_t)r * 256]; LRUO[(size_t)r * 256 + ch] = h; }
            } else {
#pragma unroll 8
                for (int i = 0; i < CHUNK; ++i) { const int r = r0 + CHUNK - 1 - i; h = LA[(size_t)r * 256] * h + LB[(size_t)r * 256];
                    const float lg = bf2f(U[(size_t)r * INW + 1024 + ch]);
                    LRUO[(size_t)r * 256 + ch] = (LRUO[(size_t)r * 256 + ch] + h) * gelu_tanh(lg); }
            }
        }
    }
}

__device__ __forceinline__ void ph_hyena_direct(const Frame& F, int l, const float* hy_bias, const float* hy_cw, const float* hy_cb) {
    LAS float* ks = (LAS float*)(F.lds);
    LAS float* vs = (LAS float*)(F.lds + 65536);
    const float* KF = (const float*)(F.ws + WS_KF) + (size_t)l * 256 * 16384;
    const float* VT = (const float*)(F.ws + WS_VT); const float* X0T = (const float*)(F.ws + WS_X0T); float* HYO = (float*)(F.ws + WS_HYO);
    for (int it = blockIdx.x; it < 512; it += F.G) {
        const int c = it >> 1, bp = it & 1;
        for (int i = F.tid; i < 4096; i += NTHR) ((LAS f32x4*)ks)[i] = ((const f32x4*)(KF + (size_t)c * 16384))[i];
        for (int i = F.tid; i < 4096; i += NTHR) { const int bb = i >> 11, q = i & 2047; ((LAS f32x4*)vs)[i] = ((const f32x4*)(VT + ((size_t)(bp * 2 + bb) * 256 + c) * SEQ))[q]; }
        __syncthreads();
        float y0[16], y1[16];
#pragma unroll
        for (int i = 0; i < 16; ++i) { y0[i] = 0.f; y1[i] = 0.f; }
#pragma unroll 2
        for (int s = 0; s < SEQ; ++s) {
            const float v0 = vs[s], v1 = vs[SEQ + s];
            const int base = (F.tid - s) & 16383;
#pragma unroll
            for (int i = 0; i < 16; ++i) { const float kk = ks[(base + 512 * i) & 16383]; y0[i] += kk * v0; y1[i] += kk * v1; }
        }
        const float bias = hy_bias[l * 256 + c];
#pragma unroll
        for (int i = 0; i < 16; ++i) { const int t = F.tid + 512 * i;
            { const int b = bp * 2; const size_t oi = ((size_t)b * 256 + c) * SEQ + t; HYO[((size_t)b * SEQ + t) * 256 + c] = (y0[i] + vs[t] * bias) * X0T[oi]; }
            { const int b = bp * 2 + 1; const size_t oi = ((size_t)b * 256 + c) * SEQ + t; HYO[((size_t)b * SEQ + t) * 256 + c] = (y1[i] + vs[SEQ + t] * bias) * X0T[oi]; } }
        __syncthreads();
    }
}
__device__ __forceinline__ void ph_khat(const Frame& F) {
    LAS f32x2v* D = (LAS f32x2v*)(F.lds);
    const float* KF = (const float*)(F.ws + WS_KF); c32* KHAT = (c32*)(F.ws + WS_KHAT);
    for (int it = blockIdx.x; it < 512; it += F.G) {
        const float* k = KF + (size_t)it * 16384; c32* out = KHAT + (size_t)it * 16384;
#pragma unroll 1
        for (int i = 0; i < 8; ++i) { const int j = F.tid + 512 * i; c32 x0, x1, x2, x3; x0.x = k[j]; x1.x = k[j + 4096]; x2.x = k[j + 8192]; x3.x = k[j + 12288]; x0.y = x1.y = x2.y = x3.y = 0.f;
            fft_first4(D, j, x0, x1, x2, x3); }
        __syncthreads();
        _Pragma("unroll 1") for (int g_ = F.tid; g_ < 1024; g_ += 512) fft_fwd16(D, g_, 4096);
        __syncthreads();
        _Pragma("unroll 1") for (int g_ = F.tid; g_ < 1024; g_ += 512) fft_fwd16(D, g_, 256);
        __syncthreads();
        _Pragma("unroll 1") for (int g_ = F.tid; g_ < 1024; g_ += 512) fft_last16_out(D, g_, out, 1.0f / 16384.0f);
        __syncthreads();
    }
}
__device__ __forceinline__ void ph_hyena_fft(const Frame& F, int l, const float* hy_bias) {
    LAS f32x2v* D = (LAS f32x2v*)(F.lds);
    const c32* KHAT = (const c32*)(F.ws + WS_KHAT) + (size_t)l * 256 * 16384;
    const float* VT = (const float*)(F.ws + WS_VT); const float* X0T = (const float*)(F.ws + WS_X0T); float* HYO = (float*)(F.ws + WS_HYO);
    for (int it = blockIdx.x; it < 512; it += F.G) {
        const int c = it >> 1, bp = it & 1;
        const float* va = VT + ((size_t)(bp * 2) * 256 + c) * SEQ; const float* vb = VT + ((size_t)(bp * 2 + 1) * 256 + c) * SEQ;
#pragma unroll 1
        for (int i = 0; i < 8; ++i) { const int j = F.tid + 512 * i; c32 x0, x1, z; x0.x = va[j]; x0.y = vb[j]; x1.x = va[j + 4096]; x1.y = vb[j + 4096]; z.x = 0.f; z.y = 0.f;
            fft_first4(D, j, x0, x1, z, z); }
        __syncthreads();
        _Pragma("unroll 1") for (int g_ = F.tid; g_ < 1024; g_ += 512) fft_fwd16(D, g_, 4096);
        __syncthreads();
        _Pragma("unroll 1") for (int g_ = F.tid; g_ < 1024; g_ += 512) fft_fwd16(D, g_, 256);
        __syncthreads();
        _Pragma("unroll 1") for (int g_ = F.tid; g_ < 1024; g_ += 512) fft_mid16(D, g_, KHAT + (size_t)c * 16384);
        __syncthreads();
        _Pragma("unroll 1") for (int g_ = F.tid; g_ < 1024; g_ += 512) fft_inv16(D, g_, 256);
        __syncthreads();
        _Pragma("unroll 1") for (int g_ = F.tid; g_ < 1024; g_ += 512) fft_inv16(D, g_, 4096);
        __syncthreads();
        const float bias = hy_bias[l * 256 + c];
        const float* xa = X0T + ((size_t)(bp * 2) * 256 + c) * SEQ; const float* xb = X0T + ((size_t)(bp * 2 + 1) * 256 + c) * SEQ;
        float* oa = HYO + ((size_t)(bp * 2) * SEQ) * 256 + c; float* ob = HYO + ((size_t)(bp * 2 + 1) * SEQ) * 256 + c;
#pragma unroll 1
        for (int i = 0; i < 8; ++i) { const int j = F.tid + 512 * i; c32 u0, u1; fft_final4(D, j, u0, u1);
            oa[(size_t)j * 256] = (u0.x + va[j] * bias) * xa[j];                 ob[(size_t)j * 256] = (-u0.y + vb[j] * bias) * xb[j];
            oa[(size_t)(j + 4096) * 256] = (u1.x + va[j + 4096] * bias) * xa[j + 4096]; ob[(size_t)(j + 4096) * 256] = (-u1.y + vb[j + 4096] * bias) * xb[j + 4096]; }
        __syncthreads();
    }
}
__device__ __forceinline__ void ph_hyena_ctx(const Frame& F, const float* hy_bias, const float* hy_cw, const float* hy_cb) {
    float* HYO = (float*)(F.ws + WS_HYO);
    {

        const bf16* U = (const bf16*)(F.ws + WS_U); const float* KFC = (const float*)(F.ws + WS_KFC);
        LAS float* vw = (LAS float*)(F.lds + F.wave * 4096);
        LAS float* kw = vw + 256;
        const float* cw = hy_cw; const float* cbp = hy_cb;
        for (int it = F.gw; it < NB * 256; it += F.ngw) {
            const int b = it >> 8, c = it & 255;
            float x0v[4];
#pragma unroll
            for (int i = 0; i < 4; ++i) { const int t = F.lane + 64 * i;
                float o[3];
#pragma unroll
                for (int g = 0; g < 3; ++g) { const int cc = g * 256 + c; float a = cbp[cc];
#pragma unroll
                    for (int j = 0; j < 3; ++j) { const int tj = t + j - 1; if (tj >= 0 && tj < CTXL) a += cw[j * 768 + cc] * bf2f(U[(size_t)(NLAT + b * CTXL + tj) * INW + 1280 + cc]); }
                    o[g] = a; }
                vw[t] = o[2] * o[1]; x0v[i] = o[0]; }
#pragma unroll
            for (int i = 0; i < 8; ++i) kw[F.lane + 64 * i] = KFC[c * 512 + F.lane + 64 * i];
            LDS_WAIT();
            float y[4] = {0.f, 0.f, 0.f, 0.f};
#pragma unroll 4
            for (int s = 0; s < CTXL; ++s) { const float vv = vw[s];
#pragma unroll
                for (int i = 0; i < 4; ++i) y[i] += kw[(F.lane + 64 * i - s) & 511] * vv; }
            const float bias = hy_bias[c];
#pragma unroll
            for (int i = 0; i < 4; ++i) { const int t = F.lane + 64 * i; HYO[(size_t)(NLAT + b * CTXL + t) * 256 + c] = (y[i] + vw[t] * bias) * x0v[i]; }
            LDS_WAIT();
        }
    }
}

__device__ __forceinline__ void ph_merge(const Frame& F, int l, int nrows, const float* out_g) {
    const bf16* ATT = (const bf16*)(F.ws + WS_ATT); const float* LRUO = (const float*)(F.ws + WS_LRUO); const float* HYO = (const float*)(F.ws + WS_HYO); bf16* MIXA = (bf16*)(F.ws + WS_MIXA);
    const float* g = out_g + l * 1024;
    for (int r = F.gw; r < nrows; r += F.ngw) {
        const v4u aw = ((const v4u*)(ATT + (size_t)r * 512))[F.lane];
        float a[8] = {bflo(aw.x), bfhi(aw.x), bflo(aw.y), bfhi(aw.y), bflo(aw.z), bfhi(aw.z), bflo(aw.w), bfhi(aw.w)};
        float ss = 0.f;
#pragma unroll
        for (int i = 0; i < 8; ++i) ss += a[i] * a[i];
        const float ra = 1.0f / sqrtf(wave_sum(ss) * (1.0f / 512.0f) + EPSN);
        const f32x4 lv = ((const f32x4*)(LRUO + (size_t)r * 256))[F.lane];
        const float rl = 1.0f / sqrtf(wave_sum(lv.x * lv.x + lv.y * lv.y + lv.z * lv.z + lv.w * lv.w) * (1.0f / 256.0f) + EPSN);
        const f32x4 hv = ((const f32x4*)(HYO + (size_t)r * 256))[F.lane];
        const float rh = 1.0f / sqrtf(wave_sum(hv.x * hv.x + hv.y * hv.y + hv.z * hv.z + hv.w * hv.w) * (1.0f / 256.0f) + EPSN);
        bf16* orow = MIXA + (size_t)r * 1024;
        { const f32x4 g0 = ((const f32x4*)g)[2 * F.lane], g1 = ((const f32x4*)g)[2 * F.lane + 1];
          v4u o; o.x = pk2(a[0] * ra * g0.x, a[1] * ra * g0.y); o.y = pk2(a[2] * ra * g0.z, a[3] * ra * g0.w); o.z = pk2(a[4] * ra * g1.x, a[5] * ra * g1.y); o.w = pk2(a[6] * ra * g1.z, a[7] * ra * g1.w);
          ((v4u*)orow)[F.lane] = o; }
        { const f32x4 gg = ((const f32x4*)(g + 512))[F.lane]; v2u o; o.x = pk2(lv.x * rl * gg.x, lv.y * rl * gg.y); o.y = pk2(lv.z * rl * gg.z, lv.w * rl * gg.w); ((v2u*)(orow + 512))[F.lane] = o; }
        { const f32x4 gg = ((const f32x4*)(g + 768))[F.lane]; v2u o; o.x = pk2(hv.x * rh * gg.x, hv.y * rh * gg.y); o.y = pk2(hv.z * rh * gg.z, hv.w * rh * gg.w); ((v2u*)(orow + 768))[F.lane] = o; }
    }
}

__device__ __forceinline__ void ph_ffn_router(const Frame& F, int l, int nrows, const float* gffn, const float* router_w, const float* router_b) {
    LAS float* rwl = (LAS float*)(F.lds);
    LAS int* hist = (LAS int*)(F.lds + 135168);
    const float* XR = (const float*)(F.ws + WS_XR); const float* MOD = (const float*)(F.ws + WS_MOD); bf16* Fb = (bf16*)(F.ws + WS_F);
    int* TOPI = (int*)(F.ws + WS_TOPI); float* GATE = (float*)(F.ws + WS_GATE); int* BLKCNT = (int*)(F.ws + WS_BLKCNT);
    for (int i = F.tid; i < 1024 * 32; i += NTHR) rwl[(i >> 5) * 33 + (i & 31)] = router_w[(size_t)l * 32768 + i];
    if (F.tid < 32) hist[F.tid] = 0;
    __syncthreads();
    const float* g = gffn + l * 1024;
    for (int r = F.gw; r < nrows; r += F.ngw) {
        const int bidx = r < NLAT ? r / SEQ : 4;
        const float* sf = MOD + (size_t)(l * 5 + bidx) * 6144 + 3 * 1024; const float* cf = sf + 1024;
        float f[16]; float ss = 0.f;
#pragma unroll
        for (int j = 0; j < 16; ++j) { f[j] = XR[(size_t)r * 1024 + 64 * j + F.lane]; ss += f[j] * f[j]; }
        const float rstd = 1.0f / sqrtf(wave_sum(ss) * (1.0f / 1024.0f) + EPSN);
        float p[32];
#pragma unroll
        for (int e = 0; e < 32; ++e) p[e] = 0.f;
#pragma unroll
        for (int j = 0; j < 16; ++j) { const int c = 64 * j + F.lane; const float fv = f[j] * rstd * g[c] * (1.0f + cf[c]) + sf[c];
            Fb[(size_t)r * 1024 + c] = (bf16)f2bf(fv);
            const LAS float* wrow = rwl + c * 33;
#pragma unroll
            for (int e = 0; e < 32; ++e) p[e] += fv * wrow[e]; }
#pragma unroll
        for (int e = 0; e < 32; ++e) p[e] = wave_sum(p[e]) + router_b[l * 32 + e];
        unsigned taken = 0u; float tv[4]; int ti[4];
#pragma unroll
        for (int k = 0; k < 4; ++k) { float best = -INFINITY; int bi = 0;
#pragma unroll
            for (int e = 0; e < 32; ++e) { const bool ok = !((taken >> e) & 1u) && (p[e] > best); best = ok ? p[e] : best; bi = ok ? e : bi; }
            taken |= 1u << bi; tv[k] = best; ti[k] = bi; }
        const float e1 = __expf(tv[1] - tv[0]), e2 = __expf(tv[2] - tv[0]), e3 = __expf(tv[3] - tv[0]); const float inv = 1.0f / (1.0f + e1 + e2 + e3);
        if (F.lane == 0) {
            TOPI[r * 4 + 0] = ti[0]; TOPI[r * 4 + 1] = ti[1]; TOPI[r * 4 + 2] = ti[2]; TOPI[r * 4 + 3] = ti[3];
            GATE[r * 4 + 0] = inv; GATE[r * 4 + 1] = e1 * inv; GATE[r * 4 + 2] = e2 * inv; GATE[r * 4 + 3] = e3 * inv;
            lds_add(&hist[ti[0]], 1); lds_add(&hist[ti[1]], 1); lds_add(&hist[ti[2]], 1); lds_add(&hist[ti[3]], 1);
        }
    }
    __syncthreads();
    if (F.tid < 32) BLKCNT[blockIdx.x * 32 + F.tid] = hist[F.tid];
}

__device__ __forceinline__ void ph_route(const Frame& F, int nrows) {
    LAS int* cursor = (LAS int*)(F.lds);
    LAS int* tot = cursor + 32;
    LAS int* mine = cursor + 64;
    const int* BLKCNT = (const int*)(F.ws + WS_BLKCNT); const int* TOPI = (const int*)(F.ws + WS_TOPI); int* POS = (int*)(F.ws + WS_POS);
    const bf16* Fb = (const bf16*)(F.ws + WS_F); bf16* AS = (bf16*)(F.ws + WS_ASORT); int* TILEE = (int*)(F.ws + WS_TILEE);
    if (F.tid < 32) { int t = 0, m = 0; for (int b = 0; b < F.G; ++b) { const int v = BLKCNT[b * 32 + F.tid]; t += v; m += (b < (int)blockIdx.x) ? v : 0; } tot[F.tid] = t; mine[F.tid] = m; }
    __syncthreads();
    if (F.tid == 0) { int tb = 0;
        for (int e = 0; e < 32; ++e) { const int nt = (tot[e] + 255) >> 8; cursor[e] = tb * 256 + mine[e];
            if (blockIdx.x == 0) for (int j = 0; j < nt; ++j) TILEE[tb + j] = e;
            tb += nt; }
        if (blockIdx.x == 0) F.ctl[CW_NTILES] = (unsigned)tb; }
    __syncthreads();
    for (int r = F.gw; r < nrows; r += F.ngw) {
        int pos = 0;
        if (F.lane < 4) { const int e = TOPI[r * 4 + F.lane]; pos = lds_add(&cursor[e], 1); POS[r * 4 + F.lane] = pos; }
        const v4u a0 = ((const v4u*)(Fb + (size_t)r * 1024))[F.lane], a1 = ((const v4u*)(Fb + (size_t)r * 1024))[64 + F.lane];
#pragma unroll
        for (int k = 0; k < 4; ++k) { const int pk = __shfl(pos, k); v4u* dst = (v4u*)(AS + (size_t)pk * 1024); dst[F.lane] = a0; dst[64 + F.lane] = a1; }
    }
}

__device__ __forceinline__ void ph_combine(const Frame& F, int l, int nrows, float* out) {
    float* XR = (float*)(F.ws + WS_XR); const float* MOD = (const float*)(F.ws + WS_MOD); const bf16* YS = (const bf16*)(F.ws + WS_YS);
    const int* POS = (const int*)(F.ws + WS_POS); const float* GATE = (const float*)(F.ws + WS_GATE);
    for (int r = F.gw; r < nrows; r += F.ngw) {
        const int bidx = r < NLAT ? r / SEQ : 4;
        const float* gf = MOD + (size_t)(l * 5 + bidx) * 6144 + 5 * 1024;
        int pos = 0; float gt = 0.f;
        if (F.lane < 4) { pos = POS[r * 4 + F.lane]; gt = GATE[r * 4 + F.lane]; }
        f32x4 y[4];
#pragma unroll
        for (int j = 0; j < 4; ++j) y[j] = (f32x4){0.f, 0.f, 0.f, 0.f};
#pragma unroll
        for (int k = 0; k < 4; ++k) { const int pk = __shfl(pos, k); const float gk = __shfl(gt, k); const v2u* yr = (const v2u*)(YS + (size_t)pk * 1024);
#pragma unroll
            for (int j = 0; j < 4; ++j) { const v2u w = yr[64 * j + F.lane]; y[j].x += gk * bflo(w.x); y[j].y += gk * bfhi(w.x); y[j].z += gk * bflo(w.y); y[j].w += gk * bfhi(w.y); } }
        float* dst = (l == 0) ? XR + (size_t)r * 1024 : out + (size_t)r * 1024;
#pragma unroll
        for (int j = 0; j < 4; ++j) { const int cb = 64 * j + F.lane; const f32x4 xv = ((const f32x4*)(XR + (size_t)r * 1024))[cb]; const f32x4 gv = ((const f32x4*)gf)[cb];
            ((f32x4*)dst)[cb] = xv + gv * y[j]; }
    }
}

struct Args { const float* in[34]; float* out; unsigned char* ws; int ph_lo, ph_hi; };
enum { I_X = 0, I_C, I_CTX, I_CCTX, I_WMOD, I_BMOD, I_GMIX, I_GFFN, I_WIN, I_QG, I_KG, I_LCW, I_LCB, I_LGW, I_LGB, I_LLAM, I_HCW, I_HCB, I_HW1, I_HB1, I_HW2, I_HB2, I_HW3, I_HFREQ, I_HDEC, I_HBIAS,
       I_OUTG, I_WOUT, I_RW, I_RB, I_MW1, I_MB1, I_MW2, I_MB2 };

__global__ void __launch_bounds__(NTHR, 2) mk_fwd(Args args) {
    extern __shared__ __attribute__((aligned(16))) unsigned char lds[];
    Frame F;
    F.lds = (LAS unsigned char*)lds; F.ws = args.ws; F.ctl = (unsigned*)(args.ws + WS_CTL);
    F.tid = threadIdx.x; F.lane = F.tid & 63; F.wave = __builtin_amdgcn_readfirstlane(F.tid >> 6);
    F.G = gridDim.x; { const int bx = blockIdx.x; F.vcu = (F.G % 8 == 0) ? (bx % 8) * (F.G / 8) + bx / 8 : bx; }
    F.gw = (int)blockIdx.x * NWAVES + F.wave; F.ngw = F.G * NWAVES;
    for (int u = F.tid; u < (LDS_BYTES - LDSCTL_OFF) / 4; u += NTHR) ((LAS unsigned*)(F.lds + LDSCTL_OFF))[u] = 0u;
    __syncthreads();
#if !MK_PER_PHASE
    XcdBarrier bar = xcd_barrier_post(F.ctl + CW_BAR, (volatile LAS unsigned*)(F.lds + LDSCTL_OFF + 32));
#define GRID_BAR() xcd_barrier(bar)
#else
#define GRID_BAR() do { } while (0)
#endif
    const int lo = args.ph_lo, hi = args.ph_hi;
#ifndef ONLY_PHASE
#define ONLY_PHASE (-1)
#endif
#define ENABLED(id) (ONLY_PHASE < 0 || ONLY_PHASE == (id))
#define IN(k) (ENABLED(k) && lo <= (k) && (k) < hi)
#define INL(j) (ENABLED(NPH_PRO + (j)) && lo <= pb + (j) && pb + (j) < hi)
#define SEAML(j) do { if (lo <= pb + (j) && pb + (j) + 1 < hi) { GRID_BAR(); } } while (0)
typedef const __attribute__((address_space(4))) Args* KArgs;
#ifndef REP_MASK
#define REP_MASK 0
#endif
#define NREP(j) (((REP_MASK >> (j)) & 1) ? 2 : 1)
#define REFRAME() Frame Fp = F; KArgs ka = (KArgs)__builtin_amdgcn_kernarg_segment_ptr(); { int t_ = F.tid; asm volatile("" : "+v"(t_), "+s"(ka)); Fp.tid = t_; Fp.lane = t_ & 63; Fp.wave = __builtin_amdgcn_readfirstlane(t_ >> 6); \
    Fp.gw = (int)blockIdx.x * NWAVES + Fp.wave; Fp.ws = ka->ws; Fp.ctl = (unsigned*)(ka->ws + WS_CTL); }
#define SEAM(k) do { if (lo <= (k) && (k) + 1 < hi) { GRID_BAR(); } } while (0)

    if (IN(0)) ph_prologue_a(F, args.in[I_C], args.in[I_CCTX], args.in[I_WMOD], args.in[I_BMOD], args.in[I_WIN], args.in[I_WOUT], args.in[I_MW1], args.in[I_MW2],
                             args.in[I_HW1], args.in[I_HB1], args.in[I_HW2], args.in[I_HB2], args.in[I_HFREQ]);
    SEAM(0);
    if (IN(1)) ph_prologue_b(F, args.in[I_HW3], args.in[I_HDEC]);
    SEAM(1);
    if (IN(2)) ph_khat(F);
    SEAM(2);

#define LAYER_BODY(l) { \
        const int pb = NPH_PRO + l * NPH_LAYER; \
        const int nrows = (l == 0) ? MT : NLAT; \
        if (INL(0)) { _Pragma("unroll") for (int rep_ = 0; rep_ < NREP(0); ++rep_) { { REFRAME(); ph_norm_mod(Fp, l, ka->in[I_X], ka->in[I_CTX], ka->in[I_GMIX]); } if (rep_ + 1 < NREP(0)) GRID_BAR(); } } \
        SEAML(0); \
        if (INL(1)) { REFRAME(); \
            pg8::Gemm g{(const bf16*)(Fp.ws + WS_H), (const bf16*)(Fp.ws + WS_WINT) + (size_t)l * 2048 * 1024, MT, 2048, 1024}; \
            pg8::StaticOrder S; S.init(MT, 2048, Fp.G, (int)blockIdx.x); \
            pg8::EpiBf16<0> E{(bf16*)(Fp.ws + WS_U), 2048, nullptr, 0, 0, 1.f}; \
            pg8::gemm_phase<pg8::EpiBf16<0>, pg8::StaticOrder, PG8_ALIGN, PG8_SP2>(Fp.lds + RING_OFF, g, S, E); \
        } \
        SEAML(1); \
        if (INL(2)) { _Pragma("unroll") for (int rep_ = 0; rep_ < NREP(2); ++rep_) { { REFRAME(); ph_post_proj(Fp, l, ka->in[I_QG], ka->in[I_KG], ka->in[I_LCW], ka->in[I_LCB], ka->in[I_LGW], ka->in[I_LGB], ka->in[I_LLAM], ka->in[I_HCW], ka->in[I_HCB]); } if (rep_ + 1 < NREP(2)) GRID_BAR(); } } \
        SEAML(2); \
        if (INL(3)) { { REFRAME(); \
            const attn_body::AttnTensors AT{(const attn_body::bf16*)(Fp.ws + WS_Q), (const attn_body::bf16*)(Fp.ws + WS_K), (const attn_body::bf16*)(Fp.ws + WS_V), (attn_body::bf16*)(Fp.ws + WS_ATT)}; \
            attn_body::attn_phase<8>((char*)lds + RING_OFF, AT, Fp.G, Fp.vcu); } \
            if (l == 0) { REFRAME(); ph_ctx_attn(Fp); } \
        } \
        SEAML(3); \
        if (INL(4)) { _Pragma("unroll") for (int rep_ = 0; rep_ < NREP(4); ++rep_) { { REFRAME(); ph_scan1(Fp); } if (rep_ + 1 < NREP(4)) GRID_BAR(); } } \
        SEAML(4); \
        if (INL(5)) { _Pragma("unroll") for (int rep_ = 0; rep_ < NREP(5); ++rep_) { { REFRAME(); ph_scan2(Fp); } if (rep_ + 1 < NREP(5)) GRID_BAR(); } } \
        SEAML(5); \
        if (INL(6)) { _Pragma("unroll") for (int rep_ = 0; rep_ < NREP(6); ++rep_) { { REFRAME(); ph_hyena_fft(Fp, l, ka->in[I_HBIAS]); if (l == 0) ph_hyena_ctx(Fp, ka->in[I_HBIAS], ka->in[I_HCW], ka->in[I_HCB]); } if (rep_ + 1 < NREP(6)) GRID_BAR(); } } \
        SEAML(6); \
        if (INL(7)) { _Pragma("unroll") for (int rep_ = 0; rep_ < NREP(7); ++rep_) { { REFRAME(); ph_merge(Fp, l, nrows, ka->in[I_OUTG]); } if (rep_ + 1 < NREP(7)) GRID_BAR(); } } \
        SEAML(7); \
        if (INL(8)) { REFRAME(); \
            pg8::Gemm g{(const bf16*)(Fp.ws + WS_MIXA), (const bf16*)(Fp.ws + WS_WOUTT) + (size_t)l * 1024 * 1024, nrows, 1024, 1024}; \
            pg8::StaticOrder S; S.init(nrows, 1024, Fp.G, (int)blockIdx.x); \
            float* XR = (float*)(Fp.ws + WS_XR); \
            pg8::EpiResid E{(l == 0) ? ka->in[I_X] : (const float*)XR, (l == 0) ? ka->in[I_CTX] : (const float*)(XR + (size_t)NLAT * 1024), NLAT, XR, 1024, \
                            (const float*)(Fp.ws + WS_MOD) + (size_t)(l * 5) * 6144 + 2 * 1024, 6144, SEQ}; \
            pg8::gemm_phase<pg8::EpiResid, pg8::StaticOrder, PG8_ALIGN, PG8_SP2>(Fp.lds + RING_OFF, g, S, E); \
        } \
        SEAML(8); \
        if (INL(9)) { _Pragma("unroll") for (int rep_ = 0; rep_ < NREP(9); ++rep_) { { REFRAME(); ph_ffn_router(Fp, l, nrows, ka->in[I_GFFN], ka->in[I_RW], ka->in[I_RB]); } if (rep_ + 1 < NREP(9)) GRID_BAR(); } } \
        SEAML(9); \
        if (INL(10)) { _Pragma("unroll") for (int rep_ = 0; rep_ < NREP(10); ++rep_) { { REFRAME(); ph_route(Fp, nrows); } if (rep_ + 1 < NREP(10)) GRID_BAR(); } } \
        SEAML(10); \
        if (INL(11) || INL(12)) { REFRAME(); \
            LAS int* tab = (LAS int*)(Fp.lds + MOETAB_OFF); \
            const int ntiles = (int)__hip_atomic_load(Fp.ctl + CW_NTILES, __ATOMIC_RELAXED, __HIP_MEMORY_SCOPE_AGENT); \
            const int* TILEE = (const int*)(Fp.ws + WS_TILEE); \
            for (int i = Fp.tid; i < ntiles && i < SORT_TILES; i += NTHR) tab[i] = TILEE[i]; \
            __syncthreads(); \
            if (INL(11)) { \
                pg8::Gemm g{(const bf16*)(Fp.ws + WS_ASORT), (const bf16*)(Fp.ws + WS_W1T) + (size_t)l * 32 * 2048 * 1024, 0, 2048, 1024}; \
                pg8::MoeOrder S{tab, ntiles, 8, Fp.G, (int)blockIdx.x}; \
                pg8::EpiSwiglu E{(bf16*)(Fp.ws + WS_ACT), 1024, ka->in[I_MB1] + (size_t)l * 32 * 2048, 2048}; \
                pg8::gemm_phase<pg8::EpiSwiglu, pg8::MoeOrder, PG8_ALIGN, PG8_SP2>(Fp.lds + RING_OFF, g, S, E); \
            } \
            SEAML(11); \
            if (INL(12)) { \
                pg8::Gemm g{(const bf16*)(Fp.ws + WS_ACT), (const bf16*)(Fp.ws + WS_W2T) + (size_t)l * 32 * 1024 * 1024, 0, 1024, 1024}; \
                pg8::MoeOrder S{tab, ntiles, 4, Fp.G, (int)blockIdx.x}; \
                pg8::EpiBf16Bias E{(bf16*)(Fp.ws + WS_YS), 1024, ka->in[I_MB2] + (size_t)l * 32 * 1024, 1024}; \
                pg8::gemm_phase<pg8::EpiBf16Bias, pg8::MoeOrder, PG8_ALIGN, PG8_SP2>(Fp.lds + RING_OFF, g, S, E); \
            } \
        } \
        SEAML(12); \
        if (INL(13)) { _Pragma("unroll") for (int rep_ = 0; rep_ < NREP(13); ++rep_) { { REFRAME(); ph_combine(Fp, l, nrows, ka->out); } if (rep_ + 1 < NREP(13)) GRID_BAR(); } } \
        SEAML(13); \
    }
    LAYER_BODY(0)
    LAYER_BODY(1)
#undef LAYER_BODY
#undef IN
#undef SEAM
#undef INL
#undef SEAML
}

extern "C" void kernel_launch(void* const* d_in, const int* in_sizes, int n_in, void* d_out, int out_size, void* d_ws, size_t ws_size, hipStream_t stream) {
    static int grid = 0;
    if (grid == 0) {
        if (n_in != 34 || in_sizes[0] != NLAT * DMODEL || out_size != NLAT * DMODEL || ws_size < WS_END) {
            fprintf(stderr, "kernel_launch: unexpected shapes (n_in %d, in0 %d, out %d, ws %zu); nothing launched\n", n_in, n_in > 0 ? in_sizes[0] : -1, out_size, ws_size); grid = -1; return; }
        int dev = 0, cus = 0;
        if (hipGetDevice(&dev) != hipSuccess || hipDeviceGetAttribute(&cus, hipDeviceAttributeMultiprocessorCount, dev) != hipSuccess) { grid = -1; return; }
        if (hipFuncSetAttribute((const void*)mk_fwd, hipFuncAttributeMaxDynamicSharedMemorySize, LDS_BYTES) != hipSuccess) { fprintf(stderr, "kernel_launch: hipFuncSetAttribute failed\n"); grid = -1; return; }
        int per_cu = 0;
        if (hipOccupancyMaxActiveBlocksPerMultiprocessor(&per_cu, (const void*)mk_fwd, NTHR, LDS_BYTES) != hipSuccess || per_cu < 1) { fprintf(stderr, "kernel_launch: occupancy query says %d\n", per_cu); }
        (void)hipGetLastError();
        grid = cus;
    }
    if (grid < 0) return;
    if (hipMemsetAsync((char*)d_ws + WS_CTL, 0, CTL_ZERO_BYTES, stream) != hipSuccess) return;
    Args a{};
    for (int i = 0; i < 34; ++i) a.in[i] = (const float*)d_in[i];
    a.out = (float*)d_out; a.ws = (unsigned char*)d_ws;
#if MK_PER_PHASE
    for (int p = 0; p < NPH; ++p) { a.ph_lo = p; a.ph_hi = p + 1; hipLaunchKernelGGL(mk_fwd, dim3(grid), dim3(NTHR), LDS_BYTES, stream, a); }
#else
    a.ph_lo = 0; a.ph_hi = NPH;
    hipLaunchKernelGGL(mk_fwd, dim3(grid), dim3(NTHR), LDS_BYTES, stream, a);
#endif
}
```

```cpp
#include <hip/hip_runtime.h>
#include <hip/hip_bf16.h>
#include <cstdio>
#include <cstdint>
#include <cmath>
#ifndef MK_PER_PHASE
#define MK_PER_PHASE 0
#endif
namespace pg8 {
#define PG8_LAS __attribute__((address_space(3)))
typedef unsigned short bf16_t;
typedef short bf16x8 __attribute__((ext_vector_type(8)));
typedef float f32x4 __attribute__((ext_vector_type(4)));
typedef unsigned u32x4 __attribute__((ext_vector_type(4)));
constexpr int BM = 256, BK = 64, HALF = 128, HTB = HALF * BK * 2  , STAGE_BYTES = 8 * HTB, NXCD = 8, WGM = 8;

__host__ __device__ __forceinline__ int lds_byte(int r, int c) { const int st = (r >> 4) * 2 + (c >> 5), rr = r & 15, cc = c & 31, ob = rr * 64 + cc * 2; return st * 1024 + (ob ^ (((ob >> 9) & 1) << 5)); }
__host__ __device__ __forceinline__ void stage_rc(int b, int& R, int& C) { const int st = b / 1024, sb = b % 1024, swz = sb ^ (((sb >> 9) & 1) << 5); R = (st >> 1) * 16 + swz / 64; C = (st & 1) * 32 + (swz % 64) / 2; }
__host__ __device__ __forceinline__ int perm32(int rho) { const int n = rho >> 4, i = rho & 15; return 8 * (i >> 2) + 4 * n + (i & 3); }

struct Unit { int pm, pn, be, e; };
struct Gemm { const bf16_t* A; const bf16_t* Bt; int M, N, K; };

struct StaticOrder {
    int nM, nN, nwg, G, c;
    __host__ __device__ void init(int M, int N, int G_, int c_) { nM = M / BM; nN = N / BM; nwg = nM * nN; G = G_; c = c_; }
    __host__ __device__ bool next(int i, Unit& u) const {
        const long L = (long)i * G + c; if (L >= nwg) return false;
        int wgid = (int)L; { const int q = nwg / NXCD, r = nwg % NXCD, xcd = wgid % NXCD, off = wgid / NXCD; wgid = (xcd < r ? xcd * (q + 1) : r * (q + 1) + (xcd - r) * q) + off; }
        const int nig = WGM * nN, gid = wgid / nig, fm = gid * WGM, gsz = (nM - fm) < WGM ? (nM - fm) : WGM;
        u.pm = fm + ((wgid % nig) % gsz); u.pn = (wgid % nig) / gsz; u.be = u.pn; u.e = 0; return true;
    }
    __device__ __forceinline__ void a_ready(const Unit&) const {}
    __device__ __forceinline__ void done(const Unit&) const {}
};

__device__ __forceinline__ unsigned cvt_pk_bf16(float lo, float hi) { unsigned r; asm volatile("v_cvt_pk_bf16_f32 %0, %1, %2" : "=v"(r) : "v"(lo), "v"(hi)); return r; }
typedef float f32x2 __attribute__((ext_vector_type(2)));
__device__ __forceinline__ f32x2 gelu_pk(f32x2 v) {
    const f32x2 av = __builtin_elementwise_abs(v), d = av * 0.2316418882f + 1.0f;
    f32x2 t; t.x = __builtin_amdgcn_rcpf(d.x); t.y = __builtin_amdgcn_rcpf(d.y);
    f32x2 q = t * 0.5307027145f + (-0.7265760135f); q = q * t + 0.7107068705f; q = q * t + (-0.142248368f); q = q * t + 0.127414796f; q = q * t;
    const f32x2 s = (v * v) * (-0.72134752044f);
    f32x2 e; e.x = __builtin_amdgcn_exp2f(s.x); e.y = __builtin_amdgcn_exp2f(s.y);
    const f32x2 m = v * (q * e), r = v - m;
    f32x2 o; o.x = v.x < 0.f ? m.x : r.x; o.y = v.y < 0.f ? m.y : r.y; return o;
}

template <int ACT  > struct EpiBf16 {
    static constexpr bool PERM = true, AFTER_DRAIN = false; static_assert(ACT == 0 || ACT == 1, "EpiBf16: ACT is 0 (none) or 1 (gelu_pk)");
    bf16_t* O; int ldc; const float* bias; int split_cols; size_t split_stride; float scale0;
    __device__ __forceinline__ void operator()(const f32x4 (&acc)[2][2][4][2], const Unit& u, int wr, int wc, int fr, int fq) const {
        const int row0 = u.pm * BM + wr * 64 + fr; int colt = u.pn * BM; bf16_t* base = O;
        float sc = 1.f; if (split_cols) { const int t = colt / split_cols; base += (size_t)t * split_stride; colt -= t * split_cols; if (t == 0) sc = scale0; }
        const int col0 = colt + wc * 32 + 8 * fq, bcol0 = u.pn * BM + wc * 32 + 8 * fq;
        f32x4 bv[2][2];
#pragma unroll
        for (int bj = 0; bj < 2; ++bj)
#pragma unroll
            for (int n = 0; n < 2; ++n) bv[bj][n] = bias ? *(const f32x4*)(bias + bcol0 + bj * HALF + 4 * n) : (f32x4){0.f, 0.f, 0.f, 0.f};
#pragma unroll
        for (int ai = 0; ai < 2; ++ai)
#pragma unroll
            for (int m = 0; m < 4; ++m) { bf16_t* rowp = base + (size_t)(row0 + ai * HALF + m * 16) * ldc + col0;
#pragma unroll
                for (int bj = 0; bj < 2; ++bj) { f32x4 v0 = acc[ai][bj][m][0] + bv[bj][0], v1 = acc[ai][bj][m][1] + bv[bj][1];
                    if (ACT == 1) { f32x2 a = gelu_pk((f32x2){v0[0], v0[1]}), b = gelu_pk((f32x2){v0[2], v0[3]}), c = gelu_pk((f32x2){v1[0], v1[1]}), d = gelu_pk((f32x2){v1[2], v1[3]});
                        v0 = (f32x4){a.x, a.y, b.x, b.y}; v1 = (f32x4){c.x, c.y, d.x, d.y}; }
                    v0 = v0 * sc; v1 = v1 * sc; u32x4 w; w.x = cvt_pk_bf16(v0[0], v0[1]); w.y = cvt_pk_bf16(v0[2], v0[3]); w.z = cvt_pk_bf16(v1[0], v1[1]); w.w = cvt_pk_bf16(v1[2], v1[3]);
                    *(u32x4*)(rowp + bj * HALF) = w; } }
    }
};


struct EpiResid {
    static constexpr bool PERM = false, AFTER_DRAIN = false;
    const float* xin_lat; const float* xin_ctx; int nlat; float* XR; int ldc; const float* mod; int mod_stride; int seq;
    __device__ __forceinline__ void operator()(const f32x4 (&acc)[2][2][4][2], const Unit& u, int wr, int wc, int fr, int fq) const {
        const int row0 = u.pm * BM + wr * 64 + fr, col0 = u.pn * BM + wc * 32 + 4 * fq;
        const int rowt = u.pm * BM; const int bidx = rowt < nlat ? rowt / seq : 4;
        const float* gate = mod + (size_t)bidx * mod_stride;
        const float* xin = rowt < nlat ? xin_lat : (xin_ctx - (size_t)nlat * ldc);
        f32x4 gv[2][2];
#pragma unroll
        for (int bj = 0; bj < 2; ++bj)
#pragma unroll
            for (int n = 0; n < 2; ++n) gv[bj][n] = *(const f32x4*)(gate + col0 + bj * HALF + n * 16);
#pragma unroll
        for (int ai = 0; ai < 2; ++ai)
#pragma unroll
            for (int m = 0; m < 4; ++m) { const size_t ro = (size_t)(row0 + ai * HALF + m * 16) * ldc + col0;
#pragma unroll
                for (int bj = 0; bj < 2; ++bj)
#pragma unroll
                    for (int n = 0; n < 2; ++n) { const f32x4 xv = *(const f32x4*)(xin + ro + bj * HALF + n * 16);
                        *(f32x4*)(XR + ro + bj * HALF + n * 16) = xv + gv[bj][n] * acc[ai][bj][m][n]; } }
    }
};
struct EpiSwiglu {
    static constexpr bool PERM = true, AFTER_DRAIN = false;
    bf16_t* O; int ldc; const float* bias; int bias_stride;
    __device__ __forceinline__ void operator()(const f32x4 (&acc)[2][2][4][2], const Unit& u, int wr, int wc, int fr, int fq) const {
        const int row0 = u.pm * BM + wr * 64 + fr; const int bcol0 = u.pn * BM + wc * 32 + 8 * fq; const int ocol0 = bcol0 >> 1;
        const float* bb = bias + (size_t)u.e * bias_stride;
        f32x4 bv[2][2];
#pragma unroll
        for (int bj = 0; bj < 2; ++bj)
#pragma unroll
            for (int n = 0; n < 2; ++n) bv[bj][n] = *(const f32x4*)(bb + bcol0 + bj * HALF + 4 * n);
#pragma unroll
        for (int ai = 0; ai < 2; ++ai)
#pragma unroll
            for (int m = 0; m < 4; ++m) { bf16_t* rowp = O + (size_t)(row0 + ai * HALF + m * 16) * ldc + ocol0;
#pragma unroll
                for (int bj = 0; bj < 2; ++bj) { const f32x4 v0 = acc[ai][bj][m][0] + bv[bj][0], v1 = acc[ai][bj][m][1] + bv[bj][1];
                    float o[4];
#pragma unroll
                    for (int p = 0; p < 4; ++p) { const float hg = p < 2 ? v0[2 * p] : v1[2 * p - 4], hl = p < 2 ? v0[2 * p + 1] : v1[2 * p - 3];
                        const float glu = fminf(hg, 7.0f), lin = fminf(fmaxf(hl, -7.0f), 7.0f);
                        const float sg = __builtin_amdgcn_rcpf(1.0f + __builtin_amdgcn_exp2f(-1.702f * 1.4426950408889634f * glu));
                        o[p] = glu * sg * (lin + 1.0f); }
                    typedef unsigned u32x2 __attribute__((ext_vector_type(2)));
                    u32x2 w; w.x = cvt_pk_bf16(o[0], o[1]); w.y = cvt_pk_bf16(o[2], o[3]);
                    *(u32x2*)(rowp + bj * (HALF / 2)) = w; } }
    }
};
struct EpiBf16Bias {
    static constexpr bool PERM = true, AFTER_DRAIN = false;
    bf16_t* O; int ldc; const float* bias; int bias_stride;
    __device__ __forceinline__ void operator()(const f32x4 (&acc)[2][2][4][2], const Unit& u, int wr, int wc, int fr, int fq) const {
        const int row0 = u.pm * BM + wr * 64 + fr; const int col0 = u.pn * BM + wc * 32 + 8 * fq;
        const float* bb = bias + (size_t)u.e * bias_stride;
        f32x4 bv[2][2];
#pragma unroll
        for (int bj = 0; bj < 2; ++bj)
#pragma unroll
            for (int n = 0; n < 2; ++n) bv[bj][n] = *(const f32x4*)(bb + col0 + bj * HALF + 4 * n);
#pragma unroll
        for (int ai = 0; ai < 2; ++ai)
#pragma unroll
            for (int m = 0; m < 4; ++m) { bf16_t* rowp = O + (size_t)(row0 + ai * HALF + m * 16) * ldc + col0;
#pragma unroll
                for (int bj = 0; bj < 2; ++bj) { const f32x4 v0 = acc[ai][bj][m][0] + bv[bj][0], v1 = acc[ai][bj][m][1] + bv[bj][1];
                    u32x4 w; w.x = cvt_pk_bf16(v0[0], v0[1]); w.y = cvt_pk_bf16(v0[2], v0[3]); w.z = cvt_pk_bf16(v1[0], v1[1]); w.w = cvt_pk_bf16(v1[2], v1[3]);
                    *(u32x4*)(rowp + bj * HALF) = w; } }
    }
};
struct MoeOrder {
    const PG8_LAS int* tab; int ntiles, nN, nper, j, m_lo, nMx;
    __device__ __forceinline__ void init(const PG8_LAS int* tab_, int ntiles_, int nN_, int G, int bx) {
        tab = tab_; ntiles = ntiles_; nN = nN_;
        if (G % 8 == 0) { const int x = bx % 8; nper = G / 8; j = bx / 8; m_lo = (x * ntiles) / 8; nMx = ((x + 1) * ntiles) / 8 - m_lo; }
        else { nper = G; j = bx; m_lo = 0; nMx = ntiles; }
    }
    __device__ __forceinline__ bool next(int i, Unit& u) const {
        const int s = i * nper + j; if (s >= nMx * nN) return false;
        const int nig = 8 * nN, gid = s / nig, fm = gid * 8, gsz = (nMx - fm) < 8 ? (nMx - fm) : 8, w = s - gid * nig;
        u.pm = m_lo + fm + (w % gsz); u.pn = w / gsz; u.e = tab[u.pm]; u.be = u.e * nN + u.pn; return true;
    }
    __device__ __forceinline__ void a_ready(const Unit&) const {}
    __device__ __forceinline__ void done(const Unit&) const {}
};
template <class Epi, class Sched, bool ALIGN_EPI = false, bool SP2 = false>
__device__ __forceinline__ void gemm_phase(PG8_LAS unsigned char* lds, const Gemm g, const Sched& S, const Epi& E) {
    int tid_ = threadIdx.x; asm volatile("" : "+v"(tid_));
    const int tid = tid_, wid = __builtin_amdgcn_readfirstlane(tid >> 6), lane = tid & 63, wr = wid >> 2, wc = wid & 3, fr = lane & 15, fq = lane >> 4;
    const int K = g.K, nt = K / BK;
    unsigned voffA[2], voffB[2];
#pragma unroll
    for (int i = 0; i < 2; ++i) { int R, C; stage_rc(tid * 16 + i * 8192, R, C); const int Rb = Epi::PERM ? ((R & ~31) + perm32(R & 31)) : R;
        voffA[i] = (unsigned)(R * K + C) * 2u; voffB[i] = (unsigned)(Rb * K + C) * 2u; }
    const size_t kstep = (size_t)(BK * 2);
    const size_t hstep = (size_t)HALF * K * 2;
    const size_t tstep = 2 * hstep;
    const unsigned ldsw = (unsigned)wid * 1024u;
    const int aoff = lds_byte(wr * 64 + fr, fq * 8), boff = lds_byte(wc * 32 + fr, fq * 8);
#define PG8_SA(b, h) (((b) * 2 + (h)) * HTB)
#define PG8_SB(b, h) ((4 + (b) * 2 + (h)) * HTB)
#define PG8_STAGE(bufoff, gbase, voff) do { _Pragma("unroll") for (int _i = 0; _i < 2; ++_i) \
        __builtin_amdgcn_global_load_lds((const unsigned*)((const char*)(gbase) + (voff)[_i]), (PG8_LAS unsigned*)(lds + (bufoff) + ldsw + _i * 8192), 16, 0, 0); } while (0)
#define PG8_LDA(dst, b, h) do { _Pragma("unroll") for (int m = 0; m < 4; ++m) _Pragma("unroll") for (int k = 0; k < 2; ++k) dst[m][k] = *(const PG8_LAS bf16x8*)(lds + PG8_SA(b, h) + aoff + m * 2048 + k * 1024); } while (0)
#define PG8_LDB(dst, b, h) do { _Pragma("unroll") for (int n = 0; n < 2; ++n) _Pragma("unroll") for (int k = 0; k < 2; ++k) dst[n][k] = *(const PG8_LAS bf16x8*)(lds + PG8_SB(b, h) + boff + n * 2048 + k * 1024); } while (0)
#define PG8_MMA(ai, bj, At, Bt) do { __builtin_amdgcn_s_setprio(1); _Pragma("unroll") for (int m = 0; m < 4; ++m) _Pragma("unroll") for (int n = 0; n < 2; ++n) _Pragma("unroll") for (int k = 0; k < 2; ++k) \
        acc[ai][bj][m][n] = __builtin_amdgcn_mfma_f32_16x16x32_bf16(Bt[n][k], At[m][k], acc[ai][bj][m][n], 0, 0, 0); __builtin_amdgcn_s_setprio(0); } while (0)
#define PG8_WAIT_V(n) asm volatile("s_waitcnt vmcnt(" #n ")" ::: "memory")
#define PG8_WAIT_L(n) asm volatile("s_waitcnt lgkmcnt(" #n ")" ::: "memory")
#define PG8_BAR __builtin_amdgcn_s_barrier()
#define PG8_SCHED __builtin_amdgcn_sched_barrier(0)
    Unit cur, nxt; int ui = 0;
    if (!S.next(0, cur)) return;
    f32x4 acc[2][2][4][2];
#pragma unroll
    for (int a = 0; a < 2; ++a)
#pragma unroll
        for (int b = 0; b < 2; ++b)
#pragma unroll
            for (int m = 0; m < 4; ++m)
#pragma unroll
                for (int n = 0; n < 2; ++n) acc[a][b][m][n] = (f32x4){0.f, 0.f, 0.f, 0.f};
    bf16x8 At[4][2], B0[2][2], B1[2][2];
    const char* cA = (const char*)g.A + (size_t)cur.pm * tstep; const char* cB = (const char*)g.Bt + (size_t)cur.be * tstep;
    S.a_ready(cur);
    if constexpr (SP2) {
        PG8_STAGE(PG8_SB(0, 0), cB, voffB); PG8_STAGE(PG8_SB(0, 1), cB + hstep, voffB); PG8_STAGE(PG8_SA(0, 0), cA, voffA); PG8_STAGE(PG8_SA(0, 1), cA + hstep, voffA);
        if (wr == 1) PG8_BAR;
        PG8_WAIT_V(2); PG8_BAR;
        PG8_STAGE(PG8_SB(1, 0), cB + kstep, voffB); PG8_STAGE(PG8_SA(1, 0), cA + kstep, voffA); PG8_STAGE(PG8_SB(1, 1), cB + hstep + kstep, voffB);
        PG8_WAIT_V(6); PG8_BAR;
    } else {
        PG8_STAGE(PG8_SB(0, 0), cB, voffB); PG8_STAGE(PG8_SA(0, 0), cA, voffA); PG8_STAGE(PG8_SB(0, 1), cB + hstep, voffB); PG8_STAGE(PG8_SA(0, 1), cA + hstep, voffA);
        if (wr == 1) PG8_BAR;
        PG8_WAIT_V(4); PG8_BAR;
        PG8_STAGE(PG8_SB(1, 0), cB + kstep, voffB); PG8_STAGE(PG8_SA(1, 0), cA + kstep, voffA); PG8_STAGE(PG8_SB(1, 1), cB + hstep + kstep, voffB);
        PG8_WAIT_V(6); PG8_BAR;
    }
    for (;;) {
        const bool has_next = S.next(ui + 1, nxt);
        const char* nA = has_next ? (const char*)g.A + (size_t)nxt.pm * tstep : cA; const char* nB = has_next ? (const char*)g.Bt + (size_t)nxt.be * tstep : cB;
        for (int t = 0; t < nt; t += 2) {
            const bool last = (t == nt - 2);
            const char* a1 = cA + (size_t)(t + 1) * kstep;
            const char* a2 = last ? nA : cA + (size_t)(t + 2) * kstep; const char* b2 = last ? nB : cB + (size_t)(t + 2) * kstep;
            const char* a3 = a2 + kstep; const char* b3 = b2 + kstep;
            if (last && has_next) S.a_ready(nxt);
            if constexpr (SP2) {
            PG8_LDB(B0, 0, 0); PG8_LDB(B1, 0, 1); PG8_SCHED; PG8_LDA(At, 0, 0); PG8_STAGE(PG8_SA(1, 1), a1 + hstep, voffA);
            PG8_WAIT_V(8); PG8_WAIT_L(0); PG8_BAR; PG8_MMA(0, 0, At, B0); PG8_MMA(0, 1, At, B1); PG8_BAR; PG8_SCHED;
            PG8_LDA(At, 0, 1); PG8_STAGE(PG8_SB(0, 0), b2, voffB); PG8_STAGE(PG8_SB(0, 1), b2 + hstep, voffB); PG8_STAGE(PG8_SA(0, 0), a2, voffA);
            PG8_WAIT_V(8); PG8_WAIT_L(0); PG8_BAR; PG8_MMA(1, 0, At, B0); PG8_MMA(1, 1, At, B1); PG8_BAR; PG8_SCHED;
            PG8_LDB(B0, 1, 0); PG8_LDB(B1, 1, 1); PG8_SCHED; PG8_LDA(At, 1, 0); PG8_STAGE(PG8_SA(0, 1), a2 + hstep, voffA);
            PG8_WAIT_V(8); PG8_WAIT_L(0); PG8_BAR; PG8_MMA(0, 0, At, B0); PG8_MMA(0, 1, At, B1); PG8_BAR; PG8_SCHED;
            PG8_LDA(At, 1, 1); PG8_STAGE(PG8_SB(1, 0), b3, voffB); PG8_STAGE(PG8_SB(1, 1), b3 + hstep, voffB); PG8_STAGE(PG8_SA(1, 0), a3, voffA);
            PG8_WAIT_V(8); PG8_WAIT_L(0); PG8_BAR; PG8_MMA(1, 0, At, B0); PG8_MMA(1, 1, At, B1); PG8_BAR; PG8_SCHED;
            } else {
            PG8_LDB(B0, 0, 0); PG8_SCHED; PG8_LDA(At, 0, 0); PG8_STAGE(PG8_SA(1, 1), a1 + hstep, voffA);
            PG8_WAIT_L(8); PG8_BAR; PG8_WAIT_L(0); PG8_MMA(0, 0, At, B0); PG8_BAR; PG8_SCHED;
            PG8_LDB(B1, 0, 1); PG8_STAGE(PG8_SB(0, 0), b2, voffB);
            PG8_BAR; PG8_WAIT_L(0); PG8_MMA(0, 1, At, B1); PG8_BAR;
            PG8_LDA(At, 0, 1); PG8_STAGE(PG8_SA(0, 0), a2, voffA);
            PG8_BAR; PG8_WAIT_L(0); PG8_MMA(1, 0, At, B0); PG8_BAR; PG8_SCHED;
            PG8_STAGE(PG8_SB(0, 1), b2 + hstep, voffB);
            PG8_WAIT_V(6); PG8_BAR; PG8_MMA(1, 1, At, B1); PG8_BAR;
            PG8_LDB(B0, 1, 0); PG8_SCHED; PG8_LDA(At, 1, 0); PG8_STAGE(PG8_SA(0, 1), a2 + hstep, voffA);
            PG8_WAIT_L(8); PG8_BAR; PG8_WAIT_L(0); PG8_MMA(0, 0, At, B0); PG8_BAR; PG8_SCHED;
            PG8_LDB(B1, 1, 1); PG8_STAGE(PG8_SB(1, 0), b3, voffB);
            PG8_BAR; PG8_WAIT_L(0); PG8_MMA(0, 1, At, B1); PG8_BAR;
            PG8_LDA(At, 1, 1); PG8_STAGE(PG8_SA(1, 0), a3, voffA);
            PG8_BAR; PG8_WAIT_L(0); PG8_MMA(1, 0, At, B0); PG8_BAR; PG8_SCHED;
            PG8_STAGE(PG8_SB(1, 1), b3 + hstep, voffB);
            PG8_WAIT_V(6); PG8_BAR; PG8_MMA(1, 1, At, B1); PG8_BAR;
            }
        }
        if constexpr (ALIGN_EPI) { if (wr == 0) PG8_BAR; }
        if constexpr (!Epi::AFTER_DRAIN) { E(acc, cur, wr, wc, fr, fq); S.done(cur); }
        if (!has_next) break;
#pragma unroll
        for (int a = 0; a < 2; ++a)
#pragma unroll
            for (int b = 0; b < 2; ++b)
#pragma unroll
                for (int m = 0; m < 4; ++m)
#pragma unroll
                    for (int n = 0; n < 2; ++n) acc[a][b][m][n] = (f32x4){0.f, 0.f, 0.f, 0.f};
        cur = nxt; cA = nA; cB = nB; ++ui;
        if constexpr (ALIGN_EPI) { if (wr == 1) PG8_BAR; }
    }
    PG8_WAIT_V(0);
    if constexpr (!ALIGN_EPI) { if (wr == 0) PG8_BAR; }
    PG8_BAR;
    if constexpr (Epi::AFTER_DRAIN) { E.fused(acc, cur, wr, wc, fr, fq, lds, wid, lane); S.done(cur); }
#undef PG8_SA
#undef PG8_SB
#undef PG8_STAGE
#undef PG8_LDA
#undef PG8_LDB
#undef PG8_MMA
#undef PG8_WAIT_V
#undef PG8_WAIT_L
#undef PG8_BAR
#undef PG8_SCHED
}
}

#ifndef PG8_SP2
#define PG8_SP2 true
#endif
#ifndef PG8_ALIGN
#define PG8_ALIGN true
#endif
#include <cmath>
namespace attn_body {
using bf16=__hip_bfloat16;
using bf16x8=__attribute__((ext_vector_type(8)))short;
using s16x4=__attribute__((ext_vector_type(4)))short;
using f32x16=__attribute__((ext_vector_type(16)))float;
using u32x4=__attribute__((ext_vector_type(4)))unsigned;
constexpr int NHEAD=8,SEQQ=8192,SEQK=8448,D=64,QP=512,KP=128;
constexpr int NW=8,QBLK=32,QB=QBLK*NW,KVBLK=64,NQB=SEQQ/QB;
constexpr int ATTN_UNIT_ROWS=QB;
__device__ __forceinline__ int crow(int r,int hi){return (r&3)+8*(r>>2)+4*hi;}
#define SBAR() __builtin_amdgcn_sched_barrier(0)
__device__ __forceinline__ void cmask(f32x16&p0,f32x16&p1,int jb,int qrel,int hi){
  const float NEG=-INFINITY; int kb=64*jb+4*hi;
  #pragma unroll
  for(int r=0;r<16;++r){int kv=kb+(r&3)+8*(r>>2); if(kv>qrel)p0[r]=NEG; if(kv+32>qrel)p1[r]=NEG;}
}

constexpr int NSLOT=3, SLOTB=8192;
constexpr int LDS_K=0, LDS_V=NSLOT*SLOTB, LDS_WS=2*NSLOT*SLOTB, LDS_OST=LDS_WS+NW*64*4, LDS_BYTES=LDS_OST+NW*4096;
constexpr float C2=0.125f*1.4426950408889634f;
__device__ __forceinline__ void glds16(const void*gsrc,unsigned lds_dst){unsigned keep;
  asm volatile("s_mov_b32 %0, m0\n\ts_mov_b32 m0, %2\n\ts_nop 0\n\tglobal_load_lds_dwordx4 %1, off\n\ts_mov_b32 m0, %0":"=&s"(keep):"v"(gsrc),"s"(lds_dst):"memory");}
__device__ __forceinline__ float max3f(float a,float b,float c){float r;asm("v_max3_f32 %0, %1, %2, %3":"=v"(r):"v"(a),"v"(b),"v"(c));return r;}
__device__ __forceinline__ float max2f(float a,float b){float r;asm("v_max_f32_e32 %0, %1, %2":"=v"(r):"v"(a),"v"(b));return r;}
__device__ __forceinline__ float fadd_s(float a,float b){float r;asm("v_add_f32_e32 %0, %1, %2":"=v"(r):"v"(a),"v"(b));return r;}
__device__ __forceinline__ float fsub_s(float a,float b){float r;asm("v_sub_f32_e32 %0, %1, %2":"=v"(r):"v"(a),"v"(b));return r;}
typedef float f32x2_t __attribute__((ext_vector_type(2))); typedef __bf16 bf16x2_t __attribute__((ext_vector_type(2)));
__device__ __forceinline__ unsigned cvtpk_s(float lo,float hi){f32x2_t v={lo,hi};bf16x2_t b=__builtin_convertvector(v,bf16x2_t);return __builtin_bit_cast(unsigned,b);}
#define WAIT_BAR(N) asm volatile("s_waitcnt vmcnt(" #N ") lgkmcnt(0)\n\ts_barrier":::"memory")

__device__ __forceinline__ void qkt(f32x16&p0,f32x16&p1,const char*Kslot,const bf16x8*qr,const f32x16&negm,int r32,int hi){
  const char*kb=Kslot+hi*1024+r32*16;
  #pragma unroll
  for(int d0=0;d0<4;++d0){
    const bf16x8 b0=*reinterpret_cast<const bf16x8*>(kb+d0*2048);
    const bf16x8 b1=*reinterpret_cast<const bf16x8*>(kb+d0*2048+512);
    if(d0==0){p0=__builtin_amdgcn_mfma_f32_32x32x16_bf16(b0,qr[0],negm,0,0,0);p1=__builtin_amdgcn_mfma_f32_32x32x16_bf16(b1,qr[0],negm,0,0,0);}
    else{p0=__builtin_amdgcn_mfma_f32_32x32x16_bf16(b0,qr[d0],p0,0,0,0);p1=__builtin_amdgcn_mfma_f32_32x32x16_bf16(b1,qr[d0],p1,0,0,0);}}
}
typedef __attribute__((address_space(3))) const char* lds_cptr;
typedef short v4i16_t __attribute__((ext_vector_type(4)));
__device__ __forceinline__ void kload8(bf16x8*kf,lds_cptr kp){
  kf[0]=*(const __attribute__((address_space(3))) bf16x8*)(kp);      kf[1]=*(const __attribute__((address_space(3))) bf16x8*)(kp+512);
  kf[2]=*(const __attribute__((address_space(3))) bf16x8*)(kp+2048); kf[3]=*(const __attribute__((address_space(3))) bf16x8*)(kp+2560);
  kf[4]=*(const __attribute__((address_space(3))) bf16x8*)(kp+4096); kf[5]=*(const __attribute__((address_space(3))) bf16x8*)(kp+4608);
  kf[6]=*(const __attribute__((address_space(3))) bf16x8*)(kp+6144); kf[7]=*(const __attribute__((address_space(3))) bf16x8*)(kp+6656);
}
__device__ __forceinline__ void kload2(bf16x8*kf,lds_cptr kp,int j){ kf[2*j]=*(const __attribute__((address_space(3))) bf16x8*)(kp+j*2048); kf[2*j+1]=*(const __attribute__((address_space(3))) bf16x8*)(kp+j*2048+512); }
__device__ __forceinline__ s16x4 vtr(lds_cptr p){ return __builtin_bit_cast(s16x4,__builtin_amdgcn_ds_read_tr16_b64_v4i16((__attribute__((address_space(3))) v4i16_t*)p)); }
__device__ __forceinline__ float rowmax(const f32x16&p0,const f32x16&p1){
  float a=max3f(p0[0],p0[1],p1[0]),b=max3f(p0[2],p0[3],p1[1]);a=max3f(a,p1[2],p1[3]);
  #pragma unroll
  for(int r=4;r<16;r+=4){a=max3f(a,p0[r],p0[r+1]);b=max3f(b,p0[r+2],p0[r+3]);a=max3f(a,p1[r],p1[r+1]);b=max3f(b,p1[r+2],p1[r+3]);}
  const float m=max2f(a,b);
  auto rr=__builtin_amdgcn_permlane32_swap(__float_as_uint(m),__float_as_uint(m),false,false);
  return max2f(__uint_as_float(rr[0]),__uint_as_float(rr[1]));
}
__device__ __forceinline__ void pv(f32x16*o,int vb,bf16x8 pa0,bf16x8 pa1,bf16x8 pa2,bf16x8 pa3){
  #pragma unroll
  for(int d0=0;d0<2;++d0){s16x4 lo[4],hi[4];
    #pragma unroll
    for(int ks=0;ks<4;++ks){
      asm volatile("ds_read_b64_tr_b16 %0,%1 offset:%c2":"=&v"(lo[ks]):"v"(vb),"i"(d0*4096+ks*1024):"memory");
      asm volatile("ds_read_b64_tr_b16 %0,%1 offset:%c2":"=&v"(hi[ks]):"v"(vb),"i"(d0*4096+ks*1024+512):"memory");}
    asm volatile("s_waitcnt lgkmcnt(0)":::"memory");SBAR();
    #define PK(k) (bf16x8){lo[k][0],lo[k][1],lo[k][2],lo[k][3],hi[k][0],hi[k][1],hi[k][2],hi[k][3]}
    o[d0]=__builtin_amdgcn_mfma_f32_32x32x16_bf16(pa0,PK(0),o[d0],0,0,0);
    o[d0]=__builtin_amdgcn_mfma_f32_32x32x16_bf16(pa1,PK(1),o[d0],0,0,0);
    o[d0]=__builtin_amdgcn_mfma_f32_32x32x16_bf16(pa2,PK(2),o[d0],0,0,0);
    o[d0]=__builtin_amdgcn_mfma_f32_32x32x16_bf16(pa3,PK(3),o[d0],0,0,0);
    #undef PK
  }
}

#ifndef ATTN_STORE16
#define ATTN_STORE16(p,v) (*(u32x4*)(p)=(v))
#endif
template<int THRL> __device__ __forceinline__ void attn_unit(int b,int h,long qrow0,int NTarg,const bf16*Q,const bf16*__restrict__ K,const bf16*__restrict__ V,bf16*O,char*shm){
  int tid_=threadIdx.x; asm volatile("":"+v"(tid_)); const int tid=tid_,lane=tid&63,r32=lane&31,hi=lane>>5; const int wid=__builtin_amdgcn_readfirstlane(tid>>6);
  const long krowbase=(long)b*SEQK; const int kvh=h>>2;
  const bf16*Qw=Q+(qrow0+wid*QBLK)*QP+h*D;
  const bf16*Kh=K+krowbase*KP+kvh*D,*Vh=V+krowbase*KP+kvh*D;
  const unsigned lds0=(unsigned)(uintptr_t)shm;
  float*wsf=(float*)(shm+LDS_WS)+wid*64;
  const bf16*ksrc=Kh+(long)lane*KP+wid*8;
  const bf16*vsrc=Vh+(long)(16*(wid&3)+(lane>>2))*KP+(wid>>2)*32+(lane&3)*8;
  const unsigned kdst=lds0+LDS_K+wid*1024, vdst=lds0+LDS_V+wid*1024;
  #define DMA_K(t,slot) glds16(ksrc+(long)(t)*KVBLK*KP,(unsigned)__builtin_amdgcn_readfirstlane(kdst+(slot)))
  #define DMA_V(t,slot) glds16(vsrc+(long)(t)*KVBLK*KP,(unsigned)__builtin_amdgcn_readfirstlane(vdst+(slot)))
  const int vb0=(int)(lds0+LDS_V)+((lane>>4)&1)*32+(lane&3)*8+(4*hi+((lane&15)>>2))*64;
  const char*Kbase=shm+LDS_K; bf16x8 kf[8];
  const lds_cptr shm3=(lds_cptr)shm; const lds_cptr kp0=shm3+LDS_K+hi*1024+r32*16; const lds_cptr vp0=shm3+LDS_V+((lane>>4)&1)*32+(lane&3)*8+(4*hi+((lane&15)>>2))*64;
  const int NT=NTarg;
  DMA_K(0,0);DMA_V(0,0);DMA_K(1,SLOTB);
  bf16x8 qr[4];
  #pragma unroll
  for(int d0=0;d0<4;++d0)qr[d0]=*reinterpret_cast<const bf16x8*>(&Qw[(long)r32*QP+d0*16+hi*8]);
  float mhat=0.f,l_reg=0.f;f32x16 o[2];o[0]=f32x16{};o[1]=f32x16{};f32x16 negm=f32x16{};asm volatile("":"+v"(negm));
  const int qrel=wid*QBLK+r32;
  #define CMASK(P0,P1,t) do{}while(0)
  bool resc=false;
  #define START(P0,P1) do{ const float rm=rowmax(P0,P1); resc=false; \
    { const float dl=rm; mhat=fadd_s(mhat,dl); \
      _Pragma("unroll") for(int r=0;r<16;++r){P0[r]=fsub_s(P0[r],dl);P1[r]=fsub_s(P1[r],dl);} \
      _Pragma("unroll") for(int r=0;r<16;++r)negm[r]=-mhat; asm volatile("":"+v"(negm)); } \
    _Pragma("unroll") for(int r=0;r<16;++r)P0[r]=__builtin_amdgcn_exp2f(P0[r]); }while(0)
  #define RESC() do{ if(resc){ asm volatile("s_waitcnt lgkmcnt(0)":::"memory"); \
      _Pragma("unroll") for(int d_=0;d_<2;++d_) _Pragma("unroll") for(int r=0;r<16;++r)o[d_][r]*=wsf[crow(r,hi)]; } }while(0)
  f32x16 pA0,pA1,pB0,pB1;
  int sl_prev=0,sl_cur=0,sl_next=SLOTB;
  #define ROT() do{sl_prev=sl_cur;sl_cur=sl_next;sl_next=(sl_next==(NSLOT-1)*SLOTB)?0:sl_next+SLOTB;}while(0)
  DMA_K(2,2*SLOTB);
  WAIT_BAR(3);
  qkt(pA0,pA1,Kbase,qr,negm,r32,hi);asm volatile("s_nop 15\n\ts_nop 7":"+v"(pA0),"+v"(pA1));CMASK(pA0,pA1,0);
  START(pA0,pA1);
  _Pragma("unroll") for(int r=0;r<16;++r)pA1[r]=__builtin_amdgcn_exp2f(pA1[r]);
  WAIT_BAR(0);
  DMA_K(3,0);DMA_V(1,SLOTB);
  ROT();
  kload8(kf,kp0+sl_cur);
  WAIT_BAR(2);
  s16x4 vlo[8],vhi[8]; u32x4 pw0,pw1,pw2,pw3;
  #define PKW(P,B) cvtpk_s(P[B],P[B+1])
  #define PAF(k) __builtin_bit_cast(bf16x8,pw##k)
  #define VFR(i) (bf16x8){vlo[i][0],vlo[i][1],vlo[i][2],vlo[i][3],vhi[i][0],vhi[i][1],vhi[i][2],vhi[i][3]}
  #define PIN(x) asm volatile("":"+v"(x))
  #define MX3(a,b,c) __builtin_fmaxf(__builtin_fmaxf((a),(b)),(c))
  #define GAPA(MF,A0,A1,A2,A3,W0,W1,PW) do{ MF; sacc+=A0; sacc+=A1; sacc+=A2; sacc+=A3; PIN(sacc); W0; W1; PIN(PW); SBAR(); }while(0)
  #define EX(v) __builtin_amdgcn_exp2f(v)
  #define GAPB(MF,X,B) do{ MF; X[B]=EX(X[B]); X[B+1]=EX(X[B+1]); X[B+2]=EX(X[B+2]); X[B+3]=EX(X[B+3]); PIN(X); SBAR(); }while(0)
  #define VRD(i) do{ vlo[i]=vtr(vp_+(((i)>>2)*4096+((i)&3)*1024)); vhi[i]=vtr(vp_+(((i)>>2)*4096+((i)&3)*1024+512)); }while(0)
  #define KRD(G,j) do{ if(G){ kload2(kf,kp0+sl_next,j); SBAR(); } }while(0)
  #define STEP(C0,C1,P0,P1,t,GK,GV,GL) do{ SBAR(); \
    const lds_cptr vp_=vp0+sl_prev; \
    VRD(0); SBAR(); float sacc=(P0[0]+P0[1]); \
    GAPA(C0=__builtin_amdgcn_mfma_f32_32x32x16_bf16(kf[0],qr[0],negm,0,0,0), P0[2],P0[3],P0[4],P0[5],     pw0[0]=PKW(P0,0), pw0[1]=PKW(P0,2), pw0); \
    VRD(4); SBAR(); GAPA(C1=__builtin_amdgcn_mfma_f32_32x32x16_bf16(kf[1],qr[0],negm,0,0,0), P0[6],P0[7],P0[8],P0[9],     pw0[2]=PKW(P0,4), pw0[3]=PKW(P0,6), pw0); \
    VRD(1); SBAR(); GAPA(C0=__builtin_amdgcn_mfma_f32_32x32x16_bf16(kf[2],qr[1],C0,0,0,0),   P0[10],P0[11],P0[12],P0[13], pw1[0]=PKW(P0,8), pw1[1]=PKW(P0,10), pw1); \
    VRD(5); SBAR(); GAPA(C1=__builtin_amdgcn_mfma_f32_32x32x16_bf16(kf[3],qr[1],C1,0,0,0),   P0[14],P0[15],P1[0],P1[1],   pw1[2]=PKW(P0,12),pw1[3]=PKW(P0,14), pw1); \
    VRD(2); SBAR(); GAPA(C0=__builtin_amdgcn_mfma_f32_32x32x16_bf16(kf[4],qr[2],C0,0,0,0),   P1[2],P1[3],P1[4],P1[5],     pw2[0]=PKW(P1,0), pw2[1]=PKW(P1,2), pw2); \
    VRD(6); SBAR(); GAPA(C1=__builtin_amdgcn_mfma_f32_32x32x16_bf16(kf[5],qr[2],C1,0,0,0),   P1[6],P1[7],P1[8],P1[9],     pw2[2]=PKW(P1,4), pw2[3]=PKW(P1,6), pw2); \
    VRD(3); SBAR(); GAPA(C0=__builtin_amdgcn_mfma_f32_32x32x16_bf16(kf[6],qr[3],C0,0,0,0),   P1[10],P1[11],P1[12],P1[13], pw3[0]=PKW(P1,8), pw3[1]=PKW(P1,10), pw3); \
    VRD(7); SBAR(); GAPA(C1=__builtin_amdgcn_mfma_f32_32x32x16_bf16(kf[7],qr[3],C1,0,0,0),   P1[14],P1[15],0.f,0.f,       pw3[2]=PKW(P1,12),pw3[3]=PKW(P1,14), pw3); \
    l_reg+=sacc; \
    if(GK){DMA_K((t)+3,sl_cur);} if(GV){DMA_V((t)+1,sl_next);} \
    CMASK(C0,C1,t); \
    { float a=MX3(C0[0],C0[1],C1[0]),b=MX3(C0[2],C0[3],C1[1]); a=MX3(a,C1[2],C1[3]); \
      _Pragma("unroll") for(int r=4;r<16;r+=4){a=MX3(a,C0[r],C0[r+1]);b=MX3(b,C0[r+2],C0[r+3]);a=MX3(a,C1[r],C1[r+1]);b=MX3(b,C1[r+2],C1[r+3]);} \
      float rm=__builtin_fmaxf(a,b); { auto rr=__builtin_amdgcn_permlane32_swap(__float_as_uint(rm),__float_as_uint(rm),false,false); rm=__builtin_fmaxf(__uint_as_float(rr[0]),__uint_as_float(rr[1])); } \
      resc=false; \
      if(__builtin_expect(__any(rm>(float)THRL),0)){ const float dl=__builtin_fmaxf(rm,0.f); mhat+=dl; \
        _Pragma("unroll") for(int r=0;r<16;++r){C0[r]-=dl;C1[r]-=dl;} \
        _Pragma("unroll") for(int r=0;r<16;++r)negm[r]=-mhat; asm volatile("":"+v"(negm)); \
        const float f=__builtin_amdgcn_exp2f(-dl); l_reg*=f; if(hi==0)wsf[r32]=f; resc=true; } } \
    SBAR(); \
    GAPB(o[0]=__builtin_amdgcn_mfma_f32_32x32x16_bf16(PAF(0),VFR(0),o[0],0,0,0), C0,0); \
    GAPB(o[1]=__builtin_amdgcn_mfma_f32_32x32x16_bf16(PAF(0),VFR(4),o[1],0,0,0), C0,4); \
    KRD(GL,0); GAPB(o[0]=__builtin_amdgcn_mfma_f32_32x32x16_bf16(PAF(1),VFR(1),o[0],0,0,0), C0,8); \
    KRD(GL,1); GAPB(o[1]=__builtin_amdgcn_mfma_f32_32x32x16_bf16(PAF(1),VFR(5),o[1],0,0,0), C0,12); \
    KRD(GL,2); GAPB(o[0]=__builtin_amdgcn_mfma_f32_32x32x16_bf16(PAF(2),VFR(2),o[0],0,0,0), C1,0); \
    KRD(GL,3); GAPB(o[1]=__builtin_amdgcn_mfma_f32_32x32x16_bf16(PAF(2),VFR(6),o[1],0,0,0), C1,4); \
    GAPB(o[0]=__builtin_amdgcn_mfma_f32_32x32x16_bf16(PAF(3),VFR(3),o[0],0,0,0), C1,8); \
    GAPB(o[1]=__builtin_amdgcn_mfma_f32_32x32x16_bf16(PAF(3),VFR(7),o[1],0,0,0), C1,12); \
    }while(0)
  int t=1;
  #undef CMASK
  #define CMASK(P0,P1,t) do{}while(0)
  for(;t+5<NT;t+=2){
    STEP(pB0,pB1,pA0,pA1,t,true,true,true);     WAIT_BAR(2); RESC(); ROT();
    STEP(pA0,pA1,pB0,pB1,t+1,true,true,true);   WAIT_BAR(2); RESC(); ROT();
  }
  #undef CMASK
  #define CMASK(P0,P1,t) do{}while(0)
  #define ENDW(tt) do{ if((tt)+3<NT){WAIT_BAR(2);} else if((tt)+2<NT){WAIT_BAR(1);} else {WAIT_BAR(0);} }while(0)
  for(;t+1<NT;t+=2){
    STEP(pB0,pB1,pA0,pA1,t,(t+3<NT),(t+1<NT),(t+1<NT));       ENDW(t);   RESC(); ROT();
    STEP(pA0,pA1,pB0,pB1,t+1,(t+4<NT),(t+2<NT),(t+2<NT));     ENDW(t+1); RESC(); ROT();
  }
  STEP(pB0,pB1,pA0,pA1,NT-1,false,false,false); RESC();
  { float sacc=pB0[0]+pB0[1]; _Pragma("unroll") for(int r=2;r<16;++r)sacc+=pB0[r]; _Pragma("unroll") for(int r=0;r<16;++r)sacc+=pB1[r]; l_reg+=sacc;
    pw0=(u32x4){PKW(pB0,0),PKW(pB0,2),PKW(pB0,4),PKW(pB0,6)};pw1=(u32x4){PKW(pB0,8),PKW(pB0,10),PKW(pB0,12),PKW(pB0,14)};pw2=(u32x4){PKW(pB1,0),PKW(pB1,2),PKW(pB1,4),PKW(pB1,6)};pw3=(u32x4){PKW(pB1,8),PKW(pB1,10),PKW(pB1,12),PKW(pB1,14)};
    SBAR(); pv(o,vb0+sl_cur,PAF(0),PAF(1),PAF(2),PAF(3)); }
  #undef PKW
  #undef PAF
  #undef VFR
  #undef PIN
  #undef MX3
  #undef GAPA
  #undef GAPB
  #undef EX
  #undef VRD
  #undef KRD
  #undef STEP
  #undef ENDW
  {auto rr=__builtin_amdgcn_permlane32_swap(__float_as_uint(l_reg),__float_as_uint(l_reg),false,false);l_reg=__uint_as_float(rr[0])+__uint_as_float(rr[1]);}
  if(hi==0)wsf[32+r32]=l_reg;asm volatile("s_waitcnt lgkmcnt(0)":::"memory");
  float rli[16];
  #pragma unroll
  for(int r=0;r<16;++r)rli[r]=__builtin_amdgcn_rcpf(wsf[32+crow(r,hi)]);
  bf16*Ow=O+(qrow0+wid*QBLK)*QP+h*D;
  { bf16*stg=(bf16*)(shm+LDS_OST)+wid*2048;
    #pragma unroll
    for(int r=0;r<16;++r){const int orow=crow(r,hi);
      #pragma unroll
      for(int d0=0;d0<2;++d0)stg[orow*64+d0*32+r32]=__float2bfloat16(o[d0][r]*rli[r]);}
    asm volatile("s_waitcnt lgkmcnt(0)":::"memory");
    #pragma unroll
    for(int i=0;i<4;++i){const int row=i*8+(lane>>3),ch=lane&7; const u32x4 v=*(const u32x4*)(stg+row*64+ch*8); ATTN_STORE16(Ow+(long)row*QP+ch*8,v);} }
  asm volatile("s_waitcnt lgkmcnt(0)\n\ts_barrier":::"memory");
  #undef DMA_K
  #undef DMA_V
  #undef CMASK
  #undef START
  #undef RESC
  #undef ROT
}
constexpr int ATTN_LDS_BYTES=LDS_BYTES;
struct AttnTensors { const bf16* Q; const bf16* K; const bf16* V; bf16* O; };
template<int THRL=8> __device__ __forceinline__ void attn_phase(char*lds,const AttnTensors&T,int G,int vcu,bool with_ctx,long ctx_row0){
  const int total=4*NHEAD*NQB;
  for(int i=0;;++i){
    int x,n;
    if(G==256){ if(i>=4)break; x=vcu>>5; n=i*32+(vcu&31); }
    else { const int u=i*G+vcu; if(u>=total)break; x=u>>7; n=u&127; }
    const int b=x>>1,kvh=x&1,h=kvh*4+(n>>5),qb=n&31;
    attn_unit<THRL>(b,h,(long)b*SEQQ+(long)qb*QB,SEQK/KVBLK,T.Q,T.K,T.V,T.O,lds);
  }
  if(with_ctx){
    for(int u=vcu;u<4*NHEAD;u+=G){ const int b=u>>3,h=u&7; attn_unit<THRL>(b,h,ctx_row0+(long)b*256,4,T.Q,T.K,T.V,T.O,lds); }
  }
}
#undef SBAR
#undef WAIT_BAR
}

constexpr int NWAVES = 8, NTHR = 512;
constexpr int DMODEL = 1024, NB = 4, SEQ = 8192, CTXL = 256, NLAT = NB * SEQ, NCTX = NB * CTXL, MT = NLAT + NCTX;
constexpr int INW = 2048, NE = 32, KEYS = SEQ + CTXL;
constexpr int SORT_TILES = 560, SORT_ROWS = SORT_TILES * 256;
constexpr float EPSN = 1e-6f;
constexpr int NCHUNK = 66, CHUNK = 128;
constexpr int NPH_PRO = 3, NPH_LAYER = 14, NPH = NPH_PRO + 2 * NPH_LAYER;

constexpr size_t MiB = 1u << 20;
constexpr size_t WS_CTL = 0, CTL_ZERO_BYTES = 1 * MiB;
constexpr size_t WS_MOD = 1 * MiB, WS_ROPEC = 2 * MiB, WS_ROPES = 3 * MiB, WS_H2 = 4 * MiB, WS_KFC = 10 * MiB, WS_BLKCNT = 12 * MiB, WS_TILEE = 13 * MiB, WS_SCANS = 14 * MiB;
constexpr size_t WS_WINT = 16 * MiB, WS_WOUTT = 24 * MiB, WS_W1T = 32 * MiB, WS_W2T = 288 * MiB, WS_KF = 416 * MiB, WS_KHAT = 448 * MiB, WS_XR = 512 * MiB, WS_H = 644 * MiB;
constexpr size_t WS_U = 712 * MiB, WS_Q = 844 * MiB, WS_K = 877 * MiB, WS_V = 886 * MiB, WS_ATT = 895 * MiB, WS_LAB = 928 * MiB, WS_LRUO = 1060 * MiB, WS_VT = 1093 * MiB, WS_X0T = 1125 * MiB,
                 WS_HYO = 1157 * MiB, WS_MIXA = 1190 * MiB;
constexpr size_t WS_F = 712 * MiB, WS_ASORT = 778 * MiB, WS_ACT = 1058 * MiB, WS_YS = 1338 * MiB, WS_TOPI = 1618 * MiB, WS_GATE = 1619 * MiB, WS_POS = 1620 * MiB, WS_END = 1622 * MiB;
constexpr size_t LAB_STRIDE = (size_t)MT * 256;
constexpr int CW_BAR = 4096;
constexpr int CW_NTILES = 64;

constexpr int RING_OFF = 0, RING_BYTES = 131072, MOETAB_OFF = 131072, LDSCTL_OFF = 155648, LDS_BYTES = 156160;

#define GAS __attribute__((address_space(1)))
#define LAS __attribute__((address_space(3)))
typedef unsigned short bf16;
typedef unsigned v4u __attribute__((ext_vector_type(4)));
typedef unsigned v2u __attribute__((ext_vector_type(2)));
typedef float f32x4 __attribute__((ext_vector_type(4)));
#define LDS_WAIT() asm volatile("s_waitcnt lgkmcnt(0)" ::: "memory")
#define VM_WAIT() asm volatile("s_waitcnt vmcnt(0)" ::: "memory")
__device__ __forceinline__ unsigned f2bf(float f) { unsigned u = __builtin_bit_cast(unsigned, f); return (u + 0x7fffu + ((u >> 16) & 1u)) >> 16; }
__device__ __forceinline__ unsigned pk2(float lo, float hi) { return f2bf(lo) | (f2bf(hi) << 16); }
__device__ __forceinline__ float bf2f(unsigned short b) { return __builtin_bit_cast(float, (unsigned)b << 16); }
__device__ __forceinline__ float bflo(unsigned w) { return __builtin_bit_cast(float, w << 16); }
__device__ __forceinline__ float bfhi(unsigned w) { return __builtin_bit_cast(float, w & 0xffff0000u); }
__device__ __forceinline__ float wave_sum(float v) {
#pragma unroll
    for (int o = 1; o < 64; o <<= 1) v += __shfl_xor(v, o);
    return v;
}
__device__ __forceinline__ float sigmoidf_(float x) { return 1.0f / (1.0f + __expf(-x)); }
__device__ __forceinline__ void sincos_d(double x, double& s, double& c) {
    const double kd = __builtin_rint(x * 0.63661977236758134308);
    const int k = (int)kd;
    double r = __builtin_fma(-kd, 1.57079632673412561417e+00, x);
    r = __builtin_fma(-kd, 6.07710050650619224932e-11, r);
    const double z = r * r;
    const double ps = r + r * z * (-1.66666666666666324348e-01 + z * (8.33333333332248946124e-03 + z * (-1.98412698298579493134e-04 + z * (2.75573137070700676789e-06 + z * (-2.50507602534068634195e-08 + z * 1.58969099521155010221e-10)))));
    const double pc = 1.0 - 0.5 * z + z * z * (4.16666666666666019037e-02 + z * (-1.38888888888741095749e-03 + z * (2.48015872894767294178e-05 + z * (-2.75573143513906633035e-07 + z * (2.08757232129817482790e-09 + z * -1.13596475577881948265e-11)))));
    const int q = k & 3;
    s = (q == 0) ? ps : (q == 1) ? pc : (q == 2) ? -ps : -pc;
    c = (q == 0) ? pc : (q == 1) ? -ps : (q == 2) ? -pc : ps;
}
__device__ __forceinline__ float gelu_tanh(float x) {
    const float u = 0.7978845608028654f * (x + 0.044715f * x * x * x);
    const float t = 1.0f - 2.0f / (1.0f + __expf(2.0f * u));
    return 0.5f * x * (1.0f + t);
}
__device__ __forceinline__ int lds_add(LAS int* p, int v) { return __hip_atomic_fetch_add(p, v, __ATOMIC_RELAXED, __HIP_MEMORY_SCOPE_WORKGROUP); }

#define FFT_FN __device__ __forceinline__
typedef float f32x2v __attribute__((ext_vector_type(2)));
#define FFT_VEC2 f32x2v
#define FFT_DPTR LAS f32x2v*
#define FFT_LD(D, i) c32_from((D)[i])
#define FFT_ST(D, i, v) ((D)[i] = c32_to(v))
struct __attribute__((aligned(8))) c32 { float x, y; };
FFT_FN c32 cmul(c32 a, c32 b) { c32 r; r.x = a.x * b.x - a.y * b.y; r.y = a.x * b.y + a.y * b.x; return r; }
FFT_FN c32 cadd(c32 a, c32 b) { c32 r; r.x = a.x + b.x; r.y = a.y + b.y; return r; }
FFT_FN c32 csub(c32 a, c32 b) { c32 r; r.x = a.x - b.x; r.y = a.y - b.y; return r; }
FFT_FN c32 cmuli_neg(c32 a) { c32 r; r.x = a.y; r.y = -a.x; return r; }
FFT_FN int fpad(int a) { return a + (a >> 4); }
#ifdef FFT_VEC2
FFT_FN c32 c32_from(FFT_VEC2 t) { c32 r; r.x = t.x; r.y = t.y; return r; }
FFT_FN FFT_VEC2 c32_to(c32 a) { FFT_VEC2 t; t.x = a.x; t.y = a.y; return t; }
#endif
FFT_FN void dft4(c32& a0, c32& a1, c32& a2, c32& a3) {
    const c32 s02 = cadd(a0, a2), d02 = csub(a0, a2), s13 = cadd(a1, a3), d13 = cmuli_neg(csub(a1, a3));
    a0 = cadd(s02, s13); a2 = csub(s02, s13); a1 = cadd(d02, d13); a3 = csub(d02, d13);
}
FFT_FN void dft16(c32 (&v)[16]) {
    const float C1 = 0.92387953251128674f, S1 = 0.38268343236508977f, C2 = 0.70710678118654752f;
#pragma unroll
    for (int q2 = 0; q2 < 4; ++q2) dft4(v[q2], v[4 + q2], v[8 + q2], v[12 + q2]);
    { c32 w;
      w.x = C1; w.y = -S1; v[4 * 1 + 1] = cmul(v[4 * 1 + 1], w);
      w.x = C2; w.y = -C2; v[4 * 2 + 1] = cmul(v[4 * 2 + 1], w);
      w.x = S1; w.y = -C1; v[4 * 3 + 1] = cmul(v[4 * 3 + 1], w);
      w.x = C2; w.y = -C2; v[4 * 1 + 2] = cmul(v[4 * 1 + 2], w);
      v[4 * 2 + 2] = cmuli_neg(v[4 * 2 + 2]);
      w.x = -C2; w.y = -C2; v[4 * 3 + 2] = cmul(v[4 * 3 + 2], w);
      w.x = S1; w.y = -C1; v[4 * 1 + 3] = cmul(v[4 * 1 + 3], w);
      w.x = -C2; w.y = -C2; v[4 * 2 + 3] = cmul(v[4 * 2 + 3], w);
      w.x = -C1; w.y = S1; v[4 * 3 + 3] = cmul(v[4 * 3 + 3], w); }
#pragma unroll
    for (int p1 = 0; p1 < 4; ++p1) dft4(v[4 * p1 + 0], v[4 * p1 + 1], v[4 * p1 + 2], v[4 * p1 + 3]);
#pragma unroll
    for (int a = 0; a < 4; ++a)
#pragma unroll
        for (int b = a + 1; b < 4; ++b) { const c32 t = v[4 * a + b]; v[4 * a + b] = v[4 * b + a]; v[4 * b + a] = t; }
}
FFT_FN c32 twid(int j, int n) { double s, c; sincos_d(-6.283185307179586476925 * (double)j / (double)n, s, c); c32 w; w.x = (float)c; w.y = (float)s; return w; }

FFT_FN void fft_fwd16(FFT_DPTR D, int g, int n) {
    const int s = n >> 4, blk = g / s, j = g - blk * s, base = blk * n + j;
    c32 v[16];
#pragma unroll
    for (int q = 0; q < 16; ++q) v[q] = FFT_LD(D, fpad(base + q * s));
    dft16(v);
    const c32 w = twid(j, n); c32 wp = w;
#pragma unroll
    for (int p = 1; p < 16; ++p) { v[p] = cmul(v[p], wp); wp = cmul(wp, w); }
#pragma unroll
    for (int p = 0; p < 16; ++p) FFT_ST(D, fpad(base + p * s), v[p]);
}
FFT_FN void fft_inv16(FFT_DPTR D, int g, int n) {
    const int s = n >> 4, blk = g / s, j = g - blk * s, base = blk * n + j;
    c32 v[16];
#pragma unroll
    for (int q = 0; q < 16; ++q) v[q] = FFT_LD(D, fpad(base + q * s));
    const c32 w = twid(j, n); c32 wp = w;
#pragma unroll
    for (int p = 1; p < 16; ++p) { v[p] = cmul(v[p], wp); wp = cmul(wp, w); }
    dft16(v);
#pragma unroll
    for (int p = 0; p < 16; ++p) FFT_ST(D, fpad(base + p * s), v[p]);
}
FFT_FN void fft_mid16(FFT_DPTR D, int g, const c32* KH) {
    c32 v[16];
#pragma unroll
    for (int q = 0; q < 16; ++q) v[q] = FFT_LD(D, 17 * g + q);
    dft16(v);
#pragma unroll
    for (int p = 0; p < 16; ++p) { const c32 k = KH[16 * g + p]; const c32 t = cmul(v[p], k); v[p].x = t.x; v[p].y = -t.y; }
    dft16(v);
#pragma unroll
    for (int p = 0; p < 16; ++p) FFT_ST(D, 17 * g + p, v[p]);
}
FFT_FN void fft_last16_out(FFT_DPTR D, int g, c32* OUT, float scale) {
    c32 v[16];
#pragma unroll
    for (int q = 0; q < 16; ++q) v[q] = FFT_LD(D, 17 * g + q);
    dft16(v);
#pragma unroll
    for (int p = 0; p < 16; ++p) { c32 t; t.x = v[p].x * scale; t.y = v[p].y * scale; OUT[16 * g + p] = t; }
}
FFT_FN void fft_first4(FFT_DPTR D, int j, c32 x0, c32 x1, c32 x2, c32 x3) {
    dft4(x0, x1, x2, x3);
    const c32 w = twid(j, 16384), w2 = cmul(w, w), w3 = cmul(w2, w);
    FFT_ST(D, fpad(j), x0); FFT_ST(D, fpad(j + 4096), cmul(x1, w)); FFT_ST(D, fpad(j + 8192), cmul(x2, w2)); FFT_ST(D, fpad(j + 12288), cmul(x3, w3));
}
FFT_FN void fft_final4(FFT_DPTR D, int j, c32& u0, c32& u1) {
    const c32 w = twid(j, 16384), w2 = cmul(w, w), w3 = cmul(w2, w);
    c32 a0 = FFT_LD(D, fpad(j)), a1 = cmul(FFT_LD(D, fpad(j + 4096)), w), a2 = cmul(FFT_LD(D, fpad(j + 8192)), w2), a3 = cmul(FFT_LD(D, fpad(j + 12288)), w3);
    dft4(a0, a1, a2, a3);
    u0 = a0; u1 = a1;
}
#define XB_TMO      128
#define XB_XCNT(j)  (256  + 64 * (j))
#define XB_XSUB(j)  (1280 + 64 * (j))
#define XB_XGEN(j)  (2304 + 64 * (j))
#define XB_TOP      3328
#define XB_TOPGEN   3392
#define XCD_BAR_WORDS 3456
#define XB_SPIN_CAP (1u << 22)

__device__ __forceinline__ unsigned xb_ld(unsigned* p)              { return __hip_atomic_load(p, __ATOMIC_RELAXED, __HIP_MEMORY_SCOPE_AGENT); }
__device__ __forceinline__ unsigned xb_add(unsigned* p, unsigned v) { return __hip_atomic_fetch_add(p, v, __ATOMIC_RELAXED, __HIP_MEMORY_SCOPE_AGENT); }
__device__ __forceinline__ unsigned xb_xcc_id() { return (unsigned)__builtin_amdgcn_s_getreg((3 << 11) | 20) & 0xFu; }
#define XB_SPIN(cond, bar) do { unsigned _sp = 0; while (cond) { __builtin_amdgcn_s_sleep(1); \
    if ((++_sp & 255u) == 0u) { if (xb_ld(&(bar)[XB_TMO])) break; if (_sp > XB_SPIN_CAP) { atomicAdd(&(bar)[XB_TMO], 1u); break; } } } } while (0)

struct XcdBarrier {
    unsigned* bar; unsigned x;
    volatile LAS unsigned* st;
};

__device__ __forceinline__ XcdBarrier xcd_barrier_post(unsigned* bar, volatile LAS unsigned* st) {
    XcdBarrier b; b.bar = bar; b.x = xb_xcc_id(); b.st = st;
    if (threadIdx.x == 0) (void)xb_add(&bar[XB_XCNT(b.x)], 1u);
    return b;
}
__device__ __forceinline__ void xcd_barrier_complete(unsigned* bar, unsigned x, unsigned& nloc, unsigned& nx) {
    const unsigned G = gridDim.x * gridDim.y * gridDim.z;
    unsigned sum, cnt, mine, sp = 0u;
    for (;;) {
        sum = 0u; cnt = 0u; mine = 0u;
#pragma unroll
        for (unsigned j = 0; j < 16; ++j) { const unsigned c = xb_ld(&bar[XB_XCNT(j)]); sum += c; cnt += (c > 0u) ? 1u : 0u; mine = (j == x) ? c : mine; }
        if (sum == G) break;
        __builtin_amdgcn_s_sleep(1);
        if ((++sp & 255u) == 0u) { if (xb_ld(&bar[XB_TMO])) break; if (sp > XB_SPIN_CAP) { atomicAdd(&bar[XB_TMO], 1u); break; } }
    }
    nloc = mine > 0u ? mine : 1u; nx = cnt > 0u ? cnt : 1u;
}

__device__ __forceinline__ void xcd_barrier(const XcdBarrier& b) {
    asm volatile("s_waitcnt vmcnt(0)" ::: "memory");
    __syncthreads();
    if (threadIdx.x == 0) {
        unsigned* bar = b.bar;
        __builtin_amdgcn_s_waitcnt(0);
        unsigned nloc = b.st[0], nx = b.st[1];
        if (nloc == 0u) { xcd_barrier_complete(bar, b.x, nloc, nx); b.st[0] = nloc; b.st[1] = nx; }
        const unsigned old = xb_add(&bar[XB_XSUB(b.x)], 1u);
        const unsigned gen = old / nloc;
        if (old + 1u == (gen + 1u) * nloc) {
            __builtin_amdgcn_fence(__ATOMIC_RELEASE, "agent");
            asm volatile("s_waitcnt vmcnt(0)" ::: "memory");
            const unsigned og = xb_add(&bar[XB_TOP], 1u);
            const unsigned tg = og / nx;
            if (og + 1u == (tg + 1u) * nx) xb_add(&bar[XB_TOPGEN], 1u);
            else XB_SPIN(xb_ld(&bar[XB_TOPGEN]) == tg, bar);
            __builtin_amdgcn_fence(__ATOMIC_ACQUIRE, "agent");
            xb_add(&bar[XB_XGEN(b.x)], 1u);
            asm volatile("s_waitcnt vmcnt(0)" ::: "memory");
        } else {
            XB_SPIN(xb_ld(&bar[XB_XGEN(b.x)]) == gen, bar);
            __builtin_amdgcn_fence(__ATOMIC_ACQUIRE, "agent");
            asm volatile("s_waitcnt vmcnt(0)" ::: "memory");
        }
    }
    __syncthreads();
}


struct Frame {
    LAS unsigned char* lds; unsigned* ctl; unsigned char* ws;
    int tid, lane, wave, vcu, G, gw, ngw;
};
__device__ const float ROPE_INV[16] = {1.0f, 0.5623413251903491f, 0.31622776601683794f, 0.1778279410038923f, 0.1f, 0.05623413251903491f, 0.03162277660168379f, 0.01778279410038923f,
                                       0.01f, 0.005623413251903491f, 0.0031622776601683794f, 0.001778279410038923f, 0.001f, 0.0005623413251903491f, 0.00031622776601683794f, 0.0001778279410038923f};

__device__ __forceinline__ void p0_transpose_item(const float* W, int K, int N, bf16* WT, LAS float* scr, int item, int lane) {
    const int nblk = N / 32, kb = item / nblk, nb = item % nblk, k0 = 64 * kb, n0 = 32 * nb;
#pragma unroll 8
    for (int i = 0; i < 32; ++i) { const int kk = 2 * i + (lane >> 5); scr[kk * 33 + (lane & 31)] = W[(size_t)(k0 + kk) * N + n0 + (lane & 31)]; }
    LDS_WAIT(); asm volatile("" ::: "memory");
    const int c = lane & 7;
#pragma unroll
    for (int j = 0; j < 4; ++j) { const int n = (lane >> 3) + 8 * j; const LAS float* s = scr + (8 * c) * 33 + n;
        v4u o; o.x = pk2(s[0 * 33], s[1 * 33]); o.y = pk2(s[2 * 33], s[3 * 33]); o.z = pk2(s[4 * 33], s[5 * 33]); o.w = pk2(s[6 * 33], s[7 * 33]);
        *(GAS v4u*)(WT + (size_t)(n0 + n) * K + k0 + 8 * c) = o; }
    LDS_WAIT(); asm volatile("" ::: "memory");
}

__device__ __forceinline__ void ph_prologue_a(const Frame& F, const float* c, const float* cctx, const float* w_mod, const float* b_mod, const float* w_in, const float* w_out,
                                              const float* moe_w1, const float* moe_w2, const float* hy_w1, const float* hy_b1, const float* hy_w2, const float* hy_b2, const float* hy_freq) {
    {
        LAS float* scr = (LAS float*)(F.lds + F.wave * 16384);
        constexpr int I_IN = 2 * 1024, I_OUT = 2 * 512, I_W1 = 64 * 1024, I_W2 = 64 * 512, NIT = I_IN + I_OUT + I_W1 + I_W2;
        bf16* WinT = (bf16*)(F.ws + WS_WINT); bf16* WoutT = (bf16*)(F.ws + WS_WOUTT); bf16* W1T = (bf16*)(F.ws + WS_W1T); bf16* W2T = (bf16*)(F.ws + WS_W2T);
        for (int it = F.gw; it < NIT; it += F.ngw) {
            int r = it;
            if (r < I_IN) { const int m = r >> 10; p0_transpose_item(w_in + (size_t)m * 1024 * 2048, 1024, 2048, WinT + (size_t)m * 2048 * 1024, scr, r & 1023, F.lane); continue; } r -= I_IN;
            if (r < I_OUT) { const int m = r >> 9; p0_transpose_item(w_out + (size_t)m * 1024 * 1024, 1024, 1024, WoutT + (size_t)m * 1024 * 1024, scr, r & 511, F.lane); continue; } r -= I_OUT;
            if (r < I_W1) { const int m = r >> 10; p0_transpose_item(moe_w1 + (size_t)m * 1024 * 2048, 1024, 2048, W1T + (size_t)m * 2048 * 1024, scr, r & 1023, F.lane); continue; } r -= I_W1;
            { const int m = r >> 9; p0_transpose_item(moe_w2 + (size_t)m * 1024 * 1024, 1024, 1024, W2T + (size_t)m * 1024 * 1024, scr, r & 511, F.lane); }
        }
    }
    __syncthreads();
    {
        LAS float* sl = (LAS float*)(F.lds);
        LAS float* red = (LAS float*)(F.lds + 20480);
        float* MOD = (float*)(F.ws + WS_MOD);
        if ((int)blockIdx.x < 192) {
            for (int i = F.tid; i < 5 * 1024; i += NTHR) { const int r = i >> 10, k = i & 1023; const float v = (r < 4) ? c[r * 1024 + k] : cctx[k]; sl[i] = v / (1.0f + __expf(-v)); }
        }
        __syncthreads();
        for (int it = blockIdx.x; it < 192; it += F.G) {
            const int l = it / 96, n = (it % 96) * 64 + F.lane;
            float a0 = 0.f, a1 = 0.f, a2 = 0.f, a3 = 0.f, a4 = 0.f;
            const float* wp = w_mod + ((size_t)l * 1024 + F.wave * 128) * 6144 + n;
#pragma unroll 8
            for (int k = 0; k < 128; ++k) { const float w = wp[(size_t)k * 6144]; const int kk = F.wave * 128 + k;
                a0 += sl[kk] * w; a1 += sl[1024 + kk] * w; a2 += sl[2048 + kk] * w; a3 += sl[3072 + kk] * w; a4 += sl[4096 + kk] * w; }
            red[(F.wave * 5 + 0) * 64 + F.lane] = a0; red[(F.wave * 5 + 1) * 64 + F.lane] = a1; red[(F.wave * 5 + 2) * 64 + F.lane] = a2; red[(F.wave * 5 + 3) * 64 + F.lane] = a3; red[(F.wave * 5 + 4) * 64 + F.lane] = a4;
            __syncthreads();
            if (F.tid < 320) { const int r = F.tid >> 6, ln = F.tid & 63; float s = 0.f;
#pragma unroll
                for (int w = 0; w < 8; ++w) s += red[(w * 5 + r) * 64 + ln];
                const int nn = (it % 96) * 64 + ln; MOD[(size_t)(l * 5 + r) * 6144 + nn] = s + b_mod[l * 6144 + nn]; }
            __syncthreads();
        }
    }
    {
        float* RC = (float*)(F.ws + WS_ROPEC); float* RS = (float*)(F.ws + WS_ROPES);
        for (int idx = blockIdx.x * NTHR + F.tid; idx < SEQ * 32; idx += F.G * NTHR) {
            const int t = idx >> 5, i = idx & 31; const int pos = (i < 16) ? (t >> 6) : (t & 63);
            const float ang = (float)pos * ROPE_INV[i & 15];
            double s, cc; sincos_d((double)ang, s, cc); RC[idx] = (float)cc; RS[idx] = (float)s; }
    }
    {
        float* H2 = (float*)(F.ws + WS_H2);
        for (int it = F.gw; it < 2 * SEQ + CTXL; it += F.ngw) {
            const int v = it >> 13, t = (v < 2) ? (it & (SEQ - 1)) : (it - 2 * SEQ), L = (v < 2) ? SEQ : CTXL, l = (v == 1) ? 1 : 0;
            const int j = F.lane;
            float z = 0.f;
            if (j == 0) z = (float)t / (float)(L - 1);
            else if (j <= 32) { const int b = (j - 1) & 15; const float band = 1e-4f + (float)b * ((15.0f - 1e-4f) / 15.0f);
                const float ang = ((6.283185307179586f / (float)L) * (float)t) * band;
                double s, cc; sincos_d((double)ang, s, cc); z = (j <= 16) ? (float)cc : -(float)s; }
            const float fr = hy_freq[l * 64 + j];
            float p1 = hy_b1[l * 64 + j];
            const float* w1 = hy_w1 + (size_t)l * 33 * 64;
#pragma unroll
            for (int i = 0; i < 33; ++i) p1 += __shfl(z, i) * w1[i * 64 + j];
            double s1, c1; sincos_d((double)(fr * p1), s1, c1); const float h1 = (float)s1;
            float p2 = hy_b2[l * 64 + j];
            const float* w2 = hy_w2 + (size_t)l * 64 * 64;
#pragma unroll 16
            for (int i = 0; i < 64; ++i) p2 += __shfl(h1, i) * w2[i * 64 + j];
            double s2, c2; sincos_d((double)(fr * p2), s2, c2);
            H2[((size_t)v * SEQ + t) * 64 + j] = (float)s2;
        }
    }
}

__device__ __forceinline__ void ph_prologue_b(const Frame& F, const float* hy_w3, const float* hy_decay) {
    LAS float* kt = (LAS float*)(F.lds);
    LAS float* w3c = (LAS float*)(F.lds + 65536);
    LAS float* red = (LAS float*)(F.lds + 65536 + 512);
    const float* H2 = (const float*)(F.ws + WS_H2);
    float* KF = (float*)(F.ws + WS_KF); float* KFC = (float*)(F.ws + WS_KFC);
    for (int it = blockIdx.x; it < 768; it += F.G) {
        const int v = it >> 8, c = it & 255, L = (v < 2) ? SEQ : CTXL, l = (v == 1) ? 1 : 0;
        if (F.tid < 128) w3c[F.tid] = hy_w3[(size_t)l * 64 * 512 + (F.tid & 63) * 512 + (F.tid >> 6) * 256 + c];
        if (F.tid == 0) kt[L] = 0.f;
        __syncthreads();
        const float df = fabsf(hy_decay[l * 512 + c]), db = fabsf(hy_decay[l * 512 + 256 + c]);
        float asum = 0.f;
        for (int t = F.tid; t < L; t += NTHR) {
            const f32x4* row = (const f32x4*)(H2 + ((size_t)v * SEQ + t) * 64);
            float hf = 0.f, hb = 0.f;
#pragma unroll
            for (int q = 0; q < 16; ++q) { const f32x4 h = row[q];
                hf += h.x * w3c[4 * q] + h.y * w3c[4 * q + 1] + h.z * w3c[4 * q + 2] + h.w * w3c[4 * q + 3];
                hb += h.x * w3c[64 + 4 * q] + h.y * w3c[64 + 4 * q + 1] + h.z * w3c[64 + 4 * q + 2] + h.w * w3c[64 + 4 * q + 3]; }
            const float t01 = (float)t / (float)(L - 1);
            hf *= expf(-t01 * df); hb *= expf(-t01 * db);
            kt[t] = hf; asum += fabsf(hf);
            if (t >= 1) { kt[2 * L - t] = hb; asum += fabsf(hb); }
        }
        asum = wave_sum(asum);
        if (F.lane == 0) red[F.wave] = asum;
        __syncthreads();
        float tot = 0.f;
#pragma unroll
        for (int w = 0; w < 8; ++w) tot += red[w];
        const float inv = 1.0f / tot;
        float* dst = (v < 2) ? (KF + (size_t)(v * 256 + c) * 16384) : (KFC + (size_t)c * 512);
        for (int j = F.tid; j < 2 * L; j += NTHR) dst[j] = kt[j] * inv;
        __syncthreads();
    }
}

__device__ __forceinline__ void ph_norm_mod(const Frame& F, int l, const float* x, const float* ctx, const float* gmix) {
    const float* XR = (const float*)(F.ws + WS_XR); const float* MOD = (const float*)(F.ws + WS_MOD); bf16* H = (bf16*)(F.ws + WS_H);
    for (int r = F.gw; r < MT; r += F.ngw) {
        const float* src = (l == 0) ? (r < NLAT ? x + (size_t)r * 1024 : ctx + (size_t)(r - NLAT) * 1024) : XR + (size_t)r * 1024;
        const int bidx = r < NLAT ? r / SEQ : 4;
        const float* shift = MOD + (size_t)(l * 5 + bidx) * 6144; const float* scale = shift + 1024; const float* g = gmix + l * 1024;
        f32x4 v[4]; float ss = 0.f;
#pragma unroll
        for (int j = 0; j < 4; ++j) { v[j] = ((const f32x4*)src)[64 * j + F.lane]; ss += (v[j].x * v[j].x + v[j].y * v[j].y) + (v[j].z * v[j].z + v[j].w * v[j].w); }
        const float rstd = 1.0f / sqrtf(wave_sum(ss) * (1.0f / 1024.0f) + EPSN);
#pragma unroll
        for (int j = 0; j < 4; ++j) { const int cb = 64 * j + F.lane; const f32x4 gg = ((const f32x4*)g)[cb], sc = ((const f32x4*)scale)[cb], sh = ((const f32x4*)shift)[cb];
            const f32x4 y = v[j] * rstd * gg * (sc + 1.0f) + sh;
            v2u o; o.x = pk2(y.x, y.y); o.y = pk2(y.z, y.w); ((v2u*)(H + (size_t)r * 1024))[cb] = o; }
    }
}

__device__ __forceinline__ void ph_post_proj(const Frame& F, int l, const float* qg_, const float* kg_, const float* lru_cw, const float* lru_cb, const float* lru_gw, const float* lru_gb,
                                             const float* lru_lam, const float* hy_cw, const float* hy_cb) {
    const bf16* U = (const bf16*)(F.ws + WS_U);
    {
        bf16* Q = (bf16*)(F.ws + WS_Q); bf16* K = (bf16*)(F.ws + WS_K); bf16* V = (bf16*)(F.ws + WS_V);
        const float* RC = (const float*)(F.ws + WS_ROPEC); const float* RS = (const float*)(F.ws + WS_ROPES);
        const float qg = qg_[l * 64 + F.lane], kg = kg_[l * 64 + F.lane];
        const float C2 = 0.125f * 1.4426950408889634f;
        for (int r = F.gw; r < MT; r += F.ngw) {
            const bool isctx = r >= NLAT; const int b = isctx ? (r - NLAT) / CTXL : r / SEQ; const int t = isctx ? (r - NLAT) % CTXL : r % SEQ;
            const bf16* ur = U + (size_t)r * INW;
            float cs = 1.f, sn = 0.f;
            if (!isctx) { cs = RC[t * 32 + (F.lane & 31)]; sn = RS[t * 32 + (F.lane & 31)]; }
            const size_t krow = (size_t)b * KEYS + (isctx ? t : CTXL + t);
#pragma unroll
            for (int hd = 0; hd < 10; ++hd) {
                const float v = bf2f(ur[hd * 64 + F.lane]);
                const float ss = wave_sum(v * v);
                float y = v * (1.0f / sqrtf(ss * (1.0f / 64.0f) + EPSN)) * (hd < 8 ? qg : kg);
                const float p = __shfl_xor(y, 32);
                if (!isctx) y = (F.lane < 32) ? (y * cs - p * sn) : (y * cs + p * sn);
                if (hd < 8) Q[(size_t)r * 512 + hd * 64 + F.lane] = (bf16)f2bf(y * C2);
                else K[krow * 128 + (hd - 8) * 64 + F.lane] = (bf16)f2bf(y);
            }
            V[krow * 128 + F.lane] = ur[640 + F.lane]; V[krow * 128 + 64 + F.lane] = ur[704 + F.lane];
        }
    }
    __syncthreads();
#ifndef REP_SUB_B
#define REP_SUB_B 1
#endif
#pragma unroll 1
    for (int repb_ = 0; repb_ < REP_SUB_B; ++repb_) {
        LAS float* lxs = (LAS float*)(F.lds);
        LAS float* xls = (LAS float*)(F.lds + 36864);
        float* LAB = (float*)(F.ws + WS_LAB);
        const int ch = F.tid & 255, half = F.tid >> 8, n = ch >> 6, e = ch & 63;
        const float cw0 = lru_cw[(l * 4 + 0) * 256 + ch], cw1 = lru_cw[(l * 4 + 1) * 256 + ch], cw2 = lru_cw[(l * 4 + 2) * 256 + ch], cw3 = lru_cw[(l * 4 + 3) * 256 + ch], cb = lru_cb[l * 256 + ch];
        for (int it = blockIdx.x; it < MT / 32; it += F.G) {
            const int r0 = it * 32; const bool isctx = r0 >= NLAT; const int Ls = isctx ? CTXL : SEQ;
            const int t0 = isctx ? (r0 - NLAT) % CTXL : r0 % SEQ; const int rbase = r0 - t0;
            for (int i = F.tid; i < 36 * 256; i += NTHR) { const int rr = i >> 8, cc = i & 255; const int t = t0 - 2 + rr;
                lxs[i] = (t >= 0 && t < Ls) ? bf2f(U[(size_t)(rbase + t) * INW + 768 + cc]) : 0.f; }
            __syncthreads();
            for (int i = F.tid; i < 32 * 256; i += NTHR) { const int tt = i >> 8;
                xls[i] = cw0 * lxs[i] + cw1 * lxs[i + 256] + cw2 * lxs[i + 512] + cw3 * lxs[i + 768] + cb; (void)tt; }
            __syncthreads();
#pragma unroll 1
            for (int d = 0; d < 2; ++d) {
                float aR[16], aI[16];
#pragma unroll
                for (int q = 0; q < 16; ++q) { aR[q] = 0.f; aI[q] = 0.f; }
                const float* wR = lru_gw + ((size_t)(((l * 2 + d) * 2 + 0) * 4 + n) * 64) * 64 + e;
                const float* wI = lru_gw + ((size_t)(((l * 2 + d) * 2 + 1) * 4 + n) * 64) * 64 + e;
#pragma unroll 2
                for (int d4 = 0; d4 < 16; ++d4) {
                    const float r0w = wR[(d4 * 4 + 0) * 64], r1w = wR[(d4 * 4 + 1) * 64], r2w = wR[(d4 * 4 + 2) * 64], r3w = wR[(d4 * 4 + 3) * 64];
                    const float i0w = wI[(d4 * 4 + 0) * 64], i1w = wI[(d4 * 4 + 1) * 64], i2w = wI[(d4 * 4 + 2) * 64], i3w = wI[(d4 * 4 + 3) * 64];
#pragma unroll
                    for (int q = 0; q < 16; ++q) { const f32x4 xv = *(const LAS f32x4*)(xls + (half * 16 + q) * 256 + n * 64 + d4 * 4);
                        aR[q] += xv.x * r0w + xv.y * r1w + xv.z * r2w + xv.w * r3w; aI[q] += xv.x * i0w + xv.y * i1w + xv.z * i2w + xv.w * i3w; }
                }
                const float bR = lru_gb[((l * 2 + d) * 2 + 0) * 256 + ch], bI = lru_gb[((l * 2 + d) * 2 + 1) * 256 + ch];
                const float lam = lru_lam[(l * 2 + d) * 256 + ch]; const float sp = log1pf(expf(-lam));
                float* LA = LAB + (size_t)(2 * d) * LAB_STRIDE; float* LB = LAB + (size_t)(2 * d + 1) * LAB_STRIDE;
#pragma unroll
                for (int q = 0; q < 16; ++q) { const int tt = half * 16 + q;
                    const float rg = sigmoidf_(aR[q] + bR), ig = sigmoidf_(aI[q] + bI);
                    const float log_a = -8.0f * rg * sp; const float a = expf(log_a);
                    const float bx = sqrtf(fmaxf(-expm1f(2.0f * log_a), 0.f)) * (ig * xls[tt * 256 + ch]);
                    LA[(size_t)(r0 + tt) * 256 + ch] = a; LB[(size_t)(r0 + tt) * 256 + ch] = bx; }
            }
            __syncthreads();
        }
    }
    {
        LAS bf16* hs = (LAS bf16*)(F.lds);
        float* VT = (float*)(F.ws + WS_VT); float* X0T = (float*)(F.ws + WS_X0T);
        const float* cw = hy_cw + (size_t)l * 3 * 768; const float* cbp = hy_cb + l * 768;
        for (int it = blockIdx.x; it < NLAT / 64; it += F.G) {
            const int b = it >> 7, t0 = (it & 127) * 64;
            for (int i = F.tid; i < 66 * 384; i += NTHR) { const int rr = i / 384, c2 = i - rr * 384; const int t = t0 - 1 + rr;
                unsigned w = 0u; if (t >= 0 && t < SEQ) w = *(const unsigned*)(U + (size_t)(b * SEQ + t) * INW + 1280 + 2 * c2);
                *(LAS unsigned*)(hs + rr * 770 + 2 * c2) = w; }
            __syncthreads();
            for (int c = F.wave; c < 256; c += NWAVES) {
                const int tt = F.lane;
                float o[3];
#pragma unroll
                for (int g = 0; g < 3; ++g) { const int cc = g * 256 + c;
                    o[g] = cw[cc] * bf2f(hs[tt * 770 + cc]) + cw[768 + cc] * bf2f(hs[(tt + 1) * 770 + cc]) + cw[1536 + cc] * bf2f(hs[(tt + 2) * 770 + cc]) + cbp[cc]; }
                const size_t oi = ((size_t)b * 256 + c) * SEQ + t0 + tt;
                VT[oi] = o[2] * o[1]; X0T[oi] = o[0];
            }
            __syncthreads();
        }
    }
}

__device__ __forceinline__ void ph_ctx_attn(const Frame& F) {
    const bf16* Q = (const bf16*)(F.ws + WS_Q); const bf16* K = (const bf16*)(F.ws + WS_K); const bf16* V = (const bf16*)(F.ws + WS_V); bf16* O = (bf16*)(F.ws + WS_ATT);
    LAS float* qs = (LAS float*)(F.lds + 90112 + F.wave * 1280);
    LAS float* ps = qs + 64;
    for (int it = F.gw; it < NCTX * 8; it += F.ngw) {
        const int rc = it >> 3, h = it & 7, b = rc / CTXL, kvh = h >> 2; const int r = NLAT + rc;
        qs[F.lane] = bf2f(Q[(size_t)r * 512 + h * 64 + F.lane]);
        LDS_WAIT();
        float sc[4]; float mx = -INFINITY;
#pragma unroll
        for (int i = 0; i < 4; ++i) { const int key = F.lane + 64 * i; const v4u* kp = (const v4u*)(K + ((size_t)b * KEYS + key) * 128 + kvh * 64);
            float s = 0.f;
#pragma unroll
            for (int q = 0; q < 8; ++q) { const v4u w = kp[q];
                s += qs[8 * q] * bflo(w.x) + qs[8 * q + 1] * bfhi(w.x) + qs[8 * q + 2] * bflo(w.y) + qs[8 * q + 3] * bfhi(w.y) + qs[8 * q + 4] * bflo(w.z) + qs[8 * q + 5] * bfhi(w.z) + qs[8 * q + 6] * bflo(w.w) + qs[8 * q + 7] * bfhi(w.w); }
            sc[i] = s; mx = fmaxf(mx, s); }
#pragma unroll
        for (int o = 1; o < 64; o <<= 1) mx = fmaxf(mx, __shfl_xor(mx, o));
        float sum = 0.f;
#pragma unroll
        for (int i = 0; i < 4; ++i) { const float p = exp2f(sc[i] - mx); sum += p; ps[F.lane + 64 * i] = p; }
        sum = wave_sum(sum);
        LDS_WAIT();
        float acc = 0.f;
        const bf16* vp = V + (size_t)b * KEYS * 128 + kvh * 64 + F.lane;
#pragma unroll 8
        for (int key = 0; key < CTXL; ++key) acc += ps[key] * bf2f(vp[(size_t)key * 128]);
        O[(size_t)r * 512 + h * 64 + F.lane] = (bf16)f2bf(acc / sum);
        LDS_WAIT();
    }
}

__device__ __forceinline__ int chunk_row0(int b, int d, int k) {
    if (k < 2) { const int cc = d ? 1 - k : k; return NLAT + b * CTXL + cc * CHUNK; }
    const int lc = d ? 63 - (k - 2) : (k - 2); return b * SEQ + lc * CHUNK;
}
__device__ __forceinline__ void ph_scan1(const Frame& F) {
    const float* LAB = (const float*)(F.ws + WS_LAB); float* SUMP = (float*)(F.ws + WS_SCANS); float* SUMH = SUMP + NB * 2 * NCHUNK * 256;
    for (int it = blockIdx.x * NTHR + F.tid; it < NB * 2 * NCHUNK * 256; it += F.G * NTHR) {
        const int ch = it & 255, k = (it >> 8) % NCHUNK, bd = (it >> 8) / NCHUNK, d = bd & 1, b = bd >> 1;
        const int r0 = chunk_row0(b, d, k);
        const float* LA = LAB + (size_t)(2 * d) * LAB_STRIDE + ch; const float* LB = LAB + (size_t)(2 * d + 1) * LAB_STRIDE + ch;
        float h = 0.f, P = 1.f;
#pragma unroll 8
        for (int i = 0; i < CHUNK; ++i) { const int r = d ? r0 + CHUNK - 1 - i : r0 + i; const float a = LA[(size_t)r * 256], bx = LB[(size_t)r * 256]; h = a * h + bx; P *= a; }
        SUMP[it] = P; SUMH[it] = h;
    }
}
__device__ __forceinline__ void ph_scan2(const Frame& F) {
    const float* LAB = (const float*)(F.ws + WS_LAB); const float* SUMP = (const float*)(F.ws + WS_SCANS); const float* SUMH = SUMP + NB * 2 * NCHUNK * 256;
    float* LRUO = (float*)(F.ws + WS_LRUO); const bf16* U = (const bf16*)(F.ws + WS_U);
    for (int it = blockIdx.x * NTHR + F.tid; it < NB * NCHUNK * 256; it += F.G * NTHR) {
        const int ch = it & 255, kc = (it >> 8) % NCHUNK, b = (it >> 8) / NCHUNK;
        const int r0 = chunk_row0(b, 0, kc);
#pragma unroll 1
        for (int d = 0; d < 2; ++d) {
            const int k = d ? ((kc < 2) ? 1 - kc : 2 + 63 - (kc - 2)) : kc;
            const size_t sb = (size_t)((b * 2 + d) * NCHUNK) * 256 + ch;
            float h = 0.f;
            for (int j = 0; j < k; ++j) h = SUMP[sb + (size_t)j * 256] * h + SUMH[sb + (size_t)j * 256];
            const float* LA = LAB + (size_t)(2 * d) * LAB_STRIDE + ch; const float* LB = LAB + (size_t)(2 * d + 1) * LAB_STRIDE + ch;
            if (d == 0) {
#pragma unroll 8
                for (int i = 0; i < CHUNK; ++i) { const int r = r0 + i; h = LA[(size_t)r * 256] * h + LB[(size_t)r * 256]; LRUO[(size_t)r * 256 + ch] = h; }
            } else {
#pragma unroll 8
                for (int i = 0; i < CHUNK; ++i) { const int r = r0 + CHUNK - 1 - i; h = LA[(size_t)r * 256] * h + LB[(size_t)r * 256];
                    const float lg = bf2f(U[(size_t)r * INW + 1024 + ch]);
                    LRUO[(size_t)r * 256 + ch] = (LRUO[(size_t)r * 256 + ch] + h) * gelu_tanh(lg); }
            }
        }
    }
}

__device__ __forceinline__ void ph_hyena_direct(const Frame& F, int l, const float* hy_bias, const float* hy_cw, const float* hy_cb) {
    LAS float* ks = (LAS float*)(F.lds);
    LAS float* vs = (LAS float*)(F.lds + 65536);
    const float* KF = (const float*)(F.ws + WS_KF) + (size_t)l * 256 * 16384;
    const float* VT = (const float*)(F.ws + WS_VT); const float* X0T = (const float*)(F.ws + WS_X0T); float* HYO = (float*)(F.ws + WS_HYO);
    for (int it = blockIdx.x; it < 512; it += F.G) {
        const int c = it >> 1, bp = it & 1;
        for (int i = F.tid; i < 4096; i += NTHR) ((LAS f32x4*)ks)[i] = ((const f32x4*)(KF + (size_t)c * 16384))[i];
        for (int i = F.tid; i < 4096; i += NTHR) { const int bb = i >> 11, q = i & 2047; ((LAS f32x4*)vs)[i] = ((const f32x4*)(VT + ((size_t)(bp * 2 + bb) * 256 + c) * SEQ))[q]; }
        __syncthreads();
        float y0[16], y1[16];
#pragma unroll
        for (int i = 0; i < 16; ++i) { y0[i] = 0.f; y1[i] = 0.f; }
#pragma unroll 2
        for (int s = 0; s < SEQ; ++s) {
            const float v0 = vs[s], v1 = vs[SEQ + s];
            const int base = (F.tid - s) & 16383;
#pragma unroll
            for (int i = 0; i < 16; ++i) { const float kk = ks[(base + 512 * i) & 16383]; y0[i] += kk * v0; y1[i] += kk * v1; }
        }
        const float bias = hy_bias[l * 256 + c];
#pragma unroll
        for (int i = 0; i < 16; ++i) { const int t = F.tid + 512 * i;
            { const int b = bp * 2; const size_t oi = ((size_t)b * 256 + c) * SEQ + t; HYO[((size_t)b * SEQ + t) * 256 + c] = (y0[i] + vs[t] * bias) * X0T[oi]; }
            { const int b = bp * 2 + 1; const size_t oi = ((size_t)b * 256 + c) * SEQ + t; HYO[((size_t)b * SEQ + t) * 256 + c] = (y1[i] + vs[SEQ + t] * bias) * X0T[oi]; } }
        __syncthreads();
    }
}
__device__ __forceinline__ void ph_khat(const Frame& F) {
    LAS f32x2v* D = (LAS f32x2v*)(F.lds);
    const float* KF = (const float*)(F.ws + WS_KF); c32* KHAT = (c32*)(F.ws + WS_KHAT);
    for (int it = blockIdx.x; it < 512; it += F.G) {
        const float* k = KF + (size_t)it * 16384; c32* out = KHAT + (size_t)it * 16384;
#pragma unroll 1
        for (int i = 0; i < 8; ++i) { const int j = F.tid + 512 * i; c32 x0, x1, x2, x3; x0.x = k[j]; x1.x = k[j + 4096]; x2.x = k[j + 8192]; x3.x = k[j + 12288]; x0.y = x1.y = x2.y = x3.y = 0.f;
            fft_first4(D, j, x0, x1, x2, x3); }
        __syncthreads();
        _Pragma("unroll 1") for (int g_ = F.tid; g_ < 1024; g_ += 512) fft_fwd16(D, g_, 4096);
        __syncthreads();
        _Pragma("unroll 1") for (int g_ = F.tid; g_ < 1024; g_ += 512) fft_fwd16(D, g_, 256);
        __syncthreads();
        _Pragma("unroll 1") for (int g_ = F.tid; g_ < 1024; g_ += 512) fft_last16_out(D, g_, out, 1.0f / 16384.0f);
        __syncthreads();
    }
}
__device__ __forceinline__ void ph_hyena_fft(const Frame& F, int l, const float* hy_bias) {
    LAS f32x2v* D = (LAS f32x2v*)(F.lds);
    const c32* KHAT = (const c32*)(F.ws + WS_KHAT) + (size_t)l * 256 * 16384;
    const float* VT = (const float*)(F.ws + WS_VT); const float* X0T = (const float*)(F.ws + WS_X0T); float* HYO = (float*)(F.ws + WS_HYO);
    for (int it = blockIdx.x; it < 512; it += F.G) {
        const int c = it >> 1, bp = it & 1;
        const float* va = VT + ((size_t)(bp * 2) * 256 + c) * SEQ; const float* vb = VT + ((size_t)(bp * 2 + 1) * 256 + c) * SEQ;
#pragma unroll 1
        for (int i = 0; i < 8; ++i) { const int j = F.tid + 512 * i; c32 x0, x1, z; x0.x = va[j]; x0.y = vb[j]; x1.x = va[j + 4096]; x1.y = vb[j + 4096]; z.x = 0.f; z.y = 0.f;
            fft_first4(D, j, x0, x1, z, z); }
        __syncthreads();
        _Pragma("unroll 1") for (int g_ = F.tid; g_ < 1024; g_ += 512) fft_fwd16(D, g_, 4096);
        __syncthreads();
        _Pragma("unroll 1") for (int g_ = F.tid; g_ < 1024; g_ += 512) fft_fwd16(D, g_, 256);
        __syncthreads();
        _Pragma("unroll 1") for (int g_ = F.tid; g_ < 1024; g_ += 512) fft_mid16(D, g_, KHAT + (size_t)c * 16384);
        __syncthreads();
        _Pragma("unroll 1") for (int g_ = F.tid; g_ < 1024; g_ += 512) fft_inv16(D, g_, 256);
        __syncthreads();
        _Pragma("unroll 1") for (int g_ = F.tid; g_ < 1024; g_ += 512) fft_inv16(D, g_, 4096);
        __syncthreads();
        const float bias = hy_bias[l * 256 + c];
        const float* xa = X0T + ((size_t)(bp * 2) * 256 + c) * SEQ; const float* xb = X0T + ((size_t)(bp * 2 + 1) * 256 + c) * SEQ;
        float* oa = HYO + ((size_t)(bp * 2) * SEQ) * 256 + c; float* ob = HYO + ((size_t)(bp * 2 + 1) * SEQ) * 256 + c;
#pragma unroll 1
        for (int i = 0; i < 8; ++i) { const int j = F.tid + 512 * i; c32 u0, u1; fft_final4(D, j, u0, u1);
            oa[(size_t)j * 256] = (u0.x + va[j] * bias) * xa[j];                 ob[(size_t)j * 256] = (-u0.y + vb[j] * bias) * xb[j];
            oa[(size_t)(j + 4096) * 256] = (u1.x + va[j + 4096] * bias) * xa[j + 4096]; ob[(size_t)(j + 4096) * 256] = (-u1.y + vb[j + 4096] * bias) * xb[j + 4096]; }
        __syncthreads();
    }
}
__device__ __forceinline__ void ph_hyena_ctx(const Frame& F, const float* hy_bias, const float* hy_cw, const float* hy_cb) {
    float* HYO = (float*)(F.ws + WS_HYO);
    {

        const bf16* U = (const bf16*)(F.ws + WS_U); const float* KFC = (const float*)(F.ws + WS_KFC);
        LAS float* vw = (LAS float*)(F.lds + F.wave * 4096);
        LAS float* kw = vw + 256;
        const float* cw = hy_cw; const float* cbp = hy_cb;
        for (int it = F.gw; it < NB * 256; it += F.ngw) {
            const int b = it >> 8, c = it & 255;
            float x0v[4];
#pragma unroll
            for (int i = 0; i < 4; ++i) { const int t = F.lane + 64 * i;
                float o[3];
#pragma unroll
                for (int g = 0; g < 3; ++g) { const int cc = g * 256 + c; float a = cbp[cc];
#pragma unroll
                    for (int j = 0; j < 3; ++j) { const int tj = t + j - 1; if (tj >= 0 && tj < CTXL) a += cw[j * 768 + cc] * bf2f(U[(size_t)(NLAT + b * CTXL + tj) * INW + 1280 + cc]); }
                    o[g] = a; }
                vw[t] = o[2] * o[1]; x0v[i] = o[0]; }
#pragma unroll
            for (int i = 0; i < 8; ++i) kw[F.lane + 64 * i] = KFC[c * 512 + F.lane + 64 * i];
            LDS_WAIT();
            float y[4] = {0.f, 0.f, 0.f, 0.f};
#pragma unroll 4
            for (int s = 0; s < CTXL; ++s) { const float vv = vw[s];
#pragma unroll
                for (int i = 0; i < 4; ++i) y[i] += kw[(F.lane + 64 * i - s) & 511] * vv; }
            const float bias = hy_bias[c];
#pragma unroll
            for (int i = 0; i < 4; ++i) { const int t = F.lane + 64 * i; HYO[(size_t)(NLAT + b * CTXL + t) * 256 + c] = (y[i] + vw[t] * bias) * x0v[i]; }
            LDS_WAIT();
        }
    }
}

__device__ __forceinline__ void ph_merge(const Frame& F, int l, int nrows, const float* out_g) {
    const bf16* ATT = (const bf16*)(F.ws + WS_ATT); const float* LRUO = (const float*)(F.ws + WS_LRUO); const float* HYO = (const float*)(F.ws + WS_HYO); bf16* MIXA = (bf16*)(F.ws + WS_MIXA);
    const float* g = out_g + l * 1024;
    for (int r = F.gw; r < nrows; r += F.ngw) {
        const v4u aw = ((const v4u*)(ATT + (size_t)r * 512))[F.lane];
        float a[8] = {bflo(aw.x), bfhi(aw.x), bflo(aw.y), bfhi(aw.y), bflo(aw.z), bfhi(aw.z), bflo(aw.w), bfhi(aw.w)};
        float ss = 0.f;
#pragma unroll
        for (int i = 0; i < 8; ++i) ss += a[i] * a[i];
        const float ra = 1.0f / sqrtf(wave_sum(ss) * (1.0f / 512.0f) + EPSN);
        const f32x4 lv = ((const f32x4*)(LRUO + (size_t)r * 256))[F.lane];
        const float rl = 1.0f / sqrtf(wave_sum(lv.x * lv.x + lv.y * lv.y + lv.z * lv.z + lv.w * lv.w) * (1.0f / 256.0f) + EPSN);
        const f32x4 hv = ((const f32x4*)(HYO + (size_t)r * 256))[F.lane];
        const float rh = 1.0f / sqrtf(wave_sum(hv.x * hv.x + hv.y * hv.y + hv.z * hv.z + hv.w * hv.w) * (1.0f / 256.0f) + EPSN);
        bf16* orow = MIXA + (size_t)r * 1024;
        { const f32x4 g0 = ((const f32x4*)g)[2 * F.lane], g1 = ((const f32x4*)g)[2 * F.lane + 1];
          v4u o; o.x = pk2(a[0] * ra * g0.x, a[1] * ra * g0.y); o.y = pk2(a[2] * ra * g0.z, a[3] * ra * g0.w); o.z = pk2(a[4] * ra * g1.x, a[5] * ra * g1.y); o.w = pk2(a[6] * ra * g1.z, a[7] * ra * g1.w);
          ((v4u*)orow)[F.lane] = o; }
        { const f32x4 gg = ((const f32x4*)(g + 512))[F.lane]; v2u o; o.x = pk2(lv.x * rl * gg.x, lv.y * rl * gg.y); o.y = pk2(lv.z * rl * gg.z, lv.w * rl * gg.w); ((v2u*)(orow + 512))[F.lane] = o; }
        { const f32x4 gg = ((const f32x4*)(g + 768))[F.lane]; v2u o; o.x = pk2(hv.x * rh * gg.x, hv.y * rh * gg.y); o.y = pk2(hv.z * rh * gg.z, hv.w * rh * gg.w); ((v2u*)(orow + 768))[F.lane] = o; }
    }
}

__device__ __forceinline__ void ph_ffn_router(const Frame& F, int l, int nrows, const float* gffn, const float* router_w, const float* router_b) {
    LAS float* rwl = (LAS float*)(F.lds);
    LAS int* hist = (LAS int*)(F.lds + 135168);
    const float* XR = (const float*)(F.ws + WS_XR); const float* MOD = (const float*)(F.ws + WS_MOD); bf16* Fb = (bf16*)(F.ws + WS_F);
    int* TOPI = (int*)(F.ws + WS_TOPI); float* GATE = (float*)(F.ws + WS_GATE); int* BLKCNT = (int*)(F.ws + WS_BLKCNT);
    for (int i = F.tid; i < 1024 * 32; i += NTHR) rwl[(i >> 5) * 33 + (i & 31)] = router_w[(size_t)l * 32768 + i];
    if (F.tid < 32) hist[F.tid] = 0;
    __syncthreads();
    const float* g = gffn + l * 1024;
    for (int r = F.gw; r < nrows; r += F.ngw) {
        const int bidx = r < NLAT ? r / SEQ : 4;
        const float* sf = MOD + (size_t)(l * 5 + bidx) * 6144 + 3 * 1024; const float* cf = sf + 1024;
        float f[16]; float ss = 0.f;
#pragma unroll
        for (int j = 0; j < 16; ++j) { f[j] = XR[(size_t)r * 1024 + 64 * j + F.lane]; ss += f[j] * f[j]; }
        const float rstd = 1.0f / sqrtf(wave_sum(ss) * (1.0f / 1024.0f) + EPSN);
        float p[32];
#pragma unroll
        for (int e = 0; e < 32; ++e) p[e] = 0.f;
#pragma unroll
        for (int j = 0; j < 16; ++j) { const int c = 64 * j + F.lane; const float fv = f[j] * rstd * g[c] * (1.0f + cf[c]) + sf[c];
            Fb[(size_t)r * 1024 + c] = (bf16)f2bf(fv);
            const LAS float* wrow = rwl + c * 33;
#pragma unroll
            for (int e = 0; e < 32; ++e) p[e] += fv * wrow[e]; }
#pragma unroll
        for (int e = 0; e < 32; ++e) p[e] = wave_sum(p[e]) + router_b[l * 32 + e];
        unsigned taken = 0u; float tv[4]; int ti[4];
#pragma unroll
        for (int k = 0; k < 4; ++k) { float best = -INFINITY; int bi = 0;
#pragma unroll
            for (int e = 0; e < 32; ++e) { const bool ok = !((taken >> e) & 1u) && (p[e] > best); best = ok ? p[e] : best; bi = ok ? e : bi; }
            taken |= 1u << bi; tv[k] = best; ti[k] = bi; }
        const float e1 = __expf(tv[1] - tv[0]), e2 = __expf(tv[2] - tv[0]), e3 = __expf(tv[3] - tv[0]); const float inv = 1.0f / (1.0f + e1 + e2 + e3);
        if (F.lane == 0) {
            TOPI[r * 4 + 0] = ti[0]; TOPI[r * 4 + 1] = ti[1]; TOPI[r * 4 + 2] = ti[2]; TOPI[r * 4 + 3] = ti[3];
            GATE[r * 4 + 0] = inv; GATE[r * 4 + 1] = e1 * inv; GATE[r * 4 + 2] = e2 * inv; GATE[r * 4 + 3] = e3 * inv;
            lds_add(&hist[ti[0]], 1); lds_add(&hist[ti[1]], 1); lds_add(&hist[ti[2]], 1); lds_add(&hist[ti[3]], 1);
        }
    }
    __syncthreads();
    if (F.tid < 32) BLKCNT[blockIdx.x * 32 + F.tid] = hist[F.tid];
}

__device__ __forceinline__ void ph_route(const Frame& F, int nrows) {
    LAS int* cursor = (LAS int*)(F.lds);
    LAS int* tot = cursor + 32;
    LAS int* mine = cursor + 64;
    const int* BLKCNT = (const int*)(F.ws + WS_BLKCNT); const int* TOPI = (const int*)(F.ws + WS_TOPI); int* POS = (int*)(F.ws + WS_POS);
    const bf16* Fb = (const bf16*)(F.ws + WS_F); bf16* AS = (bf16*)(F.ws + WS_ASORT); int* TILEE = (int*)(F.ws + WS_TILEE);
    if (F.tid < 32) { int t = 0, m = 0; for (int b = 0; b < F.G; ++b) { const int v = BLKCNT[b * 32 + F.tid]; t += v; m += (b < (int)blockIdx.x) ? v : 0; } tot[F.tid] = t; mine[F.tid] = m; }
    __syncthreads();
    if (F.tid == 0) { int tb = 0;
        for (int e = 0; e < 32; ++e) { const int nt = (tot[e] + 255) >> 8; cursor[e] = tb * 256 + mine[e];
            if (blockIdx.x == 0) for (int j = 0; j < nt; ++j) TILEE[tb + j] = e;
            tb += nt; }
        if (blockIdx.x == 0) F.ctl[CW_NTILES] = (unsigned)tb; }
    __syncthreads();
    for (int r = F.gw; r < nrows; r += F.ngw) {
        int pos = 0;
        if (F.lane < 4) { const int e = TOPI[r * 4 + F.lane]; pos = lds_add(&cursor[e], 1); POS[r * 4 + F.lane] = pos; }
        const v4u a0 = ((const v4u*)(Fb + (size_t)r * 1024))[F.lane], a1 = ((const v4u*)(Fb + (size_t)r * 1024))[64 + F.lane];
#pragma unroll
        for (int k = 0; k < 4; ++k) { const int pk = __shfl(pos, k); v4u* dst = (v4u*)(AS + (size_t)pk * 1024); dst[F.lane] = a0; dst[64 + F.lane] = a1; }
    }
}

__device__ __forceinline__ void ph_combine(const Frame& F, int l, int nrows, float* out) {
    float* XR = (float*)(F.ws + WS_XR); const float* MOD = (const float*)(F.ws + WS_MOD); const bf16* YS = (const bf16*)(F.ws + WS_YS);
    const int* POS = (const int*)(F.ws + WS_POS); const float* GATE = (const float*)(F.ws + WS_GATE);
    for (int r = F.gw; r < nrows; r += F.ngw) {
        const int bidx = r < NLAT ? r / SEQ : 4;
        const float* gf = MOD + (size_t)(l * 5 + bidx) * 6144 + 5 * 1024;
        int pos = 0; float gt = 0.f;
        if (F.lane < 4) { pos = POS[r * 4 + F.lane]; gt = GATE[r * 4 + F.lane]; }
        f32x4 y[4];
#pragma unroll
        for (int j = 0; j < 4; ++j) y[j] = (f32x4){0.f, 0.f, 0.f, 0.f};
#pragma unroll
        for (int k = 0; k < 4; ++k) { const int pk = __shfl(pos, k); const float gk = __shfl(gt, k); const v2u* yr = (const v2u*)(YS + (size_t)pk * 1024);
#pragma unroll
            for (int j = 0; j < 4; ++j) { const v2u w = yr[64 * j + F.lane]; y[j].x += gk * bflo(w.x); y[j].y += gk * bfhi(w.x); y[j].z += gk * bflo(w.y); y[j].w += gk * bfhi(w.y); } }
        float* dst = (l == 0) ? XR + (size_t)r * 1024 : out + (size_t)r * 1024;
#pragma unroll
        for (int j = 0; j < 4; ++j) { const int cb = 64 * j + F.lane; const f32x4 xv = ((const f32x4*)(XR + (size_t)r * 1024))[cb]; const f32x4 gv = ((const f32x4*)gf)[cb];
            ((f32x4*)dst)[cb] = xv + gv * y[j]; }
    }
}

struct Args { const float* in[34]; float* out; unsigned char* ws; int ph_lo, ph_hi; };
enum { I_X = 0, I_C, I_CTX, I_CCTX, I_WMOD, I_BMOD, I_GMIX, I_GFFN, I_WIN, I_QG, I_KG, I_LCW, I_LCB, I_LGW, I_LGB, I_LLAM, I_HCW, I_HCB, I_HW1, I_HB1, I_HW2, I_HB2, I_HW3, I_HFREQ, I_HDEC, I_HBIAS,
       I_OUTG, I_WOUT, I_RW, I_RB, I_MW1, I_MB1, I_MW2, I_MB2 };

__global__ void __launch_bounds__(NTHR, 2) mk_fwd(Args args) {
    extern __shared__ __attribute__((aligned(16))) unsigned char lds[];
    Frame F;
    F.lds = (LAS unsigned char*)lds; F.ws = args.ws; F.ctl = (unsigned*)(args.ws + WS_CTL);
    F.tid = threadIdx.x; F.lane = F.tid & 63; F.wave = __builtin_amdgcn_readfirstlane(F.tid >> 6);
    F.G = gridDim.x; { const int bx = blockIdx.x; F.vcu = (F.G % 8 == 0) ? (bx % 8) * (F.G / 8) + bx / 8 : bx; }
    F.gw = (int)blockIdx.x * NWAVES + F.wave; F.ngw = F.G * NWAVES;
    for (int u = F.tid; u < (LDS_BYTES - LDSCTL_OFF) / 4; u += NTHR) ((LAS unsigned*)(F.lds + LDSCTL_OFF))[u] = 0u;
    __syncthreads();
#if !MK_PER_PHASE
    XcdBarrier bar = xcd_barrier_post(F.ctl + CW_BAR, (volatile LAS unsigned*)(F.lds + LDSCTL_OFF + 32));
#define GRID_BAR() xcd_barrier(bar)
#else
#define GRID_BAR() do { } while (0)
#endif
    const int lo = args.ph_lo, hi = args.ph_hi;
#ifndef ONLY_PHASE
#define ONLY_PHASE (-1)
#endif
#define ENABLED(id) (ONLY_PHASE < 0 || ONLY_PHASE == (id))
#define IN(k) (ENABLED(k) && lo <= (k) && (k) < hi)
#define INL(j) (ENABLED(NPH_PRO + (j)) && lo <= pb + (j) && pb + (j) < hi)
#define SEAML(j) do { if (lo <= pb + (j) && pb + (j) + 1 < hi) { GRID_BAR(); } } while (0)
typedef const __attribute__((address_space(4))) Args* KArgs;
#ifndef REP_MASK
#define REP_MASK 0
#endif
#define NREP(j) (((REP_MASK >> (j)) & 1) ? 2 : 1)
#define REFRAME() Frame Fp = F; KArgs ka = (KArgs)__builtin_amdgcn_kernarg_segment_ptr(); { int t_ = F.tid; asm volatile("" : "+v"(t_), "+s"(ka)); Fp.tid = t_; Fp.lane = t_ & 63; Fp.wave = __builtin_amdgcn_readfirstlane(t_ >> 6); \
    Fp.gw = (int)blockIdx.x * NWAVES + Fp.wave; Fp.ws = ka->ws; Fp.ctl = (unsigned*)(ka->ws + WS_CTL); }
#define SEAM(k) do { if (lo <= (k) && (k) + 1 < hi) { GRID_BAR(); } } while (0)

    if (IN(0)) ph_prologue_a(F, args.in[I_C], args.in[I_CCTX], args.in[I_WMOD], args.in[I_BMOD], args.in[I_WIN], args.in[I_WOUT], args.in[I_MW1], args.in[I_MW2],
                             args.in[I_HW1], args.in[I_HB1], args.in[I_HW2], args.in[I_HB2], args.in[I_HFREQ]);
    SEAM(0);
    if (IN(1)) ph_prologue_b(F, args.in[I_HW3], args.in[I_HDEC]);
    SEAM(1);
    if (IN(2)) ph_khat(F);
    SEAM(2);

#define LAYER_BODY(l) { \
        const int pb = NPH_PRO + l * NPH_LAYER; \
        const int nrows = (l == 0) ? MT : NLAT; \
        if (INL(0)) { _Pragma("unroll") for (int rep_ = 0; rep_ < NREP(0); ++rep_) { { REFRAME(); ph_norm_mod(Fp, l, ka->in[I_X], ka->in[I_CTX], ka->in[I_GMIX]); } if (rep_ + 1 < NREP(0)) GRID_BAR(); } } \
        SEAML(0); \
        if (INL(1)) { _Pragma("unroll") for (int rep_ = 0; rep_ < NREP(1); ++rep_) { { REFRAME(); \
            pg8::Gemm g{(const bf16*)(Fp.ws + WS_H), (const bf16*)(Fp.ws + WS_WINT) + (size_t)l * 2048 * 1024, MT, 2048, 1024}; \
            pg8::StaticOrder S; S.init(MT, 2048, Fp.G, (int)blockIdx.x); \
            pg8::EpiBf16<0> E{(bf16*)(Fp.ws + WS_U), 2048, nullptr, 0, 0, 1.f}; \
            pg8::gemm_phase<pg8::EpiBf16<0>, pg8::StaticOrder, PG8_ALIGN, PG8_SP2>(Fp.lds + RING_OFF, g, S, E); \
         } if (rep_ + 1 < NREP(1)) GRID_BAR(); } } \
        SEAML(1); \
        if (INL(2)) { _Pragma("unroll") for (int rep_ = 0; rep_ < NREP(2); ++rep_) { { REFRAME(); ph_post_proj(Fp, l, ka->in[I_QG], ka->in[I_KG], ka->in[I_LCW], ka->in[I_LCB], ka->in[I_LGW], ka->in[I_LGB], ka->in[I_LLAM], ka->in[I_HCW], ka->in[I_HCB]); } if (rep_ + 1 < NREP(2)) GRID_BAR(); } } \
        SEAML(2); \
        if (INL(3)) { _Pragma("unroll") for (int rep_ = 0; rep_ < NREP(3); ++rep_) { { { REFRAME(); \
            const attn_body::AttnTensors AT{(const attn_body::bf16*)(Fp.ws + WS_Q), (const attn_body::bf16*)(Fp.ws + WS_K), (const attn_body::bf16*)(Fp.ws + WS_V), (attn_body::bf16*)(Fp.ws + WS_ATT)}; \
            attn_body::attn_phase<8>((char*)lds + RING_OFF, AT, Fp.G, Fp.vcu, l == 0, (long)NLAT); } \
         } if (rep_ + 1 < NREP(3)) GRID_BAR(); } } \
        SEAML(3); \
        if (INL(4)) { _Pragma("unroll") for (int rep_ = 0; rep_ < NREP(4); ++rep_) { { REFRAME(); ph_scan1(Fp); } if (rep_ + 1 < NREP(4)) GRID_BAR(); } } \
        SEAML(4); \
        if (INL(5)) { _Pragma("unroll") for (int rep_ = 0; rep_ < NREP(5); ++rep_) { { REFRAME(); ph_scan2(Fp); } if (rep_ + 1 < NREP(5)) GRID_BAR(); } } \
        SEAML(5); \
        if (INL(6)) { _Pragma("unroll") for (int rep_ = 0; rep_ < NREP(6); ++rep_) { { REFRAME(); ph_hyena_fft(Fp, l, ka->in[I_HBIAS]); if (l == 0) ph_hyena_ctx(Fp, ka->in[I_HBIAS], ka->in[I_HCW], ka->in[I_HCB]); } if (rep_ + 1 < NREP(6)) GRID_BAR(); } } \
        SEAML(6); \
        if (INL(7)) { _Pragma("unroll") for (int rep_ = 0; rep_ < NREP(7); ++rep_) { { REFRAME(); ph_merge(Fp, l, nrows, ka->in[I_OUTG]); } if (rep_ + 1 < NREP(7)) GRID_BAR(); } } \
        SEAML(7); \
        if (INL(8)) { REFRAME(); \
            pg8::Gemm g{(const bf16*)(Fp.ws + WS_MIXA), (const bf16*)(Fp.ws + WS_WOUTT) + (size_t)l * 1024 * 1024, nrows, 1024, 1024}; \
            pg8::StaticOrder S; S.init(nrows, 1024, Fp.G, (int)blockIdx.x); \
            float* XR = (float*)(Fp.ws + WS_XR); \
            pg8::EpiResid E{(l == 0) ? ka->in[I_X] : (const float*)XR, (l == 0) ? ka->in[I_CTX] : (const float*)(XR + (size_t)NLAT * 1024), NLAT, XR, 1024, \
                            (const float*)(Fp.ws + WS_MOD) + (size_t)(l * 5) * 6144 + 2 * 1024, 6144, SEQ}; \
            pg8::gemm_phase<pg8::EpiResid, pg8::StaticOrder, PG8_ALIGN, PG8_SP2>(Fp.lds + RING_OFF, g, S, E); \
        } \
        SEAML(8); \
        if (INL(9)) { _Pragma("unroll") for (int rep_ = 0; rep_ < NREP(9); ++rep_) { { REFRAME(); ph_ffn_router(Fp, l, nrows, ka->in[I_GFFN], ka->in[I_RW], ka->in[I_RB]); } if (rep_ + 1 < NREP(9)) GRID_BAR(); } } \
        SEAML(9); \
        if (INL(10)) { _Pragma("unroll") for (int rep_ = 0; rep_ < NREP(10); ++rep_) { { REFRAME(); ph_route(Fp, nrows); } if (rep_ + 1 < NREP(10)) GRID_BAR(); } } \
        SEAML(10); \
        if (INL(11) || INL(12)) { REFRAME(); \
            LAS int* tab = (LAS int*)(Fp.lds + MOETAB_OFF); \
            const int ntiles = (int)__hip_atomic_load(Fp.ctl + CW_NTILES, __ATOMIC_RELAXED, __HIP_MEMORY_SCOPE_AGENT); \
            const int* TILEE = (const int*)(Fp.ws + WS_TILEE); \
            for (int i = Fp.tid; i < ntiles && i < SORT_TILES; i += NTHR) tab[i] = TILEE[i]; \
            __syncthreads(); \
            if (INL(11)) { _Pragma("unroll") for (int rep_ = 0; rep_ < NREP(11); ++rep_) { { \
                pg8::Gemm g{(const bf16*)(Fp.ws + WS_ASORT), (const bf16*)(Fp.ws + WS_W1T) + (size_t)l * 32 * 2048 * 1024, 0, 2048, 1024}; \
                pg8::MoeOrder S; S.init(tab, ntiles, 8, Fp.G, (int)blockIdx.x); \
                pg8::EpiSwiglu E{(bf16*)(Fp.ws + WS_ACT), 1024, ka->in[I_MB1] + (size_t)l * 32 * 2048, 2048}; \
                pg8::gemm_phase<pg8::EpiSwiglu, pg8::MoeOrder, PG8_ALIGN, PG8_SP2>(Fp.lds + RING_OFF, g, S, E); \
             } if (rep_ + 1 < NREP(11)) GRID_BAR(); } } \
            SEAML(11); \
            if (INL(12)) { _Pragma("unroll") for (int rep_ = 0; rep_ < NREP(12); ++rep_) { { \
                pg8::Gemm g{(const bf16*)(Fp.ws + WS_ACT), (const bf16*)(Fp.ws + WS_W2T) + (size_t)l * 32 * 1024 * 1024, 0, 1024, 1024}; \
                pg8::MoeOrder S; S.init(tab, ntiles, 4, Fp.G, (int)blockIdx.x); \
                pg8::EpiBf16Bias E{(bf16*)(Fp.ws + WS_YS), 1024, ka->in[I_MB2] + (size_t)l * 32 * 1024, 1024}; \
                pg8::gemm_phase<pg8::EpiBf16Bias, pg8::MoeOrder, PG8_ALIGN, PG8_SP2>(Fp.lds + RING_OFF, g, S, E); \
             } if (rep_ + 1 < NREP(12)) GRID_BAR(); } } \
        } \
        SEAML(12); \
        if (INL(13)) { _Pragma("unroll") for (int rep_ = 0; rep_ < NREP(13); ++rep_) { { REFRAME(); ph_combine(Fp, l, nrows, ka->out); } if (rep_ + 1 < NREP(13)) GRID_BAR(); } } \
        SEAML(13); \
    }
    LAYER_BODY(0)
    LAYER_BODY(1)
#undef LAYER_BODY
#undef IN
#undef SEAM
#undef INL
#undef SEAML
}

extern "C" void kernel_launch(void* const* d_in, const int* in_sizes, int n_in, void* d_out, int out_size, void* d_ws, size_t ws_size, hipStream_t stream) {
    static int grid = 0;
    if (grid == 0) {
        if (n_in != 34 || in_sizes[0] != NLAT * DMODEL || out_size != NLAT * DMODEL || ws_size < WS_END) {
            fprintf(stderr, "kernel_launch: unexpected shapes (n_in %d, in0 %d, out %d, ws %zu); nothing launched\n", n_in, n_in > 0 ? in_sizes[0] : -1, out_size, ws_size); grid = -1; return; }
        int dev = 0, cus = 0;
        if (hipGetDevice(&dev) != hipSuccess || hipDeviceGetAttribute(&cus, hipDeviceAttributeMultiprocessorCount, dev) != hipSuccess) { grid = -1; return; }
        if (hipFuncSetAttribute((const void*)mk_fwd, hipFuncAttributeMaxDynamicSharedMemorySize, LDS_BYTES) != hipSuccess) { fprintf(stderr, "kernel_launch: hipFuncSetAttribute failed\n"); grid = -1; return; }
        int per_cu = 0;
        if (hipOccupancyMaxActiveBlocksPerMultiprocessor(&per_cu, (const void*)mk_fwd, NTHR, LDS_BYTES) != hipSuccess || per_cu < 1) { fprintf(stderr, "kernel_launch: occupancy query says %d\n", per_cu); }
        (void)hipGetLastError();
        grid = cus;
    }
    if (grid < 0) return;
    if (hipMemsetAsync((char*)d_ws + WS_CTL, 0, CTL_ZERO_BYTES, stream) != hipSuccess) return;
    Args a{};
    for (int i = 0; i < 34; ++i) a.in[i] = (const float*)d_in[i];
    a.out = (float*)d_out; a.ws = (unsigned char*)d_ws;
#if MK_PER_PHASE
    for (int p = 0; p < NPH; ++p) { a.ph_lo = p; a.ph_hi = p + 1; hipLaunchKernelGGL(mk_fwd, dim3(grid), dim3(NTHR), LDS_BYTES, stream, a); }
#else
    a.ph_lo = 0; a.ph_hi = NPH;
    hipLaunchKernelGGL(mk_fwd, dim3(grid), dim3(NTHR), LDS_BYTES, stream, a);
#endif
}
```

```cpp
#include <hip/hip_runtime.h>
#include <hip/hip_bf16.h>
#include <cstdio>
#include <cstdint>
#include <cmath>
#ifndef MK_PER_PHASE
#define MK_PER_PHASE 0
#endif
namespace pg8 {
#define PG8_LAS __attribute__((address_space(3)))
typedef unsigned short bf16_t;
typedef short bf16x8 __attribute__((ext_vector_type(8)));
typedef float f32x4 __attribute__((ext_vector_type(4)));
typedef unsigned u32x4 __attribute__((ext_vector_type(4)));
constexpr int BM = 256, BK = 64, HALF = 128, HTB = HALF * BK * 2  , STAGE_BYTES = 8 * HTB, NXCD = 8, WGM = 8;

__host__ __device__ __forceinline__ int lds_byte(int r, int c) { const int st = (r >> 4) * 2 + (c >> 5), rr = r & 15, cc = c & 31, ob = rr * 64 + cc * 2; return st * 1024 + (ob ^ (((ob >> 9) & 1) << 5)); }
__host__ __device__ __forceinline__ void stage_rc(int b, int& R, int& C) { const int st = b / 1024, sb = b % 1024, swz = sb ^ (((sb >> 9) & 1) << 5); R = (st >> 1) * 16 + swz / 64; C = (st & 1) * 32 + (swz % 64) / 2; }
__host__ __device__ __forceinline__ int perm32(int rho) { const int n = rho >> 4, i = rho & 15; return 8 * (i >> 2) + 4 * n + (i & 3); }

struct Unit { int pm, pn, be, e; };
struct Gemm { const bf16_t* A; const bf16_t* Bt; int M, N, K; };

struct StaticOrder {
    int nM, nN, nwg, G, c;
    __host__ __device__ void init(int M, int N, int G_, int c_) { nM = M / BM; nN = N / BM; nwg = nM * nN; G = G_; c = c_; }
    __host__ __device__ bool next(int i, Unit& u) const {
        const long L = (long)i * G + c; if (L >= nwg) return false;
        int wgid = (int)L; { const int q = nwg / NXCD, r = nwg % NXCD, xcd = wgid % NXCD, off = wgid / NXCD; wgid = (xcd < r ? xcd * (q + 1) : r * (q + 1) + (xcd - r) * q) + off; }
        const int nig = WGM * nN, gid = wgid / nig, fm = gid * WGM, gsz = (nM - fm) < WGM ? (nM - fm) : WGM;
        u.pm = fm + ((wgid % nig) % gsz); u.pn = (wgid % nig) / gsz; u.be = u.pn; u.e = 0; return true;
    }
    __device__ __forceinline__ void a_ready(const Unit&) const {}
    __device__ __forceinline__ void done(const Unit&) const {}
};

__device__ __forceinline__ unsigned cvt_pk_bf16(float lo, float hi) { unsigned r; asm volatile("v_cvt_pk_bf16_f32 %0, %1, %2" : "=v"(r) : "v"(lo), "v"(hi)); return r; }
typedef float f32x2 __attribute__((ext_vector_type(2)));
__device__ __forceinline__ f32x2 gelu_pk(f32x2 v) {
    const f32x2 av = __builtin_elementwise_abs(v), d = av * 0.2316418882f + 1.0f;
    f32x2 t; t.x = __builtin_amdgcn_rcpf(d.x); t.y = __builtin_amdgcn_rcpf(d.y);
    f32x2 q = t * 0.5307027145f + (-0.7265760135f); q = q * t + 0.7107068705f; q = q * t + (-0.142248368f); q = q * t + 0.127414796f; q = q * t;
    const f32x2 s = (v * v) * (-0.72134752044f);
    f32x2 e; e.x = __builtin_amdgcn_exp2f(s.x); e.y = __builtin_amdgcn_exp2f(s.y);
    const f32x2 m = v * (q * e), r = v - m;
    f32x2 o; o.x = v.x < 0.f ? m.x : r.x; o.y = v.y < 0.f ? m.y : r.y; return o;
}

template <int ACT  > struct EpiBf16 {
    static constexpr bool PERM = true, AFTER_DRAIN = false; static_assert(ACT == 0 || ACT == 1, "EpiBf16: ACT is 0 (none) or 1 (gelu_pk)");
    bf16_t* O; int ldc; const float* bias; int split_cols; size_t split_stride; float scale0;
    __device__ __forceinline__ void operator()(const f32x4 (&acc)[2][2][4][2], const Unit& u, int wr, int wc, int fr, int fq) const {
        const int row0 = u.pm * BM + wr * 64 + fr; int colt = u.pn * BM; bf16_t* base = O;
        float sc = 1.f; if (split_cols) { const int t = colt / split_cols; base += (size_t)t * split_stride; colt -= t * split_cols; if (t == 0) sc = scale0; }
        const int col0 = colt + wc * 32 + 8 * fq, bcol0 = u.pn * BM + wc * 32 + 8 * fq;
        f32x4 bv[2][2];
#pragma unroll
        for (int bj = 0; bj < 2; ++bj)
#pragma unroll
            for (int n = 0; n < 2; ++n) bv[bj][n] = bias ? *(const f32x4*)(bias + bcol0 + bj * HALF + 4 * n) : (f32x4){0.f, 0.f, 0.f, 0.f};
#pragma unroll
        for (int ai = 0; ai < 2; ++ai)
#pragma unroll
            for (int m = 0; m < 4; ++m) { bf16_t* rowp = base + (size_t)(row0 + ai * HALF + m * 16) * ldc + col0;
#pragma unroll
                for (int bj = 0; bj < 2; ++bj) { f32x4 v0 = acc[ai][bj][m][0] + bv[bj][0], v1 = acc[ai][bj][m][1] + bv[bj][1];
                    if (ACT == 1) { f32x2 a = gelu_pk((f32x2){v0[0], v0[1]}), b = gelu_pk((f32x2){v0[2], v0[3]}), c = gelu_pk((f32x2){v1[0], v1[1]}), d = gelu_pk((f32x2){v1[2], v1[3]});
                        v0 = (f32x4){a.x, a.y, b.x, b.y}; v1 = (f32x4){c.x, c.y, d.x, d.y}; }
                    v0 = v0 * sc; v1 = v1 * sc; u32x4 w; w.x = cvt_pk_bf16(v0[0], v0[1]); w.y = cvt_pk_bf16(v0[2], v0[3]); w.z = cvt_pk_bf16(v1[0], v1[1]); w.w = cvt_pk_bf16(v1[2], v1[3]);
                    *(u32x4*)(rowp + bj * HALF) = w; } }
    }
};


struct EpiResid {
    static constexpr bool PERM = false, AFTER_DRAIN = false;
    const float* xin_lat; const float* xin_ctx; int nlat; float* XR; int ldc; const float* mod; int mod_stride; int seq;
    __device__ __forceinline__ void operator()(const f32x4 (&acc)[2][2][4][2], const Unit& u, int wr, int wc, int fr, int fq) const {
        const int row0 = u.pm * BM + wr * 64 + fr, col0 = u.pn * BM + wc * 32 + 4 * fq;
        const int rowt = u.pm * BM; const int bidx = rowt < nlat ? rowt / seq : 4;
        const float* gate = mod + (size_t)bidx * mod_stride;
        const float* xin = rowt < nlat ? xin_lat : (xin_ctx - (size_t)nlat * ldc);
        f32x4 gv[2][2];
#pragma unroll
        for (int bj = 0; bj < 2; ++bj)
#pragma unroll
            for (int n = 0; n < 2; ++n) gv[bj][n] = *(const f32x4*)(gate + col0 + bj * HALF + n * 16);
#pragma unroll
        for (int ai = 0; ai < 2; ++ai)
#pragma unroll
            for (int m = 0; m < 4; ++m) { const size_t ro = (size_t)(row0 + ai * HALF + m * 16) * ldc + col0;
#pragma unroll
                for (int bj = 0; bj < 2; ++bj)
#pragma unroll
                    for (int n = 0; n < 2; ++n) { const f32x4 xv = *(const f32x4*)(xin + ro + bj * HALF + n * 16);
                        *(f32x4*)(XR + ro + bj * HALF + n * 16) = xv + gv[bj][n] * acc[ai][bj][m][n]; } }
    }
};
struct EpiSwiglu {
    static constexpr bool PERM = true, AFTER_DRAIN = false;
    bf16_t* O; int ldc; const float* bias; int bias_stride;
    __device__ __forceinline__ void operator()(const f32x4 (&acc)[2][2][4][2], const Unit& u, int wr, int wc, int fr, int fq) const {
        const int row0 = u.pm * BM + wr * 64 + fr; const int bcol0 = u.pn * BM + wc * 32 + 8 * fq; const int ocol0 = bcol0 >> 1;
        const float* bb = bias + (size_t)u.e * bias_stride;
        f32x4 bv[2][2];
#pragma unroll
        for (int bj = 0; bj < 2; ++bj)
#pragma unroll
            for (int n = 0; n < 2; ++n) bv[bj][n] = *(const f32x4*)(bb + bcol0 + bj * HALF + 4 * n);
#pragma unroll
        for (int ai = 0; ai < 2; ++ai)
#pragma unroll
            for (int m = 0; m < 4; ++m) { bf16_t* rowp = O + (size_t)(row0 + ai * HALF + m * 16) * ldc + ocol0;
#pragma unroll
                for (int bj = 0; bj < 2; ++bj) { const f32x4 v0 = acc[ai][bj][m][0] + bv[bj][0], v1 = acc[ai][bj][m][1] + bv[bj][1];
                    float o[4];
#pragma unroll
                    for (int p = 0; p < 4; ++p) { const float hg = p < 2 ? v0[2 * p] : v1[2 * p - 4], hl = p < 2 ? v0[2 * p + 1] : v1[2 * p - 3];
                        const float glu = fminf(hg, 7.0f), lin = fminf(fmaxf(hl, -7.0f), 7.0f);
                        const float sg = __builtin_amdgcn_rcpf(1.0f + __builtin_amdgcn_exp2f(-1.702f * 1.4426950408889634f * glu));
                        o[p] = glu * sg * (lin + 1.0f); }
                    typedef unsigned u32x2 __attribute__((ext_vector_type(2)));
                    u32x2 w; w.x = cvt_pk_bf16(o[0], o[1]); w.y = cvt_pk_bf16(o[2], o[3]);
                    *(u32x2*)(rowp + bj * (HALF / 2)) = w; } }
    }
};
struct EpiBf16Bias {
    static constexpr bool PERM = true, AFTER_DRAIN = false;
    bf16_t* O; int ldc; const float* bias; int bias_stride;
    __device__ __forceinline__ void operator()(const f32x4 (&acc)[2][2][4][2], const Unit& u, int wr, int wc, int fr, int fq) const {
        const int row0 = u.pm * BM + wr * 64 + fr; const int col0 = u.pn * BM + wc * 32 + 8 * fq;
        const float* bb = bias + (size_t)u.e * bias_stride;
        f32x4 bv[2][2];
#pragma unroll
        for (int bj = 0; bj < 2; ++bj)
#pragma unroll
            for (int n = 0; n < 2; ++n) bv[bj][n] = *(const f32x4*)(bb + col0 + bj * HALF + 4 * n);
#pragma unroll
        for (int ai = 0; ai < 2; ++ai)
#pragma unroll
            for (int m = 0; m < 4; ++m) { bf16_t* rowp = O + (size_t)(row0 + ai * HALF + m * 16) * ldc + col0;
#pragma unroll
                for (int bj = 0; bj < 2; ++bj) { const f32x4 v0 = acc[ai][bj][m][0] + bv[bj][0], v1 = acc[ai][bj][m][1] + bv[bj][1];
                    u32x4 w; w.x = cvt_pk_bf16(v0[0], v0[1]); w.y = cvt_pk_bf16(v0[2], v0[3]); w.z = cvt_pk_bf16(v1[0], v1[1]); w.w = cvt_pk_bf16(v1[2], v1[3]);
                    *(u32x4*)(rowp + bj * HALF) = w; } }
    }
};
struct MoeOrder {
    const PG8_LAS int* tab; int ntiles, nN, nper, j, m_lo, nMx;
    __device__ __forceinline__ void init(const PG8_LAS int* tab_, int ntiles_, int nN_, int G, int bx) {
        tab = tab_; ntiles = ntiles_; nN = nN_;
        if (G % 8 == 0) { const int x = bx % 8; nper = G / 8; j = bx / 8; m_lo = (x * ntiles) / 8; nMx = ((x + 1) * ntiles) / 8 - m_lo; }
        else { nper = G; j = bx; m_lo = 0; nMx = ntiles; }
    }
    __device__ __forceinline__ bool next(int i, Unit& u) const {
        const int s = i * nper + j; if (s >= nMx * nN) return false;
        const int nig = 8 * nN, gid = s / nig, fm = gid * 8, gsz = (nMx - fm) < 8 ? (nMx - fm) : 8, w = s - gid * nig;
        u.pm = m_lo + fm + (w % gsz); u.pn = w / gsz; u.e = tab[u.pm]; u.be = u.e * nN + u.pn; return true;
    }
    __device__ __forceinline__ void a_ready(const Unit&) const {}
    __device__ __forceinline__ void done(const Unit&) const {}
};
template <class Epi, class Sched, bool ALIGN_EPI = false, bool SP2 = false>
__device__ __forceinline__ void gemm_phase(PG8_LAS unsigned char* lds, const Gemm g, const Sched& S, const Epi& E) {
    int tid_ = threadIdx.x; asm volatile("" : "+v"(tid_));
    const int tid = tid_, wid = __builtin_amdgcn_readfirstlane(tid >> 6), lane = tid & 63, wr = wid >> 2, wc = wid & 3, fr = lane & 15, fq = lane >> 4;
    const int K = g.K, nt = K / BK;
    unsigned voffA[2], voffB[2];
#pragma unroll
    for (int i = 0; i < 2; ++i) { int R, C; stage_rc(tid * 16 + i * 8192, R, C); const int Rb = Epi::PERM ? ((R & ~31) + perm32(R & 31)) : R;
        voffA[i] = (unsigned)(R * K + C) * 2u; voffB[i] = (unsigned)(Rb * K + C) * 2u; }
    const size_t kstep = (size_t)(BK * 2);
    const size_t hstep = (size_t)HALF * K * 2;
    const size_t tstep = 2 * hstep;
    const unsigned ldsw = (unsigned)wid * 1024u;
    const int aoff = lds_byte(wr * 64 + fr, fq * 8), boff = lds_byte(wc * 32 + fr, fq * 8);
#define PG8_SA(b, h) (((b) * 2 + (h)) * HTB)
#define PG8_SB(b, h) ((4 + (b) * 2 + (h)) * HTB)
#define PG8_STAGE(bufoff, gbase, voff) do { _Pragma("unroll") for (int _i = 0; _i < 2; ++_i) \
        __builtin_amdgcn_global_load_lds((const unsigned*)((const char*)(gbase) + (voff)[_i]), (PG8_LAS unsigned*)(lds + (bufoff) + ldsw + _i * 8192), 16, 0, 0); } while (0)
#define PG8_LDA(dst, b, h) do { _Pragma("unroll") for (int m = 0; m < 4; ++m) _Pragma("unroll") for (int k = 0; k < 2; ++k) dst[m][k] = *(const PG8_LAS bf16x8*)(lds + PG8_SA(b, h) + aoff + m * 2048 + k * 1024); } while (0)
#define PG8_LDB(dst, b, h) do { _Pragma("unroll") for (int n = 0; n < 2; ++n) _Pragma("unroll") for (int k = 0; k < 2; ++k) dst[n][k] = *(const PG8_LAS bf16x8*)(lds + PG8_SB(b, h) + boff + n * 2048 + k * 1024); } while (0)
#define PG8_MMA(ai, bj, At, Bt) do { __builtin_amdgcn_s_setprio(1); _Pragma("unroll") for (int m = 0; m < 4; ++m) _Pragma("unroll") for (int n = 0; n < 2; ++n) _Pragma("unroll") for (int k = 0; k < 2; ++k) \
        acc[ai][bj][m][n] = __builtin_amdgcn_mfma_f32_16x16x32_bf16(Bt[n][k], At[m][k], acc[ai][bj][m][n], 0, 0, 0); __builtin_amdgcn_s_setprio(0); } while (0)
#define PG8_WAIT_V(n) asm volatile("s_waitcnt vmcnt(" #n ")" ::: "memory")
#define PG8_WAIT_L(n) asm volatile("s_waitcnt lgkmcnt(" #n ")" ::: "memory")
#define PG8_BAR __builtin_amdgcn_s_barrier()
#define PG8_SCHED __builtin_amdgcn_sched_barrier(0)
    Unit cur, nxt; int ui = 0;
    if (!S.next(0, cur)) return;
    f32x4 acc[2][2][4][2];
#pragma unroll
    for (int a = 0; a < 2; ++a)
#pragma unroll
        for (int b = 0; b < 2; ++b)
#pragma unroll
            for (int m = 0; m < 4; ++m)
#pragma unroll
                for (int n = 0; n < 2; ++n) acc[a][b][m][n] = (f32x4){0.f, 0.f, 0.f, 0.f};
    bf16x8 At[4][2], B0[2][2], B1[2][2];
    const char* cA = (const char*)g.A + (size_t)cur.pm * tstep; const char* cB = (const char*)g.Bt + (size_t)cur.be * tstep;
    S.a_ready(cur);
    if constexpr (SP2) {
        PG8_STAGE(PG8_SB(0, 0), cB, voffB); PG8_STAGE(PG8_SB(0, 1), cB + hstep, voffB); PG8_STAGE(PG8_SA(0, 0), cA, voffA); PG8_STAGE(PG8_SA(0, 1), cA + hstep, voffA);
        if (wr == 1) PG8_BAR;
        PG8_WAIT_V(2); PG8_BAR;
        PG8_STAGE(PG8_SB(1, 0), cB + kstep, voffB); PG8_STAGE(PG8_SA(1, 0), cA + kstep, voffA); PG8_STAGE(PG8_SB(1, 1), cB + hstep + kstep, voffB);
        PG8_WAIT_V(6); PG8_BAR;
    } else {
        PG8_STAGE(PG8_SB(0, 0), cB, voffB); PG8_STAGE(PG8_SA(0, 0), cA, voffA); PG8_STAGE(PG8_SB(0, 1), cB + hstep, voffB); PG8_STAGE(PG8_SA(0, 1), cA + hstep, voffA);
        if (wr == 1) PG8_BAR;
        PG8_WAIT_V(4); PG8_BAR;
        PG8_STAGE(PG8_SB(1, 0), cB + kstep, voffB); PG8_STAGE(PG8_SA(1, 0), cA + kstep, voffA); PG8_STAGE(PG8_SB(1, 1), cB + hstep + kstep, voffB);
        PG8_WAIT_V(6); PG8_BAR;
    }
    for (;;) {
        const bool has_next = S.next(ui + 1, nxt);
        const char* nA = has_next ? (const char*)g.A + (size_t)nxt.pm * tstep : cA; const char* nB = has_next ? (const char*)g.Bt + (size_t)nxt.be * tstep : cB;
        for (int t = 0; t < nt; t += 2) {
            const bool last = (t == nt - 2);
            const char* a1 = cA + (size_t)(t + 1) * kstep;
            const char* a2 = last ? nA : cA + (size_t)(t + 2) * kstep; const char* b2 = last ? nB : cB + (size_t)(t + 2) * kstep;
            const char* a3 = a2 + kstep; const char* b3 = b2 + kstep;
            if (last && has_next) S.a_ready(nxt);
            if constexpr (SP2) {
            PG8_LDB(B0, 0, 0); PG8_LDB(B1, 0, 1); PG8_SCHED; PG8_LDA(At, 0, 0); PG8_STAGE(PG8_SA(1, 1), a1 + hstep, voffA);
            PG8_WAIT_V(8); PG8_WAIT_L(0); PG8_BAR; PG8_MMA(0, 0, At, B0); PG8_MMA(0, 1, At, B1); PG8_BAR; PG8_SCHED;
            PG8_LDA(At, 0, 1); PG8_STAGE(PG8_SB(0, 0), b2, voffB); PG8_STAGE(PG8_SB(0, 1), b2 + hstep, voffB); PG8_STAGE(PG8_SA(0, 0), a2, voffA);
            PG8_WAIT_V(8); PG8_WAIT_L(0); PG8_BAR; PG8_MMA(1, 0, At, B0); PG8_MMA(1, 1, At, B1); PG8_BAR; PG8_SCHED;
            PG8_LDB(B0, 1, 0); PG8_LDB(B1, 1, 1); PG8_SCHED; PG8_LDA(At, 1, 0); PG8_STAGE(PG8_SA(0, 1), a2 + hstep, voffA);
            PG8_WAIT_V(8); PG8_WAIT_L(0); PG8_BAR; PG8_MMA(0, 0, At, B0); PG8_MMA(0, 1, At, B1); PG8_BAR; PG8_SCHED;
            PG8_LDA(At, 1, 1); PG8_STAGE(PG8_SB(1, 0), b3, voffB); PG8_STAGE(PG8_SB(1, 1), b3 + hstep, voffB); PG8_STAGE(PG8_SA(1, 0), a3, voffA);
            PG8_WAIT_V(8); PG8_WAIT_L(0); PG8_BAR; PG8_MMA(1, 0, At, B0); PG8_MMA(1, 1, At, B1); PG8_BAR; PG8_SCHED;
            } else {
            PG8_LDB(B0, 0, 0); PG8_SCHED; PG8_LDA(At, 0, 0); PG8_STAGE(PG8_SA(1, 1), a1 + hstep, voffA);
            PG8_WAIT_L(8); PG8_BAR; PG8_WAIT_L(0); PG8_MMA(0, 0, At, B0); PG8_BAR; PG8_SCHED;
            PG8_LDB(B1, 0, 1); PG8_STAGE(PG8_SB(0, 0), b2, voffB);
            PG8_BAR; PG8_WAIT_L(0); PG8_MMA(0, 1, At, B1); PG8_BAR;
            PG8_LDA(At, 0, 1); PG8_STAGE(PG8_SA(0, 0), a2, voffA);
            PG8_BAR; PG8_WAIT_L(0); PG8_MMA(1, 0, At, B0); PG8_BAR; PG8_SCHED;
            PG8_STAGE(PG8_SB(0, 1), b2 + hstep, voffB);
            PG8_WAIT_V(6); PG8_BAR; PG8_MMA(1, 1, At, B1); PG8_BAR;
            PG8_LDB(B0, 1, 0); PG8_SCHED; PG8_LDA(At, 1, 0); PG8_STAGE(PG8_SA(0, 1), a2 + hstep, voffA);
            PG8_WAIT_L(8); PG8_BAR; PG8_WAIT_L(0); PG8_MMA(0, 0, At, B0); PG8_BAR; PG8_SCHED;
            PG8_LDB(B1, 1, 1); PG8_STAGE(PG8_SB(1, 0), b3, voffB);
            PG8_BAR; PG8_WAIT_L(0); PG8_MMA(0, 1, At, B1); PG8_BAR;
            PG8_LDA(At, 1, 1); PG8_STAGE(PG8_SA(1, 0), a3, voffA);
            PG8_BAR; PG8_WAIT_L(0); PG8_MMA(1, 0, At, B0); PG8_BAR; PG8_SCHED;
            PG8_STAGE(PG8_SB(1, 1), b3 + hstep, voffB);
            PG8_WAIT_V(6); PG8_BAR; PG8_MMA(1, 1, At, B1); PG8_BAR;
            }
        }
        if constexpr (ALIGN_EPI) { if (wr == 0) PG8_BAR; }
        if constexpr (!Epi::AFTER_DRAIN) { E(acc, cur, wr, wc, fr, fq); S.done(cur); }
        if (!has_next) break;
#pragma unroll
        for (int a = 0; a < 2; ++a)
#pragma unroll
            for (int b = 0; b < 2; ++b)
#pragma unroll
                for (int m = 0; m < 4; ++m)
#pragma unroll
                    for (int n = 0; n < 2; ++n) acc[a][b][m][n] = (f32x4){0.f, 0.f, 0.f, 0.f};
        cur = nxt; cA = nA; cB = nB; ++ui;
        if constexpr (ALIGN_EPI) { if (wr == 1) PG8_BAR; }
    }
    PG8_WAIT_V(0);
    if constexpr (!ALIGN_EPI) { if (wr == 0) PG8_BAR; }
    PG8_BAR;
    if constexpr (Epi::AFTER_DRAIN) { E.fused(acc, cur, wr, wc, fr, fq, lds, wid, lane); S.done(cur); }
#undef PG8_SA
#undef PG8_SB
#undef PG8_STAGE
#undef PG8_LDA
#undef PG8_LDB
#undef PG8_MMA
#undef PG8_WAIT_V
#undef PG8_WAIT_L
#undef PG8_BAR
#undef PG8_SCHED
}
}

#ifndef PG8_SP2
#define PG8_SP2 true
#endif
#ifndef PG8_ALIGN
#define PG8_ALIGN true
#endif
#include <cmath>
namespace attn_body {
using bf16=__hip_bfloat16;
using bf16x8=__attribute__((ext_vector_type(8)))short;
using s16x4=__attribute__((ext_vector_type(4)))short;
using f32x16=__attribute__((ext_vector_type(16)))float;
using u32x4=__attribute__((ext_vector_type(4)))unsigned;
constexpr int NHEAD=8,SEQQ=8192,SEQK=8448,D=64,QP=512,KP=128;
constexpr int NW=8,QBLK=32,QB=QBLK*NW,KVBLK=64,NQB=SEQQ/QB;
constexpr int ATTN_UNIT_ROWS=QB;
__device__ __forceinline__ int crow(int r,int hi){return (r&3)+8*(r>>2)+4*hi;}
#define SBAR() __builtin_amdgcn_sched_barrier(0)
__device__ __forceinline__ void cmask(f32x16&p0,f32x16&p1,int jb,int qrel,int hi){
  const float NEG=-INFINITY; int kb=64*jb+4*hi;
  #pragma unroll
  for(int r=0;r<16;++r){int kv=kb+(r&3)+8*(r>>2); if(kv>qrel)p0[r]=NEG; if(kv+32>qrel)p1[r]=NEG;}
}

constexpr int NSLOT=3, SLOTB=8192;
constexpr int LDS_K=0, LDS_V=NSLOT*SLOTB, LDS_WS=2*NSLOT*SLOTB, LDS_OST=LDS_WS+NW*64*4, LDS_BYTES=LDS_OST+NW*4096;
constexpr float C2=0.125f*1.4426950408889634f;
__device__ __forceinline__ void glds16(const void*gsrc,unsigned lds_dst){unsigned keep;
  asm volatile("s_mov_b32 %0, m0\n\ts_mov_b32 m0, %2\n\ts_nop 0\n\tglobal_load_lds_dwordx4 %1, off\n\ts_mov_b32 m0, %0":"=&s"(keep):"v"(gsrc),"s"(lds_dst):"memory");}
__device__ __forceinline__ float max3f(float a,float b,float c){float r;asm("v_max3_f32 %0, %1, %2, %3":"=v"(r):"v"(a),"v"(b),"v"(c));return r;}
__device__ __forceinline__ float max2f(float a,float b){float r;asm("v_max_f32_e32 %0, %1, %2":"=v"(r):"v"(a),"v"(b));return r;}
__device__ __forceinline__ float fadd_s(float a,float b){float r;asm("v_add_f32_e32 %0, %1, %2":"=v"(r):"v"(a),"v"(b));return r;}
__device__ __forceinline__ float fsub_s(float a,float b){float r;asm("v_sub_f32_e32 %0, %1, %2":"=v"(r):"v"(a),"v"(b));return r;}
typedef float f32x2_t __attribute__((ext_vector_type(2))); typedef __bf16 bf16x2_t __attribute__((ext_vector_type(2)));
__device__ __forceinline__ unsigned cvtpk_s(float lo,float hi){f32x2_t v={lo,hi};bf16x2_t b=__builtin_convertvector(v,bf16x2_t);return __builtin_bit_cast(unsigned,b);}
#define WAIT_BAR(N) asm volatile("s_waitcnt vmcnt(" #N ") lgkmcnt(0)\n\ts_barrier":::"memory")

__device__ __forceinline__ void qkt(f32x16&p0,f32x16&p1,const char*Kslot,const bf16x8*qr,const f32x16&negm,int r32,int hi){
  const char*kb=Kslot+hi*1024+r32*16;
  #pragma unroll
  for(int d0=0;d0<4;++d0){
    const bf16x8 b0=*reinterpret_cast<const bf16x8*>(kb+d0*2048);
    const bf16x8 b1=*reinterpret_cast<const bf16x8*>(kb+d0*2048+512);
    if(d0==0){p0=__builtin_amdgcn_mfma_f32_32x32x16_bf16(b0,qr[0],negm,0,0,0);p1=__builtin_amdgcn_mfma_f32_32x32x16_bf16(b1,qr[0],negm,0,0,0);}
    else{p0=__builtin_amdgcn_mfma_f32_32x32x16_bf16(b0,qr[d0],p0,0,0,0);p1=__builtin_amdgcn_mfma_f32_32x32x16_bf16(b1,qr[d0],p1,0,0,0);}}
}
typedef __attribute__((address_space(3))) const char* lds_cptr;
typedef short v4i16_t __attribute__((ext_vector_type(4)));
__device__ __forceinline__ void kload8(bf16x8*kf,lds_cptr kp){
  kf[0]=*(const __attribute__((address_space(3))) bf16x8*)(kp);      kf[1]=*(const __attribute__((address_space(3))) bf16x8*)(kp+512);
  kf[2]=*(const __attribute__((address_space(3))) bf16x8*)(kp+2048); kf[3]=*(const __attribute__((address_space(3))) bf16x8*)(kp+2560);
  kf[4]=*(const __attribute__((address_space(3))) bf16x8*)(kp+4096); kf[5]=*(const __attribute__((address_space(3))) bf16x8*)(kp+4608);
  kf[6]=*(const __attribute__((address_space(3))) bf16x8*)(kp+6144); kf[7]=*(const __attribute__((address_space(3))) bf16x8*)(kp+6656);
}
__device__ __forceinline__ void kload2(bf16x8*kf,lds_cptr kp,int j){ kf[2*j]=*(const __attribute__((address_space(3))) bf16x8*)(kp+j*2048); kf[2*j+1]=*(const __attribute__((address_space(3))) bf16x8*)(kp+j*2048+512); }
__device__ __forceinline__ s16x4 vtr(lds_cptr p){ return __builtin_bit_cast(s16x4,__builtin_amdgcn_ds_read_tr16_b64_v4i16((__attribute__((address_space(3))) v4i16_t*)p)); }
__device__ __forceinline__ float rowmax(const f32x16&p0,const f32x16&p1){
  float a=max3f(p0[0],p0[1],p1[0]),b=max3f(p0[2],p0[3],p1[1]);a=max3f(a,p1[2],p1[3]);
  #pragma unroll
  for(int r=4;r<16;r+=4){a=max3f(a,p0[r],p0[r+1]);b=max3f(b,p0[r+2],p0[r+3]);a=max3f(a,p1[r],p1[r+1]);b=max3f(b,p1[r+2],p1[r+3]);}
  const float m=max2f(a,b);
  auto rr=__builtin_amdgcn_permlane32_swap(__float_as_uint(m),__float_as_uint(m),false,false);
  return max2f(__uint_as_float(rr[0]),__uint_as_float(rr[1]));
}
__device__ __forceinline__ void pv(f32x16*o,int vb,bf16x8 pa0,bf16x8 pa1,bf16x8 pa2,bf16x8 pa3){
  #pragma unroll
  for(int d0=0;d0<2;++d0){s16x4 lo[4],hi[4];
    #pragma unroll
    for(int ks=0;ks<4;++ks){
      asm volatile("ds_read_b64_tr_b16 %0,%1 offset:%c2":"=&v"(lo[ks]):"v"(vb),"i"(d0*4096+ks*1024):"memory");
      asm volatile("ds_read_b64_tr_b16 %0,%1 offset:%c2":"=&v"(hi[ks]):"v"(vb),"i"(d0*4096+ks*1024+512):"memory");}
    asm volatile("s_waitcnt lgkmcnt(0)":::"memory");SBAR();
    #define PK(k) (bf16x8){lo[k][0],lo[k][1],lo[k][2],lo[k][3],hi[k][0],hi[k][1],hi[k][2],hi[k][3]}
    o[d0]=__builtin_amdgcn_mfma_f32_32x32x16_bf16(pa0,PK(0),o[d0],0,0,0);
    o[d0]=__builtin_amdgcn_mfma_f32_32x32x16_bf16(pa1,PK(1),o[d0],0,0,0);
    o[d0]=__builtin_amdgcn_mfma_f32_32x32x16_bf16(pa2,PK(2),o[d0],0,0,0);
    o[d0]=__builtin_amdgcn_mfma_f32_32x32x16_bf16(pa3,PK(3),o[d0],0,0,0);
    #undef PK
  }
}

#ifndef ATTN_STORE16
#define ATTN_STORE16(p,v) (*(u32x4*)(p)=(v))
#endif
template<int THRL> __device__ __forceinline__ void attn_unit(int b,int h,long qrow0,int NTarg,const bf16*Q,const bf16*__restrict__ K,const bf16*__restrict__ V,bf16*O,char*shm){
  int tid_=threadIdx.x; asm volatile("":"+v"(tid_)); const int tid=tid_,lane=tid&63,r32=lane&31,hi=lane>>5; const int wid=__builtin_amdgcn_readfirstlane(tid>>6);
  const long krowbase=(long)b*SEQK; const int kvh=h>>2;
  const bf16*Qw=Q+(qrow0+wid*QBLK)*QP+h*D;
  const bf16*Kh=K+krowbase*KP+kvh*D,*Vh=V+krowbase*KP+kvh*D;
  const unsigned lds0=(unsigned)(uintptr_t)shm;
  float*wsf=(float*)(shm+LDS_WS)+wid*64;
  const bf16*ksrc=Kh+(long)lane*KP+wid*8;
  const bf16*vsrc=Vh+(long)(16*(wid&3)+(lane>>2))*KP+(wid>>2)*32+(lane&3)*8;
  const unsigned kdst=lds0+LDS_K+wid*1024, vdst=lds0+LDS_V+wid*1024;
  #define DMA_K(t,slot) glds16(ksrc+(long)(t)*KVBLK*KP,(unsigned)__builtin_amdgcn_readfirstlane(kdst+(slot)))
  #define DMA_V(t,slot) glds16(vsrc+(long)(t)*KVBLK*KP,(unsigned)__builtin_amdgcn_readfirstlane(vdst+(slot)))
  const int vb0=(int)(lds0+LDS_V)+((lane>>4)&1)*32+(lane&3)*8+(4*hi+((lane&15)>>2))*64;
  const char*Kbase=shm+LDS_K; bf16x8 kf[8];
  const lds_cptr shm3=(lds_cptr)shm; const lds_cptr kp0=shm3+LDS_K+hi*1024+r32*16; const lds_cptr vp0=shm3+LDS_V+((lane>>4)&1)*32+(lane&3)*8+(4*hi+((lane&15)>>2))*64;
  const int NT=NTarg;
  DMA_K(0,0);DMA_V(0,0);DMA_K(1,SLOTB);
  bf16x8 qr[4];
  #pragma unroll
  for(int d0=0;d0<4;++d0)qr[d0]=*reinterpret_cast<const bf16x8*>(&Qw[(long)r32*QP+d0*16+hi*8]);
  float mhat=0.f,l_reg=0.f;f32x16 o[2];o[0]=f32x16{};o[1]=f32x16{};f32x16 negm=f32x16{};asm volatile("":"+v"(negm));
  const int qrel=wid*QBLK+r32;
  #define CMASK(P0,P1,t) do{}while(0)
  bool resc=false;
  #define START(P0,P1) do{ const float rm=rowmax(P0,P1); resc=false; \
    { const float dl=rm; mhat=fadd_s(mhat,dl); \
      _Pragma("unroll") for(int r=0;r<16;++r){P0[r]=fsub_s(P0[r],dl);P1[r]=fsub_s(P1[r],dl);} \
      _Pragma("unroll") for(int r=0;r<16;++r)negm[r]=-mhat; asm volatile("":"+v"(negm)); } \
    _Pragma("unroll") for(int r=0;r<16;++r)P0[r]=__builtin_amdgcn_exp2f(P0[r]); }while(0)
  #define RESC() do{ if(resc){ asm volatile("s_waitcnt lgkmcnt(0)":::"memory"); \
      _Pragma("unroll") for(int d_=0;d_<2;++d_) _Pragma("unroll") for(int r=0;r<16;++r)o[d_][r]*=wsf[crow(r,hi)]; } }while(0)
  f32x16 pA0,pA1,pB0,pB1;
  int sl_prev=0,sl_cur=0,sl_next=SLOTB;
  #define ROT() do{sl_prev=sl_cur;sl_cur=sl_next;sl_next=(sl_next==(NSLOT-1)*SLOTB)?0:sl_next+SLOTB;}while(0)
  DMA_K(2,2*SLOTB);
  WAIT_BAR(3);
  qkt(pA0,pA1,Kbase,qr,negm,r32,hi);asm volatile("s_nop 15\n\ts_nop 7":"+v"(pA0),"+v"(pA1));CMASK(pA0,pA1,0);
  START(pA0,pA1);
  _Pragma("unroll") for(int r=0;r<16;++r)pA1[r]=__builtin_amdgcn_exp2f(pA1[r]);
  WAIT_BAR(0);
  DMA_K(3,0);DMA_V(1,SLOTB);
  ROT();
  kload8(kf,kp0+sl_cur);
  WAIT_BAR(2);
  s16x4 vlo[8],vhi[8]; u32x4 pw0,pw1,pw2,pw3;
  #define PKW(P,B) cvtpk_s(P[B],P[B+1])
  #define PAF(k) __builtin_bit_cast(bf16x8,pw##k)
  #define VFR(i) (bf16x8){vlo[i][0],vlo[i][1],vlo[i][2],vlo[i][3],vhi[i][0],vhi[i][1],vhi[i][2],vhi[i][3]}
  #define PIN(x) asm volatile("":"+v"(x))
  #define MX3(a,b,c) __builtin_fmaxf(__builtin_fmaxf((a),(b)),(c))
  #define GAPA(MF,A0,A1,A2,A3,W0,W1,PW) do{ MF; sacc+=A0; sacc+=A1; sacc+=A2; sacc+=A3; PIN(sacc); W0; W1; PIN(PW); SBAR(); }while(0)
  #define EX(v) __builtin_amdgcn_exp2f(v)
  #define GAPB(MF,X,B) do{ MF; X[B]=EX(X[B]); X[B+1]=EX(X[B+1]); X[B+2]=EX(X[B+2]); X[B+3]=EX(X[B+3]); PIN(X); SBAR(); }while(0)
  #define VRD(i) do{ vlo[i]=vtr(vp_+(((i)>>2)*4096+((i)&3)*1024)); vhi[i]=vtr(vp_+(((i)>>2)*4096+((i)&3)*1024+512)); }while(0)
  #define KRD(G,j) do{ if(G){ kload2(kf,kp0+sl_next,j); SBAR(); } }while(0)
  #define STEP(C0,C1,P0,P1,t,GK,GV,GL) do{ SBAR(); \
    const lds_cptr vp_=vp0+sl_prev; \
    VRD(0); SBAR(); float sacc=(P0[0]+P0[1]); \
    GAPA(C0=__builtin_amdgcn_mfma_f32_32x32x16_bf16(kf[0],qr[0],negm,0,0,0), P0[2],P0[3],P0[4],P0[5],     pw0[0]=PKW(P0,0), pw0[1]=PKW(P0,2), pw0); \
    VRD(4); SBAR(); GAPA(C1=__builtin_amdgcn_mfma_f32_32x32x16_bf16(kf[1],qr[0],negm,0,0,0), P0[6],P0[7],P0[8],P0[9],     pw0[2]=PKW(P0,4), pw0[3]=PKW(P0,6), pw0); \
    VRD(1); SBAR(); GAPA(C0=__builtin_amdgcn_mfma_f32_32x32x16_bf16(kf[2],qr[1],C0,0,0,0),   P0[10],P0[11],P0[12],P0[13], pw1[0]=PKW(P0,8), pw1[1]=PKW(P0,10), pw1); \
    VRD(5); SBAR(); GAPA(C1=__builtin_amdgcn_mfma_f32_32x32x16_bf16(kf[3],qr[1],C1,0,0,0),   P0[14],P0[15],P1[0],P1[1],   pw1[2]=PKW(P0,12),pw1[3]=PKW(P0,14), pw1); \
    VRD(2); SBAR(); GAPA(C0=__builtin_amdgcn_mfma_f32_32x32x16_bf16(kf[4],qr[2],C0,0,0,0),   P1[2],P1[3],P1[4],P1[5],     pw2[0]=PKW(P1,0), pw2[1]=PKW(P1,2), pw2); \
    VRD(6); SBAR(); GAPA(C1=__builtin_amdgcn_mfma_f32_32x32x16_bf16(kf[5],qr[2],C1,0,0,0),   P1[6],P1[7],P1[8],P1[9],     pw2[2]=PKW(P1,4), pw2[3]=PKW(P1,6), pw2); \
    VRD(3); SBAR(); GAPA(C0=__builtin_amdgcn_mfma_f32_32x32x16_bf16(kf[6],qr[3],C0,0,0,0),   P1[10],P1[11],P1[12],P1[13], pw3[0]=PKW(P1,8), pw3[1]=PKW(P1,10), pw3); \
    VRD(7); SBAR(); GAPA(C1=__builtin_amdgcn_mfma_f32_32x32x16_bf16(kf[7],qr[3],C1,0,0,0),   P1[14],P1[15],0.f,0.f,       pw3[2]=PKW(P1,12),pw3[3]=PKW(P1,14), pw3); \
    l_reg+=sacc; \
    if(GK){DMA_K((t)+3,sl_cur);} if(GV){DMA_V((t)+1,sl_next);} \
    CMASK(C0,C1,t); \
    { float a=MX3(C0[0],C0[1],C1[0]),b=MX3(C0[2],C0[3],C1[1]); a=MX3(a,C1[2],C1[3]); \
      _Pragma("unroll") for(int r=4;r<16;r+=4){a=MX3(a,C0[r],C0[r+1]);b=MX3(b,C0[r+2],C0[r+3]);a=MX3(a,C1[r],C1[r+1]);b=MX3(b,C1[r+2],C1[r+3]);} \
      float rm=__builtin_fmaxf(a,b); { auto rr=__builtin_amdgcn_permlane32_swap(__float_as_uint(rm),__float_as_uint(rm),false,false); rm=__builtin_fmaxf(__uint_as_float(rr[0]),__uint_as_float(rr[1])); } \
      resc=false; \
      if(__builtin_expect(__any(rm>(float)THRL),0)){ const float dl=__builtin_fmaxf(rm,0.f); mhat+=dl; \
        _Pragma("unroll") for(int r=0;r<16;++r){C0[r]-=dl;C1[r]-=dl;} \
        _Pragma("unroll") for(int r=0;r<16;++r)negm[r]=-mhat; asm volatile("":"+v"(negm)); \
        const float f=__builtin_amdgcn_exp2f(-dl); l_reg*=f; if(hi==0)wsf[r32]=f; resc=true; } } \
    SBAR(); \
    GAPB(o[0]=__builtin_amdgcn_mfma_f32_32x32x16_bf16(PAF(0),VFR(0),o[0],0,0,0), C0,0); \
    GAPB(o[1]=__builtin_amdgcn_mfma_f32_32x32x16_bf16(PAF(0),VFR(4),o[1],0,0,0), C0,4); \
    KRD(GL,0); GAPB(o[0]=__builtin_amdgcn_mfma_f32_32x32x16_bf16(PAF(1),VFR(1),o[0],0,0,0), C0,8); \
    KRD(GL,1); GAPB(o[1]=__builtin_amdgcn_mfma_f32_32x32x16_bf16(PAF(1),VFR(5),o[1],0,0,0), C0,12); \
    KRD(GL,2); GAPB(o[0]=__builtin_amdgcn_mfma_f32_32x32x16_bf16(PAF(2),VFR(2),o[0],0,0,0), C1,0); \
    KRD(GL,3); GAPB(o[1]=__builtin_amdgcn_mfma_f32_32x32x16_bf16(PAF(2),VFR(6),o[1],0,0,0), C1,4); \
    GAPB(o[0]=__builtin_amdgcn_mfma_f32_32x32x16_bf16(PAF(3),VFR(3),o[0],0,0,0), C1,8); \
    GAPB(o[1]=__builtin_amdgcn_mfma_f32_32x32x16_bf16(PAF(3),VFR(7),o[1],0,0,0), C1,12); \
    }while(0)
  int t=1;
  #undef CMASK
  #define CMASK(P0,P1,t) do{}while(0)
  for(;t+5<NT;t+=2){
    STEP(pB0,pB1,pA0,pA1,t,true,true,true);     WAIT_BAR(2); RESC(); ROT();
    STEP(pA0,pA1,pB0,pB1,t+1,true,true,true);   WAIT_BAR(2); RESC(); ROT();
  }
  #undef CMASK
  #define CMASK(P0,P1,t) do{}while(0)
  #define ENDW(tt) do{ if((tt)+3<NT){WAIT_BAR(2);} else if((tt)+2<NT){WAIT_BAR(1);} else {WAIT_BAR(0);} }while(0)
  for(;t+1<NT;t+=2){
    STEP(pB0,pB1,pA0,pA1,t,(t+3<NT),(t+1<NT),(t+1<NT));       ENDW(t);   RESC(); ROT();
    STEP(pA0,pA1,pB0,pB1,t+1,(t+4<NT),(t+2<NT),(t+2<NT));     ENDW(t+1); RESC(); ROT();
  }
  STEP(pB0,pB1,pA0,pA1,NT-1,false,false,false); RESC();
  { float sacc=pB0[0]+pB0[1]; _Pragma("unroll") for(int r=2;r<16;++r)sacc+=pB0[r]; _Pragma("unroll") for(int r=0;r<16;++r)sacc+=pB1[r]; l_reg+=sacc;
    pw0=(u32x4){PKW(pB0,0),PKW(pB0,2),PKW(pB0,4),PKW(pB0,6)};pw1=(u32x4){PKW(pB0,8),PKW(pB0,10),PKW(pB0,12),PKW(pB0,14)};pw2=(u32x4){PKW(pB1,0),PKW(pB1,2),PKW(pB1,4),PKW(pB1,6)};pw3=(u32x4){PKW(pB1,8),PKW(pB1,10),PKW(pB1,12),PKW(pB1,14)};
    SBAR(); pv(o,vb0+sl_cur,PAF(0),PAF(1),PAF(2),PAF(3)); }
  #undef PKW
  #undef PAF
  #undef VFR
  #undef PIN
  #undef MX3
  #undef GAPA
  #undef GAPB
  #undef EX
  #undef VRD
  #undef KRD
  #undef STEP
  #undef ENDW
  {auto rr=__builtin_amdgcn_permlane32_swap(__float_as_uint(l_reg),__float_as_uint(l_reg),false,false);l_reg=__uint_as_float(rr[0])+__uint_as_float(rr[1]);}
  if(hi==0)wsf[32+r32]=l_reg;asm volatile("s_waitcnt lgkmcnt(0)":::"memory");
  float rli[16];
  #pragma unroll
  for(int r=0;r<16;++r)rli[r]=__builtin_amdgcn_rcpf(wsf[32+crow(r,hi)]);
  bf16*Ow=O+(qrow0+wid*QBLK)*QP+h*D;
  { bf16*stg=(bf16*)(shm+LDS_OST)+wid*2048;
    #pragma unroll
    for(int r=0;r<16;++r){const int orow=crow(r,hi);
      #pragma unroll
      for(int d0=0;d0<2;++d0)stg[orow*64+d0*32+r32]=__float2bfloat16(o[d0][r]*rli[r]);}
    asm volatile("s_waitcnt lgkmcnt(0)":::"memory");
    #pragma unroll
    for(int i=0;i<4;++i){const int row=i*8+(lane>>3),ch=lane&7; const u32x4 v=*(const u32x4*)(stg+row*64+ch*8); ATTN_STORE16(Ow+(long)row*QP+ch*8,v);} }
  asm volatile("s_waitcnt lgkmcnt(0)\n\ts_barrier":::"memory");
  #undef DMA_K
  #undef DMA_V
  #undef CMASK
  #undef START
  #undef RESC
  #undef ROT
}
constexpr int ATTN_LDS_BYTES=LDS_BYTES;
struct AttnTensors { const bf16* Q; const bf16* K; const bf16* V; bf16* O; };
template<int THRL=8> __device__ __forceinline__ void attn_phase(char*lds,const AttnTensors&T,int G,int vcu,bool with_ctx,long ctx_row0){
  const int total=4*NHEAD*NQB;
  for(int i=0;;++i){
    int x,n;
    if(G==256){ if(i>=4)break; x=vcu>>5; n=i*32+(vcu&31); }
    else { const int u=i*G+vcu; if(u>=total)break; x=u>>7; n=u&127; }
    const int b=x>>1,kvh=x&1,h=kvh*4+(n>>5),qb=n&31;
    attn_unit<THRL>(b,h,(long)b*SEQQ+(long)qb*QB,SEQK/KVBLK,T.Q,T.K,T.V,T.O,lds);
  }
  if(with_ctx){
    for(int u=vcu;u<4*NHEAD;u+=G){ const int b=u>>3,h=u&7; attn_unit<THRL>(b,h,ctx_row0+(long)b*256,4,T.Q,T.K,T.V,T.O,lds); }
  }
}
#undef SBAR
#undef WAIT_BAR
}

constexpr int NWAVES = 8, NTHR = 512;
constexpr int DMODEL = 1024, NB = 4, SEQ = 8192, CTXL = 256, NLAT = NB * SEQ, NCTX = NB * CTXL, MT = NLAT + NCTX;
constexpr int INW = 2048, NE = 32, KEYS = SEQ + CTXL;
constexpr int SORT_TILES = 560, SORT_ROWS = SORT_TILES * 256;
constexpr float EPSN = 1e-6f;
constexpr int NCHUNK = 66, CHUNK = 128;
constexpr int NPH_PRO = 2, NPH_LAYER = 12, NPH = NPH_PRO + 2 * NPH_LAYER;

constexpr size_t MiB = 1u << 20;
constexpr size_t WS_CTL = 0, CTL_ZERO_BYTES = 1 * MiB;
constexpr size_t WS_MOD = 1 * MiB, WS_ROPEC = 2 * MiB, WS_ROPES = 3 * MiB, WS_H2 = 4 * MiB, WS_KFC = 10 * MiB, WS_BLKCNT = 12 * MiB, WS_TILEE = 13 * MiB, WS_SCANS = 14 * MiB;
constexpr size_t WS_WINT = 16 * MiB, WS_WOUTT = 24 * MiB, WS_W1T = 32 * MiB, WS_W2T = 288 * MiB, WS_KF = 416 * MiB, WS_KHAT = 448 * MiB, WS_XR = 512 * MiB, WS_H = 644 * MiB;
constexpr size_t WS_U = 712 * MiB, WS_Q = 844 * MiB, WS_K = 877 * MiB, WS_V = 886 * MiB, WS_ATT = 895 * MiB, WS_LAB = 928 * MiB, WS_LRUO = 1060 * MiB, WS_VT = 1093 * MiB, WS_X0T = 1125 * MiB,
                 WS_HYO = 1157 * MiB, WS_MIXA = 1190 * MiB;
constexpr size_t WS_F = 712 * MiB, WS_ASORT = 778 * MiB, WS_ACT = 1058 * MiB, WS_YS = 1338 * MiB, WS_TOPI = 1618 * MiB, WS_GATE = 1619 * MiB, WS_POS = 1620 * MiB, WS_END = 1622 * MiB;
constexpr size_t LAB_STRIDE = (size_t)MT * 256;
constexpr int CW_BAR = 4096;
constexpr int CW_NTILES = 64;

constexpr int RING_OFF = 0, RING_BYTES = 131072, MOETAB_OFF = 131072, LDSCTL_OFF = 155648, LDS_BYTES = 156160;

#define GAS __attribute__((address_space(1)))
#define LAS __attribute__((address_space(3)))
typedef unsigned short bf16;
typedef unsigned v4u __attribute__((ext_vector_type(4)));
typedef unsigned v2u __attribute__((ext_vector_type(2)));
typedef float f32x4 __attribute__((ext_vector_type(4)));
#define LDS_WAIT() asm volatile("s_waitcnt lgkmcnt(0)" ::: "memory")
#define VM_WAIT() asm volatile("s_waitcnt vmcnt(0)" ::: "memory")
__device__ __forceinline__ unsigned f2bf(float f) { unsigned u = __builtin_bit_cast(unsigned, f); return (u + 0x7fffu + ((u >> 16) & 1u)) >> 16; }
__device__ __forceinline__ unsigned pk2(float lo, float hi) { return f2bf(lo) | (f2bf(hi) << 16); }
__device__ __forceinline__ float bf2f(unsigned short b) { return __builtin_bit_cast(float, (unsigned)b << 16); }
__device__ __forceinline__ float bflo(unsigned w) { return __builtin_bit_cast(float, w << 16); }
__device__ __forceinline__ float bfhi(unsigned w) { return __builtin_bit_cast(float, w & 0xffff0000u); }
__device__ __forceinline__ float wave_sum(float v) {
#pragma unroll
    for (int o = 1; o < 64; o <<= 1) v += __shfl_xor(v, o);
    return v;
}
__device__ __forceinline__ float sigmoidf_(float x) { return 1.0f / (1.0f + __expf(-x)); }
__device__ __forceinline__ void sincos_d(double x, double& s, double& c) {
    const double kd = __builtin_rint(x * 0.63661977236758134308);
    const int k = (int)kd;
    double r = __builtin_fma(-kd, 1.57079632673412561417e+00, x);
    r = __builtin_fma(-kd, 6.07710050650619224932e-11, r);
    const double z = r * r;
    const double ps = r + r * z * (-1.66666666666666324348e-01 + z * (8.33333333332248946124e-03 + z * (-1.98412698298579493134e-04 + z * (2.75573137070700676789e-06 + z * (-2.50507602534068634195e-08 + z * 1.58969099521155010221e-10)))));
    const double pc = 1.0 - 0.5 * z + z * z * (4.16666666666666019037e-02 + z * (-1.38888888888741095749e-03 + z * (2.48015872894767294178e-05 + z * (-2.75573143513906633035e-07 + z * (2.08757232129817482790e-09 + z * -1.13596475577881948265e-11)))));
    const int q = k & 3;
    s = (q == 0) ? ps : (q == 1) ? pc : (q == 2) ? -ps : -pc;
    c = (q == 0) ? pc : (q == 1) ? -ps : (q == 2) ? -pc : ps;
}
__device__ __forceinline__ float gelu_tanh(float x) {
    const float u = 0.7978845608028654f * (x + 0.044715f * x * x * x);
    const float t = 1.0f - 2.0f / (1.0f + __expf(2.0f * u));
    return 0.5f * x * (1.0f + t);
}
__device__ __forceinline__ int lds_add(LAS int* p, int v) { return __hip_atomic_fetch_add(p, v, __ATOMIC_RELAXED, __HIP_MEMORY_SCOPE_WORKGROUP); }

#define FFT_FN __device__ __forceinline__
typedef float f32x2v __attribute__((ext_vector_type(2)));
#define FFT_VEC2 f32x2v
#define FFT_DPTR LAS f32x2v*
#define FFT_LD(D, i) c32_from((D)[i])
#define FFT_ST(D, i, v) ((D)[i] = c32_to(v))
struct __attribute__((aligned(8))) c32 { float x, y; };
FFT_FN c32 cmul(c32 a, c32 b) { c32 r; r.x = a.x * b.x - a.y * b.y; r.y = a.x * b.y + a.y * b.x; return r; }
FFT_FN c32 cadd(c32 a, c32 b) { c32 r; r.x = a.x + b.x; r.y = a.y + b.y; return r; }
FFT_FN c32 csub(c32 a, c32 b) { c32 r; r.x = a.x - b.x; r.y = a.y - b.y; return r; }
FFT_FN c32 cmuli_neg(c32 a) { c32 r; r.x = a.y; r.y = -a.x; return r; }
FFT_FN int fpad(int a) { return a + (a >> 4); }
#ifdef FFT_VEC2
FFT_FN c32 c32_from(FFT_VEC2 t) { c32 r; r.x = t.x; r.y = t.y; return r; }
FFT_FN FFT_VEC2 c32_to(c32 a) { FFT_VEC2 t; t.x = a.x; t.y = a.y; return t; }
#endif
FFT_FN void dft4(c32& a0, c32& a1, c32& a2, c32& a3) {
    const c32 s02 = cadd(a0, a2), d02 = csub(a0, a2), s13 = cadd(a1, a3), d13 = cmuli_neg(csub(a1, a3));
    a0 = cadd(s02, s13); a2 = csub(s02, s13); a1 = cadd(d02, d13); a3 = csub(d02, d13);
}
FFT_FN void dft16(c32 (&v)[16]) {
    const float C1 = 0.92387953251128674f, S1 = 0.38268343236508977f, C2 = 0.70710678118654752f;
#pragma unroll
    for (int q2 = 0; q2 < 4; ++q2) dft4(v[q2], v[4 + q2], v[8 + q2], v[12 + q2]);
    { c32 w;
      w.x = C1; w.y = -S1; v[4 * 1 + 1] = cmul(v[4 * 1 + 1], w);
      w.x = C2; w.y = -C2; v[4 * 2 + 1] = cmul(v[4 * 2 + 1], w);
      w.x = S1; w.y = -C1; v[4 * 3 + 1] = cmul(v[4 * 3 + 1], w);
      w.x = C2; w.y = -C2; v[4 * 1 + 2] = cmul(v[4 * 1 + 2], w);
      v[4 * 2 + 2] = cmuli_neg(v[4 * 2 + 2]);
      w.x = -C2; w.y = -C2; v[4 * 3 + 2] = cmul(v[4 * 3 + 2], w);
      w.x = S1; w.y = -C1; v[4 * 1 + 3] = cmul(v[4 * 1 + 3], w);
      w.x = -C2; w.y = -C2; v[4 * 2 + 3] = cmul(v[4 * 2 + 3], w);
      w.x = -C1; w.y = S1; v[4 * 3 + 3] = cmul(v[4 * 3 + 3], w); }
#pragma unroll
    for (int p1 = 0; p1 < 4; ++p1) dft4(v[4 * p1 + 0], v[4 * p1 + 1], v[4 * p1 + 2], v[4 * p1 + 3]);
#pragma unroll
    for (int a = 0; a < 4; ++a)
#pragma unroll
        for (int b = a + 1; b < 4; ++b) { const c32 t = v[4 * a + b]; v[4 * a + b] = v[4 * b + a]; v[4 * b + a] = t; }
}
FFT_FN c32 twid(int j, int n) { double s, c; sincos_d(-6.283185307179586476925 * (double)j / (double)n, s, c); c32 w; w.x = (float)c; w.y = (float)s; return w; }

FFT_FN void fft_fwd16(FFT_DPTR D, int g, int n) {
    const int s = n >> 4, blk = g / s, j = g - blk * s, base = blk * n + j;
    c32 v[16];
#pragma unroll
    for (int q = 0; q < 16; ++q) v[q] = FFT_LD(D, fpad(base + q * s));
    dft16(v);
    const c32 w = twid(j, n); c32 wp = w;
#pragma unroll
    for (int p = 1; p < 16; ++p) { v[p] = cmul(v[p], wp); wp = cmul(wp, w); }
#pragma unroll
    for (int p = 0; p < 16; ++p) FFT_ST(D, fpad(base + p * s), v[p]);
}
FFT_FN void fft_inv16(FFT_DPTR D, int g, int n) {
    const int s = n >> 4, blk = g / s, j = g - blk * s, base = blk * n + j;
    c32 v[16];
#pragma unroll
    for (int q = 0; q < 16; ++q) v[q] = FFT_LD(D, fpad(base + q * s));
    const c32 w = twid(j, n); c32 wp = w;
#pragma unroll
    for (int p = 1; p < 16; ++p) { v[p] = cmul(v[p], wp); wp = cmul(wp, w); }
    dft16(v);
#pragma unroll
    for (int p = 0; p < 16; ++p) FFT_ST(D, fpad(base + p * s), v[p]);
}
FFT_FN void fft_mid16(FFT_DPTR D, int g, const c32* KH) {
    c32 v[16];
#pragma unroll
    for (int q = 0; q < 16; ++q) v[q] = FFT_LD(D, 17 * g + q);
    dft16(v);
#pragma unroll
    for (int p = 0; p < 16; ++p) { const c32 k = KH[16 * g + p]; const c32 t = cmul(v[p], k); v[p].x = t.x; v[p].y = -t.y; }
    dft16(v);
#pragma unroll
    for (int p = 0; p < 16; ++p) FFT_ST(D, 17 * g + p, v[p]);
}
FFT_FN void fft_last16_out(FFT_DPTR D, int g, c32* OUT, float scale) {
    c32 v[16];
#pragma unroll
    for (int q = 0; q < 16; ++q) v[q] = FFT_LD(D, 17 * g + q);
    dft16(v);
#pragma unroll
    for (int p = 0; p < 16; ++p) { c32 t; t.x = v[p].x * scale; t.y = v[p].y * scale; OUT[16 * g + p] = t; }
}
FFT_FN void fft_first4(FFT_DPTR D, int j, c32 x0, c32 x1, c32 x2, c32 x3) {
    dft4(x0, x1, x2, x3);
    const c32 w = twid(j, 16384), w2 = cmul(w, w), w3 = cmul(w2, w);
    FFT_ST(D, fpad(j), x0); FFT_ST(D, fpad(j + 4096), cmul(x1, w)); FFT_ST(D, fpad(j + 8192), cmul(x2, w2)); FFT_ST(D, fpad(j + 12288), cmul(x3, w3));
}
FFT_FN void fft_final4(FFT_DPTR D, int j, c32& u0, c32& u1) {
    const c32 w = twid(j, 16384), w2 = cmul(w, w), w3 = cmul(w2, w);
    c32 a0 = FFT_LD(D, fpad(j)), a1 = cmul(FFT_LD(D, fpad(j + 4096)), w), a2 = cmul(FFT_LD(D, fpad(j + 8192)), w2), a3 = cmul(FFT_LD(D, fpad(j + 12288)), w3);
    dft4(a0, a1, a2, a3);
    u0 = a0; u1 = a1;
}
FFT_FN void fft_first4_inplace(FFT_DPTR D, int j) {
    c32 x0 = FFT_LD(D, fpad(j)), x1 = FFT_LD(D, fpad(j + 4096)), x2 = FFT_LD(D, fpad(j + 8192)), x3 = FFT_LD(D, fpad(j + 12288));
    fft_first4(D, j, x0, x1, x2, x3);
}
#define XB_TMO      128
#define XB_XCNT(j)  (256  + 64 * (j))
#define XB_XSUB(j)  (1280 + 64 * (j))
#define XB_XGEN(j)  (2304 + 64 * (j))
#define XB_TOP      3328
#define XB_TOPGEN   3392
#define XCD_BAR_WORDS 3456
#define XB_SPIN_CAP (1u << 22)

__device__ __forceinline__ unsigned xb_ld(unsigned* p)              { return __hip_atomic_load(p, __ATOMIC_RELAXED, __HIP_MEMORY_SCOPE_AGENT); }
__device__ __forceinline__ unsigned xb_add(unsigned* p, unsigned v) { return __hip_atomic_fetch_add(p, v, __ATOMIC_RELAXED, __HIP_MEMORY_SCOPE_AGENT); }
__device__ __forceinline__ unsigned xb_xcc_id() { return (unsigned)__builtin_amdgcn_s_getreg((3 << 11) | 20) & 0xFu; }
#define XB_SPIN(cond, bar) do { unsigned _sp = 0; while (cond) { __builtin_amdgcn_s_sleep(1); \
    if ((++_sp & 255u) == 0u) { if (xb_ld(&(bar)[XB_TMO])) break; if (_sp > XB_SPIN_CAP) { atomicAdd(&(bar)[XB_TMO], 1u); break; } } } } while (0)

struct XcdBarrier {
    unsigned* bar; unsigned x;
    volatile LAS unsigned* st;
};

__device__ __forceinline__ XcdBarrier xcd_barrier_post(unsigned* bar, volatile LAS unsigned* st) {
    XcdBarrier b; b.bar = bar; b.x = xb_xcc_id(); b.st = st;
    if (threadIdx.x == 0) (void)xb_add(&bar[XB_XCNT(b.x)], 1u);
    return b;
}
__device__ __forceinline__ void xcd_barrier_complete(unsigned* bar, unsigned x, unsigned& nloc, unsigned& nx) {
    const unsigned G = gridDim.x * gridDim.y * gridDim.z;
    unsigned sum, cnt, mine, sp = 0u;
    for (;;) {
        sum = 0u; cnt = 0u; mine = 0u;
#pragma unroll
        for (unsigned j = 0; j < 16; ++j) { const unsigned c = xb_ld(&bar[XB_XCNT(j)]); sum += c; cnt += (c > 0u) ? 1u : 0u; mine = (j == x) ? c : mine; }
        if (sum == G) break;
        __builtin_amdgcn_s_sleep(1);
        if ((++sp & 255u) == 0u) { if (xb_ld(&bar[XB_TMO])) break; if (sp > XB_SPIN_CAP) { atomicAdd(&bar[XB_TMO], 1u); break; } }
    }
    nloc = mine > 0u ? mine : 1u; nx = cnt > 0u ? cnt : 1u;
}

__device__ __forceinline__ void xcd_barrier(const XcdBarrier& b) {
    asm volatile("s_waitcnt vmcnt(0)" ::: "memory");
    __syncthreads();
    if (threadIdx.x == 0) {
        unsigned* bar = b.bar;
        __builtin_amdgcn_s_waitcnt(0);
        unsigned nloc = b.st[0], nx = b.st[1];
        if (nloc == 0u) { xcd_barrier_complete(bar, b.x, nloc, nx); b.st[0] = nloc; b.st[1] = nx; }
        const unsigned old = xb_add(&bar[XB_XSUB(b.x)], 1u);
        const unsigned gen = old / nloc;
        if (old + 1u == (gen + 1u) * nloc) {
            __builtin_amdgcn_fence(__ATOMIC_RELEASE, "agent");
            asm volatile("s_waitcnt vmcnt(0)" ::: "memory");
            const unsigned og = xb_add(&bar[XB_TOP], 1u);
            const unsigned tg = og / nx;
            if (og + 1u == (tg + 1u) * nx) xb_add(&bar[XB_TOPGEN], 1u);
            else XB_SPIN(xb_ld(&bar[XB_TOPGEN]) == tg, bar);
            __builtin_amdgcn_fence(__ATOMIC_ACQUIRE, "agent");
            xb_add(&bar[XB_XGEN(b.x)], 1u);
            asm volatile("s_waitcnt vmcnt(0)" ::: "memory");
        } else {
            XB_SPIN(xb_ld(&bar[XB_XGEN(b.x)]) == gen, bar);
            __builtin_amdgcn_fence(__ATOMIC_ACQUIRE, "agent");
            asm volatile("s_waitcnt vmcnt(0)" ::: "memory");
        }
    }
    __syncthreads();
}


struct Frame {
    LAS unsigned char* lds; unsigned* ctl; unsigned char* ws;
    int tid, lane, wave, vcu, G, gw, ngw;
};
__device__ const float ROPE_INV[16] = {1.0f, 0.5623413251903491f, 0.31622776601683794f, 0.1778279410038923f, 0.1f, 0.05623413251903491f, 0.03162277660168379f, 0.01778279410038923f,
                                       0.01f, 0.005623413251903491f, 0.0031622776601683794f, 0.001778279410038923f, 0.001f, 0.0005623413251903491f, 0.00031622776601683794f, 0.0001778279410038923f};

__device__ __forceinline__ void p0_transpose_item(const float* W, int K, int N, bf16* WT, LAS float* scr, int item, int lane) {
    const int nblk = N / 32, kb = item / nblk, nb = item % nblk, k0 = 64 * kb, n0 = 32 * nb;
#pragma unroll 8
    for (int i = 0; i < 32; ++i) { const int kk = 2 * i + (lane >> 5); scr[kk * 33 + (lane & 31)] = W[(size_t)(k0 + kk) * N + n0 + (lane & 31)]; }
    LDS_WAIT(); asm volatile("" ::: "memory");
    const int c = lane & 7;
#pragma unroll
    for (int j = 0; j < 4; ++j) { const int n = (lane >> 3) + 8 * j; const LAS float* s = scr + (8 * c) * 33 + n;
        v4u o; o.x = pk2(s[0 * 33], s[1 * 33]); o.y = pk2(s[2 * 33], s[3 * 33]); o.z = pk2(s[4 * 33], s[5 * 33]); o.w = pk2(s[6 * 33], s[7 * 33]);
        *(GAS v4u*)(WT + (size_t)(n0 + n) * K + k0 + 8 * c) = o; }
    LDS_WAIT(); asm volatile("" ::: "memory");
}

__device__ __forceinline__ void ph_prologue_a(const Frame& F, const float* c, const float* cctx, const float* w_mod, const float* b_mod, const float* w_in, const float* w_out,
                                              const float* moe_w1, const float* moe_w2, const float* hy_w1, const float* hy_b1, const float* hy_w2, const float* hy_b2, const float* hy_freq) {
    {
        LAS float* scr = (LAS float*)(F.lds + F.wave * 16384);
        constexpr int I_IN = 2 * 1024, I_OUT = 2 * 512, I_W1 = 64 * 1024, I_W2 = 64 * 512, NIT = I_IN + I_OUT + I_W1 + I_W2;
        bf16* WinT = (bf16*)(F.ws + WS_WINT); bf16* WoutT = (bf16*)(F.ws + WS_WOUTT); bf16* W1T = (bf16*)(F.ws + WS_W1T); bf16* W2T = (bf16*)(F.ws + WS_W2T);
        for (int it = F.gw; it < NIT; it += F.ngw) {
            int r = it;
            if (r < I_IN) { const int m = r >> 10; p0_transpose_item(w_in + (size_t)m * 1024 * 2048, 1024, 2048, WinT + (size_t)m * 2048 * 1024, scr, r & 1023, F.lane); continue; } r -= I_IN;
            if (r < I_OUT) { const int m = r >> 9; p0_transpose_item(w_out + (size_t)m * 1024 * 1024, 1024, 1024, WoutT + (size_t)m * 1024 * 1024, scr, r & 511, F.lane); continue; } r -= I_OUT;
            if (r < I_W1) { const int m = r >> 10; p0_transpose_item(moe_w1 + (size_t)m * 1024 * 2048, 1024, 2048, W1T + (size_t)m * 2048 * 1024, scr, r & 1023, F.lane); continue; } r -= I_W1;
            { const int m = r >> 9; p0_transpose_item(moe_w2 + (size_t)m * 1024 * 1024, 1024, 1024, W2T + (size_t)m * 1024 * 1024, scr, r & 511, F.lane); }
        }
    }
    __syncthreads();
    {
        LAS float* sl = (LAS float*)(F.lds);
        LAS float* red = (LAS float*)(F.lds + 20480);
        float* MOD = (float*)(F.ws + WS_MOD);
        if ((int)blockIdx.x < 192) {
            for (int i = F.tid; i < 5 * 1024; i += NTHR) { const int r = i >> 10, k = i & 1023; const float v = (r < 4) ? c[r * 1024 + k] : cctx[k]; sl[i] = v / (1.0f + __expf(-v)); }
        }
        __syncthreads();
        for (int it = blockIdx.x; it < 192; it += F.G) {
            const int l = it / 96, n = (it % 96) * 64 + F.lane;
            float a0 = 0.f, a1 = 0.f, a2 = 0.f, a3 = 0.f, a4 = 0.f;
            const float* wp = w_mod + ((size_t)l * 1024 + F.wave * 128) * 6144 + n;
#pragma unroll 8
            for (int k = 0; k < 128; ++k) { const float w = wp[(size_t)k * 6144]; const int kk = F.wave * 128 + k;
                a0 += sl[kk] * w; a1 += sl[1024 + kk] * w; a2 += sl[2048 + kk] * w; a3 += sl[3072 + kk] * w; a4 += sl[4096 + kk] * w; }
            red[(F.wave * 5 + 0) * 64 + F.lane] = a0; red[(F.wave * 5 + 1) * 64 + F.lane] = a1; red[(F.wave * 5 + 2) * 64 + F.lane] = a2; red[(F.wave * 5 + 3) * 64 + F.lane] = a3; red[(F.wave * 5 + 4) * 64 + F.lane] = a4;
            __syncthreads();
            if (F.tid < 320) { const int r = F.tid >> 6, ln = F.tid & 63; float s = 0.f;
#pragma unroll
                for (int w = 0; w < 8; ++w) s += red[(w * 5 + r) * 64 + ln];
                const int nn = (it % 96) * 64 + ln; MOD[(size_t)(l * 5 + r) * 6144 + nn] = s + b_mod[l * 6144 + nn]; }
            __syncthreads();
        }
    }
    {
        float* RC = (float*)(F.ws + WS_ROPEC); float* RS = (float*)(F.ws + WS_ROPES);
        for (int idx = blockIdx.x * NTHR + F.tid; idx < SEQ * 32; idx += F.G * NTHR) {
            const int t = idx >> 5, i = idx & 31; const int pos = (i < 16) ? (t >> 6) : (t & 63);
            const float ang = (float)pos * ROPE_INV[i & 15];
            double s, cc; sincos_d((double)ang, s, cc); RC[idx] = (float)cc; RS[idx] = (float)s; }
    }
    {
        float* H2 = (float*)(F.ws + WS_H2);
        for (int it = F.gw; it < 2 * SEQ + CTXL; it += F.ngw) {
            const int v = it >> 13, t = (v < 2) ? (it & (SEQ - 1)) : (it - 2 * SEQ), L = (v < 2) ? SEQ : CTXL, l = (v == 1) ? 1 : 0;
            const int j = F.lane;
            float z = 0.f;
            if (j == 0) z = (float)t / (float)(L - 1);
            else if (j <= 32) { const int b = (j - 1) & 15; const float band = 1e-4f + (float)b * ((15.0f - 1e-4f) / 15.0f);
                const float ang = ((6.283185307179586f / (float)L) * (float)t) * band;
                double s, cc; sincos_d((double)ang, s, cc); z = (j <= 16) ? (float)cc : -(float)s; }
            const float fr = hy_freq[l * 64 + j];
            float p1 = hy_b1[l * 64 + j];
            const float* w1 = hy_w1 + (size_t)l * 33 * 64;
#pragma unroll
            for (int i = 0; i < 33; ++i) p1 += __shfl(z, i) * w1[i * 64 + j];
            double s1, c1; sincos_d((double)(fr * p1), s1, c1); const float h1 = (float)s1;
            float p2 = hy_b2[l * 64 + j];
            const float* w2 = hy_w2 + (size_t)l * 64 * 64;
#pragma unroll 16
            for (int i = 0; i < 64; ++i) p2 += __shfl(h1, i) * w2[i * 64 + j];
            double s2, c2; sincos_d((double)(fr * p2), s2, c2);
            H2[((size_t)v * SEQ + t) * 64 + j] = (float)s2;
        }
    }
}

__device__ __forceinline__ void ph_prologue_b(const Frame& F, const float* hy_w3, const float* hy_decay) {
    LAS f32x2v* D = (LAS f32x2v*)(F.lds);
    LAS float* kt = (LAS float*)(F.lds);
    LAS float* w3c = (LAS float*)(F.lds + 139264);
    LAS float* red = (LAS float*)(F.lds + 139264 + 512);
    const float* H2 = (const float*)(F.ws + WS_H2);
    c32* KHAT = (c32*)(F.ws + WS_KHAT); float* KFC = (float*)(F.ws + WS_KFC);
    for (int it = blockIdx.x; it < 768; it += F.G) {
        const int v = it >> 8, c = it & 255, L = (v < 2) ? SEQ : CTXL, l = (v == 1) ? 1 : 0;
        if (F.tid < 128) w3c[F.tid] = hy_w3[(size_t)l * 64 * 512 + (F.tid & 63) * 512 + (F.tid >> 6) * 256 + c];
        if (F.tid == 0) { if (v < 2) { f32x2v z; z.x = 0.f; z.y = 0.f; D[fpad(L)] = z; } else kt[L] = 0.f; }
        __syncthreads();
        const float df = fabsf(hy_decay[l * 512 + c]), db = fabsf(hy_decay[l * 512 + 256 + c]);
        float asum = 0.f;
        for (int t = F.tid; t < L; t += NTHR) {
            const f32x4* row = (const f32x4*)(H2 + ((size_t)v * SEQ + t) * 64);
            float hf = 0.f, hb = 0.f;
#pragma unroll
            for (int q = 0; q < 16; ++q) { const f32x4 h = row[q];
                hf += h.x * w3c[4 * q] + h.y * w3c[4 * q + 1] + h.z * w3c[4 * q + 2] + h.w * w3c[4 * q + 3];
                hb += h.x * w3c[64 + 4 * q] + h.y * w3c[64 + 4 * q + 1] + h.z * w3c[64 + 4 * q + 2] + h.w * w3c[64 + 4 * q + 3]; }
            const float t01 = (float)t / (float)(L - 1);
            hf *= expf(-t01 * df); hb *= expf(-t01 * db);
            asum += fabsf(hf); if (t >= 1) asum += fabsf(hb);
            if (v < 2) { f32x2v z; z.x = hf; z.y = 0.f; D[fpad(t)] = z; if (t >= 1) { z.x = hb; D[fpad(2 * L - t)] = z; } }
            else { kt[t] = hf; if (t >= 1) kt[2 * L - t] = hb; }
        }
        asum = wave_sum(asum);
        if (F.lane == 0) red[F.wave] = asum;
        __syncthreads();
        float tot = 0.f;
#pragma unroll
        for (int w = 0; w < 8; ++w) tot += red[w];
        const float inv = 1.0f / tot;
        if (v < 2) {
            c32* out = KHAT + (size_t)(v * 256 + c) * 16384;
#pragma unroll 1
            for (int i = 0; i < 8; ++i) fft_first4_inplace(D, F.tid + 512 * i);
            __syncthreads();
            _Pragma("unroll 1") for (int g_ = F.tid; g_ < 1024; g_ += 512) fft_fwd16(D, g_, 4096);
            __syncthreads();
            _Pragma("unroll 1") for (int g_ = F.tid; g_ < 1024; g_ += 512) fft_fwd16(D, g_, 256);
            __syncthreads();
            _Pragma("unroll 1") for (int g_ = F.tid; g_ < 1024; g_ += 512) fft_last16_out(D, g_, out, inv * (1.0f / 16384.0f));
        } else {
            float* dst = KFC + (size_t)c * 512;
            for (int j = F.tid; j < 2 * L; j += NTHR) dst[j] = kt[j] * inv;
        }
        __syncthreads();
    }
}

__device__ __forceinline__ void ph_norm_mod(const Frame& F, int l, const float* x, const float* ctx, const float* gmix) {
    const float* XR = (const float*)(F.ws + WS_XR); const float* MOD = (const float*)(F.ws + WS_MOD); bf16* H = (bf16*)(F.ws + WS_H);
    for (int r = F.gw; r < MT; r += F.ngw) {
        const float* src = (l == 0) ? (r < NLAT ? x + (size_t)r * 1024 : ctx + (size_t)(r - NLAT) * 1024) : XR + (size_t)r * 1024;
        const int bidx = r < NLAT ? r / SEQ : 4;
        const float* shift = MOD + (size_t)(l * 5 + bidx) * 6144; const float* scale = shift + 1024; const float* g = gmix + l * 1024;
        f32x4 v[4]; float ss = 0.f;
#pragma unroll
        for (int j = 0; j < 4; ++j) { v[j] = ((const f32x4*)src)[64 * j + F.lane]; ss += (v[j].x * v[j].x + v[j].y * v[j].y) + (v[j].z * v[j].z + v[j].w * v[j].w); }
        const float rstd = 1.0f / sqrtf(wave_sum(ss) * (1.0f / 1024.0f) + EPSN);
#pragma unroll
        for (int j = 0; j < 4; ++j) { const int cb = 64 * j + F.lane; const f32x4 gg = ((const f32x4*)g)[cb], sc = ((const f32x4*)scale)[cb], sh = ((const f32x4*)shift)[cb];
            const f32x4 y = v[j] * rstd * gg * (sc + 1.0f) + sh;
            v2u o; o.x = pk2(y.x, y.y); o.y = pk2(y.z, y.w); ((v2u*)(H + (size_t)r * 1024))[cb] = o; }
    }
}

__device__ __forceinline__ void ph_post_proj(const Frame& F, int l, const float* qg_, const float* kg_, const float* lru_cw, const float* lru_cb, const float* lru_gw, const float* lru_gb,
                                             const float* lru_lam, const float* hy_cw, const float* hy_cb) {
    const bf16* U = (const bf16*)(F.ws + WS_U);
    {
        bf16* Q = (bf16*)(F.ws + WS_Q); bf16* K = (bf16*)(F.ws + WS_K); bf16* V = (bf16*)(F.ws + WS_V);
        const float* RC = (const float*)(F.ws + WS_ROPEC); const float* RS = (const float*)(F.ws + WS_ROPES);
        const int o8 = 8 * (F.lane & 7);
        const f32x4 qg0 = *(const f32x4*)(qg_ + l * 64 + o8), qg1 = *(const f32x4*)(qg_ + l * 64 + o8 + 4), kg0 = *(const f32x4*)(kg_ + l * 64 + o8), kg1 = *(const f32x4*)(kg_ + l * 64 + o8 + 4);
        const float C2 = 0.125f * 1.4426950408889634f;
        const bool lohalf = (F.lane & 4) == 0;
        for (int r = F.gw; r < MT; r += F.ngw) {
            const bool isctx = r >= NLAT; const int b = isctx ? (r - NLAT) / CTXL : r / SEQ; const int t = isctx ? (r - NLAT) % CTXL : r % SEQ;
            const bf16* ur = U + (size_t)r * INW;
            const v4u wq = ((const v4u*)ur)[F.lane];
            const v4u wk = ((const v4u*)(ur + 512))[F.lane & 31];
            f32x4 c0 = {1.f, 1.f, 1.f, 1.f}, c1 = c0, s0 = {0.f, 0.f, 0.f, 0.f}, s1 = s0;
            if (!isctx) { const float* rc = RC + t * 32 + 8 * (F.lane & 3); const float* rs = RS + t * 32 + 8 * (F.lane & 3);
                c0 = *(const f32x4*)rc; c1 = *(const f32x4*)(rc + 4); s0 = *(const f32x4*)rs; s1 = *(const f32x4*)(rs + 4); }
            const size_t krow = (size_t)b * KEYS + (isctx ? t : CTXL + t);
#pragma unroll
            for (int part = 0; part < 2; ++part) {
                const v4u w = part ? wk : wq;
                float x[8] = {bflo(w.x), bfhi(w.x), bflo(w.y), bfhi(w.y), bflo(w.z), bfhi(w.z), bflo(w.w), bfhi(w.w)};
                float ss = 0.f;
#pragma unroll
                for (int i = 0; i < 8; ++i) ss += x[i] * x[i];
                ss += __shfl_xor(ss, 1); ss += __shfl_xor(ss, 2); ss += __shfl_xor(ss, 4);
                const float rstd = 1.0f / sqrtf(ss * (1.0f / 64.0f) + EPSN);
                const f32x4 g0 = part ? kg0 : qg0, g1 = part ? kg1 : qg1;
                float y[8], o[8];
#pragma unroll
                for (int i = 0; i < 8; ++i) y[i] = x[i] * rstd * (i < 4 ? g0[i] : g1[i - 4]);
#pragma unroll
                for (int i = 0; i < 8; ++i) { const float p = __shfl_xor(y[i], 4); const float cs = i < 4 ? c0[i] : c1[i - 4], sn = i < 4 ? s0[i] : s1[i - 4];
                    o[i] = lohalf ? (y[i] * cs - p * sn) : (y[i] * cs + p * sn); }
                if (part == 0) { v4u ow; ow.x = pk2(o[0] * C2, o[1] * C2); ow.y = pk2(o[2] * C2, o[3] * C2); ow.z = pk2(o[4] * C2, o[5] * C2); ow.w = pk2(o[6] * C2, o[7] * C2);
                    ((v4u*)(Q + (size_t)r * 512))[F.lane] = ow; }
                else { v4u ow; ow.x = pk2(o[0], o[1]); ow.y = pk2(o[2], o[3]); ow.z = pk2(o[4], o[5]); ow.w = pk2(o[6], o[7]);
                    if (F.lane < 16) ((v4u*)(K + krow * 128))[F.lane] = ow;
                    else if (F.lane < 32) ((v4u*)(V + krow * 128))[F.lane - 16] = wk; }
            }
        }
    }
    __syncthreads();
#ifndef REP_SUB_B
#define REP_SUB_B 1
#endif
#pragma unroll 1
    for (int repb_ = 0; repb_ < REP_SUB_B; ++repb_) {
        LAS float* lxs = (LAS float*)(F.lds);
        LAS float* xls = (LAS float*)(F.lds + 36864);
        float* LAB = (float*)(F.ws + WS_LAB);
        const int ch = F.tid & 255, half = F.tid >> 8, n = ch >> 6, e = ch & 63;
        const float cw0 = lru_cw[(l * 4 + 0) * 256 + ch], cw1 = lru_cw[(l * 4 + 1) * 256 + ch], cw2 = lru_cw[(l * 4 + 2) * 256 + ch], cw3 = lru_cw[(l * 4 + 3) * 256 + ch], cb = lru_cb[l * 256 + ch];
        for (int it = blockIdx.x; it < MT / 32; it += F.G) {
            const int r0 = it * 32; const bool isctx = r0 >= NLAT; const int Ls = isctx ? CTXL : SEQ;
            const int t0 = isctx ? (r0 - NLAT) % CTXL : r0 % SEQ; const int rbase = r0 - t0;
            for (int i = F.tid; i < 36 * 256; i += NTHR) { const int rr = i >> 8, cc = i & 255; const int t = t0 - 2 + rr;
                lxs[i] = (t >= 0 && t < Ls) ? bf2f(U[(size_t)(rbase + t) * INW + 768 + cc]) : 0.f; }
            __syncthreads();
            for (int i = F.tid; i < 32 * 256; i += NTHR) { const int tt = i >> 8;
                xls[i] = cw0 * lxs[i] + cw1 * lxs[i + 256] + cw2 * lxs[i + 512] + cw3 * lxs[i + 768] + cb; (void)tt; }
            __syncthreads();
#pragma unroll 1
            for (int d = 0; d < 2; ++d) {
                float aR[16], aI[16];
#pragma unroll
                for (int q = 0; q < 16; ++q) { aR[q] = 0.f; aI[q] = 0.f; }
                const float* wR = lru_gw + ((size_t)(((l * 2 + d) * 2 + 0) * 4 + n) * 64) * 64 + e;
                const float* wI = lru_gw + ((size_t)(((l * 2 + d) * 2 + 1) * 4 + n) * 64) * 64 + e;
#pragma unroll 8
                for (int d4 = 0; d4 < 16; ++d4) {
                    const float r0w = wR[(d4 * 4 + 0) * 64], r1w = wR[(d4 * 4 + 1) * 64], r2w = wR[(d4 * 4 + 2) * 64], r3w = wR[(d4 * 4 + 3) * 64];
                    const float i0w = wI[(d4 * 4 + 0) * 64], i1w = wI[(d4 * 4 + 1) * 64], i2w = wI[(d4 * 4 + 2) * 64], i3w = wI[(d4 * 4 + 3) * 64];
#pragma unroll
                    for (int q = 0; q < 16; ++q) { const f32x4 xv = *(const LAS f32x4*)(xls + (half * 16 + q) * 256 + n * 64 + d4 * 4);
                        aR[q] += xv.x * r0w + xv.y * r1w + xv.z * r2w + xv.w * r3w; aI[q] += xv.x * i0w + xv.y * i1w + xv.z * i2w + xv.w * i3w; }
                }
                const float bR = lru_gb[((l * 2 + d) * 2 + 0) * 256 + ch], bI = lru_gb[((l * 2 + d) * 2 + 1) * 256 + ch];
                const float lam = lru_lam[(l * 2 + d) * 256 + ch]; const float sp = log1pf(expf(-lam));
                float* LA = LAB + (size_t)(2 * d) * LAB_STRIDE; float* LB = LAB + (size_t)(2 * d + 1) * LAB_STRIDE;
#pragma unroll
                for (int q = 0; q < 16; ++q) { const int tt = half * 16 + q;
                    const float rg = __builtin_amdgcn_rcpf(1.0f + __expf(-(aR[q] + bR))), ig = __builtin_amdgcn_rcpf(1.0f + __expf(-(aI[q] + bI)));
                    const float log_a = -8.0f * rg * sp; const float a = __expf(log_a);
                    const float bx = sqrtf(fmaxf(-expm1f(2.0f * log_a), 0.f)) * (ig * xls[tt * 256 + ch]);
                    LA[(size_t)(r0 + tt) * 256 + ch] = a; LB[(size_t)(r0 + tt) * 256 + ch] = bx; }
            }
            __syncthreads();
        }
    }
    {
        LAS bf16* hs = (LAS bf16*)(F.lds);
        float* VT = (float*)(F.ws + WS_VT); float* X0T = (float*)(F.ws + WS_X0T);
        const float* cw = hy_cw + (size_t)l * 3 * 768; const float* cbp = hy_cb + l * 768;
        for (int it = blockIdx.x; it < NLAT / 64; it += F.G) {
            const int b = it >> 7, t0 = (it & 127) * 64;
            for (int i = F.tid; i < 66 * 384; i += NTHR) { const int rr = i / 384, c2 = i - rr * 384; const int t = t0 - 1 + rr;
                unsigned w = 0u; if (t >= 0 && t < SEQ) w = *(const unsigned*)(U + (size_t)(b * SEQ + t) * INW + 1280 + 2 * c2);
                *(LAS unsigned*)(hs + rr * 770 + 2 * c2) = w; }
            __syncthreads();
            for (int c = F.wave; c < 256; c += NWAVES) {
                const int tt = F.lane;
                float o[3];
#pragma unroll
                for (int g = 0; g < 3; ++g) { const int cc = g * 256 + c;
                    o[g] = cw[cc] * bf2f(hs[tt * 770 + cc]) + cw[768 + cc] * bf2f(hs[(tt + 1) * 770 + cc]) + cw[1536 + cc] * bf2f(hs[(tt + 2) * 770 + cc]) + cbp[cc]; }
                const size_t oi = ((size_t)b * 256 + c) * SEQ + t0 + tt;
                VT[oi] = o[2] * o[1]; X0T[oi] = o[0];
            }
            __syncthreads();
        }
    }
}

__device__ __forceinline__ void ph_ctx_attn(const Frame& F) {
    const bf16* Q = (const bf16*)(F.ws + WS_Q); const bf16* K = (const bf16*)(F.ws + WS_K); const bf16* V = (const bf16*)(F.ws + WS_V); bf16* O = (bf16*)(F.ws + WS_ATT);
    LAS float* qs = (LAS float*)(F.lds + 90112 + F.wave * 1280);
    LAS float* ps = qs + 64;
    for (int it = F.gw; it < NCTX * 8; it += F.ngw) {
        const int rc = it >> 3, h = it & 7, b = rc / CTXL, kvh = h >> 2; const int r = NLAT + rc;
        qs[F.lane] = bf2f(Q[(size_t)r * 512 + h * 64 + F.lane]);
        LDS_WAIT();
        float sc[4]; float mx = -INFINITY;
#pragma unroll
        for (int i = 0; i < 4; ++i) { const int key = F.lane + 64 * i; const v4u* kp = (const v4u*)(K + ((size_t)b * KEYS + key) * 128 + kvh * 64);
            float s = 0.f;
#pragma unroll
            for (int q = 0; q < 8; ++q) { const v4u w = kp[q];
                s += qs[8 * q] * bflo(w.x) + qs[8 * q + 1] * bfhi(w.x) + qs[8 * q + 2] * bflo(w.y) + qs[8 * q + 3] * bfhi(w.y) + qs[8 * q + 4] * bflo(w.z) + qs[8 * q + 5] * bfhi(w.z) + qs[8 * q + 6] * bflo(w.w) + qs[8 * q + 7] * bfhi(w.w); }
            sc[i] = s; mx = fmaxf(mx, s); }
#pragma unroll
        for (int o = 1; o < 64; o <<= 1) mx = fmaxf(mx, __shfl_xor(mx, o));
        float sum = 0.f;
#pragma unroll
        for (int i = 0; i < 4; ++i) { const float p = exp2f(sc[i] - mx); sum += p; ps[F.lane + 64 * i] = p; }
        sum = wave_sum(sum);
        LDS_WAIT();
        float acc = 0.f;
        const bf16* vp = V + (size_t)b * KEYS * 128 + kvh * 64 + F.lane;
#pragma unroll 8
        for (int key = 0; key < CTXL; ++key) acc += ps[key] * bf2f(vp[(size_t)key * 128]);
        O[(size_t)r * 512 + h * 64 + F.lane] = (bf16)f2bf(acc / sum);
        LDS_WAIT();
    }
}

__device__ __forceinline__ int chunk_row0(int b, int d, int k) {
    if (k < 2) { const int cc = d ? 1 - k : k; return NLAT + b * CTXL + cc * CHUNK; }
    const int lc = d ? 63 - (k - 2) : (k - 2); return b * SEQ + lc * CHUNK;
}
__device__ __forceinline__ void ph_scan1(const Frame& F) {
    const float* LAB = (const float*)(F.ws + WS_LAB); float* SUMP = (float*)(F.ws + WS_SCANS); float* SUMH = SUMP + NB * 2 * NCHUNK * 256;
    for (int it = blockIdx.x * NTHR + F.tid; it < NB * 2 * NCHUNK * 256; it += F.G * NTHR) {
        const int ch = it & 255, k = (it >> 8) % NCHUNK, bd = (it >> 8) / NCHUNK, d = bd & 1, b = bd >> 1;
        const int r0 = chunk_row0(b, d, k);
        const float* LA = LAB + (size_t)(2 * d) * LAB_STRIDE + ch; const float* LB = LAB + (size_t)(2 * d + 1) * LAB_STRIDE + ch;
        float h = 0.f, P = 1.f;
#pragma unroll 8
        for (int i = 0; i < CHUNK; ++i) { const int r = d ? r0 + CHUNK - 1 - i : r0 + i; const float a = LA[(size_t)r * 256], bx = LB[(size_t)r * 256]; h = a * h + bx; P *= a; }
        SUMP[it] = P; SUMH[it] = h;
    }
}
__device__ __forceinline__ void ph_scan2(const Frame& F) {
    const float* LAB = (const float*)(F.ws + WS_LAB); const float* SUMP = (const float*)(F.ws + WS_SCANS); const float* SUMH = SUMP + NB * 2 * NCHUNK * 256;
    float* LRUO = (float*)(F.ws + WS_LRUO); const bf16* U = (const bf16*)(F.ws + WS_U);
    for (int it = blockIdx.x * NTHR + F.tid; it < NB * NCHUNK * 256; it += F.G * NTHR) {
        const int ch = it & 255, kc = (it >> 8) % NCHUNK, b = (it >> 8) / NCHUNK;
        const int r0 = chunk_row0(b, 0, kc);
#pragma unroll 1
        for (int d = 0; d < 2; ++d) {
            const int k = d ? ((kc < 2) ? 1 - kc : 2 + 63 - (kc - 2)) : kc;
            const size_t sb = (size_t)((b * 2 + d) * NCHUNK) * 256 + ch;
            float h = 0.f;
            for (int j = 0; j < k; ++j) h = SUMP[sb + (size_t)j * 256] * h + SUMH[sb + (size_t)j * 256];
            const float* LA = LAB + (size_t)(2 * d) * LAB_STRIDE + ch; const float* LB = LAB + (size_t)(2 * d + 1) * LAB_STRIDE + ch;
            if (d == 0) {
#pragma unroll 8
                for (int i = 0; i < CHUNK; ++i) { const int r = r0 + i; h = LA[(size_t)r * 256] * h + LB[(size_t)r * 256]; LRUO[(size_t)r * 256 + ch] = h; }
            } else {
#pragma unroll 8
                for (int i = 0; i < CHUNK; ++i) { const int r = r0 + CHUNK - 1 - i; h = LA[(size_t)r * 256] * h + LB[(size_t)r * 256];
                    const float lg = bf2f(U[(size_t)r * INW + 1024 + ch]);
                    LRUO[(size_t)r * 256 + ch] = (LRUO[(size_t)r * 256 + ch] + h) * gelu_tanh(lg); }
            }
        }
    }
}

__device__ __forceinline__ void ph_hyena_direct(const Frame& F, int l, const float* hy_bias, const float* hy_cw, const float* hy_cb) {
    LAS float* ks = (LAS float*)(F.lds);
    LAS float* vs = (LAS float*)(F.lds + 65536);
    const float* KF = (const float*)(F.ws + WS_KF) + (size_t)l * 256 * 16384;
    const float* VT = (const float*)(F.ws + WS_VT); const float* X0T = (const float*)(F.ws + WS_X0T); float* HYO = (float*)(F.ws + WS_HYO);
    for (int it = blockIdx.x; it < 512; it += F.G) {
        const int c = it >> 1, bp = it & 1;
        for (int i = F.tid; i < 4096; i += NTHR) ((LAS f32x4*)ks)[i] = ((const f32x4*)(KF + (size_t)c * 16384))[i];
        for (int i = F.tid; i < 4096; i += NTHR) { const int bb = i >> 11, q = i & 2047; ((LAS f32x4*)vs)[i] = ((const f32x4*)(VT + ((size_t)(bp * 2 + bb) * 256 + c) * SEQ))[q]; }
        __syncthreads();
        float y0[16], y1[16];
#pragma unroll
        for (int i = 0; i < 16; ++i) { y0[i] = 0.f; y1[i] = 0.f; }
#pragma unroll 2
        for (int s = 0; s < SEQ; ++s) {
            const float v0 = vs[s], v1 = vs[SEQ + s];
            const int base = (F.tid - s) & 16383;
#pragma unroll
            for (int i = 0; i < 16; ++i) { const float kk = ks[(base + 512 * i) & 16383]; y0[i] += kk * v0; y1[i] += kk * v1; }
        }
        const float bias = hy_bias[l * 256 + c];
#pragma unroll
        for (int i = 0; i < 16; ++i) { const int t = F.tid + 512 * i;
            { const int b = bp * 2; const size_t oi = ((size_t)b * 256 + c) * SEQ + t; HYO[((size_t)b * SEQ + t) * 256 + c] = (y0[i] + vs[t] * bias) * X0T[oi]; }
            { const int b = bp * 2 + 1; const size_t oi = ((size_t)b * 256 + c) * SEQ + t; HYO[((size_t)b * SEQ + t) * 256 + c] = (y1[i] + vs[SEQ + t] * bias) * X0T[oi]; } }
        __syncthreads();
    }
}
__device__ __forceinline__ void ph_khat(const Frame& F) {
    LAS f32x2v* D = (LAS f32x2v*)(F.lds);
    const float* KF = (const float*)(F.ws + WS_KF); c32* KHAT = (c32*)(F.ws + WS_KHAT);
    for (int it = blockIdx.x; it < 512; it += F.G) {
        const float* k = KF + (size_t)it * 16384; c32* out = KHAT + (size_t)it * 16384;
#pragma unroll 1
        for (int i = 0; i < 8; ++i) { const int j = F.tid + 512 * i; c32 x0, x1, x2, x3; x0.x = k[j]; x1.x = k[j + 4096]; x2.x = k[j + 8192]; x3.x = k[j + 12288]; x0.y = x1.y = x2.y = x3.y = 0.f;
            fft_first4(D, j, x0, x1, x2, x3); }
        __syncthreads();
        _Pragma("unroll 1") for (int g_ = F.tid; g_ < 1024; g_ += 512) fft_fwd16(D, g_, 4096);
        __syncthreads();
        _Pragma("unroll 1") for (int g_ = F.tid; g_ < 1024; g_ += 512) fft_fwd16(D, g_, 256);
        __syncthreads();
        _Pragma("unroll 1") for (int g_ = F.tid; g_ < 1024; g_ += 512) fft_last16_out(D, g_, out, 1.0f / 16384.0f);
        __syncthreads();
    }
}
__device__ __forceinline__ void ph_hyena_fft(const Frame& F, int l, const float* hy_bias) {
    LAS f32x2v* D = (LAS f32x2v*)(F.lds);
    const c32* KHAT = (const c32*)(F.ws + WS_KHAT) + (size_t)l * 256 * 16384;
    const float* VT = (const float*)(F.ws + WS_VT); const float* X0T = (const float*)(F.ws + WS_X0T); float* HYO = (float*)(F.ws + WS_HYO);
    for (int it = blockIdx.x; it < 512; it += F.G) {
        const int c = it >> 1, bp = it & 1;
        const float* va = VT + ((size_t)(bp * 2) * 256 + c) * SEQ; const float* vb = VT + ((size_t)(bp * 2 + 1) * 256 + c) * SEQ;
#ifndef REP_FFT
#define REP_FFT 1
#endif
#pragma unroll 1
        for (int repf_ = 0; repf_ < REP_FFT; ++repf_) {
#pragma unroll 1
        for (int i = 0; i < 8; ++i) { const int j = F.tid + 512 * i; c32 x0, x1, z; x0.x = va[j]; x0.y = vb[j]; x1.x = va[j + 4096]; x1.y = vb[j + 4096]; z.x = 0.f; z.y = 0.f;
            fft_first4(D, j, x0, x1, z, z); }
        __syncthreads();
        _Pragma("unroll 1") for (int g_ = F.tid; g_ < 1024; g_ += 512) fft_fwd16(D, g_, 4096);
        __syncthreads();
        _Pragma("unroll 1") for (int g_ = F.tid; g_ < 1024; g_ += 512) fft_fwd16(D, g_, 256);
        __syncthreads();
        _Pragma("unroll 1") for (int g_ = F.tid; g_ < 1024; g_ += 512) fft_mid16(D, g_, KHAT + (size_t)c * 16384);
        __syncthreads();
        _Pragma("unroll 1") for (int g_ = F.tid; g_ < 1024; g_ += 512) fft_inv16(D, g_, 256);
        __syncthreads();
        _Pragma("unroll 1") for (int g_ = F.tid; g_ < 1024; g_ += 512) fft_inv16(D, g_, 4096);
        __syncthreads();
        }
        const float bias = hy_bias[l * 256 + c];
        const float* xa = X0T + ((size_t)(bp * 2) * 256 + c) * SEQ; const float* xb = X0T + ((size_t)(bp * 2 + 1) * 256 + c) * SEQ;
        float* oa = HYO + ((size_t)(bp * 2) * 256 + c) * SEQ; float* ob = HYO + ((size_t)(bp * 2 + 1) * 256 + c) * SEQ;
#pragma unroll 2
        for (int i = 0; i < 8; ++i) { const int j = F.tid + 512 * i; c32 u0, u1; fft_final4(D, j, u0, u1);
            oa[j] = (u0.x + va[j] * bias) * xa[j];                 ob[j] = (-u0.y + vb[j] * bias) * xb[j];
            oa[j + 4096] = (u1.x + va[j + 4096] * bias) * xa[j + 4096]; ob[j + 4096] = (-u1.y + vb[j + 4096] * bias) * xb[j + 4096]; }
        __syncthreads();
    }
}
__device__ __forceinline__ void ph_hyena_ctx(const Frame& F, const float* hy_bias, const float* hy_cw, const float* hy_cb) {
    float* HYO = (float*)(F.ws + WS_HYO);
    {

        const bf16* U = (const bf16*)(F.ws + WS_U); const float* KFC = (const float*)(F.ws + WS_KFC);
        LAS float* vw = (LAS float*)(F.lds + F.wave * 4096);
        LAS float* kw = vw + 256;
        const float* cw = hy_cw; const float* cbp = hy_cb;
        for (int it = F.gw; it < NB * 256; it += F.ngw) {
            const int b = it >> 8, c = it & 255;
            float x0v[4];
#pragma unroll
            for (int i = 0; i < 4; ++i) { const int t = F.lane + 64 * i;
                float o[3];
#pragma unroll
                for (int g = 0; g < 3; ++g) { const int cc = g * 256 + c; float a = cbp[cc];
#pragma unroll
                    for (int j = 0; j < 3; ++j) { const int tj = t + j - 1; if (tj >= 0 && tj < CTXL) a += cw[j * 768 + cc] * bf2f(U[(size_t)(NLAT + b * CTXL + tj) * INW + 1280 + cc]); }
                    o[g] = a; }
                vw[t] = o[2] * o[1]; x0v[i] = o[0]; }
#pragma unroll
            for (int i = 0; i < 8; ++i) kw[F.lane + 64 * i] = KFC[c * 512 + F.lane + 64 * i];
            LDS_WAIT();
            float y[4] = {0.f, 0.f, 0.f, 0.f};
#pragma unroll 4
            for (int s = 0; s < CTXL; ++s) { const float vv = vw[s];
#pragma unroll
                for (int i = 0; i < 4; ++i) y[i] += kw[(F.lane + 64 * i - s) & 511] * vv; }
            const float bias = hy_bias[c];
#pragma unroll
            for (int i = 0; i < 4; ++i) { const int t = F.lane + 64 * i; HYO[(size_t)(NLAT + b * CTXL + t) * 256 + c] = (y[i] + vw[t] * bias) * x0v[i]; }
            LDS_WAIT();
        }
    }
}

__device__ __forceinline__ void merge_row(const Frame& F, int r, const float* g, float h0, float h1, float h2, float h3) {
    const bf16* ATT = (const bf16*)(F.ws + WS_ATT); const float* LRUO = (const float*)(F.ws + WS_LRUO); bf16* MIXA = (bf16*)(F.ws + WS_MIXA);
    const v4u aw = ((const v4u*)(ATT + (size_t)r * 512))[F.lane];
    float a[8] = {bflo(aw.x), bfhi(aw.x), bflo(aw.y), bfhi(aw.y), bflo(aw.z), bfhi(aw.z), bflo(aw.w), bfhi(aw.w)};
    float ss = 0.f;
#pragma unroll
    for (int i = 0; i < 8; ++i) ss += a[i] * a[i];
    const float ra = 1.0f / sqrtf(wave_sum(ss) * (1.0f / 512.0f) + EPSN);
    const f32x4 lv = ((const f32x4*)(LRUO + (size_t)r * 256))[F.lane];
    const float rl = 1.0f / sqrtf(wave_sum(lv.x * lv.x + lv.y * lv.y + lv.z * lv.z + lv.w * lv.w) * (1.0f / 256.0f) + EPSN);
    const float rh = 1.0f / sqrtf(wave_sum(h0 * h0 + h1 * h1 + h2 * h2 + h3 * h3) * (1.0f / 256.0f) + EPSN);
    bf16* orow = MIXA + (size_t)r * 1024;
    { const f32x4 g0 = ((const f32x4*)g)[2 * F.lane], g1 = ((const f32x4*)g)[2 * F.lane + 1];
      v4u o; o.x = pk2(a[0] * ra * g0.x, a[1] * ra * g0.y); o.y = pk2(a[2] * ra * g0.z, a[3] * ra * g0.w); o.z = pk2(a[4] * ra * g1.x, a[5] * ra * g1.y); o.w = pk2(a[6] * ra * g1.z, a[7] * ra * g1.w);
      ((v4u*)orow)[F.lane] = o; }
    { const f32x4 gg = ((const f32x4*)(g + 512))[F.lane]; v2u o; o.x = pk2(lv.x * rl * gg.x, lv.y * rl * gg.y); o.y = pk2(lv.z * rl * gg.z, lv.w * rl * gg.w); ((v2u*)(orow + 512))[F.lane] = o; }
    orow[768 + F.lane] = (bf16)f2bf(h0 * rh * g[768 + F.lane]); orow[832 + F.lane] = (bf16)f2bf(h1 * rh * g[832 + F.lane]);
    orow[896 + F.lane] = (bf16)f2bf(h2 * rh * g[896 + F.lane]); orow[960 + F.lane] = (bf16)f2bf(h3 * rh * g[960 + F.lane]);
}
__device__ __forceinline__ void ph_merge(const Frame& F, int l, int nrows, const float* out_g) {
    const float* HYO = (const float*)(F.ws + WS_HYO);
    const float* g = out_g + l * 1024;
    LAS float* tile = (LAS float*)(F.lds);
    for (int it = blockIdx.x; it < NLAT / 64; it += F.G) {
        const int b = it >> 7, t0 = (it & 127) * 64;
#pragma unroll 8
        for (int i = 0; i < 32; ++i) { const int c = F.wave * 32 + i; tile[c * 65 + F.lane] = HYO[((size_t)b * 256 + c) * SEQ + t0 + F.lane]; }
        __syncthreads();
#pragma unroll 2
        for (int k = 0; k < 8; ++k) { const int tt = F.wave * 8 + k;
            merge_row(F, b * SEQ + t0 + tt, g, tile[F.lane * 65 + tt], tile[(F.lane + 64) * 65 + tt], tile[(F.lane + 128) * 65 + tt], tile[(F.lane + 192) * 65 + tt]); }
        __syncthreads();
    }
    for (int r = NLAT + F.gw; r < nrows; r += F.ngw) {
        const float* hr = HYO + (size_t)r * 256;
        merge_row(F, r, g, hr[F.lane], hr[64 + F.lane], hr[128 + F.lane], hr[192 + F.lane]);
    }
}

__device__ __forceinline__ void ph_ffn_router(const Frame& F, int l, int nrows, const float* gffn, const float* router_w, const float* router_b) {
    LAS float* rwl = (LAS float*)(F.lds);
    LAS int* hist = (LAS int*)(F.lds + 135168);
    const float* XR = (const float*)(F.ws + WS_XR); const float* MOD = (const float*)(F.ws + WS_MOD); bf16* Fb = (bf16*)(F.ws + WS_F);
    int* TOPI = (int*)(F.ws + WS_TOPI); float* GATE = (float*)(F.ws + WS_GATE); int* BLKCNT = (int*)(F.ws + WS_BLKCNT);
    for (int i = F.tid; i < 1024 * 32; i += NTHR) rwl[(i >> 5) * 33 + (i & 31)] = router_w[(size_t)l * 32768 + i];
    if (F.tid < 32) hist[F.tid] = 0;
    __syncthreads();
    const float* g = gffn + l * 1024;
    for (int r = F.gw; r < nrows; r += F.ngw) {
        const int bidx = r < NLAT ? r / SEQ : 4;
        const float* sf = MOD + (size_t)(l * 5 + bidx) * 6144 + 3 * 1024; const float* cf = sf + 1024;
        float f[16]; float ss = 0.f;
#pragma unroll
        for (int j = 0; j < 16; ++j) { f[j] = XR[(size_t)r * 1024 + 64 * j + F.lane]; ss += f[j] * f[j]; }
        const float rstd = 1.0f / sqrtf(wave_sum(ss) * (1.0f / 1024.0f) + EPSN);
        float p[32];
#pragma unroll
        for (int e = 0; e < 32; ++e) p[e] = 0.f;
#pragma unroll
        for (int j = 0; j < 16; ++j) { const int c = 64 * j + F.lane; const float fv = f[j] * rstd * g[c] * (1.0f + cf[c]) + sf[c];
            Fb[(size_t)r * 1024 + c] = (bf16)f2bf(fv);
            const LAS float* wrow = rwl + c * 33;
#pragma unroll
            for (int e = 0; e < 32; ++e) p[e] += fv * wrow[e]; }
#pragma unroll
        for (int e = 0; e < 32; ++e) p[e] = wave_sum(p[e]) + router_b[l * 32 + e];
        unsigned taken = 0u; float tv[4]; int ti[4];
#pragma unroll
        for (int k = 0; k < 4; ++k) { float best = -INFINITY; int bi = 0;
#pragma unroll
            for (int e = 0; e < 32; ++e) { const bool ok = !((taken >> e) & 1u) && (p[e] > best); best = ok ? p[e] : best; bi = ok ? e : bi; }
            taken |= 1u << bi; tv[k] = best; ti[k] = bi; }
        const float e1 = __expf(tv[1] - tv[0]), e2 = __expf(tv[2] - tv[0]), e3 = __expf(tv[3] - tv[0]); const float inv = 1.0f / (1.0f + e1 + e2 + e3);
        if (F.lane == 0) {
            TOPI[r * 4 + 0] = ti[0]; TOPI[r * 4 + 1] = ti[1]; TOPI[r * 4 + 2] = ti[2]; TOPI[r * 4 + 3] = ti[3];
            GATE[r * 4 + 0] = inv; GATE[r * 4 + 1] = e1 * inv; GATE[r * 4 + 2] = e2 * inv; GATE[r * 4 + 3] = e3 * inv;
            lds_add(&hist[ti[0]], 1); lds_add(&hist[ti[1]], 1); lds_add(&hist[ti[2]], 1); lds_add(&hist[ti[3]], 1);
        }
    }
    __syncthreads();
    if (F.tid < 32) BLKCNT[blockIdx.x * 32 + F.tid] = hist[F.tid];
}

__device__ __forceinline__ void ph_route(const Frame& F, int nrows) {
    LAS int* cursor = (LAS int*)(F.lds);
    LAS int* tot = cursor + 32;
    LAS int* mine = cursor + 64;
    const int* BLKCNT = (const int*)(F.ws + WS_BLKCNT); const int* TOPI = (const int*)(F.ws + WS_TOPI); int* POS = (int*)(F.ws + WS_POS);
    const bf16* Fb = (const bf16*)(F.ws + WS_F); bf16* AS = (bf16*)(F.ws + WS_ASORT); int* TILEE = (int*)(F.ws + WS_TILEE);
    if (F.tid < 32) { int t = 0, m = 0; for (int b = 0; b < F.G; ++b) { const int v = BLKCNT[b * 32 + F.tid]; t += v; m += (b < (int)blockIdx.x) ? v : 0; } tot[F.tid] = t; mine[F.tid] = m; }
    __syncthreads();
    if (F.tid == 0) { int tb = 0;
        for (int e = 0; e < 32; ++e) { const int nt = (tot[e] + 255) >> 8; cursor[e] = tb * 256 + mine[e];
            if (blockIdx.x == 0) for (int j = 0; j < nt; ++j) TILEE[tb + j] = e;
            tb += nt; }
        if (blockIdx.x == 0) F.ctl[CW_NTILES] = (unsigned)tb; }
    __syncthreads();
    for (int r = F.gw; r < nrows; r += F.ngw) {
        int pos = 0;
        if (F.lane < 4) { const int e = TOPI[r * 4 + F.lane]; pos = lds_add(&cursor[e], 1); POS[r * 4 + F.lane] = pos; }
        const v4u a0 = ((const v4u*)(Fb + (size_t)r * 1024))[F.lane], a1 = ((const v4u*)(Fb + (size_t)r * 1024))[64 + F.lane];
#pragma unroll
        for (int k = 0; k < 4; ++k) { const int pk = __shfl(pos, k); v4u* dst = (v4u*)(AS + (size_t)pk * 1024); dst[F.lane] = a0; dst[64 + F.lane] = a1; }
    }
}

__device__ __forceinline__ void ph_combine(const Frame& F, int l, int nrows, float* out, const float* gmix) {
    float* XR = (float*)(F.ws + WS_XR); const float* MOD = (const float*)(F.ws + WS_MOD); const bf16* YS = (const bf16*)(F.ws + WS_YS); bf16* H = (bf16*)(F.ws + WS_H);
    const int* POS = (const int*)(F.ws + WS_POS); const float* GATE = (const float*)(F.ws + WS_GATE);
    for (int r = F.gw; r < nrows; r += F.ngw) {
        const int bidx = r < NLAT ? r / SEQ : 4;
        const float* gf = MOD + (size_t)(l * 5 + bidx) * 6144 + 5 * 1024;
        int pos = 0; float gt = 0.f;
        if (F.lane < 4) { pos = POS[r * 4 + F.lane]; gt = GATE[r * 4 + F.lane]; }
        f32x4 y[4];
#pragma unroll
        for (int j = 0; j < 4; ++j) y[j] = (f32x4){0.f, 0.f, 0.f, 0.f};
#pragma unroll
        for (int k = 0; k < 4; ++k) { const int pk = __shfl(pos, k); const float gk = __shfl(gt, k); const v2u* yr = (const v2u*)(YS + (size_t)pk * 1024);
#pragma unroll
            for (int j = 0; j < 4; ++j) { const v2u w = yr[64 * j + F.lane]; y[j].x += gk * bflo(w.x); y[j].y += gk * bfhi(w.x); y[j].z += gk * bflo(w.y); y[j].w += gk * bfhi(w.y); } }
        float* dst = (l == 0) ? XR + (size_t)r * 1024 : out + (size_t)r * 1024;
        float ss = 0.f;
#pragma unroll
        for (int j = 0; j < 4; ++j) { const int cb = 64 * j + F.lane; const f32x4 xv = ((const f32x4*)(XR + (size_t)r * 1024))[cb]; const f32x4 gv = ((const f32x4*)gf)[cb];
            y[j] = xv + gv * y[j]; ((f32x4*)dst)[cb] = y[j]; ss += (y[j].x * y[j].x + y[j].y * y[j].y) + (y[j].z * y[j].z + y[j].w * y[j].w); }
        if (l == 0) {
            const float rstd = 1.0f / sqrtf(wave_sum(ss) * (1.0f / 1024.0f) + EPSN);
            const float* shift = MOD + (size_t)(5 + bidx) * 6144; const float* scale = shift + 1024; const float* g = gmix + 1024;
#pragma unroll
            for (int j = 0; j < 4; ++j) { const int cb = 64 * j + F.lane; const f32x4 gg = ((const f32x4*)g)[cb], sc = ((const f32x4*)scale)[cb], sh = ((const f32x4*)shift)[cb];
                const f32x4 hv = y[j] * rstd * gg * (sc + 1.0f) + sh;
                v2u o; o.x = pk2(hv.x, hv.y); o.y = pk2(hv.z, hv.w); ((v2u*)(H + (size_t)r * 1024))[cb] = o; }
        }
    }
}

struct Args { const float* in[34]; float* out; unsigned char* ws; int ph_lo, ph_hi; };
enum { I_X = 0, I_C, I_CTX, I_CCTX, I_WMOD, I_BMOD, I_GMIX, I_GFFN, I_WIN, I_QG, I_KG, I_LCW, I_LCB, I_LGW, I_LGB, I_LLAM, I_HCW, I_HCB, I_HW1, I_HB1, I_HW2, I_HB2, I_HW3, I_HFREQ, I_HDEC, I_HBIAS,
       I_OUTG, I_WOUT, I_RW, I_RB, I_MW1, I_MB1, I_MW2, I_MB2 };

__global__ void __launch_bounds__(NTHR, 2) mk_fwd(Args args) {
    extern __shared__ __attribute__((aligned(16))) unsigned char lds[];
    Frame F;
    F.lds = (LAS unsigned char*)lds; F.ws = args.ws; F.ctl = (unsigned*)(args.ws + WS_CTL);
    F.tid = threadIdx.x; F.lane = F.tid & 63; F.wave = __builtin_amdgcn_readfirstlane(F.tid >> 6);
    F.G = gridDim.x; { const int bx = blockIdx.x; F.vcu = (F.G % 8 == 0) ? (bx % 8) * (F.G / 8) + bx / 8 : bx; }
    F.gw = (int)blockIdx.x * NWAVES + F.wave; F.ngw = F.G * NWAVES;
    for (int u = F.tid; u < (LDS_BYTES - LDSCTL_OFF) / 4; u += NTHR) ((LAS unsigned*)(F.lds + LDSCTL_OFF))[u] = 0u;
    __syncthreads();
#if !MK_PER_PHASE
    XcdBarrier bar = xcd_barrier_post(F.ctl + CW_BAR, (volatile LAS unsigned*)(F.lds + LDSCTL_OFF + 32));
#define GRID_BAR() xcd_barrier(bar)
#else
#define GRID_BAR() do { } while (0)
#endif
    const int lo = args.ph_lo, hi = args.ph_hi;
#ifndef ONLY_PHASE
#define ONLY_PHASE (-1)
#endif
#define ENABLED(id) (ONLY_PHASE < 0 || ONLY_PHASE == (id))
#define IN(k) (ENABLED(k) && lo <= (k) && (k) < hi)
#define INL(j) (ENABLED(NPH_PRO + (j)) && lo <= pb + (j) && pb + (j) < hi)
#define SEAML(j) do { if (lo <= pb + (j) && pb + (j) + 1 < hi) { GRID_BAR(); } } while (0)
typedef const __attribute__((address_space(4))) Args* KArgs;
#ifndef REP_MASK
#define REP_MASK 0
#endif
#define NREP(j) (((REP_MASK >> (j)) & 1) ? 2 : 1)
#define REFRAME() Frame Fp = F; KArgs ka = (KArgs)__builtin_amdgcn_kernarg_segment_ptr(); { int t_ = F.tid; asm volatile("" : "+v"(t_), "+s"(ka)); Fp.tid = t_; Fp.lane = t_ & 63; Fp.wave = __builtin_amdgcn_readfirstlane(t_ >> 6); \
    Fp.gw = (int)blockIdx.x * NWAVES + Fp.wave; Fp.ws = ka->ws; Fp.ctl = (unsigned*)(ka->ws + WS_CTL); }
#define SEAM(k) do { if (lo <= (k) && (k) + 1 < hi) { GRID_BAR(); } } while (0)

    if (IN(0)) ph_prologue_a(F, args.in[I_C], args.in[I_CCTX], args.in[I_WMOD], args.in[I_BMOD], args.in[I_WIN], args.in[I_WOUT], args.in[I_MW1], args.in[I_MW2],
                             args.in[I_HW1], args.in[I_HB1], args.in[I_HW2], args.in[I_HB2], args.in[I_HFREQ]);
    SEAM(0);
    if (IN(1)) ph_prologue_b(F, args.in[I_HW3], args.in[I_HDEC]);
    SEAM(1);

#define PHASE(j, ...) if (INL(j)) { _Pragma("unroll") for (int rep_ = 0; rep_ < NREP(j); ++rep_) { { REFRAME(); __VA_ARGS__ } if (rep_ + 1 < NREP(j)) GRID_BAR(); } }
#define LAYER_BODY(l) { \
        const int pb = NPH_PRO + l * NPH_LAYER; \
        const int nrows = (l == 0) ? MT : NLAT; \
        if (l == 0) { PHASE(0, ph_norm_mod(Fp, l, ka->in[I_X], ka->in[I_CTX], ka->in[I_GMIX]);) SEAML(0); } \
        PHASE(1, \
            pg8::Gemm g{(const bf16*)(Fp.ws + WS_H), (const bf16*)(Fp.ws + WS_WINT) + (size_t)l * 2048 * 1024, MT, 2048, 1024}; \
            pg8::StaticOrder S; S.init(MT, 2048, Fp.G, (int)blockIdx.x); \
            pg8::EpiBf16<0> E{(bf16*)(Fp.ws + WS_U), 2048, nullptr, 0, 0, 1.f}; \
            pg8::gemm_phase<pg8::EpiBf16<0>, pg8::StaticOrder, PG8_ALIGN, PG8_SP2>(Fp.lds + RING_OFF, g, S, E);) \
        SEAML(1); \
        PHASE(2, ph_post_proj(Fp, l, ka->in[I_QG], ka->in[I_KG], ka->in[I_LCW], ka->in[I_LCB], ka->in[I_LGW], ka->in[I_LGB], ka->in[I_LLAM], ka->in[I_HCW], ka->in[I_HCB]);) \
        SEAML(2); \
        PHASE(3, \
            ph_scan1(Fp); __syncthreads(); \
            const attn_body::AttnTensors AT{(const attn_body::bf16*)(Fp.ws + WS_Q), (const attn_body::bf16*)(Fp.ws + WS_K), (const attn_body::bf16*)(Fp.ws + WS_V), (attn_body::bf16*)(Fp.ws + WS_ATT)}; \
            attn_body::attn_phase<8>((char*)lds + RING_OFF, AT, Fp.G, Fp.vcu, l == 0, (long)NLAT);) \
        SEAML(3); \
        PHASE(4, ph_scan2(Fp); __syncthreads(); ph_hyena_fft(Fp, l, ka->in[I_HBIAS]); if (l == 0) ph_hyena_ctx(Fp, ka->in[I_HBIAS], ka->in[I_HCW], ka->in[I_HCB]);) \
        SEAML(4); \
        PHASE(5, ph_merge(Fp, l, nrows, ka->in[I_OUTG]);) \
        SEAML(5); \
        if (INL(6)) { REFRAME(); \
            pg8::Gemm g{(const bf16*)(Fp.ws + WS_MIXA), (const bf16*)(Fp.ws + WS_WOUTT) + (size_t)l * 1024 * 1024, nrows, 1024, 1024}; \
            pg8::StaticOrder S; S.init(nrows, 1024, Fp.G, (int)blockIdx.x); \
            float* XR = (float*)(Fp.ws + WS_XR); \
            pg8::EpiResid E{(l == 0) ? ka->in[I_X] : (const float*)XR, (l == 0) ? ka->in[I_CTX] : (const float*)(XR + (size_t)NLAT * 1024), NLAT, XR, 1024, \
                            (const float*)(Fp.ws + WS_MOD) + (size_t)(l * 5) * 6144 + 2 * 1024, 6144, SEQ}; \
            pg8::gemm_phase<pg8::EpiResid, pg8::StaticOrder, PG8_ALIGN, PG8_SP2>(Fp.lds + RING_OFF, g, S, E); \
        } \
        SEAML(6); \
        PHASE(7, ph_ffn_router(Fp, l, nrows, ka->in[I_GFFN], ka->in[I_RW], ka->in[I_RB]);) \
        SEAML(7); \
        PHASE(8, ph_route(Fp, nrows);) \
        SEAML(8); \
        if (INL(9) || INL(10)) { REFRAME(); \
            LAS int* tab = (LAS int*)(Fp.lds + MOETAB_OFF); \
            const int ntiles = (int)__hip_atomic_load(Fp.ctl + CW_NTILES, __ATOMIC_RELAXED, __HIP_MEMORY_SCOPE_AGENT); \
            const int* TILEE = (const int*)(Fp.ws + WS_TILEE); \
            for (int i = Fp.tid; i < ntiles && i < SORT_TILES; i += NTHR) tab[i] = TILEE[i]; \
            __syncthreads(); \
            if (INL(9)) { _Pragma("unroll") for (int rep_ = 0; rep_ < NREP(9); ++rep_) { { \
                pg8::Gemm g{(const bf16*)(Fp.ws + WS_ASORT), (const bf16*)(Fp.ws + WS_W1T) + (size_t)l * 32 * 2048 * 1024, 0, 2048, 1024}; \
                pg8::MoeOrder S; S.init(tab, ntiles, 8, Fp.G, (int)blockIdx.x); \
                pg8::EpiSwiglu E{(bf16*)(Fp.ws + WS_ACT), 1024, ka->in[I_MB1] + (size_t)l * 32 * 2048, 2048}; \
                pg8::gemm_phase<pg8::EpiSwiglu, pg8::MoeOrder, PG8_ALIGN, PG8_SP2>(Fp.lds + RING_OFF, g, S, E); \
             } if (rep_ + 1 < NREP(9)) GRID_BAR(); } } \
            SEAML(9); \
            if (INL(10)) { _Pragma("unroll") for (int rep_ = 0; rep_ < NREP(10); ++rep_) { { \
                pg8::Gemm g{(const bf16*)(Fp.ws + WS_ACT), (const bf16*)(Fp.ws + WS_W2T) + (size_t)l * 32 * 1024 * 1024, 0, 1024, 1024}; \
                pg8::MoeOrder S; S.init(tab, ntiles, 4, Fp.G, (int)blockIdx.x); \
                pg8::EpiBf16Bias E{(bf16*)(Fp.ws + WS_YS), 1024, ka->in[I_MB2] + (size_t)l * 32 * 1024, 1024}; \
                pg8::gemm_phase<pg8::EpiBf16Bias, pg8::MoeOrder, PG8_ALIGN, PG8_SP2>(Fp.lds + RING_OFF, g, S, E); \
             } if (rep_ + 1 < NREP(10)) GRID_BAR(); } } \
        } \
        SEAML(10); \
        if (INL(11)) { REFRAME(); ph_combine(Fp, l, nrows, ka->out, ka->in[I_GMIX]); } \
        if (l == 0) { SEAML(11); } \
    }
    LAYER_BODY(0)
    LAYER_BODY(1)
#undef LAYER_BODY
#undef PHASE
#undef IN
#undef SEAM
#undef INL
#undef SEAML
}

extern "C" void kernel_launch(void* const* d_in, const int* in_sizes, int n_in, void* d_out, int out_size, void* d_ws, size_t ws_size, hipStream_t stream) {
    static int grid = 0;
    if (grid == 0) {
        if (n_in != 34 || in_sizes[0] != NLAT * DMODEL || out_size != NLAT * DMODEL || ws_size < WS_END) {
            fprintf(stderr, "kernel_launch: unexpected shapes (n_in %d, in0 %d, out %d, ws %zu); nothing launched\n", n_in, n_in > 0 ? in_sizes[0] : -1, out_size, ws_size); grid = -1; return; }
        int dev = 0, cus = 0;
        if (hipGetDevice(&dev) != hipSuccess || hipDeviceGetAttribute(&cus, hipDeviceAttributeMultiprocessorCount, dev) != hipSuccess) { grid = -1; return; }
        if (hipFuncSetAttribute((const void*)mk_fwd, hipFuncAttributeMaxDynamicSharedMemorySize, LDS_BYTES) != hipSuccess) { fprintf(stderr, "kernel_launch: hipFuncSetAttribute failed\n"); grid = -1; return; }
        int per_cu = 0;
        if (hipOccupancyMaxActiveBlocksPerMultiprocessor(&per_cu, (const void*)mk_fwd, NTHR, LDS_BYTES) != hipSuccess || per_cu < 1) { fprintf(stderr, "kernel_launch: occupancy query says %d\n", per_cu); }
        (void)hipGetLastError();
        grid = cus;
    }
    if (grid < 0) return;
    if (hipMemsetAsync((char*)d_ws + WS_CTL, 0, CTL_ZERO_BYTES, stream) != hipSuccess) return;
    Args a{};
    for (int i = 0; i < 34; ++i) a.in[i] = (const float*)d_in[i];
    a.out = (float*)d_out; a.ws = (unsigned char*)d_ws;
#if MK_PER_PHASE
    for (int p = 0; p < NPH; ++p) { a.ph_lo = p; a.ph_hi = p + 1; hipLaunchKernelGGL(mk_fwd, dim3(grid), dim3(NTHR), LDS_BYTES, stream, a); }
#else
    a.ph_lo = 0; a.ph_hi = NPH;
    hipLaunchKernelGGL(mk_fwd, dim3(grid), dim3(NTHR), LDS_BYTES, stream, a);
#endif
}
```

```cpp
#include <hip/hip_runtime.h>
#include <hip/hip_bf16.h>
#include <cstdio>
#include <cstdint>
#include <cmath>
#ifndef MK_PER_PHASE
#define MK_PER_PHASE 0
#endif
namespace pg8 {
#define PG8_LAS __attribute__((address_space(3)))
typedef unsigned short bf16_t;
typedef short bf16x8 __attribute__((ext_vector_type(8)));
typedef float f32x4 __attribute__((ext_vector_type(4)));
typedef unsigned u32x4 __attribute__((ext_vector_type(4)));
constexpr int BM = 256, BK = 64, HALF = 128, HTB = HALF * BK * 2  , STAGE_BYTES = 8 * HTB, NXCD = 8, WGM = 8;

__host__ __device__ __forceinline__ int lds_byte(int r, int c) { const int st = (r >> 4) * 2 + (c >> 5), rr = r & 15, cc = c & 31, ob = rr * 64 + cc * 2; return st * 1024 + (ob ^ (((ob >> 9) & 1) << 5)); }
__host__ __device__ __forceinline__ void stage_rc(int b, int& R, int& C) { const int st = b / 1024, sb = b % 1024, swz = sb ^ (((sb >> 9) & 1) << 5); R = (st >> 1) * 16 + swz / 64; C = (st & 1) * 32 + (swz % 64) / 2; }
__host__ __device__ __forceinline__ int perm32(int rho) { const int n = rho >> 4, i = rho & 15; return 8 * (i >> 2) + 4 * n + (i & 3); }

struct Unit { int pm, pn, be, e; };
struct Gemm { const bf16_t* A; const bf16_t* Bt; int M, N, K; };

struct StaticOrder {
    int nM, nN, nwg, G, c;
    __host__ __device__ void init(int M, int N, int G_, int c_) { nM = M / BM; nN = N / BM; nwg = nM * nN; G = G_; c = c_; }
    __host__ __device__ bool next(int i, Unit& u) const {
        const long L = (long)i * G + c; if (L >= nwg) return false;
        int wgid = (int)L; { const int q = nwg / NXCD, r = nwg % NXCD, xcd = wgid % NXCD, off = wgid / NXCD; wgid = (xcd < r ? xcd * (q + 1) : r * (q + 1) + (xcd - r) * q) + off; }
        const int nig = WGM * nN, gid = wgid / nig, fm = gid * WGM, gsz = (nM - fm) < WGM ? (nM - fm) : WGM;
        u.pm = fm + ((wgid % nig) % gsz); u.pn = (wgid % nig) / gsz; u.be = u.pn; u.e = 0; return true;
    }
    __device__ __forceinline__ void a_ready(const Unit&) const {}
    __device__ __forceinline__ void done(const Unit&) const {}
};

__device__ __forceinline__ unsigned cvt_pk_bf16(float lo, float hi) { unsigned r; asm volatile("v_cvt_pk_bf16_f32 %0, %1, %2" : "=v"(r) : "v"(lo), "v"(hi)); return r; }
typedef float f32x2 __attribute__((ext_vector_type(2)));
__device__ __forceinline__ f32x2 gelu_pk(f32x2 v) {
    const f32x2 av = __builtin_elementwise_abs(v), d = av * 0.2316418882f + 1.0f;
    f32x2 t; t.x = __builtin_amdgcn_rcpf(d.x); t.y = __builtin_amdgcn_rcpf(d.y);
    f32x2 q = t * 0.5307027145f + (-0.7265760135f); q = q * t + 0.7107068705f; q = q * t + (-0.142248368f); q = q * t + 0.127414796f; q = q * t;
    const f32x2 s = (v * v) * (-0.72134752044f);
    f32x2 e; e.x = __builtin_amdgcn_exp2f(s.x); e.y = __builtin_amdgcn_exp2f(s.y);
    const f32x2 m = v * (q * e), r = v - m;
    f32x2 o; o.x = v.x < 0.f ? m.x : r.x; o.y = v.y < 0.f ? m.y : r.y; return o;
}

template <int ACT  > struct EpiBf16 {
    static constexpr bool PERM = true, AFTER_DRAIN = false; static_assert(ACT == 0 || ACT == 1, "EpiBf16: ACT is 0 (none) or 1 (gelu_pk)");
    bf16_t* O; int ldc; const float* bias; int split_cols; size_t split_stride; float scale0;
    __device__ __forceinline__ void operator()(const f32x4 (&acc)[2][2][4][2], const Unit& u, int wr, int wc, int fr, int fq) const {
        const int row0 = u.pm * BM + wr * 64 + fr; int colt = u.pn * BM; bf16_t* base = O;
        float sc = 1.f; if (split_cols) { const int t = colt / split_cols; base += (size_t)t * split_stride; colt -= t * split_cols; if (t == 0) sc = scale0; }
        const int col0 = colt + wc * 32 + 8 * fq, bcol0 = u.pn * BM + wc * 32 + 8 * fq;
        f32x4 bv[2][2];
#pragma unroll
        for (int bj = 0; bj < 2; ++bj)
#pragma unroll
            for (int n = 0; n < 2; ++n) bv[bj][n] = bias ? *(const f32x4*)(bias + bcol0 + bj * HALF + 4 * n) : (f32x4){0.f, 0.f, 0.f, 0.f};
#pragma unroll
        for (int ai = 0; ai < 2; ++ai)
#pragma unroll
            for (int m = 0; m < 4; ++m) { bf16_t* rowp = base + (size_t)(row0 + ai * HALF + m * 16) * ldc + col0;
#pragma unroll
                for (int bj = 0; bj < 2; ++bj) { f32x4 v0 = acc[ai][bj][m][0] + bv[bj][0], v1 = acc[ai][bj][m][1] + bv[bj][1];
                    if (ACT == 1) { f32x2 a = gelu_pk((f32x2){v0[0], v0[1]}), b = gelu_pk((f32x2){v0[2], v0[3]}), c = gelu_pk((f32x2){v1[0], v1[1]}), d = gelu_pk((f32x2){v1[2], v1[3]});
                        v0 = (f32x4){a.x, a.y, b.x, b.y}; v1 = (f32x4){c.x, c.y, d.x, d.y}; }
                    v0 = v0 * sc; v1 = v1 * sc; u32x4 w; w.x = cvt_pk_bf16(v0[0], v0[1]); w.y = cvt_pk_bf16(v0[2], v0[3]); w.z = cvt_pk_bf16(v1[0], v1[1]); w.w = cvt_pk_bf16(v1[2], v1[3]);
                    *(u32x4*)(rowp + bj * HALF) = w; } }
    }
};


struct EpiResid {
    static constexpr bool PERM = false, AFTER_DRAIN = false;
    const float* xin_lat; const float* xin_ctx; int nlat; float* XR; int ldc; const float* mod; int mod_stride; int seq;
    __device__ __forceinline__ void operator()(const f32x4 (&acc)[2][2][4][2], const Unit& u, int wr, int wc, int fr, int fq) const {
        const int row0 = u.pm * BM + wr * 64 + fr, col0 = u.pn * BM + wc * 32 + 4 * fq;
        const int rowt = u.pm * BM; const int bidx = rowt < nlat ? rowt / seq : 4;
        const float* gate = mod + (size_t)bidx * mod_stride;
        const float* xin = rowt < nlat ? xin_lat : (xin_ctx - (size_t)nlat * ldc);
        f32x4 gv[2][2];
#pragma unroll
        for (int bj = 0; bj < 2; ++bj)
#pragma unroll
            for (int n = 0; n < 2; ++n) gv[bj][n] = *(const f32x4*)(gate + col0 + bj * HALF + n * 16);
#pragma unroll
        for (int ai = 0; ai < 2; ++ai)
#pragma unroll
            for (int m = 0; m < 4; ++m) { const size_t ro = (size_t)(row0 + ai * HALF + m * 16) * ldc + col0;
#pragma unroll
                for (int bj = 0; bj < 2; ++bj)
#pragma unroll
                    for (int n = 0; n < 2; ++n) { const f32x4 xv = *(const f32x4*)(xin + ro + bj * HALF + n * 16);
                        *(f32x4*)(XR + ro + bj * HALF + n * 16) = xv + gv[bj][n] * acc[ai][bj][m][n]; } }
    }
};
struct EpiSwiglu {
    static constexpr bool PERM = true, AFTER_DRAIN = false;
    bf16_t* O; int ldc; const float* bias; int bias_stride;
    __device__ __forceinline__ void operator()(const f32x4 (&acc)[2][2][4][2], const Unit& u, int wr, int wc, int fr, int fq) const {
        const int row0 = u.pm * BM + wr * 64 + fr; const int bcol0 = u.pn * BM + wc * 32 + 8 * fq; const int ocol0 = bcol0 >> 1;
        const float* bb = bias + (size_t)u.e * bias_stride;
        f32x4 bv[2][2];
#pragma unroll
        for (int bj = 0; bj < 2; ++bj)
#pragma unroll
            for (int n = 0; n < 2; ++n) bv[bj][n] = *(const f32x4*)(bb + bcol0 + bj * HALF + 4 * n);
#pragma unroll
        for (int ai = 0; ai < 2; ++ai)
#pragma unroll
            for (int m = 0; m < 4; ++m) { bf16_t* rowp = O + (size_t)(row0 + ai * HALF + m * 16) * ldc + ocol0;
#pragma unroll
                for (int bj = 0; bj < 2; ++bj) { const f32x4 v0 = acc[ai][bj][m][0] + bv[bj][0], v1 = acc[ai][bj][m][1] + bv[bj][1];
                    float o[4];
#pragma unroll
                    for (int p = 0; p < 4; ++p) { const float hg = p < 2 ? v0[2 * p] : v1[2 * p - 4], hl = p < 2 ? v0[2 * p + 1] : v1[2 * p - 3];
                        const float glu = fminf(hg, 7.0f), lin = fminf(fmaxf(hl, -7.0f), 7.0f);
                        const float sg = __builtin_amdgcn_rcpf(1.0f + __builtin_amdgcn_exp2f(-1.702f * 1.4426950408889634f * glu));
                        o[p] = glu * sg * (lin + 1.0f); }
                    typedef unsigned u32x2 __attribute__((ext_vector_type(2)));
                    u32x2 w; w.x = cvt_pk_bf16(o[0], o[1]); w.y = cvt_pk_bf16(o[2], o[3]);
                    *(u32x2*)(rowp + bj * (HALF / 2)) = w; } }
    }
};
struct EpiBf16Bias {
    static constexpr bool PERM = true, AFTER_DRAIN = false;
    bf16_t* O; int ldc; const float* bias; int bias_stride;
    __device__ __forceinline__ void operator()(const f32x4 (&acc)[2][2][4][2], const Unit& u, int wr, int wc, int fr, int fq) const {
        const int row0 = u.pm * BM + wr * 64 + fr; const int col0 = u.pn * BM + wc * 32 + 8 * fq;
        const float* bb = bias + (size_t)u.e * bias_stride;
        f32x4 bv[2][2];
#pragma unroll
        for (int bj = 0; bj < 2; ++bj)
#pragma unroll
            for (int n = 0; n < 2; ++n) bv[bj][n] = *(const f32x4*)(bb + col0 + bj * HALF + 4 * n);
#pragma unroll
        for (int ai = 0; ai < 2; ++ai)
#pragma unroll
            for (int m = 0; m < 4; ++m) { bf16_t* rowp = O + (size_t)(row0 + ai * HALF + m * 16) * ldc + col0;
#pragma unroll
                for (int bj = 0; bj < 2; ++bj) { const f32x4 v0 = acc[ai][bj][m][0] + bv[bj][0], v1 = acc[ai][bj][m][1] + bv[bj][1];
                    u32x4 w; w.x = cvt_pk_bf16(v0[0], v0[1]); w.y = cvt_pk_bf16(v0[2], v0[3]); w.z = cvt_pk_bf16(v1[0], v1[1]); w.w = cvt_pk_bf16(v1[2], v1[3]);
                    *(u32x4*)(rowp + bj * HALF) = w; } }
    }
};
struct EpiLruGate {
    static constexpr bool PERM = false, AFTER_DRAIN = false;
    const bf16_t* XL; float* LAB; size_t lab_stride; const float* gb; const float* spt;
    __device__ __forceinline__ void operator()(const f32x4 (&acc)[2][2][4][2], const Unit& u, int wr, int wc, int fr, int fq) const {
        const int d = u.pn >> 1, half = u.pn & 1;
        const int row0 = u.pm * BM + wr * 64 + fr, ch0 = half * 128 + wc * 32 + 4 * fq;
        float* LA = LAB + (size_t)(2 * d) * lab_stride; float* LB = LAB + (size_t)(2 * d + 1) * lab_stride;
#pragma unroll
        for (int n = 0; n < 2; ++n) {
            const f32x4 bR = *(const f32x4*)(gb + (d * 2 + 0) * 256 + ch0 + 16 * n), bI = *(const f32x4*)(gb + (d * 2 + 1) * 256 + ch0 + 16 * n);
            const f32x4 sp = *(const f32x4*)(spt + d * 256 + ch0 + 16 * n) * (-8.0f * 1.4426950408889634f);
#pragma unroll
            for (int ai = 0; ai < 2; ++ai)
#pragma unroll
                for (int m = 0; m < 4; ++m) { const size_t ro = (size_t)(row0 + ai * HALF + m * 16) * 256 + ch0 + 16 * n;
                    typedef unsigned u32x2 __attribute__((ext_vector_type(2)));
                    const u32x2 xw = *(const u32x2*)(XL + ro);
                    const float xl[4] = {__builtin_bit_cast(float, xw.x << 16), __builtin_bit_cast(float, xw.x & 0xffff0000u), __builtin_bit_cast(float, xw.y << 16), __builtin_bit_cast(float, xw.y & 0xffff0000u)};
                    const f32x4 gr = acc[ai][0][m][n] + bR, gi = acc[ai][1][m][n] + bI;
                    f32x4 av, bv;
#pragma unroll
                    for (int e = 0; e < 4; ++e) {
                        const float rg = __builtin_amdgcn_rcpf(1.0f + __builtin_amdgcn_exp2f(-1.4426950408889634f * gr[e])), ig = __builtin_amdgcn_rcpf(1.0f + __builtin_amdgcn_exp2f(-1.4426950408889634f * gi[e]));
                        const float la2 = rg * sp[e];
                        const float a = __builtin_amdgcn_exp2f(la2), a2 = __builtin_amdgcn_exp2f(2.0f * la2);
                        av[e] = a; bv[e] = __builtin_amdgcn_sqrtf(fmaxf(1.0f - a2, 0.f)) * (ig * xl[e]); }
                    *(f32x4*)(LA + ro) = av; *(f32x4*)(LB + ro) = bv; asm volatile("" ::: "memory"); }
        }
    }
};
struct MoeOrder {
    const PG8_LAS int* tab; int ntiles, nN, nper, j, m_lo, nMx;
    __device__ __forceinline__ void init(const PG8_LAS int* tab_, int ntiles_, int nN_, int G, int bx) {
        tab = tab_; ntiles = ntiles_; nN = nN_;
        if (G % 8 == 0) { const int x = bx % 8; nper = G / 8; j = bx / 8; m_lo = (x * ntiles) / 8; nMx = ((x + 1) * ntiles) / 8 - m_lo; }
        else { nper = G; j = bx; m_lo = 0; nMx = ntiles; }
    }
    __device__ __forceinline__ bool next(int i, Unit& u) const {
        const int s = i * nper + j; if (s >= nMx * nN) return false;
        const int nig = 8 * nN, gid = s / nig, fm = gid * 8, gsz = (nMx - fm) < 8 ? (nMx - fm) : 8, w = s - gid * nig;
        u.pm = m_lo + fm + (w % gsz); u.pn = w / gsz; u.e = tab[u.pm]; u.be = u.e * nN + u.pn; return true;
    }
    __device__ __forceinline__ void a_ready(const Unit&) const {}
    __device__ __forceinline__ void done(const Unit&) const {}
};
template <class Epi, class Sched, bool ALIGN_EPI = false, bool SP2 = false>
__device__ __forceinline__ void gemm_phase(PG8_LAS unsigned char* lds, const Gemm g, const Sched& S, const Epi& E) {
    int tid_ = threadIdx.x; asm volatile("" : "+v"(tid_));
    const int tid = tid_, wid = __builtin_amdgcn_readfirstlane(tid >> 6), lane = tid & 63, wr = wid >> 2, wc = wid & 3, fr = lane & 15, fq = lane >> 4;
    const int K = g.K, nt = K / BK;
    unsigned voffA[2], voffB[2];
#pragma unroll
    for (int i = 0; i < 2; ++i) { int R, C; stage_rc(tid * 16 + i * 8192, R, C); const int Rb = Epi::PERM ? ((R & ~31) + perm32(R & 31)) : R;
        voffA[i] = (unsigned)(R * K + C) * 2u; voffB[i] = (unsigned)(Rb * K + C) * 2u; }
    const size_t kstep = (size_t)(BK * 2);
    const size_t hstep = (size_t)HALF * K * 2;
    const size_t tstep = 2 * hstep;
    const unsigned ldsw = (unsigned)wid * 1024u;
    const int aoff = lds_byte(wr * 64 + fr, fq * 8), boff = lds_byte(wc * 32 + fr, fq * 8);
#define PG8_SA(b, h) (((b) * 2 + (h)) * HTB)
#define PG8_SB(b, h) ((4 + (b) * 2 + (h)) * HTB)
#define PG8_STAGE(bufoff, gbase, voff) do { _Pragma("unroll") for (int _i = 0; _i < 2; ++_i) \
        __builtin_amdgcn_global_load_lds((const unsigned*)((const char*)(gbase) + (voff)[_i]), (PG8_LAS unsigned*)(lds + (bufoff) + ldsw + _i * 8192), 16, 0, 0); } while (0)
#define PG8_LDA(dst, b, h) do { _Pragma("unroll") for (int m = 0; m < 4; ++m) _Pragma("unroll") for (int k = 0; k < 2; ++k) dst[m][k] = *(const PG8_LAS bf16x8*)(lds + PG8_SA(b, h) + aoff + m * 2048 + k * 1024); } while (0)
#define PG8_LDB(dst, b, h) do { _Pragma("unroll") for (int n = 0; n < 2; ++n) _Pragma("unroll") for (int k = 0; k < 2; ++k) dst[n][k] = *(const PG8_LAS bf16x8*)(lds + PG8_SB(b, h) + boff + n * 2048 + k * 1024); } while (0)
#define PG8_MMA(ai, bj, At, Bt) do { __builtin_amdgcn_s_setprio(1); _Pragma("unroll") for (int m = 0; m < 4; ++m) _Pragma("unroll") for (int n = 0; n < 2; ++n) _Pragma("unroll") for (int k = 0; k < 2; ++k) \
        acc[ai][bj][m][n] = __builtin_amdgcn_mfma_f32_16x16x32_bf16(Bt[n][k], At[m][k], acc[ai][bj][m][n], 0, 0, 0); __builtin_amdgcn_s_setprio(0); } while (0)
#define PG8_WAIT_V(n) asm volatile("s_waitcnt vmcnt(" #n ")" ::: "memory")
#define PG8_WAIT_L(n) asm volatile("s_waitcnt lgkmcnt(" #n ")" ::: "memory")
#define PG8_BAR __builtin_amdgcn_s_barrier()
#define PG8_SCHED __builtin_amdgcn_sched_barrier(0)
    Unit cur, nxt; int ui = 0;
    if (!S.next(0, cur)) return;
    f32x4 acc[2][2][4][2];
#pragma unroll
    for (int a = 0; a < 2; ++a)
#pragma unroll
        for (int b = 0; b < 2; ++b)
#pragma unroll
            for (int m = 0; m < 4; ++m)
#pragma unroll
                for (int n = 0; n < 2; ++n) acc[a][b][m][n] = (f32x4){0.f, 0.f, 0.f, 0.f};
    bf16x8 At[4][2], B0[2][2], B1[2][2];
    const char* cA = (const char*)g.A + (size_t)cur.pm * tstep; const char* cB = (const char*)g.Bt + (size_t)cur.be * tstep;
    S.a_ready(cur);
    if constexpr (SP2) {
        PG8_STAGE(PG8_SB(0, 0), cB, voffB); PG8_STAGE(PG8_SB(0, 1), cB + hstep, voffB); PG8_STAGE(PG8_SA(0, 0), cA, voffA); PG8_STAGE(PG8_SA(0, 1), cA + hstep, voffA);
        if (wr == 1) PG8_BAR;
        PG8_WAIT_V(2); PG8_BAR;
        PG8_STAGE(PG8_SB(1, 0), cB + kstep, voffB); PG8_STAGE(PG8_SA(1, 0), cA + kstep, voffA); PG8_STAGE(PG8_SB(1, 1), cB + hstep + kstep, voffB);
        PG8_WAIT_V(6); PG8_BAR;
    } else {
        PG8_STAGE(PG8_SB(0, 0), cB, voffB); PG8_STAGE(PG8_SA(0, 0), cA, voffA); PG8_STAGE(PG8_SB(0, 1), cB + hstep, voffB); PG8_STAGE(PG8_SA(0, 1), cA + hstep, voffA);
        if (wr == 1) PG8_BAR;
        PG8_WAIT_V(4); PG8_BAR;
        PG8_STAGE(PG8_SB(1, 0), cB + kstep, voffB); PG8_STAGE(PG8_SA(1, 0), cA + kstep, voffA); PG8_STAGE(PG8_SB(1, 1), cB + hstep + kstep, voffB);
        PG8_WAIT_V(6); PG8_BAR;
    }
    for (;;) {
        const bool has_next = S.next(ui + 1, nxt);
        const char* nA = has_next ? (const char*)g.A + (size_t)nxt.pm * tstep : cA; const char* nB = has_next ? (const char*)g.Bt + (size_t)nxt.be * tstep : cB;
        for (int t = 0; t < nt; t += 2) {
            const bool last = (t == nt - 2);
            const char* a1 = cA + (size_t)(t + 1) * kstep;
            const char* a2 = last ? nA : cA + (size_t)(t + 2) * kstep; const char* b2 = last ? nB : cB + (size_t)(t + 2) * kstep;
            const char* a3 = a2 + kstep; const char* b3 = b2 + kstep;
            if (last && has_next) S.a_ready(nxt);
            if constexpr (SP2) {
            PG8_LDB(B0, 0, 0); PG8_LDB(B1, 0, 1); PG8_SCHED; PG8_LDA(At, 0, 0); PG8_STAGE(PG8_SA(1, 1), a1 + hstep, voffA);
            PG8_WAIT_V(8); PG8_WAIT_L(0); PG8_BAR; PG8_MMA(0, 0, At, B0); PG8_MMA(0, 1, At, B1); PG8_BAR; PG8_SCHED;
            PG8_LDA(At, 0, 1); PG8_STAGE(PG8_SB(0, 0), b2, voffB); PG8_STAGE(PG8_SB(0, 1), b2 + hstep, voffB); PG8_STAGE(PG8_SA(0, 0), a2, voffA);
            PG8_WAIT_V(8); PG8_WAIT_L(0); PG8_BAR; PG8_MMA(1, 0, At, B0); PG8_MMA(1, 1, At, B1); PG8_BAR; PG8_SCHED;
            PG8_LDB(B0, 1, 0); PG8_LDB(B1, 1, 1); PG8_SCHED; PG8_LDA(At, 1, 0); PG8_STAGE(PG8_SA(0, 1), a2 + hstep, voffA);
            PG8_WAIT_V(8); PG8_WAIT_L(0); PG8_BAR; PG8_MMA(0, 0, At, B0); PG8_MMA(0, 1, At, B1); PG8_BAR; PG8_SCHED;
            PG8_LDA(At, 1, 1); PG8_STAGE(PG8_SB(1, 0), b3, voffB); PG8_STAGE(PG8_SB(1, 1), b3 + hstep, voffB); PG8_STAGE(PG8_SA(1, 0), a3, voffA);
            PG8_WAIT_V(8); PG8_WAIT_L(0); PG8_BAR; PG8_MMA(1, 0, At, B0); PG8_MMA(1, 1, At, B1); PG8_BAR; PG8_SCHED;
            } else {
            PG8_LDB(B0, 0, 0); PG8_SCHED; PG8_LDA(At, 0, 0); PG8_STAGE(PG8_SA(1, 1), a1 + hstep, voffA);
            PG8_WAIT_L(8); PG8_BAR; PG8_WAIT_L(0); PG8_MMA(0, 0, At, B0); PG8_BAR; PG8_SCHED;
            PG8_LDB(B1, 0, 1); PG8_STAGE(PG8_SB(0, 0), b2, voffB);
            PG8_BAR; PG8_WAIT_L(0); PG8_MMA(0, 1, At, B1); PG8_BAR;
            PG8_LDA(At, 0, 1); PG8_STAGE(PG8_SA(0, 0), a2, voffA);
            PG8_BAR; PG8_WAIT_L(0); PG8_MMA(1, 0, At, B0); PG8_BAR; PG8_SCHED;
            PG8_STAGE(PG8_SB(0, 1), b2 + hstep, voffB);
            PG8_WAIT_V(6); PG8_BAR; PG8_MMA(1, 1, At, B1); PG8_BAR;
            PG8_LDB(B0, 1, 0); PG8_SCHED; PG8_LDA(At, 1, 0); PG8_STAGE(PG8_SA(0, 1), a2 + hstep, voffA);
            PG8_WAIT_L(8); PG8_BAR; PG8_WAIT_L(0); PG8_MMA(0, 0, At, B0); PG8_BAR; PG8_SCHED;
            PG8_LDB(B1, 1, 1); PG8_STAGE(PG8_SB(1, 0), b3, voffB);
            PG8_BAR; PG8_WAIT_L(0); PG8_MMA(0, 1, At, B1); PG8_BAR;
            PG8_LDA(At, 1, 1); PG8_STAGE(PG8_SA(1, 0), a3, voffA);
            PG8_BAR; PG8_WAIT_L(0); PG8_MMA(1, 0, At, B0); PG8_BAR; PG8_SCHED;
            PG8_STAGE(PG8_SB(1, 1), b3 + hstep, voffB);
            PG8_WAIT_V(6); PG8_BAR; PG8_MMA(1, 1, At, B1); PG8_BAR;
            }
        }
        if constexpr (ALIGN_EPI) { if (wr == 0) PG8_BAR; }
        if constexpr (!Epi::AFTER_DRAIN) { E(acc, cur, wr, wc, fr, fq); S.done(cur); }
        if (!has_next) break;
#pragma unroll
        for (int a = 0; a < 2; ++a)
#pragma unroll
            for (int b = 0; b < 2; ++b)
#pragma unroll
                for (int m = 0; m < 4; ++m)
#pragma unroll
                    for (int n = 0; n < 2; ++n) acc[a][b][m][n] = (f32x4){0.f, 0.f, 0.f, 0.f};
        cur = nxt; cA = nA; cB = nB; ++ui;
        if constexpr (ALIGN_EPI) { if (wr == 1) PG8_BAR; }
    }
    PG8_WAIT_V(0);
    if constexpr (!ALIGN_EPI) { if (wr == 0) PG8_BAR; }
    PG8_BAR;
    if constexpr (Epi::AFTER_DRAIN) { E.fused(acc, cur, wr, wc, fr, fq, lds, wid, lane); S.done(cur); }
#undef PG8_SA
#undef PG8_SB
#undef PG8_STAGE
#undef PG8_LDA
#undef PG8_LDB
#undef PG8_MMA
#undef PG8_WAIT_V
#undef PG8_WAIT_L
#undef PG8_BAR
#undef PG8_SCHED
}
}

#ifndef PG8_SP2
#define PG8_SP2 true
#endif
#ifndef PG8_ALIGN
#define PG8_ALIGN true
#endif
#include <cmath>
namespace attn_body {
using bf16=__hip_bfloat16;
using bf16x8=__attribute__((ext_vector_type(8)))short;
using s16x4=__attribute__((ext_vector_type(4)))short;
using f32x16=__attribute__((ext_vector_type(16)))float;
using u32x4=__attribute__((ext_vector_type(4)))unsigned;
constexpr int NHEAD=8,SEQQ=8192,SEQK=8448,D=64,QP=512,KP=128;
constexpr int NW=8,QBLK=32,QB=QBLK*NW,KVBLK=64,NQB=SEQQ/QB;
constexpr int ATTN_UNIT_ROWS=QB;
__device__ __forceinline__ int crow(int r,int hi){return (r&3)+8*(r>>2)+4*hi;}
#define SBAR() __builtin_amdgcn_sched_barrier(0)
__device__ __forceinline__ void cmask(f32x16&p0,f32x16&p1,int jb,int qrel,int hi){
  const float NEG=-INFINITY; int kb=64*jb+4*hi;
  #pragma unroll
  for(int r=0;r<16;++r){int kv=kb+(r&3)+8*(r>>2); if(kv>qrel)p0[r]=NEG; if(kv+32>qrel)p1[r]=NEG;}
}

constexpr int NSLOT=3, SLOTB=8192;
constexpr int LDS_K=0, LDS_V=NSLOT*SLOTB, LDS_WS=2*NSLOT*SLOTB, LDS_OST=LDS_WS+NW*64*4, LDS_BYTES=LDS_OST+NW*4096;
constexpr float C2=0.125f*1.4426950408889634f;
__device__ __forceinline__ void glds16(const void*gsrc,unsigned lds_dst){unsigned keep;
  asm volatile("s_mov_b32 %0, m0\n\ts_mov_b32 m0, %2\n\ts_nop 0\n\tglobal_load_lds_dwordx4 %1, off\n\ts_mov_b32 m0, %0":"=&s"(keep):"v"(gsrc),"s"(lds_dst):"memory");}
__device__ __forceinline__ float max3f(float a,float b,float c){float r;asm("v_max3_f32 %0, %1, %2, %3":"=v"(r):"v"(a),"v"(b),"v"(c));return r;}
__device__ __forceinline__ float max2f(float a,float b){float r;asm("v_max_f32_e32 %0, %1, %2":"=v"(r):"v"(a),"v"(b));return r;}
__device__ __forceinline__ float fadd_s(float a,float b){float r;asm("v_add_f32_e32 %0, %1, %2":"=v"(r):"v"(a),"v"(b));return r;}
__device__ __forceinline__ float fsub_s(float a,float b){float r;asm("v_sub_f32_e32 %0, %1, %2":"=v"(r):"v"(a),"v"(b));return r;}
typedef float f32x2_t __attribute__((ext_vector_type(2))); typedef __bf16 bf16x2_t __attribute__((ext_vector_type(2)));
__device__ __forceinline__ unsigned cvtpk_s(float lo,float hi){f32x2_t v={lo,hi};bf16x2_t b=__builtin_convertvector(v,bf16x2_t);return __builtin_bit_cast(unsigned,b);}
#define WAIT_BAR(N) asm volatile("s_waitcnt vmcnt(" #N ") lgkmcnt(0)\n\ts_barrier":::"memory")

__device__ __forceinline__ void qkt(f32x16&p0,f32x16&p1,const char*Kslot,const bf16x8*qr,const f32x16&negm,int r32,int hi){
  const char*kb=Kslot+hi*1024+r32*16;
  #pragma unroll
  for(int d0=0;d0<4;++d0){
    const bf16x8 b0=*reinterpret_cast<const bf16x8*>(kb+d0*2048);
    const bf16x8 b1=*reinterpret_cast<const bf16x8*>(kb+d0*2048+512);
    if(d0==0){p0=__builtin_amdgcn_mfma_f32_32x32x16_bf16(b0,qr[0],negm,0,0,0);p1=__builtin_amdgcn_mfma_f32_32x32x16_bf16(b1,qr[0],negm,0,0,0);}
    else{p0=__builtin_amdgcn_mfma_f32_32x32x16_bf16(b0,qr[d0],p0,0,0,0);p1=__builtin_amdgcn_mfma_f32_32x32x16_bf16(b1,qr[d0],p1,0,0,0);}}
}
typedef __attribute__((address_space(3))) const char* lds_cptr;
typedef short v4i16_t __attribute__((ext_vector_type(4)));
__device__ __forceinline__ void kload8(bf16x8*kf,lds_cptr kp){
  kf[0]=*(const __attribute__((address_space(3))) bf16x8*)(kp);      kf[1]=*(const __attribute__((address_space(3))) bf16x8*)(kp+512);
  kf[2]=*(const __attribute__((address_space(3))) bf16x8*)(kp+2048); kf[3]=*(const __attribute__((address_space(3))) bf16x8*)(kp+2560);
  kf[4]=*(const __attribute__((address_space(3))) bf16x8*)(kp+4096); kf[5]=*(const __attribute__((address_space(3))) bf16x8*)(kp+4608);
  kf[6]=*(const __attribute__((address_space(3))) bf16x8*)(kp+6144); kf[7]=*(const __attribute__((address_space(3))) bf16x8*)(kp+6656);
}
__device__ __forceinline__ void kload2(bf16x8*kf,lds_cptr kp,int j){ kf[2*j]=*(const __attribute__((address_space(3))) bf16x8*)(kp+j*2048); kf[2*j+1]=*(const __attribute__((address_space(3))) bf16x8*)(kp+j*2048+512); }
__device__ __forceinline__ s16x4 vtr(lds_cptr p){ return __builtin_bit_cast(s16x4,__builtin_amdgcn_ds_read_tr16_b64_v4i16((__attribute__((address_space(3))) v4i16_t*)p)); }
__device__ __forceinline__ float rowmax(const f32x16&p0,const f32x16&p1){
  float a=max3f(p0[0],p0[1],p1[0]),b=max3f(p0[2],p0[3],p1[1]);a=max3f(a,p1[2],p1[3]);
  #pragma unroll
  for(int r=4;r<16;r+=4){a=max3f(a,p0[r],p0[r+1]);b=max3f(b,p0[r+2],p0[r+3]);a=max3f(a,p1[r],p1[r+1]);b=max3f(b,p1[r+2],p1[r+3]);}
  const float m=max2f(a,b);
  auto rr=__builtin_amdgcn_permlane32_swap(__float_as_uint(m),__float_as_uint(m),false,false);
  return max2f(__uint_as_float(rr[0]),__uint_as_float(rr[1]));
}
__device__ __forceinline__ void pv(f32x16*o,int vb,bf16x8 pa0,bf16x8 pa1,bf16x8 pa2,bf16x8 pa3){
  #pragma unroll
  for(int d0=0;d0<2;++d0){s16x4 lo[4],hi[4];
    #pragma unroll
    for(int ks=0;ks<4;++ks){
      asm volatile("ds_read_b64_tr_b16 %0,%1 offset:%c2":"=&v"(lo[ks]):"v"(vb),"i"(d0*4096+ks*1024):"memory");
      asm volatile("ds_read_b64_tr_b16 %0,%1 offset:%c2":"=&v"(hi[ks]):"v"(vb),"i"(d0*4096+ks*1024+512):"memory");}
    asm volatile("s_waitcnt lgkmcnt(0)":::"memory");SBAR();
    #define PK(k) (bf16x8){lo[k][0],lo[k][1],lo[k][2],lo[k][3],hi[k][0],hi[k][1],hi[k][2],hi[k][3]}
    o[d0]=__builtin_amdgcn_mfma_f32_32x32x16_bf16(pa0,PK(0),o[d0],0,0,0);
    o[d0]=__builtin_amdgcn_mfma_f32_32x32x16_bf16(pa1,PK(1),o[d0],0,0,0);
    o[d0]=__builtin_amdgcn_mfma_f32_32x32x16_bf16(pa2,PK(2),o[d0],0,0,0);
    o[d0]=__builtin_amdgcn_mfma_f32_32x32x16_bf16(pa3,PK(3),o[d0],0,0,0);
    #undef PK
  }
}

#ifndef ATTN_STORE16
#define ATTN_STORE16(p,v) (*(u32x4*)(p)=(v))
#endif
template<int THRL> __device__ __forceinline__ void attn_unit(int b,int h,long qrow0,int NTarg,const bf16*Q,const bf16*__restrict__ K,const bf16*__restrict__ V,bf16*O,char*shm){
  int tid_=threadIdx.x; asm volatile("":"+v"(tid_)); const int tid=tid_,lane=tid&63,r32=lane&31,hi=lane>>5; const int wid=__builtin_amdgcn_readfirstlane(tid>>6);
  const long krowbase=(long)b*SEQK; const int kvh=h>>2;
  const bf16*Qw=Q+(qrow0+wid*QBLK)*QP+h*D;
  const bf16*Kh=K+krowbase*KP+kvh*D,*Vh=V+krowbase*KP+kvh*D;
  const unsigned lds0=(unsigned)(uintptr_t)shm;
  float*wsf=(float*)(shm+LDS_WS)+wid*64;
  const bf16*ksrc=Kh+(long)lane*KP+wid*8;
  const bf16*vsrc=Vh+(long)(16*(wid&3)+(lane>>2))*KP+(wid>>2)*32+(lane&3)*8;
  const unsigned kdst=lds0+LDS_K+wid*1024, vdst=lds0+LDS_V+wid*1024;
  #define DMA_K(t,slot) glds16(ksrc+(long)(t)*KVBLK*KP,(unsigned)__builtin_amdgcn_readfirstlane(kdst+(slot)))
  #define DMA_V(t,slot) glds16(vsrc+(long)(t)*KVBLK*KP,(unsigned)__builtin_amdgcn_readfirstlane(vdst+(slot)))
  const int vb0=(int)(lds0+LDS_V)+((lane>>4)&1)*32+(lane&3)*8+(4*hi+((lane&15)>>2))*64;
  const char*Kbase=shm+LDS_K; bf16x8 kf[8];
  const lds_cptr shm3=(lds_cptr)shm; const lds_cptr kp0=shm3+LDS_K+hi*1024+r32*16; const lds_cptr vp0=shm3+LDS_V+((lane>>4)&1)*32+(lane&3)*8+(4*hi+((lane&15)>>2))*64;
  const int NT=NTarg;
  DMA_K(0,0);DMA_V(0,0);DMA_K(1,SLOTB);
  bf16x8 qr[4];
  #pragma unroll
  for(int d0=0;d0<4;++d0)qr[d0]=*reinterpret_cast<const bf16x8*>(&Qw[(long)r32*QP+d0*16+hi*8]);
  float mhat=0.f,l_reg=0.f;f32x16 o[2];o[0]=f32x16{};o[1]=f32x16{};f32x16 negm=f32x16{};asm volatile("":"+v"(negm));
  const int qrel=wid*QBLK+r32;
  #define CMASK(P0,P1,t) do{}while(0)
  bool resc=false;
  #define START(P0,P1) do{ const float rm=rowmax(P0,P1); resc=false; \
    { const float dl=rm; mhat=fadd_s(mhat,dl); \
      _Pragma("unroll") for(int r=0;r<16;++r){P0[r]=fsub_s(P0[r],dl);P1[r]=fsub_s(P1[r],dl);} \
      _Pragma("unroll") for(int r=0;r<16;++r)negm[r]=-mhat; asm volatile("":"+v"(negm)); } \
    _Pragma("unroll") for(int r=0;r<16;++r)P0[r]=__builtin_amdgcn_exp2f(P0[r]); }while(0)
  #define RESC() do{ if(resc){ asm volatile("s_waitcnt lgkmcnt(0)":::"memory"); \
      _Pragma("unroll") for(int d_=0;d_<2;++d_) _Pragma("unroll") for(int r=0;r<16;++r)o[d_][r]*=wsf[crow(r,hi)]; } }while(0)
  f32x16 pA0,pA1,pB0,pB1;
  int sl_prev=0,sl_cur=0,sl_next=SLOTB;
  #define ROT() do{sl_prev=sl_cur;sl_cur=sl_next;sl_next=(sl_next==(NSLOT-1)*SLOTB)?0:sl_next+SLOTB;}while(0)
  DMA_K(2,2*SLOTB);
  WAIT_BAR(3);
  qkt(pA0,pA1,Kbase,qr,negm,r32,hi);asm volatile("s_nop 15\n\ts_nop 7":"+v"(pA0),"+v"(pA1));CMASK(pA0,pA1,0);
  START(pA0,pA1);
  _Pragma("unroll") for(int r=0;r<16;++r)pA1[r]=__builtin_amdgcn_exp2f(pA1[r]);
  WAIT_BAR(0);
  DMA_K(3,0);DMA_V(1,SLOTB);
  ROT();
  kload8(kf,kp0+sl_cur);
  WAIT_BAR(2);
  s16x4 vlo[8],vhi[8]; u32x4 pw0,pw1,pw2,pw3;
  #define PKW(P,B) cvtpk_s(P[B],P[B+1])
  #define PAF(k) __builtin_bit_cast(bf16x8,pw##k)
  #define VFR(i) (bf16x8){vlo[i][0],vlo[i][1],vlo[i][2],vlo[i][3],vhi[i][0],vhi[i][1],vhi[i][2],vhi[i][3]}
  #define PIN(x) asm volatile("":"+v"(x))
  #define MX3(a,b,c) __builtin_fmaxf(__builtin_fmaxf((a),(b)),(c))
  #define GAPA(MF,A0,A1,A2,A3,W0,W1,PW) do{ MF; sacc+=A0; sacc+=A1; sacc+=A2; sacc+=A3; PIN(sacc); W0; W1; PIN(PW); SBAR(); }while(0)
  #define EX(v) __builtin_amdgcn_exp2f(v)
  #define GAPB(MF,X,B) do{ MF; X[B]=EX(X[B]); X[B+1]=EX(X[B+1]); X[B+2]=EX(X[B+2]); X[B+3]=EX(X[B+3]); PIN(X); SBAR(); }while(0)
  #define VRD(i) do{ vlo[i]=vtr(vp_+(((i)>>2)*4096+((i)&3)*1024)); vhi[i]=vtr(vp_+(((i)>>2)*4096+((i)&3)*1024+512)); }while(0)
  #define KRD(G,j) do{ if(G){ kload2(kf,kp0+sl_next,j); SBAR(); } }while(0)
  #define STEP(C0,C1,P0,P1,t,GK,GV,GL) do{ SBAR(); \
    const lds_cptr vp_=vp0+sl_prev; \
    VRD(0); SBAR(); float sacc=(P0[0]+P0[1]); \
    GAPA(C0=__builtin_amdgcn_mfma_f32_32x32x16_bf16(kf[0],qr[0],negm,0,0,0), P0[2],P0[3],P0[4],P0[5],     pw0[0]=PKW(P0,0), pw0[1]=PKW(P0,2), pw0); \
    VRD(4); SBAR(); GAPA(C1=__builtin_amdgcn_mfma_f32_32x32x16_bf16(kf[1],qr[0],negm,0,0,0), P0[6],P0[7],P0[8],P0[9],     pw0[2]=PKW(P0,4), pw0[3]=PKW(P0,6), pw0); \
    VRD(1); SBAR(); GAPA(C0=__builtin_amdgcn_mfma_f32_32x32x16_bf16(kf[2],qr[1],C0,0,0,0),   P0[10],P0[11],P0[12],P0[13], pw1[0]=PKW(P0,8), pw1[1]=PKW(P0,10), pw1); \
    VRD(5); SBAR(); GAPA(C1=__builtin_amdgcn_mfma_f32_32x32x16_bf16(kf[3],qr[1],C1,0,0,0),   P0[14],P0[15],P1[0],P1[1],   pw1[2]=PKW(P0,12),pw1[3]=PKW(P0,14), pw1); \
    VRD(2); SBAR(); GAPA(C0=__builtin_amdgcn_mfma_f32_32x32x16_bf16(kf[4],qr[2],C0,0,0,0),   P1[2],P1[3],P1[4],P1[5],     pw2[0]=PKW(P1,0), pw2[1]=PKW(P1,2), pw2); \
    VRD(6); SBAR(); GAPA(C1=__builtin_amdgcn_mfma_f32_32x32x16_bf16(kf[5],qr[2],C1,0,0,0),   P1[6],P1[7],P1[8],P1[9],     pw2[2]=PKW(P1,4), pw2[3]=PKW(P1,6), pw2); \
    VRD(3); SBAR(); GAPA(C0=__builtin_amdgcn_mfma_f32_32x32x16_bf16(kf[6],qr[3],C0,0,0,0),   P1[10],P1[11],P1[12],P1[13], pw3[0]=PKW(P1,8), pw3[1]=PKW(P1,10), pw3); \
    VRD(7); SBAR(); GAPA(C1=__builtin_amdgcn_mfma_f32_32x32x16_bf16(kf[7],qr[3],C1,0,0,0),   P1[14],P1[15],0.f,0.f,       pw3[2]=PKW(P1,12),pw3[3]=PKW(P1,14), pw3); \
    l_reg+=sacc; \
    if(GK){DMA_K((t)+3,sl_cur);} if(GV){DMA_V((t)+1,sl_next);} \
    CMASK(C0,C1,t); \
    { float a=MX3(C0[0],C0[1],C1[0]),b=MX3(C0[2],C0[3],C1[1]); a=MX3(a,C1[2],C1[3]); \
      _Pragma("unroll") for(int r=4;r<16;r+=4){a=MX3(a,C0[r],C0[r+1]);b=MX3(b,C0[r+2],C0[r+3]);a=MX3(a,C1[r],C1[r+1]);b=MX3(b,C1[r+2],C1[r+3]);} \
      float rm=__builtin_fmaxf(a,b); { auto rr=__builtin_amdgcn_permlane32_swap(__float_as_uint(rm),__float_as_uint(rm),false,false); rm=__builtin_fmaxf(__uint_as_float(rr[0]),__uint_as_float(rr[1])); } \
      resc=false; \
      if(__builtin_expect(__any(rm>(float)THRL),0)){ const float dl=__builtin_fmaxf(rm,0.f); mhat+=dl; \
        _Pragma("unroll") for(int r=0;r<16;++r){C0[r]-=dl;C1[r]-=dl;} \
        _Pragma("unroll") for(int r=0;r<16;++r)negm[r]=-mhat; asm volatile("":"+v"(negm)); \
        const float f=__builtin_amdgcn_exp2f(-dl); l_reg*=f; if(hi==0)wsf[r32]=f; resc=true; } } \
    SBAR(); \
    GAPB(o[0]=__builtin_amdgcn_mfma_f32_32x32x16_bf16(PAF(0),VFR(0),o[0],0,0,0), C0,0); \
    GAPB(o[1]=__builtin_amdgcn_mfma_f32_32x32x16_bf16(PAF(0),VFR(4),o[1],0,0,0), C0,4); \
    KRD(GL,0); GAPB(o[0]=__builtin_amdgcn_mfma_f32_32x32x16_bf16(PAF(1),VFR(1),o[0],0,0,0), C0,8); \
    KRD(GL,1); GAPB(o[1]=__builtin_amdgcn_mfma_f32_32x32x16_bf16(PAF(1),VFR(5),o[1],0,0,0), C0,12); \
    KRD(GL,2); GAPB(o[0]=__builtin_amdgcn_mfma_f32_32x32x16_bf16(PAF(2),VFR(2),o[0],0,0,0), C1,0); \
    KRD(GL,3); GAPB(o[1]=__builtin_amdgcn_mfma_f32_32x32x16_bf16(PAF(2),VFR(6),o[1],0,0,0), C1,4); \
    GAPB(o[0]=__builtin_amdgcn_mfma_f32_32x32x16_bf16(PAF(3),VFR(3),o[0],0,0,0), C1,8); \
    GAPB(o[1]=__builtin_amdgcn_mfma_f32_32x32x16_bf16(PAF(3),VFR(7),o[1],0,0,0), C1,12); \
    }while(0)
  int t=1;
  #undef CMASK
  #define CMASK(P0,P1,t) do{}while(0)
  for(;t+5<NT;t+=2){
    STEP(pB0,pB1,pA0,pA1,t,true,true,true);     WAIT_BAR(2); RESC(); ROT();
    STEP(pA0,pA1,pB0,pB1,t+1,true,true,true);   WAIT_BAR(2); RESC(); ROT();
  }
  #undef CMASK
  #define CMASK(P0,P1,t) do{}while(0)
  #define ENDW(tt) do{ if((tt)+3<NT){WAIT_BAR(2);} else if((tt)+2<NT){WAIT_BAR(1);} else {WAIT_BAR(0);} }while(0)
  for(;t+1<NT;t+=2){
    STEP(pB0,pB1,pA0,pA1,t,(t+3<NT),(t+1<NT),(t+1<NT));       ENDW(t);   RESC(); ROT();
    STEP(pA0,pA1,pB0,pB1,t+1,(t+4<NT),(t+2<NT),(t+2<NT));     ENDW(t+1); RESC(); ROT();
  }
  STEP(pB0,pB1,pA0,pA1,NT-1,false,false,false); RESC();
  { float sacc=pB0[0]+pB0[1]; _Pragma("unroll") for(int r=2;r<16;++r)sacc+=pB0[r]; _Pragma("unroll") for(int r=0;r<16;++r)sacc+=pB1[r]; l_reg+=sacc;
    pw0=(u32x4){PKW(pB0,0),PKW(pB0,2),PKW(pB0,4),PKW(pB0,6)};pw1=(u32x4){PKW(pB0,8),PKW(pB0,10),PKW(pB0,12),PKW(pB0,14)};pw2=(u32x4){PKW(pB1,0),PKW(pB1,2),PKW(pB1,4),PKW(pB1,6)};pw3=(u32x4){PKW(pB1,8),PKW(pB1,10),PKW(pB1,12),PKW(pB1,14)};
    SBAR(); pv(o,vb0+sl_cur,PAF(0),PAF(1),PAF(2),PAF(3)); }
  #undef PKW
  #undef PAF
  #undef VFR
  #undef PIN
  #undef MX3
  #undef GAPA
  #undef GAPB
  #undef EX
  #undef VRD
  #undef KRD
  #undef STEP
  #undef ENDW
  {auto rr=__builtin_amdgcn_permlane32_swap(__float_as_uint(l_reg),__float_as_uint(l_reg),false,false);l_reg=__uint_as_float(rr[0])+__uint_as_float(rr[1]);}
  if(hi==0)wsf[32+r32]=l_reg;asm volatile("s_waitcnt lgkmcnt(0)":::"memory");
  float rli[16];
  #pragma unroll
  for(int r=0;r<16;++r)rli[r]=__builtin_amdgcn_rcpf(wsf[32+crow(r,hi)]);
  bf16*Ow=O+(qrow0+wid*QBLK)*QP+h*D;
  { bf16*stg=(bf16*)(shm+LDS_OST)+wid*2048;
    #pragma unroll
    for(int r=0;r<16;++r){const int orow=crow(r,hi);
      #pragma unroll
      for(int d0=0;d0<2;++d0)stg[orow*64+d0*32+r32]=__float2bfloat16(o[d0][r]*rli[r]);}
    asm volatile("s_waitcnt lgkmcnt(0)":::"memory");
    #pragma unroll
    for(int i=0;i<4;++i){const int row=i*8+(lane>>3),ch=lane&7; const u32x4 v=*(const u32x4*)(stg+row*64+ch*8); ATTN_STORE16(Ow+(long)row*QP+ch*8,v);} }
  asm volatile("s_waitcnt lgkmcnt(0)\n\ts_barrier":::"memory");
  #undef DMA_K
  #undef DMA_V
  #undef CMASK
  #undef START
  #undef RESC
  #undef ROT
}
constexpr int ATTN_LDS_BYTES=LDS_BYTES;
struct AttnTensors { const bf16* Q; const bf16* K; const bf16* V; bf16* O; };
template<int THRL=8> __device__ __forceinline__ void attn_phase(char*lds,const AttnTensors&T,int G,int vcu,bool with_ctx,long ctx_row0){
  const int total=4*NHEAD*NQB;
  for(int i=0;;++i){
    int x,n;
    if(G==256){ if(i>=4)break; x=vcu>>5; n=i*32+(vcu&31); }
    else { const int u=i*G+vcu; if(u>=total)break; x=u>>7; n=u&127; }
    const int b=x>>1,kvh=x&1,h=kvh*4+(n>>5),qb=n&31;
    attn_unit<THRL>(b,h,(long)b*SEQQ+(long)qb*QB,SEQK/KVBLK,T.Q,T.K,T.V,T.O,lds);
  }
  if(with_ctx){
    for(int u=vcu;u<4*NHEAD;u+=G){ const int b=u>>3,h=u&7; attn_unit<THRL>(b,h,ctx_row0+(long)b*256,4,T.Q,T.K,T.V,T.O,lds); }
  }
}
#undef SBAR
#undef WAIT_BAR
}

constexpr int NWAVES = 8, NTHR = 512;
constexpr int DMODEL = 1024, NB = 4, SEQ = 8192, CTXL = 256, NLAT = NB * SEQ, NCTX = NB * CTXL, MT = NLAT + NCTX;
constexpr int INW = 2048, NE = 32, KEYS = SEQ + CTXL;
constexpr int SORT_TILES = 560, SORT_ROWS = SORT_TILES * 256;
constexpr float EPSN = 1e-6f;
constexpr int NCHUNK = 66, CHUNK = 128;
constexpr int NPH_PRO = 2, NPH_LAYER = 13, NPH = NPH_PRO + 2 * NPH_LAYER;

constexpr size_t MiB = 1u << 20;
constexpr size_t WS_CTL = 0, CTL_ZERO_BYTES = 1 * MiB;
constexpr size_t WS_MOD = 1 * MiB, WS_ROPEC = 2 * MiB, WS_ROPES = 3 * MiB, WS_H2 = 4 * MiB, WS_KFC = 10 * MiB, WS_BLKCNT = 12 * MiB, WS_TILEE = 13 * MiB, WS_SCANS = 14 * MiB;
constexpr size_t WS_WINT = 16 * MiB, WS_WOUTT = 24 * MiB, WS_W1T = 32 * MiB, WS_W2T = 288 * MiB, WS_KF = 416 * MiB, WS_KHAT = 448 * MiB, WS_XR = 512 * MiB, WS_H = 644 * MiB;
constexpr size_t WS_U = 712 * MiB, WS_Q = 844 * MiB, WS_K = 877 * MiB, WS_V = 886 * MiB, WS_ATT = 895 * MiB, WS_LAB = 928 * MiB, WS_LRUO = 1060 * MiB, WS_VT = 1093 * MiB, WS_X0T = 1125 * MiB,
                 WS_HYO = 1157 * MiB, WS_MIXA = 1190 * MiB;
constexpr size_t WS_WGT = 11 * MiB, WS_SPT = 10 * MiB + 768 * 1024, WS_XL = 1256 * MiB;
constexpr size_t WS_F = 712 * MiB, WS_ASORT = 778 * MiB, WS_ACT = 1058 * MiB, WS_YS = 1338 * MiB, WS_TOPI = 1618 * MiB, WS_GATE = 1619 * MiB, WS_POS = 1620 * MiB, WS_END = 1622 * MiB;
constexpr size_t LAB_STRIDE = (size_t)MT * 256;
constexpr int CW_BAR = 4096;
constexpr int CW_NTILES = 64;

constexpr int RING_OFF = 0, RING_BYTES = 131072, MOETAB_OFF = 131072, LDSCTL_OFF = 155648, LDS_BYTES = 156160;

#define GAS __attribute__((address_space(1)))
#define LAS __attribute__((address_space(3)))
typedef unsigned short bf16;
typedef unsigned v4u __attribute__((ext_vector_type(4)));
typedef unsigned v2u __attribute__((ext_vector_type(2)));
typedef float f32x4 __attribute__((ext_vector_type(4)));
#define LDS_WAIT() asm volatile("s_waitcnt lgkmcnt(0)" ::: "memory")
#define VM_WAIT() asm volatile("s_waitcnt vmcnt(0)" ::: "memory")
__device__ __forceinline__ unsigned f2bf(float f) { unsigned u = __builtin_bit_cast(unsigned, f); return (u + 0x7fffu + ((u >> 16) & 1u)) >> 16; }
__device__ __forceinline__ unsigned pk2(float lo, float hi) { return f2bf(lo) | (f2bf(hi) << 16); }
__device__ __forceinline__ float bf2f(unsigned short b) { return __builtin_bit_cast(float, (unsigned)b << 16); }
__device__ __forceinline__ float bflo(unsigned w) { return __builtin_bit_cast(float, w << 16); }
__device__ __forceinline__ float bfhi(unsigned w) { return __builtin_bit_cast(float, w & 0xffff0000u); }
__device__ __forceinline__ float wave_sum(float v) {
#pragma unroll
    for (int o = 1; o < 64; o <<= 1) v += __shfl_xor(v, o);
    return v;
}
__device__ __forceinline__ float sigmoidf_(float x) { return 1.0f / (1.0f + __expf(-x)); }
__device__ __forceinline__ void sincos_d(double x, double& s, double& c) {
    const double kd = __builtin_rint(x * 0.63661977236758134308);
    const int k = (int)kd;
    double r = __builtin_fma(-kd, 1.57079632673412561417e+00, x);
    r = __builtin_fma(-kd, 6.07710050650619224932e-11, r);
    const double z = r * r;
    const double ps = r + r * z * (-1.66666666666666324348e-01 + z * (8.33333333332248946124e-03 + z * (-1.98412698298579493134e-04 + z * (2.75573137070700676789e-06 + z * (-2.50507602534068634195e-08 + z * 1.58969099521155010221e-10)))));
    const double pc = 1.0 - 0.5 * z + z * z * (4.16666666666666019037e-02 + z * (-1.38888888888741095749e-03 + z * (2.48015872894767294178e-05 + z * (-2.75573143513906633035e-07 + z * (2.08757232129817482790e-09 + z * -1.13596475577881948265e-11)))));
    const int q = k & 3;
    s = (q == 0) ? ps : (q == 1) ? pc : (q == 2) ? -ps : -pc;
    c = (q == 0) ? pc : (q == 1) ? -ps : (q == 2) ? -pc : ps;
}
__device__ __forceinline__ float gelu_tanh(float x) {
    const float u = 0.7978845608028654f * (x + 0.044715f * x * x * x);
    const float t = 1.0f - 2.0f / (1.0f + __expf(2.0f * u));
    return 0.5f * x * (1.0f + t);
}
__device__ __forceinline__ int lds_add(LAS int* p, int v) { return __hip_atomic_fetch_add(p, v, __ATOMIC_RELAXED, __HIP_MEMORY_SCOPE_WORKGROUP); }

#define FFT_FN __device__ __forceinline__
typedef float f32x2v __attribute__((ext_vector_type(2)));
#define FFT_VEC2 f32x2v
#define FFT_DPTR LAS f32x2v*
#define FFT_LD(D, i) c32_from((D)[i])
#define FFT_ST(D, i, v) ((D)[i] = c32_to(v))
struct __attribute__((aligned(8))) c32 { float x, y; };
FFT_FN c32 cmul(c32 a, c32 b) { c32 r; r.x = a.x * b.x - a.y * b.y; r.y = a.x * b.y + a.y * b.x; return r; }
FFT_FN c32 cadd(c32 a, c32 b) { c32 r; r.x = a.x + b.x; r.y = a.y + b.y; return r; }
FFT_FN c32 csub(c32 a, c32 b) { c32 r; r.x = a.x - b.x; r.y = a.y - b.y; return r; }
FFT_FN c32 cmuli_neg(c32 a) { c32 r; r.x = a.y; r.y = -a.x; return r; }
FFT_FN int fpad(int a) { return a + (a >> 4); }
#ifdef FFT_VEC2
FFT_FN c32 c32_from(FFT_VEC2 t) { c32 r; r.x = t.x; r.y = t.y; return r; }
FFT_FN FFT_VEC2 c32_to(c32 a) { FFT_VEC2 t; t.x = a.x; t.y = a.y; return t; }
#endif
FFT_FN void dft4(c32& a0, c32& a1, c32& a2, c32& a3) {
    const c32 s02 = cadd(a0, a2), d02 = csub(a0, a2), s13 = cadd(a1, a3), d13 = cmuli_neg(csub(a1, a3));
    a0 = cadd(s02, s13); a2 = csub(s02, s13); a1 = cadd(d02, d13); a3 = csub(d02, d13);
}
FFT_FN void dft16(c32 (&v)[16]) {
    const float C1 = 0.92387953251128674f, S1 = 0.38268343236508977f, C2 = 0.70710678118654752f;
#pragma unroll
    for (int q2 = 0; q2 < 4; ++q2) dft4(v[q2], v[4 + q2], v[8 + q2], v[12 + q2]);
    { c32 w;
      w.x = C1; w.y = -S1; v[4 * 1 + 1] = cmul(v[4 * 1 + 1], w);
      w.x = C2; w.y = -C2; v[4 * 2 + 1] = cmul(v[4 * 2 + 1], w);
      w.x = S1; w.y = -C1; v[4 * 3 + 1] = cmul(v[4 * 3 + 1], w);
      w.x = C2; w.y = -C2; v[4 * 1 + 2] = cmul(v[4 * 1 + 2], w);
      v[4 * 2 + 2] = cmuli_neg(v[4 * 2 + 2]);
      w.x = -C2; w.y = -C2; v[4 * 3 + 2] = cmul(v[4 * 3 + 2], w);
      w.x = S1; w.y = -C1; v[4 * 1 + 3] = cmul(v[4 * 1 + 3], w);
      w.x = -C2; w.y = -C2; v[4 * 2 + 3] = cmul(v[4 * 2 + 3], w);
      w.x = -C1; w.y = S1; v[4 * 3 + 3] = cmul(v[4 * 3 + 3], w); }
#pragma unroll
    for (int p1 = 0; p1 < 4; ++p1) dft4(v[4 * p1 + 0], v[4 * p1 + 1], v[4 * p1 + 2], v[4 * p1 + 3]);
#pragma unroll
    for (int a = 0; a < 4; ++a)
#pragma unroll
        for (int b = a + 1; b < 4; ++b) { const c32 t = v[4 * a + b]; v[4 * a + b] = v[4 * b + a]; v[4 * b + a] = t; }
}
FFT_FN c32 twid(int j, int n) { double s, c; sincos_d(-6.283185307179586476925 * (double)j / (double)n, s, c); c32 w; w.x = (float)c; w.y = (float)s; return w; }

FFT_FN void fft_fwd16(FFT_DPTR D, int g, int n) {
    const int s = n >> 4, blk = g / s, j = g - blk * s, base = blk * n + j;
    c32 v[16];
#pragma unroll
    for (int q = 0; q < 16; ++q) v[q] = FFT_LD(D, fpad(base + q * s));
    dft16(v);
    const c32 w = twid(j, n); c32 wp = w;
#pragma unroll
    for (int p = 1; p < 16; ++p) { v[p] = cmul(v[p], wp); wp = cmul(wp, w); }
#pragma unroll
    for (int p = 0; p < 16; ++p) FFT_ST(D, fpad(base + p * s), v[p]);
}
FFT_FN void fft_inv16(FFT_DPTR D, int g, int n) {
    const int s = n >> 4, blk = g / s, j = g - blk * s, base = blk * n + j;
    c32 v[16];
#pragma unroll
    for (int q = 0; q < 16; ++q) v[q] = FFT_LD(D, fpad(base + q * s));
    const c32 w = twid(j, n); c32 wp = w;
#pragma unroll
    for (int p = 1; p < 16; ++p) { v[p] = cmul(v[p], wp); wp = cmul(wp, w); }
    dft16(v);
#pragma unroll
    for (int p = 0; p < 16; ++p) FFT_ST(D, fpad(base + p * s), v[p]);
}
FFT_FN void fft_mid16(FFT_DPTR D, int g, const c32* KH) {
    c32 v[16];
#pragma unroll
    for (int q = 0; q < 16; ++q) v[q] = FFT_LD(D, 17 * g + q);
    dft16(v);
#pragma unroll
    for (int p = 0; p < 16; ++p) { const c32 k = KH[16 * g + p]; const c32 t = cmul(v[p], k); v[p].x = t.x; v[p].y = -t.y; }
    dft16(v);
#pragma unroll
    for (int p = 0; p < 16; ++p) FFT_ST(D, 17 * g + p, v[p]);
}
FFT_FN void fft_last16_out(FFT_DPTR D, int g, c32* OUT, float scale) {
    c32 v[16];
#pragma unroll
    for (int q = 0; q < 16; ++q) v[q] = FFT_LD(D, 17 * g + q);
    dft16(v);
#pragma unroll
    for (int p = 0; p < 16; ++p) { c32 t; t.x = v[p].x * scale; t.y = v[p].y * scale; OUT[16 * g + p] = t; }
}
FFT_FN void fft_first4(FFT_DPTR D, int j, c32 x0, c32 x1, c32 x2, c32 x3) {
    dft4(x0, x1, x2, x3);
    const c32 w = twid(j, 16384), w2 = cmul(w, w), w3 = cmul(w2, w);
    FFT_ST(D, fpad(j), x0); FFT_ST(D, fpad(j + 4096), cmul(x1, w)); FFT_ST(D, fpad(j + 8192), cmul(x2, w2)); FFT_ST(D, fpad(j + 12288), cmul(x3, w3));
}
FFT_FN void fft_final4(FFT_DPTR D, int j, c32& u0, c32& u1) {
    const c32 w = twid(j, 16384), w2 = cmul(w, w), w3 = cmul(w2, w);
    c32 a0 = FFT_LD(D, fpad(j)), a1 = cmul(FFT_LD(D, fpad(j + 4096)), w), a2 = cmul(FFT_LD(D, fpad(j + 8192)), w2), a3 = cmul(FFT_LD(D, fpad(j + 12288)), w3);
    dft4(a0, a1, a2, a3);
    u0 = a0; u1 = a1;
}
FFT_FN void fft_first4_inplace(FFT_DPTR D, int j) {
    c32 x0 = FFT_LD(D, fpad(j)), x1 = FFT_LD(D, fpad(j + 4096)), x2 = FFT_LD(D, fpad(j + 8192)), x3 = FFT_LD(D, fpad(j + 12288));
    fft_first4(D, j, x0, x1, x2, x3);
}
#define XB_TMO      128
#define XB_XCNT(j)  (256  + 64 * (j))
#define XB_XSUB(j)  (1280 + 64 * (j))
#define XB_XGEN(j)  (2304 + 64 * (j))
#define XB_TOP      3328
#define XB_TOPGEN   3392
#define XCD_BAR_WORDS 3456
#define XB_SPIN_CAP (1u << 22)

__device__ __forceinline__ unsigned xb_ld(unsigned* p)              { return __hip_atomic_load(p, __ATOMIC_RELAXED, __HIP_MEMORY_SCOPE_AGENT); }
__device__ __forceinline__ unsigned xb_add(unsigned* p, unsigned v) { return __hip_atomic_fetch_add(p, v, __ATOMIC_RELAXED, __HIP_MEMORY_SCOPE_AGENT); }
__device__ __forceinline__ unsigned xb_xcc_id() { return (unsigned)__builtin_amdgcn_s_getreg((3 << 11) | 20) & 0xFu; }
#define XB_SPIN(cond, bar) do { unsigned _sp = 0; while (cond) { __builtin_amdgcn_s_sleep(1); \
    if ((++_sp & 255u) == 0u) { if (xb_ld(&(bar)[XB_TMO])) break; if (_sp > XB_SPIN_CAP) { atomicAdd(&(bar)[XB_TMO], 1u); break; } } } } while (0)

struct XcdBarrier {
    unsigned* bar; unsigned x;
    volatile LAS unsigned* st;
};

__device__ __forceinline__ XcdBarrier xcd_barrier_post(unsigned* bar, volatile LAS unsigned* st) {
    XcdBarrier b; b.bar = bar; b.x = xb_xcc_id(); b.st = st;
    if (threadIdx.x == 0) (void)xb_add(&bar[XB_XCNT(b.x)], 1u);
    return b;
}
__device__ __forceinline__ void xcd_barrier_complete(unsigned* bar, unsigned x, unsigned& nloc, unsigned& nx) {
    const unsigned G = gridDim.x * gridDim.y * gridDim.z;
    unsigned sum, cnt, mine, sp = 0u;
    for (;;) {
        sum = 0u; cnt = 0u; mine = 0u;
#pragma unroll
        for (unsigned j = 0; j < 16; ++j) { const unsigned c = xb_ld(&bar[XB_XCNT(j)]); sum += c; cnt += (c > 0u) ? 1u : 0u; mine = (j == x) ? c : mine; }
        if (sum == G) break;
        __builtin_amdgcn_s_sleep(1);
        if ((++sp & 255u) == 0u) { if (xb_ld(&bar[XB_TMO])) break; if (sp > XB_SPIN_CAP) { atomicAdd(&bar[XB_TMO], 1u); break; } }
    }
    nloc = mine > 0u ? mine : 1u; nx = cnt > 0u ? cnt : 1u;
}

__device__ __forceinline__ void xcd_barrier(const XcdBarrier& b) {
    asm volatile("s_waitcnt vmcnt(0)" ::: "memory");
    __syncthreads();
    if (threadIdx.x == 0) {
        unsigned* bar = b.bar;
        __builtin_amdgcn_s_waitcnt(0);
        unsigned nloc = b.st[0], nx = b.st[1];
        if (nloc == 0u) { xcd_barrier_complete(bar, b.x, nloc, nx); b.st[0] = nloc; b.st[1] = nx; }
        const unsigned old = xb_add(&bar[XB_XSUB(b.x)], 1u);
        const unsigned gen = old / nloc;
        if (old + 1u == (gen + 1u) * nloc) {
            __builtin_amdgcn_fence(__ATOMIC_RELEASE, "agent");
            asm volatile("s_waitcnt vmcnt(0)" ::: "memory");
            const unsigned og = xb_add(&bar[XB_TOP], 1u);
            const unsigned tg = og / nx;
            if (og + 1u == (tg + 1u) * nx) xb_add(&bar[XB_TOPGEN], 1u);
            else XB_SPIN(xb_ld(&bar[XB_TOPGEN]) == tg, bar);
            __builtin_amdgcn_fence(__ATOMIC_ACQUIRE, "agent");
            xb_add(&bar[XB_XGEN(b.x)], 1u);
            asm volatile("s_waitcnt vmcnt(0)" ::: "memory");
        } else {
            XB_SPIN(xb_ld(&bar[XB_XGEN(b.x)]) == gen, bar);
            __builtin_amdgcn_fence(__ATOMIC_ACQUIRE, "agent");
            asm volatile("s_waitcnt vmcnt(0)" ::: "memory");
        }
    }
    __syncthreads();
}


struct Frame {
    LAS unsigned char* lds; unsigned* ctl; unsigned char* ws;
    int tid, lane, wave, vcu, G, gw, ngw;
};
__device__ const float ROPE_INV[16] = {1.0f, 0.5623413251903491f, 0.31622776601683794f, 0.1778279410038923f, 0.1f, 0.05623413251903491f, 0.03162277660168379f, 0.01778279410038923f,
                                       0.01f, 0.005623413251903491f, 0.0031622776601683794f, 0.001778279410038923f, 0.001f, 0.0005623413251903491f, 0.00031622776601683794f, 0.0001778279410038923f};

__device__ __forceinline__ void p0_transpose_item(const float* W, int K, int N, bf16* WT, LAS float* scr, int item, int lane) {
    const int nblk = N / 32, kb = item / nblk, nb = item % nblk, k0 = 64 * kb, n0 = 32 * nb;
#pragma unroll 8
    for (int i = 0; i < 32; ++i) { const int kk = 2 * i + (lane >> 5); scr[kk * 33 + (lane & 31)] = W[(size_t)(k0 + kk) * N + n0 + (lane & 31)]; }
    LDS_WAIT(); asm volatile("" ::: "memory");
    const int c = lane & 7;
#pragma unroll
    for (int j = 0; j < 4; ++j) { const int n = (lane >> 3) + 8 * j; const LAS float* s = scr + (8 * c) * 33 + n;
        v4u o; o.x = pk2(s[0 * 33], s[1 * 33]); o.y = pk2(s[2 * 33], s[3 * 33]); o.z = pk2(s[4 * 33], s[5 * 33]); o.w = pk2(s[6 * 33], s[7 * 33]);
        *(GAS v4u*)(WT + (size_t)(n0 + n) * K + k0 + 8 * c) = o; }
    LDS_WAIT(); asm volatile("" ::: "memory");
}

__device__ __forceinline__ void ph_prologue_a(const Frame& F, const float* c, const float* cctx, const float* w_mod, const float* b_mod, const float* w_in, const float* w_out,
                                              const float* moe_w1, const float* moe_w2, const float* hy_w1, const float* hy_b1, const float* hy_w2, const float* hy_b2, const float* hy_freq, const float* lru_gw, const float* lru_lam) {
    {
        LAS float* scr = (LAS float*)(F.lds + F.wave * 16384);
        constexpr int I_IN = 2 * 1024, I_OUT = 2 * 512, I_W1 = 64 * 1024, I_W2 = 64 * 512, NIT = I_IN + I_OUT + I_W1 + I_W2;
        bf16* WinT = (bf16*)(F.ws + WS_WINT); bf16* WoutT = (bf16*)(F.ws + WS_WOUTT); bf16* W1T = (bf16*)(F.ws + WS_W1T); bf16* W2T = (bf16*)(F.ws + WS_W2T);
        for (int it = F.gw; it < NIT; it += F.ngw) {
            int r = it;
            if (r < I_IN) { const int m = r >> 10; p0_transpose_item(w_in + (size_t)m * 1024 * 2048, 1024, 2048, WinT + (size_t)m * 2048 * 1024, scr, r & 1023, F.lane); continue; } r -= I_IN;
            if (r < I_OUT) { const int m = r >> 9; p0_transpose_item(w_out + (size_t)m * 1024 * 1024, 1024, 1024, WoutT + (size_t)m * 1024 * 1024, scr, r & 511, F.lane); continue; } r -= I_OUT;
            if (r < I_W1) { const int m = r >> 10; p0_transpose_item(moe_w1 + (size_t)m * 1024 * 2048, 1024, 2048, W1T + (size_t)m * 2048 * 1024, scr, r & 1023, F.lane); continue; } r -= I_W1;
            { const int m = r >> 9; p0_transpose_item(moe_w2 + (size_t)m * 1024 * 1024, 1024, 1024, W2T + (size_t)m * 1024 * 1024, scr, r & 511, F.lane); }
        }
    }
    __syncthreads();
    {
        LAS float* sl = (LAS float*)(F.lds);
        LAS float* red = (LAS float*)(F.lds + 20480);
        float* MOD = (float*)(F.ws + WS_MOD);
        if ((int)blockIdx.x < 192) {
            for (int i = F.tid; i < 5 * 1024; i += NTHR) { const int r = i >> 10, k = i & 1023; const float v = (r < 4) ? c[r * 1024 + k] : cctx[k]; sl[i] = v / (1.0f + __expf(-v)); }
        }
        __syncthreads();
        for (int it = blockIdx.x; it < 192; it += F.G) {
            const int l = it / 96, n = (it % 96) * 64 + F.lane;
            float a0 = 0.f, a1 = 0.f, a2 = 0.f, a3 = 0.f, a4 = 0.f;
            const float* wp = w_mod + ((size_t)l * 1024 + F.wave * 128) * 6144 + n;
#pragma unroll 8
            for (int k = 0; k < 128; ++k) { const float w = wp[(size_t)k * 6144]; const int kk = F.wave * 128 + k;
                a0 += sl[kk] * w; a1 += sl[1024 + kk] * w; a2 += sl[2048 + kk] * w; a3 += sl[3072 + kk] * w; a4 += sl[4096 + kk] * w; }
            red[(F.wave * 5 + 0) * 64 + F.lane] = a0; red[(F.wave * 5 + 1) * 64 + F.lane] = a1; red[(F.wave * 5 + 2) * 64 + F.lane] = a2; red[(F.wave * 5 + 3) * 64 + F.lane] = a3; red[(F.wave * 5 + 4) * 64 + F.lane] = a4;
            __syncthreads();
            if (F.tid < 320) { const int r = F.tid >> 6, ln = F.tid & 63; float s = 0.f;
#pragma unroll
                for (int w = 0; w < 8; ++w) s += red[(w * 5 + r) * 64 + ln];
                const int nn = (it % 96) * 64 + ln; MOD[(size_t)(l * 5 + r) * 6144 + nn] = s + b_mod[l * 6144 + nn]; }
            __syncthreads();
        }
    }
    {
        bf16* WGT = (bf16*)(F.ws + WS_WGT); float* SPT = (float*)(F.ws + WS_SPT);
        for (int idx = blockIdx.x * NTHR + F.tid; idx < 2 * 1024 * 256; idx += F.G * NTHR) {
            const int l = idx >> 18, nidx = (idx >> 8) & 1023, k = idx & 255;
            const int pn = nidx >> 8, j = (nidx >> 7) & 1, cc = nidx & 127, d = pn >> 1, ch = 128 * (pn & 1) + cc, n = ch >> 6, e = ch & 63;
            const float v = ((k >> 6) == n) ? lru_gw[((size_t)((((l * 2 + d) * 2 + j) * 4 + n) * 64 + (k & 63))) * 64 + e] : 0.f;
            WGT[idx] = (bf16)f2bf(v); }
        for (int idx = blockIdx.x * NTHR + F.tid; idx < 2 * 2 * 256; idx += F.G * NTHR) SPT[idx] = log1pf(expf(-lru_lam[idx]));
    }
    {
        float* RC = (float*)(F.ws + WS_ROPEC); float* RS = (float*)(F.ws + WS_ROPES);
        for (int idx = blockIdx.x * NTHR + F.tid; idx < SEQ * 32; idx += F.G * NTHR) {
            const int t = idx >> 5, i = idx & 31; const int pos = (i < 16) ? (t >> 6) : (t & 63);
            const float ang = (float)pos * ROPE_INV[i & 15];
            double s, cc; sincos_d((double)ang, s, cc); RC[idx] = (float)cc; RS[idx] = (float)s; }
    }
    {
        float* H2 = (float*)(F.ws + WS_H2);
        for (int it = F.gw; it < 2 * SEQ + CTXL; it += F.ngw) {
            const int v = it >> 13, t = (v < 2) ? (it & (SEQ - 1)) : (it - 2 * SEQ), L = (v < 2) ? SEQ : CTXL, l = (v == 1) ? 1 : 0;
            const int j = F.lane;
            float z = 0.f;
            if (j == 0) z = (float)t / (float)(L - 1);
            else if (j <= 32) { const int b = (j - 1) & 15; const float band = 1e-4f + (float)b * ((15.0f - 1e-4f) / 15.0f);
                const float ang = ((6.283185307179586f / (float)L) * (float)t) * band;
                double s, cc; sincos_d((double)ang, s, cc); z = (j <= 16) ? (float)cc : -(float)s; }
            const float fr = hy_freq[l * 64 + j];
            float p1 = hy_b1[l * 64 + j];
            const float* w1 = hy_w1 + (size_t)l * 33 * 64;
#pragma unroll
            for (int i = 0; i < 33; ++i) p1 += __shfl(z, i) * w1[i * 64 + j];
            double s1, c1; sincos_d((double)(fr * p1), s1, c1); const float h1 = (float)s1;
            float p2 = hy_b2[l * 64 + j];
            const float* w2 = hy_w2 + (size_t)l * 64 * 64;
#pragma unroll 16
            for (int i = 0; i < 64; ++i) p2 += __shfl(h1, i) * w2[i * 64 + j];
            double s2, c2; sincos_d((double)(fr * p2), s2, c2);
            H2[((size_t)v * SEQ + t) * 64 + j] = (float)s2;
        }
    }
}

__device__ __forceinline__ void ph_prologue_b(const Frame& F, const float* hy_w3, const float* hy_decay) {
    LAS f32x2v* D = (LAS f32x2v*)(F.lds);
    LAS float* kt = (LAS float*)(F.lds);
    LAS float* w3c = (LAS float*)(F.lds + 139264);
    LAS float* red = (LAS float*)(F.lds + 139264 + 512);
    const float* H2 = (const float*)(F.ws + WS_H2);
    c32* KHAT = (c32*)(F.ws + WS_KHAT); float* KFC = (float*)(F.ws + WS_KFC);
    for (int it = blockIdx.x; it < 768; it += F.G) {
        const int v = it >> 8, c = it & 255, L = (v < 2) ? SEQ : CTXL, l = (v == 1) ? 1 : 0;
        if (F.tid < 128) w3c[F.tid] = hy_w3[(size_t)l * 64 * 512 + (F.tid & 63) * 512 + (F.tid >> 6) * 256 + c];
        if (F.tid == 0) { if (v < 2) { f32x2v z; z.x = 0.f; z.y = 0.f; D[fpad(L)] = z; } else kt[L] = 0.f; }
        __syncthreads();
        const float df = fabsf(hy_decay[l * 512 + c]), db = fabsf(hy_decay[l * 512 + 256 + c]);
        float asum = 0.f;
        for (int t = F.tid; t < L; t += NTHR) {
            const f32x4* row = (const f32x4*)(H2 + ((size_t)v * SEQ + t) * 64);
            float hf = 0.f, hb = 0.f;
#pragma unroll
            for (int q = 0; q < 16; ++q) { const f32x4 h = row[q];
                hf += h.x * w3c[4 * q] + h.y * w3c[4 * q + 1] + h.z * w3c[4 * q + 2] + h.w * w3c[4 * q + 3];
                hb += h.x * w3c[64 + 4 * q] + h.y * w3c[64 + 4 * q + 1] + h.z * w3c[64 + 4 * q + 2] + h.w * w3c[64 + 4 * q + 3]; }
            const float t01 = (float)t / (float)(L - 1);
            hf *= expf(-t01 * df); hb *= expf(-t01 * db);
            asum += fabsf(hf); if (t >= 1) asum += fabsf(hb);
            if (v < 2) { f32x2v z; z.x = hf; z.y = 0.f; D[fpad(t)] = z; if (t >= 1) { z.x = hb; D[fpad(2 * L - t)] = z; } }
            else { kt[t] = hf; if (t >= 1) kt[2 * L - t] = hb; }
        }
        asum = wave_sum(asum);
        if (F.lane == 0) red[F.wave] = asum;
        __syncthreads();
        float tot = 0.f;
#pragma unroll
        for (int w = 0; w < 8; ++w) tot += red[w];
        const float inv = 1.0f / tot;
        if (v < 2) {
            c32* out = KHAT + (size_t)(v * 256 + c) * 16384;
#pragma unroll 1
            for (int i = 0; i < 8; ++i) fft_first4_inplace(D, F.tid + 512 * i);
            __syncthreads();
            _Pragma("unroll 1") for (int g_ = F.tid; g_ < 1024; g_ += 512) fft_fwd16(D, g_, 4096);
            __syncthreads();
            _Pragma("unroll 1") for (int g_ = F.tid; g_ < 1024; g_ += 512) fft_fwd16(D, g_, 256);
            __syncthreads();
            _Pragma("unroll 1") for (int g_ = F.tid; g_ < 1024; g_ += 512) fft_last16_out(D, g_, out, inv * (1.0f / 16384.0f));
        } else {
            float* dst = KFC + (size_t)c * 512;
            for (int j = F.tid; j < 2 * L; j += NTHR) dst[j] = kt[j] * inv;
        }
        __syncthreads();
    }
}

__device__ __forceinline__ void ph_norm_mod(const Frame& F, int l, const float* x, const float* ctx, const float* gmix) {
    const float* XR = (const float*)(F.ws + WS_XR); const float* MOD = (const float*)(F.ws + WS_MOD); bf16* H = (bf16*)(F.ws + WS_H);
    for (int r = F.gw; r < MT; r += F.ngw) {
        const float* src = (l == 0) ? (r < NLAT ? x + (size_t)r * 1024 : ctx + (size_t)(r - NLAT) * 1024) : XR + (size_t)r * 1024;
        const int bidx = r < NLAT ? r / SEQ : 4;
        const float* shift = MOD + (size_t)(l * 5 + bidx) * 6144; const float* scale = shift + 1024; const float* g = gmix + l * 1024;
        f32x4 v[4]; float ss = 0.f;
#pragma unroll
        for (int j = 0; j < 4; ++j) { v[j] = ((const f32x4*)src)[64 * j + F.lane]; ss += (v[j].x * v[j].x + v[j].y * v[j].y) + (v[j].z * v[j].z + v[j].w * v[j].w); }
        const float rstd = 1.0f / sqrtf(wave_sum(ss) * (1.0f / 1024.0f) + EPSN);
#pragma unroll
        for (int j = 0; j < 4; ++j) { const int cb = 64 * j + F.lane; const f32x4 gg = ((const f32x4*)g)[cb], sc = ((const f32x4*)scale)[cb], sh = ((const f32x4*)shift)[cb];
            const f32x4 y = v[j] * rstd * gg * (sc + 1.0f) + sh;
            v2u o; o.x = pk2(y.x, y.y); o.y = pk2(y.z, y.w); ((v2u*)(H + (size_t)r * 1024))[cb] = o; }
    }
}

__device__ __forceinline__ void ph_post_proj(const Frame& F, int l, const float* qg_, const float* kg_, const float* lru_cw, const float* lru_cb, const float* hy_cw, const float* hy_cb) {
    const bf16* U = (const bf16*)(F.ws + WS_U);
    {
        bf16* Q = (bf16*)(F.ws + WS_Q); bf16* K = (bf16*)(F.ws + WS_K); bf16* V = (bf16*)(F.ws + WS_V);
        const float* RC = (const float*)(F.ws + WS_ROPEC); const float* RS = (const float*)(F.ws + WS_ROPES);
        const int o8 = 8 * (F.lane & 7);
        const f32x4 qg0 = *(const f32x4*)(qg_ + l * 64 + o8), qg1 = *(const f32x4*)(qg_ + l * 64 + o8 + 4), kg0 = *(const f32x4*)(kg_ + l * 64 + o8), kg1 = *(const f32x4*)(kg_ + l * 64 + o8 + 4);
        const float C2 = 0.125f * 1.4426950408889634f;
        const bool lohalf = (F.lane & 4) == 0;
        for (int r = F.gw; r < MT; r += F.ngw) {
            const bool isctx = r >= NLAT; const int b = isctx ? (r - NLAT) / CTXL : r / SEQ; const int t = isctx ? (r - NLAT) % CTXL : r % SEQ;
            const bf16* ur = U + (size_t)r * INW;
            const v4u wq = ((const v4u*)ur)[F.lane];
            const v4u wk = ((const v4u*)(ur + 512))[F.lane & 31];
            f32x4 c0 = {1.f, 1.f, 1.f, 1.f}, c1 = c0, s0 = {0.f, 0.f, 0.f, 0.f}, s1 = s0;
            if (!isctx) { const float* rc = RC + t * 32 + 8 * (F.lane & 3); const float* rs = RS + t * 32 + 8 * (F.lane & 3);
                c0 = *(const f32x4*)rc; c1 = *(const f32x4*)(rc + 4); s0 = *(const f32x4*)rs; s1 = *(const f32x4*)(rs + 4); }
            const size_t krow = (size_t)b * KEYS + (isctx ? t : CTXL + t);
#pragma unroll
            for (int part = 0; part < 2; ++part) {
                const v4u w = part ? wk : wq;
                float x[8] = {bflo(w.x), bfhi(w.x), bflo(w.y), bfhi(w.y), bflo(w.z), bfhi(w.z), bflo(w.w), bfhi(w.w)};
                float ss = 0.f;
#pragma unroll
                for (int i = 0; i < 8; ++i) ss += x[i] * x[i];
                ss += __shfl_xor(ss, 1); ss += __shfl_xor(ss, 2); ss += __shfl_xor(ss, 4);
                const float rstd = 1.0f / sqrtf(ss * (1.0f / 64.0f) + EPSN);
                const f32x4 g0 = part ? kg0 : qg0, g1 = part ? kg1 : qg1;
                float y[8], o[8];
#pragma unroll
                for (int i = 0; i < 8; ++i) y[i] = x[i] * rstd * (i < 4 ? g0[i] : g1[i - 4]);
#pragma unroll
                for (int i = 0; i < 8; ++i) { const float p = __shfl_xor(y[i], 4); const float cs = i < 4 ? c0[i] : c1[i - 4], sn = i < 4 ? s0[i] : s1[i - 4];
                    o[i] = lohalf ? (y[i] * cs - p * sn) : (y[i] * cs + p * sn); }
                if (part == 0) { v4u ow; ow.x = pk2(o[0] * C2, o[1] * C2); ow.y = pk2(o[2] * C2, o[3] * C2); ow.z = pk2(o[4] * C2, o[5] * C2); ow.w = pk2(o[6] * C2, o[7] * C2);
                    ((v4u*)(Q + (size_t)r * 512))[F.lane] = ow; }
                else { v4u ow; ow.x = pk2(o[0], o[1]); ow.y = pk2(o[2], o[3]); ow.z = pk2(o[4], o[5]); ow.w = pk2(o[6], o[7]);
                    if (F.lane < 16) ((v4u*)(K + krow * 128))[F.lane] = ow;
                    else if (F.lane < 32) ((v4u*)(V + krow * 128))[F.lane - 16] = wk; }
            }
        }
    }
    {
        bf16* XL = (bf16*)(F.ws + WS_XL);
        for (int idx = blockIdx.x * NTHR + F.tid; idx < MT * 32; idx += F.G * NTHR) {
            const int r = idx >> 5, c8 = (idx & 31) * 8;
            const bool isctx = r >= NLAT; const int Ls = isctx ? CTXL : SEQ; const int t = isctx ? (r - NLAT) % CTXL : r % SEQ;
            float acc[8];
#pragma unroll
            for (int i = 0; i < 8; ++i) acc[i] = lru_cb[l * 256 + c8 + i];
#pragma unroll
            for (int j = 0; j < 4; ++j) { const int tj = t + j - 2;
                if (tj >= 0 && tj < Ls) { const v4u w = *(const v4u*)(U + (size_t)(r + j - 2) * INW + 768 + c8);
                    const f32x4 w0 = *(const f32x4*)(lru_cw + (l * 4 + j) * 256 + c8), w1 = *(const f32x4*)(lru_cw + (l * 4 + j) * 256 + c8 + 4);
                    acc[0] += w0.x * bflo(w.x); acc[1] += w0.y * bfhi(w.x); acc[2] += w0.z * bflo(w.y); acc[3] += w0.w * bfhi(w.y);
                    acc[4] += w1.x * bflo(w.z); acc[5] += w1.y * bfhi(w.z); acc[6] += w1.z * bflo(w.w); acc[7] += w1.w * bfhi(w.w); } }
            v4u o; o.x = pk2(acc[0], acc[1]); o.y = pk2(acc[2], acc[3]); o.z = pk2(acc[4], acc[5]); o.w = pk2(acc[6], acc[7]);
            *(v4u*)(XL + (size_t)r * 256 + c8) = o;
        }
    }
    __syncthreads();
    {
        LAS bf16* hs = (LAS bf16*)(F.lds);
        float* VT = (float*)(F.ws + WS_VT); float* X0T = (float*)(F.ws + WS_X0T);
        const float* cw = hy_cw + (size_t)l * 3 * 768; const float* cbp = hy_cb + l * 768;
        for (int it = blockIdx.x; it < NLAT / 64; it += F.G) {
            const int b = it >> 7, t0 = (it & 127) * 64;
            for (int i = F.tid; i < 66 * 384; i += NTHR) { const int rr = i / 384, c2 = i - rr * 384; const int t = t0 - 1 + rr;
                unsigned w = 0u; if (t >= 0 && t < SEQ) w = *(const unsigned*)(U + (size_t)(b * SEQ + t) * INW + 1280 + 2 * c2);
                *(LAS unsigned*)(hs + rr * 770 + 2 * c2) = w; }
            __syncthreads();
            for (int c = F.wave; c < 256; c += NWAVES) {
                const int tt = F.lane;
                float o[3];
#pragma unroll
                for (int g = 0; g < 3; ++g) { const int cc = g * 256 + c;
                    o[g] = cw[cc] * bf2f(hs[tt * 770 + cc]) + cw[768 + cc] * bf2f(hs[(tt + 1) * 770 + cc]) + cw[1536 + cc] * bf2f(hs[(tt + 2) * 770 + cc]) + cbp[cc]; }
                const size_t oi = ((size_t)b * 256 + c) * SEQ + t0 + tt;
                VT[oi] = o[2] * o[1]; X0T[oi] = o[0];
            }
            __syncthreads();
        }
    }
}

__device__ __forceinline__ void ph_ctx_attn(const Frame& F) {
    const bf16* Q = (const bf16*)(F.ws + WS_Q); const bf16* K = (const bf16*)(F.ws + WS_K); const bf16* V = (const bf16*)(F.ws + WS_V); bf16* O = (bf16*)(F.ws + WS_ATT);
    LAS float* qs = (LAS float*)(F.lds + 90112 + F.wave * 1280);
    LAS float* ps = qs + 64;
    for (int it = F.gw; it < NCTX * 8; it += F.ngw) {
        const int rc = it >> 3, h = it & 7, b = rc / CTXL, kvh = h >> 2; const int r = NLAT + rc;
        qs[F.lane] = bf2f(Q[(size_t)r * 512 + h * 64 + F.lane]);
        LDS_WAIT();
        float sc[4]; float mx = -INFINITY;
#pragma unroll
        for (int i = 0; i < 4; ++i) { const int key = F.lane + 64 * i; const v4u* kp = (const v4u*)(K + ((size_t)b * KEYS + key) * 128 + kvh * 64);
            float s = 0.f;
#pragma unroll
            for (int q = 0; q < 8; ++q) { const v4u w = kp[q];
                s += qs[8 * q] * bflo(w.x) + qs[8 * q + 1] * bfhi(w.x) + qs[8 * q + 2] * bflo(w.y) + qs[8 * q + 3] * bfhi(w.y) + qs[8 * q + 4] * bflo(w.z) + qs[8 * q + 5] * bfhi(w.z) + qs[8 * q + 6] * bflo(w.w) + qs[8 * q + 7] * bfhi(w.w); }
            sc[i] = s; mx = fmaxf(mx, s); }
#pragma unroll
        for (int o = 1; o < 64; o <<= 1) mx = fmaxf(mx, __shfl_xor(mx, o));
        float sum = 0.f;
#pragma unroll
        for (int i = 0; i < 4; ++i) { const float p = exp2f(sc[i] - mx); sum += p; ps[F.lane + 64 * i] = p; }
        sum = wave_sum(sum);
        LDS_WAIT();
        float acc = 0.f;
        const bf16* vp = V + (size_t)b * KEYS * 128 + kvh * 64 + F.lane;
#pragma unroll 8
        for (int key = 0; key < CTXL; ++key) acc += ps[key] * bf2f(vp[(size_t)key * 128]);
        O[(size_t)r * 512 + h * 64 + F.lane] = (bf16)f2bf(acc / sum);
        LDS_WAIT();
    }
}

__device__ __forceinline__ int chunk_row0(int b, int d, int k) {
    if (k < 2) { const int cc = d ? 1 - k : k; return NLAT + b * CTXL + cc * CHUNK; }
    const int lc = d ? 63 - (k - 2) : (k - 2); return b * SEQ + lc * CHUNK;
}
__device__ __forceinline__ void ph_scan1(const Frame& F) {
    const float* LAB = (const float*)(F.ws + WS_LAB); float* SUMP = (float*)(F.ws + WS_SCANS); float* SUMH = SUMP + NB * 2 * NCHUNK * 256;
    for (int it = blockIdx.x * NTHR + F.tid; it < NB * 2 * NCHUNK * 256; it += F.G * NTHR) {
        const int ch = it & 255, k = (it >> 8) % NCHUNK, bd = (it >> 8) / NCHUNK, d = bd & 1, b = bd >> 1;
        const int r0 = chunk_row0(b, d, k);
        const float* LA = LAB + (size_t)(2 * d) * LAB_STRIDE + ch; const float* LB = LAB + (size_t)(2 * d + 1) * LAB_STRIDE + ch;
        float h = 0.f, P = 1.f;
#pragma unroll 8
        for (int i = 0; i < CHUNK; ++i) { const int r = d ? r0 + CHUNK - 1 - i : r0 + i; const float a = LA[(size_t)r * 256], bx = LB[(size_t)r * 256]; h = a * h + bx; P *= a; }
        SUMP[it] = P; SUMH[it] = h;
    }
}
__device__ __forceinline__ void ph_scan2(const Frame& F) {
    const float* LAB = (const float*)(F.ws + WS_LAB); const float* SUMP = (const float*)(F.ws + WS_SCANS); const float* SUMH = SUMP + NB * 2 * NCHUNK * 256;
    float* LRUO = (float*)(F.ws + WS_LRUO); const bf16* U = (const bf16*)(F.ws + WS_U);
    for (int it = blockIdx.x * NTHR + F.tid; it < NB * NCHUNK * 256; it += F.G * NTHR) {
        const int ch = it & 255, kc = (it >> 8) % NCHUNK, b = (it >> 8) / NCHUNK;
        const int r0 = chunk_row0(b, 0, kc);
#pragma unroll 1
        for (int d = 0; d < 2; ++d) {
            const int k = d ? ((kc < 2) ? 1 - kc : 2 + 63 - (kc - 2)) : kc;
            const size_t sb = (size_t)((b * 2 + d) * NCHUNK) * 256 + ch;
            float h = 0.f;
            for (int j = 0; j < k; ++j) h = SUMP[sb + (size_t)j * 256] * h + SUMH[sb + (size_t)j * 256];
            const float* LA = LAB + (size_t)(2 * d) * LAB_STRIDE + ch; const float* LB = LAB + (size_t)(2 * d + 1) * LAB_STRIDE + ch;
            if (d == 0) {
#pragma unroll 8
                for (int i = 0; i < CHUNK; ++i) { const int r = r0 + i; h = LA[(size_t)r * 256] * h + LB[(size_t)r * 256]; LRUO[(size_t)r * 256 + ch] = h; }
            } else {
#pragma unroll 8
                for (int i = 0; i < CHUNK; ++i) { const int r = r0 + CHUNK - 1 - i; h = LA[(size_t)r * 256] * h + LB[(size_t)r * 256];
                    const float lg = bf2f(U[(size_t)r * INW + 1024 + ch]);
                    LRUO[(size_t)r * 256 + ch] = (LRUO[(size_t)r * 256 + ch] + h) * gelu_tanh(lg); }
            }
        }
    }
}

__device__ __forceinline__ void ph_hyena_direct(const Frame& F, int l, const float* hy_bias, const float* hy_cw, const float* hy_cb) {
    LAS float* ks = (LAS float*)(F.lds);
    LAS float* vs = (LAS float*)(F.lds + 65536);
    const float* KF = (const float*)(F.ws + WS_KF) + (size_t)l * 256 * 16384;
    const float* VT = (const float*)(F.ws + WS_VT); const float* X0T = (const float*)(F.ws + WS_X0T); float* HYO = (float*)(F.ws + WS_HYO);
    for (int it = blockIdx.x; it < 512; it += F.G) {
        const int c = it >> 1, bp = it & 1;
        for (int i = F.tid; i < 4096; i += NTHR) ((LAS f32x4*)ks)[i] = ((const f32x4*)(KF + (size_t)c * 16384))[i];
        for (int i = F.tid; i < 4096; i += NTHR) { const int bb = i >> 11, q = i & 2047; ((LAS f32x4*)vs)[i] = ((const f32x4*)(VT + ((size_t)(bp * 2 + bb) * 256 + c) * SEQ))[q]; }
        __syncthreads();
        float y0[16], y1[16];
#pragma unroll
        for (int i = 0; i < 16; ++i) { y0[i] = 0.f; y1[i] = 0.f; }
#pragma unroll 2
        for (int s = 0; s < SEQ; ++s) {
            const float v0 = vs[s], v1 = vs[SEQ + s];
            const int base = (F.tid - s) & 16383;
#pragma unroll
            for (int i = 0; i < 16; ++i) { const float kk = ks[(base + 512 * i) & 16383]; y0[i] += kk * v0; y1[i] += kk * v1; }
        }
        const float bias = hy_bias[l * 256 + c];
#pragma unroll
        for (int i = 0; i < 16; ++i) { const int t = F.tid + 512 * i;
            { const int b = bp * 2; const size_t oi = ((size_t)b * 256 + c) * SEQ + t; HYO[((size_t)b * SEQ + t) * 256 + c] = (y0[i] + vs[t] * bias) * X0T[oi]; }
            { const int b = bp * 2 + 1; const size_t oi = ((size_t)b * 256 + c) * SEQ + t; HYO[((size_t)b * SEQ + t) * 256 + c] = (y1[i] + vs[SEQ + t] * bias) * X0T[oi]; } }
        __syncthreads();
    }
}
__device__ __forceinline__ void ph_khat(const Frame& F) {
    LAS f32x2v* D = (LAS f32x2v*)(F.lds);
    const float* KF = (const float*)(F.ws + WS_KF); c32* KHAT = (c32*)(F.ws + WS_KHAT);
    for (int it = blockIdx.x; it < 512; it += F.G) {
        const float* k = KF + (size_t)it * 16384; c32* out = KHAT + (size_t)it * 16384;
#pragma unroll 1
        for (int i = 0; i < 8; ++i) { const int j = F.tid + 512 * i; c32 x0, x1, x2, x3; x0.x = k[j]; x1.x = k[j + 4096]; x2.x = k[j + 8192]; x3.x = k[j + 12288]; x0.y = x1.y = x2.y = x3.y = 0.f;
            fft_first4(D, j, x0, x1, x2, x3); }
        __syncthreads();
        _Pragma("unroll 1") for (int g_ = F.tid; g_ < 1024; g_ += 512) fft_fwd16(D, g_, 4096);
        __syncthreads();
        _Pragma("unroll 1") for (int g_ = F.tid; g_ < 1024; g_ += 512) fft_fwd16(D, g_, 256);
        __syncthreads();
        _Pragma("unroll 1") for (int g_ = F.tid; g_ < 1024; g_ += 512) fft_last16_out(D, g_, out, 1.0f / 16384.0f);
        __syncthreads();
    }
}
__device__ __forceinline__ void ph_hyena_fft(const Frame& F, int l, const float* hy_bias) {
    LAS f32x2v* D = (LAS f32x2v*)(F.lds);
    const c32* KHAT = (const c32*)(F.ws + WS_KHAT) + (size_t)l * 256 * 16384;
    const float* VT = (const float*)(F.ws + WS_VT); const float* X0T = (const float*)(F.ws + WS_X0T); float* HYO = (float*)(F.ws + WS_HYO);
    for (int it = blockIdx.x; it < 512; it += F.G) {
        const int c = it >> 1, bp = it & 1;
        const float* va = VT + ((size_t)(bp * 2) * 256 + c) * SEQ; const float* vb = VT + ((size_t)(bp * 2 + 1) * 256 + c) * SEQ;
#ifndef REP_FFT
#define REP_FFT 1
#endif
#pragma unroll 1
        for (int repf_ = 0; repf_ < REP_FFT; ++repf_) {
#pragma unroll 1
        for (int i = 0; i < 8; ++i) { const int j = F.tid + 512 * i; c32 x0, x1, z; x0.x = va[j]; x0.y = vb[j]; x1.x = va[j + 4096]; x1.y = vb[j + 4096]; z.x = 0.f; z.y = 0.f;
            fft_first4(D, j, x0, x1, z, z); }
        __syncthreads();
        _Pragma("unroll 1") for (int g_ = F.tid; g_ < 1024; g_ += 512) fft_fwd16(D, g_, 4096);
        __syncthreads();
        _Pragma("unroll 1") for (int g_ = F.tid; g_ < 1024; g_ += 512) fft_fwd16(D, g_, 256);
        __syncthreads();
        _Pragma("unroll 1") for (int g_ = F.tid; g_ < 1024; g_ += 512) fft_mid16(D, g_, KHAT + (size_t)c * 16384);
        __syncthreads();
        _Pragma("unroll 1") for (int g_ = F.tid; g_ < 1024; g_ += 512) fft_inv16(D, g_, 256);
        __syncthreads();
        _Pragma("unroll 1") for (int g_ = F.tid; g_ < 1024; g_ += 512) fft_inv16(D, g_, 4096);
        __syncthreads();
        }
        const float bias = hy_bias[l * 256 + c];
        const float* xa = X0T + ((size_t)(bp * 2) * 256 + c) * SEQ; const float* xb = X0T + ((size_t)(bp * 2 + 1) * 256 + c) * SEQ;
        float* oa = HYO + ((size_t)(bp * 2) * 256 + c) * SEQ; float* ob = HYO + ((size_t)(bp * 2 + 1) * 256 + c) * SEQ;
#pragma unroll 2
        for (int i = 0; i < 8; ++i) { const int j = F.tid + 512 * i; c32 u0, u1; fft_final4(D, j, u0, u1);
            oa[j] = (u0.x + va[j] * bias) * xa[j];                 ob[j] = (-u0.y + vb[j] * bias) * xb[j];
            oa[j + 4096] = (u1.x + va[j + 4096] * bias) * xa[j + 4096]; ob[j + 4096] = (-u1.y + vb[j + 4096] * bias) * xb[j + 4096]; }
        __syncthreads();
    }
}
__device__ __forceinline__ void ph_hyena_ctx(const Frame& F, const float* hy_bias, const float* hy_cw, const float* hy_cb) {
    float* HYO = (float*)(F.ws + WS_HYO);
    {

        const bf16* U = (const bf16*)(F.ws + WS_U); const float* KFC = (const float*)(F.ws + WS_KFC);
        LAS float* vw = (LAS float*)(F.lds + F.wave * 4096);
        LAS float* kw = vw + 256;
        const float* cw = hy_cw; const float* cbp = hy_cb;
        for (int it = F.gw; it < NB * 256; it += F.ngw) {
            const int b = it >> 8, c = it & 255;
            float x0v[4];
#pragma unroll
            for (int i = 0; i < 4; ++i) { const int t = F.lane + 64 * i;
                float o[3];
#pragma unroll
                for (int g = 0; g < 3; ++g) { const int cc = g * 256 + c; float a = cbp[cc];
#pragma unroll
                    for (int j = 0; j < 3; ++j) { const int tj = t + j - 1; if (tj >= 0 && tj < CTXL) a += cw[j * 768 + cc] * bf2f(U[(size_t)(NLAT + b * CTXL + tj) * INW + 1280 + cc]); }
                    o[g] = a; }
                vw[t] = o[2] * o[1]; x0v[i] = o[0]; }
#pragma unroll
            for (int i = 0; i < 8; ++i) kw[F.lane + 64 * i] = KFC[c * 512 + F.lane + 64 * i];
            LDS_WAIT();
            float y[4] = {0.f, 0.f, 0.f, 0.f};
#pragma unroll 4
            for (int s = 0; s < CTXL; ++s) { const float vv = vw[s];
#pragma unroll
                for (int i = 0; i < 4; ++i) y[i] += kw[(F.lane + 64 * i - s) & 511] * vv; }
            const float bias = hy_bias[c];
#pragma unroll
            for (int i = 0; i < 4; ++i) { const int t = F.lane + 64 * i; HYO[(size_t)(NLAT + b * CTXL + t) * 256 + c] = (y[i] + vw[t] * bias) * x0v[i]; }
            LDS_WAIT();
        }
    }
}

__device__ __forceinline__ void merge_row(const Frame& F, int r, const float* g, float h0, float h1, float h2, float h3) {
    const bf16* ATT = (const bf16*)(F.ws + WS_ATT); const float* LRUO = (const float*)(F.ws + WS_LRUO); bf16* MIXA = (bf16*)(F.ws + WS_MIXA);
    const v4u aw = ((const v4u*)(ATT + (size_t)r * 512))[F.lane];
    float a[8] = {bflo(aw.x), bfhi(aw.x), bflo(aw.y), bfhi(aw.y), bflo(aw.z), bfhi(aw.z), bflo(aw.w), bfhi(aw.w)};
    float ss = 0.f;
#pragma unroll
    for (int i = 0; i < 8; ++i) ss += a[i] * a[i];
    const float ra = 1.0f / sqrtf(wave_sum(ss) * (1.0f / 512.0f) + EPSN);
    const f32x4 lv = ((const f32x4*)(LRUO + (size_t)r * 256))[F.lane];
    const float rl = 1.0f / sqrtf(wave_sum(lv.x * lv.x + lv.y * lv.y + lv.z * lv.z + lv.w * lv.w) * (1.0f / 256.0f) + EPSN);
    const float rh = 1.0f / sqrtf(wave_sum(h0 * h0 + h1 * h1 + h2 * h2 + h3 * h3) * (1.0f / 256.0f) + EPSN);
    bf16* orow = MIXA + (size_t)r * 1024;
    { const f32x4 g0 = ((const f32x4*)g)[2 * F.lane], g1 = ((const f32x4*)g)[2 * F.lane + 1];
      v4u o; o.x = pk2(a[0] * ra * g0.x, a[1] * ra * g0.y); o.y = pk2(a[2] * ra * g0.z, a[3] * ra * g0.w); o.z = pk2(a[4] * ra * g1.x, a[5] * ra * g1.y); o.w = pk2(a[6] * ra * g1.z, a[7] * ra * g1.w);
      ((v4u*)orow)[F.lane] = o; }
    { const f32x4 gg = ((const f32x4*)(g + 512))[F.lane]; v2u o; o.x = pk2(lv.x * rl * gg.x, lv.y * rl * gg.y); o.y = pk2(lv.z * rl * gg.z, lv.w * rl * gg.w); ((v2u*)(orow + 512))[F.lane] = o; }
    orow[768 + F.lane] = (bf16)f2bf(h0 * rh * g[768 + F.lane]); orow[832 + F.lane] = (bf16)f2bf(h1 * rh * g[832 + F.lane]);
    orow[896 + F.lane] = (bf16)f2bf(h2 * rh * g[896 + F.lane]); orow[960 + F.lane] = (bf16)f2bf(h3 * rh * g[960 + F.lane]);
}
__device__ __forceinline__ void ph_merge(const Frame& F, int l, int nrows, const float* out_g) {
    const float* HYO = (const float*)(F.ws + WS_HYO);
    const float* g = out_g + l * 1024;
    LAS float* tile = (LAS float*)(F.lds);
    for (int it = blockIdx.x; it < NLAT / 64; it += F.G) {
        const int b = it >> 7, t0 = (it & 127) * 64;
#pragma unroll 8
        for (int i = 0; i < 32; ++i) { const int c = F.wave * 32 + i; tile[c * 65 + F.lane] = HYO[((size_t)b * 256 + c) * SEQ + t0 + F.lane]; }
        __syncthreads();
#pragma unroll 2
        for (int k = 0; k < 8; ++k) { const int tt = F.wave * 8 + k;
            merge_row(F, b * SEQ + t0 + tt, g, tile[F.lane * 65 + tt], tile[(F.lane + 64) * 65 + tt], tile[(F.lane + 128) * 65 + tt], tile[(F.lane + 192) * 65 + tt]); }
        __syncthreads();
    }
    for (int r = NLAT + F.gw; r < nrows; r += F.ngw) {
        const float* hr = HYO + (size_t)r * 256;
        merge_row(F, r, g, hr[F.lane], hr[64 + F.lane], hr[128 + F.lane], hr[192 + F.lane]);
    }
}

__device__ __forceinline__ void ph_ffn_router(const Frame& F, int l, int nrows, const float* gffn, const float* router_w, const float* router_b) {
    LAS float* rwl = (LAS float*)(F.lds);
    LAS int* hist = (LAS int*)(F.lds + 135168);
    const float* XR = (const float*)(F.ws + WS_XR); const float* MOD = (const float*)(F.ws + WS_MOD); bf16* Fb = (bf16*)(F.ws + WS_F);
    int* TOPI = (int*)(F.ws + WS_TOPI); float* GATE = (float*)(F.ws + WS_GATE); int* BLKCNT = (int*)(F.ws + WS_BLKCNT);
    for (int i = F.tid; i < 1024 * 32; i += NTHR) rwl[(i >> 5) * 33 + (i & 31)] = router_w[(size_t)l * 32768 + i];
    if (F.tid < 32) hist[F.tid] = 0;
    __syncthreads();
    const float* g = gffn + l * 1024;
    for (int r = F.gw; r < nrows; r += F.ngw) {
        const int bidx = r < NLAT ? r / SEQ : 4;
        const float* sf = MOD + (size_t)(l * 5 + bidx) * 6144 + 3 * 1024; const float* cf = sf + 1024;
        float f[16]; float ss = 0.f;
#pragma unroll
        for (int j = 0; j < 16; ++j) { f[j] = XR[(size_t)r * 1024 + 64 * j + F.lane]; ss += f[j] * f[j]; }
        const float rstd = 1.0f / sqrtf(wave_sum(ss) * (1.0f / 1024.0f) + EPSN);
        float p[32];
#pragma unroll
        for (int e = 0; e < 32; ++e) p[e] = 0.f;
#pragma unroll
        for (int j = 0; j < 16; ++j) { const int c = 64 * j + F.lane; const float fv = f[j] * rstd * g[c] * (1.0f + cf[c]) + sf[c];
            Fb[(size_t)r * 1024 + c] = (bf16)f2bf(fv);
            const LAS float* wrow = rwl + c * 33;
#pragma unroll
            for (int e = 0; e < 32; ++e) p[e] += fv * wrow[e]; }
#pragma unroll
        for (int e = 0; e < 32; ++e) p[e] = wave_sum(p[e]) + router_b[l * 32 + e];
        unsigned taken = 0u; float tv[4]; int ti[4];
#pragma unroll
        for (int k = 0; k < 4; ++k) { float best = -INFINITY; int bi = 0;
#pragma unroll
            for (int e = 0; e < 32; ++e) { const bool ok = !((taken >> e) & 1u) && (p[e] > best); best = ok ? p[e] : best; bi = ok ? e : bi; }
            taken |= 1u << bi; tv[k] = best; ti[k] = bi; }
        const float e1 = __expf(tv[1] - tv[0]), e2 = __expf(tv[2] - tv[0]), e3 = __expf(tv[3] - tv[0]); const float inv = 1.0f / (1.0f + e1 + e2 + e3);
        if (F.lane == 0) {
            TOPI[r * 4 + 0] = ti[0]; TOPI[r * 4 + 1] = ti[1]; TOPI[r * 4 + 2] = ti[2]; TOPI[r * 4 + 3] = ti[3];
            GATE[r * 4 + 0] = inv; GATE[r * 4 + 1] = e1 * inv; GATE[r * 4 + 2] = e2 * inv; GATE[r * 4 + 3] = e3 * inv;
            lds_add(&hist[ti[0]], 1); lds_add(&hist[ti[1]], 1); lds_add(&hist[ti[2]], 1); lds_add(&hist[ti[3]], 1);
        }
    }
    __syncthreads();
    if (F.tid < 32) BLKCNT[blockIdx.x * 32 + F.tid] = hist[F.tid];
}

__device__ __forceinline__ void ph_route(const Frame& F, int nrows) {
    LAS int* cursor = (LAS int*)(F.lds);
    LAS int* tot = cursor + 32;
    LAS int* mine = cursor + 64;
    const int* BLKCNT = (const int*)(F.ws + WS_BLKCNT); const int* TOPI = (const int*)(F.ws + WS_TOPI); int* POS = (int*)(F.ws + WS_POS);
    const bf16* Fb = (const bf16*)(F.ws + WS_F); bf16* AS = (bf16*)(F.ws + WS_ASORT); int* TILEE = (int*)(F.ws + WS_TILEE);
    if (F.tid < 32) { int t = 0, m = 0; for (int b = 0; b < F.G; ++b) { const int v = BLKCNT[b * 32 + F.tid]; t += v; m += (b < (int)blockIdx.x) ? v : 0; } tot[F.tid] = t; mine[F.tid] = m; }
    __syncthreads();
    if (F.tid == 0) { int tb = 0;
        for (int e = 0; e < 32; ++e) { const int nt = (tot[e] + 255) >> 8; cursor[e] = tb * 256 + mine[e];
            if (blockIdx.x == 0) for (int j = 0; j < nt; ++j) TILEE[tb + j] = e;
            tb += nt; }
        if (blockIdx.x == 0) F.ctl[CW_NTILES] = (unsigned)tb; }
    __syncthreads();
    for (int r = F.gw; r < nrows; r += F.ngw) {
        int pos = 0;
        if (F.lane < 4) { const int e = TOPI[r * 4 + F.lane]; pos = lds_add(&cursor[e], 1); POS[r * 4 + F.lane] = pos; }
        const v4u a0 = ((const v4u*)(Fb + (size_t)r * 1024))[F.lane], a1 = ((const v4u*)(Fb + (size_t)r * 1024))[64 + F.lane];
#pragma unroll
        for (int k = 0; k < 4; ++k) { const int pk = __shfl(pos, k); v4u* dst = (v4u*)(AS + (size_t)pk * 1024); dst[F.lane] = a0; dst[64 + F.lane] = a1; }
    }
}

__device__ __forceinline__ void ph_combine(const Frame& F, int l, int nrows, float* out, const float* gmix) {
    float* XR = (float*)(F.ws + WS_XR); const float* MOD = (const float*)(F.ws + WS_MOD); const bf16* YS = (const bf16*)(F.ws + WS_YS); bf16* H = (bf16*)(F.ws + WS_H);
    const int* POS = (const int*)(F.ws + WS_POS); const float* GATE = (const float*)(F.ws + WS_GATE);
    for (int r = F.gw; r < nrows; r += F.ngw) {
        const int bidx = r < NLAT ? r / SEQ : 4;
        const float* gf = MOD + (size_t)(l * 5 + bidx) * 6144 + 5 * 1024;
        int pos = 0; float gt = 0.f;
        if (F.lane < 4) { pos = POS[r * 4 + F.lane]; gt = GATE[r * 4 + F.lane]; }
        f32x4 y[4];
#pragma unroll
        for (int j = 0; j < 4; ++j) y[j] = (f32x4){0.f, 0.f, 0.f, 0.f};
#pragma unroll
        for (int k = 0; k < 4; ++k) { const int pk = __shfl(pos, k); const float gk = __shfl(gt, k); const v2u* yr = (const v2u*)(YS + (size_t)pk * 1024);
#pragma unroll
            for (int j = 0; j < 4; ++j) { const v2u w = yr[64 * j + F.lane]; y[j].x += gk * bflo(w.x); y[j].y += gk * bfhi(w.x); y[j].z += gk * bflo(w.y); y[j].w += gk * bfhi(w.y); } }
        float* dst = (l == 0) ? XR + (size_t)r * 1024 : out + (size_t)r * 1024;
        float ss = 0.f;
#pragma unroll
        for (int j = 0; j < 4; ++j) { const int cb = 64 * j + F.lane; const f32x4 xv = ((const f32x4*)(XR + (size_t)r * 1024))[cb]; const f32x4 gv = ((const f32x4*)gf)[cb];
            y[j] = xv + gv * y[j]; ((f32x4*)dst)[cb] = y[j]; ss += (y[j].x * y[j].x + y[j].y * y[j].y) + (y[j].z * y[j].z + y[j].w * y[j].w); }
        if (l == 0) {
            const float rstd = 1.0f / sqrtf(wave_sum(ss) * (1.0f / 1024.0f) + EPSN);
            const float* shift = MOD + (size_t)(5 + bidx) * 6144; const float* scale = shift + 1024; const float* g = gmix + 1024;
#pragma unroll
            for (int j = 0; j < 4; ++j) { const int cb = 64 * j + F.lane; const f32x4 gg = ((const f32x4*)g)[cb], sc = ((const f32x4*)scale)[cb], sh = ((const f32x4*)shift)[cb];
                const f32x4 hv = y[j] * rstd * gg * (sc + 1.0f) + sh;
                v2u o; o.x = pk2(hv.x, hv.y); o.y = pk2(hv.z, hv.w); ((v2u*)(H + (size_t)r * 1024))[cb] = o; }
        }
    }
}

struct Args { const float* in[34]; float* out; unsigned char* ws; int ph_lo, ph_hi; };
enum { I_X = 0, I_C, I_CTX, I_CCTX, I_WMOD, I_BMOD, I_GMIX, I_GFFN, I_WIN, I_QG, I_KG, I_LCW, I_LCB, I_LGW, I_LGB, I_LLAM, I_HCW, I_HCB, I_HW1, I_HB1, I_HW2, I_HB2, I_HW3, I_HFREQ, I_HDEC, I_HBIAS,
       I_OUTG, I_WOUT, I_RW, I_RB, I_MW1, I_MB1, I_MW2, I_MB2 };

__global__ void __launch_bounds__(NTHR, 2) mk_fwd(Args args) {
    extern __shared__ __attribute__((aligned(16))) unsigned char lds[];
    Frame F;
    F.lds = (LAS unsigned char*)lds; F.ws = args.ws; F.ctl = (unsigned*)(args.ws + WS_CTL);
    F.tid = threadIdx.x; F.lane = F.tid & 63; F.wave = __builtin_amdgcn_readfirstlane(F.tid >> 6);
    F.G = gridDim.x; { const int bx = blockIdx.x; F.vcu = (F.G % 8 == 0) ? (bx % 8) * (F.G / 8) + bx / 8 : bx; }
    F.gw = (int)blockIdx.x * NWAVES + F.wave; F.ngw = F.G * NWAVES;
    for (int u = F.tid; u < (LDS_BYTES - LDSCTL_OFF) / 4; u += NTHR) ((LAS unsigned*)(F.lds + LDSCTL_OFF))[u] = 0u;
    __syncthreads();
#if !MK_PER_PHASE
    XcdBarrier bar = xcd_barrier_post(F.ctl + CW_BAR, (volatile LAS unsigned*)(F.lds + LDSCTL_OFF + 32));
#define GRID_BAR() xcd_barrier(bar)
#else
#define GRID_BAR() do { } while (0)
#endif
    const int lo = args.ph_lo, hi = args.ph_hi;
#ifndef ONLY_PHASE
#define ONLY_PHASE (-1)
#endif
#define ENABLED(id) (ONLY_PHASE < 0 || ONLY_PHASE == (id))
#define IN(k) (ENABLED(k) && lo <= (k) && (k) < hi)
#define INL(j) (ENABLED(NPH_PRO + (j)) && lo <= pb + (j) && pb + (j) < hi)
#define SEAML(j) do { if (lo <= pb + (j) && pb + (j) + 1 < hi) { GRID_BAR(); } } while (0)
typedef const __attribute__((address_space(4))) Args* KArgs;
#ifndef REP_MASK
#define REP_MASK 0
#endif
#define NREP(j) (((REP_MASK >> (j)) & 1) ? 2 : 1)
#define REFRAME() Frame Fp = F; KArgs ka = (KArgs)__builtin_amdgcn_kernarg_segment_ptr(); { int t_ = F.tid; asm volatile("" : "+v"(t_), "+s"(ka)); Fp.tid = t_; Fp.lane = t_ & 63; Fp.wave = __builtin_amdgcn_readfirstlane(t_ >> 6); \
    Fp.gw = (int)blockIdx.x * NWAVES + Fp.wave; Fp.ws = ka->ws; Fp.ctl = (unsigned*)(ka->ws + WS_CTL); }
#define SEAM(k) do { if (lo <= (k) && (k) + 1 < hi) { GRID_BAR(); } } while (0)

    if (IN(0)) ph_prologue_a(F, args.in[I_C], args.in[I_CCTX], args.in[I_WMOD], args.in[I_BMOD], args.in[I_WIN], args.in[I_WOUT], args.in[I_MW1], args.in[I_MW2],
                             args.in[I_HW1], args.in[I_HB1], args.in[I_HW2], args.in[I_HB2], args.in[I_HFREQ], args.in[I_LGW], args.in[I_LLAM]);
    SEAM(0);
    if (IN(1)) ph_prologue_b(F, args.in[I_HW3], args.in[I_HDEC]);
    SEAM(1);

#define PHASE(j, ...) if (INL(j)) { _Pragma("unroll") for (int rep_ = 0; rep_ < NREP(j); ++rep_) { { REFRAME(); __VA_ARGS__ } if (rep_ + 1 < NREP(j)) GRID_BAR(); } }
#define LAYER_BODY(l) { \
        const int pb = NPH_PRO + l * NPH_LAYER; \
        const int nrows = (l == 0) ? MT : NLAT; \
        if (l == 0) { PHASE(0, ph_norm_mod(Fp, l, ka->in[I_X], ka->in[I_CTX], ka->in[I_GMIX]);) SEAML(0); } \
        PHASE(1, \
            pg8::Gemm g{(const bf16*)(Fp.ws + WS_H), (const bf16*)(Fp.ws + WS_WINT) + (size_t)l * 2048 * 1024, MT, 2048, 1024}; \
            pg8::StaticOrder S; S.init(MT, 2048, Fp.G, (int)blockIdx.x); \
            pg8::EpiBf16<0> E{(bf16*)(Fp.ws + WS_U), 2048, nullptr, 0, 0, 1.f}; \
            pg8::gemm_phase<pg8::EpiBf16<0>, pg8::StaticOrder, PG8_ALIGN, PG8_SP2>(Fp.lds + RING_OFF, g, S, E);) \
        SEAML(1); \
        PHASE(2, ph_post_proj(Fp, l, ka->in[I_QG], ka->in[I_KG], ka->in[I_LCW], ka->in[I_LCB], ka->in[I_HCW], ka->in[I_HCB]);) \
        SEAML(2); \
        PHASE(3, \
            int kg_ = 256; asm volatile("" : "+s"(kg_)); \
            pg8::Gemm g{(const bf16*)(Fp.ws + WS_XL), (const bf16*)(Fp.ws + WS_WGT) + (size_t)l * 1024 * 256, MT, 1024, kg_}; \
            pg8::StaticOrder S; S.init(MT, 1024, Fp.G, (int)blockIdx.x); \
            pg8::EpiLruGate E{(const bf16*)(Fp.ws + WS_XL), (float*)(Fp.ws + WS_LAB), LAB_STRIDE, ka->in[I_LGB] + (size_t)l * 1024, (const float*)(Fp.ws + WS_SPT) + l * 512}; \
            pg8::gemm_phase<pg8::EpiLruGate, pg8::StaticOrder, PG8_ALIGN, PG8_SP2>(Fp.lds + RING_OFF, g, S, E);) \
        SEAML(3); \
        PHASE(4, \
            ph_scan1(Fp); __syncthreads(); \
            const attn_body::AttnTensors AT{(const attn_body::bf16*)(Fp.ws + WS_Q), (const attn_body::bf16*)(Fp.ws + WS_K), (const attn_body::bf16*)(Fp.ws + WS_V), (attn_body::bf16*)(Fp.ws + WS_ATT)}; \
            attn_body::attn_phase<8>((char*)lds + RING_OFF, AT, Fp.G, Fp.vcu, l == 0, (long)NLAT);) \
        SEAML(4); \
        PHASE(5, ph_scan2(Fp); __syncthreads(); ph_hyena_fft(Fp, l, ka->in[I_HBIAS]); if (l == 0) ph_hyena_ctx(Fp, ka->in[I_HBIAS], ka->in[I_HCW], ka->in[I_HCB]);) \
        SEAML(5); \
        PHASE(6, ph_merge(Fp, l, nrows, ka->in[I_OUTG]);) \
        SEAML(6); \
        if (INL(7)) { REFRAME(); \
            pg8::Gemm g{(const bf16*)(Fp.ws + WS_MIXA), (const bf16*)(Fp.ws + WS_WOUTT) + (size_t)l * 1024 * 1024, nrows, 1024, 1024}; \
            pg8::StaticOrder S; S.init(nrows, 1024, Fp.G, (int)blockIdx.x); \
            float* XR = (float*)(Fp.ws + WS_XR); \
            pg8::EpiResid E{(l == 0) ? ka->in[I_X] : (const float*)XR, (l == 0) ? ka->in[I_CTX] : (const float*)(XR + (size_t)NLAT * 1024), NLAT, XR, 1024, \
                            (const float*)(Fp.ws + WS_MOD) + (size_t)(l * 5) * 6144 + 2 * 1024, 6144, SEQ}; \
            pg8::gemm_phase<pg8::EpiResid, pg8::StaticOrder, PG8_ALIGN, PG8_SP2>(Fp.lds + RING_OFF, g, S, E); \
        } \
        SEAML(7); \
        PHASE(8, ph_ffn_router(Fp, l, nrows, ka->in[I_GFFN], ka->in[I_RW], ka->in[I_RB]);) \
        SEAML(8); \
        PHASE(9, ph_route(Fp, nrows);) \
        SEAML(9); \
        if (INL(10) || INL(11)) { REFRAME(); \
            LAS int* tab = (LAS int*)(Fp.lds + MOETAB_OFF); \
            const int ntiles = (int)__hip_atomic_load(Fp.ctl + CW_NTILES, __ATOMIC_RELAXED, __HIP_MEMORY_SCOPE_AGENT); \
            const int* TILEE = (const int*)(Fp.ws + WS_TILEE); \
            for (int i = Fp.tid; i < ntiles && i < SORT_TILES; i += NTHR) tab[i] = TILEE[i]; \
            __syncthreads(); \
            if (INL(10)) { _Pragma("unroll") for (int rep_ = 0; rep_ < NREP(10); ++rep_) { { \
                pg8::Gemm g{(const bf16*)(Fp.ws + WS_ASORT), (const bf16*)(Fp.ws + WS_W1T) + (size_t)l * 32 * 2048 * 1024, 0, 2048, 1024}; \
                pg8::MoeOrder S; S.init(tab, ntiles, 8, Fp.G, (int)blockIdx.x); \
                pg8::EpiSwiglu E{(bf16*)(Fp.ws + WS_ACT), 1024, ka->in[I_MB1] + (size_t)l * 32 * 2048, 2048}; \
                pg8::gemm_phase<pg8::EpiSwiglu, pg8::MoeOrder, PG8_ALIGN, PG8_SP2>(Fp.lds + RING_OFF, g, S, E); \
             } if (rep_ + 1 < NREP(10)) GRID_BAR(); } } \
            SEAML(10); \
            if (INL(11)) { _Pragma("unroll") for (int rep_ = 0; rep_ < NREP(11); ++rep_) { { \
                pg8::Gemm g{(const bf16*)(Fp.ws + WS_ACT), (const bf16*)(Fp.ws + WS_W2T) + (size_t)l * 32 * 1024 * 1024, 0, 1024, 1024}; \
                pg8::MoeOrder S; S.init(tab, ntiles, 4, Fp.G, (int)blockIdx.x); \
                pg8::EpiBf16Bias E{(bf16*)(Fp.ws + WS_YS), 1024, ka->in[I_MB2] + (size_t)l * 32 * 1024, 1024}; \
                pg8::gemm_phase<pg8::EpiBf16Bias, pg8::MoeOrder, PG8_ALIGN, PG8_SP2>(Fp.lds + RING_OFF, g, S, E); \
             } if (rep_ + 1 < NREP(11)) GRID_BAR(); } } \
        } \
        SEAML(11); \
        if (INL(12)) { REFRAME(); ph_combine(Fp, l, nrows, ka->out, ka->in[I_GMIX]); } \
        if (l == 0) { SEAML(12); } \
    }
    LAYER_BODY(0)
    LAYER_BODY(1)
#undef LAYER_BODY
#undef PHASE
#undef IN
#undef SEAM
#undef INL
#undef SEAML
}

extern "C" void kernel_launch(void* const* d_in, const int* in_sizes, int n_in, void* d_out, int out_size, void* d_ws, size_t ws_size, hipStream_t stream) {
    static int grid = 0;
    if (grid == 0) {
        if (n_in != 34 || in_sizes[0] != NLAT * DMODEL || out_size != NLAT * DMODEL || ws_size < WS_END) {
            fprintf(stderr, "kernel_launch: unexpected shapes (n_in %d, in0 %d, out %d, ws %zu); nothing launched\n", n_in, n_in > 0 ? in_sizes[0] : -1, out_size, ws_size); grid = -1; return; }
        int dev = 0, cus = 0;
        if (hipGetDevice(&dev) != hipSuccess || hipDeviceGetAttribute(&cus, hipDeviceAttributeMultiprocessorCount, dev) != hipSuccess) { grid = -1; return; }
        if (hipFuncSetAttribute((const void*)mk_fwd, hipFuncAttributeMaxDynamicSharedMemorySize, LDS_BYTES) != hipSuccess) { fprintf(stderr, "kernel_launch: hipFuncSetAttribute failed\n"); grid = -1; return; }
        int per_cu = 0;
        if (hipOccupancyMaxActiveBlocksPerMultiprocessor(&per_cu, (const void*)mk_fwd, NTHR, LDS_BYTES) != hipSuccess || per_cu < 1) { fprintf(stderr, "kernel_launch: occupancy query says %d\n", per_cu); }
        (void)hipGetLastError();
        grid = cus;
    }
    if (grid < 0) return;
    if (hipMemsetAsync((char*)d_ws + WS_CTL, 0, CTL_ZERO_BYTES, stream) != hipSuccess) return;
    Args a{};
    for (int i = 0; i < 34; ++i) a.in[i] = (const float*)d_in[i];
    a.out = (float*)d_out; a.ws = (unsigned char*)d_ws;
#if MK_PER_PHASE
    for (int p = 0; p < NPH; ++p) { a.ph_lo = p; a.ph_hi = p + 1; hipLaunchKernelGGL(mk_fwd, dim3(grid), dim3(NTHR), LDS_BYTES, stream, a); }
#else
    a.ph_lo = 0; a.ph_hi = NPH;
    hipLaunchKernelGGL(mk_fwd, dim3(grid), dim3(NTHR), LDS_BYTES, stream, a);
#endif
}
```

```cpp
#include <hip/hip_runtime.h>
#include <hip/hip_bf16.h>
#include <cstdio>
#include <cstdint>
#include <cmath>
#ifndef MK_PER_PHASE
#define MK_PER_PHASE 0
#endif
namespace pg8 {
#define PG8_LAS __attribute__((address_space(3)))
typedef unsigned short bf16_t;
typedef short bf16x8 __attribute__((ext_vector_type(8)));
typedef float f32x4 __attribute__((ext_vector_type(4)));
typedef unsigned u32x4 __attribute__((ext_vector_type(4)));
constexpr int BM = 256, BK = 64, HALF = 128, HTB = HALF * BK * 2  , STAGE_BYTES = 8 * HTB, NXCD = 8, WGM = 8;

__host__ __device__ __forceinline__ int lds_byte(int r, int c) { const int st = (r >> 4) * 2 + (c >> 5), rr = r & 15, cc = c & 31, ob = rr * 64 + cc * 2; return st * 1024 + (ob ^ (((ob >> 9) & 1) << 5)); }
__host__ __device__ __forceinline__ void stage_rc(int b, int& R, int& C) { const int st = b / 1024, sb = b % 1024, swz = sb ^ (((sb >> 9) & 1) << 5); R = (st >> 1) * 16 + swz / 64; C = (st & 1) * 32 + (swz % 64) / 2; }
__host__ __device__ __forceinline__ int perm32(int rho) { const int n = rho >> 4, i = rho & 15; return 8 * (i >> 2) + 4 * n + (i & 3); }

struct Unit { int pm, pn, be, e; };
struct Gemm { const bf16_t* A; const bf16_t* Bt; int M, N, K; };

struct StaticOrder {
    int nM, nN, nwg, G, c;
    __host__ __device__ void init(int M, int N, int G_, int c_) { nM = M / BM; nN = N / BM; nwg = nM * nN; G = G_; c = c_; }
    __host__ __device__ bool next(int i, Unit& u) const {
        const long L = (long)i * G + c; if (L >= nwg) return false;
        int wgid = (int)L; { const int q = nwg / NXCD, r = nwg % NXCD, xcd = wgid % NXCD, off = wgid / NXCD; wgid = (xcd < r ? xcd * (q + 1) : r * (q + 1) + (xcd - r) * q) + off; }
        const int nig = WGM * nN, gid = wgid / nig, fm = gid * WGM, gsz = (nM - fm) < WGM ? (nM - fm) : WGM;
        u.pm = fm + ((wgid % nig) % gsz); u.pn = (wgid % nig) / gsz; u.be = u.pn; u.e = 0; return true;
    }
    __device__ __forceinline__ void a_ready(const Unit&) const {}
    __device__ __forceinline__ void done(const Unit&) const {}
};

__device__ __forceinline__ unsigned cvt_pk_bf16(float lo, float hi) { unsigned r; asm volatile("v_cvt_pk_bf16_f32 %0, %1, %2" : "=v"(r) : "v"(lo), "v"(hi)); return r; }
typedef float f32x2 __attribute__((ext_vector_type(2)));
__device__ __forceinline__ f32x2 gelu_pk(f32x2 v) {
    const f32x2 av = __builtin_elementwise_abs(v), d = av * 0.2316418882f + 1.0f;
    f32x2 t; t.x = __builtin_amdgcn_rcpf(d.x); t.y = __builtin_amdgcn_rcpf(d.y);
    f32x2 q = t * 0.5307027145f + (-0.7265760135f); q = q * t + 0.7107068705f; q = q * t + (-0.142248368f); q = q * t + 0.127414796f; q = q * t;
    const f32x2 s = (v * v) * (-0.72134752044f);
    f32x2 e; e.x = __builtin_amdgcn_exp2f(s.x); e.y = __builtin_amdgcn_exp2f(s.y);
    const f32x2 m = v * (q * e), r = v - m;
    f32x2 o; o.x = v.x < 0.f ? m.x : r.x; o.y = v.y < 0.f ? m.y : r.y; return o;
}

template <int ACT  > struct EpiBf16 {
    static constexpr bool PERM = true, AFTER_DRAIN = false; static_assert(ACT == 0 || ACT == 1, "EpiBf16: ACT is 0 (none) or 1 (gelu_pk)");
    bf16_t* O; int ldc; const float* bias; int split_cols; size_t split_stride; float scale0;
    __device__ __forceinline__ void operator()(const f32x4 (&acc)[2][2][4][2], const Unit& u, int wr, int wc, int fr, int fq) const {
        const int row0 = u.pm * BM + wr * 64 + fr; int colt = u.pn * BM; bf16_t* base = O;
        float sc = 1.f; if (split_cols) { const int t = colt / split_cols; base += (size_t)t * split_stride; colt -= t * split_cols; if (t == 0) sc = scale0; }
        const int col0 = colt + wc * 32 + 8 * fq, bcol0 = u.pn * BM + wc * 32 + 8 * fq;
        f32x4 bv[2][2];
#pragma unroll
        for (int bj = 0; bj < 2; ++bj)
#pragma unroll
            for (int n = 0; n < 2; ++n) bv[bj][n] = bias ? *(const f32x4*)(bias + bcol0 + bj * HALF + 4 * n) : (f32x4){0.f, 0.f, 0.f, 0.f};
#pragma unroll
        for (int ai = 0; ai < 2; ++ai)
#pragma unroll
            for (int m = 0; m < 4; ++m) { bf16_t* rowp = base + (size_t)(row0 + ai * HALF + m * 16) * ldc + col0;
#pragma unroll
                for (int bj = 0; bj < 2; ++bj) { f32x4 v0 = acc[ai][bj][m][0] + bv[bj][0], v1 = acc[ai][bj][m][1] + bv[bj][1];
                    if (ACT == 1) { f32x2 a = gelu_pk((f32x2){v0[0], v0[1]}), b = gelu_pk((f32x2){v0[2], v0[3]}), c = gelu_pk((f32x2){v1[0], v1[1]}), d = gelu_pk((f32x2){v1[2], v1[3]});
                        v0 = (f32x4){a.x, a.y, b.x, b.y}; v1 = (f32x4){c.x, c.y, d.x, d.y}; }
                    v0 = v0 * sc; v1 = v1 * sc; u32x4 w; w.x = cvt_pk_bf16(v0[0], v0[1]); w.y = cvt_pk_bf16(v0[2], v0[3]); w.z = cvt_pk_bf16(v1[0], v1[1]); w.w = cvt_pk_bf16(v1[2], v1[3]);
                    *(u32x4*)(rowp + bj * HALF) = w; } }
    }
};


struct EpiResid {
    static constexpr bool PERM = false, AFTER_DRAIN = false;
    const float* xin_lat; const float* xin_ctx; int nlat; float* XR; int ldc; const float* mod; int mod_stride; int seq;
    __device__ __forceinline__ void operator()(const f32x4 (&acc)[2][2][4][2], const Unit& u, int wr, int wc, int fr, int fq) const {
        const int row0 = u.pm * BM + wr * 64 + fr, col0 = u.pn * BM + wc * 32 + 4 * fq;
        const int rowt = u.pm * BM; const int bidx = rowt < nlat ? rowt / seq : 4;
        const float* gate = mod + (size_t)bidx * mod_stride;
        const float* xin = rowt < nlat ? xin_lat : (xin_ctx - (size_t)nlat * ldc);
        f32x4 gv[2][2];
#pragma unroll
        for (int bj = 0; bj < 2; ++bj)
#pragma unroll
            for (int n = 0; n < 2; ++n) gv[bj][n] = *(const f32x4*)(gate + col0 + bj * HALF + n * 16);
#pragma unroll
        for (int ai = 0; ai < 2; ++ai)
#pragma unroll
            for (int m = 0; m < 4; ++m) { const size_t ro = (size_t)(row0 + ai * HALF + m * 16) * ldc + col0;
#pragma unroll
                for (int bj = 0; bj < 2; ++bj)
#pragma unroll
                    for (int n = 0; n < 2; ++n) { const f32x4 xv = *(const f32x4*)(xin + ro + bj * HALF + n * 16);
                        *(f32x4*)(XR + ro + bj * HALF + n * 16) = xv + gv[bj][n] * acc[ai][bj][m][n]; } }
    }
};
struct EpiSwiglu {
    static constexpr bool PERM = true, AFTER_DRAIN = false;
    bf16_t* O; int ldc; const float* bias; int bias_stride;
    __device__ __forceinline__ void operator()(const f32x4 (&acc)[2][2][4][2], const Unit& u, int wr, int wc, int fr, int fq) const {
        const int row0 = u.pm * BM + wr * 64 + fr; const int bcol0 = u.pn * BM + wc * 32 + 8 * fq; const int ocol0 = bcol0 >> 1;
        const float* bb = bias + (size_t)u.e * bias_stride;
        f32x4 bv[2][2];
#pragma unroll
        for (int bj = 0; bj < 2; ++bj)
#pragma unroll
            for (int n = 0; n < 2; ++n) bv[bj][n] = *(const f32x4*)(bb + bcol0 + bj * HALF + 4 * n);
#pragma unroll
        for (int ai = 0; ai < 2; ++ai)
#pragma unroll
            for (int m = 0; m < 4; ++m) { bf16_t* rowp = O + (size_t)(row0 + ai * HALF + m * 16) * ldc + ocol0;
#pragma unroll
                for (int bj = 0; bj < 2; ++bj) { const f32x4 v0 = acc[ai][bj][m][0] + bv[bj][0], v1 = acc[ai][bj][m][1] + bv[bj][1];
                    float o[4];
#pragma unroll
                    for (int p = 0; p < 4; ++p) { const float hg = p < 2 ? v0[2 * p] : v1[2 * p - 4], hl = p < 2 ? v0[2 * p + 1] : v1[2 * p - 3];
                        const float glu = fminf(hg, 7.0f), lin = fminf(fmaxf(hl, -7.0f), 7.0f);
                        const float sg = __builtin_amdgcn_rcpf(1.0f + __builtin_amdgcn_exp2f(-1.702f * 1.4426950408889634f * glu));
                        o[p] = glu * sg * (lin + 1.0f); }
                    typedef unsigned u32x2 __attribute__((ext_vector_type(2)));
                    u32x2 w; w.x = cvt_pk_bf16(o[0], o[1]); w.y = cvt_pk_bf16(o[2], o[3]);
                    *(u32x2*)(rowp + bj * (HALF / 2)) = w; } }
    }
};
struct EpiBf16Bias {
    static constexpr bool PERM = true, AFTER_DRAIN = false;
    bf16_t* O; int ldc; const float* bias; int bias_stride;
    __device__ __forceinline__ void operator()(const f32x4 (&acc)[2][2][4][2], const Unit& u, int wr, int wc, int fr, int fq) const {
        const int row0 = u.pm * BM + wr * 64 + fr; const int col0 = u.pn * BM + wc * 32 + 8 * fq;
        const float* bb = bias + (size_t)u.e * bias_stride;
        f32x4 bv[2][2];
#pragma unroll
        for (int bj = 0; bj < 2; ++bj)
#pragma unroll
            for (int n = 0; n < 2; ++n) bv[bj][n] = *(const f32x4*)(bb + col0 + bj * HALF + 4 * n);
#pragma unroll
        for (int ai = 0; ai < 2; ++ai)
#pragma unroll
            for (int m = 0; m < 4; ++m) { bf16_t* rowp = O + (size_t)(row0 + ai * HALF + m * 16) * ldc + col0;
#pragma unroll
                for (int bj = 0; bj < 2; ++bj) { const f32x4 v0 = acc[ai][bj][m][0] + bv[bj][0], v1 = acc[ai][bj][m][1] + bv[bj][1];
                    u32x4 w; w.x = cvt_pk_bf16(v0[0], v0[1]); w.y = cvt_pk_bf16(v0[2], v0[3]); w.z = cvt_pk_bf16(v1[0], v1[1]); w.w = cvt_pk_bf16(v1[2], v1[3]);
                    *(u32x4*)(rowp + bj * HALF) = w; } }
    }
};
struct EpiLruGate {
    static constexpr bool PERM = false, AFTER_DRAIN = false;
    const bf16_t* XL; bf16_t* LAB; size_t lab_stride; const float* gb; const float* spt;
    __device__ __forceinline__ void operator()(const f32x4 (&acc)[2][2][4][2], const Unit& u, int wr, int wc, int fr, int fq) const {
        const int d = u.pn >> 1, half = u.pn & 1;
        const int row0 = u.pm * BM + wr * 64 + fr, ch0 = half * 128 + wc * 32 + 4 * fq;
        bf16_t* LA = LAB + (size_t)(2 * d) * lab_stride; bf16_t* LB = LAB + (size_t)(2 * d + 1) * lab_stride;
#pragma unroll
        for (int n = 0; n < 2; ++n) {
            const f32x4 bR = *(const f32x4*)(gb + (d * 2 + 0) * 256 + ch0 + 16 * n), bI = *(const f32x4*)(gb + (d * 2 + 1) * 256 + ch0 + 16 * n);
            const f32x4 sp = *(const f32x4*)(spt + d * 256 + ch0 + 16 * n) * (-8.0f * 1.4426950408889634f);
#pragma unroll
            for (int ai = 0; ai < 2; ++ai)
#pragma unroll
                for (int m = 0; m < 4; ++m) { const size_t ro = (size_t)(row0 + ai * HALF + m * 16) * 256 + ch0 + 16 * n;
                    typedef unsigned u32x2 __attribute__((ext_vector_type(2)));
                    const u32x2 xw = *(const u32x2*)(XL + ro);
                    const float xl[4] = {__builtin_bit_cast(float, xw.x << 16), __builtin_bit_cast(float, xw.x & 0xffff0000u), __builtin_bit_cast(float, xw.y << 16), __builtin_bit_cast(float, xw.y & 0xffff0000u)};
                    const f32x4 gr = acc[ai][0][m][n] + bR, gi = acc[ai][1][m][n] + bI;
                    f32x4 av, bv;
#pragma unroll
                    for (int e = 0; e < 4; ++e) {
                        const float rg = __builtin_amdgcn_rcpf(1.0f + __builtin_amdgcn_exp2f(-1.4426950408889634f * gr[e])), ig = __builtin_amdgcn_rcpf(1.0f + __builtin_amdgcn_exp2f(-1.4426950408889634f * gi[e]));
                        const float la2 = rg * sp[e];
                        const float a2 = __builtin_amdgcn_exp2f(2.0f * la2);
                        av[e] = la2; bv[e] = __builtin_amdgcn_sqrtf(fmaxf(1.0f - a2, 0.f)) * (ig * xl[e]); }
                    u32x2 wa, wb; wa.x = cvt_pk_bf16(av[0], av[1]); wa.y = cvt_pk_bf16(av[2], av[3]); wb.x = cvt_pk_bf16(bv[0], bv[1]); wb.y = cvt_pk_bf16(bv[2], bv[3]);
                    *(u32x2*)(LA + ro) = wa; *(u32x2*)(LB + ro) = wb; }
        }
    }
};
struct MoeOrder {
    const PG8_LAS int* tab; int ntiles, nN, nper, j, m_lo, nMx;
    __device__ __forceinline__ void init(const PG8_LAS int* tab_, int ntiles_, int nN_, int G, int bx) {
        tab = tab_; ntiles = ntiles_; nN = nN_;
        if (G % 8 == 0) { const int x = bx % 8; nper = G / 8; j = bx / 8; m_lo = (x * ntiles) / 8; nMx = ((x + 1) * ntiles) / 8 - m_lo; }
        else { nper = G; j = bx; m_lo = 0; nMx = ntiles; }
    }
    __device__ __forceinline__ bool next(int i, Unit& u) const {
        const int s = i * nper + j; if (s >= nMx * nN) return false;
        const int nig = 8 * nN, gid = s / nig, fm = gid * 8, gsz = (nMx - fm) < 8 ? (nMx - fm) : 8, w = s - gid * nig;
        u.pm = m_lo + fm + (w % gsz); u.pn = w / gsz; u.e = tab[u.pm]; u.be = u.e * nN + u.pn; return true;
    }
    __device__ __forceinline__ void a_ready(const Unit&) const {}
    __device__ __forceinline__ void done(const Unit&) const {}
};
template <class Epi, class Sched, bool ALIGN_EPI = false, bool SP2 = false>
__device__ __forceinline__ void gemm_phase(PG8_LAS unsigned char* lds, const Gemm g, const Sched& S, const Epi& E) {
    int tid_ = threadIdx.x; asm volatile("" : "+v"(tid_));
    const int tid = tid_, wid = __builtin_amdgcn_readfirstlane(tid >> 6), lane = tid & 63, wr = wid >> 2, wc = wid & 3, fr = lane & 15, fq = lane >> 4;
    const int K = g.K, nt = K / BK;
    unsigned voffA[2], voffB[2];
#pragma unroll
    for (int i = 0; i < 2; ++i) { int R, C; stage_rc(tid * 16 + i * 8192, R, C); const int Rb = Epi::PERM ? ((R & ~31) + perm32(R & 31)) : R;
        voffA[i] = (unsigned)(R * K + C) * 2u; voffB[i] = (unsigned)(Rb * K + C) * 2u; }
    const size_t kstep = (size_t)(BK * 2);
    const size_t hstep = (size_t)HALF * K * 2;
    const size_t tstep = 2 * hstep;
    const unsigned ldsw = (unsigned)wid * 1024u;
    const int aoff = lds_byte(wr * 64 + fr, fq * 8), boff = lds_byte(wc * 32 + fr, fq * 8);
#define PG8_SA(b, h) (((b) * 2 + (h)) * HTB)
#define PG8_SB(b, h) ((4 + (b) * 2 + (h)) * HTB)
#define PG8_STAGE(bufoff, gbase, voff) do { _Pragma("unroll") for (int _i = 0; _i < 2; ++_i) \
        __builtin_amdgcn_global_load_lds((const unsigned*)((const char*)(gbase) + (voff)[_i]), (PG8_LAS unsigned*)(lds + (bufoff) + ldsw + _i * 8192), 16, 0, 0); } while (0)
#define PG8_LDA(dst, b, h) do { _Pragma("unroll") for (int m = 0; m < 4; ++m) _Pragma("unroll") for (int k = 0; k < 2; ++k) dst[m][k] = *(const PG8_LAS bf16x8*)(lds + PG8_SA(b, h) + aoff + m * 2048 + k * 1024); } while (0)
#define PG8_LDB(dst, b, h) do { _Pragma("unroll") for (int n = 0; n < 2; ++n) _Pragma("unroll") for (int k = 0; k < 2; ++k) dst[n][k] = *(const PG8_LAS bf16x8*)(lds + PG8_SB(b, h) + boff + n * 2048 + k * 1024); } while (0)
#define PG8_MMA(ai, bj, At, Bt) do { __builtin_amdgcn_s_setprio(1); _Pragma("unroll") for (int m = 0; m < 4; ++m) _Pragma("unroll") for (int n = 0; n < 2; ++n) _Pragma("unroll") for (int k = 0; k < 2; ++k) \
        acc[ai][bj][m][n] = __builtin_amdgcn_mfma_f32_16x16x32_bf16(Bt[n][k], At[m][k], acc[ai][bj][m][n], 0, 0, 0); __builtin_amdgcn_s_setprio(0); } while (0)
#define PG8_WAIT_V(n) asm volatile("s_waitcnt vmcnt(" #n ")" ::: "memory")
#define PG8_WAIT_L(n) asm volatile("s_waitcnt lgkmcnt(" #n ")" ::: "memory")
#define PG8_BAR __builtin_amdgcn_s_barrier()
#define PG8_SCHED __builtin_amdgcn_sched_barrier(0)
    Unit cur, nxt; int ui = 0;
    if (!S.next(0, cur)) return;
    f32x4 acc[2][2][4][2];
#pragma unroll
    for (int a = 0; a < 2; ++a)
#pragma unroll
        for (int b = 0; b < 2; ++b)
#pragma unroll
            for (int m = 0; m < 4; ++m)
#pragma unroll
                for (int n = 0; n < 2; ++n) acc[a][b][m][n] = (f32x4){0.f, 0.f, 0.f, 0.f};
    bf16x8 At[4][2], B0[2][2], B1[2][2];
    const char* cA = (const char*)g.A + (size_t)cur.pm * tstep; const char* cB = (const char*)g.Bt + (size_t)cur.be * tstep;
    S.a_ready(cur);
    if constexpr (SP2) {
        PG8_STAGE(PG8_SB(0, 0), cB, voffB); PG8_STAGE(PG8_SB(0, 1), cB + hstep, voffB); PG8_STAGE(PG8_SA(0, 0), cA, voffA); PG8_STAGE(PG8_SA(0, 1), cA + hstep, voffA);
        if (wr == 1) PG8_BAR;
        PG8_WAIT_V(2); PG8_BAR;
        PG8_STAGE(PG8_SB(1, 0), cB + kstep, voffB); PG8_STAGE(PG8_SA(1, 0), cA + kstep, voffA); PG8_STAGE(PG8_SB(1, 1), cB + hstep + kstep, voffB);
        PG8_WAIT_V(6); PG8_BAR;
    } else {
        PG8_STAGE(PG8_SB(0, 0), cB, voffB); PG8_STAGE(PG8_SA(0, 0), cA, voffA); PG8_STAGE(PG8_SB(0, 1), cB + hstep, voffB); PG8_STAGE(PG8_SA(0, 1), cA + hstep, voffA);
        if (wr == 1) PG8_BAR;
        PG8_WAIT_V(4); PG8_BAR;
        PG8_STAGE(PG8_SB(1, 0), cB + kstep, voffB); PG8_STAGE(PG8_SA(1, 0), cA + kstep, voffA); PG8_STAGE(PG8_SB(1, 1), cB + hstep + kstep, voffB);
        PG8_WAIT_V(6); PG8_BAR;
    }
    for (;;) {
        const bool has_next = S.next(ui + 1, nxt);
        const char* nA = has_next ? (const char*)g.A + (size_t)nxt.pm * tstep : cA; const char* nB = has_next ? (const char*)g.Bt + (size_t)nxt.be * tstep : cB;
        for (int t = 0; t < nt; t += 2) {
            const bool last = (t == nt - 2);
            const char* a1 = cA + (size_t)(t + 1) * kstep;
            const char* a2 = last ? nA : cA + (size_t)(t + 2) * kstep; const char* b2 = last ? nB : cB + (size_t)(t + 2) * kstep;
            const char* a3 = a2 + kstep; const char* b3 = b2 + kstep;
            if (last && has_next) S.a_ready(nxt);
            if constexpr (SP2) {
            PG8_LDB(B0, 0, 0); PG8_LDB(B1, 0, 1); PG8_SCHED; PG8_LDA(At, 0, 0); PG8_STAGE(PG8_SA(1, 1), a1 + hstep, voffA);
            PG8_WAIT_V(8); PG8_WAIT_L(0); PG8_BAR; PG8_MMA(0, 0, At, B0); PG8_MMA(0, 1, At, B1); PG8_BAR; PG8_SCHED;
            PG8_LDA(At, 0, 1); PG8_STAGE(PG8_SB(0, 0), b2, voffB); PG8_STAGE(PG8_SB(0, 1), b2 + hstep, voffB); PG8_STAGE(PG8_SA(0, 0), a2, voffA);
            PG8_WAIT_V(8); PG8_WAIT_L(0); PG8_BAR; PG8_MMA(1, 0, At, B0); PG8_MMA(1, 1, At, B1); PG8_BAR; PG8_SCHED;
            PG8_LDB(B0, 1, 0); PG8_LDB(B1, 1, 1); PG8_SCHED; PG8_LDA(At, 1, 0); PG8_STAGE(PG8_SA(0, 1), a2 + hstep, voffA);
            PG8_WAIT_V(8); PG8_WAIT_L(0); PG8_BAR; PG8_MMA(0, 0, At, B0); PG8_MMA(0, 1, At, B1); PG8_BAR; PG8_SCHED;
            PG8_LDA(At, 1, 1); PG8_STAGE(PG8_SB(1, 0), b3, voffB); PG8_STAGE(PG8_SB(1, 1), b3 + hstep, voffB); PG8_STAGE(PG8_SA(1, 0), a3, voffA);
            PG8_WAIT_V(8); PG8_WAIT_L(0); PG8_BAR; PG8_MMA(1, 0, At, B0); PG8_MMA(1, 1, At, B1); PG8_BAR; PG8_SCHED;
            } else {
            PG8_LDB(B0, 0, 0); PG8_SCHED; PG8_LDA(At, 0, 0); PG8_STAGE(PG8_SA(1, 1), a1 + hstep, voffA);
            PG8_WAIT_L(8); PG8_BAR; PG8_WAIT_L(0); PG8_MMA(0, 0, At, B0); PG8_BAR; PG8_SCHED;
            PG8_LDB(B1, 0, 1); PG8_STAGE(PG8_SB(0, 0), b2, voffB);
            PG8_BAR; PG8_WAIT_L(0); PG8_MMA(0, 1, At, B1); PG8_BAR;
            PG8_LDA(At, 0, 1); PG8_STAGE(PG8_SA(0, 0), a2, voffA);
            PG8_BAR; PG8_WAIT_L(0); PG8_MMA(1, 0, At, B0); PG8_BAR; PG8_SCHED;
            PG8_STAGE(PG8_SB(0, 1), b2 + hstep, voffB);
            PG8_WAIT_V(6); PG8_BAR; PG8_MMA(1, 1, At, B1); PG8_BAR;
            PG8_LDB(B0, 1, 0); PG8_SCHED; PG8_LDA(At, 1, 0); PG8_STAGE(PG8_SA(0, 1), a2 + hstep, voffA);
            PG8_WAIT_L(8); PG8_BAR; PG8_WAIT_L(0); PG8_MMA(0, 0, At, B0); PG8_BAR; PG8_SCHED;
            PG8_LDB(B1, 1, 1); PG8_STAGE(PG8_SB(1, 0), b3, voffB);
            PG8_BAR; PG8_WAIT_L(0); PG8_MMA(0, 1, At, B1); PG8_BAR;
            PG8_LDA(At, 1, 1); PG8_STAGE(PG8_SA(1, 0), a3, voffA);
            PG8_BAR; PG8_WAIT_L(0); PG8_MMA(1, 0, At, B0); PG8_BAR; PG8_SCHED;
            PG8_STAGE(PG8_SB(1, 1), b3 + hstep, voffB);
            PG8_WAIT_V(6); PG8_BAR; PG8_MMA(1, 1, At, B1); PG8_BAR;
            }
        }
        if constexpr (ALIGN_EPI) { if (wr == 0) PG8_BAR; }
        if constexpr (!Epi::AFTER_DRAIN) { E(acc, cur, wr, wc, fr, fq); S.done(cur); }
        if (!has_next) break;
#pragma unroll
        for (int a = 0; a < 2; ++a)
#pragma unroll
            for (int b = 0; b < 2; ++b)
#pragma unroll
                for (int m = 0; m < 4; ++m)
#pragma unroll
                    for (int n = 0; n < 2; ++n) acc[a][b][m][n] = (f32x4){0.f, 0.f, 0.f, 0.f};
        cur = nxt; cA = nA; cB = nB; ++ui;
        if constexpr (ALIGN_EPI) { if (wr == 1) PG8_BAR; }
    }
    PG8_WAIT_V(0);
    if constexpr (!ALIGN_EPI) { if (wr == 0) PG8_BAR; }
    PG8_BAR;
    if constexpr (Epi::AFTER_DRAIN) { E.fused(acc, cur, wr, wc, fr, fq, lds, wid, lane); S.done(cur); }
#undef PG8_SA
#undef PG8_SB
#undef PG8_STAGE
#undef PG8_LDA
#undef PG8_LDB
#undef PG8_MMA
#undef PG8_WAIT_V
#undef PG8_WAIT_L
#undef PG8_BAR
#undef PG8_SCHED
}
}

#ifndef PG8_SP2
#define PG8_SP2 true
#endif
#ifndef PG8_ALIGN
#define PG8_ALIGN true
#endif
#include <cmath>
namespace attn_body {
using bf16=__hip_bfloat16;
using bf16x8=__attribute__((ext_vector_type(8)))short;
using s16x4=__attribute__((ext_vector_type(4)))short;
using f32x16=__attribute__((ext_vector_type(16)))float;
using u32x4=__attribute__((ext_vector_type(4)))unsigned;
constexpr int NHEAD=8,SEQQ=8192,SEQK=8448,D=64,QP=512,KP=128;
constexpr int NW=8,QBLK=32,QB=QBLK*NW,KVBLK=64,NQB=SEQQ/QB;
constexpr int ATTN_UNIT_ROWS=QB;
__device__ __forceinline__ int crow(int r,int hi){return (r&3)+8*(r>>2)+4*hi;}
#define SBAR() __builtin_amdgcn_sched_barrier(0)
__device__ __forceinline__ void cmask(f32x16&p0,f32x16&p1,int jb,int qrel,int hi){
  const float NEG=-INFINITY; int kb=64*jb+4*hi;
  #pragma unroll
  for(int r=0;r<16;++r){int kv=kb+(r&3)+8*(r>>2); if(kv>qrel)p0[r]=NEG; if(kv+32>qrel)p1[r]=NEG;}
}

constexpr int NSLOT=3, SLOTB=8192;
constexpr int LDS_K=0, LDS_V=NSLOT*SLOTB, LDS_WS=2*NSLOT*SLOTB, LDS_OST=LDS_WS+NW*64*4, LDS_BYTES=LDS_OST+NW*4096;
constexpr float C2=0.125f*1.4426950408889634f;
__device__ __forceinline__ void glds16(const void*gsrc,unsigned lds_dst){unsigned keep;
  asm volatile("s_mov_b32 %0, m0\n\ts_mov_b32 m0, %2\n\ts_nop 0\n\tglobal_load_lds_dwordx4 %1, off\n\ts_mov_b32 m0, %0":"=&s"(keep):"v"(gsrc),"s"(lds_dst):"memory");}
__device__ __forceinline__ float max3f(float a,float b,float c){float r;asm("v_max3_f32 %0, %1, %2, %3":"=v"(r):"v"(a),"v"(b),"v"(c));return r;}
__device__ __forceinline__ float max2f(float a,float b){float r;asm("v_max_f32_e32 %0, %1, %2":"=v"(r):"v"(a),"v"(b));return r;}
__device__ __forceinline__ float fadd_s(float a,float b){float r;asm("v_add_f32_e32 %0, %1, %2":"=v"(r):"v"(a),"v"(b));return r;}
__device__ __forceinline__ float fsub_s(float a,float b){float r;asm("v_sub_f32_e32 %0, %1, %2":"=v"(r):"v"(a),"v"(b));return r;}
typedef float f32x2_t __attribute__((ext_vector_type(2))); typedef __bf16 bf16x2_t __attribute__((ext_vector_type(2)));
__device__ __forceinline__ unsigned cvtpk_s(float lo,float hi){f32x2_t v={lo,hi};bf16x2_t b=__builtin_convertvector(v,bf16x2_t);return __builtin_bit_cast(unsigned,b);}
#define WAIT_BAR(N) asm volatile("s_waitcnt vmcnt(" #N ") lgkmcnt(0)\n\ts_barrier":::"memory")

__device__ __forceinline__ void qkt(f32x16&p0,f32x16&p1,const char*Kslot,const bf16x8*qr,const f32x16&negm,int r32,int hi){
  const char*kb=Kslot+hi*1024+r32*16;
  #pragma unroll
  for(int d0=0;d0<4;++d0){
    const bf16x8 b0=*reinterpret_cast<const bf16x8*>(kb+d0*2048);
    const bf16x8 b1=*reinterpret_cast<const bf16x8*>(kb+d0*2048+512);
    if(d0==0){p0=__builtin_amdgcn_mfma_f32_32x32x16_bf16(b0,qr[0],negm,0,0,0);p1=__builtin_amdgcn_mfma_f32_32x32x16_bf16(b1,qr[0],negm,0,0,0);}
    else{p0=__builtin_amdgcn_mfma_f32_32x32x16_bf16(b0,qr[d0],p0,0,0,0);p1=__builtin_amdgcn_mfma_f32_32x32x16_bf16(b1,qr[d0],p1,0,0,0);}}
}
typedef __attribute__((address_space(3))) const char* lds_cptr;
typedef short v4i16_t __attribute__((ext_vector_type(4)));
__device__ __forceinline__ void kload8(bf16x8*kf,lds_cptr kp){
  kf[0]=*(const __attribute__((address_space(3))) bf16x8*)(kp);      kf[1]=*(const __attribute__((address_space(3))) bf16x8*)(kp+512);
  kf[2]=*(const __attribute__((address_space(3))) bf16x8*)(kp+2048); kf[3]=*(const __attribute__((address_space(3))) bf16x8*)(kp+2560);
  kf[4]=*(const __attribute__((address_space(3))) bf16x8*)(kp+4096); kf[5]=*(const __attribute__((address_space(3))) bf16x8*)(kp+4608);
  kf[6]=*(const __attribute__((address_space(3))) bf16x8*)(kp+6144); kf[7]=*(const __attribute__((address_space(3))) bf16x8*)(kp+6656);
}
__device__ __forceinline__ void kload2(bf16x8*kf,lds_cptr kp,int j){ kf[2*j]=*(const __attribute__((address_space(3))) bf16x8*)(kp+j*2048); kf[2*j+1]=*(const __attribute__((address_space(3))) bf16x8*)(kp+j*2048+512); }
__device__ __forceinline__ s16x4 vtr(lds_cptr p){ return __builtin_bit_cast(s16x4,__builtin_amdgcn_ds_read_tr16_b64_v4i16((__attribute__((address_space(3))) v4i16_t*)p)); }
__device__ __forceinline__ float rowmax(const f32x16&p0,const f32x16&p1){
  float a=max3f(p0[0],p0[1],p1[0]),b=max3f(p0[2],p0[3],p1[1]);a=max3f(a,p1[2],p1[3]);
  #pragma unroll
  for(int r=4;r<16;r+=4){a=max3f(a,p0[r],p0[r+1]);b=max3f(b,p0[r+2],p0[r+3]);a=max3f(a,p1[r],p1[r+1]);b=max3f(b,p1[r+2],p1[r+3]);}
  const float m=max2f(a,b);
  auto rr=__builtin_amdgcn_permlane32_swap(__float_as_uint(m),__float_as_uint(m),false,false);
  return max2f(__uint_as_float(rr[0]),__uint_as_float(rr[1]));
}
__device__ __forceinline__ void pv(f32x16*o,int vb,bf16x8 pa0,bf16x8 pa1,bf16x8 pa2,bf16x8 pa3){
  #pragma unroll
  for(int d0=0;d0<2;++d0){s16x4 lo[4],hi[4];
    #pragma unroll
    for(int ks=0;ks<4;++ks){
      asm volatile("ds_read_b64_tr_b16 %0,%1 offset:%c2":"=&v"(lo[ks]):"v"(vb),"i"(d0*4096+ks*1024):"memory");
      asm volatile("ds_read_b64_tr_b16 %0,%1 offset:%c2":"=&v"(hi[ks]):"v"(vb),"i"(d0*4096+ks*1024+512):"memory");}
    asm volatile("s_waitcnt lgkmcnt(0)":::"memory");SBAR();
    #define PK(k) (bf16x8){lo[k][0],lo[k][1],lo[k][2],lo[k][3],hi[k][0],hi[k][1],hi[k][2],hi[k][3]}
    o[d0]=__builtin_amdgcn_mfma_f32_32x32x16_bf16(pa0,PK(0),o[d0],0,0,0);
    o[d0]=__builtin_amdgcn_mfma_f32_32x32x16_bf16(pa1,PK(1),o[d0],0,0,0);
    o[d0]=__builtin_amdgcn_mfma_f32_32x32x16_bf16(pa2,PK(2),o[d0],0,0,0);
    o[d0]=__builtin_amdgcn_mfma_f32_32x32x16_bf16(pa3,PK(3),o[d0],0,0,0);
    #undef PK
  }
}

#ifndef ATTN_STORE16
#define ATTN_STORE16(p,v) (*(u32x4*)(p)=(v))
#endif
template<int THRL> __device__ __forceinline__ void attn_unit(int b,int h,long qrow0,int NTarg,const bf16*Q,const bf16*__restrict__ K,const bf16*__restrict__ V,bf16*O,char*shm){
  int tid_=threadIdx.x; asm volatile("":"+v"(tid_)); const int tid=tid_,lane=tid&63,r32=lane&31,hi=lane>>5; const int wid=__builtin_amdgcn_readfirstlane(tid>>6);
  const long krowbase=(long)b*SEQK; const int kvh=h>>2;
  const bf16*Qw=Q+(qrow0+wid*QBLK)*QP+h*D;
  const bf16*Kh=K+krowbase*KP+kvh*D,*Vh=V+krowbase*KP+kvh*D;
  const unsigned lds0=(unsigned)(uintptr_t)shm;
  float*wsf=(float*)(shm+LDS_WS)+wid*64;
  const bf16*ksrc=Kh+(long)lane*KP+wid*8;
  const bf16*vsrc=Vh+(long)(16*(wid&3)+(lane>>2))*KP+(wid>>2)*32+(lane&3)*8;
  const unsigned kdst=lds0+LDS_K+wid*1024, vdst=lds0+LDS_V+wid*1024;
  #define DMA_K(t,slot) glds16(ksrc+(long)(t)*KVBLK*KP,(unsigned)__builtin_amdgcn_readfirstlane(kdst+(slot)))
  #define DMA_V(t,slot) glds16(vsrc+(long)(t)*KVBLK*KP,(unsigned)__builtin_amdgcn_readfirstlane(vdst+(slot)))
  const int vb0=(int)(lds0+LDS_V)+((lane>>4)&1)*32+(lane&3)*8+(4*hi+((lane&15)>>2))*64;
  const char*Kbase=shm+LDS_K; bf16x8 kf[8];
  const lds_cptr shm3=(lds_cptr)shm; const lds_cptr kp0=shm3+LDS_K+hi*1024+r32*16; const lds_cptr vp0=shm3+LDS_V+((lane>>4)&1)*32+(lane&3)*8+(4*hi+((lane&15)>>2))*64;
  const int NT=NTarg;
  DMA_K(0,0);DMA_V(0,0);DMA_K(1,SLOTB);
  bf16x8 qr[4];
  #pragma unroll
  for(int d0=0;d0<4;++d0)qr[d0]=*reinterpret_cast<const bf16x8*>(&Qw[(long)r32*QP+d0*16+hi*8]);
  float mhat=0.f,l_reg=0.f;f32x16 o[2];o[0]=f32x16{};o[1]=f32x16{};f32x16 negm=f32x16{};asm volatile("":"+v"(negm));
  const int qrel=wid*QBLK+r32;
  #define CMASK(P0,P1,t) do{}while(0)
  bool resc=false;
  #define START(P0,P1) do{ const float rm=rowmax(P0,P1); resc=false; \
    { const float dl=rm; mhat=fadd_s(mhat,dl); \
      _Pragma("unroll") for(int r=0;r<16;++r){P0[r]=fsub_s(P0[r],dl);P1[r]=fsub_s(P1[r],dl);} \
      _Pragma("unroll") for(int r=0;r<16;++r)negm[r]=-mhat; asm volatile("":"+v"(negm)); } \
    _Pragma("unroll") for(int r=0;r<16;++r)P0[r]=__builtin_amdgcn_exp2f(P0[r]); }while(0)
  #define RESC() do{ if(resc){ asm volatile("s_waitcnt lgkmcnt(0)":::"memory"); \
      _Pragma("unroll") for(int d_=0;d_<2;++d_) _Pragma("unroll") for(int r=0;r<16;++r)o[d_][r]*=wsf[crow(r,hi)]; } }while(0)
  f32x16 pA0,pA1,pB0,pB1;
  int sl_prev=0,sl_cur=0,sl_next=SLOTB;
  #define ROT() do{sl_prev=sl_cur;sl_cur=sl_next;sl_next=(sl_next==(NSLOT-1)*SLOTB)?0:sl_next+SLOTB;}while(0)
  DMA_K(2,2*SLOTB);
  WAIT_BAR(3);
  qkt(pA0,pA1,Kbase,qr,negm,r32,hi);asm volatile("s_nop 15\n\ts_nop 7":"+v"(pA0),"+v"(pA1));CMASK(pA0,pA1,0);
  START(pA0,pA1);
  _Pragma("unroll") for(int r=0;r<16;++r)pA1[r]=__builtin_amdgcn_exp2f(pA1[r]);
  WAIT_BAR(0);
  DMA_K(3,0);DMA_V(1,SLOTB);
  ROT();
  kload8(kf,kp0+sl_cur);
  WAIT_BAR(2);
  s16x4 vlo[8],vhi[8]; u32x4 pw0,pw1,pw2,pw3;
  #define PKW(P,B) cvtpk_s(P[B],P[B+1])
  #define PAF(k) __builtin_bit_cast(bf16x8,pw##k)
  #define VFR(i) (bf16x8){vlo[i][0],vlo[i][1],vlo[i][2],vlo[i][3],vhi[i][0],vhi[i][1],vhi[i][2],vhi[i][3]}
  #define PIN(x) asm volatile("":"+v"(x))
  #define MX3(a,b,c) __builtin_fmaxf(__builtin_fmaxf((a),(b)),(c))
  #define GAPA(MF,A0,A1,A2,A3,W0,W1,PW) do{ MF; sacc+=A0; sacc+=A1; sacc+=A2; sacc+=A3; PIN(sacc); W0; W1; PIN(PW); SBAR(); }while(0)
  #define EX(v) __builtin_amdgcn_exp2f(v)
  #define GAPB(MF,X,B) do{ MF; X[B]=EX(X[B]); X[B+1]=EX(X[B+1]); X[B+2]=EX(X[B+2]); X[B+3]=EX(X[B+3]); PIN(X); SBAR(); }while(0)
  #define VRD(i) do{ vlo[i]=vtr(vp_+(((i)>>2)*4096+((i)&3)*1024)); vhi[i]=vtr(vp_+(((i)>>2)*4096+((i)&3)*1024+512)); }while(0)
  #define KRD(G,j) do{ if(G){ kload2(kf,kp0+sl_next,j); SBAR(); } }while(0)
  #define STEP(C0,C1,P0,P1,t,GK,GV,GL) do{ SBAR(); \
    const lds_cptr vp_=vp0+sl_prev; \
    VRD(0); SBAR(); float sacc=(P0[0]+P0[1]); \
    GAPA(C0=__builtin_amdgcn_mfma_f32_32x32x16_bf16(kf[0],qr[0],negm,0,0,0), P0[2],P0[3],P0[4],P0[5],     pw0[0]=PKW(P0,0), pw0[1]=PKW(P0,2), pw0); \
    VRD(4); SBAR(); GAPA(C1=__builtin_amdgcn_mfma_f32_32x32x16_bf16(kf[1],qr[0],negm,0,0,0), P0[6],P0[7],P0[8],P0[9],     pw0[2]=PKW(P0,4), pw0[3]=PKW(P0,6), pw0); \
    VRD(1); SBAR(); GAPA(C0=__builtin_amdgcn_mfma_f32_32x32x16_bf16(kf[2],qr[1],C0,0,0,0),   P0[10],P0[11],P0[12],P0[13], pw1[0]=PKW(P0,8), pw1[1]=PKW(P0,10), pw1); \
    VRD(5); SBAR(); GAPA(C1=__builtin_amdgcn_mfma_f32_32x32x16_bf16(kf[3],qr[1],C1,0,0,0),   P0[14],P0[15],P1[0],P1[1],   pw1[2]=PKW(P0,12),pw1[3]=PKW(P0,14), pw1); \
    VRD(2); SBAR(); GAPA(C0=__builtin_amdgcn_mfma_f32_32x32x16_bf16(kf[4],qr[2],C0,0,0,0),   P1[2],P1[3],P1[4],P1[5],     pw2[0]=PKW(P1,0), pw2[1]=PKW(P1,2), pw2); \
    VRD(6); SBAR(); GAPA(C1=__builtin_amdgcn_mfma_f32_32x32x16_bf16(kf[5],qr[2],C1,0,0,0),   P1[6],P1[7],P1[8],P1[9],     pw2[2]=PKW(P1,4), pw2[3]=PKW(P1,6), pw2); \
    VRD(3); SBAR(); GAPA(C0=__builtin_amdgcn_mfma_f32_32x32x16_bf16(kf[6],qr[3],C0,0,0,0),   P1[10],P1[11],P1[12],P1[13], pw3[0]=PKW(P1,8), pw3[1]=PKW(P1,10), pw3); \
    VRD(7); SBAR(); GAPA(C1=__builtin_amdgcn_mfma_f32_32x32x16_bf16(kf[7],qr[3],C1,0,0,0),   P1[14],P1[15],0.f,0.f,       pw3[2]=PKW(P1,12),pw3[3]=PKW(P1,14), pw3); \
    l_reg+=sacc; \
    if(GK){DMA_K((t)+3,sl_cur);} if(GV){DMA_V((t)+1,sl_next);} \
    CMASK(C0,C1,t); \
    { float a=MX3(C0[0],C0[1],C1[0]),b=MX3(C0[2],C0[3],C1[1]); a=MX3(a,C1[2],C1[3]); \
      _Pragma("unroll") for(int r=4;r<16;r+=4){a=MX3(a,C0[r],C0[r+1]);b=MX3(b,C0[r+2],C0[r+3]);a=MX3(a,C1[r],C1[r+1]);b=MX3(b,C1[r+2],C1[r+3]);} \
      float rm=__builtin_fmaxf(a,b); { auto rr=__builtin_amdgcn_permlane32_swap(__float_as_uint(rm),__float_as_uint(rm),false,false); rm=__builtin_fmaxf(__uint_as_float(rr[0]),__uint_as_float(rr[1])); } \
      resc=false; \
      if(__builtin_expect(__any(rm>(float)THRL),0)){ const float dl=__builtin_fmaxf(rm,0.f); mhat+=dl; \
        _Pragma("unroll") for(int r=0;r<16;++r){C0[r]-=dl;C1[r]-=dl;} \
        _Pragma("unroll") for(int r=0;r<16;++r)negm[r]=-mhat; asm volatile("":"+v"(negm)); \
        const float f=__builtin_amdgcn_exp2f(-dl); l_reg*=f; if(hi==0)wsf[r32]=f; resc=true; } } \
    SBAR(); \
    GAPB(o[0]=__builtin_amdgcn_mfma_f32_32x32x16_bf16(PAF(0),VFR(0),o[0],0,0,0), C0,0); \
    GAPB(o[1]=__builtin_amdgcn_mfma_f32_32x32x16_bf16(PAF(0),VFR(4),o[1],0,0,0), C0,4); \
    KRD(GL,0); GAPB(o[0]=__builtin_amdgcn_mfma_f32_32x32x16_bf16(PAF(1),VFR(1),o[0],0,0,0), C0,8); \
    KRD(GL,1); GAPB(o[1]=__builtin_amdgcn_mfma_f32_32x32x16_bf16(PAF(1),VFR(5),o[1],0,0,0), C0,12); \
    KRD(GL,2); GAPB(o[0]=__builtin_amdgcn_mfma_f32_32x32x16_bf16(PAF(2),VFR(2),o[0],0,0,0), C1,0); \
    KRD(GL,3); GAPB(o[1]=__builtin_amdgcn_mfma_f32_32x32x16_bf16(PAF(2),VFR(6),o[1],0,0,0), C1,4); \
    GAPB(o[0]=__builtin_amdgcn_mfma_f32_32x32x16_bf16(PAF(3),VFR(3),o[0],0,0,0), C1,8); \
    GAPB(o[1]=__builtin_amdgcn_mfma_f32_32x32x16_bf16(PAF(3),VFR(7),o[1],0,0,0), C1,12); \
    }while(0)
  int t=1;
  #undef CMASK
  #define CMASK(P0,P1,t) do{}while(0)
  for(;t+5<NT;t+=2){
    STEP(pB0,pB1,pA0,pA1,t,true,true,true);     WAIT_BAR(2); RESC(); ROT();
    STEP(pA0,pA1,pB0,pB1,t+1,true,true,true);   WAIT_BAR(2); RESC(); ROT();
  }
  #undef CMASK
  #define CMASK(P0,P1,t) do{}while(0)
  #define ENDW(tt) do{ if((tt)+3<NT){WAIT_BAR(2);} else if((tt)+2<NT){WAIT_BAR(1);} else {WAIT_BAR(0);} }while(0)
  for(;t+1<NT;t+=2){
    STEP(pB0,pB1,pA0,pA1,t,(t+3<NT),(t+1<NT),(t+1<NT));       ENDW(t);   RESC(); ROT();
    STEP(pA0,pA1,pB0,pB1,t+1,(t+4<NT),(t+2<NT),(t+2<NT));     ENDW(t+1); RESC(); ROT();
  }
  STEP(pB0,pB1,pA0,pA1,NT-1,false,false,false); RESC();
  { float sacc=pB0[0]+pB0[1]; _Pragma("unroll") for(int r=2;r<16;++r)sacc+=pB0[r]; _Pragma("unroll") for(int r=0;r<16;++r)sacc+=pB1[r]; l_reg+=sacc;
    pw0=(u32x4){PKW(pB0,0),PKW(pB0,2),PKW(pB0,4),PKW(pB0,6)};pw1=(u32x4){PKW(pB0,8),PKW(pB0,10),PKW(pB0,12),PKW(pB0,14)};pw2=(u32x4){PKW(pB1,0),PKW(pB1,2),PKW(pB1,4),PKW(pB1,6)};pw3=(u32x4){PKW(pB1,8),PKW(pB1,10),PKW(pB1,12),PKW(pB1,14)};
    SBAR(); pv(o,vb0+sl_cur,PAF(0),PAF(1),PAF(2),PAF(3)); }
  #undef PKW
  #undef PAF
  #undef VFR
  #undef PIN
  #undef MX3
  #undef GAPA
  #undef GAPB
  #undef EX
  #undef VRD
  #undef KRD
  #undef STEP
  #undef ENDW
  {auto rr=__builtin_amdgcn_permlane32_swap(__float_as_uint(l_reg),__float_as_uint(l_reg),false,false);l_reg=__uint_as_float(rr[0])+__uint_as_float(rr[1]);}
  if(hi==0)wsf[32+r32]=l_reg;asm volatile("s_waitcnt lgkmcnt(0)":::"memory");
  float rli[16];
  #pragma unroll
  for(int r=0;r<16;++r)rli[r]=__builtin_amdgcn_rcpf(wsf[32+crow(r,hi)]);
  bf16*Ow=O+(qrow0+wid*QBLK)*QP+h*D;
  { bf16*stg=(bf16*)(shm+LDS_OST)+wid*2048;
    #pragma unroll
    for(int r=0;r<16;++r){const int orow=crow(r,hi);
      #pragma unroll
      for(int d0=0;d0<2;++d0)stg[orow*64+d0*32+r32]=__float2bfloat16(o[d0][r]*rli[r]);}
    asm volatile("s_waitcnt lgkmcnt(0)":::"memory");
    #pragma unroll
    for(int i=0;i<4;++i){const int row=i*8+(lane>>3),ch=lane&7; const u32x4 v=*(const u32x4*)(stg+row*64+ch*8); ATTN_STORE16(Ow+(long)row*QP+ch*8,v);} }
  asm volatile("s_waitcnt lgkmcnt(0)\n\ts_barrier":::"memory");
  #undef DMA_K
  #undef DMA_V
  #undef CMASK
  #undef START
  #undef RESC
  #undef ROT
}
constexpr int ATTN_LDS_BYTES=LDS_BYTES;
struct AttnTensors { const bf16* Q; const bf16* K; const bf16* V; bf16* O; };
template<int THRL=8> __device__ __forceinline__ void attn_phase(char*lds,const AttnTensors&T,int G,int vcu,bool with_ctx,long ctx_row0){
  const int total=4*NHEAD*NQB;
  for(int i=0;;++i){
    int x,n;
    if(G==256){ if(i>=4)break; x=vcu>>5; n=i*32+(vcu&31); }
    else { const int u=i*G+vcu; if(u>=total)break; x=u>>7; n=u&127; }
    const int b=x>>1,kvh=x&1,h=kvh*4+(n>>5),qb=n&31;
    attn_unit<THRL>(b,h,(long)b*SEQQ+(long)qb*QB,SEQK/KVBLK,T.Q,T.K,T.V,T.O,lds);
  }
  if(with_ctx){
    for(int u=vcu;u<4*NHEAD;u+=G){ const int b=u>>3,h=u&7; attn_unit<THRL>(b,h,ctx_row0+(long)b*256,4,T.Q,T.K,T.V,T.O,lds); }
  }
}
#undef SBAR
#undef WAIT_BAR
}

constexpr int NWAVES = 8, NTHR = 512;
constexpr int DMODEL = 1024, NB = 4, SEQ = 8192, CTXL = 256, NLAT = NB * SEQ, NCTX = NB * CTXL, MT = NLAT + NCTX;
constexpr int INW = 2048, NE = 32, KEYS = SEQ + CTXL;
constexpr int SORT_TILES = 560, SORT_ROWS = SORT_TILES * 256;
constexpr float EPSN = 1e-6f;
constexpr int NCHUNK = 66, CHUNK = 128;
constexpr int NPH_PRO = 2, NPH_LAYER = 13, NPH = NPH_PRO + 2 * NPH_LAYER;

constexpr size_t MiB = 1u << 20;
constexpr size_t WS_CTL = 0, CTL_ZERO_BYTES = 1 * MiB;
constexpr size_t WS_MOD = 1 * MiB, WS_ROPEC = 2 * MiB, WS_ROPES = 3 * MiB, WS_H2 = 4 * MiB, WS_KFC = 10 * MiB, WS_BLKCNT = 12 * MiB, WS_TILEE = 13 * MiB, WS_SCANS = 14 * MiB;
constexpr size_t WS_WINT = 16 * MiB, WS_WOUTT = 24 * MiB, WS_W1T = 32 * MiB, WS_W2T = 288 * MiB, WS_KF = 416 * MiB, WS_KHAT = 448 * MiB, WS_XR = 512 * MiB, WS_H = 644 * MiB;
constexpr size_t WS_U = 712 * MiB, WS_Q = 844 * MiB, WS_K = 877 * MiB, WS_V = 886 * MiB, WS_ATT = 895 * MiB, WS_LAB = 928 * MiB, WS_LRUO = 1060 * MiB, WS_VT = 1093 * MiB, WS_X0T = 1125 * MiB,
                 WS_HYO = 1157 * MiB, WS_MIXA = 1190 * MiB;
constexpr size_t WS_WGT = 11 * MiB, WS_SPT = 10 * MiB + 768 * 1024, WS_XL = 1256 * MiB;
constexpr size_t WS_GC = 10 * MiB + 896 * 1024;
constexpr size_t WS_CB = 10 * MiB + 960 * 1024;
constexpr size_t WS_F = 712 * MiB, WS_ASORT = 778 * MiB, WS_ACT = 1058 * MiB, WS_YS = 1338 * MiB, WS_TOPI = 1618 * MiB, WS_GATE = 1619 * MiB, WS_POS = 1620 * MiB, WS_END = 1622 * MiB;
constexpr size_t LAB_STRIDE = (size_t)MT * 256;
constexpr int CW_BAR = 4096;
constexpr int CW_NTILES = 64;

constexpr int RING_OFF = 0, RING_BYTES = 131072, MOETAB_OFF = 131072, LDSCTL_OFF = 155648, LDS_BYTES = 156160;

#define GAS __attribute__((address_space(1)))
#define LAS __attribute__((address_space(3)))
typedef unsigned short bf16;
typedef unsigned v4u __attribute__((ext_vector_type(4)));
typedef unsigned v2u __attribute__((ext_vector_type(2)));
typedef float f32x4 __attribute__((ext_vector_type(4)));
#define LDS_WAIT() asm volatile("s_waitcnt lgkmcnt(0)" ::: "memory")
#define VM_WAIT() asm volatile("s_waitcnt vmcnt(0)" ::: "memory")
__device__ __forceinline__ unsigned f2bf(float f) { unsigned u = __builtin_bit_cast(unsigned, f); return (u + 0x7fffu + ((u >> 16) & 1u)) >> 16; }
__device__ __forceinline__ unsigned pk2(float lo, float hi) { return f2bf(lo) | (f2bf(hi) << 16); }
__device__ __forceinline__ float bf2f(unsigned short b) { return __builtin_bit_cast(float, (unsigned)b << 16); }
__device__ __forceinline__ float bflo(unsigned w) { return __builtin_bit_cast(float, w << 16); }
__device__ __forceinline__ float bfhi(unsigned w) { return __builtin_bit_cast(float, w & 0xffff0000u); }
__device__ __forceinline__ float wave_sum(float v) {
#pragma unroll
    for (int o = 1; o < 64; o <<= 1) v += __shfl_xor(v, o);
    return v;
}
__device__ __forceinline__ float sigmoidf_(float x) { return 1.0f / (1.0f + __expf(-x)); }
__device__ __forceinline__ void sincos_d(double x, double& s, double& c) {
    const double kd = __builtin_rint(x * 0.63661977236758134308);
    const int k = (int)kd;
    double r = __builtin_fma(-kd, 1.57079632673412561417e+00, x);
    r = __builtin_fma(-kd, 6.07710050650619224932e-11, r);
    const double z = r * r;
    const double ps = r + r * z * (-1.66666666666666324348e-01 + z * (8.33333333332248946124e-03 + z * (-1.98412698298579493134e-04 + z * (2.75573137070700676789e-06 + z * (-2.50507602534068634195e-08 + z * 1.58969099521155010221e-10)))));
    const double pc = 1.0 - 0.5 * z + z * z * (4.16666666666666019037e-02 + z * (-1.38888888888741095749e-03 + z * (2.48015872894767294178e-05 + z * (-2.75573143513906633035e-07 + z * (2.08757232129817482790e-09 + z * -1.13596475577881948265e-11)))));
    const int q = k & 3;
    s = (q == 0) ? ps : (q == 1) ? pc : (q == 2) ? -ps : -pc;
    c = (q == 0) ? pc : (q == 1) ? -ps : (q == 2) ? -pc : ps;
}
__device__ __forceinline__ float gelu_tanh(float x) {
    const float u = 0.7978845608028654f * (x + 0.044715f * x * x * x);
    const float t = 1.0f - 2.0f / (1.0f + __expf(2.0f * u));
    return 0.5f * x * (1.0f + t);
}
__device__ __forceinline__ int lds_add(LAS int* p, int v) { return __hip_atomic_fetch_add(p, v, __ATOMIC_RELAXED, __HIP_MEMORY_SCOPE_WORKGROUP); }

#define FFT_FN __device__ __forceinline__
typedef float f32x2v __attribute__((ext_vector_type(2)));
#define FFT_VEC2 f32x2v
#define FFT_DPTR LAS f32x2v*
#define FFT_LD(D, i) c32_from((D)[i])
#define FFT_ST(D, i, v) ((D)[i] = c32_to(v))
struct __attribute__((aligned(8))) c32 { float x, y; };
FFT_FN c32 cmul(c32 a, c32 b) { c32 r; r.x = a.x * b.x - a.y * b.y; r.y = a.x * b.y + a.y * b.x; return r; }
FFT_FN c32 cadd(c32 a, c32 b) { c32 r; r.x = a.x + b.x; r.y = a.y + b.y; return r; }
FFT_FN c32 csub(c32 a, c32 b) { c32 r; r.x = a.x - b.x; r.y = a.y - b.y; return r; }
FFT_FN c32 cmuli_neg(c32 a) { c32 r; r.x = a.y; r.y = -a.x; return r; }
FFT_FN int fpad(int a) { return a + (a >> 4); }
#ifdef FFT_VEC2
FFT_FN c32 c32_from(FFT_VEC2 t) { c32 r; r.x = t.x; r.y = t.y; return r; }
FFT_FN FFT_VEC2 c32_to(c32 a) { FFT_VEC2 t; t.x = a.x; t.y = a.y; return t; }
#endif
FFT_FN void dft4(c32& a0, c32& a1, c32& a2, c32& a3) {
    const c32 s02 = cadd(a0, a2), d02 = csub(a0, a2), s13 = cadd(a1, a3), d13 = cmuli_neg(csub(a1, a3));
    a0 = cadd(s02, s13); a2 = csub(s02, s13); a1 = cadd(d02, d13); a3 = csub(d02, d13);
}
FFT_FN void dft16(c32 (&v)[16]) {
    const float C1 = 0.92387953251128674f, S1 = 0.38268343236508977f, C2 = 0.70710678118654752f;
#pragma unroll
    for (int q2 = 0; q2 < 4; ++q2) dft4(v[q2], v[4 + q2], v[8 + q2], v[12 + q2]);
    { c32 w;
      w.x = C1; w.y = -S1; v[4 * 1 + 1] = cmul(v[4 * 1 + 1], w);
      w.x = C2; w.y = -C2; v[4 * 2 + 1] = cmul(v[4 * 2 + 1], w);
      w.x = S1; w.y = -C1; v[4 * 3 + 1] = cmul(v[4 * 3 + 1], w);
      w.x = C2; w.y = -C2; v[4 * 1 + 2] = cmul(v[4 * 1 + 2], w);
      v[4 * 2 + 2] = cmuli_neg(v[4 * 2 + 2]);
      w.x = -C2; w.y = -C2; v[4 * 3 + 2] = cmul(v[4 * 3 + 2], w);
      w.x = S1; w.y = -C1; v[4 * 1 + 3] = cmul(v[4 * 1 + 3], w);
      w.x = -C2; w.y = -C2; v[4 * 2 + 3] = cmul(v[4 * 2 + 3], w);
      w.x = -C1; w.y = S1; v[4 * 3 + 3] = cmul(v[4 * 3 + 3], w); }
#pragma unroll
    for (int p1 = 0; p1 < 4; ++p1) dft4(v[4 * p1 + 0], v[4 * p1 + 1], v[4 * p1 + 2], v[4 * p1 + 3]);
#pragma unroll
    for (int a = 0; a < 4; ++a)
#pragma unroll
        for (int b = a + 1; b < 4; ++b) { const c32 t = v[4 * a + b]; v[4 * a + b] = v[4 * b + a]; v[4 * b + a] = t; }
}
FFT_FN c32 twid(int j, int n) { float rev = (float)j / (float)n; asm volatile("" : "+v"(rev)); c32 w; w.x = __builtin_amdgcn_cosf(rev); w.y = -__builtin_amdgcn_sinf(rev); return w; }

FFT_FN void fft_fwd16(FFT_DPTR D, int g, int n) {
    const int s = n >> 4, blk = g / s, j = g - blk * s, base = blk * n + j;
    c32 v[16];
#pragma unroll
    for (int q = 0; q < 16; ++q) v[q] = FFT_LD(D, fpad(base + q * s));
    dft16(v);
    const c32 w = twid(j, n); c32 wp = w;
#pragma unroll
    for (int p = 1; p < 16; ++p) { v[p] = cmul(v[p], wp); wp = cmul(wp, w); }
#pragma unroll
    for (int p = 0; p < 16; ++p) FFT_ST(D, fpad(base + p * s), v[p]);
}
FFT_FN void fft_inv16(FFT_DPTR D, int g, int n) {
    const int s = n >> 4, blk = g / s, j = g - blk * s, base = blk * n + j;
    c32 v[16];
#pragma unroll
    for (int q = 0; q < 16; ++q) v[q] = FFT_LD(D, fpad(base + q * s));
    const c32 w = twid(j, n); c32 wp = w;
#pragma unroll
    for (int p = 1; p < 16; ++p) { v[p] = cmul(v[p], wp); wp = cmul(wp, w); }
    dft16(v);
#pragma unroll
    for (int p = 0; p < 16; ++p) FFT_ST(D, fpad(base + p * s), v[p]);
}
FFT_FN void fft_mid16(FFT_DPTR D, int g, const c32* KH) {
    c32 v[16];
#pragma unroll
    for (int q = 0; q < 16; ++q) v[q] = FFT_LD(D, 17 * g + q);
    dft16(v);
#pragma unroll
    for (int p = 0; p < 16; ++p) { const c32 k = KH[16 * g + p]; const c32 t = cmul(v[p], k); v[p].x = t.x; v[p].y = -t.y; }
    dft16(v);
#pragma unroll
    for (int p = 0; p < 16; ++p) FFT_ST(D, 17 * g + p, v[p]);
}
FFT_FN void fft_last16_out(FFT_DPTR D, int g, c32* OUT, float scale) {
    c32 v[16];
#pragma unroll
    for (int q = 0; q < 16; ++q) v[q] = FFT_LD(D, 17 * g + q);
    dft16(v);
#pragma unroll
    for (int p = 0; p < 16; ++p) { c32 t; t.x = v[p].x * scale; t.y = v[p].y * scale; OUT[16 * g + p] = t; }
}
FFT_FN void fft_first4(FFT_DPTR D, int j, c32 x0, c32 x1, c32 x2, c32 x3) {
    dft4(x0, x1, x2, x3);
    const c32 w = twid(j, 16384), w2 = cmul(w, w), w3 = cmul(w2, w);
    FFT_ST(D, fpad(j), x0); FFT_ST(D, fpad(j + 4096), cmul(x1, w)); FFT_ST(D, fpad(j + 8192), cmul(x2, w2)); FFT_ST(D, fpad(j + 12288), cmul(x3, w3));
}
FFT_FN void fft_final4(FFT_DPTR D, int j, c32& u0, c32& u1) {
    const c32 w = twid(j, 16384), w2 = cmul(w, w), w3 = cmul(w2, w);
    c32 a0 = FFT_LD(D, fpad(j)), a1 = cmul(FFT_LD(D, fpad(j + 4096)), w), a2 = cmul(FFT_LD(D, fpad(j + 8192)), w2), a3 = cmul(FFT_LD(D, fpad(j + 12288)), w3);
    dft4(a0, a1, a2, a3);
    u0 = a0; u1 = a1;
}
FFT_FN void fft_first4_inplace(FFT_DPTR D, int j) {
    c32 x0 = FFT_LD(D, fpad(j)), x1 = FFT_LD(D, fpad(j + 4096)), x2 = FFT_LD(D, fpad(j + 8192)), x3 = FFT_LD(D, fpad(j + 12288));
    fft_first4(D, j, x0, x1, x2, x3);
}
#define XB_TMO      128
#define XB_XCNT(j)  (256  + 64 * (j))
#define XB_XSUB(j)  (1280 + 64 * (j))
#define XB_XGEN(j)  (2304 + 64 * (j))
#define XB_TOP      3328
#define XB_TOPGEN   3392
#define XCD_BAR_WORDS 3456
#define XB_SPIN_CAP (1u << 22)

__device__ __forceinline__ unsigned xb_ld(unsigned* p)              { return __hip_atomic_load(p, __ATOMIC_RELAXED, __HIP_MEMORY_SCOPE_AGENT); }
__device__ __forceinline__ unsigned xb_add(unsigned* p, unsigned v) { return __hip_atomic_fetch_add(p, v, __ATOMIC_RELAXED, __HIP_MEMORY_SCOPE_AGENT); }
__device__ __forceinline__ unsigned xb_xcc_id() { return (unsigned)__builtin_amdgcn_s_getreg((3 << 11) | 20) & 0xFu; }
#define XB_SPIN(cond, bar) do { unsigned _sp = 0; while (cond) { __builtin_amdgcn_s_sleep(1); \
    if ((++_sp & 255u) == 0u) { if (xb_ld(&(bar)[XB_TMO])) break; if (_sp > XB_SPIN_CAP) { atomicAdd(&(bar)[XB_TMO], 1u); break; } } } } while (0)

struct XcdBarrier {
    unsigned* bar; unsigned x;
    volatile LAS unsigned* st;
};

__device__ __forceinline__ XcdBarrier xcd_barrier_post(unsigned* bar, volatile LAS unsigned* st) {
    XcdBarrier b; b.bar = bar; b.x = xb_xcc_id(); b.st = st;
    if (threadIdx.x == 0) (void)xb_add(&bar[XB_XCNT(b.x)], 1u);
    return b;
}
__device__ __forceinline__ void xcd_barrier_complete(unsigned* bar, unsigned x, unsigned& nloc, unsigned& nx) {
    const unsigned G = gridDim.x * gridDim.y * gridDim.z;
    unsigned sum, cnt, mine, sp = 0u;
    for (;;) {
        sum = 0u; cnt = 0u; mine = 0u;
#pragma unroll
        for (unsigned j = 0; j < 16; ++j) { const unsigned c = xb_ld(&bar[XB_XCNT(j)]); sum += c; cnt += (c > 0u) ? 1u : 0u; mine = (j == x) ? c : mine; }
        if (sum == G) break;
        __builtin_amdgcn_s_sleep(1);
        if ((++sp & 255u) == 0u) { if (xb_ld(&bar[XB_TMO])) break; if (sp > XB_SPIN_CAP) { atomicAdd(&bar[XB_TMO], 1u); break; } }
    }
    nloc = mine > 0u ? mine : 1u; nx = cnt > 0u ? cnt : 1u;
}

__device__ __forceinline__ void xcd_barrier(const XcdBarrier& b) {
    asm volatile("s_waitcnt vmcnt(0)" ::: "memory");
    __syncthreads();
    if (threadIdx.x == 0) {
        unsigned* bar = b.bar;
        __builtin_amdgcn_s_waitcnt(0);
        unsigned nloc = b.st[0], nx = b.st[1];
        if (nloc == 0u) { xcd_barrier_complete(bar, b.x, nloc, nx); b.st[0] = nloc; b.st[1] = nx; }
        const unsigned old = xb_add(&bar[XB_XSUB(b.x)], 1u);
        const unsigned gen = old / nloc;
        if (old + 1u == (gen + 1u) * nloc) {
            __builtin_amdgcn_fence(__ATOMIC_RELEASE, "agent");
            asm volatile("s_waitcnt vmcnt(0)" ::: "memory");
            const unsigned og = xb_add(&bar[XB_TOP], 1u);
            const unsigned tg = og / nx;
            if (og + 1u == (tg + 1u) * nx) xb_add(&bar[XB_TOPGEN], 1u);
            else XB_SPIN(xb_ld(&bar[XB_TOPGEN]) == tg, bar);
            __builtin_amdgcn_fence(__ATOMIC_ACQUIRE, "agent");
            xb_add(&bar[XB_XGEN(b.x)], 1u);
            asm volatile("s_waitcnt vmcnt(0)" ::: "memory");
        } else {
            XB_SPIN(xb_ld(&bar[XB_XGEN(b.x)]) == gen, bar);
            __builtin_amdgcn_fence(__ATOMIC_ACQUIRE, "agent");
            asm volatile("s_waitcnt vmcnt(0)" ::: "memory");
        }
    }
    __syncthreads();
}


struct Frame {
    LAS unsigned char* lds; unsigned* ctl; unsigned char* ws;
    int tid, lane, wave, vcu, G, gw, ngw;
};
__device__ const float ROPE_INV[16] = {1.0f, 0.5623413251903491f, 0.31622776601683794f, 0.1778279410038923f, 0.1f, 0.05623413251903491f, 0.03162277660168379f, 0.01778279410038923f,
                                       0.01f, 0.005623413251903491f, 0.0031622776601683794f, 0.001778279410038923f, 0.001f, 0.0005623413251903491f, 0.00031622776601683794f, 0.0001778279410038923f};

__device__ __forceinline__ void p0_transpose_item(const float* W, int K, int N, bf16* WT, LAS float* scr, int item, int lane) {
    const int nblk = N / 32, kb = item / nblk, nb = item % nblk, k0 = 64 * kb, n0 = 32 * nb;
#pragma unroll 8
    for (int i = 0; i < 32; ++i) { const int kk = 2 * i + (lane >> 5); scr[kk * 33 + (lane & 31)] = W[(size_t)(k0 + kk) * N + n0 + (lane & 31)]; }
    LDS_WAIT(); asm volatile("" ::: "memory");
    const int c = lane & 7;
#pragma unroll
    for (int j = 0; j < 4; ++j) { const int n = (lane >> 3) + 8 * j; const LAS float* s = scr + (8 * c) * 33 + n;
        v4u o; o.x = pk2(s[0 * 33], s[1 * 33]); o.y = pk2(s[2 * 33], s[3 * 33]); o.z = pk2(s[4 * 33], s[5 * 33]); o.w = pk2(s[6 * 33], s[7 * 33]);
        *(GAS v4u*)(WT + (size_t)(n0 + n) * K + k0 + 8 * c) = o; }
    LDS_WAIT(); asm volatile("" ::: "memory");
}

__device__ __forceinline__ void ph_prologue_a(const Frame& F, const float* c, const float* cctx, const float* w_mod, const float* b_mod, const float* w_in, const float* w_out,
                                              const float* moe_w1, const float* moe_w2, const float* hy_w1, const float* hy_b1, const float* hy_w2, const float* hy_b2, const float* hy_freq, const float* lru_gw, const float* lru_lam) {
    {
        LAS float* scr = (LAS float*)(F.lds + F.wave * 16384);
        constexpr int I_IN = 2 * 1024, I_OUT = 2 * 512, I_W1 = 64 * 1024, I_W2 = 64 * 512, NIT = I_IN + I_OUT + I_W1 + I_W2;
        bf16* WinT = (bf16*)(F.ws + WS_WINT); bf16* WoutT = (bf16*)(F.ws + WS_WOUTT); bf16* W1T = (bf16*)(F.ws + WS_W1T); bf16* W2T = (bf16*)(F.ws + WS_W2T);
        for (int it = F.gw; it < NIT; it += F.ngw) {
            int r = it;
            if (r < I_IN) { const int m = r >> 10; p0_transpose_item(w_in + (size_t)m * 1024 * 2048, 1024, 2048, WinT + (size_t)m * 2048 * 1024, scr, r & 1023, F.lane); continue; } r -= I_IN;
            if (r < I_OUT) { const int m = r >> 9; p0_transpose_item(w_out + (size_t)m * 1024 * 1024, 1024, 1024, WoutT + (size_t)m * 1024 * 1024, scr, r & 511, F.lane); continue; } r -= I_OUT;
            if (r < I_W1) { const int m = r >> 10; p0_transpose_item(moe_w1 + (size_t)m * 1024 * 2048, 1024, 2048, W1T + (size_t)m * 2048 * 1024, scr, r & 1023, F.lane); continue; } r -= I_W1;
            { const int m = r >> 9; p0_transpose_item(moe_w2 + (size_t)m * 1024 * 1024, 1024, 1024, W2T + (size_t)m * 1024 * 1024, scr, r & 511, F.lane); }
        }
    }
    __syncthreads();
    {
        LAS float* sl = (LAS float*)(F.lds);
        LAS float* red = (LAS float*)(F.lds + 20480);
        float* MOD = (float*)(F.ws + WS_MOD);
        if ((int)blockIdx.x < 192) {
            for (int i = F.tid; i < 5 * 1024; i += NTHR) { const int r = i >> 10, k = i & 1023; const float v = (r < 4) ? c[r * 1024 + k] : cctx[k]; sl[i] = v / (1.0f + __expf(-v)); }
        }
        __syncthreads();
        for (int it = blockIdx.x; it < 192; it += F.G) {
            const int l = it / 96, n = (it % 96) * 64 + F.lane;
            float a0 = 0.f, a1 = 0.f, a2 = 0.f, a3 = 0.f, a4 = 0.f;
            const float* wp = w_mod + ((size_t)l * 1024 + F.wave * 128) * 6144 + n;
#pragma unroll 8
            for (int k = 0; k < 128; ++k) { const float w = wp[(size_t)k * 6144]; const int kk = F.wave * 128 + k;
                a0 += sl[kk] * w; a1 += sl[1024 + kk] * w; a2 += sl[2048 + kk] * w; a3 += sl[3072 + kk] * w; a4 += sl[4096 + kk] * w; }
            red[(F.wave * 5 + 0) * 64 + F.lane] = a0; red[(F.wave * 5 + 1) * 64 + F.lane] = a1; red[(F.wave * 5 + 2) * 64 + F.lane] = a2; red[(F.wave * 5 + 3) * 64 + F.lane] = a3; red[(F.wave * 5 + 4) * 64 + F.lane] = a4;
            __syncthreads();
            if (F.tid < 320) { const int r = F.tid >> 6, ln = F.tid & 63; float s = 0.f;
#pragma unroll
                for (int w = 0; w < 8; ++w) s += red[(w * 5 + r) * 64 + ln];
                const int nn = (it % 96) * 64 + ln; MOD[(size_t)(l * 5 + r) * 6144 + nn] = s + b_mod[l * 6144 + nn]; }
            __syncthreads();
        }
    }
    {
        bf16* WGT = (bf16*)(F.ws + WS_WGT); float* SPT = (float*)(F.ws + WS_SPT);
        for (int idx = blockIdx.x * NTHR + F.tid; idx < 2 * 1024 * 256; idx += F.G * NTHR) {
            const int l = idx >> 18, nidx = (idx >> 8) & 1023, k = idx & 255;
            const int pn = nidx >> 8, j = (nidx >> 7) & 1, cc = nidx & 127, d = pn >> 1, ch = 128 * (pn & 1) + cc, n = ch >> 6, e = ch & 63;
            const float v = ((k >> 6) == n) ? lru_gw[((size_t)((((l * 2 + d) * 2 + j) * 4 + n) * 64 + (k & 63))) * 64 + e] : 0.f;
            WGT[idx] = (bf16)f2bf(v); }
        for (int idx = blockIdx.x * NTHR + F.tid; idx < 2 * 2 * 256; idx += F.G * NTHR) SPT[idx] = log1pf(expf(-lru_lam[idx]));
    }
    {
        float* RC = (float*)(F.ws + WS_ROPEC); float* RS = (float*)(F.ws + WS_ROPES);
        for (int idx = blockIdx.x * NTHR + F.tid; idx < SEQ * 32; idx += F.G * NTHR) {
            const int t = idx >> 5, i = idx & 31; const int pos = (i < 16) ? (t >> 6) : (t & 63);
            const float ang = (float)pos * ROPE_INV[i & 15];
            double s, cc; sincos_d((double)ang, s, cc); RC[idx] = (float)cc; RS[idx] = (float)s; }
    }
    {
        float* H2 = (float*)(F.ws + WS_H2);
        for (int it = F.gw; it < 2 * SEQ + CTXL; it += F.ngw) {
            const int v = it >> 13, t = (v < 2) ? (it & (SEQ - 1)) : (it - 2 * SEQ), L = (v < 2) ? SEQ : CTXL, l = (v == 1) ? 1 : 0;
            const int j = F.lane;
            float z = 0.f;
            if (j == 0) z = (float)t / (float)(L - 1);
            else if (j <= 32) { const int b = (j - 1) & 15; const float band = 1e-4f + (float)b * ((15.0f - 1e-4f) / 15.0f);
                const float ang = ((6.283185307179586f / (float)L) * (float)t) * band;
                double s, cc; sincos_d((double)ang, s, cc); z = (j <= 16) ? (float)cc : -(float)s; }
            const float fr = hy_freq[l * 64 + j];
            float p1 = hy_b1[l * 64 + j];
            const float* w1 = hy_w1 + (size_t)l * 33 * 64;
#pragma unroll
            for (int i = 0; i < 33; ++i) p1 += __shfl(z, i) * w1[i * 64 + j];
            double s1, c1; sincos_d((double)(fr * p1), s1, c1); const float h1 = (float)s1;
            float p2 = hy_b2[l * 64 + j];
            const float* w2 = hy_w2 + (size_t)l * 64 * 64;
#pragma unroll 16
            for (int i = 0; i < 64; ++i) p2 += __shfl(h1, i) * w2[i * 64 + j];
            double s2, c2; sincos_d((double)(fr * p2), s2, c2);
            H2[((size_t)v * SEQ + t) * 64 + j] = (float)s2;
        }
    }
}

__device__ __forceinline__ void ph_prologue_b(const Frame& F, const float* hy_w3, const float* hy_decay, const float* gffn, const float* router_w, const float* router_b) {
    { const float* MOD = (const float*)(F.ws + WS_MOD); float* CB = (float*)(F.ws + WS_CB);
      for (int it = F.gw; it < 2 * 5 * 32; it += F.ngw) { const int lb = it >> 5, e = it & 31, l = lb / 5; const float* sf = MOD + (size_t)lb * 6144 + 3 * 1024; float s = 0.f;
#pragma unroll
          for (int q = 0; q < 16; ++q) { const int cc = 64 * q + F.lane; s += sf[cc] * router_w[(size_t)l * 32768 + cc * 32 + e]; }
          s = wave_sum(s); if (F.lane == 0) CB[it] = s + router_b[l * 32 + e]; } }
    { const float* MOD = (const float*)(F.ws + WS_MOD); float* GC = (float*)(F.ws + WS_GC);
      for (int idx = blockIdx.x * NTHR + F.tid; idx < 2 * 5 * 1024; idx += F.G * NTHR) { const int lb = idx >> 10, cc = idx & 1023, l = lb / 5; GC[idx] = gffn[l * 1024 + cc] * (1.0f + MOD[(size_t)lb * 6144 + 4 * 1024 + cc]); } }
    LAS f32x2v* D = (LAS f32x2v*)(F.lds);
    LAS float* kt = (LAS float*)(F.lds);
    LAS float* w3c = (LAS float*)(F.lds + 139264);
    LAS float* red = (LAS float*)(F.lds + 139264 + 512);
    const float* H2 = (const float*)(F.ws + WS_H2);
    c32* KHAT = (c32*)(F.ws + WS_KHAT); float* KFC = (float*)(F.ws + WS_KFC);
    for (int it = blockIdx.x; it < 768; it += F.G) {
        const int v = it >> 8, c = it & 255, L = (v < 2) ? SEQ : CTXL, l = (v == 1) ? 1 : 0;
        if (F.tid < 128) w3c[F.tid] = hy_w3[(size_t)l * 64 * 512 + (F.tid & 63) * 512 + (F.tid >> 6) * 256 + c];
        if (F.tid == 0) { if (v < 2) { f32x2v z; z.x = 0.f; z.y = 0.f; D[fpad(L)] = z; } else kt[L] = 0.f; }
        __syncthreads();
        const float df = fabsf(hy_decay[l * 512 + c]), db = fabsf(hy_decay[l * 512 + 256 + c]);
        float asum = 0.f;
        for (int t = F.tid; t < L; t += NTHR) {
            const f32x4* row = (const f32x4*)(H2 + ((size_t)v * SEQ + t) * 64);
            float hf = 0.f, hb = 0.f;
#pragma unroll
            for (int q = 0; q < 16; ++q) { const f32x4 h = row[q];
                hf += h.x * w3c[4 * q] + h.y * w3c[4 * q + 1] + h.z * w3c[4 * q + 2] + h.w * w3c[4 * q + 3];
                hb += h.x * w3c[64 + 4 * q] + h.y * w3c[64 + 4 * q + 1] + h.z * w3c[64 + 4 * q + 2] + h.w * w3c[64 + 4 * q + 3]; }
            const float t01 = (float)t / (float)(L - 1);
            hf *= expf(-t01 * df); hb *= expf(-t01 * db);
            asum += fabsf(hf); if (t >= 1) asum += fabsf(hb);
            if (v < 2) { f32x2v z; z.x = hf; z.y = 0.f; D[fpad(t)] = z; if (t >= 1) { z.x = hb; D[fpad(2 * L - t)] = z; } }
            else { kt[t] = hf; if (t >= 1) kt[2 * L - t] = hb; }
        }
        asum = wave_sum(asum);
        if (F.lane == 0) red[F.wave] = asum;
        __syncthreads();
        float tot = 0.f;
#pragma unroll
        for (int w = 0; w < 8; ++w) tot += red[w];
        const float inv = 1.0f / tot;
        if (v < 2) {
            c32* out = KHAT + (size_t)(v * 256 + c) * 16384;
#pragma unroll 1
            for (int i = 0; i < 8; ++i) fft_first4_inplace(D, F.tid + 512 * i);
            __syncthreads();
            _Pragma("unroll 1") for (int g_ = F.tid; g_ < 1024; g_ += 512) fft_fwd16(D, g_, 4096);
            __syncthreads();
            _Pragma("unroll 1") for (int g_ = F.tid; g_ < 1024; g_ += 512) fft_fwd16(D, g_, 256);
            __syncthreads();
            _Pragma("unroll 1") for (int g_ = F.tid; g_ < 1024; g_ += 512) fft_last16_out(D, g_, out, inv * (1.0f / 16384.0f));
        } else {
            float* dst = KFC + (size_t)c * 512;
            for (int j = F.tid; j < 2 * L; j += NTHR) dst[j] = kt[j] * inv;
        }
        __syncthreads();
    }
}

__device__ __forceinline__ void ph_norm_mod(const Frame& F, int l, const float* x, const float* ctx, const float* gmix) {
    const float* XR = (const float*)(F.ws + WS_XR); const float* MOD = (const float*)(F.ws + WS_MOD); bf16* H = (bf16*)(F.ws + WS_H);
    for (int r = F.gw; r < MT; r += F.ngw) {
        const float* src = (l == 0) ? (r < NLAT ? x + (size_t)r * 1024 : ctx + (size_t)(r - NLAT) * 1024) : XR + (size_t)r * 1024;
        const int bidx = r < NLAT ? r / SEQ : 4;
        const float* shift = MOD + (size_t)(l * 5 + bidx) * 6144; const float* scale = shift + 1024; const float* g = gmix + l * 1024;
        f32x4 v[4]; float ss = 0.f;
#pragma unroll
        for (int j = 0; j < 4; ++j) { v[j] = ((const f32x4*)src)[64 * j + F.lane]; ss += (v[j].x * v[j].x + v[j].y * v[j].y) + (v[j].z * v[j].z + v[j].w * v[j].w); }
        const float rstd = 1.0f / sqrtf(wave_sum(ss) * (1.0f / 1024.0f) + EPSN);
#pragma unroll
        for (int j = 0; j < 4; ++j) { const int cb = 64 * j + F.lane; const f32x4 gg = ((const f32x4*)g)[cb], sc = ((const f32x4*)scale)[cb], sh = ((const f32x4*)shift)[cb];
            const f32x4 y = v[j] * rstd * gg * (sc + 1.0f) + sh;
            v2u o; o.x = pk2(y.x, y.y); o.y = pk2(y.z, y.w); ((v2u*)(H + (size_t)r * 1024))[cb] = o; }
    }
}

__device__ __forceinline__ void ph_post_proj(const Frame& F, int l, const float* qg_, const float* kg_, const float* lru_cw, const float* lru_cb, const float* hy_cw, const float* hy_cb) {
    const bf16* U = (const bf16*)(F.ws + WS_U);
    {
        bf16* Q = (bf16*)(F.ws + WS_Q); bf16* K = (bf16*)(F.ws + WS_K); bf16* V = (bf16*)(F.ws + WS_V);
        const float* RC = (const float*)(F.ws + WS_ROPEC); const float* RS = (const float*)(F.ws + WS_ROPES);
        const int o8 = 8 * (F.lane & 7);
        const f32x4 qg0 = *(const f32x4*)(qg_ + l * 64 + o8), qg1 = *(const f32x4*)(qg_ + l * 64 + o8 + 4), kg0 = *(const f32x4*)(kg_ + l * 64 + o8), kg1 = *(const f32x4*)(kg_ + l * 64 + o8 + 4);
        const float C2 = 0.125f * 1.4426950408889634f;
        const bool lohalf = (F.lane & 4) == 0;
        for (int r = F.gw; r < MT; r += F.ngw) {
            const bool isctx = r >= NLAT; const int b = isctx ? (r - NLAT) / CTXL : r / SEQ; const int t = isctx ? (r - NLAT) % CTXL : r % SEQ;
            const bf16* ur = U + (size_t)r * INW;
            const v4u wq = ((const v4u*)ur)[F.lane];
            const v4u wk = ((const v4u*)(ur + 512))[F.lane & 31];
            f32x4 c0 = {1.f, 1.f, 1.f, 1.f}, c1 = c0, s0 = {0.f, 0.f, 0.f, 0.f}, s1 = s0;
            if (!isctx) { const float* rc = RC + t * 32 + 8 * (F.lane & 3); const float* rs = RS + t * 32 + 8 * (F.lane & 3);
                c0 = *(const f32x4*)rc; c1 = *(const f32x4*)(rc + 4); s0 = *(const f32x4*)rs; s1 = *(const f32x4*)(rs + 4); }
            const size_t krow = (size_t)b * KEYS + (isctx ? t : CTXL + t);
#pragma unroll
            for (int part = 0; part < 2; ++part) {
                const v4u w = part ? wk : wq;
                float x[8] = {bflo(w.x), bfhi(w.x), bflo(w.y), bfhi(w.y), bflo(w.z), bfhi(w.z), bflo(w.w), bfhi(w.w)};
                float ss = 0.f;
#pragma unroll
                for (int i = 0; i < 8; ++i) ss += x[i] * x[i];
                ss += __shfl_xor(ss, 1); ss += __shfl_xor(ss, 2); ss += __shfl_xor(ss, 4);
                const float rstd = 1.0f / sqrtf(ss * (1.0f / 64.0f) + EPSN);
                const f32x4 g0 = part ? kg0 : qg0, g1 = part ? kg1 : qg1;
                float y[8], o[8];
#pragma unroll
                for (int i = 0; i < 8; ++i) y[i] = x[i] * rstd * (i < 4 ? g0[i] : g1[i - 4]);
#pragma unroll
                for (int i = 0; i < 8; ++i) { const float p = __shfl_xor(y[i], 4); const float cs = i < 4 ? c0[i] : c1[i - 4], sn = i < 4 ? s0[i] : s1[i - 4];
                    o[i] = lohalf ? (y[i] * cs - p * sn) : (y[i] * cs + p * sn); }
                if (part == 0) { v4u ow; ow.x = pk2(o[0] * C2, o[1] * C2); ow.y = pk2(o[2] * C2, o[3] * C2); ow.z = pk2(o[4] * C2, o[5] * C2); ow.w = pk2(o[6] * C2, o[7] * C2);
                    ((v4u*)(Q + (size_t)r * 512))[F.lane] = ow; }
                else { v4u ow; ow.x = pk2(o[0], o[1]); ow.y = pk2(o[2], o[3]); ow.z = pk2(o[4], o[5]); ow.w = pk2(o[6], o[7]);
                    if (F.lane < 16) ((v4u*)(K + krow * 128))[F.lane] = ow;
                    else if (F.lane < 32) ((v4u*)(V + krow * 128))[F.lane - 16] = wk; }
            }
        }
    }
    {
        bf16* XL = (bf16*)(F.ws + WS_XL);
        for (int idx = blockIdx.x * NTHR + F.tid; idx < MT * 32; idx += F.G * NTHR) {
            const int r = idx >> 5, c8 = (idx & 31) * 8;
            const bool isctx = r >= NLAT; const int Ls = isctx ? CTXL : SEQ; const int t = isctx ? (r - NLAT) % CTXL : r % SEQ;
            float acc[8];
#pragma unroll
            for (int i = 0; i < 8; ++i) acc[i] = lru_cb[l * 256 + c8 + i];
#pragma unroll
            for (int j = 0; j < 4; ++j) { const int tj = t + j - 2;
                if (tj >= 0 && tj < Ls) { const v4u w = *(const v4u*)(U + (size_t)(r + j - 2) * INW + 768 + c8);
                    const f32x4 w0 = *(const f32x4*)(lru_cw + (l * 4 + j) * 256 + c8), w1 = *(const f32x4*)(lru_cw + (l * 4 + j) * 256 + c8 + 4);
                    acc[0] += w0.x * bflo(w.x); acc[1] += w0.y * bfhi(w.x); acc[2] += w0.z * bflo(w.y); acc[3] += w0.w * bfhi(w.y);
                    acc[4] += w1.x * bflo(w.z); acc[5] += w1.y * bfhi(w.z); acc[6] += w1.z * bflo(w.w); acc[7] += w1.w * bfhi(w.w); } }
            v4u o; o.x = pk2(acc[0], acc[1]); o.y = pk2(acc[2], acc[3]); o.z = pk2(acc[4], acc[5]); o.w = pk2(acc[6], acc[7]);
            *(v4u*)(XL + (size_t)r * 256 + c8) = o;
        }
    }
    __syncthreads();
    {
        LAS bf16* hs = (LAS bf16*)(F.lds);
        float* VT = (float*)(F.ws + WS_VT); float* X0T = (float*)(F.ws + WS_X0T);
        const float* cw = hy_cw + (size_t)l * 3 * 768; const float* cbp = hy_cb + l * 768;
        for (int it = blockIdx.x; it < NLAT / 64; it += F.G) {
            const int b = it >> 7, t0 = (it & 127) * 64;
            for (int i = F.tid; i < 66 * 384; i += NTHR) { const int rr = i / 384, c2 = i - rr * 384; const int t = t0 - 1 + rr;
                unsigned w = 0u; if (t >= 0 && t < SEQ) w = *(const unsigned*)(U + (size_t)(b * SEQ + t) * INW + 1280 + 2 * c2);
                *(LAS unsigned*)(hs + rr * 770 + 2 * c2) = w; }
            __syncthreads();
            for (int c = F.wave; c < 256; c += NWAVES) {
                const int tt = F.lane;
                float o[3];
#pragma unroll
                for (int g = 0; g < 3; ++g) { const int cc = g * 256 + c;
                    o[g] = cw[cc] * bf2f(hs[tt * 770 + cc]) + cw[768 + cc] * bf2f(hs[(tt + 1) * 770 + cc]) + cw[1536 + cc] * bf2f(hs[(tt + 2) * 770 + cc]) + cbp[cc]; }
                const size_t oi = ((size_t)b * 256 + c) * SEQ + t0 + tt;
                VT[oi] = o[2] * o[1]; X0T[oi] = o[0];
            }
            __syncthreads();
        }
    }
}

__device__ __forceinline__ void ph_ctx_attn(const Frame& F) {
    const bf16* Q = (const bf16*)(F.ws + WS_Q); const bf16* K = (const bf16*)(F.ws + WS_K); const bf16* V = (const bf16*)(F.ws + WS_V); bf16* O = (bf16*)(F.ws + WS_ATT);
    LAS float* qs = (LAS float*)(F.lds + 90112 + F.wave * 1280);
    LAS float* ps = qs + 64;
    for (int it = F.gw; it < NCTX * 8; it += F.ngw) {
        const int rc = it >> 3, h = it & 7, b = rc / CTXL, kvh = h >> 2; const int r = NLAT + rc;
        qs[F.lane] = bf2f(Q[(size_t)r * 512 + h * 64 + F.lane]);
        LDS_WAIT();
        float sc[4]; float mx = -INFINITY;
#pragma unroll
        for (int i = 0; i < 4; ++i) { const int key = F.lane + 64 * i; const v4u* kp = (const v4u*)(K + ((size_t)b * KEYS + key) * 128 + kvh * 64);
            float s = 0.f;
#pragma unroll
            for (int q = 0; q < 8; ++q) { const v4u w = kp[q];
                s += qs[8 * q] * bflo(w.x) + qs[8 * q + 1] * bfhi(w.x) + qs[8 * q + 2] * bflo(w.y) + qs[8 * q + 3] * bfhi(w.y) + qs[8 * q + 4] * bflo(w.z) + qs[8 * q + 5] * bfhi(w.z) + qs[8 * q + 6] * bflo(w.w) + qs[8 * q + 7] * bfhi(w.w); }
            sc[i] = s; mx = fmaxf(mx, s); }
#pragma unroll
        for (int o = 1; o < 64; o <<= 1) mx = fmaxf(mx, __shfl_xor(mx, o));
        float sum = 0.f;
#pragma unroll
        for (int i = 0; i < 4; ++i) { const float p = exp2f(sc[i] - mx); sum += p; ps[F.lane + 64 * i] = p; }
        sum = wave_sum(sum);
        LDS_WAIT();
        float acc = 0.f;
        const bf16* vp = V + (size_t)b * KEYS * 128 + kvh * 64 + F.lane;
#pragma unroll 8
        for (int key = 0; key < CTXL; ++key) acc += ps[key] * bf2f(vp[(size_t)key * 128]);
        O[(size_t)r * 512 + h * 64 + F.lane] = (bf16)f2bf(acc / sum);
        LDS_WAIT();
    }
}

__device__ __forceinline__ int chunk_row0(int b, int d, int k) {
    if (k < 2) { const int cc = d ? 1 - k : k; return NLAT + b * CTXL + cc * CHUNK; }
    const int lc = d ? 63 - (k - 2) : (k - 2); return b * SEQ + lc * CHUNK;
}
__device__ __forceinline__ void ph_scan1(const Frame& F) {
    const bf16* LAB = (const bf16*)(F.ws + WS_LAB); float* SUMP = (float*)(F.ws + WS_SCANS); float* SUMH = SUMP + NB * 2 * NCHUNK * 256;
    for (int it = blockIdx.x * NTHR + F.tid; it < NB * 2 * NCHUNK * 256; it += F.G * NTHR) {
        const int ch = it & 255, k = (it >> 8) % NCHUNK, bd = (it >> 8) / NCHUNK, d = bd & 1, b = bd >> 1;
        const int r0 = chunk_row0(b, d, k);
        const bf16* LA = LAB + (size_t)(2 * d) * LAB_STRIDE + ch; const bf16* LB = LAB + (size_t)(2 * d + 1) * LAB_STRIDE + ch;
        float h = 0.f, Ps = 0.f;
#pragma unroll 16
        for (int i = 0; i < CHUNK; ++i) { const int r = d ? r0 + CHUNK - 1 - i : r0 + i; const float la = bf2f(LA[(size_t)r * 256]), bx = bf2f(LB[(size_t)r * 256]); h = __builtin_amdgcn_exp2f(la) * h + bx; Ps += la; }
        SUMP[it] = __builtin_amdgcn_exp2f(Ps); SUMH[it] = h;
    }
}
__device__ __forceinline__ void ph_scan2(const Frame& F) {
    const bf16* LAB = (const bf16*)(F.ws + WS_LAB); const float* SUMP = (const float*)(F.ws + WS_SCANS); const float* SUMH = SUMP + NB * 2 * NCHUNK * 256;
    float* LRUO = (float*)(F.ws + WS_LRUO); const bf16* U = (const bf16*)(F.ws + WS_U);
    for (int it = blockIdx.x * NTHR + F.tid; it < NB * NCHUNK * 256; it += F.G * NTHR) {
        const int ch = it & 255, kc = (it >> 8) % NCHUNK, b = (it >> 8) / NCHUNK;
        const int r0 = chunk_row0(b, 0, kc);
#pragma unroll 1
        for (int d = 0; d < 2; ++d) {
            const int k = d ? ((kc < 2) ? 1 - kc : 2 + 63 - (kc - 2)) : kc;
            const size_t sb = (size_t)((b * 2 + d) * NCHUNK) * 256 + ch;
            float h = 0.f;
#pragma unroll 8
            for (int j = 0; j < k; ++j) h = SUMP[sb + (size_t)j * 256] * h + SUMH[sb + (size_t)j * 256];
            const bf16* LA = LAB + (size_t)(2 * d) * LAB_STRIDE + ch; const bf16* LB = LAB + (size_t)(2 * d + 1) * LAB_STRIDE + ch;
            if (d == 0) {
#pragma unroll 16
                for (int i = 0; i < CHUNK; ++i) { const int r = r0 + i; h = __builtin_amdgcn_exp2f(bf2f(LA[(size_t)r * 256])) * h + bf2f(LB[(size_t)r * 256]); LRUO[(size_t)r * 256 + ch] = h; }
            } else {
#pragma unroll 8
                for (int i = 0; i < CHUNK; ++i) { const int r = r0 + CHUNK - 1 - i; h = __builtin_amdgcn_exp2f(bf2f(LA[(size_t)r * 256])) * h + bf2f(LB[(size_t)r * 256]);
                    const float lg = bf2f(U[(size_t)r * INW + 1024 + ch]);
                    LRUO[(size_t)r * 256 + ch] = (LRUO[(size_t)r * 256 + ch] + h) * gelu_tanh(lg); }
            }
        }
    }
}

__device__ __forceinline__ void ph_hyena_direct(const Frame& F, int l, const float* hy_bias, const float* hy_cw, const float* hy_cb) {
    LAS float* ks = (LAS float*)(F.lds);
    LAS float* vs = (LAS float*)(F.lds + 65536);
    const float* KF = (const float*)(F.ws + WS_KF) + (size_t)l * 256 * 16384;
    const float* VT = (const float*)(F.ws + WS_VT); const float* X0T = (const float*)(F.ws + WS_X0T); float* HYO = (float*)(F.ws + WS_HYO);
    for (int it = blockIdx.x; it < 512; it += F.G) {
        const int c = it >> 1, bp = it & 1;
        for (int i = F.tid; i < 4096; i += NTHR) ((LAS f32x4*)ks)[i] = ((const f32x4*)(KF + (size_t)c * 16384))[i];
        for (int i = F.tid; i < 4096; i += NTHR) { const int bb = i >> 11, q = i & 2047; ((LAS f32x4*)vs)[i] = ((const f32x4*)(VT + ((size_t)(bp * 2 + bb) * 256 + c) * SEQ))[q]; }
        __syncthreads();
        float y0[16], y1[16];
#pragma unroll
        for (int i = 0; i < 16; ++i) { y0[i] = 0.f; y1[i] = 0.f; }
#pragma unroll 2
        for (int s = 0; s < SEQ; ++s) {
            const float v0 = vs[s], v1 = vs[SEQ + s];
            const int base = (F.tid - s) & 16383;
#pragma unroll
            for (int i = 0; i < 16; ++i) { const float kk = ks[(base + 512 * i) & 16383]; y0[i] += kk * v0; y1[i] += kk * v1; }
        }
        const float bias = hy_bias[l * 256 + c];
#pragma unroll
        for (int i = 0; i < 16; ++i) { const int t = F.tid + 512 * i;
            { const int b = bp * 2; const size_t oi = ((size_t)b * 256 + c) * SEQ + t; HYO[((size_t)b * SEQ + t) * 256 + c] = (y0[i] + vs[t] * bias) * X0T[oi]; }
            { const int b = bp * 2 + 1; const size_t oi = ((size_t)b * 256 + c) * SEQ + t; HYO[((size_t)b * SEQ + t) * 256 + c] = (y1[i] + vs[SEQ + t] * bias) * X0T[oi]; } }
        __syncthreads();
    }
}
__device__ __forceinline__ void ph_khat(const Frame& F) {
    LAS f32x2v* D = (LAS f32x2v*)(F.lds);
    const float* KF = (const float*)(F.ws + WS_KF); c32* KHAT = (c32*)(F.ws + WS_KHAT);
    for (int it = blockIdx.x; it < 512; it += F.G) {
        const float* k = KF + (size_t)it * 16384; c32* out = KHAT + (size_t)it * 16384;
#pragma unroll 1
        for (int i = 0; i < 8; ++i) { const int j = F.tid + 512 * i; c32 x0, x1, x2, x3; x0.x = k[j]; x1.x = k[j + 4096]; x2.x = k[j + 8192]; x3.x = k[j + 12288]; x0.y = x1.y = x2.y = x3.y = 0.f;
            fft_first4(D, j, x0, x1, x2, x3); }
        __syncthreads();
        _Pragma("unroll 1") for (int g_ = F.tid; g_ < 1024; g_ += 512) fft_fwd16(D, g_, 4096);
        __syncthreads();
        _Pragma("unroll 1") for (int g_ = F.tid; g_ < 1024; g_ += 512) fft_fwd16(D, g_, 256);
        __syncthreads();
        _Pragma("unroll 1") for (int g_ = F.tid; g_ < 1024; g_ += 512) fft_last16_out(D, g_, out, 1.0f / 16384.0f);
        __syncthreads();
    }
}
__device__ __forceinline__ void ph_hyena_fft(const Frame& F, int l, const float* hy_bias) {
    LAS f32x2v* D = (LAS f32x2v*)(F.lds);
    const c32* KHAT = (const c32*)(F.ws + WS_KHAT) + (size_t)l * 256 * 16384;
    const float* VT = (const float*)(F.ws + WS_VT); const float* X0T = (const float*)(F.ws + WS_X0T); float* HYO = (float*)(F.ws + WS_HYO);
    for (int it = blockIdx.x; it < 512; it += F.G) {
        const int c = it >> 1, bp = it & 1;
        const float* va = VT + ((size_t)(bp * 2) * 256 + c) * SEQ; const float* vb = VT + ((size_t)(bp * 2 + 1) * 256 + c) * SEQ;
#ifndef REP_FFT
#define REP_FFT 1
#endif
#pragma unroll 1
        for (int repf_ = 0; repf_ < REP_FFT; ++repf_) {
#pragma unroll 1
        for (int i = 0; i < 8; ++i) { const int j = F.tid + 512 * i; c32 x0, x1, z; x0.x = va[j]; x0.y = vb[j]; x1.x = va[j + 4096]; x1.y = vb[j + 4096]; z.x = 0.f; z.y = 0.f;
            fft_first4(D, j, x0, x1, z, z); }
        __syncthreads();
        _Pragma("unroll 1") for (int g_ = F.tid; g_ < 1024; g_ += 512) fft_fwd16(D, g_, 4096);
        __syncthreads();
        _Pragma("unroll 1") for (int g_ = F.tid; g_ < 1024; g_ += 512) fft_fwd16(D, g_, 256);
        __syncthreads();
        _Pragma("unroll 1") for (int g_ = F.tid; g_ < 1024; g_ += 512) fft_mid16(D, g_, KHAT + (size_t)c * 16384);
        __syncthreads();
        _Pragma("unroll 1") for (int g_ = F.tid; g_ < 1024; g_ += 512) fft_inv16(D, g_, 256);
        __syncthreads();
        _Pragma("unroll 1") for (int g_ = F.tid; g_ < 1024; g_ += 512) fft_inv16(D, g_, 4096);
        __syncthreads();
        }
        const float bias = hy_bias[l * 256 + c];
        const float* xa = X0T + ((size_t)(bp * 2) * 256 + c) * SEQ; const float* xb = X0T + ((size_t)(bp * 2 + 1) * 256 + c) * SEQ;
        float* oa = HYO + ((size_t)(bp * 2) * 256 + c) * SEQ; float* ob = HYO + ((size_t)(bp * 2 + 1) * 256 + c) * SEQ;
#pragma unroll 2
        for (int i = 0; i < 8; ++i) { const int j = F.tid + 512 * i; c32 u0, u1; fft_final4(D, j, u0, u1);
            oa[j] = (u0.x + va[j] * bias) * xa[j];                 ob[j] = (-u0.y + vb[j] * bias) * xb[j];
            oa[j + 4096] = (u1.x + va[j + 4096] * bias) * xa[j + 4096]; ob[j + 4096] = (-u1.y + vb[j + 4096] * bias) * xb[j + 4096]; }
        __syncthreads();
    }
}
__device__ __forceinline__ void ph_hyena_ctx(const Frame& F, const float* hy_bias, const float* hy_cw, const float* hy_cb) {
    float* HYO = (float*)(F.ws + WS_HYO);
    {

        const bf16* U = (const bf16*)(F.ws + WS_U); const float* KFC = (const float*)(F.ws + WS_KFC);
        LAS float* vw = (LAS float*)(F.lds + F.wave * 4096);
        LAS float* kw = vw + 256;
        const float* cw = hy_cw; const float* cbp = hy_cb;
        for (int it = F.gw; it < NB * 256; it += F.ngw) {
            const int b = it >> 8, c = it & 255;
            float x0v[4];
#pragma unroll
            for (int i = 0; i < 4; ++i) { const int t = F.lane + 64 * i;
                float o[3];
#pragma unroll
                for (int g = 0; g < 3; ++g) { const int cc = g * 256 + c; float a = cbp[cc];
#pragma unroll
                    for (int j = 0; j < 3; ++j) { const int tj = t + j - 1; if (tj >= 0 && tj < CTXL) a += cw[j * 768 + cc] * bf2f(U[(size_t)(NLAT + b * CTXL + tj) * INW + 1280 + cc]); }
                    o[g] = a; }
                vw[t] = o[2] * o[1]; x0v[i] = o[0]; }
#pragma unroll
            for (int i = 0; i < 8; ++i) kw[F.lane + 64 * i] = KFC[c * 512 + F.lane + 64 * i];
            LDS_WAIT();
            float y[4] = {0.f, 0.f, 0.f, 0.f};
#pragma unroll 4
            for (int s = 0; s < CTXL; ++s) { const float vv = vw[s];
#pragma unroll
                for (int i = 0; i < 4; ++i) y[i] += kw[(F.lane + 64 * i - s) & 511] * vv; }
            const float bias = hy_bias[c];
#pragma unroll
            for (int i = 0; i < 4; ++i) { const int t = F.lane + 64 * i; HYO[(size_t)(NLAT + b * CTXL + t) * 256 + c] = (y[i] + vw[t] * bias) * x0v[i]; }
            LDS_WAIT();
        }
    }
}

__device__ __forceinline__ void merge_row(const Frame& F, int r, const float* g, float h0, float h1, float h2, float h3) {
    const bf16* ATT = (const bf16*)(F.ws + WS_ATT); const float* LRUO = (const float*)(F.ws + WS_LRUO); bf16* MIXA = (bf16*)(F.ws + WS_MIXA);
    const v4u aw = ((const v4u*)(ATT + (size_t)r * 512))[F.lane];
    float a[8] = {bflo(aw.x), bfhi(aw.x), bflo(aw.y), bfhi(aw.y), bflo(aw.z), bfhi(aw.z), bflo(aw.w), bfhi(aw.w)};
    float ss = 0.f;
#pragma unroll
    for (int i = 0; i < 8; ++i) ss += a[i] * a[i];
    const float ra = 1.0f / sqrtf(wave_sum(ss) * (1.0f / 512.0f) + EPSN);
    const f32x4 lv = ((const f32x4*)(LRUO + (size_t)r * 256))[F.lane];
    const float rl = 1.0f / sqrtf(wave_sum(lv.x * lv.x + lv.y * lv.y + lv.z * lv.z + lv.w * lv.w) * (1.0f / 256.0f) + EPSN);
    const float rh = 1.0f / sqrtf(wave_sum(h0 * h0 + h1 * h1 + h2 * h2 + h3 * h3) * (1.0f / 256.0f) + EPSN);
    bf16* orow = MIXA + (size_t)r * 1024;
    { const f32x4 g0 = ((const f32x4*)g)[2 * F.lane], g1 = ((const f32x4*)g)[2 * F.lane + 1];
      v4u o; o.x = pk2(a[0] * ra * g0.x, a[1] * ra * g0.y); o.y = pk2(a[2] * ra * g0.z, a[3] * ra * g0.w); o.z = pk2(a[4] * ra * g1.x, a[5] * ra * g1.y); o.w = pk2(a[6] * ra * g1.z, a[7] * ra * g1.w);
      ((v4u*)orow)[F.lane] = o; }
    { const f32x4 gg = ((const f32x4*)(g + 512))[F.lane]; v2u o; o.x = pk2(lv.x * rl * gg.x, lv.y * rl * gg.y); o.y = pk2(lv.z * rl * gg.z, lv.w * rl * gg.w); ((v2u*)(orow + 512))[F.lane] = o; }
    orow[768 + F.lane] = (bf16)f2bf(h0 * rh * g[768 + F.lane]); orow[832 + F.lane] = (bf16)f2bf(h1 * rh * g[832 + F.lane]);
    orow[896 + F.lane] = (bf16)f2bf(h2 * rh * g[896 + F.lane]); orow[960 + F.lane] = (bf16)f2bf(h3 * rh * g[960 + F.lane]);
}
__device__ __forceinline__ void ph_merge(const Frame& F, int l, int nrows, const float* out_g) {
    const float* HYO = (const float*)(F.ws + WS_HYO);
    const float* g = out_g + l * 1024;
    LAS float* tile = (LAS float*)(F.lds);
    for (int it = blockIdx.x; it < NLAT / 64; it += F.G) {
        const int b = it >> 7, t0 = (it & 127) * 64;
#pragma unroll 8
        for (int i = 0; i < 32; ++i) { const int c = F.wave * 32 + i; tile[c * 65 + F.lane] = HYO[((size_t)b * 256 + c) * SEQ + t0 + F.lane]; }
        __syncthreads();
#pragma unroll 2
        for (int k = 0; k < 8; ++k) { const int tt = F.wave * 8 + k;
            merge_row(F, b * SEQ + t0 + tt, g, tile[F.lane * 65 + tt], tile[(F.lane + 64) * 65 + tt], tile[(F.lane + 128) * 65 + tt], tile[(F.lane + 192) * 65 + tt]); }
        __syncthreads();
    }
    for (int r = NLAT + F.gw; r < nrows; r += F.ngw) {
        const float* hr = HYO + (size_t)r * 256;
        merge_row(F, r, g, hr[F.lane], hr[64 + F.lane], hr[128 + F.lane], hr[192 + F.lane]);
    }
}

__device__ __forceinline__ void ph_ffn_router_old(const Frame& F, int l, int nrows, const float* gffn, const float* router_w, const float* router_b) {
    LAS float* rwl = (LAS float*)(F.lds);
    LAS int* hist = (LAS int*)(F.lds + 135168);
    const float* XR = (const float*)(F.ws + WS_XR); const float* MOD = (const float*)(F.ws + WS_MOD); bf16* Fb = (bf16*)(F.ws + WS_F);
    int* TOPI = (int*)(F.ws + WS_TOPI); float* GATE = (float*)(F.ws + WS_GATE); int* BLKCNT = (int*)(F.ws + WS_BLKCNT);
    for (int i = F.tid; i < 1024 * 32; i += NTHR) rwl[(i >> 5) * 33 + (i & 31)] = router_w[(size_t)l * 32768 + i];
    if (F.tid < 32) hist[F.tid] = 0;
    __syncthreads();
    const float* g = gffn + l * 1024;
    for (int r = F.gw; r < nrows; r += F.ngw) {
        const int bidx = r < NLAT ? r / SEQ : 4;
        const float* sf = MOD + (size_t)(l * 5 + bidx) * 6144 + 3 * 1024; const float* cf = sf + 1024;
        float f[16]; float ss = 0.f;
#pragma unroll
        for (int j = 0; j < 16; ++j) { f[j] = XR[(size_t)r * 1024 + 64 * j + F.lane]; ss += f[j] * f[j]; }
        const float rstd = 1.0f / sqrtf(wave_sum(ss) * (1.0f / 1024.0f) + EPSN);
        float p[32];
#pragma unroll
        for (int e = 0; e < 32; ++e) p[e] = 0.f;
#pragma unroll
        for (int j = 0; j < 16; ++j) { const int c = 64 * j + F.lane; const float fv = f[j] * rstd * g[c] * (1.0f + cf[c]) + sf[c];
            Fb[(size_t)r * 1024 + c] = (bf16)f2bf(fv);
            const LAS float* wrow = rwl + c * 33;
#pragma unroll
            for (int e = 0; e < 32; ++e) p[e] += fv * wrow[e]; }
#pragma unroll
        for (int e = 0; e < 32; ++e) p[e] = wave_sum(p[e]) + router_b[l * 32 + e];
        unsigned taken = 0u; float tv[4]; int ti[4];
#pragma unroll
        for (int k = 0; k < 4; ++k) { float best = -INFINITY; int bi = 0;
#pragma unroll
            for (int e = 0; e < 32; ++e) { const bool ok = !((taken >> e) & 1u) && (p[e] > best); best = ok ? p[e] : best; bi = ok ? e : bi; }
            taken |= 1u << bi; tv[k] = best; ti[k] = bi; }
        const float e1 = __expf(tv[1] - tv[0]), e2 = __expf(tv[2] - tv[0]), e3 = __expf(tv[3] - tv[0]); const float inv = 1.0f / (1.0f + e1 + e2 + e3);
        if (F.lane == 0) {
            TOPI[r * 4 + 0] = ti[0]; TOPI[r * 4 + 1] = ti[1]; TOPI[r * 4 + 2] = ti[2]; TOPI[r * 4 + 3] = ti[3];
            GATE[r * 4 + 0] = inv; GATE[r * 4 + 1] = e1 * inv; GATE[r * 4 + 2] = e2 * inv; GATE[r * 4 + 3] = e3 * inv;
            lds_add(&hist[ti[0]], 1); lds_add(&hist[ti[1]], 1); lds_add(&hist[ti[2]], 1); lds_add(&hist[ti[3]], 1);
        }
    }
    __syncthreads();
    if (F.tid < 32) BLKCNT[blockIdx.x * 32 + F.tid] = hist[F.tid];
}

__device__ __forceinline__ void ph_ffn_router(const Frame& F, int l, int nrows, const float* router_w) {
    LAS float* rwl = (LAS float*)(F.lds);
    LAS float* cbl = (LAS float*)(F.lds + 147456);
    LAS int* hist = (LAS int*)(F.lds + 147456 + 640);
    const float* XR = (const float*)(F.ws + WS_XR); const float* MOD = (const float*)(F.ws + WS_MOD); const float* GC = (const float*)(F.ws + WS_GC) + (size_t)l * 5 * 1024; bf16* Fb = (bf16*)(F.ws + WS_F);
    int* TOPI = (int*)(F.ws + WS_TOPI); float* GATE = (float*)(F.ws + WS_GATE); int* BLKCNT = (int*)(F.ws + WS_BLKCNT);
    for (int i = F.tid; i < 1024 * 32; i += NTHR) rwl[(i >> 5) * 36 + (i & 31)] = router_w[(size_t)l * 32768 + i];
    if (F.tid < 32) hist[F.tid] = 0;
    __syncthreads();
    if (F.tid < 160) cbl[F.tid] = ((const float*)(F.ws + WS_CB))[l * 160 + F.tid];
    __syncthreads();
    const int j = F.lane & 15, kq = F.lane >> 4;
    for (int grp = F.gw; grp < nrows / 16; grp += F.ngw) {
        const int r0 = grp * 16, r = r0 + j; const int bidx = r0 < NLAT ? r0 / SEQ : 4;
        const float* xrow = XR + (size_t)r * 1024 + 4 * kq; const float* gcp = GC + bidx * 1024 + 4 * kq; const float* sfp = MOD + (size_t)(l * 5 + bidx) * 6144 + 3 * 1024 + 4 * kq;
        f32x4 acc0 = {0.f, 0.f, 0.f, 0.f}, acc1 = acc0; float ss = 0.f;
#pragma unroll 16
        for (int i = 0; i < 64; ++i) {
            const f32x4 x4 = *(const f32x4*)(xrow + 16 * i); const f32x4 g4 = *(const f32x4*)(gcp + 16 * i);
            ss += (x4.x * x4.x + x4.y * x4.y) + (x4.z * x4.z + x4.w * x4.w);
            const f32x4 xb = x4 * g4;
            const LAS float* wp = rwl + (16 * i + 4 * kq) * 36 + j;
#pragma unroll
            for (int e = 0; e < 4; ++e) { acc0 = __builtin_amdgcn_mfma_f32_16x16x4f32(wp[e * 36], xb[e], acc0, 0, 0, 0); acc1 = __builtin_amdgcn_mfma_f32_16x16x4f32(wp[e * 36 + 16], xb[e], acc1, 0, 0, 0); }
        }
        ss += __shfl_xor(ss, 16); ss += __shfl_xor(ss, 32);
        const float rstd = 1.0f / sqrtf(ss * (1.0f / 1024.0f) + EPSN);
        float lg[8];
#pragma unroll
        for (int rr = 0; rr < 4; ++rr) { lg[rr] = rstd * acc0[rr] + cbl[bidx * 32 + 4 * kq + rr]; lg[4 + rr] = rstd * acc1[rr] + cbl[bidx * 32 + 16 + 4 * kq + rr]; }
        float p[32];
#pragma unroll
        for (int e = 0; e < 32; ++e) p[e] = __shfl(lg[(e >> 4) * 4 + (e & 3)], j + 16 * ((e & 15) >> 2));
        unsigned taken = 0u; float tv[4]; int ti[4];
#pragma unroll
        for (int k = 0; k < 4; ++k) { float best = -INFINITY; int bi = 0;
#pragma unroll
            for (int e = 0; e < 32; ++e) { const bool ok = !((taken >> e) & 1u) && (p[e] > best); best = ok ? p[e] : best; bi = ok ? e : bi; }
            taken |= 1u << bi; tv[k] = best; ti[k] = bi; }
        const float e1 = __expf(tv[1] - tv[0]), e2 = __expf(tv[2] - tv[0]), e3 = __expf(tv[3] - tv[0]); const float inv = 1.0f / (1.0f + e1 + e2 + e3);
        if (kq == 0) {
            TOPI[r * 4 + 0] = ti[0]; TOPI[r * 4 + 1] = ti[1]; TOPI[r * 4 + 2] = ti[2]; TOPI[r * 4 + 3] = ti[3];
            GATE[r * 4 + 0] = inv; GATE[r * 4 + 1] = e1 * inv; GATE[r * 4 + 2] = e2 * inv; GATE[r * 4 + 3] = e3 * inv;
            lds_add(&hist[ti[0]], 1); lds_add(&hist[ti[1]], 1); lds_add(&hist[ti[2]], 1); lds_add(&hist[ti[3]], 1);
        }
        bf16* frow = Fb + (size_t)r * 1024 + 4 * kq;
#pragma unroll 8
        for (int i = 0; i < 64; ++i) {
            const f32x4 x4 = *(const f32x4*)(xrow + 16 * i); const f32x4 g4 = *(const f32x4*)(gcp + 16 * i); const f32x4 s4 = *(const f32x4*)(sfp + 16 * i);
            const f32x4 fv = x4 * rstd * g4 + s4;
            v2u o; o.x = pk2(fv.x, fv.y); o.y = pk2(fv.z, fv.w); *(v2u*)(frow + 16 * i) = o; }
    }
    __syncthreads();
    if (F.tid < 32) BLKCNT[blockIdx.x * 32 + F.tid] = hist[F.tid];
}

__device__ __forceinline__ void ph_route(const Frame& F, int nrows) {
    LAS int* cursor = (LAS int*)(F.lds);
    LAS int* tot = cursor + 32;
    LAS int* mine = cursor + 64;
    const int* BLKCNT = (const int*)(F.ws + WS_BLKCNT); const int* TOPI = (const int*)(F.ws + WS_TOPI); int* POS = (int*)(F.ws + WS_POS);
    const bf16* Fb = (const bf16*)(F.ws + WS_F); bf16* AS = (bf16*)(F.ws + WS_ASORT); int* TILEE = (int*)(F.ws + WS_TILEE);
    { LAS int* part = cursor + 96;
      const int e = F.tid & 31, sl = F.tid >> 5; int t = 0, m = 0;
      for (int b = sl; b < F.G; b += 16) { const int v = BLKCNT[b * 32 + e]; t += v; m += (b < (int)blockIdx.x) ? v : 0; }
      part[sl * 64 + e] = t; part[sl * 64 + 32 + e] = m;
      __syncthreads();
      if (F.tid < 32) { int tt = 0, mm = 0;
#pragma unroll
          for (int s = 0; s < 16; ++s) { tt += part[s * 64 + F.tid]; mm += part[s * 64 + 32 + F.tid]; }
          tot[F.tid] = tt; mine[F.tid] = mm; } }
    __syncthreads();
    if (F.tid == 0) { int tb = 0;
        for (int e = 0; e < 32; ++e) { const int nt = (tot[e] + 255) >> 8; cursor[e] = tb * 256 + mine[e];
            if (blockIdx.x == 0) for (int j = 0; j < nt; ++j) TILEE[tb + j] = e;
            tb += nt; }
        if (blockIdx.x == 0) F.ctl[CW_NTILES] = (unsigned)tb; }
    __syncthreads();
    for (int rr = F.gw * 16; rr < nrows; rr += (rr % 16 == 15) ? (F.ngw * 16 - 15) : 1) {
        const int r = rr;
        int pos = 0;
        if (F.lane < 4) { const int e = TOPI[r * 4 + F.lane]; pos = lds_add(&cursor[e], 1); POS[r * 4 + F.lane] = pos; }
        const v4u a0 = ((const v4u*)(Fb + (size_t)r * 1024))[F.lane], a1 = ((const v4u*)(Fb + (size_t)r * 1024))[64 + F.lane];
#pragma unroll
        for (int k = 0; k < 4; ++k) { const int pk = __shfl(pos, k); v4u* dst = (v4u*)(AS + (size_t)pk * 1024); dst[F.lane] = a0; dst[64 + F.lane] = a1; }
    }
}

__device__ __forceinline__ void ph_combine(const Frame& F, int l, int nrows, float* out, const float* gmix) {
    float* XR = (float*)(F.ws + WS_XR); const float* MOD = (const float*)(F.ws + WS_MOD); const bf16* YS = (const bf16*)(F.ws + WS_YS); bf16* H = (bf16*)(F.ws + WS_H);
    const int* POS = (const int*)(F.ws + WS_POS); const float* GATE = (const float*)(F.ws + WS_GATE);
    for (int r = F.gw; r < nrows; r += F.ngw) {
        const int bidx = r < NLAT ? r / SEQ : 4;
        const float* gf = MOD + (size_t)(l * 5 + bidx) * 6144 + 5 * 1024;
        int pos = 0; float gt = 0.f;
        if (F.lane < 4) { pos = POS[r * 4 + F.lane]; gt = GATE[r * 4 + F.lane]; }
        f32x4 y[4];
#pragma unroll
        for (int j = 0; j < 4; ++j) y[j] = (f32x4){0.f, 0.f, 0.f, 0.f};
#pragma unroll
        for (int k = 0; k < 4; ++k) { const int pk = __shfl(pos, k); const float gk = __shfl(gt, k); const v2u* yr = (const v2u*)(YS + (size_t)pk * 1024);
#pragma unroll
            for (int j = 0; j < 4; ++j) { const v2u w = yr[64 * j + F.lane]; y[j].x += gk * bflo(w.x); y[j].y += gk * bfhi(w.x); y[j].z += gk * bflo(w.y); y[j].w += gk * bfhi(w.y); } }
        float* dst = (l == 0) ? XR + (size_t)r * 1024 : out + (size_t)r * 1024;
        float ss = 0.f;
#pragma unroll
        for (int j = 0; j < 4; ++j) { const int cb = 64 * j + F.lane; const f32x4 xv = ((const f32x4*)(XR + (size_t)r * 1024))[cb]; const f32x4 gv = ((const f32x4*)gf)[cb];
            y[j] = xv + gv * y[j]; ((f32x4*)dst)[cb] = y[j]; ss += (y[j].x * y[j].x + y[j].y * y[j].y) + (y[j].z * y[j].z + y[j].w * y[j].w); }
        if (l == 0) {
            const float rstd = 1.0f / sqrtf(wave_sum(ss) * (1.0f / 1024.0f) + EPSN);
            const float* shift = MOD + (size_t)(5 + bidx) * 6144; const float* scale = shift + 1024; const float* g = gmix + 1024;
#pragma unroll
            for (int j = 0; j < 4; ++j) { const int cb = 64 * j + F.lane; const f32x4 gg = ((const f32x4*)g)[cb], sc = ((const f32x4*)scale)[cb], sh = ((const f32x4*)shift)[cb];
                const f32x4 hv = y[j] * rstd * gg * (sc + 1.0f) + sh;
                v2u o; o.x = pk2(hv.x, hv.y); o.y = pk2(hv.z, hv.w); ((v2u*)(H + (size_t)r * 1024))[cb] = o; }
        }
    }
}

struct Args { const float* in[34]; float* out; unsigned char* ws; int ph_lo, ph_hi; };
enum { I_X = 0, I_C, I_CTX, I_CCTX, I_WMOD, I_BMOD, I_GMIX, I_GFFN, I_WIN, I_QG, I_KG, I_LCW, I_LCB, I_LGW, I_LGB, I_LLAM, I_HCW, I_HCB, I_HW1, I_HB1, I_HW2, I_HB2, I_HW3, I_HFREQ, I_HDEC, I_HBIAS,
       I_OUTG, I_WOUT, I_RW, I_RB, I_MW1, I_MB1, I_MW2, I_MB2 };

__global__ void __launch_bounds__(NTHR, 2) mk_fwd(Args args) {
    extern __shared__ __attribute__((aligned(16))) unsigned char lds[];
    Frame F;
    F.lds = (LAS unsigned char*)lds; F.ws = args.ws; F.ctl = (unsigned*)(args.ws + WS_CTL);
    F.tid = threadIdx.x; F.lane = F.tid & 63; F.wave = __builtin_amdgcn_readfirstlane(F.tid >> 6);
    F.G = gridDim.x; { const int bx = blockIdx.x; F.vcu = (F.G % 8 == 0) ? (bx % 8) * (F.G / 8) + bx / 8 : bx; }
    F.gw = (int)blockIdx.x * NWAVES + F.wave; F.ngw = F.G * NWAVES;
    for (int u = F.tid; u < (LDS_BYTES - LDSCTL_OFF) / 4; u += NTHR) ((LAS unsigned*)(F.lds + LDSCTL_OFF))[u] = 0u;
    __syncthreads();
#if !MK_PER_PHASE
    XcdBarrier bar = xcd_barrier_post(F.ctl + CW_BAR, (volatile LAS unsigned*)(F.lds + LDSCTL_OFF + 32));
#define GRID_BAR() xcd_barrier(bar)
#else
#define GRID_BAR() do { } while (0)
#endif
    const int lo = args.ph_lo, hi = args.ph_hi;
#ifndef ONLY_PHASE
#define ONLY_PHASE (-1)
#endif
#define ENABLED(id) (ONLY_PHASE < 0 || ONLY_PHASE == (id))
#define IN(k) (ENABLED(k) && lo <= (k) && (k) < hi)
#define INL(j) (ENABLED(NPH_PRO + (j)) && lo <= pb + (j) && pb + (j) < hi)
#define SEAML(j) do { if (lo <= pb + (j) && pb + (j) + 1 < hi) { GRID_BAR(); } } while (0)
typedef const __attribute__((address_space(4))) Args* KArgs;
#ifndef REP_MASK
#define REP_MASK 0
#endif
#define NREP(j) (((REP_MASK >> (j)) & 1) ? 2 : 1)
#define REFRAME() Frame Fp = F; KArgs ka = (KArgs)__builtin_amdgcn_kernarg_segment_ptr(); { int t_ = F.tid; asm volatile("" : "+v"(t_), "+s"(ka)); Fp.tid = t_; Fp.lane = t_ & 63; Fp.wave = __builtin_amdgcn_readfirstlane(t_ >> 6); \
    Fp.gw = (int)blockIdx.x * NWAVES + Fp.wave; Fp.ws = ka->ws; Fp.ctl = (unsigned*)(ka->ws + WS_CTL); }
#define SEAM(k) do { if (lo <= (k) && (k) + 1 < hi) { GRID_BAR(); } } while (0)

    if (IN(0)) ph_prologue_a(F, args.in[I_C], args.in[I_CCTX], args.in[I_WMOD], args.in[I_BMOD], args.in[I_WIN], args.in[I_WOUT], args.in[I_MW1], args.in[I_MW2],
                             args.in[I_HW1], args.in[I_HB1], args.in[I_HW2], args.in[I_HB2], args.in[I_HFREQ], args.in[I_LGW], args.in[I_LLAM]);
    SEAM(0);
    if (IN(1)) ph_prologue_b(F, args.in[I_HW3], args.in[I_HDEC], args.in[I_GFFN], args.in[I_RW], args.in[I_RB]);
    SEAM(1);

#define PHASE(j, ...) if (INL(j)) { _Pragma("unroll") for (int rep_ = 0; rep_ < NREP(j); ++rep_) { { REFRAME(); __VA_ARGS__ } if (rep_ + 1 < NREP(j)) GRID_BAR(); } }
#define LAYER_BODY(l) { \
        const int pb = NPH_PRO + l * NPH_LAYER; \
        const int nrows = (l == 0) ? MT : NLAT; \
        if (l == 0) { PHASE(0, ph_norm_mod(Fp, l, ka->in[I_X], ka->in[I_CTX], ka->in[I_GMIX]);) SEAML(0); } \
        PHASE(1, \
            pg8::Gemm g{(const bf16*)(Fp.ws + WS_H), (const bf16*)(Fp.ws + WS_WINT) + (size_t)l * 2048 * 1024, MT, 2048, 1024}; \
            pg8::StaticOrder S; S.init(MT, 2048, Fp.G, (int)blockIdx.x); \
            pg8::EpiBf16<0> E{(bf16*)(Fp.ws + WS_U), 2048, nullptr, 0, 0, 1.f}; \
            pg8::gemm_phase<pg8::EpiBf16<0>, pg8::StaticOrder, PG8_ALIGN, PG8_SP2>(Fp.lds + RING_OFF, g, S, E);) \
        SEAML(1); \
        PHASE(2, ph_post_proj(Fp, l, ka->in[I_QG], ka->in[I_KG], ka->in[I_LCW], ka->in[I_LCB], ka->in[I_HCW], ka->in[I_HCB]);) \
        SEAML(2); \
        PHASE(3, \
            int kg_ = 256; asm volatile("" : "+s"(kg_)); \
            pg8::Gemm g{(const bf16*)(Fp.ws + WS_XL), (const bf16*)(Fp.ws + WS_WGT) + (size_t)l * 1024 * 256, MT, 1024, kg_}; \
            pg8::StaticOrder S; S.init(MT, 1024, Fp.G, (int)blockIdx.x); \
            pg8::EpiLruGate E{(const bf16*)(Fp.ws + WS_XL), (bf16*)(Fp.ws + WS_LAB), LAB_STRIDE, ka->in[I_LGB] + (size_t)l * 1024, (const float*)(Fp.ws + WS_SPT) + l * 512}; \
            pg8::gemm_phase<pg8::EpiLruGate, pg8::StaticOrder, PG8_ALIGN, PG8_SP2>(Fp.lds + RING_OFF, g, S, E);) \
        SEAML(3); \
        PHASE(4, \
            ph_scan1(Fp); __syncthreads(); \
            const attn_body::AttnTensors AT{(const attn_body::bf16*)(Fp.ws + WS_Q), (const attn_body::bf16*)(Fp.ws + WS_K), (const attn_body::bf16*)(Fp.ws + WS_V), (attn_body::bf16*)(Fp.ws + WS_ATT)}; \
            attn_body::attn_phase<8>((char*)lds + RING_OFF, AT, Fp.G, Fp.vcu, l == 0, (long)NLAT);) \
        SEAML(4); \
        PHASE(5, ph_scan2(Fp); __syncthreads(); ph_hyena_fft(Fp, l, ka->in[I_HBIAS]); if (l == 0) ph_hyena_ctx(Fp, ka->in[I_HBIAS], ka->in[I_HCW], ka->in[I_HCB]);) \
        SEAML(5); \
        PHASE(6, ph_merge(Fp, l, nrows, ka->in[I_OUTG]);) \
        SEAML(6); \
        if (INL(7)) { REFRAME(); \
            pg8::Gemm g{(const bf16*)(Fp.ws + WS_MIXA), (const bf16*)(Fp.ws + WS_WOUTT) + (size_t)l * 1024 * 1024, nrows, 1024, 1024}; \
            pg8::StaticOrder S; S.init(nrows, 1024, Fp.G, (int)blockIdx.x); \
            float* XR = (float*)(Fp.ws + WS_XR); \
            pg8::EpiResid E{(l == 0) ? ka->in[I_X] : (const float*)XR, (l == 0) ? ka->in[I_CTX] : (const float*)(XR + (size_t)NLAT * 1024), NLAT, XR, 1024, \
                            (const float*)(Fp.ws + WS_MOD) + (size_t)(l * 5) * 6144 + 2 * 1024, 6144, SEQ}; \
            pg8::gemm_phase<pg8::EpiResid, pg8::StaticOrder, PG8_ALIGN, PG8_SP2>(Fp.lds + RING_OFF, g, S, E); \
        } \
        SEAML(7); \
        PHASE(8, ph_ffn_router(Fp, l, nrows, ka->in[I_RW]);) \
        SEAML(8); \
        PHASE(9, ph_route(Fp, nrows);) \
        SEAML(9); \
        if (INL(10) || INL(11)) { REFRAME(); \
            LAS int* tab = (LAS int*)(Fp.lds + MOETAB_OFF); \
            const int ntiles = (int)__hip_atomic_load(Fp.ctl + CW_NTILES, __ATOMIC_RELAXED, __HIP_MEMORY_SCOPE_AGENT); \
            const int* TILEE = (const int*)(Fp.ws + WS_TILEE); \
            for (int i = Fp.tid; i < ntiles && i < SORT_TILES; i += NTHR) tab[i] = TILEE[i]; \
            __syncthreads(); \
            if (INL(10)) { _Pragma("unroll") for (int rep_ = 0; rep_ < NREP(10); ++rep_) { { \
                pg8::Gemm g{(const bf16*)(Fp.ws + WS_ASORT), (const bf16*)(Fp.ws + WS_W1T) + (size_t)l * 32 * 2048 * 1024, 0, 2048, 1024}; \
                pg8::MoeOrder S; S.init(tab, ntiles, 8, Fp.G, (int)blockIdx.x); \
                pg8::EpiSwiglu E{(bf16*)(Fp.ws + WS_ACT), 1024, ka->in[I_MB1] + (size_t)l * 32 * 2048, 2048}; \
                pg8::gemm_phase<pg8::EpiSwiglu, pg8::MoeOrder, PG8_ALIGN, PG8_SP2>(Fp.lds + RING_OFF, g, S, E); \
             } if (rep_ + 1 < NREP(10)) GRID_BAR(); } } \
            SEAML(10); \
            if (INL(11)) { _Pragma("unroll") for (int rep_ = 0; rep_ < NREP(11); ++rep_) { { \
                pg8::Gemm g{(const bf16*)(Fp.ws + WS_ACT), (const bf16*)(Fp.ws + WS_W2T) + (size_t)l * 32 * 1024 * 1024, 0, 1024, 1024}; \
                pg8::MoeOrder S; S.init(tab, ntiles, 4, Fp.G, (int)blockIdx.x); \
                pg8::EpiBf16Bias E{(bf16*)(Fp.ws + WS_YS), 1024, ka->in[I_MB2] + (size_t)l * 32 * 1024, 1024}; \
                pg8::gemm_phase<pg8::EpiBf16Bias, pg8::MoeOrder, PG8_ALIGN, PG8_SP2>(Fp.lds + RING_OFF, g, S, E); \
             } if (rep_ + 1 < NREP(11)) GRID_BAR(); } } \
        } \
        SEAML(11); \
        if (INL(12)) { REFRAME(); ph_combine(Fp, l, nrows, ka->out, ka->in[I_GMIX]); } \
        if (l == 0) { SEAML(12); } \
    }
    LAYER_BODY(0)
    LAYER_BODY(1)
#undef LAYER_BODY
#undef PHASE
#undef IN
#undef SEAM
#undef INL
#undef SEAML
}

extern "C" void kernel_launch(void* const* d_in, const int* in_sizes, int n_in, void* d_out, int out_size, void* d_ws, size_t ws_size, hipStream_t stream) {
    static int grid = 0;
    if (grid == 0) {
        if (n_in != 34 || in_sizes[0] != NLAT * DMODEL || out_size != NLAT * DMODEL || ws_size < WS_END) {
            fprintf(stderr, "kernel_launch: unexpected shapes (n_in %d, in0 %d, out %d, ws %zu); nothing launched\n", n_in, n_in > 0 ? in_sizes[0] : -1, out_size, ws_size); grid = -1; return; }
        int dev = 0, cus = 0;
        if (hipGetDevice(&dev) != hipSuccess || hipDeviceGetAttribute(&cus, hipDeviceAttributeMultiprocessorCount, dev) != hipSuccess) { grid = -1; return; }
        if (hipFuncSetAttribute((const void*)mk_fwd, hipFuncAttributeMaxDynamicSharedMemorySize, LDS_BYTES) != hipSuccess) { fprintf(stderr, "kernel_launch: hipFuncSetAttribute failed\n"); grid = -1; return; }
        int per_cu = 0;
        if (hipOccupancyMaxActiveBlocksPerMultiprocessor(&per_cu, (const void*)mk_fwd, NTHR, LDS_BYTES) != hipSuccess || per_cu < 1) { fprintf(stderr, "kernel_launch: occupancy query says %d\n", per_cu); }
        (void)hipGetLastError();
        grid = cus;
    }
    if (grid < 0) return;
    if (hipMemsetAsync((char*)d_ws + WS_CTL, 0, CTL_ZERO_BYTES, stream) != hipSuccess) return;
    Args a{};
    for (int i = 0; i < 34; ++i) a.in[i] = (const float*)d_in[i];
    a.out = (float*)d_out; a.ws = (unsigned char*)d_ws;
#if MK_PER_PHASE
    for (int p = 0; p < NPH; ++p) { a.ph_lo = p; a.ph_hi = p + 1; hipLaunchKernelGGL(mk_fwd, dim3(grid), dim3(NTHR), LDS_BYTES, stream, a); }
#else
    a.ph_lo = 0; a.ph_hi = NPH;
    hipLaunchKernelGGL(mk_fwd, dim3(grid), dim3(NTHR), LDS_BYTES, stream, a);
#endif
}
```

```cpp
#include <hip/hip_runtime.h>
#include <hip/hip_bf16.h>
#include <cstdio>
#include <cstdint>
#include <cmath>
#ifndef MK_PER_PHASE
#define MK_PER_PHASE 0
#endif
namespace pg8 {
#define PG8_LAS __attribute__((address_space(3)))
typedef unsigned short bf16_t;
typedef short bf16x8 __attribute__((ext_vector_type(8)));
typedef float f32x4 __attribute__((ext_vector_type(4)));
typedef unsigned u32x4 __attribute__((ext_vector_type(4)));
constexpr int BM = 256, BK = 64, HALF = 128, HTB = HALF * BK * 2  , STAGE_BYTES = 8 * HTB, NXCD = 8, WGM = 8;

__host__ __device__ __forceinline__ int lds_byte(int r, int c) { const int st = (r >> 4) * 2 + (c >> 5), rr = r & 15, cc = c & 31, ob = rr * 64 + cc * 2; return st * 1024 + (ob ^ (((ob >> 9) & 1) << 5)); }
__host__ __device__ __forceinline__ void stage_rc(int b, int& R, int& C) { const int st = b / 1024, sb = b % 1024, swz = sb ^ (((sb >> 9) & 1) << 5); R = (st >> 1) * 16 + swz / 64; C = (st & 1) * 32 + (swz % 64) / 2; }
__host__ __device__ __forceinline__ int perm32(int rho) { const int n = rho >> 4, i = rho & 15; return 8 * (i >> 2) + 4 * n + (i & 3); }

struct Unit { int pm, pn, be, e; };
struct Gemm { const bf16_t* A; const bf16_t* Bt; int M, N, K; };

struct StaticOrder {
    int nM, nN, nwg, G, c;
    __host__ __device__ void init(int M, int N, int G_, int c_) { nM = M / BM; nN = N / BM; nwg = nM * nN; G = G_; c = c_; }
    __host__ __device__ bool next(int i, Unit& u) const {
        const long L = (long)i * G + c; if (L >= nwg) return false;
        int wgid = (int)L; { const int q = nwg / NXCD, r = nwg % NXCD, xcd = wgid % NXCD, off = wgid / NXCD; wgid = (xcd < r ? xcd * (q + 1) : r * (q + 1) + (xcd - r) * q) + off; }
        const int nig = WGM * nN, gid = wgid / nig, fm = gid * WGM, gsz = (nM - fm) < WGM ? (nM - fm) : WGM;
        u.pm = fm + ((wgid % nig) % gsz); u.pn = (wgid % nig) / gsz; u.be = u.pn; u.e = 0; return true;
    }
    __device__ __forceinline__ void a_ready(const Unit&) const {}
    __device__ __forceinline__ void done(const Unit&) const {}
};

__device__ __forceinline__ unsigned cvt_pk_bf16(float lo, float hi) { unsigned r; asm volatile("v_cvt_pk_bf16_f32 %0, %1, %2" : "=v"(r) : "v"(lo), "v"(hi)); return r; }
typedef float f32x2 __attribute__((ext_vector_type(2)));
__device__ __forceinline__ f32x2 gelu_pk(f32x2 v) {
    const f32x2 av = __builtin_elementwise_abs(v), d = av * 0.2316418882f + 1.0f;
    f32x2 t; t.x = __builtin_amdgcn_rcpf(d.x); t.y = __builtin_amdgcn_rcpf(d.y);
    f32x2 q = t * 0.5307027145f + (-0.7265760135f); q = q * t + 0.7107068705f; q = q * t + (-0.142248368f); q = q * t + 0.127414796f; q = q * t;
    const f32x2 s = (v * v) * (-0.72134752044f);
    f32x2 e; e.x = __builtin_amdgcn_exp2f(s.x); e.y = __builtin_amdgcn_exp2f(s.y);
    const f32x2 m = v * (q * e), r = v - m;
    f32x2 o; o.x = v.x < 0.f ? m.x : r.x; o.y = v.y < 0.f ? m.y : r.y; return o;
}

template <int ACT  > struct EpiBf16 {
    static constexpr bool PERM = true, AFTER_DRAIN = false; static_assert(ACT == 0 || ACT == 1, "EpiBf16: ACT is 0 (none) or 1 (gelu_pk)");
    bf16_t* O; int ldc; const float* bias; int split_cols; size_t split_stride; float scale0;
    __device__ __forceinline__ void operator()(const f32x4 (&acc)[2][2][4][2], const Unit& u, int wr, int wc, int fr, int fq) const {
        const int row0 = u.pm * BM + wr * 64 + fr; int colt = u.pn * BM; bf16_t* base = O;
        float sc = 1.f; if (split_cols) { const int t = colt / split_cols; base += (size_t)t * split_stride; colt -= t * split_cols; if (t == 0) sc = scale0; }
        const int col0 = colt + wc * 32 + 8 * fq, bcol0 = u.pn * BM + wc * 32 + 8 * fq;
        f32x4 bv[2][2];
#pragma unroll
        for (int bj = 0; bj < 2; ++bj)
#pragma unroll
            for (int n = 0; n < 2; ++n) bv[bj][n] = bias ? *(const f32x4*)(bias + bcol0 + bj * HALF + 4 * n) : (f32x4){0.f, 0.f, 0.f, 0.f};
#pragma unroll
        for (int ai = 0; ai < 2; ++ai)
#pragma unroll
            for (int m = 0; m < 4; ++m) { bf16_t* rowp = base + (size_t)(row0 + ai * HALF + m * 16) * ldc + col0;
#pragma unroll
                for (int bj = 0; bj < 2; ++bj) { f32x4 v0 = acc[ai][bj][m][0] + bv[bj][0], v1 = acc[ai][bj][m][1] + bv[bj][1];
                    if (ACT == 1) { f32x2 a = gelu_pk((f32x2){v0[0], v0[1]}), b = gelu_pk((f32x2){v0[2], v0[3]}), c = gelu_pk((f32x2){v1[0], v1[1]}), d = gelu_pk((f32x2){v1[2], v1[3]});
                        v0 = (f32x4){a.x, a.y, b.x, b.y}; v1 = (f32x4){c.x, c.y, d.x, d.y}; }
                    v0 = v0 * sc; v1 = v1 * sc; u32x4 w; w.x = cvt_pk_bf16(v0[0], v0[1]); w.y = cvt_pk_bf16(v0[2], v0[3]); w.z = cvt_pk_bf16(v1[0], v1[1]); w.w = cvt_pk_bf16(v1[2], v1[3]);
                    *(u32x4*)(rowp + bj * HALF) = w; } }
    }
};


template <bool XIN_BF16> struct EpiResid {
    static constexpr bool PERM = false, AFTER_DRAIN = false;
    const float* xin_lat; const float* xin_ctx; int nlat; bf16_t* XR; int ldc; const float* mod; int mod_stride; int seq; float* rssp;
    __device__ __forceinline__ void operator()(const f32x4 (&acc)[2][2][4][2], const Unit& u, int wr, int wc, int fr, int fq) const {
        typedef unsigned u32x2 __attribute__((ext_vector_type(2)));
        const int row0 = u.pm * BM + wr * 64 + fr, col0 = u.pn * BM + wc * 32 + 4 * fq;
        const int rowt = u.pm * BM; const int bidx = rowt < nlat ? rowt / seq : 4;
        const float* gate = mod + (size_t)bidx * mod_stride;
        const float* xin = rowt < nlat ? xin_lat : (xin_ctx - (size_t)nlat * ldc);
        f32x4 gv[2][2];
#pragma unroll
        for (int bj = 0; bj < 2; ++bj)
#pragma unroll
            for (int n = 0; n < 2; ++n) gv[bj][n] = *(const f32x4*)(gate + col0 + bj * HALF + n * 16);
#pragma unroll
        for (int ai = 0; ai < 2; ++ai)
#pragma unroll
            for (int m = 0; m < 4; ++m) { const int row = row0 + ai * HALF + m * 16; const size_t ro = (size_t)row * ldc + col0; float s2 = 0.f;
#pragma unroll
                for (int bj = 0; bj < 2; ++bj)
#pragma unroll
                    for (int n = 0; n < 2; ++n) { const size_t idx = ro + bj * HALF + n * 16; f32x4 xv;
                        if (XIN_BF16) { const u32x2 w = *(const u32x2*)(XR + idx); xv = (f32x4){__builtin_bit_cast(float, w.x << 16), __builtin_bit_cast(float, w.x & 0xffff0000u), __builtin_bit_cast(float, w.y << 16), __builtin_bit_cast(float, w.y & 0xffff0000u)}; }
                        else xv = *(const f32x4*)(xin + idx);
                        const f32x4 v = xv + gv[bj][n] * acc[ai][bj][m][n];
                        s2 += (v[0] * v[0] + v[1] * v[1]) + (v[2] * v[2] + v[3] * v[3]);
                        u32x2 o; o.x = cvt_pk_bf16(v[0], v[1]); o.y = cvt_pk_bf16(v[2], v[3]); *(u32x2*)(XR + idx) = o; }
                s2 += __shfl_xor(s2, 16); s2 += __shfl_xor(s2, 32);
                if (fq == 0) rssp[(size_t)row * 16 + u.pn * 4 + wc] = s2; }
    }
};
struct EpiSwiglu {
    static constexpr bool PERM = true, AFTER_DRAIN = false;
    bf16_t* O; int ldc; const float* bias; int bias_stride;
    __device__ __forceinline__ void operator()(const f32x4 (&acc)[2][2][4][2], const Unit& u, int wr, int wc, int fr, int fq) const {
        const int row0 = u.pm * BM + wr * 64 + fr; const int bcol0 = u.pn * BM + wc * 32 + 8 * fq; const int ocol0 = bcol0 >> 1;
        const float* bb = bias + (size_t)u.e * bias_stride;
        f32x4 bv[2][2];
#pragma unroll
        for (int bj = 0; bj < 2; ++bj)
#pragma unroll
            for (int n = 0; n < 2; ++n) bv[bj][n] = *(const f32x4*)(bb + bcol0 + bj * HALF + 4 * n);
#pragma unroll
        for (int ai = 0; ai < 2; ++ai)
#pragma unroll
            for (int m = 0; m < 4; ++m) { bf16_t* rowp = O + (size_t)(row0 + ai * HALF + m * 16) * ldc + ocol0;
#pragma unroll
                for (int bj = 0; bj < 2; ++bj) { const f32x4 v0 = acc[ai][bj][m][0] + bv[bj][0], v1 = acc[ai][bj][m][1] + bv[bj][1];
                    float o[4];
#pragma unroll
                    for (int p = 0; p < 4; ++p) { const float hg = p < 2 ? v0[2 * p] : v1[2 * p - 4], hl = p < 2 ? v0[2 * p + 1] : v1[2 * p - 3];
                        const float glu = fminf(hg, 7.0f), lin = fminf(fmaxf(hl, -7.0f), 7.0f);
                        const float sg = __builtin_amdgcn_rcpf(1.0f + __builtin_amdgcn_exp2f(-1.702f * 1.4426950408889634f * glu));
                        o[p] = glu * sg * (lin + 1.0f); }
                    typedef unsigned u32x2 __attribute__((ext_vector_type(2)));
                    u32x2 w; w.x = cvt_pk_bf16(o[0], o[1]); w.y = cvt_pk_bf16(o[2], o[3]);
                    *(u32x2*)(rowp + bj * (HALF / 2)) = w; } }
    }
};
struct EpiBf16Bias {
    static constexpr bool PERM = true, AFTER_DRAIN = false;
    bf16_t* O; int ldc; const float* bias; int bias_stride;
    __device__ __forceinline__ void operator()(const f32x4 (&acc)[2][2][4][2], const Unit& u, int wr, int wc, int fr, int fq) const {
        const int row0 = u.pm * BM + wr * 64 + fr; const int col0 = u.pn * BM + wc * 32 + 8 * fq;
        const float* bb = bias + (size_t)u.e * bias_stride;
        f32x4 bv[2][2];
#pragma unroll
        for (int bj = 0; bj < 2; ++bj)
#pragma unroll
            for (int n = 0; n < 2; ++n) bv[bj][n] = *(const f32x4*)(bb + col0 + bj * HALF + 4 * n);
#pragma unroll
        for (int ai = 0; ai < 2; ++ai)
#pragma unroll
            for (int m = 0; m < 4; ++m) { bf16_t* rowp = O + (size_t)(row0 + ai * HALF + m * 16) * ldc + col0;
#pragma unroll
                for (int bj = 0; bj < 2; ++bj) { const f32x4 v0 = acc[ai][bj][m][0] + bv[bj][0], v1 = acc[ai][bj][m][1] + bv[bj][1];
                    u32x4 w; w.x = cvt_pk_bf16(v0[0], v0[1]); w.y = cvt_pk_bf16(v0[2], v0[3]); w.z = cvt_pk_bf16(v1[0], v1[1]); w.w = cvt_pk_bf16(v1[2], v1[3]);
                    *(u32x4*)(rowp + bj * HALF) = w; } }
    }
};
struct EpiLruGate {
    static constexpr bool PERM = false, AFTER_DRAIN = false;
    const bf16_t* XL; bf16_t* LAB; size_t lab_stride; const float* gb; const float* spt;
    __device__ __forceinline__ void operator()(const f32x4 (&acc)[2][2][4][2], const Unit& u, int wr, int wc, int fr, int fq) const {
        const int d = u.pn >> 1, half = u.pn & 1;
        const int row0 = u.pm * BM + wr * 64 + fr, ch0 = half * 128 + wc * 32 + 4 * fq;
        bf16_t* LA = LAB + (size_t)(2 * d) * lab_stride; bf16_t* LB = LAB + (size_t)(2 * d + 1) * lab_stride;
#pragma unroll
        for (int n = 0; n < 2; ++n) {
            const f32x4 bR = *(const f32x4*)(gb + (d * 2 + 0) * 256 + ch0 + 16 * n), bI = *(const f32x4*)(gb + (d * 2 + 1) * 256 + ch0 + 16 * n);
            const f32x4 sp = *(const f32x4*)(spt + d * 256 + ch0 + 16 * n) * (-8.0f * 1.4426950408889634f);
#pragma unroll
            for (int ai = 0; ai < 2; ++ai)
#pragma unroll
                for (int m = 0; m < 4; ++m) { const size_t ro = (size_t)(row0 + ai * HALF + m * 16) * 256 + ch0 + 16 * n;
                    typedef unsigned u32x2 __attribute__((ext_vector_type(2)));
                    const u32x2 xw = *(const u32x2*)(XL + ro);
                    const float xl[4] = {__builtin_bit_cast(float, xw.x << 16), __builtin_bit_cast(float, xw.x & 0xffff0000u), __builtin_bit_cast(float, xw.y << 16), __builtin_bit_cast(float, xw.y & 0xffff0000u)};
                    const f32x4 gr = acc[ai][0][m][n] + bR, gi = acc[ai][1][m][n] + bI;
                    f32x4 av, bv;
#pragma unroll
                    for (int e = 0; e < 4; ++e) {
                        const float rg = __builtin_amdgcn_rcpf(1.0f + __builtin_amdgcn_exp2f(-1.4426950408889634f * gr[e])), ig = __builtin_amdgcn_rcpf(1.0f + __builtin_amdgcn_exp2f(-1.4426950408889634f * gi[e]));
                        const float la2 = rg * sp[e];
                        const float a2 = __builtin_amdgcn_exp2f(2.0f * la2);
                        av[e] = la2; bv[e] = __builtin_amdgcn_sqrtf(fmaxf(1.0f - a2, 0.f)) * (ig * xl[e]); }
                    u32x2 wa, wb; wa.x = cvt_pk_bf16(av[0], av[1]); wa.y = cvt_pk_bf16(av[2], av[3]); wb.x = cvt_pk_bf16(bv[0], bv[1]); wb.y = cvt_pk_bf16(bv[2], bv[3]);
                    *(u32x2*)(LA + ro) = wa; *(u32x2*)(LB + ro) = wb; }
        }
    }
};
struct MoeOrder {
    const PG8_LAS int* tab; int ntiles, nN, nper, j, m_lo, nMx;
    __device__ __forceinline__ void init(const PG8_LAS int* tab_, int ntiles_, int nN_, int G, int bx) {
        tab = tab_; ntiles = ntiles_; nN = nN_;
        if (G % 8 == 0) { const int x = bx % 8; nper = G / 8; j = bx / 8; m_lo = (x * ntiles) / 8; nMx = ((x + 1) * ntiles) / 8 - m_lo; }
        else { nper = G; j = bx; m_lo = 0; nMx = ntiles; }
    }
    __device__ __forceinline__ bool next(int i, Unit& u) const {
        const int s = i * nper + j; if (s >= nMx * nN) return false;
        const int nig = 8 * nN, gid = s / nig, fm = gid * 8, gsz = (nMx - fm) < 8 ? (nMx - fm) : 8, w = s - gid * nig;
        u.pm = m_lo + fm + (w % gsz); u.pn = w / gsz; u.e = tab[u.pm]; u.be = u.e * nN + u.pn; return true;
    }
    __device__ __forceinline__ void a_ready(const Unit&) const {}
    __device__ __forceinline__ void done(const Unit&) const {}
};
template <class Epi, class Sched, bool ALIGN_EPI = false, bool SP2 = false>
__device__ __forceinline__ void gemm_phase(PG8_LAS unsigned char* lds, const Gemm g, const Sched& S, const Epi& E) {
    int tid_ = threadIdx.x; asm volatile("" : "+v"(tid_));
    const int tid = tid_, wid = __builtin_amdgcn_readfirstlane(tid >> 6), lane = tid & 63, wr = wid >> 2, wc = wid & 3, fr = lane & 15, fq = lane >> 4;
    const int K = g.K, nt = K / BK;
    unsigned voffA[2], voffB[2];
#pragma unroll
    for (int i = 0; i < 2; ++i) { int R, C; stage_rc(tid * 16 + i * 8192, R, C); const int Rb = Epi::PERM ? ((R & ~31) + perm32(R & 31)) : R;
        voffA[i] = (unsigned)(R * K + C) * 2u; voffB[i] = (unsigned)(Rb * K + C) * 2u; }
    const size_t kstep = (size_t)(BK * 2);
    const size_t hstep = (size_t)HALF * K * 2;
    const size_t tstep = 2 * hstep;
    const unsigned ldsw = (unsigned)wid * 1024u;
    const int aoff = lds_byte(wr * 64 + fr, fq * 8), boff = lds_byte(wc * 32 + fr, fq * 8);
#define PG8_SA(b, h) (((b) * 2 + (h)) * HTB)
#define PG8_SB(b, h) ((4 + (b) * 2 + (h)) * HTB)
#define PG8_STAGE(bufoff, gbase, voff) do { _Pragma("unroll") for (int _i = 0; _i < 2; ++_i) \
        __builtin_amdgcn_global_load_lds((const unsigned*)((const char*)(gbase) + (voff)[_i]), (PG8_LAS unsigned*)(lds + (bufoff) + ldsw + _i * 8192), 16, 0, 0); } while (0)
#define PG8_LDA(dst, b, h) do { _Pragma("unroll") for (int m = 0; m < 4; ++m) _Pragma("unroll") for (int k = 0; k < 2; ++k) dst[m][k] = *(const PG8_LAS bf16x8*)(lds + PG8_SA(b, h) + aoff + m * 2048 + k * 1024); } while (0)
#define PG8_LDB(dst, b, h) do { _Pragma("unroll") for (int n = 0; n < 2; ++n) _Pragma("unroll") for (int k = 0; k < 2; ++k) dst[n][k] = *(const PG8_LAS bf16x8*)(lds + PG8_SB(b, h) + boff + n * 2048 + k * 1024); } while (0)
#define PG8_MMA(ai, bj, At, Bt) do { __builtin_amdgcn_s_setprio(1); _Pragma("unroll") for (int m = 0; m < 4; ++m) _Pragma("unroll") for (int n = 0; n < 2; ++n) _Pragma("unroll") for (int k = 0; k < 2; ++k) \
        acc[ai][bj][m][n] = __builtin_amdgcn_mfma_f32_16x16x32_bf16(Bt[n][k], At[m][k], acc[ai][bj][m][n], 0, 0, 0); __builtin_amdgcn_s_setprio(0); } while (0)
#define PG8_WAIT_V(n) asm volatile("s_waitcnt vmcnt(" #n ")" ::: "memory")
#define PG8_WAIT_L(n) asm volatile("s_waitcnt lgkmcnt(" #n ")" ::: "memory")
#define PG8_BAR __builtin_amdgcn_s_barrier()
#define PG8_SCHED __builtin_amdgcn_sched_barrier(0)
    Unit cur, nxt; int ui = 0;
    if (!S.next(0, cur)) return;
    f32x4 acc[2][2][4][2];
#pragma unroll
    for (int a = 0; a < 2; ++a)
#pragma unroll
        for (int b = 0; b < 2; ++b)
#pragma unroll
            for (int m = 0; m < 4; ++m)
#pragma unroll
                for (int n = 0; n < 2; ++n) acc[a][b][m][n] = (f32x4){0.f, 0.f, 0.f, 0.f};
    bf16x8 At[4][2], B0[2][2], B1[2][2];
    const char* cA = (const char*)g.A + (size_t)cur.pm * tstep; const char* cB = (const char*)g.Bt + (size_t)cur.be * tstep;
    S.a_ready(cur);
    if constexpr (SP2) {
        PG8_STAGE(PG8_SB(0, 0), cB, voffB); PG8_STAGE(PG8_SB(0, 1), cB + hstep, voffB); PG8_STAGE(PG8_SA(0, 0), cA, voffA); PG8_STAGE(PG8_SA(0, 1), cA + hstep, voffA);
        if (wr == 1) PG8_BAR;
        PG8_WAIT_V(2); PG8_BAR;
        PG8_STAGE(PG8_SB(1, 0), cB + kstep, voffB); PG8_STAGE(PG8_SA(1, 0), cA + kstep, voffA); PG8_STAGE(PG8_SB(1, 1), cB + hstep + kstep, voffB);
        PG8_WAIT_V(6); PG8_BAR;
    } else {
        PG8_STAGE(PG8_SB(0, 0), cB, voffB); PG8_STAGE(PG8_SA(0, 0), cA, voffA); PG8_STAGE(PG8_SB(0, 1), cB + hstep, voffB); PG8_STAGE(PG8_SA(0, 1), cA + hstep, voffA);
        if (wr == 1) PG8_BAR;
        PG8_WAIT_V(4); PG8_BAR;
        PG8_STAGE(PG8_SB(1, 0), cB + kstep, voffB); PG8_STAGE(PG8_SA(1, 0), cA + kstep, voffA); PG8_STAGE(PG8_SB(1, 1), cB + hstep + kstep, voffB);
        PG8_WAIT_V(6); PG8_BAR;
    }
    for (;;) {
        const bool has_next = S.next(ui + 1, nxt);
        const char* nA = has_next ? (const char*)g.A + (size_t)nxt.pm * tstep : cA; const char* nB = has_next ? (const char*)g.Bt + (size_t)nxt.be * tstep : cB;
        for (int t = 0; t < nt; t += 2) {
            const bool last = (t == nt - 2);
            const char* a1 = cA + (size_t)(t + 1) * kstep;
            const char* a2 = last ? nA : cA + (size_t)(t + 2) * kstep; const char* b2 = last ? nB : cB + (size_t)(t + 2) * kstep;
            const char* a3 = a2 + kstep; const char* b3 = b2 + kstep;
            if (last && has_next) S.a_ready(nxt);
            if constexpr (SP2) {
            PG8_LDB(B0, 0, 0); PG8_LDB(B1, 0, 1); PG8_SCHED; PG8_LDA(At, 0, 0); PG8_STAGE(PG8_SA(1, 1), a1 + hstep, voffA);
            PG8_WAIT_V(8); PG8_WAIT_L(0); PG8_BAR; PG8_MMA(0, 0, At, B0); PG8_MMA(0, 1, At, B1); PG8_BAR; PG8_SCHED;
            PG8_LDA(At, 0, 1); PG8_STAGE(PG8_SB(0, 0), b2, voffB); PG8_STAGE(PG8_SB(0, 1), b2 + hstep, voffB); PG8_STAGE(PG8_SA(0, 0), a2, voffA);
            PG8_WAIT_V(8); PG8_WAIT_L(0); PG8_BAR; PG8_MMA(1, 0, At, B0); PG8_MMA(1, 1, At, B1); PG8_BAR; PG8_SCHED;
            PG8_LDB(B0, 1, 0); PG8_LDB(B1, 1, 1); PG8_SCHED; PG8_LDA(At, 1, 0); PG8_STAGE(PG8_SA(0, 1), a2 + hstep, voffA);
            PG8_WAIT_V(8); PG8_WAIT_L(0); PG8_BAR; PG8_MMA(0, 0, At, B0); PG8_MMA(0, 1, At, B1); PG8_BAR; PG8_SCHED;
            PG8_LDA(At, 1, 1); PG8_STAGE(PG8_SB(1, 0), b3, voffB); PG8_STAGE(PG8_SB(1, 1), b3 + hstep, voffB); PG8_STAGE(PG8_SA(1, 0), a3, voffA);
            PG8_WAIT_V(8); PG8_WAIT_L(0); PG8_BAR; PG8_MMA(1, 0, At, B0); PG8_MMA(1, 1, At, B1); PG8_BAR; PG8_SCHED;
            } else {
            PG8_LDB(B0, 0, 0); PG8_SCHED; PG8_LDA(At, 0, 0); PG8_STAGE(PG8_SA(1, 1), a1 + hstep, voffA);
            PG8_WAIT_L(8); PG8_BAR; PG8_WAIT_L(0); PG8_MMA(0, 0, At, B0); PG8_BAR; PG8_SCHED;
            PG8_LDB(B1, 0, 1); PG8_STAGE(PG8_SB(0, 0), b2, voffB);
            PG8_BAR; PG8_WAIT_L(0); PG8_MMA(0, 1, At, B1); PG8_BAR;
            PG8_LDA(At, 0, 1); PG8_STAGE(PG8_SA(0, 0), a2, voffA);
            PG8_BAR; PG8_WAIT_L(0); PG8_MMA(1, 0, At, B0); PG8_BAR; PG8_SCHED;
            PG8_STAGE(PG8_SB(0, 1), b2 + hstep, voffB);
            PG8_WAIT_V(6); PG8_BAR; PG8_MMA(1, 1, At, B1); PG8_BAR;
            PG8_LDB(B0, 1, 0); PG8_SCHED; PG8_LDA(At, 1, 0); PG8_STAGE(PG8_SA(0, 1), a2 + hstep, voffA);
            PG8_WAIT_L(8); PG8_BAR; PG8_WAIT_L(0); PG8_MMA(0, 0, At, B0); PG8_BAR; PG8_SCHED;
            PG8_LDB(B1, 1, 1); PG8_STAGE(PG8_SB(1, 0), b3, voffB);
            PG8_BAR; PG8_WAIT_L(0); PG8_MMA(0, 1, At, B1); PG8_BAR;
            PG8_LDA(At, 1, 1); PG8_STAGE(PG8_SA(1, 0), a3, voffA);
            PG8_BAR; PG8_WAIT_L(0); PG8_MMA(1, 0, At, B0); PG8_BAR; PG8_SCHED;
            PG8_STAGE(PG8_SB(1, 1), b3 + hstep, voffB);
            PG8_WAIT_V(6); PG8_BAR; PG8_MMA(1, 1, At, B1); PG8_BAR;
            }
        }
        if constexpr (ALIGN_EPI) { if (wr == 0) PG8_BAR; }
        if constexpr (!Epi::AFTER_DRAIN) { E(acc, cur, wr, wc, fr, fq); S.done(cur); }
        if (!has_next) break;
#pragma unroll
        for (int a = 0; a < 2; ++a)
#pragma unroll
            for (int b = 0; b < 2; ++b)
#pragma unroll
                for (int m = 0; m < 4; ++m)
#pragma unroll
                    for (int n = 0; n < 2; ++n) acc[a][b][m][n] = (f32x4){0.f, 0.f, 0.f, 0.f};
        cur = nxt; cA = nA; cB = nB; ++ui;
        if constexpr (ALIGN_EPI) { if (wr == 1) PG8_BAR; }
    }
    PG8_WAIT_V(0);
    if constexpr (!ALIGN_EPI) { if (wr == 0) PG8_BAR; }
    PG8_BAR;
    if constexpr (Epi::AFTER_DRAIN) { E.fused(acc, cur, wr, wc, fr, fq, lds, wid, lane); S.done(cur); }
#undef PG8_SA
#undef PG8_SB
#undef PG8_STAGE
#undef PG8_LDA
#undef PG8_LDB
#undef PG8_MMA
#undef PG8_WAIT_V
#undef PG8_WAIT_L
#undef PG8_BAR
#undef PG8_SCHED
}
}

#ifndef PG8_SP2
#define PG8_SP2 true
#endif
#ifndef PG8_ALIGN
#define PG8_ALIGN true
#endif
#include <cmath>
namespace attn_body {
using bf16=__hip_bfloat16;
using bf16x8=__attribute__((ext_vector_type(8)))short;
using s16x4=__attribute__((ext_vector_type(4)))short;
using f32x16=__attribute__((ext_vector_type(16)))float;
using u32x4=__attribute__((ext_vector_type(4)))unsigned;
constexpr int NHEAD=8,SEQQ=8192,SEQK=8448,D=64,QP=512,KP=128;
constexpr int NW=8,QBLK=32,QB=QBLK*NW,KVBLK=64,NQB=SEQQ/QB;
constexpr int ATTN_UNIT_ROWS=QB;
__device__ __forceinline__ int crow(int r,int hi){return (r&3)+8*(r>>2)+4*hi;}
#define SBAR() __builtin_amdgcn_sched_barrier(0)
__device__ __forceinline__ void cmask(f32x16&p0,f32x16&p1,int jb,int qrel,int hi){
  const float NEG=-INFINITY; int kb=64*jb+4*hi;
  #pragma unroll
  for(int r=0;r<16;++r){int kv=kb+(r&3)+8*(r>>2); if(kv>qrel)p0[r]=NEG; if(kv+32>qrel)p1[r]=NEG;}
}

constexpr int NSLOT=3, SLOTB=8192;
constexpr int LDS_K=0, LDS_V=NSLOT*SLOTB, LDS_WS=2*NSLOT*SLOTB, LDS_OST=LDS_WS+NW*64*4, LDS_BYTES=LDS_OST+NW*4096;
constexpr float C2=0.125f*1.4426950408889634f;
__device__ __forceinline__ void glds16(const void*gsrc,unsigned lds_dst){unsigned keep;
  asm volatile("s_mov_b32 %0, m0\n\ts_mov_b32 m0, %2\n\ts_nop 0\n\tglobal_load_lds_dwordx4 %1, off\n\ts_mov_b32 m0, %0":"=&s"(keep):"v"(gsrc),"s"(lds_dst):"memory");}
__device__ __forceinline__ float max3f(float a,float b,float c){float r;asm("v_max3_f32 %0, %1, %2, %3":"=v"(r):"v"(a),"v"(b),"v"(c));return r;}
__device__ __forceinline__ float max2f(float a,float b){float r;asm("v_max_f32_e32 %0, %1, %2":"=v"(r):"v"(a),"v"(b));return r;}
__device__ __forceinline__ float fadd_s(float a,float b){float r;asm("v_add_f32_e32 %0, %1, %2":"=v"(r):"v"(a),"v"(b));return r;}
__device__ __forceinline__ float fsub_s(float a,float b){float r;asm("v_sub_f32_e32 %0, %1, %2":"=v"(r):"v"(a),"v"(b));return r;}
typedef float f32x2_t __attribute__((ext_vector_type(2))); typedef __bf16 bf16x2_t __attribute__((ext_vector_type(2)));
__device__ __forceinline__ unsigned cvtpk_s(float lo,float hi){f32x2_t v={lo,hi};bf16x2_t b=__builtin_convertvector(v,bf16x2_t);return __builtin_bit_cast(unsigned,b);}
#define WAIT_BAR(N) asm volatile("s_waitcnt vmcnt(" #N ") lgkmcnt(0)\n\ts_barrier":::"memory")

__device__ __forceinline__ void qkt(f32x16&p0,f32x16&p1,const char*Kslot,const bf16x8*qr,const f32x16&negm,int r32,int hi){
  const char*kb=Kslot+hi*1024+r32*16;
  #pragma unroll
  for(int d0=0;d0<4;++d0){
    const bf16x8 b0=*reinterpret_cast<const bf16x8*>(kb+d0*2048);
    const bf16x8 b1=*reinterpret_cast<const bf16x8*>(kb+d0*2048+512);
    if(d0==0){p0=__builtin_amdgcn_mfma_f32_32x32x16_bf16(b0,qr[0],negm,0,0,0);p1=__builtin_amdgcn_mfma_f32_32x32x16_bf16(b1,qr[0],negm,0,0,0);}
    else{p0=__builtin_amdgcn_mfma_f32_32x32x16_bf16(b0,qr[d0],p0,0,0,0);p1=__builtin_amdgcn_mfma_f32_32x32x16_bf16(b1,qr[d0],p1,0,0,0);}}
}
typedef __attribute__((address_space(3))) const char* lds_cptr;
typedef short v4i16_t __attribute__((ext_vector_type(4)));
__device__ __forceinline__ void kload8(bf16x8*kf,lds_cptr kp){
  kf[0]=*(const __attribute__((address_space(3))) bf16x8*)(kp);      kf[1]=*(const __attribute__((address_space(3))) bf16x8*)(kp+512);
  kf[2]=*(const __attribute__((address_space(3))) bf16x8*)(kp+2048); kf[3]=*(const __attribute__((address_space(3))) bf16x8*)(kp+2560);
  kf[4]=*(const __attribute__((address_space(3))) bf16x8*)(kp+4096); kf[5]=*(const __attribute__((address_space(3))) bf16x8*)(kp+4608);
  kf[6]=*(const __attribute__((address_space(3))) bf16x8*)(kp+6144); kf[7]=*(const __attribute__((address_space(3))) bf16x8*)(kp+6656);
}
__device__ __forceinline__ void kload2(bf16x8*kf,lds_cptr kp,int j){ kf[2*j]=*(const __attribute__((address_space(3))) bf16x8*)(kp+j*2048); kf[2*j+1]=*(const __attribute__((address_space(3))) bf16x8*)(kp+j*2048+512); }
__device__ __forceinline__ s16x4 vtr(lds_cptr p){ return __builtin_bit_cast(s16x4,__builtin_amdgcn_ds_read_tr16_b64_v4i16((__attribute__((address_space(3))) v4i16_t*)p)); }
__device__ __forceinline__ float rowmax(const f32x16&p0,const f32x16&p1){
  float a=max3f(p0[0],p0[1],p1[0]),b=max3f(p0[2],p0[3],p1[1]);a=max3f(a,p1[2],p1[3]);
  #pragma unroll
  for(int r=4;r<16;r+=4){a=max3f(a,p0[r],p0[r+1]);b=max3f(b,p0[r+2],p0[r+3]);a=max3f(a,p1[r],p1[r+1]);b=max3f(b,p1[r+2],p1[r+3]);}
  const float m=max2f(a,b);
  auto rr=__builtin_amdgcn_permlane32_swap(__float_as_uint(m),__float_as_uint(m),false,false);
  return max2f(__uint_as_float(rr[0]),__uint_as_float(rr[1]));
}
__device__ __forceinline__ void pv(f32x16*o,int vb,bf16x8 pa0,bf16x8 pa1,bf16x8 pa2,bf16x8 pa3){
  #pragma unroll
  for(int d0=0;d0<2;++d0){s16x4 lo[4],hi[4];
    #pragma unroll
    for(int ks=0;ks<4;++ks){
      asm volatile("ds_read_b64_tr_b16 %0,%1 offset:%c2":"=&v"(lo[ks]):"v"(vb),"i"(d0*4096+ks*1024):"memory");
      asm volatile("ds_read_b64_tr_b16 %0,%1 offset:%c2":"=&v"(hi[ks]):"v"(vb),"i"(d0*4096+ks*1024+512):"memory");}
    asm volatile("s_waitcnt lgkmcnt(0)":::"memory");SBAR();
    #define PK(k) (bf16x8){lo[k][0],lo[k][1],lo[k][2],lo[k][3],hi[k][0],hi[k][1],hi[k][2],hi[k][3]}
    o[d0]=__builtin_amdgcn_mfma_f32_32x32x16_bf16(pa0,PK(0),o[d0],0,0,0);
    o[d0]=__builtin_amdgcn_mfma_f32_32x32x16_bf16(pa1,PK(1),o[d0],0,0,0);
    o[d0]=__builtin_amdgcn_mfma_f32_32x32x16_bf16(pa2,PK(2),o[d0],0,0,0);
    o[d0]=__builtin_amdgcn_mfma_f32_32x32x16_bf16(pa3,PK(3),o[d0],0,0,0);
    #undef PK
  }
}

#ifndef ATTN_STORE16
#define ATTN_STORE16(p,v) (*(u32x4*)(p)=(v))
#endif
template<int THRL> __device__ __forceinline__ void attn_unit(int b,int h,long qrow0,int NTarg,const bf16*Q,const bf16*__restrict__ K,const bf16*__restrict__ V,bf16*O,char*shm){
  int tid_=threadIdx.x; asm volatile("":"+v"(tid_)); const int tid=tid_,lane=tid&63,r32=lane&31,hi=lane>>5; const int wid=__builtin_amdgcn_readfirstlane(tid>>6);
  const long krowbase=(long)b*SEQK; const int kvh=h>>2;
  const bf16*Qw=Q+(qrow0+wid*QBLK)*QP+h*D;
  const bf16*Kh=K+krowbase*KP+kvh*D,*Vh=V+krowbase*KP+kvh*D;
  const unsigned lds0=(unsigned)(uintptr_t)shm;
  float*wsf=(float*)(shm+LDS_WS)+wid*64;
  const bf16*ksrc=Kh+(long)lane*KP+wid*8;
  const bf16*vsrc=Vh+(long)(16*(wid&3)+(lane>>2))*KP+(wid>>2)*32+(lane&3)*8;
  const unsigned kdst=lds0+LDS_K+wid*1024, vdst=lds0+LDS_V+wid*1024;
  #define DMA_K(t,slot) glds16(ksrc+(long)(t)*KVBLK*KP,(unsigned)__builtin_amdgcn_readfirstlane(kdst+(slot)))
  #define DMA_V(t,slot) glds16(vsrc+(long)(t)*KVBLK*KP,(unsigned)__builtin_amdgcn_readfirstlane(vdst+(slot)))
  const int vb0=(int)(lds0+LDS_V)+((lane>>4)&1)*32+(lane&3)*8+(4*hi+((lane&15)>>2))*64;
  const char*Kbase=shm+LDS_K; bf16x8 kf[8];
  const lds_cptr shm3=(lds_cptr)shm; const lds_cptr kp0=shm3+LDS_K+hi*1024+r32*16; const lds_cptr vp0=shm3+LDS_V+((lane>>4)&1)*32+(lane&3)*8+(4*hi+((lane&15)>>2))*64;
  const int NT=NTarg;
  DMA_K(0,0);DMA_V(0,0);DMA_K(1,SLOTB);
  bf16x8 qr[4];
  #pragma unroll
  for(int d0=0;d0<4;++d0)qr[d0]=*reinterpret_cast<const bf16x8*>(&Qw[(long)r32*QP+d0*16+hi*8]);
  float mhat=0.f,l_reg=0.f;f32x16 o[2];o[0]=f32x16{};o[1]=f32x16{};f32x16 negm=f32x16{};asm volatile("":"+v"(negm));
  const int qrel=wid*QBLK+r32;
  #define CMASK(P0,P1,t) do{}while(0)
  bool resc=false;
  #define START(P0,P1) do{ const float rm=rowmax(P0,P1); resc=false; \
    { const float dl=rm; mhat=fadd_s(mhat,dl); \
      _Pragma("unroll") for(int r=0;r<16;++r){P0[r]=fsub_s(P0[r],dl);P1[r]=fsub_s(P1[r],dl);} \
      _Pragma("unroll") for(int r=0;r<16;++r)negm[r]=-mhat; asm volatile("":"+v"(negm)); } \
    _Pragma("unroll") for(int r=0;r<16;++r)P0[r]=__builtin_amdgcn_exp2f(P0[r]); }while(0)
  #define RESC() do{ if(resc){ asm volatile("s_waitcnt lgkmcnt(0)":::"memory"); \
      _Pragma("unroll") for(int d_=0;d_<2;++d_) _Pragma("unroll") for(int r=0;r<16;++r)o[d_][r]*=wsf[crow(r,hi)]; } }while(0)
  f32x16 pA0,pA1,pB0,pB1;
  int sl_prev=0,sl_cur=0,sl_next=SLOTB;
  #define ROT() do{sl_prev=sl_cur;sl_cur=sl_next;sl_next=(sl_next==(NSLOT-1)*SLOTB)?0:sl_next+SLOTB;}while(0)
  DMA_K(2,2*SLOTB);
  WAIT_BAR(3);
  qkt(pA0,pA1,Kbase,qr,negm,r32,hi);asm volatile("s_nop 15\n\ts_nop 7":"+v"(pA0),"+v"(pA1));CMASK(pA0,pA1,0);
  START(pA0,pA1);
  _Pragma("unroll") for(int r=0;r<16;++r)pA1[r]=__builtin_amdgcn_exp2f(pA1[r]);
  WAIT_BAR(0);
  DMA_K(3,0);DMA_V(1,SLOTB);
  ROT();
  kload8(kf,kp0+sl_cur);
  WAIT_BAR(2);
  s16x4 vlo[8],vhi[8]; u32x4 pw0,pw1,pw2,pw3;
  #define PKW(P,B) cvtpk_s(P[B],P[B+1])
  #define PAF(k) __builtin_bit_cast(bf16x8,pw##k)
  #define VFR(i) (bf16x8){vlo[i][0],vlo[i][1],vlo[i][2],vlo[i][3],vhi[i][0],vhi[i][1],vhi[i][2],vhi[i][3]}
  #define PIN(x) asm volatile("":"+v"(x))
  #define MX3(a,b,c) __builtin_fmaxf(__builtin_fmaxf((a),(b)),(c))
  #define GAPA(MF,A0,A1,A2,A3,W0,W1,PW) do{ MF; sacc+=A0; sacc+=A1; sacc+=A2; sacc+=A3; PIN(sacc); W0; W1; PIN(PW); SBAR(); }while(0)
  #define EX(v) __builtin_amdgcn_exp2f(v)
  #define GAPB(MF,X,B) do{ MF; X[B]=EX(X[B]); X[B+1]=EX(X[B+1]); X[B+2]=EX(X[B+2]); X[B+3]=EX(X[B+3]); PIN(X); SBAR(); }while(0)
  #define VRD(i) do{ vlo[i]=vtr(vp_+(((i)>>2)*4096+((i)&3)*1024)); vhi[i]=vtr(vp_+(((i)>>2)*4096+((i)&3)*1024+512)); }while(0)
  #define KRD(G,j) do{ if(G){ kload2(kf,kp0+sl_next,j); SBAR(); } }while(0)
  #define STEP(C0,C1,P0,P1,t,GK,GV,GL) do{ SBAR(); \
    const lds_cptr vp_=vp0+sl_prev; \
    VRD(0); SBAR(); float sacc=(P0[0]+P0[1]); \
    GAPA(C0=__builtin_amdgcn_mfma_f32_32x32x16_bf16(kf[0],qr[0],negm,0,0,0), P0[2],P0[3],P0[4],P0[5],     pw0[0]=PKW(P0,0), pw0[1]=PKW(P0,2), pw0); \
    VRD(4); SBAR(); GAPA(C1=__builtin_amdgcn_mfma_f32_32x32x16_bf16(kf[1],qr[0],negm,0,0,0), P0[6],P0[7],P0[8],P0[9],     pw0[2]=PKW(P0,4), pw0[3]=PKW(P0,6), pw0); \
    VRD(1); SBAR(); GAPA(C0=__builtin_amdgcn_mfma_f32_32x32x16_bf16(kf[2],qr[1],C0,0,0,0),   P0[10],P0[11],P0[12],P0[13], pw1[0]=PKW(P0,8), pw1[1]=PKW(P0,10), pw1); \
    VRD(5); SBAR(); GAPA(C1=__builtin_amdgcn_mfma_f32_32x32x16_bf16(kf[3],qr[1],C1,0,0,0),   P0[14],P0[15],P1[0],P1[1],   pw1[2]=PKW(P0,12),pw1[3]=PKW(P0,14), pw1); \
    VRD(2); SBAR(); GAPA(C0=__builtin_amdgcn_mfma_f32_32x32x16_bf16(kf[4],qr[2],C0,0,0,0),   P1[2],P1[3],P1[4],P1[5],     pw2[0]=PKW(P1,0), pw2[1]=PKW(P1,2), pw2); \
    VRD(6); SBAR(); GAPA(C1=__builtin_amdgcn_mfma_f32_32x32x16_bf16(kf[5],qr[2],C1,0,0,0),   P1[6],P1[7],P1[8],P1[9],     pw2[2]=PKW(P1,4), pw2[3]=PKW(P1,6), pw2); \
    VRD(3); SBAR(); GAPA(C0=__builtin_amdgcn_mfma_f32_32x32x16_bf16(kf[6],qr[3],C0,0,0,0),   P1[10],P1[11],P1[12],P1[13], pw3[0]=PKW(P1,8), pw3[1]=PKW(P1,10), pw3); \
    VRD(7); SBAR(); GAPA(C1=__builtin_amdgcn_mfma_f32_32x32x16_bf16(kf[7],qr[3],C1,0,0,0),   P1[14],P1[15],0.f,0.f,       pw3[2]=PKW(P1,12),pw3[3]=PKW(P1,14), pw3); \
    l_reg+=sacc; \
    if(GK){DMA_K((t)+3,sl_cur);} if(GV){DMA_V((t)+1,sl_next);} \
    CMASK(C0,C1,t); \
    { float a=MX3(C0[0],C0[1],C1[0]),b=MX3(C0[2],C0[3],C1[1]); a=MX3(a,C1[2],C1[3]); \
      _Pragma("unroll") for(int r=4;r<16;r+=4){a=MX3(a,C0[r],C0[r+1]);b=MX3(b,C0[r+2],C0[r+3]);a=MX3(a,C1[r],C1[r+1]);b=MX3(b,C1[r+2],C1[r+3]);} \
      float rm=__builtin_fmaxf(a,b); { auto rr=__builtin_amdgcn_permlane32_swap(__float_as_uint(rm),__float_as_uint(rm),false,false); rm=__builtin_fmaxf(__uint_as_float(rr[0]),__uint_as_float(rr[1])); } \
      resc=false; \
      if(__builtin_expect(__any(rm>(float)THRL),0)){ const float dl=__builtin_fmaxf(rm,0.f); mhat+=dl; \
        _Pragma("unroll") for(int r=0;r<16;++r){C0[r]-=dl;C1[r]-=dl;} \
        _Pragma("unroll") for(int r=0;r<16;++r)negm[r]=-mhat; asm volatile("":"+v"(negm)); \
        const float f=__builtin_amdgcn_exp2f(-dl); l_reg*=f; if(hi==0)wsf[r32]=f; resc=true; } } \
    SBAR(); \
    GAPB(o[0]=__builtin_amdgcn_mfma_f32_32x32x16_bf16(PAF(0),VFR(0),o[0],0,0,0), C0,0); \
    GAPB(o[1]=__builtin_amdgcn_mfma_f32_32x32x16_bf16(PAF(0),VFR(4),o[1],0,0,0), C0,4); \
    KRD(GL,0); GAPB(o[0]=__builtin_amdgcn_mfma_f32_32x32x16_bf16(PAF(1),VFR(1),o[0],0,0,0), C0,8); \
    KRD(GL,1); GAPB(o[1]=__builtin_amdgcn_mfma_f32_32x32x16_bf16(PAF(1),VFR(5),o[1],0,0,0), C0,12); \
    KRD(GL,2); GAPB(o[0]=__builtin_amdgcn_mfma_f32_32x32x16_bf16(PAF(2),VFR(2),o[0],0,0,0), C1,0); \
    KRD(GL,3); GAPB(o[1]=__builtin_amdgcn_mfma_f32_32x32x16_bf16(PAF(2),VFR(6),o[1],0,0,0), C1,4); \
    GAPB(o[0]=__builtin_amdgcn_mfma_f32_32x32x16_bf16(PAF(3),VFR(3),o[0],0,0,0), C1,8); \
    GAPB(o[1]=__builtin_amdgcn_mfma_f32_32x32x16_bf16(PAF(3),VFR(7),o[1],0,0,0), C1,12); \
    }while(0)
  int t=1;
  #undef CMASK
  #define CMASK(P0,P1,t) do{}while(0)
  for(;t+5<NT;t+=2){
    STEP(pB0,pB1,pA0,pA1,t,true,true,true);     WAIT_BAR(2); RESC(); ROT();
    STEP(pA0,pA1,pB0,pB1,t+1,true,true,true);   WAIT_BAR(2); RESC(); ROT();
  }
  #undef CMASK
  #define CMASK(P0,P1,t) do{}while(0)
  #define ENDW(tt) do{ if((tt)+3<NT){WAIT_BAR(2);} else if((tt)+2<NT){WAIT_BAR(1);} else {WAIT_BAR(0);} }while(0)
  for(;t+1<NT;t+=2){
    STEP(pB0,pB1,pA0,pA1,t,(t+3<NT),(t+1<NT),(t+1<NT));       ENDW(t);   RESC(); ROT();
    STEP(pA0,pA1,pB0,pB1,t+1,(t+4<NT),(t+2<NT),(t+2<NT));     ENDW(t+1); RESC(); ROT();
  }
  STEP(pB0,pB1,pA0,pA1,NT-1,false,false,false); RESC();
  { float sacc=pB0[0]+pB0[1]; _Pragma("unroll") for(int r=2;r<16;++r)sacc+=pB0[r]; _Pragma("unroll") for(int r=0;r<16;++r)sacc+=pB1[r]; l_reg+=sacc;
    pw0=(u32x4){PKW(pB0,0),PKW(pB0,2),PKW(pB0,4),PKW(pB0,6)};pw1=(u32x4){PKW(pB0,8),PKW(pB0,10),PKW(pB0,12),PKW(pB0,14)};pw2=(u32x4){PKW(pB1,0),PKW(pB1,2),PKW(pB1,4),PKW(pB1,6)};pw3=(u32x4){PKW(pB1,8),PKW(pB1,10),PKW(pB1,12),PKW(pB1,14)};
    SBAR(); pv(o,vb0+sl_cur,PAF(0),PAF(1),PAF(2),PAF(3)); }
  #undef PKW
  #undef PAF
  #undef VFR
  #undef PIN
  #undef MX3
  #undef GAPA
  #undef GAPB
  #undef EX
  #undef VRD
  #undef KRD
  #undef STEP
  #undef ENDW
  {auto rr=__builtin_amdgcn_permlane32_swap(__float_as_uint(l_reg),__float_as_uint(l_reg),false,false);l_reg=__uint_as_float(rr[0])+__uint_as_float(rr[1]);}
  if(hi==0)wsf[32+r32]=l_reg;asm volatile("s_waitcnt lgkmcnt(0)":::"memory");
  float rli[16];
  #pragma unroll
  for(int r=0;r<16;++r)rli[r]=__builtin_amdgcn_rcpf(wsf[32+crow(r,hi)]);
  bf16*Ow=O+(qrow0+wid*QBLK)*QP+h*D;
  { bf16*stg=(bf16*)(shm+LDS_OST)+wid*2048;
    #pragma unroll
    for(int r=0;r<16;++r){const int orow=crow(r,hi);
      #pragma unroll
      for(int d0=0;d0<2;++d0)stg[orow*64+d0*32+r32]=__float2bfloat16(o[d0][r]*rli[r]);}
    asm volatile("s_waitcnt lgkmcnt(0)":::"memory");
    #pragma unroll
    for(int i=0;i<4;++i){const int row=i*8+(lane>>3),ch=lane&7; const u32x4 v=*(const u32x4*)(stg+row*64+ch*8); ATTN_STORE16(Ow+(long)row*QP+ch*8,v);} }
  asm volatile("s_waitcnt lgkmcnt(0)\n\ts_barrier":::"memory");
  #undef DMA_K
  #undef DMA_V
  #undef CMASK
  #undef START
  #undef RESC
  #undef ROT
}
constexpr int ATTN_LDS_BYTES=LDS_BYTES;
struct AttnTensors { const bf16* Q; const bf16* K; const bf16* V; bf16* O; };
template<int THRL=8> __device__ __forceinline__ void attn_phase(char*lds,const AttnTensors&T,int G,int vcu,bool with_ctx,long ctx_row0){
  const int total=4*NHEAD*NQB;
  for(int i=0;;++i){
    int x,n;
    if(G==256){ if(i>=4)break; x=vcu>>5; n=i*32+(vcu&31); }
    else { const int u=i*G+vcu; if(u>=total)break; x=u>>7; n=u&127; }
    const int b=x>>1,kvh=x&1,h=kvh*4+(n>>5),qb=n&31;
    attn_unit<THRL>(b,h,(long)b*SEQQ+(long)qb*QB,SEQK/KVBLK,T.Q,T.K,T.V,T.O,lds);
  }
  if(with_ctx){
    for(int u=vcu;u<4*NHEAD;u+=G){ const int b=u>>3,h=u&7; attn_unit<THRL>(b,h,ctx_row0+(long)b*256,4,T.Q,T.K,T.V,T.O,lds); }
  }
}
#undef SBAR
#undef WAIT_BAR
}

constexpr int NWAVES = 8, NTHR = 512;
constexpr int DMODEL = 1024, NB = 4, SEQ = 8192, CTXL = 256, NLAT = NB * SEQ, NCTX = NB * CTXL, MT = NLAT + NCTX;
constexpr int INW = 2048, NE = 32, KEYS = SEQ + CTXL;
constexpr int SORT_TILES = 560, SORT_ROWS = SORT_TILES * 256;
constexpr float EPSN = 1e-6f;
constexpr int NCHUNK = 66, CHUNK = 128;
constexpr int NPH_PRO = 2, NPH_LAYER = 13, NPH = NPH_PRO + 2 * NPH_LAYER;

constexpr size_t MiB = 1u << 20;
constexpr size_t WS_CTL = 0, CTL_ZERO_BYTES = 1 * MiB;
constexpr size_t WS_MOD = 1 * MiB, WS_ROPEC = 2 * MiB, WS_ROPES = 3 * MiB, WS_H2 = 4 * MiB, WS_KFC = 10 * MiB, WS_BLKCNT = 12 * MiB, WS_TILEE = 13 * MiB, WS_SCANS = 14 * MiB;
constexpr size_t WS_WINT = 16 * MiB, WS_WOUTT = 24 * MiB, WS_W1T = 32 * MiB, WS_W2T = 288 * MiB, WS_KF = 416 * MiB, WS_KHAT = 448 * MiB, WS_XR = 512 * MiB, WS_H = 644 * MiB;
constexpr size_t WS_U = 712 * MiB, WS_Q = 844 * MiB, WS_K = 877 * MiB, WS_V = 886 * MiB, WS_ATT = 895 * MiB, WS_LAB = 928 * MiB, WS_LRUO = 1060 * MiB, WS_VT = 1093 * MiB, WS_X0T = 1125 * MiB,
                 WS_HYO = 1157 * MiB, WS_MIXA = 1190 * MiB;
constexpr size_t WS_WGT = 11 * MiB, WS_SPT = 10 * MiB + 768 * 1024, WS_XL = 1256 * MiB;
constexpr size_t WS_GC = 10 * MiB + 896 * 1024;
constexpr size_t WS_CB = 10 * MiB + 960 * 1024;
constexpr size_t WS_F = 712 * MiB, WS_ASORT = 778 * MiB, WS_ACT = 1058 * MiB, WS_YS = 1338 * MiB, WS_TOPI = 1618 * MiB, WS_GATE = 1619 * MiB, WS_POS = 1620 * MiB, WS_RSSP = 1622 * MiB, WS_END = 1625 * MiB;
constexpr size_t LAB_STRIDE = (size_t)MT * 256;
constexpr int CW_BAR = 4096;
constexpr int CW_NTILES = 64;

constexpr int RING_OFF = 0, RING_BYTES = 131072, MOETAB_OFF = 131072, LDSCTL_OFF = 155648, LDS_BYTES = 156160;

#define GAS __attribute__((address_space(1)))
#define LAS __attribute__((address_space(3)))
typedef unsigned short bf16;
typedef unsigned v4u __attribute__((ext_vector_type(4)));
typedef unsigned v2u __attribute__((ext_vector_type(2)));
typedef float f32x4 __attribute__((ext_vector_type(4)));
#define LDS_WAIT() asm volatile("s_waitcnt lgkmcnt(0)" ::: "memory")
#define VM_WAIT() asm volatile("s_waitcnt vmcnt(0)" ::: "memory")
__device__ __forceinline__ unsigned f2bf(float f) { unsigned u = __builtin_bit_cast(unsigned, f); return (u + 0x7fffu + ((u >> 16) & 1u)) >> 16; }
__device__ __forceinline__ unsigned pk2(float lo, float hi) { return f2bf(lo) | (f2bf(hi) << 16); }
__device__ __forceinline__ float bf2f(unsigned short b) { return __builtin_bit_cast(float, (unsigned)b << 16); }
__device__ __forceinline__ float bflo(unsigned w) { return __builtin_bit_cast(float, w << 16); }
__device__ __forceinline__ float bfhi(unsigned w) { return __builtin_bit_cast(float, w & 0xffff0000u); }
__device__ __forceinline__ float wave_sum(float v) {
#pragma unroll
    for (int o = 1; o < 64; o <<= 1) v += __shfl_xor(v, o);
    return v;
}
__device__ __forceinline__ float sigmoidf_(float x) { return 1.0f / (1.0f + __expf(-x)); }
__device__ __forceinline__ void sincos_d(double x, double& s, double& c) {
    const double kd = __builtin_rint(x * 0.63661977236758134308);
    const int k = (int)kd;
    double r = __builtin_fma(-kd, 1.57079632673412561417e+00, x);
    r = __builtin_fma(-kd, 6.07710050650619224932e-11, r);
    const double z = r * r;
    const double ps = r + r * z * (-1.66666666666666324348e-01 + z * (8.33333333332248946124e-03 + z * (-1.98412698298579493134e-04 + z * (2.75573137070700676789e-06 + z * (-2.50507602534068634195e-08 + z * 1.58969099521155010221e-10)))));
    const double pc = 1.0 - 0.5 * z + z * z * (4.16666666666666019037e-02 + z * (-1.38888888888741095749e-03 + z * (2.48015872894767294178e-05 + z * (-2.75573143513906633035e-07 + z * (2.08757232129817482790e-09 + z * -1.13596475577881948265e-11)))));
    const int q = k & 3;
    s = (q == 0) ? ps : (q == 1) ? pc : (q == 2) ? -ps : -pc;
    c = (q == 0) ? pc : (q == 1) ? -ps : (q == 2) ? -pc : ps;
}
__device__ __forceinline__ float gelu_tanh(float x) {
    const float u = 0.7978845608028654f * (x + 0.044715f * x * x * x);
    const float t = 1.0f - 2.0f / (1.0f + __expf(2.0f * u));
    return 0.5f * x * (1.0f + t);
}
__device__ __forceinline__ int lds_add(LAS int* p, int v) { return __hip_atomic_fetch_add(p, v, __ATOMIC_RELAXED, __HIP_MEMORY_SCOPE_WORKGROUP); }

#define FFT_FN __device__ __forceinline__
typedef float f32x2v __attribute__((ext_vector_type(2)));
#define FFT_VEC2 f32x2v
#define FFT_DPTR LAS f32x2v*
#define FFT_LD(D, i) c32_from((D)[i])
#define FFT_ST(D, i, v) ((D)[i] = c32_to(v))
struct __attribute__((aligned(8))) c32 { float x, y; };
FFT_FN c32 cmul(c32 a, c32 b) { c32 r; r.x = a.x * b.x - a.y * b.y; r.y = a.x * b.y + a.y * b.x; return r; }
FFT_FN c32 cadd(c32 a, c32 b) { c32 r; r.x = a.x + b.x; r.y = a.y + b.y; return r; }
FFT_FN c32 csub(c32 a, c32 b) { c32 r; r.x = a.x - b.x; r.y = a.y - b.y; return r; }
FFT_FN c32 cmuli_neg(c32 a) { c32 r; r.x = a.y; r.y = -a.x; return r; }
FFT_FN int fpad(int a) { return a + (a >> 4); }
#ifdef FFT_VEC2
FFT_FN c32 c32_from(FFT_VEC2 t) { c32 r; r.x = t.x; r.y = t.y; return r; }
FFT_FN FFT_VEC2 c32_to(c32 a) { FFT_VEC2 t; t.x = a.x; t.y = a.y; return t; }
#endif
FFT_FN void dft4(c32& a0, c32& a1, c32& a2, c32& a3) {
    const c32 s02 = cadd(a0, a2), d02 = csub(a0, a2), s13 = cadd(a1, a3), d13 = cmuli_neg(csub(a1, a3));
    a0 = cadd(s02, s13); a2 = csub(s02, s13); a1 = cadd(d02, d13); a3 = csub(d02, d13);
}
FFT_FN void dft16(c32 (&v)[16]) {
    const float C1 = 0.92387953251128674f, S1 = 0.38268343236508977f, C2 = 0.70710678118654752f;
#pragma unroll
    for (int q2 = 0; q2 < 4; ++q2) dft4(v[q2], v[4 + q2], v[8 + q2], v[12 + q2]);
    { c32 w;
      w.x = C1; w.y = -S1; v[4 * 1 + 1] = cmul(v[4 * 1 + 1], w);
      w.x = C2; w.y = -C2; v[4 * 2 + 1] = cmul(v[4 * 2 + 1], w);
      w.x = S1; w.y = -C1; v[4 * 3 + 1] = cmul(v[4 * 3 + 1], w);
      w.x = C2; w.y = -C2; v[4 * 1 + 2] = cmul(v[4 * 1 + 2], w);
      v[4 * 2 + 2] = cmuli_neg(v[4 * 2 + 2]);
      w.x = -C2; w.y = -C2; v[4 * 3 + 2] = cmul(v[4 * 3 + 2], w);
      w.x = S1; w.y = -C1; v[4 * 1 + 3] = cmul(v[4 * 1 + 3], w);
      w.x = -C2; w.y = -C2; v[4 * 2 + 3] = cmul(v[4 * 2 + 3], w);
      w.x = -C1; w.y = S1; v[4 * 3 + 3] = cmul(v[4 * 3 + 3], w); }
#pragma unroll
    for (int p1 = 0; p1 < 4; ++p1) dft4(v[4 * p1 + 0], v[4 * p1 + 1], v[4 * p1 + 2], v[4 * p1 + 3]);
#pragma unroll
    for (int a = 0; a < 4; ++a)
#pragma unroll
        for (int b = a + 1; b < 4; ++b) { const c32 t = v[4 * a + b]; v[4 * a + b] = v[4 * b + a]; v[4 * b + a] = t; }
}
FFT_FN c32 twid(int j, int n) { float rev = (float)j / (float)n; asm volatile("" : "+v"(rev)); c32 w; w.x = __builtin_amdgcn_cosf(rev); w.y = -__builtin_amdgcn_sinf(rev); return w; }

FFT_FN void fft_fwd16(FFT_DPTR D, int g, int n) {
    const int s = n >> 4, blk = g / s, j = g - blk * s, base = blk * n + j;
    c32 v[16];
#pragma unroll
    for (int q = 0; q < 16; ++q) v[q] = FFT_LD(D, fpad(base + q * s));
    dft16(v);
    const c32 w = twid(j, n); c32 wp = w;
#pragma unroll
    for (int p = 1; p < 16; ++p) { v[p] = cmul(v[p], wp); wp = cmul(wp, w); }
#pragma unroll
    for (int p = 0; p < 16; ++p) FFT_ST(D, fpad(base + p * s), v[p]);
}
FFT_FN void fft_inv16(FFT_DPTR D, int g, int n) {
    const int s = n >> 4, blk = g / s, j = g - blk * s, base = blk * n + j;
    c32 v[16];
#pragma unroll
    for (int q = 0; q < 16; ++q) v[q] = FFT_LD(D, fpad(base + q * s));
    const c32 w = twid(j, n); c32 wp = w;
#pragma unroll
    for (int p = 1; p < 16; ++p) { v[p] = cmul(v[p], wp); wp = cmul(wp, w); }
    dft16(v);
#pragma unroll
    for (int p = 0; p < 16; ++p) FFT_ST(D, fpad(base + p * s), v[p]);
}
FFT_FN void fft_mid16(FFT_DPTR D, int g, const c32* KH) {
    c32 v[16];
#pragma unroll
    for (int q = 0; q < 16; ++q) v[q] = FFT_LD(D, 17 * g + q);
    dft16(v);
#pragma unroll
    for (int p = 0; p < 16; ++p) { const c32 k = KH[16 * g + p]; const c32 t = cmul(v[p], k); v[p].x = t.x; v[p].y = -t.y; }
    dft16(v);
#pragma unroll
    for (int p = 0; p < 16; ++p) FFT_ST(D, 17 * g + p, v[p]);
}
FFT_FN void fft_last16_out(FFT_DPTR D, int g, c32* OUT, float scale) {
    c32 v[16];
#pragma unroll
    for (int q = 0; q < 16; ++q) v[q] = FFT_LD(D, 17 * g + q);
    dft16(v);
#pragma unroll
    for (int p = 0; p < 16; ++p) { c32 t; t.x = v[p].x * scale; t.y = v[p].y * scale; OUT[16 * g + p] = t; }
}
FFT_FN void fft_first4(FFT_DPTR D, int j, c32 x0, c32 x1, c32 x2, c32 x3) {
    dft4(x0, x1, x2, x3);
    const c32 w = twid(j, 16384), w2 = cmul(w, w), w3 = cmul(w2, w);
    FFT_ST(D, fpad(j), x0); FFT_ST(D, fpad(j + 4096), cmul(x1, w)); FFT_ST(D, fpad(j + 8192), cmul(x2, w2)); FFT_ST(D, fpad(j + 12288), cmul(x3, w3));
}
FFT_FN void fft_final4(FFT_DPTR D, int j, c32& u0, c32& u1) {
    const c32 w = twid(j, 16384), w2 = cmul(w, w), w3 = cmul(w2, w);
    c32 a0 = FFT_LD(D, fpad(j)), a1 = cmul(FFT_LD(D, fpad(j + 4096)), w), a2 = cmul(FFT_LD(D, fpad(j + 8192)), w2), a3 = cmul(FFT_LD(D, fpad(j + 12288)), w3);
    dft4(a0, a1, a2, a3);
    u0 = a0; u1 = a1;
}
FFT_FN void fft_first4_inplace(FFT_DPTR D, int j) {
    c32 x0 = FFT_LD(D, fpad(j)), x1 = FFT_LD(D, fpad(j + 4096)), x2 = FFT_LD(D, fpad(j + 8192)), x3 = FFT_LD(D, fpad(j + 12288));
    fft_first4(D, j, x0, x1, x2, x3);
}
#define XB_TMO      128
#define XB_XCNT(j)  (256  + 64 * (j))
#define XB_XSUB(j)  (1280 + 64 * (j))
#define XB_XGEN(j)  (2304 + 64 * (j))
#define XB_TOP      3328
#define XB_TOPGEN   3392
#define XCD_BAR_WORDS 3456
#define XB_SPIN_CAP (1u << 22)

__device__ __forceinline__ unsigned xb_ld(unsigned* p)              { return __hip_atomic_load(p, __ATOMIC_RELAXED, __HIP_MEMORY_SCOPE_AGENT); }
__device__ __forceinline__ unsigned xb_add(unsigned* p, unsigned v) { return __hip_atomic_fetch_add(p, v, __ATOMIC_RELAXED, __HIP_MEMORY_SCOPE_AGENT); }
__device__ __forceinline__ unsigned xb_xcc_id() { return (unsigned)__builtin_amdgcn_s_getreg((3 << 11) | 20) & 0xFu; }
#define XB_SPIN(cond, bar) do { unsigned _sp = 0; while (cond) { __builtin_amdgcn_s_sleep(1); \
    if ((++_sp & 255u) == 0u) { if (xb_ld(&(bar)[XB_TMO])) break; if (_sp > XB_SPIN_CAP) { atomicAdd(&(bar)[XB_TMO], 1u); break; } } } } while (0)

struct XcdBarrier {
    unsigned* bar; unsigned x;
    volatile LAS unsigned* st;
};

__device__ __forceinline__ XcdBarrier xcd_barrier_post(unsigned* bar, volatile LAS unsigned* st) {
    XcdBarrier b; b.bar = bar; b.x = xb_xcc_id(); b.st = st;
    if (threadIdx.x == 0) (void)xb_add(&bar[XB_XCNT(b.x)], 1u);
    return b;
}
__device__ __forceinline__ void xcd_barrier_complete(unsigned* bar, unsigned x, unsigned& nloc, unsigned& nx) {
    const unsigned G = gridDim.x * gridDim.y * gridDim.z;
    unsigned sum, cnt, mine, sp = 0u;
    for (;;) {
        sum = 0u; cnt = 0u; mine = 0u;
#pragma unroll
        for (unsigned j = 0; j < 16; ++j) { const unsigned c = xb_ld(&bar[XB_XCNT(j)]); sum += c; cnt += (c > 0u) ? 1u : 0u; mine = (j == x) ? c : mine; }
        if (sum == G) break;
        __builtin_amdgcn_s_sleep(1);
        if ((++sp & 255u) == 0u) { if (xb_ld(&bar[XB_TMO])) break; if (sp > XB_SPIN_CAP) { atomicAdd(&bar[XB_TMO], 1u); break; } }
    }
    nloc = mine > 0u ? mine : 1u; nx = cnt > 0u ? cnt : 1u;
}

__device__ __forceinline__ void xcd_barrier(const XcdBarrier& b) {
    asm volatile("s_waitcnt vmcnt(0)" ::: "memory");
    __syncthreads();
    if (threadIdx.x == 0) {
        unsigned* bar = b.bar;
        __builtin_amdgcn_s_waitcnt(0);
        unsigned nloc = b.st[0], nx = b.st[1];
        if (nloc == 0u) { xcd_barrier_complete(bar, b.x, nloc, nx); b.st[0] = nloc; b.st[1] = nx; }
        const unsigned old = xb_add(&bar[XB_XSUB(b.x)], 1u);
        const unsigned gen = old / nloc;
        if (old + 1u == (gen + 1u) * nloc) {
            __builtin_amdgcn_fence(__ATOMIC_RELEASE, "agent");
            asm volatile("s_waitcnt vmcnt(0)" ::: "memory");
            const unsigned og = xb_add(&bar[XB_TOP], 1u);
            const unsigned tg = og / nx;
            if (og + 1u == (tg + 1u) * nx) xb_add(&bar[XB_TOPGEN], 1u);
            else XB_SPIN(xb_ld(&bar[XB_TOPGEN]) == tg, bar);
            __builtin_amdgcn_fence(__ATOMIC_ACQUIRE, "agent");
            xb_add(&bar[XB_XGEN(b.x)], 1u);
            asm volatile("s_waitcnt vmcnt(0)" ::: "memory");
        } else {
            XB_SPIN(xb_ld(&bar[XB_XGEN(b.x)]) == gen, bar);
            __builtin_amdgcn_fence(__ATOMIC_ACQUIRE, "agent");
            asm volatile("s_waitcnt vmcnt(0)" ::: "memory");
        }
    }
    __syncthreads();
}


struct Frame {
    LAS unsigned char* lds; unsigned* ctl; unsigned char* ws;
    int tid, lane, wave, vcu, G, gw, ngw;
};
__device__ const float ROPE_INV[16] = {1.0f, 0.5623413251903491f, 0.31622776601683794f, 0.1778279410038923f, 0.1f, 0.05623413251903491f, 0.03162277660168379f, 0.01778279410038923f,
                                       0.01f, 0.005623413251903491f, 0.0031622776601683794f, 0.001778279410038923f, 0.001f, 0.0005623413251903491f, 0.00031622776601683794f, 0.0001778279410038923f};

__device__ __forceinline__ void p0_transpose_item(const float* W, int K, int N, bf16* WT, LAS float* scr, int item, int lane) {
    const int nblk = N / 32, kb = item / nblk, nb = item % nblk, k0 = 64 * kb, n0 = 32 * nb;
#pragma unroll 8
    for (int i = 0; i < 32; ++i) { const int kk = 2 * i + (lane >> 5); scr[kk * 33 + (lane & 31)] = W[(size_t)(k0 + kk) * N + n0 + (lane & 31)]; }
    LDS_WAIT(); asm volatile("" ::: "memory");
    const int c = lane & 7;
#pragma unroll
    for (int j = 0; j < 4; ++j) { const int n = (lane >> 3) + 8 * j; const LAS float* s = scr + (8 * c) * 33 + n;
        v4u o; o.x = pk2(s[0 * 33], s[1 * 33]); o.y = pk2(s[2 * 33], s[3 * 33]); o.z = pk2(s[4 * 33], s[5 * 33]); o.w = pk2(s[6 * 33], s[7 * 33]);
        *(GAS v4u*)(WT + (size_t)(n0 + n) * K + k0 + 8 * c) = o; }
    LDS_WAIT(); asm volatile("" ::: "memory");
}

__device__ __forceinline__ void ph_prologue_a(const Frame& F, const float* c, const float* cctx, const float* w_mod, const float* b_mod, const float* w_in, const float* w_out,
                                              const float* moe_w1, const float* moe_w2, const float* hy_w1, const float* hy_b1, const float* hy_w2, const float* hy_b2, const float* hy_freq, const float* lru_gw, const float* lru_lam) {
    {
        LAS float* scr = (LAS float*)(F.lds + F.wave * 16384);
        constexpr int I_IN = 2 * 1024, I_OUT = 2 * 512, I_W1 = 64 * 1024, I_W2 = 64 * 512, NIT = I_IN + I_OUT + I_W1 + I_W2;
        bf16* WinT = (bf16*)(F.ws + WS_WINT); bf16* WoutT = (bf16*)(F.ws + WS_WOUTT); bf16* W1T = (bf16*)(F.ws + WS_W1T); bf16* W2T = (bf16*)(F.ws + WS_W2T);
        for (int it = F.gw; it < NIT; it += F.ngw) {
            int r = it;
            if (r < I_IN) { const int m = r >> 10; p0_transpose_item(w_in + (size_t)m * 1024 * 2048, 1024, 2048, WinT + (size_t)m * 2048 * 1024, scr, r & 1023, F.lane); continue; } r -= I_IN;
            if (r < I_OUT) { const int m = r >> 9; p0_transpose_item(w_out + (size_t)m * 1024 * 1024, 1024, 1024, WoutT + (size_t)m * 1024 * 1024, scr, r & 511, F.lane); continue; } r -= I_OUT;
            if (r < I_W1) { const int m = r >> 10; p0_transpose_item(moe_w1 + (size_t)m * 1024 * 2048, 1024, 2048, W1T + (size_t)m * 2048 * 1024, scr, r & 1023, F.lane); continue; } r -= I_W1;
            { const int m = r >> 9; p0_transpose_item(moe_w2 + (size_t)m * 1024 * 1024, 1024, 1024, W2T + (size_t)m * 1024 * 1024, scr, r & 511, F.lane); }
        }
    }
    __syncthreads();
    {
        LAS float* sl = (LAS float*)(F.lds);
        LAS float* red = (LAS float*)(F.lds + 20480);
        float* MOD = (float*)(F.ws + WS_MOD);
        if ((int)blockIdx.x < 192) {
            for (int i = F.tid; i < 5 * 1024; i += NTHR) { const int r = i >> 10, k = i & 1023; const float v = (r < 4) ? c[r * 1024 + k] : cctx[k]; sl[i] = v / (1.0f + __expf(-v)); }
        }
        __syncthreads();
        for (int it = blockIdx.x; it < 192; it += F.G) {
            const int l = it / 96, n = (it % 96) * 64 + F.lane;
            float a0 = 0.f, a1 = 0.f, a2 = 0.f, a3 = 0.f, a4 = 0.f;
            const float* wp = w_mod + ((size_t)l * 1024 + F.wave * 128) * 6144 + n;
#pragma unroll 8
            for (int k = 0; k < 128; ++k) { const float w = wp[(size_t)k * 6144]; const int kk = F.wave * 128 + k;
                a0 += sl[kk] * w; a1 += sl[1024 + kk] * w; a2 += sl[2048 + kk] * w; a3 += sl[3072 + kk] * w; a4 += sl[4096 + kk] * w; }
            red[(F.wave * 5 + 0) * 64 + F.lane] = a0; red[(F.wave * 5 + 1) * 64 + F.lane] = a1; red[(F.wave * 5 + 2) * 64 + F.lane] = a2; red[(F.wave * 5 + 3) * 64 + F.lane] = a3; red[(F.wave * 5 + 4) * 64 + F.lane] = a4;
            __syncthreads();
            if (F.tid < 320) { const int r = F.tid >> 6, ln = F.tid & 63; float s = 0.f;
#pragma unroll
                for (int w = 0; w < 8; ++w) s += red[(w * 5 + r) * 64 + ln];
                const int nn = (it % 96) * 64 + ln; MOD[(size_t)(l * 5 + r) * 6144 + nn] = s + b_mod[l * 6144 + nn]; }
            __syncthreads();
        }
    }
    {
        bf16* WGT = (bf16*)(F.ws + WS_WGT); float* SPT = (float*)(F.ws + WS_SPT);
        for (int idx = blockIdx.x * NTHR + F.tid; idx < 2 * 1024 * 256; idx += F.G * NTHR) {
            const int l = idx >> 18, nidx = (idx >> 8) & 1023, k = idx & 255;
            const int pn = nidx >> 8, j = (nidx >> 7) & 1, cc = nidx & 127, d = pn >> 1, ch = 128 * (pn & 1) + cc, n = ch >> 6, e = ch & 63;
            const float v = ((k >> 6) == n) ? lru_gw[((size_t)((((l * 2 + d) * 2 + j) * 4 + n) * 64 + (k & 63))) * 64 + e] : 0.f;
            WGT[idx] = (bf16)f2bf(v); }
        for (int idx = blockIdx.x * NTHR + F.tid; idx < 2 * 2 * 256; idx += F.G * NTHR) SPT[idx] = log1pf(expf(-lru_lam[idx]));
    }
    {
        float* RC = (float*)(F.ws + WS_ROPEC); float* RS = (float*)(F.ws + WS_ROPES);
        for (int idx = blockIdx.x * NTHR + F.tid; idx < SEQ * 32; idx += F.G * NTHR) {
            const int t = idx >> 5, i = idx & 31; const int pos = (i < 16) ? (t >> 6) : (t & 63);
            const float ang = (float)pos * ROPE_INV[i & 15];
            double s, cc; sincos_d((double)ang, s, cc); RC[idx] = (float)cc; RS[idx] = (float)s; }
    }
    {
        float* H2 = (float*)(F.ws + WS_H2);
        for (int it = F.gw; it < 2 * SEQ + CTXL; it += F.ngw) {
            const int v = it >> 13, t = (v < 2) ? (it & (SEQ - 1)) : (it - 2 * SEQ), L = (v < 2) ? SEQ : CTXL, l = (v == 1) ? 1 : 0;
            const int j = F.lane;
            float z = 0.f;
            if (j == 0) z = (float)t / (float)(L - 1);
            else if (j <= 32) { const int b = (j - 1) & 15; const float band = 1e-4f + (float)b * ((15.0f - 1e-4f) / 15.0f);
                const float ang = ((6.283185307179586f / (float)L) * (float)t) * band;
                double s, cc; sincos_d((double)ang, s, cc); z = (j <= 16) ? (float)cc : -(float)s; }
            const float fr = hy_freq[l * 64 + j];
            float p1 = hy_b1[l * 64 + j];
            const float* w1 = hy_w1 + (size_t)l * 33 * 64;
#pragma unroll
            for (int i = 0; i < 33; ++i) p1 += __shfl(z, i) * w1[i * 64 + j];
            double s1, c1; sincos_d((double)(fr * p1), s1, c1); const float h1 = (float)s1;
            float p2 = hy_b2[l * 64 + j];
            const float* w2 = hy_w2 + (size_t)l * 64 * 64;
#pragma unroll 16
            for (int i = 0; i < 64; ++i) p2 += __shfl(h1, i) * w2[i * 64 + j];
            double s2, c2; sincos_d((double)(fr * p2), s2, c2);
            H2[((size_t)v * SEQ + t) * 64 + j] = (float)s2;
        }
    }
}

__device__ __forceinline__ void ph_prologue_b(const Frame& F, const float* hy_w3, const float* hy_decay, const float* gffn, const float* router_w, const float* router_b) {
    { const float* MOD = (const float*)(F.ws + WS_MOD); float* CB = (float*)(F.ws + WS_CB);
      for (int it = F.gw; it < 2 * 5 * 32; it += F.ngw) { const int lb = it >> 5, e = it & 31, l = lb / 5; const float* sf = MOD + (size_t)lb * 6144 + 3 * 1024; float s = 0.f;
#pragma unroll
          for (int q = 0; q < 16; ++q) { const int cc = 64 * q + F.lane; s += sf[cc] * router_w[(size_t)l * 32768 + cc * 32 + e]; }
          s = wave_sum(s); if (F.lane == 0) CB[it] = s + router_b[l * 32 + e]; } }
    { const float* MOD = (const float*)(F.ws + WS_MOD); float* GC = (float*)(F.ws + WS_GC);
      for (int idx = blockIdx.x * NTHR + F.tid; idx < 2 * 5 * 1024; idx += F.G * NTHR) { const int lb = idx >> 10, cc = idx & 1023, l = lb / 5; GC[idx] = gffn[l * 1024 + cc] * (1.0f + MOD[(size_t)lb * 6144 + 4 * 1024 + cc]); } }
    LAS f32x2v* D = (LAS f32x2v*)(F.lds);
    LAS float* kt = (LAS float*)(F.lds);
    LAS float* w3c = (LAS float*)(F.lds + 139264);
    LAS float* red = (LAS float*)(F.lds + 139264 + 512);
    const float* H2 = (const float*)(F.ws + WS_H2);
    c32* KHAT = (c32*)(F.ws + WS_KHAT); float* KFC = (float*)(F.ws + WS_KFC);
    for (int it = blockIdx.x; it < 768; it += F.G) {
        const int v = it >> 8, c = it & 255, L = (v < 2) ? SEQ : CTXL, l = (v == 1) ? 1 : 0;
        if (F.tid < 128) w3c[F.tid] = hy_w3[(size_t)l * 64 * 512 + (F.tid & 63) * 512 + (F.tid >> 6) * 256 + c];
        if (F.tid == 0) { if (v < 2) { f32x2v z; z.x = 0.f; z.y = 0.f; D[fpad(L)] = z; } else kt[L] = 0.f; }
        __syncthreads();
        const float df = fabsf(hy_decay[l * 512 + c]), db = fabsf(hy_decay[l * 512 + 256 + c]);
        float asum = 0.f;
        for (int t = F.tid; t < L; t += NTHR) {
            const f32x4* row = (const f32x4*)(H2 + ((size_t)v * SEQ + t) * 64);
            float hf = 0.f, hb = 0.f;
#pragma unroll
            for (int q = 0; q < 16; ++q) { const f32x4 h = row[q];
                hf += h.x * w3c[4 * q] + h.y * w3c[4 * q + 1] + h.z * w3c[4 * q + 2] + h.w * w3c[4 * q + 3];
                hb += h.x * w3c[64 + 4 * q] + h.y * w3c[64 + 4 * q + 1] + h.z * w3c[64 + 4 * q + 2] + h.w * w3c[64 + 4 * q + 3]; }
            const float t01 = (float)t / (float)(L - 1);
            hf *= expf(-t01 * df); hb *= expf(-t01 * db);
            asum += fabsf(hf); if (t >= 1) asum += fabsf(hb);
            if (v < 2) { f32x2v z; z.x = hf; z.y = 0.f; D[fpad(t)] = z; if (t >= 1) { z.x = hb; D[fpad(2 * L - t)] = z; } }
            else { kt[t] = hf; if (t >= 1) kt[2 * L - t] = hb; }
        }
        asum = wave_sum(asum);
        if (F.lane == 0) red[F.wave] = asum;
        __syncthreads();
        float tot = 0.f;
#pragma unroll
        for (int w = 0; w < 8; ++w) tot += red[w];
        const float inv = 1.0f / tot;
        if (v < 2) {
            c32* out = KHAT + (size_t)(v * 256 + c) * 16384;
#pragma unroll 1
            for (int i = 0; i < 8; ++i) fft_first4_inplace(D, F.tid + 512 * i);
            __syncthreads();
            _Pragma("unroll 1") for (int g_ = F.tid; g_ < 1024; g_ += 512) fft_fwd16(D, g_, 4096);
            __syncthreads();
            _Pragma("unroll 1") for (int g_ = F.tid; g_ < 1024; g_ += 512) fft_fwd16(D, g_, 256);
            __syncthreads();
            _Pragma("unroll 1") for (int g_ = F.tid; g_ < 1024; g_ += 512) fft_last16_out(D, g_, out, inv * (1.0f / 16384.0f));
        } else {
            float* dst = KFC + (size_t)c * 512;
            for (int j = F.tid; j < 2 * L; j += NTHR) dst[j] = kt[j] * inv;
        }
        __syncthreads();
    }
}

__device__ __forceinline__ void ph_norm_mod(const Frame& F, int l, const float* x, const float* ctx, const float* gmix) {
    const float* XR = (const float*)(F.ws + WS_XR); const float* MOD = (const float*)(F.ws + WS_MOD); bf16* H = (bf16*)(F.ws + WS_H);
    for (int r = F.gw; r < MT; r += F.ngw) {
        const float* src = (l == 0) ? (r < NLAT ? x + (size_t)r * 1024 : ctx + (size_t)(r - NLAT) * 1024) : XR + (size_t)r * 1024;
        const int bidx = r < NLAT ? r / SEQ : 4;
        const float* shift = MOD + (size_t)(l * 5 + bidx) * 6144; const float* scale = shift + 1024; const float* g = gmix + l * 1024;
        f32x4 v[4]; float ss = 0.f;
#pragma unroll
        for (int j = 0; j < 4; ++j) { v[j] = ((const f32x4*)src)[64 * j + F.lane]; ss += (v[j].x * v[j].x + v[j].y * v[j].y) + (v[j].z * v[j].z + v[j].w * v[j].w); }
        const float rstd = 1.0f / sqrtf(wave_sum(ss) * (1.0f / 1024.0f) + EPSN);
#pragma unroll
        for (int j = 0; j < 4; ++j) { const int cb = 64 * j + F.lane; const f32x4 gg = ((const f32x4*)g)[cb], sc = ((const f32x4*)scale)[cb], sh = ((const f32x4*)shift)[cb];
            const f32x4 y = v[j] * rstd * gg * (sc + 1.0f) + sh;
            v2u o; o.x = pk2(y.x, y.y); o.y = pk2(y.z, y.w); ((v2u*)(H + (size_t)r * 1024))[cb] = o; }
    }
}

__device__ __forceinline__ void ph_post_proj(const Frame& F, int l, const float* qg_, const float* kg_, const float* lru_cw, const float* lru_cb, const float* hy_cw, const float* hy_cb) {
    const bf16* U = (const bf16*)(F.ws + WS_U);
    {
        bf16* Q = (bf16*)(F.ws + WS_Q); bf16* K = (bf16*)(F.ws + WS_K); bf16* V = (bf16*)(F.ws + WS_V);
        const float* RC = (const float*)(F.ws + WS_ROPEC); const float* RS = (const float*)(F.ws + WS_ROPES);
        const int o8 = 8 * (F.lane & 7);
        const f32x4 qg0 = *(const f32x4*)(qg_ + l * 64 + o8), qg1 = *(const f32x4*)(qg_ + l * 64 + o8 + 4), kg0 = *(const f32x4*)(kg_ + l * 64 + o8), kg1 = *(const f32x4*)(kg_ + l * 64 + o8 + 4);
        const float C2 = 0.125f * 1.4426950408889634f;
        const bool lohalf = (F.lane & 4) == 0;
        for (int r = F.gw; r < MT; r += F.ngw) {
            const bool isctx = r >= NLAT; const int b = isctx ? (r - NLAT) / CTXL : r / SEQ; const int t = isctx ? (r - NLAT) % CTXL : r % SEQ;
            const bf16* ur = U + (size_t)r * INW;
            const v4u wq = ((const v4u*)ur)[F.lane];
            const v4u wk = ((const v4u*)(ur + 512))[F.lane & 31];
            f32x4 c0 = {1.f, 1.f, 1.f, 1.f}, c1 = c0, s0 = {0.f, 0.f, 0.f, 0.f}, s1 = s0;
            if (!isctx) { const float* rc = RC + t * 32 + 8 * (F.lane & 3); const float* rs = RS + t * 32 + 8 * (F.lane & 3);
                c0 = *(const f32x4*)rc; c1 = *(const f32x4*)(rc + 4); s0 = *(const f32x4*)rs; s1 = *(const f32x4*)(rs + 4); }
            const size_t krow = (size_t)b * KEYS + (isctx ? t : CTXL + t);
#pragma unroll
            for (int part = 0; part < 2; ++part) {
                const v4u w = part ? wk : wq;
                float x[8] = {bflo(w.x), bfhi(w.x), bflo(w.y), bfhi(w.y), bflo(w.z), bfhi(w.z), bflo(w.w), bfhi(w.w)};
                float ss = 0.f;
#pragma unroll
                for (int i = 0; i < 8; ++i) ss += x[i] * x[i];
                ss += __shfl_xor(ss, 1); ss += __shfl_xor(ss, 2); ss += __shfl_xor(ss, 4);
                const float rstd = 1.0f / sqrtf(ss * (1.0f / 64.0f) + EPSN);
                const f32x4 g0 = part ? kg0 : qg0, g1 = part ? kg1 : qg1;
                float y[8], o[8];
#pragma unroll
                for (int i = 0; i < 8; ++i) y[i] = x[i] * rstd * (i < 4 ? g0[i] : g1[i - 4]);
#pragma unroll
                for (int i = 0; i < 8; ++i) { const float p = __shfl_xor(y[i], 4); const float cs = i < 4 ? c0[i] : c1[i - 4], sn = i < 4 ? s0[i] : s1[i - 4];
                    o[i] = lohalf ? (y[i] * cs - p * sn) : (y[i] * cs + p * sn); }
                if (part == 0) { v4u ow; ow.x = pk2(o[0] * C2, o[1] * C2); ow.y = pk2(o[2] * C2, o[3] * C2); ow.z = pk2(o[4] * C2, o[5] * C2); ow.w = pk2(o[6] * C2, o[7] * C2);
                    ((v4u*)(Q + (size_t)r * 512))[F.lane] = ow; }
                else { v4u ow; ow.x = pk2(o[0], o[1]); ow.y = pk2(o[2], o[3]); ow.z = pk2(o[4], o[5]); ow.w = pk2(o[6], o[7]);
                    if (F.lane < 16) ((v4u*)(K + krow * 128))[F.lane] = ow;
                    else if (F.lane < 32) ((v4u*)(V + krow * 128))[F.lane - 16] = wk; }
            }
        }
    }
    {
        bf16* XL = (bf16*)(F.ws + WS_XL);
        for (int idx = blockIdx.x * NTHR + F.tid; idx < MT * 32; idx += F.G * NTHR) {
            const int r = idx >> 5, c8 = (idx & 31) * 8;
            const bool isctx = r >= NLAT; const int Ls = isctx ? CTXL : SEQ; const int t = isctx ? (r - NLAT) % CTXL : r % SEQ;
            float acc[8];
#pragma unroll
            for (int i = 0; i < 8; ++i) acc[i] = lru_cb[l * 256 + c8 + i];
#pragma unroll
            for (int j = 0; j < 4; ++j) { const int tj = t + j - 2;
                if (tj >= 0 && tj < Ls) { const v4u w = *(const v4u*)(U + (size_t)(r + j - 2) * INW + 768 + c8);
                    const f32x4 w0 = *(const f32x4*)(lru_cw + (l * 4 + j) * 256 + c8), w1 = *(const f32x4*)(lru_cw + (l * 4 + j) * 256 + c8 + 4);
                    acc[0] += w0.x * bflo(w.x); acc[1] += w0.y * bfhi(w.x); acc[2] += w0.z * bflo(w.y); acc[3] += w0.w * bfhi(w.y);
                    acc[4] += w1.x * bflo(w.z); acc[5] += w1.y * bfhi(w.z); acc[6] += w1.z * bflo(w.w); acc[7] += w1.w * bfhi(w.w); } }
            v4u o; o.x = pk2(acc[0], acc[1]); o.y = pk2(acc[2], acc[3]); o.z = pk2(acc[4], acc[5]); o.w = pk2(acc[6], acc[7]);
            *(v4u*)(XL + (size_t)r * 256 + c8) = o;
        }
    }
    __syncthreads();
    {
        LAS bf16* hs = (LAS bf16*)(F.lds);
        float* VT = (float*)(F.ws + WS_VT); float* X0T = (float*)(F.ws + WS_X0T);
        const float* cw = hy_cw + (size_t)l * 3 * 768; const float* cbp = hy_cb + l * 768;
        for (int it = blockIdx.x; it < NLAT / 64; it += F.G) {
            const int b = it >> 7, t0 = (it & 127) * 64;
            for (int i = F.tid; i < 66 * 384; i += NTHR) { const int rr = i / 384, c2 = i - rr * 384; const int t = t0 - 1 + rr;
                unsigned w = 0u; if (t >= 0 && t < SEQ) w = *(const unsigned*)(U + (size_t)(b * SEQ + t) * INW + 1280 + 2 * c2);
                *(LAS unsigned*)(hs + rr * 770 + 2 * c2) = w; }
            __syncthreads();
            for (int c = F.wave; c < 256; c += NWAVES) {
                const int tt = F.lane;
                float o[3];
#pragma unroll
                for (int g = 0; g < 3; ++g) { const int cc = g * 256 + c;
                    o[g] = cw[cc] * bf2f(hs[tt * 770 + cc]) + cw[768 + cc] * bf2f(hs[(tt + 1) * 770 + cc]) + cw[1536 + cc] * bf2f(hs[(tt + 2) * 770 + cc]) + cbp[cc]; }
                const size_t oi = ((size_t)b * 256 + c) * SEQ + t0 + tt;
                VT[oi] = o[2] * o[1]; X0T[oi] = o[0];
            }
            __syncthreads();
        }
    }
}

__device__ __forceinline__ void ph_ctx_attn(const Frame& F) {
    const bf16* Q = (const bf16*)(F.ws + WS_Q); const bf16* K = (const bf16*)(F.ws + WS_K); const bf16* V = (const bf16*)(F.ws + WS_V); bf16* O = (bf16*)(F.ws + WS_ATT);
    LAS float* qs = (LAS float*)(F.lds + 90112 + F.wave * 1280);
    LAS float* ps = qs + 64;
    for (int it = F.gw; it < NCTX * 8; it += F.ngw) {
        const int rc = it >> 3, h = it & 7, b = rc / CTXL, kvh = h >> 2; const int r = NLAT + rc;
        qs[F.lane] = bf2f(Q[(size_t)r * 512 + h * 64 + F.lane]);
        LDS_WAIT();
        float sc[4]; float mx = -INFINITY;
#pragma unroll
        for (int i = 0; i < 4; ++i) { const int key = F.lane + 64 * i; const v4u* kp = (const v4u*)(K + ((size_t)b * KEYS + key) * 128 + kvh * 64);
            float s = 0.f;
#pragma unroll
            for (int q = 0; q < 8; ++q) { const v4u w = kp[q];
                s += qs[8 * q] * bflo(w.x) + qs[8 * q + 1] * bfhi(w.x) + qs[8 * q + 2] * bflo(w.y) + qs[8 * q + 3] * bfhi(w.y) + qs[8 * q + 4] * bflo(w.z) + qs[8 * q + 5] * bfhi(w.z) + qs[8 * q + 6] * bflo(w.w) + qs[8 * q + 7] * bfhi(w.w); }
            sc[i] = s; mx = fmaxf(mx, s); }
#pragma unroll
        for (int o = 1; o < 64; o <<= 1) mx = fmaxf(mx, __shfl_xor(mx, o));
        float sum = 0.f;
#pragma unroll
        for (int i = 0; i < 4; ++i) { const float p = exp2f(sc[i] - mx); sum += p; ps[F.lane + 64 * i] = p; }
        sum = wave_sum(sum);
        LDS_WAIT();
        float acc = 0.f;
        const bf16* vp = V + (size_t)b * KEYS * 128 + kvh * 64 + F.lane;
#pragma unroll 8
        for (int key = 0; key < CTXL; ++key) acc += ps[key] * bf2f(vp[(size_t)key * 128]);
        O[(size_t)r * 512 + h * 64 + F.lane] = (bf16)f2bf(acc / sum);
        LDS_WAIT();
    }
}

__device__ __forceinline__ int chunk_row0(int b, int d, int k) {
    if (k < 2) { const int cc = d ? 1 - k : k; return NLAT + b * CTXL + cc * CHUNK; }
    const int lc = d ? 63 - (k - 2) : (k - 2); return b * SEQ + lc * CHUNK;
}
__device__ __forceinline__ void ph_scan1(const Frame& F) {
    const bf16* LAB = (const bf16*)(F.ws + WS_LAB); float* SUMP = (float*)(F.ws + WS_SCANS); float* SUMH = SUMP + NB * 2 * NCHUNK * 256;
    for (int it = blockIdx.x * NTHR + F.tid; it < NB * 2 * NCHUNK * 256; it += F.G * NTHR) {
        const int ch = it & 255, k = (it >> 8) % NCHUNK, bd = (it >> 8) / NCHUNK, d = bd & 1, b = bd >> 1;
        const int r0 = chunk_row0(b, d, k);
        const bf16* LA = LAB + (size_t)(2 * d) * LAB_STRIDE + ch; const bf16* LB = LAB + (size_t)(2 * d + 1) * LAB_STRIDE + ch;
        float h = 0.f, Ps = 0.f;
#pragma unroll 16
        for (int i = 0; i < CHUNK; ++i) { const int r = d ? r0 + CHUNK - 1 - i : r0 + i; const float la = bf2f(LA[(size_t)r * 256]), bx = bf2f(LB[(size_t)r * 256]); h = __builtin_amdgcn_exp2f(la) * h + bx; Ps += la; }
        SUMP[it] = __builtin_amdgcn_exp2f(Ps); SUMH[it] = h;
    }
}
__device__ __forceinline__ void ph_scan2(const Frame& F) {
    const bf16* LAB = (const bf16*)(F.ws + WS_LAB); const float* SUMP = (const float*)(F.ws + WS_SCANS); const float* SUMH = SUMP + NB * 2 * NCHUNK * 256;
    float* LRUO = (float*)(F.ws + WS_LRUO); const bf16* U = (const bf16*)(F.ws + WS_U);
    for (int it = blockIdx.x * NTHR + F.tid; it < NB * NCHUNK * 256; it += F.G * NTHR) {
        const int ch = it & 255, kc = (it >> 8) % NCHUNK, b = (it >> 8) / NCHUNK;
        const int r0 = chunk_row0(b, 0, kc);
#pragma unroll 1
        for (int d = 0; d < 2; ++d) {
            const int k = d ? ((kc < 2) ? 1 - kc : 2 + 63 - (kc - 2)) : kc;
            const size_t sb = (size_t)((b * 2 + d) * NCHUNK) * 256 + ch;
            float h = 0.f;
#pragma unroll 8
            for (int j = 0; j < k; ++j) h = SUMP[sb + (size_t)j * 256] * h + SUMH[sb + (size_t)j * 256];
            const bf16* LA = LAB + (size_t)(2 * d) * LAB_STRIDE + ch; const bf16* LB = LAB + (size_t)(2 * d + 1) * LAB_STRIDE + ch;
            if (d == 0) {
#pragma unroll 16
                for (int i = 0; i < CHUNK; ++i) { const int r = r0 + i; h = __builtin_amdgcn_exp2f(bf2f(LA[(size_t)r * 256])) * h + bf2f(LB[(size_t)r * 256]); LRUO[(size_t)r * 256 + ch] = h; }
            } else {
#pragma unroll 8
                for (int i = 0; i < CHUNK; ++i) { const int r = r0 + CHUNK - 1 - i; h = __builtin_amdgcn_exp2f(bf2f(LA[(size_t)r * 256])) * h + bf2f(LB[(size_t)r * 256]);
                    const float lg = bf2f(U[(size_t)r * INW + 1024 + ch]);
                    LRUO[(size_t)r * 256 + ch] = (LRUO[(size_t)r * 256 + ch] + h) * gelu_tanh(lg); }
            }
        }
    }
}

__device__ __forceinline__ void ph_hyena_direct(const Frame& F, int l, const float* hy_bias, const float* hy_cw, const float* hy_cb) {
    LAS float* ks = (LAS float*)(F.lds);
    LAS float* vs = (LAS float*)(F.lds + 65536);
    const float* KF = (const float*)(F.ws + WS_KF) + (size_t)l * 256 * 16384;
    const float* VT = (const float*)(F.ws + WS_VT); const float* X0T = (const float*)(F.ws + WS_X0T); float* HYO = (float*)(F.ws + WS_HYO);
    for (int it = blockIdx.x; it < 512; it += F.G) {
        const int c = it >> 1, bp = it & 1;
        for (int i = F.tid; i < 4096; i += NTHR) ((LAS f32x4*)ks)[i] = ((const f32x4*)(KF + (size_t)c * 16384))[i];
        for (int i = F.tid; i < 4096; i += NTHR) { const int bb = i >> 11, q = i & 2047; ((LAS f32x4*)vs)[i] = ((const f32x4*)(VT + ((size_t)(bp * 2 + bb) * 256 + c) * SEQ))[q]; }
        __syncthreads();
        float y0[16], y1[16];
#pragma unroll
        for (int i = 0; i < 16; ++i) { y0[i] = 0.f; y1[i] = 0.f; }
#pragma unroll 2
        for (int s = 0; s < SEQ; ++s) {
            const float v0 = vs[s], v1 = vs[SEQ + s];
            const int base = (F.tid - s) & 16383;
#pragma unroll
            for (int i = 0; i < 16; ++i) { const float kk = ks[(base + 512 * i) & 16383]; y0[i] += kk * v0; y1[i] += kk * v1; }
        }
        const float bias = hy_bias[l * 256 + c];
#pragma unroll
        for (int i = 0; i < 16; ++i) { const int t = F.tid + 512 * i;
            { const int b = bp * 2; const size_t oi = ((size_t)b * 256 + c) * SEQ + t; HYO[((size_t)b * SEQ + t) * 256 + c] = (y0[i] + vs[t] * bias) * X0T[oi]; }
            { const int b = bp * 2 + 1; const size_t oi = ((size_t)b * 256 + c) * SEQ + t; HYO[((size_t)b * SEQ + t) * 256 + c] = (y1[i] + vs[SEQ + t] * bias) * X0T[oi]; } }
        __syncthreads();
    }
}
__device__ __forceinline__ void ph_khat(const Frame& F) {
    LAS f32x2v* D = (LAS f32x2v*)(F.lds);
    const float* KF = (const float*)(F.ws + WS_KF); c32* KHAT = (c32*)(F.ws + WS_KHAT);
    for (int it = blockIdx.x; it < 512; it += F.G) {
        const float* k = KF + (size_t)it * 16384; c32* out = KHAT + (size_t)it * 16384;
#pragma unroll 1
        for (int i = 0; i < 8; ++i) { const int j = F.tid + 512 * i; c32 x0, x1, x2, x3; x0.x = k[j]; x1.x = k[j + 4096]; x2.x = k[j + 8192]; x3.x = k[j + 12288]; x0.y = x1.y = x2.y = x3.y = 0.f;
            fft_first4(D, j, x0, x1, x2, x3); }
        __syncthreads();
        _Pragma("unroll 1") for (int g_ = F.tid; g_ < 1024; g_ += 512) fft_fwd16(D, g_, 4096);
        __syncthreads();
        _Pragma("unroll 1") for (int g_ = F.tid; g_ < 1024; g_ += 512) fft_fwd16(D, g_, 256);
        __syncthreads();
        _Pragma("unroll 1") for (int g_ = F.tid; g_ < 1024; g_ += 512) fft_last16_out(D, g_, out, 1.0f / 16384.0f);
        __syncthreads();
    }
}
__device__ __forceinline__ void ph_hyena_fft(const Frame& F, int l, const float* hy_bias) {
    LAS f32x2v* D = (LAS f32x2v*)(F.lds);
    const c32* KHAT = (const c32*)(F.ws + WS_KHAT) + (size_t)l * 256 * 16384;
    const float* VT = (const float*)(F.ws + WS_VT); const float* X0T = (const float*)(F.ws + WS_X0T); float* HYO = (float*)(F.ws + WS_HYO);
    for (int it = blockIdx.x; it < 512; it += F.G) {
        const int c = it >> 1, bp = it & 1;
        const float* va = VT + ((size_t)(bp * 2) * 256 + c) * SEQ; const float* vb = VT + ((size_t)(bp * 2 + 1) * 256 + c) * SEQ;
#ifndef REP_FFT
#define REP_FFT 1
#endif
#pragma unroll 1
        for (int repf_ = 0; repf_ < REP_FFT; ++repf_) {
#pragma unroll 1
        for (int i = 0; i < 8; ++i) { const int j = F.tid + 512 * i; c32 x0, x1, z; x0.x = va[j]; x0.y = vb[j]; x1.x = va[j + 4096]; x1.y = vb[j + 4096]; z.x = 0.f; z.y = 0.f;
            fft_first4(D, j, x0, x1, z, z); }
        __syncthreads();
        _Pragma("unroll 1") for (int g_ = F.tid; g_ < 1024; g_ += 512) fft_fwd16(D, g_, 4096);
        __syncthreads();
        _Pragma("unroll 1") for (int g_ = F.tid; g_ < 1024; g_ += 512) fft_fwd16(D, g_, 256);
        __syncthreads();
        _Pragma("unroll 1") for (int g_ = F.tid; g_ < 1024; g_ += 512) fft_mid16(D, g_, KHAT + (size_t)c * 16384);
        __syncthreads();
        _Pragma("unroll 1") for (int g_ = F.tid; g_ < 1024; g_ += 512) fft_inv16(D, g_, 256);
        __syncthreads();
        _Pragma("unroll 1") for (int g_ = F.tid; g_ < 1024; g_ += 512) fft_inv16(D, g_, 4096);
        __syncthreads();
        }
        const float bias = hy_bias[l * 256 + c];
        const float* xa = X0T + ((size_t)(bp * 2) * 256 + c) * SEQ; const float* xb = X0T + ((size_t)(bp * 2 + 1) * 256 + c) * SEQ;
        float* oa = HYO + ((size_t)(bp * 2) * 256 + c) * SEQ; float* ob = HYO + ((size_t)(bp * 2 + 1) * 256 + c) * SEQ;
#pragma unroll 2
        for (int i = 0; i < 8; ++i) { const int j = F.tid + 512 * i; c32 u0, u1; fft_final4(D, j, u0, u1);
            oa[j] = (u0.x + va[j] * bias) * xa[j];                 ob[j] = (-u0.y + vb[j] * bias) * xb[j];
            oa[j + 4096] = (u1.x + va[j + 4096] * bias) * xa[j + 4096]; ob[j + 4096] = (-u1.y + vb[j + 4096] * bias) * xb[j + 4096]; }
        __syncthreads();
    }
}
__device__ __forceinline__ void ph_hyena_ctx(const Frame& F, const float* hy_bias, const float* hy_cw, const float* hy_cb) {
    float* HYO = (float*)(F.ws + WS_HYO);
    {

        const bf16* U = (const bf16*)(F.ws + WS_U); const float* KFC = (const float*)(F.ws + WS_KFC);
        LAS float* vw = (LAS float*)(F.lds + F.wave * 4096);
        LAS float* kw = vw + 256;
        const float* cw = hy_cw; const float* cbp = hy_cb;
        for (int it = F.gw; it < NB * 256; it += F.ngw) {
            const int b = it >> 8, c = it & 255;
            float x0v[4];
#pragma unroll
            for (int i = 0; i < 4; ++i) { const int t = F.lane + 64 * i;
                float o[3];
#pragma unroll
                for (int g = 0; g < 3; ++g) { const int cc = g * 256 + c; float a = cbp[cc];
#pragma unroll
                    for (int j = 0; j < 3; ++j) { const int tj = t + j - 1; if (tj >= 0 && tj < CTXL) a += cw[j * 768 + cc] * bf2f(U[(size_t)(NLAT + b * CTXL + tj) * INW + 1280 + cc]); }
                    o[g] = a; }
                vw[t] = o[2] * o[1]; x0v[i] = o[0]; }
#pragma unroll
            for (int i = 0; i < 8; ++i) kw[F.lane + 64 * i] = KFC[c * 512 + F.lane + 64 * i];
            LDS_WAIT();
            float y[4] = {0.f, 0.f, 0.f, 0.f};
#pragma unroll 4
            for (int s = 0; s < CTXL; ++s) { const float vv = vw[s];
#pragma unroll
                for (int i = 0; i < 4; ++i) y[i] += kw[(F.lane + 64 * i - s) & 511] * vv; }
            const float bias = hy_bias[c];
#pragma unroll
            for (int i = 0; i < 4; ++i) { const int t = F.lane + 64 * i; HYO[(size_t)(NLAT + b * CTXL + t) * 256 + c] = (y[i] + vw[t] * bias) * x0v[i]; }
            LDS_WAIT();
        }
    }
}

__device__ __forceinline__ void merge_row(const Frame& F, int r, const float* g, float h0, float h1, float h2, float h3) {
    const bf16* ATT = (const bf16*)(F.ws + WS_ATT); const float* LRUO = (const float*)(F.ws + WS_LRUO); bf16* MIXA = (bf16*)(F.ws + WS_MIXA);
    const v4u aw = ((const v4u*)(ATT + (size_t)r * 512))[F.lane];
    float a[8] = {bflo(aw.x), bfhi(aw.x), bflo(aw.y), bfhi(aw.y), bflo(aw.z), bfhi(aw.z), bflo(aw.w), bfhi(aw.w)};
    float ss = 0.f;
#pragma unroll
    for (int i = 0; i < 8; ++i) ss += a[i] * a[i];
    const float ra = 1.0f / sqrtf(wave_sum(ss) * (1.0f / 512.0f) + EPSN);
    const f32x4 lv = ((const f32x4*)(LRUO + (size_t)r * 256))[F.lane];
    const float rl = 1.0f / sqrtf(wave_sum(lv.x * lv.x + lv.y * lv.y + lv.z * lv.z + lv.w * lv.w) * (1.0f / 256.0f) + EPSN);
    const float rh = 1.0f / sqrtf(wave_sum(h0 * h0 + h1 * h1 + h2 * h2 + h3 * h3) * (1.0f / 256.0f) + EPSN);
    bf16* orow = MIXA + (size_t)r * 1024;
    { const f32x4 g0 = ((const f32x4*)g)[2 * F.lane], g1 = ((const f32x4*)g)[2 * F.lane + 1];
      v4u o; o.x = pk2(a[0] * ra * g0.x, a[1] * ra * g0.y); o.y = pk2(a[2] * ra * g0.z, a[3] * ra * g0.w); o.z = pk2(a[4] * ra * g1.x, a[5] * ra * g1.y); o.w = pk2(a[6] * ra * g1.z, a[7] * ra * g1.w);
      ((v4u*)orow)[F.lane] = o; }
    { const f32x4 gg = ((const f32x4*)(g + 512))[F.lane]; v2u o; o.x = pk2(lv.x * rl * gg.x, lv.y * rl * gg.y); o.y = pk2(lv.z * rl * gg.z, lv.w * rl * gg.w); ((v2u*)(orow + 512))[F.lane] = o; }
    orow[768 + F.lane] = (bf16)f2bf(h0 * rh * g[768 + F.lane]); orow[832 + F.lane] = (bf16)f2bf(h1 * rh * g[832 + F.lane]);
    orow[896 + F.lane] = (bf16)f2bf(h2 * rh * g[896 + F.lane]); orow[960 + F.lane] = (bf16)f2bf(h3 * rh * g[960 + F.lane]);
}
__device__ __forceinline__ void ph_merge(const Frame& F, int l, int nrows, const float* out_g) {
    const float* HYO = (const float*)(F.ws + WS_HYO);
    const float* g = out_g + l * 1024;
    LAS float* tile = (LAS float*)(F.lds);
    for (int it = blockIdx.x; it < NLAT / 64; it += F.G) {
        const int b = it >> 7, t0 = (it & 127) * 64;
#pragma unroll 8
        for (int i = 0; i < 32; ++i) { const int c = F.wave * 32 + i; tile[c * 65 + F.lane] = HYO[((size_t)b * 256 + c) * SEQ + t0 + F.lane]; }
        __syncthreads();
#pragma unroll 2
        for (int k = 0; k < 8; ++k) { const int tt = F.wave * 8 + k;
            merge_row(F, b * SEQ + t0 + tt, g, tile[F.lane * 65 + tt], tile[(F.lane + 64) * 65 + tt], tile[(F.lane + 128) * 65 + tt], tile[(F.lane + 192) * 65 + tt]); }
        __syncthreads();
    }
    for (int r = NLAT + F.gw; r < nrows; r += F.ngw) {
        const float* hr = HYO + (size_t)r * 256;
        merge_row(F, r, g, hr[F.lane], hr[64 + F.lane], hr[128 + F.lane], hr[192 + F.lane]);
    }
}

__device__ __forceinline__ void ph_ffn_router_old(const Frame& F, int l, int nrows, const float* gffn, const float* router_w, const float* router_b) {
    LAS float* rwl = (LAS float*)(F.lds);
    LAS int* hist = (LAS int*)(F.lds + 135168);
    const float* XR = (const float*)(F.ws + WS_XR); const float* MOD = (const float*)(F.ws + WS_MOD); bf16* Fb = (bf16*)(F.ws + WS_F);
    int* TOPI = (int*)(F.ws + WS_TOPI); float* GATE = (float*)(F.ws + WS_GATE); int* BLKCNT = (int*)(F.ws + WS_BLKCNT);
    for (int i = F.tid; i < 1024 * 32; i += NTHR) rwl[(i >> 5) * 33 + (i & 31)] = router_w[(size_t)l * 32768 + i];
    if (F.tid < 32) hist[F.tid] = 0;
    __syncthreads();
    const float* g = gffn + l * 1024;
    for (int r = F.gw; r < nrows; r += F.ngw) {
        const int bidx = r < NLAT ? r / SEQ : 4;
        const float* sf = MOD + (size_t)(l * 5 + bidx) * 6144 + 3 * 1024; const float* cf = sf + 1024;
        float f[16]; float ss = 0.f;
#pragma unroll
        for (int j = 0; j < 16; ++j) { f[j] = XR[(size_t)r * 1024 + 64 * j + F.lane]; ss += f[j] * f[j]; }
        const float rstd = 1.0f / sqrtf(wave_sum(ss) * (1.0f / 1024.0f) + EPSN);
        float p[32];
#pragma unroll
        for (int e = 0; e < 32; ++e) p[e] = 0.f;
#pragma unroll
        for (int j = 0; j < 16; ++j) { const int c = 64 * j + F.lane; const float fv = f[j] * rstd * g[c] * (1.0f + cf[c]) + sf[c];
            Fb[(size_t)r * 1024 + c] = (bf16)f2bf(fv);
            const LAS float* wrow = rwl + c * 33;
#pragma unroll
            for (int e = 0; e < 32; ++e) p[e] += fv * wrow[e]; }
#pragma unroll
        for (int e = 0; e < 32; ++e) p[e] = wave_sum(p[e]) + router_b[l * 32 + e];
        unsigned taken = 0u; float tv[4]; int ti[4];
#pragma unroll
        for (int k = 0; k < 4; ++k) { float best = -INFINITY; int bi = 0;
#pragma unroll
            for (int e = 0; e < 32; ++e) { const bool ok = !((taken >> e) & 1u) && (p[e] > best); best = ok ? p[e] : best; bi = ok ? e : bi; }
            taken |= 1u << bi; tv[k] = best; ti[k] = bi; }
        const float e1 = __expf(tv[1] - tv[0]), e2 = __expf(tv[2] - tv[0]), e3 = __expf(tv[3] - tv[0]); const float inv = 1.0f / (1.0f + e1 + e2 + e3);
        if (F.lane == 0) {
            TOPI[r * 4 + 0] = ti[0]; TOPI[r * 4 + 1] = ti[1]; TOPI[r * 4 + 2] = ti[2]; TOPI[r * 4 + 3] = ti[3];
            GATE[r * 4 + 0] = inv; GATE[r * 4 + 1] = e1 * inv; GATE[r * 4 + 2] = e2 * inv; GATE[r * 4 + 3] = e3 * inv;
            lds_add(&hist[ti[0]], 1); lds_add(&hist[ti[1]], 1); lds_add(&hist[ti[2]], 1); lds_add(&hist[ti[3]], 1);
        }
    }
    __syncthreads();
    if (F.tid < 32) BLKCNT[blockIdx.x * 32 + F.tid] = hist[F.tid];
}

__device__ __forceinline__ void ph_ffn_router(const Frame& F, int l, int nrows, const float* router_w) {
    LAS float* rwl = (LAS float*)(F.lds);
    LAS float* cbl = (LAS float*)(F.lds + 147456);
    LAS int* hist = (LAS int*)(F.lds + 147456 + 640);
    const bf16* XR = (const bf16*)(F.ws + WS_XR); const float* RSSP = (const float*)(F.ws + WS_RSSP); const float* MOD = (const float*)(F.ws + WS_MOD);
    const float* GC = (const float*)(F.ws + WS_GC) + (size_t)l * 5 * 1024; bf16* Fb = (bf16*)(F.ws + WS_F);
    int* TOPI = (int*)(F.ws + WS_TOPI); float* GATE = (float*)(F.ws + WS_GATE); int* BLKCNT = (int*)(F.ws + WS_BLKCNT);
    for (int i = F.tid; i < 1024 * 32; i += NTHR) rwl[(i >> 5) * 36 + (i & 31)] = router_w[(size_t)l * 32768 + i];
    if (F.tid < 32) hist[F.tid] = 0;
    if (F.tid < 160) cbl[F.tid] = ((const float*)(F.ws + WS_CB))[l * 160 + F.tid];
    __syncthreads();
    const int j = F.lane & 15, kq = F.lane >> 4;
    for (int grp = F.gw; grp < nrows / 16; grp += F.ngw) {
        const int r0 = grp * 16, r = r0 + j; const int bidx = r0 < NLAT ? r0 / SEQ : 4;
        const bf16* xrow = XR + (size_t)r * 1024 + 4 * kq; const float* gcp = GC + bidx * 1024 + 4 * kq; const float* sfp = MOD + (size_t)(l * 5 + bidx) * 6144 + 3 * 1024 + 4 * kq;
        bf16* frow = Fb + (size_t)r * 1024 + 4 * kq;
        float ss; { const f32x4 q = *(const f32x4*)(RSSP + (size_t)r * 16 + 4 * kq); ss = (q.x + q.y) + (q.z + q.w); }
        ss += __shfl_xor(ss, 16); ss += __shfl_xor(ss, 32);
        const float rstd = 1.0f / sqrtf(ss * (1.0f / 1024.0f) + EPSN);
        f32x4 acc0 = {0.f, 0.f, 0.f, 0.f}, acc1 = acc0;
#pragma unroll 8
        for (int i = 0; i < 64; ++i) {
            const v2u xw = *(const v2u*)(xrow + 16 * i); const f32x4 g4 = *(const f32x4*)(gcp + 16 * i); const f32x4 s4 = *(const f32x4*)(sfp + 16 * i);
            const f32x4 x4 = {bflo(xw.x), bfhi(xw.x), bflo(xw.y), bfhi(xw.y)};
            const f32x4 xb = x4 * g4;
            const f32x4 fv = xb * rstd + s4;
            v2u o; o.x = pk2(fv.x, fv.y); o.y = pk2(fv.z, fv.w); *(v2u*)(frow + 16 * i) = o;
            const LAS float* wp = rwl + (16 * i + 4 * kq) * 36 + j;
#pragma unroll
            for (int e = 0; e < 4; ++e) { acc0 = __builtin_amdgcn_mfma_f32_16x16x4f32(wp[e * 36], xb[e], acc0, 0, 0, 0); acc1 = __builtin_amdgcn_mfma_f32_16x16x4f32(wp[e * 36 + 16], xb[e], acc1, 0, 0, 0); }
        }
        float lg[8];
#pragma unroll
        for (int rr = 0; rr < 4; ++rr) { lg[rr] = rstd * acc0[rr] + cbl[bidx * 32 + 4 * kq + rr]; lg[4 + rr] = rstd * acc1[rr] + cbl[bidx * 32 + 16 + 4 * kq + rr]; }
        float p[32];
#pragma unroll
        for (int e = 0; e < 32; ++e) p[e] = __shfl(lg[(e >> 4) * 4 + (e & 3)], j + 16 * ((e & 15) >> 2));
        unsigned taken = 0u; float tv[4]; int ti[4];
#pragma unroll
        for (int k = 0; k < 4; ++k) { float best = -INFINITY; int bi = 0;
#pragma unroll
            for (int e = 0; e < 32; ++e) { const bool ok = !((taken >> e) & 1u) && (p[e] > best); best = ok ? p[e] : best; bi = ok ? e : bi; }
            taken |= 1u << bi; tv[k] = best; ti[k] = bi; }
        const float e1 = __expf(tv[1] - tv[0]), e2 = __expf(tv[2] - tv[0]), e3 = __expf(tv[3] - tv[0]); const float inv = 1.0f / (1.0f + e1 + e2 + e3);
        if (kq == 0) {
            TOPI[r * 4 + 0] = ti[0]; TOPI[r * 4 + 1] = ti[1]; TOPI[r * 4 + 2] = ti[2]; TOPI[r * 4 + 3] = ti[3];
            GATE[r * 4 + 0] = inv; GATE[r * 4 + 1] = e1 * inv; GATE[r * 4 + 2] = e2 * inv; GATE[r * 4 + 3] = e3 * inv;
            lds_add(&hist[ti[0]], 1); lds_add(&hist[ti[1]], 1); lds_add(&hist[ti[2]], 1); lds_add(&hist[ti[3]], 1);
        }
    }
    __syncthreads();
    if (F.tid < 32) BLKCNT[blockIdx.x * 32 + F.tid] = hist[F.tid];
}

__device__ __forceinline__ void ph_route(const Frame& F, int nrows) {
    LAS int* cursor = (LAS int*)(F.lds);
    LAS int* tot = cursor + 32;
    LAS int* mine = cursor + 64;
    const int* BLKCNT = (const int*)(F.ws + WS_BLKCNT); const int* TOPI = (const int*)(F.ws + WS_TOPI); int* POS = (int*)(F.ws + WS_POS);
    const bf16* Fb = (const bf16*)(F.ws + WS_F); bf16* AS = (bf16*)(F.ws + WS_ASORT); int* TILEE = (int*)(F.ws + WS_TILEE);
    { LAS int* part = cursor + 96;
      const int e = F.tid & 31, sl = F.tid >> 5; int t = 0, m = 0;
      for (int b = sl; b < F.G; b += 16) { const int v = BLKCNT[b * 32 + e]; t += v; m += (b < (int)blockIdx.x) ? v : 0; }
      part[sl * 64 + e] = t; part[sl * 64 + 32 + e] = m;
      __syncthreads();
      if (F.tid < 32) { int tt = 0, mm = 0;
#pragma unroll
          for (int s = 0; s < 16; ++s) { tt += part[s * 64 + F.tid]; mm += part[s * 64 + 32 + F.tid]; }
          tot[F.tid] = tt; mine[F.tid] = mm; } }
    __syncthreads();
    if (F.tid == 0) { int tb = 0;
        for (int e = 0; e < 32; ++e) { const int nt = (tot[e] + 255) >> 8; cursor[e] = tb * 256 + mine[e];
            if (blockIdx.x == 0) for (int j = 0; j < nt; ++j) TILEE[tb + j] = e;
            tb += nt; }
        if (blockIdx.x == 0) F.ctl[CW_NTILES] = (unsigned)tb; }
    __syncthreads();
    for (int rr = F.gw * 16; rr < nrows; rr += (rr % 16 == 15) ? (F.ngw * 16 - 15) : 1) {
        const int r = rr;
        int pos = 0;
        if (F.lane < 4) { const int e = TOPI[r * 4 + F.lane]; pos = lds_add(&cursor[e], 1); POS[r * 4 + F.lane] = pos; }
        const v4u a0 = ((const v4u*)(Fb + (size_t)r * 1024))[F.lane], a1 = ((const v4u*)(Fb + (size_t)r * 1024))[64 + F.lane];
#pragma unroll
        for (int k = 0; k < 4; ++k) { const int pk = __shfl(pos, k); v4u* dst = (v4u*)(AS + (size_t)pk * 1024); dst[F.lane] = a0; dst[64 + F.lane] = a1; }
    }
}

__device__ __forceinline__ void ph_combine(const Frame& F, int l, int nrows, float* out, const float* gmix) {
    bf16* XR = (bf16*)(F.ws + WS_XR); const float* MOD = (const float*)(F.ws + WS_MOD); const bf16* YS = (const bf16*)(F.ws + WS_YS); bf16* H = (bf16*)(F.ws + WS_H);
    const int* POS = (const int*)(F.ws + WS_POS); const float* GATE = (const float*)(F.ws + WS_GATE);
    for (int r = F.gw; r < nrows; r += F.ngw) {
        const int bidx = r < NLAT ? r / SEQ : 4;
        const float* gf = MOD + (size_t)(l * 5 + bidx) * 6144 + 5 * 1024;
        int pos = 0; float gt = 0.f;
        if (F.lane < 4) { pos = POS[r * 4 + F.lane]; gt = GATE[r * 4 + F.lane]; }
        f32x4 y[4];
#pragma unroll
        for (int j = 0; j < 4; ++j) y[j] = (f32x4){0.f, 0.f, 0.f, 0.f};
#pragma unroll
        for (int k = 0; k < 4; ++k) { const int pk = __shfl(pos, k); const float gk = __shfl(gt, k); const v2u* yr = (const v2u*)(YS + (size_t)pk * 1024);
#pragma unroll
            for (int j = 0; j < 4; ++j) { const v2u w = yr[64 * j + F.lane]; y[j].x += gk * bflo(w.x); y[j].y += gk * bfhi(w.x); y[j].z += gk * bflo(w.y); y[j].w += gk * bfhi(w.y); } }
        float ss = 0.f;
#pragma unroll
        for (int j = 0; j < 4; ++j) { const int cb = 64 * j + F.lane; const v2u xw = ((const v2u*)(XR + (size_t)r * 1024))[cb]; const f32x4 xv = {bflo(xw.x), bfhi(xw.x), bflo(xw.y), bfhi(xw.y)}; const f32x4 gv = ((const f32x4*)gf)[cb];
            y[j] = xv + gv * y[j];
            if (l == 0) { v2u o; o.x = pk2(y[j].x, y[j].y); o.y = pk2(y[j].z, y[j].w); ((v2u*)(XR + (size_t)r * 1024))[cb] = o; } else ((f32x4*)(out + (size_t)r * 1024))[cb] = y[j];
            ss += (y[j].x * y[j].x + y[j].y * y[j].y) + (y[j].z * y[j].z + y[j].w * y[j].w); }
        if (l == 0) {
            const float rstd = 1.0f / sqrtf(wave_sum(ss) * (1.0f / 1024.0f) + EPSN);
            const float* shift = MOD + (size_t)(5 + bidx) * 6144; const float* scale = shift + 1024; const float* g = gmix + 1024;
#pragma unroll
            for (int j = 0; j < 4; ++j) { const int cb = 64 * j + F.lane; const f32x4 gg = ((const f32x4*)g)[cb], sc = ((const f32x4*)scale)[cb], sh = ((const f32x4*)shift)[cb];
                const f32x4 hv = y[j] * rstd * gg * (sc + 1.0f) + sh;
                v2u o; o.x = pk2(hv.x, hv.y); o.y = pk2(hv.z, hv.w); ((v2u*)(H + (size_t)r * 1024))[cb] = o; }
        }
    }
}

struct Args { const float* in[34]; float* out; unsigned char* ws; int ph_lo, ph_hi; };
enum { I_X = 0, I_C, I_CTX, I_CCTX, I_WMOD, I_BMOD, I_GMIX, I_GFFN, I_WIN, I_QG, I_KG, I_LCW, I_LCB, I_LGW, I_LGB, I_LLAM, I_HCW, I_HCB, I_HW1, I_HB1, I_HW2, I_HB2, I_HW3, I_HFREQ, I_HDEC, I_HBIAS,
       I_OUTG, I_WOUT, I_RW, I_RB, I_MW1, I_MB1, I_MW2, I_MB2 };

__global__ void __launch_bounds__(NTHR, 2) mk_fwd(Args args) {
    extern __shared__ __attribute__((aligned(16))) unsigned char lds[];
    Frame F;
    F.lds = (LAS unsigned char*)lds; F.ws = args.ws; F.ctl = (unsigned*)(args.ws + WS_CTL);
    F.tid = threadIdx.x; F.lane = F.tid & 63; F.wave = __builtin_amdgcn_readfirstlane(F.tid >> 6);
    F.G = gridDim.x; { const int bx = blockIdx.x; F.vcu = (F.G % 8 == 0) ? (bx % 8) * (F.G / 8) + bx / 8 : bx; }
    F.gw = (int)blockIdx.x * NWAVES + F.wave; F.ngw = F.G * NWAVES;
    for (int u = F.tid; u < (LDS_BYTES - LDSCTL_OFF) / 4; u += NTHR) ((LAS unsigned*)(F.lds + LDSCTL_OFF))[u] = 0u;
    __syncthreads();
#if !MK_PER_PHASE
    XcdBarrier bar = xcd_barrier_post(F.ctl + CW_BAR, (volatile LAS unsigned*)(F.lds + LDSCTL_OFF + 32));
#define GRID_BAR() xcd_barrier(bar)
#else
#define GRID_BAR() do { } while (0)
#endif
    const int lo = args.ph_lo, hi = args.ph_hi;
#ifndef ONLY_PHASE
#define ONLY_PHASE (-1)
#endif
#define ENABLED(id) (ONLY_PHASE < 0 || ONLY_PHASE == (id))
#define IN(k) (ENABLED(k) && lo <= (k) && (k) < hi)
#define INL(j) (ENABLED(NPH_PRO + (j)) && lo <= pb + (j) && pb + (j) < hi)
#define SEAML(j) do { if (lo <= pb + (j) && pb + (j) + 1 < hi) { GRID_BAR(); } } while (0)
typedef const __attribute__((address_space(4))) Args* KArgs;
#ifndef REP_MASK
#define REP_MASK 0
#endif
#define NREP(j) (((REP_MASK >> (j)) & 1) ? 2 : 1)
#define REFRAME() Frame Fp = F; KArgs ka = (KArgs)__builtin_amdgcn_kernarg_segment_ptr(); { int t_ = F.tid; asm volatile("" : "+v"(t_), "+s"(ka)); Fp.tid = t_; Fp.lane = t_ & 63; Fp.wave = __builtin_amdgcn_readfirstlane(t_ >> 6); \
    Fp.gw = (int)blockIdx.x * NWAVES + Fp.wave; Fp.ws = ka->ws; Fp.ctl = (unsigned*)(ka->ws + WS_CTL); }
#define SEAM(k) do { if (lo <= (k) && (k) + 1 < hi) { GRID_BAR(); } } while (0)

    if (IN(0)) ph_prologue_a(F, args.in[I_C], args.in[I_CCTX], args.in[I_WMOD], args.in[I_BMOD], args.in[I_WIN], args.in[I_WOUT], args.in[I_MW1], args.in[I_MW2],
                             args.in[I_HW1], args.in[I_HB1], args.in[I_HW2], args.in[I_HB2], args.in[I_HFREQ], args.in[I_LGW], args.in[I_LLAM]);
    SEAM(0);
    if (IN(1)) ph_prologue_b(F, args.in[I_HW3], args.in[I_HDEC], args.in[I_GFFN], args.in[I_RW], args.in[I_RB]);
    SEAM(1);

#define PHASE(j, ...) if (INL(j)) { _Pragma("unroll") for (int rep_ = 0; rep_ < NREP(j); ++rep_) { { REFRAME(); __VA_ARGS__ } if (rep_ + 1 < NREP(j)) GRID_BAR(); } }
#define LAYER_BODY(l) { \
        const int pb = NPH_PRO + l * NPH_LAYER; \
        const int nrows = (l == 0) ? MT : NLAT; \
        if (l == 0) { PHASE(0, ph_norm_mod(Fp, l, ka->in[I_X], ka->in[I_CTX], ka->in[I_GMIX]);) SEAML(0); } \
        PHASE(1, \
            pg8::Gemm g{(const bf16*)(Fp.ws + WS_H), (const bf16*)(Fp.ws + WS_WINT) + (size_t)l * 2048 * 1024, MT, 2048, 1024}; \
            pg8::StaticOrder S; S.init(MT, 2048, Fp.G, (int)blockIdx.x); \
            pg8::EpiBf16<0> E{(bf16*)(Fp.ws + WS_U), 2048, nullptr, 0, 0, 1.f}; \
            pg8::gemm_phase<pg8::EpiBf16<0>, pg8::StaticOrder, PG8_ALIGN, PG8_SP2>(Fp.lds + RING_OFF, g, S, E);) \
        SEAML(1); \
        PHASE(2, ph_post_proj(Fp, l, ka->in[I_QG], ka->in[I_KG], ka->in[I_LCW], ka->in[I_LCB], ka->in[I_HCW], ka->in[I_HCB]);) \
        SEAML(2); \
        PHASE(3, \
            int kg_ = 256; asm volatile("" : "+s"(kg_)); \
            pg8::Gemm g{(const bf16*)(Fp.ws + WS_XL), (const bf16*)(Fp.ws + WS_WGT) + (size_t)l * 1024 * 256, MT, 1024, kg_}; \
            pg8::StaticOrder S; S.init(MT, 1024, Fp.G, (int)blockIdx.x); \
            pg8::EpiLruGate E{(const bf16*)(Fp.ws + WS_XL), (bf16*)(Fp.ws + WS_LAB), LAB_STRIDE, ka->in[I_LGB] + (size_t)l * 1024, (const float*)(Fp.ws + WS_SPT) + l * 512}; \
            pg8::gemm_phase<pg8::EpiLruGate, pg8::StaticOrder, PG8_ALIGN, PG8_SP2>(Fp.lds + RING_OFF, g, S, E);) \
        SEAML(3); \
        PHASE(4, \
            ph_scan1(Fp); __syncthreads(); \
            const attn_body::AttnTensors AT{(const attn_body::bf16*)(Fp.ws + WS_Q), (const attn_body::bf16*)(Fp.ws + WS_K), (const attn_body::bf16*)(Fp.ws + WS_V), (attn_body::bf16*)(Fp.ws + WS_ATT)}; \
            attn_body::attn_phase<8>((char*)lds + RING_OFF, AT, Fp.G, Fp.vcu, l == 0, (long)NLAT);) \
        SEAML(4); \
        PHASE(5, ph_scan2(Fp); __syncthreads(); ph_hyena_fft(Fp, l, ka->in[I_HBIAS]); if (l == 0) ph_hyena_ctx(Fp, ka->in[I_HBIAS], ka->in[I_HCW], ka->in[I_HCB]);) \
        SEAML(5); \
        PHASE(6, ph_merge(Fp, l, nrows, ka->in[I_OUTG]);) \
        SEAML(6); \
        if (INL(7)) { REFRAME(); \
            pg8::Gemm g{(const bf16*)(Fp.ws + WS_MIXA), (const bf16*)(Fp.ws + WS_WOUTT) + (size_t)l * 1024 * 1024, nrows, 1024, 1024}; \
            pg8::StaticOrder S; S.init(nrows, 1024, Fp.G, (int)blockIdx.x); \
            bf16* XR = (bf16*)(Fp.ws + WS_XR); \
            pg8::EpiResid<(l) == 1> E{ka->in[I_X], ka->in[I_CTX], NLAT, XR, 1024, \
                            (const float*)(Fp.ws + WS_MOD) + (size_t)(l * 5) * 6144 + 2 * 1024, 6144, SEQ, (float*)(Fp.ws + WS_RSSP)}; \
            pg8::gemm_phase<pg8::EpiResid<(l) == 1>, pg8::StaticOrder, PG8_ALIGN, PG8_SP2>(Fp.lds + RING_OFF, g, S, E); \
        } \
        SEAML(7); \
        PHASE(8, ph_ffn_router(Fp, l, nrows, ka->in[I_RW]);) \
        SEAML(8); \
        PHASE(9, ph_route(Fp, nrows);) \
        SEAML(9); \
        if (INL(10) || INL(11)) { REFRAME(); \
            LAS int* tab = (LAS int*)(Fp.lds + MOETAB_OFF); \
            const int ntiles = (int)__hip_atomic_load(Fp.ctl + CW_NTILES, __ATOMIC_RELAXED, __HIP_MEMORY_SCOPE_AGENT); \
            const int* TILEE = (const int*)(Fp.ws + WS_TILEE); \
            for (int i = Fp.tid; i < ntiles && i < SORT_TILES; i += NTHR) tab[i] = TILEE[i]; \
            __syncthreads(); \
            if (INL(10)) { _Pragma("unroll") for (int rep_ = 0; rep_ < NREP(10); ++rep_) { { \
                pg8::Gemm g{(const bf16*)(Fp.ws + WS_ASORT), (const bf16*)(Fp.ws + WS_W1T) + (size_t)l * 32 * 2048 * 1024, 0, 2048, 1024}; \
                pg8::MoeOrder S; S.init(tab, ntiles, 8, Fp.G, (int)blockIdx.x); \
                pg8::EpiSwiglu E{(bf16*)(Fp.ws + WS_ACT), 1024, ka->in[I_MB1] + (size_t)l * 32 * 2048, 2048}; \
                pg8::gemm_phase<pg8::EpiSwiglu, pg8::MoeOrder, PG8_ALIGN, PG8_SP2>(Fp.lds + RING_OFF, g, S, E); \
             } if (rep_ + 1 < NREP(10)) GRID_BAR(); } } \
            SEAML(10); \
            if (INL(11)) { _Pragma("unroll") for (int rep_ = 0; rep_ < NREP(11); ++rep_) { { \
                pg8::Gemm g{(const bf16*)(Fp.ws + WS_ACT), (const bf16*)(Fp.ws + WS_W2T) + (size_t)l * 32 * 1024 * 1024, 0, 1024, 1024}; \
                pg8::MoeOrder S; S.init(tab, ntiles, 4, Fp.G, (int)blockIdx.x); \
                pg8::EpiBf16Bias E{(bf16*)(Fp.ws + WS_YS), 1024, ka->in[I_MB2] + (size_t)l * 32 * 1024, 1024}; \
                pg8::gemm_phase<pg8::EpiBf16Bias, pg8::MoeOrder, PG8_ALIGN, PG8_SP2>(Fp.lds + RING_OFF, g, S, E); \
             } if (rep_ + 1 < NREP(11)) GRID_BAR(); } } \
        } \
        SEAML(11); \
        if (INL(12)) { REFRAME(); ph_combine(Fp, l, nrows, ka->out, ka->in[I_GMIX]); } \
        if (l == 0) { SEAML(12); } \
    }
    LAYER_BODY(0)
    LAYER_BODY(1)
#undef LAYER_BODY
#undef PHASE
#undef IN
#undef SEAM
#undef INL
#undef SEAML
}

extern "C" void kernel_launch(void* const* d_in, const int* in_sizes, int n_in, void* d_out, int out_size, void* d_ws, size_t ws_size, hipStream_t stream) {
    static int grid = 0;
    if (grid == 0) {
        if (n_in != 34 || in_sizes[0] != NLAT * DMODEL || out_size != NLAT * DMODEL || ws_size < WS_END) {
            fprintf(stderr, "kernel_launch: unexpected shapes (n_in %d, in0 %d, out %d, ws %zu); nothing launched\n", n_in, n_in > 0 ? in_sizes[0] : -1, out_size, ws_size); grid = -1; return; }
        int dev = 0, cus = 0;
        if (hipGetDevice(&dev) != hipSuccess || hipDeviceGetAttribute(&cus, hipDeviceAttributeMultiprocessorCount, dev) != hipSuccess) { grid = -1; return; }
        if (hipFuncSetAttribute((const void*)mk_fwd, hipFuncAttributeMaxDynamicSharedMemorySize, LDS_BYTES) != hipSuccess) { fprintf(stderr, "kernel_launch: hipFuncSetAttribute failed\n"); grid = -1; return; }
        int per_cu = 0;
        if (hipOccupancyMaxActiveBlocksPerMultiprocessor(&per_cu, (const void*)mk_fwd, NTHR, LDS_BYTES) != hipSuccess || per_cu < 1) { fprintf(stderr, "kernel_launch: occupancy query says %d\n", per_cu); }
        (void)hipGetLastError();
        grid = cus;
    }
    if (grid < 0) return;
    if (hipMemsetAsync((char*)d_ws + WS_CTL, 0, CTL_ZERO_BYTES, stream) != hipSuccess) return;
    Args a{};
    for (int i = 0; i < 34; ++i) a.in[i] = (const float*)d_in[i];
    a.out = (float*)d_out; a.ws = (unsigned char*)d_ws;
#if MK_PER_PHASE
    for (int p = 0; p < NPH; ++p) { a.ph_lo = p; a.ph_hi = p + 1; hipLaunchKernelGGL(mk_fwd, dim3(grid), dim3(NTHR), LDS_BYTES, stream, a); }
#else
    a.ph_lo = 0; a.ph_hi = NPH;
    hipLaunchKernelGGL(mk_fwd, dim3(grid), dim3(NTHR), LDS_BYTES, stream, a);
#endif
}
```

```cpp
#include <hip/hip_runtime.h>
#include <hip/hip_bf16.h>
#include <cstdio>
#include <cstdint>
#include <cmath>
#ifndef MK_PER_PHASE
#define MK_PER_PHASE 0
#endif
namespace pg8 {
#define PG8_LAS __attribute__((address_space(3)))
typedef unsigned short bf16_t;
typedef short bf16x8 __attribute__((ext_vector_type(8)));
typedef float f32x4 __attribute__((ext_vector_type(4)));
typedef unsigned u32x4 __attribute__((ext_vector_type(4)));
constexpr int BM = 256, BK = 64, HALF = 128, HTB = HALF * BK * 2  , STAGE_BYTES = 8 * HTB, NXCD = 8, WGM = 8;

__host__ __device__ __forceinline__ int lds_byte(int r, int c) { const int st = (r >> 4) * 2 + (c >> 5), rr = r & 15, cc = c & 31, ob = rr * 64 + cc * 2; return st * 1024 + (ob ^ (((ob >> 9) & 1) << 5)); }
__host__ __device__ __forceinline__ void stage_rc(int b, int& R, int& C) { const int st = b / 1024, sb = b % 1024, swz = sb ^ (((sb >> 9) & 1) << 5); R = (st >> 1) * 16 + swz / 64; C = (st & 1) * 32 + (swz % 64) / 2; }
__host__ __device__ __forceinline__ int perm32(int rho) { const int n = rho >> 4, i = rho & 15; return 8 * (i >> 2) + 4 * n + (i & 3); }

struct Unit { int pm, pn, be, e; };
struct Gemm { const bf16_t* A; const bf16_t* Bt; int M, N, K; };

struct StaticOrder {
    static constexpr bool GATHER = false;
    __device__ __forceinline__ int row_of(int r) const { return r; }
    int nM, nN, nwg, G, c;
    __host__ __device__ void init(int M, int N, int G_, int c_) { nM = M / BM; nN = N / BM; nwg = nM * nN; G = G_; c = c_; }
    __host__ __device__ bool next(int i, Unit& u) const {
        const long L = (long)i * G + c; if (L >= nwg) return false;
        int wgid = (int)L; { const int q = nwg / NXCD, r = nwg % NXCD, xcd = wgid % NXCD, off = wgid / NXCD; wgid = (xcd < r ? xcd * (q + 1) : r * (q + 1) + (xcd - r) * q) + off; }
        const int nig = WGM * nN, gid = wgid / nig, fm = gid * WGM, gsz = (nM - fm) < WGM ? (nM - fm) : WGM;
        u.pm = fm + ((wgid % nig) % gsz); u.pn = (wgid % nig) / gsz; u.be = u.pn; u.e = 0; return true;
    }
    __device__ __forceinline__ void a_ready(const Unit&) const {}
    __device__ __forceinline__ void done(const Unit&) const {}
};

__device__ __forceinline__ unsigned cvt_pk_bf16(float lo, float hi) { unsigned r; asm volatile("v_cvt_pk_bf16_f32 %0, %1, %2" : "=v"(r) : "v"(lo), "v"(hi)); return r; }
typedef float f32x2 __attribute__((ext_vector_type(2)));
__device__ __forceinline__ f32x2 gelu_pk(f32x2 v) {
    const f32x2 av = __builtin_elementwise_abs(v), d = av * 0.2316418882f + 1.0f;
    f32x2 t; t.x = __builtin_amdgcn_rcpf(d.x); t.y = __builtin_amdgcn_rcpf(d.y);
    f32x2 q = t * 0.5307027145f + (-0.7265760135f); q = q * t + 0.7107068705f; q = q * t + (-0.142248368f); q = q * t + 0.127414796f; q = q * t;
    const f32x2 s = (v * v) * (-0.72134752044f);
    f32x2 e; e.x = __builtin_amdgcn_exp2f(s.x); e.y = __builtin_amdgcn_exp2f(s.y);
    const f32x2 m = v * (q * e), r = v - m;
    f32x2 o; o.x = v.x < 0.f ? m.x : r.x; o.y = v.y < 0.f ? m.y : r.y; return o;
}

template <int ACT  > struct EpiBf16 {
    static constexpr bool PERM = true, AFTER_DRAIN = false; static_assert(ACT == 0 || ACT == 1, "EpiBf16: ACT is 0 (none) or 1 (gelu_pk)");
    bf16_t* O; int ldc; const float* bias; int split_cols; size_t split_stride; float scale0;
    __device__ __forceinline__ void operator()(const f32x4 (&acc)[2][2][4][2], const Unit& u, int wr, int wc, int fr, int fq) const {
        const int row0 = u.pm * BM + wr * 64 + fr; int colt = u.pn * BM; bf16_t* base = O;
        float sc = 1.f; if (split_cols) { const int t = colt / split_cols; base += (size_t)t * split_stride; colt -= t * split_cols; if (t == 0) sc = scale0; }
        const int col0 = colt + wc * 32 + 8 * fq, bcol0 = u.pn * BM + wc * 32 + 8 * fq;
        f32x4 bv[2][2];
#pragma unroll
        for (int bj = 0; bj < 2; ++bj)
#pragma unroll
            for (int n = 0; n < 2; ++n) bv[bj][n] = bias ? *(const f32x4*)(bias + bcol0 + bj * HALF + 4 * n) : (f32x4){0.f, 0.f, 0.f, 0.f};
#pragma unroll
        for (int ai = 0; ai < 2; ++ai)
#pragma unroll
            for (int m = 0; m < 4; ++m) { bf16_t* rowp = base + (size_t)(row0 + ai * HALF + m * 16) * ldc + col0;
#pragma unroll
                for (int bj = 0; bj < 2; ++bj) { f32x4 v0 = acc[ai][bj][m][0] + bv[bj][0], v1 = acc[ai][bj][m][1] + bv[bj][1];
                    if (ACT == 1) { f32x2 a = gelu_pk((f32x2){v0[0], v0[1]}), b = gelu_pk((f32x2){v0[2], v0[3]}), c = gelu_pk((f32x2){v1[0], v1[1]}), d = gelu_pk((f32x2){v1[2], v1[3]});
                        v0 = (f32x4){a.x, a.y, b.x, b.y}; v1 = (f32x4){c.x, c.y, d.x, d.y}; }
                    v0 = v0 * sc; v1 = v1 * sc; u32x4 w; w.x = cvt_pk_bf16(v0[0], v0[1]); w.y = cvt_pk_bf16(v0[2], v0[3]); w.z = cvt_pk_bf16(v1[0], v1[1]); w.w = cvt_pk_bf16(v1[2], v1[3]);
                    *(u32x4*)(rowp + bj * HALF) = w; } }
    }
};


template <bool XIN_BF16> struct EpiResid {
    static constexpr bool PERM = false, AFTER_DRAIN = false;
    const float* xin_lat; const float* xin_ctx; int nlat; bf16_t* XR; int ldc; const float* mod; int mod_stride; int seq; float* rssp;
    __device__ __forceinline__ void operator()(const f32x4 (&acc)[2][2][4][2], const Unit& u, int wr, int wc, int fr, int fq) const {
        typedef unsigned u32x2 __attribute__((ext_vector_type(2)));
        const int row0 = u.pm * BM + wr * 64 + fr, col0 = u.pn * BM + wc * 32 + 4 * fq;
        const int rowt = u.pm * BM; const int bidx = rowt < nlat ? rowt / seq : 4;
        const float* gate = mod + (size_t)bidx * mod_stride;
        const float* xin = rowt < nlat ? xin_lat : (xin_ctx - (size_t)nlat * ldc);
        f32x4 gv[2][2];
#pragma unroll
        for (int bj = 0; bj < 2; ++bj)
#pragma unroll
            for (int n = 0; n < 2; ++n) gv[bj][n] = *(const f32x4*)(gate + col0 + bj * HALF + n * 16);
#pragma unroll
        for (int ai = 0; ai < 2; ++ai)
#pragma unroll
            for (int m = 0; m < 4; ++m) { const int row = row0 + ai * HALF + m * 16; const size_t ro = (size_t)row * ldc + col0; float s2 = 0.f;
#pragma unroll
                for (int bj = 0; bj < 2; ++bj)
#pragma unroll
                    for (int n = 0; n < 2; ++n) { const size_t idx = ro + bj * HALF + n * 16; f32x4 xv;
                        if (XIN_BF16) { const u32x2 w = *(const u32x2*)(XR + idx); xv = (f32x4){__builtin_bit_cast(float, w.x << 16), __builtin_bit_cast(float, w.x & 0xffff0000u), __builtin_bit_cast(float, w.y << 16), __builtin_bit_cast(float, w.y & 0xffff0000u)}; }
                        else xv = *(const f32x4*)(xin + idx);
                        const f32x4 v = xv + gv[bj][n] * acc[ai][bj][m][n];
                        s2 += (v[0] * v[0] + v[1] * v[1]) + (v[2] * v[2] + v[3] * v[3]);
                        u32x2 o; o.x = cvt_pk_bf16(v[0], v[1]); o.y = cvt_pk_bf16(v[2], v[3]); *(u32x2*)(XR + idx) = o; }
                s2 += __shfl_xor(s2, 16); s2 += __shfl_xor(s2, 32);
                if (fq == 0) rssp[(size_t)row * 16 + u.pn * 4 + wc] = s2; }
    }
};
struct EpiSwiglu {
    static constexpr bool PERM = true, AFTER_DRAIN = false;
    bf16_t* O; int ldc; const float* bias; int bias_stride;
    __device__ __forceinline__ void operator()(const f32x4 (&acc)[2][2][4][2], const Unit& u, int wr, int wc, int fr, int fq) const {
        const int row0 = u.pm * BM + wr * 64 + fr; const int bcol0 = u.pn * BM + wc * 32 + 8 * fq; const int ocol0 = bcol0 >> 1;
        const float* bb = bias + (size_t)u.e * bias_stride;
        f32x4 bv[2][2];
#pragma unroll
        for (int bj = 0; bj < 2; ++bj)
#pragma unroll
            for (int n = 0; n < 2; ++n) bv[bj][n] = *(const f32x4*)(bb + bcol0 + bj * HALF + 4 * n);
#pragma unroll
        for (int ai = 0; ai < 2; ++ai)
#pragma unroll
            for (int m = 0; m < 4; ++m) { bf16_t* rowp = O + (size_t)(row0 + ai * HALF + m * 16) * ldc + ocol0;
#pragma unroll
                for (int bj = 0; bj < 2; ++bj) { const f32x4 v0 = acc[ai][bj][m][0] + bv[bj][0], v1 = acc[ai][bj][m][1] + bv[bj][1];
                    float o[4];
#pragma unroll
                    for (int p = 0; p < 4; ++p) { const float hg = p < 2 ? v0[2 * p] : v1[2 * p - 4], hl = p < 2 ? v0[2 * p + 1] : v1[2 * p - 3];
                        const float glu = fminf(hg, 7.0f), lin = fminf(fmaxf(hl, -7.0f), 7.0f);
                        const float sg = __builtin_amdgcn_rcpf(1.0f + __builtin_amdgcn_exp2f(-1.702f * 1.4426950408889634f * glu));
                        o[p] = glu * sg * (lin + 1.0f); }
                    typedef unsigned u32x2 __attribute__((ext_vector_type(2)));
                    u32x2 w; w.x = cvt_pk_bf16(o[0], o[1]); w.y = cvt_pk_bf16(o[2], o[3]);
                    *(u32x2*)(rowp + bj * (HALF / 2)) = w; } }
    }
};
struct EpiBf16Bias {
    static constexpr bool PERM = true, AFTER_DRAIN = false;
    bf16_t* O; int ldc; const float* bias; int bias_stride;
    __device__ __forceinline__ void operator()(const f32x4 (&acc)[2][2][4][2], const Unit& u, int wr, int wc, int fr, int fq) const {
        const int row0 = u.pm * BM + wr * 64 + fr; const int col0 = u.pn * BM + wc * 32 + 8 * fq;
        const float* bb = bias + (size_t)u.e * bias_stride;
        f32x4 bv[2][2];
#pragma unroll
        for (int bj = 0; bj < 2; ++bj)
#pragma unroll
            for (int n = 0; n < 2; ++n) bv[bj][n] = *(const f32x4*)(bb + col0 + bj * HALF + 4 * n);
#pragma unroll
        for (int ai = 0; ai < 2; ++ai)
#pragma unroll
            for (int m = 0; m < 4; ++m) { bf16_t* rowp = O + (size_t)(row0 + ai * HALF + m * 16) * ldc + col0;
#pragma unroll
                for (int bj = 0; bj < 2; ++bj) { const f32x4 v0 = acc[ai][bj][m][0] + bv[bj][0], v1 = acc[ai][bj][m][1] + bv[bj][1];
                    u32x4 w; w.x = cvt_pk_bf16(v0[0], v0[1]); w.y = cvt_pk_bf16(v0[2], v0[3]); w.z = cvt_pk_bf16(v1[0], v1[1]); w.w = cvt_pk_bf16(v1[2], v1[3]);
                    *(u32x4*)(rowp + bj * HALF) = w; } }
    }
};
struct EpiLruGate {
    static constexpr bool PERM = false, AFTER_DRAIN = false;
    const bf16_t* XL; bf16_t* LAB; size_t lab_stride; const float* gb; const float* spt;
    __device__ __forceinline__ void operator()(const f32x4 (&acc)[2][2][4][2], const Unit& u, int wr, int wc, int fr, int fq) const {
        const int d = u.pn >> 1, half = u.pn & 1;
        const int row0 = u.pm * BM + wr * 64 + fr, ch0 = half * 128 + wc * 32 + 4 * fq;
        bf16_t* LA = LAB + (size_t)(2 * d) * lab_stride; bf16_t* LB = LAB + (size_t)(2 * d + 1) * lab_stride;
#pragma unroll
        for (int n = 0; n < 2; ++n) {
            const f32x4 bR = *(const f32x4*)(gb + (d * 2 + 0) * 256 + ch0 + 16 * n), bI = *(const f32x4*)(gb + (d * 2 + 1) * 256 + ch0 + 16 * n);
            const f32x4 sp = *(const f32x4*)(spt + d * 256 + ch0 + 16 * n) * (-8.0f * 1.4426950408889634f);
#pragma unroll
            for (int ai = 0; ai < 2; ++ai)
#pragma unroll
                for (int m = 0; m < 4; ++m) { const size_t ro = (size_t)(row0 + ai * HALF + m * 16) * 256 + ch0 + 16 * n;
                    typedef unsigned u32x2 __attribute__((ext_vector_type(2)));
                    const u32x2 xw = *(const u32x2*)(XL + ro);
                    const float xl[4] = {__builtin_bit_cast(float, xw.x << 16), __builtin_bit_cast(float, xw.x & 0xffff0000u), __builtin_bit_cast(float, xw.y << 16), __builtin_bit_cast(float, xw.y & 0xffff0000u)};
                    const f32x4 gr = acc[ai][0][m][n] + bR, gi = acc[ai][1][m][n] + bI;
                    f32x4 av, bv;
#pragma unroll
                    for (int e = 0; e < 4; ++e) {
                        const float rg = __builtin_amdgcn_rcpf(1.0f + __builtin_amdgcn_exp2f(-1.4426950408889634f * gr[e])), ig = __builtin_amdgcn_rcpf(1.0f + __builtin_amdgcn_exp2f(-1.4426950408889634f * gi[e]));
                        const float la2 = rg * sp[e];
                        const float a2 = __builtin_amdgcn_exp2f(2.0f * la2);
                        av[e] = la2; bv[e] = __builtin_amdgcn_sqrtf(fmaxf(1.0f - a2, 0.f)) * (ig * xl[e]); }
                    u32x2 wa, wb; wa.x = cvt_pk_bf16(av[0], av[1]); wa.y = cvt_pk_bf16(av[2], av[3]); wb.x = cvt_pk_bf16(bv[0], bv[1]); wb.y = cvt_pk_bf16(bv[2], bv[3]);
                    *(u32x2*)(LA + ro) = wa; *(u32x2*)(LB + ro) = wb; }
        }
    }
};
template <bool GATHER_> struct MoeOrderT {
    static constexpr bool GATHER = GATHER_;
    const int* rowtok;
    __device__ __forceinline__ int row_of(int r) const { return GATHER_ ? rowtok[r] : r; }
    const PG8_LAS int* tab; int ntiles, nN, nper, j, m_lo, nMx;
    __device__ __forceinline__ void init(const PG8_LAS int* tab_, int ntiles_, int nN_, int G, int bx) {
        tab = tab_; ntiles = ntiles_; nN = nN_;
        if (G % 8 == 0) { const int x = bx % 8; nper = G / 8; j = bx / 8; m_lo = (x * ntiles) / 8; nMx = ((x + 1) * ntiles) / 8 - m_lo; }
        else { nper = G; j = bx; m_lo = 0; nMx = ntiles; }
    }
    __device__ __forceinline__ bool next(int i, Unit& u) const {
        const int s = i * nper + j; if (s >= nMx * nN) return false;
        const int nig = 8 * nN, gid = s / nig, fm = gid * 8, gsz = (nMx - fm) < 8 ? (nMx - fm) : 8, w = s - gid * nig;
        u.pm = m_lo + fm + (w % gsz); u.pn = w / gsz; u.e = tab[u.pm]; u.be = u.e * nN + u.pn; return true;
    }
    __device__ __forceinline__ void a_ready(const Unit&) const {}
    __device__ __forceinline__ void done(const Unit&) const {}
};
template <class Epi, class Sched, bool ALIGN_EPI = false, bool SP2 = false>
__device__ __forceinline__ void gemm_phase(PG8_LAS unsigned char* lds, const Gemm g, const Sched& S, const Epi& E) {
    int tid_ = threadIdx.x; asm volatile("" : "+v"(tid_));
    const int tid = tid_, wid = __builtin_amdgcn_readfirstlane(tid >> 6), lane = tid & 63, wr = wid >> 2, wc = wid & 3, fr = lane & 15, fq = lane >> 4;
    const int K = g.K, nt = K / BK;
    unsigned voffA[2], voffB[2];
#pragma unroll
    for (int i = 0; i < 2; ++i) { int R, C; stage_rc(tid * 16 + i * 8192, R, C); const int Rb = Epi::PERM ? ((R & ~31) + perm32(R & 31)) : R;
        voffA[i] = (unsigned)(R * K + C) * 2u; voffB[i] = (unsigned)(Rb * K + C) * 2u; }
    unsigned gA_[2][2] = {{0u, 0u}, {0u, 0u}}, gN_[2][2] = {{0u, 0u}, {0u, 0u}};
    static_assert(!Sched::GATHER || SP2, "the gathered A operand is wired into the SP2 loop only");
#define PG8_GLOAD(dst, pm_) do { _Pragma("unroll") for (int h_ = 0; h_ < 2; ++h_) _Pragma("unroll") for (int i_ = 0; i_ < 2; ++i_) { int R_, C_; stage_rc(tid * 16 + i_ * 8192, R_, C_); \
        dst[h_][i_] = (unsigned)S.row_of((pm_) * BM + h_ * HALF + R_) * (unsigned)(K * 2) + (unsigned)(C_ * 2); } } while (0)
    const size_t kstep = (size_t)(BK * 2);
    const size_t hstep = (size_t)HALF * K * 2;
    const size_t tstep = 2 * hstep;
    const unsigned ldsw = (unsigned)wid * 1024u;
    const int aoff = lds_byte(wr * 64 + fr, fq * 8), boff = lds_byte(wc * 32 + fr, fq * 8);
#define PG8_SA(b, h) (((b) * 2 + (h)) * HTB)
#define PG8_SB(b, h) ((4 + (b) * 2 + (h)) * HTB)
#define PG8_STAGE(bufoff, gbase, voff) do { _Pragma("unroll") for (int _i = 0; _i < 2; ++_i) \
        __builtin_amdgcn_global_load_lds((const unsigned*)((const char*)(gbase) + (voff)[_i]), (PG8_LAS unsigned*)(lds + (bufoff) + ldsw + _i * 8192), 16, 0, 0); } while (0)
#define PG8_STA(bufoff, ptr, h, useN) do { if constexpr (Sched::GATHER) { unsigned o_[2] = {(useN) ? gN_[h][0] : gA_[h][0], (useN) ? gN_[h][1] : gA_[h][1]}; PG8_STAGE(bufoff, ptr, o_); } \
        else { PG8_STAGE(bufoff, (ptr) + ((h) ? hstep : 0), voffA); } } while (0)
#define PG8_LDA(dst, b, h) do { _Pragma("unroll") for (int m = 0; m < 4; ++m) _Pragma("unroll") for (int k = 0; k < 2; ++k) dst[m][k] = *(const PG8_LAS bf16x8*)(lds + PG8_SA(b, h) + aoff + m * 2048 + k * 1024); } while (0)
#define PG8_LDB(dst, b, h) do { _Pragma("unroll") for (int n = 0; n < 2; ++n) _Pragma("unroll") for (int k = 0; k < 2; ++k) dst[n][k] = *(const PG8_LAS bf16x8*)(lds + PG8_SB(b, h) + boff + n * 2048 + k * 1024); } while (0)
#define PG8_MMA(ai, bj, At, Bt) do { __builtin_amdgcn_s_setprio(1); _Pragma("unroll") for (int m = 0; m < 4; ++m) _Pragma("unroll") for (int n = 0; n < 2; ++n) _Pragma("unroll") for (int k = 0; k < 2; ++k) \
        acc[ai][bj][m][n] = __builtin_amdgcn_mfma_f32_16x16x32_bf16(Bt[n][k], At[m][k], acc[ai][bj][m][n], 0, 0, 0); __builtin_amdgcn_s_setprio(0); } while (0)
#define PG8_WAIT_V(n) asm volatile("s_waitcnt vmcnt(" #n ")" ::: "memory")
#define PG8_WAIT_L(n) asm volatile("s_waitcnt lgkmcnt(" #n ")" ::: "memory")
#define PG8_BAR __builtin_amdgcn_s_barrier()
#define PG8_SCHED __builtin_amdgcn_sched_barrier(0)
    Unit cur, nxt; int ui = 0;
    if (!S.next(0, cur)) return;
    f32x4 acc[2][2][4][2];
#pragma unroll
    for (int a = 0; a < 2; ++a)
#pragma unroll
        for (int b = 0; b < 2; ++b)
#pragma unroll
            for (int m = 0; m < 4; ++m)
#pragma unroll
                for (int n = 0; n < 2; ++n) acc[a][b][m][n] = (f32x4){0.f, 0.f, 0.f, 0.f};
    bf16x8 At[4][2], B0[2][2], B1[2][2];
    const char* cA = (const char*)g.A + (Sched::GATHER ? (size_t)0 : (size_t)cur.pm * tstep); if constexpr (Sched::GATHER) PG8_GLOAD(gA_, cur.pm);
    const char* cB = (const char*)g.Bt + (size_t)cur.be * tstep;
    S.a_ready(cur);
    if constexpr (SP2) {
        PG8_STAGE(PG8_SB(0, 0), cB, voffB); PG8_STAGE(PG8_SB(0, 1), cB + hstep, voffB); PG8_STA(PG8_SA(0, 0), cA, 0, false); PG8_STA(PG8_SA(0, 1), cA, 1, false);
        if (wr == 1) PG8_BAR;
        PG8_WAIT_V(2); PG8_BAR;
        PG8_STAGE(PG8_SB(1, 0), cB + kstep, voffB); PG8_STA(PG8_SA(1, 0), cA + kstep, 0, false); PG8_STAGE(PG8_SB(1, 1), cB + hstep + kstep, voffB);
        PG8_WAIT_V(6); PG8_BAR;
    } else {
        PG8_STAGE(PG8_SB(0, 0), cB, voffB); PG8_STAGE(PG8_SA(0, 0), cA, voffA); PG8_STAGE(PG8_SB(0, 1), cB + hstep, voffB); PG8_STAGE(PG8_SA(0, 1), cA + hstep, voffA);
        if (wr == 1) PG8_BAR;
        PG8_WAIT_V(4); PG8_BAR;
        PG8_STAGE(PG8_SB(1, 0), cB + kstep, voffB); PG8_STAGE(PG8_SA(1, 0), cA + kstep, voffA); PG8_STAGE(PG8_SB(1, 1), cB + hstep + kstep, voffB);
        PG8_WAIT_V(6); PG8_BAR;
    }
    for (;;) {
        const bool has_next = S.next(ui + 1, nxt);
        const char* nA = (has_next && !Sched::GATHER) ? (const char*)g.A + (size_t)nxt.pm * tstep : cA; const char* nB = has_next ? (const char*)g.Bt + (size_t)nxt.be * tstep : cB;
        for (int t = 0; t < nt; t += 2) {
            const bool last = (t == nt - 2);
            const char* a1 = cA + (size_t)(t + 1) * kstep;
            const char* a2 = last ? nA : cA + (size_t)(t + 2) * kstep; const char* b2 = last ? nB : cB + (size_t)(t + 2) * kstep;
            const char* a3 = a2 + kstep; const char* b3 = b2 + kstep;
            if (last && has_next) S.a_ready(nxt);
            if constexpr (Sched::GATHER) { if (last) { if (has_next) PG8_GLOAD(gN_, nxt.pm); else { gN_[0][0] = gA_[0][0]; gN_[0][1] = gA_[0][1]; gN_[1][0] = gA_[1][0]; gN_[1][1] = gA_[1][1]; } } }
            if constexpr (SP2) {
            PG8_LDB(B0, 0, 0); PG8_LDB(B1, 0, 1); PG8_SCHED; PG8_LDA(At, 0, 0); PG8_STA(PG8_SA(1, 1), a1, 1, false);
            PG8_WAIT_V(8); PG8_WAIT_L(0); PG8_BAR; PG8_MMA(0, 0, At, B0); PG8_MMA(0, 1, At, B1); PG8_BAR; PG8_SCHED;
            PG8_LDA(At, 0, 1); PG8_STAGE(PG8_SB(0, 0), b2, voffB); PG8_STAGE(PG8_SB(0, 1), b2 + hstep, voffB); PG8_STA(PG8_SA(0, 0), a2, 0, last);
            PG8_WAIT_V(8); PG8_WAIT_L(0); PG8_BAR; PG8_MMA(1, 0, At, B0); PG8_MMA(1, 1, At, B1); PG8_BAR; PG8_SCHED;
            PG8_LDB(B0, 1, 0); PG8_LDB(B1, 1, 1); PG8_SCHED; PG8_LDA(At, 1, 0); PG8_STA(PG8_SA(0, 1), a2, 1, last);
            PG8_WAIT_V(8); PG8_WAIT_L(0); PG8_BAR; PG8_MMA(0, 0, At, B0); PG8_MMA(0, 1, At, B1); PG8_BAR; PG8_SCHED;
            PG8_LDA(At, 1, 1); PG8_STAGE(PG8_SB(1, 0), b3, voffB); PG8_STAGE(PG8_SB(1, 1), b3 + hstep, voffB); PG8_STA(PG8_SA(1, 0), a3, 0, last);
            PG8_WAIT_V(8); PG8_WAIT_L(0); PG8_BAR; PG8_MMA(1, 0, At, B0); PG8_MMA(1, 1, At, B1); PG8_BAR; PG8_SCHED;
            } else {
            PG8_LDB(B0, 0, 0); PG8_SCHED; PG8_LDA(At, 0, 0); PG8_STAGE(PG8_SA(1, 1), a1 + hstep, voffA);
            PG8_WAIT_L(8); PG8_BAR; PG8_WAIT_L(0); PG8_MMA(0, 0, At, B0); PG8_BAR; PG8_SCHED;
            PG8_LDB(B1, 0, 1); PG8_STAGE(PG8_SB(0, 0), b2, voffB);
            PG8_BAR; PG8_WAIT_L(0); PG8_MMA(0, 1, At, B1); PG8_BAR;
            PG8_LDA(At, 0, 1); PG8_STAGE(PG8_SA(0, 0), a2, voffA);
            PG8_BAR; PG8_WAIT_L(0); PG8_MMA(1, 0, At, B0); PG8_BAR; PG8_SCHED;
            PG8_STAGE(PG8_SB(0, 1), b2 + hstep, voffB);
            PG8_WAIT_V(6); PG8_BAR; PG8_MMA(1, 1, At, B1); PG8_BAR;
            PG8_LDB(B0, 1, 0); PG8_SCHED; PG8_LDA(At, 1, 0); PG8_STAGE(PG8_SA(0, 1), a2 + hstep, voffA);
            PG8_WAIT_L(8); PG8_BAR; PG8_WAIT_L(0); PG8_MMA(0, 0, At, B0); PG8_BAR; PG8_SCHED;
            PG8_LDB(B1, 1, 1); PG8_STAGE(PG8_SB(1, 0), b3, voffB);
            PG8_BAR; PG8_WAIT_L(0); PG8_MMA(0, 1, At, B1); PG8_BAR;
            PG8_LDA(At, 1, 1); PG8_STAGE(PG8_SA(1, 0), a3, voffA);
            PG8_BAR; PG8_WAIT_L(0); PG8_MMA(1, 0, At, B0); PG8_BAR; PG8_SCHED;
            PG8_STAGE(PG8_SB(1, 1), b3 + hstep, voffB);
            PG8_WAIT_V(6); PG8_BAR; PG8_MMA(1, 1, At, B1); PG8_BAR;
            }
        }
        if constexpr (ALIGN_EPI) { if (wr == 0) PG8_BAR; }
        if constexpr (!Epi::AFTER_DRAIN) { E(acc, cur, wr, wc, fr, fq); S.done(cur); }
        if (!has_next) break;
#pragma unroll
        for (int a = 0; a < 2; ++a)
#pragma unroll
            for (int b = 0; b < 2; ++b)
#pragma unroll
                for (int m = 0; m < 4; ++m)
#pragma unroll
                    for (int n = 0; n < 2; ++n) acc[a][b][m][n] = (f32x4){0.f, 0.f, 0.f, 0.f};
        cur = nxt; cA = nA; cB = nB; ++ui;
        if constexpr (Sched::GATHER) { gA_[0][0] = gN_[0][0]; gA_[0][1] = gN_[0][1]; gA_[1][0] = gN_[1][0]; gA_[1][1] = gN_[1][1]; }
        if constexpr (ALIGN_EPI) { if (wr == 1) PG8_BAR; }
    }
    PG8_WAIT_V(0);
    if constexpr (!ALIGN_EPI) { if (wr == 0) PG8_BAR; }
    PG8_BAR;
    if constexpr (Epi::AFTER_DRAIN) { E.fused(acc, cur, wr, wc, fr, fq, lds, wid, lane); S.done(cur); }
#undef PG8_SA
#undef PG8_SB
#undef PG8_STAGE
#undef PG8_STA
#undef PG8_GLOAD
#undef PG8_LDA
#undef PG8_LDB
#undef PG8_MMA
#undef PG8_WAIT_V
#undef PG8_WAIT_L
#undef PG8_BAR
#undef PG8_SCHED
}
}

#ifndef PG8_SP2
#define PG8_SP2 true
#endif
#ifndef PG8_ALIGN
#define PG8_ALIGN true
#endif
#include <cmath>
namespace attn_body {
using bf16=__hip_bfloat16;
using bf16x8=__attribute__((ext_vector_type(8)))short;
using s16x4=__attribute__((ext_vector_type(4)))short;
using f32x16=__attribute__((ext_vector_type(16)))float;
using u32x4=__attribute__((ext_vector_type(4)))unsigned;
constexpr int NHEAD=8,SEQQ=8192,SEQK=8448,D=64,QP=512,KP=128;
constexpr int NW=8,QBLK=32,QB=QBLK*NW,KVBLK=64,NQB=SEQQ/QB;
constexpr int ATTN_UNIT_ROWS=QB;
__device__ __forceinline__ int crow(int r,int hi){return (r&3)+8*(r>>2)+4*hi;}
#define SBAR() __builtin_amdgcn_sched_barrier(0)
__device__ __forceinline__ void cmask(f32x16&p0,f32x16&p1,int jb,int qrel,int hi){
  const float NEG=-INFINITY; int kb=64*jb+4*hi;
  #pragma unroll
  for(int r=0;r<16;++r){int kv=kb+(r&3)+8*(r>>2); if(kv>qrel)p0[r]=NEG; if(kv+32>qrel)p1[r]=NEG;}
}

constexpr int NSLOT=3, SLOTB=8192;
constexpr int LDS_K=0, LDS_V=NSLOT*SLOTB, LDS_WS=2*NSLOT*SLOTB, LDS_OST=LDS_WS+NW*64*4, LDS_BYTES=LDS_OST+NW*4096;
constexpr float C2=0.125f*1.4426950408889634f;
__device__ __forceinline__ void glds16(const void*gsrc,unsigned lds_dst){unsigned keep;
  asm volatile("s_mov_b32 %0, m0\n\ts_mov_b32 m0, %2\n\ts_nop 0\n\tglobal_load_lds_dwordx4 %1, off\n\ts_mov_b32 m0, %0":"=&s"(keep):"v"(gsrc),"s"(lds_dst):"memory");}
__device__ __forceinline__ float max3f(float a,float b,float c){float r;asm("v_max3_f32 %0, %1, %2, %3":"=v"(r):"v"(a),"v"(b),"v"(c));return r;}
__device__ __forceinline__ float max2f(float a,float b){float r;asm("v_max_f32_e32 %0, %1, %2":"=v"(r):"v"(a),"v"(b));return r;}
__device__ __forceinline__ float fadd_s(float a,float b){float r;asm("v_add_f32_e32 %0, %1, %2":"=v"(r):"v"(a),"v"(b));return r;}
__device__ __forceinline__ float fsub_s(float a,float b){float r;asm("v_sub_f32_e32 %0, %1, %2":"=v"(r):"v"(a),"v"(b));return r;}
typedef float f32x2_t __attribute__((ext_vector_type(2))); typedef __bf16 bf16x2_t __attribute__((ext_vector_type(2)));
__device__ __forceinline__ unsigned cvtpk_s(float lo,float hi){f32x2_t v={lo,hi};bf16x2_t b=__builtin_convertvector(v,bf16x2_t);return __builtin_bit_cast(unsigned,b);}
#define WAIT_BAR(N) asm volatile("s_waitcnt vmcnt(" #N ") lgkmcnt(0)\n\ts_barrier":::"memory")

__device__ __forceinline__ void qkt(f32x16&p0,f32x16&p1,const char*Kslot,const bf16x8*qr,const f32x16&negm,int r32,int hi){
  const char*kb=Kslot+hi*1024+r32*16;
  #pragma unroll
  for(int d0=0;d0<4;++d0){
    const bf16x8 b0=*reinterpret_cast<const bf16x8*>(kb+d0*2048);
    const bf16x8 b1=*reinterpret_cast<const bf16x8*>(kb+d0*2048+512);
    if(d0==0){p0=__builtin_amdgcn_mfma_f32_32x32x16_bf16(b0,qr[0],negm,0,0,0);p1=__builtin_amdgcn_mfma_f32_32x32x16_bf16(b1,qr[0],negm,0,0,0);}
    else{p0=__builtin_amdgcn_mfma_f32_32x32x16_bf16(b0,qr[d0],p0,0,0,0);p1=__builtin_amdgcn_mfma_f32_32x32x16_bf16(b1,qr[d0],p1,0,0,0);}}
}
typedef __attribute__((address_space(3))) const char* lds_cptr;
typedef short v4i16_t __attribute__((ext_vector_type(4)));
__device__ __forceinline__ void kload8(bf16x8*kf,lds_cptr kp){
  kf[0]=*(const __attribute__((address_space(3))) bf16x8*)(kp);      kf[1]=*(const __attribute__((address_space(3))) bf16x8*)(kp+512);
  kf[2]=*(const __attribute__((address_space(3))) bf16x8*)(kp+2048); kf[3]=*(const __attribute__((address_space(3))) bf16x8*)(kp+2560);
  kf[4]=*(const __attribute__((address_space(3))) bf16x8*)(kp+4096); kf[5]=*(const __attribute__((address_space(3))) bf16x8*)(kp+4608);
  kf[6]=*(const __attribute__((address_space(3))) bf16x8*)(kp+6144); kf[7]=*(const __attribute__((address_space(3))) bf16x8*)(kp+6656);
}
__device__ __forceinline__ void kload2(bf16x8*kf,lds_cptr kp,int j){ kf[2*j]=*(const __attribute__((address_space(3))) bf16x8*)(kp+j*2048); kf[2*j+1]=*(const __attribute__((address_space(3))) bf16x8*)(kp+j*2048+512); }
__device__ __forceinline__ s16x4 vtr(lds_cptr p){ return __builtin_bit_cast(s16x4,__builtin_amdgcn_ds_read_tr16_b64_v4i16((__attribute__((address_space(3))) v4i16_t*)p)); }
__device__ __forceinline__ float rowmax(const f32x16&p0,const f32x16&p1){
  float a=max3f(p0[0],p0[1],p1[0]),b=max3f(p0[2],p0[3],p1[1]);a=max3f(a,p1[2],p1[3]);
  #pragma unroll
  for(int r=4;r<16;r+=4){a=max3f(a,p0[r],p0[r+1]);b=max3f(b,p0[r+2],p0[r+3]);a=max3f(a,p1[r],p1[r+1]);b=max3f(b,p1[r+2],p1[r+3]);}
  const float m=max2f(a,b);
  auto rr=__builtin_amdgcn_permlane32_swap(__float_as_uint(m),__float_as_uint(m),false,false);
  return max2f(__uint_as_float(rr[0]),__uint_as_float(rr[1]));
}
__device__ __forceinline__ void pv(f32x16*o,int vb,bf16x8 pa0,bf16x8 pa1,bf16x8 pa2,bf16x8 pa3){
  #pragma unroll
  for(int d0=0;d0<2;++d0){s16x4 lo[4],hi[4];
    #pragma unroll
    for(int ks=0;ks<4;++ks){
      asm volatile("ds_read_b64_tr_b16 %0,%1 offset:%c2":"=&v"(lo[ks]):"v"(vb),"i"(d0*4096+ks*1024):"memory");
      asm volatile("ds_read_b64_tr_b16 %0,%1 offset:%c2":"=&v"(hi[ks]):"v"(vb),"i"(d0*4096+ks*1024+512):"memory");}
    asm volatile("s_waitcnt lgkmcnt(0)":::"memory");SBAR();
    #define PK(k) (bf16x8){lo[k][0],lo[k][1],lo[k][2],lo[k][3],hi[k][0],hi[k][1],hi[k][2],hi[k][3]}
    o[d0]=__builtin_amdgcn_mfma_f32_32x32x16_bf16(pa0,PK(0),o[d0],0,0,0);
    o[d0]=__builtin_amdgcn_mfma_f32_32x32x16_bf16(pa1,PK(1),o[d0],0,0,0);
    o[d0]=__builtin_amdgcn_mfma_f32_32x32x16_bf16(pa2,PK(2),o[d0],0,0,0);
    o[d0]=__builtin_amdgcn_mfma_f32_32x32x16_bf16(pa3,PK(3),o[d0],0,0,0);
    #undef PK
  }
}

#ifndef ATTN_STORE16
#define ATTN_STORE16(p,v) (*(u32x4*)(p)=(v))
#endif
template<int THRL> __device__ __forceinline__ void attn_unit(int b,int h,long qrow0,int NTarg,const bf16*Q,const bf16*__restrict__ K,const bf16*__restrict__ V,bf16*O,char*shm){
  int tid_=threadIdx.x; asm volatile("":"+v"(tid_)); const int tid=tid_,lane=tid&63,r32=lane&31,hi=lane>>5; const int wid=__builtin_amdgcn_readfirstlane(tid>>6);
  const long krowbase=(long)b*SEQK; const int kvh=h>>2;
  const bf16*Qw=Q+(qrow0+wid*QBLK)*QP+h*D;
  const bf16*Kh=K+krowbase*KP+kvh*D,*Vh=V+krowbase*KP+kvh*D;
  const unsigned lds0=(unsigned)(uintptr_t)shm;
  float*wsf=(float*)(shm+LDS_WS)+wid*64;
  const bf16*ksrc=Kh+(long)lane*KP+wid*8;
  const bf16*vsrc=Vh+(long)(16*(wid&3)+(lane>>2))*KP+(wid>>2)*32+(lane&3)*8;
  const unsigned kdst=lds0+LDS_K+wid*1024, vdst=lds0+LDS_V+wid*1024;
  #define DMA_K(t,slot) glds16(ksrc+(long)(t)*KVBLK*KP,(unsigned)__builtin_amdgcn_readfirstlane(kdst+(slot)))
  #define DMA_V(t,slot) glds16(vsrc+(long)(t)*KVBLK*KP,(unsigned)__builtin_amdgcn_readfirstlane(vdst+(slot)))
  const int vb0=(int)(lds0+LDS_V)+((lane>>4)&1)*32+(lane&3)*8+(4*hi+((lane&15)>>2))*64;
  const char*Kbase=shm+LDS_K; bf16x8 kf[8];
  const lds_cptr shm3=(lds_cptr)shm; const lds_cptr kp0=shm3+LDS_K+hi*1024+r32*16; const lds_cptr vp0=shm3+LDS_V+((lane>>4)&1)*32+(lane&3)*8+(4*hi+((lane&15)>>2))*64;
  const int NT=NTarg;
  DMA_K(0,0);DMA_V(0,0);DMA_K(1,SLOTB);
  bf16x8 qr[4];
  #pragma unroll
  for(int d0=0;d0<4;++d0)qr[d0]=*reinterpret_cast<const bf16x8*>(&Qw[(long)r32*QP+d0*16+hi*8]);
  float mhat=0.f,l_reg=0.f;f32x16 o[2];o[0]=f32x16{};o[1]=f32x16{};f32x16 negm=f32x16{};asm volatile("":"+v"(negm));
  const int qrel=wid*QBLK+r32;
  #define CMASK(P0,P1,t) do{}while(0)
  bool resc=false;
  #define START(P0,P1) do{ const float rm=rowmax(P0,P1); resc=false; \
    { const float dl=rm; mhat=fadd_s(mhat,dl); \
      _Pragma("unroll") for(int r=0;r<16;++r){P0[r]=fsub_s(P0[r],dl);P1[r]=fsub_s(P1[r],dl);} \
      _Pragma("unroll") for(int r=0;r<16;++r)negm[r]=-mhat; asm volatile("":"+v"(negm)); } \
    _Pragma("unroll") for(int r=0;r<16;++r)P0[r]=__builtin_amdgcn_exp2f(P0[r]); }while(0)
  #define RESC() do{ if(resc){ asm volatile("s_waitcnt lgkmcnt(0)":::"memory"); \
      _Pragma("unroll") for(int d_=0;d_<2;++d_) _Pragma("unroll") for(int r=0;r<16;++r)o[d_][r]*=wsf[crow(r,hi)]; } }while(0)
  f32x16 pA0,pA1,pB0,pB1;
  int sl_prev=0,sl_cur=0,sl_next=SLOTB;
  #define ROT() do{sl_prev=sl_cur;sl_cur=sl_next;sl_next=(sl_next==(NSLOT-1)*SLOTB)?0:sl_next+SLOTB;}while(0)
  DMA_K(2,2*SLOTB);
  WAIT_BAR(3);
  qkt(pA0,pA1,Kbase,qr,negm,r32,hi);asm volatile("s_nop 15\n\ts_nop 7":"+v"(pA0),"+v"(pA1));CMASK(pA0,pA1,0);
  START(pA0,pA1);
  _Pragma("unroll") for(int r=0;r<16;++r)pA1[r]=__builtin_amdgcn_exp2f(pA1[r]);
  WAIT_BAR(0);
  DMA_K(3,0);DMA_V(1,SLOTB);
  ROT();
  kload8(kf,kp0+sl_cur);
  WAIT_BAR(2);
  s16x4 vlo[8],vhi[8]; u32x4 pw0,pw1,pw2,pw3;
  #define PKW(P,B) cvtpk_s(P[B],P[B+1])
  #define PAF(k) __builtin_bit_cast(bf16x8,pw##k)
  #define VFR(i) (bf16x8){vlo[i][0],vlo[i][1],vlo[i][2],vlo[i][3],vhi[i][0],vhi[i][1],vhi[i][2],vhi[i][3]}
  #define PIN(x) asm volatile("":"+v"(x))
  #define MX3(a,b,c) __builtin_fmaxf(__builtin_fmaxf((a),(b)),(c))
  #define GAPA(MF,A0,A1,A2,A3,W0,W1,PW) do{ MF; sacc+=A0; sacc+=A1; sacc+=A2; sacc+=A3; PIN(sacc); W0; W1; PIN(PW); SBAR(); }while(0)
  #define EX(v) __builtin_amdgcn_exp2f(v)
  #define GAPB(MF,X,B) do{ MF; X[B]=EX(X[B]); X[B+1]=EX(X[B+1]); X[B+2]=EX(X[B+2]); X[B+3]=EX(X[B+3]); PIN(X); SBAR(); }while(0)
  #define VRD(i) do{ vlo[i]=vtr(vp_+(((i)>>2)*4096+((i)&3)*1024)); vhi[i]=vtr(vp_+(((i)>>2)*4096+((i)&3)*1024+512)); }while(0)
  #define KRD(G,j) do{ if(G){ kload2(kf,kp0+sl_next,j); SBAR(); } }while(0)
  #define STEP(C0,C1,P0,P1,t,GK,GV,GL) do{ SBAR(); \
    const lds_cptr vp_=vp0+sl_prev; \
    VRD(0); SBAR(); float sacc=(P0[0]+P0[1]); \
    GAPA(C0=__builtin_amdgcn_mfma_f32_32x32x16_bf16(kf[0],qr[0],negm,0,0,0), P0[2],P0[3],P0[4],P0[5],     pw0[0]=PKW(P0,0), pw0[1]=PKW(P0,2), pw0); \
    VRD(4); SBAR(); GAPA(C1=__builtin_amdgcn_mfma_f32_32x32x16_bf16(kf[1],qr[0],negm,0,0,0), P0[6],P0[7],P0[8],P0[9],     pw0[2]=PKW(P0,4), pw0[3]=PKW(P0,6), pw0); \
    VRD(1); SBAR(); GAPA(C0=__builtin_amdgcn_mfma_f32_32x32x16_bf16(kf[2],qr[1],C0,0,0,0),   P0[10],P0[11],P0[12],P0[13], pw1[0]=PKW(P0,8), pw1[1]=PKW(P0,10), pw1); \
    VRD(5); SBAR(); GAPA(C1=__builtin_amdgcn_mfma_f32_32x32x16_bf16(kf[3],qr[1],C1,0,0,0),   P0[14],P0[15],P1[0],P1[1],   pw1[2]=PKW(P0,12),pw1[3]=PKW(P0,14), pw1); \
    VRD(2); SBAR(); GAPA(C0=__builtin_amdgcn_mfma_f32_32x32x16_bf16(kf[4],qr[2],C0,0,0,0),   P1[2],P1[3],P1[4],P1[5],     pw2[0]=PKW(P1,0), pw2[1]=PKW(P1,2), pw2); \
    VRD(6); SBAR(); GAPA(C1=__builtin_amdgcn_mfma_f32_32x32x16_bf16(kf[5],qr[2],C1,0,0,0),   P1[6],P1[7],P1[8],P1[9],     pw2[2]=PKW(P1,4), pw2[3]=PKW(P1,6), pw2); \
    VRD(3); SBAR(); GAPA(C0=__builtin_amdgcn_mfma_f32_32x32x16_bf16(kf[6],qr[3],C0,0,0,0),   P1[10],P1[11],P1[12],P1[13], pw3[0]=PKW(P1,8), pw3[1]=PKW(P1,10), pw3); \
    VRD(7); SBAR(); GAPA(C1=__builtin_amdgcn_mfma_f32_32x32x16_bf16(kf[7],qr[3],C1,0,0,0),   P1[14],P1[15],0.f,0.f,       pw3[2]=PKW(P1,12),pw3[3]=PKW(P1,14), pw3); \
    l_reg+=sacc; \
    if(GK){DMA_K((t)+3,sl_cur);} if(GV){DMA_V((t)+1,sl_next);} \
    CMASK(C0,C1,t); \
    { float a=MX3(C0[0],C0[1],C1[0]),b=MX3(C0[2],C0[3],C1[1]); a=MX3(a,C1[2],C1[3]); \
      _Pragma("unroll") for(int r=4;r<16;r+=4){a=MX3(a,C0[r],C0[r+1]);b=MX3(b,C0[r+2],C0[r+3]);a=MX3(a,C1[r],C1[r+1]);b=MX3(b,C1[r+2],C1[r+3]);} \
      float rm=__builtin_fmaxf(a,b); { auto rr=__builtin_amdgcn_permlane32_swap(__float_as_uint(rm),__float_as_uint(rm),false,false); rm=__builtin_fmaxf(__uint_as_float(rr[0]),__uint_as_float(rr[1])); } \
      resc=false; \
      if(__builtin_expect(__any(rm>(float)THRL),0)){ const float dl=__builtin_fmaxf(rm,0.f); mhat+=dl; \
        _Pragma("unroll") for(int r=0;r<16;++r){C0[r]-=dl;C1[r]-=dl;} \
        _Pragma("unroll") for(int r=0;r<16;++r)negm[r]=-mhat; asm volatile("":"+v"(negm)); \
        const float f=__builtin_amdgcn_exp2f(-dl); l_reg*=f; if(hi==0)wsf[r32]=f; resc=true; } } \
    SBAR(); \
    GAPB(o[0]=__builtin_amdgcn_mfma_f32_32x32x16_bf16(PAF(0),VFR(0),o[0],0,0,0), C0,0); \
    GAPB(o[1]=__builtin_amdgcn_mfma_f32_32x32x16_bf16(PAF(0),VFR(4),o[1],0,0,0), C0,4); \
    KRD(GL,0); GAPB(o[0]=__builtin_amdgcn_mfma_f32_32x32x16_bf16(PAF(1),VFR(1),o[0],0,0,0), C0,8); \
    KRD(GL,1); GAPB(o[1]=__builtin_amdgcn_mfma_f32_32x32x16_bf16(PAF(1),VFR(5),o[1],0,0,0), C0,12); \
    KRD(GL,2); GAPB(o[0]=__builtin_amdgcn_mfma_f32_32x32x16_bf16(PAF(2),VFR(2),o[0],0,0,0), C1,0); \
    KRD(GL,3); GAPB(o[1]=__builtin_amdgcn_mfma_f32_32x32x16_bf16(PAF(2),VFR(6),o[1],0,0,0), C1,4); \
    GAPB(o[0]=__builtin_amdgcn_mfma_f32_32x32x16_bf16(PAF(3),VFR(3),o[0],0,0,0), C1,8); \
    GAPB(o[1]=__builtin_amdgcn_mfma_f32_32x32x16_bf16(PAF(3),VFR(7),o[1],0,0,0), C1,12); \
    }while(0)
  int t=1;
  #undef CMASK
  #define CMASK(P0,P1,t) do{}while(0)
  for(;t+5<NT;t+=2){
    STEP(pB0,pB1,pA0,pA1,t,true,true,true);     WAIT_BAR(2); RESC(); ROT();
    STEP(pA0,pA1,pB0,pB1,t+1,true,true,true);   WAIT_BAR(2); RESC(); ROT();
  }
  #undef CMASK
  #define CMASK(P0,P1,t) do{}while(0)
  #define ENDW(tt) do{ if((tt)+3<NT){WAIT_BAR(2);} else if((tt)+2<NT){WAIT_BAR(1);} else {WAIT_BAR(0);} }while(0)
  for(;t+1<NT;t+=2){
    STEP(pB0,pB1,pA0,pA1,t,(t+3<NT),(t+1<NT),(t+1<NT));       ENDW(t);   RESC(); ROT();
    STEP(pA0,pA1,pB0,pB1,t+1,(t+4<NT),(t+2<NT),(t+2<NT));     ENDW(t+1); RESC(); ROT();
  }
  STEP(pB0,pB1,pA0,pA1,NT-1,false,false,false); RESC();
  { float sacc=pB0[0]+pB0[1]; _Pragma("unroll") for(int r=2;r<16;++r)sacc+=pB0[r]; _Pragma("unroll") for(int r=0;r<16;++r)sacc+=pB1[r]; l_reg+=sacc;
    pw0=(u32x4){PKW(pB0,0),PKW(pB0,2),PKW(pB0,4),PKW(pB0,6)};pw1=(u32x4){PKW(pB0,8),PKW(pB0,10),PKW(pB0,12),PKW(pB0,14)};pw2=(u32x4){PKW(pB1,0),PKW(pB1,2),PKW(pB1,4),PKW(pB1,6)};pw3=(u32x4){PKW(pB1,8),PKW(pB1,10),PKW(pB1,12),PKW(pB1,14)};
    SBAR(); pv(o,vb0+sl_cur,PAF(0),PAF(1),PAF(2),PAF(3)); }
  #undef PKW
  #undef PAF
  #undef VFR
  #undef PIN
  #undef MX3
  #undef GAPA
  #undef GAPB
  #undef EX
  #undef VRD
  #undef KRD
  #undef STEP
  #undef ENDW
  {auto rr=__builtin_amdgcn_permlane32_swap(__float_as_uint(l_reg),__float_as_uint(l_reg),false,false);l_reg=__uint_as_float(rr[0])+__uint_as_float(rr[1]);}
  if(hi==0)wsf[32+r32]=l_reg;asm volatile("s_waitcnt lgkmcnt(0)":::"memory");
  float rli[16];
  #pragma unroll
  for(int r=0;r<16;++r)rli[r]=__builtin_amdgcn_rcpf(wsf[32+crow(r,hi)]);
  bf16*Ow=O+(qrow0+wid*QBLK)*QP+h*D;
  { bf16*stg=(bf16*)(shm+LDS_OST)+wid*2048;
    #pragma unroll
    for(int r=0;r<16;++r){const int orow=crow(r,hi);
      #pragma unroll
      for(int d0=0;d0<2;++d0)stg[orow*64+d0*32+r32]=__float2bfloat16(o[d0][r]*rli[r]);}
    asm volatile("s_waitcnt lgkmcnt(0)":::"memory");
    #pragma unroll
    for(int i=0;i<4;++i){const int row=i*8+(lane>>3),ch=lane&7; const u32x4 v=*(const u32x4*)(stg+row*64+ch*8); ATTN_STORE16(Ow+(long)row*QP+ch*8,v);} }
  asm volatile("s_waitcnt lgkmcnt(0)\n\ts_barrier":::"memory");
  #undef DMA_K
  #undef DMA_V
  #undef CMASK
  #undef START
  #undef RESC
  #undef ROT
}
constexpr int ATTN_LDS_BYTES=LDS_BYTES;
struct AttnTensors { const bf16* Q; const bf16* K; const bf16* V; bf16* O; };
template<int THRL=8> __device__ __forceinline__ void attn_phase(char*lds,const AttnTensors&T,int G,int vcu,bool with_ctx,long ctx_row0){
  const int total=4*NHEAD*NQB;
  for(int i=0;;++i){
    int x,n;
    if(G==256){ if(i>=4)break; x=vcu>>5; n=i*32+(vcu&31); }
    else { const int u=i*G+vcu; if(u>=total)break; x=u>>7; n=u&127; }
    const int b=x>>1,kvh=x&1,h=kvh*4+(n>>5),qb=n&31;
    attn_unit<THRL>(b,h,(long)b*SEQQ+(long)qb*QB,SEQK/KVBLK,T.Q,T.K,T.V,T.O,lds);
  }
  if(with_ctx){
    for(int u=vcu;u<4*NHEAD;u+=G){ const int b=u>>3,h=u&7; attn_unit<THRL>(b,h,ctx_row0+(long)b*256,4,T.Q,T.K,T.V,T.O,lds); }
  }
}
#undef SBAR
#undef WAIT_BAR
}

constexpr int NWAVES = 8, NTHR = 512;
constexpr int DMODEL = 1024, NB = 4, SEQ = 8192, CTXL = 256, NLAT = NB * SEQ, NCTX = NB * CTXL, MT = NLAT + NCTX;
constexpr int INW = 2048, NE = 32, KEYS = SEQ + CTXL;
constexpr int SORT_TILES = 560, SORT_ROWS = SORT_TILES * 256;
constexpr float EPSN = 1e-6f;
constexpr int NCHUNK = 66, CHUNK = 128;
constexpr int NPH_PRO = 2, NPH_LAYER = 13, NPH = NPH_PRO + 2 * NPH_LAYER;

constexpr size_t MiB = 1u << 20;
constexpr size_t WS_CTL = 0, CTL_ZERO_BYTES = 1 * MiB;
constexpr size_t WS_MOD = 1 * MiB, WS_ROPEC = 2 * MiB, WS_ROPES = 3 * MiB, WS_H2 = 4 * MiB, WS_KFC = 10 * MiB, WS_BLKCNT = 12 * MiB, WS_TILEE = 13 * MiB, WS_SCANS = 14 * MiB;
constexpr size_t WS_WINT = 16 * MiB, WS_WOUTT = 24 * MiB, WS_W1T = 32 * MiB, WS_W2T = 288 * MiB, WS_KF = 416 * MiB, WS_KHAT = 448 * MiB, WS_XR = 512 * MiB, WS_H = 644 * MiB;
constexpr size_t WS_U = 712 * MiB, WS_Q = 844 * MiB, WS_K = 877 * MiB, WS_V = 886 * MiB, WS_ATT = 895 * MiB, WS_LAB = 928 * MiB, WS_LRUO = 1060 * MiB, WS_VT = 1093 * MiB, WS_X0T = 1125 * MiB,
                 WS_HYO = 1157 * MiB, WS_MIXA = 1190 * MiB;
constexpr size_t WS_WGT = 11 * MiB, WS_SPT = 10 * MiB + 768 * 1024, WS_XL = 1256 * MiB;
constexpr size_t WS_GC = 10 * MiB + 896 * 1024;
constexpr size_t WS_CB = 10 * MiB + 960 * 1024;
constexpr size_t WS_F = 712 * MiB, WS_ASORT = 778 * MiB, WS_ACT = 1058 * MiB, WS_YS = 1338 * MiB, WS_TOPI = 1618 * MiB, WS_GATE = 1619 * MiB, WS_POS = 1620 * MiB, WS_RSSP = 1622 * MiB, WS_ROWTOK = 1625 * MiB, WS_END = 1626 * MiB;
constexpr size_t LAB_STRIDE = (size_t)MT * 256;
constexpr int CW_BAR = 4096;
constexpr int CW_NTILES = 64;

constexpr int RING_OFF = 0, RING_BYTES = 131072, MOETAB_OFF = 131072, LDSCTL_OFF = 155648, LDS_BYTES = 156160;

#define GAS __attribute__((address_space(1)))
#define LAS __attribute__((address_space(3)))
typedef unsigned short bf16;
typedef unsigned v4u __attribute__((ext_vector_type(4)));
typedef unsigned v2u __attribute__((ext_vector_type(2)));
typedef float f32x4 __attribute__((ext_vector_type(4)));
#define LDS_WAIT() asm volatile("s_waitcnt lgkmcnt(0)" ::: "memory")
#define VM_WAIT() asm volatile("s_waitcnt vmcnt(0)" ::: "memory")
__device__ __forceinline__ unsigned f2bf(float f) { unsigned u = __builtin_bit_cast(unsigned, f); return (u + 0x7fffu + ((u >> 16) & 1u)) >> 16; }
__device__ __forceinline__ unsigned pk2(float lo, float hi) { return f2bf(lo) | (f2bf(hi) << 16); }
__device__ __forceinline__ float bf2f(unsigned short b) { return __builtin_bit_cast(float, (unsigned)b << 16); }
__device__ __forceinline__ float bflo(unsigned w) { return __builtin_bit_cast(float, w << 16); }
__device__ __forceinline__ float bfhi(unsigned w) { return __builtin_bit_cast(float, w & 0xffff0000u); }
__device__ __forceinline__ float wave_sum(float v) {
#pragma unroll
    for (int o = 1; o < 64; o <<= 1) v += __shfl_xor(v, o);
    return v;
}
__device__ __forceinline__ float sigmoidf_(float x) { return 1.0f / (1.0f + __expf(-x)); }
__device__ __forceinline__ void sincos_d(double x, double& s, double& c) {
    const double kd = __builtin_rint(x * 0.63661977236758134308);
    const int k = (int)kd;
    double r = __builtin_fma(-kd, 1.57079632673412561417e+00, x);
    r = __builtin_fma(-kd, 6.07710050650619224932e-11, r);
    const double z = r * r;
    const double ps = r + r * z * (-1.66666666666666324348e-01 + z * (8.33333333332248946124e-03 + z * (-1.98412698298579493134e-04 + z * (2.75573137070700676789e-06 + z * (-2.50507602534068634195e-08 + z * 1.58969099521155010221e-10)))));
    const double pc = 1.0 - 0.5 * z + z * z * (4.16666666666666019037e-02 + z * (-1.38888888888741095749e-03 + z * (2.48015872894767294178e-05 + z * (-2.75573143513906633035e-07 + z * (2.08757232129817482790e-09 + z * -1.13596475577881948265e-11)))));
    const int q = k & 3;
    s = (q == 0) ? ps : (q == 1) ? pc : (q == 2) ? -ps : -pc;
    c = (q == 0) ? pc : (q == 1) ? -ps : (q == 2) ? -pc : ps;
}
__device__ __forceinline__ float gelu_tanh(float x) {
    const float u = 0.7978845608028654f * (x + 0.044715f * x * x * x);
    const float t = 1.0f - 2.0f / (1.0f + __expf(2.0f * u));
    return 0.5f * x * (1.0f + t);
}
__device__ __forceinline__ int lds_add(LAS int* p, int v) { return __hip_atomic_fetch_add(p, v, __ATOMIC_RELAXED, __HIP_MEMORY_SCOPE_WORKGROUP); }

#define FFT_FN __device__ __forceinline__
typedef float f32x2v __attribute__((ext_vector_type(2)));
#define FFT_VEC2 f32x2v
#define FFT_DPTR LAS f32x2v*
#define FFT_LD(D, i) c32_from((D)[i])
#define FFT_ST(D, i, v) ((D)[i] = c32_to(v))
struct __attribute__((aligned(8))) c32 { float x, y; };
FFT_FN c32 cmul(c32 a, c32 b) { c32 r; r.x = a.x * b.x - a.y * b.y; r.y = a.x * b.y + a.y * b.x; return r; }
FFT_FN c32 cadd(c32 a, c32 b) { c32 r; r.x = a.x + b.x; r.y = a.y + b.y; return r; }
FFT_FN c32 csub(c32 a, c32 b) { c32 r; r.x = a.x - b.x; r.y = a.y - b.y; return r; }
FFT_FN c32 cmuli_neg(c32 a) { c32 r; r.x = a.y; r.y = -a.x; return r; }
FFT_FN int fpad(int a) { return a + (a >> 4); }
#ifdef FFT_VEC2
FFT_FN c32 c32_from(FFT_VEC2 t) { c32 r; r.x = t.x; r.y = t.y; return r; }
FFT_FN FFT_VEC2 c32_to(c32 a) { FFT_VEC2 t; t.x = a.x; t.y = a.y; return t; }
#endif
FFT_FN void dft4(c32& a0, c32& a1, c32& a2, c32& a3) {
    const c32 s02 = cadd(a0, a2), d02 = csub(a0, a2), s13 = cadd(a1, a3), d13 = cmuli_neg(csub(a1, a3));
    a0 = cadd(s02, s13); a2 = csub(s02, s13); a1 = cadd(d02, d13); a3 = csub(d02, d13);
}
FFT_FN void dft16(c32 (&v)[16]) {
    const float C1 = 0.92387953251128674f, S1 = 0.38268343236508977f, C2 = 0.70710678118654752f;
#pragma unroll
    for (int q2 = 0; q2 < 4; ++q2) dft4(v[q2], v[4 + q2], v[8 + q2], v[12 + q2]);
    { c32 w;
      w.x = C1; w.y = -S1; v[4 * 1 + 1] = cmul(v[4 * 1 + 1], w);
      w.x = C2; w.y = -C2; v[4 * 2 + 1] = cmul(v[4 * 2 + 1], w);
      w.x = S1; w.y = -C1; v[4 * 3 + 1] = cmul(v[4 * 3 + 1], w);
      w.x = C2; w.y = -C2; v[4 * 1 + 2] = cmul(v[4 * 1 + 2], w);
      v[4 * 2 + 2] = cmuli_neg(v[4 * 2 + 2]);
      w.x = -C2; w.y = -C2; v[4 * 3 + 2] = cmul(v[4 * 3 + 2], w);
      w.x = S1; w.y = -C1; v[4 * 1 + 3] = cmul(v[4 * 1 + 3], w);
      w.x = -C2; w.y = -C2; v[4 * 2 + 3] = cmul(v[4 * 2 + 3], w);
      w.x = -C1; w.y = S1; v[4 * 3 + 3] = cmul(v[4 * 3 + 3], w); }
#pragma unroll
    for (int p1 = 0; p1 < 4; ++p1) dft4(v[4 * p1 + 0], v[4 * p1 + 1], v[4 * p1 + 2], v[4 * p1 + 3]);
#pragma unroll
    for (int a = 0; a < 4; ++a)
#pragma unroll
        for (int b = a + 1; b < 4; ++b) { const c32 t = v[4 * a + b]; v[4 * a + b] = v[4 * b + a]; v[4 * b + a] = t; }
}
FFT_FN c32 twid(int j, int n) { float rev = (float)j / (float)n; asm volatile("" : "+v"(rev)); c32 w; w.x = __builtin_amdgcn_cosf(rev); w.y = -__builtin_amdgcn_sinf(rev); return w; }

FFT_FN void fft_fwd16(FFT_DPTR D, int g, int n) {
    const int s = n >> 4, blk = g / s, j = g - blk * s, base = blk * n + j;
    c32 v[16];
#pragma unroll
    for (int q = 0; q < 16; ++q) v[q] = FFT_LD(D, fpad(base + q * s));
    dft16(v);
    const c32 w = twid(j, n); c32 wp = w;
#pragma unroll
    for (int p = 1; p < 16; ++p) { v[p] = cmul(v[p], wp); wp = cmul(wp, w); }
#pragma unroll
    for (int p = 0; p < 16; ++p) FFT_ST(D, fpad(base + p * s), v[p]);
}
FFT_FN void fft_inv16(FFT_DPTR D, int g, int n) {
    const int s = n >> 4, blk = g / s, j = g - blk * s, base = blk * n + j;
    c32 v[16];
#pragma unroll
    for (int q = 0; q < 16; ++q) v[q] = FFT_LD(D, fpad(base + q * s));
    const c32 w = twid(j, n); c32 wp = w;
#pragma unroll
    for (int p = 1; p < 16; ++p) { v[p] = cmul(v[p], wp); wp = cmul(wp, w); }
    dft16(v);
#pragma unroll
    for (int p = 0; p < 16; ++p) FFT_ST(D, fpad(base + p * s), v[p]);
}
FFT_FN void fft_mid16(FFT_DPTR D, int g, const c32* KH) {
    c32 v[16];
#pragma unroll
    for (int q = 0; q < 16; ++q) v[q] = FFT_LD(D, 17 * g + q);
    dft16(v);
#pragma unroll
    for (int p = 0; p < 16; ++p) { const c32 k = KH[16 * g + p]; const c32 t = cmul(v[p], k); v[p].x = t.x; v[p].y = -t.y; }
    dft16(v);
#pragma unroll
    for (int p = 0; p < 16; ++p) FFT_ST(D, 17 * g + p, v[p]);
}
FFT_FN void fft_last16_out(FFT_DPTR D, int g, c32* OUT, float scale) {
    c32 v[16];
#pragma unroll
    for (int q = 0; q < 16; ++q) v[q] = FFT_LD(D, 17 * g + q);
    dft16(v);
#pragma unroll
    for (int p = 0; p < 16; ++p) { c32 t; t.x = v[p].x * scale; t.y = v[p].y * scale; OUT[16 * g + p] = t; }
}
FFT_FN void fft_first4(FFT_DPTR D, int j, c32 x0, c32 x1, c32 x2, c32 x3) {
    dft4(x0, x1, x2, x3);
    const c32 w = twid(j, 16384), w2 = cmul(w, w), w3 = cmul(w2, w);
    FFT_ST(D, fpad(j), x0); FFT_ST(D, fpad(j + 4096), cmul(x1, w)); FFT_ST(D, fpad(j + 8192), cmul(x2, w2)); FFT_ST(D, fpad(j + 12288), cmul(x3, w3));
}
FFT_FN void fft_final4(FFT_DPTR D, int j, c32& u0, c32& u1) {
    const c32 w = twid(j, 16384), w2 = cmul(w, w), w3 = cmul(w2, w);
    c32 a0 = FFT_LD(D, fpad(j)), a1 = cmul(FFT_LD(D, fpad(j + 4096)), w), a2 = cmul(FFT_LD(D, fpad(j + 8192)), w2), a3 = cmul(FFT_LD(D, fpad(j + 12288)), w3);
    dft4(a0, a1, a2, a3);
    u0 = a0; u1 = a1;
}
FFT_FN void fft_first4_inplace(FFT_DPTR D, int j) {
    c32 x0 = FFT_LD(D, fpad(j)), x1 = FFT_LD(D, fpad(j + 4096)), x2 = FFT_LD(D, fpad(j + 8192)), x3 = FFT_LD(D, fpad(j + 12288));
    fft_first4(D, j, x0, x1, x2, x3);
}
#define XB_TMO      128
#define XB_XCNT(j)  (256  + 64 * (j))
#define XB_XSUB(j)  (1280 + 64 * (j))
#define XB_XGEN(j)  (2304 + 64 * (j))
#define XB_TOP      3328
#define XB_TOPGEN   3392
#define XCD_BAR_WORDS 3456
#define XB_SPIN_CAP (1u << 22)

__device__ __forceinline__ unsigned xb_ld(unsigned* p)              { return __hip_atomic_load(p, __ATOMIC_RELAXED, __HIP_MEMORY_SCOPE_AGENT); }
__device__ __forceinline__ unsigned xb_add(unsigned* p, unsigned v) { return __hip_atomic_fetch_add(p, v, __ATOMIC_RELAXED, __HIP_MEMORY_SCOPE_AGENT); }
__device__ __forceinline__ unsigned xb_xcc_id() { return (unsigned)__builtin_amdgcn_s_getreg((3 << 11) | 20) & 0xFu; }
#define XB_SPIN(cond, bar) do { unsigned _sp = 0; while (cond) { __builtin_amdgcn_s_sleep(1); \
    if ((++_sp & 255u) == 0u) { if (xb_ld(&(bar)[XB_TMO])) break; if (_sp > XB_SPIN_CAP) { atomicAdd(&(bar)[XB_TMO], 1u); break; } } } } while (0)

struct XcdBarrier {
    unsigned* bar; unsigned x;
    volatile LAS unsigned* st;
};

__device__ __forceinline__ XcdBarrier xcd_barrier_post(unsigned* bar, volatile LAS unsigned* st) {
    XcdBarrier b; b.bar = bar; b.x = xb_xcc_id(); b.st = st;
    if (threadIdx.x == 0) (void)xb_add(&bar[XB_XCNT(b.x)], 1u);
    return b;
}
__device__ __forceinline__ void xcd_barrier_complete(unsigned* bar, unsigned x, unsigned& nloc, unsigned& nx) {
    const unsigned G = gridDim.x * gridDim.y * gridDim.z;
    unsigned sum, cnt, mine, sp = 0u;
    for (;;) {
        sum = 0u; cnt = 0u; mine = 0u;
#pragma unroll
        for (unsigned j = 0; j < 16; ++j) { const unsigned c = xb_ld(&bar[XB_XCNT(j)]); sum += c; cnt += (c > 0u) ? 1u : 0u; mine = (j == x) ? c : mine; }
        if (sum == G) break;
        __builtin_amdgcn_s_sleep(1);
        if ((++sp & 255u) == 0u) { if (xb_ld(&bar[XB_TMO])) break; if (sp > XB_SPIN_CAP) { atomicAdd(&bar[XB_TMO], 1u); break; } }
    }
    nloc = mine > 0u ? mine : 1u; nx = cnt > 0u ? cnt : 1u;
}

__device__ __forceinline__ void xcd_barrier(const XcdBarrier& b) {
    asm volatile("s_waitcnt vmcnt(0)" ::: "memory");
    __syncthreads();
    if (threadIdx.x == 0) {
        unsigned* bar = b.bar;
        __builtin_amdgcn_s_waitcnt(0);
        unsigned nloc = b.st[0], nx = b.st[1];
        if (nloc == 0u) { xcd_barrier_complete(bar, b.x, nloc, nx); b.st[0] = nloc; b.st[1] = nx; }
        const unsigned old = xb_add(&bar[XB_XSUB(b.x)], 1u);
        const unsigned gen = old / nloc;
        if (old + 1u == (gen + 1u) * nloc) {
            __builtin_amdgcn_fence(__ATOMIC_RELEASE, "agent");
            asm volatile("s_waitcnt vmcnt(0)" ::: "memory");
            const unsigned og = xb_add(&bar[XB_TOP], 1u);
            const unsigned tg = og / nx;
            if (og + 1u == (tg + 1u) * nx) xb_add(&bar[XB_TOPGEN], 1u);
            else XB_SPIN(xb_ld(&bar[XB_TOPGEN]) == tg, bar);
            __builtin_amdgcn_fence(__ATOMIC_ACQUIRE, "agent");
            xb_add(&bar[XB_XGEN(b.x)], 1u);
            asm volatile("s_waitcnt vmcnt(0)" ::: "memory");
        } else {
            XB_SPIN(xb_ld(&bar[XB_XGEN(b.x)]) == gen, bar);
            __builtin_amdgcn_fence(__ATOMIC_ACQUIRE, "agent");
            asm volatile("s_waitcnt vmcnt(0)" ::: "memory");
        }
    }
    __syncthreads();
}


struct Frame {
    LAS unsigned char* lds; unsigned* ctl; unsigned char* ws;
    int tid, lane, wave, vcu, G, gw, ngw;
};
__device__ const float ROPE_INV[16] = {1.0f, 0.5623413251903491f, 0.31622776601683794f, 0.1778279410038923f, 0.1f, 0.05623413251903491f, 0.03162277660168379f, 0.01778279410038923f,
                                       0.01f, 0.005623413251903491f, 0.0031622776601683794f, 0.001778279410038923f, 0.001f, 0.0005623413251903491f, 0.00031622776601683794f, 0.0001778279410038923f};

__device__ __forceinline__ void p0_transpose_item(const float* W, int K, int N, bf16* WT, LAS float* scr, int item, int lane) {
    const int nblk = N / 32, kb = item / nblk, nb = item % nblk, k0 = 64 * kb, n0 = 32 * nb;
#pragma unroll 8
    for (int i = 0; i < 32; ++i) { const int kk = 2 * i + (lane >> 5); scr[kk * 33 + (lane & 31)] = W[(size_t)(k0 + kk) * N + n0 + (lane & 31)]; }
    LDS_WAIT(); asm volatile("" ::: "memory");
    const int c = lane & 7;
#pragma unroll
    for (int j = 0; j < 4; ++j) { const int n = (lane >> 3) + 8 * j; const LAS float* s = scr + (8 * c) * 33 + n;
        v4u o; o.x = pk2(s[0 * 33], s[1 * 33]); o.y = pk2(s[2 * 33], s[3 * 33]); o.z = pk2(s[4 * 33], s[5 * 33]); o.w = pk2(s[6 * 33], s[7 * 33]);
        *(GAS v4u*)(WT + (size_t)(n0 + n) * K + k0 + 8 * c) = o; }
    LDS_WAIT(); asm volatile("" ::: "memory");
}

__device__ __forceinline__ void ph_prologue_a(const Frame& F, const float* c, const float* cctx, const float* w_mod, const float* b_mod, const float* w_in, const float* w_out,
                                              const float* moe_w1, const float* moe_w2, const float* hy_w1, const float* hy_b1, const float* hy_w2, const float* hy_b2, const float* hy_freq, const float* lru_gw, const float* lru_lam) {
    {
        LAS float* scr = (LAS float*)(F.lds + F.wave * 16384);
        constexpr int I_IN = 2 * 1024, I_OUT = 2 * 512, I_W1 = 64 * 1024, I_W2 = 64 * 512, NIT = I_IN + I_OUT + I_W1 + I_W2;
        bf16* WinT = (bf16*)(F.ws + WS_WINT); bf16* WoutT = (bf16*)(F.ws + WS_WOUTT); bf16* W1T = (bf16*)(F.ws + WS_W1T); bf16* W2T = (bf16*)(F.ws + WS_W2T);
        for (int it = F.gw; it < NIT; it += F.ngw) {
            int r = it;
            if (r < I_IN) { const int m = r >> 10; p0_transpose_item(w_in + (size_t)m * 1024 * 2048, 1024, 2048, WinT + (size_t)m * 2048 * 1024, scr, r & 1023, F.lane); continue; } r -= I_IN;
            if (r < I_OUT) { const int m = r >> 9; p0_transpose_item(w_out + (size_t)m * 1024 * 1024, 1024, 1024, WoutT + (size_t)m * 1024 * 1024, scr, r & 511, F.lane); continue; } r -= I_OUT;
            if (r < I_W1) { const int m = r >> 10; p0_transpose_item(moe_w1 + (size_t)m * 1024 * 2048, 1024, 2048, W1T + (size_t)m * 2048 * 1024, scr, r & 1023, F.lane); continue; } r -= I_W1;
            { const int m = r >> 9; p0_transpose_item(moe_w2 + (size_t)m * 1024 * 1024, 1024, 1024, W2T + (size_t)m * 1024 * 1024, scr, r & 511, F.lane); }
        }
    }
    __syncthreads();
    {
        LAS float* sl = (LAS float*)(F.lds);
        LAS float* red = (LAS float*)(F.lds + 20480);
        float* MOD = (float*)(F.ws + WS_MOD);
        if ((int)blockIdx.x < 192) {
            for (int i = F.tid; i < 5 * 1024; i += NTHR) { const int r = i >> 10, k = i & 1023; const float v = (r < 4) ? c[r * 1024 + k] : cctx[k]; sl[i] = v / (1.0f + __expf(-v)); }
        }
        __syncthreads();
        for (int it = blockIdx.x; it < 192; it += F.G) {
            const int l = it / 96, n = (it % 96) * 64 + F.lane;
            float a0 = 0.f, a1 = 0.f, a2 = 0.f, a3 = 0.f, a4 = 0.f;
            const float* wp = w_mod + ((size_t)l * 1024 + F.wave * 128) * 6144 + n;
#pragma unroll 8
            for (int k = 0; k < 128; ++k) { const float w = wp[(size_t)k * 6144]; const int kk = F.wave * 128 + k;
                a0 += sl[kk] * w; a1 += sl[1024 + kk] * w; a2 += sl[2048 + kk] * w; a3 += sl[3072 + kk] * w; a4 += sl[4096 + kk] * w; }
            red[(F.wave * 5 + 0) * 64 + F.lane] = a0; red[(F.wave * 5 + 1) * 64 + F.lane] = a1; red[(F.wave * 5 + 2) * 64 + F.lane] = a2; red[(F.wave * 5 + 3) * 64 + F.lane] = a3; red[(F.wave * 5 + 4) * 64 + F.lane] = a4;
            __syncthreads();
            if (F.tid < 320) { const int r = F.tid >> 6, ln = F.tid & 63; float s = 0.f;
#pragma unroll
                for (int w = 0; w < 8; ++w) s += red[(w * 5 + r) * 64 + ln];
                const int nn = (it % 96) * 64 + ln; MOD[(size_t)(l * 5 + r) * 6144 + nn] = s + b_mod[l * 6144 + nn]; }
            __syncthreads();
        }
    }
    {
        bf16* WGT = (bf16*)(F.ws + WS_WGT); float* SPT = (float*)(F.ws + WS_SPT);
        for (int idx = blockIdx.x * NTHR + F.tid; idx < 2 * 1024 * 256; idx += F.G * NTHR) {
            const int l = idx >> 18, nidx = (idx >> 8) & 1023, k = idx & 255;
            const int pn = nidx >> 8, j = (nidx >> 7) & 1, cc = nidx & 127, d = pn >> 1, ch = 128 * (pn & 1) + cc, n = ch >> 6, e = ch & 63;
            const float v = ((k >> 6) == n) ? lru_gw[((size_t)((((l * 2 + d) * 2 + j) * 4 + n) * 64 + (k & 63))) * 64 + e] : 0.f;
            WGT[idx] = (bf16)f2bf(v); }
        for (int idx = blockIdx.x * NTHR + F.tid; idx < 2 * 2 * 256; idx += F.G * NTHR) SPT[idx] = log1pf(expf(-lru_lam[idx]));
    }
    {
        float* RC = (float*)(F.ws + WS_ROPEC); float* RS = (float*)(F.ws + WS_ROPES);
        for (int idx = blockIdx.x * NTHR + F.tid; idx < SEQ * 32; idx += F.G * NTHR) {
            const int t = idx >> 5, i = idx & 31; const int pos = (i < 16) ? (t >> 6) : (t & 63);
            const float ang = (float)pos * ROPE_INV[i & 15];
            double s, cc; sincos_d((double)ang, s, cc); RC[idx] = (float)cc; RS[idx] = (float)s; }
    }
    {
        float* H2 = (float*)(F.ws + WS_H2);
        for (int it = F.gw; it < 2 * SEQ + CTXL; it += F.ngw) {
            const int v = it >> 13, t = (v < 2) ? (it & (SEQ - 1)) : (it - 2 * SEQ), L = (v < 2) ? SEQ : CTXL, l = (v == 1) ? 1 : 0;
            const int j = F.lane;
            float z = 0.f;
            if (j == 0) z = (float)t / (float)(L - 1);
            else if (j <= 32) { const int b = (j - 1) & 15; const float band = 1e-4f + (float)b * ((15.0f - 1e-4f) / 15.0f);
                const float ang = ((6.283185307179586f / (float)L) * (float)t) * band;
                double s, cc; sincos_d((double)ang, s, cc); z = (j <= 16) ? (float)cc : -(float)s; }
            const float fr = hy_freq[l * 64 + j];
            float p1 = hy_b1[l * 64 + j];
            const float* w1 = hy_w1 + (size_t)l * 33 * 64;
#pragma unroll
            for (int i = 0; i < 33; ++i) p1 += __shfl(z, i) * w1[i * 64 + j];
            double s1, c1; sincos_d((double)(fr * p1), s1, c1); const float h1 = (float)s1;
            float p2 = hy_b2[l * 64 + j];
            const float* w2 = hy_w2 + (size_t)l * 64 * 64;
#pragma unroll 16
            for (int i = 0; i < 64; ++i) p2 += __shfl(h1, i) * w2[i * 64 + j];
            double s2, c2; sincos_d((double)(fr * p2), s2, c2);
            H2[((size_t)v * SEQ + t) * 64 + j] = (float)s2;
        }
    }
}

__device__ __forceinline__ void ph_prologue_b(const Frame& F, const float* hy_w3, const float* hy_decay, const float* gffn, const float* router_w, const float* router_b) {
    { const float* MOD = (const float*)(F.ws + WS_MOD); float* CB = (float*)(F.ws + WS_CB);
      for (int it = F.gw; it < 2 * 5 * 32; it += F.ngw) { const int lb = it >> 5, e = it & 31, l = lb / 5; const float* sf = MOD + (size_t)lb * 6144 + 3 * 1024; float s = 0.f;
#pragma unroll
          for (int q = 0; q < 16; ++q) { const int cc = 64 * q + F.lane; s += sf[cc] * router_w[(size_t)l * 32768 + cc * 32 + e]; }
          s = wave_sum(s); if (F.lane == 0) CB[it] = s + router_b[l * 32 + e]; } }
    { const float* MOD = (const float*)(F.ws + WS_MOD); float* GC = (float*)(F.ws + WS_GC);
      for (int idx = blockIdx.x * NTHR + F.tid; idx < 2 * 5 * 1024; idx += F.G * NTHR) { const int lb = idx >> 10, cc = idx & 1023, l = lb / 5; GC[idx] = gffn[l * 1024 + cc] * (1.0f + MOD[(size_t)lb * 6144 + 4 * 1024 + cc]); } }
    LAS f32x2v* D = (LAS f32x2v*)(F.lds);
    LAS float* kt = (LAS float*)(F.lds);
    LAS float* w3c = (LAS float*)(F.lds + 139264);
    LAS float* red = (LAS float*)(F.lds + 139264 + 512);
    const float* H2 = (const float*)(F.ws + WS_H2);
    c32* KHAT = (c32*)(F.ws + WS_KHAT); float* KFC = (float*)(F.ws + WS_KFC);
    for (int it = blockIdx.x; it < 768; it += F.G) {
        const int v = it >> 8, c = it & 255, L = (v < 2) ? SEQ : CTXL, l = (v == 1) ? 1 : 0;
        if (F.tid < 128) w3c[F.tid] = hy_w3[(size_t)l * 64 * 512 + (F.tid & 63) * 512 + (F.tid >> 6) * 256 + c];
        if (F.tid == 0) { if (v < 2) { f32x2v z; z.x = 0.f; z.y = 0.f; D[fpad(L)] = z; } else kt[L] = 0.f; }
        __syncthreads();
        const float df = fabsf(hy_decay[l * 512 + c]), db = fabsf(hy_decay[l * 512 + 256 + c]);
        float asum = 0.f;
        for (int t = F.tid; t < L; t += NTHR) {
            const f32x4* row = (const f32x4*)(H2 + ((size_t)v * SEQ + t) * 64);
            float hf = 0.f, hb = 0.f;
#pragma unroll
            for (int q = 0; q < 16; ++q) { const f32x4 h = row[q];
                hf += h.x * w3c[4 * q] + h.y * w3c[4 * q + 1] + h.z * w3c[4 * q + 2] + h.w * w3c[4 * q + 3];
                hb += h.x * w3c[64 + 4 * q] + h.y * w3c[64 + 4 * q + 1] + h.z * w3c[64 + 4 * q + 2] + h.w * w3c[64 + 4 * q + 3]; }
            const float t01 = (float)t / (float)(L - 1);
            hf *= expf(-t01 * df); hb *= expf(-t01 * db);
            asum += fabsf(hf); if (t >= 1) asum += fabsf(hb);
            if (v < 2) { f32x2v z; z.x = hf; z.y = 0.f; D[fpad(t)] = z; if (t >= 1) { z.x = hb; D[fpad(2 * L - t)] = z; } }
            else { kt[t] = hf; if (t >= 1) kt[2 * L - t] = hb; }
        }
        asum = wave_sum(asum);
        if (F.lane == 0) red[F.wave] = asum;
        __syncthreads();
        float tot = 0.f;
#pragma unroll
        for (int w = 0; w < 8; ++w) tot += red[w];
        const float inv = 1.0f / tot;
        if (v < 2) {
            c32* out = KHAT + (size_t)(v * 256 + c) * 16384;
#pragma unroll 1
            for (int i = 0; i < 8; ++i) fft_first4_inplace(D, F.tid + 512 * i);
            __syncthreads();
            _Pragma("unroll 1") for (int g_ = F.tid; g_ < 1024; g_ += 512) fft_fwd16(D, g_, 4096);
            __syncthreads();
            _Pragma("unroll 1") for (int g_ = F.tid; g_ < 1024; g_ += 512) fft_fwd16(D, g_, 256);
            __syncthreads();
            _Pragma("unroll 1") for (int g_ = F.tid; g_ < 1024; g_ += 512) fft_last16_out(D, g_, out, inv * (1.0f / 16384.0f));
        } else {
            float* dst = KFC + (size_t)c * 512;
            for (int j = F.tid; j < 2 * L; j += NTHR) dst[j] = kt[j] * inv;
        }
        __syncthreads();
    }
}

__device__ __forceinline__ void ph_norm_mod(const Frame& F, int l, const float* x, const float* ctx, const float* gmix) {
    const float* XR = (const float*)(F.ws + WS_XR); const float* MOD = (const float*)(F.ws + WS_MOD); bf16* H = (bf16*)(F.ws + WS_H);
    for (int r = F.gw; r < MT; r += F.ngw) {
        const float* src = (l == 0) ? (r < NLAT ? x + (size_t)r * 1024 : ctx + (size_t)(r - NLAT) * 1024) : XR + (size_t)r * 1024;
        const int bidx = r < NLAT ? r / SEQ : 4;
        const float* shift = MOD + (size_t)(l * 5 + bidx) * 6144; const float* scale = shift + 1024; const float* g = gmix + l * 1024;
        f32x4 v[4]; float ss = 0.f;
#pragma unroll
        for (int j = 0; j < 4; ++j) { v[j] = ((const f32x4*)src)[64 * j + F.lane]; ss += (v[j].x * v[j].x + v[j].y * v[j].y) + (v[j].z * v[j].z + v[j].w * v[j].w); }
        const float rstd = 1.0f / sqrtf(wave_sum(ss) * (1.0f / 1024.0f) + EPSN);
#pragma unroll
        for (int j = 0; j < 4; ++j) { const int cb = 64 * j + F.lane; const f32x4 gg = ((const f32x4*)g)[cb], sc = ((const f32x4*)scale)[cb], sh = ((const f32x4*)shift)[cb];
            const f32x4 y = v[j] * rstd * gg * (sc + 1.0f) + sh;
            v2u o; o.x = pk2(y.x, y.y); o.y = pk2(y.z, y.w); ((v2u*)(H + (size_t)r * 1024))[cb] = o; }
    }
}

__device__ __forceinline__ void ph_post_proj(const Frame& F, int l, const float* qg_, const float* kg_, const float* lru_cw, const float* lru_cb, const float* hy_cw, const float* hy_cb) {
    const bf16* U = (const bf16*)(F.ws + WS_U);
    {
        bf16* Q = (bf16*)(F.ws + WS_Q); bf16* K = (bf16*)(F.ws + WS_K); bf16* V = (bf16*)(F.ws + WS_V);
        const float* RC = (const float*)(F.ws + WS_ROPEC); const float* RS = (const float*)(F.ws + WS_ROPES);
        const int o8 = 8 * (F.lane & 7);
        const f32x4 qg0 = *(const f32x4*)(qg_ + l * 64 + o8), qg1 = *(const f32x4*)(qg_ + l * 64 + o8 + 4), kg0 = *(const f32x4*)(kg_ + l * 64 + o8), kg1 = *(const f32x4*)(kg_ + l * 64 + o8 + 4);
        const float C2 = 0.125f * 1.4426950408889634f;
        const bool lohalf = (F.lane & 4) == 0;
        for (int r = F.gw; r < MT; r += F.ngw) {
            const bool isctx = r >= NLAT; const int b = isctx ? (r - NLAT) / CTXL : r / SEQ; const int t = isctx ? (r - NLAT) % CTXL : r % SEQ;
            const bf16* ur = U + (size_t)r * INW;
            const v4u wq = ((const v4u*)ur)[F.lane];
            const v4u wk = ((const v4u*)(ur + 512))[F.lane & 31];
            f32x4 c0 = {1.f, 1.f, 1.f, 1.f}, c1 = c0, s0 = {0.f, 0.f, 0.f, 0.f}, s1 = s0;
            if (!isctx) { const float* rc = RC + t * 32 + 8 * (F.lane & 3); const float* rs = RS + t * 32 + 8 * (F.lane & 3);
                c0 = *(const f32x4*)rc; c1 = *(const f32x4*)(rc + 4); s0 = *(const f32x4*)rs; s1 = *(const f32x4*)(rs + 4); }
            const size_t krow = (size_t)b * KEYS + (isctx ? t : CTXL + t);
#pragma unroll
            for (int part = 0; part < 2; ++part) {
                const v4u w = part ? wk : wq;
                float x[8] = {bflo(w.x), bfhi(w.x), bflo(w.y), bfhi(w.y), bflo(w.z), bfhi(w.z), bflo(w.w), bfhi(w.w)};
                float ss = 0.f;
#pragma unroll
                for (int i = 0; i < 8; ++i) ss += x[i] * x[i];
                ss += __shfl_xor(ss, 1); ss += __shfl_xor(ss, 2); ss += __shfl_xor(ss, 4);
                const float rstd = 1.0f / sqrtf(ss * (1.0f / 64.0f) + EPSN);
                const f32x4 g0 = part ? kg0 : qg0, g1 = part ? kg1 : qg1;
                float y[8], o[8];
#pragma unroll
                for (int i = 0; i < 8; ++i) y[i] = x[i] * rstd * (i < 4 ? g0[i] : g1[i - 4]);
#pragma unroll
                for (int i = 0; i < 8; ++i) { const float p = __shfl_xor(y[i], 4); const float cs = i < 4 ? c0[i] : c1[i - 4], sn = i < 4 ? s0[i] : s1[i - 4];
                    o[i] = lohalf ? (y[i] * cs - p * sn) : (y[i] * cs + p * sn); }
                if (part == 0) { v4u ow; ow.x = pk2(o[0] * C2, o[1] * C2); ow.y = pk2(o[2] * C2, o[3] * C2); ow.z = pk2(o[4] * C2, o[5] * C2); ow.w = pk2(o[6] * C2, o[7] * C2);
                    ((v4u*)(Q + (size_t)r * 512))[F.lane] = ow; }
                else { v4u ow; ow.x = pk2(o[0], o[1]); ow.y = pk2(o[2], o[3]); ow.z = pk2(o[4], o[5]); ow.w = pk2(o[6], o[7]);
                    if (F.lane < 16) ((v4u*)(K + krow * 128))[F.lane] = ow;
                    else if (F.lane < 32) ((v4u*)(V + krow * 128))[F.lane - 16] = wk; }
            }
        }
    }
    {
        bf16* XL = (bf16*)(F.ws + WS_XL);
        for (int idx = blockIdx.x * NTHR + F.tid; idx < MT * 32; idx += F.G * NTHR) {
            const int r = idx >> 5, c8 = (idx & 31) * 8;
            const bool isctx = r >= NLAT; const int Ls = isctx ? CTXL : SEQ; const int t = isctx ? (r - NLAT) % CTXL : r % SEQ;
            float acc[8];
#pragma unroll
            for (int i = 0; i < 8; ++i) acc[i] = lru_cb[l * 256 + c8 + i];
#pragma unroll
            for (int j = 0; j < 4; ++j) { const int tj = t + j - 2;
                if (tj >= 0 && tj < Ls) { const v4u w = *(const v4u*)(U + (size_t)(r + j - 2) * INW + 768 + c8);
                    const f32x4 w0 = *(const f32x4*)(lru_cw + (l * 4 + j) * 256 + c8), w1 = *(const f32x4*)(lru_cw + (l * 4 + j) * 256 + c8 + 4);
                    acc[0] += w0.x * bflo(w.x); acc[1] += w0.y * bfhi(w.x); acc[2] += w0.z * bflo(w.y); acc[3] += w0.w * bfhi(w.y);
                    acc[4] += w1.x * bflo(w.z); acc[5] += w1.y * bfhi(w.z); acc[6] += w1.z * bflo(w.w); acc[7] += w1.w * bfhi(w.w); } }
            v4u o; o.x = pk2(acc[0], acc[1]); o.y = pk2(acc[2], acc[3]); o.z = pk2(acc[4], acc[5]); o.w = pk2(acc[6], acc[7]);
            *(v4u*)(XL + (size_t)r * 256 + c8) = o;
        }
    }
    __syncthreads();
    {
        LAS bf16* hs = (LAS bf16*)(F.lds);
        float* VT = (float*)(F.ws + WS_VT); float* X0T = (float*)(F.ws + WS_X0T);
        const float* cw = hy_cw + (size_t)l * 3 * 768; const float* cbp = hy_cb + l * 768;
        for (int it = blockIdx.x; it < NLAT / 64; it += F.G) {
            const int b = it >> 7, t0 = (it & 127) * 64;
            for (int i = F.tid; i < 66 * 384; i += NTHR) { const int rr = i / 384, c2 = i - rr * 384; const int t = t0 - 1 + rr;
                unsigned w = 0u; if (t >= 0 && t < SEQ) w = *(const unsigned*)(U + (size_t)(b * SEQ + t) * INW + 1280 + 2 * c2);
                *(LAS unsigned*)(hs + rr * 770 + 2 * c2) = w; }
            __syncthreads();
            for (int c = F.wave; c < 256; c += NWAVES) {
                const int tt = F.lane;
                float o[3];
#pragma unroll
                for (int g = 0; g < 3; ++g) { const int cc = g * 256 + c;
                    o[g] = cw[cc] * bf2f(hs[tt * 770 + cc]) + cw[768 + cc] * bf2f(hs[(tt + 1) * 770 + cc]) + cw[1536 + cc] * bf2f(hs[(tt + 2) * 770 + cc]) + cbp[cc]; }
                const size_t oi = ((size_t)b * 256 + c) * SEQ + t0 + tt;
                VT[oi] = o[2] * o[1]; X0T[oi] = o[0];
            }
            __syncthreads();
        }
    }
}

__device__ __forceinline__ void ph_ctx_attn(const Frame& F) {
    const bf16* Q = (const bf16*)(F.ws + WS_Q); const bf16* K = (const bf16*)(F.ws + WS_K); const bf16* V = (const bf16*)(F.ws + WS_V); bf16* O = (bf16*)(F.ws + WS_ATT);
    LAS float* qs = (LAS float*)(F.lds + 90112 + F.wave * 1280);
    LAS float* ps = qs + 64;
    for (int it = F.gw; it < NCTX * 8; it += F.ngw) {
        const int rc = it >> 3, h = it & 7, b = rc / CTXL, kvh = h >> 2; const int r = NLAT + rc;
        qs[F.lane] = bf2f(Q[(size_t)r * 512 + h * 64 + F.lane]);
        LDS_WAIT();
        float sc[4]; float mx = -INFINITY;
#pragma unroll
        for (int i = 0; i < 4; ++i) { const int key = F.lane + 64 * i; const v4u* kp = (const v4u*)(K + ((size_t)b * KEYS + key) * 128 + kvh * 64);
            float s = 0.f;
#pragma unroll
            for (int q = 0; q < 8; ++q) { const v4u w = kp[q];
                s += qs[8 * q] * bflo(w.x) + qs[8 * q + 1] * bfhi(w.x) + qs[8 * q + 2] * bflo(w.y) + qs[8 * q + 3] * bfhi(w.y) + qs[8 * q + 4] * bflo(w.z) + qs[8 * q + 5] * bfhi(w.z) + qs[8 * q + 6] * bflo(w.w) + qs[8 * q + 7] * bfhi(w.w); }
            sc[i] = s; mx = fmaxf(mx, s); }
#pragma unroll
        for (int o = 1; o < 64; o <<= 1) mx = fmaxf(mx, __shfl_xor(mx, o));
        float sum = 0.f;
#pragma unroll
        for (int i = 0; i < 4; ++i) { const float p = exp2f(sc[i] - mx); sum += p; ps[F.lane + 64 * i] = p; }
        sum = wave_sum(sum);
        LDS_WAIT();
        float acc = 0.f;
        const bf16* vp = V + (size_t)b * KEYS * 128 + kvh * 64 + F.lane;
#pragma unroll 8
        for (int key = 0; key < CTXL; ++key) acc += ps[key] * bf2f(vp[(size_t)key * 128]);
        O[(size_t)r * 512 + h * 64 + F.lane] = (bf16)f2bf(acc / sum);
        LDS_WAIT();
    }
}

__device__ __forceinline__ int chunk_row0(int b, int d, int k) {
    if (k < 2) { const int cc = d ? 1 - k : k; return NLAT + b * CTXL + cc * CHUNK; }
    const int lc = d ? 63 - (k - 2) : (k - 2); return b * SEQ + lc * CHUNK;
}
__device__ __forceinline__ void ph_scan1(const Frame& F) {
    const bf16* LAB = (const bf16*)(F.ws + WS_LAB); float* SUMP = (float*)(F.ws + WS_SCANS); float* SUMH = SUMP + NB * 2 * NCHUNK * 256;
    for (int it = blockIdx.x * NTHR + F.tid; it < NB * 2 * NCHUNK * 256; it += F.G * NTHR) {
        const int ch = it & 255, k = (it >> 8) % NCHUNK, bd = (it >> 8) / NCHUNK, d = bd & 1, b = bd >> 1;
        const int r0 = chunk_row0(b, d, k);
        const bf16* LA = LAB + (size_t)(2 * d) * LAB_STRIDE + ch; const bf16* LB = LAB + (size_t)(2 * d + 1) * LAB_STRIDE + ch;
        float h = 0.f, Ps = 0.f;
#pragma unroll 16
        for (int i = 0; i < CHUNK; ++i) { const int r = d ? r0 + CHUNK - 1 - i : r0 + i; const float la = bf2f(LA[(size_t)r * 256]), bx = bf2f(LB[(size_t)r * 256]); h = __builtin_amdgcn_exp2f(la) * h + bx; Ps += la; }
        SUMP[it] = __builtin_amdgcn_exp2f(Ps); SUMH[it] = h;
    }
}
__device__ __forceinline__ void ph_scan2(const Frame& F) {
    const bf16* LAB = (const bf16*)(F.ws + WS_LAB); const float* SUMP = (const float*)(F.ws + WS_SCANS); const float* SUMH = SUMP + NB * 2 * NCHUNK * 256;
    float* LRUO = (float*)(F.ws + WS_LRUO); const bf16* U = (const bf16*)(F.ws + WS_U);
    for (int it = blockIdx.x * NTHR + F.tid; it < NB * NCHUNK * 256; it += F.G * NTHR) {
        const int ch = it & 255, kc = (it >> 8) % NCHUNK, b = (it >> 8) / NCHUNK;
        const int r0 = chunk_row0(b, 0, kc);
#pragma unroll 1
        for (int d = 0; d < 2; ++d) {
            const int k = d ? ((kc < 2) ? 1 - kc : 2 + 63 - (kc - 2)) : kc;
            const size_t sb = (size_t)((b * 2 + d) * NCHUNK) * 256 + ch;
            float h = 0.f;
#pragma unroll 8
            for (int j = 0; j < k; ++j) h = SUMP[sb + (size_t)j * 256] * h + SUMH[sb + (size_t)j * 256];
            const bf16* LA = LAB + (size_t)(2 * d) * LAB_STRIDE + ch; const bf16* LB = LAB + (size_t)(2 * d + 1) * LAB_STRIDE + ch;
            if (d == 0) {
#pragma unroll 16
                for (int i = 0; i < CHUNK; ++i) { const int r = r0 + i; h = __builtin_amdgcn_exp2f(bf2f(LA[(size_t)r * 256])) * h + bf2f(LB[(size_t)r * 256]); LRUO[(size_t)r * 256 + ch] = h; }
            } else {
#pragma unroll 8
                for (int i = 0; i < CHUNK; ++i) { const int r = r0 + CHUNK - 1 - i; h = __builtin_amdgcn_exp2f(bf2f(LA[(size_t)r * 256])) * h + bf2f(LB[(size_t)r * 256]);
                    const float lg = bf2f(U[(size_t)r * INW + 1024 + ch]);
                    LRUO[(size_t)r * 256 + ch] = (LRUO[(size_t)r * 256 + ch] + h) * gelu_tanh(lg); }
            }
        }
    }
}

__device__ __forceinline__ void ph_hyena_direct(const Frame& F, int l, const float* hy_bias, const float* hy_cw, const float* hy_cb) {
    LAS float* ks = (LAS float*)(F.lds);
    LAS float* vs = (LAS float*)(F.lds + 65536);
    const float* KF = (const float*)(F.ws + WS_KF) + (size_t)l * 256 * 16384;
    const float* VT = (const float*)(F.ws + WS_VT); const float* X0T = (const float*)(F.ws + WS_X0T); float* HYO = (float*)(F.ws + WS_HYO);
    for (int it = blockIdx.x; it < 512; it += F.G) {
        const int c = it >> 1, bp = it & 1;
        for (int i = F.tid; i < 4096; i += NTHR) ((LAS f32x4*)ks)[i] = ((const f32x4*)(KF + (size_t)c * 16384))[i];
        for (int i = F.tid; i < 4096; i += NTHR) { const int bb = i >> 11, q = i & 2047; ((LAS f32x4*)vs)[i] = ((const f32x4*)(VT + ((size_t)(bp * 2 + bb) * 256 + c) * SEQ))[q]; }
        __syncthreads();
        float y0[16], y1[16];
#pragma unroll
        for (int i = 0; i < 16; ++i) { y0[i] = 0.f; y1[i] = 0.f; }
#pragma unroll 2
        for (int s = 0; s < SEQ; ++s) {
            const float v0 = vs[s], v1 = vs[SEQ + s];
            const int base = (F.tid - s) & 16383;
#pragma unroll
            for (int i = 0; i < 16; ++i) { const float kk = ks[(base + 512 * i) & 16383]; y0[i] += kk * v0; y1[i] += kk * v1; }
        }
        const float bias = hy_bias[l * 256 + c];
#pragma unroll
        for (int i = 0; i < 16; ++i) { const int t = F.tid + 512 * i;
            { const int b = bp * 2; const size_t oi = ((size_t)b * 256 + c) * SEQ + t; HYO[((size_t)b * SEQ + t) * 256 + c] = (y0[i] + vs[t] * bias) * X0T[oi]; }
            { const int b = bp * 2 + 1; const size_t oi = ((size_t)b * 256 + c) * SEQ + t; HYO[((size_t)b * SEQ + t) * 256 + c] = (y1[i] + vs[SEQ + t] * bias) * X0T[oi]; } }
        __syncthreads();
    }
}
__device__ __forceinline__ void ph_khat(const Frame& F) {
    LAS f32x2v* D = (LAS f32x2v*)(F.lds);
    const float* KF = (const float*)(F.ws + WS_KF); c32* KHAT = (c32*)(F.ws + WS_KHAT);
    for (int it = blockIdx.x; it < 512; it += F.G) {
        const float* k = KF + (size_t)it * 16384; c32* out = KHAT + (size_t)it * 16384;
#pragma unroll 1
        for (int i = 0; i < 8; ++i) { const int j = F.tid + 512 * i; c32 x0, x1, x2, x3; x0.x = k[j]; x1.x = k[j + 4096]; x2.x = k[j + 8192]; x3.x = k[j + 12288]; x0.y = x1.y = x2.y = x3.y = 0.f;
            fft_first4(D, j, x0, x1, x2, x3); }
        __syncthreads();
        _Pragma("unroll 1") for (int g_ = F.tid; g_ < 1024; g_ += 512) fft_fwd16(D, g_, 4096);
        __syncthreads();
        _Pragma("unroll 1") for (int g_ = F.tid; g_ < 1024; g_ += 512) fft_fwd16(D, g_, 256);
        __syncthreads();
        _Pragma("unroll 1") for (int g_ = F.tid; g_ < 1024; g_ += 512) fft_last16_out(D, g_, out, 1.0f / 16384.0f);
        __syncthreads();
    }
}
__device__ __forceinline__ void ph_hyena_fft(const Frame& F, int l, const float* hy_bias) {
    LAS f32x2v* D = (LAS f32x2v*)(F.lds);
    const c32* KHAT = (const c32*)(F.ws + WS_KHAT) + (size_t)l * 256 * 16384;
    const float* VT = (const float*)(F.ws + WS_VT); const float* X0T = (const float*)(F.ws + WS_X0T); float* HYO = (float*)(F.ws + WS_HYO);
    for (int it = blockIdx.x; it < 512; it += F.G) {
        const int c = it >> 1, bp = it & 1;
        const float* va = VT + ((size_t)(bp * 2) * 256 + c) * SEQ; const float* vb = VT + ((size_t)(bp * 2 + 1) * 256 + c) * SEQ;
#ifndef REP_FFT
#define REP_FFT 1
#endif
#pragma unroll 1
        for (int repf_ = 0; repf_ < REP_FFT; ++repf_) {
#pragma unroll 1
        for (int i = 0; i < 8; ++i) { const int j = F.tid + 512 * i; c32 x0, x1, z; x0.x = va[j]; x0.y = vb[j]; x1.x = va[j + 4096]; x1.y = vb[j + 4096]; z.x = 0.f; z.y = 0.f;
            fft_first4(D, j, x0, x1, z, z); }
        __syncthreads();
        _Pragma("unroll 1") for (int g_ = F.tid; g_ < 1024; g_ += 512) fft_fwd16(D, g_, 4096);
        __syncthreads();
        _Pragma("unroll 1") for (int g_ = F.tid; g_ < 1024; g_ += 512) fft_fwd16(D, g_, 256);
        __syncthreads();
        _Pragma("unroll 1") for (int g_ = F.tid; g_ < 1024; g_ += 512) fft_mid16(D, g_, KHAT + (size_t)c * 16384);
        __syncthreads();
        _Pragma("unroll 1") for (int g_ = F.tid; g_ < 1024; g_ += 512) fft_inv16(D, g_, 256);
        __syncthreads();
        _Pragma("unroll 1") for (int g_ = F.tid; g_ < 1024; g_ += 512) fft_inv16(D, g_, 4096);
        __syncthreads();
        }
        const float bias = hy_bias[l * 256 + c];
        const float* xa = X0T + ((size_t)(bp * 2) * 256 + c) * SEQ; const float* xb = X0T + ((size_t)(bp * 2 + 1) * 256 + c) * SEQ;
        float* oa = HYO + ((size_t)(bp * 2) * 256 + c) * SEQ; float* ob = HYO + ((size_t)(bp * 2 + 1) * 256 + c) * SEQ;
#pragma unroll 2
        for (int i = 0; i < 8; ++i) { const int j = F.tid + 512 * i; c32 u0, u1; fft_final4(D, j, u0, u1);
            oa[j] = (u0.x + va[j] * bias) * xa[j];                 ob[j] = (-u0.y + vb[j] * bias) * xb[j];
            oa[j + 4096] = (u1.x + va[j + 4096] * bias) * xa[j + 4096]; ob[j + 4096] = (-u1.y + vb[j + 4096] * bias) * xb[j + 4096]; }
        __syncthreads();
    }
}
__device__ __forceinline__ void ph_hyena_ctx(const Frame& F, const float* hy_bias, const float* hy_cw, const float* hy_cb) {
    float* HYO = (float*)(F.ws + WS_HYO);
    {

        const bf16* U = (const bf16*)(F.ws + WS_U); const float* KFC = (const float*)(F.ws + WS_KFC);
        LAS float* vw = (LAS float*)(F.lds + F.wave * 4096);
        LAS float* kw = vw + 256;
        const float* cw = hy_cw; const float* cbp = hy_cb;
        for (int it = F.gw; it < NB * 256; it += F.ngw) {
            const int b = it >> 8, c = it & 255;
            float x0v[4];
#pragma unroll
            for (int i = 0; i < 4; ++i) { const int t = F.lane + 64 * i;
                float o[3];
#pragma unroll
                for (int g = 0; g < 3; ++g) { const int cc = g * 256 + c; float a = cbp[cc];
#pragma unroll
                    for (int j = 0; j < 3; ++j) { const int tj = t + j - 1; if (tj >= 0 && tj < CTXL) a += cw[j * 768 + cc] * bf2f(U[(size_t)(NLAT + b * CTXL + tj) * INW + 1280 + cc]); }
                    o[g] = a; }
                vw[t] = o[2] * o[1]; x0v[i] = o[0]; }
#pragma unroll
            for (int i = 0; i < 8; ++i) kw[F.lane + 64 * i] = KFC[c * 512 + F.lane + 64 * i];
            LDS_WAIT();
            float y[4] = {0.f, 0.f, 0.f, 0.f};
#pragma unroll 4
            for (int s = 0; s < CTXL; ++s) { const float vv = vw[s];
#pragma unroll
                for (int i = 0; i < 4; ++i) y[i] += kw[(F.lane + 64 * i - s) & 511] * vv; }
            const float bias = hy_bias[c];
#pragma unroll
            for (int i = 0; i < 4; ++i) { const int t = F.lane + 64 * i; HYO[(size_t)(NLAT + b * CTXL + t) * 256 + c] = (y[i] + vw[t] * bias) * x0v[i]; }
            LDS_WAIT();
        }
    }
}

__device__ __forceinline__ void merge_row(const Frame& F, int r, const float* g, float h0, float h1, float h2, float h3) {
    const bf16* ATT = (const bf16*)(F.ws + WS_ATT); const float* LRUO = (const float*)(F.ws + WS_LRUO); bf16* MIXA = (bf16*)(F.ws + WS_MIXA);
    const v4u aw = ((const v4u*)(ATT + (size_t)r * 512))[F.lane];
    float a[8] = {bflo(aw.x), bfhi(aw.x), bflo(aw.y), bfhi(aw.y), bflo(aw.z), bfhi(aw.z), bflo(aw.w), bfhi(aw.w)};
    float ss = 0.f;
#pragma unroll
    for (int i = 0; i < 8; ++i) ss += a[i] * a[i];
    const float ra = 1.0f / sqrtf(wave_sum(ss) * (1.0f / 512.0f) + EPSN);
    const f32x4 lv = ((const f32x4*)(LRUO + (size_t)r * 256))[F.lane];
    const float rl = 1.0f / sqrtf(wave_sum(lv.x * lv.x + lv.y * lv.y + lv.z * lv.z + lv.w * lv.w) * (1.0f / 256.0f) + EPSN);
    const float rh = 1.0f / sqrtf(wave_sum(h0 * h0 + h1 * h1 + h2 * h2 + h3 * h3) * (1.0f / 256.0f) + EPSN);
    bf16* orow = MIXA + (size_t)r * 1024;
    { const f32x4 g0 = ((const f32x4*)g)[2 * F.lane], g1 = ((const f32x4*)g)[2 * F.lane + 1];
      v4u o; o.x = pk2(a[0] * ra * g0.x, a[1] * ra * g0.y); o.y = pk2(a[2] * ra * g0.z, a[3] * ra * g0.w); o.z = pk2(a[4] * ra * g1.x, a[5] * ra * g1.y); o.w = pk2(a[6] * ra * g1.z, a[7] * ra * g1.w);
      ((v4u*)orow)[F.lane] = o; }
    { const f32x4 gg = ((const f32x4*)(g + 512))[F.lane]; v2u o; o.x = pk2(lv.x * rl * gg.x, lv.y * rl * gg.y); o.y = pk2(lv.z * rl * gg.z, lv.w * rl * gg.w); ((v2u*)(orow + 512))[F.lane] = o; }
    orow[768 + F.lane] = (bf16)f2bf(h0 * rh * g[768 + F.lane]); orow[832 + F.lane] = (bf16)f2bf(h1 * rh * g[832 + F.lane]);
    orow[896 + F.lane] = (bf16)f2bf(h2 * rh * g[896 + F.lane]); orow[960 + F.lane] = (bf16)f2bf(h3 * rh * g[960 + F.lane]);
}
__device__ __forceinline__ void ph_merge(const Frame& F, int l, int nrows, const float* out_g) {
    const float* HYO = (const float*)(F.ws + WS_HYO);
    const float* g = out_g + l * 1024;
    LAS float* tile = (LAS float*)(F.lds);
    for (int it = blockIdx.x; it < NLAT / 64; it += F.G) {
        const int b = it >> 7, t0 = (it & 127) * 64;
#pragma unroll 8
        for (int i = 0; i < 32; ++i) { const int c = F.wave * 32 + i; tile[c * 65 + F.lane] = HYO[((size_t)b * 256 + c) * SEQ + t0 + F.lane]; }
        __syncthreads();
#pragma unroll 2
        for (int k = 0; k < 8; ++k) { const int tt = F.wave * 8 + k;
            merge_row(F, b * SEQ + t0 + tt, g, tile[F.lane * 65 + tt], tile[(F.lane + 64) * 65 + tt], tile[(F.lane + 128) * 65 + tt], tile[(F.lane + 192) * 65 + tt]); }
        __syncthreads();
    }
    for (int r = NLAT + F.gw; r < nrows; r += F.ngw) {
        const float* hr = HYO + (size_t)r * 256;
        merge_row(F, r, g, hr[F.lane], hr[64 + F.lane], hr[128 + F.lane], hr[192 + F.lane]);
    }
}

__device__ __forceinline__ void ph_ffn_router_old(const Frame& F, int l, int nrows, const float* gffn, const float* router_w, const float* router_b) {
    LAS float* rwl = (LAS float*)(F.lds);
    LAS int* hist = (LAS int*)(F.lds + 135168);
    const float* XR = (const float*)(F.ws + WS_XR); const float* MOD = (const float*)(F.ws + WS_MOD); bf16* Fb = (bf16*)(F.ws + WS_F);
    int* TOPI = (int*)(F.ws + WS_TOPI); float* GATE = (float*)(F.ws + WS_GATE); int* BLKCNT = (int*)(F.ws + WS_BLKCNT);
    for (int i = F.tid; i < 1024 * 32; i += NTHR) rwl[(i >> 5) * 33 + (i & 31)] = router_w[(size_t)l * 32768 + i];
    if (F.tid < 32) hist[F.tid] = 0;
    __syncthreads();
    const float* g = gffn + l * 1024;
    for (int r = F.gw; r < nrows; r += F.ngw) {
        const int bidx = r < NLAT ? r / SEQ : 4;
        const float* sf = MOD + (size_t)(l * 5 + bidx) * 6144 + 3 * 1024; const float* cf = sf + 1024;
        float f[16]; float ss = 0.f;
#pragma unroll
        for (int j = 0; j < 16; ++j) { f[j] = XR[(size_t)r * 1024 + 64 * j + F.lane]; ss += f[j] * f[j]; }
        const float rstd = 1.0f / sqrtf(wave_sum(ss) * (1.0f / 1024.0f) + EPSN);
        float p[32];
#pragma unroll
        for (int e = 0; e < 32; ++e) p[e] = 0.f;
#pragma unroll
        for (int j = 0; j < 16; ++j) { const int c = 64 * j + F.lane; const float fv = f[j] * rstd * g[c] * (1.0f + cf[c]) + sf[c];
            Fb[(size_t)r * 1024 + c] = (bf16)f2bf(fv);
            const LAS float* wrow = rwl + c * 33;
#pragma unroll
            for (int e = 0; e < 32; ++e) p[e] += fv * wrow[e]; }
#pragma unroll
        for (int e = 0; e < 32; ++e) p[e] = wave_sum(p[e]) + router_b[l * 32 + e];
        unsigned taken = 0u; float tv[4]; int ti[4];
#pragma unroll
        for (int k = 0; k < 4; ++k) { float best = -INFINITY; int bi = 0;
#pragma unroll
            for (int e = 0; e < 32; ++e) { const bool ok = !((taken >> e) & 1u) && (p[e] > best); best = ok ? p[e] : best; bi = ok ? e : bi; }
            taken |= 1u << bi; tv[k] = best; ti[k] = bi; }
        const float e1 = __expf(tv[1] - tv[0]), e2 = __expf(tv[2] - tv[0]), e3 = __expf(tv[3] - tv[0]); const float inv = 1.0f / (1.0f + e1 + e2 + e3);
        if (F.lane == 0) {
            TOPI[r * 4 + 0] = ti[0]; TOPI[r * 4 + 1] = ti[1]; TOPI[r * 4 + 2] = ti[2]; TOPI[r * 4 + 3] = ti[3];
            GATE[r * 4 + 0] = inv; GATE[r * 4 + 1] = e1 * inv; GATE[r * 4 + 2] = e2 * inv; GATE[r * 4 + 3] = e3 * inv;
            lds_add(&hist[ti[0]], 1); lds_add(&hist[ti[1]], 1); lds_add(&hist[ti[2]], 1); lds_add(&hist[ti[3]], 1);
        }
    }
    __syncthreads();
    if (F.tid < 32) BLKCNT[blockIdx.x * 32 + F.tid] = hist[F.tid];
}

__device__ __forceinline__ void ph_ffn_router(const Frame& F, int l, int nrows, const float* router_w) {
    LAS float* rwl = (LAS float*)(F.lds);
    LAS float* cbl = (LAS float*)(F.lds + 147456);
    LAS int* hist = (LAS int*)(F.lds + 147456 + 640);
    const bf16* XR = (const bf16*)(F.ws + WS_XR); const float* RSSP = (const float*)(F.ws + WS_RSSP); const float* MOD = (const float*)(F.ws + WS_MOD);
    const float* GC = (const float*)(F.ws + WS_GC) + (size_t)l * 5 * 1024; bf16* Fb = (bf16*)(F.ws + WS_F);
    int* TOPI = (int*)(F.ws + WS_TOPI); float* GATE = (float*)(F.ws + WS_GATE); int* BLKCNT = (int*)(F.ws + WS_BLKCNT);
    for (int i = F.tid; i < 1024 * 32; i += NTHR) rwl[(i >> 5) * 36 + (i & 31)] = router_w[(size_t)l * 32768 + i];
    if (F.tid < 32) hist[F.tid] = 0;
    if (F.tid < 160) cbl[F.tid] = ((const float*)(F.ws + WS_CB))[l * 160 + F.tid];
    __syncthreads();
    const int j = F.lane & 15, kq = F.lane >> 4;
    for (int grp = F.gw; grp < nrows / 16; grp += F.ngw) {
        const int r0 = grp * 16, r = r0 + j; const int bidx = r0 < NLAT ? r0 / SEQ : 4;
        const bf16* xrow = XR + (size_t)r * 1024 + 4 * kq; const float* gcp = GC + bidx * 1024 + 4 * kq; const float* sfp = MOD + (size_t)(l * 5 + bidx) * 6144 + 3 * 1024 + 4 * kq;
        bf16* frow = Fb + (size_t)r * 1024 + 4 * kq;
        float ss; { const f32x4 q = *(const f32x4*)(RSSP + (size_t)r * 16 + 4 * kq); ss = (q.x + q.y) + (q.z + q.w); }
        ss += __shfl_xor(ss, 16); ss += __shfl_xor(ss, 32);
        const float rstd = 1.0f / sqrtf(ss * (1.0f / 1024.0f) + EPSN);
        f32x4 acc0 = {0.f, 0.f, 0.f, 0.f}, acc1 = acc0;
#pragma unroll 1
        for (int ib = 0; ib < 64; ib += 8) {
            v2u xw[8]; f32x4 g4[8], s4[8];
#pragma unroll
            for (int u = 0; u < 8; ++u) { xw[u] = *(const v2u*)(xrow + 16 * (ib + u)); g4[u] = *(const f32x4*)(gcp + 16 * (ib + u)); s4[u] = *(const f32x4*)(sfp + 16 * (ib + u)); }
#pragma unroll
            for (int u = 0; u < 8; ++u) {
                const f32x4 x4 = {bflo(xw[u].x), bfhi(xw[u].x), bflo(xw[u].y), bfhi(xw[u].y)};
                const f32x4 xb = x4 * g4[u];
                const f32x4 fv = xb * rstd + s4[u];
                v2u o; o.x = pk2(fv.x, fv.y); o.y = pk2(fv.z, fv.w); *(v2u*)(frow + 16 * (ib + u)) = o;
                const LAS float* wp = rwl + (16 * (ib + u) + 4 * kq) * 36 + j;
#pragma unroll
                for (int e = 0; e < 4; ++e) { acc0 = __builtin_amdgcn_mfma_f32_16x16x4f32(wp[e * 36], xb[e], acc0, 0, 0, 0); acc1 = __builtin_amdgcn_mfma_f32_16x16x4f32(wp[e * 36 + 16], xb[e], acc1, 0, 0, 0); }
            }
        }
        float lg[8];
#pragma unroll
        for (int rr = 0; rr < 4; ++rr) { lg[rr] = rstd * acc0[rr] + cbl[bidx * 32 + 4 * kq + rr]; lg[4 + rr] = rstd * acc1[rr] + cbl[bidx * 32 + 16 + 4 * kq + rr]; }
        float p[32];
#pragma unroll
        for (int e = 0; e < 32; ++e) p[e] = __shfl(lg[(e >> 4) * 4 + (e & 3)], j + 16 * ((e & 15) >> 2));
        unsigned taken = 0u; float tv[4]; int ti[4];
#pragma unroll
        for (int k = 0; k < 4; ++k) { float best = -INFINITY; int bi = 0;
#pragma unroll
            for (int e = 0; e < 32; ++e) { const bool ok = !((taken >> e) & 1u) && (p[e] > best); best = ok ? p[e] : best; bi = ok ? e : bi; }
            taken |= 1u << bi; tv[k] = best; ti[k] = bi; }
        const float e1 = __expf(tv[1] - tv[0]), e2 = __expf(tv[2] - tv[0]), e3 = __expf(tv[3] - tv[0]); const float inv = 1.0f / (1.0f + e1 + e2 + e3);
        if (kq == 0) {
            TOPI[r * 4 + 0] = ti[0]; TOPI[r * 4 + 1] = ti[1]; TOPI[r * 4 + 2] = ti[2]; TOPI[r * 4 + 3] = ti[3];
            GATE[r * 4 + 0] = inv; GATE[r * 4 + 1] = e1 * inv; GATE[r * 4 + 2] = e2 * inv; GATE[r * 4 + 3] = e3 * inv;
            lds_add(&hist[ti[0]], 1); lds_add(&hist[ti[1]], 1); lds_add(&hist[ti[2]], 1); lds_add(&hist[ti[3]], 1);
        }
    }
    __syncthreads();
    if (F.tid < 32) BLKCNT[blockIdx.x * 32 + F.tid] = hist[F.tid];
}

__device__ __forceinline__ void ph_route(const Frame& F, int nrows) {
    LAS int* cursor = (LAS int*)(F.lds);
    LAS int* tot = cursor + 32;
    LAS int* mine = cursor + 64;
    LAS int* part = cursor + 96;
    LAS int* ebase = cursor + 96 + 1024;
    const int* BLKCNT = (const int*)(F.ws + WS_BLKCNT); const int* TOPI = (const int*)(F.ws + WS_TOPI); int* POS = (int*)(F.ws + WS_POS);
    int* ROWTOK = (int*)(F.ws + WS_ROWTOK); int* TILEE = (int*)(F.ws + WS_TILEE);
    { const int e = F.tid & 31, sl = F.tid >> 5; int t = 0, m = 0;
      for (int b = sl; b < F.G; b += 16) { const int v = BLKCNT[b * 32 + e]; t += v; m += (b < (int)blockIdx.x) ? v : 0; }
      part[sl * 64 + e] = t; part[sl * 64 + 32 + e] = m;
      __syncthreads();
      if (F.tid < 32) { int tt = 0, mm = 0;
#pragma unroll
          for (int s = 0; s < 16; ++s) { tt += part[s * 64 + F.tid]; mm += part[s * 64 + 32 + F.tid]; }
          tot[F.tid] = tt; mine[F.tid] = mm; } }
    __syncthreads();
    if (F.tid == 0) { int tb = 0;
        for (int e = 0; e < 32; ++e) { const int nt = (tot[e] + 255) >> 8; cursor[e] = tb * 256 + mine[e]; ebase[e] = tb * 256;
            if (blockIdx.x == 0) for (int j = 0; j < nt; ++j) TILEE[tb + j] = e;
            tb += nt; }
        ebase[32] = tb * 256;
        if (blockIdx.x == 0) F.ctl[CW_NTILES] = (unsigned)tb; }
    __syncthreads();
    for (int e = blockIdx.x; e < 32; e += F.G) for (int p = ebase[e] + tot[e] + F.tid; p < ebase[e + 1]; p += NTHR) ROWTOK[p] = 0;
    const int sub = F.lane >> 2, k = F.lane & 3;
    for (int grp = F.gw; grp < nrows / 16; grp += F.ngw) {
        const int r = grp * 16 + sub; const int e = TOPI[r * 4 + k]; const int pos = lds_add(&cursor[e], 1); POS[r * 4 + k] = pos; ROWTOK[pos] = r; }
}

__device__ __forceinline__ void ph_combine(const Frame& F, int l, int nrows, float* out, const float* gmix) {
    bf16* XR = (bf16*)(F.ws + WS_XR); const float* MOD = (const float*)(F.ws + WS_MOD); const bf16* YS = (const bf16*)(F.ws + WS_YS); bf16* H = (bf16*)(F.ws + WS_H);
    const int* POS = (const int*)(F.ws + WS_POS); const float* GATE = (const float*)(F.ws + WS_GATE);
    for (int r = F.gw; r < nrows; r += F.ngw) {
        const int bidx = r < NLAT ? r / SEQ : 4;
        const float* gf = MOD + (size_t)(l * 5 + bidx) * 6144 + 5 * 1024;
        int pos = 0; float gt = 0.f;
        if (F.lane < 4) { pos = POS[r * 4 + F.lane]; gt = GATE[r * 4 + F.lane]; }
        f32x4 y[4];
#pragma unroll
        for (int j = 0; j < 4; ++j) y[j] = (f32x4){0.f, 0.f, 0.f, 0.f};
#pragma unroll
        for (int k = 0; k < 4; ++k) { const int pk = __shfl(pos, k); const float gk = __shfl(gt, k); const v2u* yr = (const v2u*)(YS + (size_t)pk * 1024);
#pragma unroll
            for (int j = 0; j < 4; ++j) { const v2u w = yr[64 * j + F.lane]; y[j].x += gk * bflo(w.x); y[j].y += gk * bfhi(w.x); y[j].z += gk * bflo(w.y); y[j].w += gk * bfhi(w.y); } }
        float ss = 0.f;
#pragma unroll
        for (int j = 0; j < 4; ++j) { const int cb = 64 * j + F.lane; const v2u xw = ((const v2u*)(XR + (size_t)r * 1024))[cb]; const f32x4 xv = {bflo(xw.x), bfhi(xw.x), bflo(xw.y), bfhi(xw.y)}; const f32x4 gv = ((const f32x4*)gf)[cb];
            y[j] = xv + gv * y[j];
            if (l == 0) { v2u o; o.x = pk2(y[j].x, y[j].y); o.y = pk2(y[j].z, y[j].w); ((v2u*)(XR + (size_t)r * 1024))[cb] = o; } else ((f32x4*)(out + (size_t)r * 1024))[cb] = y[j];
            ss += (y[j].x * y[j].x + y[j].y * y[j].y) + (y[j].z * y[j].z + y[j].w * y[j].w); }
        if (l == 0) {
            const float rstd = 1.0f / sqrtf(wave_sum(ss) * (1.0f / 1024.0f) + EPSN);
            const float* shift = MOD + (size_t)(5 + bidx) * 6144; const float* scale = shift + 1024; const float* g = gmix + 1024;
#pragma unroll
            for (int j = 0; j < 4; ++j) { const int cb = 64 * j + F.lane; const f32x4 gg = ((const f32x4*)g)[cb], sc = ((const f32x4*)scale)[cb], sh = ((const f32x4*)shift)[cb];
                const f32x4 hv = y[j] * rstd * gg * (sc + 1.0f) + sh;
                v2u o; o.x = pk2(hv.x, hv.y); o.y = pk2(hv.z, hv.w); ((v2u*)(H + (size_t)r * 1024))[cb] = o; }
        }
    }
}

struct Args { const float* in[34]; float* out; unsigned char* ws; int ph_lo, ph_hi; };
enum { I_X = 0, I_C, I_CTX, I_CCTX, I_WMOD, I_BMOD, I_GMIX, I_GFFN, I_WIN, I_QG, I_KG, I_LCW, I_LCB, I_LGW, I_LGB, I_LLAM, I_HCW, I_HCB, I_HW1, I_HB1, I_HW2, I_HB2, I_HW3, I_HFREQ, I_HDEC, I_HBIAS,
       I_OUTG, I_WOUT, I_RW, I_RB, I_MW1, I_MB1, I_MW2, I_MB2 };

__global__ void __launch_bounds__(NTHR, 2) mk_fwd(Args args) {
    extern __shared__ __attribute__((aligned(16))) unsigned char lds[];
    Frame F;
    F.lds = (LAS unsigned char*)lds; F.ws = args.ws; F.ctl = (unsigned*)(args.ws + WS_CTL);
    F.tid = threadIdx.x; F.lane = F.tid & 63; F.wave = __builtin_amdgcn_readfirstlane(F.tid >> 6);
    F.G = gridDim.x; { const int bx = blockIdx.x; F.vcu = (F.G % 8 == 0) ? (bx % 8) * (F.G / 8) + bx / 8 : bx; }
    F.gw = (int)blockIdx.x * NWAVES + F.wave; F.ngw = F.G * NWAVES;
    for (int u = F.tid; u < (LDS_BYTES - LDSCTL_OFF) / 4; u += NTHR) ((LAS unsigned*)(F.lds + LDSCTL_OFF))[u] = 0u;
    __syncthreads();
#if !MK_PER_PHASE
    XcdBarrier bar = xcd_barrier_post(F.ctl + CW_BAR, (volatile LAS unsigned*)(F.lds + LDSCTL_OFF + 32));
#define GRID_BAR() xcd_barrier(bar)
#else
#define GRID_BAR() do { } while (0)
#endif
    const int lo = args.ph_lo, hi = args.ph_hi;
#ifndef ONLY_PHASE
#define ONLY_PHASE (-1)
#endif
#define ENABLED(id) (ONLY_PHASE < 0 || ONLY_PHASE == (id))
#define IN(k) (ENABLED(k) && lo <= (k) && (k) < hi)
#define INL(j) (ENABLED(NPH_PRO + (j)) && lo <= pb + (j) && pb + (j) < hi)
#define SEAML(j) do { if (lo <= pb + (j) && pb + (j) + 1 < hi) { GRID_BAR(); } } while (0)
typedef const __attribute__((address_space(4))) Args* KArgs;
#ifndef REP_MASK
#define REP_MASK 0
#endif
#define NREP(j) (((REP_MASK >> (j)) & 1) ? 2 : 1)
#define REFRAME() Frame Fp = F; KArgs ka = (KArgs)__builtin_amdgcn_kernarg_segment_ptr(); { int t_ = F.tid; asm volatile("" : "+v"(t_), "+s"(ka)); Fp.tid = t_; Fp.lane = t_ & 63; Fp.wave = __builtin_amdgcn_readfirstlane(t_ >> 6); \
    Fp.gw = (int)blockIdx.x * NWAVES + Fp.wave; Fp.ws = ka->ws; Fp.ctl = (unsigned*)(ka->ws + WS_CTL); }
#define SEAM(k) do { if (lo <= (k) && (k) + 1 < hi) { GRID_BAR(); } } while (0)

    if (IN(0)) ph_prologue_a(F, args.in[I_C], args.in[I_CCTX], args.in[I_WMOD], args.in[I_BMOD], args.in[I_WIN], args.in[I_WOUT], args.in[I_MW1], args.in[I_MW2],
                             args.in[I_HW1], args.in[I_HB1], args.in[I_HW2], args.in[I_HB2], args.in[I_HFREQ], args.in[I_LGW], args.in[I_LLAM]);
    SEAM(0);
    if (IN(1)) ph_prologue_b(F, args.in[I_HW3], args.in[I_HDEC], args.in[I_GFFN], args.in[I_RW], args.in[I_RB]);
    SEAM(1);

#define PHASE(j, ...) if (INL(j)) { _Pragma("unroll") for (int rep_ = 0; rep_ < NREP(j); ++rep_) { { REFRAME(); __VA_ARGS__ } if (rep_ + 1 < NREP(j)) GRID_BAR(); } }
#define LAYER_BODY(l) { \
        const int pb = NPH_PRO + l * NPH_LAYER; \
        const int nrows = (l == 0) ? MT : NLAT; \
        if (l == 0) { PHASE(0, ph_norm_mod(Fp, l, ka->in[I_X], ka->in[I_CTX], ka->in[I_GMIX]);) SEAML(0); } \
        PHASE(1, \
            pg8::Gemm g{(const bf16*)(Fp.ws + WS_H), (const bf16*)(Fp.ws + WS_WINT) + (size_t)l * 2048 * 1024, MT, 2048, 1024}; \
            pg8::StaticOrder S; S.init(MT, 2048, Fp.G, (int)blockIdx.x); \
            pg8::EpiBf16<0> E{(bf16*)(Fp.ws + WS_U), 2048, nullptr, 0, 0, 1.f}; \
            pg8::gemm_phase<pg8::EpiBf16<0>, pg8::StaticOrder, PG8_ALIGN, PG8_SP2>(Fp.lds + RING_OFF, g, S, E);) \
        SEAML(1); \
        PHASE(2, ph_post_proj(Fp, l, ka->in[I_QG], ka->in[I_KG], ka->in[I_LCW], ka->in[I_LCB], ka->in[I_HCW], ka->in[I_HCB]);) \
        SEAML(2); \
        PHASE(3, \
            int kg_ = 256; asm volatile("" : "+s"(kg_)); \
            pg8::Gemm g{(const bf16*)(Fp.ws + WS_XL), (const bf16*)(Fp.ws + WS_WGT) + (size_t)l * 1024 * 256, MT, 1024, kg_}; \
            pg8::StaticOrder S; S.init(MT, 1024, Fp.G, (int)blockIdx.x); \
            pg8::EpiLruGate E{(const bf16*)(Fp.ws + WS_XL), (bf16*)(Fp.ws + WS_LAB), LAB_STRIDE, ka->in[I_LGB] + (size_t)l * 1024, (const float*)(Fp.ws + WS_SPT) + l * 512}; \
            pg8::gemm_phase<pg8::EpiLruGate, pg8::StaticOrder, PG8_ALIGN, PG8_SP2>(Fp.lds + RING_OFF, g, S, E);) \
        SEAML(3); \
        PHASE(4, \
            ph_scan1(Fp); __syncthreads(); \
            const attn_body::AttnTensors AT{(const attn_body::bf16*)(Fp.ws + WS_Q), (const attn_body::bf16*)(Fp.ws + WS_K), (const attn_body::bf16*)(Fp.ws + WS_V), (attn_body::bf16*)(Fp.ws + WS_ATT)}; \
            attn_body::attn_phase<8>((char*)lds + RING_OFF, AT, Fp.G, Fp.vcu, l == 0, (long)NLAT);) \
        SEAML(4); \
        PHASE(5, ph_scan2(Fp); __syncthreads(); ph_hyena_fft(Fp, l, ka->in[I_HBIAS]); if (l == 0) ph_hyena_ctx(Fp, ka->in[I_HBIAS], ka->in[I_HCW], ka->in[I_HCB]);) \
        SEAML(5); \
        PHASE(6, ph_merge(Fp, l, nrows, ka->in[I_OUTG]);) \
        SEAML(6); \
        if (INL(7)) { REFRAME(); \
            pg8::Gemm g{(const bf16*)(Fp.ws + WS_MIXA), (const bf16*)(Fp.ws + WS_WOUTT) + (size_t)l * 1024 * 1024, nrows, 1024, 1024}; \
            pg8::StaticOrder S; S.init(nrows, 1024, Fp.G, (int)blockIdx.x); \
            bf16* XR = (bf16*)(Fp.ws + WS_XR); \
            pg8::EpiResid<(l) == 1> E{ka->in[I_X], ka->in[I_CTX], NLAT, XR, 1024, \
                            (const float*)(Fp.ws + WS_MOD) + (size_t)(l * 5) * 6144 + 2 * 1024, 6144, SEQ, (float*)(Fp.ws + WS_RSSP)}; \
            pg8::gemm_phase<pg8::EpiResid<(l) == 1>, pg8::StaticOrder, PG8_ALIGN, PG8_SP2>(Fp.lds + RING_OFF, g, S, E); \
        } \
        SEAML(7); \
        PHASE(8, ph_ffn_router(Fp, l, nrows, ka->in[I_RW]);) \
        SEAML(8); \
        PHASE(9, ph_route(Fp, nrows);) \
        SEAML(9); \
        if (INL(10) || INL(11)) { REFRAME(); \
            LAS int* tab = (LAS int*)(Fp.lds + MOETAB_OFF); \
            const int ntiles = (int)__hip_atomic_load(Fp.ctl + CW_NTILES, __ATOMIC_RELAXED, __HIP_MEMORY_SCOPE_AGENT); \
            const int* TILEE = (const int*)(Fp.ws + WS_TILEE); \
            for (int i = Fp.tid; i < ntiles && i < SORT_TILES; i += NTHR) tab[i] = TILEE[i]; \
            __syncthreads(); \
            if (INL(10)) { _Pragma("unroll") for (int rep_ = 0; rep_ < NREP(10); ++rep_) { { \
                pg8::Gemm g{(const bf16*)(Fp.ws + WS_F), (const bf16*)(Fp.ws + WS_W1T) + (size_t)l * 32 * 2048 * 1024, 0, 2048, 1024}; \
                pg8::MoeOrderT<true> S; S.init(tab, ntiles, 8, Fp.G, (int)blockIdx.x); S.rowtok = (const int*)(Fp.ws + WS_ROWTOK); \
                pg8::EpiSwiglu E{(bf16*)(Fp.ws + WS_ACT), 1024, ka->in[I_MB1] + (size_t)l * 32 * 2048, 2048}; \
                pg8::gemm_phase<pg8::EpiSwiglu, pg8::MoeOrderT<true>, PG8_ALIGN, PG8_SP2>(Fp.lds + RING_OFF, g, S, E); \
             } if (rep_ + 1 < NREP(10)) GRID_BAR(); } } \
            SEAML(10); \
            if (INL(11)) { _Pragma("unroll") for (int rep_ = 0; rep_ < NREP(11); ++rep_) { { \
                pg8::Gemm g{(const bf16*)(Fp.ws + WS_ACT), (const bf16*)(Fp.ws + WS_W2T) + (size_t)l * 32 * 1024 * 1024, 0, 1024, 1024}; \
                pg8::MoeOrderT<false> S; S.init(tab, ntiles, 4, Fp.G, (int)blockIdx.x); S.rowtok = nullptr; \
                pg8::EpiBf16Bias E{(bf16*)(Fp.ws + WS_YS), 1024, ka->in[I_MB2] + (size_t)l * 32 * 1024, 1024}; \
                pg8::gemm_phase<pg8::EpiBf16Bias, pg8::MoeOrderT<false>, PG8_ALIGN, PG8_SP2>(Fp.lds + RING_OFF, g, S, E); \
             } if (rep_ + 1 < NREP(11)) GRID_BAR(); } } \
        } \
        SEAML(11); \
        if (INL(12)) { REFRAME(); ph_combine(Fp, l, nrows, ka->out, ka->in[I_GMIX]); } \
        if (l == 0) { SEAML(12); } \
    }
    LAYER_BODY(0)
    LAYER_BODY(1)
#undef LAYER_BODY
#undef PHASE
#undef IN
#undef SEAM
#undef INL
#undef SEAML
}

extern "C" void kernel_launch(void* const* d_in, const int* in_sizes, int n_in, void* d_out, int out_size, void* d_ws, size_t ws_size, hipStream_t stream) {
    static int grid = 0;
    if (grid == 0) {
        if (n_in != 34 || in_sizes[0] != NLAT * DMODEL || out_size != NLAT * DMODEL || ws_size < WS_END) {
            fprintf(stderr, "kernel_launch: unexpected shapes (n_in %d, in0 %d, out %d, ws %zu); nothing launched\n", n_in, n_in > 0 ? in_sizes[0] : -1, out_size, ws_size); grid = -1; return; }
        int dev = 0, cus = 0;
        if (hipGetDevice(&dev) != hipSuccess || hipDeviceGetAttribute(&cus, hipDeviceAttributeMultiprocessorCount, dev) != hipSuccess) { grid = -1; return; }
        if (hipFuncSetAttribute((const void*)mk_fwd, hipFuncAttributeMaxDynamicSharedMemorySize, LDS_BYTES) != hipSuccess) { fprintf(stderr, "kernel_launch: hipFuncSetAttribute failed\n"); grid = -1; return; }
        int per_cu = 0;
        if (hipOccupancyMaxActiveBlocksPerMultiprocessor(&per_cu, (const void*)mk_fwd, NTHR, LDS_BYTES) != hipSuccess || per_cu < 1) { fprintf(stderr, "kernel_launch: occupancy query says %d\n", per_cu); }
        (void)hipGetLastError();
        grid = cus;
    }
    if (grid < 0) return;
    if (hipMemsetAsync((char*)d_ws + WS_CTL, 0, CTL_ZERO_BYTES, stream) != hipSuccess) return;
    Args a{};
    for (int i = 0; i < 34; ++i) a.in[i] = (const float*)d_in[i];
    a.out = (float*)d_out; a.ws = (unsigned char*)d_ws;
#if MK_PER_PHASE
    for (int p = 0; p < NPH; ++p) { a.ph_lo = p; a.ph_hi = p + 1; hipLaunchKernelGGL(mk_fwd, dim3(grid), dim3(NTHR), LDS_BYTES, stream, a); }
#else
    a.ph_lo = 0; a.ph_hi = NPH;
    hipLaunchKernelGGL(mk_fwd, dim3(grid), dim3(NTHR), LDS_BYTES, stream, a);
#endif
}
```

```cpp
#include <hip/hip_runtime.h>
#include <hip/hip_bf16.h>
#include <cstdio>
#include <cstdint>
#include <cmath>
#ifndef MK_PER_PHASE
#define MK_PER_PHASE 0
#endif
namespace pg8 {
#define PG8_LAS __attribute__((address_space(3)))
typedef unsigned short bf16_t;
typedef short bf16x8 __attribute__((ext_vector_type(8)));
typedef float f32x4 __attribute__((ext_vector_type(4)));
typedef unsigned u32x4 __attribute__((ext_vector_type(4)));
constexpr int BM = 256, BK = 64, HALF = 128, HTB = HALF * BK * 2  , STAGE_BYTES = 8 * HTB, NXCD = 8, WGM = 8;

__host__ __device__ __forceinline__ int lds_byte(int r, int c) { const int st = (r >> 4) * 2 + (c >> 5), rr = r & 15, cc = c & 31, ob = rr * 64 + cc * 2; return st * 1024 + (ob ^ (((ob >> 9) & 1) << 5)); }
__host__ __device__ __forceinline__ void stage_rc(int b, int& R, int& C) { const int st = b / 1024, sb = b % 1024, swz = sb ^ (((sb >> 9) & 1) << 5); R = (st >> 1) * 16 + swz / 64; C = (st & 1) * 32 + (swz % 64) / 2; }
__host__ __device__ __forceinline__ int perm32(int rho) { const int n = rho >> 4, i = rho & 15; return 8 * (i >> 2) + 4 * n + (i & 3); }

struct Unit { int pm, pn, be, e; };
struct Gemm { const bf16_t* A; const bf16_t* Bt; int M, N, K; };

struct StaticOrder {
    static constexpr bool GATHER = false;
    __device__ __forceinline__ int row_of(int r) const { return r; }
    int nM, nN, nwg, G, c;
    __host__ __device__ void init(int M, int N, int G_, int c_) { nM = M / BM; nN = N / BM; nwg = nM * nN; G = G_; c = c_; }
    __host__ __device__ bool next(int i, Unit& u) const {
        const long L = (long)i * G + c; if (L >= nwg) return false;
        int wgid = (int)L; { const int q = nwg / NXCD, r = nwg % NXCD, xcd = wgid % NXCD, off = wgid / NXCD; wgid = (xcd < r ? xcd * (q + 1) : r * (q + 1) + (xcd - r) * q) + off; }
        const int nig = WGM * nN, gid = wgid / nig, fm = gid * WGM, gsz = (nM - fm) < WGM ? (nM - fm) : WGM;
        u.pm = fm + ((wgid % nig) % gsz); u.pn = (wgid % nig) / gsz; u.be = u.pn; u.e = 0; return true;
    }
    __device__ __forceinline__ void a_ready(const Unit&) const {}
    __device__ __forceinline__ void done(const Unit&) const {}
};

__device__ __forceinline__ unsigned cvt_pk_bf16(float lo, float hi) { unsigned r; asm volatile("v_cvt_pk_bf16_f32 %0, %1, %2" : "=v"(r) : "v"(lo), "v"(hi)); return r; }
typedef float f32x2 __attribute__((ext_vector_type(2)));
__device__ __forceinline__ f32x2 gelu_pk(f32x2 v) {
    const f32x2 av = __builtin_elementwise_abs(v), d = av * 0.2316418882f + 1.0f;
    f32x2 t; t.x = __builtin_amdgcn_rcpf(d.x); t.y = __builtin_amdgcn_rcpf(d.y);
    f32x2 q = t * 0.5307027145f + (-0.7265760135f); q = q * t + 0.7107068705f; q = q * t + (-0.142248368f); q = q * t + 0.127414796f; q = q * t;
    const f32x2 s = (v * v) * (-0.72134752044f);
    f32x2 e; e.x = __builtin_amdgcn_exp2f(s.x); e.y = __builtin_amdgcn_exp2f(s.y);
    const f32x2 m = v * (q * e), r = v - m;
    f32x2 o; o.x = v.x < 0.f ? m.x : r.x; o.y = v.y < 0.f ? m.y : r.y; return o;
}

template <int ACT  > struct EpiBf16 {
    static constexpr bool PERM = true, AFTER_DRAIN = false; static_assert(ACT == 0 || ACT == 1, "EpiBf16: ACT is 0 (none) or 1 (gelu_pk)");
    bf16_t* O; int ldc; const float* bias; int split_cols; size_t split_stride; float scale0;
    __device__ __forceinline__ void operator()(const f32x4 (&acc)[2][2][4][2], const Unit& u, int wr, int wc, int fr, int fq) const {
        const int row0 = u.pm * BM + wr * 64 + fr; int colt = u.pn * BM; bf16_t* base = O;
        float sc = 1.f; if (split_cols) { const int t = colt / split_cols; base += (size_t)t * split_stride; colt -= t * split_cols; if (t == 0) sc = scale0; }
        const int col0 = colt + wc * 32 + 8 * fq, bcol0 = u.pn * BM + wc * 32 + 8 * fq;
        f32x4 bv[2][2];
#pragma unroll
        for (int bj = 0; bj < 2; ++bj)
#pragma unroll
            for (int n = 0; n < 2; ++n) bv[bj][n] = bias ? *(const f32x4*)(bias + bcol0 + bj * HALF + 4 * n) : (f32x4){0.f, 0.f, 0.f, 0.f};
#pragma unroll
        for (int ai = 0; ai < 2; ++ai)
#pragma unroll
            for (int m = 0; m < 4; ++m) { bf16_t* rowp = base + (size_t)(row0 + ai * HALF + m * 16) * ldc + col0;
#pragma unroll
                for (int bj = 0; bj < 2; ++bj) { f32x4 v0 = acc[ai][bj][m][0] + bv[bj][0], v1 = acc[ai][bj][m][1] + bv[bj][1];
                    if (ACT == 1) { f32x2 a = gelu_pk((f32x2){v0[0], v0[1]}), b = gelu_pk((f32x2){v0[2], v0[3]}), c = gelu_pk((f32x2){v1[0], v1[1]}), d = gelu_pk((f32x2){v1[2], v1[3]});
                        v0 = (f32x4){a.x, a.y, b.x, b.y}; v1 = (f32x4){c.x, c.y, d.x, d.y}; }
                    v0 = v0 * sc; v1 = v1 * sc; u32x4 w; w.x = cvt_pk_bf16(v0[0], v0[1]); w.y = cvt_pk_bf16(v0[2], v0[3]); w.z = cvt_pk_bf16(v1[0], v1[1]); w.w = cvt_pk_bf16(v1[2], v1[3]);
                    *(u32x4*)(rowp + bj * HALF) = w; } }
    }
};


template <bool XIN_BF16> struct EpiResid {
    static constexpr bool PERM = false, AFTER_DRAIN = false;
    const float* xin_lat; const float* xin_ctx; int nlat; bf16_t* XR; int ldc; const float* mod; int mod_stride; int seq; float* rssp;
    __device__ __forceinline__ void operator()(const f32x4 (&acc)[2][2][4][2], const Unit& u, int wr, int wc, int fr, int fq) const {
        typedef unsigned u32x2 __attribute__((ext_vector_type(2)));
        const int row0 = u.pm * BM + wr * 64 + fr, col0 = u.pn * BM + wc * 32 + 4 * fq;
        const int rowt = u.pm * BM; const int bidx = rowt < nlat ? rowt / seq : 4;
        const float* gate = mod + (size_t)bidx * mod_stride;
        const float* xin = rowt < nlat ? xin_lat : (xin_ctx - (size_t)nlat * ldc);
        f32x4 gv[2][2];
#pragma unroll
        for (int bj = 0; bj < 2; ++bj)
#pragma unroll
            for (int n = 0; n < 2; ++n) gv[bj][n] = *(const f32x4*)(gate + col0 + bj * HALF + n * 16);
#pragma unroll
        for (int ai = 0; ai < 2; ++ai)
#pragma unroll
            for (int m = 0; m < 4; ++m) { const int row = row0 + ai * HALF + m * 16; const size_t ro = (size_t)row * ldc + col0; float s2 = 0.f;
#pragma unroll
                for (int bj = 0; bj < 2; ++bj)
#pragma unroll
                    for (int n = 0; n < 2; ++n) { const size_t idx = ro + bj * HALF + n * 16; f32x4 xv;
                        if (XIN_BF16) { const u32x2 w = *(const u32x2*)(XR + idx); xv = (f32x4){__builtin_bit_cast(float, w.x << 16), __builtin_bit_cast(float, w.x & 0xffff0000u), __builtin_bit_cast(float, w.y << 16), __builtin_bit_cast(float, w.y & 0xffff0000u)}; }
                        else xv = *(const f32x4*)(xin + idx);
                        const f32x4 v = xv + gv[bj][n] * acc[ai][bj][m][n];
                        s2 += (v[0] * v[0] + v[1] * v[1]) + (v[2] * v[2] + v[3] * v[3]);
                        u32x2 o; o.x = cvt_pk_bf16(v[0], v[1]); o.y = cvt_pk_bf16(v[2], v[3]); *(u32x2*)(XR + idx) = o; }
                s2 += __shfl_xor(s2, 16); s2 += __shfl_xor(s2, 32);
                if (fq == 0) rssp[(size_t)row * 16 + u.pn * 4 + wc] = s2; }
    }
};
struct EpiSwiglu {
    static constexpr bool PERM = true, AFTER_DRAIN = false;
    bf16_t* O; int ldc; const float* bias; int bias_stride;
    __device__ __forceinline__ void operator()(const f32x4 (&acc)[2][2][4][2], const Unit& u, int wr, int wc, int fr, int fq) const {
        const int row0 = u.pm * BM + wr * 64 + fr; const int bcol0 = u.pn * BM + wc * 32 + 8 * fq; const int ocol0 = bcol0 >> 1;
        const float* bb = bias + (size_t)u.e * bias_stride;
        f32x4 bv[2][2];
#pragma unroll
        for (int bj = 0; bj < 2; ++bj)
#pragma unroll
            for (int n = 0; n < 2; ++n) bv[bj][n] = *(const f32x4*)(bb + bcol0 + bj * HALF + 4 * n);
#pragma unroll
        for (int ai = 0; ai < 2; ++ai)
#pragma unroll
            for (int m = 0; m < 4; ++m) { bf16_t* rowp = O + (size_t)(row0 + ai * HALF + m * 16) * ldc + ocol0;
#pragma unroll
                for (int bj = 0; bj < 2; ++bj) { const f32x4 v0 = acc[ai][bj][m][0] + bv[bj][0], v1 = acc[ai][bj][m][1] + bv[bj][1];
                    float o[4];
#pragma unroll
                    for (int p = 0; p < 4; ++p) { const float hg = p < 2 ? v0[2 * p] : v1[2 * p - 4], hl = p < 2 ? v0[2 * p + 1] : v1[2 * p - 3];
                        const float glu = fminf(hg, 7.0f), lin = fminf(fmaxf(hl, -7.0f), 7.0f);
                        const float sg = __builtin_amdgcn_rcpf(1.0f + __builtin_amdgcn_exp2f(-1.702f * 1.4426950408889634f * glu));
                        o[p] = glu * sg * (lin + 1.0f); }
                    typedef unsigned u32x2 __attribute__((ext_vector_type(2)));
                    u32x2 w; w.x = cvt_pk_bf16(o[0], o[1]); w.y = cvt_pk_bf16(o[2], o[3]);
                    *(u32x2*)(rowp + bj * (HALF / 2)) = w; } }
    }
};
struct EpiBf16Bias {
    static constexpr bool PERM = true, AFTER_DRAIN = false;
    bf16_t* O; int ldc; const float* bias; int bias_stride;
    __device__ __forceinline__ void operator()(const f32x4 (&acc)[2][2][4][2], const Unit& u, int wr, int wc, int fr, int fq) const {
        const int row0 = u.pm * BM + wr * 64 + fr; const int col0 = u.pn * BM + wc * 32 + 8 * fq;
        const float* bb = bias + (size_t)u.e * bias_stride;
        f32x4 bv[2][2];
#pragma unroll
        for (int bj = 0; bj < 2; ++bj)
#pragma unroll
            for (int n = 0; n < 2; ++n) bv[bj][n] = *(const f32x4*)(bb + col0 + bj * HALF + 4 * n);
#pragma unroll
        for (int ai = 0; ai < 2; ++ai)
#pragma unroll
            for (int m = 0; m < 4; ++m) { bf16_t* rowp = O + (size_t)(row0 + ai * HALF + m * 16) * ldc + col0;
#pragma unroll
                for (int bj = 0; bj < 2; ++bj) { const f32x4 v0 = acc[ai][bj][m][0] + bv[bj][0], v1 = acc[ai][bj][m][1] + bv[bj][1];
                    u32x4 w; w.x = cvt_pk_bf16(v0[0], v0[1]); w.y = cvt_pk_bf16(v0[2], v0[3]); w.z = cvt_pk_bf16(v1[0], v1[1]); w.w = cvt_pk_bf16(v1[2], v1[3]);
                    *(u32x4*)(rowp + bj * HALF) = w; } }
    }
};
struct EpiLruGate {
    static constexpr bool PERM = false, AFTER_DRAIN = false;
    const bf16_t* XL; bf16_t* LAB; size_t lab_stride; const float* gb; const float* spt;
    __device__ __forceinline__ void operator()(const f32x4 (&acc)[2][2][4][2], const Unit& u, int wr, int wc, int fr, int fq) const {
        const int d = u.pn >> 1, half = u.pn & 1;
        const int row0 = u.pm * BM + wr * 64 + fr, ch0 = half * 128 + wc * 32 + 4 * fq;
        bf16_t* LA = LAB + (size_t)(2 * d) * lab_stride; bf16_t* LB = LAB + (size_t)(2 * d + 1) * lab_stride;
#pragma unroll
        for (int n = 0; n < 2; ++n) {
            const f32x4 bR = *(const f32x4*)(gb + (d * 2 + 0) * 256 + ch0 + 16 * n), bI = *(const f32x4*)(gb + (d * 2 + 1) * 256 + ch0 + 16 * n);
            const f32x4 sp = *(const f32x4*)(spt + d * 256 + ch0 + 16 * n) * (-8.0f * 1.4426950408889634f);
#pragma unroll
            for (int ai = 0; ai < 2; ++ai)
#pragma unroll
                for (int m = 0; m < 4; ++m) { const size_t ro = (size_t)(row0 + ai * HALF + m * 16) * 256 + ch0 + 16 * n;
                    typedef unsigned u32x2 __attribute__((ext_vector_type(2)));
                    const u32x2 xw = *(const u32x2*)(XL + ro);
                    const float xl[4] = {__builtin_bit_cast(float, xw.x << 16), __builtin_bit_cast(float, xw.x & 0xffff0000u), __builtin_bit_cast(float, xw.y << 16), __builtin_bit_cast(float, xw.y & 0xffff0000u)};
                    const f32x4 gr = acc[ai][0][m][n] + bR, gi = acc[ai][1][m][n] + bI;
                    f32x4 av, bv;
#pragma unroll
                    for (int e = 0; e < 4; ++e) {
                        const float rg = __builtin_amdgcn_rcpf(1.0f + __builtin_amdgcn_exp2f(-1.4426950408889634f * gr[e])), ig = __builtin_amdgcn_rcpf(1.0f + __builtin_amdgcn_exp2f(-1.4426950408889634f * gi[e]));
                        const float la2 = rg * sp[e];
                        const float a2 = __builtin_amdgcn_exp2f(2.0f * la2);
                        av[e] = la2; bv[e] = __builtin_amdgcn_sqrtf(fmaxf(1.0f - a2, 0.f)) * (ig * xl[e]); }
                    u32x2 wa, wb; wa.x = cvt_pk_bf16(av[0], av[1]); wa.y = cvt_pk_bf16(av[2], av[3]); wb.x = cvt_pk_bf16(bv[0], bv[1]); wb.y = cvt_pk_bf16(bv[2], bv[3]);
                    *(u32x2*)(LA + ro) = wa; *(u32x2*)(LB + ro) = wb; }
        }
    }
};
template <bool GATHER_> struct MoeOrderT {
    static constexpr bool GATHER = GATHER_;
    const int* rowtok;
    __device__ __forceinline__ int row_of(int r) const { return GATHER_ ? rowtok[r] : r; }
    const PG8_LAS int* tab; int ntiles, nN, nper, j, m_lo, nMx, wgm;
    __device__ __forceinline__ void init(const PG8_LAS int* tab_, int ntiles_, int nN_, int G, int bx, int wgm_) {
        tab = tab_; ntiles = ntiles_; nN = nN_; wgm = wgm_;
        if (G % 8 == 0) { const int x = bx % 8; nper = G / 8; j = bx / 8; m_lo = (x * ntiles) / 8; nMx = ((x + 1) * ntiles) / 8 - m_lo; }
        else { nper = G; j = bx; m_lo = 0; nMx = ntiles; }
    }
    __device__ __forceinline__ bool next(int i, Unit& u) const {
        const int s = i * nper + j; if (s >= nMx * nN) return false;
        const int nig = wgm * nN, gid = s / nig, fm = gid * wgm, gsz = (nMx - fm) < wgm ? (nMx - fm) : wgm, w = s - gid * nig;
        u.pm = m_lo + fm + (w % gsz); u.pn = w / gsz; u.e = tab[u.pm]; u.be = u.e * nN + u.pn; return true;
    }
    __device__ __forceinline__ void a_ready(const Unit&) const {}
    __device__ __forceinline__ void done(const Unit&) const {}
};
template <class Epi, class Sched, bool ALIGN_EPI = false, bool SP2 = false>
__device__ __forceinline__ void gemm_phase(PG8_LAS unsigned char* lds, const Gemm g, const Sched& S, const Epi& E) {
    int tid_ = threadIdx.x; asm volatile("" : "+v"(tid_));
    const int tid = tid_, wid = __builtin_amdgcn_readfirstlane(tid >> 6), lane = tid & 63, wr = wid >> 2, wc = wid & 3, fr = lane & 15, fq = lane >> 4;
    const int K = g.K, nt = K / BK;
    unsigned voffA[2], voffB[2];
#pragma unroll
    for (int i = 0; i < 2; ++i) { int R, C; stage_rc(tid * 16 + i * 8192, R, C); const int Rb = Epi::PERM ? ((R & ~31) + perm32(R & 31)) : R;
        voffA[i] = (unsigned)(R * K + C) * 2u; voffB[i] = (unsigned)(Rb * K + C) * 2u; }
    unsigned gA_[2][2] = {{0u, 0u}, {0u, 0u}}, gN_[2][2] = {{0u, 0u}, {0u, 0u}};
    static_assert(!Sched::GATHER || SP2, "the gathered A operand is wired into the SP2 loop only");
#define PG8_GLOAD(dst, pm_) do { _Pragma("unroll") for (int h_ = 0; h_ < 2; ++h_) _Pragma("unroll") for (int i_ = 0; i_ < 2; ++i_) { int R_, C_; stage_rc(tid * 16 + i_ * 8192, R_, C_); \
        dst[h_][i_] = (unsigned)S.row_of((pm_) * BM + h_ * HALF + R_) * (unsigned)(K * 2) + (unsigned)(C_ * 2); } } while (0)
    const size_t kstep = (size_t)(BK * 2);
    const size_t hstep = (size_t)HALF * K * 2;
    const size_t tstep = 2 * hstep;
    const unsigned ldsw = (unsigned)wid * 1024u;
    const int aoff = lds_byte(wr * 64 + fr, fq * 8), boff = lds_byte(wc * 32 + fr, fq * 8);
#define PG8_SA(b, h) (((b) * 2 + (h)) * HTB)
#define PG8_SB(b, h) ((4 + (b) * 2 + (h)) * HTB)
#define PG8_STAGE(bufoff, gbase, voff) do { _Pragma("unroll") for (int _i = 0; _i < 2; ++_i) \
        __builtin_amdgcn_global_load_lds((const unsigned*)((const char*)(gbase) + (voff)[_i]), (PG8_LAS unsigned*)(lds + (bufoff) + ldsw + _i * 8192), 16, 0, 0); } while (0)
#define PG8_STA(bufoff, ptr, h, useN) do { if constexpr (Sched::GATHER) { unsigned o_[2] = {(useN) ? gN_[h][0] : gA_[h][0], (useN) ? gN_[h][1] : gA_[h][1]}; PG8_STAGE(bufoff, ptr, o_); } \
        else { PG8_STAGE(bufoff, (ptr) + ((h) ? hstep : 0), voffA); } } while (0)
#define PG8_LDA(dst, b, h) do { _Pragma("unroll") for (int m = 0; m < 4; ++m) _Pragma("unroll") for (int k = 0; k < 2; ++k) dst[m][k] = *(const PG8_LAS bf16x8*)(lds + PG8_SA(b, h) + aoff + m * 2048 + k * 1024); } while (0)
#define PG8_LDB(dst, b, h) do { _Pragma("unroll") for (int n = 0; n < 2; ++n) _Pragma("unroll") for (int k = 0; k < 2; ++k) dst[n][k] = *(const PG8_LAS bf16x8*)(lds + PG8_SB(b, h) + boff + n * 2048 + k * 1024); } while (0)
#define PG8_MMA(ai, bj, At, Bt) do { __builtin_amdgcn_s_setprio(1); _Pragma("unroll") for (int m = 0; m < 4; ++m) _Pragma("unroll") for (int n = 0; n < 2; ++n) _Pragma("unroll") for (int k = 0; k < 2; ++k) \
        acc[ai][bj][m][n] = __builtin_amdgcn_mfma_f32_16x16x32_bf16(Bt[n][k], At[m][k], acc[ai][bj][m][n], 0, 0, 0); __builtin_amdgcn_s_setprio(0); } while (0)
#define PG8_WAIT_V(n) asm volatile("s_waitcnt vmcnt(" #n ")" ::: "memory")
#define PG8_WAIT_L(n) asm volatile("s_waitcnt lgkmcnt(" #n ")" ::: "memory")
#define PG8_BAR __builtin_amdgcn_s_barrier()
#define PG8_SCHED __builtin_amdgcn_sched_barrier(0)
    Unit cur, nxt; int ui = 0;
    if (!S.next(0, cur)) return;
    f32x4 acc[2][2][4][2];
#pragma unroll
    for (int a = 0; a < 2; ++a)
#pragma unroll
        for (int b = 0; b < 2; ++b)
#pragma unroll
            for (int m = 0; m < 4; ++m)
#pragma unroll
                for (int n = 0; n < 2; ++n) acc[a][b][m][n] = (f32x4){0.f, 0.f, 0.f, 0.f};
    bf16x8 At[4][2], B0[2][2], B1[2][2];
    const char* cA = (const char*)g.A + (Sched::GATHER ? (size_t)0 : (size_t)cur.pm * tstep); if constexpr (Sched::GATHER) PG8_GLOAD(gA_, cur.pm);
    const char* cB = (const char*)g.Bt + (size_t)cur.be * tstep;
    S.a_ready(cur);
    if constexpr (SP2) {
        PG8_STAGE(PG8_SB(0, 0), cB, voffB); PG8_STAGE(PG8_SB(0, 1), cB + hstep, voffB); PG8_STA(PG8_SA(0, 0), cA, 0, false); PG8_STA(PG8_SA(0, 1), cA, 1, false);
        if (wr == 1) PG8_BAR;
        PG8_WAIT_V(2); PG8_BAR;
        PG8_STAGE(PG8_SB(1, 0), cB + kstep, voffB); PG8_STA(PG8_SA(1, 0), cA + kstep, 0, false); PG8_STAGE(PG8_SB(1, 1), cB + hstep + kstep, voffB);
        PG8_WAIT_V(6); PG8_BAR;
    } else {
        PG8_STAGE(PG8_SB(0, 0), cB, voffB); PG8_STAGE(PG8_SA(0, 0), cA, voffA); PG8_STAGE(PG8_SB(0, 1), cB + hstep, voffB); PG8_STAGE(PG8_SA(0, 1), cA + hstep, voffA);
        if (wr == 1) PG8_BAR;
        PG8_WAIT_V(4); PG8_BAR;
        PG8_STAGE(PG8_SB(1, 0), cB + kstep, voffB); PG8_STAGE(PG8_SA(1, 0), cA + kstep, voffA); PG8_STAGE(PG8_SB(1, 1), cB + hstep + kstep, voffB);
        PG8_WAIT_V(6); PG8_BAR;
    }
    for (;;) {
        const bool has_next = S.next(ui + 1, nxt);
        const char* nA = (has_next && !Sched::GATHER) ? (const char*)g.A + (size_t)nxt.pm * tstep : cA; const char* nB = has_next ? (const char*)g.Bt + (size_t)nxt.be * tstep : cB;
        for (int t = 0; t < nt; t += 2) {
            const bool last = (t == nt - 2);
            const char* a1 = cA + (size_t)(t + 1) * kstep;
            const char* a2 = last ? nA : cA + (size_t)(t + 2) * kstep; const char* b2 = last ? nB : cB + (size_t)(t + 2) * kstep;
            const char* a3 = a2 + kstep; const char* b3 = b2 + kstep;
            if (last && has_next) S.a_ready(nxt);
            if constexpr (Sched::GATHER) { if (last) { if (has_next) PG8_GLOAD(gN_, nxt.pm); else { gN_[0][0] = gA_[0][0]; gN_[0][1] = gA_[0][1]; gN_[1][0] = gA_[1][0]; gN_[1][1] = gA_[1][1]; } } }
            if constexpr (SP2) {
            PG8_LDB(B0, 0, 0); PG8_LDB(B1, 0, 1); PG8_SCHED; PG8_LDA(At, 0, 0); PG8_STA(PG8_SA(1, 1), a1, 1, false);
            PG8_WAIT_V(8); PG8_WAIT_L(0); PG8_BAR; PG8_MMA(0, 0, At, B0); PG8_MMA(0, 1, At, B1); PG8_BAR; PG8_SCHED;
            PG8_LDA(At, 0, 1); PG8_STAGE(PG8_SB(0, 0), b2, voffB); PG8_STAGE(PG8_SB(0, 1), b2 + hstep, voffB); PG8_STA(PG8_SA(0, 0), a2, 0, last);
            PG8_WAIT_V(8); PG8_WAIT_L(0); PG8_BAR; PG8_MMA(1, 0, At, B0); PG8_MMA(1, 1, At, B1); PG8_BAR; PG8_SCHED;
            PG8_LDB(B0, 1, 0); PG8_LDB(B1, 1, 1); PG8_SCHED; PG8_LDA(At, 1, 0); PG8_STA(PG8_SA(0, 1), a2, 1, last);
            PG8_WAIT_V(8); PG8_WAIT_L(0); PG8_BAR; PG8_MMA(0, 0, At, B0); PG8_MMA(0, 1, At, B1); PG8_BAR; PG8_SCHED;
            PG8_LDA(At, 1, 1); PG8_STAGE(PG8_SB(1, 0), b3, voffB); PG8_STAGE(PG8_SB(1, 1), b3 + hstep, voffB); PG8_STA(PG8_SA(1, 0), a3, 0, last);
            PG8_WAIT_V(8); PG8_WAIT_L(0); PG8_BAR; PG8_MMA(1, 0, At, B0); PG8_MMA(1, 1, At, B1); PG8_BAR; PG8_SCHED;
            } else {
            PG8_LDB(B0, 0, 0); PG8_SCHED; PG8_LDA(At, 0, 0); PG8_STAGE(PG8_SA(1, 1), a1 + hstep, voffA);
            PG8_WAIT_L(8); PG8_BAR; PG8_WAIT_L(0); PG8_MMA(0, 0, At, B0); PG8_BAR; PG8_SCHED;
            PG8_LDB(B1, 0, 1); PG8_STAGE(PG8_SB(0, 0), b2, voffB);
            PG8_BAR; PG8_WAIT_L(0); PG8_MMA(0, 1, At, B1); PG8_BAR;
            PG8_LDA(At, 0, 1); PG8_STAGE(PG8_SA(0, 0), a2, voffA);
            PG8_BAR; PG8_WAIT_L(0); PG8_MMA(1, 0, At, B0); PG8_BAR; PG8_SCHED;
            PG8_STAGE(PG8_SB(0, 1), b2 + hstep, voffB);
            PG8_WAIT_V(6); PG8_BAR; PG8_MMA(1, 1, At, B1); PG8_BAR;
            PG8_LDB(B0, 1, 0); PG8_SCHED; PG8_LDA(At, 1, 0); PG8_STAGE(PG8_SA(0, 1), a2 + hstep, voffA);
            PG8_WAIT_L(8); PG8_BAR; PG8_WAIT_L(0); PG8_MMA(0, 0, At, B0); PG8_BAR; PG8_SCHED;
            PG8_LDB(B1, 1, 1); PG8_STAGE(PG8_SB(1, 0), b3, voffB);
            PG8_BAR; PG8_WAIT_L(0); PG8_MMA(0, 1, At, B1); PG8_BAR;
            PG8_LDA(At, 1, 1); PG8_STAGE(PG8_SA(1, 0), a3, voffA);
            PG8_BAR; PG8_WAIT_L(0); PG8_MMA(1, 0, At, B0); PG8_BAR; PG8_SCHED;
            PG8_STAGE(PG8_SB(1, 1), b3 + hstep, voffB);
            PG8_WAIT_V(6); PG8_BAR; PG8_MMA(1, 1, At, B1); PG8_BAR;
            }
        }
        if constexpr (ALIGN_EPI) { if (wr == 0) PG8_BAR; }
        if constexpr (!Epi::AFTER_DRAIN) { E(acc, cur, wr, wc, fr, fq); S.done(cur); }
        if (!has_next) break;
#pragma unroll
        for (int a = 0; a < 2; ++a)
#pragma unroll
            for (int b = 0; b < 2; ++b)
#pragma unroll
                for (int m = 0; m < 4; ++m)
#pragma unroll
                    for (int n = 0; n < 2; ++n) acc[a][b][m][n] = (f32x4){0.f, 0.f, 0.f, 0.f};
        cur = nxt; cA = nA; cB = nB; ++ui;
        if constexpr (Sched::GATHER) { gA_[0][0] = gN_[0][0]; gA_[0][1] = gN_[0][1]; gA_[1][0] = gN_[1][0]; gA_[1][1] = gN_[1][1]; }
        if constexpr (ALIGN_EPI) { if (wr == 1) PG8_BAR; }
    }
    PG8_WAIT_V(0);
    if constexpr (!ALIGN_EPI) { if (wr == 0) PG8_BAR; }
    PG8_BAR;
    if constexpr (Epi::AFTER_DRAIN) { E.fused(acc, cur, wr, wc, fr, fq, lds, wid, lane); S.done(cur); }
#undef PG8_SA
#undef PG8_SB
#undef PG8_STAGE
#undef PG8_STA
#undef PG8_GLOAD
#undef PG8_LDA
#undef PG8_LDB
#undef PG8_MMA
#undef PG8_WAIT_V
#undef PG8_WAIT_L
#undef PG8_BAR
#undef PG8_SCHED
}
}

#ifndef PG8_SP2
#define PG8_SP2 true
#endif
#ifndef PG8_ALIGN
#define PG8_ALIGN true
#endif
#include <cmath>
namespace attn_body {
using bf16=__hip_bfloat16;
using bf16x8=__attribute__((ext_vector_type(8)))short;
using s16x4=__attribute__((ext_vector_type(4)))short;
using f32x16=__attribute__((ext_vector_type(16)))float;
using u32x4=__attribute__((ext_vector_type(4)))unsigned;
constexpr int NHEAD=8,SEQQ=8192,SEQK=8448,D=64,QP=512,KP=128;
constexpr int NW=8,QBLK=32,QB=QBLK*NW,KVBLK=64,NQB=SEQQ/QB;
constexpr int ATTN_UNIT_ROWS=QB;
__device__ __forceinline__ int crow(int r,int hi){return (r&3)+8*(r>>2)+4*hi;}
#define SBAR() __builtin_amdgcn_sched_barrier(0)
__device__ __forceinline__ void cmask(f32x16&p0,f32x16&p1,int jb,int qrel,int hi){
  const float NEG=-INFINITY; int kb=64*jb+4*hi;
  #pragma unroll
  for(int r=0;r<16;++r){int kv=kb+(r&3)+8*(r>>2); if(kv>qrel)p0[r]=NEG; if(kv+32>qrel)p1[r]=NEG;}
}

constexpr int NSLOT=3, SLOTB=8192;
constexpr int LDS_K=0, LDS_V=NSLOT*SLOTB, LDS_WS=2*NSLOT*SLOTB, LDS_OST=LDS_WS+NW*64*4, LDS_BYTES=LDS_OST+NW*4096;
constexpr float C2=0.125f*1.4426950408889634f;
__device__ __forceinline__ void glds16(const void*gsrc,unsigned lds_dst){unsigned keep;
  asm volatile("s_mov_b32 %0, m0\n\ts_mov_b32 m0, %2\n\ts_nop 0\n\tglobal_load_lds_dwordx4 %1, off\n\ts_mov_b32 m0, %0":"=&s"(keep):"v"(gsrc),"s"(lds_dst):"memory");}
__device__ __forceinline__ float max3f(float a,float b,float c){float r;asm("v_max3_f32 %0, %1, %2, %3":"=v"(r):"v"(a),"v"(b),"v"(c));return r;}
__device__ __forceinline__ float max2f(float a,float b){float r;asm("v_max_f32_e32 %0, %1, %2":"=v"(r):"v"(a),"v"(b));return r;}
__device__ __forceinline__ float fadd_s(float a,float b){float r;asm("v_add_f32_e32 %0, %1, %2":"=v"(r):"v"(a),"v"(b));return r;}
__device__ __forceinline__ float fsub_s(float a,float b){float r;asm("v_sub_f32_e32 %0, %1, %2":"=v"(r):"v"(a),"v"(b));return r;}
typedef float f32x2_t __attribute__((ext_vector_type(2))); typedef __bf16 bf16x2_t __attribute__((ext_vector_type(2)));
__device__ __forceinline__ unsigned cvtpk_s(float lo,float hi){f32x2_t v={lo,hi};bf16x2_t b=__builtin_convertvector(v,bf16x2_t);return __builtin_bit_cast(unsigned,b);}
#define WAIT_BAR(N) asm volatile("s_waitcnt vmcnt(" #N ") lgkmcnt(0)\n\ts_barrier":::"memory")

__device__ __forceinline__ void qkt(f32x16&p0,f32x16&p1,const char*Kslot,const bf16x8*qr,const f32x16&negm,int r32,int hi){
  const char*kb=Kslot+hi*1024+r32*16;
  #pragma unroll
  for(int d0=0;d0<4;++d0){
    const bf16x8 b0=*reinterpret_cast<const bf16x8*>(kb+d0*2048);
    const bf16x8 b1=*reinterpret_cast<const bf16x8*>(kb+d0*2048+512);
    if(d0==0){p0=__builtin_amdgcn_mfma_f32_32x32x16_bf16(b0,qr[0],negm,0,0,0);p1=__builtin_amdgcn_mfma_f32_32x32x16_bf16(b1,qr[0],negm,0,0,0);}
    else{p0=__builtin_amdgcn_mfma_f32_32x32x16_bf16(b0,qr[d0],p0,0,0,0);p1=__builtin_amdgcn_mfma_f32_32x32x16_bf16(b1,qr[d0],p1,0,0,0);}}
}
typedef __attribute__((address_space(3))) const char* lds_cptr;
typedef short v4i16_t __attribute__((ext_vector_type(4)));
__device__ __forceinline__ void kload8(bf16x8*kf,lds_cptr kp){
  kf[0]=*(const __attribute__((address_space(3))) bf16x8*)(kp);      kf[1]=*(const __attribute__((address_space(3))) bf16x8*)(kp+512);
  kf[2]=*(const __attribute__((address_space(3))) bf16x8*)(kp+2048); kf[3]=*(const __attribute__((address_space(3))) bf16x8*)(kp+2560);
  kf[4]=*(const __attribute__((address_space(3))) bf16x8*)(kp+4096); kf[5]=*(const __attribute__((address_space(3))) bf16x8*)(kp+4608);
  kf[6]=*(const __attribute__((address_space(3))) bf16x8*)(kp+6144); kf[7]=*(const __attribute__((address_space(3))) bf16x8*)(kp+6656);
}
__device__ __forceinline__ void kload2(bf16x8*kf,lds_cptr kp,int j){ kf[2*j]=*(const __attribute__((address_space(3))) bf16x8*)(kp+j*2048); kf[2*j+1]=*(const __attribute__((address_space(3))) bf16x8*)(kp+j*2048+512); }
__device__ __forceinline__ s16x4 vtr(lds_cptr p){ return __builtin_bit_cast(s16x4,__builtin_amdgcn_ds_read_tr16_b64_v4i16((__attribute__((address_space(3))) v4i16_t*)p)); }
__device__ __forceinline__ float rowmax(const f32x16&p0,const f32x16&p1){
  float a=max3f(p0[0],p0[1],p1[0]),b=max3f(p0[2],p0[3],p1[1]);a=max3f(a,p1[2],p1[3]);
  #pragma unroll
  for(int r=4;r<16;r+=4){a=max3f(a,p0[r],p0[r+1]);b=max3f(b,p0[r+2],p0[r+3]);a=max3f(a,p1[r],p1[r+1]);b=max3f(b,p1[r+2],p1[r+3]);}
  const float m=max2f(a,b);
  auto rr=__builtin_amdgcn_permlane32_swap(__float_as_uint(m),__float_as_uint(m),false,false);
  return max2f(__uint_as_float(rr[0]),__uint_as_float(rr[1]));
}
__device__ __forceinline__ void pv(f32x16*o,int vb,bf16x8 pa0,bf16x8 pa1,bf16x8 pa2,bf16x8 pa3){
  #pragma unroll
  for(int d0=0;d0<2;++d0){s16x4 lo[4],hi[4];
    #pragma unroll
    for(int ks=0;ks<4;++ks){
      asm volatile("ds_read_b64_tr_b16 %0,%1 offset:%c2":"=&v"(lo[ks]):"v"(vb),"i"(d0*4096+ks*1024):"memory");
      asm volatile("ds_read_b64_tr_b16 %0,%1 offset:%c2":"=&v"(hi[ks]):"v"(vb),"i"(d0*4096+ks*1024+512):"memory");}
    asm volatile("s_waitcnt lgkmcnt(0)":::"memory");SBAR();
    #define PK(k) (bf16x8){lo[k][0],lo[k][1],lo[k][2],lo[k][3],hi[k][0],hi[k][1],hi[k][2],hi[k][3]}
    o[d0]=__builtin_amdgcn_mfma_f32_32x32x16_bf16(pa0,PK(0),o[d0],0,0,0);
    o[d0]=__builtin_amdgcn_mfma_f32_32x32x16_bf16(pa1,PK(1),o[d0],0,0,0);
    o[d0]=__builtin_amdgcn_mfma_f32_32x32x16_bf16(pa2,PK(2),o[d0],0,0,0);
    o[d0]=__builtin_amdgcn_mfma_f32_32x32x16_bf16(pa3,PK(3),o[d0],0,0,0);
    #undef PK
  }
}

#ifndef ATTN_STORE16
#define ATTN_STORE16(p,v) (*(u32x4*)(p)=(v))
#endif
template<int THRL> __device__ __forceinline__ void attn_unit(int b,int h,long qrow0,int NTarg,const bf16*Q,const bf16*__restrict__ K,const bf16*__restrict__ V,bf16*O,char*shm){
  int tid_=threadIdx.x; asm volatile("":"+v"(tid_)); const int tid=tid_,lane=tid&63,r32=lane&31,hi=lane>>5; const int wid=__builtin_amdgcn_readfirstlane(tid>>6);
  const long krowbase=(long)b*SEQK; const int kvh=h>>2;
  const bf16*Qw=Q+(qrow0+wid*QBLK)*QP+h*D;
  const bf16*Kh=K+krowbase*KP+kvh*D,*Vh=V+krowbase*KP+kvh*D;
  const unsigned lds0=(unsigned)(uintptr_t)shm;
  float*wsf=(float*)(shm+LDS_WS)+wid*64;
  const bf16*ksrc=Kh+(long)lane*KP+wid*8;
  const bf16*vsrc=Vh+(long)(16*(wid&3)+(lane>>2))*KP+(wid>>2)*32+(lane&3)*8;
  const unsigned kdst=lds0+LDS_K+wid*1024, vdst=lds0+LDS_V+wid*1024;
  #define DMA_K(t,slot) glds16(ksrc+(long)(t)*KVBLK*KP,(unsigned)__builtin_amdgcn_readfirstlane(kdst+(slot)))
  #define DMA_V(t,slot) glds16(vsrc+(long)(t)*KVBLK*KP,(unsigned)__builtin_amdgcn_readfirstlane(vdst+(slot)))
  const int vb0=(int)(lds0+LDS_V)+((lane>>4)&1)*32+(lane&3)*8+(4*hi+((lane&15)>>2))*64;
  const char*Kbase=shm+LDS_K; bf16x8 kf[8];
  const lds_cptr shm3=(lds_cptr)shm; const lds_cptr kp0=shm3+LDS_K+hi*1024+r32*16; const lds_cptr vp0=shm3+LDS_V+((lane>>4)&1)*32+(lane&3)*8+(4*hi+((lane&15)>>2))*64;
  const int NT=NTarg;
  DMA_K(0,0);DMA_V(0,0);DMA_K(1,SLOTB);
  bf16x8 qr[4];
  #pragma unroll
  for(int d0=0;d0<4;++d0)qr[d0]=*reinterpret_cast<const bf16x8*>(&Qw[(long)r32*QP+d0*16+hi*8]);
  float mhat=0.f,l_reg=0.f;f32x16 o[2];o[0]=f32x16{};o[1]=f32x16{};f32x16 negm=f32x16{};asm volatile("":"+v"(negm));
  const int qrel=wid*QBLK+r32;
  #define CMASK(P0,P1,t) do{}while(0)
  bool resc=false;
  #define START(P0,P1) do{ const float rm=rowmax(P0,P1); resc=false; \
    { const float dl=rm; mhat=fadd_s(mhat,dl); \
      _Pragma("unroll") for(int r=0;r<16;++r){P0[r]=fsub_s(P0[r],dl);P1[r]=fsub_s(P1[r],dl);} \
      _Pragma("unroll") for(int r=0;r<16;++r)negm[r]=-mhat; asm volatile("":"+v"(negm)); } \
    _Pragma("unroll") for(int r=0;r<16;++r)P0[r]=__builtin_amdgcn_exp2f(P0[r]); }while(0)
  #define RESC() do{ if(resc){ asm volatile("s_waitcnt lgkmcnt(0)":::"memory"); \
      _Pragma("unroll") for(int d_=0;d_<2;++d_) _Pragma("unroll") for(int r=0;r<16;++r)o[d_][r]*=wsf[crow(r,hi)]; } }while(0)
  f32x16 pA0,pA1,pB0,pB1;
  int sl_prev=0,sl_cur=0,sl_next=SLOTB;
  #define ROT() do{sl_prev=sl_cur;sl_cur=sl_next;sl_next=(sl_next==(NSLOT-1)*SLOTB)?0:sl_next+SLOTB;}while(0)
  DMA_K(2,2*SLOTB);
  WAIT_BAR(3);
  qkt(pA0,pA1,Kbase,qr,negm,r32,hi);asm volatile("s_nop 15\n\ts_nop 7":"+v"(pA0),"+v"(pA1));CMASK(pA0,pA1,0);
  START(pA0,pA1);
  _Pragma("unroll") for(int r=0;r<16;++r)pA1[r]=__builtin_amdgcn_exp2f(pA1[r]);
  WAIT_BAR(0);
  DMA_K(3,0);DMA_V(1,SLOTB);
  ROT();
  kload8(kf,kp0+sl_cur);
  WAIT_BAR(2);
  s16x4 vlo[8],vhi[8]; u32x4 pw0,pw1,pw2,pw3;
  #define PKW(P,B) cvtpk_s(P[B],P[B+1])
  #define PAF(k) __builtin_bit_cast(bf16x8,pw##k)
  #define VFR(i) (bf16x8){vlo[i][0],vlo[i][1],vlo[i][2],vlo[i][3],vhi[i][0],vhi[i][1],vhi[i][2],vhi[i][3]}
  #define PIN(x) asm volatile("":"+v"(x))
  #define MX3(a,b,c) __builtin_fmaxf(__builtin_fmaxf((a),(b)),(c))
  #define GAPA(MF,A0,A1,A2,A3,W0,W1,PW) do{ MF; sacc+=A0; sacc+=A1; sacc+=A2; sacc+=A3; PIN(sacc); W0; W1; PIN(PW); SBAR(); }while(0)
  #define EX(v) __builtin_amdgcn_exp2f(v)
  #define GAPB(MF,X,B) do{ MF; X[B]=EX(X[B]); X[B+1]=EX(X[B+1]); X[B+2]=EX(X[B+2]); X[B+3]=EX(X[B+3]); PIN(X); SBAR(); }while(0)
  #define VRD(i) do{ vlo[i]=vtr(vp_+(((i)>>2)*4096+((i)&3)*1024)); vhi[i]=vtr(vp_+(((i)>>2)*4096+((i)&3)*1024+512)); }while(0)
  #define KRD(G,j) do{ if(G){ kload2(kf,kp0+sl_next,j); SBAR(); } }while(0)
  #define STEP(C0,C1,P0,P1,t,GK,GV,GL) do{ SBAR(); \
    const lds_cptr vp_=vp0+sl_prev; \
    VRD(0); SBAR(); float sacc=(P0[0]+P0[1]); \
    GAPA(C0=__builtin_amdgcn_mfma_f32_32x32x16_bf16(kf[0],qr[0],negm,0,0,0), P0[2],P0[3],P0[4],P0[5],     pw0[0]=PKW(P0,0), pw0[1]=PKW(P0,2), pw0); \
    VRD(4); SBAR(); GAPA(C1=__builtin_amdgcn_mfma_f32_32x32x16_bf16(kf[1],qr[0],negm,0,0,0), P0[6],P0[7],P0[8],P0[9],     pw0[2]=PKW(P0,4), pw0[3]=PKW(P0,6), pw0); \
    VRD(1); SBAR(); GAPA(C0=__builtin_amdgcn_mfma_f32_32x32x16_bf16(kf[2],qr[1],C0,0,0,0),   P0[10],P0[11],P0[12],P0[13], pw1[0]=PKW(P0,8), pw1[1]=PKW(P0,10), pw1); \
    VRD(5); SBAR(); GAPA(C1=__builtin_amdgcn_mfma_f32_32x32x16_bf16(kf[3],qr[1],C1,0,0,0),   P0[14],P0[15],P1[0],P1[1],   pw1[2]=PKW(P0,12),pw1[3]=PKW(P0,14), pw1); \
    VRD(2); SBAR(); GAPA(C0=__builtin_amdgcn_mfma_f32_32x32x16_bf16(kf[4],qr[2],C0,0,0,0),   P1[2],P1[3],P1[4],P1[5],     pw2[0]=PKW(P1,0), pw2[1]=PKW(P1,2), pw2); \
    VRD(6); SBAR(); GAPA(C1=__builtin_amdgcn_mfma_f32_32x32x16_bf16(kf[5],qr[2],C1,0,0,0),   P1[6],P1[7],P1[8],P1[9],     pw2[2]=PKW(P1,4), pw2[3]=PKW(P1,6), pw2); \
    VRD(3); SBAR(); GAPA(C0=__builtin_amdgcn_mfma_f32_32x32x16_bf16(kf[6],qr[3],C0,0,0,0),   P1[10],P1[11],P1[12],P1[13], pw3[0]=PKW(P1,8), pw3[1]=PKW(P1,10), pw3); \
    VRD(7); SBAR(); GAPA(C1=__builtin_amdgcn_mfma_f32_32x32x16_bf16(kf[7],qr[3],C1,0,0,0),   P1[14],P1[15],0.f,0.f,       pw3[2]=PKW(P1,12),pw3[3]=PKW(P1,14), pw3); \
    l_reg+=sacc; \
    if(GK){DMA_K((t)+3,sl_cur);} if(GV){DMA_V((t)+1,sl_next);} \
    CMASK(C0,C1,t); \
    { float a=MX3(C0[0],C0[1],C1[0]),b=MX3(C0[2],C0[3],C1[1]); a=MX3(a,C1[2],C1[3]); \
      _Pragma("unroll") for(int r=4;r<16;r+=4){a=MX3(a,C0[r],C0[r+1]);b=MX3(b,C0[r+2],C0[r+3]);a=MX3(a,C1[r],C1[r+1]);b=MX3(b,C1[r+2],C1[r+3]);} \
      float rm=__builtin_fmaxf(a,b); { auto rr=__builtin_amdgcn_permlane32_swap(__float_as_uint(rm),__float_as_uint(rm),false,false); rm=__builtin_fmaxf(__uint_as_float(rr[0]),__uint_as_float(rr[1])); } \
      resc=false; \
      if(__builtin_expect(__any(rm>(float)THRL),0)){ const float dl=__builtin_fmaxf(rm,0.f); mhat+=dl; \
        _Pragma("unroll") for(int r=0;r<16;++r){C0[r]-=dl;C1[r]-=dl;} \
        _Pragma("unroll") for(int r=0;r<16;++r)negm[r]=-mhat; asm volatile("":"+v"(negm)); \
        const float f=__builtin_amdgcn_exp2f(-dl); l_reg*=f; if(hi==0)wsf[r32]=f; resc=true; } } \
    SBAR(); \
    GAPB(o[0]=__builtin_amdgcn_mfma_f32_32x32x16_bf16(PAF(0),VFR(0),o[0],0,0,0), C0,0); \
    GAPB(o[1]=__builtin_amdgcn_mfma_f32_32x32x16_bf16(PAF(0),VFR(4),o[1],0,0,0), C0,4); \
    KRD(GL,0); GAPB(o[0]=__builtin_amdgcn_mfma_f32_32x32x16_bf16(PAF(1),VFR(1),o[0],0,0,0), C0,8); \
    KRD(GL,1); GAPB(o[1]=__builtin_amdgcn_mfma_f32_32x32x16_bf16(PAF(1),VFR(5),o[1],0,0,0), C0,12); \
    KRD(GL,2); GAPB(o[0]=__builtin_amdgcn_mfma_f32_32x32x16_bf16(PAF(2),VFR(2),o[0],0,0,0), C1,0); \
    KRD(GL,3); GAPB(o[1]=__builtin_amdgcn_mfma_f32_32x32x16_bf16(PAF(2),VFR(6),o[1],0,0,0), C1,4); \
    GAPB(o[0]=__builtin_amdgcn_mfma_f32_32x32x16_bf16(PAF(3),VFR(3),o[0],0,0,0), C1,8); \
    GAPB(o[1]=__builtin_amdgcn_mfma_f32_32x32x16_bf16(PAF(3),VFR(7),o[1],0,0,0), C1,12); \
    }while(0)
  int t=1;
  #undef CMASK
  #define CMASK(P0,P1,t) do{}while(0)
  for(;t+5<NT;t+=2){
    STEP(pB0,pB1,pA0,pA1,t,true,true,true);     WAIT_BAR(2); RESC(); ROT();
    STEP(pA0,pA1,pB0,pB1,t+1,true,true,true);   WAIT_BAR(2); RESC(); ROT();
  }
  #undef CMASK
  #define CMASK(P0,P1,t) do{}while(0)
  #define ENDW(tt) do{ if((tt)+3<NT){WAIT_BAR(2);} else if((tt)+2<NT){WAIT_BAR(1);} else {WAIT_BAR(0);} }while(0)
  for(;t+1<NT;t+=2){
    STEP(pB0,pB1,pA0,pA1,t,(t+3<NT),(t+1<NT),(t+1<NT));       ENDW(t);   RESC(); ROT();
    STEP(pA0,pA1,pB0,pB1,t+1,(t+4<NT),(t+2<NT),(t+2<NT));     ENDW(t+1); RESC(); ROT();
  }
  STEP(pB0,pB1,pA0,pA1,NT-1,false,false,false); RESC();
  { float sacc=pB0[0]+pB0[1]; _Pragma("unroll") for(int r=2;r<16;++r)sacc+=pB0[r]; _Pragma("unroll") for(int r=0;r<16;++r)sacc+=pB1[r]; l_reg+=sacc;
    pw0=(u32x4){PKW(pB0,0),PKW(pB0,2),PKW(pB0,4),PKW(pB0,6)};pw1=(u32x4){PKW(pB0,8),PKW(pB0,10),PKW(pB0,12),PKW(pB0,14)};pw2=(u32x4){PKW(pB1,0),PKW(pB1,2),PKW(pB1,4),PKW(pB1,6)};pw3=(u32x4){PKW(pB1,8),PKW(pB1,10),PKW(pB1,12),PKW(pB1,14)};
    SBAR(); pv(o,vb0+sl_cur,PAF(0),PAF(1),PAF(2),PAF(3)); }
  #undef PKW
  #undef PAF
  #undef VFR
  #undef PIN
  #undef MX3
  #undef GAPA
  #undef GAPB
  #undef EX
  #undef VRD
  #undef KRD
  #undef STEP
  #undef ENDW
  {auto rr=__builtin_amdgcn_permlane32_swap(__float_as_uint(l_reg),__float_as_uint(l_reg),false,false);l_reg=__uint_as_float(rr[0])+__uint_as_float(rr[1]);}
  if(hi==0)wsf[32+r32]=l_reg;asm volatile("s_waitcnt lgkmcnt(0)":::"memory");
  float rli[16];
  #pragma unroll
  for(int r=0;r<16;++r)rli[r]=__builtin_amdgcn_rcpf(wsf[32+crow(r,hi)]);
  bf16*Ow=O+(qrow0+wid*QBLK)*QP+h*D;
  { bf16*stg=(bf16*)(shm+LDS_OST)+wid*2048;
    #pragma unroll
    for(int r=0;r<16;++r){const int orow=crow(r,hi);
      #pragma unroll
      for(int d0=0;d0<2;++d0)stg[orow*64+d0*32+r32]=__float2bfloat16(o[d0][r]*rli[r]);}
    asm volatile("s_waitcnt lgkmcnt(0)":::"memory");
    #pragma unroll
    for(int i=0;i<4;++i){const int row=i*8+(lane>>3),ch=lane&7; const u32x4 v=*(const u32x4*)(stg+row*64+ch*8); ATTN_STORE16(Ow+(long)row*QP+ch*8,v);} }
  asm volatile("s_waitcnt lgkmcnt(0)\n\ts_barrier":::"memory");
  #undef DMA_K
  #undef DMA_V
  #undef CMASK
  #undef START
  #undef RESC
  #undef ROT
}
constexpr int ATTN_LDS_BYTES=LDS_BYTES;
struct AttnTensors { const bf16* Q; const bf16* K; const bf16* V; bf16* O; };
template<int THRL=8> __device__ __forceinline__ void attn_phase(char*lds,const AttnTensors&T,int G,int vcu,bool with_ctx,long ctx_row0){
  const int total=4*NHEAD*NQB;
  for(int i=0;;++i){
    int x,n;
    if(G==256){ if(i>=4)break; x=vcu>>5; n=i*32+(vcu&31); }
    else { const int u=i*G+vcu; if(u>=total)break; x=u>>7; n=u&127; }
    const int b=x>>1,kvh=x&1,h=kvh*4+(n>>5),qb=n&31;
    attn_unit<THRL>(b,h,(long)b*SEQQ+(long)qb*QB,SEQK/KVBLK,T.Q,T.K,T.V,T.O,lds);
  }
  if(with_ctx){
    for(int u=vcu;u<4*NHEAD;u+=G){ const int b=u>>3,h=u&7; attn_unit<THRL>(b,h,ctx_row0+(long)b*256,4,T.Q,T.K,T.V,T.O,lds); }
  }
}
#undef SBAR
#undef WAIT_BAR
}

constexpr int NWAVES = 8, NTHR = 512;
constexpr int DMODEL = 1024, NB = 4, SEQ = 8192, CTXL = 256, NLAT = NB * SEQ, NCTX = NB * CTXL, MT = NLAT + NCTX;
constexpr int INW = 2048, NE = 32, KEYS = SEQ + CTXL;
constexpr int SORT_TILES = 560, SORT_ROWS = SORT_TILES * 256;
constexpr float EPSN = 1e-6f;
constexpr int NCHUNK = 66, CHUNK = 128;
constexpr int NPH_PRO = 2, NPH_LAYER = 13, NPH = NPH_PRO + 2 * NPH_LAYER;

constexpr size_t MiB = 1u << 20;
constexpr size_t WS_CTL = 0, CTL_ZERO_BYTES = 1 * MiB;
constexpr size_t WS_MOD = 1 * MiB, WS_ROPEC = 2 * MiB, WS_ROPES = 3 * MiB, WS_H2 = 4 * MiB, WS_KFC = 10 * MiB, WS_BLKCNT = 12 * MiB, WS_TILEE = 13 * MiB, WS_SCANS = 14 * MiB;
constexpr size_t WS_WINT = 16 * MiB, WS_WOUTT = 24 * MiB, WS_W1T = 32 * MiB, WS_W2T = 288 * MiB, WS_KF = 416 * MiB, WS_KHAT = 448 * MiB, WS_XR = 512 * MiB, WS_H = 644 * MiB;
constexpr size_t WS_U = 712 * MiB, WS_Q = 844 * MiB, WS_K = 877 * MiB, WS_V = 886 * MiB, WS_ATT = 895 * MiB, WS_LAB = 928 * MiB, WS_LRUO = 1060 * MiB, WS_VT = 1093 * MiB, WS_X0T = 1125 * MiB,
                 WS_HYO = 1157 * MiB, WS_MIXA = 1190 * MiB;
constexpr size_t WS_WGT = 11 * MiB, WS_SPT = 10 * MiB + 768 * 1024, WS_XL = 1256 * MiB;
constexpr size_t WS_GC = 10 * MiB + 896 * 1024;
constexpr size_t WS_CB = 10 * MiB + 960 * 1024;
constexpr size_t WS_F = 712 * MiB, WS_ASORT = 778 * MiB, WS_ACT = 1058 * MiB, WS_YS = 1338 * MiB, WS_TOPI = 1618 * MiB, WS_GATE = 1619 * MiB, WS_POS = 1620 * MiB, WS_RSSP = 1622 * MiB, WS_ROWTOK = 1625 * MiB, WS_END = 1626 * MiB;
constexpr size_t LAB_STRIDE = (size_t)MT * 256;
constexpr int CW_BAR = 4096;
constexpr int CW_NTILES = 64;

constexpr int RING_OFF = 0, RING_BYTES = 131072, MOETAB_OFF = 131072, LDSCTL_OFF = 155648, LDS_BYTES = 156160;

#define GAS __attribute__((address_space(1)))
#define LAS __attribute__((address_space(3)))
typedef unsigned short bf16;
typedef unsigned v4u __attribute__((ext_vector_type(4)));
typedef unsigned v2u __attribute__((ext_vector_type(2)));
typedef float f32x4 __attribute__((ext_vector_type(4)));
#define LDS_WAIT() asm volatile("s_waitcnt lgkmcnt(0)" ::: "memory")
#define VM_WAIT() asm volatile("s_waitcnt vmcnt(0)" ::: "memory")
__device__ __forceinline__ unsigned f2bf(float f) { unsigned u = __builtin_bit_cast(unsigned, f); return (u + 0x7fffu + ((u >> 16) & 1u)) >> 16; }
__device__ __forceinline__ unsigned pk2(float lo, float hi) { return f2bf(lo) | (f2bf(hi) << 16); }
__device__ __forceinline__ float bf2f(unsigned short b) { return __builtin_bit_cast(float, (unsigned)b << 16); }
__device__ __forceinline__ float bflo(unsigned w) { return __builtin_bit_cast(float, w << 16); }
__device__ __forceinline__ float bfhi(unsigned w) { return __builtin_bit_cast(float, w & 0xffff0000u); }
__device__ __forceinline__ float wave_sum(float v) {
#pragma unroll
    for (int o = 1; o < 64; o <<= 1) v += __shfl_xor(v, o);
    return v;
}
__device__ __forceinline__ float sigmoidf_(float x) { return 1.0f / (1.0f + __expf(-x)); }
__device__ __forceinline__ void sincos_d(double x, double& s, double& c) {
    const double kd = __builtin_rint(x * 0.63661977236758134308);
    const int k = (int)kd;
    double r = __builtin_fma(-kd, 1.57079632673412561417e+00, x);
    r = __builtin_fma(-kd, 6.07710050650619224932e-11, r);
    const double z = r * r;
    const double ps = r + r * z * (-1.66666666666666324348e-01 + z * (8.33333333332248946124e-03 + z * (-1.98412698298579493134e-04 + z * (2.75573137070700676789e-06 + z * (-2.50507602534068634195e-08 + z * 1.58969099521155010221e-10)))));
    const double pc = 1.0 - 0.5 * z + z * z * (4.16666666666666019037e-02 + z * (-1.38888888888741095749e-03 + z * (2.48015872894767294178e-05 + z * (-2.75573143513906633035e-07 + z * (2.08757232129817482790e-09 + z * -1.13596475577881948265e-11)))));
    const int q = k & 3;
    s = (q == 0) ? ps : (q == 1) ? pc : (q == 2) ? -ps : -pc;
    c = (q == 0) ? pc : (q == 1) ? -ps : (q == 2) ? -pc : ps;
}
__device__ __forceinline__ float gelu_tanh(float x) {
    const float u = 0.7978845608028654f * (x + 0.044715f * x * x * x);
    const float t = 1.0f - 2.0f / (1.0f + __expf(2.0f * u));
    return 0.5f * x * (1.0f + t);
}
__device__ __forceinline__ int lds_add(LAS int* p, int v) { return __hip_atomic_fetch_add(p, v, __ATOMIC_RELAXED, __HIP_MEMORY_SCOPE_WORKGROUP); }

#define FFT_FN __device__ __forceinline__
typedef float f32x2v __attribute__((ext_vector_type(2)));
#define FFT_VEC2 f32x2v
#define FFT_DPTR LAS f32x2v*
#define FFT_LD(D, i) c32_from((D)[i])
#define FFT_ST(D, i, v) ((D)[i] = c32_to(v))
struct __attribute__((aligned(8))) c32 { float x, y; };
FFT_FN c32 cmul(c32 a, c32 b) { c32 r; r.x = a.x * b.x - a.y * b.y; r.y = a.x * b.y + a.y * b.x; return r; }
FFT_FN c32 cadd(c32 a, c32 b) { c32 r; r.x = a.x + b.x; r.y = a.y + b.y; return r; }
FFT_FN c32 csub(c32 a, c32 b) { c32 r; r.x = a.x - b.x; r.y = a.y - b.y; return r; }
FFT_FN c32 cmuli_neg(c32 a) { c32 r; r.x = a.y; r.y = -a.x; return r; }
FFT_FN int fpad(int a) { return a + (a >> 4); }
#ifdef FFT_VEC2
FFT_FN c32 c32_from(FFT_VEC2 t) { c32 r; r.x = t.x; r.y = t.y; return r; }
FFT_FN FFT_VEC2 c32_to(c32 a) { FFT_VEC2 t; t.x = a.x; t.y = a.y; return t; }
#endif
FFT_FN void dft4(c32& a0, c32& a1, c32& a2, c32& a3) {
    const c32 s02 = cadd(a0, a2), d02 = csub(a0, a2), s13 = cadd(a1, a3), d13 = cmuli_neg(csub(a1, a3));
    a0 = cadd(s02, s13); a2 = csub(s02, s13); a1 = cadd(d02, d13); a3 = csub(d02, d13);
}
FFT_FN void dft16(c32 (&v)[16]) {
    const float C1 = 0.92387953251128674f, S1 = 0.38268343236508977f, C2 = 0.70710678118654752f;
#pragma unroll
    for (int q2 = 0; q2 < 4; ++q2) dft4(v[q2], v[4 + q2], v[8 + q2], v[12 + q2]);
    { c32 w;
      w.x = C1; w.y = -S1; v[4 * 1 + 1] = cmul(v[4 * 1 + 1], w);
      w.x = C2; w.y = -C2; v[4 * 2 + 1] = cmul(v[4 * 2 + 1], w);
      w.x = S1; w.y = -C1; v[4 * 3 + 1] = cmul(v[4 * 3 + 1], w);
      w.x = C2; w.y = -C2; v[4 * 1 + 2] = cmul(v[4 * 1 + 2], w);
      v[4 * 2 + 2] = cmuli_neg(v[4 * 2 + 2]);
      w.x = -C2; w.y = -C2; v[4 * 3 + 2] = cmul(v[4 * 3 + 2], w);
      w.x = S1; w.y = -C1; v[4 * 1 + 3] = cmul(v[4 * 1 + 3], w);
      w.x = -C2; w.y = -C2; v[4 * 2 + 3] = cmul(v[4 * 2 + 3], w);
      w.x = -C1; w.y = S1; v[4 * 3 + 3] = cmul(v[4 * 3 + 3], w); }
#pragma unroll
    for (int p1 = 0; p1 < 4; ++p1) dft4(v[4 * p1 + 0], v[4 * p1 + 1], v[4 * p1 + 2], v[4 * p1 + 3]);
#pragma unroll
    for (int a = 0; a < 4; ++a)
#pragma unroll
        for (int b = a + 1; b < 4; ++b) { const c32 t = v[4 * a + b]; v[4 * a + b] = v[4 * b + a]; v[4 * b + a] = t; }
}
FFT_FN c32 twid(int j, int n) { float rev = (float)j / (float)n; asm volatile("" : "+v"(rev)); c32 w; w.x = __builtin_amdgcn_cosf(rev); w.y = -__builtin_amdgcn_sinf(rev); return w; }

FFT_FN void fft_fwd16(FFT_DPTR D, int g, int n) {
    const int s = n >> 4, blk = g / s, j = g - blk * s, base = blk * n + j;
    c32 v[16];
#pragma unroll
    for (int q = 0; q < 16; ++q) v[q] = FFT_LD(D, fpad(base + q * s));
    dft16(v);
    const c32 w = twid(j, n); c32 wp = w;
#pragma unroll
    for (int p = 1; p < 16; ++p) { v[p] = cmul(v[p], wp); wp = cmul(wp, w); }
#pragma unroll
    for (int p = 0; p < 16; ++p) FFT_ST(D, fpad(base + p * s), v[p]);
}
FFT_FN void fft_inv16(FFT_DPTR D, int g, int n) {
    const int s = n >> 4, blk = g / s, j = g - blk * s, base = blk * n + j;
    c32 v[16];
#pragma unroll
    for (int q = 0; q < 16; ++q) v[q] = FFT_LD(D, fpad(base + q * s));
    const c32 w = twid(j, n); c32 wp = w;
#pragma unroll
    for (int p = 1; p < 16; ++p) { v[p] = cmul(v[p], wp); wp = cmul(wp, w); }
    dft16(v);
#pragma unroll
    for (int p = 0; p < 16; ++p) FFT_ST(D, fpad(base + p * s), v[p]);
}
FFT_FN void fft_mid16(FFT_DPTR D, int g, const c32* KH) {
    c32 v[16];
#pragma unroll
    for (int q = 0; q < 16; ++q) v[q] = FFT_LD(D, 17 * g + q);
    dft16(v);
#pragma unroll
    for (int p = 0; p < 16; ++p) { const c32 k = KH[16 * g + p]; const c32 t = cmul(v[p], k); v[p].x = t.x; v[p].y = -t.y; }
    dft16(v);
#pragma unroll
    for (int p = 0; p < 16; ++p) FFT_ST(D, 17 * g + p, v[p]);
}
FFT_FN void fft_last16_out(FFT_DPTR D, int g, c32* OUT, float scale) {
    c32 v[16];
#pragma unroll
    for (int q = 0; q < 16; ++q) v[q] = FFT_LD(D, 17 * g + q);
    dft16(v);
#pragma unroll
    for (int p = 0; p < 16; ++p) { c32 t; t.x = v[p].x * scale; t.y = v[p].y * scale; OUT[16 * g + p] = t; }
}
FFT_FN void fft_first4(FFT_DPTR D, int j, c32 x0, c32 x1, c32 x2, c32 x3) {
    dft4(x0, x1, x2, x3);
    const c32 w = twid(j, 16384), w2 = cmul(w, w), w3 = cmul(w2, w);
    FFT_ST(D, fpad(j), x0); FFT_ST(D, fpad(j + 4096), cmul(x1, w)); FFT_ST(D, fpad(j + 8192), cmul(x2, w2)); FFT_ST(D, fpad(j + 12288), cmul(x3, w3));
}
FFT_FN void fft_final4(FFT_DPTR D, int j, c32& u0, c32& u1) {
    const c32 w = twid(j, 16384), w2 = cmul(w, w), w3 = cmul(w2, w);
    c32 a0 = FFT_LD(D, fpad(j)), a1 = cmul(FFT_LD(D, fpad(j + 4096)), w), a2 = cmul(FFT_LD(D, fpad(j + 8192)), w2), a3 = cmul(FFT_LD(D, fpad(j + 12288)), w3);
    dft4(a0, a1, a2, a3);
    u0 = a0; u1 = a1;
}
FFT_FN void fft_first4_inplace(FFT_DPTR D, int j) {
    c32 x0 = FFT_LD(D, fpad(j)), x1 = FFT_LD(D, fpad(j + 4096)), x2 = FFT_LD(D, fpad(j + 8192)), x3 = FFT_LD(D, fpad(j + 12288));
    fft_first4(D, j, x0, x1, x2, x3);
}
#define XB_TMO      128
#define XB_XCNT(j)  (256  + 64 * (j))
#define XB_XSUB(j)  (1280 + 64 * (j))
#define XB_XGEN(j)  (2304 + 64 * (j))
#define XB_TOP      3328
#define XB_TOPGEN   3392
#define XCD_BAR_WORDS 3456
#define XB_SPIN_CAP (1u << 22)

__device__ __forceinline__ unsigned xb_ld(unsigned* p)              { return __hip_atomic_load(p, __ATOMIC_RELAXED, __HIP_MEMORY_SCOPE_AGENT); }
__device__ __forceinline__ unsigned xb_add(unsigned* p, unsigned v) { return __hip_atomic_fetch_add(p, v, __ATOMIC_RELAXED, __HIP_MEMORY_SCOPE_AGENT); }
__device__ __forceinline__ unsigned xb_xcc_id() { return (unsigned)__builtin_amdgcn_s_getreg((3 << 11) | 20) & 0xFu; }
#define XB_SPIN(cond, bar) do { unsigned _sp = 0; while (cond) { __builtin_amdgcn_s_sleep(1); \
    if ((++_sp & 255u) == 0u) { if (xb_ld(&(bar)[XB_TMO])) break; if (_sp > XB_SPIN_CAP) { atomicAdd(&(bar)[XB_TMO], 1u); break; } } } } while (0)

struct XcdBarrier {
    unsigned* bar; unsigned x;
    volatile LAS unsigned* st;
};

__device__ __forceinline__ XcdBarrier xcd_barrier_post(unsigned* bar, volatile LAS unsigned* st) {
    XcdBarrier b; b.bar = bar; b.x = xb_xcc_id(); b.st = st;
    if (threadIdx.x == 0) (void)xb_add(&bar[XB_XCNT(b.x)], 1u);
    return b;
}
__device__ __forceinline__ void xcd_barrier_complete(unsigned* bar, unsigned x, unsigned& nloc, unsigned& nx) {
    const unsigned G = gridDim.x * gridDim.y * gridDim.z;
    unsigned sum, cnt, mine, sp = 0u;
    for (;;) {
        sum = 0u; cnt = 0u; mine = 0u;
#pragma unroll
        for (unsigned j = 0; j < 16; ++j) { const unsigned c = xb_ld(&bar[XB_XCNT(j)]); sum += c; cnt += (c > 0u) ? 1u : 0u; mine = (j == x) ? c : mine; }
        if (sum == G) break;
        __builtin_amdgcn_s_sleep(1);
        if ((++sp & 255u) == 0u) { if (xb_ld(&bar[XB_TMO])) break; if (sp > XB_SPIN_CAP) { atomicAdd(&bar[XB_TMO], 1u); break; } }
    }
    nloc = mine > 0u ? mine : 1u; nx = cnt > 0u ? cnt : 1u;
}

__device__ __forceinline__ void xcd_barrier(const XcdBarrier& b) {
    asm volatile("s_waitcnt vmcnt(0)" ::: "memory");
    __syncthreads();
    if (threadIdx.x == 0) {
        unsigned* bar = b.bar;
        __builtin_amdgcn_s_waitcnt(0);
        unsigned nloc = b.st[0], nx = b.st[1];
        if (nloc == 0u) { xcd_barrier_complete(bar, b.x, nloc, nx); b.st[0] = nloc; b.st[1] = nx; }
        const unsigned old = xb_add(&bar[XB_XSUB(b.x)], 1u);
        const unsigned gen = old / nloc;
        if (old + 1u == (gen + 1u) * nloc) {
            __builtin_amdgcn_fence(__ATOMIC_RELEASE, "agent");
            asm volatile("s_waitcnt vmcnt(0)" ::: "memory");
            const unsigned og = xb_add(&bar[XB_TOP], 1u);
            const unsigned tg = og / nx;
            if (og + 1u == (tg + 1u) * nx) xb_add(&bar[XB_TOPGEN], 1u);
            else XB_SPIN(xb_ld(&bar[XB_TOPGEN]) == tg, bar);
            __builtin_amdgcn_fence(__ATOMIC_ACQUIRE, "agent");
            xb_add(&bar[XB_XGEN(b.x)], 1u);
            asm volatile("s_waitcnt vmcnt(0)" ::: "memory");
        } else {
            XB_SPIN(xb_ld(&bar[XB_XGEN(b.x)]) == gen, bar);
            __builtin_amdgcn_fence(__ATOMIC_ACQUIRE, "agent");
            asm volatile("s_waitcnt vmcnt(0)" ::: "memory");
        }
    }
    __syncthreads();
}


struct Frame {
    LAS unsigned char* lds; unsigned* ctl; unsigned char* ws;
    int tid, lane, wave, vcu, G, gw, ngw;
};
__device__ const float ROPE_INV[16] = {1.0f, 0.5623413251903491f, 0.31622776601683794f, 0.1778279410038923f, 0.1f, 0.05623413251903491f, 0.03162277660168379f, 0.01778279410038923f,
                                       0.01f, 0.005623413251903491f, 0.0031622776601683794f, 0.001778279410038923f, 0.001f, 0.0005623413251903491f, 0.00031622776601683794f, 0.0001778279410038923f};

__device__ __forceinline__ void p0_transpose_item(const float* W, int K, int N, bf16* WT, LAS float* scr, int item, int lane) {
    const int nblk = N / 32, kb = item / nblk, nb = item % nblk, k0 = 64 * kb, n0 = 32 * nb;
#pragma unroll 8
    for (int i = 0; i < 32; ++i) { const int kk = 2 * i + (lane >> 5); scr[kk * 33 + (lane & 31)] = W[(size_t)(k0 + kk) * N + n0 + (lane & 31)]; }
    LDS_WAIT(); asm volatile("" ::: "memory");
    const int c = lane & 7;
#pragma unroll
    for (int j = 0; j < 4; ++j) { const int n = (lane >> 3) + 8 * j; const LAS float* s = scr + (8 * c) * 33 + n;
        v4u o; o.x = pk2(s[0 * 33], s[1 * 33]); o.y = pk2(s[2 * 33], s[3 * 33]); o.z = pk2(s[4 * 33], s[5 * 33]); o.w = pk2(s[6 * 33], s[7 * 33]);
        *(GAS v4u*)(WT + (size_t)(n0 + n) * K + k0 + 8 * c) = o; }
    LDS_WAIT(); asm volatile("" ::: "memory");
}

__device__ __forceinline__ void ph_prologue_a(const Frame& F, const float* c, const float* cctx, const float* w_mod, const float* b_mod, const float* w_in, const float* w_out,
                                              const float* moe_w1, const float* moe_w2, const float* hy_w1, const float* hy_b1, const float* hy_w2, const float* hy_b2, const float* hy_freq, const float* lru_gw, const float* lru_lam) {
    {
        LAS float* scr = (LAS float*)(F.lds + F.wave * 16384);
        constexpr int I_IN = 2 * 1024, I_OUT = 2 * 512, I_W1 = 64 * 1024, I_W2 = 64 * 512, NIT = I_IN + I_OUT + I_W1 + I_W2;
        bf16* WinT = (bf16*)(F.ws + WS_WINT); bf16* WoutT = (bf16*)(F.ws + WS_WOUTT); bf16* W1T = (bf16*)(F.ws + WS_W1T); bf16* W2T = (bf16*)(F.ws + WS_W2T);
        for (int it = F.gw; it < NIT; it += F.ngw) {
            int r = it;
            if (r < I_IN) { const int m = r >> 10; p0_transpose_item(w_in + (size_t)m * 1024 * 2048, 1024, 2048, WinT + (size_t)m * 2048 * 1024, scr, r & 1023, F.lane); continue; } r -= I_IN;
            if (r < I_OUT) { const int m = r >> 9; p0_transpose_item(w_out + (size_t)m * 1024 * 1024, 1024, 1024, WoutT + (size_t)m * 1024 * 1024, scr, r & 511, F.lane); continue; } r -= I_OUT;
            if (r < I_W1) { const int m = r >> 10; p0_transpose_item(moe_w1 + (size_t)m * 1024 * 2048, 1024, 2048, W1T + (size_t)m * 2048 * 1024, scr, r & 1023, F.lane); continue; } r -= I_W1;
            { const int m = r >> 9; p0_transpose_item(moe_w2 + (size_t)m * 1024 * 1024, 1024, 1024, W2T + (size_t)m * 1024 * 1024, scr, r & 511, F.lane); }
        }
    }
    __syncthreads();
    {
        LAS float* sl = (LAS float*)(F.lds);
        LAS float* red = (LAS float*)(F.lds + 20480);
        float* MOD = (float*)(F.ws + WS_MOD);
        if ((int)blockIdx.x < 192) {
            for (int i = F.tid; i < 5 * 1024; i += NTHR) { const int r = i >> 10, k = i & 1023; const float v = (r < 4) ? c[r * 1024 + k] : cctx[k]; sl[i] = v / (1.0f + __expf(-v)); }
        }
        __syncthreads();
        for (int it = blockIdx.x; it < 192; it += F.G) {
            const int l = it / 96, n = (it % 96) * 64 + F.lane;
            float a0 = 0.f, a1 = 0.f, a2 = 0.f, a3 = 0.f, a4 = 0.f;
            const float* wp = w_mod + ((size_t)l * 1024 + F.wave * 128) * 6144 + n;
#pragma unroll 8
            for (int k = 0; k < 128; ++k) { const float w = wp[(size_t)k * 6144]; const int kk = F.wave * 128 + k;
                a0 += sl[kk] * w; a1 += sl[1024 + kk] * w; a2 += sl[2048 + kk] * w; a3 += sl[3072 + kk] * w; a4 += sl[4096 + kk] * w; }
            red[(F.wave * 5 + 0) * 64 + F.lane] = a0; red[(F.wave * 5 + 1) * 64 + F.lane] = a1; red[(F.wave * 5 + 2) * 64 + F.lane] = a2; red[(F.wave * 5 + 3) * 64 + F.lane] = a3; red[(F.wave * 5 + 4) * 64 + F.lane] = a4;
            __syncthreads();
            if (F.tid < 320) { const int r = F.tid >> 6, ln = F.tid & 63; float s = 0.f;
#pragma unroll
                for (int w = 0; w < 8; ++w) s += red[(w * 5 + r) * 64 + ln];
                const int nn = (it % 96) * 64 + ln; MOD[(size_t)(l * 5 + r) * 6144 + nn] = s + b_mod[l * 6144 + nn]; }
            __syncthreads();
        }
    }
    {
        bf16* WGT = (bf16*)(F.ws + WS_WGT); float* SPT = (float*)(F.ws + WS_SPT);
        for (int idx = blockIdx.x * NTHR + F.tid; idx < 2 * 1024 * 256; idx += F.G * NTHR) {
            const int l = idx >> 18, nidx = (idx >> 8) & 1023, k = idx & 255;
            const int pn = nidx >> 8, j = (nidx >> 7) & 1, cc = nidx & 127, d = pn >> 1, ch = 128 * (pn & 1) + cc, n = ch >> 6, e = ch & 63;
            const float v = ((k >> 6) == n) ? lru_gw[((size_t)((((l * 2 + d) * 2 + j) * 4 + n) * 64 + (k & 63))) * 64 + e] : 0.f;
            WGT[idx] = (bf16)f2bf(v); }
        for (int idx = blockIdx.x * NTHR + F.tid; idx < 2 * 2 * 256; idx += F.G * NTHR) SPT[idx] = log1pf(expf(-lru_lam[idx]));
    }
    {
        float* RC = (float*)(F.ws + WS_ROPEC); float* RS = (float*)(F.ws + WS_ROPES);
        for (int idx = blockIdx.x * NTHR + F.tid; idx < SEQ * 32; idx += F.G * NTHR) {
            const int t = idx >> 5, i = idx & 31; const int pos = (i < 16) ? (t >> 6) : (t & 63);
            const float ang = (float)pos * ROPE_INV[i & 15];
            double s, cc; sincos_d((double)ang, s, cc); RC[idx] = (float)cc; RS[idx] = (float)s; }
    }
    {
        float* H2 = (float*)(F.ws + WS_H2);
        for (int it = F.gw; it < 2 * SEQ + CTXL; it += F.ngw) {
            const int v = it >> 13, t = (v < 2) ? (it & (SEQ - 1)) : (it - 2 * SEQ), L = (v < 2) ? SEQ : CTXL, l = (v == 1) ? 1 : 0;
            const int j = F.lane;
            float z = 0.f;
            if (j == 0) z = (float)t / (float)(L - 1);
            else if (j <= 32) { const int b = (j - 1) & 15; const float band = 1e-4f + (float)b * ((15.0f - 1e-4f) / 15.0f);
                const float ang = ((6.283185307179586f / (float)L) * (float)t) * band;
                double s, cc; sincos_d((double)ang, s, cc); z = (j <= 16) ? (float)cc : -(float)s; }
            const float fr = hy_freq[l * 64 + j];
            float p1 = hy_b1[l * 64 + j];
            const float* w1 = hy_w1 + (size_t)l * 33 * 64;
#pragma unroll
            for (int i = 0; i < 33; ++i) p1 += __shfl(z, i) * w1[i * 64 + j];
            double s1, c1; sincos_d((double)(fr * p1), s1, c1); const float h1 = (float)s1;
            float p2 = hy_b2[l * 64 + j];
            const float* w2 = hy_w2 + (size_t)l * 64 * 64;
#pragma unroll 16
            for (int i = 0; i < 64; ++i) p2 += __shfl(h1, i) * w2[i * 64 + j];
            double s2, c2; sincos_d((double)(fr * p2), s2, c2);
            H2[((size_t)v * SEQ + t) * 64 + j] = (float)s2;
        }
    }
}

__device__ __forceinline__ void ph_prologue_b(const Frame& F, const float* hy_w3, const float* hy_decay, const float* gffn, const float* router_w, const float* router_b) {
    { const float* MOD = (const float*)(F.ws + WS_MOD); float* CB = (float*)(F.ws + WS_CB);
      for (int it = F.gw; it < 2 * 5 * 32; it += F.ngw) { const int lb = it >> 5, e = it & 31, l = lb / 5; const float* sf = MOD + (size_t)lb * 6144 + 3 * 1024; float s = 0.f;
#pragma unroll
          for (int q = 0; q < 16; ++q) { const int cc = 64 * q + F.lane; s += sf[cc] * router_w[(size_t)l * 32768 + cc * 32 + e]; }
          s = wave_sum(s); if (F.lane == 0) CB[it] = s + router_b[l * 32 + e]; } }
    { const float* MOD = (const float*)(F.ws + WS_MOD); float* GC = (float*)(F.ws + WS_GC);
      for (int idx = blockIdx.x * NTHR + F.tid; idx < 2 * 5 * 1024; idx += F.G * NTHR) { const int lb = idx >> 10, cc = idx & 1023, l = lb / 5; GC[idx] = gffn[l * 1024 + cc] * (1.0f + MOD[(size_t)lb * 6144 + 4 * 1024 + cc]); } }
    LAS f32x2v* D = (LAS f32x2v*)(F.lds);
    LAS float* kt = (LAS float*)(F.lds);
    LAS float* w3c = (LAS float*)(F.lds + 139264);
    LAS float* red = (LAS float*)(F.lds + 139264 + 512);
    const float* H2 = (const float*)(F.ws + WS_H2);
    c32* KHAT = (c32*)(F.ws + WS_KHAT); float* KFC = (float*)(F.ws + WS_KFC);
    for (int it = blockIdx.x; it < 768; it += F.G) {
        const int v = it >> 8, c = it & 255, L = (v < 2) ? SEQ : CTXL, l = (v == 1) ? 1 : 0;
        if (F.tid < 128) w3c[F.tid] = hy_w3[(size_t)l * 64 * 512 + (F.tid & 63) * 512 + (F.tid >> 6) * 256 + c];
        if (F.tid == 0) { if (v < 2) { f32x2v z; z.x = 0.f; z.y = 0.f; D[fpad(L)] = z; } else kt[L] = 0.f; }
        __syncthreads();
        const float df = fabsf(hy_decay[l * 512 + c]), db = fabsf(hy_decay[l * 512 + 256 + c]);
        float asum = 0.f;
        for (int t = F.tid; t < L; t += NTHR) {
            const f32x4* row = (const f32x4*)(H2 + ((size_t)v * SEQ + t) * 64);
            float hf = 0.f, hb = 0.f;
#pragma unroll
            for (int q = 0; q < 16; ++q) { const f32x4 h = row[q];
                hf += h.x * w3c[4 * q] + h.y * w3c[4 * q + 1] + h.z * w3c[4 * q + 2] + h.w * w3c[4 * q + 3];
                hb += h.x * w3c[64 + 4 * q] + h.y * w3c[64 + 4 * q + 1] + h.z * w3c[64 + 4 * q + 2] + h.w * w3c[64 + 4 * q + 3]; }
            const float t01 = (float)t / (float)(L - 1);
            hf *= expf(-t01 * df); hb *= expf(-t01 * db);
            asum += fabsf(hf); if (t >= 1) asum += fabsf(hb);
            if (v < 2) { f32x2v z; z.x = hf; z.y = 0.f; D[fpad(t)] = z; if (t >= 1) { z.x = hb; D[fpad(2 * L - t)] = z; } }
            else { kt[t] = hf; if (t >= 1) kt[2 * L - t] = hb; }
        }
        asum = wave_sum(asum);
        if (F.lane == 0) red[F.wave] = asum;
        __syncthreads();
        float tot = 0.f;
#pragma unroll
        for (int w = 0; w < 8; ++w) tot += red[w];
        const float inv = 1.0f / tot;
        if (v < 2) {
            c32* out = KHAT + (size_t)(v * 256 + c) * 16384;
#pragma unroll 1
            for (int i = 0; i < 8; ++i) fft_first4_inplace(D, F.tid + 512 * i);
            __syncthreads();
            _Pragma("unroll 1") for (int g_ = F.tid; g_ < 1024; g_ += 512) fft_fwd16(D, g_, 4096);
            __syncthreads();
            _Pragma("unroll 1") for (int g_ = F.tid; g_ < 1024; g_ += 512) fft_fwd16(D, g_, 256);
            __syncthreads();
            _Pragma("unroll 1") for (int g_ = F.tid; g_ < 1024; g_ += 512) fft_last16_out(D, g_, out, inv * (1.0f / 16384.0f));
        } else {
            float* dst = KFC + (size_t)c * 512;
            for (int j = F.tid; j < 2 * L; j += NTHR) dst[j] = kt[j] * inv;
        }
        __syncthreads();
    }
}

__device__ __forceinline__ void ph_norm_mod(const Frame& F, int l, const float* x, const float* ctx, const float* gmix) {
    const float* XR = (const float*)(F.ws + WS_XR); const float* MOD = (const float*)(F.ws + WS_MOD); bf16* H = (bf16*)(F.ws + WS_H);
    for (int r = F.gw; r < MT; r += F.ngw) {
        const float* src = (l == 0) ? (r < NLAT ? x + (size_t)r * 1024 : ctx + (size_t)(r - NLAT) * 1024) : XR + (size_t)r * 1024;
        const int bidx = r < NLAT ? r / SEQ : 4;
        const float* shift = MOD + (size_t)(l * 5 + bidx) * 6144; const float* scale = shift + 1024; const float* g = gmix + l * 1024;
        f32x4 v[4]; float ss = 0.f;
#pragma unroll
        for (int j = 0; j < 4; ++j) { v[j] = ((const f32x4*)src)[64 * j + F.lane]; ss += (v[j].x * v[j].x + v[j].y * v[j].y) + (v[j].z * v[j].z + v[j].w * v[j].w); }
        const float rstd = 1.0f / sqrtf(wave_sum(ss) * (1.0f / 1024.0f) + EPSN);
#pragma unroll
        for (int j = 0; j < 4; ++j) { const int cb = 64 * j + F.lane; const f32x4 gg = ((const f32x4*)g)[cb], sc = ((const f32x4*)scale)[cb], sh = ((const f32x4*)shift)[cb];
            const f32x4 y = v[j] * rstd * gg * (sc + 1.0f) + sh;
            v2u o; o.x = pk2(y.x, y.y); o.y = pk2(y.z, y.w); ((v2u*)(H + (size_t)r * 1024))[cb] = o; }
    }
}

__device__ __forceinline__ void ph_post_proj(const Frame& F, int l, const float* qg_, const float* kg_, const float* lru_cw, const float* lru_cb, const float* hy_cw, const float* hy_cb) {
    const bf16* U = (const bf16*)(F.ws + WS_U);
    {
        bf16* Q = (bf16*)(F.ws + WS_Q); bf16* K = (bf16*)(F.ws + WS_K); bf16* V = (bf16*)(F.ws + WS_V);
        const float* RC = (const float*)(F.ws + WS_ROPEC); const float* RS = (const float*)(F.ws + WS_ROPES);
        const int o8 = 8 * (F.lane & 7);
        const f32x4 qg0 = *(const f32x4*)(qg_ + l * 64 + o8), qg1 = *(const f32x4*)(qg_ + l * 64 + o8 + 4), kg0 = *(const f32x4*)(kg_ + l * 64 + o8), kg1 = *(const f32x4*)(kg_ + l * 64 + o8 + 4);
        const float C2 = 0.125f * 1.4426950408889634f;
        const bool lohalf = (F.lane & 4) == 0;
        for (int r = F.gw; r < MT; r += F.ngw) {
            const bool isctx = r >= NLAT; const int b = isctx ? (r - NLAT) / CTXL : r / SEQ; const int t = isctx ? (r - NLAT) % CTXL : r % SEQ;
            const bf16* ur = U + (size_t)r * INW;
            const v4u wq = ((const v4u*)ur)[F.lane];
            const v4u wk = ((const v4u*)(ur + 512))[F.lane & 31];
            f32x4 c0 = {1.f, 1.f, 1.f, 1.f}, c1 = c0, s0 = {0.f, 0.f, 0.f, 0.f}, s1 = s0;
            if (!isctx) { const float* rc = RC + t * 32 + 8 * (F.lane & 3); const float* rs = RS + t * 32 + 8 * (F.lane & 3);
                c0 = *(const f32x4*)rc; c1 = *(const f32x4*)(rc + 4); s0 = *(const f32x4*)rs; s1 = *(const f32x4*)(rs + 4); }
            const size_t krow = (size_t)b * KEYS + (isctx ? t : CTXL + t);
#pragma unroll
            for (int part = 0; part < 2; ++part) {
                const v4u w = part ? wk : wq;
                float x[8] = {bflo(w.x), bfhi(w.x), bflo(w.y), bfhi(w.y), bflo(w.z), bfhi(w.z), bflo(w.w), bfhi(w.w)};
                float ss = 0.f;
#pragma unroll
                for (int i = 0; i < 8; ++i) ss += x[i] * x[i];
                ss += __shfl_xor(ss, 1); ss += __shfl_xor(ss, 2); ss += __shfl_xor(ss, 4);
                const float rstd = 1.0f / sqrtf(ss * (1.0f / 64.0f) + EPSN);
                const f32x4 g0 = part ? kg0 : qg0, g1 = part ? kg1 : qg1;
                float y[8], o[8];
#pragma unroll
                for (int i = 0; i < 8; ++i) y[i] = x[i] * rstd * (i < 4 ? g0[i] : g1[i - 4]);
#pragma unroll
                for (int i = 0; i < 8; ++i) { const float p = __shfl_xor(y[i], 4); const float cs = i < 4 ? c0[i] : c1[i - 4], sn = i < 4 ? s0[i] : s1[i - 4];
                    o[i] = lohalf ? (y[i] * cs - p * sn) : (y[i] * cs + p * sn); }
                if (part == 0) { v4u ow; ow.x = pk2(o[0] * C2, o[1] * C2); ow.y = pk2(o[2] * C2, o[3] * C2); ow.z = pk2(o[4] * C2, o[5] * C2); ow.w = pk2(o[6] * C2, o[7] * C2);
                    ((v4u*)(Q + (size_t)r * 512))[F.lane] = ow; }
                else { v4u ow; ow.x = pk2(o[0], o[1]); ow.y = pk2(o[2], o[3]); ow.z = pk2(o[4], o[5]); ow.w = pk2(o[6], o[7]);
                    if (F.lane < 16) ((v4u*)(K + krow * 128))[F.lane] = ow;
                    else if (F.lane < 32) ((v4u*)(V + krow * 128))[F.lane - 16] = wk; }
            }
        }
    }
    {
        bf16* XL = (bf16*)(F.ws + WS_XL);
        for (int idx = blockIdx.x * NTHR + F.tid; idx < MT * 32; idx += F.G * NTHR) {
            const int r = idx >> 5, c8 = (idx & 31) * 8;
            const bool isctx = r >= NLAT; const int Ls = isctx ? CTXL : SEQ; const int t = isctx ? (r - NLAT) % CTXL : r % SEQ;
            float acc[8];
#pragma unroll
            for (int i = 0; i < 8; ++i) acc[i] = lru_cb[l * 256 + c8 + i];
#pragma unroll
            for (int j = 0; j < 4; ++j) { const int tj = t + j - 2;
                if (tj >= 0 && tj < Ls) { const v4u w = *(const v4u*)(U + (size_t)(r + j - 2) * INW + 768 + c8);
                    const f32x4 w0 = *(const f32x4*)(lru_cw + (l * 4 + j) * 256 + c8), w1 = *(const f32x4*)(lru_cw + (l * 4 + j) * 256 + c8 + 4);
                    acc[0] += w0.x * bflo(w.x); acc[1] += w0.y * bfhi(w.x); acc[2] += w0.z * bflo(w.y); acc[3] += w0.w * bfhi(w.y);
                    acc[4] += w1.x * bflo(w.z); acc[5] += w1.y * bfhi(w.z); acc[6] += w1.z * bflo(w.w); acc[7] += w1.w * bfhi(w.w); } }
            v4u o; o.x = pk2(acc[0], acc[1]); o.y = pk2(acc[2], acc[3]); o.z = pk2(acc[4], acc[5]); o.w = pk2(acc[6], acc[7]);
            *(v4u*)(XL + (size_t)r * 256 + c8) = o;
        }
    }
    __syncthreads();
    {
        LAS bf16* hs = (LAS bf16*)(F.lds);
        bf16* VT = (bf16*)(F.ws + WS_VT); bf16* X0T = (bf16*)(F.ws + WS_X0T);
        const float* cw = hy_cw + (size_t)l * 3 * 768; const float* cbp = hy_cb + l * 768;
        for (int it = blockIdx.x; it < NLAT / 64; it += F.G) {
            const int b = it >> 7, t0 = (it & 127) * 64;
            for (int i = F.tid; i < 66 * 384; i += NTHR) { const int rr = i / 384, c2 = i - rr * 384; const int t = t0 - 1 + rr;
                unsigned w = 0u; if (t >= 0 && t < SEQ) w = *(const unsigned*)(U + (size_t)(b * SEQ + t) * INW + 1280 + 2 * c2);
                *(LAS unsigned*)(hs + rr * 770 + 2 * c2) = w; }
            __syncthreads();
            for (int c = F.wave; c < 256; c += NWAVES) {
                const int tt = F.lane;
                float o[3];
#pragma unroll
                for (int g = 0; g < 3; ++g) { const int cc = g * 256 + c;
                    o[g] = cw[cc] * bf2f(hs[tt * 770 + cc]) + cw[768 + cc] * bf2f(hs[(tt + 1) * 770 + cc]) + cw[1536 + cc] * bf2f(hs[(tt + 2) * 770 + cc]) + cbp[cc]; }
                const size_t oi = ((size_t)b * 256 + c) * SEQ + t0 + tt;
                VT[oi] = (bf16)f2bf(o[2] * o[1]); X0T[oi] = (bf16)f2bf(o[0]);
            }
            __syncthreads();
        }
    }
}


__device__ __forceinline__ int chunk_row0(int b, int d, int k) {
    if (k < 2) { const int cc = d ? 1 - k : k; return NLAT + b * CTXL + cc * CHUNK; }
    const int lc = d ? 63 - (k - 2) : (k - 2); return b * SEQ + lc * CHUNK;
}
__device__ __forceinline__ void ph_scan1(const Frame& F) {
    const bf16* LAB = (const bf16*)(F.ws + WS_LAB); float* SUMP = (float*)(F.ws + WS_SCANS); float* SUMH = SUMP + NB * 2 * NCHUNK * 256;
    for (int it = blockIdx.x * NTHR + F.tid; it < NB * 2 * NCHUNK * 256; it += F.G * NTHR) {
        const int ch = it & 255, k = (it >> 8) % NCHUNK, bd = (it >> 8) / NCHUNK, d = bd & 1, b = bd >> 1;
        const int r0 = chunk_row0(b, d, k);
        const bf16* LA = LAB + (size_t)(2 * d) * LAB_STRIDE + ch; const bf16* LB = LAB + (size_t)(2 * d + 1) * LAB_STRIDE + ch;
        float h = 0.f, Ps = 0.f;
#pragma unroll 16
        for (int i = 0; i < CHUNK; ++i) { const int r = d ? r0 + CHUNK - 1 - i : r0 + i; const float la = bf2f(LA[(size_t)r * 256]), bx = bf2f(LB[(size_t)r * 256]); h = __builtin_amdgcn_exp2f(la) * h + bx; Ps += la; }
        SUMP[it] = __builtin_amdgcn_exp2f(Ps); SUMH[it] = h;
    }
}
__device__ __forceinline__ void ph_scan2(const Frame& F) {
    const bf16* LAB = (const bf16*)(F.ws + WS_LAB); const float* SUMP = (const float*)(F.ws + WS_SCANS); const float* SUMH = SUMP + NB * 2 * NCHUNK * 256;
    float* LRUO = (float*)(F.ws + WS_LRUO); const bf16* U = (const bf16*)(F.ws + WS_U);
    for (int it = blockIdx.x * NTHR + F.tid; it < NB * NCHUNK * 256; it += F.G * NTHR) {
        const int ch = it & 255, kc = (it >> 8) % NCHUNK, b = (it >> 8) / NCHUNK;
        const int r0 = chunk_row0(b, 0, kc);
#pragma unroll 1
        for (int d = 0; d < 2; ++d) {
            const int k = d ? ((kc < 2) ? 1 - kc : 2 + 63 - (kc - 2)) : kc;
            const size_t sb = (size_t)((b * 2 + d) * NCHUNK) * 256 + ch;
            float h = 0.f;
#pragma unroll 8
            for (int j = 0; j < k; ++j) h = SUMP[sb + (size_t)j * 256] * h + SUMH[sb + (size_t)j * 256];
            const bf16* LA = LAB + (size_t)(2 * d) * LAB_STRIDE + ch; const bf16* LB = LAB + (size_t)(2 * d + 1) * LAB_STRIDE + ch;
            if (d == 0) {
#pragma unroll 16
                for (int i = 0; i < CHUNK; ++i) { const int r = r0 + i; h = __builtin_amdgcn_exp2f(bf2f(LA[(size_t)r * 256])) * h + bf2f(LB[(size_t)r * 256]); LRUO[(size_t)r * 256 + ch] = h; }
            } else {
#pragma unroll 8
                for (int i = 0; i < CHUNK; ++i) { const int r = r0 + CHUNK - 1 - i; h = __builtin_amdgcn_exp2f(bf2f(LA[(size_t)r * 256])) * h + bf2f(LB[(size_t)r * 256]);
                    const float lg = bf2f(U[(size_t)r * INW + 1024 + ch]);
                    LRUO[(size_t)r * 256 + ch] = (LRUO[(size_t)r * 256 + ch] + h) * gelu_tanh(lg); }
            }
        }
    }
}

__device__ __forceinline__ void ph_hyena_fft(const Frame& F, int l, const float* hy_bias) {
    LAS f32x2v* D = (LAS f32x2v*)(F.lds);
    const c32* KHAT = (const c32*)(F.ws + WS_KHAT) + (size_t)l * 256 * 16384;
    const bf16* VT = (const bf16*)(F.ws + WS_VT); const bf16* X0T = (const bf16*)(F.ws + WS_X0T); bf16* HYO = (bf16*)(F.ws + WS_HYO);
    for (int it = blockIdx.x; it < 512; it += F.G) {
        const int c = it >> 1, bp = it & 1;
        const bf16* va = VT + ((size_t)(bp * 2) * 256 + c) * SEQ; const bf16* vb = VT + ((size_t)(bp * 2 + 1) * 256 + c) * SEQ;
#ifndef REP_FFT
#define REP_FFT 1
#endif
#pragma unroll 1
        for (int repf_ = 0; repf_ < REP_FFT; ++repf_) {
#pragma unroll 1
        for (int i = 0; i < 8; ++i) { const int j = F.tid + 512 * i; c32 x0, x1, z; x0.x = bf2f(va[j]); x0.y = bf2f(vb[j]); x1.x = bf2f(va[j + 4096]); x1.y = bf2f(vb[j + 4096]); z.x = 0.f; z.y = 0.f;
            fft_first4(D, j, x0, x1, z, z); }
        __syncthreads();
        _Pragma("unroll 1") for (int g_ = F.tid; g_ < 1024; g_ += 512) fft_fwd16(D, g_, 4096);
        __syncthreads();
        _Pragma("unroll 1") for (int g_ = F.tid; g_ < 1024; g_ += 512) fft_fwd16(D, g_, 256);
        __syncthreads();
        _Pragma("unroll 1") for (int g_ = F.tid; g_ < 1024; g_ += 512) fft_mid16(D, g_, KHAT + (size_t)c * 16384);
        __syncthreads();
        _Pragma("unroll 1") for (int g_ = F.tid; g_ < 1024; g_ += 512) fft_inv16(D, g_, 256);
        __syncthreads();
        _Pragma("unroll 1") for (int g_ = F.tid; g_ < 1024; g_ += 512) fft_inv16(D, g_, 4096);
        __syncthreads();
        }
        const float bias = hy_bias[l * 256 + c];
        const bf16* xa = X0T + ((size_t)(bp * 2) * 256 + c) * SEQ; const bf16* xb = X0T + ((size_t)(bp * 2 + 1) * 256 + c) * SEQ;
        bf16* oa = HYO + ((size_t)(bp * 2) * 256 + c) * SEQ; bf16* ob = HYO + ((size_t)(bp * 2 + 1) * 256 + c) * SEQ;
#pragma unroll 2
        for (int i = 0; i < 8; ++i) { const int j = F.tid + 512 * i; c32 u0, u1; fft_final4(D, j, u0, u1);
            oa[j] = (bf16)f2bf((u0.x + bf2f(va[j]) * bias) * bf2f(xa[j]));                 ob[j] = (bf16)f2bf((-u0.y + bf2f(vb[j]) * bias) * bf2f(xb[j]));
            oa[j + 4096] = (bf16)f2bf((u1.x + bf2f(va[j + 4096]) * bias) * bf2f(xa[j + 4096])); ob[j + 4096] = (bf16)f2bf((-u1.y + bf2f(vb[j + 4096]) * bias) * bf2f(xb[j + 4096])); }
        __syncthreads();
    }
}
__device__ __forceinline__ void ph_hyena_ctx(const Frame& F, const float* hy_bias, const float* hy_cw, const float* hy_cb) {
    float* HYO = (float*)(F.ws + WS_HYO);
    {

        const bf16* U = (const bf16*)(F.ws + WS_U); const float* KFC = (const float*)(F.ws + WS_KFC);
        LAS float* vw = (LAS float*)(F.lds + F.wave * 4096);
        LAS float* kw = vw + 256;
        const float* cw = hy_cw; const float* cbp = hy_cb;
        for (int it = F.gw; it < NB * 256; it += F.ngw) {
            const int b = it >> 8, c = it & 255;
            float x0v[4];
#pragma unroll
            for (int i = 0; i < 4; ++i) { const int t = F.lane + 64 * i;
                float o[3];
#pragma unroll
                for (int g = 0; g < 3; ++g) { const int cc = g * 256 + c; float a = cbp[cc];
#pragma unroll
                    for (int j = 0; j < 3; ++j) { const int tj = t + j - 1; if (tj >= 0 && tj < CTXL) a += cw[j * 768 + cc] * bf2f(U[(size_t)(NLAT + b * CTXL + tj) * INW + 1280 + cc]); }
                    o[g] = a; }
                vw[t] = o[2] * o[1]; x0v[i] = o[0]; }
#pragma unroll
            for (int i = 0; i < 8; ++i) kw[F.lane + 64 * i] = KFC[c * 512 + F.lane + 64 * i];
            LDS_WAIT();
            float y[4] = {0.f, 0.f, 0.f, 0.f};
#pragma unroll 4
            for (int s = 0; s < CTXL; ++s) { const float vv = vw[s];
#pragma unroll
                for (int i = 0; i < 4; ++i) y[i] += kw[(F.lane + 64 * i - s) & 511] * vv; }
            const float bias = hy_bias[c];
#pragma unroll
            for (int i = 0; i < 4; ++i) { const int t = F.lane + 64 * i; HYO[(size_t)(NLAT + b * CTXL + t) * 256 + c] = (y[i] + vw[t] * bias) * x0v[i]; }
            LDS_WAIT();
        }
    }
}

__device__ __forceinline__ void merge_row(const Frame& F, int r, const float* g, float h0, float h1, float h2, float h3) {
    const bf16* ATT = (const bf16*)(F.ws + WS_ATT); const float* LRUO = (const float*)(F.ws + WS_LRUO); bf16* MIXA = (bf16*)(F.ws + WS_MIXA);
    const v4u aw = ((const v4u*)(ATT + (size_t)r * 512))[F.lane];
    float a[8] = {bflo(aw.x), bfhi(aw.x), bflo(aw.y), bfhi(aw.y), bflo(aw.z), bfhi(aw.z), bflo(aw.w), bfhi(aw.w)};
    float ss = 0.f;
#pragma unroll
    for (int i = 0; i < 8; ++i) ss += a[i] * a[i];
    const float ra = 1.0f / sqrtf(wave_sum(ss) * (1.0f / 512.0f) + EPSN);
    const f32x4 lv = ((const f32x4*)(LRUO + (size_t)r * 256))[F.lane];
    const float rl = 1.0f / sqrtf(wave_sum(lv.x * lv.x + lv.y * lv.y + lv.z * lv.z + lv.w * lv.w) * (1.0f / 256.0f) + EPSN);
    const float rh = 1.0f / sqrtf(wave_sum(h0 * h0 + h1 * h1 + h2 * h2 + h3 * h3) * (1.0f / 256.0f) + EPSN);
    bf16* orow = MIXA + (size_t)r * 1024;
    { const f32x4 g0 = ((const f32x4*)g)[2 * F.lane], g1 = ((const f32x4*)g)[2 * F.lane + 1];
      v4u o; o.x = pk2(a[0] * ra * g0.x, a[1] * ra * g0.y); o.y = pk2(a[2] * ra * g0.z, a[3] * ra * g0.w); o.z = pk2(a[4] * ra * g1.x, a[5] * ra * g1.y); o.w = pk2(a[6] * ra * g1.z, a[7] * ra * g1.w);
      ((v4u*)orow)[F.lane] = o; }
    { const f32x4 gg = ((const f32x4*)(g + 512))[F.lane]; v2u o; o.x = pk2(lv.x * rl * gg.x, lv.y * rl * gg.y); o.y = pk2(lv.z * rl * gg.z, lv.w * rl * gg.w); ((v2u*)(orow + 512))[F.lane] = o; }
    orow[768 + F.lane] = (bf16)f2bf(h0 * rh * g[768 + F.lane]); orow[832 + F.lane] = (bf16)f2bf(h1 * rh * g[832 + F.lane]);
    orow[896 + F.lane] = (bf16)f2bf(h2 * rh * g[896 + F.lane]); orow[960 + F.lane] = (bf16)f2bf(h3 * rh * g[960 + F.lane]);
}
__device__ __forceinline__ void ph_merge(const Frame& F, int l, int nrows, const float* out_g) {
    const float* HYO = (const float*)(F.ws + WS_HYO);
    const float* g = out_g + l * 1024;
    LAS float* tile = (LAS float*)(F.lds);
    for (int it = blockIdx.x; it < NLAT / 64; it += F.G) {
        const int b = it >> 7, t0 = (it & 127) * 64;
#pragma unroll 8
        for (int i = 0; i < 32; ++i) { const int c = F.wave * 32 + i; tile[c * 65 + F.lane] = bf2f(((const bf16*)HYO)[((size_t)b * 256 + c) * SEQ + t0 + F.lane]); }
        __syncthreads();
#pragma unroll 2
        for (int k = 0; k < 8; ++k) { const int tt = F.wave * 8 + k;
            merge_row(F, b * SEQ + t0 + tt, g, tile[F.lane * 65 + tt], tile[(F.lane + 64) * 65 + tt], tile[(F.lane + 128) * 65 + tt], tile[(F.lane + 192) * 65 + tt]); }
        __syncthreads();
    }
    for (int r = NLAT + F.gw; r < nrows; r += F.ngw) {
        const float* hr = HYO + (size_t)r * 256;
        merge_row(F, r, g, hr[F.lane], hr[64 + F.lane], hr[128 + F.lane], hr[192 + F.lane]);
    }
}


__device__ __forceinline__ void ph_ffn_router(const Frame& F, int l, int nrows, const float* router_w) {
    LAS float* rwl = (LAS float*)(F.lds);
    LAS float* cbl = (LAS float*)(F.lds + 147456);
    LAS int* hist = (LAS int*)(F.lds + 147456 + 640);
    const bf16* XR = (const bf16*)(F.ws + WS_XR); const float* RSSP = (const float*)(F.ws + WS_RSSP); const float* MOD = (const float*)(F.ws + WS_MOD);
    const float* GC = (const float*)(F.ws + WS_GC) + (size_t)l * 5 * 1024; bf16* Fb = (bf16*)(F.ws + WS_F);
    int* TOPI = (int*)(F.ws + WS_TOPI); float* GATE = (float*)(F.ws + WS_GATE); int* BLKCNT = (int*)(F.ws + WS_BLKCNT);
    for (int i = F.tid; i < 1024 * 32; i += NTHR) rwl[(i >> 5) * 36 + (i & 31)] = router_w[(size_t)l * 32768 + i];
    if (F.tid < 32) hist[F.tid] = 0;
    if (F.tid < 160) cbl[F.tid] = ((const float*)(F.ws + WS_CB))[l * 160 + F.tid];
    __syncthreads();
    const int j = F.lane & 15, kq = F.lane >> 4;
    for (int grp = F.gw; grp < nrows / 16; grp += F.ngw) {
        const int r0 = grp * 16, r = r0 + j; const int bidx = r0 < NLAT ? r0 / SEQ : 4;
        const bf16* xrow = XR + (size_t)r * 1024 + 4 * kq; const float* gcp = GC + bidx * 1024 + 4 * kq; const float* sfp = MOD + (size_t)(l * 5 + bidx) * 6144 + 3 * 1024 + 4 * kq;
        bf16* frow = Fb + (size_t)r * 1024 + 4 * kq;
        float ss; { const f32x4 q = *(const f32x4*)(RSSP + (size_t)r * 16 + 4 * kq); ss = (q.x + q.y) + (q.z + q.w); }
        ss += __shfl_xor(ss, 16); ss += __shfl_xor(ss, 32);
        const float rstd = 1.0f / sqrtf(ss * (1.0f / 1024.0f) + EPSN);
        f32x4 acc0 = {0.f, 0.f, 0.f, 0.f}, acc1 = acc0;
#pragma unroll 1
        for (int ib = 0; ib < 64; ib += 8) {
            v2u xw[8]; f32x4 g4[8], s4[8];
#pragma unroll
            for (int u = 0; u < 8; ++u) { xw[u] = *(const v2u*)(xrow + 16 * (ib + u)); g4[u] = *(const f32x4*)(gcp + 16 * (ib + u)); s4[u] = *(const f32x4*)(sfp + 16 * (ib + u)); }
#pragma unroll
            for (int u = 0; u < 8; ++u) {
                const f32x4 x4 = {bflo(xw[u].x), bfhi(xw[u].x), bflo(xw[u].y), bfhi(xw[u].y)};
                const f32x4 xb = x4 * g4[u];
                const f32x4 fv = xb * rstd + s4[u];
                v2u o; o.x = pk2(fv.x, fv.y); o.y = pk2(fv.z, fv.w); *(v2u*)(frow + 16 * (ib + u)) = o;
                const LAS float* wp = rwl + (16 * (ib + u) + 4 * kq) * 36 + j;
#pragma unroll
                for (int e = 0; e < 4; ++e) { acc0 = __builtin_amdgcn_mfma_f32_16x16x4f32(wp[e * 36], xb[e], acc0, 0, 0, 0); acc1 = __builtin_amdgcn_mfma_f32_16x16x4f32(wp[e * 36 + 16], xb[e], acc1, 0, 0, 0); }
            }
        }
        float lg[8];
#pragma unroll
        for (int rr = 0; rr < 4; ++rr) { lg[rr] = rstd * acc0[rr] + cbl[bidx * 32 + 4 * kq + rr]; lg[4 + rr] = rstd * acc1[rr] + cbl[bidx * 32 + 16 + 4 * kq + rr]; }
        float p[32];
#pragma unroll
        for (int e = 0; e < 32; ++e) p[e] = __shfl(lg[(e >> 4) * 4 + (e & 3)], j + 16 * ((e & 15) >> 2));
        unsigned taken = 0u; float tv[4]; int ti[4];
#pragma unroll
        for (int k = 0; k < 4; ++k) { float best = -INFINITY; int bi = 0;
#pragma unroll
            for (int e = 0; e < 32; ++e) { const bool ok = !((taken >> e) & 1u) && (p[e] > best); best = ok ? p[e] : best; bi = ok ? e : bi; }
            taken |= 1u << bi; tv[k] = best; ti[k] = bi; }
        const float e1 = __expf(tv[1] - tv[0]), e2 = __expf(tv[2] - tv[0]), e3 = __expf(tv[3] - tv[0]); const float inv = 1.0f / (1.0f + e1 + e2 + e3);
        if (kq == 0) {
            TOPI[r * 4 + 0] = ti[0]; TOPI[r * 4 + 1] = ti[1]; TOPI[r * 4 + 2] = ti[2]; TOPI[r * 4 + 3] = ti[3];
            GATE[r * 4 + 0] = inv; GATE[r * 4 + 1] = e1 * inv; GATE[r * 4 + 2] = e2 * inv; GATE[r * 4 + 3] = e3 * inv;
            lds_add(&hist[ti[0]], 1); lds_add(&hist[ti[1]], 1); lds_add(&hist[ti[2]], 1); lds_add(&hist[ti[3]], 1);
        }
    }
    __syncthreads();
    if (F.tid < 32) BLKCNT[blockIdx.x * 32 + F.tid] = hist[F.tid];
}

__device__ __forceinline__ void ph_route(const Frame& F, int nrows) {
    LAS int* cursor = (LAS int*)(F.lds);
    LAS int* tot = cursor + 32;
    LAS int* mine = cursor + 64;
    LAS int* part = cursor + 96;
    LAS int* ebase = cursor + 96 + 1024;
    const int* BLKCNT = (const int*)(F.ws + WS_BLKCNT); const int* TOPI = (const int*)(F.ws + WS_TOPI); int* POS = (int*)(F.ws + WS_POS);
    int* ROWTOK = (int*)(F.ws + WS_ROWTOK); int* TILEE = (int*)(F.ws + WS_TILEE);
    { const int e = F.tid & 31, sl = F.tid >> 5; int t = 0, m = 0;
      for (int b = sl; b < F.G; b += 16) { const int v = BLKCNT[b * 32 + e]; t += v; m += (b < (int)blockIdx.x) ? v : 0; }
      part[sl * 64 + e] = t; part[sl * 64 + 32 + e] = m;
      __syncthreads();
      if (F.tid < 32) { int tt = 0, mm = 0;
#pragma unroll
          for (int s = 0; s < 16; ++s) { tt += part[s * 64 + F.tid]; mm += part[s * 64 + 32 + F.tid]; }
          tot[F.tid] = tt; mine[F.tid] = mm; } }
    __syncthreads();
    if (F.tid == 0) { int tb = 0;
        for (int e = 0; e < 32; ++e) { const int nt = (tot[e] + 255) >> 8; cursor[e] = tb * 256 + mine[e]; ebase[e] = tb * 256;
            if (blockIdx.x == 0) for (int j = 0; j < nt; ++j) TILEE[tb + j] = e;
            tb += nt; }
        ebase[32] = tb * 256;
        if (blockIdx.x == 0) F.ctl[CW_NTILES] = (unsigned)tb; }
    __syncthreads();
    for (int e = blockIdx.x; e < 32; e += F.G) for (int p = ebase[e] + tot[e] + F.tid; p < ebase[e + 1]; p += NTHR) ROWTOK[p] = 0;
    const int sub = F.lane >> 2, k = F.lane & 3;
    for (int grp = F.gw; grp < nrows / 16; grp += F.ngw) {
        const int r = grp * 16 + sub; const int e = TOPI[r * 4 + k]; const int pos = lds_add(&cursor[e], 1); POS[r * 4 + k] = pos; ROWTOK[pos] = r; }
}

__device__ __forceinline__ void ph_combine(const Frame& F, int l, int nrows, float* out, const float* gmix) {
    bf16* XR = (bf16*)(F.ws + WS_XR); const float* MOD = (const float*)(F.ws + WS_MOD); const bf16* YS = (const bf16*)(F.ws + WS_YS); bf16* H = (bf16*)(F.ws + WS_H);
    const int* POS = (const int*)(F.ws + WS_POS); const float* GATE = (const float*)(F.ws + WS_GATE);
    for (int r = F.gw; r < nrows; r += F.ngw) {
        const int bidx = r < NLAT ? r / SEQ : 4;
        const float* gf = MOD + (size_t)(l * 5 + bidx) * 6144 + 5 * 1024;
        int pos = 0; float gt = 0.f;
        if (F.lane < 4) { pos = POS[r * 4 + F.lane]; gt = GATE[r * 4 + F.lane]; }
        f32x4 y[4];
#pragma unroll
        for (int j = 0; j < 4; ++j) y[j] = (f32x4){0.f, 0.f, 0.f, 0.f};
#pragma unroll
        for (int k = 0; k < 4; ++k) { const int pk = __shfl(pos, k); const float gk = __shfl(gt, k); const v2u* yr = (const v2u*)(YS + (size_t)pk * 1024);
#pragma unroll
            for (int j = 0; j < 4; ++j) { const v2u w = yr[64 * j + F.lane]; y[j].x += gk * bflo(w.x); y[j].y += gk * bfhi(w.x); y[j].z += gk * bflo(w.y); y[j].w += gk * bfhi(w.y); } }
        float ss = 0.f;
#pragma unroll
        for (int j = 0; j < 4; ++j) { const int cb = 64 * j + F.lane; const v2u xw = ((const v2u*)(XR + (size_t)r * 1024))[cb]; const f32x4 xv = {bflo(xw.x), bfhi(xw.x), bflo(xw.y), bfhi(xw.y)}; const f32x4 gv = ((const f32x4*)gf)[cb];
            y[j] = xv + gv * y[j];
            if (l == 0) { v2u o; o.x = pk2(y[j].x, y[j].y); o.y = pk2(y[j].z, y[j].w); ((v2u*)(XR + (size_t)r * 1024))[cb] = o; } else ((f32x4*)(out + (size_t)r * 1024))[cb] = y[j];
            ss += (y[j].x * y[j].x + y[j].y * y[j].y) + (y[j].z * y[j].z + y[j].w * y[j].w); }
        if (l == 0) {
            const float rstd = 1.0f / sqrtf(wave_sum(ss) * (1.0f / 1024.0f) + EPSN);
            const float* shift = MOD + (size_t)(5 + bidx) * 6144; const float* scale = shift + 1024; const float* g = gmix + 1024;
#pragma unroll
            for (int j = 0; j < 4; ++j) { const int cb = 64 * j + F.lane; const f32x4 gg = ((const f32x4*)g)[cb], sc = ((const f32x4*)scale)[cb], sh = ((const f32x4*)shift)[cb];
                const f32x4 hv = y[j] * rstd * gg * (sc + 1.0f) + sh;
                v2u o; o.x = pk2(hv.x, hv.y); o.y = pk2(hv.z, hv.w); ((v2u*)(H + (size_t)r * 1024))[cb] = o; }
        }
    }
}

struct Args { const float* in[34]; float* out; unsigned char* ws; int ph_lo, ph_hi; };
enum { I_X = 0, I_C, I_CTX, I_CCTX, I_WMOD, I_BMOD, I_GMIX, I_GFFN, I_WIN, I_QG, I_KG, I_LCW, I_LCB, I_LGW, I_LGB, I_LLAM, I_HCW, I_HCB, I_HW1, I_HB1, I_HW2, I_HB2, I_HW3, I_HFREQ, I_HDEC, I_HBIAS,
       I_OUTG, I_WOUT, I_RW, I_RB, I_MW1, I_MB1, I_MW2, I_MB2 };

__global__ void __launch_bounds__(NTHR, 2) mk_fwd(Args args) {
    extern __shared__ __attribute__((aligned(16))) unsigned char lds[];
    Frame F;
    F.lds = (LAS unsigned char*)lds; F.ws = args.ws; F.ctl = (unsigned*)(args.ws + WS_CTL);
    F.tid = threadIdx.x; F.lane = F.tid & 63; F.wave = __builtin_amdgcn_readfirstlane(F.tid >> 6);
    F.G = gridDim.x; { const int bx = blockIdx.x; F.vcu = (F.G % 8 == 0) ? (bx % 8) * (F.G / 8) + bx / 8 : bx; }
    F.gw = (int)blockIdx.x * NWAVES + F.wave; F.ngw = F.G * NWAVES;
    for (int u = F.tid; u < (LDS_BYTES - LDSCTL_OFF) / 4; u += NTHR) ((LAS unsigned*)(F.lds + LDSCTL_OFF))[u] = 0u;
    __syncthreads();
#if !MK_PER_PHASE
    XcdBarrier bar = xcd_barrier_post(F.ctl + CW_BAR, (volatile LAS unsigned*)(F.lds + LDSCTL_OFF + 32));
#define GRID_BAR() xcd_barrier(bar)
#else
#define GRID_BAR() do { } while (0)
#endif
    const int lo = args.ph_lo, hi = args.ph_hi;
#ifndef ONLY_PHASE
#define ONLY_PHASE (-1)
#endif
#define ENABLED(id) (ONLY_PHASE < 0 || ONLY_PHASE == (id))
#define IN(k) (ENABLED(k) && lo <= (k) && (k) < hi)
#define INL(j) (ENABLED(NPH_PRO + (j)) && lo <= pb + (j) && pb + (j) < hi)
#define SEAML(j) do { if (lo <= pb + (j) && pb + (j) + 1 < hi) { GRID_BAR(); } } while (0)
typedef const __attribute__((address_space(4))) Args* KArgs;
#ifndef REP_MASK
#define REP_MASK 0
#endif
#define NREP(j) (((REP_MASK >> (j)) & 1) ? 2 : 1)
#define REFRAME() Frame Fp = F; KArgs ka = (KArgs)__builtin_amdgcn_kernarg_segment_ptr(); { int t_ = F.tid; asm volatile("" : "+v"(t_), "+s"(ka)); Fp.tid = t_; Fp.lane = t_ & 63; Fp.wave = __builtin_amdgcn_readfirstlane(t_ >> 6); \
    Fp.gw = (int)blockIdx.x * NWAVES + Fp.wave; Fp.ws = ka->ws; Fp.ctl = (unsigned*)(ka->ws + WS_CTL); }
#define SEAM(k) do { if (lo <= (k) && (k) + 1 < hi) { GRID_BAR(); } } while (0)

    if (IN(0)) ph_prologue_a(F, args.in[I_C], args.in[I_CCTX], args.in[I_WMOD], args.in[I_BMOD], args.in[I_WIN], args.in[I_WOUT], args.in[I_MW1], args.in[I_MW2],
                             args.in[I_HW1], args.in[I_HB1], args.in[I_HW2], args.in[I_HB2], args.in[I_HFREQ], args.in[I_LGW], args.in[I_LLAM]);
    SEAM(0);
    if (IN(1)) ph_prologue_b(F, args.in[I_HW3], args.in[I_HDEC], args.in[I_GFFN], args.in[I_RW], args.in[I_RB]);
    SEAM(1);

#ifndef MOE_WGM1
#define MOE_WGM1 4
#endif
#ifndef MOE_WGM2
#define MOE_WGM2 8
#endif
#define PHASE(j, ...) if (INL(j)) { _Pragma("unroll") for (int rep_ = 0; rep_ < NREP(j); ++rep_) { { REFRAME(); __VA_ARGS__ } if (rep_ + 1 < NREP(j)) GRID_BAR(); } }
#define LAYER_BODY(l) { \
        const int pb = NPH_PRO + l * NPH_LAYER; \
        const int nrows = (l == 0) ? MT : NLAT; \
        if (l == 0) { PHASE(0, ph_norm_mod(Fp, l, ka->in[I_X], ka->in[I_CTX], ka->in[I_GMIX]);) SEAML(0); } \
        PHASE(1, \
            pg8::Gemm g{(const bf16*)(Fp.ws + WS_H), (const bf16*)(Fp.ws + WS_WINT) + (size_t)l * 2048 * 1024, MT, 2048, 1024}; \
            pg8::StaticOrder S; S.init(MT, 2048, Fp.G, (int)blockIdx.x); \
            pg8::EpiBf16<0> E{(bf16*)(Fp.ws + WS_U), 2048, nullptr, 0, 0, 1.f}; \
            pg8::gemm_phase<pg8::EpiBf16<0>, pg8::StaticOrder, PG8_ALIGN, PG8_SP2>(Fp.lds + RING_OFF, g, S, E);) \
        SEAML(1); \
        PHASE(2, ph_post_proj(Fp, l, ka->in[I_QG], ka->in[I_KG], ka->in[I_LCW], ka->in[I_LCB], ka->in[I_HCW], ka->in[I_HCB]);) \
        SEAML(2); \
        PHASE(3, \
            int kg_ = 256; asm volatile("" : "+s"(kg_)); \
            pg8::Gemm g{(const bf16*)(Fp.ws + WS_XL), (const bf16*)(Fp.ws + WS_WGT) + (size_t)l * 1024 * 256, MT, 1024, kg_}; \
            pg8::StaticOrder S; S.init(MT, 1024, Fp.G, (int)blockIdx.x); \
            pg8::EpiLruGate E{(const bf16*)(Fp.ws + WS_XL), (bf16*)(Fp.ws + WS_LAB), LAB_STRIDE, ka->in[I_LGB] + (size_t)l * 1024, (const float*)(Fp.ws + WS_SPT) + l * 512}; \
            pg8::gemm_phase<pg8::EpiLruGate, pg8::StaticOrder, PG8_ALIGN, PG8_SP2>(Fp.lds + RING_OFF, g, S, E);) \
        SEAML(3); \
        PHASE(4, \
            ph_scan1(Fp); __syncthreads(); \
            const attn_body::AttnTensors AT{(const attn_body::bf16*)(Fp.ws + WS_Q), (const attn_body::bf16*)(Fp.ws + WS_K), (const attn_body::bf16*)(Fp.ws + WS_V), (attn_body::bf16*)(Fp.ws + WS_ATT)}; \
            attn_body::attn_phase<8>((char*)lds + RING_OFF, AT, Fp.G, Fp.vcu, l == 0, (long)NLAT);) \
        SEAML(4); \
        PHASE(5, ph_scan2(Fp); __syncthreads(); ph_hyena_fft(Fp, l, ka->in[I_HBIAS]); if (l == 0) ph_hyena_ctx(Fp, ka->in[I_HBIAS], ka->in[I_HCW], ka->in[I_HCB]);) \
        SEAML(5); \
        PHASE(6, ph_merge(Fp, l, nrows, ka->in[I_OUTG]);) \
        SEAML(6); \
        if (INL(7)) { REFRAME(); \
            pg8::Gemm g{(const bf16*)(Fp.ws + WS_MIXA), (const bf16*)(Fp.ws + WS_WOUTT) + (size_t)l * 1024 * 1024, nrows, 1024, 1024}; \
            pg8::StaticOrder S; S.init(nrows, 1024, Fp.G, (int)blockIdx.x); \
            bf16* XR = (bf16*)(Fp.ws + WS_XR); \
            pg8::EpiResid<(l) == 1> E{ka->in[I_X], ka->in[I_CTX], NLAT, XR, 1024, \
                            (const float*)(Fp.ws + WS_MOD) + (size_t)(l * 5) * 6144 + 2 * 1024, 6144, SEQ, (float*)(Fp.ws + WS_RSSP)}; \
            pg8::gemm_phase<pg8::EpiResid<(l) == 1>, pg8::StaticOrder, PG8_ALIGN, PG8_SP2>(Fp.lds + RING_OFF, g, S, E); \
        } \
        SEAML(7); \
        PHASE(8, ph_ffn_router(Fp, l, nrows, ka->in[I_RW]);) \
        SEAML(8); \
        PHASE(9, ph_route(Fp, nrows);) \
        SEAML(9); \
        if (INL(10) || INL(11)) { REFRAME(); \
            LAS int* tab = (LAS int*)(Fp.lds + MOETAB_OFF); \
            const int ntiles = (int)__hip_atomic_load(Fp.ctl + CW_NTILES, __ATOMIC_RELAXED, __HIP_MEMORY_SCOPE_AGENT); \
            const int* TILEE = (const int*)(Fp.ws + WS_TILEE); \
            for (int i = Fp.tid; i < ntiles && i < SORT_TILES; i += NTHR) tab[i] = TILEE[i]; \
            __syncthreads(); \
            if (INL(10)) { _Pragma("unroll") for (int rep_ = 0; rep_ < NREP(10); ++rep_) { { \
                pg8::Gemm g{(const bf16*)(Fp.ws + WS_F), (const bf16*)(Fp.ws + WS_W1T) + (size_t)l * 32 * 2048 * 1024, 0, 2048, 1024}; \
                pg8::MoeOrderT<true> S; S.init(tab, ntiles, 8, Fp.G, (int)blockIdx.x, MOE_WGM1); S.rowtok = (const int*)(Fp.ws + WS_ROWTOK); \
                pg8::EpiSwiglu E{(bf16*)(Fp.ws + WS_ACT), 1024, ka->in[I_MB1] + (size_t)l * 32 * 2048, 2048}; \
                pg8::gemm_phase<pg8::EpiSwiglu, pg8::MoeOrderT<true>, PG8_ALIGN, PG8_SP2>(Fp.lds + RING_OFF, g, S, E); \
             } if (rep_ + 1 < NREP(10)) GRID_BAR(); } } \
            SEAML(10); \
            if (INL(11)) { _Pragma("unroll") for (int rep_ = 0; rep_ < NREP(11); ++rep_) { { \
                pg8::Gemm g{(const bf16*)(Fp.ws + WS_ACT), (const bf16*)(Fp.ws + WS_W2T) + (size_t)l * 32 * 1024 * 1024, 0, 1024, 1024}; \
                pg8::MoeOrderT<false> S; S.init(tab, ntiles, 4, Fp.G, (int)blockIdx.x, MOE_WGM2); S.rowtok = nullptr; \
                pg8::EpiBf16Bias E{(bf16*)(Fp.ws + WS_YS), 1024, ka->in[I_MB2] + (size_t)l * 32 * 1024, 1024}; \
                pg8::gemm_phase<pg8::EpiBf16Bias, pg8::MoeOrderT<false>, PG8_ALIGN, PG8_SP2>(Fp.lds + RING_OFF, g, S, E); \
             } if (rep_ + 1 < NREP(11)) GRID_BAR(); } } \
        } \
        SEAML(11); \
        if (INL(12)) { REFRAME(); ph_combine(Fp, l, nrows, ka->out, ka->in[I_GMIX]); } \
        if (l == 0) { SEAML(12); } \
    }
    LAYER_BODY(0)
    LAYER_BODY(1)
#undef LAYER_BODY
#undef PHASE
#undef IN
#undef SEAM
#undef INL
#undef SEAML
}

extern "C" void kernel_launch(void* const* d_in, const int* in_sizes, int n_in, void* d_out, int out_size, void* d_ws, size_t ws_size, hipStream_t stream) {
    static int grid = 0;
    if (grid == 0) {
        if (n_in != 34 || in_sizes[0] != NLAT * DMODEL || out_size != NLAT * DMODEL || ws_size < WS_END) {
            fprintf(stderr, "kernel_launch: unexpected shapes (n_in %d, in0 %d, out %d, ws %zu); nothing launched\n", n_in, n_in > 0 ? in_sizes[0] : -1, out_size, ws_size); grid = -1; return; }
        int dev = 0, cus = 0;
        if (hipGetDevice(&dev) != hipSuccess || hipDeviceGetAttribute(&cus, hipDeviceAttributeMultiprocessorCount, dev) != hipSuccess) { grid = -1; return; }
        if (hipFuncSetAttribute((const void*)mk_fwd, hipFuncAttributeMaxDynamicSharedMemorySize, LDS_BYTES) != hipSuccess) { fprintf(stderr, "kernel_launch: hipFuncSetAttribute failed\n"); grid = -1; return; }
        int per_cu = 0;
        if (hipOccupancyMaxActiveBlocksPerMultiprocessor(&per_cu, (const void*)mk_fwd, NTHR, LDS_BYTES) != hipSuccess || per_cu < 1) { fprintf(stderr, "kernel_launch: occupancy query says %d\n", per_cu); }
        (void)hipGetLastError();
        grid = cus;
    }
    if (grid < 0) return;
    if (hipMemsetAsync((char*)d_ws + WS_CTL, 0, CTL_ZERO_BYTES, stream) != hipSuccess) return;
    Args a{};
    for (int i = 0; i < 34; ++i) a.in[i] = (const float*)d_in[i];
    a.out = (float*)d_out; a.ws = (unsigned char*)d_ws;
#if MK_PER_PHASE
    for (int p = 0; p < NPH; ++p) { a.ph_lo = p; a.ph_hi = p + 1; hipLaunchKernelGGL(mk_fwd, dim3(grid), dim3(NTHR), LDS_BYTES, stream, a); }
#else
    a.ph_lo = 0; a.ph_hi = NPH;
    hipLaunchKernelGGL(mk_fwd, dim3(grid), dim3(NTHR), LDS_BYTES, stream, a);
#endif
}
```

```cpp
#include <hip/hip_runtime.h>
#include <hip/hip_bf16.h>
#include <cstdio>
#include <cstdint>
#include <cmath>
#ifndef MK_PER_PHASE
#define MK_PER_PHASE 0
#endif
namespace pg8 {
#define PG8_LAS __attribute__((address_space(3)))
typedef unsigned short bf16_t;
typedef short bf16x8 __attribute__((ext_vector_type(8)));
typedef float f32x4 __attribute__((ext_vector_type(4)));
typedef unsigned u32x4 __attribute__((ext_vector_type(4)));
constexpr int BM = 256, BK = 64, HALF = 128, HTB = HALF * BK * 2  , STAGE_BYTES = 8 * HTB, NXCD = 8, WGM = 8;

__host__ __device__ __forceinline__ int lds_byte(int r, int c) { const int st = (r >> 4) * 2 + (c >> 5), rr = r & 15, cc = c & 31, ob = rr * 64 + cc * 2; return st * 1024 + (ob ^ (((ob >> 9) & 1) << 5)); }
__host__ __device__ __forceinline__ void stage_rc(int b, int& R, int& C) { const int st = b / 1024, sb = b % 1024, swz = sb ^ (((sb >> 9) & 1) << 5); R = (st >> 1) * 16 + swz / 64; C = (st & 1) * 32 + (swz % 64) / 2; }
__host__ __device__ __forceinline__ int perm32(int rho) { const int n = rho >> 4, i = rho & 15; return 8 * (i >> 2) + 4 * n + (i & 3); }

struct Unit { int pm, pn, be, e; };
struct Gemm { const bf16_t* A; const bf16_t* Bt; int M, N, K; };

struct StaticOrder {
    static constexpr bool GATHER = false;
    __device__ __forceinline__ int row_of(int r) const { return r; }
    int nM, nN, nwg, G, c;
    __host__ __device__ void init(int M, int N, int G_, int c_) { nM = M / BM; nN = N / BM; nwg = nM * nN; G = G_; c = c_; }
    __host__ __device__ bool next(int i, Unit& u) const {
        const long L = (long)i * G + c; if (L >= nwg) return false;
        int wgid = (int)L; { const int q = nwg / NXCD, r = nwg % NXCD, xcd = wgid % NXCD, off = wgid / NXCD; wgid = (xcd < r ? xcd * (q + 1) : r * (q + 1) + (xcd - r) * q) + off; }
        const int nig = WGM * nN, gid = wgid / nig, fm = gid * WGM, gsz = (nM - fm) < WGM ? (nM - fm) : WGM;
        u.pm = fm + ((wgid % nig) % gsz); u.pn = (wgid % nig) / gsz; u.be = u.pn; u.e = 0; return true;
    }
    __device__ __forceinline__ void a_ready(const Unit&) const {}
    __device__ __forceinline__ void done(const Unit&) const {}
};

__device__ __forceinline__ unsigned cvt_pk_bf16(float lo, float hi) { unsigned r; asm volatile("v_cvt_pk_bf16_f32 %0, %1, %2" : "=v"(r) : "v"(lo), "v"(hi)); return r; }
typedef float f32x2 __attribute__((ext_vector_type(2)));
__device__ __forceinline__ f32x2 gelu_pk(f32x2 v) {
    const f32x2 av = __builtin_elementwise_abs(v), d = av * 0.2316418882f + 1.0f;
    f32x2 t; t.x = __builtin_amdgcn_rcpf(d.x); t.y = __builtin_amdgcn_rcpf(d.y);
    f32x2 q = t * 0.5307027145f + (-0.7265760135f); q = q * t + 0.7107068705f; q = q * t + (-0.142248368f); q = q * t + 0.127414796f; q = q * t;
    const f32x2 s = (v * v) * (-0.72134752044f);
    f32x2 e; e.x = __builtin_amdgcn_exp2f(s.x); e.y = __builtin_amdgcn_exp2f(s.y);
    const f32x2 m = v * (q * e), r = v - m;
    f32x2 o; o.x = v.x < 0.f ? m.x : r.x; o.y = v.y < 0.f ? m.y : r.y; return o;
}

template <int ACT  > struct EpiBf16 {
    static constexpr bool PERM = true, AFTER_DRAIN = false; static_assert(ACT == 0 || ACT == 1, "EpiBf16: ACT is 0 (none) or 1 (gelu_pk)");
    bf16_t* O; int ldc; const float* bias; int split_cols; size_t split_stride; float scale0;
    struct Pre {}; __device__ __forceinline__ void preload(Pre&, const Unit&, int, int, int, int) const {}
    __device__ __forceinline__ void operator()(const f32x4 (&acc)[2][2][4][2], const Unit& u, int wr, int wc, int fr, int fq, const Pre&) const {
        const int row0 = u.pm * BM + wr * 64 + fr; int colt = u.pn * BM; bf16_t* base = O;
        float sc = 1.f; if (split_cols) { const int t = colt / split_cols; base += (size_t)t * split_stride; colt -= t * split_cols; if (t == 0) sc = scale0; }
        const int col0 = colt + wc * 32 + 8 * fq, bcol0 = u.pn * BM + wc * 32 + 8 * fq;
        f32x4 bv[2][2];
#pragma unroll
        for (int bj = 0; bj < 2; ++bj)
#pragma unroll
            for (int n = 0; n < 2; ++n) bv[bj][n] = bias ? *(const f32x4*)(bias + bcol0 + bj * HALF + 4 * n) : (f32x4){0.f, 0.f, 0.f, 0.f};
#pragma unroll
        for (int ai = 0; ai < 2; ++ai)
#pragma unroll
            for (int m = 0; m < 4; ++m) { bf16_t* rowp = base + (size_t)(row0 + ai * HALF + m * 16) * ldc + col0;
#pragma unroll
                for (int bj = 0; bj < 2; ++bj) { f32x4 v0 = acc[ai][bj][m][0] + bv[bj][0], v1 = acc[ai][bj][m][1] + bv[bj][1];
                    if (ACT == 1) { f32x2 a = gelu_pk((f32x2){v0[0], v0[1]}), b = gelu_pk((f32x2){v0[2], v0[3]}), c = gelu_pk((f32x2){v1[0], v1[1]}), d = gelu_pk((f32x2){v1[2], v1[3]});
                        v0 = (f32x4){a.x, a.y, b.x, b.y}; v1 = (f32x4){c.x, c.y, d.x, d.y}; }
                    v0 = v0 * sc; v1 = v1 * sc; u32x4 w; w.x = cvt_pk_bf16(v0[0], v0[1]); w.y = cvt_pk_bf16(v0[2], v0[3]); w.z = cvt_pk_bf16(v1[0], v1[1]); w.w = cvt_pk_bf16(v1[2], v1[3]);
                    *(u32x4*)(rowp + bj * HALF) = w; } }
    }
};


template <bool XIN_BF16> struct EpiResid {
    static constexpr bool PERM = false, AFTER_DRAIN = false;
    const float* xin_lat; const float* xin_ctx; int nlat; bf16_t* XR; int ldc; const float* mod; int mod_stride; int seq; float* rssp;
    struct Pre {}; __device__ __forceinline__ void preload(Pre&, const Unit&, int, int, int, int) const {}
    __device__ __forceinline__ void operator()(const f32x4 (&acc)[2][2][4][2], const Unit& u, int wr, int wc, int fr, int fq, const Pre&) const {
        typedef unsigned u32x2 __attribute__((ext_vector_type(2)));
        const int row0 = u.pm * BM + wr * 64 + fr, col0 = u.pn * BM + wc * 32 + 4 * fq;
        const int rowt = u.pm * BM; const int bidx = rowt < nlat ? rowt / seq : 4;
        const float* gate = mod + (size_t)bidx * mod_stride;
        const float* xin = rowt < nlat ? xin_lat : (xin_ctx - (size_t)nlat * ldc);
        f32x4 gv[2][2];
#pragma unroll
        for (int bj = 0; bj < 2; ++bj)
#pragma unroll
            for (int n = 0; n < 2; ++n) gv[bj][n] = *(const f32x4*)(gate + col0 + bj * HALF + n * 16);
#pragma unroll
        for (int ai = 0; ai < 2; ++ai)
#pragma unroll
            for (int m = 0; m < 4; ++m) { const int row = row0 + ai * HALF + m * 16; const size_t ro = (size_t)row * ldc + col0; float s2 = 0.f;
#pragma unroll
                for (int bj = 0; bj < 2; ++bj)
#pragma unroll
                    for (int n = 0; n < 2; ++n) { const size_t idx = ro + bj * HALF + n * 16; f32x4 xv;
                        if (XIN_BF16) { const u32x2 w = *(const u32x2*)(XR + idx); xv = (f32x4){__builtin_bit_cast(float, w.x << 16), __builtin_bit_cast(float, w.x & 0xffff0000u), __builtin_bit_cast(float, w.y << 16), __builtin_bit_cast(float, w.y & 0xffff0000u)}; }
                        else xv = *(const f32x4*)(xin + idx);
                        const f32x4 v = xv + gv[bj][n] * acc[ai][bj][m][n];
                        s2 += (v[0] * v[0] + v[1] * v[1]) + (v[2] * v[2] + v[3] * v[3]);
                        u32x2 o; o.x = cvt_pk_bf16(v[0], v[1]); o.y = cvt_pk_bf16(v[2], v[3]); *(u32x2*)(XR + idx) = o; }
                s2 += __shfl_xor(s2, 16); s2 += __shfl_xor(s2, 32);
                if (fq == 0) rssp[(size_t)row * 16 + u.pn * 4 + wc] = s2; }
    }
};
struct EpiSwiglu {
    static constexpr bool PERM = true, AFTER_DRAIN = false;
    bf16_t* O; int ldc; const float* bias; int bias_stride;
    struct Pre { unsigned bw[2][2][2]; };
    __device__ __forceinline__ void preload(Pre& p, const Unit& u, int wr, int wc, int fr, int fq) const {
        const float* bb = bias + (size_t)u.e * bias_stride + u.pn * BM + wc * 32 + 8 * fq;
#pragma unroll
        for (int bj = 0; bj < 2; ++bj)
#pragma unroll
            for (int n = 0; n < 2; ++n) { const f32x4 v = *(const f32x4*)(bb + bj * HALF + 4 * n); p.bw[bj][n][0] = cvt_pk_bf16(v[0], v[1]); p.bw[bj][n][1] = cvt_pk_bf16(v[2], v[3]); }
    }
    __device__ __forceinline__ void operator()(const f32x4 (&acc)[2][2][4][2], const Unit& u, int wr, int wc, int fr, int fq, const Pre& pre) const {
        const int row0 = u.pm * BM + wr * 64 + fr; const int bcol0 = u.pn * BM + wc * 32 + 8 * fq; const int ocol0 = bcol0 >> 1;
        f32x4 bv[2][2];
#pragma unroll
        for (int bj = 0; bj < 2; ++bj)
#pragma unroll
            for (int n = 0; n < 2; ++n) { const unsigned w0 = pre.bw[bj][n][0], w1 = pre.bw[bj][n][1];
                bv[bj][n] = (f32x4){__builtin_bit_cast(float, w0 << 16), __builtin_bit_cast(float, w0 & 0xffff0000u), __builtin_bit_cast(float, w1 << 16), __builtin_bit_cast(float, w1 & 0xffff0000u)}; }
#pragma unroll
        for (int ai = 0; ai < 2; ++ai)
#pragma unroll
            for (int m = 0; m < 4; ++m) { bf16_t* rowp = O + (size_t)(row0 + ai * HALF + m * 16) * ldc + ocol0;
#pragma unroll
                for (int bj = 0; bj < 2; ++bj) { const f32x4 v0 = acc[ai][bj][m][0] + bv[bj][0], v1 = acc[ai][bj][m][1] + bv[bj][1];
                    float o[4];
#pragma unroll
                    for (int p = 0; p < 4; ++p) { const float hg = p < 2 ? v0[2 * p] : v1[2 * p - 4], hl = p < 2 ? v0[2 * p + 1] : v1[2 * p - 3];
                        const float glu = fminf(hg, 7.0f), lin = fminf(fmaxf(hl, -7.0f), 7.0f);
                        const float sg = __builtin_amdgcn_rcpf(1.0f + __builtin_amdgcn_exp2f(-1.702f * 1.4426950408889634f * glu));
                        o[p] = glu * sg * (lin + 1.0f); }
                    typedef unsigned u32x2 __attribute__((ext_vector_type(2)));
                    u32x2 w; w.x = cvt_pk_bf16(o[0], o[1]); w.y = cvt_pk_bf16(o[2], o[3]);
                    *(u32x2*)(rowp + bj * (HALF / 2)) = w; } }
    }
};
struct EpiBf16Bias {
    static constexpr bool PERM = true, AFTER_DRAIN = false;
    bf16_t* O; int ldc; const float* bias; int bias_stride;
    struct Pre { f32x4 bv[2][2]; };
    __device__ __forceinline__ void preload(Pre& p, const Unit& u, int wr, int wc, int fr, int fq) const {
        const float* bb = bias + (size_t)u.e * bias_stride + u.pn * BM + wc * 32 + 8 * fq;
#pragma unroll
        for (int bj = 0; bj < 2; ++bj)
#pragma unroll
            for (int n = 0; n < 2; ++n) p.bv[bj][n] = *(const f32x4*)(bb + bj * HALF + 4 * n);
    }
    __device__ __forceinline__ void operator()(const f32x4 (&acc)[2][2][4][2], const Unit& u, int wr, int wc, int fr, int fq, const Pre& pre) const {
        const int row0 = u.pm * BM + wr * 64 + fr; const int col0 = u.pn * BM + wc * 32 + 8 * fq;
#pragma unroll
        for (int ai = 0; ai < 2; ++ai)
#pragma unroll
            for (int m = 0; m < 4; ++m) { bf16_t* rowp = O + (size_t)(row0 + ai * HALF + m * 16) * ldc + col0;
#pragma unroll
                for (int bj = 0; bj < 2; ++bj) { const f32x4 v0 = acc[ai][bj][m][0] + pre.bv[bj][0], v1 = acc[ai][bj][m][1] + pre.bv[bj][1];
                    u32x4 w; w.x = cvt_pk_bf16(v0[0], v0[1]); w.y = cvt_pk_bf16(v0[2], v0[3]); w.z = cvt_pk_bf16(v1[0], v1[1]); w.w = cvt_pk_bf16(v1[2], v1[3]);
                    *(u32x4*)(rowp + bj * HALF) = w; } }
    }
};
struct EpiLruGate {
    static constexpr bool PERM = false, AFTER_DRAIN = false;
    const bf16_t* XL; bf16_t* LAB; size_t lab_stride; const float* gb; const float* spt;
    struct Pre {}; __device__ __forceinline__ void preload(Pre&, const Unit&, int, int, int, int) const {}
    __device__ __forceinline__ void operator()(const f32x4 (&acc)[2][2][4][2], const Unit& u, int wr, int wc, int fr, int fq, const Pre&) const {
        const int d = u.pn >> 1, half = u.pn & 1;
        const int row0 = u.pm * BM + wr * 64 + fr, ch0 = half * 128 + wc * 32 + 4 * fq;
        bf16_t* LA = LAB + (size_t)(2 * d) * lab_stride; bf16_t* LB = LAB + (size_t)(2 * d + 1) * lab_stride;
#pragma unroll
        for (int n = 0; n < 2; ++n) {
            const f32x4 bR = *(const f32x4*)(gb + (d * 2 + 0) * 256 + ch0 + 16 * n), bI = *(const f32x4*)(gb + (d * 2 + 1) * 256 + ch0 + 16 * n);
            const f32x4 sp = *(const f32x4*)(spt + d * 256 + ch0 + 16 * n) * (-8.0f * 1.4426950408889634f);
#pragma unroll
            for (int ai = 0; ai < 2; ++ai)
#pragma unroll
                for (int m = 0; m < 4; ++m) { const size_t ro = (size_t)(row0 + ai * HALF + m * 16) * 256 + ch0 + 16 * n;
                    typedef unsigned u32x2 __attribute__((ext_vector_type(2)));
                    const u32x2 xw = *(const u32x2*)(XL + ro);
                    const float xl[4] = {__builtin_bit_cast(float, xw.x << 16), __builtin_bit_cast(float, xw.x & 0xffff0000u), __builtin_bit_cast(float, xw.y << 16), __builtin_bit_cast(float, xw.y & 0xffff0000u)};
                    const f32x4 gr = acc[ai][0][m][n] + bR, gi = acc[ai][1][m][n] + bI;
                    f32x4 av, bv;
#pragma unroll
                    for (int e = 0; e < 4; ++e) {
                        const float rg = __builtin_amdgcn_rcpf(1.0f + __builtin_amdgcn_exp2f(-1.4426950408889634f * gr[e])), ig = __builtin_amdgcn_rcpf(1.0f + __builtin_amdgcn_exp2f(-1.4426950408889634f * gi[e]));
                        const float la2 = rg * sp[e];
                        const float a2 = __builtin_amdgcn_exp2f(2.0f * la2);
                        av[e] = la2; bv[e] = __builtin_amdgcn_sqrtf(fmaxf(1.0f - a2, 0.f)) * (ig * xl[e]); }
                    u32x2 wa, wb; wa.x = cvt_pk_bf16(av[0], av[1]); wa.y = cvt_pk_bf16(av[2], av[3]); wb.x = cvt_pk_bf16(bv[0], bv[1]); wb.y = cvt_pk_bf16(bv[2], bv[3]);
                    *(u32x2*)(LA + ro) = wa; *(u32x2*)(LB + ro) = wb; }
        }
    }
};
template <bool GATHER_> struct MoeOrderT {
    static constexpr bool GATHER = GATHER_;
    const int* rowtok;
    __device__ __forceinline__ int row_of(int r) const { return GATHER_ ? rowtok[r] : r; }
    const PG8_LAS int* tab; int ntiles, nN, nper, j, m_lo, nMx, wgm, rev;
    __device__ __forceinline__ void init(const PG8_LAS int* tab_, int ntiles_, int nN_, int G, int bx, int wgm_) {
        tab = tab_; ntiles = ntiles_; nN = nN_; wgm = wgm_; rev = 0;
        if (G % 8 == 0) { const int x = bx % 8; nper = G / 8; j = bx / 8; m_lo = (x * ntiles) / 8; nMx = ((x + 1) * ntiles) / 8 - m_lo; }
        else { nper = G; j = bx; m_lo = 0; nMx = ntiles; }
    }
    __device__ __forceinline__ bool next(int i, Unit& u) const {
        const int s = i * nper + j; if (s >= nMx * nN) return false;
        const int nig = wgm * nN, gid = s / nig, fm = gid * wgm, gsz = (nMx - fm) < wgm ? (nMx - fm) : wgm, w = s - gid * nig;
        const int mi = fm + (w % gsz); u.pm = m_lo + (rev ? (nMx - 1 - mi) : mi); u.pn = w / gsz; u.e = tab[u.pm]; u.be = u.e * nN + u.pn; return true;
    }
    __device__ __forceinline__ void a_ready(const Unit&) const {}
    __device__ __forceinline__ void done(const Unit&) const {}
};
template <class Epi, class Sched, bool ALIGN_EPI = false, bool SP2 = false>
__device__ __forceinline__ void gemm_phase(PG8_LAS unsigned char* lds, const Gemm g, const Sched& S, const Epi& E) {
    int tid_ = threadIdx.x; asm volatile("" : "+v"(tid_));
    const int tid = tid_, wid = __builtin_amdgcn_readfirstlane(tid >> 6), lane = tid & 63, wr = wid >> 2, wc = wid & 3, fr = lane & 15, fq = lane >> 4;
    const int K = g.K, nt = K / BK;
    unsigned voffA[2], voffB[2];
#pragma unroll
    for (int i = 0; i < 2; ++i) { int R, C; stage_rc(tid * 16 + i * 8192, R, C); const int Rb = Epi::PERM ? ((R & ~31) + perm32(R & 31)) : R;
        voffA[i] = (unsigned)(R * K + C) * 2u; voffB[i] = (unsigned)(Rb * K + C) * 2u; }
    unsigned gA_[2] = {0u, 0u}, gN_[2] = {0u, 0u}, gC_[2] = {0u, 0u};
    static_assert(!Sched::GATHER || SP2, "the gathered A operand is wired into the SP2 loop only");
    if constexpr (Sched::GATHER) { _Pragma("unroll") for (int i_ = 0; i_ < 2; ++i_) { int R_, C_; stage_rc(tid * 16 + i_ * 8192, R_, C_); gC_[i_] = (unsigned)(C_ * 2); } }
#define PG8_GLOAD(dst, pm_) do { _Pragma("unroll") for (int h_ = 0; h_ < 2; ++h_) { unsigned t_[2]; _Pragma("unroll") for (int i_ = 0; i_ < 2; ++i_) { int R_, C_; stage_rc(tid * 16 + i_ * 8192, R_, C_); \
        t_[i_] = (unsigned)S.row_of((pm_) * BM + h_ * HALF + R_); } dst[h_] = t_[0] | (t_[1] << 16); } } while (0)
    const size_t kstep = (size_t)(BK * 2);
    const size_t hstep = (size_t)HALF * K * 2;
    const size_t tstep = 2 * hstep;
    const unsigned ldsw = (unsigned)wid * 1024u;
    const int aoff = lds_byte(wr * 64 + fr, fq * 8), boff = lds_byte(wc * 32 + fr, fq * 8);
#define PG8_SA(b, h) (((b) * 2 + (h)) * HTB)
#define PG8_SB(b, h) ((4 + (b) * 2 + (h)) * HTB)
#define PG8_STAGE(bufoff, gbase, voff) do { _Pragma("unroll") for (int _i = 0; _i < 2; ++_i) \
        __builtin_amdgcn_global_load_lds((const unsigned*)((const char*)(gbase) + (voff)[_i]), (PG8_LAS unsigned*)(lds + (bufoff) + ldsw + _i * 8192), 16, 0, 0); } while (0)
#define PG8_STA(bufoff, ptr, h, useN) do { if constexpr (Sched::GATHER) { const unsigned pk_ = (useN) ? gN_[h] : gA_[h]; unsigned o_[2] = {(pk_ & 0xffffu) * (unsigned)(K * 2) + gC_[0], (pk_ >> 16) * (unsigned)(K * 2) + gC_[1]}; PG8_STAGE(bufoff, ptr, o_); } \
        else { PG8_STAGE(bufoff, (ptr) + ((h) ? hstep : 0), voffA); } } while (0)
#define PG8_LDA(dst, b, h) do { _Pragma("unroll") for (int m = 0; m < 4; ++m) _Pragma("unroll") for (int k = 0; k < 2; ++k) dst[m][k] = *(const PG8_LAS bf16x8*)(lds + PG8_SA(b, h) + aoff + m * 2048 + k * 1024); } while (0)
#define PG8_LDB(dst, b, h) do { _Pragma("unroll") for (int n = 0; n < 2; ++n) _Pragma("unroll") for (int k = 0; k < 2; ++k) dst[n][k] = *(const PG8_LAS bf16x8*)(lds + PG8_SB(b, h) + boff + n * 2048 + k * 1024); } while (0)
#define PG8_MMA(ai, bj, At, Bt) do { __builtin_amdgcn_s_setprio(1); _Pragma("unroll") for (int m = 0; m < 4; ++m) _Pragma("unroll") for (int n = 0; n < 2; ++n) _Pragma("unroll") for (int k = 0; k < 2; ++k) \
        acc[ai][bj][m][n] = __builtin_amdgcn_mfma_f32_16x16x32_bf16(Bt[n][k], At[m][k], acc[ai][bj][m][n], 0, 0, 0); __builtin_amdgcn_s_setprio(0); } while (0)
#define PG8_WAIT_V(n) asm volatile("s_waitcnt vmcnt(" #n ")" ::: "memory")
#define PG8_WAIT_L(n) asm volatile("s_waitcnt lgkmcnt(" #n ")" ::: "memory")
#define PG8_BAR __builtin_amdgcn_s_barrier()
#define PG8_SCHED __builtin_amdgcn_sched_barrier(0)
    Unit cur, nxt; int ui = 0;
    if (!S.next(0, cur)) return;
    f32x4 acc[2][2][4][2];
#pragma unroll
    for (int a = 0; a < 2; ++a)
#pragma unroll
        for (int b = 0; b < 2; ++b)
#pragma unroll
            for (int m = 0; m < 4; ++m)
#pragma unroll
                for (int n = 0; n < 2; ++n) acc[a][b][m][n] = (f32x4){0.f, 0.f, 0.f, 0.f};
    bf16x8 At[4][2], B0[2][2], B1[2][2];
    typename Epi::Pre pre;
    const char* cA = (const char*)g.A + (Sched::GATHER ? (size_t)0 : (size_t)cur.pm * tstep); if constexpr (Sched::GATHER) PG8_GLOAD(gA_, cur.pm);
    const char* cB = (const char*)g.Bt + (size_t)cur.be * tstep;
    S.a_ready(cur);
    if constexpr (SP2) {
        PG8_STAGE(PG8_SB(0, 0), cB, voffB); PG8_STAGE(PG8_SB(0, 1), cB + hstep, voffB); PG8_STA(PG8_SA(0, 0), cA, 0, false); PG8_STA(PG8_SA(0, 1), cA, 1, false);
        if (wr == 1) PG8_BAR;
        PG8_WAIT_V(2); PG8_BAR;
        PG8_STAGE(PG8_SB(1, 0), cB + kstep, voffB); PG8_STA(PG8_SA(1, 0), cA + kstep, 0, false); PG8_STAGE(PG8_SB(1, 1), cB + hstep + kstep, voffB);
        PG8_WAIT_V(6); PG8_BAR;
    } else {
        PG8_STAGE(PG8_SB(0, 0), cB, voffB); PG8_STAGE(PG8_SA(0, 0), cA, voffA); PG8_STAGE(PG8_SB(0, 1), cB + hstep, voffB); PG8_STAGE(PG8_SA(0, 1), cA + hstep, voffA);
        if (wr == 1) PG8_BAR;
        PG8_WAIT_V(4); PG8_BAR;
        PG8_STAGE(PG8_SB(1, 0), cB + kstep, voffB); PG8_STAGE(PG8_SA(1, 0), cA + kstep, voffA); PG8_STAGE(PG8_SB(1, 1), cB + hstep + kstep, voffB);
        PG8_WAIT_V(6); PG8_BAR;
    }
    for (;;) {
        const bool has_next = S.next(ui + 1, nxt);
        const char* nA = (has_next && !Sched::GATHER) ? (const char*)g.A + (size_t)nxt.pm * tstep : cA; const char* nB = has_next ? (const char*)g.Bt + (size_t)nxt.be * tstep : cB;
        if constexpr (Sched::GATHER) { if (has_next) PG8_GLOAD(gN_, nxt.pm); else { gN_[0] = gA_[0]; gN_[1] = gA_[1]; } }
        for (int t = 0; t < nt; t += 2) {
            const bool last = (t == nt - 2);
            const char* a1 = cA + (size_t)(t + 1) * kstep;
            const char* a2 = last ? nA : cA + (size_t)(t + 2) * kstep; const char* b2 = last ? nB : cB + (size_t)(t + 2) * kstep;
            const char* a3 = a2 + kstep; const char* b3 = b2 + kstep;
            if (last) E.preload(pre, cur, wr, wc, fr, fq);
            if (last && has_next) S.a_ready(nxt);
            if constexpr (SP2) {
            PG8_LDB(B0, 0, 0); PG8_LDB(B1, 0, 1); PG8_SCHED; PG8_LDA(At, 0, 0); PG8_STA(PG8_SA(1, 1), a1, 1, false);
            PG8_WAIT_V(8); PG8_WAIT_L(0); PG8_BAR; PG8_MMA(0, 0, At, B0); PG8_MMA(0, 1, At, B1); PG8_BAR; PG8_SCHED;
            PG8_LDA(At, 0, 1); PG8_STAGE(PG8_SB(0, 0), b2, voffB); PG8_STAGE(PG8_SB(0, 1), b2 + hstep, voffB); PG8_STA(PG8_SA(0, 0), a2, 0, last);
            PG8_WAIT_V(8); PG8_WAIT_L(0); PG8_BAR; PG8_MMA(1, 0, At, B0); PG8_MMA(1, 1, At, B1); PG8_BAR; PG8_SCHED;
            PG8_LDB(B0, 1, 0); PG8_LDB(B1, 1, 1); PG8_SCHED; PG8_LDA(At, 1, 0); PG8_STA(PG8_SA(0, 1), a2, 1, last);
            PG8_WAIT_V(8); PG8_WAIT_L(0); PG8_BAR; PG8_MMA(0, 0, At, B0); PG8_MMA(0, 1, At, B1); PG8_BAR; PG8_SCHED;
            PG8_LDA(At, 1, 1); PG8_STAGE(PG8_SB(1, 0), b3, voffB); PG8_STAGE(PG8_SB(1, 1), b3 + hstep, voffB); PG8_STA(PG8_SA(1, 0), a3, 0, last);
            PG8_WAIT_V(8); PG8_WAIT_L(0); PG8_BAR; PG8_MMA(1, 0, At, B0); PG8_MMA(1, 1, At, B1); PG8_BAR; PG8_SCHED;
            } else {
            PG8_LDB(B0, 0, 0); PG8_SCHED; PG8_LDA(At, 0, 0); PG8_STAGE(PG8_SA(1, 1), a1 + hstep, voffA);
            PG8_WAIT_L(8); PG8_BAR; PG8_WAIT_L(0); PG8_MMA(0, 0, At, B0); PG8_BAR; PG8_SCHED;
            PG8_LDB(B1, 0, 1); PG8_STAGE(PG8_SB(0, 0), b2, voffB);
            PG8_BAR; PG8_WAIT_L(0); PG8_MMA(0, 1, At, B1); PG8_BAR;
            PG8_LDA(At, 0, 1); PG8_STAGE(PG8_SA(0, 0), a2, voffA);
            PG8_BAR; PG8_WAIT_L(0); PG8_MMA(1, 0, At, B0); PG8_BAR; PG8_SCHED;
            PG8_STAGE(PG8_SB(0, 1), b2 + hstep, voffB);
            PG8_WAIT_V(6); PG8_BAR; PG8_MMA(1, 1, At, B1); PG8_BAR;
            PG8_LDB(B0, 1, 0); PG8_SCHED; PG8_LDA(At, 1, 0); PG8_STAGE(PG8_SA(0, 1), a2 + hstep, voffA);
            PG8_WAIT_L(8); PG8_BAR; PG8_WAIT_L(0); PG8_MMA(0, 0, At, B0); PG8_BAR; PG8_SCHED;
            PG8_LDB(B1, 1, 1); PG8_STAGE(PG8_SB(1, 0), b3, voffB);
            PG8_BAR; PG8_WAIT_L(0); PG8_MMA(0, 1, At, B1); PG8_BAR;
            PG8_LDA(At, 1, 1); PG8_STAGE(PG8_SA(1, 0), a3, voffA);
            PG8_BAR; PG8_WAIT_L(0); PG8_MMA(1, 0, At, B0); PG8_BAR; PG8_SCHED;
            PG8_STAGE(PG8_SB(1, 1), b3 + hstep, voffB);
            PG8_WAIT_V(6); PG8_BAR; PG8_MMA(1, 1, At, B1); PG8_BAR;
            }
        }
        if constexpr (ALIGN_EPI) { if (wr == 0) PG8_BAR; }
        if constexpr (!Epi::AFTER_DRAIN) { E(acc, cur, wr, wc, fr, fq, pre); S.done(cur); }
        if (!has_next) break;
#pragma unroll
        for (int a = 0; a < 2; ++a)
#pragma unroll
            for (int b = 0; b < 2; ++b)
#pragma unroll
                for (int m = 0; m < 4; ++m)
#pragma unroll
                    for (int n = 0; n < 2; ++n) acc[a][b][m][n] = (f32x4){0.f, 0.f, 0.f, 0.f};
        cur = nxt; cA = nA; cB = nB; ++ui;
        if constexpr (Sched::GATHER) { gA_[0] = gN_[0]; gA_[1] = gN_[1]; }
        if constexpr (ALIGN_EPI) { if (wr == 1) PG8_BAR; }
    }
    PG8_WAIT_V(0);
    if constexpr (!ALIGN_EPI) { if (wr == 0) PG8_BAR; }
    PG8_BAR;
    if constexpr (Epi::AFTER_DRAIN) { E.fused(acc, cur, wr, wc, fr, fq, lds, wid, lane); S.done(cur); }
#undef PG8_SA
#undef PG8_SB
#undef PG8_STAGE
#undef PG8_STA
#undef PG8_GLOAD
#undef PG8_LDA
#undef PG8_LDB
#undef PG8_MMA
#undef PG8_WAIT_V
#undef PG8_WAIT_L
#undef PG8_BAR
#undef PG8_SCHED
}
}

#ifndef PG8_SP2
#define PG8_SP2 true
#endif
#ifndef PG8_ALIGN
#define PG8_ALIGN true
#endif
#include <cmath>
namespace attn_body {
using bf16=__hip_bfloat16;
using bf16x8=__attribute__((ext_vector_type(8)))short;
using s16x4=__attribute__((ext_vector_type(4)))short;
using f32x16=__attribute__((ext_vector_type(16)))float;
using u32x4=__attribute__((ext_vector_type(4)))unsigned;
using f32x4_t=__attribute__((ext_vector_type(4)))float;
constexpr int NHEAD=8,SEQQ=8192,SEQK=8448,D=64,QP=512,KP=128,QIN=2048;
constexpr int NW=8,QBLK=32,QB=QBLK*NW,KVBLK=64,NQB=SEQQ/QB;
constexpr int ATTN_UNIT_ROWS=QB;
__device__ __forceinline__ int crow(int r,int hi){return (r&3)+8*(r>>2)+4*hi;}
#define SBAR() __builtin_amdgcn_sched_barrier(0)
__device__ __forceinline__ void cmask(f32x16&p0,f32x16&p1,int jb,int qrel,int hi){
  const float NEG=-INFINITY; int kb=64*jb+4*hi;
  #pragma unroll
  for(int r=0;r<16;++r){int kv=kb+(r&3)+8*(r>>2); if(kv>qrel)p0[r]=NEG; if(kv+32>qrel)p1[r]=NEG;}
}

constexpr int NSLOT=3, SLOTB=8192;
constexpr int LDS_K=0, LDS_V=NSLOT*SLOTB, LDS_WS=2*NSLOT*SLOTB, LDS_OST=LDS_WS+NW*64*4, LDS_BYTES=LDS_OST+NW*4096;
constexpr float C2=0.125f*1.4426950408889634f;
__device__ __forceinline__ void glds16(const void*gsrc,unsigned lds_dst){unsigned keep;
  asm volatile("s_mov_b32 %0, m0\n\ts_mov_b32 m0, %2\n\ts_nop 0\n\tglobal_load_lds_dwordx4 %1, off\n\ts_mov_b32 m0, %0":"=&s"(keep):"v"(gsrc),"s"(lds_dst):"memory");}
__device__ __forceinline__ float max3f(float a,float b,float c){float r;asm("v_max3_f32 %0, %1, %2, %3":"=v"(r):"v"(a),"v"(b),"v"(c));return r;}
__device__ __forceinline__ float max2f(float a,float b){float r;asm("v_max_f32_e32 %0, %1, %2":"=v"(r):"v"(a),"v"(b));return r;}
__device__ __forceinline__ float fadd_s(float a,float b){float r;asm("v_add_f32_e32 %0, %1, %2":"=v"(r):"v"(a),"v"(b));return r;}
__device__ __forceinline__ float fsub_s(float a,float b){float r;asm("v_sub_f32_e32 %0, %1, %2":"=v"(r):"v"(a),"v"(b));return r;}
typedef float f32x2_t __attribute__((ext_vector_type(2))); typedef __bf16 bf16x2_t __attribute__((ext_vector_type(2)));
__device__ __forceinline__ unsigned cvtpk_s(float lo,float hi){f32x2_t v={lo,hi};bf16x2_t b=__builtin_convertvector(v,bf16x2_t);return __builtin_bit_cast(unsigned,b);}
#define WAIT_BAR(N) asm volatile("s_waitcnt vmcnt(" #N ") lgkmcnt(0)\n\ts_barrier":::"memory")

__device__ __forceinline__ void qkt(f32x16&p0,f32x16&p1,const char*Kslot,const bf16x8*qr,const f32x16&negm,int r32,int hi){
  const char*kb=Kslot+hi*1024+r32*16;
  #pragma unroll
  for(int d0=0;d0<4;++d0){
    const bf16x8 b0=*reinterpret_cast<const bf16x8*>(kb+d0*2048);
    const bf16x8 b1=*reinterpret_cast<const bf16x8*>(kb+d0*2048+512);
    if(d0==0){p0=__builtin_amdgcn_mfma_f32_32x32x16_bf16(b0,qr[0],negm,0,0,0);p1=__builtin_amdgcn_mfma_f32_32x32x16_bf16(b1,qr[0],negm,0,0,0);}
    else{p0=__builtin_amdgcn_mfma_f32_32x32x16_bf16(b0,qr[d0],p0,0,0,0);p1=__builtin_amdgcn_mfma_f32_32x32x16_bf16(b1,qr[d0],p1,0,0,0);}}
}
typedef __attribute__((address_space(3))) const char* lds_cptr;
typedef short v4i16_t __attribute__((ext_vector_type(4)));
__device__ __forceinline__ void kload8(bf16x8*kf,lds_cptr kp){
  kf[0]=*(const __attribute__((address_space(3))) bf16x8*)(kp);      kf[1]=*(const __attribute__((address_space(3))) bf16x8*)(kp+512);
  kf[2]=*(const __attribute__((address_space(3))) bf16x8*)(kp+2048); kf[3]=*(const __attribute__((address_space(3))) bf16x8*)(kp+2560);
  kf[4]=*(const __attribute__((address_space(3))) bf16x8*)(kp+4096); kf[5]=*(const __attribute__((address_space(3))) bf16x8*)(kp+4608);
  kf[6]=*(const __attribute__((address_space(3))) bf16x8*)(kp+6144); kf[7]=*(const __attribute__((address_space(3))) bf16x8*)(kp+6656);
}
__device__ __forceinline__ void kload2(bf16x8*kf,lds_cptr kp,int j){ kf[2*j]=*(const __attribute__((address_space(3))) bf16x8*)(kp+j*2048); kf[2*j+1]=*(const __attribute__((address_space(3))) bf16x8*)(kp+j*2048+512); }
__device__ __forceinline__ s16x4 vtr(lds_cptr p){ return __builtin_bit_cast(s16x4,__builtin_amdgcn_ds_read_tr16_b64_v4i16((__attribute__((address_space(3))) v4i16_t*)p)); }
__device__ __forceinline__ float rowmax(const f32x16&p0,const f32x16&p1){
  float a=max3f(p0[0],p0[1],p1[0]),b=max3f(p0[2],p0[3],p1[1]);a=max3f(a,p1[2],p1[3]);
  #pragma unroll
  for(int r=4;r<16;r+=4){a=max3f(a,p0[r],p0[r+1]);b=max3f(b,p0[r+2],p0[r+3]);a=max3f(a,p1[r],p1[r+1]);b=max3f(b,p1[r+2],p1[r+3]);}
  const float m=max2f(a,b);
  auto rr=__builtin_amdgcn_permlane32_swap(__float_as_uint(m),__float_as_uint(m),false,false);
  return max2f(__uint_as_float(rr[0]),__uint_as_float(rr[1]));
}
__device__ __forceinline__ void pv(f32x16*o,int vb,bf16x8 pa0,bf16x8 pa1,bf16x8 pa2,bf16x8 pa3){
  #pragma unroll
  for(int d0=0;d0<2;++d0){s16x4 lo[4],hi[4];
    #pragma unroll
    for(int ks=0;ks<4;++ks){
      asm volatile("ds_read_b64_tr_b16 %0,%1 offset:%c2":"=&v"(lo[ks]):"v"(vb),"i"(d0*4096+ks*1024):"memory");
      asm volatile("ds_read_b64_tr_b16 %0,%1 offset:%c2":"=&v"(hi[ks]):"v"(vb),"i"(d0*4096+ks*1024+512):"memory");}
    asm volatile("s_waitcnt lgkmcnt(0)":::"memory");SBAR();
    #define PK(k) (bf16x8){lo[k][0],lo[k][1],lo[k][2],lo[k][3],hi[k][0],hi[k][1],hi[k][2],hi[k][3]}
    o[d0]=__builtin_amdgcn_mfma_f32_32x32x16_bf16(pa0,PK(0),o[d0],0,0,0);
    o[d0]=__builtin_amdgcn_mfma_f32_32x32x16_bf16(pa1,PK(1),o[d0],0,0,0);
    o[d0]=__builtin_amdgcn_mfma_f32_32x32x16_bf16(pa2,PK(2),o[d0],0,0,0);
    o[d0]=__builtin_amdgcn_mfma_f32_32x32x16_bf16(pa3,PK(3),o[d0],0,0,0);
    #undef PK
  }
}

#ifndef ATTN_STORE16
#define ATTN_STORE16(p,v) (*(u32x4*)(p)=(v))
#endif
struct QPre { const float* qg; const float* rc; const float* rs; };
template<int THRL> __device__ __forceinline__ void attn_unit(int b,int h,long qrow0,int NTarg,int tq0,const QPre&QN,const bf16*Q,const bf16*__restrict__ K,const bf16*__restrict__ V,bf16*O,char*shm){
  int tid_=threadIdx.x; asm volatile("":"+v"(tid_)); const int tid=tid_,lane=tid&63,r32=lane&31,hi=lane>>5; const int wid=__builtin_amdgcn_readfirstlane(tid>>6);
  const long krowbase=(long)b*SEQK; const int kvh=h>>2;
  const bf16*Qw=Q+(qrow0+wid*QBLK)*QIN+h*D;
  const bf16*Kh=K+krowbase*KP+kvh*D,*Vh=V+krowbase*KP+kvh*D;
  const unsigned lds0=(unsigned)(uintptr_t)shm;
  float*wsf=(float*)(shm+LDS_WS)+wid*64;
  const bf16*ksrc=Kh+(long)lane*KP+wid*8;
  const bf16*vsrc=Vh+(long)(16*(wid&3)+(lane>>2))*KP+(wid>>2)*32+(lane&3)*8;
  const unsigned kdst=lds0+LDS_K+wid*1024, vdst=lds0+LDS_V+wid*1024;
  #define DMA_K(t,slot) glds16(ksrc+(long)(t)*KVBLK*KP,(unsigned)__builtin_amdgcn_readfirstlane(kdst+(slot)))
  #define DMA_V(t,slot) glds16(vsrc+(long)(t)*KVBLK*KP,(unsigned)__builtin_amdgcn_readfirstlane(vdst+(slot)))
  const int vb0=(int)(lds0+LDS_V)+((lane>>4)&1)*32+(lane&3)*8+(4*hi+((lane&15)>>2))*64;
  const char*Kbase=shm+LDS_K; bf16x8 kf[8];
  const lds_cptr shm3=(lds_cptr)shm; const lds_cptr kp0=shm3+LDS_K+hi*1024+r32*16; const lds_cptr vp0=shm3+LDS_V+((lane>>4)&1)*32+(lane&3)*8+(4*hi+((lane&15)>>2))*64;
  const int NT=NTarg;
  DMA_K(0,0);DMA_V(0,0);DMA_K(1,SLOTB);
  bf16x8 qr[4];
  #pragma unroll
  for(int d0=0;d0<4;++d0)qr[d0]=*reinterpret_cast<const bf16x8*>(&Qw[(long)r32*QIN+d0*16+hi*8]);
  {
    float x[4][8]; float ss=0.f;
    #pragma unroll
    for(int d0=0;d0<4;++d0){
      #pragma unroll
      for(int e=0;e<8;++e){ x[d0][e]=__builtin_bit_cast(float,(unsigned)(unsigned short)qr[d0][e]<<16); ss+=x[d0][e]*x[d0][e]; } }
    ss+=__shfl_xor(ss,32);
    const float rstd=C2/sqrtf(ss*(1.0f/64.0f)+1e-6f);
    #pragma unroll
    for(int d0=0;d0<4;++d0){ const f32x4_t g0=*reinterpret_cast<const f32x4_t*>(QN.qg+16*d0+8*hi), g1=*reinterpret_cast<const f32x4_t*>(QN.qg+16*d0+8*hi+4);
      #pragma unroll
      for(int e=0;e<8;++e) x[d0][e]*=rstd*(e<4?g0[e]:g1[e-4]); }
    if(tq0>=0){ const int t=tq0+wid*QBLK+r32;
      #pragma unroll
      for(int d0=0;d0<2;++d0){ const float*cp=QN.rc+(long)t*32+16*d0+8*hi,*sp=QN.rs+(long)t*32+16*d0+8*hi;
        const f32x4_t c0=*reinterpret_cast<const f32x4_t*>(cp),c1=*reinterpret_cast<const f32x4_t*>(cp+4),s0=*reinterpret_cast<const f32x4_t*>(sp),s1=*reinterpret_cast<const f32x4_t*>(sp+4);
        #pragma unroll
        for(int e=0;e<8;++e){ const float cs=e<4?c0[e]:c1[e-4], sn=e<4?s0[e]:s1[e-4]; const float a=x[d0][e], bq=x[d0+2][e]; x[d0][e]=a*cs-bq*sn; x[d0+2][e]=bq*cs+a*sn; } } }
    #pragma unroll
    for(int d0=0;d0<4;++d0){ u32x4 pk; pk[0]=cvtpk_s(x[d0][0],x[d0][1]); pk[1]=cvtpk_s(x[d0][2],x[d0][3]); pk[2]=cvtpk_s(x[d0][4],x[d0][5]); pk[3]=cvtpk_s(x[d0][6],x[d0][7]); qr[d0]=__builtin_bit_cast(bf16x8,pk); }
  }
  float mhat=0.f,l_reg=0.f;f32x16 o[2];o[0]=f32x16{};o[1]=f32x16{};f32x16 negm=f32x16{};asm volatile("":"+v"(negm));
  const int qrel=wid*QBLK+r32;
  #define CMASK(P0,P1,t) do{}while(0)
  bool resc=false;
  #define START(P0,P1) do{ const float rm=rowmax(P0,P1); resc=false; \
    { const float dl=rm; mhat=fadd_s(mhat,dl); \
      _Pragma("unroll") for(int r=0;r<16;++r){P0[r]=fsub_s(P0[r],dl);P1[r]=fsub_s(P1[r],dl);} \
      _Pragma("unroll") for(int r=0;r<16;++r)negm[r]=-mhat; asm volatile("":"+v"(negm)); } \
    _Pragma("unroll") for(int r=0;r<16;++r)P0[r]=__builtin_amdgcn_exp2f(P0[r]); }while(0)
  #define RESC() do{ if(resc){ asm volatile("s_waitcnt lgkmcnt(0)":::"memory"); \
      _Pragma("unroll") for(int d_=0;d_<2;++d_) _Pragma("unroll") for(int r=0;r<16;++r)o[d_][r]*=wsf[crow(r,hi)]; } }while(0)
  f32x16 pA0,pA1,pB0,pB1;
  int sl_prev=0,sl_cur=0,sl_next=SLOTB;
  #define ROT() do{sl_prev=sl_cur;sl_cur=sl_next;sl_next=(sl_next==(NSLOT-1)*SLOTB)?0:sl_next+SLOTB;}while(0)
  DMA_K(2,2*SLOTB);
  WAIT_BAR(3);
  qkt(pA0,pA1,Kbase,qr,negm,r32,hi);asm volatile("s_nop 15\n\ts_nop 7":"+v"(pA0),"+v"(pA1));CMASK(pA0,pA1,0);
  START(pA0,pA1);
  _Pragma("unroll") for(int r=0;r<16;++r)pA1[r]=__builtin_amdgcn_exp2f(pA1[r]);
  WAIT_BAR(0);
  DMA_K(3,0);DMA_V(1,SLOTB);
  ROT();
  kload8(kf,kp0+sl_cur);
  WAIT_BAR(2);
  s16x4 vlo[8],vhi[8]; u32x4 pw0,pw1,pw2,pw3;
  #define PKW(P,B) cvtpk_s(P[B],P[B+1])
  #define PAF(k) __builtin_bit_cast(bf16x8,pw##k)
  #define VFR(i) (bf16x8){vlo[i][0],vlo[i][1],vlo[i][2],vlo[i][3],vhi[i][0],vhi[i][1],vhi[i][2],vhi[i][3]}
  #define PIN(x) asm volatile("":"+v"(x))
  #define MX3(a,b,c) __builtin_fmaxf(__builtin_fmaxf((a),(b)),(c))
  #define GAPA(MF,A0,A1,A2,A3,W0,W1,PW) do{ MF; sacc+=A0; sacc+=A1; sacc+=A2; sacc+=A3; PIN(sacc); W0; W1; PIN(PW); SBAR(); }while(0)
  #define EX(v) __builtin_amdgcn_exp2f(v)
  #define GAPB(MF,X,B) do{ MF; X[B]=EX(X[B]); X[B+1]=EX(X[B+1]); X[B+2]=EX(X[B+2]); X[B+3]=EX(X[B+3]); PIN(X); SBAR(); }while(0)
  #define VRD(i) do{ vlo[i]=vtr(vp_+(((i)>>2)*4096+((i)&3)*1024)); vhi[i]=vtr(vp_+(((i)>>2)*4096+((i)&3)*1024+512)); }while(0)
  #define KRD(G,j) do{ if(G){ kload2(kf,kp0+sl_next,j); SBAR(); } }while(0)
  #define STEP(C0,C1,P0,P1,t,GK,GV,GL) do{ SBAR(); \
    const lds_cptr vp_=vp0+sl_prev; \
    VRD(0); SBAR(); float sacc=(P0[0]+P0[1]); \
    GAPA(C0=__builtin_amdgcn_mfma_f32_32x32x16_bf16(kf[0],qr[0],negm,0,0,0), P0[2],P0[3],P0[4],P0[5],     pw0[0]=PKW(P0,0), pw0[1]=PKW(P0,2), pw0); \
    VRD(4); SBAR(); GAPA(C1=__builtin_amdgcn_mfma_f32_32x32x16_bf16(kf[1],qr[0],negm,0,0,0), P0[6],P0[7],P0[8],P0[9],     pw0[2]=PKW(P0,4), pw0[3]=PKW(P0,6), pw0); \
    VRD(1); SBAR(); GAPA(C0=__builtin_amdgcn_mfma_f32_32x32x16_bf16(kf[2],qr[1],C0,0,0,0),   P0[10],P0[11],P0[12],P0[13], pw1[0]=PKW(P0,8), pw1[1]=PKW(P0,10), pw1); \
    VRD(5); SBAR(); GAPA(C1=__builtin_amdgcn_mfma_f32_32x32x16_bf16(kf[3],qr[1],C1,0,0,0),   P0[14],P0[15],P1[0],P1[1],   pw1[2]=PKW(P0,12),pw1[3]=PKW(P0,14), pw1); \
    VRD(2); SBAR(); GAPA(C0=__builtin_amdgcn_mfma_f32_32x32x16_bf16(kf[4],qr[2],C0,0,0,0),   P1[2],P1[3],P1[4],P1[5],     pw2[0]=PKW(P1,0), pw2[1]=PKW(P1,2), pw2); \
    VRD(6); SBAR(); GAPA(C1=__builtin_amdgcn_mfma_f32_32x32x16_bf16(kf[5],qr[2],C1,0,0,0),   P1[6],P1[7],P1[8],P1[9],     pw2[2]=PKW(P1,4), pw2[3]=PKW(P1,6), pw2); \
    VRD(3); SBAR(); GAPA(C0=__builtin_amdgcn_mfma_f32_32x32x16_bf16(kf[6],qr[3],C0,0,0,0),   P1[10],P1[11],P1[12],P1[13], pw3[0]=PKW(P1,8), pw3[1]=PKW(P1,10), pw3); \
    VRD(7); SBAR(); GAPA(C1=__builtin_amdgcn_mfma_f32_32x32x16_bf16(kf[7],qr[3],C1,0,0,0),   P1[14],P1[15],0.f,0.f,       pw3[2]=PKW(P1,12),pw3[3]=PKW(P1,14), pw3); \
    l_reg+=sacc; \
    if(GK){DMA_K((t)+3,sl_cur);} if(GV){DMA_V((t)+1,sl_next);} \
    CMASK(C0,C1,t); \
    { float a=MX3(C0[0],C0[1],C1[0]),b=MX3(C0[2],C0[3],C1[1]); a=MX3(a,C1[2],C1[3]); \
      _Pragma("unroll") for(int r=4;r<16;r+=4){a=MX3(a,C0[r],C0[r+1]);b=MX3(b,C0[r+2],C0[r+3]);a=MX3(a,C1[r],C1[r+1]);b=MX3(b,C1[r+2],C1[r+3]);} \
      float rm=__builtin_fmaxf(a,b); { auto rr=__builtin_amdgcn_permlane32_swap(__float_as_uint(rm),__float_as_uint(rm),false,false); rm=__builtin_fmaxf(__uint_as_float(rr[0]),__uint_as_float(rr[1])); } \
      resc=false; \
      if(__builtin_expect(__any(rm>(float)THRL),0)){ const float dl=__builtin_fmaxf(rm,0.f); mhat+=dl; \
        _Pragma("unroll") for(int r=0;r<16;++r){C0[r]-=dl;C1[r]-=dl;} \
        _Pragma("unroll") for(int r=0;r<16;++r)negm[r]=-mhat; asm volatile("":"+v"(negm)); \
        const float f=__builtin_amdgcn_exp2f(-dl); l_reg*=f; if(hi==0)wsf[r32]=f; resc=true; } } \
    SBAR(); \
    GAPB(o[0]=__builtin_amdgcn_mfma_f32_32x32x16_bf16(PAF(0),VFR(0),o[0],0,0,0), C0,0); \
    GAPB(o[1]=__builtin_amdgcn_mfma_f32_32x32x16_bf16(PAF(0),VFR(4),o[1],0,0,0), C0,4); \
    KRD(GL,0); GAPB(o[0]=__builtin_amdgcn_mfma_f32_32x32x16_bf16(PAF(1),VFR(1),o[0],0,0,0), C0,8); \
    KRD(GL,1); GAPB(o[1]=__builtin_amdgcn_mfma_f32_32x32x16_bf16(PAF(1),VFR(5),o[1],0,0,0), C0,12); \
    KRD(GL,2); GAPB(o[0]=__builtin_amdgcn_mfma_f32_32x32x16_bf16(PAF(2),VFR(2),o[0],0,0,0), C1,0); \
    KRD(GL,3); GAPB(o[1]=__builtin_amdgcn_mfma_f32_32x32x16_bf16(PAF(2),VFR(6),o[1],0,0,0), C1,4); \
    GAPB(o[0]=__builtin_amdgcn_mfma_f32_32x32x16_bf16(PAF(3),VFR(3),o[0],0,0,0), C1,8); \
    GAPB(o[1]=__builtin_amdgcn_mfma_f32_32x32x16_bf16(PAF(3),VFR(7),o[1],0,0,0), C1,12); \
    }while(0)
  int t=1;
  #undef CMASK
  #define CMASK(P0,P1,t) do{}while(0)
  for(;t+5<NT;t+=2){
    STEP(pB0,pB1,pA0,pA1,t,true,true,true);     WAIT_BAR(2); RESC(); ROT();
    STEP(pA0,pA1,pB0,pB1,t+1,true,true,true);   WAIT_BAR(2); RESC(); ROT();
  }
  #undef CMASK
  #define CMASK(P0,P1,t) do{}while(0)
  #define ENDW(tt) do{ if((tt)+3<NT){WAIT_BAR(2);} else if((tt)+2<NT){WAIT_BAR(1);} else {WAIT_BAR(0);} }while(0)
  for(;t+1<NT;t+=2){
    STEP(pB0,pB1,pA0,pA1,t,(t+3<NT),(t+1<NT),(t+1<NT));       ENDW(t);   RESC(); ROT();
    STEP(pA0,pA1,pB0,pB1,t+1,(t+4<NT),(t+2<NT),(t+2<NT));     ENDW(t+1); RESC(); ROT();
  }
  STEP(pB0,pB1,pA0,pA1,NT-1,false,false,false); RESC();
  { float sacc=pB0[0]+pB0[1]; _Pragma("unroll") for(int r=2;r<16;++r)sacc+=pB0[r]; _Pragma("unroll") for(int r=0;r<16;++r)sacc+=pB1[r]; l_reg+=sacc;
    pw0=(u32x4){PKW(pB0,0),PKW(pB0,2),PKW(pB0,4),PKW(pB0,6)};pw1=(u32x4){PKW(pB0,8),PKW(pB0,10),PKW(pB0,12),PKW(pB0,14)};pw2=(u32x4){PKW(pB1,0),PKW(pB1,2),PKW(pB1,4),PKW(pB1,6)};pw3=(u32x4){PKW(pB1,8),PKW(pB1,10),PKW(pB1,12),PKW(pB1,14)};
    SBAR(); pv(o,vb0+sl_cur,PAF(0),PAF(1),PAF(2),PAF(3)); }
  #undef PKW
  #undef PAF
  #undef VFR
  #undef PIN
  #undef MX3
  #undef GAPA
  #undef GAPB
  #undef EX
  #undef VRD
  #undef KRD
  #undef STEP
  #undef ENDW
  {auto rr=__builtin_amdgcn_permlane32_swap(__float_as_uint(l_reg),__float_as_uint(l_reg),false,false);l_reg=__uint_as_float(rr[0])+__uint_as_float(rr[1]);}
  if(hi==0)wsf[32+r32]=l_reg;asm volatile("s_waitcnt lgkmcnt(0)":::"memory");
  float rli[16];
  #pragma unroll
  for(int r=0;r<16;++r)rli[r]=__builtin_amdgcn_rcpf(wsf[32+crow(r,hi)]);
  bf16*Ow=O+(qrow0+wid*QBLK)*QP+h*D;
  { bf16*stg=(bf16*)(shm+LDS_OST)+wid*2048;
    #pragma unroll
    for(int r=0;r<16;++r){const int orow=crow(r,hi);
      #pragma unroll
      for(int d0=0;d0<2;++d0)stg[orow*64+d0*32+r32]=__float2bfloat16(o[d0][r]*rli[r]);}
    asm volatile("s_waitcnt lgkmcnt(0)":::"memory");
    #pragma unroll
    for(int i=0;i<4;++i){const int row=i*8+(lane>>3),ch=lane&7; const u32x4 v=*(const u32x4*)(stg+row*64+ch*8); ATTN_STORE16(Ow+(long)row*QP+ch*8,v);} }
  asm volatile("s_waitcnt lgkmcnt(0)\n\ts_barrier":::"memory");
  #undef DMA_K
  #undef DMA_V
  #undef CMASK
  #undef START
  #undef RESC
  #undef ROT
}
constexpr int ATTN_LDS_BYTES=LDS_BYTES;
struct AttnTensors { const bf16* Q; const bf16* K; const bf16* V; bf16* O; };
template<int THRL=8> __device__ __forceinline__ void attn_phase(char*lds,const AttnTensors&T,const QPre&QN,int G,int vcu,bool with_ctx,long ctx_row0){
  const int total=4*NHEAD*NQB;
  for(int i=0;;++i){
    int x,n;
    if(G==256){ if(i>=4)break; x=vcu>>5; n=i*32+(vcu&31); }
    else { const int u=i*G+vcu; if(u>=total)break; x=u>>7; n=u&127; }
    const int b=x>>1,kvh=x&1,h=kvh*4+(n>>5),qb=n&31;
    attn_unit<THRL>(b,h,(long)b*SEQQ+(long)qb*QB,SEQK/KVBLK,qb*QB,QN,T.Q,T.K,T.V,T.O,lds);
  }
  if(with_ctx){
    for(int u=vcu;u<4*NHEAD;u+=G){ const int b=u>>3,h=u&7; attn_unit<THRL>(b,h,ctx_row0+(long)b*256,4,-1,QN,T.Q,T.K,T.V,T.O,lds); }
  }
}
#undef SBAR
#undef WAIT_BAR
}

constexpr int NWAVES = 8, NTHR = 512;
constexpr int DMODEL = 1024, NB = 4, SEQ = 8192, CTXL = 256, NLAT = NB * SEQ, NCTX = NB * CTXL, MT = NLAT + NCTX;
constexpr int INW = 2048, NE = 32, KEYS = SEQ + CTXL;
constexpr int SORT_TILES = 560, SORT_ROWS = SORT_TILES * 256;
constexpr float EPSN = 1e-6f;
constexpr int NCHUNK = 66, CHUNK = 128;
constexpr int NPH_PRO = 2, NPH_LAYER = 13, NPH = NPH_PRO + 2 * NPH_LAYER;

constexpr size_t MiB = 1u << 20;
constexpr size_t WS_CTL = 0, CTL_ZERO_BYTES = 1 * MiB;
constexpr size_t WS_MOD = 1 * MiB, WS_ROPEC = 2 * MiB, WS_ROPES = 3 * MiB, WS_H2 = 4 * MiB, WS_KFC = 10 * MiB, WS_BLKCNT = 12 * MiB, WS_TILEE = 13 * MiB, WS_SCANS = 14 * MiB;
constexpr size_t WS_WINT = 16 * MiB, WS_WOUTT = 24 * MiB, WS_W1T = 32 * MiB, WS_W2T = 288 * MiB, WS_KF = 416 * MiB, WS_KHAT = 448 * MiB, WS_XR = 512 * MiB, WS_H = 644 * MiB;
constexpr size_t WS_U = 712 * MiB, WS_Q = 844 * MiB, WS_K = 877 * MiB, WS_V = 886 * MiB, WS_ATT = 895 * MiB, WS_LAB = 928 * MiB, WS_LRUO = 1060 * MiB, WS_VT = 1093 * MiB, WS_X0T = 1125 * MiB,
                 WS_HYO = 1157 * MiB, WS_MIXA = 1190 * MiB;
constexpr size_t WS_WGT = 11 * MiB, WS_SPT = 10 * MiB + 768 * 1024, WS_XL = 1256 * MiB;
constexpr size_t WS_GC = 10 * MiB + 896 * 1024;
constexpr size_t WS_CB = 10 * MiB + 960 * 1024;
constexpr size_t WS_F = 712 * MiB, WS_ASORT = 778 * MiB, WS_ACT = 1058 * MiB, WS_YS = 1338 * MiB, WS_TOPI = 1618 * MiB, WS_GATE = 1619 * MiB, WS_POS = 1620 * MiB, WS_RSSP = 1622 * MiB, WS_ROWTOK = 1625 * MiB, WS_END = 1626 * MiB;
constexpr size_t LAB_STRIDE = (size_t)MT * 256;
constexpr int CW_BAR = 4096;
constexpr int CW_NTILES = 64;

constexpr int RING_OFF = 0, RING_BYTES = 131072, MOETAB_OFF = 131072, LDSCTL_OFF = 155648, LDS_BYTES = 156160;

#define GAS __attribute__((address_space(1)))
#define LAS __attribute__((address_space(3)))
typedef unsigned short bf16;
typedef unsigned v4u __attribute__((ext_vector_type(4)));
typedef unsigned v2u __attribute__((ext_vector_type(2)));
typedef float f32x4 __attribute__((ext_vector_type(4)));
#define LDS_WAIT() asm volatile("s_waitcnt lgkmcnt(0)" ::: "memory")
#define VM_WAIT() asm volatile("s_waitcnt vmcnt(0)" ::: "memory")
__device__ __forceinline__ unsigned f2bf(float f) { unsigned u = __builtin_bit_cast(unsigned, f); return (u + 0x7fffu + ((u >> 16) & 1u)) >> 16; }
__device__ __forceinline__ unsigned pk2(float lo, float hi) { return f2bf(lo) | (f2bf(hi) << 16); }
__device__ __forceinline__ float bf2f(unsigned short b) { return __builtin_bit_cast(float, (unsigned)b << 16); }
__device__ __forceinline__ float bflo(unsigned w) { return __builtin_bit_cast(float, w << 16); }
__device__ __forceinline__ float bfhi(unsigned w) { return __builtin_bit_cast(float, w & 0xffff0000u); }
__device__ __forceinline__ float wave_sum(float v) {
#pragma unroll
    for (int o = 1; o < 64; o <<= 1) v += __shfl_xor(v, o);
    return v;
}
__device__ __forceinline__ float sigmoidf_(float x) { return 1.0f / (1.0f + __expf(-x)); }
__device__ __forceinline__ void sincos_d(double x, double& s, double& c) {
    const double kd = __builtin_rint(x * 0.63661977236758134308);
    const int k = (int)kd;
    double r = __builtin_fma(-kd, 1.57079632673412561417e+00, x);
    r = __builtin_fma(-kd, 6.07710050650619224932e-11, r);
    const double z = r * r;
    const double ps = r + r * z * (-1.66666666666666324348e-01 + z * (8.33333333332248946124e-03 + z * (-1.98412698298579493134e-04 + z * (2.75573137070700676789e-06 + z * (-2.50507602534068634195e-08 + z * 1.58969099521155010221e-10)))));
    const double pc = 1.0 - 0.5 * z + z * z * (4.16666666666666019037e-02 + z * (-1.38888888888741095749e-03 + z * (2.48015872894767294178e-05 + z * (-2.75573143513906633035e-07 + z * (2.08757232129817482790e-09 + z * -1.13596475577881948265e-11)))));
    const int q = k & 3;
    s = (q == 0) ? ps : (q == 1) ? pc : (q == 2) ? -ps : -pc;
    c = (q == 0) ? pc : (q == 1) ? -ps : (q == 2) ? -pc : ps;
}
__device__ __forceinline__ float gelu_tanh(float x) {
    const float u = 0.7978845608028654f * (x + 0.044715f * x * x * x);
    const float t = 1.0f - 2.0f / (1.0f + __expf(2.0f * u));
    return 0.5f * x * (1.0f + t);
}
__device__ __forceinline__ int lds_add(LAS int* p, int v) { return __hip_atomic_fetch_add(p, v, __ATOMIC_RELAXED, __HIP_MEMORY_SCOPE_WORKGROUP); }

#define FFT_FN __device__ __forceinline__
typedef float f32x2v __attribute__((ext_vector_type(2)));
#define FFT_VEC2 f32x2v
#define FFT_DPTR LAS f32x2v*
#define FFT_LD(D, i) c32_from((D)[i])
#define FFT_ST(D, i, v) ((D)[i] = c32_to(v))
struct __attribute__((aligned(8))) c32 { float x, y; };
FFT_FN c32 cmul(c32 a, c32 b) { c32 r; r.x = a.x * b.x - a.y * b.y; r.y = a.x * b.y + a.y * b.x; return r; }
FFT_FN c32 cadd(c32 a, c32 b) { c32 r; r.x = a.x + b.x; r.y = a.y + b.y; return r; }
FFT_FN c32 csub(c32 a, c32 b) { c32 r; r.x = a.x - b.x; r.y = a.y - b.y; return r; }
FFT_FN c32 cmuli_neg(c32 a) { c32 r; r.x = a.y; r.y = -a.x; return r; }
FFT_FN int fpad(int a) { return a + (a >> 4); }
#ifdef FFT_VEC2
FFT_FN c32 c32_from(FFT_VEC2 t) { c32 r; r.x = t.x; r.y = t.y; return r; }
FFT_FN FFT_VEC2 c32_to(c32 a) { FFT_VEC2 t; t.x = a.x; t.y = a.y; return t; }
#endif
FFT_FN void dft4(c32& a0, c32& a1, c32& a2, c32& a3) {
    const c32 s02 = cadd(a0, a2), d02 = csub(a0, a2), s13 = cadd(a1, a3), d13 = cmuli_neg(csub(a1, a3));
    a0 = cadd(s02, s13); a2 = csub(s02, s13); a1 = cadd(d02, d13); a3 = csub(d02, d13);
}
FFT_FN void dft16(c32 (&v)[16]) {
    const float C1 = 0.92387953251128674f, S1 = 0.38268343236508977f, C2 = 0.70710678118654752f;
#pragma unroll
    for (int q2 = 0; q2 < 4; ++q2) dft4(v[q2], v[4 + q2], v[8 + q2], v[12 + q2]);
    { c32 w;
      w.x = C1; w.y = -S1; v[4 * 1 + 1] = cmul(v[4 * 1 + 1], w);
      w.x = C2; w.y = -C2; v[4 * 2 + 1] = cmul(v[4 * 2 + 1], w);
      w.x = S1; w.y = -C1; v[4 * 3 + 1] = cmul(v[4 * 3 + 1], w);
      w.x = C2; w.y = -C2; v[4 * 1 + 2] = cmul(v[4 * 1 + 2], w);
      v[4 * 2 + 2] = cmuli_neg(v[4 * 2 + 2]);
      w.x = -C2; w.y = -C2; v[4 * 3 + 2] = cmul(v[4 * 3 + 2], w);
      w.x = S1; w.y = -C1; v[4 * 1 + 3] = cmul(v[4 * 1 + 3], w);
      w.x = -C2; w.y = -C2; v[4 * 2 + 3] = cmul(v[4 * 2 + 3], w);
      w.x = -C1; w.y = S1; v[4 * 3 + 3] = cmul(v[4 * 3 + 3], w); }
#pragma unroll
    for (int p1 = 0; p1 < 4; ++p1) dft4(v[4 * p1 + 0], v[4 * p1 + 1], v[4 * p1 + 2], v[4 * p1 + 3]);
#pragma unroll
    for (int a = 0; a < 4; ++a)
#pragma unroll
        for (int b = a + 1; b < 4; ++b) { const c32 t = v[4 * a + b]; v[4 * a + b] = v[4 * b + a]; v[4 * b + a] = t; }
}
FFT_FN c32 twid(int j, int n) { float rev = (float)j / (float)n; asm volatile("" : "+v"(rev)); c32 w; w.x = __builtin_amdgcn_cosf(rev); w.y = -__builtin_amdgcn_sinf(rev); return w; }

FFT_FN void fft_fwd16(FFT_DPTR D, int g, int n) {
    const int s = n >> 4, blk = g / s, j = g - blk * s, base = blk * n + j;
    c32 v[16];
#pragma unroll
    for (int q = 0; q < 16; ++q) v[q] = FFT_LD(D, fpad(base + q * s));
    dft16(v);
    const c32 w = twid(j, n); c32 wp = w;
#pragma unroll
    for (int p = 1; p < 16; ++p) { v[p] = cmul(v[p], wp); wp = cmul(wp, w); }
#pragma unroll
    for (int p = 0; p < 16; ++p) FFT_ST(D, fpad(base + p * s), v[p]);
}
FFT_FN void fft_inv16(FFT_DPTR D, int g, int n) {
    const int s = n >> 4, blk = g / s, j = g - blk * s, base = blk * n + j;
    c32 v[16];
#pragma unroll
    for (int q = 0; q < 16; ++q) v[q] = FFT_LD(D, fpad(base + q * s));
    const c32 w = twid(j, n); c32 wp = w;
#pragma unroll
    for (int p = 1; p < 16; ++p) { v[p] = cmul(v[p], wp); wp = cmul(wp, w); }
    dft16(v);
#pragma unroll
    for (int p = 0; p < 16; ++p) FFT_ST(D, fpad(base + p * s), v[p]);
}
FFT_FN void fft_mid16(FFT_DPTR D, int g, const c32* KH) {
    c32 v[16];
#pragma unroll
    for (int q = 0; q < 16; ++q) v[q] = FFT_LD(D, 17 * g + q);
    dft16(v);
#pragma unroll
    for (int p = 0; p < 16; ++p) { const c32 k = KH[16 * g + p]; const c32 t = cmul(v[p], k); v[p].x = t.x; v[p].y = -t.y; }
    dft16(v);
#pragma unroll
    for (int p = 0; p < 16; ++p) FFT_ST(D, 17 * g + p, v[p]);
}
FFT_FN void fft_last16_out(FFT_DPTR D, int g, c32* OUT, float scale) {
    c32 v[16];
#pragma unroll
    for (int q = 0; q < 16; ++q) v[q] = FFT_LD(D, 17 * g + q);
    dft16(v);
#pragma unroll
    for (int p = 0; p < 16; ++p) { c32 t; t.x = v[p].x * scale; t.y = v[p].y * scale; OUT[16 * g + p] = t; }
}
FFT_FN void fft_first4(FFT_DPTR D, int j, c32 x0, c32 x1, c32 x2, c32 x3) {
    dft4(x0, x1, x2, x3);
    const c32 w = twid(j, 16384), w2 = cmul(w, w), w3 = cmul(w2, w);
    FFT_ST(D, fpad(j), x0); FFT_ST(D, fpad(j + 4096), cmul(x1, w)); FFT_ST(D, fpad(j + 8192), cmul(x2, w2)); FFT_ST(D, fpad(j + 12288), cmul(x3, w3));
}
FFT_FN void fft_final4(FFT_DPTR D, int j, c32& u0, c32& u1) {
    const c32 w = twid(j, 16384), w2 = cmul(w, w), w3 = cmul(w2, w);
    c32 a0 = FFT_LD(D, fpad(j)), a1 = cmul(FFT_LD(D, fpad(j + 4096)), w), a2 = cmul(FFT_LD(D, fpad(j + 8192)), w2), a3 = cmul(FFT_LD(D, fpad(j + 12288)), w3);
    dft4(a0, a1, a2, a3);
    u0 = a0; u1 = a1;
}
FFT_FN void fft_first4_inplace(FFT_DPTR D, int j) {
    c32 x0 = FFT_LD(D, fpad(j)), x1 = FFT_LD(D, fpad(j + 4096)), x2 = FFT_LD(D, fpad(j + 8192)), x3 = FFT_LD(D, fpad(j + 12288));
    fft_first4(D, j, x0, x1, x2, x3);
}
#define XB_TMO      128
#define XB_XCNT(j)  (256  + 64 * (j))
#define XB_XSUB(j)  (1280 + 64 * (j))
#define XB_XGEN(j)  (2304 + 64 * (j))
#define XB_TOP      3328
#define XB_TOPGEN   3392
#define XCD_BAR_WORDS 3456
#define XB_SPIN_CAP (1u << 22)

__device__ __forceinline__ unsigned xb_ld(unsigned* p)              { return __hip_atomic_load(p, __ATOMIC_RELAXED, __HIP_MEMORY_SCOPE_AGENT); }
__device__ __forceinline__ unsigned xb_add(unsigned* p, unsigned v) { return __hip_atomic_fetch_add(p, v, __ATOMIC_RELAXED, __HIP_MEMORY_SCOPE_AGENT); }
__device__ __forceinline__ unsigned xb_xcc_id() { return (unsigned)__builtin_amdgcn_s_getreg((3 << 11) | 20) & 0xFu; }
#define XB_SPIN(cond, bar) do { unsigned _sp = 0; while (cond) { __builtin_amdgcn_s_sleep(1); \
    if ((++_sp & 255u) == 0u) { if (xb_ld(&(bar)[XB_TMO])) break; if (_sp > XB_SPIN_CAP) { atomicAdd(&(bar)[XB_TMO], 1u); break; } } } } while (0)

struct XcdBarrier {
    unsigned* bar; unsigned x;
    volatile LAS unsigned* st;
};

__device__ __forceinline__ XcdBarrier xcd_barrier_post(unsigned* bar, volatile LAS unsigned* st) {
    XcdBarrier b; b.bar = bar; b.x = xb_xcc_id(); b.st = st;
    if (threadIdx.x == 0) (void)xb_add(&bar[XB_XCNT(b.x)], 1u);
    return b;
}
__device__ __forceinline__ void xcd_barrier_complete(unsigned* bar, unsigned x, unsigned& nloc, unsigned& nx) {
    const unsigned G = gridDim.x * gridDim.y * gridDim.z;
    unsigned sum, cnt, mine, sp = 0u;
    for (;;) {
        sum = 0u; cnt = 0u; mine = 0u;
#pragma unroll
        for (unsigned j = 0; j < 16; ++j) { const unsigned c = xb_ld(&bar[XB_XCNT(j)]); sum += c; cnt += (c > 0u) ? 1u : 0u; mine = (j == x) ? c : mine; }
        if (sum == G) break;
        __builtin_amdgcn_s_sleep(1);
        if ((++sp & 255u) == 0u) { if (xb_ld(&bar[XB_TMO])) break; if (sp > XB_SPIN_CAP) { atomicAdd(&bar[XB_TMO], 1u); break; } }
    }
    nloc = mine > 0u ? mine : 1u; nx = cnt > 0u ? cnt : 1u;
}

__device__ __forceinline__ void xcd_barrier(const XcdBarrier& b) {
    asm volatile("s_waitcnt vmcnt(0)" ::: "memory");
    __syncthreads();
    if (threadIdx.x == 0) {
        unsigned* bar = b.bar;
        __builtin_amdgcn_s_waitcnt(0);
        unsigned nloc = b.st[0], nx = b.st[1];
        if (nloc == 0u) { xcd_barrier_complete(bar, b.x, nloc, nx); b.st[0] = nloc; b.st[1] = nx; }
        const unsigned old = xb_add(&bar[XB_XSUB(b.x)], 1u);
        const unsigned gen = old / nloc;
        if (old + 1u == (gen + 1u) * nloc) {
            __builtin_amdgcn_fence(__ATOMIC_RELEASE, "agent");
            asm volatile("s_waitcnt vmcnt(0)" ::: "memory");
            const unsigned og = xb_add(&bar[XB_TOP], 1u);
            const unsigned tg = og / nx;
            if (og + 1u == (tg + 1u) * nx) xb_add(&bar[XB_TOPGEN], 1u);
            else XB_SPIN(xb_ld(&bar[XB_TOPGEN]) == tg, bar);
            __builtin_amdgcn_fence(__ATOMIC_ACQUIRE, "agent");
            xb_add(&bar[XB_XGEN(b.x)], 1u);
            asm volatile("s_waitcnt vmcnt(0)" ::: "memory");
        } else {
            XB_SPIN(xb_ld(&bar[XB_XGEN(b.x)]) == gen, bar);
            __builtin_amdgcn_fence(__ATOMIC_ACQUIRE, "agent");
            asm volatile("s_waitcnt vmcnt(0)" ::: "memory");
        }
    }
    __syncthreads();
}


struct Frame {
    LAS unsigned char* lds; unsigned* ctl; unsigned char* ws;
    int tid, lane, wave, vcu, G, gw, ngw;
};
__device__ const float ROPE_INV[16] = {1.0f, 0.5623413251903491f, 0.31622776601683794f, 0.1778279410038923f, 0.1f, 0.05623413251903491f, 0.03162277660168379f, 0.01778279410038923f,
                                       0.01f, 0.005623413251903491f, 0.0031622776601683794f, 0.001778279410038923f, 0.001f, 0.0005623413251903491f, 0.00031622776601683794f, 0.0001778279410038923f};

__device__ __forceinline__ void p0_transpose_item(const float* W, int K, int N, bf16* WT, LAS float* scr, int item, int lane) {
    const int nblk = N / 32, kb = item / nblk, nb = item % nblk, k0 = 64 * kb, n0 = 32 * nb;
#pragma unroll 8
    for (int i = 0; i < 32; ++i) { const int kk = 2 * i + (lane >> 5); scr[kk * 33 + (lane & 31)] = W[(size_t)(k0 + kk) * N + n0 + (lane & 31)]; }
    LDS_WAIT(); asm volatile("" ::: "memory");
    const int c = lane & 7;
#pragma unroll
    for (int j = 0; j < 4; ++j) { const int n = (lane >> 3) + 8 * j; const LAS float* s = scr + (8 * c) * 33 + n;
        v4u o; o.x = pk2(s[0 * 33], s[1 * 33]); o.y = pk2(s[2 * 33], s[3 * 33]); o.z = pk2(s[4 * 33], s[5 * 33]); o.w = pk2(s[6 * 33], s[7 * 33]);
        *(GAS v4u*)(WT + (size_t)(n0 + n) * K + k0 + 8 * c) = o; }
    LDS_WAIT(); asm volatile("" ::: "memory");
}

__device__ __forceinline__ void ph_prologue_a(const Frame& F, const float* c, const float* cctx, const float* w_mod, const float* b_mod, const float* w_in, const float* w_out,
                                              const float* moe_w1, const float* moe_w2, const float* hy_w1, const float* hy_b1, const float* hy_w2, const float* hy_b2, const float* hy_freq, const float* lru_gw, const float* lru_lam) {
    {
        LAS float* scr = (LAS float*)(F.lds + F.wave * 16384);
        constexpr int I_IN = 2 * 1024, I_OUT = 2 * 512, I_W1 = 64 * 1024, I_W2 = 64 * 512, NIT = I_IN + I_OUT + I_W1 + I_W2;
        bf16* WinT = (bf16*)(F.ws + WS_WINT); bf16* WoutT = (bf16*)(F.ws + WS_WOUTT); bf16* W1T = (bf16*)(F.ws + WS_W1T); bf16* W2T = (bf16*)(F.ws + WS_W2T);
        for (int it = F.gw; it < NIT; it += F.ngw) {
            int r = it;
            if (r < I_IN) { const int m = r >> 10; p0_transpose_item(w_in + (size_t)m * 1024 * 2048, 1024, 2048, WinT + (size_t)m * 2048 * 1024, scr, r & 1023, F.lane); continue; } r -= I_IN;
            if (r < I_OUT) { const int m = r >> 9; p0_transpose_item(w_out + (size_t)m * 1024 * 1024, 1024, 1024, WoutT + (size_t)m * 1024 * 1024, scr, r & 511, F.lane); continue; } r -= I_OUT;
            if (r < I_W1) { const int m = r >> 10; p0_transpose_item(moe_w1 + (size_t)m * 1024 * 2048, 1024, 2048, W1T + (size_t)m * 2048 * 1024, scr, r & 1023, F.lane); continue; } r -= I_W1;
            { const int m = r >> 9; p0_transpose_item(moe_w2 + (size_t)m * 1024 * 1024, 1024, 1024, W2T + (size_t)m * 1024 * 1024, scr, r & 511, F.lane); }
        }
    }
    __syncthreads();
    {
        LAS float* sl = (LAS float*)(F.lds);
        LAS float* red = (LAS float*)(F.lds + 20480);
        float* MOD = (float*)(F.ws + WS_MOD);
        if ((int)blockIdx.x < 192) {
            for (int i = F.tid; i < 5 * 1024; i += NTHR) { const int r = i >> 10, k = i & 1023; const float v = (r < 4) ? c[r * 1024 + k] : cctx[k]; sl[i] = v / (1.0f + __expf(-v)); }
        }
        __syncthreads();
        for (int it = blockIdx.x; it < 192; it += F.G) {
            const int l = it / 96, n = (it % 96) * 64 + F.lane;
            float a0 = 0.f, a1 = 0.f, a2 = 0.f, a3 = 0.f, a4 = 0.f;
            const float* wp = w_mod + ((size_t)l * 1024 + F.wave * 128) * 6144 + n;
#pragma unroll 8
            for (int k = 0; k < 128; ++k) { const float w = wp[(size_t)k * 6144]; const int kk = F.wave * 128 + k;
                a0 += sl[kk] * w; a1 += sl[1024 + kk] * w; a2 += sl[2048 + kk] * w; a3 += sl[3072 + kk] * w; a4 += sl[4096 + kk] * w; }
            red[(F.wave * 5 + 0) * 64 + F.lane] = a0; red[(F.wave * 5 + 1) * 64 + F.lane] = a1; red[(F.wave * 5 + 2) * 64 + F.lane] = a2; red[(F.wave * 5 + 3) * 64 + F.lane] = a3; red[(F.wave * 5 + 4) * 64 + F.lane] = a4;
            __syncthreads();
            if (F.tid < 320) { const int r = F.tid >> 6, ln = F.tid & 63; float s = 0.f;
#pragma unroll
                for (int w = 0; w < 8; ++w) s += red[(w * 5 + r) * 64 + ln];
                const int nn = (it % 96) * 64 + ln; MOD[(size_t)(l * 5 + r) * 6144 + nn] = s + b_mod[l * 6144 + nn]; }
            __syncthreads();
        }
    }
    {
        bf16* WGT = (bf16*)(F.ws + WS_WGT); float* SPT = (float*)(F.ws + WS_SPT);
        for (int idx = blockIdx.x * NTHR + F.tid; idx < 2 * 1024 * 256; idx += F.G * NTHR) {
            const int l = idx >> 18, nidx = (idx >> 8) & 1023, k = idx & 255;
            const int pn = nidx >> 8, j = (nidx >> 7) & 1, cc = nidx & 127, d = pn >> 1, ch = 128 * (pn & 1) + cc, n = ch >> 6, e = ch & 63;
            const float v = ((k >> 6) == n) ? lru_gw[((size_t)((((l * 2 + d) * 2 + j) * 4 + n) * 64 + (k & 63))) * 64 + e] : 0.f;
            WGT[idx] = (bf16)f2bf(v); }
        for (int idx = blockIdx.x * NTHR + F.tid; idx < 2 * 2 * 256; idx += F.G * NTHR) SPT[idx] = log1pf(expf(-lru_lam[idx]));
    }
    {
        float* RC = (float*)(F.ws + WS_ROPEC); float* RS = (float*)(F.ws + WS_ROPES);
        for (int idx = blockIdx.x * NTHR + F.tid; idx < SEQ * 32; idx += F.G * NTHR) {
            const int t = idx >> 5, i = idx & 31; const int pos = (i < 16) ? (t >> 6) : (t & 63);
            const float ang = (float)pos * ROPE_INV[i & 15];
            double s, cc; sincos_d((double)ang, s, cc); RC[idx] = (float)cc; RS[idx] = (float)s; }
    }
    {
        float* H2 = (float*)(F.ws + WS_H2);
        for (int it = F.gw; it < 2 * SEQ + CTXL; it += F.ngw) {
            const int v = it >> 13, t = (v < 2) ? (it & (SEQ - 1)) : (it - 2 * SEQ), L = (v < 2) ? SEQ : CTXL, l = (v == 1) ? 1 : 0;
            const int j = F.lane;
            float z = 0.f;
            if (j == 0) z = (float)t / (float)(L - 1);
            else if (j <= 32) { const int b = (j - 1) & 15; const float band = 1e-4f + (float)b * ((15.0f - 1e-4f) / 15.0f);
                const float ang = ((6.283185307179586f / (float)L) * (float)t) * band;
                double s, cc; sincos_d((double)ang, s, cc); z = (j <= 16) ? (float)cc : -(float)s; }
            const float fr = hy_freq[l * 64 + j];
            float p1 = hy_b1[l * 64 + j];
            const float* w1 = hy_w1 + (size_t)l * 33 * 64;
#pragma unroll
            for (int i = 0; i < 33; ++i) p1 += __shfl(z, i) * w1[i * 64 + j];
            double s1, c1; sincos_d((double)(fr * p1), s1, c1); const float h1 = (float)s1;
            float p2 = hy_b2[l * 64 + j];
            const float* w2 = hy_w2 + (size_t)l * 64 * 64;
#pragma unroll 16
            for (int i = 0; i < 64; ++i) p2 += __shfl(h1, i) * w2[i * 64 + j];
            double s2, c2; sincos_d((double)(fr * p2), s2, c2);
            H2[((size_t)v * SEQ + t) * 64 + j] = (float)s2;
        }
    }
}

__device__ __forceinline__ void ph_prologue_b(const Frame& F, const float* hy_w3, const float* hy_decay, const float* gffn, const float* router_w, const float* router_b) {
    { const float* MOD = (const float*)(F.ws + WS_MOD); float* CB = (float*)(F.ws + WS_CB);
      for (int it = F.gw; it < 2 * 5 * 32; it += F.ngw) { const int lb = it >> 5, e = it & 31, l = lb / 5; const float* sf = MOD + (size_t)lb * 6144 + 3 * 1024; float s = 0.f;
#pragma unroll
          for (int q = 0; q < 16; ++q) { const int cc = 64 * q + F.lane; s += sf[cc] * router_w[(size_t)l * 32768 + cc * 32 + e]; }
          s = wave_sum(s); if (F.lane == 0) CB[it] = s + router_b[l * 32 + e]; } }
    { const float* MOD = (const float*)(F.ws + WS_MOD); float* GC = (float*)(F.ws + WS_GC);
      for (int idx = blockIdx.x * NTHR + F.tid; idx < 2 * 5 * 1024; idx += F.G * NTHR) { const int lb = idx >> 10, cc = idx & 1023, l = lb / 5; GC[idx] = gffn[l * 1024 + cc] * (1.0f + MOD[(size_t)lb * 6144 + 4 * 1024 + cc]); } }
    LAS f32x2v* D = (LAS f32x2v*)(F.lds);
    LAS float* kt = (LAS float*)(F.lds);
    LAS float* w3c = (LAS float*)(F.lds + 139264);
    LAS float* red = (LAS float*)(F.lds + 139264 + 512);
    const float* H2 = (const float*)(F.ws + WS_H2);
    c32* KHAT = (c32*)(F.ws + WS_KHAT); float* KFC = (float*)(F.ws + WS_KFC);
    for (int it = blockIdx.x; it < 768; it += F.G) {
        const int v = it >> 8, c = it & 255, L = (v < 2) ? SEQ : CTXL, l = (v == 1) ? 1 : 0;
        if (F.tid < 128) w3c[F.tid] = hy_w3[(size_t)l * 64 * 512 + (F.tid & 63) * 512 + (F.tid >> 6) * 256 + c];
        if (F.tid == 0) { if (v < 2) { f32x2v z; z.x = 0.f; z.y = 0.f; D[fpad(L)] = z; } else kt[L] = 0.f; }
        __syncthreads();
        const float df = fabsf(hy_decay[l * 512 + c]), db = fabsf(hy_decay[l * 512 + 256 + c]);
        float asum = 0.f;
        for (int t = F.tid; t < L; t += NTHR) {
            const f32x4* row = (const f32x4*)(H2 + ((size_t)v * SEQ + t) * 64);
            float hf = 0.f, hb = 0.f;
#pragma unroll
            for (int q = 0; q < 16; ++q) { const f32x4 h = row[q];
                hf += h.x * w3c[4 * q] + h.y * w3c[4 * q + 1] + h.z * w3c[4 * q + 2] + h.w * w3c[4 * q + 3];
                hb += h.x * w3c[64 + 4 * q] + h.y * w3c[64 + 4 * q + 1] + h.z * w3c[64 + 4 * q + 2] + h.w * w3c[64 + 4 * q + 3]; }
            const float t01 = (float)t / (float)(L - 1);
            hf *= expf(-t01 * df); hb *= expf(-t01 * db);
            asum += fabsf(hf); if (t >= 1) asum += fabsf(hb);
            if (v < 2) { f32x2v z; z.x = hf; z.y = 0.f; D[fpad(t)] = z; if (t >= 1) { z.x = hb; D[fpad(2 * L - t)] = z; } }
            else { kt[t] = hf; if (t >= 1) kt[2 * L - t] = hb; }
        }
        asum = wave_sum(asum);
        if (F.lane == 0) red[F.wave] = asum;
        __syncthreads();
        float tot = 0.f;
#pragma unroll
        for (int w = 0; w < 8; ++w) tot += red[w];
        const float inv = 1.0f / tot;
        if (v < 2) {
            c32* out = KHAT + (size_t)(v * 256 + c) * 16384;
#pragma unroll 1
            for (int i = 0; i < 8; ++i) fft_first4_inplace(D, F.tid + 512 * i);
            __syncthreads();
            _Pragma("unroll 1") for (int g_ = F.tid; g_ < 1024; g_ += 512) fft_fwd16(D, g_, 4096);
            __syncthreads();
            _Pragma("unroll 1") for (int g_ = F.tid; g_ < 1024; g_ += 512) fft_fwd16(D, g_, 256);
            __syncthreads();
            _Pragma("unroll 1") for (int g_ = F.tid; g_ < 1024; g_ += 512) fft_last16_out(D, g_, out, inv * (1.0f / 16384.0f));
        } else {
            float* dst = KFC + (size_t)c * 512;
            for (int j = F.tid; j < 2 * L; j += NTHR) dst[j] = kt[j] * inv;
        }
        __syncthreads();
    }
}

__device__ __forceinline__ void ph_norm_mod(const Frame& F, int l, const float* x, const float* ctx, const float* gmix) {
    const float* XR = (const float*)(F.ws + WS_XR); const float* MOD = (const float*)(F.ws + WS_MOD); bf16* H = (bf16*)(F.ws + WS_H);
    for (int r = F.gw; r < MT; r += F.ngw) {
        const float* src = (l == 0) ? (r < NLAT ? x + (size_t)r * 1024 : ctx + (size_t)(r - NLAT) * 1024) : XR + (size_t)r * 1024;
        const int bidx = r < NLAT ? r / SEQ : 4;
        const float* shift = MOD + (size_t)(l * 5 + bidx) * 6144; const float* scale = shift + 1024; const float* g = gmix + l * 1024;
        f32x4 v[4]; float ss = 0.f;
#pragma unroll
        for (int j = 0; j < 4; ++j) { v[j] = ((const f32x4*)src)[64 * j + F.lane]; ss += (v[j].x * v[j].x + v[j].y * v[j].y) + (v[j].z * v[j].z + v[j].w * v[j].w); }
        const float rstd = 1.0f / sqrtf(wave_sum(ss) * (1.0f / 1024.0f) + EPSN);
#pragma unroll
        for (int j = 0; j < 4; ++j) { const int cb = 64 * j + F.lane; const f32x4 gg = ((const f32x4*)g)[cb], sc = ((const f32x4*)scale)[cb], sh = ((const f32x4*)shift)[cb];
            const f32x4 y = v[j] * rstd * gg * (sc + 1.0f) + sh;
            v2u o; o.x = pk2(y.x, y.y); o.y = pk2(y.z, y.w); ((v2u*)(H + (size_t)r * 1024))[cb] = o; }
    }
}

__device__ __forceinline__ void ph_post_proj(const Frame& F, int l, const float* qg_, const float* kg_, const float* lru_cw, const float* lru_cb, const float* hy_cw, const float* hy_cb) {
    const bf16* U = (const bf16*)(F.ws + WS_U);
    {
        bf16* K = (bf16*)(F.ws + WS_K); bf16* V = (bf16*)(F.ws + WS_V);
        const float* RC = (const float*)(F.ws + WS_ROPEC); const float* RS = (const float*)(F.ws + WS_ROPES);
        const int o8 = 8 * (F.lane & 7), hl = F.lane & 31;
        const f32x4 kg0 = *(const f32x4*)(kg_ + l * 64 + o8), kg1 = *(const f32x4*)(kg_ + l * 64 + o8 + 4);
        const bool lohalf = (F.lane & 4) == 0;
        for (int r2 = 2 * F.gw; r2 < MT; r2 += 2 * F.ngw) {
            const int r = r2 + (F.lane >> 5);
            const bool isctx = r >= NLAT; const int b = isctx ? (r - NLAT) / CTXL : r / SEQ; const int t = isctx ? (r - NLAT) % CTXL : r % SEQ;
            const v4u wk = ((const v4u*)(U + (size_t)r * INW + 512))[hl];
            f32x4 c0 = {1.f, 1.f, 1.f, 1.f}, c1 = c0, s0 = {0.f, 0.f, 0.f, 0.f}, s1 = s0;
            if (!isctx) { const float* rc = RC + t * 32 + 8 * (F.lane & 3); const float* rs = RS + t * 32 + 8 * (F.lane & 3);
                c0 = *(const f32x4*)rc; c1 = *(const f32x4*)(rc + 4); s0 = *(const f32x4*)rs; s1 = *(const f32x4*)(rs + 4); }
            const size_t krow = (size_t)b * KEYS + (isctx ? t : CTXL + t);
            float x[8] = {bflo(wk.x), bfhi(wk.x), bflo(wk.y), bfhi(wk.y), bflo(wk.z), bfhi(wk.z), bflo(wk.w), bfhi(wk.w)};
            float ss = 0.f;
#pragma unroll
            for (int i = 0; i < 8; ++i) ss += x[i] * x[i];
            ss += __shfl_xor(ss, 1); ss += __shfl_xor(ss, 2); ss += __shfl_xor(ss, 4);
            const float rstd = 1.0f / sqrtf(ss * (1.0f / 64.0f) + EPSN);
            float y[8], o[8];
#pragma unroll
            for (int i = 0; i < 8; ++i) y[i] = x[i] * rstd * (i < 4 ? kg0[i] : kg1[i - 4]);
#pragma unroll
            for (int i = 0; i < 8; ++i) { const float p = __shfl_xor(y[i], 4); const float cs = i < 4 ? c0[i] : c1[i - 4], sn = i < 4 ? s0[i] : s1[i - 4];
                o[i] = lohalf ? (y[i] * cs - p * sn) : (y[i] * cs + p * sn); }
            v4u ow; ow.x = pk2(o[0], o[1]); ow.y = pk2(o[2], o[3]); ow.z = pk2(o[4], o[5]); ow.w = pk2(o[6], o[7]);
            if (hl < 16) ((v4u*)(K + krow * 128))[hl] = ow; else ((v4u*)(V + krow * 128))[hl - 16] = wk;
        }
    }
    {
        bf16* XL = (bf16*)(F.ws + WS_XL);
        for (int idx = blockIdx.x * NTHR + F.tid; idx < MT * 32; idx += F.G * NTHR) {
            const int r = idx >> 5, c8 = (idx & 31) * 8;
            const bool isctx = r >= NLAT; const int Ls = isctx ? CTXL : SEQ; const int t = isctx ? (r - NLAT) % CTXL : r % SEQ;
            float acc[8];
#pragma unroll
            for (int i = 0; i < 8; ++i) acc[i] = lru_cb[l * 256 + c8 + i];
#pragma unroll
            for (int j = 0; j < 4; ++j) { const int tj = t + j - 2;
                if (tj >= 0 && tj < Ls) { const v4u w = *(const v4u*)(U + (size_t)(r + j - 2) * INW + 768 + c8);
                    const f32x4 w0 = *(const f32x4*)(lru_cw + (l * 4 + j) * 256 + c8), w1 = *(const f32x4*)(lru_cw + (l * 4 + j) * 256 + c8 + 4);
                    acc[0] += w0.x * bflo(w.x); acc[1] += w0.y * bfhi(w.x); acc[2] += w0.z * bflo(w.y); acc[3] += w0.w * bfhi(w.y);
                    acc[4] += w1.x * bflo(w.z); acc[5] += w1.y * bfhi(w.z); acc[6] += w1.z * bflo(w.w); acc[7] += w1.w * bfhi(w.w); } }
            v4u o; o.x = pk2(acc[0], acc[1]); o.y = pk2(acc[2], acc[3]); o.z = pk2(acc[4], acc[5]); o.w = pk2(acc[6], acc[7]);
            *(v4u*)(XL + (size_t)r * 256 + c8) = o;
        }
    }
    __syncthreads();
    {
        LAS bf16* hs = (LAS bf16*)(F.lds);
        bf16* VT = (bf16*)(F.ws + WS_VT); bf16* X0T = (bf16*)(F.ws + WS_X0T);
        const float* cw = hy_cw + (size_t)l * 3 * 768; const float* cbp = hy_cb + l * 768;
        for (int it = blockIdx.x; it < NLAT / 64; it += F.G) {
            const int b = it >> 7, t0 = (it & 127) * 64;
            for (int i = F.tid; i < 66 * 384; i += NTHR) { const int rr = i / 384, c2 = i - rr * 384; const int t = t0 - 1 + rr;
                unsigned w = 0u; if (t >= 0 && t < SEQ) w = *(const unsigned*)(U + (size_t)(b * SEQ + t) * INW + 1280 + 2 * c2);
                *(LAS unsigned*)(hs + rr * 770 + 2 * c2) = w; }
            __syncthreads();
            for (int c = F.wave; c < 256; c += NWAVES) {
                const int tt = F.lane;
                float o[3];
#pragma unroll
                for (int g = 0; g < 3; ++g) { const int cc = g * 256 + c;
                    o[g] = cw[cc] * bf2f(hs[tt * 770 + cc]) + cw[768 + cc] * bf2f(hs[(tt + 1) * 770 + cc]) + cw[1536 + cc] * bf2f(hs[(tt + 2) * 770 + cc]) + cbp[cc]; }
                const size_t oi = ((size_t)b * 256 + c) * SEQ + t0 + tt;
                VT[oi] = (bf16)f2bf(o[2] * o[1]); X0T[oi] = (bf16)f2bf(o[0]);
            }
            __syncthreads();
        }
    }
}


__device__ __forceinline__ int chunk_row0(int b, int d, int k) {
    if (k < 2) { const int cc = d ? 1 - k : k; return NLAT + b * CTXL + cc * CHUNK; }
    const int lc = d ? 63 - (k - 2) : (k - 2); return b * SEQ + lc * CHUNK;
}
__device__ __forceinline__ void ph_scan1(const Frame& F) {
    const bf16* LAB = (const bf16*)(F.ws + WS_LAB); float* SUMP = (float*)(F.ws + WS_SCANS); float* SUMH = SUMP + NB * 2 * NCHUNK * 256;
    for (int it = blockIdx.x * NTHR + F.tid; it < NB * 2 * NCHUNK * 256; it += F.G * NTHR) {
        const int ch = it & 255, k = (it >> 8) % NCHUNK, bd = (it >> 8) / NCHUNK, d = bd & 1, b = bd >> 1;
        const int r0 = chunk_row0(b, d, k);
        const bf16* LA = LAB + (size_t)(2 * d) * LAB_STRIDE + ch; const bf16* LB = LAB + (size_t)(2 * d + 1) * LAB_STRIDE + ch;
        float h = 0.f, Ps = 0.f;
#pragma unroll 16
        for (int i = 0; i < CHUNK; ++i) { const int r = d ? r0 + CHUNK - 1 - i : r0 + i; const float la = bf2f(LA[(size_t)r * 256]), bx = bf2f(LB[(size_t)r * 256]); h = __builtin_amdgcn_exp2f(la) * h + bx; Ps += la; }
        SUMP[it] = __builtin_amdgcn_exp2f(Ps); SUMH[it] = h;
    }
}
__device__ __forceinline__ void ph_scan2(const Frame& F) {
    const bf16* LAB = (const bf16*)(F.ws + WS_LAB); const float* SUMP = (const float*)(F.ws + WS_SCANS); const float* SUMH = SUMP + NB * 2 * NCHUNK * 256;
    float* LRUO = (float*)(F.ws + WS_LRUO); const bf16* U = (const bf16*)(F.ws + WS_U);
    for (int it = blockIdx.x * NTHR + F.tid; it < NB * NCHUNK * 256; it += F.G * NTHR) {
        const int ch = it & 255, kc = (it >> 8) % NCHUNK, b = (it >> 8) / NCHUNK;
        const int r0 = chunk_row0(b, 0, kc);
#pragma unroll 1
        for (int d = 0; d < 2; ++d) {
            const int k = d ? ((kc < 2) ? 1 - kc : 2 + 63 - (kc - 2)) : kc;
            const size_t sb = (size_t)((b * 2 + d) * NCHUNK) * 256 + ch;
            float h = 0.f;
#pragma unroll 8
            for (int j = 0; j < k; ++j) h = SUMP[sb + (size_t)j * 256] * h + SUMH[sb + (size_t)j * 256];
            const bf16* LA = LAB + (size_t)(2 * d) * LAB_STRIDE + ch; const bf16* LB = LAB + (size_t)(2 * d + 1) * LAB_STRIDE + ch;
            if (d == 0) {
#pragma unroll 16
                for (int i = 0; i < CHUNK; ++i) { const int r = r0 + i; h = __builtin_amdgcn_exp2f(bf2f(LA[(size_t)r * 256])) * h + bf2f(LB[(size_t)r * 256]); LRUO[(size_t)r * 256 + ch] = h; }
            } else {
#pragma unroll 8
                for (int i = 0; i < CHUNK; ++i) { const int r = r0 + CHUNK - 1 - i; h = __builtin_amdgcn_exp2f(bf2f(LA[(size_t)r * 256])) * h + bf2f(LB[(size_t)r * 256]);
                    const float lg = bf2f(U[(size_t)r * INW + 1024 + ch]);
                    LRUO[(size_t)r * 256 + ch] = (LRUO[(size_t)r * 256 + ch] + h) * gelu_tanh(lg); }
            }
        }
    }
}

__device__ __forceinline__ void ph_hyena_fft(const Frame& F, int l, const float* hy_bias) {
    LAS f32x2v* D = (LAS f32x2v*)(F.lds);
    const c32* KHAT = (const c32*)(F.ws + WS_KHAT) + (size_t)l * 256 * 16384;
    const bf16* VT = (const bf16*)(F.ws + WS_VT); const bf16* X0T = (const bf16*)(F.ws + WS_X0T); bf16* HYO = (bf16*)(F.ws + WS_HYO);
    for (int it = blockIdx.x; it < 512; it += F.G) {
        const int c = it >> 1, bp = it & 1;
        const bf16* va = VT + ((size_t)(bp * 2) * 256 + c) * SEQ; const bf16* vb = VT + ((size_t)(bp * 2 + 1) * 256 + c) * SEQ;
#ifndef REP_FFT
#define REP_FFT 1
#endif
#pragma unroll 1
        for (int repf_ = 0; repf_ < REP_FFT; ++repf_) {
#pragma unroll 1
        for (int i = 0; i < 8; ++i) { const int j = F.tid + 512 * i; c32 x0, x1, z; x0.x = bf2f(va[j]); x0.y = bf2f(vb[j]); x1.x = bf2f(va[j + 4096]); x1.y = bf2f(vb[j + 4096]); z.x = 0.f; z.y = 0.f;
            fft_first4(D, j, x0, x1, z, z); }
        __syncthreads();
        _Pragma("unroll 1") for (int g_ = F.tid; g_ < 1024; g_ += 512) fft_fwd16(D, g_, 4096);
        __syncthreads();
        _Pragma("unroll 1") for (int g_ = F.tid; g_ < 1024; g_ += 512) fft_fwd16(D, g_, 256);
        __syncthreads();
        _Pragma("unroll 1") for (int g_ = F.tid; g_ < 1024; g_ += 512) fft_mid16(D, g_, KHAT + (size_t)c * 16384);
        __syncthreads();
        _Pragma("unroll 1") for (int g_ = F.tid; g_ < 1024; g_ += 512) fft_inv16(D, g_, 256);
        __syncthreads();
        _Pragma("unroll 1") for (int g_ = F.tid; g_ < 1024; g_ += 512) fft_inv16(D, g_, 4096);
        __syncthreads();
        }
        const float bias = hy_bias[l * 256 + c];
        const bf16* xa = X0T + ((size_t)(bp * 2) * 256 + c) * SEQ; const bf16* xb = X0T + ((size_t)(bp * 2 + 1) * 256 + c) * SEQ;
        bf16* oa = HYO + ((size_t)(bp * 2) * 256 + c) * SEQ; bf16* ob = HYO + ((size_t)(bp * 2 + 1) * 256 + c) * SEQ;
#pragma unroll 2
        for (int i = 0; i < 8; ++i) { const int j = F.tid + 512 * i; c32 u0, u1; fft_final4(D, j, u0, u1);
            oa[j] = (bf16)f2bf((u0.x + bf2f(va[j]) * bias) * bf2f(xa[j]));                 ob[j] = (bf16)f2bf((-u0.y + bf2f(vb[j]) * bias) * bf2f(xb[j]));
            oa[j + 4096] = (bf16)f2bf((u1.x + bf2f(va[j + 4096]) * bias) * bf2f(xa[j + 4096])); ob[j + 4096] = (bf16)f2bf((-u1.y + bf2f(vb[j + 4096]) * bias) * bf2f(xb[j + 4096])); }
        __syncthreads();
    }
}
__device__ __forceinline__ void ph_hyena_ctx(const Frame& F, const float* hy_bias, const float* hy_cw, const float* hy_cb) {
    float* HYO = (float*)(F.ws + WS_HYO);
    {

        const bf16* U = (const bf16*)(F.ws + WS_U); const float* KFC = (const float*)(F.ws + WS_KFC);
        LAS float* vw = (LAS float*)(F.lds + F.wave * 4096);
        LAS float* kw = vw + 256;
        const float* cw = hy_cw; const float* cbp = hy_cb;
        for (int it = F.gw; it < NB * 256; it += F.ngw) {
            const int b = it >> 8, c = it & 255;
            float x0v[4];
#pragma unroll
            for (int i = 0; i < 4; ++i) { const int t = F.lane + 64 * i;
                float o[3];
#pragma unroll
                for (int g = 0; g < 3; ++g) { const int cc = g * 256 + c; float a = cbp[cc];
#pragma unroll
                    for (int j = 0; j < 3; ++j) { const int tj = t + j - 1; if (tj >= 0 && tj < CTXL) a += cw[j * 768 + cc] * bf2f(U[(size_t)(NLAT + b * CTXL + tj) * INW + 1280 + cc]); }
                    o[g] = a; }
                vw[t] = o[2] * o[1]; x0v[i] = o[0]; }
#pragma unroll
            for (int i = 0; i < 8; ++i) kw[F.lane + 64 * i] = KFC[c * 512 + F.lane + 64 * i];
            LDS_WAIT();
            float y[4] = {0.f, 0.f, 0.f, 0.f};
#pragma unroll 4
            for (int s = 0; s < CTXL; ++s) { const float vv = vw[s];
#pragma unroll
                for (int i = 0; i < 4; ++i) y[i] += kw[(F.lane + 64 * i - s) & 511] * vv; }
            const float bias = hy_bias[c];
#pragma unroll
            for (int i = 0; i < 4; ++i) { const int t = F.lane + 64 * i; HYO[(size_t)(NLAT + b * CTXL + t) * 256 + c] = (y[i] + vw[t] * bias) * x0v[i]; }
            LDS_WAIT();
        }
    }
}

__device__ __forceinline__ void merge_row(const Frame& F, int r, const float* g, float h0, float h1, float h2, float h3) {
    const bf16* ATT = (const bf16*)(F.ws + WS_ATT); const float* LRUO = (const float*)(F.ws + WS_LRUO); bf16* MIXA = (bf16*)(F.ws + WS_MIXA);
    const v4u aw = ((const v4u*)(ATT + (size_t)r * 512))[F.lane];
    float a[8] = {bflo(aw.x), bfhi(aw.x), bflo(aw.y), bfhi(aw.y), bflo(aw.z), bfhi(aw.z), bflo(aw.w), bfhi(aw.w)};
    float ss = 0.f;
#pragma unroll
    for (int i = 0; i < 8; ++i) ss += a[i] * a[i];
    const float ra = 1.0f / sqrtf(wave_sum(ss) * (1.0f / 512.0f) + EPSN);
    const f32x4 lv = ((const f32x4*)(LRUO + (size_t)r * 256))[F.lane];
    const float rl = 1.0f / sqrtf(wave_sum(lv.x * lv.x + lv.y * lv.y + lv.z * lv.z + lv.w * lv.w) * (1.0f / 256.0f) + EPSN);
    const float rh = 1.0f / sqrtf(wave_sum(h0 * h0 + h1 * h1 + h2 * h2 + h3 * h3) * (1.0f / 256.0f) + EPSN);
    bf16* orow = MIXA + (size_t)r * 1024;
    { const f32x4 g0 = ((const f32x4*)g)[2 * F.lane], g1 = ((const f32x4*)g)[2 * F.lane + 1];
      v4u o; o.x = pk2(a[0] * ra * g0.x, a[1] * ra * g0.y); o.y = pk2(a[2] * ra * g0.z, a[3] * ra * g0.w); o.z = pk2(a[4] * ra * g1.x, a[5] * ra * g1.y); o.w = pk2(a[6] * ra * g1.z, a[7] * ra * g1.w);
      ((v4u*)orow)[F.lane] = o; }
    { const f32x4 gg = ((const f32x4*)(g + 512))[F.lane]; v2u o; o.x = pk2(lv.x * rl * gg.x, lv.y * rl * gg.y); o.y = pk2(lv.z * rl * gg.z, lv.w * rl * gg.w); ((v2u*)(orow + 512))[F.lane] = o; }
    orow[768 + F.lane] = (bf16)f2bf(h0 * rh * g[768 + F.lane]); orow[832 + F.lane] = (bf16)f2bf(h1 * rh * g[832 + F.lane]);
    orow[896 + F.lane] = (bf16)f2bf(h2 * rh * g[896 + F.lane]); orow[960 + F.lane] = (bf16)f2bf(h3 * rh * g[960 + F.lane]);
}
__device__ __forceinline__ void ph_merge(const Frame& F, int l, int nrows, const float* out_g) {
    const float* HYO = (const float*)(F.ws + WS_HYO);
    const float* g = out_g + l * 1024;
    LAS float* tile = (LAS float*)(F.lds);
    for (int it = blockIdx.x; it < NLAT / 64; it += F.G) {
        const int b = it >> 7, t0 = (it & 127) * 64;
#pragma unroll 8
        for (int i = 0; i < 32; ++i) { const int c = F.wave * 32 + i; tile[c * 65 + F.lane] = bf2f(((const bf16*)HYO)[((size_t)b * 256 + c) * SEQ + t0 + F.lane]); }
        __syncthreads();
#pragma unroll 2
        for (int k = 0; k < 8; ++k) { const int tt = F.wave * 8 + k;
            merge_row(F, b * SEQ + t0 + tt, g, tile[F.lane * 65 + tt], tile[(F.lane + 64) * 65 + tt], tile[(F.lane + 128) * 65 + tt], tile[(F.lane + 192) * 65 + tt]); }
        __syncthreads();
    }
    for (int r = NLAT + F.gw; r < nrows; r += F.ngw) {
        const float* hr = HYO + (size_t)r * 256;
        merge_row(F, r, g, hr[F.lane], hr[64 + F.lane], hr[128 + F.lane], hr[192 + F.lane]);
    }
}


__device__ __forceinline__ void ph_ffn_router(const Frame& F, int l, int nrows, const float* router_w) {
    LAS float* rwl = (LAS float*)(F.lds);
    LAS float* cbl = (LAS float*)(F.lds + 147456);
    LAS int* hist = (LAS int*)(F.lds + 147456 + 640);
    const bf16* XR = (const bf16*)(F.ws + WS_XR); const float* RSSP = (const float*)(F.ws + WS_RSSP); const float* MOD = (const float*)(F.ws + WS_MOD);
    const float* GC = (const float*)(F.ws + WS_GC) + (size_t)l * 5 * 1024; bf16* Fb = (bf16*)(F.ws + WS_F);
    int* TOPI = (int*)(F.ws + WS_TOPI); float* GATE = (float*)(F.ws + WS_GATE); int* BLKCNT = (int*)(F.ws + WS_BLKCNT);
    for (int i = F.tid; i < 1024 * 32; i += NTHR) rwl[(i >> 5) * 36 + (i & 31)] = router_w[(size_t)l * 32768 + i];
    if (F.tid < 32) hist[F.tid] = 0;
    if (F.tid < 160) cbl[F.tid] = ((const float*)(F.ws + WS_CB))[l * 160 + F.tid];
    __syncthreads();
    const int j = F.lane & 15, kq = F.lane >> 4;
    for (int grp = F.gw; grp < nrows / 16; grp += F.ngw) {
        const int r0 = grp * 16, r = r0 + j; const int bidx = r0 < NLAT ? r0 / SEQ : 4;
        const bf16* xrow = XR + (size_t)r * 1024 + 4 * kq; const float* gcp = GC + bidx * 1024 + 4 * kq; const float* sfp = MOD + (size_t)(l * 5 + bidx) * 6144 + 3 * 1024 + 4 * kq;
        bf16* frow = Fb + (size_t)r * 1024 + 4 * kq;
        float ss; { const f32x4 q = *(const f32x4*)(RSSP + (size_t)r * 16 + 4 * kq); ss = (q.x + q.y) + (q.z + q.w); }
        ss += __shfl_xor(ss, 16); ss += __shfl_xor(ss, 32);
        const float rstd = 1.0f / sqrtf(ss * (1.0f / 1024.0f) + EPSN);
        f32x4 acc0 = {0.f, 0.f, 0.f, 0.f}, acc1 = acc0;
#pragma unroll 1
        for (int ib = 0; ib < 64; ib += 8) {
            v2u xw[8]; f32x4 g4[8], s4[8];
#pragma unroll
            for (int u = 0; u < 8; ++u) { xw[u] = *(const v2u*)(xrow + 16 * (ib + u)); g4[u] = *(const f32x4*)(gcp + 16 * (ib + u)); s4[u] = *(const f32x4*)(sfp + 16 * (ib + u)); }
#pragma unroll
            for (int u = 0; u < 8; ++u) {
                const f32x4 x4 = {bflo(xw[u].x), bfhi(xw[u].x), bflo(xw[u].y), bfhi(xw[u].y)};
                const f32x4 xb = x4 * g4[u];
                const f32x4 fv = xb * rstd + s4[u];
                v2u o; o.x = pk2(fv.x, fv.y); o.y = pk2(fv.z, fv.w); *(v2u*)(frow + 16 * (ib + u)) = o;
                const LAS float* wp = rwl + (16 * (ib + u) + 4 * kq) * 36 + j;
#pragma unroll
                for (int e = 0; e < 4; ++e) { acc0 = __builtin_amdgcn_mfma_f32_16x16x4f32(wp[e * 36], xb[e], acc0, 0, 0, 0); acc1 = __builtin_amdgcn_mfma_f32_16x16x4f32(wp[e * 36 + 16], xb[e], acc1, 0, 0, 0); }
            }
        }
        float lg[8];
#pragma unroll
        for (int rr = 0; rr < 4; ++rr) { lg[rr] = rstd * acc0[rr] + cbl[bidx * 32 + 4 * kq + rr]; lg[4 + rr] = rstd * acc1[rr] + cbl[bidx * 32 + 16 + 4 * kq + rr]; }
        float p[32];
#pragma unroll
        for (int e = 0; e < 32; ++e) p[e] = __shfl(lg[(e >> 4) * 4 + (e & 3)], j + 16 * ((e & 15) >> 2));
        unsigned taken = 0u; float tv[4]; int ti[4];
#pragma unroll
        for (int k = 0; k < 4; ++k) { float best = -INFINITY; int bi = 0;
#pragma unroll
            for (int e = 0; e < 32; ++e) { const bool ok = !((taken >> e) & 1u) && (p[e] > best); best = ok ? p[e] : best; bi = ok ? e : bi; }
            taken |= 1u << bi; tv[k] = best; ti[k] = bi; }
        const float e1 = __expf(tv[1] - tv[0]), e2 = __expf(tv[2] - tv[0]), e3 = __expf(tv[3] - tv[0]); const float inv = 1.0f / (1.0f + e1 + e2 + e3);
        if (kq == 0) {
            TOPI[r * 4 + 0] = ti[0]; TOPI[r * 4 + 1] = ti[1]; TOPI[r * 4 + 2] = ti[2]; TOPI[r * 4 + 3] = ti[3];
            GATE[r * 4 + 0] = inv; GATE[r * 4 + 1] = e1 * inv; GATE[r * 4 + 2] = e2 * inv; GATE[r * 4 + 3] = e3 * inv;
            lds_add(&hist[ti[0]], 1); lds_add(&hist[ti[1]], 1); lds_add(&hist[ti[2]], 1); lds_add(&hist[ti[3]], 1);
        }
    }
    __syncthreads();
    if (F.tid < 32) BLKCNT[blockIdx.x * 32 + F.tid] = hist[F.tid];
}

__device__ __forceinline__ void ph_route(const Frame& F, int nrows) {
    LAS int* cursor = (LAS int*)(F.lds);
    LAS int* tot = cursor + 32;
    LAS int* mine = cursor + 64;
    LAS int* part = cursor + 96;
    LAS int* ebase = cursor + 96 + 1024;
    const int* BLKCNT = (const int*)(F.ws + WS_BLKCNT); const int* TOPI = (const int*)(F.ws + WS_TOPI); int* POS = (int*)(F.ws + WS_POS);
    int* ROWTOK = (int*)(F.ws + WS_ROWTOK); int* TILEE = (int*)(F.ws + WS_TILEE);
    { const int e = F.tid & 31, sl = F.tid >> 5; int t = 0, m = 0;
      for (int b = sl; b < F.G; b += 16) { const int v = BLKCNT[b * 32 + e]; t += v; m += (b < (int)blockIdx.x) ? v : 0; }
      part[sl * 64 + e] = t; part[sl * 64 + 32 + e] = m;
      __syncthreads();
      if (F.tid < 32) { int tt = 0, mm = 0;
#pragma unroll
          for (int s = 0; s < 16; ++s) { tt += part[s * 64 + F.tid]; mm += part[s * 64 + 32 + F.tid]; }
          tot[F.tid] = tt; mine[F.tid] = mm; } }
    __syncthreads();
    if (F.tid == 0) { int tb = 0;
        for (int e = 0; e < 32; ++e) { const int nt = (tot[e] + 255) >> 8; cursor[e] = tb * 256 + mine[e]; ebase[e] = tb * 256;
            if (blockIdx.x == 0) for (int j = 0; j < nt; ++j) TILEE[tb + j] = e;
            tb += nt; }
        ebase[32] = tb * 256;
        if (blockIdx.x == 0) F.ctl[CW_NTILES] = (unsigned)tb; }
    __syncthreads();
    for (int e = blockIdx.x; e < 32; e += F.G) for (int p = ebase[e] + tot[e] + F.tid; p < ebase[e + 1]; p += NTHR) ROWTOK[p] = 0;
    const int sub = F.lane >> 2, k = F.lane & 3;
    for (int grp = F.gw; grp < nrows / 16; grp += F.ngw) {
        const int r = grp * 16 + sub; const int e = TOPI[r * 4 + k]; const int pos = lds_add(&cursor[e], 1); POS[r * 4 + k] = pos; ROWTOK[pos] = r; }
}

__device__ __forceinline__ void ph_combine(const Frame& F, int l, int nrows, float* out, const float* gmix) {
    bf16* XR = (bf16*)(F.ws + WS_XR); const float* MOD = (const float*)(F.ws + WS_MOD); const bf16* YS = (const bf16*)(F.ws + WS_YS); bf16* H = (bf16*)(F.ws + WS_H);
    const int* POS = (const int*)(F.ws + WS_POS); const float* GATE = (const float*)(F.ws + WS_GATE);
    for (int r = 2 * F.gw; r < nrows; r += 2 * F.ngw) {
        const int bidx = r < NLAT ? r / SEQ : 4;
        const float* gf = MOD + (size_t)(l * 5 + bidx) * 6144 + 5 * 1024;
        int pos = 0; float gt = 0.f;
        if (F.lane < 8) { pos = POS[r * 4 + F.lane]; gt = GATE[r * 4 + F.lane]; }
        v2u w[2][4][4], xw[2][4]; float gk[2][4];
#pragma unroll
        for (int rr = 0; rr < 2; ++rr)
#pragma unroll
            for (int k = 0; k < 4; ++k) { const int pk = __shfl(pos, rr * 4 + k); gk[rr][k] = __shfl(gt, rr * 4 + k); const v2u* yr = (const v2u*)(YS + (size_t)pk * 1024);
#pragma unroll
                for (int j = 0; j < 4; ++j) w[rr][k][j] = yr[64 * j + F.lane]; }
#pragma unroll
        for (int rr = 0; rr < 2; ++rr)
#pragma unroll
            for (int j = 0; j < 4; ++j) xw[rr][j] = ((const v2u*)(XR + (size_t)(r + rr) * 1024))[64 * j + F.lane];
        f32x4 gv[4];
#pragma unroll
        for (int j = 0; j < 4; ++j) gv[j] = ((const f32x4*)gf)[64 * j + F.lane];
#pragma unroll
        for (int rr = 0; rr < 2; ++rr) {
            const int row = r + rr;
            f32x4 y[4]; float ss = 0.f;
#pragma unroll
            for (int j = 0; j < 4; ++j) { f32x4 a = {0.f, 0.f, 0.f, 0.f};
#pragma unroll
                for (int k = 0; k < 4; ++k) { const v2u ww = w[rr][k][j]; const float g_ = gk[rr][k]; a.x += g_ * bflo(ww.x); a.y += g_ * bfhi(ww.x); a.z += g_ * bflo(ww.y); a.w += g_ * bfhi(ww.y); }
                const f32x4 xv = {bflo(xw[rr][j].x), bfhi(xw[rr][j].x), bflo(xw[rr][j].y), bfhi(xw[rr][j].y)};
                y[j] = xv + gv[j] * a;
                const int cb = 64 * j + F.lane;
                if (l == 0) { v2u o; o.x = pk2(y[j].x, y[j].y); o.y = pk2(y[j].z, y[j].w); ((v2u*)(XR + (size_t)row * 1024))[cb] = o; } else ((f32x4*)(out + (size_t)row * 1024))[cb] = y[j];
                ss += (y[j].x * y[j].x + y[j].y * y[j].y) + (y[j].z * y[j].z + y[j].w * y[j].w); }
            if (l == 0) {
                const float rstd = 1.0f / sqrtf(wave_sum(ss) * (1.0f / 1024.0f) + EPSN);
                const float* shift = MOD + (size_t)(5 + bidx) * 6144; const float* scale = shift + 1024; const float* g = gmix + 1024;
#pragma unroll
                for (int j = 0; j < 4; ++j) { const int cb = 64 * j + F.lane; const f32x4 gg = ((const f32x4*)g)[cb], sc = ((const f32x4*)scale)[cb], sh = ((const f32x4*)shift)[cb];
                    const f32x4 hv = y[j] * rstd * gg * (sc + 1.0f) + sh;
                    v2u o; o.x = pk2(hv.x, hv.y); o.y = pk2(hv.z, hv.w); ((v2u*)(H + (size_t)row * 1024))[cb] = o; }
            }
        }
    }
}

struct Args { const float* in[34]; float* out; unsigned char* ws; int ph_lo, ph_hi; };
enum { I_X = 0, I_C, I_CTX, I_CCTX, I_WMOD, I_BMOD, I_GMIX, I_GFFN, I_WIN, I_QG, I_KG, I_LCW, I_LCB, I_LGW, I_LGB, I_LLAM, I_HCW, I_HCB, I_HW1, I_HB1, I_HW2, I_HB2, I_HW3, I_HFREQ, I_HDEC, I_HBIAS,
       I_OUTG, I_WOUT, I_RW, I_RB, I_MW1, I_MB1, I_MW2, I_MB2 };

__global__ void __launch_bounds__(NTHR, 2) mk_fwd(Args args) {
    extern __shared__ __attribute__((aligned(16))) unsigned char lds[];
    Frame F;
    F.lds = (LAS unsigned char*)lds; F.ws = args.ws; F.ctl = (unsigned*)(args.ws + WS_CTL);
    F.tid = threadIdx.x; F.lane = F.tid & 63; F.wave = __builtin_amdgcn_readfirstlane(F.tid >> 6);
    F.G = gridDim.x; { const int bx = blockIdx.x; F.vcu = (F.G % 8 == 0) ? (bx % 8) * (F.G / 8) + bx / 8 : bx; }
    F.gw = (int)blockIdx.x * NWAVES + F.wave; F.ngw = F.G * NWAVES;
    for (int u = F.tid; u < (LDS_BYTES - LDSCTL_OFF) / 4; u += NTHR) ((LAS unsigned*)(F.lds + LDSCTL_OFF))[u] = 0u;
    __syncthreads();
#if !MK_PER_PHASE
    XcdBarrier bar = xcd_barrier_post(F.ctl + CW_BAR, (volatile LAS unsigned*)(F.lds + LDSCTL_OFF + 32));
#define GRID_BAR() xcd_barrier(bar)
#else
#define GRID_BAR() do { } while (0)
#endif
    const int lo = args.ph_lo, hi = args.ph_hi;
#ifndef ONLY_PHASE
#define ONLY_PHASE (-1)
#endif
#define ENABLED(id) (ONLY_PHASE < 0 || ONLY_PHASE == (id))
#define IN(k) (ENABLED(k) && lo <= (k) && (k) < hi)
#define INL(j) (ENABLED(NPH_PRO + (j)) && lo <= pb + (j) && pb + (j) < hi)
#define SEAML(j) do { if (lo <= pb + (j) && pb + (j) + 1 < hi) { GRID_BAR(); } } while (0)
typedef const __attribute__((address_space(4))) Args* KArgs;
#ifndef REP_MASK
#define REP_MASK 0
#endif
#define NREP(j) (((REP_MASK >> (j)) & 1) ? 2 : 1)
#define REFRAME() Frame Fp = F; KArgs ka = (KArgs)__builtin_amdgcn_kernarg_segment_ptr(); { int t_ = F.tid; asm volatile("" : "+v"(t_), "+s"(ka)); Fp.tid = t_; Fp.lane = t_ & 63; Fp.wave = __builtin_amdgcn_readfirstlane(t_ >> 6); \
    Fp.gw = (int)blockIdx.x * NWAVES + Fp.wave; Fp.ws = ka->ws; Fp.ctl = (unsigned*)(ka->ws + WS_CTL); }
#define SEAM(k) do { if (lo <= (k) && (k) + 1 < hi) { GRID_BAR(); } } while (0)

    if (IN(0)) ph_prologue_a(F, args.in[I_C], args.in[I_CCTX], args.in[I_WMOD], args.in[I_BMOD], args.in[I_WIN], args.in[I_WOUT], args.in[I_MW1], args.in[I_MW2],
                             args.in[I_HW1], args.in[I_HB1], args.in[I_HW2], args.in[I_HB2], args.in[I_HFREQ], args.in[I_LGW], args.in[I_LLAM]);
    SEAM(0);
    if (IN(1)) ph_prologue_b(F, args.in[I_HW3], args.in[I_HDEC], args.in[I_GFFN], args.in[I_RW], args.in[I_RB]);
    SEAM(1);

#ifndef MOE_WGM1
#define MOE_WGM1 4
#endif
#ifndef MOE_WGM2
#define MOE_WGM2 8
#endif
#define PHASE(j, ...) if (INL(j)) { _Pragma("unroll") for (int rep_ = 0; rep_ < NREP(j); ++rep_) { { REFRAME(); __VA_ARGS__ } if (rep_ + 1 < NREP(j)) GRID_BAR(); } }
#define LAYER_BODY(l) { \
        const int pb = NPH_PRO + l * NPH_LAYER; \
        const int nrows = (l == 0) ? MT : NLAT; \
        if (l == 0) { PHASE(0, ph_norm_mod(Fp, l, ka->in[I_X], ka->in[I_CTX], ka->in[I_GMIX]);) SEAML(0); } \
        PHASE(1, \
            pg8::Gemm g{(const bf16*)(Fp.ws + WS_H), (const bf16*)(Fp.ws + WS_WINT) + (size_t)l * 2048 * 1024, MT, 2048, 1024}; \
            pg8::StaticOrder S; S.init(MT, 2048, Fp.G, (int)blockIdx.x); \
            pg8::EpiBf16<0> E{(bf16*)(Fp.ws + WS_U), 2048, nullptr, 0, 0, 1.f}; \
            pg8::gemm_phase<pg8::EpiBf16<0>, pg8::StaticOrder, PG8_ALIGN, PG8_SP2>(Fp.lds + RING_OFF, g, S, E);) \
        SEAML(1); \
        PHASE(2, ph_post_proj(Fp, l, ka->in[I_QG], ka->in[I_KG], ka->in[I_LCW], ka->in[I_LCB], ka->in[I_HCW], ka->in[I_HCB]);) \
        SEAML(2); \
        PHASE(3, \
            int kg_ = 256; asm volatile("" : "+s"(kg_)); \
            pg8::Gemm g{(const bf16*)(Fp.ws + WS_XL), (const bf16*)(Fp.ws + WS_WGT) + (size_t)l * 1024 * 256, MT, 1024, kg_}; \
            pg8::StaticOrder S; S.init(MT, 1024, Fp.G, (int)blockIdx.x); \
            pg8::EpiLruGate E{(const bf16*)(Fp.ws + WS_XL), (bf16*)(Fp.ws + WS_LAB), LAB_STRIDE, ka->in[I_LGB] + (size_t)l * 1024, (const float*)(Fp.ws + WS_SPT) + l * 512}; \
            pg8::gemm_phase<pg8::EpiLruGate, pg8::StaticOrder, PG8_ALIGN, PG8_SP2>(Fp.lds + RING_OFF, g, S, E);) \
        SEAML(3); \
        PHASE(4, \
            ph_scan1(Fp); __syncthreads(); \
            const attn_body::AttnTensors AT{(const attn_body::bf16*)(Fp.ws + WS_U), (const attn_body::bf16*)(Fp.ws + WS_K), (const attn_body::bf16*)(Fp.ws + WS_V), (attn_body::bf16*)(Fp.ws + WS_ATT)}; \
            const attn_body::QPre QN{ka->in[I_QG] + l * 64, (const float*)(Fp.ws + WS_ROPEC), (const float*)(Fp.ws + WS_ROPES)}; \
            attn_body::attn_phase<8>((char*)lds + RING_OFF, AT, QN, Fp.G, Fp.vcu, l == 0, (long)NLAT);) \
        SEAML(4); \
        PHASE(5, ph_scan2(Fp); __syncthreads(); ph_hyena_fft(Fp, l, ka->in[I_HBIAS]); if (l == 0) ph_hyena_ctx(Fp, ka->in[I_HBIAS], ka->in[I_HCW], ka->in[I_HCB]);) \
        SEAML(5); \
        PHASE(6, ph_merge(Fp, l, nrows, ka->in[I_OUTG]);) \
        SEAML(6); \
        if (INL(7)) { REFRAME(); \
            pg8::Gemm g{(const bf16*)(Fp.ws + WS_MIXA), (const bf16*)(Fp.ws + WS_WOUTT) + (size_t)l * 1024 * 1024, nrows, 1024, 1024}; \
            pg8::StaticOrder S; S.init(nrows, 1024, Fp.G, (int)blockIdx.x); \
            bf16* XR = (bf16*)(Fp.ws + WS_XR); \
            pg8::EpiResid<(l) == 1> E{ka->in[I_X], ka->in[I_CTX], NLAT, XR, 1024, \
                            (const float*)(Fp.ws + WS_MOD) + (size_t)(l * 5) * 6144 + 2 * 1024, 6144, SEQ, (float*)(Fp.ws + WS_RSSP)}; \
            pg8::gemm_phase<pg8::EpiResid<(l) == 1>, pg8::StaticOrder, PG8_ALIGN, PG8_SP2>(Fp.lds + RING_OFF, g, S, E); \
        } \
        SEAML(7); \
        PHASE(8, ph_ffn_router(Fp, l, nrows, ka->in[I_RW]);) \
        SEAML(8); \
        PHASE(9, ph_route(Fp, nrows);) \
        SEAML(9); \
        if (INL(10) || INL(11)) { REFRAME(); \
            LAS int* tab = (LAS int*)(Fp.lds + MOETAB_OFF); \
            const int ntiles = (int)__hip_atomic_load(Fp.ctl + CW_NTILES, __ATOMIC_RELAXED, __HIP_MEMORY_SCOPE_AGENT); \
            const int* TILEE = (const int*)(Fp.ws + WS_TILEE); \
            for (int i = Fp.tid; i < ntiles && i < SORT_TILES; i += NTHR) tab[i] = TILEE[i]; \
            __syncthreads(); \
            if (INL(10)) { _Pragma("unroll") for (int rep_ = 0; rep_ < NREP(10); ++rep_) { { \
                pg8::Gemm g{(const bf16*)(Fp.ws + WS_F), (const bf16*)(Fp.ws + WS_W1T) + (size_t)l * 32 * 2048 * 1024, 0, 2048, 1024}; \
                pg8::MoeOrderT<true> S; S.init(tab, ntiles, 8, Fp.G, (int)blockIdx.x, MOE_WGM1); S.rowtok = (const int*)(Fp.ws + WS_ROWTOK); \
                pg8::EpiSwiglu E{(bf16*)(Fp.ws + WS_ACT), 1024, ka->in[I_MB1] + (size_t)l * 32 * 2048, 2048}; \
                pg8::gemm_phase<pg8::EpiSwiglu, pg8::MoeOrderT<true>, PG8_ALIGN, PG8_SP2>(Fp.lds + RING_OFF, g, S, E); \
             } if (rep_ + 1 < NREP(10)) GRID_BAR(); } } \
            SEAML(10); \
            if (INL(11)) { _Pragma("unroll") for (int rep_ = 0; rep_ < NREP(11); ++rep_) { { \
                pg8::Gemm g{(const bf16*)(Fp.ws + WS_ACT), (const bf16*)(Fp.ws + WS_W2T) + (size_t)l * 32 * 1024 * 1024, 0, 1024, 1024}; \
                pg8::MoeOrderT<false> S; S.init(tab, ntiles, 4, Fp.G, (int)blockIdx.x, MOE_WGM2); S.rowtok = nullptr; S.rev = 1; \
                pg8::EpiBf16Bias E{(bf16*)(Fp.ws + WS_YS), 1024, ka->in[I_MB2] + (size_t)l * 32 * 1024, 1024}; \
                pg8::gemm_phase<pg8::EpiBf16Bias, pg8::MoeOrderT<false>, PG8_ALIGN, PG8_SP2>(Fp.lds + RING_OFF, g, S, E); \
             } if (rep_ + 1 < NREP(11)) GRID_BAR(); } } \
        } \
        SEAML(11); \
        if (INL(12)) { REFRAME(); ph_combine(Fp, l, nrows, ka->out, ka->in[I_GMIX]); } \
        if (l == 0) { SEAML(12); } \
    }
    LAYER_BODY(0)
    LAYER_BODY(1)
#undef LAYER_BODY
#undef PHASE
#undef IN
#undef SEAM
#undef INL
#undef SEAML
}

extern "C" void kernel_launch(void* const* d_in, const int* in_sizes, int n_in, void* d_out, int out_size, void* d_ws, size_t ws_size, hipStream_t stream) {
    static int grid = 0;
    if (grid == 0) {
        if (n_in != 34 || in_sizes[0] != NLAT * DMODEL || out_size != NLAT * DMODEL || ws_size < WS_END) {
            fprintf(stderr, "kernel_launch: unexpected shapes (n_in %d, in0 %d, out %d, ws %zu); nothing launched\n", n_in, n_in > 0 ? in_sizes[0] : -1, out_size, ws_size); grid = -1; return; }
        int dev = 0, cus = 0;
        if (hipGetDevice(&dev) != hipSuccess || hipDeviceGetAttribute(&cus, hipDeviceAttributeMultiprocessorCount, dev) != hipSuccess) { grid = -1; return; }
        if (hipFuncSetAttribute((const void*)mk_fwd, hipFuncAttributeMaxDynamicSharedMemorySize, LDS_BYTES) != hipSuccess) { fprintf(stderr, "kernel_launch: hipFuncSetAttribute failed\n"); grid = -1; return; }
        int per_cu = 0;
        if (hipOccupancyMaxActiveBlocksPerMultiprocessor(&per_cu, (const void*)mk_fwd, NTHR, LDS_BYTES) != hipSuccess || per_cu < 1) { fprintf(stderr, "kernel_launch: occupancy query says %d\n", per_cu); }
        (void)hipGetLastError();
        grid = cus;
    }
    if (grid < 0) return;
    if (hipMemsetAsync((char*)d_ws + WS_CTL, 0, CTL_ZERO_BYTES, stream) != hipSuccess) return;
    Args a{};
    for (int i = 0; i < 34; ++i) a.in[i] = (const float*)d_in[i];
    a.out = (float*)d_out; a.ws = (unsigned char*)d_ws;
#if MK_PER_PHASE
    for (int p = 0; p < NPH; ++p) { a.ph_lo = p; a.ph_hi = p + 1; hipLaunchKernelGGL(mk_fwd, dim3(grid), dim3(NTHR), LDS_BYTES, stream, a); }
#else
    a.ph_lo = 0; a.ph_hi = NPH;
    hipLaunchKernelGGL(mk_fwd, dim3(grid), dim3(NTHR), LDS_BYTES, stream, a);
#endif
}
```

```cpp
#include <hip/hip_runtime.h>
#include <hip/hip_bf16.h>
#include <cstdio>
#include <cstdint>
#include <cmath>
#ifndef MK_PER_PHASE
#define MK_PER_PHASE 0
#endif
namespace pg8 {
#define PG8_LAS __attribute__((address_space(3)))
typedef unsigned short bf16_t;
typedef short bf16x8 __attribute__((ext_vector_type(8)));
typedef float f32x4 __attribute__((ext_vector_type(4)));
typedef unsigned u32x4 __attribute__((ext_vector_type(4)));
constexpr int BM = 256, BK = 64, HALF = 128, HTB = HALF * BK * 2  , STAGE_BYTES = 8 * HTB, NXCD = 8, WGM = 8;

__host__ __device__ __forceinline__ int lds_byte(int r, int c) { const int st = (r >> 4) * 2 + (c >> 5), rr = r & 15, cc = c & 31, ob = rr * 64 + cc * 2; return st * 1024 + (ob ^ (((ob >> 9) & 1) << 5)); }
__host__ __device__ __forceinline__ void stage_rc(int b, int& R, int& C) { const int st = b / 1024, sb = b % 1024, swz = sb ^ (((sb >> 9) & 1) << 5); R = (st >> 1) * 16 + swz / 64; C = (st & 1) * 32 + (swz % 64) / 2; }
__host__ __device__ __forceinline__ int perm32(int rho) { const int n = rho >> 4, i = rho & 15; return 8 * (i >> 2) + 4 * n + (i & 3); }

struct Unit { int pm, pn, be, e; };
struct Gemm { const bf16_t* A; const bf16_t* Bt; int M, N, K; };

struct StaticOrder {
    static constexpr bool GATHER = false;
    __device__ __forceinline__ int row_of(int r) const { return r; }
    int nM, nN, nwg, G, c;
    __host__ __device__ void init(int M, int N, int G_, int c_) { nM = M / BM; nN = N / BM; nwg = nM * nN; G = G_; c = c_; }
    __host__ __device__ bool next(int i, Unit& u) const {
        const long L = (long)i * G + c; if (L >= nwg) return false;
        int wgid = (int)L; { const int q = nwg / NXCD, r = nwg % NXCD, xcd = wgid % NXCD, off = wgid / NXCD; wgid = (xcd < r ? xcd * (q + 1) : r * (q + 1) + (xcd - r) * q) + off; }
        const int nig = WGM * nN, gid = wgid / nig, fm = gid * WGM, gsz = (nM - fm) < WGM ? (nM - fm) : WGM;
        u.pm = fm + ((wgid % nig) % gsz); u.pn = (wgid % nig) / gsz; u.be = u.pn; u.e = 0; return true;
    }
    __device__ __forceinline__ void a_ready(const Unit&) const {}
    __device__ __forceinline__ void done(const Unit&) const {}
};

__device__ __forceinline__ unsigned cvt_pk_bf16(float lo, float hi) { unsigned r; asm volatile("v_cvt_pk_bf16_f32 %0, %1, %2" : "=v"(r) : "v"(lo), "v"(hi)); return r; }
typedef float f32x2 __attribute__((ext_vector_type(2)));
__device__ __forceinline__ f32x2 gelu_pk(f32x2 v) {
    const f32x2 av = __builtin_elementwise_abs(v), d = av * 0.2316418882f + 1.0f;
    f32x2 t; t.x = __builtin_amdgcn_rcpf(d.x); t.y = __builtin_amdgcn_rcpf(d.y);
    f32x2 q = t * 0.5307027145f + (-0.7265760135f); q = q * t + 0.7107068705f; q = q * t + (-0.142248368f); q = q * t + 0.127414796f; q = q * t;
    const f32x2 s = (v * v) * (-0.72134752044f);
    f32x2 e; e.x = __builtin_amdgcn_exp2f(s.x); e.y = __builtin_amdgcn_exp2f(s.y);
    const f32x2 m = v * (q * e), r = v - m;
    f32x2 o; o.x = v.x < 0.f ? m.x : r.x; o.y = v.y < 0.f ? m.y : r.y; return o;
}

template <int ACT  > struct EpiBf16 {
    static constexpr bool PERM = true, AFTER_DRAIN = false; static_assert(ACT == 0 || ACT == 1, "EpiBf16: ACT is 0 (none) or 1 (gelu_pk)");
    bf16_t* O; int ldc; const float* bias; int split_cols; size_t split_stride; float scale0;
    struct Pre {}; __device__ __forceinline__ void preload(Pre&, const Unit&, int, int, int, int) const {}
    __device__ __forceinline__ void operator()(const f32x4 (&acc)[2][2][4][2], const Unit& u, int wr, int wc, int fr, int fq, const Pre&) const {
        const int row0 = u.pm * BM + wr * 64 + fr; int colt = u.pn * BM; bf16_t* base = O;
        float sc = 1.f; if (split_cols) { const int t = colt / split_cols; base += (size_t)t * split_stride; colt -= t * split_cols; if (t == 0) sc = scale0; }
        const int col0 = colt + wc * 32 + 8 * fq, bcol0 = u.pn * BM + wc * 32 + 8 * fq;
        f32x4 bv[2][2];
#pragma unroll
        for (int bj = 0; bj < 2; ++bj)
#pragma unroll
            for (int n = 0; n < 2; ++n) bv[bj][n] = bias ? *(const f32x4*)(bias + bcol0 + bj * HALF + 4 * n) : (f32x4){0.f, 0.f, 0.f, 0.f};
#pragma unroll
        for (int ai = 0; ai < 2; ++ai)
#pragma unroll
            for (int m = 0; m < 4; ++m) { bf16_t* rowp = base + (size_t)(row0 + ai * HALF + m * 16) * ldc + col0;
#pragma unroll
                for (int bj = 0; bj < 2; ++bj) { f32x4 v0 = acc[ai][bj][m][0] + bv[bj][0], v1 = acc[ai][bj][m][1] + bv[bj][1];
                    if (ACT == 1) { f32x2 a = gelu_pk((f32x2){v0[0], v0[1]}), b = gelu_pk((f32x2){v0[2], v0[3]}), c = gelu_pk((f32x2){v1[0], v1[1]}), d = gelu_pk((f32x2){v1[2], v1[3]});
                        v0 = (f32x4){a.x, a.y, b.x, b.y}; v1 = (f32x4){c.x, c.y, d.x, d.y}; }
                    v0 = v0 * sc; v1 = v1 * sc; u32x4 w; w.x = cvt_pk_bf16(v0[0], v0[1]); w.y = cvt_pk_bf16(v0[2], v0[3]); w.z = cvt_pk_bf16(v1[0], v1[1]); w.w = cvt_pk_bf16(v1[2], v1[3]);
                    *(u32x4*)(rowp + bj * HALF) = w; } }
    }
};


template <bool XIN_BF16> struct EpiResid {
    static constexpr bool PERM = false, AFTER_DRAIN = false;
    const float* xin_lat; const float* xin_ctx; int nlat; bf16_t* XR; int ldc; const float* mod; int mod_stride; int seq; float* rssp;
    struct Pre {}; __device__ __forceinline__ void preload(Pre&, const Unit&, int, int, int, int) const {}
    __device__ __forceinline__ void operator()(const f32x4 (&acc)[2][2][4][2], const Unit& u, int wr, int wc, int fr, int fq, const Pre&) const {
        typedef unsigned u32x2 __attribute__((ext_vector_type(2)));
        const int row0 = u.pm * BM + wr * 64 + fr, col0 = u.pn * BM + wc * 32 + 4 * fq;
        const int rowt = u.pm * BM; const int bidx = rowt < nlat ? rowt / seq : 4;
        const float* gate = mod + (size_t)bidx * mod_stride;
        const float* xin = rowt < nlat ? xin_lat : (xin_ctx - (size_t)nlat * ldc);
        f32x4 gv[2][2];
#pragma unroll
        for (int bj = 0; bj < 2; ++bj)
#pragma unroll
            for (int n = 0; n < 2; ++n) gv[bj][n] = *(const f32x4*)(gate + col0 + bj * HALF + n * 16);
#pragma unroll
        for (int ai = 0; ai < 2; ++ai)
#pragma unroll
            for (int m = 0; m < 4; ++m) { const int row = row0 + ai * HALF + m * 16; const size_t ro = (size_t)row * ldc + col0; float s2 = 0.f;
#pragma unroll
                for (int bj = 0; bj < 2; ++bj)
#pragma unroll
                    for (int n = 0; n < 2; ++n) { const size_t idx = ro + bj * HALF + n * 16; f32x4 xv;
                        if (XIN_BF16) { const u32x2 w = *(const u32x2*)(XR + idx); xv = (f32x4){__builtin_bit_cast(float, w.x << 16), __builtin_bit_cast(float, w.x & 0xffff0000u), __builtin_bit_cast(float, w.y << 16), __builtin_bit_cast(float, w.y & 0xffff0000u)}; }
                        else xv = *(const f32x4*)(xin + idx);
                        const f32x4 v = xv + gv[bj][n] * acc[ai][bj][m][n];
                        s2 += (v[0] * v[0] + v[1] * v[1]) + (v[2] * v[2] + v[3] * v[3]);
                        u32x2 o; o.x = cvt_pk_bf16(v[0], v[1]); o.y = cvt_pk_bf16(v[2], v[3]); *(u32x2*)(XR + idx) = o; }
                s2 += __shfl_xor(s2, 16); s2 += __shfl_xor(s2, 32);
                if (fq == 0) rssp[(size_t)row * 16 + u.pn * 4 + wc] = s2; }
    }
};
struct EpiSwiglu {
    static constexpr bool PERM = true, AFTER_DRAIN = false;
    bf16_t* O; int ldc; const float* bias; int bias_stride;
    struct Pre { unsigned bw[2][2][2]; };
    __device__ __forceinline__ void preload(Pre& p, const Unit& u, int wr, int wc, int fr, int fq) const {
        const float* bb = bias + (size_t)u.e * bias_stride + u.pn * BM + wc * 32 + 8 * fq;
#pragma unroll
        for (int bj = 0; bj < 2; ++bj)
#pragma unroll
            for (int n = 0; n < 2; ++n) { const f32x4 v = *(const f32x4*)(bb + bj * HALF + 4 * n); p.bw[bj][n][0] = cvt_pk_bf16(v[0], v[1]); p.bw[bj][n][1] = cvt_pk_bf16(v[2], v[3]); }
    }
    __device__ __forceinline__ void operator()(const f32x4 (&acc)[2][2][4][2], const Unit& u, int wr, int wc, int fr, int fq, const Pre& pre) const {
        const int row0 = u.pm * BM + wr * 64 + fr; const int bcol0 = u.pn * BM + wc * 32 + 8 * fq; const int ocol0 = bcol0 >> 1;
        f32x4 bv[2][2];
#pragma unroll
        for (int bj = 0; bj < 2; ++bj)
#pragma unroll
            for (int n = 0; n < 2; ++n) { const unsigned w0 = pre.bw[bj][n][0], w1 = pre.bw[bj][n][1];
                bv[bj][n] = (f32x4){__builtin_bit_cast(float, w0 << 16), __builtin_bit_cast(float, w0 & 0xffff0000u), __builtin_bit_cast(float, w1 << 16), __builtin_bit_cast(float, w1 & 0xffff0000u)}; }
#pragma unroll
        for (int ai = 0; ai < 2; ++ai)
#pragma unroll
            for (int m = 0; m < 4; ++m) { bf16_t* rowp = O + (size_t)(row0 + ai * HALF + m * 16) * ldc + ocol0;
#pragma unroll
                for (int bj = 0; bj < 2; ++bj) { const f32x4 v0 = acc[ai][bj][m][0] + bv[bj][0], v1 = acc[ai][bj][m][1] + bv[bj][1];
                    float o[4];
#pragma unroll
                    for (int p = 0; p < 4; ++p) { const float hg = p < 2 ? v0[2 * p] : v1[2 * p - 4], hl = p < 2 ? v0[2 * p + 1] : v1[2 * p - 3];
                        const float glu = fminf(hg, 7.0f), lin = fminf(fmaxf(hl, -7.0f), 7.0f);
                        const float sg = __builtin_amdgcn_rcpf(1.0f + __builtin_amdgcn_exp2f(-1.702f * 1.4426950408889634f * glu));
                        o[p] = glu * sg * (lin + 1.0f); }
                    typedef unsigned u32x2 __attribute__((ext_vector_type(2)));
                    u32x2 w; w.x = cvt_pk_bf16(o[0], o[1]); w.y = cvt_pk_bf16(o[2], o[3]);
                    *(u32x2*)(rowp + bj * (HALF / 2)) = w; } }
    }
};
struct EpiBf16Bias {
    static constexpr bool PERM = true, AFTER_DRAIN = false;
    bf16_t* O; int ldc; const float* bias; int bias_stride;
    struct Pre { f32x4 bv[2][2]; };
    __device__ __forceinline__ void preload(Pre& p, const Unit& u, int wr, int wc, int fr, int fq) const {
        const float* bb = bias + (size_t)u.e * bias_stride + u.pn * BM + wc * 32 + 8 * fq;
#pragma unroll
        for (int bj = 0; bj < 2; ++bj)
#pragma unroll
            for (int n = 0; n < 2; ++n) p.bv[bj][n] = *(const f32x4*)(bb + bj * HALF + 4 * n);
    }
    __device__ __forceinline__ void operator()(const f32x4 (&acc)[2][2][4][2], const Unit& u, int wr, int wc, int fr, int fq, const Pre& pre) const {
        const int row0 = u.pm * BM + wr * 64 + fr; const int col0 = u.pn * BM + wc * 32 + 8 * fq;
#pragma unroll
        for (int ai = 0; ai < 2; ++ai)
#pragma unroll
            for (int m = 0; m < 4; ++m) { bf16_t* rowp = O + (size_t)(row0 + ai * HALF + m * 16) * ldc + col0;
#pragma unroll
                for (int bj = 0; bj < 2; ++bj) { const f32x4 v0 = acc[ai][bj][m][0] + pre.bv[bj][0], v1 = acc[ai][bj][m][1] + pre.bv[bj][1];
                    u32x4 w; w.x = cvt_pk_bf16(v0[0], v0[1]); w.y = cvt_pk_bf16(v0[2], v0[3]); w.z = cvt_pk_bf16(v1[0], v1[1]); w.w = cvt_pk_bf16(v1[2], v1[3]);
                    *(u32x4*)(rowp + bj * HALF) = w; } }
    }
};
struct EpiLruGate {
    static constexpr bool PERM = false, AFTER_DRAIN = false;
    const bf16_t* XL; bf16_t* LAB; size_t lab_stride; const float* gb; const float* spt;
    struct Pre {}; __device__ __forceinline__ void preload(Pre&, const Unit&, int, int, int, int) const {}
    __device__ __forceinline__ void operator()(const f32x4 (&acc)[2][2][4][2], const Unit& u, int wr, int wc, int fr, int fq, const Pre&) const {
        const int d = u.pn >> 1, half = u.pn & 1;
        const int row0 = u.pm * BM + wr * 64 + fr, ch0 = half * 128 + wc * 32 + 4 * fq;
        bf16_t* LA = LAB + (size_t)(2 * d) * lab_stride; bf16_t* LB = LAB + (size_t)(2 * d + 1) * lab_stride;
#pragma unroll
        for (int n = 0; n < 2; ++n) {
            const f32x4 bR = *(const f32x4*)(gb + (d * 2 + 0) * 256 + ch0 + 16 * n), bI = *(const f32x4*)(gb + (d * 2 + 1) * 256 + ch0 + 16 * n);
            const f32x4 sp = *(const f32x4*)(spt + d * 256 + ch0 + 16 * n) * (-8.0f * 1.4426950408889634f);
#pragma unroll
            for (int ai = 0; ai < 2; ++ai)
#pragma unroll
                for (int m = 0; m < 4; ++m) { const size_t ro = (size_t)(row0 + ai * HALF + m * 16) * 256 + ch0 + 16 * n;
                    typedef unsigned u32x2 __attribute__((ext_vector_type(2)));
                    const u32x2 xw = *(const u32x2*)(XL + ro);
                    const float xl[4] = {__builtin_bit_cast(float, xw.x << 16), __builtin_bit_cast(float, xw.x & 0xffff0000u), __builtin_bit_cast(float, xw.y << 16), __builtin_bit_cast(float, xw.y & 0xffff0000u)};
                    const f32x4 gr = acc[ai][0][m][n] + bR, gi = acc[ai][1][m][n] + bI;
                    f32x4 av, bv;
#pragma unroll
                    for (int e = 0; e < 4; ++e) {
                        const float rg = __builtin_amdgcn_rcpf(1.0f + __builtin_amdgcn_exp2f(-1.4426950408889634f * gr[e])), ig = __builtin_amdgcn_rcpf(1.0f + __builtin_amdgcn_exp2f(-1.4426950408889634f * gi[e]));
                        const float la2 = rg * sp[e];
                        const float a2 = __builtin_amdgcn_exp2f(2.0f * la2);
                        av[e] = la2; bv[e] = __builtin_amdgcn_sqrtf(fmaxf(1.0f - a2, 0.f)) * (ig * xl[e]); }
                    u32x2 wa, wb; wa.x = cvt_pk_bf16(av[0], av[1]); wa.y = cvt_pk_bf16(av[2], av[3]); wb.x = cvt_pk_bf16(bv[0], bv[1]); wb.y = cvt_pk_bf16(bv[2], bv[3]);
                    *(u32x2*)(LA + ro) = wa; *(u32x2*)(LB + ro) = wb; }
        }
    }
};
template <bool GATHER_> struct MoeOrderT {
    static constexpr bool GATHER = GATHER_;
    const int* rowtok;
    __device__ __forceinline__ int row_of(int r) const { return GATHER_ ? rowtok[r] : r; }
    const PG8_LAS int* tab; int ntiles, nN, nper, j, m_lo, nMx, wgm, rev;
    __device__ __forceinline__ void init(const PG8_LAS int* tab_, int ntiles_, int nN_, int G, int bx, int wgm_) {
        tab = tab_; ntiles = ntiles_; nN = nN_; wgm = wgm_; rev = 0;
        if (G % 8 == 0) { const int x = bx % 8; nper = G / 8; j = bx / 8; m_lo = (x * ntiles) / 8; nMx = ((x + 1) * ntiles) / 8 - m_lo; }
        else { nper = G; j = bx; m_lo = 0; nMx = ntiles; }
    }
    __device__ __forceinline__ bool next(int i, Unit& u) const {
        const int s = i * nper + j; if (s >= nMx * nN) return false;
        const int nig = wgm * nN, gid = s / nig, fm = gid * wgm, gsz = (nMx - fm) < wgm ? (nMx - fm) : wgm, w = s - gid * nig;
        const int mi = fm + (w % gsz); u.pm = m_lo + (rev ? (nMx - 1 - mi) : mi); u.pn = w / gsz; u.e = tab[u.pm]; u.be = u.e * nN + u.pn; return true;
    }
    __device__ __forceinline__ void a_ready(const Unit&) const {}
    __device__ __forceinline__ void done(const Unit&) const {}
};
template <class Epi, class Sched, bool ALIGN_EPI = false, bool SP2 = false>
__device__ __forceinline__ void gemm_phase(PG8_LAS unsigned char* lds, const Gemm g, const Sched& S, const Epi& E) {
    int tid_ = threadIdx.x; asm volatile("" : "+v"(tid_));
    const int tid = tid_, wid = __builtin_amdgcn_readfirstlane(tid >> 6), lane = tid & 63, wr = wid >> 2, wc = wid & 3, fr = lane & 15, fq = lane >> 4;
    const int K = g.K, nt = K / BK;
    unsigned voffA[2], voffB[2];
#pragma unroll
    for (int i = 0; i < 2; ++i) { int R, C; stage_rc(tid * 16 + i * 8192, R, C); const int Rb = Epi::PERM ? ((R & ~31) + perm32(R & 31)) : R;
        voffA[i] = (unsigned)(R * K + C) * 2u; voffB[i] = (unsigned)(Rb * K + C) * 2u; }
    unsigned gA_[2] = {0u, 0u}, gN_[2] = {0u, 0u}, gC_[2] = {0u, 0u};
    static_assert(!Sched::GATHER || SP2, "the gathered A operand is wired into the SP2 loop only");
    if constexpr (Sched::GATHER) { _Pragma("unroll") for (int i_ = 0; i_ < 2; ++i_) { int R_, C_; stage_rc(tid * 16 + i_ * 8192, R_, C_); gC_[i_] = (unsigned)(C_ * 2); } }
#define PG8_GLOAD(dst, pm_) do { _Pragma("unroll") for (int h_ = 0; h_ < 2; ++h_) { unsigned t_[2]; _Pragma("unroll") for (int i_ = 0; i_ < 2; ++i_) { int R_, C_; stage_rc(tid * 16 + i_ * 8192, R_, C_); \
        t_[i_] = (unsigned)S.row_of((pm_) * BM + h_ * HALF + R_); } dst[h_] = t_[0] | (t_[1] << 16); } } while (0)
    const size_t kstep = (size_t)(BK * 2);
    const size_t hstep = (size_t)HALF * K * 2;
    const size_t tstep = 2 * hstep;
    const unsigned ldsw = (unsigned)wid * 1024u;
    const int aoff = lds_byte(wr * 64 + fr, fq * 8), boff = lds_byte(wc * 32 + fr, fq * 8);
#define PG8_SA(b, h) (((b) * 2 + (h)) * HTB)
#define PG8_SB(b, h) ((4 + (b) * 2 + (h)) * HTB)
#define PG8_STAGE(bufoff, gbase, voff) do { _Pragma("unroll") for (int _i = 0; _i < 2; ++_i) \
        __builtin_amdgcn_global_load_lds((const unsigned*)((const char*)(gbase) + (voff)[_i]), (PG8_LAS unsigned*)(lds + (bufoff) + ldsw + _i * 8192), 16, 0, 0); } while (0)
#define PG8_STA(bufoff, ptr, h, useN) do { if constexpr (Sched::GATHER) { const unsigned pk_ = (useN) ? gN_[h] : gA_[h]; unsigned o_[2] = {(pk_ & 0xffffu) * (unsigned)(K * 2) + gC_[0], (pk_ >> 16) * (unsigned)(K * 2) + gC_[1]}; PG8_STAGE(bufoff, ptr, o_); } \
        else { PG8_STAGE(bufoff, (ptr) + ((h) ? hstep : 0), voffA); } } while (0)
#define PG8_LDA(dst, b, h) do { _Pragma("unroll") for (int m = 0; m < 4; ++m) _Pragma("unroll") for (int k = 0; k < 2; ++k) dst[m][k] = *(const PG8_LAS bf16x8*)(lds + PG8_SA(b, h) + aoff + m * 2048 + k * 1024); } while (0)
#define PG8_LDB(dst, b, h) do { _Pragma("unroll") for (int n = 0; n < 2; ++n) _Pragma("unroll") for (int k = 0; k < 2; ++k) dst[n][k] = *(const PG8_LAS bf16x8*)(lds + PG8_SB(b, h) + boff + n * 2048 + k * 1024); } while (0)
#define PG8_MMA(ai, bj, At, Bt) do { __builtin_amdgcn_s_setprio(1); _Pragma("unroll") for (int m = 0; m < 4; ++m) _Pragma("unroll") for (int n = 0; n < 2; ++n) _Pragma("unroll") for (int k = 0; k < 2; ++k) \
        acc[ai][bj][m][n] = __builtin_amdgcn_mfma_f32_16x16x32_bf16(Bt[n][k], At[m][k], acc[ai][bj][m][n], 0, 0, 0); __builtin_amdgcn_s_setprio(0); } while (0)
#define PG8_WAIT_V(n) asm volatile("s_waitcnt vmcnt(" #n ")" ::: "memory")
#define PG8_WAIT_L(n) asm volatile("s_waitcnt lgkmcnt(" #n ")" ::: "memory")
#define PG8_BAR __builtin_amdgcn_s_barrier()
#define PG8_SCHED __builtin_amdgcn_sched_barrier(0)
    Unit cur, nxt; int ui = 0;
    if (!S.next(0, cur)) return;
    f32x4 acc[2][2][4][2];
#pragma unroll
    for (int a = 0; a < 2; ++a)
#pragma unroll
        for (int b = 0; b < 2; ++b)
#pragma unroll
            for (int m = 0; m < 4; ++m)
#pragma unroll
                for (int n = 0; n < 2; ++n) acc[a][b][m][n] = (f32x4){0.f, 0.f, 0.f, 0.f};
    bf16x8 At[4][2], B0[2][2], B1[2][2];
    typename Epi::Pre pre;
    const char* cA = (const char*)g.A + (Sched::GATHER ? (size_t)0 : (size_t)cur.pm * tstep); if constexpr (Sched::GATHER) PG8_GLOAD(gA_, cur.pm);
    const char* cB = (const char*)g.Bt + (size_t)cur.be * tstep;
    S.a_ready(cur);
    if constexpr (SP2) {
        PG8_STAGE(PG8_SB(0, 0), cB, voffB); PG8_STAGE(PG8_SB(0, 1), cB + hstep, voffB); PG8_STA(PG8_SA(0, 0), cA, 0, false); PG8_STA(PG8_SA(0, 1), cA, 1, false);
        if (wr == 1) PG8_BAR;
        PG8_WAIT_V(2); PG8_BAR;
        PG8_STAGE(PG8_SB(1, 0), cB + kstep, voffB); PG8_STA(PG8_SA(1, 0), cA + kstep, 0, false); PG8_STAGE(PG8_SB(1, 1), cB + hstep + kstep, voffB);
        PG8_WAIT_V(6); PG8_BAR;
    } else {
        PG8_STAGE(PG8_SB(0, 0), cB, voffB); PG8_STAGE(PG8_SA(0, 0), cA, voffA); PG8_STAGE(PG8_SB(0, 1), cB + hstep, voffB); PG8_STAGE(PG8_SA(0, 1), cA + hstep, voffA);
        if (wr == 1) PG8_BAR;
        PG8_WAIT_V(4); PG8_BAR;
        PG8_STAGE(PG8_SB(1, 0), cB + kstep, voffB); PG8_STAGE(PG8_SA(1, 0), cA + kstep, voffA); PG8_STAGE(PG8_SB(1, 1), cB + hstep + kstep, voffB);
        PG8_WAIT_V(6); PG8_BAR;
    }
    for (;;) {
        const bool has_next = S.next(ui + 1, nxt);
        const char* nA = (has_next && !Sched::GATHER) ? (const char*)g.A + (size_t)nxt.pm * tstep : cA; const char* nB = has_next ? (const char*)g.Bt + (size_t)nxt.be * tstep : cB;
        if constexpr (Sched::GATHER) { if (has_next) PG8_GLOAD(gN_, nxt.pm); else { gN_[0] = gA_[0]; gN_[1] = gA_[1]; } }
        for (int t = 0; t < nt; t += 2) {
            const bool last = (t == nt - 2);
            const char* a1 = cA + (size_t)(t + 1) * kstep;
            const char* a2 = last ? nA : cA + (size_t)(t + 2) * kstep; const char* b2 = last ? nB : cB + (size_t)(t + 2) * kstep;
            const char* a3 = a2 + kstep; const char* b3 = b2 + kstep;
            if (last) E.preload(pre, cur, wr, wc, fr, fq);
            if (last && has_next) S.a_ready(nxt);
            if constexpr (SP2) {
            PG8_LDB(B0, 0, 0); PG8_LDB(B1, 0, 1); PG8_SCHED; PG8_LDA(At, 0, 0); PG8_STA(PG8_SA(1, 1), a1, 1, false);
            PG8_WAIT_V(8); PG8_WAIT_L(0); PG8_BAR; PG8_MMA(0, 0, At, B0); PG8_MMA(0, 1, At, B1); PG8_BAR; PG8_SCHED;
            PG8_LDA(At, 0, 1); PG8_STAGE(PG8_SB(0, 0), b2, voffB); PG8_STAGE(PG8_SB(0, 1), b2 + hstep, voffB); PG8_STA(PG8_SA(0, 0), a2, 0, last);
            PG8_WAIT_V(8); PG8_WAIT_L(0); PG8_BAR; PG8_MMA(1, 0, At, B0); PG8_MMA(1, 1, At, B1); PG8_BAR; PG8_SCHED;
            PG8_LDB(B0, 1, 0); PG8_LDB(B1, 1, 1); PG8_SCHED; PG8_LDA(At, 1, 0); PG8_STA(PG8_SA(0, 1), a2, 1, last);
            PG8_WAIT_V(8); PG8_WAIT_L(0); PG8_BAR; PG8_MMA(0, 0, At, B0); PG8_MMA(0, 1, At, B1); PG8_BAR; PG8_SCHED;
            PG8_LDA(At, 1, 1); PG8_STAGE(PG8_SB(1, 0), b3, voffB); PG8_STAGE(PG8_SB(1, 1), b3 + hstep, voffB); PG8_STA(PG8_SA(1, 0), a3, 0, last);
            PG8_WAIT_V(8); PG8_WAIT_L(0); PG8_BAR; PG8_MMA(1, 0, At, B0); PG8_MMA(1, 1, At, B1); PG8_BAR; PG8_SCHED;
            } else {
            PG8_LDB(B0, 0, 0); PG8_SCHED; PG8_LDA(At, 0, 0); PG8_STAGE(PG8_SA(1, 1), a1 + hstep, voffA);
            PG8_WAIT_L(8); PG8_BAR; PG8_WAIT_L(0); PG8_MMA(0, 0, At, B0); PG8_BAR; PG8_SCHED;
            PG8_LDB(B1, 0, 1); PG8_STAGE(PG8_SB(0, 0), b2, voffB);
            PG8_BAR; PG8_WAIT_L(0); PG8_MMA(0, 1, At, B1); PG8_BAR;
            PG8_LDA(At, 0, 1); PG8_STAGE(PG8_SA(0, 0), a2, voffA);
            PG8_BAR; PG8_WAIT_L(0); PG8_MMA(1, 0, At, B0); PG8_BAR; PG8_SCHED;
            PG8_STAGE(PG8_SB(0, 1), b2 + hstep, voffB);
            PG8_WAIT_V(6); PG8_BAR; PG8_MMA(1, 1, At, B1); PG8_BAR;
            PG8_LDB(B0, 1, 0); PG8_SCHED; PG8_LDA(At, 1, 0); PG8_STAGE(PG8_SA(0, 1), a2 + hstep, voffA);
            PG8_WAIT_L(8); PG8_BAR; PG8_WAIT_L(0); PG8_MMA(0, 0, At, B0); PG8_BAR; PG8_SCHED;
            PG8_LDB(B1, 1, 1); PG8_STAGE(PG8_SB(1, 0), b3, voffB);
            PG8_BAR; PG8_WAIT_L(0); PG8_MMA(0, 1, At, B1); PG8_BAR;
            PG8_LDA(At, 1, 1); PG8_STAGE(PG8_SA(1, 0), a3, voffA);
            PG8_BAR; PG8_WAIT_L(0); PG8_MMA(1, 0, At, B0); PG8_BAR; PG8_SCHED;
            PG8_STAGE(PG8_SB(1, 1), b3 + hstep, voffB);
            PG8_WAIT_V(6); PG8_BAR; PG8_MMA(1, 1, At, B1); PG8_BAR;
            }
        }
        if constexpr (ALIGN_EPI) { if (wr == 0) PG8_BAR; }
        if constexpr (!Epi::AFTER_DRAIN) { E(acc, cur, wr, wc, fr, fq, pre); S.done(cur); }
        if (!has_next) break;
#pragma unroll
        for (int a = 0; a < 2; ++a)
#pragma unroll
            for (int b = 0; b < 2; ++b)
#pragma unroll
                for (int m = 0; m < 4; ++m)
#pragma unroll
                    for (int n = 0; n < 2; ++n) acc[a][b][m][n] = (f32x4){0.f, 0.f, 0.f, 0.f};
        cur = nxt; cA = nA; cB = nB; ++ui;
        if constexpr (Sched::GATHER) { gA_[0] = gN_[0]; gA_[1] = gN_[1]; }
        if constexpr (ALIGN_EPI) { if (wr == 1) PG8_BAR; }
    }
    PG8_WAIT_V(0);
    if constexpr (!ALIGN_EPI) { if (wr == 0) PG8_BAR; }
    PG8_BAR;
    if constexpr (Epi::AFTER_DRAIN) { E.fused(acc, cur, wr, wc, fr, fq, lds, wid, lane); S.done(cur); }
#undef PG8_SA
#undef PG8_SB
#undef PG8_STAGE
#undef PG8_STA
#undef PG8_GLOAD
#undef PG8_LDA
#undef PG8_LDB
#undef PG8_MMA
#undef PG8_WAIT_V
#undef PG8_WAIT_L
#undef PG8_BAR
#undef PG8_SCHED
}
}

#ifndef PG8_SP2
#define PG8_SP2 true
#endif
#ifndef PG8_ALIGN
#define PG8_ALIGN true
#endif
#include <cmath>
namespace attn_body {
using bf16=__hip_bfloat16;
using bf16x8=__attribute__((ext_vector_type(8)))short;
using s16x4=__attribute__((ext_vector_type(4)))short;
using f32x16=__attribute__((ext_vector_type(16)))float;
using u32x4=__attribute__((ext_vector_type(4)))unsigned;
using f32x4_t=__attribute__((ext_vector_type(4)))float;
constexpr int NHEAD=8,SEQQ=8192,SEQK=8448,D=64,QP=512,KP=128,QIN=2048;
constexpr int NW=8,QBLK=32,QB=QBLK*NW,KVBLK=64,NQB=SEQQ/QB;
constexpr int ATTN_UNIT_ROWS=QB;
__device__ __forceinline__ int crow(int r,int hi){return (r&3)+8*(r>>2)+4*hi;}
#define SBAR() __builtin_amdgcn_sched_barrier(0)
__device__ __forceinline__ void cmask(f32x16&p0,f32x16&p1,int jb,int qrel,int hi){
  const float NEG=-INFINITY; int kb=64*jb+4*hi;
  #pragma unroll
  for(int r=0;r<16;++r){int kv=kb+(r&3)+8*(r>>2); if(kv>qrel)p0[r]=NEG; if(kv+32>qrel)p1[r]=NEG;}
}

constexpr int NSLOT=3, SLOTB=8192;
constexpr int LDS_K=0, LDS_V=NSLOT*SLOTB, LDS_WS=2*NSLOT*SLOTB, LDS_OST=LDS_WS+NW*64*4, LDS_BYTES=LDS_OST+NW*4096;
constexpr float C2=0.125f*1.4426950408889634f;
__device__ __forceinline__ void glds16(const void*gsrc,unsigned lds_dst){unsigned keep;
  asm volatile("s_mov_b32 %0, m0\n\ts_mov_b32 m0, %2\n\ts_nop 0\n\tglobal_load_lds_dwordx4 %1, off\n\ts_mov_b32 m0, %0":"=&s"(keep):"v"(gsrc),"s"(lds_dst):"memory");}
__device__ __forceinline__ float max3f(float a,float b,float c){float r;asm("v_max3_f32 %0, %1, %2, %3":"=v"(r):"v"(a),"v"(b),"v"(c));return r;}
__device__ __forceinline__ float max2f(float a,float b){float r;asm("v_max_f32_e32 %0, %1, %2":"=v"(r):"v"(a),"v"(b));return r;}
__device__ __forceinline__ float fadd_s(float a,float b){float r;asm("v_add_f32_e32 %0, %1, %2":"=v"(r):"v"(a),"v"(b));return r;}
__device__ __forceinline__ float fsub_s(float a,float b){float r;asm("v_sub_f32_e32 %0, %1, %2":"=v"(r):"v"(a),"v"(b));return r;}
typedef float f32x2_t __attribute__((ext_vector_type(2))); typedef __bf16 bf16x2_t __attribute__((ext_vector_type(2)));
__device__ __forceinline__ unsigned cvtpk_s(float lo,float hi){f32x2_t v={lo,hi};bf16x2_t b=__builtin_convertvector(v,bf16x2_t);return __builtin_bit_cast(unsigned,b);}
#define WAIT_BAR(N) asm volatile("s_waitcnt vmcnt(" #N ") lgkmcnt(0)\n\ts_barrier":::"memory")

__device__ __forceinline__ void qkt(f32x16&p0,f32x16&p1,const char*Kslot,const bf16x8*qr,const f32x16&negm,int r32,int hi){
  const char*kb=Kslot+hi*1024+r32*16;
  #pragma unroll
  for(int d0=0;d0<4;++d0){
    const bf16x8 b0=*reinterpret_cast<const bf16x8*>(kb+d0*2048);
    const bf16x8 b1=*reinterpret_cast<const bf16x8*>(kb+d0*2048+512);
    if(d0==0){p0=__builtin_amdgcn_mfma_f32_32x32x16_bf16(b0,qr[0],negm,0,0,0);p1=__builtin_amdgcn_mfma_f32_32x32x16_bf16(b1,qr[0],negm,0,0,0);}
    else{p0=__builtin_amdgcn_mfma_f32_32x32x16_bf16(b0,qr[d0],p0,0,0,0);p1=__builtin_amdgcn_mfma_f32_32x32x16_bf16(b1,qr[d0],p1,0,0,0);}}
}
typedef __attribute__((address_space(3))) const char* lds_cptr;
typedef short v4i16_t __attribute__((ext_vector_type(4)));
__device__ __forceinline__ void kload8(bf16x8*kf,lds_cptr kp){
  kf[0]=*(const __attribute__((address_space(3))) bf16x8*)(kp);      kf[1]=*(const __attribute__((address_space(3))) bf16x8*)(kp+512);
  kf[2]=*(const __attribute__((address_space(3))) bf16x8*)(kp+2048); kf[3]=*(const __attribute__((address_space(3))) bf16x8*)(kp+2560);
  kf[4]=*(const __attribute__((address_space(3))) bf16x8*)(kp+4096); kf[5]=*(const __attribute__((address_space(3))) bf16x8*)(kp+4608);
  kf[6]=*(const __attribute__((address_space(3))) bf16x8*)(kp+6144); kf[7]=*(const __attribute__((address_space(3))) bf16x8*)(kp+6656);
}
__device__ __forceinline__ void kload2(bf16x8*kf,lds_cptr kp,int j){ kf[2*j]=*(const __attribute__((address_space(3))) bf16x8*)(kp+j*2048); kf[2*j+1]=*(const __attribute__((address_space(3))) bf16x8*)(kp+j*2048+512); }
__device__ __forceinline__ s16x4 vtr(lds_cptr p){ return __builtin_bit_cast(s16x4,__builtin_amdgcn_ds_read_tr16_b64_v4i16((__attribute__((address_space(3))) v4i16_t*)p)); }
__device__ __forceinline__ float rowmax(const f32x16&p0,const f32x16&p1){
  float a=max3f(p0[0],p0[1],p1[0]),b=max3f(p0[2],p0[3],p1[1]);a=max3f(a,p1[2],p1[3]);
  #pragma unroll
  for(int r=4;r<16;r+=4){a=max3f(a,p0[r],p0[r+1]);b=max3f(b,p0[r+2],p0[r+3]);a=max3f(a,p1[r],p1[r+1]);b=max3f(b,p1[r+2],p1[r+3]);}
  const float m=max2f(a,b);
  auto rr=__builtin_amdgcn_permlane32_swap(__float_as_uint(m),__float_as_uint(m),false,false);
  return max2f(__uint_as_float(rr[0]),__uint_as_float(rr[1]));
}
__device__ __forceinline__ void pv(f32x16*o,int vb,bf16x8 pa0,bf16x8 pa1,bf16x8 pa2,bf16x8 pa3){
  #pragma unroll
  for(int d0=0;d0<2;++d0){s16x4 lo[4],hi[4];
    #pragma unroll
    for(int ks=0;ks<4;++ks){
      asm volatile("ds_read_b64_tr_b16 %0,%1 offset:%c2":"=&v"(lo[ks]):"v"(vb),"i"(d0*4096+ks*1024):"memory");
      asm volatile("ds_read_b64_tr_b16 %0,%1 offset:%c2":"=&v"(hi[ks]):"v"(vb),"i"(d0*4096+ks*1024+512):"memory");}
    asm volatile("s_waitcnt lgkmcnt(0)":::"memory");SBAR();
    #define PK(k) (bf16x8){lo[k][0],lo[k][1],lo[k][2],lo[k][3],hi[k][0],hi[k][1],hi[k][2],hi[k][3]}
    o[d0]=__builtin_amdgcn_mfma_f32_32x32x16_bf16(pa0,PK(0),o[d0],0,0,0);
    o[d0]=__builtin_amdgcn_mfma_f32_32x32x16_bf16(pa1,PK(1),o[d0],0,0,0);
    o[d0]=__builtin_amdgcn_mfma_f32_32x32x16_bf16(pa2,PK(2),o[d0],0,0,0);
    o[d0]=__builtin_amdgcn_mfma_f32_32x32x16_bf16(pa3,PK(3),o[d0],0,0,0);
    #undef PK
  }
}

#ifndef ATTN_STORE16
#define ATTN_STORE16(p,v) (*(u32x4*)(p)=(v))
#endif
struct QPre { const float* qg; const float* rc; const float* rs; };
template<int THRL> __device__ __forceinline__ void attn_unit(int b,int h,long qrow0,int NTarg,int tq0,const QPre&QN,const bf16*Q,const bf16*__restrict__ K,const bf16*__restrict__ V,bf16*O,char*shm){
  int tid_=threadIdx.x; asm volatile("":"+v"(tid_)); const int tid=tid_,lane=tid&63,r32=lane&31,hi=lane>>5; const int wid=__builtin_amdgcn_readfirstlane(tid>>6);
  const long krowbase=(long)b*SEQK; const int kvh=h>>2;
  const bf16*Qw=Q+(qrow0+wid*QBLK)*QIN+h*D;
  const bf16*Kh=K+krowbase*KP+kvh*D,*Vh=V+krowbase*KP+kvh*D;
  const unsigned lds0=(unsigned)(uintptr_t)shm;
  float*wsf=(float*)(shm+LDS_WS)+wid*64;
  const bf16*ksrc=Kh+(long)lane*KP+wid*8;
  const bf16*vsrc=Vh+(long)(16*(wid&3)+(lane>>2))*KP+(wid>>2)*32+(lane&3)*8;
  const unsigned kdst=lds0+LDS_K+wid*1024, vdst=lds0+LDS_V+wid*1024;
  #define DMA_K(t,slot) glds16(ksrc+(long)(t)*KVBLK*KP,(unsigned)__builtin_amdgcn_readfirstlane(kdst+(slot)))
  #define DMA_V(t,slot) glds16(vsrc+(long)(t)*KVBLK*KP,(unsigned)__builtin_amdgcn_readfirstlane(vdst+(slot)))
  const int vb0=(int)(lds0+LDS_V)+((lane>>4)&1)*32+(lane&3)*8+(4*hi+((lane&15)>>2))*64;
  const char*Kbase=shm+LDS_K; bf16x8 kf[8];
  const lds_cptr shm3=(lds_cptr)shm; const lds_cptr kp0=shm3+LDS_K+hi*1024+r32*16; const lds_cptr vp0=shm3+LDS_V+((lane>>4)&1)*32+(lane&3)*8+(4*hi+((lane&15)>>2))*64;
  const int NT=NTarg;
  DMA_K(0,0);DMA_V(0,0);DMA_K(1,SLOTB);
  bf16x8 qr[4];
  #pragma unroll
  for(int d0=0;d0<4;++d0)qr[d0]=*reinterpret_cast<const bf16x8*>(&Qw[(long)r32*QIN+d0*16+hi*8]);
  {
    float x[4][8]; float ss=0.f;
    #pragma unroll
    for(int d0=0;d0<4;++d0){
      #pragma unroll
      for(int e=0;e<8;++e){ x[d0][e]=__builtin_bit_cast(float,(unsigned)(unsigned short)qr[d0][e]<<16); ss+=x[d0][e]*x[d0][e]; } }
    ss+=__shfl_xor(ss,32);
    const float rstd=C2/sqrtf(ss*(1.0f/64.0f)+1e-6f);
    #pragma unroll
    for(int d0=0;d0<4;++d0){ const f32x4_t g0=*reinterpret_cast<const f32x4_t*>(QN.qg+16*d0+8*hi), g1=*reinterpret_cast<const f32x4_t*>(QN.qg+16*d0+8*hi+4);
      #pragma unroll
      for(int e=0;e<8;++e) x[d0][e]*=rstd*(e<4?g0[e]:g1[e-4]); }
    if(tq0>=0){ const int t=tq0+wid*QBLK+r32;
      #pragma unroll
      for(int d0=0;d0<2;++d0){ const float*cp=QN.rc+(long)t*32+16*d0+8*hi,*sp=QN.rs+(long)t*32+16*d0+8*hi;
        const f32x4_t c0=*reinterpret_cast<const f32x4_t*>(cp),c1=*reinterpret_cast<const f32x4_t*>(cp+4),s0=*reinterpret_cast<const f32x4_t*>(sp),s1=*reinterpret_cast<const f32x4_t*>(sp+4);
        #pragma unroll
        for(int e=0;e<8;++e){ const float cs=e<4?c0[e]:c1[e-4], sn=e<4?s0[e]:s1[e-4]; const float a=x[d0][e], bq=x[d0+2][e]; x[d0][e]=a*cs-bq*sn; x[d0+2][e]=bq*cs+a*sn; } } }
    #pragma unroll
    for(int d0=0;d0<4;++d0){ u32x4 pk; pk[0]=cvtpk_s(x[d0][0],x[d0][1]); pk[1]=cvtpk_s(x[d0][2],x[d0][3]); pk[2]=cvtpk_s(x[d0][4],x[d0][5]); pk[3]=cvtpk_s(x[d0][6],x[d0][7]); qr[d0]=__builtin_bit_cast(bf16x8,pk); }
  }
  float mhat=0.f,l_reg=0.f;f32x16 o[2];o[0]=f32x16{};o[1]=f32x16{};f32x16 negm=f32x16{};asm volatile("":"+v"(negm));
  const int qrel=wid*QBLK+r32;
  #define CMASK(P0,P1,t) do{}while(0)
  bool resc=false;
  #define START(P0,P1) do{ const float rm=rowmax(P0,P1); resc=false; \
    { const float dl=rm; mhat=fadd_s(mhat,dl); \
      _Pragma("unroll") for(int r=0;r<16;++r){P0[r]=fsub_s(P0[r],dl);P1[r]=fsub_s(P1[r],dl);} \
      _Pragma("unroll") for(int r=0;r<16;++r)negm[r]=-mhat; asm volatile("":"+v"(negm)); } \
    _Pragma("unroll") for(int r=0;r<16;++r)P0[r]=__builtin_amdgcn_exp2f(P0[r]); }while(0)
  #define RESC() do{ if(resc){ asm volatile("s_waitcnt lgkmcnt(0)":::"memory"); \
      _Pragma("unroll") for(int d_=0;d_<2;++d_) _Pragma("unroll") for(int r=0;r<16;++r)o[d_][r]*=wsf[crow(r,hi)]; } }while(0)
  f32x16 pA0,pA1,pB0,pB1;
  int sl_prev=0,sl_cur=0,sl_next=SLOTB;
  #define ROT() do{sl_prev=sl_cur;sl_cur=sl_next;sl_next=(sl_next==(NSLOT-1)*SLOTB)?0:sl_next+SLOTB;}while(0)
  DMA_K(2,2*SLOTB);
  WAIT_BAR(3);
  qkt(pA0,pA1,Kbase,qr,negm,r32,hi);asm volatile("s_nop 15\n\ts_nop 7":"+v"(pA0),"+v"(pA1));CMASK(pA0,pA1,0);
  START(pA0,pA1);
  _Pragma("unroll") for(int r=0;r<16;++r)pA1[r]=__builtin_amdgcn_exp2f(pA1[r]);
  WAIT_BAR(0);
  DMA_K(3,0);DMA_V(1,SLOTB);
  ROT();
  kload8(kf,kp0+sl_cur);
  WAIT_BAR(2);
  s16x4 vlo[8],vhi[8]; u32x4 pw0,pw1,pw2,pw3;
  #define PKW(P,B) cvtpk_s(P[B],P[B+1])
  #define PAF(k) __builtin_bit_cast(bf16x8,pw##k)
  #define VFR(i) (bf16x8){vlo[i][0],vlo[i][1],vlo[i][2],vlo[i][3],vhi[i][0],vhi[i][1],vhi[i][2],vhi[i][3]}
  #define PIN(x) asm volatile("":"+v"(x))
  #define MX3(a,b,c) __builtin_fmaxf(__builtin_fmaxf((a),(b)),(c))
  #define GAPA(MF,A0,A1,A2,A3,W0,W1,PW) do{ MF; sacc+=A0; sacc+=A1; sacc+=A2; sacc+=A3; PIN(sacc); W0; W1; PIN(PW); SBAR(); }while(0)
  #define EX(v) __builtin_amdgcn_exp2f(v)
  #define GAPB(MF,X,B) do{ MF; X[B]=EX(X[B]); X[B+1]=EX(X[B+1]); X[B+2]=EX(X[B+2]); X[B+3]=EX(X[B+3]); PIN(X); SBAR(); }while(0)
  #define VRD(i) do{ vlo[i]=vtr(vp_+(((i)>>2)*4096+((i)&3)*1024)); vhi[i]=vtr(vp_+(((i)>>2)*4096+((i)&3)*1024+512)); }while(0)
  #define KRD(G,j) do{ if(G){ kload2(kf,kp0+sl_next,j); SBAR(); } }while(0)
  #define STEP(C0,C1,P0,P1,t,GK,GV,GL) do{ SBAR(); \
    const lds_cptr vp_=vp0+sl_prev; \
    VRD(0); SBAR(); float sacc=(P0[0]+P0[1]); \
    GAPA(C0=__builtin_amdgcn_mfma_f32_32x32x16_bf16(kf[0],qr[0],negm,0,0,0), P0[2],P0[3],P0[4],P0[5],     pw0[0]=PKW(P0,0), pw0[1]=PKW(P0,2), pw0); \
    VRD(4); SBAR(); GAPA(C1=__builtin_amdgcn_mfma_f32_32x32x16_bf16(kf[1],qr[0],negm,0,0,0), P0[6],P0[7],P0[8],P0[9],     pw0[2]=PKW(P0,4), pw0[3]=PKW(P0,6), pw0); \
    VRD(1); SBAR(); GAPA(C0=__builtin_amdgcn_mfma_f32_32x32x16_bf16(kf[2],qr[1],C0,0,0,0),   P0[10],P0[11],P0[12],P0[13], pw1[0]=PKW(P0,8), pw1[1]=PKW(P0,10), pw1); \
    VRD(5); SBAR(); GAPA(C1=__builtin_amdgcn_mfma_f32_32x32x16_bf16(kf[3],qr[1],C1,0,0,0),   P0[14],P0[15],P1[0],P1[1],   pw1[2]=PKW(P0,12),pw1[3]=PKW(P0,14), pw1); \
    VRD(2); SBAR(); GAPA(C0=__builtin_amdgcn_mfma_f32_32x32x16_bf16(kf[4],qr[2],C0,0,0,0),   P1[2],P1[3],P1[4],P1[5],     pw2[0]=PKW(P1,0), pw2[1]=PKW(P1,2), pw2); \
    VRD(6); SBAR(); GAPA(C1=__builtin_amdgcn_mfma_f32_32x32x16_bf16(kf[5],qr[2],C1,0,0,0),   P1[6],P1[7],P1[8],P1[9],     pw2[2]=PKW(P1,4), pw2[3]=PKW(P1,6), pw2); \
    VRD(3); SBAR(); GAPA(C0=__builtin_amdgcn_mfma_f32_32x32x16_bf16(kf[6],qr[3],C0,0,0,0),   P1[10],P1[11],P1[12],P1[13], pw3[0]=PKW(P1,8), pw3[1]=PKW(P1,10), pw3); \
    VRD(7); SBAR(); GAPA(C1=__builtin_amdgcn_mfma_f32_32x32x16_bf16(kf[7],qr[3],C1,0,0,0),   P1[14],P1[15],0.f,0.f,       pw3[2]=PKW(P1,12),pw3[3]=PKW(P1,14), pw3); \
    l_reg+=sacc; \
    if(GK){DMA_K((t)+3,sl_cur);} if(GV){DMA_V((t)+1,sl_next);} \
    CMASK(C0,C1,t); \
    { float a=MX3(C0[0],C0[1],C1[0]),b=MX3(C0[2],C0[3],C1[1]); a=MX3(a,C1[2],C1[3]); \
      _Pragma("unroll") for(int r=4;r<16;r+=4){a=MX3(a,C0[r],C0[r+1]);b=MX3(b,C0[r+2],C0[r+3]);a=MX3(a,C1[r],C1[r+1]);b=MX3(b,C1[r+2],C1[r+3]);} \
      float rm=__builtin_fmaxf(a,b); { auto rr=__builtin_amdgcn_permlane32_swap(__float_as_uint(rm),__float_as_uint(rm),false,false); rm=__builtin_fmaxf(__uint_as_float(rr[0]),__uint_as_float(rr[1])); } \
      resc=false; \
      if(__builtin_expect(__any(rm>(float)THRL),0)){ const float dl=__builtin_fmaxf(rm,0.f); mhat+=dl; \
        _Pragma("unroll") for(int r=0;r<16;++r){C0[r]-=dl;C1[r]-=dl;} \
        _Pragma("unroll") for(int r=0;r<16;++r)negm[r]=-mhat; asm volatile("":"+v"(negm)); \
        const float f=__builtin_amdgcn_exp2f(-dl); l_reg*=f; if(hi==0)wsf[r32]=f; resc=true; } } \
    SBAR(); \
    GAPB(o[0]=__builtin_amdgcn_mfma_f32_32x32x16_bf16(PAF(0),VFR(0),o[0],0,0,0), C0,0); \
    GAPB(o[1]=__builtin_amdgcn_mfma_f32_32x32x16_bf16(PAF(0),VFR(4),o[1],0,0,0), C0,4); \
    KRD(GL,0); GAPB(o[0]=__builtin_amdgcn_mfma_f32_32x32x16_bf16(PAF(1),VFR(1),o[0],0,0,0), C0,8); \
    KRD(GL,1); GAPB(o[1]=__builtin_amdgcn_mfma_f32_32x32x16_bf16(PAF(1),VFR(5),o[1],0,0,0), C0,12); \
    KRD(GL,2); GAPB(o[0]=__builtin_amdgcn_mfma_f32_32x32x16_bf16(PAF(2),VFR(2),o[0],0,0,0), C1,0); \
    KRD(GL,3); GAPB(o[1]=__builtin_amdgcn_mfma_f32_32x32x16_bf16(PAF(2),VFR(6),o[1],0,0,0), C1,4); \
    GAPB(o[0]=__builtin_amdgcn_mfma_f32_32x32x16_bf16(PAF(3),VFR(3),o[0],0,0,0), C1,8); \
    GAPB(o[1]=__builtin_amdgcn_mfma_f32_32x32x16_bf16(PAF(3),VFR(7),o[1],0,0,0), C1,12); \
    }while(0)
  int t=1;
  #undef CMASK
  #define CMASK(P0,P1,t) do{}while(0)
  for(;t+5<NT;t+=2){
    STEP(pB0,pB1,pA0,pA1,t,true,true,true);     WAIT_BAR(2); RESC(); ROT();
    STEP(pA0,pA1,pB0,pB1,t+1,true,true,true);   WAIT_BAR(2); RESC(); ROT();
  }
  #undef CMASK
  #define CMASK(P0,P1,t) do{}while(0)
  #define ENDW(tt) do{ if((tt)+3<NT){WAIT_BAR(2);} else if((tt)+2<NT){WAIT_BAR(1);} else {WAIT_BAR(0);} }while(0)
  for(;t+1<NT;t+=2){
    STEP(pB0,pB1,pA0,pA1,t,(t+3<NT),(t+1<NT),(t+1<NT));       ENDW(t);   RESC(); ROT();
    STEP(pA0,pA1,pB0,pB1,t+1,(t+4<NT),(t+2<NT),(t+2<NT));     ENDW(t+1); RESC(); ROT();
  }
  STEP(pB0,pB1,pA0,pA1,NT-1,false,false,false); RESC();
  { float sacc=pB0[0]+pB0[1]; _Pragma("unroll") for(int r=2;r<16;++r)sacc+=pB0[r]; _Pragma("unroll") for(int r=0;r<16;++r)sacc+=pB1[r]; l_reg+=sacc;
    pw0=(u32x4){PKW(pB0,0),PKW(pB0,2),PKW(pB0,4),PKW(pB0,6)};pw1=(u32x4){PKW(pB0,8),PKW(pB0,10),PKW(pB0,12),PKW(pB0,14)};pw2=(u32x4){PKW(pB1,0),PKW(pB1,2),PKW(pB1,4),PKW(pB1,6)};pw3=(u32x4){PKW(pB1,8),PKW(pB1,10),PKW(pB1,12),PKW(pB1,14)};
    SBAR(); pv(o,vb0+sl_cur,PAF(0),PAF(1),PAF(2),PAF(3)); }
  #undef PKW
  #undef PAF
  #undef VFR
  #undef PIN
  #undef MX3
  #undef GAPA
  #undef GAPB
  #undef EX
  #undef VRD
  #undef KRD
  #undef STEP
  #undef ENDW
  {auto rr=__builtin_amdgcn_permlane32_swap(__float_as_uint(l_reg),__float_as_uint(l_reg),false,false);l_reg=__uint_as_float(rr[0])+__uint_as_float(rr[1]);}
  if(hi==0)wsf[32+r32]=l_reg;asm volatile("s_waitcnt lgkmcnt(0)":::"memory");
  float rli[16];
  #pragma unroll
  for(int r=0;r<16;++r)rli[r]=__builtin_amdgcn_rcpf(wsf[32+crow(r,hi)]);
  bf16*Ow=O+(qrow0+wid*QBLK)*QP+h*D;
  { bf16*stg=(bf16*)(shm+LDS_OST)+wid*2048;
    #pragma unroll
    for(int r=0;r<16;++r){const int orow=crow(r,hi);
      #pragma unroll
      for(int d0=0;d0<2;++d0)stg[orow*64+d0*32+r32]=__float2bfloat16(o[d0][r]*rli[r]);}
    asm volatile("s_waitcnt lgkmcnt(0)":::"memory");
    #pragma unroll
    for(int i=0;i<4;++i){const int row=i*8+(lane>>3),ch=lane&7; const u32x4 v=*(const u32x4*)(stg+row*64+ch*8); ATTN_STORE16(Ow+(long)row*QP+ch*8,v);} }
  asm volatile("s_waitcnt lgkmcnt(0)\n\ts_barrier":::"memory");
  #undef DMA_K
  #undef DMA_V
  #undef CMASK
  #undef START
  #undef RESC
  #undef ROT
}
constexpr int ATTN_LDS_BYTES=LDS_BYTES;
struct AttnTensors { const bf16* Q; const bf16* K; const bf16* V; bf16* O; };
template<int THRL=8> __device__ __forceinline__ void attn_phase(char*lds,const AttnTensors&T,const QPre&QN,int G,int vcu,bool with_ctx,long ctx_row0){
  const int total=4*NHEAD*NQB;
  for(int i=0;;++i){
    int x,n;
    if(G==256){ if(i>=4)break; x=vcu>>5; n=i*32+(vcu&31); }
    else { const int u=i*G+vcu; if(u>=total)break; x=u>>7; n=u&127; }
    const int b=x>>1,kvh=x&1,h=kvh*4+(n>>5),qb=n&31;
    attn_unit<THRL>(b,h,(long)b*SEQQ+(long)qb*QB,SEQK/KVBLK,qb*QB,QN,T.Q,T.K,T.V,T.O,lds);
  }
  if(with_ctx){
    for(int u=vcu;u<4*NHEAD;u+=G){ const int b=u>>3,h=u&7; attn_unit<THRL>(b,h,ctx_row0+(long)b*256,4,-1,QN,T.Q,T.K,T.V,T.O,lds); }
  }
}
#undef SBAR
#undef WAIT_BAR
}

constexpr int NWAVES = 8, NTHR = 512;
constexpr int DMODEL = 1024, NB = 4, SEQ = 8192, CTXL = 256, NLAT = NB * SEQ, NCTX = NB * CTXL, MT = NLAT + NCTX;
constexpr int INW = 2048, NE = 32, KEYS = SEQ + CTXL;
constexpr int SORT_TILES = 560, SORT_ROWS = SORT_TILES * 256;
constexpr float EPSN = 1e-6f;
constexpr int NCHUNK = 66, CHUNK = 128;
constexpr int NPH_PRO = 2, NPH_LAYER = 13, NPH = NPH_PRO + 2 * NPH_LAYER;

constexpr size_t MiB = 1u << 20;
constexpr size_t WS_CTL = 0, CTL_ZERO_BYTES = 1 * MiB;
constexpr size_t WS_MOD = 1 * MiB, WS_ROPEC = 2 * MiB, WS_ROPES = 3 * MiB, WS_H2 = 4 * MiB, WS_KFC = 10 * MiB, WS_BLKCNT = 12 * MiB, WS_TILEE = 13 * MiB, WS_SCANS = 14 * MiB;
constexpr size_t WS_WINT = 16 * MiB, WS_WOUTT = 24 * MiB, WS_W1T = 32 * MiB, WS_W2T = 288 * MiB, WS_KF = 416 * MiB, WS_KHAT = 448 * MiB, WS_XR = 512 * MiB, WS_H = 644 * MiB;
constexpr size_t WS_U = 712 * MiB, WS_Q = 844 * MiB, WS_K = 877 * MiB, WS_V = 886 * MiB, WS_ATT = 895 * MiB, WS_LAB = 928 * MiB, WS_LRUO = 1060 * MiB, WS_VT = 1093 * MiB, WS_X0T = 1125 * MiB,
                 WS_HYO = 1157 * MiB, WS_MIXA = 1190 * MiB;
constexpr size_t WS_WGT = 11 * MiB, WS_SPT = 10 * MiB + 768 * 1024, WS_XL = 1256 * MiB;
constexpr size_t WS_GC = 10 * MiB + 896 * 1024;
constexpr size_t WS_CB = 10 * MiB + 960 * 1024;
constexpr size_t WS_F = 712 * MiB, WS_ASORT = 778 * MiB, WS_ACT = 1058 * MiB, WS_YS = 1338 * MiB, WS_TOPI = 1618 * MiB, WS_GATE = 1619 * MiB, WS_POS = 1620 * MiB, WS_RSSP = 1622 * MiB, WS_ROWTOK = 1625 * MiB, WS_END = 1626 * MiB;
constexpr size_t LAB_STRIDE = (size_t)MT * 256;
constexpr int CW_BAR = 4096;
constexpr int CW_NTILES = 64;

constexpr int RING_OFF = 0, RING_BYTES = 131072, MOETAB_OFF = 131072, LDSCTL_OFF = 155648, LDS_BYTES = 156160;

#define GAS __attribute__((address_space(1)))
#define LAS __attribute__((address_space(3)))
typedef unsigned short bf16;
typedef unsigned v4u __attribute__((ext_vector_type(4)));
typedef unsigned v2u __attribute__((ext_vector_type(2)));
typedef float f32x4 __attribute__((ext_vector_type(4)));
#define LDS_WAIT() asm volatile("s_waitcnt lgkmcnt(0)" ::: "memory")
#define VM_WAIT() asm volatile("s_waitcnt vmcnt(0)" ::: "memory")
__device__ __forceinline__ unsigned f2bf(float f) { unsigned u = __builtin_bit_cast(unsigned, f); return (u + 0x7fffu + ((u >> 16) & 1u)) >> 16; }
__device__ __forceinline__ unsigned pk2(float lo, float hi) { return f2bf(lo) | (f2bf(hi) << 16); }
__device__ __forceinline__ float bf2f(unsigned short b) { return __builtin_bit_cast(float, (unsigned)b << 16); }
__device__ __forceinline__ float bflo(unsigned w) { return __builtin_bit_cast(float, w << 16); }
__device__ __forceinline__ float bfhi(unsigned w) { return __builtin_bit_cast(float, w & 0xffff0000u); }
__device__ __forceinline__ float wave_sum(float v) {
#pragma unroll
    for (int o = 1; o < 64; o <<= 1) v += __shfl_xor(v, o);
    return v;
}
__device__ __forceinline__ float sigmoidf_(float x) { return 1.0f / (1.0f + __expf(-x)); }
__device__ __forceinline__ void sincos_d(double x, double& s, double& c) {
    const double kd = __builtin_rint(x * 0.63661977236758134308);
    const int k = (int)kd;
    double r = __builtin_fma(-kd, 1.57079632673412561417e+00, x);
    r = __builtin_fma(-kd, 6.07710050650619224932e-11, r);
    const double z = r * r;
    const double ps = r + r * z * (-1.66666666666666324348e-01 + z * (8.33333333332248946124e-03 + z * (-1.98412698298579493134e-04 + z * (2.75573137070700676789e-06 + z * (-2.50507602534068634195e-08 + z * 1.58969099521155010221e-10)))));
    const double pc = 1.0 - 0.5 * z + z * z * (4.16666666666666019037e-02 + z * (-1.38888888888741095749e-03 + z * (2.48015872894767294178e-05 + z * (-2.75573143513906633035e-07 + z * (2.08757232129817482790e-09 + z * -1.13596475577881948265e-11)))));
    const int q = k & 3;
    s = (q == 0) ? ps : (q == 1) ? pc : (q == 2) ? -ps : -pc;
    c = (q == 0) ? pc : (q == 1) ? -ps : (q == 2) ? -pc : ps;
}
__device__ __forceinline__ float gelu_tanh(float x) {
    const float u = 0.7978845608028654f * (x + 0.044715f * x * x * x);
    const float t = 1.0f - 2.0f / (1.0f + __expf(2.0f * u));
    return 0.5f * x * (1.0f + t);
}
__device__ __forceinline__ int lds_add(LAS int* p, int v) { return __hip_atomic_fetch_add(p, v, __ATOMIC_RELAXED, __HIP_MEMORY_SCOPE_WORKGROUP); }

#define FFT_FN __device__ __forceinline__
typedef float f32x2v __attribute__((ext_vector_type(2)));
#define FFT_VEC2 f32x2v
#define FFT_DPTR LAS f32x2v*
#define FFT_LD(D, i) c32_from((D)[i])
#define FFT_ST(D, i, v) ((D)[i] = c32_to(v))
struct __attribute__((aligned(8))) c32 { float x, y; };
FFT_FN c32 cmul(c32 a, c32 b) { c32 r; r.x = a.x * b.x - a.y * b.y; r.y = a.x * b.y + a.y * b.x; return r; }
FFT_FN c32 cadd(c32 a, c32 b) { c32 r; r.x = a.x + b.x; r.y = a.y + b.y; return r; }
FFT_FN c32 csub(c32 a, c32 b) { c32 r; r.x = a.x - b.x; r.y = a.y - b.y; return r; }
FFT_FN c32 cmuli_neg(c32 a) { c32 r; r.x = a.y; r.y = -a.x; return r; }
FFT_FN int fpad(int a) { return a + (a >> 4); }
#ifdef FFT_VEC2
FFT_FN c32 c32_from(FFT_VEC2 t) { c32 r; r.x = t.x; r.y = t.y; return r; }
FFT_FN FFT_VEC2 c32_to(c32 a) { FFT_VEC2 t; t.x = a.x; t.y = a.y; return t; }
#endif
FFT_FN void dft4(c32& a0, c32& a1, c32& a2, c32& a3) {
    const c32 s02 = cadd(a0, a2), d02 = csub(a0, a2), s13 = cadd(a1, a3), d13 = cmuli_neg(csub(a1, a3));
    a0 = cadd(s02, s13); a2 = csub(s02, s13); a1 = cadd(d02, d13); a3 = csub(d02, d13);
}
FFT_FN void dft16(c32 (&v)[16]) {
    const float C1 = 0.92387953251128674f, S1 = 0.38268343236508977f, C2 = 0.70710678118654752f;
#pragma unroll
    for (int q2 = 0; q2 < 4; ++q2) dft4(v[q2], v[4 + q2], v[8 + q2], v[12 + q2]);
    { c32 w;
      w.x = C1; w.y = -S1; v[4 * 1 + 1] = cmul(v[4 * 1 + 1], w);
      w.x = C2; w.y = -C2; v[4 * 2 + 1] = cmul(v[4 * 2 + 1], w);
      w.x = S1; w.y = -C1; v[4 * 3 + 1] = cmul(v[4 * 3 + 1], w);
      w.x = C2; w.y = -C2; v[4 * 1 + 2] = cmul(v[4 * 1 + 2], w);
      v[4 * 2 + 2] = cmuli_neg(v[4 * 2 + 2]);
      w.x = -C2; w.y = -C2; v[4 * 3 + 2] = cmul(v[4 * 3 + 2], w);
      w.x = S1; w.y = -C1; v[4 * 1 + 3] = cmul(v[4 * 1 + 3], w);
      w.x = -C2; w.y = -C2; v[4 * 2 + 3] = cmul(v[4 * 2 + 3], w);
      w.x = -C1; w.y = S1; v[4 * 3 + 3] = cmul(v[4 * 3 + 3], w); }
#pragma unroll
    for (int p1 = 0; p1 < 4; ++p1) dft4(v[4 * p1 + 0], v[4 * p1 + 1], v[4 * p1 + 2], v[4 * p1 + 3]);
#pragma unroll
    for (int a = 0; a < 4; ++a)
#pragma unroll
        for (int b = a + 1; b < 4; ++b) { const c32 t = v[4 * a + b]; v[4 * a + b] = v[4 * b + a]; v[4 * b + a] = t; }
}
FFT_FN c32 twid(int j, int n) { float rev = (float)j / (float)n; asm volatile("" : "+v"(rev)); c32 w; w.x = __builtin_amdgcn_cosf(rev); w.y = -__builtin_amdgcn_sinf(rev); return w; }

FFT_FN void fft_fwd16(FFT_DPTR D, int g, int n) {
    const int s = n >> 4, blk = g / s, j = g - blk * s, base = blk * n + j;
    c32 v[16];
#pragma unroll
    for (int q = 0; q < 16; ++q) v[q] = FFT_LD(D, fpad(base + q * s));
    dft16(v);
    const c32 w = twid(j, n); c32 wp = w;
#pragma unroll
    for (int p = 1; p < 16; ++p) { v[p] = cmul(v[p], wp); wp = cmul(wp, w); }
#pragma unroll
    for (int p = 0; p < 16; ++p) FFT_ST(D, fpad(base + p * s), v[p]);
}
FFT_FN void fft_inv16(FFT_DPTR D, int g, int n) {
    const int s = n >> 4, blk = g / s, j = g - blk * s, base = blk * n + j;
    c32 v[16];
#pragma unroll
    for (int q = 0; q < 16; ++q) v[q] = FFT_LD(D, fpad(base + q * s));
    const c32 w = twid(j, n); c32 wp = w;
#pragma unroll
    for (int p = 1; p < 16; ++p) { v[p] = cmul(v[p], wp); wp = cmul(wp, w); }
    dft16(v);
#pragma unroll
    for (int p = 0; p < 16; ++p) FFT_ST(D, fpad(base + p * s), v[p]);
}
FFT_FN void fft_mid16(FFT_DPTR D, int g, const c32* KH) {
    c32 v[16];
#pragma unroll
    for (int q = 0; q < 16; ++q) v[q] = FFT_LD(D, 17 * g + q);
    dft16(v);
#pragma unroll
    for (int p = 0; p < 16; ++p) { const c32 k = KH[16 * g + p]; const c32 t = cmul(v[p], k); v[p].x = t.x; v[p].y = -t.y; }
    dft16(v);
#pragma unroll
    for (int p = 0; p < 16; ++p) FFT_ST(D, 17 * g + p, v[p]);
}
FFT_FN void fft_last16_out(FFT_DPTR D, int g, c32* OUT, float scale) {
    c32 v[16];
#pragma unroll
    for (int q = 0; q < 16; ++q) v[q] = FFT_LD(D, 17 * g + q);
    dft16(v);
#pragma unroll
    for (int p = 0; p < 16; ++p) { c32 t; t.x = v[p].x * scale; t.y = v[p].y * scale; OUT[16 * g + p] = t; }
}
FFT_FN void fft_first4(FFT_DPTR D, int j, c32 x0, c32 x1, c32 x2, c32 x3) {
    dft4(x0, x1, x2, x3);
    const c32 w = twid(j, 16384), w2 = cmul(w, w), w3 = cmul(w2, w);
    FFT_ST(D, fpad(j), x0); FFT_ST(D, fpad(j + 4096), cmul(x1, w)); FFT_ST(D, fpad(j + 8192), cmul(x2, w2)); FFT_ST(D, fpad(j + 12288), cmul(x3, w3));
}
FFT_FN void fft_final4(FFT_DPTR D, int j, c32& u0, c32& u1) {
    const c32 w = twid(j, 16384), w2 = cmul(w, w), w3 = cmul(w2, w);
    c32 a0 = FFT_LD(D, fpad(j)), a1 = cmul(FFT_LD(D, fpad(j + 4096)), w), a2 = cmul(FFT_LD(D, fpad(j + 8192)), w2), a3 = cmul(FFT_LD(D, fpad(j + 12288)), w3);
    dft4(a0, a1, a2, a3);
    u0 = a0; u1 = a1;
}
FFT_FN void fft_first4_inplace(FFT_DPTR D, int j) {
    c32 x0 = FFT_LD(D, fpad(j)), x1 = FFT_LD(D, fpad(j + 4096)), x2 = FFT_LD(D, fpad(j + 8192)), x3 = FFT_LD(D, fpad(j + 12288));
    fft_first4(D, j, x0, x1, x2, x3);
}
#define XB_TMO      128
#define XB_XCNT(j)  (256  + 64 * (j))
#define XB_XSUB(j)  (1280 + 64 * (j))
#define XB_XGEN(j)  (2304 + 64 * (j))
#define XB_TOP      3328
#define XB_TOPGEN   3392
#define XCD_BAR_WORDS 3456
#define XB_SPIN_CAP (1u << 22)

__device__ __forceinline__ unsigned xb_ld(unsigned* p)              { return __hip_atomic_load(p, __ATOMIC_RELAXED, __HIP_MEMORY_SCOPE_AGENT); }
__device__ __forceinline__ unsigned xb_add(unsigned* p, unsigned v) { return __hip_atomic_fetch_add(p, v, __ATOMIC_RELAXED, __HIP_MEMORY_SCOPE_AGENT); }
__device__ __forceinline__ unsigned xb_xcc_id() { return (unsigned)__builtin_amdgcn_s_getreg((3 << 11) | 20) & 0xFu; }
#define XB_SPIN(cond, bar) do { unsigned _sp = 0; while (cond) { __builtin_amdgcn_s_sleep(1); \
    if ((++_sp & 255u) == 0u) { if (xb_ld(&(bar)[XB_TMO])) break; if (_sp > XB_SPIN_CAP) { atomicAdd(&(bar)[XB_TMO], 1u); break; } } } } while (0)

struct XcdBarrier {
    unsigned* bar; unsigned x;
    volatile LAS unsigned* st;
};

__device__ __forceinline__ XcdBarrier xcd_barrier_post(unsigned* bar, volatile LAS unsigned* st) {
    XcdBarrier b; b.bar = bar; b.x = xb_xcc_id(); b.st = st;
    if (threadIdx.x == 0) (void)xb_add(&bar[XB_XCNT(b.x)], 1u);
    return b;
}
__device__ __forceinline__ void xcd_barrier_complete(unsigned* bar, unsigned x, unsigned& nloc, unsigned& nx) {
    const unsigned G = gridDim.x * gridDim.y * gridDim.z;
    unsigned sum, cnt, mine, sp = 0u;
    for (;;) {
        sum = 0u; cnt = 0u; mine = 0u;
#pragma unroll
        for (unsigned j = 0; j < 16; ++j) { const unsigned c = xb_ld(&bar[XB_XCNT(j)]); sum += c; cnt += (c > 0u) ? 1u : 0u; mine = (j == x) ? c : mine; }
        if (sum == G) break;
        __builtin_amdgcn_s_sleep(1);
        if ((++sp & 255u) == 0u) { if (xb_ld(&bar[XB_TMO])) break; if (sp > XB_SPIN_CAP) { atomicAdd(&bar[XB_TMO], 1u); break; } }
    }
    nloc = mine > 0u ? mine : 1u; nx = cnt > 0u ? cnt : 1u;
}

__device__ __forceinline__ void xcd_barrier(const XcdBarrier& b) {
    asm volatile("s_waitcnt vmcnt(0)" ::: "memory");
    __syncthreads();
    if (threadIdx.x == 0) {
        unsigned* bar = b.bar;
        __builtin_amdgcn_s_waitcnt(0);
        unsigned nloc = b.st[0], nx = b.st[1];
        if (nloc == 0u) { xcd_barrier_complete(bar, b.x, nloc, nx); b.st[0] = nloc; b.st[1] = nx; }
        const unsigned old = xb_add(&bar[XB_XSUB(b.x)], 1u);
        const unsigned gen = old / nloc;
        if (old + 1u == (gen + 1u) * nloc) {
            __builtin_amdgcn_fence(__ATOMIC_RELEASE, "agent");
            asm volatile("s_waitcnt vmcnt(0)" ::: "memory");
            const unsigned og = xb_add(&bar[XB_TOP], 1u);
            const unsigned tg = og / nx;
            if (og + 1u == (tg + 1u) * nx) xb_add(&bar[XB_TOPGEN], 1u);
            else XB_SPIN(xb_ld(&bar[XB_TOPGEN]) == tg, bar);
            __builtin_amdgcn_fence(__ATOMIC_ACQUIRE, "agent");
            xb_add(&bar[XB_XGEN(b.x)], 1u);
            asm volatile("s_waitcnt vmcnt(0)" ::: "memory");
        } else {
            XB_SPIN(xb_ld(&bar[XB_XGEN(b.x)]) == gen, bar);
            __builtin_amdgcn_fence(__ATOMIC_ACQUIRE, "agent");
            asm volatile("s_waitcnt vmcnt(0)" ::: "memory");
        }
    }
    __syncthreads();
}


struct Frame {
    LAS unsigned char* lds; unsigned* ctl; unsigned char* ws;
    int tid, lane, wave, vcu, G, gw, ngw;
};
__device__ const float ROPE_INV[16] = {1.0f, 0.5623413251903491f, 0.31622776601683794f, 0.1778279410038923f, 0.1f, 0.05623413251903491f, 0.03162277660168379f, 0.01778279410038923f,
                                       0.01f, 0.005623413251903491f, 0.0031622776601683794f, 0.001778279410038923f, 0.001f, 0.0005623413251903491f, 0.00031622776601683794f, 0.0001778279410038923f};

__device__ __forceinline__ void p0_transpose_item(const float* W, int K, int N, bf16* WT, LAS float* scr, int item, int lane) {
    const int nblk = N / 32, kb = item / nblk, nb = item % nblk, k0 = 64 * kb, n0 = 32 * nb;
#pragma unroll 8
    for (int i = 0; i < 32; ++i) { const int kk = 2 * i + (lane >> 5); scr[kk * 33 + (lane & 31)] = W[(size_t)(k0 + kk) * N + n0 + (lane & 31)]; }
    LDS_WAIT(); asm volatile("" ::: "memory");
    const int c = lane & 7;
#pragma unroll
    for (int j = 0; j < 4; ++j) { const int n = (lane >> 3) + 8 * j; const LAS float* s = scr + (8 * c) * 33 + n;
        v4u o; o.x = pk2(s[0 * 33], s[1 * 33]); o.y = pk2(s[2 * 33], s[3 * 33]); o.z = pk2(s[4 * 33], s[5 * 33]); o.w = pk2(s[6 * 33], s[7 * 33]);
        *(GAS v4u*)(WT + (size_t)(n0 + n) * K + k0 + 8 * c) = o; }
    LDS_WAIT(); asm volatile("" ::: "memory");
}

__device__ __forceinline__ void ph_prologue_a(const Frame& F, const float* c, const float* cctx, const float* w_mod, const float* b_mod, const float* w_in, const float* w_out,
                                              const float* moe_w1, const float* moe_w2, const float* hy_w1, const float* hy_b1, const float* hy_w2, const float* hy_b2, const float* hy_freq, const float* lru_gw, const float* lru_lam) {
    {
        LAS float* scr = (LAS float*)(F.lds + F.wave * 16384);
        constexpr int I_IN = 2 * 1024, I_OUT = 2 * 512, I_W1 = 64 * 1024, I_W2 = 64 * 512, NIT = I_IN + I_OUT + I_W1 + I_W2;
        bf16* WinT = (bf16*)(F.ws + WS_WINT); bf16* WoutT = (bf16*)(F.ws + WS_WOUTT); bf16* W1T = (bf16*)(F.ws + WS_W1T); bf16* W2T = (bf16*)(F.ws + WS_W2T);
        for (int it = F.gw; it < NIT; it += F.ngw) {
            int r = it;
            if (r < I_IN) { const int m = r >> 10; p0_transpose_item(w_in + (size_t)m * 1024 * 2048, 1024, 2048, WinT + (size_t)m * 2048 * 1024, scr, r & 1023, F.lane); continue; } r -= I_IN;
            if (r < I_OUT) { const int m = r >> 9; p0_transpose_item(w_out + (size_t)m * 1024 * 1024, 1024, 1024, WoutT + (size_t)m * 1024 * 1024, scr, r & 511, F.lane); continue; } r -= I_OUT;
            if (r < I_W1) { const int m = r >> 10; p0_transpose_item(moe_w1 + (size_t)m * 1024 * 2048, 1024, 2048, W1T + (size_t)m * 2048 * 1024, scr, r & 1023, F.lane); continue; } r -= I_W1;
            { const int m = r >> 9; p0_transpose_item(moe_w2 + (size_t)m * 1024 * 1024, 1024, 1024, W2T + (size_t)m * 1024 * 1024, scr, r & 511, F.lane); }
        }
    }
    __syncthreads();
    {
        LAS float* sl = (LAS float*)(F.lds);
        LAS float* red = (LAS float*)(F.lds + 20480);
        float* MOD = (float*)(F.ws + WS_MOD);
        if ((int)blockIdx.x < 192) {
            for (int i = F.tid; i < 5 * 1024; i += NTHR) { const int r = i >> 10, k = i & 1023; const float v = (r < 4) ? c[r * 1024 + k] : cctx[k]; sl[i] = v / (1.0f + __expf(-v)); }
        }
        __syncthreads();
        for (int it = blockIdx.x; it < 192; it += F.G) {
            const int l = it / 96, n = (it % 96) * 64 + F.lane;
            float a0 = 0.f, a1 = 0.f, a2 = 0.f, a3 = 0.f, a4 = 0.f;
            const float* wp = w_mod + ((size_t)l * 1024 + F.wave * 128) * 6144 + n;
#pragma unroll 8
            for (int k = 0; k < 128; ++k) { const float w = wp[(size_t)k * 6144]; const int kk = F.wave * 128 + k;
                a0 += sl[kk] * w; a1 += sl[1024 + kk] * w; a2 += sl[2048 + kk] * w; a3 += sl[3072 + kk] * w; a4 += sl[4096 + kk] * w; }
            red[(F.wave * 5 + 0) * 64 + F.lane] = a0; red[(F.wave * 5 + 1) * 64 + F.lane] = a1; red[(F.wave * 5 + 2) * 64 + F.lane] = a2; red[(F.wave * 5 + 3) * 64 + F.lane] = a3; red[(F.wave * 5 + 4) * 64 + F.lane] = a4;
            __syncthreads();
            if (F.tid < 320) { const int r = F.tid >> 6, ln = F.tid & 63; float s = 0.f;
#pragma unroll
                for (int w = 0; w < 8; ++w) s += red[(w * 5 + r) * 64 + ln];
                const int nn = (it % 96) * 64 + ln; MOD[(size_t)(l * 5 + r) * 6144 + nn] = s + b_mod[l * 6144 + nn]; }
            __syncthreads();
        }
    }
    {
        bf16* WGT = (bf16*)(F.ws + WS_WGT); float* SPT = (float*)(F.ws + WS_SPT);
        for (int idx = blockIdx.x * NTHR + F.tid; idx < 2 * 1024 * 256; idx += F.G * NTHR) {
            const int l = idx >> 18, nidx = (idx >> 8) & 1023, k = idx & 255;
            const int pn = nidx >> 8, j = (nidx >> 7) & 1, cc = nidx & 127, d = pn >> 1, ch = 128 * (pn & 1) + cc, n = ch >> 6, e = ch & 63;
            const float v = ((k >> 6) == n) ? lru_gw[((size_t)((((l * 2 + d) * 2 + j) * 4 + n) * 64 + (k & 63))) * 64 + e] : 0.f;
            WGT[idx] = (bf16)f2bf(v); }
        for (int idx = blockIdx.x * NTHR + F.tid; idx < 2 * 2 * 256; idx += F.G * NTHR) SPT[idx] = log1pf(expf(-lru_lam[idx]));
    }
    {
        float* RC = (float*)(F.ws + WS_ROPEC); float* RS = (float*)(F.ws + WS_ROPES);
        for (int idx = blockIdx.x * NTHR + F.tid; idx < SEQ * 32; idx += F.G * NTHR) {
            const int t = idx >> 5, i = idx & 31; const int pos = (i < 16) ? (t >> 6) : (t & 63);
            const float ang = (float)pos * ROPE_INV[i & 15];
            double s, cc; sincos_d((double)ang, s, cc); RC[idx] = (float)cc; RS[idx] = (float)s; }
    }
    {
        float* H2 = (float*)(F.ws + WS_H2);
        for (int it = F.gw; it < 2 * SEQ + CTXL; it += F.ngw) {
            const int v = it >> 13, t = (v < 2) ? (it & (SEQ - 1)) : (it - 2 * SEQ), L = (v < 2) ? SEQ : CTXL, l = (v == 1) ? 1 : 0;
            const int j = F.lane;
            float z = 0.f;
            if (j == 0) z = (float)t / (float)(L - 1);
            else if (j <= 32) { const int b = (j - 1) & 15; const float band = 1e-4f + (float)b * ((15.0f - 1e-4f) / 15.0f);
                const float ang = ((6.283185307179586f / (float)L) * (float)t) * band;
                double s, cc; sincos_d((double)ang, s, cc); z = (j <= 16) ? (float)cc : -(float)s; }
            const float fr = hy_freq[l * 64 + j];
            float p1 = hy_b1[l * 64 + j];
            const float* w1 = hy_w1 + (size_t)l * 33 * 64;
#pragma unroll
            for (int i = 0; i < 33; ++i) p1 += __shfl(z, i) * w1[i * 64 + j];
            double s1, c1; sincos_d((double)(fr * p1), s1, c1); const float h1 = (float)s1;
            float p2 = hy_b2[l * 64 + j];
            const float* w2 = hy_w2 + (size_t)l * 64 * 64;
#pragma unroll 16
            for (int i = 0; i < 64; ++i) p2 += __shfl(h1, i) * w2[i * 64 + j];
            double s2, c2; sincos_d((double)(fr * p2), s2, c2);
            H2[((size_t)v * SEQ + t) * 64 + j] = (float)s2;
        }
    }
}

__device__ __forceinline__ void ph_prologue_b(const Frame& F, const float* hy_w3, const float* hy_decay, const float* gffn, const float* router_w, const float* router_b) {
    { const float* MOD = (const float*)(F.ws + WS_MOD); float* CB = (float*)(F.ws + WS_CB);
      for (int it = F.gw; it < 2 * 5 * 32; it += F.ngw) { const int lb = it >> 5, e = it & 31, l = lb / 5; const float* sf = MOD + (size_t)lb * 6144 + 3 * 1024; float s = 0.f;
#pragma unroll
          for (int q = 0; q < 16; ++q) { const int cc = 64 * q + F.lane; s += sf[cc] * router_w[(size_t)l * 32768 + cc * 32 + e]; }
          s = wave_sum(s); if (F.lane == 0) CB[it] = s + router_b[l * 32 + e]; } }
    { const float* MOD = (const float*)(F.ws + WS_MOD); float* GC = (float*)(F.ws + WS_GC);
      for (int idx = blockIdx.x * NTHR + F.tid; idx < 2 * 5 * 1024; idx += F.G * NTHR) { const int lb = idx >> 10, cc = idx & 1023, l = lb / 5; GC[idx] = gffn[l * 1024 + cc] * (1.0f + MOD[(size_t)lb * 6144 + 4 * 1024 + cc]); } }
    LAS f32x2v* D = (LAS f32x2v*)(F.lds);
    LAS float* kt = (LAS float*)(F.lds);
    LAS float* w3c = (LAS float*)(F.lds + 139264);
    LAS float* red = (LAS float*)(F.lds + 139264 + 512);
    const float* H2 = (const float*)(F.ws + WS_H2);
    c32* KHAT = (c32*)(F.ws + WS_KHAT); float* KFC = (float*)(F.ws + WS_KFC);
    for (int it = blockIdx.x; it < 768; it += F.G) {
        const int v = it >> 8, c = it & 255, L = (v < 2) ? SEQ : CTXL, l = (v == 1) ? 1 : 0;
        if (F.tid < 128) w3c[F.tid] = hy_w3[(size_t)l * 64 * 512 + (F.tid & 63) * 512 + (F.tid >> 6) * 256 + c];
        if (F.tid == 0) { if (v < 2) { f32x2v z; z.x = 0.f; z.y = 0.f; D[fpad(L)] = z; } else kt[L] = 0.f; }
        __syncthreads();
        const float df = fabsf(hy_decay[l * 512 + c]), db = fabsf(hy_decay[l * 512 + 256 + c]);
        float asum = 0.f;
        for (int t = F.tid; t < L; t += NTHR) {
            const f32x4* row = (const f32x4*)(H2 + ((size_t)v * SEQ + t) * 64);
            float hf = 0.f, hb = 0.f;
#pragma unroll
            for (int q = 0; q < 16; ++q) { const f32x4 h = row[q];
                hf += h.x * w3c[4 * q] + h.y * w3c[4 * q + 1] + h.z * w3c[4 * q + 2] + h.w * w3c[4 * q + 3];
                hb += h.x * w3c[64 + 4 * q] + h.y * w3c[64 + 4 * q + 1] + h.z * w3c[64 + 4 * q + 2] + h.w * w3c[64 + 4 * q + 3]; }
            const float t01 = (float)t / (float)(L - 1);
            hf *= expf(-t01 * df); hb *= expf(-t01 * db);
            asum += fabsf(hf); if (t >= 1) asum += fabsf(hb);
            if (v < 2) { f32x2v z; z.x = hf; z.y = 0.f; D[fpad(t)] = z; if (t >= 1) { z.x = hb; D[fpad(2 * L - t)] = z; } }
            else { kt[t] = hf; if (t >= 1) kt[2 * L - t] = hb; }
        }
        asum = wave_sum(asum);
        if (F.lane == 0) red[F.wave] = asum;
        __syncthreads();
        float tot = 0.f;
#pragma unroll
        for (int w = 0; w < 8; ++w) tot += red[w];
        const float inv = 1.0f / tot;
        if (v < 2) {
            c32* out = KHAT + (size_t)(v * 256 + c) * 16384;
#pragma unroll 1
            for (int i = 0; i < 8; ++i) fft_first4_inplace(D, F.tid + 512 * i);
            __syncthreads();
            { fft_fwd16(D, F.tid, 4096); fft_fwd16(D, F.tid + 512, 4096); }
            __syncthreads();
            { fft_fwd16(D, F.tid, 256); fft_fwd16(D, F.tid + 512, 256); }
            __syncthreads();
            _Pragma("unroll 1") for (int g_ = F.tid; g_ < 1024; g_ += 512) fft_last16_out(D, g_, out, inv * (1.0f / 16384.0f));
        } else {
            float* dst = KFC + (size_t)c * 512;
            for (int j = F.tid; j < 2 * L; j += NTHR) dst[j] = kt[j] * inv;
        }
        __syncthreads();
    }
}

__device__ __forceinline__ void ph_norm_mod(const Frame& F, int l, const float* x, const float* ctx, const float* gmix) {
    const float* XR = (const float*)(F.ws + WS_XR); const float* MOD = (const float*)(F.ws + WS_MOD); bf16* H = (bf16*)(F.ws + WS_H);
    for (int r = F.gw; r < MT; r += F.ngw) {
        const float* src = (l == 0) ? (r < NLAT ? x + (size_t)r * 1024 : ctx + (size_t)(r - NLAT) * 1024) : XR + (size_t)r * 1024;
        const int bidx = r < NLAT ? r / SEQ : 4;
        const float* shift = MOD + (size_t)(l * 5 + bidx) * 6144; const float* scale = shift + 1024; const float* g = gmix + l * 1024;
        f32x4 v[4]; float ss = 0.f;
#pragma unroll
        for (int j = 0; j < 4; ++j) { v[j] = ((const f32x4*)src)[64 * j + F.lane]; ss += (v[j].x * v[j].x + v[j].y * v[j].y) + (v[j].z * v[j].z + v[j].w * v[j].w); }
        const float rstd = 1.0f / sqrtf(wave_sum(ss) * (1.0f / 1024.0f) + EPSN);
#pragma unroll
        for (int j = 0; j < 4; ++j) { const int cb = 64 * j + F.lane; const f32x4 gg = ((const f32x4*)g)[cb], sc = ((const f32x4*)scale)[cb], sh = ((const f32x4*)shift)[cb];
            const f32x4 y = v[j] * rstd * gg * (sc + 1.0f) + sh;
            v2u o; o.x = pk2(y.x, y.y); o.y = pk2(y.z, y.w); ((v2u*)(H + (size_t)r * 1024))[cb] = o; }
    }
}

__device__ __forceinline__ void ph_post_proj(const Frame& F, int l, const float* qg_, const float* kg_, const float* lru_cw, const float* lru_cb, const float* hy_cw, const float* hy_cb) {
    const bf16* U = (const bf16*)(F.ws + WS_U);
    {
        bf16* K = (bf16*)(F.ws + WS_K); bf16* V = (bf16*)(F.ws + WS_V);
        const float* RC = (const float*)(F.ws + WS_ROPEC); const float* RS = (const float*)(F.ws + WS_ROPES);
        const int o8 = 8 * (F.lane & 7), hl = F.lane & 31;
        const f32x4 kg0 = *(const f32x4*)(kg_ + l * 64 + o8), kg1 = *(const f32x4*)(kg_ + l * 64 + o8 + 4);
        const bool lohalf = (F.lane & 4) == 0;
        for (int r2 = 2 * F.gw; r2 < MT; r2 += 2 * F.ngw) {
            const int r = r2 + (F.lane >> 5);
            const bool isctx = r >= NLAT; const int b = isctx ? (r - NLAT) / CTXL : r / SEQ; const int t = isctx ? (r - NLAT) % CTXL : r % SEQ;
            const v4u wk = ((const v4u*)(U + (size_t)r * INW + 512))[hl];
            f32x4 c0 = {1.f, 1.f, 1.f, 1.f}, c1 = c0, s0 = {0.f, 0.f, 0.f, 0.f}, s1 = s0;
            if (!isctx) { const float* rc = RC + t * 32 + 8 * (F.lane & 3); const float* rs = RS + t * 32 + 8 * (F.lane & 3);
                c0 = *(const f32x4*)rc; c1 = *(const f32x4*)(rc + 4); s0 = *(const f32x4*)rs; s1 = *(const f32x4*)(rs + 4); }
            const size_t krow = (size_t)b * KEYS + (isctx ? t : CTXL + t);
            float x[8] = {bflo(wk.x), bfhi(wk.x), bflo(wk.y), bfhi(wk.y), bflo(wk.z), bfhi(wk.z), bflo(wk.w), bfhi(wk.w)};
            float ss = 0.f;
#pragma unroll
            for (int i = 0; i < 8; ++i) ss += x[i] * x[i];
            ss += __shfl_xor(ss, 1); ss += __shfl_xor(ss, 2); ss += __shfl_xor(ss, 4);
            const float rstd = 1.0f / sqrtf(ss * (1.0f / 64.0f) + EPSN);
            float y[8], o[8];
#pragma unroll
            for (int i = 0; i < 8; ++i) y[i] = x[i] * rstd * (i < 4 ? kg0[i] : kg1[i - 4]);
#pragma unroll
            for (int i = 0; i < 8; ++i) { const float p = __shfl_xor(y[i], 4); const float cs = i < 4 ? c0[i] : c1[i - 4], sn = i < 4 ? s0[i] : s1[i - 4];
                o[i] = lohalf ? (y[i] * cs - p * sn) : (y[i] * cs + p * sn); }
            v4u ow; ow.x = pk2(o[0], o[1]); ow.y = pk2(o[2], o[3]); ow.z = pk2(o[4], o[5]); ow.w = pk2(o[6], o[7]);
            if (hl < 16) ((v4u*)(K + krow * 128))[hl] = ow; else ((v4u*)(V + krow * 128))[hl - 16] = wk;
        }
    }
    {
        bf16* XL = (bf16*)(F.ws + WS_XL);
        for (int idx = blockIdx.x * NTHR + F.tid; idx < MT * 32; idx += F.G * NTHR) {
            const int r = idx >> 5, c8 = (idx & 31) * 8;
            const bool isctx = r >= NLAT; const int Ls = isctx ? CTXL : SEQ; const int t = isctx ? (r - NLAT) % CTXL : r % SEQ;
            float acc[8];
#pragma unroll
            for (int i = 0; i < 8; ++i) acc[i] = lru_cb[l * 256 + c8 + i];
#pragma unroll
            for (int j = 0; j < 4; ++j) { const int tj = t + j - 2;
                if (tj >= 0 && tj < Ls) { const v4u w = *(const v4u*)(U + (size_t)(r + j - 2) * INW + 768 + c8);
                    const f32x4 w0 = *(const f32x4*)(lru_cw + (l * 4 + j) * 256 + c8), w1 = *(const f32x4*)(lru_cw + (l * 4 + j) * 256 + c8 + 4);
                    acc[0] += w0.x * bflo(w.x); acc[1] += w0.y * bfhi(w.x); acc[2] += w0.z * bflo(w.y); acc[3] += w0.w * bfhi(w.y);
                    acc[4] += w1.x * bflo(w.z); acc[5] += w1.y * bfhi(w.z); acc[6] += w1.z * bflo(w.w); acc[7] += w1.w * bfhi(w.w); } }
            v4u o; o.x = pk2(acc[0], acc[1]); o.y = pk2(acc[2], acc[3]); o.z = pk2(acc[4], acc[5]); o.w = pk2(acc[6], acc[7]);
            *(v4u*)(XL + (size_t)r * 256 + c8) = o;
        }
    }
    __syncthreads();
    {
        LAS bf16* hs = (LAS bf16*)(F.lds);
        bf16* VT = (bf16*)(F.ws + WS_VT); bf16* X0T = (bf16*)(F.ws + WS_X0T);
        const float* cw = hy_cw + (size_t)l * 3 * 768; const float* cbp = hy_cb + l * 768;
        for (int it = blockIdx.x; it < NLAT / 64; it += F.G) {
            const int b = it >> 7, t0 = (it & 127) * 64;
            for (int i = F.tid; i < 66 * 384; i += NTHR) { const int rr = i / 384, c2 = i - rr * 384; const int t = t0 - 1 + rr;
                unsigned w = 0u; if (t >= 0 && t < SEQ) w = *(const unsigned*)(U + (size_t)(b * SEQ + t) * INW + 1280 + 2 * c2);
                *(LAS unsigned*)(hs + rr * 770 + 2 * c2) = w; }
            __syncthreads();
            for (int c = F.wave; c < 256; c += NWAVES) {
                const int tt = F.lane;
                float o[3];
#pragma unroll
                for (int g = 0; g < 3; ++g) { const int cc = g * 256 + c;
                    o[g] = cw[cc] * bf2f(hs[tt * 770 + cc]) + cw[768 + cc] * bf2f(hs[(tt + 1) * 770 + cc]) + cw[1536 + cc] * bf2f(hs[(tt + 2) * 770 + cc]) + cbp[cc]; }
                const size_t oi = ((size_t)b * 256 + c) * SEQ + t0 + tt;
                VT[oi] = (bf16)f2bf(o[2] * o[1]); X0T[oi] = (bf16)f2bf(o[0]);
            }
            __syncthreads();
        }
    }
}


__device__ __forceinline__ int chunk_row0(int b, int d, int k) {
    if (k < 2) { const int cc = d ? 1 - k : k; return NLAT + b * CTXL + cc * CHUNK; }
    const int lc = d ? 63 - (k - 2) : (k - 2); return b * SEQ + lc * CHUNK;
}
__device__ __forceinline__ void ph_scan1(const Frame& F) {
    const bf16* LAB = (const bf16*)(F.ws + WS_LAB); float* SUMP = (float*)(F.ws + WS_SCANS); float* SUMH = SUMP + NB * 2 * NCHUNK * 256;
    for (int it = blockIdx.x * NTHR + F.tid; it < NB * 2 * NCHUNK * 256; it += F.G * NTHR) {
        const int ch = it & 255, k = (it >> 8) % NCHUNK, bd = (it >> 8) / NCHUNK, d = bd & 1, b = bd >> 1;
        const int r0 = chunk_row0(b, d, k);
        const bf16* LA = LAB + (size_t)(2 * d) * LAB_STRIDE + ch; const bf16* LB = LAB + (size_t)(2 * d + 1) * LAB_STRIDE + ch;
        float h = 0.f, Ps = 0.f;
#pragma unroll 16
        for (int i = 0; i < CHUNK; ++i) { const int r = d ? r0 + CHUNK - 1 - i : r0 + i; const float la = bf2f(LA[(size_t)r * 256]), bx = bf2f(LB[(size_t)r * 256]); h = __builtin_amdgcn_exp2f(la) * h + bx; Ps += la; }
        SUMP[it] = __builtin_amdgcn_exp2f(Ps); SUMH[it] = h;
    }
}
__device__ __forceinline__ void ph_scan2(const Frame& F) {
    const bf16* LAB = (const bf16*)(F.ws + WS_LAB); const float* SUMP = (const float*)(F.ws + WS_SCANS); const float* SUMH = SUMP + NB * 2 * NCHUNK * 256;
    float* LRUO = (float*)(F.ws + WS_LRUO); const bf16* U = (const bf16*)(F.ws + WS_U);
    for (int it = blockIdx.x * NTHR + F.tid; it < NB * NCHUNK * 256; it += F.G * NTHR) {
        const int ch = it & 255, kc = (it >> 8) % NCHUNK, b = (it >> 8) / NCHUNK;
        const int r0 = chunk_row0(b, 0, kc);
#pragma unroll 1
        for (int d = 0; d < 2; ++d) {
            const int k = d ? ((kc < 2) ? 1 - kc : 2 + 63 - (kc - 2)) : kc;
            const size_t sb = (size_t)((b * 2 + d) * NCHUNK) * 256 + ch;
            float h = 0.f;
#pragma unroll 8
            for (int j = 0; j < k; ++j) h = SUMP[sb + (size_t)j * 256] * h + SUMH[sb + (size_t)j * 256];
            const bf16* LA = LAB + (size_t)(2 * d) * LAB_STRIDE + ch; const bf16* LB = LAB + (size_t)(2 * d + 1) * LAB_STRIDE + ch;
            if (d == 0) {
#pragma unroll 16
                for (int i = 0; i < CHUNK; ++i) { const int r = r0 + i; h = __builtin_amdgcn_exp2f(bf2f(LA[(size_t)r * 256])) * h + bf2f(LB[(size_t)r * 256]); LRUO[(size_t)r * 256 + ch] = h; }
            } else {
#pragma unroll 8
                for (int i = 0; i < CHUNK; ++i) { const int r = r0 + CHUNK - 1 - i; h = __builtin_amdgcn_exp2f(bf2f(LA[(size_t)r * 256])) * h + bf2f(LB[(size_t)r * 256]);
                    const float lg = bf2f(U[(size_t)r * INW + 1024 + ch]);
                    LRUO[(size_t)r * 256 + ch] = (LRUO[(size_t)r * 256 + ch] + h) * gelu_tanh(lg); }
            }
        }
    }
}

__device__ __forceinline__ void ph_hyena_fft(const Frame& F, int l, const float* hy_bias) {
    LAS f32x2v* D = (LAS f32x2v*)(F.lds);
    const c32* KHAT = (const c32*)(F.ws + WS_KHAT) + (size_t)l * 256 * 16384;
    const bf16* VT = (const bf16*)(F.ws + WS_VT); const bf16* X0T = (const bf16*)(F.ws + WS_X0T); bf16* HYO = (bf16*)(F.ws + WS_HYO);
    for (int it = blockIdx.x; it < 512; it += F.G) {
        const int c = it >> 1, bp = it & 1;
        const bf16* va = VT + ((size_t)(bp * 2) * 256 + c) * SEQ; const bf16* vb = VT + ((size_t)(bp * 2 + 1) * 256 + c) * SEQ;
#ifndef REP_FFT
#define REP_FFT 1
#endif
#pragma unroll 1
        for (int repf_ = 0; repf_ < REP_FFT; ++repf_) {
#pragma unroll 1
        for (int i = 0; i < 8; ++i) { const int j = F.tid + 512 * i; c32 x0, x1, z; x0.x = bf2f(va[j]); x0.y = bf2f(vb[j]); x1.x = bf2f(va[j + 4096]); x1.y = bf2f(vb[j + 4096]); z.x = 0.f; z.y = 0.f;
            fft_first4(D, j, x0, x1, z, z); }
        __syncthreads();
        { fft_fwd16(D, F.tid, 4096); fft_fwd16(D, F.tid + 512, 4096); }
        __syncthreads();
        { fft_fwd16(D, F.tid, 256); fft_fwd16(D, F.tid + 512, 256); }
        __syncthreads();
        _Pragma("unroll 1") for (int g_ = F.tid; g_ < 1024; g_ += 512) fft_mid16(D, g_, KHAT + (size_t)c * 16384);
        __syncthreads();
        { fft_inv16(D, F.tid, 256); fft_inv16(D, F.tid + 512, 256); }
        __syncthreads();
        { fft_inv16(D, F.tid, 4096); fft_inv16(D, F.tid + 512, 4096); }
        __syncthreads();
        }
        const float bias = hy_bias[l * 256 + c];
        const bf16* xa = X0T + ((size_t)(bp * 2) * 256 + c) * SEQ; const bf16* xb = X0T + ((size_t)(bp * 2 + 1) * 256 + c) * SEQ;
        bf16* oa = HYO + ((size_t)(bp * 2) * 256 + c) * SEQ; bf16* ob = HYO + ((size_t)(bp * 2 + 1) * 256 + c) * SEQ;
#pragma unroll 2
        for (int i = 0; i < 8; ++i) { const int j = F.tid + 512 * i; c32 u0, u1; fft_final4(D, j, u0, u1);
            oa[j] = (bf16)f2bf((u0.x + bf2f(va[j]) * bias) * bf2f(xa[j]));                 ob[j] = (bf16)f2bf((-u0.y + bf2f(vb[j]) * bias) * bf2f(xb[j]));
            oa[j + 4096] = (bf16)f2bf((u1.x + bf2f(va[j + 4096]) * bias) * bf2f(xa[j + 4096])); ob[j + 4096] = (bf16)f2bf((-u1.y + bf2f(vb[j + 4096]) * bias) * bf2f(xb[j + 4096])); }
        __syncthreads();
    }
}
__device__ __forceinline__ void ph_hyena_ctx(const Frame& F, const float* hy_bias, const float* hy_cw, const float* hy_cb) {
    float* HYO = (float*)(F.ws + WS_HYO);
    {

        const bf16* U = (const bf16*)(F.ws + WS_U); const float* KFC = (const float*)(F.ws + WS_KFC);
        LAS float* vw = (LAS float*)(F.lds + F.wave * 4096);
        LAS float* kw = vw + 256;
        const float* cw = hy_cw; const float* cbp = hy_cb;
        for (int it = F.gw; it < NB * 256; it += F.ngw) {
            const int b = it >> 8, c = it & 255;
            float x0v[4];
#pragma unroll
            for (int i = 0; i < 4; ++i) { const int t = F.lane + 64 * i;
                float o[3];
#pragma unroll
                for (int g = 0; g < 3; ++g) { const int cc = g * 256 + c; float a = cbp[cc];
#pragma unroll
                    for (int j = 0; j < 3; ++j) { const int tj = t + j - 1; if (tj >= 0 && tj < CTXL) a += cw[j * 768 + cc] * bf2f(U[(size_t)(NLAT + b * CTXL + tj) * INW + 1280 + cc]); }
                    o[g] = a; }
                vw[t] = o[2] * o[1]; x0v[i] = o[0]; }
#pragma unroll
            for (int i = 0; i < 8; ++i) kw[F.lane + 64 * i] = KFC[c * 512 + F.lane + 64 * i];
            LDS_WAIT();
            float y[4] = {0.f, 0.f, 0.f, 0.f};
#pragma unroll 4
            for (int s = 0; s < CTXL; ++s) { const float vv = vw[s];
#pragma unroll
                for (int i = 0; i < 4; ++i) y[i] += kw[(F.lane + 64 * i - s) & 511] * vv; }
            const float bias = hy_bias[c];
#pragma unroll
            for (int i = 0; i < 4; ++i) { const int t = F.lane + 64 * i; HYO[(size_t)(NLAT + b * CTXL + t) * 256 + c] = (y[i] + vw[t] * bias) * x0v[i]; }
            LDS_WAIT();
        }
    }
}

__device__ __forceinline__ void merge_row(const Frame& F, int r, const float* g, float h0, float h1, float h2, float h3) {
    const bf16* ATT = (const bf16*)(F.ws + WS_ATT); const float* LRUO = (const float*)(F.ws + WS_LRUO); bf16* MIXA = (bf16*)(F.ws + WS_MIXA);
    const v4u aw = ((const v4u*)(ATT + (size_t)r * 512))[F.lane];
    float a[8] = {bflo(aw.x), bfhi(aw.x), bflo(aw.y), bfhi(aw.y), bflo(aw.z), bfhi(aw.z), bflo(aw.w), bfhi(aw.w)};
    float ss = 0.f;
#pragma unroll
    for (int i = 0; i < 8; ++i) ss += a[i] * a[i];
    const float ra = 1.0f / sqrtf(wave_sum(ss) * (1.0f / 512.0f) + EPSN);
    const f32x4 lv = ((const f32x4*)(LRUO + (size_t)r * 256))[F.lane];
    const float rl = 1.0f / sqrtf(wave_sum(lv.x * lv.x + lv.y * lv.y + lv.z * lv.z + lv.w * lv.w) * (1.0f / 256.0f) + EPSN);
    const float rh = 1.0f / sqrtf(wave_sum(h0 * h0 + h1 * h1 + h2 * h2 + h3 * h3) * (1.0f / 256.0f) + EPSN);
    bf16* orow = MIXA + (size_t)r * 1024;
    { const f32x4 g0 = ((const f32x4*)g)[2 * F.lane], g1 = ((const f32x4*)g)[2 * F.lane + 1];
      v4u o; o.x = pk2(a[0] * ra * g0.x, a[1] * ra * g0.y); o.y = pk2(a[2] * ra * g0.z, a[3] * ra * g0.w); o.z = pk2(a[4] * ra * g1.x, a[5] * ra * g1.y); o.w = pk2(a[6] * ra * g1.z, a[7] * ra * g1.w);
      ((v4u*)orow)[F.lane] = o; }
    { const f32x4 gg = ((const f32x4*)(g + 512))[F.lane]; v2u o; o.x = pk2(lv.x * rl * gg.x, lv.y * rl * gg.y); o.y = pk2(lv.z * rl * gg.z, lv.w * rl * gg.w); ((v2u*)(orow + 512))[F.lane] = o; }
    orow[768 + F.lane] = (bf16)f2bf(h0 * rh * g[768 + F.lane]); orow[832 + F.lane] = (bf16)f2bf(h1 * rh * g[832 + F.lane]);
    orow[896 + F.lane] = (bf16)f2bf(h2 * rh * g[896 + F.lane]); orow[960 + F.lane] = (bf16)f2bf(h3 * rh * g[960 + F.lane]);
}
__device__ __forceinline__ void ph_merge(const Frame& F, int l, int nrows, const float* out_g) {
    const float* HYO = (const float*)(F.ws + WS_HYO);
    const float* g = out_g + l * 1024;
    LAS float* tile = (LAS float*)(F.lds);
    for (int it = blockIdx.x; it < NLAT / 64; it += F.G) {
        const int b = it >> 7, t0 = (it & 127) * 64;
#pragma unroll 8
        for (int i = 0; i < 32; ++i) { const int c = F.wave * 32 + i; tile[c * 65 + F.lane] = bf2f(((const bf16*)HYO)[((size_t)b * 256 + c) * SEQ + t0 + F.lane]); }
        __syncthreads();
#pragma unroll 2
        for (int k = 0; k < 8; ++k) { const int tt = F.wave * 8 + k;
            merge_row(F, b * SEQ + t0 + tt, g, tile[F.lane * 65 + tt], tile[(F.lane + 64) * 65 + tt], tile[(F.lane + 128) * 65 + tt], tile[(F.lane + 192) * 65 + tt]); }
        __syncthreads();
    }
    for (int r = NLAT + F.gw; r < nrows; r += F.ngw) {
        const float* hr = HYO + (size_t)r * 256;
        merge_row(F, r, g, hr[F.lane], hr[64 + F.lane], hr[128 + F.lane], hr[192 + F.lane]);
    }
}


__device__ __forceinline__ void ph_ffn_router(const Frame& F, int l, int nrows, const float* router_w) {
    LAS float* rwl = (LAS float*)(F.lds);
    LAS float* cbl = (LAS float*)(F.lds + 147456);
    LAS int* hist = (LAS int*)(F.lds + 147456 + 640);
    const bf16* XR = (const bf16*)(F.ws + WS_XR); const float* RSSP = (const float*)(F.ws + WS_RSSP); const float* MOD = (const float*)(F.ws + WS_MOD);
    const float* GC = (const float*)(F.ws + WS_GC) + (size_t)l * 5 * 1024; bf16* Fb = (bf16*)(F.ws + WS_F);
    int* TOPI = (int*)(F.ws + WS_TOPI); float* GATE = (float*)(F.ws + WS_GATE); int* BLKCNT = (int*)(F.ws + WS_BLKCNT);
    for (int i = F.tid; i < 1024 * 32; i += NTHR) rwl[(i >> 5) * 36 + (i & 31)] = router_w[(size_t)l * 32768 + i];
    if (F.tid < 32) hist[F.tid] = 0;
    if (F.tid < 160) cbl[F.tid] = ((const float*)(F.ws + WS_CB))[l * 160 + F.tid];
    __syncthreads();
    const int j = F.lane & 15, kq = F.lane >> 4;
    for (int grp = F.gw; grp < nrows / 16; grp += F.ngw) {
        const int r0 = grp * 16, r = r0 + j; const int bidx = r0 < NLAT ? r0 / SEQ : 4;
        const bf16* xrow = XR + (size_t)r * 1024 + 4 * kq; const float* gcp = GC + bidx * 1024 + 4 * kq; const float* sfp = MOD + (size_t)(l * 5 + bidx) * 6144 + 3 * 1024 + 4 * kq;
        bf16* frow = Fb + (size_t)r * 1024 + 4 * kq;
        float ss; { const f32x4 q = *(const f32x4*)(RSSP + (size_t)r * 16 + 4 * kq); ss = (q.x + q.y) + (q.z + q.w); }
        ss += __shfl_xor(ss, 16); ss += __shfl_xor(ss, 32);
        const float rstd = 1.0f / sqrtf(ss * (1.0f / 1024.0f) + EPSN);
        f32x4 acc0 = {0.f, 0.f, 0.f, 0.f}, acc1 = acc0;
#pragma unroll 1
        for (int ib = 0; ib < 64; ib += 8) {
            v2u xw[8]; f32x4 g4[8], s4[8];
#pragma unroll
            for (int u = 0; u < 8; ++u) { xw[u] = *(const v2u*)(xrow + 16 * (ib + u)); g4[u] = *(const f32x4*)(gcp + 16 * (ib + u)); s4[u] = *(const f32x4*)(sfp + 16 * (ib + u)); }
#pragma unroll
            for (int u = 0; u < 8; ++u) {
                const f32x4 x4 = {bflo(xw[u].x), bfhi(xw[u].x), bflo(xw[u].y), bfhi(xw[u].y)};
                const f32x4 xb = x4 * g4[u];
                const f32x4 fv = xb * rstd + s4[u];
                v2u o; o.x = pk2(fv.x, fv.y); o.y = pk2(fv.z, fv.w); *(v2u*)(frow + 16 * (ib + u)) = o;
                const LAS float* wp = rwl + (16 * (ib + u) + 4 * kq) * 36 + j;
#pragma unroll
                for (int e = 0; e < 4; ++e) { acc0 = __builtin_amdgcn_mfma_f32_16x16x4f32(wp[e * 36], xb[e], acc0, 0, 0, 0); acc1 = __builtin_amdgcn_mfma_f32_16x16x4f32(wp[e * 36 + 16], xb[e], acc1, 0, 0, 0); }
            }
        }
        float lg[8];
#pragma unroll
        for (int rr = 0; rr < 4; ++rr) { lg[rr] = rstd * acc0[rr] + cbl[bidx * 32 + 4 * kq + rr]; lg[4 + rr] = rstd * acc1[rr] + cbl[bidx * 32 + 16 + 4 * kq + rr]; }
        float p[32];
#pragma unroll
        for (int e = 0; e < 32; ++e) p[e] = __shfl(lg[(e >> 4) * 4 + (e & 3)], j + 16 * ((e & 15) >> 2));
        unsigned taken = 0u; float tv[4]; int ti[4];
#pragma unroll
        for (int k = 0; k < 4; ++k) { float best = -INFINITY; int bi = 0;
#pragma unroll
            for (int e = 0; e < 32; ++e) { const bool ok = !((taken >> e) & 1u) && (p[e] > best); best = ok ? p[e] : best; bi = ok ? e : bi; }
            taken |= 1u << bi; tv[k] = best; ti[k] = bi; }
        const float e1 = __expf(tv[1] - tv[0]), e2 = __expf(tv[2] - tv[0]), e3 = __expf(tv[3] - tv[0]); const float inv = 1.0f / (1.0f + e1 + e2 + e3);
        if (kq == 0) {
            TOPI[r * 4 + 0] = ti[0]; TOPI[r * 4 + 1] = ti[1]; TOPI[r * 4 + 2] = ti[2]; TOPI[r * 4 + 3] = ti[3];
            GATE[r * 4 + 0] = inv; GATE[r * 4 + 1] = e1 * inv; GATE[r * 4 + 2] = e2 * inv; GATE[r * 4 + 3] = e3 * inv;
            lds_add(&hist[ti[0]], 1); lds_add(&hist[ti[1]], 1); lds_add(&hist[ti[2]], 1); lds_add(&hist[ti[3]], 1);
        }
    }
    __syncthreads();
    if (F.tid < 32) BLKCNT[blockIdx.x * 32 + F.tid] = hist[F.tid];
}

__device__ __forceinline__ void ph_route(const Frame& F, int nrows) {
    LAS int* cursor = (LAS int*)(F.lds);
    LAS int* tot = cursor + 32;
    LAS int* mine = cursor + 64;
    LAS int* part = cursor + 96;
    LAS int* ebase = cursor + 96 + 1024;
    const int* BLKCNT = (const int*)(F.ws + WS_BLKCNT); const int* TOPI = (const int*)(F.ws + WS_TOPI); int* POS = (int*)(F.ws + WS_POS);
    int* ROWTOK = (int*)(F.ws + WS_ROWTOK); int* TILEE = (int*)(F.ws + WS_TILEE);
    { const int e = F.tid & 31, sl = F.tid >> 5; int t = 0, m = 0;
      for (int b = sl; b < F.G; b += 16) { const int v = BLKCNT[b * 32 + e]; t += v; m += (b < (int)blockIdx.x) ? v : 0; }
      part[sl * 64 + e] = t; part[sl * 64 + 32 + e] = m;
      __syncthreads();
      if (F.tid < 32) { int tt = 0, mm = 0;
#pragma unroll
          for (int s = 0; s < 16; ++s) { tt += part[s * 64 + F.tid]; mm += part[s * 64 + 32 + F.tid]; }
          tot[F.tid] = tt; mine[F.tid] = mm; } }
    __syncthreads();
    if (F.tid == 0) { int tb = 0;
        for (int e = 0; e < 32; ++e) { const int nt = (tot[e] + 255) >> 8; cursor[e] = tb * 256 + mine[e]; ebase[e] = tb * 256;
            if (blockIdx.x == 0) for (int j = 0; j < nt; ++j) TILEE[tb + j] = e;
            tb += nt; }
        ebase[32] = tb * 256;
        if (blockIdx.x == 0) F.ctl[CW_NTILES] = (unsigned)tb; }
    __syncthreads();
    for (int e = blockIdx.x; e < 32; e += F.G) for (int p = ebase[e] + tot[e] + F.tid; p < ebase[e + 1]; p += NTHR) ROWTOK[p] = 0;
    const int sub = F.lane >> 2, k = F.lane & 3;
    for (int grp = F.gw; grp < nrows / 16; grp += F.ngw) {
        const int r = grp * 16 + sub; const int e = TOPI[r * 4 + k]; const int pos = lds_add(&cursor[e], 1); POS[r * 4 + k] = pos; ROWTOK[pos] = r; }
}

__device__ __forceinline__ void ph_combine(const Frame& F, int l, int nrows, float* out, const float* gmix) {
    bf16* XR = (bf16*)(F.ws + WS_XR); const float* MOD = (const float*)(F.ws + WS_MOD); const bf16* YS = (const bf16*)(F.ws + WS_YS); bf16* H = (bf16*)(F.ws + WS_H);
    const int* POS = (const int*)(F.ws + WS_POS); const float* GATE = (const float*)(F.ws + WS_GATE);
    for (int r = 2 * F.gw; r < nrows; r += 2 * F.ngw) {
        const int bidx = r < NLAT ? r / SEQ : 4;
        const float* gf = MOD + (size_t)(l * 5 + bidx) * 6144 + 5 * 1024;
        int pos = 0; float gt = 0.f;
        if (F.lane < 8) { pos = POS[r * 4 + F.lane]; gt = GATE[r * 4 + F.lane]; }
        v2u w[2][4][4], xw[2][4]; float gk[2][4];
#pragma unroll
        for (int rr = 0; rr < 2; ++rr)
#pragma unroll
            for (int k = 0; k < 4; ++k) { const int pk = __shfl(pos, rr * 4 + k); gk[rr][k] = __shfl(gt, rr * 4 + k); const v2u* yr = (const v2u*)(YS + (size_t)pk * 1024);
#pragma unroll
                for (int j = 0; j < 4; ++j) w[rr][k][j] = yr[64 * j + F.lane]; }
#pragma unroll
        for (int rr = 0; rr < 2; ++rr)
#pragma unroll
            for (int j = 0; j < 4; ++j) xw[rr][j] = ((const v2u*)(XR + (size_t)(r + rr) * 1024))[64 * j + F.lane];
        f32x4 gv[4];
#pragma unroll
        for (int j = 0; j < 4; ++j) gv[j] = ((const f32x4*)gf)[64 * j + F.lane];
#pragma unroll
        for (int rr = 0; rr < 2; ++rr) {
            const int row = r + rr;
            f32x4 y[4]; float ss = 0.f;
#pragma unroll
            for (int j = 0; j < 4; ++j) { f32x4 a = {0.f, 0.f, 0.f, 0.f};
#pragma unroll
                for (int k = 0; k < 4; ++k) { const v2u ww = w[rr][k][j]; const float g_ = gk[rr][k]; a.x += g_ * bflo(ww.x); a.y += g_ * bfhi(ww.x); a.z += g_ * bflo(ww.y); a.w += g_ * bfhi(ww.y); }
                const f32x4 xv = {bflo(xw[rr][j].x), bfhi(xw[rr][j].x), bflo(xw[rr][j].y), bfhi(xw[rr][j].y)};
                y[j] = xv + gv[j] * a;
                const int cb = 64 * j + F.lane;
                if (l == 0) { v2u o; o.x = pk2(y[j].x, y[j].y); o.y = pk2(y[j].z, y[j].w); ((v2u*)(XR + (size_t)row * 1024))[cb] = o; } else ((f32x4*)(out + (size_t)row * 1024))[cb] = y[j];
                ss += (y[j].x * y[j].x + y[j].y * y[j].y) + (y[j].z * y[j].z + y[j].w * y[j].w); }
            if (l == 0) {
                const float rstd = 1.0f / sqrtf(wave_sum(ss) * (1.0f / 1024.0f) + EPSN);
                const float* shift = MOD + (size_t)(5 + bidx) * 6144; const float* scale = shift + 1024; const float* g = gmix + 1024;
#pragma unroll
                for (int j = 0; j < 4; ++j) { const int cb = 64 * j + F.lane; const f32x4 gg = ((const f32x4*)g)[cb], sc = ((const f32x4*)scale)[cb], sh = ((const f32x4*)shift)[cb];
                    const f32x4 hv = y[j] * rstd * gg * (sc + 1.0f) + sh;
                    v2u o; o.x = pk2(hv.x, hv.y); o.y = pk2(hv.z, hv.w); ((v2u*)(H + (size_t)row * 1024))[cb] = o; }
            }
        }
    }
}

struct Args { const float* in[34]; float* out; unsigned char* ws; int ph_lo, ph_hi; };
enum { I_X = 0, I_C, I_CTX, I_CCTX, I_WMOD, I_BMOD, I_GMIX, I_GFFN, I_WIN, I_QG, I_KG, I_LCW, I_LCB, I_LGW, I_LGB, I_LLAM, I_HCW, I_HCB, I_HW1, I_HB1, I_HW2, I_HB2, I_HW3, I_HFREQ, I_HDEC, I_HBIAS,
       I_OUTG, I_WOUT, I_RW, I_RB, I_MW1, I_MB1, I_MW2, I_MB2 };

__global__ void __launch_bounds__(NTHR, 2) mk_fwd(Args args) {
    extern __shared__ __attribute__((aligned(16))) unsigned char lds[];
    Frame F;
    F.lds = (LAS unsigned char*)lds; F.ws = args.ws; F.ctl = (unsigned*)(args.ws + WS_CTL);
    F.tid = threadIdx.x; F.lane = F.tid & 63; F.wave = __builtin_amdgcn_readfirstlane(F.tid >> 6);
    F.G = gridDim.x; { const int bx = blockIdx.x; F.vcu = (F.G % 8 == 0) ? (bx % 8) * (F.G / 8) + bx / 8 : bx; }
    F.gw = (int)blockIdx.x * NWAVES + F.wave; F.ngw = F.G * NWAVES;
    for (int u = F.tid; u < (LDS_BYTES - LDSCTL_OFF) / 4; u += NTHR) ((LAS unsigned*)(F.lds + LDSCTL_OFF))[u] = 0u;
    __syncthreads();
#if !MK_PER_PHASE
    XcdBarrier bar = xcd_barrier_post(F.ctl + CW_BAR, (volatile LAS unsigned*)(F.lds + LDSCTL_OFF + 32));
#define GRID_BAR() xcd_barrier(bar)
#else
#define GRID_BAR() do { } while (0)
#endif
    const int lo = args.ph_lo, hi = args.ph_hi;
#ifndef ONLY_PHASE
#define ONLY_PHASE (-1)
#endif
#define ENABLED(id) (ONLY_PHASE < 0 || ONLY_PHASE == (id))
#define IN(k) (ENABLED(k) && lo <= (k) && (k) < hi)
#define INL(j) (ENABLED(NPH_PRO + (j)) && lo <= pb + (j) && pb + (j) < hi)
#define SEAML(j) do { if (lo <= pb + (j) && pb + (j) + 1 < hi) { GRID_BAR(); } } while (0)
typedef const __attribute__((address_space(4))) Args* KArgs;
#ifndef REP_MASK
#define REP_MASK 0
#endif
#define NREP(j) (((REP_MASK >> (j)) & 1) ? 2 : 1)
#define REFRAME() Frame Fp = F; KArgs ka = (KArgs)__builtin_amdgcn_kernarg_segment_ptr(); { int t_ = F.tid; asm volatile("" : "+v"(t_), "+s"(ka)); Fp.tid = t_; Fp.lane = t_ & 63; Fp.wave = __builtin_amdgcn_readfirstlane(t_ >> 6); \
    Fp.gw = (int)blockIdx.x * NWAVES + Fp.wave; Fp.ws = ka->ws; Fp.ctl = (unsigned*)(ka->ws + WS_CTL); }
#define SEAM(k) do { if (lo <= (k) && (k) + 1 < hi) { GRID_BAR(); } } while (0)

    if (IN(0)) ph_prologue_a(F, args.in[I_C], args.in[I_CCTX], args.in[I_WMOD], args.in[I_BMOD], args.in[I_WIN], args.in[I_WOUT], args.in[I_MW1], args.in[I_MW2],
                             args.in[I_HW1], args.in[I_HB1], args.in[I_HW2], args.in[I_HB2], args.in[I_HFREQ], args.in[I_LGW], args.in[I_LLAM]);
    SEAM(0);
    if (IN(1)) ph_prologue_b(F, args.in[I_HW3], args.in[I_HDEC], args.in[I_GFFN], args.in[I_RW], args.in[I_RB]);
    SEAM(1);

#ifndef MOE_WGM1
#define MOE_WGM1 4
#endif
#ifndef MOE_WGM2
#define MOE_WGM2 8
#endif
#define PHASE(j, ...) if (INL(j)) { _Pragma("unroll") for (int rep_ = 0; rep_ < NREP(j); ++rep_) { { REFRAME(); __VA_ARGS__ } if (rep_ + 1 < NREP(j)) GRID_BAR(); } }
#define LAYER_BODY(l) { \
        const int pb = NPH_PRO + l * NPH_LAYER; \
        const int nrows = (l == 0) ? MT : NLAT; \
        if (l == 0) { PHASE(0, ph_norm_mod(Fp, l, ka->in[I_X], ka->in[I_CTX], ka->in[I_GMIX]);) SEAML(0); } \
        PHASE(1, \
            pg8::Gemm g{(const bf16*)(Fp.ws + WS_H), (const bf16*)(Fp.ws + WS_WINT) + (size_t)l * 2048 * 1024, MT, 2048, 1024}; \
            pg8::StaticOrder S; S.init(MT, 2048, Fp.G, (int)blockIdx.x); \
            pg8::EpiBf16<0> E{(bf16*)(Fp.ws + WS_U), 2048, nullptr, 0, 0, 1.f}; \
            pg8::gemm_phase<pg8::EpiBf16<0>, pg8::StaticOrder, PG8_ALIGN, PG8_SP2>(Fp.lds + RING_OFF, g, S, E);) \
        SEAML(1); \
        PHASE(2, ph_post_proj(Fp, l, ka->in[I_QG], ka->in[I_KG], ka->in[I_LCW], ka->in[I_LCB], ka->in[I_HCW], ka->in[I_HCB]);) \
        SEAML(2); \
        PHASE(3, \
            int kg_ = 256; asm volatile("" : "+s"(kg_)); \
            pg8::Gemm g{(const bf16*)(Fp.ws + WS_XL), (const bf16*)(Fp.ws + WS_WGT) + (size_t)l * 1024 * 256, MT, 1024, kg_}; \
            pg8::StaticOrder S; S.init(MT, 1024, Fp.G, (int)blockIdx.x); \
            pg8::EpiLruGate E{(const bf16*)(Fp.ws + WS_XL), (bf16*)(Fp.ws + WS_LAB), LAB_STRIDE, ka->in[I_LGB] + (size_t)l * 1024, (const float*)(Fp.ws + WS_SPT) + l * 512}; \
            pg8::gemm_phase<pg8::EpiLruGate, pg8::StaticOrder, PG8_ALIGN, PG8_SP2>(Fp.lds + RING_OFF, g, S, E);) \
        SEAML(3); \
        PHASE(4, \
            ph_scan1(Fp); __syncthreads(); \
            const attn_body::AttnTensors AT{(const attn_body::bf16*)(Fp.ws + WS_U), (const attn_body::bf16*)(Fp.ws + WS_K), (const attn_body::bf16*)(Fp.ws + WS_V), (attn_body::bf16*)(Fp.ws + WS_ATT)}; \
            const attn_body::QPre QN{ka->in[I_QG] + l * 64, (const float*)(Fp.ws + WS_ROPEC), (const float*)(Fp.ws + WS_ROPES)}; \
            attn_body::attn_phase<8>((char*)lds + RING_OFF, AT, QN, Fp.G, Fp.vcu, l == 0, (long)NLAT);) \
        SEAML(4); \
        PHASE(5, ph_scan2(Fp); __syncthreads(); ph_hyena_fft(Fp, l, ka->in[I_HBIAS]); if (l == 0) ph_hyena_ctx(Fp, ka->in[I_HBIAS], ka->in[I_HCW], ka->in[I_HCB]);) \
        SEAML(5); \
        PHASE(6, ph_merge(Fp, l, nrows, ka->in[I_OUTG]);) \
        SEAML(6); \
        if (INL(7)) { REFRAME(); \
            pg8::Gemm g{(const bf16*)(Fp.ws + WS_MIXA), (const bf16*)(Fp.ws + WS_WOUTT) + (size_t)l * 1024 * 1024, nrows, 1024, 1024}; \
            pg8::StaticOrder S; S.init(nrows, 1024, Fp.G, (int)blockIdx.x); \
            bf16* XR = (bf16*)(Fp.ws + WS_XR); \
            pg8::EpiResid<(l) == 1> E{ka->in[I_X], ka->in[I_CTX], NLAT, XR, 1024, \
                            (const float*)(Fp.ws + WS_MOD) + (size_t)(l * 5) * 6144 + 2 * 1024, 6144, SEQ, (float*)(Fp.ws + WS_RSSP)}; \
            pg8::gemm_phase<pg8::EpiResid<(l) == 1>, pg8::StaticOrder, PG8_ALIGN, PG8_SP2>(Fp.lds + RING_OFF, g, S, E); \
        } \
        SEAML(7); \
        PHASE(8, ph_ffn_router(Fp, l, nrows, ka->in[I_RW]);) \
        SEAML(8); \
        PHASE(9, ph_route(Fp, nrows);) \
        SEAML(9); \
        if (INL(10) || INL(11)) { REFRAME(); \
            LAS int* tab = (LAS int*)(Fp.lds + MOETAB_OFF); \
            const int ntiles = (int)__hip_atomic_load(Fp.ctl + CW_NTILES, __ATOMIC_RELAXED, __HIP_MEMORY_SCOPE_AGENT); \
            const int* TILEE = (const int*)(Fp.ws + WS_TILEE); \
            for (int i = Fp.tid; i < ntiles && i < SORT_TILES; i += NTHR) tab[i] = TILEE[i]; \
            __syncthreads(); \
            if (INL(10)) { _Pragma("unroll") for (int rep_ = 0; rep_ < NREP(10); ++rep_) { { \
                pg8::Gemm g{(const bf16*)(Fp.ws + WS_F), (const bf16*)(Fp.ws + WS_W1T) + (size_t)l * 32 * 2048 * 1024, 0, 2048, 1024}; \
                pg8::MoeOrderT<true> S; S.init(tab, ntiles, 8, Fp.G, (int)blockIdx.x, MOE_WGM1); S.rowtok = (const int*)(Fp.ws + WS_ROWTOK); \
                pg8::EpiSwiglu E{(bf16*)(Fp.ws + WS_ACT), 1024, ka->in[I_MB1] + (size_t)l * 32 * 2048, 2048}; \
                pg8::gemm_phase<pg8::EpiSwiglu, pg8::MoeOrderT<true>, PG8_ALIGN, PG8_SP2>(Fp.lds + RING_OFF, g, S, E); \
             } if (rep_ + 1 < NREP(10)) GRID_BAR(); } } \
            SEAML(10); \
            if (INL(11)) { _Pragma("unroll") for (int rep_ = 0; rep_ < NREP(11); ++rep_) { { \
                pg8::Gemm g{(const bf16*)(Fp.ws + WS_ACT), (const bf16*)(Fp.ws + WS_W2T) + (size_t)l * 32 * 1024 * 1024, 0, 1024, 1024}; \
                pg8::MoeOrderT<false> S; S.init(tab, ntiles, 4, Fp.G, (int)blockIdx.x, MOE_WGM2); S.rowtok = nullptr; S.rev = 1; \
                pg8::EpiBf16Bias E{(bf16*)(Fp.ws + WS_YS), 1024, ka->in[I_MB2] + (size_t)l * 32 * 1024, 1024}; \
                pg8::gemm_phase<pg8::EpiBf16Bias, pg8::MoeOrderT<false>, PG8_ALIGN, PG8_SP2>(Fp.lds + RING_OFF, g, S, E); \
             } if (rep_ + 1 < NREP(11)) GRID_BAR(); } } \
        } \
        SEAML(11); \
        if (INL(12)) { REFRAME(); ph_combine(Fp, l, nrows, ka->out, ka->in[I_GMIX]); } \
        if (l == 0) { SEAML(12); } \
    }
    LAYER_BODY(0)
    LAYER_BODY(1)
#undef LAYER_BODY
#undef PHASE
#undef IN
#undef SEAM
#undef INL
#undef SEAML
}

extern "C" void kernel_launch(void* const* d_in, const int* in_sizes, int n_in, void* d_out, int out_size, void* d_ws, size_t ws_size, hipStream_t stream) {
    static int grid = 0;
    if (grid == 0) {
        if (n_in != 34 || in_sizes[0] != NLAT * DMODEL || out_size != NLAT * DMODEL || ws_size < WS_END) {
            fprintf(stderr, "kernel_launch: unexpected shapes (n_in %d, in0 %d, out %d, ws %zu); nothing launched\n", n_in, n_in > 0 ? in_sizes[0] : -1, out_size, ws_size); grid = -1; return; }
        int dev = 0, cus = 0;
        if (hipGetDevice(&dev) != hipSuccess || hipDeviceGetAttribute(&cus, hipDeviceAttributeMultiprocessorCount, dev) != hipSuccess) { grid = -1; return; }
        if (hipFuncSetAttribute((const void*)mk_fwd, hipFuncAttributeMaxDynamicSharedMemorySize, LDS_BYTES) != hipSuccess) { fprintf(stderr, "kernel_launch: hipFuncSetAttribute failed\n"); grid = -1; return; }
        int per_cu = 0;
        if (hipOccupancyMaxActiveBlocksPerMultiprocessor(&per_cu, (const void*)mk_fwd, NTHR, LDS_BYTES) != hipSuccess || per_cu < 1) { fprintf(stderr, "kernel_launch: occupancy query says %d\n", per_cu); }
        (void)hipGetLastError();
        grid = cus;
    }
    if (grid < 0) return;
    if (hipMemsetAsync((char*)d_ws + WS_CTL, 0, CTL_ZERO_BYTES, stream) != hipSuccess) return;
    Args a{};
    for (int i = 0; i < 34; ++i) a.in[i] = (const float*)d_in[i];
    a.out = (float*)d_out; a.ws = (unsigned char*)d_ws;
#if MK_PER_PHASE
    for (int p = 0; p < NPH; ++p) { a.ph_lo = p; a.ph_hi = p + 1; hipLaunchKernelGGL(mk_fwd, dim3(grid), dim3(NTHR), LDS_BYTES, stream, a); }
#else
    a.ph_lo = 0; a.ph_hi = NPH;
    hipLaunchKernelGGL(mk_fwd, dim3(grid), dim3(NTHR), LDS_BYTES, stream, a);
#endif
}
```

```cpp
#include <hip/hip_runtime.h>
#include <hip/hip_bf16.h>
#include <cstdio>
#include <cstdint>
#include <cmath>
#ifndef MOE_FP8
#define MOE_FP8 1
#endif
#ifndef MK_PER_PHASE
#define MK_PER_PHASE 0
#endif
namespace pg8 {
#define PG8_LAS __attribute__((address_space(3)))
typedef unsigned short bf16_t;
typedef short bf16x8 __attribute__((ext_vector_type(8)));
typedef float f32x4 __attribute__((ext_vector_type(4)));
typedef unsigned u32x4 __attribute__((ext_vector_type(4)));
constexpr int BM = 256, BK = 64, HALF = 128, HTB = HALF * BK * 2  , STAGE_BYTES = 8 * HTB, NXCD = 8, WGM = 8;

__host__ __device__ __forceinline__ int lds_byte(int r, int c) { const int st = (r >> 4) * 2 + (c >> 5), rr = r & 15, cc = c & 31, ob = rr * 64 + cc * 2; return st * 1024 + (ob ^ (((ob >> 9) & 1) << 5)); }
__host__ __device__ __forceinline__ void stage_rc(int b, int& R, int& C) { const int st = b / 1024, sb = b % 1024, swz = sb ^ (((sb >> 9) & 1) << 5); R = (st >> 1) * 16 + swz / 64; C = (st & 1) * 32 + (swz % 64) / 2; }
__host__ __device__ __forceinline__ int perm32(int rho) { const int n = rho >> 4, i = rho & 15; return 8 * (i >> 2) + 4 * n + (i & 3); }

struct Unit { int pm, pn, be, e; };
struct Gemm { const bf16_t* A; const bf16_t* Bt; int M, N, K; };

struct StaticOrder {
    static constexpr bool GATHER = false;
    __device__ __forceinline__ int row_of(int r) const { return r; }
    int nM, nN, nwg, G, c;
    __host__ __device__ void init(int M, int N, int G_, int c_) { nM = M / BM; nN = N / BM; nwg = nM * nN; G = G_; c = c_; }
    __host__ __device__ bool next(int i, Unit& u) const {
        const long L = (long)i * G + c; if (L >= nwg) return false;
        int wgid = (int)L; { const int q = nwg / NXCD, r = nwg % NXCD, xcd = wgid % NXCD, off = wgid / NXCD; wgid = (xcd < r ? xcd * (q + 1) : r * (q + 1) + (xcd - r) * q) + off; }
        const int nig = WGM * nN, gid = wgid / nig, fm = gid * WGM, gsz = (nM - fm) < WGM ? (nM - fm) : WGM;
        u.pm = fm + ((wgid % nig) % gsz); u.pn = (wgid % nig) / gsz; u.be = u.pn; u.e = 0; return true;
    }
    __device__ __forceinline__ void a_ready(const Unit&) const {}
    __device__ __forceinline__ void done(const Unit&) const {}
};

__device__ __forceinline__ unsigned cvt_pk_bf16(float lo, float hi) { unsigned r; asm volatile("v_cvt_pk_bf16_f32 %0, %1, %2" : "=v"(r) : "v"(lo), "v"(hi)); return r; }
__device__ __forceinline__ unsigned pack4_fp8(float a, float b, float c, float d) {
    a = fminf(fmaxf(a, -448.f), 448.f); b = fminf(fmaxf(b, -448.f), 448.f); c = fminf(fmaxf(c, -448.f), 448.f); d = fminf(fmaxf(d, -448.f), 448.f);
    int w = 0; w = __builtin_amdgcn_cvt_pk_fp8_f32(a, b, w, false); w = __builtin_amdgcn_cvt_pk_fp8_f32(c, d, w, true); return (unsigned)w;
}
constexpr float F8_SF = 16.f, F8_SW = 64.f, F8_SA = 4.f;
typedef float f32x2 __attribute__((ext_vector_type(2)));
__device__ __forceinline__ f32x2 gelu_pk(f32x2 v) {
    const f32x2 av = __builtin_elementwise_abs(v), d = av * 0.2316418882f + 1.0f;
    f32x2 t; t.x = __builtin_amdgcn_rcpf(d.x); t.y = __builtin_amdgcn_rcpf(d.y);
    f32x2 q = t * 0.5307027145f + (-0.7265760135f); q = q * t + 0.7107068705f; q = q * t + (-0.142248368f); q = q * t + 0.127414796f; q = q * t;
    const f32x2 s = (v * v) * (-0.72134752044f);
    f32x2 e; e.x = __builtin_amdgcn_exp2f(s.x); e.y = __builtin_amdgcn_exp2f(s.y);
    const f32x2 m = v * (q * e), r = v - m;
    f32x2 o; o.x = v.x < 0.f ? m.x : r.x; o.y = v.y < 0.f ? m.y : r.y; return o;
}

template <int ACT  > struct EpiBf16 {
    static constexpr bool PERM = true, AFTER_DRAIN = false; static_assert(ACT == 0 || ACT == 1, "EpiBf16: ACT is 0 (none) or 1 (gelu_pk)");
    bf16_t* O; int ldc; const float* bias; int split_cols; size_t split_stride; float scale0;
    struct Pre {}; __device__ __forceinline__ void preload(Pre&, const Unit&, int, int, int, int) const {}
    __device__ __forceinline__ void operator()(const f32x4 (&acc)[2][2][4][2], const Unit& u, int wr, int wc, int fr, int fq, const Pre&) const {
        const int row0 = u.pm * BM + wr * 64 + fr; int colt = u.pn * BM; bf16_t* base = O;
        float sc = 1.f; if (split_cols) { const int t = colt / split_cols; base += (size_t)t * split_stride; colt -= t * split_cols; if (t == 0) sc = scale0; }
        const int col0 = colt + wc * 32 + 8 * fq, bcol0 = u.pn * BM + wc * 32 + 8 * fq;
        f32x4 bv[2][2];
#pragma unroll
        for (int bj = 0; bj < 2; ++bj)
#pragma unroll
            for (int n = 0; n < 2; ++n) bv[bj][n] = bias ? *(const f32x4*)(bias + bcol0 + bj * HALF + 4 * n) : (f32x4){0.f, 0.f, 0.f, 0.f};
#pragma unroll
        for (int ai = 0; ai < 2; ++ai)
#pragma unroll
            for (int m = 0; m < 4; ++m) { bf16_t* rowp = base + (size_t)(row0 + ai * HALF + m * 16) * ldc + col0;
#pragma unroll
                for (int bj = 0; bj < 2; ++bj) { f32x4 v0 = acc[ai][bj][m][0] + bv[bj][0], v1 = acc[ai][bj][m][1] + bv[bj][1];
                    if (ACT == 1) { f32x2 a = gelu_pk((f32x2){v0[0], v0[1]}), b = gelu_pk((f32x2){v0[2], v0[3]}), c = gelu_pk((f32x2){v1[0], v1[1]}), d = gelu_pk((f32x2){v1[2], v1[3]});
                        v0 = (f32x4){a.x, a.y, b.x, b.y}; v1 = (f32x4){c.x, c.y, d.x, d.y}; }
                    v0 = v0 * sc; v1 = v1 * sc; u32x4 w; w.x = cvt_pk_bf16(v0[0], v0[1]); w.y = cvt_pk_bf16(v0[2], v0[3]); w.z = cvt_pk_bf16(v1[0], v1[1]); w.w = cvt_pk_bf16(v1[2], v1[3]);
                    *(u32x4*)(rowp + bj * HALF) = w; } }
    }
};


template <bool XIN_BF16> struct EpiResid {
    static constexpr bool PERM = false, AFTER_DRAIN = false;
    const float* xin_lat; const float* xin_ctx; int nlat; bf16_t* XR; int ldc; const float* mod; int mod_stride; int seq; float* rssp;
    struct Pre {}; __device__ __forceinline__ void preload(Pre&, const Unit&, int, int, int, int) const {}
    __device__ __forceinline__ void operator()(const f32x4 (&acc)[2][2][4][2], const Unit& u, int wr, int wc, int fr, int fq, const Pre&) const {
        typedef unsigned u32x2 __attribute__((ext_vector_type(2)));
        const int row0 = u.pm * BM + wr * 64 + fr, col0 = u.pn * BM + wc * 32 + 4 * fq;
        const int rowt = u.pm * BM; const int bidx = rowt < nlat ? rowt / seq : 4;
        const float* gate = mod + (size_t)bidx * mod_stride;
        const float* xin = rowt < nlat ? xin_lat : (xin_ctx - (size_t)nlat * ldc);
        f32x4 gv[2][2];
#pragma unroll
        for (int bj = 0; bj < 2; ++bj)
#pragma unroll
            for (int n = 0; n < 2; ++n) gv[bj][n] = *(const f32x4*)(gate + col0 + bj * HALF + n * 16);
#pragma unroll
        for (int ai = 0; ai < 2; ++ai)
#pragma unroll
            for (int m = 0; m < 4; ++m) { const int row = row0 + ai * HALF + m * 16; const size_t ro = (size_t)row * ldc + col0; float s2 = 0.f;
#pragma unroll
                for (int bj = 0; bj < 2; ++bj)
#pragma unroll
                    for (int n = 0; n < 2; ++n) { const size_t idx = ro + bj * HALF + n * 16; f32x4 xv;
                        if (XIN_BF16) { const u32x2 w = *(const u32x2*)(XR + idx); xv = (f32x4){__builtin_bit_cast(float, w.x << 16), __builtin_bit_cast(float, w.x & 0xffff0000u), __builtin_bit_cast(float, w.y << 16), __builtin_bit_cast(float, w.y & 0xffff0000u)}; }
                        else xv = *(const f32x4*)(xin + idx);
                        const f32x4 v = xv + gv[bj][n] * acc[ai][bj][m][n];
                        s2 += (v[0] * v[0] + v[1] * v[1]) + (v[2] * v[2] + v[3] * v[3]);
                        u32x2 o; o.x = cvt_pk_bf16(v[0], v[1]); o.y = cvt_pk_bf16(v[2], v[3]); *(u32x2*)(XR + idx) = o; }
                s2 += __shfl_xor(s2, 16); s2 += __shfl_xor(s2, 32);
                if (fq == 0) rssp[(size_t)row * 16 + u.pn * 4 + wc] = s2; }
    }
};
struct EpiSwiglu {
    static constexpr bool PERM = true, AFTER_DRAIN = false;
    bf16_t* O; int ldc; const float* bias; int bias_stride;
    struct Pre { unsigned bw[2][2][2]; };
    __device__ __forceinline__ void preload(Pre& p, const Unit& u, int wr, int wc, int fr, int fq) const {
        const float* bb = bias + (size_t)u.e * bias_stride + u.pn * BM + wc * 32 + 8 * fq;
#pragma unroll
        for (int bj = 0; bj < 2; ++bj)
#pragma unroll
            for (int n = 0; n < 2; ++n) { const f32x4 v = *(const f32x4*)(bb + bj * HALF + 4 * n); p.bw[bj][n][0] = cvt_pk_bf16(v[0], v[1]); p.bw[bj][n][1] = cvt_pk_bf16(v[2], v[3]); }
    }
    __device__ __forceinline__ void operator()(const f32x4 (&acc)[2][2][4][2], const Unit& u, int wr, int wc, int fr, int fq, const Pre& pre) const {
        const int row0 = u.pm * BM + wr * 64 + fr; const int bcol0 = u.pn * BM + wc * 32 + 8 * fq; const int ocol0 = bcol0 >> 1;
        f32x4 bv[2][2];
#pragma unroll
        for (int bj = 0; bj < 2; ++bj)
#pragma unroll
            for (int n = 0; n < 2; ++n) { const unsigned w0 = pre.bw[bj][n][0], w1 = pre.bw[bj][n][1];
                bv[bj][n] = (f32x4){__builtin_bit_cast(float, w0 << 16), __builtin_bit_cast(float, w0 & 0xffff0000u), __builtin_bit_cast(float, w1 << 16), __builtin_bit_cast(float, w1 & 0xffff0000u)}; }
#pragma unroll
        for (int ai = 0; ai < 2; ++ai)
#pragma unroll
            for (int m = 0; m < 4; ++m) { bf16_t* rowp = O + (size_t)(row0 + ai * HALF + m * 16) * ldc + ocol0;
#pragma unroll
                for (int bj = 0; bj < 2; ++bj) { const f32x4 v0 = acc[ai][bj][m][0] + bv[bj][0], v1 = acc[ai][bj][m][1] + bv[bj][1];
                    float o[4];
#pragma unroll
                    for (int p = 0; p < 4; ++p) { const float hg = p < 2 ? v0[2 * p] : v1[2 * p - 4], hl = p < 2 ? v0[2 * p + 1] : v1[2 * p - 3];
                        const float glu = fminf(hg, 7.0f), lin = fminf(fmaxf(hl, -7.0f), 7.0f);
                        const float sg = __builtin_amdgcn_rcpf(1.0f + __builtin_amdgcn_exp2f(-1.702f * 1.4426950408889634f * glu));
                        o[p] = glu * sg * (lin + 1.0f); }
                    typedef unsigned u32x2 __attribute__((ext_vector_type(2)));
                    u32x2 w; w.x = cvt_pk_bf16(o[0], o[1]); w.y = cvt_pk_bf16(o[2], o[3]);
                    *(u32x2*)(rowp + bj * (HALF / 2)) = w; } }
    }
};
struct EpiSwigluF8 {
    static constexpr bool PERM = true, AFTER_DRAIN = false;
    bf16_t* O; int ldc; const float* bias; int bias_stride;
    struct Pre {}; __device__ __forceinline__ void preload(Pre&, const Unit&, int, int, int, int) const {}
    __device__ __forceinline__ void operator()(const f32x4 (&acc)[2][2][4][2], const Unit& u, int wr, int wc, int fr, int fq, const Pre&) const {
        asm volatile("" : "+v"(fr), "+v"(fq));
        const int row0 = u.pm * BM + wr * 64 + fr; const int bcol0 = u.pn * BM + wc * 32 + 8 * fq; const int ocol0 = bcol0 >> 1;
        const float* bb = bias + (size_t)u.e * bias_stride;
        f32x4 bv[2][2];
#pragma unroll
        for (int bj = 0; bj < 2; ++bj)
#pragma unroll
            for (int n = 0; n < 2; ++n) bv[bj][n] = *(const f32x4*)(bb + bcol0 + bj * HALF + 4 * n);
#pragma unroll
        for (int ai = 0; ai < 2; ++ai)
#pragma unroll
            for (int m = 0; m < 4; ++m) {
#pragma unroll
                for (int bj = 0; bj < 2; ++bj) { const f32x4 v0 = acc[ai][bj][m][0] * (1.0f / (F8_SF * F8_SW)) + bv[bj][0], v1 = acc[ai][bj][m][1] * (1.0f / (F8_SF * F8_SW)) + bv[bj][1];
                    float o[4];
#pragma unroll
                    for (int p = 0; p < 4; ++p) { const float hg = p < 2 ? v0[2 * p] : v1[2 * p - 4], hl = p < 2 ? v0[2 * p + 1] : v1[2 * p - 3];
                        const float glu = fminf(hg, 7.0f), lin = fminf(fmaxf(hl, -7.0f), 7.0f);
                        const float sg = __builtin_amdgcn_rcpf(1.0f + __builtin_amdgcn_exp2f(-1.702f * 1.4426950408889634f * glu));
                        o[p] = glu * sg * (lin + 1.0f); }
                    *(unsigned*)((unsigned char*)O + (size_t)(row0 + ai * HALF + m * 16) * ldc + ocol0 + bj * (HALF / 2)) = pack4_fp8(o[0] * F8_SA, o[1] * F8_SA, o[2] * F8_SA, o[3] * F8_SA); } }
    }
};
struct EpiBf16Bias {
    static constexpr bool PERM = true, AFTER_DRAIN = false;
    bf16_t* O; int ldc; const float* bias; int bias_stride;
    struct Pre { f32x4 bv[2][2]; };
    __device__ __forceinline__ void preload(Pre& p, const Unit& u, int wr, int wc, int fr, int fq) const {
        const float* bb = bias + (size_t)u.e * bias_stride + u.pn * BM + wc * 32 + 8 * fq;
#pragma unroll
        for (int bj = 0; bj < 2; ++bj)
#pragma unroll
            for (int n = 0; n < 2; ++n) p.bv[bj][n] = *(const f32x4*)(bb + bj * HALF + 4 * n);
    }
    __device__ __forceinline__ void operator()(const f32x4 (&acc)[2][2][4][2], const Unit& u, int wr, int wc, int fr, int fq, const Pre& pre) const {
        const int row0 = u.pm * BM + wr * 64 + fr; const int col0 = u.pn * BM + wc * 32 + 8 * fq;
#pragma unroll
        for (int ai = 0; ai < 2; ++ai)
#pragma unroll
            for (int m = 0; m < 4; ++m) { bf16_t* rowp = O + (size_t)(row0 + ai * HALF + m * 16) * ldc + col0;
#pragma unroll
                for (int bj = 0; bj < 2; ++bj) { const f32x4 v0 = acc[ai][bj][m][0] + pre.bv[bj][0], v1 = acc[ai][bj][m][1] + pre.bv[bj][1];
                    u32x4 w; w.x = cvt_pk_bf16(v0[0], v0[1]); w.y = cvt_pk_bf16(v0[2], v0[3]); w.z = cvt_pk_bf16(v1[0], v1[1]); w.w = cvt_pk_bf16(v1[2], v1[3]);
                    *(u32x4*)(rowp + bj * HALF) = w; } }
    }
};
struct EpiBf16BiasFold {
    static constexpr bool PERM = true, AFTER_DRAIN = false;
    bf16_t* O; int ldc; const float* bias; int bias_stride;
    struct Pre { f32x4 bv[2][2]; };
    __device__ __forceinline__ void preload(Pre& p, const Unit& u, int wr, int wc, int fr, int fq) const {
        const float* bb = bias + (size_t)u.e * bias_stride + u.pn * BM + wc * 32 + 8 * fq;
#pragma unroll
        for (int bj = 0; bj < 2; ++bj)
#pragma unroll
            for (int n = 0; n < 2; ++n) p.bv[bj][n] = *(const f32x4*)(bb + bj * HALF + 4 * n);
    }
    __device__ __forceinline__ void operator()(const f32x4 (&acc)[2][2][4][2], const Unit& u, int wr, int wc, int fr, int fq, const Pre& pre) const {
        const int row0 = u.pm * BM + wr * 64 + fr; const int col0 = u.pn * BM + wc * 32 + 8 * fq;
#pragma unroll
        for (int ai = 0; ai < 2; ++ai)
#pragma unroll
            for (int m = 0; m < 4; ++m) { bf16_t* rowp = O + (size_t)((row0 + ai * HALF + m * 16) & 255) * ldc + col0;
#pragma unroll
                for (int bj = 0; bj < 2; ++bj) { const f32x4 v0 = acc[ai][bj][m][0] + pre.bv[bj][0], v1 = acc[ai][bj][m][1] + pre.bv[bj][1];
                    u32x4 w; w.x = cvt_pk_bf16(v0[0], v0[1]); w.y = cvt_pk_bf16(v0[2], v0[3]); w.z = cvt_pk_bf16(v1[0], v1[1]); w.w = cvt_pk_bf16(v1[2], v1[3]);
                    *(u32x4*)(rowp + bj * HALF) = w; } }
    }
};
struct EpiBf16BiasF8 {
    static constexpr bool PERM = true, AFTER_DRAIN = false;
    bf16_t* O; int ldc; const float* bias; int bias_stride;
    struct Pre {}; __device__ __forceinline__ void preload(Pre&, const Unit&, int, int, int, int) const {}
    __device__ __forceinline__ void operator()(const f32x4 (&acc)[2][2][4][2], const Unit& u, int wr, int wc, int fr, int fq, const Pre&) const {
        asm volatile("" : "+v"(fr), "+v"(fq));
        const int row0 = u.pm * BM + wr * 64 + fr; const int col0 = u.pn * BM + wc * 32 + 8 * fq;
        const float* bb = bias + (size_t)u.e * bias_stride;
        f32x4 bv[2][2];
#pragma unroll
        for (int bj = 0; bj < 2; ++bj)
#pragma unroll
            for (int n = 0; n < 2; ++n) bv[bj][n] = *(const f32x4*)(bb + col0 + bj * HALF + 4 * n);
#pragma unroll
        for (int ai = 0; ai < 2; ++ai)
#pragma unroll
            for (int m = 0; m < 4; ++m) { bf16_t* rowp = O + (size_t)(row0 + ai * HALF + m * 16) * ldc + col0;
#pragma unroll
                for (int bj = 0; bj < 2; ++bj) { const f32x4 v0 = acc[ai][bj][m][0] * (1.0f / (F8_SA * F8_SW)) + bv[bj][0], v1 = acc[ai][bj][m][1] * (1.0f / (F8_SA * F8_SW)) + bv[bj][1];
                    u32x4 w; w.x = cvt_pk_bf16(v0[0], v0[1]); w.y = cvt_pk_bf16(v0[2], v0[3]); w.z = cvt_pk_bf16(v1[0], v1[1]); w.w = cvt_pk_bf16(v1[2], v1[3]);
                    *(u32x4*)(rowp + bj * HALF) = w; } }
    }
};
struct EpiLruGate {
    static constexpr bool PERM = false, AFTER_DRAIN = false;
    const bf16_t* XL; bf16_t* LAB; size_t lab_stride; const float* gb; const float* spt;
    struct Pre {}; __device__ __forceinline__ void preload(Pre&, const Unit&, int, int, int, int) const {}
    __device__ __forceinline__ void operator()(const f32x4 (&acc)[2][2][4][2], const Unit& u, int wr, int wc, int fr, int fq, const Pre&) const {
        const int d = u.pn >> 1, half = u.pn & 1;
        const int row0 = u.pm * BM + wr * 64 + fr, ch0 = half * 128 + wc * 32 + 4 * fq;
        bf16_t* LA = LAB + (size_t)(2 * d) * lab_stride; bf16_t* LB = LAB + (size_t)(2 * d + 1) * lab_stride;
#pragma unroll
        for (int n = 0; n < 2; ++n) {
            const f32x4 bR = *(const f32x4*)(gb + (d * 2 + 0) * 256 + ch0 + 16 * n), bI = *(const f32x4*)(gb + (d * 2 + 1) * 256 + ch0 + 16 * n);
            const f32x4 sp = *(const f32x4*)(spt + d * 256 + ch0 + 16 * n) * (-8.0f * 1.4426950408889634f);
#pragma unroll
            for (int ai = 0; ai < 2; ++ai)
#pragma unroll
                for (int m = 0; m < 4; ++m) { const size_t ro = (size_t)(row0 + ai * HALF + m * 16) * 256 + ch0 + 16 * n;
                    typedef unsigned u32x2 __attribute__((ext_vector_type(2)));
                    const u32x2 xw = *(const u32x2*)(XL + ro);
                    const float xl[4] = {__builtin_bit_cast(float, xw.x << 16), __builtin_bit_cast(float, xw.x & 0xffff0000u), __builtin_bit_cast(float, xw.y << 16), __builtin_bit_cast(float, xw.y & 0xffff0000u)};
                    const f32x4 gr = acc[ai][0][m][n] + bR, gi = acc[ai][1][m][n] + bI;
                    f32x4 av, bv;
#pragma unroll
                    for (int e = 0; e < 4; ++e) {
                        const float rg = __builtin_amdgcn_rcpf(1.0f + __builtin_amdgcn_exp2f(-1.4426950408889634f * gr[e])), ig = __builtin_amdgcn_rcpf(1.0f + __builtin_amdgcn_exp2f(-1.4426950408889634f * gi[e]));
                        const float la2 = rg * sp[e];
                        const float a2 = __builtin_amdgcn_exp2f(2.0f * la2);
                        av[e] = la2; bv[e] = __builtin_amdgcn_sqrtf(fmaxf(1.0f - a2, 0.f)) * (ig * xl[e]); }
                    u32x2 wa, wb; wa.x = cvt_pk_bf16(av[0], av[1]); wa.y = cvt_pk_bf16(av[2], av[3]); wb.x = cvt_pk_bf16(bv[0], bv[1]); wb.y = cvt_pk_bf16(bv[2], bv[3]);
                    *(u32x2*)(LA + ro) = wa; *(u32x2*)(LB + ro) = wb; }
        }
    }
};
struct EpiNone {
    static constexpr bool PERM = true, AFTER_DRAIN = false;
    struct Pre {}; __device__ __forceinline__ void preload(Pre&, const Unit&, int, int, int, int) const {}
    __device__ __forceinline__ void operator()(const f32x4 (&acc)[2][2][4][2], const Unit& u, int wr, int wc, int fr, int fq, const Pre&) const {
#pragma unroll
        for (int a = 0; a < 2; ++a)
#pragma unroll
            for (int b2 = 0; b2 < 2; ++b2)
#pragma unroll
                for (int m = 0; m < 4; ++m)
#pragma unroll
                    for (int n = 0; n < 2; ++n) { f32x4 v = acc[a][b2][m][n]; asm volatile("" :: "v"(v)); }
    }
};
template <bool GATHER_> struct MoeOrderT {
    static constexpr bool GATHER = GATHER_;
    const int* rowtok;
    __device__ __forceinline__ int row_of(int r) const { return GATHER_ ? rowtok[r] : r; }
    const PG8_LAS int* tab; int ntiles, nN, nper, j, m_lo, nMx, wgm, rev;
    __device__ __forceinline__ void init(const PG8_LAS int* tab_, int ntiles_, int nN_, int G, int bx, int wgm_) {
        tab = tab_; ntiles = ntiles_; nN = nN_; wgm = wgm_; rev = 0;
        if (G % 8 == 0) { const int x = bx % 8; nper = G / 8; j = bx / 8; m_lo = (x * ntiles) / 8; nMx = ((x + 1) * ntiles) / 8 - m_lo; }
        else { nper = G; j = bx; m_lo = 0; nMx = ntiles; }
    }
    __device__ __forceinline__ bool next(int i, Unit& u) const {
        const int s = i * nper + j; if (s >= nMx * nN) return false;
        const int nig = wgm * nN, gid = s / nig, fm = gid * wgm, gsz = (nMx - fm) < wgm ? (nMx - fm) : wgm, w = s - gid * nig;
        const int mi = fm + (w % gsz); u.pm = m_lo + (rev ? (nMx - 1 - mi) : mi); u.pn = w / gsz; u.e = tab[u.pm]; u.be = u.e * nN + u.pn; return true;
    }
    __device__ __forceinline__ void a_ready(const Unit&) const {}
    __device__ __forceinline__ void done(const Unit&) const {}
};
template <class Epi, class Sched, bool ALIGN_EPI = false, bool SP2 = false, bool FP8 = false>
__device__ __forceinline__ void gemm_phase(PG8_LAS unsigned char* lds, const Gemm g, const Sched& S, const Epi& E) {
    int tid_ = threadIdx.x; asm volatile("" : "+v"(tid_));
    const int tid = tid_, wid = __builtin_amdgcn_readfirstlane(tid >> 6), lane = tid & 63, wr = wid >> 2, wc = wid & 3, fr = lane & 15, fq = lane >> 4;
    const int K = g.K, nt = K / BK;
    unsigned voffA[2], voffB[2];
#pragma unroll
    for (int i = 0; i < 2; ++i) { int R, C; stage_rc(tid * 16 + i * 8192, R, C); const int Rb = Epi::PERM ? ((R & ~31) + perm32(R & 31)) : R;
        voffA[i] = (unsigned)(R * K + C) * 2u; voffB[i] = (unsigned)(Rb * K + C) * 2u; }
    unsigned gA_[2] = {0u, 0u}, gN_[2] = {0u, 0u}, gC_[2] = {0u, 0u};
    static_assert(!Sched::GATHER || SP2, "the gathered A operand is wired into the SP2 loop only");
    if constexpr (Sched::GATHER) { _Pragma("unroll") for (int i_ = 0; i_ < 2; ++i_) { int R_, C_; stage_rc(tid * 16 + i_ * 8192, R_, C_); gC_[i_] = (unsigned)(C_ * 2); } }
#define PG8_GLOAD(dst, pm_) do { _Pragma("unroll") for (int h_ = 0; h_ < 2; ++h_) { unsigned t_[2]; _Pragma("unroll") for (int i_ = 0; i_ < 2; ++i_) { int R_, C_; stage_rc(tid * 16 + i_ * 8192, R_, C_); \
        t_[i_] = (unsigned)S.row_of((pm_) * BM + h_ * HALF + R_); } dst[h_] = t_[0] | (t_[1] << 16); } } while (0)
    const size_t kstep = (size_t)(BK * 2);
    const size_t hstep = (size_t)HALF * K * 2;
    const size_t tstep = 2 * hstep;
    const unsigned ldsw = (unsigned)wid * 1024u;
    const int aoff = lds_byte(wr * 64 + fr, fq * 8), boff = lds_byte(wc * 32 + fr, fq * 8);
#define PG8_SA(b, h) (((b) * 2 + (h)) * HTB)
#define PG8_SB(b, h) ((4 + (b) * 2 + (h)) * HTB)
#define PG8_STAGE(bufoff, gbase, voff) do { _Pragma("unroll") for (int _i = 0; _i < 2; ++_i) \
        __builtin_amdgcn_global_load_lds((const unsigned*)((const char*)(gbase) + (voff)[_i]), (PG8_LAS unsigned*)(lds + (bufoff) + ldsw + _i * 8192), 16, 0, 0); } while (0)
#define PG8_STA(bufoff, ptr, h, useN) do { if constexpr (Sched::GATHER) { const unsigned pk_ = (useN) ? gN_[h] : gA_[h]; unsigned o_[2] = {(pk_ & 0xffffu) * (unsigned)(K * 2) + gC_[0], (pk_ >> 16) * (unsigned)(K * 2) + gC_[1]}; PG8_STAGE(bufoff, ptr, o_); } \
        else { PG8_STAGE(bufoff, (ptr) + ((h) ? hstep : 0), voffA); } } while (0)
#define PG8_LDA(dst, b, h) do { _Pragma("unroll") for (int m = 0; m < 4; ++m) { if constexpr (FP8) { \
            dst##8[m] = __builtin_shufflevector(*(const PG8_LAS i32x4_*)(lds + PG8_SA(b, h) + aoff + m * 2048), *(const PG8_LAS i32x4_*)(lds + PG8_SA(b, h) + aoff + m * 2048 + 1024), 0, 1, 2, 3, 4, 5, 6, 7); } \
        else { _Pragma("unroll") for (int k = 0; k < 2; ++k) dst[m][k] = *(const PG8_LAS bf16x8*)(lds + PG8_SA(b, h) + aoff + m * 2048 + k * 1024); } } } while (0)
#define PG8_LDB(dst, b, h) do { _Pragma("unroll") for (int n = 0; n < 2; ++n) { if constexpr (FP8) { \
            dst##8[n] = __builtin_shufflevector(*(const PG8_LAS i32x4_*)(lds + PG8_SB(b, h) + boff + n * 2048), *(const PG8_LAS i32x4_*)(lds + PG8_SB(b, h) + boff + n * 2048 + 1024), 0, 1, 2, 3, 4, 5, 6, 7); } \
        else { _Pragma("unroll") for (int k = 0; k < 2; ++k) dst[n][k] = *(const PG8_LAS bf16x8*)(lds + PG8_SB(b, h) + boff + n * 2048 + k * 1024); } } } while (0)
#define PG8_MMA(ai, bj, At, Bt) do { __builtin_amdgcn_s_setprio(1); _Pragma("unroll") for (int m = 0; m < 4; ++m) _Pragma("unroll") for (int n = 0; n < 2; ++n) { \
        if constexpr (FP8) asm volatile("v_mfma_f32_16x16x128_f8f6f4 %0, %1, %2, %0" : "+v"(acc[ai][bj][m][n]) : "v"(Bt##8[n]), "v"(At##8[m]));   \
        else { _Pragma("unroll") for (int k = 0; k < 2; ++k) acc[ai][bj][m][n] = __builtin_amdgcn_mfma_f32_16x16x32_bf16(Bt[n][k], At[m][k], acc[ai][bj][m][n], 0, 0, 0); } } \
        __builtin_amdgcn_s_setprio(0); } while (0)
#define PG8_WAIT_V(n) asm volatile("s_waitcnt vmcnt(" #n ")" ::: "memory")
#define PG8_WAIT_L(n) asm volatile("s_waitcnt lgkmcnt(" #n ")" ::: "memory")
#define PG8_BAR __builtin_amdgcn_s_barrier()
#define PG8_SCHED __builtin_amdgcn_sched_barrier(0)
    Unit cur, nxt; int ui = 0;
    if (!S.next(0, cur)) return;
    f32x4 acc[2][2][4][2];
#pragma unroll
    for (int a = 0; a < 2; ++a)
#pragma unroll
        for (int b = 0; b < 2; ++b)
#pragma unroll
            for (int m = 0; m < 4; ++m)
#pragma unroll
                for (int n = 0; n < 2; ++n) acc[a][b][m][n] = (f32x4){0.f, 0.f, 0.f, 0.f};
    typedef int i32x4_ __attribute__((ext_vector_type(4))); typedef int i32x8_ __attribute__((ext_vector_type(8)));
    bf16x8 At[4][2], B0[2][2], B1[2][2]; i32x8_ At8[4], B08[2], B18[2];
    typename Epi::Pre pre;
    const char* cA = (const char*)g.A + (Sched::GATHER ? (size_t)0 : (size_t)cur.pm * tstep); if constexpr (Sched::GATHER) PG8_GLOAD(gA_, cur.pm);
    const char* cB = (const char*)g.Bt + (size_t)cur.be * tstep;
    S.a_ready(cur);
    if constexpr (SP2) {
        PG8_STAGE(PG8_SB(0, 0), cB, voffB); PG8_STAGE(PG8_SB(0, 1), cB + hstep, voffB); PG8_STA(PG8_SA(0, 0), cA, 0, false); PG8_STA(PG8_SA(0, 1), cA, 1, false);
        if (wr == 1) PG8_BAR;
        PG8_WAIT_V(2); PG8_BAR;
        PG8_STAGE(PG8_SB(1, 0), cB + kstep, voffB); PG8_STA(PG8_SA(1, 0), cA + kstep, 0, false); PG8_STAGE(PG8_SB(1, 1), cB + hstep + kstep, voffB);
        PG8_WAIT_V(6); PG8_BAR;
    } else {
        PG8_STAGE(PG8_SB(0, 0), cB, voffB); PG8_STAGE(PG8_SA(0, 0), cA, voffA); PG8_STAGE(PG8_SB(0, 1), cB + hstep, voffB); PG8_STAGE(PG8_SA(0, 1), cA + hstep, voffA);
        if (wr == 1) PG8_BAR;
        PG8_WAIT_V(4); PG8_BAR;
        PG8_STAGE(PG8_SB(1, 0), cB + kstep, voffB); PG8_STAGE(PG8_SA(1, 0), cA + kstep, voffA); PG8_STAGE(PG8_SB(1, 1), cB + hstep + kstep, voffB);
        PG8_WAIT_V(6); PG8_BAR;
    }
    for (;;) {
        const bool has_next = S.next(ui + 1, nxt);
        const char* nA = (has_next && !Sched::GATHER) ? (const char*)g.A + (size_t)nxt.pm * tstep : cA; const char* nB = has_next ? (const char*)g.Bt + (size_t)nxt.be * tstep : cB;
        if constexpr (Sched::GATHER) { if (has_next) PG8_GLOAD(gN_, nxt.pm); else { gN_[0] = gA_[0]; gN_[1] = gA_[1]; } }
        for (int t = 0; t < nt; t += 2) {
            const bool last = (t == nt - 2);
            const char* a1 = cA + (size_t)(t + 1) * kstep;
            const char* a2 = last ? nA : cA + (size_t)(t + 2) * kstep; const char* b2 = last ? nB : cB + (size_t)(t + 2) * kstep;
            const char* a3 = a2 + kstep; const char* b3 = b2 + kstep;
            if (last) E.preload(pre, cur, wr, wc, fr, fq);
            if (last && has_next) S.a_ready(nxt);
            if constexpr (SP2) {
            PG8_LDB(B0, 0, 0); PG8_LDB(B1, 0, 1); PG8_SCHED; PG8_LDA(At, 0, 0); PG8_STA(PG8_SA(1, 1), a1, 1, false);
            PG8_WAIT_V(8); PG8_WAIT_L(0); PG8_BAR; PG8_MMA(0, 0, At, B0); PG8_MMA(0, 1, At, B1); PG8_BAR; PG8_SCHED;
            PG8_LDA(At, 0, 1); PG8_STAGE(PG8_SB(0, 0), b2, voffB); PG8_STAGE(PG8_SB(0, 1), b2 + hstep, voffB); PG8_STA(PG8_SA(0, 0), a2, 0, last);
            PG8_WAIT_V(8); PG8_WAIT_L(0); PG8_BAR; PG8_MMA(1, 0, At, B0); PG8_MMA(1, 1, At, B1); PG8_BAR; PG8_SCHED;
            PG8_LDB(B0, 1, 0); PG8_LDB(B1, 1, 1); PG8_SCHED; PG8_LDA(At, 1, 0); PG8_STA(PG8_SA(0, 1), a2, 1, last);
            PG8_WAIT_V(8); PG8_WAIT_L(0); PG8_BAR; PG8_MMA(0, 0, At, B0); PG8_MMA(0, 1, At, B1); PG8_BAR; PG8_SCHED;
            PG8_LDA(At, 1, 1); PG8_STAGE(PG8_SB(1, 0), b3, voffB); PG8_STAGE(PG8_SB(1, 1), b3 + hstep, voffB); PG8_STA(PG8_SA(1, 0), a3, 0, last);
            PG8_WAIT_V(8); PG8_WAIT_L(0); PG8_BAR; PG8_MMA(1, 0, At, B0); PG8_MMA(1, 1, At, B1); PG8_BAR; PG8_SCHED;
            } else {
            PG8_LDB(B0, 0, 0); PG8_SCHED; PG8_LDA(At, 0, 0); PG8_STAGE(PG8_SA(1, 1), a1 + hstep, voffA);
            PG8_WAIT_L(8); PG8_BAR; PG8_WAIT_L(0); PG8_MMA(0, 0, At, B0); PG8_BAR; PG8_SCHED;
            PG8_LDB(B1, 0, 1); PG8_STAGE(PG8_SB(0, 0), b2, voffB);
            PG8_BAR; PG8_WAIT_L(0); PG8_MMA(0, 1, At, B1); PG8_BAR;
            PG8_LDA(At, 0, 1); PG8_STAGE(PG8_SA(0, 0), a2, voffA);
            PG8_BAR; PG8_WAIT_L(0); PG8_MMA(1, 0, At, B0); PG8_BAR; PG8_SCHED;
            PG8_STAGE(PG8_SB(0, 1), b2 + hstep, voffB);
            PG8_WAIT_V(6); PG8_BAR; PG8_MMA(1, 1, At, B1); PG8_BAR;
            PG8_LDB(B0, 1, 0); PG8_SCHED; PG8_LDA(At, 1, 0); PG8_STAGE(PG8_SA(0, 1), a2 + hstep, voffA);
            PG8_WAIT_L(8); PG8_BAR; PG8_WAIT_L(0); PG8_MMA(0, 0, At, B0); PG8_BAR; PG8_SCHED;
            PG8_LDB(B1, 1, 1); PG8_STAGE(PG8_SB(1, 0), b3, voffB);
            PG8_BAR; PG8_WAIT_L(0); PG8_MMA(0, 1, At, B1); PG8_BAR;
            PG8_LDA(At, 1, 1); PG8_STAGE(PG8_SA(1, 0), a3, voffA);
            PG8_BAR; PG8_WAIT_L(0); PG8_MMA(1, 0, At, B0); PG8_BAR; PG8_SCHED;
            PG8_STAGE(PG8_SB(1, 1), b3 + hstep, voffB);
            PG8_WAIT_V(6); PG8_BAR; PG8_MMA(1, 1, At, B1); PG8_BAR;
            }
        }
        if constexpr (ALIGN_EPI) { if (wr == 0) PG8_BAR; }
        if constexpr (!Epi::AFTER_DRAIN) { E(acc, cur, wr, wc, fr, fq, pre); S.done(cur); }
        if (!has_next) break;
#pragma unroll
        for (int a = 0; a < 2; ++a)
#pragma unroll
            for (int b = 0; b < 2; ++b)
#pragma unroll
                for (int m = 0; m < 4; ++m)
#pragma unroll
                    for (int n = 0; n < 2; ++n) acc[a][b][m][n] = (f32x4){0.f, 0.f, 0.f, 0.f};
        cur = nxt; cA = nA; cB = nB; ++ui;
        if constexpr (Sched::GATHER) { gA_[0] = gN_[0]; gA_[1] = gN_[1]; }
        if constexpr (ALIGN_EPI) { if (wr == 1) PG8_BAR; }
    }
    PG8_WAIT_V(0);
    if constexpr (!ALIGN_EPI) { if (wr == 0) PG8_BAR; }
    PG8_BAR;
    if constexpr (Epi::AFTER_DRAIN) { E.fused(acc, cur, wr, wc, fr, fq, lds, wid, lane); S.done(cur); }
#undef PG8_SA
#undef PG8_SB
#undef PG8_STAGE
#undef PG8_STA
#undef PG8_GLOAD
#undef PG8_LDA
#undef PG8_LDB
#undef PG8_MMA
#undef PG8_WAIT_V
#undef PG8_WAIT_L
#undef PG8_BAR
#undef PG8_SCHED
}
}

#ifndef PG8_SP2
#define PG8_SP2 true
#endif
#ifndef PG8_ALIGN
#define PG8_ALIGN true
#endif
#include <cmath>
namespace attn_body {
using bf16=__hip_bfloat16;
using bf16x8=__attribute__((ext_vector_type(8)))short;
using s16x4=__attribute__((ext_vector_type(4)))short;
using f32x16=__attribute__((ext_vector_type(16)))float;
using u32x4=__attribute__((ext_vector_type(4)))unsigned;
using f32x4_t=__attribute__((ext_vector_type(4)))float;
constexpr int NHEAD=8,SEQQ=8192,SEQK=8448,D=64,QP=512,KP=128,QIN=2048;
constexpr int NW=8,QBLK=32,QB=QBLK*NW,KVBLK=64,NQB=SEQQ/QB;
constexpr int ATTN_UNIT_ROWS=QB;
__device__ __forceinline__ int crow(int r,int hi){return (r&3)+8*(r>>2)+4*hi;}
#define SBAR() __builtin_amdgcn_sched_barrier(0)
__device__ __forceinline__ void cmask(f32x16&p0,f32x16&p1,int jb,int qrel,int hi){
  const float NEG=-INFINITY; int kb=64*jb+4*hi;
  #pragma unroll
  for(int r=0;r<16;++r){int kv=kb+(r&3)+8*(r>>2); if(kv>qrel)p0[r]=NEG; if(kv+32>qrel)p1[r]=NEG;}
}

constexpr int NSLOT=3, SLOTB=8192;
constexpr int LDS_K=0, LDS_V=NSLOT*SLOTB, LDS_WS=2*NSLOT*SLOTB, LDS_OST=LDS_WS+NW*64*4, LDS_BYTES=LDS_OST+NW*4096;
constexpr float C2=0.125f*1.4426950408889634f;
__device__ __forceinline__ void glds16(const void*gsrc,unsigned lds_dst){unsigned keep;
  asm volatile("s_mov_b32 %0, m0\n\ts_mov_b32 m0, %2\n\ts_nop 0\n\tglobal_load_lds_dwordx4 %1, off\n\ts_mov_b32 m0, %0":"=&s"(keep):"v"(gsrc),"s"(lds_dst):"memory");}
__device__ __forceinline__ float max3f(float a,float b,float c){float r;asm("v_max3_f32 %0, %1, %2, %3":"=v"(r):"v"(a),"v"(b),"v"(c));return r;}
__device__ __forceinline__ float max2f(float a,float b){float r;asm("v_max_f32_e32 %0, %1, %2":"=v"(r):"v"(a),"v"(b));return r;}
__device__ __forceinline__ float fadd_s(float a,float b){float r;asm("v_add_f32_e32 %0, %1, %2":"=v"(r):"v"(a),"v"(b));return r;}
__device__ __forceinline__ float fsub_s(float a,float b){float r;asm("v_sub_f32_e32 %0, %1, %2":"=v"(r):"v"(a),"v"(b));return r;}
typedef float f32x2_t __attribute__((ext_vector_type(2))); typedef __bf16 bf16x2_t __attribute__((ext_vector_type(2)));
__device__ __forceinline__ unsigned cvtpk_s(float lo,float hi){f32x2_t v={lo,hi};bf16x2_t b=__builtin_convertvector(v,bf16x2_t);return __builtin_bit_cast(unsigned,b);}
#define WAIT_BAR(N) asm volatile("s_waitcnt vmcnt(" #N ") lgkmcnt(0)\n\ts_barrier":::"memory")

__device__ __forceinline__ void qkt(f32x16&p0,f32x16&p1,const char*Kslot,const bf16x8*qr,const f32x16&negm,int r32,int hi){
  const char*kb=Kslot+hi*1024+r32*16;
  #pragma unroll
  for(int d0=0;d0<4;++d0){
    const bf16x8 b0=*reinterpret_cast<const bf16x8*>(kb+d0*2048);
    const bf16x8 b1=*reinterpret_cast<const bf16x8*>(kb+d0*2048+512);
    if(d0==0){p0=__builtin_amdgcn_mfma_f32_32x32x16_bf16(b0,qr[0],negm,0,0,0);p1=__builtin_amdgcn_mfma_f32_32x32x16_bf16(b1,qr[0],negm,0,0,0);}
    else{p0=__builtin_amdgcn_mfma_f32_32x32x16_bf16(b0,qr[d0],p0,0,0,0);p1=__builtin_amdgcn_mfma_f32_32x32x16_bf16(b1,qr[d0],p1,0,0,0);}}
}
typedef __attribute__((address_space(3))) const char* lds_cptr;
typedef short v4i16_t __attribute__((ext_vector_type(4)));
__device__ __forceinline__ void kload8(bf16x8*kf,lds_cptr kp){
  kf[0]=*(const __attribute__((address_space(3))) bf16x8*)(kp);      kf[1]=*(const __attribute__((address_space(3))) bf16x8*)(kp+512);
  kf[2]=*(const __attribute__((address_space(3))) bf16x8*)(kp+2048); kf[3]=*(const __attribute__((address_space(3))) bf16x8*)(kp+2560);
  kf[4]=*(const __attribute__((address_space(3))) bf16x8*)(kp+4096); kf[5]=*(const __attribute__((address_space(3))) bf16x8*)(kp+4608);
  kf[6]=*(const __attribute__((address_space(3))) bf16x8*)(kp+6144); kf[7]=*(const __attribute__((address_space(3))) bf16x8*)(kp+6656);
}
__device__ __forceinline__ void kload2(bf16x8*kf,lds_cptr kp,int j){ kf[2*j]=*(const __attribute__((address_space(3))) bf16x8*)(kp+j*2048); kf[2*j+1]=*(const __attribute__((address_space(3))) bf16x8*)(kp+j*2048+512); }
__device__ __forceinline__ s16x4 vtr(lds_cptr p){ return __builtin_bit_cast(s16x4,__builtin_amdgcn_ds_read_tr16_b64_v4i16((__attribute__((address_space(3))) v4i16_t*)p)); }
__device__ __forceinline__ float rowmax(const f32x16&p0,const f32x16&p1){
  float a=max3f(p0[0],p0[1],p1[0]),b=max3f(p0[2],p0[3],p1[1]);a=max3f(a,p1[2],p1[3]);
  #pragma unroll
  for(int r=4;r<16;r+=4){a=max3f(a,p0[r],p0[r+1]);b=max3f(b,p0[r+2],p0[r+3]);a=max3f(a,p1[r],p1[r+1]);b=max3f(b,p1[r+2],p1[r+3]);}
  const float m=max2f(a,b);
  auto rr=__builtin_amdgcn_permlane32_swap(__float_as_uint(m),__float_as_uint(m),false,false);
  return max2f(__uint_as_float(rr[0]),__uint_as_float(rr[1]));
}
__device__ __forceinline__ void pv(f32x16*o,int vb,bf16x8 pa0,bf16x8 pa1,bf16x8 pa2,bf16x8 pa3){
  #pragma unroll
  for(int d0=0;d0<2;++d0){s16x4 lo[4],hi[4];
    #pragma unroll
    for(int ks=0;ks<4;++ks){
      asm volatile("ds_read_b64_tr_b16 %0,%1 offset:%c2":"=&v"(lo[ks]):"v"(vb),"i"(d0*4096+ks*1024):"memory");
      asm volatile("ds_read_b64_tr_b16 %0,%1 offset:%c2":"=&v"(hi[ks]):"v"(vb),"i"(d0*4096+ks*1024+512):"memory");}
    asm volatile("s_waitcnt lgkmcnt(0)":::"memory");SBAR();
    #define PK(k) (bf16x8){lo[k][0],lo[k][1],lo[k][2],lo[k][3],hi[k][0],hi[k][1],hi[k][2],hi[k][3]}
    o[d0]=__builtin_amdgcn_mfma_f32_32x32x16_bf16(pa0,PK(0),o[d0],0,0,0);
    o[d0]=__builtin_amdgcn_mfma_f32_32x32x16_bf16(pa1,PK(1),o[d0],0,0,0);
    o[d0]=__builtin_amdgcn_mfma_f32_32x32x16_bf16(pa2,PK(2),o[d0],0,0,0);
    o[d0]=__builtin_amdgcn_mfma_f32_32x32x16_bf16(pa3,PK(3),o[d0],0,0,0);
    #undef PK
  }
}

#ifndef ATTN_STORE16
#define ATTN_STORE16(p,v) (*(u32x4*)(p)=(v))
#endif
struct QPre { const float* qg; const float* rc; const float* rs; };
template<int THRL> __device__ __forceinline__ void attn_unit(int b,int h,long qrow0,int NTarg,int tq0,const QPre&QN,const bf16*Q,const bf16*__restrict__ K,const bf16*__restrict__ V,bf16*O,char*shm){
  int tid_=threadIdx.x; asm volatile("":"+v"(tid_)); const int tid=tid_,lane=tid&63,r32=lane&31,hi=lane>>5; const int wid=__builtin_amdgcn_readfirstlane(tid>>6);
  const long krowbase=(long)b*SEQK; const int kvh=h>>2;
  const bf16*Qw=Q+(qrow0+wid*QBLK)*QIN+h*D;
  const bf16*Kh=K+krowbase*KP+kvh*D,*Vh=V+krowbase*KP+kvh*D;
  const unsigned lds0=(unsigned)(uintptr_t)shm;
  float*wsf=(float*)(shm+LDS_WS)+wid*64;
  const bf16*ksrc=Kh+(long)lane*KP+wid*8;
  const bf16*vsrc=Vh+(long)(16*(wid&3)+(lane>>2))*KP+(wid>>2)*32+(lane&3)*8;
  const unsigned kdst=lds0+LDS_K+wid*1024, vdst=lds0+LDS_V+wid*1024;
  #define DMA_K(t,slot) glds16(ksrc+(long)(t)*KVBLK*KP,(unsigned)__builtin_amdgcn_readfirstlane(kdst+(slot)))
  #define DMA_V(t,slot) glds16(vsrc+(long)(t)*KVBLK*KP,(unsigned)__builtin_amdgcn_readfirstlane(vdst+(slot)))
  const int vb0=(int)(lds0+LDS_V)+((lane>>4)&1)*32+(lane&3)*8+(4*hi+((lane&15)>>2))*64;
  const char*Kbase=shm+LDS_K; bf16x8 kf[8];
  const lds_cptr shm3=(lds_cptr)shm; const lds_cptr kp0=shm3+LDS_K+hi*1024+r32*16; const lds_cptr vp0=shm3+LDS_V+((lane>>4)&1)*32+(lane&3)*8+(4*hi+((lane&15)>>2))*64;
  const int NT=NTarg;
  DMA_K(0,0);DMA_V(0,0);DMA_K(1,SLOTB);
  bf16x8 qr[4];
  #pragma unroll
  for(int d0=0;d0<4;++d0)qr[d0]=*reinterpret_cast<const bf16x8*>(&Qw[(long)r32*QIN+d0*16+hi*8]);
  {
    float x[4][8]; float ss=0.f;
    #pragma unroll
    for(int d0=0;d0<4;++d0){
      #pragma unroll
      for(int e=0;e<8;++e){ x[d0][e]=__builtin_bit_cast(float,(unsigned)(unsigned short)qr[d0][e]<<16); ss+=x[d0][e]*x[d0][e]; } }
    ss+=__shfl_xor(ss,32);
    const float rstd=C2/sqrtf(ss*(1.0f/64.0f)+1e-6f);
    #pragma unroll
    for(int d0=0;d0<4;++d0){ const f32x4_t g0=*reinterpret_cast<const f32x4_t*>(QN.qg+16*d0+8*hi), g1=*reinterpret_cast<const f32x4_t*>(QN.qg+16*d0+8*hi+4);
      #pragma unroll
      for(int e=0;e<8;++e) x[d0][e]*=rstd*(e<4?g0[e]:g1[e-4]); }
    if(tq0>=0){ const int t=tq0+wid*QBLK+r32;
      #pragma unroll
      for(int d0=0;d0<2;++d0){ const float*cp=QN.rc+(long)t*32+16*d0+8*hi,*sp=QN.rs+(long)t*32+16*d0+8*hi;
        const f32x4_t c0=*reinterpret_cast<const f32x4_t*>(cp),c1=*reinterpret_cast<const f32x4_t*>(cp+4),s0=*reinterpret_cast<const f32x4_t*>(sp),s1=*reinterpret_cast<const f32x4_t*>(sp+4);
        #pragma unroll
        for(int e=0;e<8;++e){ const float cs=e<4?c0[e]:c1[e-4], sn=e<4?s0[e]:s1[e-4]; const float a=x[d0][e], bq=x[d0+2][e]; x[d0][e]=a*cs-bq*sn; x[d0+2][e]=bq*cs+a*sn; } } }
    #pragma unroll
    for(int d0=0;d0<4;++d0){ u32x4 pk; pk[0]=cvtpk_s(x[d0][0],x[d0][1]); pk[1]=cvtpk_s(x[d0][2],x[d0][3]); pk[2]=cvtpk_s(x[d0][4],x[d0][5]); pk[3]=cvtpk_s(x[d0][6],x[d0][7]); qr[d0]=__builtin_bit_cast(bf16x8,pk); }
  }
  float mhat=0.f,l_reg=0.f;f32x16 o[2];o[0]=f32x16{};o[1]=f32x16{};f32x16 negm=f32x16{};asm volatile("":"+v"(negm));
  const int qrel=wid*QBLK+r32;
  #define CMASK(P0,P1,t) do{}while(0)
  bool resc=false;
  #define START(P0,P1) do{ const float rm=rowmax(P0,P1); resc=false; \
    { const float dl=rm; mhat=fadd_s(mhat,dl); \
      _Pragma("unroll") for(int r=0;r<16;++r){P0[r]=fsub_s(P0[r],dl);P1[r]=fsub_s(P1[r],dl);} \
      _Pragma("unroll") for(int r=0;r<16;++r)negm[r]=-mhat; asm volatile("":"+v"(negm)); } \
    _Pragma("unroll") for(int r=0;r<16;++r)P0[r]=__builtin_amdgcn_exp2f(P0[r]); }while(0)
  #define RESC() do{ if(resc){ asm volatile("s_waitcnt lgkmcnt(0)":::"memory"); \
      _Pragma("unroll") for(int d_=0;d_<2;++d_) _Pragma("unroll") for(int r=0;r<16;++r)o[d_][r]*=wsf[crow(r,hi)]; } }while(0)
  f32x16 pA0,pA1,pB0,pB1;
  int sl_prev=0,sl_cur=0,sl_next=SLOTB;
  #define ROT() do{sl_prev=sl_cur;sl_cur=sl_next;sl_next=(sl_next==(NSLOT-1)*SLOTB)?0:sl_next+SLOTB;}while(0)
  DMA_K(2,2*SLOTB);
  WAIT_BAR(3);
  qkt(pA0,pA1,Kbase,qr,negm,r32,hi);asm volatile("s_nop 15\n\ts_nop 7":"+v"(pA0),"+v"(pA1));CMASK(pA0,pA1,0);
  START(pA0,pA1);
  _Pragma("unroll") for(int r=0;r<16;++r)pA1[r]=__builtin_amdgcn_exp2f(pA1[r]);
  WAIT_BAR(0);
  DMA_K(3,0);DMA_V(1,SLOTB);
  ROT();
  kload8(kf,kp0+sl_cur);
  WAIT_BAR(2);
  s16x4 vlo[8],vhi[8]; u32x4 pw0,pw1,pw2,pw3;
  #define PKW(P,B) cvtpk_s(P[B],P[B+1])
  #define PAF(k) __builtin_bit_cast(bf16x8,pw##k)
  #define VFR(i) (bf16x8){vlo[i][0],vlo[i][1],vlo[i][2],vlo[i][3],vhi[i][0],vhi[i][1],vhi[i][2],vhi[i][3]}
  #define PIN(x) asm volatile("":"+v"(x))
  #define MX3(a,b,c) __builtin_fmaxf(__builtin_fmaxf((a),(b)),(c))
  #define GAPA(MF,A0,A1,A2,A3,W0,W1,PW) do{ MF; sacc+=A0; sacc+=A1; sacc+=A2; sacc+=A3; PIN(sacc); W0; W1; PIN(PW); SBAR(); }while(0)
  #define EX(v) __builtin_amdgcn_exp2f(v)
  #define GAPB(MF,X,B) do{ MF; X[B]=EX(X[B]); X[B+1]=EX(X[B+1]); X[B+2]=EX(X[B+2]); X[B+3]=EX(X[B+3]); PIN(X); SBAR(); }while(0)
  #define VRD(i) do{ vlo[i]=vtr(vp_+(((i)>>2)*4096+((i)&3)*1024)); vhi[i]=vtr(vp_+(((i)>>2)*4096+((i)&3)*1024+512)); }while(0)
  #define KRD(G,j) do{ if(G){ kload2(kf,kp0+sl_next,j); SBAR(); } }while(0)
  #define STEP(C0,C1,P0,P1,t,GK,GV,GL) do{ SBAR(); \
    const lds_cptr vp_=vp0+sl_prev; \
    VRD(0); SBAR(); float sacc=(P0[0]+P0[1]); \
    GAPA(C0=__builtin_amdgcn_mfma_f32_32x32x16_bf16(kf[0],qr[0],negm,0,0,0), P0[2],P0[3],P0[4],P0[5],     pw0[0]=PKW(P0,0), pw0[1]=PKW(P0,2), pw0); \
    VRD(4); SBAR(); GAPA(C1=__builtin_amdgcn_mfma_f32_32x32x16_bf16(kf[1],qr[0],negm,0,0,0), P0[6],P0[7],P0[8],P0[9],     pw0[2]=PKW(P0,4), pw0[3]=PKW(P0,6), pw0); \
    VRD(1); SBAR(); GAPA(C0=__builtin_amdgcn_mfma_f32_32x32x16_bf16(kf[2],qr[1],C0,0,0,0),   P0[10],P0[11],P0[12],P0[13], pw1[0]=PKW(P0,8), pw1[1]=PKW(P0,10), pw1); \
    VRD(5); SBAR(); GAPA(C1=__builtin_amdgcn_mfma_f32_32x32x16_bf16(kf[3],qr[1],C1,0,0,0),   P0[14],P0[15],P1[0],P1[1],   pw1[2]=PKW(P0,12),pw1[3]=PKW(P0,14), pw1); \
    VRD(2); SBAR(); GAPA(C0=__builtin_amdgcn_mfma_f32_32x32x16_bf16(kf[4],qr[2],C0,0,0,0),   P1[2],P1[3],P1[4],P1[5],     pw2[0]=PKW(P1,0), pw2[1]=PKW(P1,2), pw2); \
    VRD(6); SBAR(); GAPA(C1=__builtin_amdgcn_mfma_f32_32x32x16_bf16(kf[5],qr[2],C1,0,0,0),   P1[6],P1[7],P1[8],P1[9],     pw2[2]=PKW(P1,4), pw2[3]=PKW(P1,6), pw2); \
    VRD(3); SBAR(); GAPA(C0=__builtin_amdgcn_mfma_f32_32x32x16_bf16(kf[6],qr[3],C0,0,0,0),   P1[10],P1[11],P1[12],P1[13], pw3[0]=PKW(P1,8), pw3[1]=PKW(P1,10), pw3); \
    VRD(7); SBAR(); GAPA(C1=__builtin_amdgcn_mfma_f32_32x32x16_bf16(kf[7],qr[3],C1,0,0,0),   P1[14],P1[15],0.f,0.f,       pw3[2]=PKW(P1,12),pw3[3]=PKW(P1,14), pw3); \
    l_reg+=sacc; \
    if(GK){DMA_K((t)+3,sl_cur);} if(GV){DMA_V((t)+1,sl_next);} \
    CMASK(C0,C1,t); \
    { float a=MX3(C0[0],C0[1],C1[0]),b=MX3(C0[2],C0[3],C1[1]); a=MX3(a,C1[2],C1[3]); \
      _Pragma("unroll") for(int r=4;r<16;r+=4){a=MX3(a,C0[r],C0[r+1]);b=MX3(b,C0[r+2],C0[r+3]);a=MX3(a,C1[r],C1[r+1]);b=MX3(b,C1[r+2],C1[r+3]);} \
      float rm=__builtin_fmaxf(a,b); { auto rr=__builtin_amdgcn_permlane32_swap(__float_as_uint(rm),__float_as_uint(rm),false,false); rm=__builtin_fmaxf(__uint_as_float(rr[0]),__uint_as_float(rr[1])); } \
      resc=false; \
      if(__builtin_expect(__any(rm>(float)THRL),0)){ const float dl=__builtin_fmaxf(rm,0.f); mhat+=dl; \
        _Pragma("unroll") for(int r=0;r<16;++r){C0[r]-=dl;C1[r]-=dl;} \
        _Pragma("unroll") for(int r=0;r<16;++r)negm[r]=-mhat; asm volatile("":"+v"(negm)); \
        const float f=__builtin_amdgcn_exp2f(-dl); l_reg*=f; if(hi==0)wsf[r32]=f; resc=true; } } \
    SBAR(); \
    GAPB(o[0]=__builtin_amdgcn_mfma_f32_32x32x16_bf16(PAF(0),VFR(0),o[0],0,0,0), C0,0); \
    GAPB(o[1]=__builtin_amdgcn_mfma_f32_32x32x16_bf16(PAF(0),VFR(4),o[1],0,0,0), C0,4); \
    KRD(GL,0); GAPB(o[0]=__builtin_amdgcn_mfma_f32_32x32x16_bf16(PAF(1),VFR(1),o[0],0,0,0), C0,8); \
    KRD(GL,1); GAPB(o[1]=__builtin_amdgcn_mfma_f32_32x32x16_bf16(PAF(1),VFR(5),o[1],0,0,0), C0,12); \
    KRD(GL,2); GAPB(o[0]=__builtin_amdgcn_mfma_f32_32x32x16_bf16(PAF(2),VFR(2),o[0],0,0,0), C1,0); \
    KRD(GL,3); GAPB(o[1]=__builtin_amdgcn_mfma_f32_32x32x16_bf16(PAF(2),VFR(6),o[1],0,0,0), C1,4); \
    GAPB(o[0]=__builtin_amdgcn_mfma_f32_32x32x16_bf16(PAF(3),VFR(3),o[0],0,0,0), C1,8); \
    GAPB(o[1]=__builtin_amdgcn_mfma_f32_32x32x16_bf16(PAF(3),VFR(7),o[1],0,0,0), C1,12); \
    }while(0)
  int t=1;
  #undef CMASK
  #define CMASK(P0,P1,t) do{}while(0)
  for(;t+5<NT;t+=2){
    STEP(pB0,pB1,pA0,pA1,t,true,true,true);     WAIT_BAR(2); RESC(); ROT();
    STEP(pA0,pA1,pB0,pB1,t+1,true,true,true);   WAIT_BAR(2); RESC(); ROT();
  }
  #undef CMASK
  #define CMASK(P0,P1,t) do{}while(0)
  #define ENDW(tt) do{ if((tt)+3<NT){WAIT_BAR(2);} else if((tt)+2<NT){WAIT_BAR(1);} else {WAIT_BAR(0);} }while(0)
  for(;t+1<NT;t+=2){
    STEP(pB0,pB1,pA0,pA1,t,(t+3<NT),(t+1<NT),(t+1<NT));       ENDW(t);   RESC(); ROT();
    STEP(pA0,pA1,pB0,pB1,t+1,(t+4<NT),(t+2<NT),(t+2<NT));     ENDW(t+1); RESC(); ROT();
  }
  STEP(pB0,pB1,pA0,pA1,NT-1,false,false,false); RESC();
  { float sacc=pB0[0]+pB0[1]; _Pragma("unroll") for(int r=2;r<16;++r)sacc+=pB0[r]; _Pragma("unroll") for(int r=0;r<16;++r)sacc+=pB1[r]; l_reg+=sacc;
    pw0=(u32x4){PKW(pB0,0),PKW(pB0,2),PKW(pB0,4),PKW(pB0,6)};pw1=(u32x4){PKW(pB0,8),PKW(pB0,10),PKW(pB0,12),PKW(pB0,14)};pw2=(u32x4){PKW(pB1,0),PKW(pB1,2),PKW(pB1,4),PKW(pB1,6)};pw3=(u32x4){PKW(pB1,8),PKW(pB1,10),PKW(pB1,12),PKW(pB1,14)};
    SBAR(); pv(o,vb0+sl_cur,PAF(0),PAF(1),PAF(2),PAF(3)); }
  #undef PKW
  #undef PAF
  #undef VFR
  #undef PIN
  #undef MX3
  #undef GAPA
  #undef GAPB
  #undef EX
  #undef VRD
  #undef KRD
  #undef STEP
  #undef ENDW
  {auto rr=__builtin_amdgcn_permlane32_swap(__float_as_uint(l_reg),__float_as_uint(l_reg),false,false);l_reg=__uint_as_float(rr[0])+__uint_as_float(rr[1]);}
  if(hi==0)wsf[32+r32]=l_reg;asm volatile("s_waitcnt lgkmcnt(0)":::"memory");
  float rli[16];
  #pragma unroll
  for(int r=0;r<16;++r)rli[r]=__builtin_amdgcn_rcpf(wsf[32+crow(r,hi)]);
  bf16*Ow=O+(qrow0+wid*QBLK)*QP+h*D;
  { bf16*stg=(bf16*)(shm+LDS_OST)+wid*2048;
    #pragma unroll
    for(int r=0;r<16;++r){const int orow=crow(r,hi);
      #pragma unroll
      for(int d0=0;d0<2;++d0)stg[orow*64+d0*32+r32]=__float2bfloat16(o[d0][r]*rli[r]);}
    asm volatile("s_waitcnt lgkmcnt(0)":::"memory");
    #pragma unroll
    for(int i=0;i<4;++i){const int row=i*8+(lane>>3),ch=lane&7; const u32x4 v=*(const u32x4*)(stg+row*64+ch*8); ATTN_STORE16(Ow+(long)row*QP+ch*8,v);} }
  asm volatile("s_waitcnt lgkmcnt(0)\n\ts_barrier":::"memory");
  #undef DMA_K
  #undef DMA_V
  #undef CMASK
  #undef START
  #undef RESC
  #undef ROT
}
constexpr int ATTN_LDS_BYTES=LDS_BYTES;
struct AttnTensors { const bf16* Q; const bf16* K; const bf16* V; bf16* O; };
template<int THRL=8> __device__ __forceinline__ void attn_phase(char*lds,const AttnTensors&T,const QPre&QN,int G,int vcu,bool with_ctx,long ctx_row0){
  const int total=4*NHEAD*NQB;
  for(int i=0;;++i){
    int x,n;
    if(G==256){ if(i>=4)break; x=vcu>>5; n=i*32+(vcu&31); }
    else { const int u=i*G+vcu; if(u>=total)break; x=u>>7; n=u&127; }
    const int b=x>>1,kvh=x&1,h=kvh*4+(n>>5),qb=n&31;
    attn_unit<THRL>(b,h,(long)b*SEQQ+(long)qb*QB,SEQK/KVBLK,qb*QB,QN,T.Q,T.K,T.V,T.O,lds);
  }
  if(with_ctx){
    for(int u=vcu;u<4*NHEAD;u+=G){ const int b=u>>3,h=u&7; attn_unit<THRL>(b,h,ctx_row0+(long)b*256,4,-1,QN,T.Q,T.K,T.V,T.O,lds); }
  }
}
#undef SBAR
#undef WAIT_BAR
}

constexpr int NWAVES = 8, NTHR = 512;
constexpr int DMODEL = 1024, NB = 4, SEQ = 8192, CTXL = 256, NLAT = NB * SEQ, NCTX = NB * CTXL, MT = NLAT + NCTX;
constexpr int INW = 2048, NE = 32, KEYS = SEQ + CTXL;
constexpr int SORT_TILES = 560, SORT_ROWS = SORT_TILES * 256;
constexpr float EPSN = 1e-6f;
constexpr int NCHUNK = 66, CHUNK = 128;
constexpr int NPH_PRO = 2, NPH_LAYER = 13, NPH = NPH_PRO + 2 * NPH_LAYER;

constexpr size_t MiB = 1u << 20;
constexpr size_t WS_CTL = 0, CTL_ZERO_BYTES = 1 * MiB;
constexpr size_t WS_MOD = 1 * MiB, WS_ROPEC = 2 * MiB, WS_ROPES = 3 * MiB, WS_H2 = 4 * MiB, WS_KFC = 10 * MiB, WS_BLKCNT = 12 * MiB, WS_TILEE = 13 * MiB, WS_SCANS = 14 * MiB;
constexpr size_t WS_WINT = 16 * MiB, WS_WOUTT = 24 * MiB, WS_W1T = 32 * MiB, WS_W2T = 288 * MiB, WS_KF = 416 * MiB, WS_KHAT = 448 * MiB, WS_XR = 512 * MiB, WS_H = 644 * MiB;
constexpr size_t WS_U = 712 * MiB, WS_Q = 844 * MiB, WS_K = 877 * MiB, WS_V = 886 * MiB, WS_ATT = 895 * MiB, WS_LAB = 928 * MiB, WS_LRUO = 1060 * MiB, WS_VT = 1093 * MiB, WS_X0T = 1125 * MiB,
                 WS_HYO = 1157 * MiB, WS_MIXA = 1190 * MiB;
constexpr size_t WS_WGT = 11 * MiB, WS_SPT = 10 * MiB + 768 * 1024, WS_XL = 1256 * MiB;
constexpr size_t WS_GC = 10 * MiB + 896 * 1024;
constexpr size_t WS_CB = 10 * MiB + 960 * 1024;
constexpr size_t WS_F = 712 * MiB, WS_ASORT = 778 * MiB, WS_ACT = 1058 * MiB, WS_YS = 1338 * MiB, WS_TOPI = 1618 * MiB, WS_GATE = 1619 * MiB, WS_POS = 1620 * MiB, WS_RSSP = 1622 * MiB, WS_ROWTOK = 1625 * MiB, WS_END = 1626 * MiB;
constexpr size_t LAB_STRIDE = (size_t)MT * 256;
constexpr int CW_BAR = 4096;
constexpr int CW_NTILES = 64;

constexpr int RING_OFF = 0, RING_BYTES = 131072, MOETAB_OFF = 131072, LDSCTL_OFF = 155648, LDS_BYTES = 156160;

#define GAS __attribute__((address_space(1)))
#define LAS __attribute__((address_space(3)))
typedef unsigned short bf16;
typedef unsigned v4u __attribute__((ext_vector_type(4)));
typedef unsigned v2u __attribute__((ext_vector_type(2)));
typedef float f32x4 __attribute__((ext_vector_type(4)));
#define LDS_WAIT() asm volatile("s_waitcnt lgkmcnt(0)" ::: "memory")
#define VM_WAIT() asm volatile("s_waitcnt vmcnt(0)" ::: "memory")
__device__ __forceinline__ unsigned f2bf(float f) { unsigned u = __builtin_bit_cast(unsigned, f); return (u + 0x7fffu + ((u >> 16) & 1u)) >> 16; }
__device__ __forceinline__ unsigned pk2(float lo, float hi) { return f2bf(lo) | (f2bf(hi) << 16); }
__device__ __forceinline__ float bf2f(unsigned short b) { return __builtin_bit_cast(float, (unsigned)b << 16); }
__device__ __forceinline__ float bflo(unsigned w) { return __builtin_bit_cast(float, w << 16); }
__device__ __forceinline__ float bfhi(unsigned w) { return __builtin_bit_cast(float, w & 0xffff0000u); }
__device__ __forceinline__ float wave_sum(float v) {
#pragma unroll
    for (int o = 1; o < 64; o <<= 1) v += __shfl_xor(v, o);
    return v;
}
__device__ __forceinline__ float sigmoidf_(float x) { return 1.0f / (1.0f + __expf(-x)); }
__device__ __forceinline__ void sincos_d(double x, double& s, double& c) {
    const double kd = __builtin_rint(x * 0.63661977236758134308);
    const int k = (int)kd;
    double r = __builtin_fma(-kd, 1.57079632673412561417e+00, x);
    r = __builtin_fma(-kd, 6.07710050650619224932e-11, r);
    const double z = r * r;
    const double ps = r + r * z * (-1.66666666666666324348e-01 + z * (8.33333333332248946124e-03 + z * (-1.98412698298579493134e-04 + z * (2.75573137070700676789e-06 + z * (-2.50507602534068634195e-08 + z * 1.58969099521155010221e-10)))));
    const double pc = 1.0 - 0.5 * z + z * z * (4.16666666666666019037e-02 + z * (-1.38888888888741095749e-03 + z * (2.48015872894767294178e-05 + z * (-2.75573143513906633035e-07 + z * (2.08757232129817482790e-09 + z * -1.13596475577881948265e-11)))));
    const int q = k & 3;
    s = (q == 0) ? ps : (q == 1) ? pc : (q == 2) ? -ps : -pc;
    c = (q == 0) ? pc : (q == 1) ? -ps : (q == 2) ? -pc : ps;
}
__device__ __forceinline__ float gelu_tanh(float x) {
    const float u = 0.7978845608028654f * (x + 0.044715f * x * x * x);
    const float t = 1.0f - 2.0f / (1.0f + __expf(2.0f * u));
    return 0.5f * x * (1.0f + t);
}
__device__ __forceinline__ int lds_add(LAS int* p, int v) { return __hip_atomic_fetch_add(p, v, __ATOMIC_RELAXED, __HIP_MEMORY_SCOPE_WORKGROUP); }

#define FFT_FN __device__ __forceinline__
typedef float f32x2v __attribute__((ext_vector_type(2)));
#define FFT_VEC2 f32x2v
#define FFT_DPTR LAS f32x2v*
#define FFT_LD(D, i) c32_from((D)[i])
#define FFT_ST(D, i, v) ((D)[i] = c32_to(v))
struct __attribute__((aligned(8))) c32 { float x, y; };
FFT_FN c32 cmul(c32 a, c32 b) { c32 r; r.x = a.x * b.x - a.y * b.y; r.y = a.x * b.y + a.y * b.x; return r; }
FFT_FN c32 cadd(c32 a, c32 b) { c32 r; r.x = a.x + b.x; r.y = a.y + b.y; return r; }
FFT_FN c32 csub(c32 a, c32 b) { c32 r; r.x = a.x - b.x; r.y = a.y - b.y; return r; }
FFT_FN c32 cmuli_neg(c32 a) { c32 r; r.x = a.y; r.y = -a.x; return r; }
FFT_FN int fpad(int a) { return a + (a >> 4); }
#ifdef FFT_VEC2
FFT_FN c32 c32_from(FFT_VEC2 t) { c32 r; r.x = t.x; r.y = t.y; return r; }
FFT_FN FFT_VEC2 c32_to(c32 a) { FFT_VEC2 t; t.x = a.x; t.y = a.y; return t; }
#endif
FFT_FN void dft4(c32& a0, c32& a1, c32& a2, c32& a3) {
    const c32 s02 = cadd(a0, a2), d02 = csub(a0, a2), s13 = cadd(a1, a3), d13 = cmuli_neg(csub(a1, a3));
    a0 = cadd(s02, s13); a2 = csub(s02, s13); a1 = cadd(d02, d13); a3 = csub(d02, d13);
}
FFT_FN void dft16(c32 (&v)[16]) {
    const float C1 = 0.92387953251128674f, S1 = 0.38268343236508977f, C2 = 0.70710678118654752f;
#pragma unroll
    for (int q2 = 0; q2 < 4; ++q2) dft4(v[q2], v[4 + q2], v[8 + q2], v[12 + q2]);
    { c32 w;
      w.x = C1; w.y = -S1; v[4 * 1 + 1] = cmul(v[4 * 1 + 1], w);
      w.x = C2; w.y = -C2; v[4 * 2 + 1] = cmul(v[4 * 2 + 1], w);
      w.x = S1; w.y = -C1; v[4 * 3 + 1] = cmul(v[4 * 3 + 1], w);
      w.x = C2; w.y = -C2; v[4 * 1 + 2] = cmul(v[4 * 1 + 2], w);
      v[4 * 2 + 2] = cmuli_neg(v[4 * 2 + 2]);
      w.x = -C2; w.y = -C2; v[4 * 3 + 2] = cmul(v[4 * 3 + 2], w);
      w.x = S1; w.y = -C1; v[4 * 1 + 3] = cmul(v[4 * 1 + 3], w);
      w.x = -C2; w.y = -C2; v[4 * 2 + 3] = cmul(v[4 * 2 + 3], w);
      w.x = -C1; w.y = S1; v[4 * 3 + 3] = cmul(v[4 * 3 + 3], w); }
#pragma unroll
    for (int p1 = 0; p1 < 4; ++p1) dft4(v[4 * p1 + 0], v[4 * p1 + 1], v[4 * p1 + 2], v[4 * p1 + 3]);
#pragma unroll
    for (int a = 0; a < 4; ++a)
#pragma unroll
        for (int b = a + 1; b < 4; ++b) { const c32 t = v[4 * a + b]; v[4 * a + b] = v[4 * b + a]; v[4 * b + a] = t; }
}
FFT_FN c32 twid(int j, int n) { float rev = (float)j / (float)n; asm volatile("" : "+v"(rev)); c32 w; w.x = __builtin_amdgcn_cosf(rev); w.y = -__builtin_amdgcn_sinf(rev); return w; }

FFT_FN void fft_fwd16(FFT_DPTR D, int g, int n) {
    const int s = n >> 4, blk = g / s, j = g - blk * s, base = blk * n + j;
    c32 v[16];
#pragma unroll
    for (int q = 0; q < 16; ++q) v[q] = FFT_LD(D, fpad(base + q * s));
    dft16(v);
    const c32 w = twid(j, n); c32 wp = w;
#pragma unroll
    for (int p = 1; p < 16; ++p) { v[p] = cmul(v[p], wp); wp = cmul(wp, w); }
#pragma unroll
    for (int p = 0; p < 16; ++p) FFT_ST(D, fpad(base + p * s), v[p]);
}
FFT_FN void fft_inv16(FFT_DPTR D, int g, int n) {
    const int s = n >> 4, blk = g / s, j = g - blk * s, base = blk * n + j;
    c32 v[16];
#pragma unroll
    for (int q = 0; q < 16; ++q) v[q] = FFT_LD(D, fpad(base + q * s));
    const c32 w = twid(j, n); c32 wp = w;
#pragma unroll
    for (int p = 1; p < 16; ++p) { v[p] = cmul(v[p], wp); wp = cmul(wp, w); }
    dft16(v);
#pragma unroll
    for (int p = 0; p < 16; ++p) FFT_ST(D, fpad(base + p * s), v[p]);
}
FFT_FN void fft_mid16(FFT_DPTR D, int g, const c32* KH) {
    c32 v[16];
#pragma unroll
    for (int q = 0; q < 16; ++q) v[q] = FFT_LD(D, 17 * g + q);
    dft16(v);
#pragma unroll
    for (int p = 0; p < 16; ++p) { const c32 k = KH[16 * g + p]; const c32 t = cmul(v[p], k); v[p].x = t.x; v[p].y = -t.y; }
    dft16(v);
#pragma unroll
    for (int p = 0; p < 16; ++p) FFT_ST(D, 17 * g + p, v[p]);
}
FFT_FN void fft_last16_out(FFT_DPTR D, int g, c32* OUT, float scale) {
    c32 v[16];
#pragma unroll
    for (int q = 0; q < 16; ++q) v[q] = FFT_LD(D, 17 * g + q);
    dft16(v);
#pragma unroll
    for (int p = 0; p < 16; ++p) { c32 t; t.x = v[p].x * scale; t.y = v[p].y * scale; OUT[16 * g + p] = t; }
}
FFT_FN void fft_first4(FFT_DPTR D, int j, c32 x0, c32 x1, c32 x2, c32 x3) {
    dft4(x0, x1, x2, x3);
    const c32 w = twid(j, 16384), w2 = cmul(w, w), w3 = cmul(w2, w);
    FFT_ST(D, fpad(j), x0); FFT_ST(D, fpad(j + 4096), cmul(x1, w)); FFT_ST(D, fpad(j + 8192), cmul(x2, w2)); FFT_ST(D, fpad(j + 12288), cmul(x3, w3));
}
FFT_FN void fft_final4(FFT_DPTR D, int j, c32& u0, c32& u1) {
    const c32 w = twid(j, 16384), w2 = cmul(w, w), w3 = cmul(w2, w);
    c32 a0 = FFT_LD(D, fpad(j)), a1 = cmul(FFT_LD(D, fpad(j + 4096)), w), a2 = cmul(FFT_LD(D, fpad(j + 8192)), w2), a3 = cmul(FFT_LD(D, fpad(j + 12288)), w3);
    dft4(a0, a1, a2, a3);
    u0 = a0; u1 = a1;
}
FFT_FN void fft_first4_inplace(FFT_DPTR D, int j) {
    c32 x0 = FFT_LD(D, fpad(j)), x1 = FFT_LD(D, fpad(j + 4096)), x2 = FFT_LD(D, fpad(j + 8192)), x3 = FFT_LD(D, fpad(j + 12288));
    fft_first4(D, j, x0, x1, x2, x3);
}
#define XB_TMO      128
#define XB_XCNT(j)  (256  + 64 * (j))
#define XB_XSUB(j)  (1280 + 64 * (j))
#define XB_XGEN(j)  (2304 + 64 * (j))
#define XB_TOP      3328
#define XB_TOPGEN   3392
#define XCD_BAR_WORDS 3456
#define XB_SPIN_CAP (1u << 22)

__device__ __forceinline__ unsigned xb_ld(unsigned* p)              { return __hip_atomic_load(p, __ATOMIC_RELAXED, __HIP_MEMORY_SCOPE_AGENT); }
__device__ __forceinline__ unsigned xb_add(unsigned* p, unsigned v) { return __hip_atomic_fetch_add(p, v, __ATOMIC_RELAXED, __HIP_MEMORY_SCOPE_AGENT); }
__device__ __forceinline__ unsigned xb_xcc_id() { return (unsigned)__builtin_amdgcn_s_getreg((3 << 11) | 20) & 0xFu; }
#define XB_SPIN(cond, bar) do { unsigned _sp = 0; while (cond) { __builtin_amdgcn_s_sleep(1); \
    if ((++_sp & 255u) == 0u) { if (xb_ld(&(bar)[XB_TMO])) break; if (_sp > XB_SPIN_CAP) { atomicAdd(&(bar)[XB_TMO], 1u); break; } } } } while (0)

struct XcdBarrier {
    unsigned* bar; unsigned x;
    volatile LAS unsigned* st;
};

__device__ __forceinline__ XcdBarrier xcd_barrier_post(unsigned* bar, volatile LAS unsigned* st) {
    XcdBarrier b; b.bar = bar; b.x = xb_xcc_id(); b.st = st;
    if (threadIdx.x == 0) (void)xb_add(&bar[XB_XCNT(b.x)], 1u);
    return b;
}
__device__ __forceinline__ void xcd_barrier_complete(unsigned* bar, unsigned x, unsigned& nloc, unsigned& nx) {
    const unsigned G = gridDim.x * gridDim.y * gridDim.z;
    unsigned sum, cnt, mine, sp = 0u;
    for (;;) {
        sum = 0u; cnt = 0u; mine = 0u;
#pragma unroll
        for (unsigned j = 0; j < 16; ++j) { const unsigned c = xb_ld(&bar[XB_XCNT(j)]); sum += c; cnt += (c > 0u) ? 1u : 0u; mine = (j == x) ? c : mine; }
        if (sum == G) break;
        __builtin_amdgcn_s_sleep(1);
        if ((++sp & 255u) == 0u) { if (xb_ld(&bar[XB_TMO])) break; if (sp > XB_SPIN_CAP) { atomicAdd(&bar[XB_TMO], 1u); break; } }
    }
    nloc = mine > 0u ? mine : 1u; nx = cnt > 0u ? cnt : 1u;
}

__device__ __forceinline__ void xcd_barrier(const XcdBarrier& b) {
    asm volatile("s_waitcnt vmcnt(0)" ::: "memory");
    __syncthreads();
    if (threadIdx.x == 0) {
        unsigned* bar = b.bar;
        __builtin_amdgcn_s_waitcnt(0);
        unsigned nloc = b.st[0], nx = b.st[1];
        if (nloc == 0u) { xcd_barrier_complete(bar, b.x, nloc, nx); b.st[0] = nloc; b.st[1] = nx; }
        const unsigned old = xb_add(&bar[XB_XSUB(b.x)], 1u);
        const unsigned gen = old / nloc;
        if (old + 1u == (gen + 1u) * nloc) {
            __builtin_amdgcn_fence(__ATOMIC_RELEASE, "agent");
            asm volatile("s_waitcnt vmcnt(0)" ::: "memory");
            const unsigned og = xb_add(&bar[XB_TOP], 1u);
            const unsigned tg = og / nx;
            if (og + 1u == (tg + 1u) * nx) xb_add(&bar[XB_TOPGEN], 1u);
            else XB_SPIN(xb_ld(&bar[XB_TOPGEN]) == tg, bar);
            __builtin_amdgcn_fence(__ATOMIC_ACQUIRE, "agent");
            xb_add(&bar[XB_XGEN(b.x)], 1u);
            asm volatile("s_waitcnt vmcnt(0)" ::: "memory");
        } else {
            XB_SPIN(xb_ld(&bar[XB_XGEN(b.x)]) == gen, bar);
            __builtin_amdgcn_fence(__ATOMIC_ACQUIRE, "agent");
            asm volatile("s_waitcnt vmcnt(0)" ::: "memory");
        }
    }
    __syncthreads();
}


struct Frame {
    LAS unsigned char* lds; unsigned* ctl; unsigned char* ws;
    int tid, lane, wave, vcu, G, gw, ngw;
};
__device__ const float ROPE_INV[16] = {1.0f, 0.5623413251903491f, 0.31622776601683794f, 0.1778279410038923f, 0.1f, 0.05623413251903491f, 0.03162277660168379f, 0.01778279410038923f,
                                       0.01f, 0.005623413251903491f, 0.0031622776601683794f, 0.001778279410038923f, 0.001f, 0.0005623413251903491f, 0.00031622776601683794f, 0.0001778279410038923f};

__device__ __forceinline__ void p0_transpose_item(const float* W, int K, int N, bf16* WT, LAS float* scr, int item, int lane) {
    const int nblk = N / 32, kb = item / nblk, nb = item % nblk, k0 = 64 * kb, n0 = 32 * nb;
#pragma unroll 8
    for (int i = 0; i < 32; ++i) { const int kk = 2 * i + (lane >> 5); scr[kk * 33 + (lane & 31)] = W[(size_t)(k0 + kk) * N + n0 + (lane & 31)]; }
    LDS_WAIT(); asm volatile("" ::: "memory");
    const int c = lane & 7;
#pragma unroll
    for (int j = 0; j < 4; ++j) { const int n = (lane >> 3) + 8 * j; const LAS float* s = scr + (8 * c) * 33 + n;
        v4u o; o.x = pk2(s[0 * 33], s[1 * 33]); o.y = pk2(s[2 * 33], s[3 * 33]); o.z = pk2(s[4 * 33], s[5 * 33]); o.w = pk2(s[6 * 33], s[7 * 33]);
        *(GAS v4u*)(WT + (size_t)(n0 + n) * K + k0 + 8 * c) = o; }
    LDS_WAIT(); asm volatile("" ::: "memory");
}

__device__ __forceinline__ void p0_transpose_item_f8(const float* W, int K, int N, unsigned char* WT, LAS float* scr, int item, int lane) {
    const int nblk = N / 32, kb = item / nblk, nb = item % nblk, k0 = 64 * kb, n0 = 32 * nb;
#pragma unroll 8
    for (int i = 0; i < 32; ++i) { const int kk = 2 * i + (lane >> 5); scr[kk * 33 + (lane & 31)] = W[(size_t)(k0 + kk) * N + n0 + (lane & 31)]; }
    LDS_WAIT(); asm volatile("" ::: "memory");
    const int c = lane & 7;
#pragma unroll
    for (int j = 0; j < 4; ++j) { const int n = (lane >> 3) + 8 * j; const LAS float* s = scr + (8 * c) * 33 + n;
        v2u o; o.x = pg8::pack4_fp8(s[0 * 33] * pg8::F8_SW, s[1 * 33] * pg8::F8_SW, s[2 * 33] * pg8::F8_SW, s[3 * 33] * pg8::F8_SW);
        o.y = pg8::pack4_fp8(s[4 * 33] * pg8::F8_SW, s[5 * 33] * pg8::F8_SW, s[6 * 33] * pg8::F8_SW, s[7 * 33] * pg8::F8_SW);
        *(GAS v2u*)(WT + (size_t)(n0 + n) * K + k0 + 8 * c) = o; }
    LDS_WAIT(); asm volatile("" ::: "memory");
}

__device__ __forceinline__ void ph_prologue_a(const Frame& F, const float* c, const float* cctx, const float* w_mod, const float* b_mod, const float* w_in, const float* w_out,
                                              const float* moe_w1, const float* moe_w2, const float* hy_w1, const float* hy_b1, const float* hy_w2, const float* hy_b2, const float* hy_freq, const float* lru_gw, const float* lru_lam) {
    {
        LAS float* scr = (LAS float*)(F.lds + F.wave * 16384);
        constexpr int I_IN = 2 * 1024, I_OUT = 2 * 512, I_W1 = 64 * 1024, I_W2 = 64 * 512, NIT = I_IN + I_OUT + I_W1 + I_W2;
        bf16* WinT = (bf16*)(F.ws + WS_WINT); bf16* WoutT = (bf16*)(F.ws + WS_WOUTT); bf16* W1T = (bf16*)(F.ws + WS_W1T); bf16* W2T = (bf16*)(F.ws + WS_W2T);
        for (int it = F.gw; it < NIT; it += F.ngw) {
            int r = it;
            if (r < I_IN) { const int m = r >> 10; p0_transpose_item(w_in + (size_t)m * 1024 * 2048, 1024, 2048, WinT + (size_t)m * 2048 * 1024, scr, r & 1023, F.lane); continue; } r -= I_IN;
            if (r < I_OUT) { const int m = r >> 9; p0_transpose_item(w_out + (size_t)m * 1024 * 1024, 1024, 1024, WoutT + (size_t)m * 1024 * 1024, scr, r & 511, F.lane); continue; } r -= I_OUT;
#if MOE_FP8
            if (r < I_W1) { const int m = r >> 10; p0_transpose_item_f8(moe_w1 + (size_t)m * 1024 * 2048, 1024, 2048, (unsigned char*)W1T + (size_t)m * 2048 * 1024, scr, r & 1023, F.lane); continue; } r -= I_W1;
            { const int m = r >> 9; p0_transpose_item_f8(moe_w2 + (size_t)m * 1024 * 1024, 1024, 1024, (unsigned char*)W2T + (size_t)m * 1024 * 1024, scr, r & 511, F.lane); }
#else
            if (r < I_W1) { const int m = r >> 10; p0_transpose_item(moe_w1 + (size_t)m * 1024 * 2048, 1024, 2048, W1T + (size_t)m * 2048 * 1024, scr, r & 1023, F.lane); continue; } r -= I_W1;
            { const int m = r >> 9; p0_transpose_item(moe_w2 + (size_t)m * 1024 * 1024, 1024, 1024, W2T + (size_t)m * 1024 * 1024, scr, r & 511, F.lane); }
#endif
        }
    }
    __syncthreads();
    {
        LAS float* sl = (LAS float*)(F.lds);
        LAS float* red = (LAS float*)(F.lds + 20480);
        float* MOD = (float*)(F.ws + WS_MOD);
        if ((int)blockIdx.x < 192) {
            for (int i = F.tid; i < 5 * 1024; i += NTHR) { const int r = i >> 10, k = i & 1023; const float v = (r < 4) ? c[r * 1024 + k] : cctx[k]; sl[i] = v / (1.0f + __expf(-v)); }
        }
        __syncthreads();
        for (int it = blockIdx.x; it < 192; it += F.G) {
            const int l = it / 96, n = (it % 96) * 64 + F.lane;
            float a0 = 0.f, a1 = 0.f, a2 = 0.f, a3 = 0.f, a4 = 0.f;
            const float* wp = w_mod + ((size_t)l * 1024 + F.wave * 128) * 6144 + n;
#pragma unroll 8
            for (int k = 0; k < 128; ++k) { const float w = wp[(size_t)k * 6144]; const int kk = F.wave * 128 + k;
                a0 += sl[kk] * w; a1 += sl[1024 + kk] * w; a2 += sl[2048 + kk] * w; a3 += sl[3072 + kk] * w; a4 += sl[4096 + kk] * w; }
            red[(F.wave * 5 + 0) * 64 + F.lane] = a0; red[(F.wave * 5 + 1) * 64 + F.lane] = a1; red[(F.wave * 5 + 2) * 64 + F.lane] = a2; red[(F.wave * 5 + 3) * 64 + F.lane] = a3; red[(F.wave * 5 + 4) * 64 + F.lane] = a4;
            __syncthreads();
            if (F.tid < 320) { const int r = F.tid >> 6, ln = F.tid & 63; float s = 0.f;
#pragma unroll
                for (int w = 0; w < 8; ++w) s += red[(w * 5 + r) * 64 + ln];
                const int nn = (it % 96) * 64 + ln; MOD[(size_t)(l * 5 + r) * 6144 + nn] = s + b_mod[l * 6144 + nn]; }
            __syncthreads();
        }
    }
    {
        bf16* WGT = (bf16*)(F.ws + WS_WGT); float* SPT = (float*)(F.ws + WS_SPT);
        for (int idx = blockIdx.x * NTHR + F.tid; idx < 2 * 1024 * 256; idx += F.G * NTHR) {
            const int l = idx >> 18, nidx = (idx >> 8) & 1023, k = idx & 255;
            const int pn = nidx >> 8, j = (nidx >> 7) & 1, cc = nidx & 127, d = pn >> 1, ch = 128 * (pn & 1) + cc, n = ch >> 6, e = ch & 63;
            const float v = ((k >> 6) == n) ? lru_gw[((size_t)((((l * 2 + d) * 2 + j) * 4 + n) * 64 + (k & 63))) * 64 + e] : 0.f;
            WGT[idx] = (bf16)f2bf(v); }
        for (int idx = blockIdx.x * NTHR + F.tid; idx < 2 * 2 * 256; idx += F.G * NTHR) SPT[idx] = log1pf(expf(-lru_lam[idx]));
    }
    {
        float* RC = (float*)(F.ws + WS_ROPEC); float* RS = (float*)(F.ws + WS_ROPES);
        for (int idx = blockIdx.x * NTHR + F.tid; idx < SEQ * 32; idx += F.G * NTHR) {
            const int t = idx >> 5, i = idx & 31; const int pos = (i < 16) ? (t >> 6) : (t & 63);
            const float ang = (float)pos * ROPE_INV[i & 15];
            double s, cc; sincos_d((double)ang, s, cc); RC[idx] = (float)cc; RS[idx] = (float)s; }
    }
    {
        float* H2 = (float*)(F.ws + WS_H2);
        for (int it = F.gw; it < 2 * SEQ + CTXL; it += F.ngw) {
            const int v = it >> 13, t = (v < 2) ? (it & (SEQ - 1)) : (it - 2 * SEQ), L = (v < 2) ? SEQ : CTXL, l = (v == 1) ? 1 : 0;
            const int j = F.lane;
            float z = 0.f;
            if (j == 0) z = (float)t / (float)(L - 1);
            else if (j <= 32) { const int b = (j - 1) & 15; const float band = 1e-4f + (float)b * ((15.0f - 1e-4f) / 15.0f);
                const float ang = ((6.283185307179586f / (float)L) * (float)t) * band;
                double s, cc; sincos_d((double)ang, s, cc); z = (j <= 16) ? (float)cc : -(float)s; }
            const float fr = hy_freq[l * 64 + j];
            float p1 = hy_b1[l * 64 + j];
            const float* w1 = hy_w1 + (size_t)l * 33 * 64;
#pragma unroll
            for (int i = 0; i < 33; ++i) p1 += __shfl(z, i) * w1[i * 64 + j];
            double s1, c1; sincos_d((double)(fr * p1), s1, c1); const float h1 = (float)s1;
            float p2 = hy_b2[l * 64 + j];
            const float* w2 = hy_w2 + (size_t)l * 64 * 64;
#pragma unroll 16
            for (int i = 0; i < 64; ++i) p2 += __shfl(h1, i) * w2[i * 64 + j];
            double s2, c2; sincos_d((double)(fr * p2), s2, c2);
            H2[((size_t)v * SEQ + t) * 64 + j] = (float)s2;
        }
    }
}

__device__ __forceinline__ void ph_prologue_b(const Frame& F, const float* hy_w3, const float* hy_decay, const float* gffn, const float* router_w, const float* router_b) {
    { const float* MOD = (const float*)(F.ws + WS_MOD); float* CB = (float*)(F.ws + WS_CB);
      for (int it = F.gw; it < 2 * 5 * 32; it += F.ngw) { const int lb = it >> 5, e = it & 31, l = lb / 5; const float* sf = MOD + (size_t)lb * 6144 + 3 * 1024; float s = 0.f;
#pragma unroll
          for (int q = 0; q < 16; ++q) { const int cc = 64 * q + F.lane; s += sf[cc] * router_w[(size_t)l * 32768 + cc * 32 + e]; }
          s = wave_sum(s); if (F.lane == 0) CB[it] = s + router_b[l * 32 + e]; } }
    { const float* MOD = (const float*)(F.ws + WS_MOD); float* GC = (float*)(F.ws + WS_GC);
      for (int idx = blockIdx.x * NTHR + F.tid; idx < 2 * 5 * 1024; idx += F.G * NTHR) { const int lb = idx >> 10, cc = idx & 1023, l = lb / 5; GC[idx] = gffn[l * 1024 + cc] * (1.0f + MOD[(size_t)lb * 6144 + 4 * 1024 + cc]); } }
    LAS f32x2v* D = (LAS f32x2v*)(F.lds);
    LAS float* kt = (LAS float*)(F.lds);
    LAS float* w3c = (LAS float*)(F.lds + 139264);
    LAS float* red = (LAS float*)(F.lds + 139264 + 512);
    const float* H2 = (const float*)(F.ws + WS_H2);
    c32* KHAT = (c32*)(F.ws + WS_KHAT); float* KFC = (float*)(F.ws + WS_KFC);
    for (int it = blockIdx.x; it < 768; it += F.G) {
        const int v = it >> 8, c = it & 255, L = (v < 2) ? SEQ : CTXL, l = (v == 1) ? 1 : 0;
        if (F.tid < 128) w3c[F.tid] = hy_w3[(size_t)l * 64 * 512 + (F.tid & 63) * 512 + (F.tid >> 6) * 256 + c];
        if (F.tid == 0) { if (v < 2) { f32x2v z; z.x = 0.f; z.y = 0.f; D[fpad(L)] = z; } else kt[L] = 0.f; }
        __syncthreads();
        const float df = fabsf(hy_decay[l * 512 + c]), db = fabsf(hy_decay[l * 512 + 256 + c]);
        float asum = 0.f;
        for (int t = F.tid; t < L; t += NTHR) {
            const f32x4* row = (const f32x4*)(H2 + ((size_t)v * SEQ + t) * 64);
            float hf = 0.f, hb = 0.f;
#pragma unroll
            for (int q = 0; q < 16; ++q) { const f32x4 h = row[q];
                hf += h.x * w3c[4 * q] + h.y * w3c[4 * q + 1] + h.z * w3c[4 * q + 2] + h.w * w3c[4 * q + 3];
                hb += h.x * w3c[64 + 4 * q] + h.y * w3c[64 + 4 * q + 1] + h.z * w3c[64 + 4 * q + 2] + h.w * w3c[64 + 4 * q + 3]; }
            const float t01 = (float)t / (float)(L - 1);
            hf *= expf(-t01 * df); hb *= expf(-t01 * db);
            asum += fabsf(hf); if (t >= 1) asum += fabsf(hb);
            if (v < 2) { f32x2v z; z.x = hf; z.y = 0.f; D[fpad(t)] = z; if (t >= 1) { z.x = hb; D[fpad(2 * L - t)] = z; } }
            else { kt[t] = hf; if (t >= 1) kt[2 * L - t] = hb; }
        }
        asum = wave_sum(asum);
        if (F.lane == 0) red[F.wave] = asum;
        __syncthreads();
        float tot = 0.f;
#pragma unroll
        for (int w = 0; w < 8; ++w) tot += red[w];
        const float inv = 1.0f / tot;
        if (v < 2) {
            c32* out = KHAT + (size_t)(v * 256 + c) * 16384;
#pragma unroll 1
            for (int i = 0; i < 8; ++i) fft_first4_inplace(D, F.tid + 512 * i);
            __syncthreads();
            { fft_fwd16(D, F.tid, 4096); fft_fwd16(D, F.tid + 512, 4096); }
            __syncthreads();
            { fft_fwd16(D, F.tid, 256); fft_fwd16(D, F.tid + 512, 256); }
            __syncthreads();
            _Pragma("unroll 1") for (int g_ = F.tid; g_ < 1024; g_ += 512) fft_last16_out(D, g_, out, inv * (1.0f / 16384.0f));
        } else {
            float* dst = KFC + (size_t)c * 512;
            for (int j = F.tid; j < 2 * L; j += NTHR) dst[j] = kt[j] * inv;
        }
        __syncthreads();
    }
}

__device__ __forceinline__ void ph_norm_mod(const Frame& F, int l, const float* x, const float* ctx, const float* gmix) {
    const float* XR = (const float*)(F.ws + WS_XR); const float* MOD = (const float*)(F.ws + WS_MOD); bf16* H = (bf16*)(F.ws + WS_H);
    for (int r = F.gw; r < MT; r += F.ngw) {
        const float* src = (l == 0) ? (r < NLAT ? x + (size_t)r * 1024 : ctx + (size_t)(r - NLAT) * 1024) : XR + (size_t)r * 1024;
        const int bidx = r < NLAT ? r / SEQ : 4;
        const float* shift = MOD + (size_t)(l * 5 + bidx) * 6144; const float* scale = shift + 1024; const float* g = gmix + l * 1024;
        f32x4 v[4]; float ss = 0.f;
#pragma unroll
        for (int j = 0; j < 4; ++j) { v[j] = ((const f32x4*)src)[64 * j + F.lane]; ss += (v[j].x * v[j].x + v[j].y * v[j].y) + (v[j].z * v[j].z + v[j].w * v[j].w); }
        const float rstd = 1.0f / sqrtf(wave_sum(ss) * (1.0f / 1024.0f) + EPSN);
#pragma unroll
        for (int j = 0; j < 4; ++j) { const int cb = 64 * j + F.lane; const f32x4 gg = ((const f32x4*)g)[cb], sc = ((const f32x4*)scale)[cb], sh = ((const f32x4*)shift)[cb];
            const f32x4 y = v[j] * rstd * gg * (sc + 1.0f) + sh;
            v2u o; o.x = pk2(y.x, y.y); o.y = pk2(y.z, y.w); ((v2u*)(H + (size_t)r * 1024))[cb] = o; }
    }
}

__device__ __forceinline__ void ph_post_proj(const Frame& F, int l, const float* qg_, const float* kg_, const float* lru_cw, const float* lru_cb, const float* hy_cw, const float* hy_cb) {
    const bf16* U = (const bf16*)(F.ws + WS_U);
    {
        bf16* K = (bf16*)(F.ws + WS_K); bf16* V = (bf16*)(F.ws + WS_V);
        const float* RC = (const float*)(F.ws + WS_ROPEC); const float* RS = (const float*)(F.ws + WS_ROPES);
        const int o8 = 8 * (F.lane & 7), hl = F.lane & 31;
        const f32x4 kg0 = *(const f32x4*)(kg_ + l * 64 + o8), kg1 = *(const f32x4*)(kg_ + l * 64 + o8 + 4);
        const bool lohalf = (F.lane & 4) == 0;
        for (int r2 = 2 * F.gw; r2 < MT; r2 += 2 * F.ngw) {
            const int r = r2 + (F.lane >> 5);
            const bool isctx = r >= NLAT; const int b = isctx ? (r - NLAT) / CTXL : r / SEQ; const int t = isctx ? (r - NLAT) % CTXL : r % SEQ;
            const v4u wk = ((const v4u*)(U + (size_t)r * INW + 512))[hl];
            f32x4 c0 = {1.f, 1.f, 1.f, 1.f}, c1 = c0, s0 = {0.f, 0.f, 0.f, 0.f}, s1 = s0;
            if (!isctx) { const float* rc = RC + t * 32 + 8 * (F.lane & 3); const float* rs = RS + t * 32 + 8 * (F.lane & 3);
                c0 = *(const f32x4*)rc; c1 = *(const f32x4*)(rc + 4); s0 = *(const f32x4*)rs; s1 = *(const f32x4*)(rs + 4); }
            const size_t krow = (size_t)b * KEYS + (isctx ? t : CTXL + t);
            float x[8] = {bflo(wk.x), bfhi(wk.x), bflo(wk.y), bfhi(wk.y), bflo(wk.z), bfhi(wk.z), bflo(wk.w), bfhi(wk.w)};
            float ss = 0.f;
#pragma unroll
            for (int i = 0; i < 8; ++i) ss += x[i] * x[i];
            ss += __shfl_xor(ss, 1); ss += __shfl_xor(ss, 2); ss += __shfl_xor(ss, 4);
            const float rstd = 1.0f / sqrtf(ss * (1.0f / 64.0f) + EPSN);
            float y[8], o[8];
#pragma unroll
            for (int i = 0; i < 8; ++i) y[i] = x[i] * rstd * (i < 4 ? kg0[i] : kg1[i - 4]);
#pragma unroll
            for (int i = 0; i < 8; ++i) { const float p = __shfl_xor(y[i], 4); const float cs = i < 4 ? c0[i] : c1[i - 4], sn = i < 4 ? s0[i] : s1[i - 4];
                o[i] = lohalf ? (y[i] * cs - p * sn) : (y[i] * cs + p * sn); }
            v4u ow; ow.x = pk2(o[0], o[1]); ow.y = pk2(o[2], o[3]); ow.z = pk2(o[4], o[5]); ow.w = pk2(o[6], o[7]);
            if (hl < 16) ((v4u*)(K + krow * 128))[hl] = ow; else ((v4u*)(V + krow * 128))[hl - 16] = wk;
        }
    }
    {
        bf16* XL = (bf16*)(F.ws + WS_XL);
        for (int idx = blockIdx.x * NTHR + F.tid; idx < MT * 32; idx += F.G * NTHR) {
            const int r = idx >> 5, c8 = (idx & 31) * 8;
            const bool isctx = r >= NLAT; const int Ls = isctx ? CTXL : SEQ; const int t = isctx ? (r - NLAT) % CTXL : r % SEQ;
            float acc[8];
#pragma unroll
            for (int i = 0; i < 8; ++i) acc[i] = lru_cb[l * 256 + c8 + i];
#pragma unroll
            for (int j = 0; j < 4; ++j) { const int tj = t + j - 2;
                if (tj >= 0 && tj < Ls) { const v4u w = *(const v4u*)(U + (size_t)(r + j - 2) * INW + 768 + c8);
                    const f32x4 w0 = *(const f32x4*)(lru_cw + (l * 4 + j) * 256 + c8), w1 = *(const f32x4*)(lru_cw + (l * 4 + j) * 256 + c8 + 4);
                    acc[0] += w0.x * bflo(w.x); acc[1] += w0.y * bfhi(w.x); acc[2] += w0.z * bflo(w.y); acc[3] += w0.w * bfhi(w.y);
                    acc[4] += w1.x * bflo(w.z); acc[5] += w1.y * bfhi(w.z); acc[6] += w1.z * bflo(w.w); acc[7] += w1.w * bfhi(w.w); } }
            v4u o; o.x = pk2(acc[0], acc[1]); o.y = pk2(acc[2], acc[3]); o.z = pk2(acc[4], acc[5]); o.w = pk2(acc[6], acc[7]);
            *(v4u*)(XL + (size_t)r * 256 + c8) = o;
        }
    }
    __syncthreads();
    {
        LAS bf16* hs = (LAS bf16*)(F.lds);
        bf16* VT = (bf16*)(F.ws + WS_VT); bf16* X0T = (bf16*)(F.ws + WS_X0T);
        const float* cw = hy_cw + (size_t)l * 3 * 768; const float* cbp = hy_cb + l * 768;
        for (int it = blockIdx.x; it < NLAT / 64; it += F.G) {
            const int b = it >> 7, t0 = (it & 127) * 64;
            for (int i = F.tid; i < 66 * 384; i += NTHR) { const int rr = i / 384, c2 = i - rr * 384; const int t = t0 - 1 + rr;
                unsigned w = 0u; if (t >= 0 && t < SEQ) w = *(const unsigned*)(U + (size_t)(b * SEQ + t) * INW + 1280 + 2 * c2);
                *(LAS unsigned*)(hs + rr * 770 + 2 * c2) = w; }
            __syncthreads();
            for (int c = F.wave; c < 256; c += NWAVES) {
                const int tt = F.lane;
                float o[3];
#pragma unroll
                for (int g = 0; g < 3; ++g) { const int cc = g * 256 + c;
                    o[g] = cw[cc] * bf2f(hs[tt * 770 + cc]) + cw[768 + cc] * bf2f(hs[(tt + 1) * 770 + cc]) + cw[1536 + cc] * bf2f(hs[(tt + 2) * 770 + cc]) + cbp[cc]; }
                const size_t oi = ((size_t)b * 256 + c) * SEQ + t0 + tt;
                VT[oi] = (bf16)f2bf(o[2] * o[1]); X0T[oi] = (bf16)f2bf(o[0]);
            }
            __syncthreads();
        }
    }
}


__device__ __forceinline__ int chunk_row0(int b, int d, int k) {
    if (k < 2) { const int cc = d ? 1 - k : k; return NLAT + b * CTXL + cc * CHUNK; }
    const int lc = d ? 63 - (k - 2) : (k - 2); return b * SEQ + lc * CHUNK;
}
__device__ __forceinline__ void ph_scan1(const Frame& F) {
    const bf16* LAB = (const bf16*)(F.ws + WS_LAB); float* SUMP = (float*)(F.ws + WS_SCANS); float* SUMH = SUMP + NB * 2 * NCHUNK * 256;
    for (int it = blockIdx.x * NTHR + F.tid; it < NB * 2 * NCHUNK * 256; it += F.G * NTHR) {
        const int ch = it & 255, k = (it >> 8) % NCHUNK, bd = (it >> 8) / NCHUNK, d = bd & 1, b = bd >> 1;
        const int r0 = chunk_row0(b, d, k);
        const bf16* LA = LAB + (size_t)(2 * d) * LAB_STRIDE + ch; const bf16* LB = LAB + (size_t)(2 * d + 1) * LAB_STRIDE + ch;
        float h = 0.f, Ps = 0.f;
#pragma unroll 16
        for (int i = 0; i < CHUNK; ++i) { const int r = d ? r0 + CHUNK - 1 - i : r0 + i; const float la = bf2f(LA[(size_t)r * 256]), bx = bf2f(LB[(size_t)r * 256]); h = __builtin_amdgcn_exp2f(la) * h + bx; Ps += la; }
        SUMP[it] = __builtin_amdgcn_exp2f(Ps); SUMH[it] = h;
    }
}
__device__ __forceinline__ void ph_scan2(const Frame& F) {
    const bf16* LAB = (const bf16*)(F.ws + WS_LAB); const float* SUMP = (const float*)(F.ws + WS_SCANS); const float* SUMH = SUMP + NB * 2 * NCHUNK * 256;
    float* LRUO = (float*)(F.ws + WS_LRUO); const bf16* U = (const bf16*)(F.ws + WS_U);
    for (int it = blockIdx.x * NTHR + F.tid; it < NB * NCHUNK * 256; it += F.G * NTHR) {
        const int ch = it & 255, kc = (it >> 8) % NCHUNK, b = (it >> 8) / NCHUNK;
        const int r0 = chunk_row0(b, 0, kc);
#pragma unroll 1
        for (int d = 0; d < 2; ++d) {
            const int k = d ? ((kc < 2) ? 1 - kc : 2 + 63 - (kc - 2)) : kc;
            const size_t sb = (size_t)((b * 2 + d) * NCHUNK) * 256 + ch;
            float h = 0.f;
#pragma unroll 8
            for (int j = 0; j < k; ++j) h = SUMP[sb + (size_t)j * 256] * h + SUMH[sb + (size_t)j * 256];
            const bf16* LA = LAB + (size_t)(2 * d) * LAB_STRIDE + ch; const bf16* LB = LAB + (size_t)(2 * d + 1) * LAB_STRIDE + ch;
            if (d == 0) {
#pragma unroll 16
                for (int i = 0; i < CHUNK; ++i) { const int r = r0 + i; h = __builtin_amdgcn_exp2f(bf2f(LA[(size_t)r * 256])) * h + bf2f(LB[(size_t)r * 256]); LRUO[(size_t)r * 256 + ch] = h; }
            } else {
#pragma unroll 8
                for (int i = 0; i < CHUNK; ++i) { const int r = r0 + CHUNK - 1 - i; h = __builtin_amdgcn_exp2f(bf2f(LA[(size_t)r * 256])) * h + bf2f(LB[(size_t)r * 256]);
                    const float lg = bf2f(U[(size_t)r * INW + 1024 + ch]);
                    LRUO[(size_t)r * 256 + ch] = (LRUO[(size_t)r * 256 + ch] + h) * gelu_tanh(lg); }
            }
        }
    }
}

__device__ __forceinline__ void ph_hyena_fft(const Frame& F, int l, const float* hy_bias) {
    LAS f32x2v* D = (LAS f32x2v*)(F.lds);
    const c32* KHAT = (const c32*)(F.ws + WS_KHAT) + (size_t)l * 256 * 16384;
    const bf16* VT = (const bf16*)(F.ws + WS_VT); const bf16* X0T = (const bf16*)(F.ws + WS_X0T); bf16* HYO = (bf16*)(F.ws + WS_HYO);
    for (int it = blockIdx.x; it < 512; it += F.G) {
        const int c = it >> 1, bp = it & 1;
        const bf16* va = VT + ((size_t)(bp * 2) * 256 + c) * SEQ; const bf16* vb = VT + ((size_t)(bp * 2 + 1) * 256 + c) * SEQ;
#ifndef REP_FFT
#define REP_FFT 1
#endif
#pragma unroll 1
        for (int repf_ = 0; repf_ < REP_FFT; ++repf_) {
#pragma unroll 1
        for (int i = 0; i < 8; ++i) { const int j = F.tid + 512 * i; c32 x0, x1, z; x0.x = bf2f(va[j]); x0.y = bf2f(vb[j]); x1.x = bf2f(va[j + 4096]); x1.y = bf2f(vb[j + 4096]); z.x = 0.f; z.y = 0.f;
            fft_first4(D, j, x0, x1, z, z); }
        __syncthreads();
        { fft_fwd16(D, F.tid, 4096); fft_fwd16(D, F.tid + 512, 4096); }
        __syncthreads();
        { fft_fwd16(D, F.tid, 256); fft_fwd16(D, F.tid + 512, 256); }
        __syncthreads();
        _Pragma("unroll 1") for (int g_ = F.tid; g_ < 1024; g_ += 512) fft_mid16(D, g_, KHAT + (size_t)c * 16384);
        __syncthreads();
        { fft_inv16(D, F.tid, 256); fft_inv16(D, F.tid + 512, 256); }
        __syncthreads();
        { fft_inv16(D, F.tid, 4096); fft_inv16(D, F.tid + 512, 4096); }
        __syncthreads();
        }
        const float bias = hy_bias[l * 256 + c];
        const bf16* xa = X0T + ((size_t)(bp * 2) * 256 + c) * SEQ; const bf16* xb = X0T + ((size_t)(bp * 2 + 1) * 256 + c) * SEQ;
        bf16* oa = HYO + ((size_t)(bp * 2) * 256 + c) * SEQ; bf16* ob = HYO + ((size_t)(bp * 2 + 1) * 256 + c) * SEQ;
#pragma unroll 2
        for (int i = 0; i < 8; ++i) { const int j = F.tid + 512 * i; c32 u0, u1; fft_final4(D, j, u0, u1);
            oa[j] = (bf16)f2bf((u0.x + bf2f(va[j]) * bias) * bf2f(xa[j]));                 ob[j] = (bf16)f2bf((-u0.y + bf2f(vb[j]) * bias) * bf2f(xb[j]));
            oa[j + 4096] = (bf16)f2bf((u1.x + bf2f(va[j + 4096]) * bias) * bf2f(xa[j + 4096])); ob[j + 4096] = (bf16)f2bf((-u1.y + bf2f(vb[j + 4096]) * bias) * bf2f(xb[j + 4096])); }
        __syncthreads();
    }
}
__device__ __forceinline__ void ph_hyena_ctx(const Frame& F, const float* hy_bias, const float* hy_cw, const float* hy_cb) {
    float* HYO = (float*)(F.ws + WS_HYO);
    {

        const bf16* U = (const bf16*)(F.ws + WS_U); const float* KFC = (const float*)(F.ws + WS_KFC);
        LAS float* vw = (LAS float*)(F.lds + F.wave * 4096);
        LAS float* kw = vw + 256;
        const float* cw = hy_cw; const float* cbp = hy_cb;
        for (int it = F.gw; it < NB * 256; it += F.ngw) {
            const int b = it >> 8, c = it & 255;
            float x0v[4];
#pragma unroll
            for (int i = 0; i < 4; ++i) { const int t = F.lane + 64 * i;
                float o[3];
#pragma unroll
                for (int g = 0; g < 3; ++g) { const int cc = g * 256 + c; float a = cbp[cc];
#pragma unroll
                    for (int j = 0; j < 3; ++j) { const int tj = t + j - 1; if (tj >= 0 && tj < CTXL) a += cw[j * 768 + cc] * bf2f(U[(size_t)(NLAT + b * CTXL + tj) * INW + 1280 + cc]); }
                    o[g] = a; }
                vw[t] = o[2] * o[1]; x0v[i] = o[0]; }
#pragma unroll
            for (int i = 0; i < 8; ++i) kw[F.lane + 64 * i] = KFC[c * 512 + F.lane + 64 * i];
            LDS_WAIT();
            float y[4] = {0.f, 0.f, 0.f, 0.f};
#pragma unroll 4
            for (int s = 0; s < CTXL; ++s) { const float vv = vw[s];
#pragma unroll
                for (int i = 0; i < 4; ++i) y[i] += kw[(F.lane + 64 * i - s) & 511] * vv; }
            const float bias = hy_bias[c];
#pragma unroll
            for (int i = 0; i < 4; ++i) { const int t = F.lane + 64 * i; HYO[(size_t)(NLAT + b * CTXL + t) * 256 + c] = (y[i] + vw[t] * bias) * x0v[i]; }
            LDS_WAIT();
        }
    }
}

__device__ __forceinline__ void merge_row(const Frame& F, int r, const float* g, float h0, float h1, float h2, float h3) {
    const bf16* ATT = (const bf16*)(F.ws + WS_ATT); const float* LRUO = (const float*)(F.ws + WS_LRUO); bf16* MIXA = (bf16*)(F.ws + WS_MIXA);
    const v4u aw = ((const v4u*)(ATT + (size_t)r * 512))[F.lane];
    float a[8] = {bflo(aw.x), bfhi(aw.x), bflo(aw.y), bfhi(aw.y), bflo(aw.z), bfhi(aw.z), bflo(aw.w), bfhi(aw.w)};
    float ss = 0.f;
#pragma unroll
    for (int i = 0; i < 8; ++i) ss += a[i] * a[i];
    const float ra = 1.0f / sqrtf(wave_sum(ss) * (1.0f / 512.0f) + EPSN);
    const f32x4 lv = ((const f32x4*)(LRUO + (size_t)r * 256))[F.lane];
    const float rl = 1.0f / sqrtf(wave_sum(lv.x * lv.x + lv.y * lv.y + lv.z * lv.z + lv.w * lv.w) * (1.0f / 256.0f) + EPSN);
    const float rh = 1.0f / sqrtf(wave_sum(h0 * h0 + h1 * h1 + h2 * h2 + h3 * h3) * (1.0f / 256.0f) + EPSN);
    bf16* orow = MIXA + (size_t)r * 1024;
    { const f32x4 g0 = ((const f32x4*)g)[2 * F.lane], g1 = ((const f32x4*)g)[2 * F.lane + 1];
      v4u o; o.x = pk2(a[0] * ra * g0.x, a[1] * ra * g0.y); o.y = pk2(a[2] * ra * g0.z, a[3] * ra * g0.w); o.z = pk2(a[4] * ra * g1.x, a[5] * ra * g1.y); o.w = pk2(a[6] * ra * g1.z, a[7] * ra * g1.w);
      ((v4u*)orow)[F.lane] = o; }
    { const f32x4 gg = ((const f32x4*)(g + 512))[F.lane]; v2u o; o.x = pk2(lv.x * rl * gg.x, lv.y * rl * gg.y); o.y = pk2(lv.z * rl * gg.z, lv.w * rl * gg.w); ((v2u*)(orow + 512))[F.lane] = o; }
    orow[768 + F.lane] = (bf16)f2bf(h0 * rh * g[768 + F.lane]); orow[832 + F.lane] = (bf16)f2bf(h1 * rh * g[832 + F.lane]);
    orow[896 + F.lane] = (bf16)f2bf(h2 * rh * g[896 + F.lane]); orow[960 + F.lane] = (bf16)f2bf(h3 * rh * g[960 + F.lane]);
}
__device__ __forceinline__ void ph_merge(const Frame& F, int l, int nrows, const float* out_g) {
    const float* HYO = (const float*)(F.ws + WS_HYO);
    const float* g = out_g + l * 1024;
    LAS float* tile = (LAS float*)(F.lds);
    for (int it = blockIdx.x; it < NLAT / 64; it += F.G) {
        const int b = it >> 7, t0 = (it & 127) * 64;
#pragma unroll 8
        for (int i = 0; i < 32; ++i) { const int c = F.wave * 32 + i; tile[c * 65 + F.lane] = bf2f(((const bf16*)HYO)[((size_t)b * 256 + c) * SEQ + t0 + F.lane]); }
        __syncthreads();
#pragma unroll 2
        for (int k = 0; k < 8; ++k) { const int tt = F.wave * 8 + k;
            merge_row(F, b * SEQ + t0 + tt, g, tile[F.lane * 65 + tt], tile[(F.lane + 64) * 65 + tt], tile[(F.lane + 128) * 65 + tt], tile[(F.lane + 192) * 65 + tt]); }
        __syncthreads();
    }
    for (int r = NLAT + F.gw; r < nrows; r += F.ngw) {
        const float* hr = HYO + (size_t)r * 256;
        merge_row(F, r, g, hr[F.lane], hr[64 + F.lane], hr[128 + F.lane], hr[192 + F.lane]);
    }
}


__device__ __forceinline__ void ph_ffn_router(const Frame& F, int l, int nrows, const float* router_w) {
    LAS float* rwl = (LAS float*)(F.lds);
    LAS float* cbl = (LAS float*)(F.lds + 147456);
    LAS int* hist = (LAS int*)(F.lds + 147456 + 640);
    const bf16* XR = (const bf16*)(F.ws + WS_XR); const float* RSSP = (const float*)(F.ws + WS_RSSP); const float* MOD = (const float*)(F.ws + WS_MOD);
    const float* GC = (const float*)(F.ws + WS_GC) + (size_t)l * 5 * 1024; bf16* Fb = (bf16*)(F.ws + WS_F);
    int* TOPI = (int*)(F.ws + WS_TOPI); float* GATE = (float*)(F.ws + WS_GATE); int* BLKCNT = (int*)(F.ws + WS_BLKCNT);
    for (int i = F.tid; i < 1024 * 32; i += NTHR) rwl[(i >> 5) * 36 + (i & 31)] = router_w[(size_t)l * 32768 + i];
    if (F.tid < 32) hist[F.tid] = 0;
    if (F.tid < 160) cbl[F.tid] = ((const float*)(F.ws + WS_CB))[l * 160 + F.tid];
    __syncthreads();
    const int j = F.lane & 15, kq = F.lane >> 4;
    for (int grp = F.gw; grp < nrows / 16; grp += F.ngw) {
        const int r0 = grp * 16, r = r0 + j; const int bidx = r0 < NLAT ? r0 / SEQ : 4;
        const bf16* xrow = XR + (size_t)r * 1024 + 4 * kq; const float* gcp = GC + bidx * 1024 + 4 * kq; const float* sfp = MOD + (size_t)(l * 5 + bidx) * 6144 + 3 * 1024 + 4 * kq;
        bf16* frow = Fb + (size_t)r * 1024 + 4 * kq;
        float ss; { const f32x4 q = *(const f32x4*)(RSSP + (size_t)r * 16 + 4 * kq); ss = (q.x + q.y) + (q.z + q.w); }
        ss += __shfl_xor(ss, 16); ss += __shfl_xor(ss, 32);
        const float rstd = 1.0f / sqrtf(ss * (1.0f / 1024.0f) + EPSN);
        f32x4 acc0 = {0.f, 0.f, 0.f, 0.f}, acc1 = acc0;
#pragma unroll 1
        for (int ib = 0; ib < 64; ib += 8) {
            v2u xw[8]; f32x4 g4[8], s4[8];
#pragma unroll
            for (int u = 0; u < 8; ++u) { xw[u] = *(const v2u*)(xrow + 16 * (ib + u)); g4[u] = *(const f32x4*)(gcp + 16 * (ib + u)); s4[u] = *(const f32x4*)(sfp + 16 * (ib + u)); }
#pragma unroll
            for (int u = 0; u < 8; ++u) {
                const f32x4 x4 = {bflo(xw[u].x), bfhi(xw[u].x), bflo(xw[u].y), bfhi(xw[u].y)};
                const f32x4 xb = x4 * g4[u];
                const f32x4 fv = xb * rstd + s4[u];
#if MOE_FP8
                *(unsigned*)((unsigned char*)Fb + (size_t)r * 1024 + 4 * kq + 16 * (ib + u)) = pg8::pack4_fp8(fv.x * pg8::F8_SF, fv.y * pg8::F8_SF, fv.z * pg8::F8_SF, fv.w * pg8::F8_SF);
#else
                v2u o; o.x = pk2(fv.x, fv.y); o.y = pk2(fv.z, fv.w); *(v2u*)(frow + 16 * (ib + u)) = o;
#endif
                const LAS float* wp = rwl + (16 * (ib + u) + 4 * kq) * 36 + j;
#pragma unroll
                for (int e = 0; e < 4; ++e) { acc0 = __builtin_amdgcn_mfma_f32_16x16x4f32(wp[e * 36], xb[e], acc0, 0, 0, 0); acc1 = __builtin_amdgcn_mfma_f32_16x16x4f32(wp[e * 36 + 16], xb[e], acc1, 0, 0, 0); }
            }
        }
        float lg[8];
#pragma unroll
        for (int rr = 0; rr < 4; ++rr) { lg[rr] = rstd * acc0[rr] + cbl[bidx * 32 + 4 * kq + rr]; lg[4 + rr] = rstd * acc1[rr] + cbl[bidx * 32 + 16 + 4 * kq + rr]; }
        float p[32];
#pragma unroll
        for (int e = 0; e < 32; ++e) p[e] = __shfl(lg[(e >> 4) * 4 + (e & 3)], j + 16 * ((e & 15) >> 2));
        unsigned taken = 0u; float tv[4]; int ti[4];
#pragma unroll
        for (int k = 0; k < 4; ++k) { float best = -INFINITY; int bi = 0;
#pragma unroll
            for (int e = 0; e < 32; ++e) { const bool ok = !((taken >> e) & 1u) && (p[e] > best); best = ok ? p[e] : best; bi = ok ? e : bi; }
            taken |= 1u << bi; tv[k] = best; ti[k] = bi; }
        const float e1 = __expf(tv[1] - tv[0]), e2 = __expf(tv[2] - tv[0]), e3 = __expf(tv[3] - tv[0]); const float inv = 1.0f / (1.0f + e1 + e2 + e3);
        if (kq == 0) {
            TOPI[r * 4 + 0] = ti[0]; TOPI[r * 4 + 1] = ti[1]; TOPI[r * 4 + 2] = ti[2]; TOPI[r * 4 + 3] = ti[3];
            GATE[r * 4 + 0] = inv; GATE[r * 4 + 1] = e1 * inv; GATE[r * 4 + 2] = e2 * inv; GATE[r * 4 + 3] = e3 * inv;
            lds_add(&hist[ti[0]], 1); lds_add(&hist[ti[1]], 1); lds_add(&hist[ti[2]], 1); lds_add(&hist[ti[3]], 1);
        }
    }
    __syncthreads();
    if (F.tid < 32) BLKCNT[blockIdx.x * 32 + F.tid] = hist[F.tid];
}

__device__ __forceinline__ void ph_route(const Frame& F, int nrows) {
    LAS int* cursor = (LAS int*)(F.lds);
    LAS int* tot = cursor + 32;
    LAS int* mine = cursor + 64;
    LAS int* part = cursor + 96;
    LAS int* ebase = cursor + 96 + 1024;
    const int* BLKCNT = (const int*)(F.ws + WS_BLKCNT); const int* TOPI = (const int*)(F.ws + WS_TOPI); int* POS = (int*)(F.ws + WS_POS);
    int* ROWTOK = (int*)(F.ws + WS_ROWTOK); int* TILEE = (int*)(F.ws + WS_TILEE);
    { const int e = F.tid & 31, sl = F.tid >> 5; int t = 0, m = 0;
      for (int b = sl; b < F.G; b += 16) { const int v = BLKCNT[b * 32 + e]; t += v; m += (b < (int)blockIdx.x) ? v : 0; }
      part[sl * 64 + e] = t; part[sl * 64 + 32 + e] = m;
      __syncthreads();
      if (F.tid < 32) { int tt = 0, mm = 0;
#pragma unroll
          for (int s = 0; s < 16; ++s) { tt += part[s * 64 + F.tid]; mm += part[s * 64 + 32 + F.tid]; }
          tot[F.tid] = tt; mine[F.tid] = mm; } }
    __syncthreads();
    if (F.tid == 0) { int tb = 0;
        for (int e = 0; e < 32; ++e) { const int nt = (tot[e] + 255) >> 8; cursor[e] = tb * 256 + mine[e]; ebase[e] = tb * 256;
            if (blockIdx.x == 0) for (int j = 0; j < nt; ++j) TILEE[tb + j] = e;
            tb += nt; }
        ebase[32] = tb * 256;
        if (blockIdx.x == 0) F.ctl[CW_NTILES] = (unsigned)tb; }
    __syncthreads();
    for (int e = blockIdx.x; e < 32; e += F.G) for (int p = ebase[e] + tot[e] + F.tid; p < ebase[e + 1]; p += NTHR) ROWTOK[p] = 0;
    const int sub = F.lane >> 2, k = F.lane & 3;
    for (int grp = F.gw; grp < nrows / 16; grp += F.ngw) {
        const int r = grp * 16 + sub; const int e = TOPI[r * 4 + k]; const int pos = lds_add(&cursor[e], 1); POS[r * 4 + k] = pos; ROWTOK[pos] = r; }
}

__device__ __forceinline__ void ph_combine(const Frame& F, int l, int nrows, float* out, const float* gmix) {
    bf16* XR = (bf16*)(F.ws + WS_XR); const float* MOD = (const float*)(F.ws + WS_MOD); const bf16* YS = (const bf16*)(F.ws + WS_YS); bf16* H = (bf16*)(F.ws + WS_H);
    const int* POS = (const int*)(F.ws + WS_POS); const float* GATE = (const float*)(F.ws + WS_GATE);
    for (int r = 2 * F.gw; r < nrows; r += 2 * F.ngw) {
        const int bidx = r < NLAT ? r / SEQ : 4;
        const float* gf = MOD + (size_t)(l * 5 + bidx) * 6144 + 5 * 1024;
        int pos = 0; float gt = 0.f;
        if (F.lane < 8) { pos = POS[r * 4 + F.lane]; gt = GATE[r * 4 + F.lane]; }
        v2u w[2][4][4], xw[2][4]; float gk[2][4];
#pragma unroll
        for (int rr = 0; rr < 2; ++rr)
#pragma unroll
            for (int k = 0; k < 4; ++k) { const int pk = __shfl(pos, rr * 4 + k); gk[rr][k] = __shfl(gt, rr * 4 + k); const v2u* yr = (const v2u*)(YS + (size_t)pk * 1024);
#pragma unroll
                for (int j = 0; j < 4; ++j) w[rr][k][j] = yr[64 * j + F.lane]; }
#pragma unroll
        for (int rr = 0; rr < 2; ++rr)
#pragma unroll
            for (int j = 0; j < 4; ++j) xw[rr][j] = ((const v2u*)(XR + (size_t)(r + rr) * 1024))[64 * j + F.lane];
        f32x4 gv[4];
#pragma unroll
        for (int j = 0; j < 4; ++j) gv[j] = ((const f32x4*)gf)[64 * j + F.lane];
#pragma unroll
        for (int rr = 0; rr < 2; ++rr) {
            const int row = r + rr;
            f32x4 y[4]; float ss = 0.f;
#pragma unroll
            for (int j = 0; j < 4; ++j) { f32x4 a = {0.f, 0.f, 0.f, 0.f};
#pragma unroll
                for (int k = 0; k < 4; ++k) { const v2u ww = w[rr][k][j]; const float g_ = gk[rr][k]; a.x += g_ * bflo(ww.x); a.y += g_ * bfhi(ww.x); a.z += g_ * bflo(ww.y); a.w += g_ * bfhi(ww.y); }
                const f32x4 xv = {bflo(xw[rr][j].x), bfhi(xw[rr][j].x), bflo(xw[rr][j].y), bfhi(xw[rr][j].y)};
                y[j] = xv + gv[j] * a;
                const int cb = 64 * j + F.lane;
                if (l == 0) { v2u o; o.x = pk2(y[j].x, y[j].y); o.y = pk2(y[j].z, y[j].w); ((v2u*)(XR + (size_t)row * 1024))[cb] = o; } else ((f32x4*)(out + (size_t)row * 1024))[cb] = y[j];
                ss += (y[j].x * y[j].x + y[j].y * y[j].y) + (y[j].z * y[j].z + y[j].w * y[j].w); }
            if (l == 0) {
                const float rstd = 1.0f / sqrtf(wave_sum(ss) * (1.0f / 1024.0f) + EPSN);
                const float* shift = MOD + (size_t)(5 + bidx) * 6144; const float* scale = shift + 1024; const float* g = gmix + 1024;
#pragma unroll
                for (int j = 0; j < 4; ++j) { const int cb = 64 * j + F.lane; const f32x4 gg = ((const f32x4*)g)[cb], sc = ((const f32x4*)scale)[cb], sh = ((const f32x4*)shift)[cb];
                    const f32x4 hv = y[j] * rstd * gg * (sc + 1.0f) + sh;
                    v2u o; o.x = pk2(hv.x, hv.y); o.y = pk2(hv.z, hv.w); ((v2u*)(H + (size_t)row * 1024))[cb] = o; }
            }
        }
    }
}

struct Args { const float* in[34]; float* out; unsigned char* ws; int ph_lo, ph_hi; };
enum { I_X = 0, I_C, I_CTX, I_CCTX, I_WMOD, I_BMOD, I_GMIX, I_GFFN, I_WIN, I_QG, I_KG, I_LCW, I_LCB, I_LGW, I_LGB, I_LLAM, I_HCW, I_HCB, I_HW1, I_HB1, I_HW2, I_HB2, I_HW3, I_HFREQ, I_HDEC, I_HBIAS,
       I_OUTG, I_WOUT, I_RW, I_RB, I_MW1, I_MB1, I_MW2, I_MB2 };

__global__ void __launch_bounds__(NTHR, 2) mk_fwd(Args args) {
    extern __shared__ __attribute__((aligned(16))) unsigned char lds[];
    Frame F;
    F.lds = (LAS unsigned char*)lds; F.ws = args.ws; F.ctl = (unsigned*)(args.ws + WS_CTL);
    F.tid = threadIdx.x; F.lane = F.tid & 63; F.wave = __builtin_amdgcn_readfirstlane(F.tid >> 6);
    F.G = gridDim.x; { const int bx = blockIdx.x; F.vcu = (F.G % 8 == 0) ? (bx % 8) * (F.G / 8) + bx / 8 : bx; }
    F.gw = (int)blockIdx.x * NWAVES + F.wave; F.ngw = F.G * NWAVES;
    for (int u = F.tid; u < (LDS_BYTES - LDSCTL_OFF) / 4; u += NTHR) ((LAS unsigned*)(F.lds + LDSCTL_OFF))[u] = 0u;
    __syncthreads();
#if !MK_PER_PHASE
    XcdBarrier bar = xcd_barrier_post(F.ctl + CW_BAR, (volatile LAS unsigned*)(F.lds + LDSCTL_OFF + 32));
#define GRID_BAR() xcd_barrier(bar)
#else
#define GRID_BAR() do { } while (0)
#endif
    const int lo = args.ph_lo, hi = args.ph_hi;
#ifndef ONLY_PHASE
#define ONLY_PHASE (-1)
#endif
#define ENABLED(id) (ONLY_PHASE < 0 || ONLY_PHASE == (id))
#define IN(k) (ENABLED(k) && lo <= (k) && (k) < hi)
#define INL(j) (ENABLED(NPH_PRO + (j)) && lo <= pb + (j) && pb + (j) < hi)
#define SEAML(j) do { if (lo <= pb + (j) && pb + (j) + 1 < hi) { GRID_BAR(); } } while (0)
typedef const __attribute__((address_space(4))) Args* KArgs;
#ifndef REP_MASK
#define REP_MASK 0
#endif
#define NREP(j) (((REP_MASK >> (j)) & 1) ? 2 : 1)
#define REFRAME() Frame Fp = F; KArgs ka = (KArgs)__builtin_amdgcn_kernarg_segment_ptr(); { int t_ = F.tid; asm volatile("" : "+v"(t_), "+s"(ka)); Fp.tid = t_; Fp.lane = t_ & 63; Fp.wave = __builtin_amdgcn_readfirstlane(t_ >> 6); \
    Fp.gw = (int)blockIdx.x * NWAVES + Fp.wave; Fp.ws = ka->ws; Fp.ctl = (unsigned*)(ka->ws + WS_CTL); }
#define SEAM(k) do { if (lo <= (k) && (k) + 1 < hi) { GRID_BAR(); } } while (0)

    if (IN(0)) ph_prologue_a(F, args.in[I_C], args.in[I_CCTX], args.in[I_WMOD], args.in[I_BMOD], args.in[I_WIN], args.in[I_WOUT], args.in[I_MW1], args.in[I_MW2],
                             args.in[I_HW1], args.in[I_HB1], args.in[I_HW2], args.in[I_HB2], args.in[I_HFREQ], args.in[I_LGW], args.in[I_LLAM]);
    SEAM(0);
    if (IN(1)) ph_prologue_b(F, args.in[I_HW3], args.in[I_HDEC], args.in[I_GFFN], args.in[I_RW], args.in[I_RB]);
    SEAM(1);

#if MOE_FP8
#define MOE_EPI1 pg8::EpiSwigluF8
#define MOE_EPI2 pg8::EpiBf16BiasF8
#else
#define MOE_EPI1 pg8::EpiSwiglu
#define MOE_EPI2 pg8::EpiBf16Bias
#endif
#ifndef PROBE_MOE2
#define PROBE_MOE2 0
#endif
#ifndef PROBE_MOE2B
#define PROBE_MOE2B 0
#endif
#ifndef PROBE_GEMM_K
#define PROBE_GEMM_K 0
#endif
#ifndef MOE_WGM1
#define MOE_WGM1 4
#endif
#ifndef MOE_WGM2
#define MOE_WGM2 8
#endif
#define PHASE(j, ...) if (INL(j)) { _Pragma("unroll") for (int rep_ = 0; rep_ < NREP(j); ++rep_) { { REFRAME(); __VA_ARGS__ } if (rep_ + 1 < NREP(j)) GRID_BAR(); } }
#define LAYER_BODY(l) { \
        const int pb = NPH_PRO + l * NPH_LAYER; \
        const int nrows = (l == 0) ? MT : NLAT; \
        if (l == 0) { PHASE(0, ph_norm_mod(Fp, l, ka->in[I_X], ka->in[I_CTX], ka->in[I_GMIX]);) SEAML(0); } \
        PHASE(1, \
            pg8::Gemm g{(const bf16*)(Fp.ws + WS_H), (const bf16*)(Fp.ws + WS_WINT) + (size_t)l * 2048 * 1024, MT, 2048, 1024}; \
            pg8::StaticOrder S; S.init(MT, 2048, Fp.G, (int)blockIdx.x); \
            pg8::EpiBf16<0> E{(bf16*)(Fp.ws + WS_U), 2048, nullptr, 0, 0, 1.f}; \
            pg8::gemm_phase<pg8::EpiBf16<0>, pg8::StaticOrder, PG8_ALIGN, PG8_SP2>(Fp.lds + RING_OFF, g, S, E);) \
        SEAML(1); \
        if (PROBE_GEMM_K > 0 && INL(1)) { REFRAME(); int kp_ = PROBE_GEMM_K; asm volatile("" : "+s"(kp_)); \
            pg8::Gemm g{(const bf16*)(Fp.ws + WS_H), (const bf16*)(Fp.ws + WS_WINT) + (size_t)l * 2048 * 1024, MT, 2048, kp_}; \
            pg8::StaticOrder S; S.init(MT, 2048, Fp.G, (int)blockIdx.x); \
            pg8::EpiNone E{}; \
            pg8::gemm_phase<pg8::EpiNone, pg8::StaticOrder, PG8_ALIGN, PG8_SP2>(Fp.lds + RING_OFF, g, S, E); GRID_BAR(); } \
        PHASE(2, ph_post_proj(Fp, l, ka->in[I_QG], ka->in[I_KG], ka->in[I_LCW], ka->in[I_LCB], ka->in[I_HCW], ka->in[I_HCB]);) \
        SEAML(2); \
        PHASE(3, \
            int kg_ = 256; asm volatile("" : "+s"(kg_)); \
            pg8::Gemm g{(const bf16*)(Fp.ws + WS_XL), (const bf16*)(Fp.ws + WS_WGT) + (size_t)l * 1024 * 256, MT, 1024, kg_}; \
            pg8::StaticOrder S; S.init(MT, 1024, Fp.G, (int)blockIdx.x); \
            pg8::EpiLruGate E{(const bf16*)(Fp.ws + WS_XL), (bf16*)(Fp.ws + WS_LAB), LAB_STRIDE, ka->in[I_LGB] + (size_t)l * 1024, (const float*)(Fp.ws + WS_SPT) + l * 512}; \
            pg8::gemm_phase<pg8::EpiLruGate, pg8::StaticOrder, PG8_ALIGN, PG8_SP2>(Fp.lds + RING_OFF, g, S, E);) \
        SEAML(3); \
        PHASE(4, \
            ph_scan1(Fp); __syncthreads(); \
            const attn_body::AttnTensors AT{(const attn_body::bf16*)(Fp.ws + WS_U), (const attn_body::bf16*)(Fp.ws + WS_K), (const attn_body::bf16*)(Fp.ws + WS_V), (attn_body::bf16*)(Fp.ws + WS_ATT)}; \
            const attn_body::QPre QN{ka->in[I_QG] + l * 64, (const float*)(Fp.ws + WS_ROPEC), (const float*)(Fp.ws + WS_ROPES)}; \
            attn_body::attn_phase<8>((char*)lds + RING_OFF, AT, QN, Fp.G, Fp.vcu, l == 0, (long)NLAT);) \
        SEAML(4); \
        PHASE(5, ph_scan2(Fp); __syncthreads(); ph_hyena_fft(Fp, l, ka->in[I_HBIAS]); if (l == 0) ph_hyena_ctx(Fp, ka->in[I_HBIAS], ka->in[I_HCW], ka->in[I_HCB]);) \
        SEAML(5); \
        PHASE(6, ph_merge(Fp, l, nrows, ka->in[I_OUTG]);) \
        SEAML(6); \
        if (INL(7)) { REFRAME(); \
            pg8::Gemm g{(const bf16*)(Fp.ws + WS_MIXA), (const bf16*)(Fp.ws + WS_WOUTT) + (size_t)l * 1024 * 1024, nrows, 1024, 1024}; \
            pg8::StaticOrder S; S.init(nrows, 1024, Fp.G, (int)blockIdx.x); \
            bf16* XR = (bf16*)(Fp.ws + WS_XR); \
            pg8::EpiResid<(l) == 1> E{ka->in[I_X], ka->in[I_CTX], NLAT, XR, 1024, \
                            (const float*)(Fp.ws + WS_MOD) + (size_t)(l * 5) * 6144 + 2 * 1024, 6144, SEQ, (float*)(Fp.ws + WS_RSSP)}; \
            pg8::gemm_phase<pg8::EpiResid<(l) == 1>, pg8::StaticOrder, PG8_ALIGN, PG8_SP2>(Fp.lds + RING_OFF, g, S, E); \
        } \
        SEAML(7); \
        PHASE(8, ph_ffn_router(Fp, l, nrows, ka->in[I_RW]);) \
        SEAML(8); \
        PHASE(9, ph_route(Fp, nrows);) \
        SEAML(9); \
        if (INL(10) || INL(11)) { REFRAME(); \
            LAS int* tab = (LAS int*)(Fp.lds + MOETAB_OFF); \
            const int ntiles = (int)__hip_atomic_load(Fp.ctl + CW_NTILES, __ATOMIC_RELAXED, __HIP_MEMORY_SCOPE_AGENT); \
            const int* TILEE = (const int*)(Fp.ws + WS_TILEE); \
            for (int i = Fp.tid; i < ntiles && i < SORT_TILES; i += NTHR) tab[i] = TILEE[i]; \
            __syncthreads(); \
            if (INL(10)) { _Pragma("unroll") for (int rep_ = 0; rep_ < NREP(10); ++rep_) { { \
                int km1_ = 1024 / (1 + MOE_FP8); asm volatile("" : "+s"(km1_)); \
                pg8::Gemm g{(const bf16*)(Fp.ws + WS_F), (const bf16*)(Fp.ws + WS_W1T) + (size_t)l * 32 * 2048 * (1024 / (1 + MOE_FP8)), 0, 2048, km1_}; \
                pg8::MoeOrderT<true> S; S.init(tab, ntiles, 8, Fp.G, (int)blockIdx.x, MOE_WGM1); S.rowtok = (const int*)(Fp.ws + WS_ROWTOK); \
                MOE_EPI1 E{(bf16*)(Fp.ws + WS_ACT), 1024, ka->in[I_MB1] + (size_t)l * 32 * 2048, 2048}; \
                pg8::gemm_phase<MOE_EPI1, pg8::MoeOrderT<true>, PG8_ALIGN, PG8_SP2, MOE_FP8 != 0>(Fp.lds + RING_OFF, g, S, E); \
             } if (rep_ + 1 < NREP(10)) GRID_BAR(); } } \
            SEAML(10); \
            if (PROBE_MOE2B && INL(11)) { \
                pg8::Gemm g{(const bf16*)(Fp.ws + WS_ACT), (const bf16*)(Fp.ws + WS_W2T) + (size_t)l * 32 * 1024 * 1024, 0, 1024, 1024}; \
                pg8::MoeOrderT<false> S; S.init(tab, ntiles, 4, Fp.G, (int)blockIdx.x, MOE_WGM2); S.rowtok = nullptr; S.rev = 1; \
                pg8::EpiNone E{}; \
                pg8::gemm_phase<pg8::EpiNone, pg8::MoeOrderT<false>, PG8_ALIGN, PG8_SP2>(Fp.lds + RING_OFF, g, S, E); GRID_BAR(); } \
            if (INL(11)) { _Pragma("unroll") for (int rep_ = 0; rep_ < NREP(11); ++rep_) { { \
                int km2_ = 1024 / (1 + MOE_FP8); asm volatile("" : "+s"(km2_)); \
                pg8::Gemm g{(const bf16*)(Fp.ws + WS_ACT), (const bf16*)(Fp.ws + WS_W2T) + (size_t)l * 32 * 1024 * (1024 / (1 + MOE_FP8)), 0, 1024, km2_}; \
                pg8::MoeOrderT<false> S; S.init(tab, ntiles, 4, Fp.G, (int)blockIdx.x, MOE_WGM2); S.rowtok = nullptr; S.rev = 1; \
                MOE_EPI2 E{(bf16*)(Fp.ws + WS_YS), 1024, ka->in[I_MB2] + (size_t)l * 32 * 1024, 1024}; \
                pg8::gemm_phase<MOE_EPI2, pg8::MoeOrderT<false>, PG8_ALIGN, PG8_SP2, MOE_FP8 != 0>(Fp.lds + RING_OFF, g, S, E); \
             } if (rep_ + 1 < NREP(11)) GRID_BAR(); } } \
            if (PROBE_MOE2 && INL(11)) { GRID_BAR(); \
                pg8::Gemm g{(const bf16*)(Fp.ws + WS_ACT), (const bf16*)(Fp.ws + WS_W2T) + (size_t)l * 32 * 1024 * 1024, 0, 1024, 1024}; \
                pg8::MoeOrderT<false> S; S.init(tab, ntiles, 4, Fp.G, (int)blockIdx.x, MOE_WGM2); S.rowtok = nullptr; S.rev = (PROBE_MOE2 == 2) ? 0 : 1; \
                if (PROBE_MOE2 == 3) { pg8::EpiBf16BiasFold E{(bf16*)(Fp.ws + WS_ASORT), 1024, ka->in[I_MB2] + (size_t)l * 32 * 1024, 1024}; \
                    pg8::gemm_phase<pg8::EpiBf16BiasFold, pg8::MoeOrderT<false>, PG8_ALIGN, PG8_SP2>(Fp.lds + RING_OFF, g, S, E); } \
                else { pg8::EpiNone E{}; \
                pg8::gemm_phase<pg8::EpiNone, pg8::MoeOrderT<false>, PG8_ALIGN, PG8_SP2>(Fp.lds + RING_OFF, g, S, E); } } \
        } \
        SEAML(11); \
        if (INL(12)) { REFRAME(); ph_combine(Fp, l, nrows, ka->out, ka->in[I_GMIX]); } \
        if (l == 0) { SEAML(12); } \
    }
    LAYER_BODY(0)
    LAYER_BODY(1)
#undef LAYER_BODY
#undef PHASE
#undef IN
#undef SEAM
#undef INL
#undef SEAML
}

extern "C" void kernel_launch(void* const* d_in, const int* in_sizes, int n_in, void* d_out, int out_size, void* d_ws, size_t ws_size, hipStream_t stream) {
    static int grid = 0;
    if (grid == 0) {
        if (n_in != 34 || in_sizes[0] != NLAT * DMODEL || out_size != NLAT * DMODEL || ws_size < WS_END) {
            fprintf(stderr, "kernel_launch: unexpected shapes (n_in %d, in0 %d, out %d, ws %zu); nothing launched\n", n_in, n_in > 0 ? in_sizes[0] : -1, out_size, ws_size); grid = -1; return; }
        int dev = 0, cus = 0;
        if (hipGetDevice(&dev) != hipSuccess || hipDeviceGetAttribute(&cus, hipDeviceAttributeMultiprocessorCount, dev) != hipSuccess) { grid = -1; return; }
        if (hipFuncSetAttribute((const void*)mk_fwd, hipFuncAttributeMaxDynamicSharedMemorySize, LDS_BYTES) != hipSuccess) { fprintf(stderr, "kernel_launch: hipFuncSetAttribute failed\n"); grid = -1; return; }
        int per_cu = 0;
        if (hipOccupancyMaxActiveBlocksPerMultiprocessor(&per_cu, (const void*)mk_fwd, NTHR, LDS_BYTES) != hipSuccess || per_cu < 1) { fprintf(stderr, "kernel_launch: occupancy query says %d\n", per_cu); }
        (void)hipGetLastError();
        grid = cus;
    }
    if (grid < 0) return;
    if (hipMemsetAsync((char*)d_ws + WS_CTL, 0, CTL_ZERO_BYTES, stream) != hipSuccess) return;
    Args a{};
    for (int i = 0; i < 34; ++i) a.in[i] = (const float*)d_in[i];
    a.out = (float*)d_out; a.ws = (unsigned char*)d_ws;
#if MK_PER_PHASE
    for (int p = 0; p < NPH; ++p) { a.ph_lo = p; a.ph_hi = p + 1; hipLaunchKernelGGL(mk_fwd, dim3(grid), dim3(NTHR), LDS_BYTES, stream, a); }
#else
    a.ph_lo = 0; a.ph_hi = NPH;
    hipLaunchKernelGGL(mk_fwd, dim3(grid), dim3(NTHR), LDS_BYTES, stream, a);
#endif
}
```

```cpp
#include <hip/hip_runtime.h>
#include <hip/hip_bf16.h>
#include <cstdio>
#include <cstdint>
#include <cmath>
#ifndef MOE_FP8
#define MOE_FP8 1
#endif
#ifndef MK_PER_PHASE
#define MK_PER_PHASE 0
#endif
namespace pg8 {
#define PG8_LAS __attribute__((address_space(3)))
typedef unsigned short bf16_t;
typedef short bf16x8 __attribute__((ext_vector_type(8)));
typedef float f32x4 __attribute__((ext_vector_type(4)));
typedef unsigned u32x4 __attribute__((ext_vector_type(4)));
constexpr int BM = 256, BK = 64, HALF = 128, HTB = HALF * BK * 2  , STAGE_BYTES = 8 * HTB, NXCD = 8, WGM = 8;

__host__ __device__ __forceinline__ int lds_byte(int r, int c) { const int st = (r >> 4) * 2 + (c >> 5), rr = r & 15, cc = c & 31, ob = rr * 64 + cc * 2; return st * 1024 + (ob ^ (((ob >> 9) & 1) << 5)); }
__host__ __device__ __forceinline__ void stage_rc(int b, int& R, int& C) { const int st = b / 1024, sb = b % 1024, swz = sb ^ (((sb >> 9) & 1) << 5); R = (st >> 1) * 16 + swz / 64; C = (st & 1) * 32 + (swz % 64) / 2; }
__host__ __device__ __forceinline__ int perm32(int rho) { const int n = rho >> 4, i = rho & 15; return 8 * (i >> 2) + 4 * n + (i & 3); }

struct Unit { int pm, pn, be, e; };
struct Gemm { const bf16_t* A; const bf16_t* Bt; int M, N, K; };

struct StaticOrder {
    static constexpr bool GATHER = false;
    __device__ __forceinline__ int row_of(int r) const { return r; }
    int nM, nN, nwg, G, c;
    __host__ __device__ void init(int M, int N, int G_, int c_) { nM = M / BM; nN = N / BM; nwg = nM * nN; G = G_; c = c_; }
    __host__ __device__ bool next(int i, Unit& u) const {
        const long L = (long)i * G + c; if (L >= nwg) return false;
        int wgid = (int)L; { const int q = nwg / NXCD, r = nwg % NXCD, xcd = wgid % NXCD, off = wgid / NXCD; wgid = (xcd < r ? xcd * (q + 1) : r * (q + 1) + (xcd - r) * q) + off; }
        const int nig = WGM * nN, gid = wgid / nig, fm = gid * WGM, gsz = (nM - fm) < WGM ? (nM - fm) : WGM;
        u.pm = fm + ((wgid % nig) % gsz); u.pn = (wgid % nig) / gsz; u.be = u.pn; u.e = 0; return true;
    }
    __device__ __forceinline__ void a_ready(const Unit&) const {}
    __device__ __forceinline__ void done(const Unit&) const {}
};

__device__ __forceinline__ unsigned cvt_pk_bf16(float lo, float hi) { unsigned r; asm volatile("v_cvt_pk_bf16_f32 %0, %1, %2" : "=v"(r) : "v"(lo), "v"(hi)); return r; }
__device__ __forceinline__ unsigned pack4_fp8(float a, float b, float c, float d) {
    a = fminf(fmaxf(a, -448.f), 448.f); b = fminf(fmaxf(b, -448.f), 448.f); c = fminf(fmaxf(c, -448.f), 448.f); d = fminf(fmaxf(d, -448.f), 448.f);
    int w = 0; w = __builtin_amdgcn_cvt_pk_fp8_f32(a, b, w, false); w = __builtin_amdgcn_cvt_pk_fp8_f32(c, d, w, true); return (unsigned)w;
}
constexpr float F8_SF = 16.f, F8_SW = 64.f, F8_SA = 4.f, F8_SY = 32.f;
typedef float f32x2 __attribute__((ext_vector_type(2)));
__device__ __forceinline__ f32x2 gelu_pk(f32x2 v) {
    const f32x2 av = __builtin_elementwise_abs(v), d = av * 0.2316418882f + 1.0f;
    f32x2 t; t.x = __builtin_amdgcn_rcpf(d.x); t.y = __builtin_amdgcn_rcpf(d.y);
    f32x2 q = t * 0.5307027145f + (-0.7265760135f); q = q * t + 0.7107068705f; q = q * t + (-0.142248368f); q = q * t + 0.127414796f; q = q * t;
    const f32x2 s = (v * v) * (-0.72134752044f);
    f32x2 e; e.x = __builtin_amdgcn_exp2f(s.x); e.y = __builtin_amdgcn_exp2f(s.y);
    const f32x2 m = v * (q * e), r = v - m;
    f32x2 o; o.x = v.x < 0.f ? m.x : r.x; o.y = v.y < 0.f ? m.y : r.y; return o;
}

template <int ACT  > struct EpiBf16 {
    static constexpr bool PERM = true, AFTER_DRAIN = false; static_assert(ACT == 0 || ACT == 1, "EpiBf16: ACT is 0 (none) or 1 (gelu_pk)");
    bf16_t* O; int ldc; const float* bias; int split_cols; size_t split_stride; float scale0;
    struct Pre {}; __device__ __forceinline__ void preload(Pre&, const Unit&, int, int, int, int) const {}
    __device__ __forceinline__ void operator()(const f32x4 (&acc)[2][2][4][2], const Unit& u, int wr, int wc, int fr, int fq, const Pre&) const {
        const int row0 = u.pm * BM + wr * 64 + fr; int colt = u.pn * BM; bf16_t* base = O;
        float sc = 1.f; if (split_cols) { const int t = colt / split_cols; base += (size_t)t * split_stride; colt -= t * split_cols; if (t == 0) sc = scale0; }
        const int col0 = colt + wc * 32 + 8 * fq, bcol0 = u.pn * BM + wc * 32 + 8 * fq;
        f32x4 bv[2][2];
#pragma unroll
        for (int bj = 0; bj < 2; ++bj)
#pragma unroll
            for (int n = 0; n < 2; ++n) bv[bj][n] = bias ? *(const f32x4*)(bias + bcol0 + bj * HALF + 4 * n) : (f32x4){0.f, 0.f, 0.f, 0.f};
#pragma unroll
        for (int ai = 0; ai < 2; ++ai)
#pragma unroll
            for (int m = 0; m < 4; ++m) { bf16_t* rowp = base + (size_t)(row0 + ai * HALF + m * 16) * ldc + col0;
#pragma unroll
                for (int bj = 0; bj < 2; ++bj) { f32x4 v0 = acc[ai][bj][m][0] + bv[bj][0], v1 = acc[ai][bj][m][1] + bv[bj][1];
                    if (ACT == 1) { f32x2 a = gelu_pk((f32x2){v0[0], v0[1]}), b = gelu_pk((f32x2){v0[2], v0[3]}), c = gelu_pk((f32x2){v1[0], v1[1]}), d = gelu_pk((f32x2){v1[2], v1[3]});
                        v0 = (f32x4){a.x, a.y, b.x, b.y}; v1 = (f32x4){c.x, c.y, d.x, d.y}; }
                    v0 = v0 * sc; v1 = v1 * sc; u32x4 w; w.x = cvt_pk_bf16(v0[0], v0[1]); w.y = cvt_pk_bf16(v0[2], v0[3]); w.z = cvt_pk_bf16(v1[0], v1[1]); w.w = cvt_pk_bf16(v1[2], v1[3]);
                    *(u32x4*)(rowp + bj * HALF) = w; } }
    }
};


template <bool XIN_BF16> struct EpiResid {
    static constexpr bool PERM = false, AFTER_DRAIN = false;
    const float* xin_lat; const float* xin_ctx; int nlat; bf16_t* XR; int ldc; const float* mod; int mod_stride; int seq; float* rssp;
    struct Pre {}; __device__ __forceinline__ void preload(Pre&, const Unit&, int, int, int, int) const {}
    __device__ __forceinline__ void operator()(const f32x4 (&acc)[2][2][4][2], const Unit& u, int wr, int wc, int fr, int fq, const Pre&) const {
        typedef unsigned u32x2 __attribute__((ext_vector_type(2)));
        const int row0 = u.pm * BM + wr * 64 + fr, col0 = u.pn * BM + wc * 32 + 4 * fq;
        const int rowt = u.pm * BM; const int bidx = rowt < nlat ? rowt / seq : 4;
        const float* gate = mod + (size_t)bidx * mod_stride;
        const float* xin = rowt < nlat ? xin_lat : (xin_ctx - (size_t)nlat * ldc);
        f32x4 gv[2][2];
#pragma unroll
        for (int bj = 0; bj < 2; ++bj)
#pragma unroll
            for (int n = 0; n < 2; ++n) gv[bj][n] = *(const f32x4*)(gate + col0 + bj * HALF + n * 16);
#pragma unroll
        for (int ai = 0; ai < 2; ++ai)
#pragma unroll
            for (int m = 0; m < 4; ++m) { const int row = row0 + ai * HALF + m * 16; const size_t ro = (size_t)row * ldc + col0; float s2 = 0.f;
#pragma unroll
                for (int bj = 0; bj < 2; ++bj)
#pragma unroll
                    for (int n = 0; n < 2; ++n) { const size_t idx = ro + bj * HALF + n * 16; f32x4 xv;
                        if (XIN_BF16) { const u32x2 w = *(const u32x2*)(XR + idx); xv = (f32x4){__builtin_bit_cast(float, w.x << 16), __builtin_bit_cast(float, w.x & 0xffff0000u), __builtin_bit_cast(float, w.y << 16), __builtin_bit_cast(float, w.y & 0xffff0000u)}; }
                        else xv = *(const f32x4*)(xin + idx);
                        const f32x4 v = xv + gv[bj][n] * acc[ai][bj][m][n];
                        s2 += (v[0] * v[0] + v[1] * v[1]) + (v[2] * v[2] + v[3] * v[3]);
                        u32x2 o; o.x = cvt_pk_bf16(v[0], v[1]); o.y = cvt_pk_bf16(v[2], v[3]); *(u32x2*)(XR + idx) = o; }
                s2 += __shfl_xor(s2, 16); s2 += __shfl_xor(s2, 32);
                if (fq == 0) rssp[(size_t)row * 16 + u.pn * 4 + wc] = s2; }
    }
};
struct EpiSwiglu {
    static constexpr bool PERM = true, AFTER_DRAIN = false;
    bf16_t* O; int ldc; const float* bias; int bias_stride;
    struct Pre { unsigned bw[2][2][2]; };
    __device__ __forceinline__ void preload(Pre& p, const Unit& u, int wr, int wc, int fr, int fq) const {
        const float* bb = bias + (size_t)u.e * bias_stride + u.pn * BM + wc * 32 + 8 * fq;
#pragma unroll
        for (int bj = 0; bj < 2; ++bj)
#pragma unroll
            for (int n = 0; n < 2; ++n) { const f32x4 v = *(const f32x4*)(bb + bj * HALF + 4 * n); p.bw[bj][n][0] = cvt_pk_bf16(v[0], v[1]); p.bw[bj][n][1] = cvt_pk_bf16(v[2], v[3]); }
    }
    __device__ __forceinline__ void operator()(const f32x4 (&acc)[2][2][4][2], const Unit& u, int wr, int wc, int fr, int fq, const Pre& pre) const {
        const int row0 = u.pm * BM + wr * 64 + fr; const int bcol0 = u.pn * BM + wc * 32 + 8 * fq; const int ocol0 = bcol0 >> 1;
        f32x4 bv[2][2];
#pragma unroll
        for (int bj = 0; bj < 2; ++bj)
#pragma unroll
            for (int n = 0; n < 2; ++n) { const unsigned w0 = pre.bw[bj][n][0], w1 = pre.bw[bj][n][1];
                bv[bj][n] = (f32x4){__builtin_bit_cast(float, w0 << 16), __builtin_bit_cast(float, w0 & 0xffff0000u), __builtin_bit_cast(float, w1 << 16), __builtin_bit_cast(float, w1 & 0xffff0000u)}; }
#pragma unroll
        for (int ai = 0; ai < 2; ++ai)
#pragma unroll
            for (int m = 0; m < 4; ++m) { bf16_t* rowp = O + (size_t)(row0 + ai * HALF + m * 16) * ldc + ocol0;
#pragma unroll
                for (int bj = 0; bj < 2; ++bj) { const f32x4 v0 = acc[ai][bj][m][0] + bv[bj][0], v1 = acc[ai][bj][m][1] + bv[bj][1];
                    float o[4];
#pragma unroll
                    for (int p = 0; p < 4; ++p) { const float hg = p < 2 ? v0[2 * p] : v1[2 * p - 4], hl = p < 2 ? v0[2 * p + 1] : v1[2 * p - 3];
                        const float glu = fminf(hg, 7.0f), lin = fminf(fmaxf(hl, -7.0f), 7.0f);
                        const float sg = __builtin_amdgcn_rcpf(1.0f + __builtin_amdgcn_exp2f(-1.702f * 1.4426950408889634f * glu));
                        o[p] = glu * sg * (lin + 1.0f); }
                    typedef unsigned u32x2 __attribute__((ext_vector_type(2)));
                    u32x2 w; w.x = cvt_pk_bf16(o[0], o[1]); w.y = cvt_pk_bf16(o[2], o[3]);
                    *(u32x2*)(rowp + bj * (HALF / 2)) = w; } }
    }
};
struct EpiSwigluF8 {
    static constexpr bool PERM = true, AFTER_DRAIN = false;
    bf16_t* O; int ldc; const float* bias; int bias_stride;
    struct Pre { unsigned bw[2][2][2]; };
    __device__ __forceinline__ void preload(Pre& p, const Unit& u, int wr, int wc, int fr, int fq) const {
        const float* bb = bias + (size_t)u.e * bias_stride + u.pn * BM + wc * 32 + 8 * fq;
#pragma unroll
        for (int bj = 0; bj < 2; ++bj)
#pragma unroll
            for (int n = 0; n < 2; ++n) { const f32x4 v = *(const f32x4*)(bb + bj * HALF + 4 * n); p.bw[bj][n][0] = cvt_pk_bf16(v[0], v[1]); p.bw[bj][n][1] = cvt_pk_bf16(v[2], v[3]); }
    }
    __device__ __forceinline__ void operator()(const f32x4 (&acc)[2][2][4][2], const Unit& u, int wr, int wc, int fr, int fq, const Pre& pre) const {
        asm volatile("" : "+v"(fr), "+v"(fq));
        const int row0 = u.pm * BM + wr * 64 + fr; const int bcol0 = u.pn * BM + wc * 32 + 8 * fq; const int ocol0 = bcol0 >> 1;
        f32x4 bv[2][2];
#pragma unroll
        for (int bj = 0; bj < 2; ++bj)
#pragma unroll
            for (int n = 0; n < 2; ++n) { const unsigned w0 = pre.bw[bj][n][0], w1 = pre.bw[bj][n][1];
                bv[bj][n] = (f32x4){__builtin_bit_cast(float, w0 << 16), __builtin_bit_cast(float, w0 & 0xffff0000u), __builtin_bit_cast(float, w1 << 16), __builtin_bit_cast(float, w1 & 0xffff0000u)}; }
#pragma unroll
        for (int ai = 0; ai < 2; ++ai)
#pragma unroll
            for (int m = 0; m < 4; ++m) {
#pragma unroll
                for (int bj = 0; bj < 2; ++bj) { const f32x4 v0 = acc[ai][bj][m][0] * (1.0f / (F8_SF * F8_SW)) + bv[bj][0], v1 = acc[ai][bj][m][1] * (1.0f / (F8_SF * F8_SW)) + bv[bj][1];
                    float o[4];
#pragma unroll
                    for (int p = 0; p < 4; ++p) { const float hg = p < 2 ? v0[2 * p] : v1[2 * p - 4], hl = p < 2 ? v0[2 * p + 1] : v1[2 * p - 3];
                        const float glu = fminf(hg, 7.0f), lin = fminf(fmaxf(hl, -7.0f), 7.0f);
                        const float sg = __builtin_amdgcn_rcpf(1.0f + __builtin_amdgcn_exp2f(-1.702f * 1.4426950408889634f * glu));
                        o[p] = glu * sg * (lin + 1.0f); }
                    *(unsigned*)((unsigned char*)O + (size_t)(row0 + ai * HALF + m * 16) * ldc + ocol0 + bj * (HALF / 2)) = pack4_fp8(o[0] * F8_SA, o[1] * F8_SA, o[2] * F8_SA, o[3] * F8_SA); } }
    }
};
struct EpiBf16Bias {
    static constexpr bool PERM = true, AFTER_DRAIN = false;
    bf16_t* O; int ldc; const float* bias; int bias_stride;
    struct Pre { f32x4 bv[2][2]; };
    __device__ __forceinline__ void preload(Pre& p, const Unit& u, int wr, int wc, int fr, int fq) const {
        const float* bb = bias + (size_t)u.e * bias_stride + u.pn * BM + wc * 32 + 8 * fq;
#pragma unroll
        for (int bj = 0; bj < 2; ++bj)
#pragma unroll
            for (int n = 0; n < 2; ++n) p.bv[bj][n] = *(const f32x4*)(bb + bj * HALF + 4 * n);
    }
    __device__ __forceinline__ void operator()(const f32x4 (&acc)[2][2][4][2], const Unit& u, int wr, int wc, int fr, int fq, const Pre& pre) const {
        const int row0 = u.pm * BM + wr * 64 + fr; const int col0 = u.pn * BM + wc * 32 + 8 * fq;
#pragma unroll
        for (int ai = 0; ai < 2; ++ai)
#pragma unroll
            for (int m = 0; m < 4; ++m) { bf16_t* rowp = O + (size_t)(row0 + ai * HALF + m * 16) * ldc + col0;
#pragma unroll
                for (int bj = 0; bj < 2; ++bj) { const f32x4 v0 = acc[ai][bj][m][0] + pre.bv[bj][0], v1 = acc[ai][bj][m][1] + pre.bv[bj][1];
                    u32x4 w; w.x = cvt_pk_bf16(v0[0], v0[1]); w.y = cvt_pk_bf16(v0[2], v0[3]); w.z = cvt_pk_bf16(v1[0], v1[1]); w.w = cvt_pk_bf16(v1[2], v1[3]);
                    *(u32x4*)(rowp + bj * HALF) = w; } }
    }
};
struct EpiBf16BiasFold {
    static constexpr bool PERM = true, AFTER_DRAIN = false;
    bf16_t* O; int ldc; const float* bias; int bias_stride;
    struct Pre { f32x4 bv[2][2]; };
    __device__ __forceinline__ void preload(Pre& p, const Unit& u, int wr, int wc, int fr, int fq) const {
        const float* bb = bias + (size_t)u.e * bias_stride + u.pn * BM + wc * 32 + 8 * fq;
#pragma unroll
        for (int bj = 0; bj < 2; ++bj)
#pragma unroll
            for (int n = 0; n < 2; ++n) p.bv[bj][n] = *(const f32x4*)(bb + bj * HALF + 4 * n);
    }
    __device__ __forceinline__ void operator()(const f32x4 (&acc)[2][2][4][2], const Unit& u, int wr, int wc, int fr, int fq, const Pre& pre) const {
        const int row0 = u.pm * BM + wr * 64 + fr; const int col0 = u.pn * BM + wc * 32 + 8 * fq;
#pragma unroll
        for (int ai = 0; ai < 2; ++ai)
#pragma unroll
            for (int m = 0; m < 4; ++m) { bf16_t* rowp = O + (size_t)((row0 + ai * HALF + m * 16) & 255) * ldc + col0;
#pragma unroll
                for (int bj = 0; bj < 2; ++bj) { const f32x4 v0 = acc[ai][bj][m][0] + pre.bv[bj][0], v1 = acc[ai][bj][m][1] + pre.bv[bj][1];
                    u32x4 w; w.x = cvt_pk_bf16(v0[0], v0[1]); w.y = cvt_pk_bf16(v0[2], v0[3]); w.z = cvt_pk_bf16(v1[0], v1[1]); w.w = cvt_pk_bf16(v1[2], v1[3]);
                    *(u32x4*)(rowp + bj * HALF) = w; } }
    }
};
struct EpiBf16BiasF8 {
    static constexpr bool PERM = true, AFTER_DRAIN = false;
    bf16_t* O; int ldc; const float* bias; int bias_stride;
    struct Pre { f32x4 bv[2][2]; };
    __device__ __forceinline__ void preload(Pre& p, const Unit& u, int wr, int wc, int fr, int fq) const {
        const float* bb = bias + (size_t)u.e * bias_stride + u.pn * BM + wc * 32 + 8 * fq;
#pragma unroll
        for (int bj = 0; bj < 2; ++bj)
#pragma unroll
            for (int n = 0; n < 2; ++n) p.bv[bj][n] = *(const f32x4*)(bb + bj * HALF + 4 * n);
    }
    __device__ __forceinline__ void operator()(const f32x4 (&acc)[2][2][4][2], const Unit& u, int wr, int wc, int fr, int fq, const Pre& pre) const {
        asm volatile("" : "+v"(fr), "+v"(fq));
        const int row0 = u.pm * BM + wr * 64 + fr; const int col0 = u.pn * BM + wc * 32 + 8 * fq;
#pragma unroll
        for (int ai = 0; ai < 2; ++ai)
#pragma unroll
            for (int m = 0; m < 4; ++m) { bf16_t* rowp = O + (size_t)(row0 + ai * HALF + m * 16) * ldc + col0;
#pragma unroll
                for (int bj = 0; bj < 2; ++bj) { const f32x4 v0 = acc[ai][bj][m][0] * (1.0f / (F8_SA * F8_SW)) + pre.bv[bj][0], v1 = acc[ai][bj][m][1] * (1.0f / (F8_SA * F8_SW)) + pre.bv[bj][1];
                    u32x4 w; w.x = cvt_pk_bf16(v0[0], v0[1]); w.y = cvt_pk_bf16(v0[2], v0[3]); w.z = cvt_pk_bf16(v1[0], v1[1]); w.w = cvt_pk_bf16(v1[2], v1[3]);
                    *(u32x4*)(rowp + bj * HALF) = w; } }
    }
};
struct EpiF8BiasF8 {
    static constexpr bool PERM = true, AFTER_DRAIN = false;
    bf16_t* O; int ldc; const float* bias; int bias_stride;
    struct Pre { f32x4 bv[2][2]; };
    __device__ __forceinline__ void preload(Pre& p, const Unit& u, int wr, int wc, int fr, int fq) const {
        const float* bb = bias + (size_t)u.e * bias_stride + u.pn * BM + wc * 32 + 8 * fq;
#pragma unroll
        for (int bj = 0; bj < 2; ++bj)
#pragma unroll
            for (int n = 0; n < 2; ++n) p.bv[bj][n] = *(const f32x4*)(bb + bj * HALF + 4 * n);
    }
    __device__ __forceinline__ void operator()(const f32x4 (&acc)[2][2][4][2], const Unit& u, int wr, int wc, int fr, int fq, const Pre& pre) const {
        asm volatile("" : "+v"(fr), "+v"(fq));
        const int row0 = u.pm * BM + wr * 64 + fr; const int col0 = u.pn * BM + wc * 32 + 8 * fq;
#pragma unroll
        for (int ai = 0; ai < 2; ++ai)
#pragma unroll
            for (int m = 0; m < 4; ++m) { unsigned char* rowp = (unsigned char*)O + (size_t)(row0 + ai * HALF + m * 16) * ldc + col0;
#pragma unroll
                for (int bj = 0; bj < 2; ++bj) { const f32x4 v0 = (acc[ai][bj][m][0] * (1.0f / (F8_SA * F8_SW)) + pre.bv[bj][0]) * F8_SY, v1 = (acc[ai][bj][m][1] * (1.0f / (F8_SA * F8_SW)) + pre.bv[bj][1]) * F8_SY;
                    typedef unsigned u32x2 __attribute__((ext_vector_type(2)));
                    u32x2 w; w.x = pack4_fp8(v0[0], v0[1], v0[2], v0[3]); w.y = pack4_fp8(v1[0], v1[1], v1[2], v1[3]);
                    *(u32x2*)(rowp + bj * HALF) = w; } }
    }
};
struct EpiLruGate {
    static constexpr bool PERM = false, AFTER_DRAIN = false;
    const bf16_t* XL; bf16_t* LAB; size_t lab_stride; const float* gb; const float* spt;
    struct Pre {}; __device__ __forceinline__ void preload(Pre&, const Unit&, int, int, int, int) const {}
    __device__ __forceinline__ void operator()(const f32x4 (&acc)[2][2][4][2], const Unit& u, int wr, int wc, int fr, int fq, const Pre&) const {
        const int d = u.pn >> 1, half = u.pn & 1;
        const int row0 = u.pm * BM + wr * 64 + fr, ch0 = half * 128 + wc * 32 + 4 * fq;
        bf16_t* LA = LAB + (size_t)(2 * d) * lab_stride; bf16_t* LB = LAB + (size_t)(2 * d + 1) * lab_stride;
#pragma unroll
        for (int n = 0; n < 2; ++n) {
            const f32x4 bR = *(const f32x4*)(gb + (d * 2 + 0) * 256 + ch0 + 16 * n), bI = *(const f32x4*)(gb + (d * 2 + 1) * 256 + ch0 + 16 * n);
            const f32x4 sp = *(const f32x4*)(spt + d * 256 + ch0 + 16 * n) * (-8.0f * 1.4426950408889634f);
#pragma unroll
            for (int ai = 0; ai < 2; ++ai)
#pragma unroll
                for (int m = 0; m < 4; ++m) { const size_t ro = (size_t)(row0 + ai * HALF + m * 16) * 256 + ch0 + 16 * n;
                    typedef unsigned u32x2 __attribute__((ext_vector_type(2)));
                    const u32x2 xw = *(const u32x2*)(XL + ro);
                    const float xl[4] = {__builtin_bit_cast(float, xw.x << 16), __builtin_bit_cast(float, xw.x & 0xffff0000u), __builtin_bit_cast(float, xw.y << 16), __builtin_bit_cast(float, xw.y & 0xffff0000u)};
                    const f32x4 gr = acc[ai][0][m][n] + bR, gi = acc[ai][1][m][n] + bI;
                    f32x4 av, bv;
#pragma unroll
                    for (int e = 0; e < 4; ++e) {
                        const float rg = __builtin_amdgcn_rcpf(1.0f + __builtin_amdgcn_exp2f(-1.4426950408889634f * gr[e])), ig = __builtin_amdgcn_rcpf(1.0f + __builtin_amdgcn_exp2f(-1.4426950408889634f * gi[e]));
                        const float la2 = rg * sp[e];
                        const float a2 = __builtin_amdgcn_exp2f(2.0f * la2);
                        av[e] = la2; bv[e] = __builtin_amdgcn_sqrtf(fmaxf(1.0f - a2, 0.f)) * (ig * xl[e]); }
                    u32x2 wa, wb; wa.x = cvt_pk_bf16(av[0], av[1]); wa.y = cvt_pk_bf16(av[2], av[3]); wb.x = cvt_pk_bf16(bv[0], bv[1]); wb.y = cvt_pk_bf16(bv[2], bv[3]);
                    *(u32x2*)(LA + ro) = wa; *(u32x2*)(LB + ro) = wb; }
        }
    }
};
struct EpiNone {
    static constexpr bool PERM = true, AFTER_DRAIN = false;
    struct Pre {}; __device__ __forceinline__ void preload(Pre&, const Unit&, int, int, int, int) const {}
    __device__ __forceinline__ void operator()(const f32x4 (&acc)[2][2][4][2], const Unit& u, int wr, int wc, int fr, int fq, const Pre&) const {
#pragma unroll
        for (int a = 0; a < 2; ++a)
#pragma unroll
            for (int b2 = 0; b2 < 2; ++b2)
#pragma unroll
                for (int m = 0; m < 4; ++m)
#pragma unroll
                    for (int n = 0; n < 2; ++n) { f32x4 v = acc[a][b2][m][n]; asm volatile("" :: "v"(v)); }
    }
};
template <bool GATHER_> struct MoeOrderT {
    static constexpr bool GATHER = GATHER_;
    const int* rowtok;
    __device__ __forceinline__ int row_of(int r) const { return GATHER_ ? rowtok[r] : r; }
    const PG8_LAS int* tab; int ntiles, nN, nper, j, m_lo, nMx, wgm, rev;
    __device__ __forceinline__ void init(const PG8_LAS int* tab_, int ntiles_, int nN_, int G, int bx, int wgm_) {
        tab = tab_; ntiles = ntiles_; nN = nN_; wgm = wgm_; rev = 0;
        if (G % 8 == 0) { const int x = bx % 8; nper = G / 8; j = bx / 8; m_lo = (x * ntiles) / 8; nMx = ((x + 1) * ntiles) / 8 - m_lo; }
        else { nper = G; j = bx; m_lo = 0; nMx = ntiles; }
    }
    __device__ __forceinline__ bool next(int i, Unit& u) const {
        const int s = i * nper + j; if (s >= nMx * nN) return false;
        const int nig = wgm * nN, gid = s / nig, fm = gid * wgm, gsz = (nMx - fm) < wgm ? (nMx - fm) : wgm, w = s - gid * nig;
        const int mi = fm + (w % gsz); u.pm = m_lo + (rev ? (nMx - 1 - mi) : mi); u.pn = w / gsz; u.e = tab[u.pm]; u.be = u.e * nN + u.pn; return true;
    }
    __device__ __forceinline__ void a_ready(const Unit&) const {}
    __device__ __forceinline__ void done(const Unit&) const {}
};
template <class Epi, class Sched, bool ALIGN_EPI = false, bool SP2 = false, bool FP8 = false>
__device__ __forceinline__ void gemm_phase(PG8_LAS unsigned char* lds, const Gemm g, const Sched& S, const Epi& E) {
    int tid_ = threadIdx.x; asm volatile("" : "+v"(tid_));
    const int tid = tid_, wid = __builtin_amdgcn_readfirstlane(tid >> 6), lane = tid & 63, wr = wid >> 2, wc = wid & 3, fr = lane & 15, fq = lane >> 4;
    const int K = g.K, nt = K / BK;
    unsigned voffA[2], voffB[2];
#pragma unroll
    for (int i = 0; i < 2; ++i) { int R, C; stage_rc(tid * 16 + i * 8192, R, C); const int Rb = Epi::PERM ? ((R & ~31) + perm32(R & 31)) : R;
        voffA[i] = (unsigned)(R * K + C) * 2u; voffB[i] = (unsigned)(Rb * K + C) * 2u; }
    unsigned gA_[2] = {0u, 0u}, gN_[2] = {0u, 0u}, gC_[2] = {0u, 0u};
    static_assert(!Sched::GATHER || SP2, "the gathered A operand is wired into the SP2 loop only");
    if constexpr (Sched::GATHER) { _Pragma("unroll") for (int i_ = 0; i_ < 2; ++i_) { int R_, C_; stage_rc(tid * 16 + i_ * 8192, R_, C_); gC_[i_] = (unsigned)(C_ * 2); } }
#define PG8_GLOAD(dst, pm_) do { _Pragma("unroll") for (int h_ = 0; h_ < 2; ++h_) { unsigned t_[2]; _Pragma("unroll") for (int i_ = 0; i_ < 2; ++i_) { int R_, C_; stage_rc(tid * 16 + i_ * 8192, R_, C_); \
        t_[i_] = (unsigned)S.row_of((pm_) * BM + h_ * HALF + R_); } dst[h_] = t_[0] | (t_[1] << 16); } } while (0)
    const size_t kstep = (size_t)(BK * 2);
    const size_t hstep = (size_t)HALF * K * 2;
    const size_t tstep = 2 * hstep;
    const unsigned ldsw = (unsigned)wid * 1024u;
    const int aoff = lds_byte(wr * 64 + fr, fq * 8), boff = lds_byte(wc * 32 + fr, fq * 8);
#define PG8_SA(b, h) (((b) * 2 + (h)) * HTB)
#define PG8_SB(b, h) ((4 + (b) * 2 + (h)) * HTB)
#define PG8_STAGE(bufoff, gbase, voff) do { _Pragma("unroll") for (int _i = 0; _i < 2; ++_i) \
        __builtin_amdgcn_global_load_lds((const unsigned*)((const char*)(gbase) + (voff)[_i]), (PG8_LAS unsigned*)(lds + (bufoff) + ldsw + _i * 8192), 16, 0, 0); } while (0)
#define PG8_STA(bufoff, ptr, h, useN) do { if constexpr (Sched::GATHER) { const unsigned pk_ = (useN) ? gN_[h] : gA_[h]; unsigned o_[2] = {(pk_ & 0xffffu) * (unsigned)(K * 2) + gC_[0], (pk_ >> 16) * (unsigned)(K * 2) + gC_[1]}; PG8_STAGE(bufoff, ptr, o_); } \
        else { PG8_STAGE(bufoff, (ptr) + ((h) ? hstep : 0), voffA); } } while (0)
#define PG8_LDA(dst, b, h) do { _Pragma("unroll") for (int m = 0; m < 4; ++m) { if constexpr (FP8) { \
            dst##8[m] = __builtin_shufflevector(*(const PG8_LAS i32x4_*)(lds + PG8_SA(b, h) + aoff + m * 2048), *(const PG8_LAS i32x4_*)(lds + PG8_SA(b, h) + aoff + m * 2048 + 1024), 0, 1, 2, 3, 4, 5, 6, 7); } \
        else { _Pragma("unroll") for (int k = 0; k < 2; ++k) dst[m][k] = *(const PG8_LAS bf16x8*)(lds + PG8_SA(b, h) + aoff + m * 2048 + k * 1024); } } } while (0)
#define PG8_LDB(dst, b, h) do { _Pragma("unroll") for (int n = 0; n < 2; ++n) { if constexpr (FP8) { \
            dst##8[n] = __builtin_shufflevector(*(const PG8_LAS i32x4_*)(lds + PG8_SB(b, h) + boff + n * 2048), *(const PG8_LAS i32x4_*)(lds + PG8_SB(b, h) + boff + n * 2048 + 1024), 0, 1, 2, 3, 4, 5, 6, 7); } \
        else { _Pragma("unroll") for (int k = 0; k < 2; ++k) dst[n][k] = *(const PG8_LAS bf16x8*)(lds + PG8_SB(b, h) + boff + n * 2048 + k * 1024); } } } while (0)
#define PG8_MMA(ai, bj, At, Bt) do { __builtin_amdgcn_s_setprio(1); _Pragma("unroll") for (int m = 0; m < 4; ++m) _Pragma("unroll") for (int n = 0; n < 2; ++n) { \
        if constexpr (FP8) asm volatile("v_mfma_f32_16x16x128_f8f6f4 %0, %1, %2, %0" : "+v"(acc[ai][bj][m][n]) : "v"(Bt##8[n]), "v"(At##8[m]));   \
        else { _Pragma("unroll") for (int k = 0; k < 2; ++k) acc[ai][bj][m][n] = __builtin_amdgcn_mfma_f32_16x16x32_bf16(Bt[n][k], At[m][k], acc[ai][bj][m][n], 0, 0, 0); } } \
        __builtin_amdgcn_s_setprio(0); } while (0)
#define PG8_WAIT_V(n) asm volatile("s_waitcnt vmcnt(" #n ")" ::: "memory")
#define PG8_WAIT_L(n) asm volatile("s_waitcnt lgkmcnt(" #n ")" ::: "memory")
#define PG8_BAR __builtin_amdgcn_s_barrier()
#define PG8_SCHED __builtin_amdgcn_sched_barrier(0)
    Unit cur, nxt; int ui = 0;
    if (!S.next(0, cur)) return;
    f32x4 acc[2][2][4][2];
#pragma unroll
    for (int a = 0; a < 2; ++a)
#pragma unroll
        for (int b = 0; b < 2; ++b)
#pragma unroll
            for (int m = 0; m < 4; ++m)
#pragma unroll
                for (int n = 0; n < 2; ++n) acc[a][b][m][n] = (f32x4){0.f, 0.f, 0.f, 0.f};
    typedef int i32x4_ __attribute__((ext_vector_type(4))); typedef int i32x8_ __attribute__((ext_vector_type(8)));
    bf16x8 At[4][2], B0[2][2], B1[2][2]; i32x8_ At8[4], B08[2], B18[2];
    typename Epi::Pre pre;
    const char* cA = (const char*)g.A + (Sched::GATHER ? (size_t)0 : (size_t)cur.pm * tstep); if constexpr (Sched::GATHER) PG8_GLOAD(gA_, cur.pm);
    const char* cB = (const char*)g.Bt + (size_t)cur.be * tstep;
    S.a_ready(cur);
    if constexpr (SP2) {
        PG8_STAGE(PG8_SB(0, 0), cB, voffB); PG8_STAGE(PG8_SB(0, 1), cB + hstep, voffB); PG8_STA(PG8_SA(0, 0), cA, 0, false); PG8_STA(PG8_SA(0, 1), cA, 1, false);
        if (wr == 1) PG8_BAR;
        PG8_WAIT_V(2); PG8_BAR;
        PG8_STAGE(PG8_SB(1, 0), cB + kstep, voffB); PG8_STA(PG8_SA(1, 0), cA + kstep, 0, false); PG8_STAGE(PG8_SB(1, 1), cB + hstep + kstep, voffB);
        PG8_WAIT_V(6); PG8_BAR;
    } else {
        PG8_STAGE(PG8_SB(0, 0), cB, voffB); PG8_STAGE(PG8_SA(0, 0), cA, voffA); PG8_STAGE(PG8_SB(0, 1), cB + hstep, voffB); PG8_STAGE(PG8_SA(0, 1), cA + hstep, voffA);
        if (wr == 1) PG8_BAR;
        PG8_WAIT_V(4); PG8_BAR;
        PG8_STAGE(PG8_SB(1, 0), cB + kstep, voffB); PG8_STAGE(PG8_SA(1, 0), cA + kstep, voffA); PG8_STAGE(PG8_SB(1, 1), cB + hstep + kstep, voffB);
        PG8_WAIT_V(6); PG8_BAR;
    }
    for (;;) {
        const bool has_next = S.next(ui + 1, nxt);
        const char* nA = (has_next && !Sched::GATHER) ? (const char*)g.A + (size_t)nxt.pm * tstep : cA; const char* nB = has_next ? (const char*)g.Bt + (size_t)nxt.be * tstep : cB;
        if constexpr (Sched::GATHER) { if (has_next) PG8_GLOAD(gN_, nxt.pm); else { gN_[0] = gA_[0]; gN_[1] = gA_[1]; } }
        for (int t = 0; t < nt; t += 2) {
            const bool last = (t == nt - 2);
            const char* a1 = cA + (size_t)(t + 1) * kstep;
            const char* a2 = last ? nA : cA + (size_t)(t + 2) * kstep; const char* b2 = last ? nB : cB + (size_t)(t + 2) * kstep;
            const char* a3 = a2 + kstep; const char* b3 = b2 + kstep;
            if (last) E.preload(pre, cur, wr, wc, fr, fq);
            if (last && has_next) S.a_ready(nxt);
            if constexpr (SP2) {
            PG8_LDB(B0, 0, 0); PG8_LDB(B1, 0, 1); PG8_SCHED; PG8_LDA(At, 0, 0); PG8_STA(PG8_SA(1, 1), a1, 1, false);
            PG8_WAIT_V(8); PG8_WAIT_L(0); PG8_BAR; PG8_MMA(0, 0, At, B0); PG8_MMA(0, 1, At, B1); PG8_BAR; PG8_SCHED;
            PG8_LDA(At, 0, 1); PG8_STAGE(PG8_SB(0, 0), b2, voffB); PG8_STAGE(PG8_SB(0, 1), b2 + hstep, voffB); PG8_STA(PG8_SA(0, 0), a2, 0, last);
            PG8_WAIT_V(8); PG8_WAIT_L(0); PG8_BAR; PG8_MMA(1, 0, At, B0); PG8_MMA(1, 1, At, B1); PG8_BAR; PG8_SCHED;
            PG8_LDB(B0, 1, 0); PG8_LDB(B1, 1, 1); PG8_SCHED; PG8_LDA(At, 1, 0); PG8_STA(PG8_SA(0, 1), a2, 1, last);
            PG8_WAIT_V(8); PG8_WAIT_L(0); PG8_BAR; PG8_MMA(0, 0, At, B0); PG8_MMA(0, 1, At, B1); PG8_BAR; PG8_SCHED;
            PG8_LDA(At, 1, 1); PG8_STAGE(PG8_SB(1, 0), b3, voffB); PG8_STAGE(PG8_SB(1, 1), b3 + hstep, voffB); PG8_STA(PG8_SA(1, 0), a3, 0, last);
            PG8_WAIT_V(8); PG8_WAIT_L(0); PG8_BAR; PG8_MMA(1, 0, At, B0); PG8_MMA(1, 1, At, B1); PG8_BAR; PG8_SCHED;
            } else {
            PG8_LDB(B0, 0, 0); PG8_SCHED; PG8_LDA(At, 0, 0); PG8_STAGE(PG8_SA(1, 1), a1 + hstep, voffA);
            PG8_WAIT_L(8); PG8_BAR; PG8_WAIT_L(0); PG8_MMA(0, 0, At, B0); PG8_BAR; PG8_SCHED;
            PG8_LDB(B1, 0, 1); PG8_STAGE(PG8_SB(0, 0), b2, voffB);
            PG8_BAR; PG8_WAIT_L(0); PG8_MMA(0, 1, At, B1); PG8_BAR;
            PG8_LDA(At, 0, 1); PG8_STAGE(PG8_SA(0, 0), a2, voffA);
            PG8_BAR; PG8_WAIT_L(0); PG8_MMA(1, 0, At, B0); PG8_BAR; PG8_SCHED;
            PG8_STAGE(PG8_SB(0, 1), b2 + hstep, voffB);
            PG8_WAIT_V(6); PG8_BAR; PG8_MMA(1, 1, At, B1); PG8_BAR;
            PG8_LDB(B0, 1, 0); PG8_SCHED; PG8_LDA(At, 1, 0); PG8_STAGE(PG8_SA(0, 1), a2 + hstep, voffA);
            PG8_WAIT_L(8); PG8_BAR; PG8_WAIT_L(0); PG8_MMA(0, 0, At, B0); PG8_BAR; PG8_SCHED;
            PG8_LDB(B1, 1, 1); PG8_STAGE(PG8_SB(1, 0), b3, voffB);
            PG8_BAR; PG8_WAIT_L(0); PG8_MMA(0, 1, At, B1); PG8_BAR;
            PG8_LDA(At, 1, 1); PG8_STAGE(PG8_SA(1, 0), a3, voffA);
            PG8_BAR; PG8_WAIT_L(0); PG8_MMA(1, 0, At, B0); PG8_BAR; PG8_SCHED;
            PG8_STAGE(PG8_SB(1, 1), b3 + hstep, voffB);
            PG8_WAIT_V(6); PG8_BAR; PG8_MMA(1, 1, At, B1); PG8_BAR;
            }
        }
        if constexpr (ALIGN_EPI) { if (wr == 0) PG8_BAR; }
        if constexpr (!Epi::AFTER_DRAIN) { E(acc, cur, wr, wc, fr, fq, pre); S.done(cur); }
        if (!has_next) break;
#pragma unroll
        for (int a = 0; a < 2; ++a)
#pragma unroll
            for (int b = 0; b < 2; ++b)
#pragma unroll
                for (int m = 0; m < 4; ++m)
#pragma unroll
                    for (int n = 0; n < 2; ++n) acc[a][b][m][n] = (f32x4){0.f, 0.f, 0.f, 0.f};
        cur = nxt; cA = nA; cB = nB; ++ui;
        if constexpr (Sched::GATHER) { gA_[0] = gN_[0]; gA_[1] = gN_[1]; }
        if constexpr (ALIGN_EPI) { if (wr == 1) PG8_BAR; }
    }
    PG8_WAIT_V(0);
    if constexpr (!ALIGN_EPI) { if (wr == 0) PG8_BAR; }
    PG8_BAR;
    if constexpr (Epi::AFTER_DRAIN) { E.fused(acc, cur, wr, wc, fr, fq, lds, wid, lane); S.done(cur); }
#undef PG8_SA
#undef PG8_SB
#undef PG8_STAGE
#undef PG8_STA
#undef PG8_GLOAD
#undef PG8_LDA
#undef PG8_LDB
#undef PG8_MMA
#undef PG8_WAIT_V
#undef PG8_WAIT_L
#undef PG8_BAR
#undef PG8_SCHED
}
}

#ifndef PG8_SP2
#define PG8_SP2 true
#endif
#ifndef PG8_ALIGN
#define PG8_ALIGN true
#endif
#include <cmath>
namespace attn_body {
using bf16=__hip_bfloat16;
using bf16x8=__attribute__((ext_vector_type(8)))short;
using s16x4=__attribute__((ext_vector_type(4)))short;
using f32x16=__attribute__((ext_vector_type(16)))float;
using u32x4=__attribute__((ext_vector_type(4)))unsigned;
using f32x4_t=__attribute__((ext_vector_type(4)))float;
constexpr int NHEAD=8,SEQQ=8192,SEQK=8448,D=64,QP=512,KP=128,QIN=2048;
constexpr int NW=8,QBLK=32,QB=QBLK*NW,KVBLK=64,NQB=SEQQ/QB;
constexpr int ATTN_UNIT_ROWS=QB;
__device__ __forceinline__ int crow(int r,int hi){return (r&3)+8*(r>>2)+4*hi;}
#define SBAR() __builtin_amdgcn_sched_barrier(0)
__device__ __forceinline__ void cmask(f32x16&p0,f32x16&p1,int jb,int qrel,int hi){
  const float NEG=-INFINITY; int kb=64*jb+4*hi;
  #pragma unroll
  for(int r=0;r<16;++r){int kv=kb+(r&3)+8*(r>>2); if(kv>qrel)p0[r]=NEG; if(kv+32>qrel)p1[r]=NEG;}
}

constexpr int NSLOT=3, SLOTB=8192;
constexpr int LDS_K=0, LDS_V=NSLOT*SLOTB, LDS_WS=2*NSLOT*SLOTB, LDS_OST=LDS_WS+NW*64*4, LDS_BYTES=LDS_OST+NW*4096;
constexpr float C2=0.125f*1.4426950408889634f;
__device__ __forceinline__ void glds16(const void*gsrc,unsigned lds_dst){unsigned keep;
  asm volatile("s_mov_b32 %0, m0\n\ts_mov_b32 m0, %2\n\ts_nop 0\n\tglobal_load_lds_dwordx4 %1, off\n\ts_mov_b32 m0, %0":"=&s"(keep):"v"(gsrc),"s"(lds_dst):"memory");}
__device__ __forceinline__ float max3f(float a,float b,float c){float r;asm("v_max3_f32 %0, %1, %2, %3":"=v"(r):"v"(a),"v"(b),"v"(c));return r;}
__device__ __forceinline__ float max2f(float a,float b){float r;asm("v_max_f32_e32 %0, %1, %2":"=v"(r):"v"(a),"v"(b));return r;}
__device__ __forceinline__ float fadd_s(float a,float b){float r;asm("v_add_f32_e32 %0, %1, %2":"=v"(r):"v"(a),"v"(b));return r;}
__device__ __forceinline__ float fsub_s(float a,float b){float r;asm("v_sub_f32_e32 %0, %1, %2":"=v"(r):"v"(a),"v"(b));return r;}
typedef float f32x2_t __attribute__((ext_vector_type(2))); typedef __bf16 bf16x2_t __attribute__((ext_vector_type(2)));
__device__ __forceinline__ unsigned cvtpk_s(float lo,float hi){f32x2_t v={lo,hi};bf16x2_t b=__builtin_convertvector(v,bf16x2_t);return __builtin_bit_cast(unsigned,b);}
#define WAIT_BAR(N) asm volatile("s_waitcnt vmcnt(" #N ") lgkmcnt(0)\n\ts_barrier":::"memory")

__device__ __forceinline__ void qkt(f32x16&p0,f32x16&p1,const char*Kslot,const bf16x8*qr,const f32x16&negm,int r32,int hi){
  const char*kb=Kslot+hi*1024+r32*16;
  #pragma unroll
  for(int d0=0;d0<4;++d0){
    const bf16x8 b0=*reinterpret_cast<const bf16x8*>(kb+d0*2048);
    const bf16x8 b1=*reinterpret_cast<const bf16x8*>(kb+d0*2048+512);
    if(d0==0){p0=__builtin_amdgcn_mfma_f32_32x32x16_bf16(b0,qr[0],negm,0,0,0);p1=__builtin_amdgcn_mfma_f32_32x32x16_bf16(b1,qr[0],negm,0,0,0);}
    else{p0=__builtin_amdgcn_mfma_f32_32x32x16_bf16(b0,qr[d0],p0,0,0,0);p1=__builtin_amdgcn_mfma_f32_32x32x16_bf16(b1,qr[d0],p1,0,0,0);}}
}
typedef __attribute__((address_space(3))) const char* lds_cptr;
typedef short v4i16_t __attribute__((ext_vector_type(4)));
__device__ __forceinline__ void kload8(bf16x8*kf,lds_cptr kp){
  kf[0]=*(const __attribute__((address_space(3))) bf16x8*)(kp);      kf[1]=*(const __attribute__((address_space(3))) bf16x8*)(kp+512);
  kf[2]=*(const __attribute__((address_space(3))) bf16x8*)(kp+2048); kf[3]=*(const __attribute__((address_space(3))) bf16x8*)(kp+2560);
  kf[4]=*(const __attribute__((address_space(3))) bf16x8*)(kp+4096); kf[5]=*(const __attribute__((address_space(3))) bf16x8*)(kp+4608);
  kf[6]=*(const __attribute__((address_space(3))) bf16x8*)(kp+6144); kf[7]=*(const __attribute__((address_space(3))) bf16x8*)(kp+6656);
}
__device__ __forceinline__ void kload2(bf16x8*kf,lds_cptr kp,int j){ kf[2*j]=*(const __attribute__((address_space(3))) bf16x8*)(kp+j*2048); kf[2*j+1]=*(const __attribute__((address_space(3))) bf16x8*)(kp+j*2048+512); }
__device__ __forceinline__ s16x4 vtr(lds_cptr p){ return __builtin_bit_cast(s16x4,__builtin_amdgcn_ds_read_tr16_b64_v4i16((__attribute__((address_space(3))) v4i16_t*)p)); }
__device__ __forceinline__ float rowmax(const f32x16&p0,const f32x16&p1){
  float a=max3f(p0[0],p0[1],p1[0]),b=max3f(p0[2],p0[3],p1[1]);a=max3f(a,p1[2],p1[3]);
  #pragma unroll
  for(int r=4;r<16;r+=4){a=max3f(a,p0[r],p0[r+1]);b=max3f(b,p0[r+2],p0[r+3]);a=max3f(a,p1[r],p1[r+1]);b=max3f(b,p1[r+2],p1[r+3]);}
  const float m=max2f(a,b);
  auto rr=__builtin_amdgcn_permlane32_swap(__float_as_uint(m),__float_as_uint(m),false,false);
  return max2f(__uint_as_float(rr[0]),__uint_as_float(rr[1]));
}
__device__ __forceinline__ void pv(f32x16*o,int vb,bf16x8 pa0,bf16x8 pa1,bf16x8 pa2,bf16x8 pa3){
  #pragma unroll
  for(int d0=0;d0<2;++d0){s16x4 lo[4],hi[4];
    #pragma unroll
    for(int ks=0;ks<4;++ks){
      asm volatile("ds_read_b64_tr_b16 %0,%1 offset:%c2":"=&v"(lo[ks]):"v"(vb),"i"(d0*4096+ks*1024):"memory");
      asm volatile("ds_read_b64_tr_b16 %0,%1 offset:%c2":"=&v"(hi[ks]):"v"(vb),"i"(d0*4096+ks*1024+512):"memory");}
    asm volatile("s_waitcnt lgkmcnt(0)":::"memory");SBAR();
    #define PK(k) (bf16x8){lo[k][0],lo[k][1],lo[k][2],lo[k][3],hi[k][0],hi[k][1],hi[k][2],hi[k][3]}
    o[d0]=__builtin_amdgcn_mfma_f32_32x32x16_bf16(pa0,PK(0),o[d0],0,0,0);
    o[d0]=__builtin_amdgcn_mfma_f32_32x32x16_bf16(pa1,PK(1),o[d0],0,0,0);
    o[d0]=__builtin_amdgcn_mfma_f32_32x32x16_bf16(pa2,PK(2),o[d0],0,0,0);
    o[d0]=__builtin_amdgcn_mfma_f32_32x32x16_bf16(pa3,PK(3),o[d0],0,0,0);
    #undef PK
  }
}

#ifndef ATTN_STORE16
#define ATTN_STORE16(p,v) (*(u32x4*)(p)=(v))
#endif
struct QPre { const float* qg; const float* rc; const float* rs; };
template<int THRL> __device__ __forceinline__ void attn_unit(int b,int h,long qrow0,int NTarg,int tq0,const QPre&QN,const bf16*Q,const bf16*__restrict__ K,const bf16*__restrict__ V,bf16*O,char*shm){
  int tid_=threadIdx.x; asm volatile("":"+v"(tid_)); const int tid=tid_,lane=tid&63,r32=lane&31,hi=lane>>5; const int wid=__builtin_amdgcn_readfirstlane(tid>>6);
  const long krowbase=(long)b*SEQK; const int kvh=h>>2;
  const bf16*Qw=Q+(qrow0+wid*QBLK)*QIN+h*D;
  const bf16*Kh=K+krowbase*KP+kvh*D,*Vh=V+krowbase*KP+kvh*D;
  const unsigned lds0=(unsigned)(uintptr_t)shm;
  float*wsf=(float*)(shm+LDS_WS)+wid*64;
  const bf16*ksrc=Kh+(long)lane*KP+wid*8;
  const bf16*vsrc=Vh+(long)(16*(wid&3)+(lane>>2))*KP+(wid>>2)*32+(lane&3)*8;
  const unsigned kdst=lds0+LDS_K+wid*1024, vdst=lds0+LDS_V+wid*1024;
  #define DMA_K(t,slot) glds16(ksrc+(long)(t)*KVBLK*KP,(unsigned)__builtin_amdgcn_readfirstlane(kdst+(slot)))
  #define DMA_V(t,slot) glds16(vsrc+(long)(t)*KVBLK*KP,(unsigned)__builtin_amdgcn_readfirstlane(vdst+(slot)))
  const int vb0=(int)(lds0+LDS_V)+((lane>>4)&1)*32+(lane&3)*8+(4*hi+((lane&15)>>2))*64;
  const char*Kbase=shm+LDS_K; bf16x8 kf[8];
  const lds_cptr shm3=(lds_cptr)shm; const lds_cptr kp0=shm3+LDS_K+hi*1024+r32*16; const lds_cptr vp0=shm3+LDS_V+((lane>>4)&1)*32+(lane&3)*8+(4*hi+((lane&15)>>2))*64;
  const int NT=NTarg;
  DMA_K(0,0);DMA_V(0,0);DMA_K(1,SLOTB);
  bf16x8 qr[4];
  #pragma unroll
  for(int d0=0;d0<4;++d0)qr[d0]=*reinterpret_cast<const bf16x8*>(&Qw[(long)r32*QIN+d0*16+hi*8]);
  {
    float x[4][8]; float ss=0.f;
    #pragma unroll
    for(int d0=0;d0<4;++d0){
      #pragma unroll
      for(int e=0;e<8;++e){ x[d0][e]=__builtin_bit_cast(float,(unsigned)(unsigned short)qr[d0][e]<<16); ss+=x[d0][e]*x[d0][e]; } }
    ss+=__shfl_xor(ss,32);
    const float rstd=C2/sqrtf(ss*(1.0f/64.0f)+1e-6f);
    #pragma unroll
    for(int d0=0;d0<4;++d0){ const f32x4_t g0=*reinterpret_cast<const f32x4_t*>(QN.qg+16*d0+8*hi), g1=*reinterpret_cast<const f32x4_t*>(QN.qg+16*d0+8*hi+4);
      #pragma unroll
      for(int e=0;e<8;++e) x[d0][e]*=rstd*(e<4?g0[e]:g1[e-4]); }
    if(tq0>=0){ const int t=tq0+wid*QBLK+r32;
      #pragma unroll
      for(int d0=0;d0<2;++d0){ const float*cp=QN.rc+(long)t*32+16*d0+8*hi,*sp=QN.rs+(long)t*32+16*d0+8*hi;
        const f32x4_t c0=*reinterpret_cast<const f32x4_t*>(cp),c1=*reinterpret_cast<const f32x4_t*>(cp+4),s0=*reinterpret_cast<const f32x4_t*>(sp),s1=*reinterpret_cast<const f32x4_t*>(sp+4);
        #pragma unroll
        for(int e=0;e<8;++e){ const float cs=e<4?c0[e]:c1[e-4], sn=e<4?s0[e]:s1[e-4]; const float a=x[d0][e], bq=x[d0+2][e]; x[d0][e]=a*cs-bq*sn; x[d0+2][e]=bq*cs+a*sn; } } }
    #pragma unroll
    for(int d0=0;d0<4;++d0){ u32x4 pk; pk[0]=cvtpk_s(x[d0][0],x[d0][1]); pk[1]=cvtpk_s(x[d0][2],x[d0][3]); pk[2]=cvtpk_s(x[d0][4],x[d0][5]); pk[3]=cvtpk_s(x[d0][6],x[d0][7]); qr[d0]=__builtin_bit_cast(bf16x8,pk); }
  }
  float mhat=0.f,l_reg=0.f;f32x16 o[2];o[0]=f32x16{};o[1]=f32x16{};f32x16 negm=f32x16{};asm volatile("":"+v"(negm));
  const int qrel=wid*QBLK+r32;
  #define CMASK(P0,P1,t) do{}while(0)
  bool resc=false;
  #define START(P0,P1) do{ const float rm=rowmax(P0,P1); resc=false; \
    { const float dl=rm; mhat=fadd_s(mhat,dl); \
      _Pragma("unroll") for(int r=0;r<16;++r){P0[r]=fsub_s(P0[r],dl);P1[r]=fsub_s(P1[r],dl);} \
      _Pragma("unroll") for(int r=0;r<16;++r)negm[r]=-mhat; asm volatile("":"+v"(negm)); } \
    _Pragma("unroll") for(int r=0;r<16;++r)P0[r]=__builtin_amdgcn_exp2f(P0[r]); }while(0)
  #define RESC() do{ if(resc){ asm volatile("s_waitcnt lgkmcnt(0)":::"memory"); \
      _Pragma("unroll") for(int d_=0;d_<2;++d_) _Pragma("unroll") for(int r=0;r<16;++r)o[d_][r]*=wsf[crow(r,hi)]; } }while(0)
  f32x16 pA0,pA1,pB0,pB1;
  int sl_prev=0,sl_cur=0,sl_next=SLOTB;
  #define ROT() do{sl_prev=sl_cur;sl_cur=sl_next;sl_next=(sl_next==(NSLOT-1)*SLOTB)?0:sl_next+SLOTB;}while(0)
  DMA_K(2,2*SLOTB);
  WAIT_BAR(3);
  qkt(pA0,pA1,Kbase,qr,negm,r32,hi);asm volatile("s_nop 15\n\ts_nop 7":"+v"(pA0),"+v"(pA1));CMASK(pA0,pA1,0);
  START(pA0,pA1);
  _Pragma("unroll") for(int r=0;r<16;++r)pA1[r]=__builtin_amdgcn_exp2f(pA1[r]);
  WAIT_BAR(0);
  DMA_K(3,0);DMA_V(1,SLOTB);
  ROT();
  kload8(kf,kp0+sl_cur);
  WAIT_BAR(2);
  s16x4 vlo[8],vhi[8]; u32x4 pw0,pw1,pw2,pw3;
  #define PKW(P,B) cvtpk_s(P[B],P[B+1])
  #define PAF(k) __builtin_bit_cast(bf16x8,pw##k)
  #define VFR(i) (bf16x8){vlo[i][0],vlo[i][1],vlo[i][2],vlo[i][3],vhi[i][0],vhi[i][1],vhi[i][2],vhi[i][3]}
  #define PIN(x) asm volatile("":"+v"(x))
  #define MX3(a,b,c) __builtin_fmaxf(__builtin_fmaxf((a),(b)),(c))
  #define GAPA(MF,A0,A1,A2,A3,W0,W1,PW) do{ MF; sacc+=A0; sacc+=A1; sacc+=A2; sacc+=A3; PIN(sacc); W0; W1; PIN(PW); SBAR(); }while(0)
  #define EX(v) __builtin_amdgcn_exp2f(v)
  #define GAPB(MF,X,B) do{ MF; X[B]=EX(X[B]); X[B+1]=EX(X[B+1]); X[B+2]=EX(X[B+2]); X[B+3]=EX(X[B+3]); PIN(X); SBAR(); }while(0)
  #define VRD(i) do{ vlo[i]=vtr(vp_+(((i)>>2)*4096+((i)&3)*1024)); vhi[i]=vtr(vp_+(((i)>>2)*4096+((i)&3)*1024+512)); }while(0)
  #define KRD(G,j) do{ if(G){ kload2(kf,kp0+sl_next,j); SBAR(); } }while(0)
  #define STEP(C0,C1,P0,P1,t,GK,GV,GL) do{ SBAR(); \
    const lds_cptr vp_=vp0+sl_prev; \
    VRD(0); SBAR(); float sacc=(P0[0]+P0[1]); \
    GAPA(C0=__builtin_amdgcn_mfma_f32_32x32x16_bf16(kf[0],qr[0],negm,0,0,0), P0[2],P0[3],P0[4],P0[5],     pw0[0]=PKW(P0,0), pw0[1]=PKW(P0,2), pw0); \
    VRD(4); SBAR(); GAPA(C1=__builtin_amdgcn_mfma_f32_32x32x16_bf16(kf[1],qr[0],negm,0,0,0), P0[6],P0[7],P0[8],P0[9],     pw0[2]=PKW(P0,4), pw0[3]=PKW(P0,6), pw0); \
    VRD(1); SBAR(); GAPA(C0=__builtin_amdgcn_mfma_f32_32x32x16_bf16(kf[2],qr[1],C0,0,0,0),   P0[10],P0[11],P0[12],P0[13], pw1[0]=PKW(P0,8), pw1[1]=PKW(P0,10), pw1); \
    VRD(5); SBAR(); GAPA(C1=__builtin_amdgcn_mfma_f32_32x32x16_bf16(kf[3],qr[1],C1,0,0,0),   P0[14],P0[15],P1[0],P1[1],   pw1[2]=PKW(P0,12),pw1[3]=PKW(P0,14), pw1); \
    VRD(2); SBAR(); GAPA(C0=__builtin_amdgcn_mfma_f32_32x32x16_bf16(kf[4],qr[2],C0,0,0,0),   P1[2],P1[3],P1[4],P1[5],     pw2[0]=PKW(P1,0), pw2[1]=PKW(P1,2), pw2); \
    VRD(6); SBAR(); GAPA(C1=__builtin_amdgcn_mfma_f32_32x32x16_bf16(kf[5],qr[2],C1,0,0,0),   P1[6],P1[7],P1[8],P1[9],     pw2[2]=PKW(P1,4), pw2[3]=PKW(P1,6), pw2); \
    VRD(3); SBAR(); GAPA(C0=__builtin_amdgcn_mfma_f32_32x32x16_bf16(kf[6],qr[3],C0,0,0,0),   P1[10],P1[11],P1[12],P1[13], pw3[0]=PKW(P1,8), pw3[1]=PKW(P1,10), pw3); \
    VRD(7); SBAR(); GAPA(C1=__builtin_amdgcn_mfma_f32_32x32x16_bf16(kf[7],qr[3],C1,0,0,0),   P1[14],P1[15],0.f,0.f,       pw3[2]=PKW(P1,12),pw3[3]=PKW(P1,14), pw3); \
    l_reg+=sacc; \
    if(GK){DMA_K((t)+3,sl_cur);} if(GV){DMA_V((t)+1,sl_next);} \
    CMASK(C0,C1,t); \
    { float a=MX3(C0[0],C0[1],C1[0]),b=MX3(C0[2],C0[3],C1[1]); a=MX3(a,C1[2],C1[3]); \
      _Pragma("unroll") for(int r=4;r<16;r+=4){a=MX3(a,C0[r],C0[r+1]);b=MX3(b,C0[r+2],C0[r+3]);a=MX3(a,C1[r],C1[r+1]);b=MX3(b,C1[r+2],C1[r+3]);} \
      float rm=__builtin_fmaxf(a,b); { auto rr=__builtin_amdgcn_permlane32_swap(__float_as_uint(rm),__float_as_uint(rm),false,false); rm=__builtin_fmaxf(__uint_as_float(rr[0]),__uint_as_float(rr[1])); } \
      resc=false; \
      if(__builtin_expect(__any(rm>(float)THRL),0)){ const float dl=__builtin_fmaxf(rm,0.f); mhat+=dl; \
        _Pragma("unroll") for(int r=0;r<16;++r){C0[r]-=dl;C1[r]-=dl;} \
        _Pragma("unroll") for(int r=0;r<16;++r)negm[r]=-mhat; asm volatile("":"+v"(negm)); \
        const float f=__builtin_amdgcn_exp2f(-dl); l_reg*=f; if(hi==0)wsf[r32]=f; resc=true; } } \
    SBAR(); \
    GAPB(o[0]=__builtin_amdgcn_mfma_f32_32x32x16_bf16(PAF(0),VFR(0),o[0],0,0,0), C0,0); \
    GAPB(o[1]=__builtin_amdgcn_mfma_f32_32x32x16_bf16(PAF(0),VFR(4),o[1],0,0,0), C0,4); \
    KRD(GL,0); GAPB(o[0]=__builtin_amdgcn_mfma_f32_32x32x16_bf16(PAF(1),VFR(1),o[0],0,0,0), C0,8); \
    KRD(GL,1); GAPB(o[1]=__builtin_amdgcn_mfma_f32_32x32x16_bf16(PAF(1),VFR(5),o[1],0,0,0), C0,12); \
    KRD(GL,2); GAPB(o[0]=__builtin_amdgcn_mfma_f32_32x32x16_bf16(PAF(2),VFR(2),o[0],0,0,0), C1,0); \
    KRD(GL,3); GAPB(o[1]=__builtin_amdgcn_mfma_f32_32x32x16_bf16(PAF(2),VFR(6),o[1],0,0,0), C1,4); \
    GAPB(o[0]=__builtin_amdgcn_mfma_f32_32x32x16_bf16(PAF(3),VFR(3),o[0],0,0,0), C1,8); \
    GAPB(o[1]=__builtin_amdgcn_mfma_f32_32x32x16_bf16(PAF(3),VFR(7),o[1],0,0,0), C1,12); \
    }while(0)
  int t=1;
  #undef CMASK
  #define CMASK(P0,P1,t) do{}while(0)
  for(;t+5<NT;t+=2){
    STEP(pB0,pB1,pA0,pA1,t,true,true,true);     WAIT_BAR(2); RESC(); ROT();
    STEP(pA0,pA1,pB0,pB1,t+1,true,true,true);   WAIT_BAR(2); RESC(); ROT();
  }
  #undef CMASK
  #define CMASK(P0,P1,t) do{}while(0)
  #define ENDW(tt) do{ if((tt)+3<NT){WAIT_BAR(2);} else if((tt)+2<NT){WAIT_BAR(1);} else {WAIT_BAR(0);} }while(0)
  for(;t+1<NT;t+=2){
    STEP(pB0,pB1,pA0,pA1,t,(t+3<NT),(t+1<NT),(t+1<NT));       ENDW(t);   RESC(); ROT();
    STEP(pA0,pA1,pB0,pB1,t+1,(t+4<NT),(t+2<NT),(t+2<NT));     ENDW(t+1); RESC(); ROT();
  }
  STEP(pB0,pB1,pA0,pA1,NT-1,false,false,false); RESC();
  { float sacc=pB0[0]+pB0[1]; _Pragma("unroll") for(int r=2;r<16;++r)sacc+=pB0[r]; _Pragma("unroll") for(int r=0;r<16;++r)sacc+=pB1[r]; l_reg+=sacc;
    pw0=(u32x4){PKW(pB0,0),PKW(pB0,2),PKW(pB0,4),PKW(pB0,6)};pw1=(u32x4){PKW(pB0,8),PKW(pB0,10),PKW(pB0,12),PKW(pB0,14)};pw2=(u32x4){PKW(pB1,0),PKW(pB1,2),PKW(pB1,4),PKW(pB1,6)};pw3=(u32x4){PKW(pB1,8),PKW(pB1,10),PKW(pB1,12),PKW(pB1,14)};
    SBAR(); pv(o,vb0+sl_cur,PAF(0),PAF(1),PAF(2),PAF(3)); }
  #undef PKW
  #undef PAF
  #undef VFR
  #undef PIN
  #undef MX3
  #undef GAPA
  #undef GAPB
  #undef EX
  #undef VRD
  #undef KRD
  #undef STEP
  #undef ENDW
  {auto rr=__builtin_amdgcn_permlane32_swap(__float_as_uint(l_reg),__float_as_uint(l_reg),false,false);l_reg=__uint_as_float(rr[0])+__uint_as_float(rr[1]);}
  if(hi==0)wsf[32+r32]=l_reg;asm volatile("s_waitcnt lgkmcnt(0)":::"memory");
  float rli[16];
  #pragma unroll
  for(int r=0;r<16;++r)rli[r]=__builtin_amdgcn_rcpf(wsf[32+crow(r,hi)]);
  bf16*Ow=O+(qrow0+wid*QBLK)*QP+h*D;
  { bf16*stg=(bf16*)(shm+LDS_OST)+wid*2048;
    #pragma unroll
    for(int r=0;r<16;++r){const int orow=crow(r,hi);
      #pragma unroll
      for(int d0=0;d0<2;++d0)stg[orow*64+d0*32+r32]=__float2bfloat16(o[d0][r]*rli[r]);}
    asm volatile("s_waitcnt lgkmcnt(0)":::"memory");
    #pragma unroll
    for(int i=0;i<4;++i){const int row=i*8+(lane>>3),ch=lane&7; const u32x4 v=*(const u32x4*)(stg+row*64+ch*8); ATTN_STORE16(Ow+(long)row*QP+ch*8,v);} }
  asm volatile("s_waitcnt lgkmcnt(0)\n\ts_barrier":::"memory");
  #undef DMA_K
  #undef DMA_V
  #undef CMASK
  #undef START
  #undef RESC
  #undef ROT
}
constexpr int ATTN_LDS_BYTES=LDS_BYTES;
struct AttnTensors { const bf16* Q; const bf16* K; const bf16* V; bf16* O; };
template<int THRL=8> __device__ __forceinline__ void attn_phase(char*lds,const AttnTensors&T,const QPre&QN,int G,int vcu,bool with_ctx,long ctx_row0){
  const int total=4*NHEAD*NQB;
  for(int i=0;;++i){
    int x,n;
    if(G==256){ if(i>=4)break; x=vcu>>5; n=i*32+(vcu&31); }
    else { const int u=i*G+vcu; if(u>=total)break; x=u>>7; n=u&127; }
    const int b=x>>1,kvh=x&1,h=kvh*4+(n>>5),qb=n&31;
    attn_unit<THRL>(b,h,(long)b*SEQQ+(long)qb*QB,SEQK/KVBLK,qb*QB,QN,T.Q,T.K,T.V,T.O,lds);
  }
  if(with_ctx){
    for(int u=vcu;u<4*NHEAD;u+=G){ const int b=u>>3,h=u&7; attn_unit<THRL>(b,h,ctx_row0+(long)b*256,4,-1,QN,T.Q,T.K,T.V,T.O,lds); }
  }
}
#undef SBAR
#undef WAIT_BAR
}

constexpr int NWAVES = 8, NTHR = 512;
constexpr int DMODEL = 1024, NB = 4, SEQ = 8192, CTXL = 256, NLAT = NB * SEQ, NCTX = NB * CTXL, MT = NLAT + NCTX;
constexpr int INW = 2048, NE = 32, KEYS = SEQ + CTXL;
constexpr int SORT_TILES = 560, SORT_ROWS = SORT_TILES * 256;
constexpr float EPSN = 1e-6f;
constexpr int NCHUNK = 66, CHUNK = 128;
constexpr int NPH_PRO = 2, NPH_LAYER = 13, NPH = NPH_PRO + 2 * NPH_LAYER;

constexpr size_t MiB = 1u << 20;
constexpr size_t WS_CTL = 0, CTL_ZERO_BYTES = 1 * MiB;
constexpr size_t WS_MOD = 1 * MiB, WS_ROPEC = 2 * MiB, WS_ROPES = 3 * MiB, WS_H2 = 4 * MiB, WS_KFC = 10 * MiB, WS_BLKCNT = 12 * MiB, WS_TILEE = 13 * MiB, WS_SCANS = 14 * MiB;
constexpr size_t WS_WINT = 16 * MiB, WS_WOUTT = 24 * MiB, WS_W1T = 32 * MiB, WS_W2T = 288 * MiB, WS_KF = 416 * MiB, WS_KHAT = 448 * MiB, WS_XR = 512 * MiB, WS_H = 644 * MiB;
constexpr size_t WS_U = 712 * MiB, WS_Q = 844 * MiB, WS_K = 877 * MiB, WS_V = 886 * MiB, WS_ATT = 895 * MiB, WS_LAB = 928 * MiB, WS_LRUO = 1060 * MiB, WS_VT = 1093 * MiB, WS_X0T = 1125 * MiB,
                 WS_HYO = 1157 * MiB, WS_MIXA = 1190 * MiB;
constexpr size_t WS_WGT = 11 * MiB, WS_SPT = 10 * MiB + 768 * 1024, WS_XL = 1256 * MiB;
constexpr size_t WS_GC = 10 * MiB + 896 * 1024;
constexpr size_t WS_CB = 10 * MiB + 960 * 1024;
constexpr size_t WS_F = 712 * MiB, WS_ASORT = 778 * MiB, WS_ACT = 1058 * MiB, WS_YS = 1338 * MiB, WS_TOPI = 1618 * MiB, WS_GATE = 1619 * MiB, WS_POS = 1620 * MiB, WS_RSSP = 1622 * MiB, WS_ROWTOK = 1625 * MiB, WS_END = 1626 * MiB;
constexpr size_t LAB_STRIDE = (size_t)MT * 256;
constexpr int CW_BAR = 4096;
constexpr int CW_NTILES = 64;

constexpr int RING_OFF = 0, RING_BYTES = 131072, MOETAB_OFF = 131072, LDSCTL_OFF = 155648, LDS_BYTES = 156160;

#define GAS __attribute__((address_space(1)))
#define LAS __attribute__((address_space(3)))
typedef unsigned short bf16;
typedef unsigned v4u __attribute__((ext_vector_type(4)));
typedef unsigned v2u __attribute__((ext_vector_type(2)));
typedef float f32x4 __attribute__((ext_vector_type(4)));
#define LDS_WAIT() asm volatile("s_waitcnt lgkmcnt(0)" ::: "memory")
#define VM_WAIT() asm volatile("s_waitcnt vmcnt(0)" ::: "memory")
__device__ __forceinline__ unsigned f2bf(float f) { unsigned u = __builtin_bit_cast(unsigned, f); return (u + 0x7fffu + ((u >> 16) & 1u)) >> 16; }
__device__ __forceinline__ unsigned pk2(float lo, float hi) { return f2bf(lo) | (f2bf(hi) << 16); }
__device__ __forceinline__ float bf2f(unsigned short b) { return __builtin_bit_cast(float, (unsigned)b << 16); }
__device__ __forceinline__ float bflo(unsigned w) { return __builtin_bit_cast(float, w << 16); }
__device__ __forceinline__ float bfhi(unsigned w) { return __builtin_bit_cast(float, w & 0xffff0000u); }
__device__ __forceinline__ float wave_sum(float v) {
#pragma unroll
    for (int o = 1; o < 64; o <<= 1) v += __shfl_xor(v, o);
    return v;
}
__device__ __forceinline__ float sigmoidf_(float x) { return 1.0f / (1.0f + __expf(-x)); }
__device__ __forceinline__ void sincos_d(double x, double& s, double& c) {
    const double kd = __builtin_rint(x * 0.63661977236758134308);
    const int k = (int)kd;
    double r = __builtin_fma(-kd, 1.57079632673412561417e+00, x);
    r = __builtin_fma(-kd, 6.07710050650619224932e-11, r);
    const double z = r * r;
    const double ps = r + r * z * (-1.66666666666666324348e-01 + z * (8.33333333332248946124e-03 + z * (-1.98412698298579493134e-04 + z * (2.75573137070700676789e-06 + z * (-2.50507602534068634195e-08 + z * 1.58969099521155010221e-10)))));
    const double pc = 1.0 - 0.5 * z + z * z * (4.16666666666666019037e-02 + z * (-1.38888888888741095749e-03 + z * (2.48015872894767294178e-05 + z * (-2.75573143513906633035e-07 + z * (2.08757232129817482790e-09 + z * -1.13596475577881948265e-11)))));
    const int q = k & 3;
    s = (q == 0) ? ps : (q == 1) ? pc : (q == 2) ? -ps : -pc;
    c = (q == 0) ? pc : (q == 1) ? -ps : (q == 2) ? -pc : ps;
}
__device__ __forceinline__ float gelu_tanh(float x) {
    const float u = 0.7978845608028654f * (x + 0.044715f * x * x * x);
    const float t = 1.0f - 2.0f / (1.0f + __expf(2.0f * u));
    return 0.5f * x * (1.0f + t);
}
__device__ __forceinline__ int lds_add(LAS int* p, int v) { return __hip_atomic_fetch_add(p, v, __ATOMIC_RELAXED, __HIP_MEMORY_SCOPE_WORKGROUP); }

#define FFT_FN __device__ __forceinline__
typedef float f32x2v __attribute__((ext_vector_type(2)));
#define FFT_VEC2 f32x2v
#define FFT_DPTR LAS f32x2v*
#define FFT_LD(D, i) c32_from((D)[i])
#define FFT_ST(D, i, v) ((D)[i] = c32_to(v))
struct __attribute__((aligned(8))) c32 { float x, y; };
FFT_FN c32 cmul(c32 a, c32 b) { c32 r; r.x = a.x * b.x - a.y * b.y; r.y = a.x * b.y + a.y * b.x; return r; }
FFT_FN c32 cadd(c32 a, c32 b) { c32 r; r.x = a.x + b.x; r.y = a.y + b.y; return r; }
FFT_FN c32 csub(c32 a, c32 b) { c32 r; r.x = a.x - b.x; r.y = a.y - b.y; return r; }
FFT_FN c32 cmuli_neg(c32 a) { c32 r; r.x = a.y; r.y = -a.x; return r; }
FFT_FN int fpad(int a) { return a + (a >> 4); }
#ifdef FFT_VEC2
FFT_FN c32 c32_from(FFT_VEC2 t) { c32 r; r.x = t.x; r.y = t.y; return r; }
FFT_FN FFT_VEC2 c32_to(c32 a) { FFT_VEC2 t; t.x = a.x; t.y = a.y; return t; }
#endif
FFT_FN void dft4(c32& a0, c32& a1, c32& a2, c32& a3) {
    const c32 s02 = cadd(a0, a2), d02 = csub(a0, a2), s13 = cadd(a1, a3), d13 = cmuli_neg(csub(a1, a3));
    a0 = cadd(s02, s13); a2 = csub(s02, s13); a1 = cadd(d02, d13); a3 = csub(d02, d13);
}
FFT_FN void dft16(c32 (&v)[16]) {
    const float C1 = 0.92387953251128674f, S1 = 0.38268343236508977f, C2 = 0.70710678118654752f;
#pragma unroll
    for (int q2 = 0; q2 < 4; ++q2) dft4(v[q2], v[4 + q2], v[8 + q2], v[12 + q2]);
    { c32 w;
      w.x = C1; w.y = -S1; v[4 * 1 + 1] = cmul(v[4 * 1 + 1], w);
      w.x = C2; w.y = -C2; v[4 * 2 + 1] = cmul(v[4 * 2 + 1], w);
      w.x = S1; w.y = -C1; v[4 * 3 + 1] = cmul(v[4 * 3 + 1], w);
      w.x = C2; w.y = -C2; v[4 * 1 + 2] = cmul(v[4 * 1 + 2], w);
      v[4 * 2 + 2] = cmuli_neg(v[4 * 2 + 2]);
      w.x = -C2; w.y = -C2; v[4 * 3 + 2] = cmul(v[4 * 3 + 2], w);
      w.x = S1; w.y = -C1; v[4 * 1 + 3] = cmul(v[4 * 1 + 3], w);
      w.x = -C2; w.y = -C2; v[4 * 2 + 3] = cmul(v[4 * 2 + 3], w);
      w.x = -C1; w.y = S1; v[4 * 3 + 3] = cmul(v[4 * 3 + 3], w); }
#pragma unroll
    for (int p1 = 0; p1 < 4; ++p1) dft4(v[4 * p1 + 0], v[4 * p1 + 1], v[4 * p1 + 2], v[4 * p1 + 3]);
#pragma unroll
    for (int a = 0; a < 4; ++a)
#pragma unroll
        for (int b = a + 1; b < 4; ++b) { const c32 t = v[4 * a + b]; v[4 * a + b] = v[4 * b + a]; v[4 * b + a] = t; }
}
FFT_FN c32 twid(int j, int n) { float rev = (float)j / (float)n; asm volatile("" : "+v"(rev)); c32 w; w.x = __builtin_amdgcn_cosf(rev); w.y = -__builtin_amdgcn_sinf(rev); return w; }

FFT_FN void fft_fwd16(FFT_DPTR D, int g, int n) {
    const int s = n >> 4, blk = g / s, j = g - blk * s, base = blk * n + j;
    c32 v[16];
#pragma unroll
    for (int q = 0; q < 16; ++q) v[q] = FFT_LD(D, fpad(base + q * s));
    dft16(v);
    const c32 w = twid(j, n); c32 wp = w;
#pragma unroll
    for (int p = 1; p < 16; ++p) { v[p] = cmul(v[p], wp); wp = cmul(wp, w); }
#pragma unroll
    for (int p = 0; p < 16; ++p) FFT_ST(D, fpad(base + p * s), v[p]);
}
FFT_FN void fft_inv16(FFT_DPTR D, int g, int n) {
    const int s = n >> 4, blk = g / s, j = g - blk * s, base = blk * n + j;
    c32 v[16];
#pragma unroll
    for (int q = 0; q < 16; ++q) v[q] = FFT_LD(D, fpad(base + q * s));
    const c32 w = twid(j, n); c32 wp = w;
#pragma unroll
    for (int p = 1; p < 16; ++p) { v[p] = cmul(v[p], wp); wp = cmul(wp, w); }
    dft16(v);
#pragma unroll
    for (int p = 0; p < 16; ++p) FFT_ST(D, fpad(base + p * s), v[p]);
}
FFT_FN void fft_mid16(FFT_DPTR D, int g, const c32* KH) {
    c32 v[16];
#pragma unroll
    for (int q = 0; q < 16; ++q) v[q] = FFT_LD(D, 17 * g + q);
    dft16(v);
#pragma unroll
    for (int p = 0; p < 16; ++p) { const c32 k = KH[16 * g + p]; const c32 t = cmul(v[p], k); v[p].x = t.x; v[p].y = -t.y; }
    dft16(v);
#pragma unroll
    for (int p = 0; p < 16; ++p) FFT_ST(D, 17 * g + p, v[p]);
}
FFT_FN void fft_last16_out(FFT_DPTR D, int g, c32* OUT, float scale) {
    c32 v[16];
#pragma unroll
    for (int q = 0; q < 16; ++q) v[q] = FFT_LD(D, 17 * g + q);
    dft16(v);
#pragma unroll
    for (int p = 0; p < 16; ++p) { c32 t; t.x = v[p].x * scale; t.y = v[p].y * scale; OUT[16 * g + p] = t; }
}
FFT_FN void fft_first4(FFT_DPTR D, int j, c32 x0, c32 x1, c32 x2, c32 x3) {
    dft4(x0, x1, x2, x3);
    const c32 w = twid(j, 16384), w2 = cmul(w, w), w3 = cmul(w2, w);
    FFT_ST(D, fpad(j), x0); FFT_ST(D, fpad(j + 4096), cmul(x1, w)); FFT_ST(D, fpad(j + 8192), cmul(x2, w2)); FFT_ST(D, fpad(j + 12288), cmul(x3, w3));
}
FFT_FN void fft_final4(FFT_DPTR D, int j, c32& u0, c32& u1) {
    const c32 w = twid(j, 16384), w2 = cmul(w, w), w3 = cmul(w2, w);
    c32 a0 = FFT_LD(D, fpad(j)), a1 = cmul(FFT_LD(D, fpad(j + 4096)), w), a2 = cmul(FFT_LD(D, fpad(j + 8192)), w2), a3 = cmul(FFT_LD(D, fpad(j + 12288)), w3);
    dft4(a0, a1, a2, a3);
    u0 = a0; u1 = a1;
}
FFT_FN void fft_first4_inplace(FFT_DPTR D, int j) {
    c32 x0 = FFT_LD(D, fpad(j)), x1 = FFT_LD(D, fpad(j + 4096)), x2 = FFT_LD(D, fpad(j + 8192)), x3 = FFT_LD(D, fpad(j + 12288));
    fft_first4(D, j, x0, x1, x2, x3);
}
#define XB_TMO      128
#define XB_XCNT(j)  (256  + 64 * (j))
#define XB_XSUB(j)  (1280 + 64 * (j))
#define XB_XGEN(j)  (2304 + 64 * (j))
#define XB_TOP      3328
#define XB_TOPGEN   3392
#define XCD_BAR_WORDS 3456
#define XB_SPIN_CAP (1u << 22)

__device__ __forceinline__ unsigned xb_ld(unsigned* p)              { return __hip_atomic_load(p, __ATOMIC_RELAXED, __HIP_MEMORY_SCOPE_AGENT); }
__device__ __forceinline__ unsigned xb_add(unsigned* p, unsigned v) { return __hip_atomic_fetch_add(p, v, __ATOMIC_RELAXED, __HIP_MEMORY_SCOPE_AGENT); }
__device__ __forceinline__ unsigned xb_xcc_id() { return (unsigned)__builtin_amdgcn_s_getreg((3 << 11) | 20) & 0xFu; }
#define XB_SPIN(cond, bar) do { unsigned _sp = 0; while (cond) { __builtin_amdgcn_s_sleep(1); \
    if ((++_sp & 255u) == 0u) { if (xb_ld(&(bar)[XB_TMO])) break; if (_sp > XB_SPIN_CAP) { atomicAdd(&(bar)[XB_TMO], 1u); break; } } } } while (0)

struct XcdBarrier {
    unsigned* bar; unsigned x;
    volatile LAS unsigned* st;
};

__device__ __forceinline__ XcdBarrier xcd_barrier_post(unsigned* bar, volatile LAS unsigned* st) {
    XcdBarrier b; b.bar = bar; b.x = xb_xcc_id(); b.st = st;
    if (threadIdx.x == 0) (void)xb_add(&bar[XB_XCNT(b.x)], 1u);
    return b;
}
__device__ __forceinline__ void xcd_barrier_complete(unsigned* bar, unsigned x, unsigned& nloc, unsigned& nx) {
    const unsigned G = gridDim.x * gridDim.y * gridDim.z;
    unsigned sum, cnt, mine, sp = 0u;
    for (;;) {
        sum = 0u; cnt = 0u; mine = 0u;
#pragma unroll
        for (unsigned j = 0; j < 16; ++j) { const unsigned c = xb_ld(&bar[XB_XCNT(j)]); sum += c; cnt += (c > 0u) ? 1u : 0u; mine = (j == x) ? c : mine; }
        if (sum == G) break;
        __builtin_amdgcn_s_sleep(1);
        if ((++sp & 255u) == 0u) { if (xb_ld(&bar[XB_TMO])) break; if (sp > XB_SPIN_CAP) { atomicAdd(&bar[XB_TMO], 1u); break; } }
    }
    nloc = mine > 0u ? mine : 1u; nx = cnt > 0u ? cnt : 1u;
}

__device__ __forceinline__ void xcd_barrier(const XcdBarrier& b) {
    asm volatile("s_waitcnt vmcnt(0)" ::: "memory");
    __syncthreads();
    if (threadIdx.x == 0) {
        unsigned* bar = b.bar;
        __builtin_amdgcn_s_waitcnt(0);
        unsigned nloc = b.st[0], nx = b.st[1];
        if (nloc == 0u) { xcd_barrier_complete(bar, b.x, nloc, nx); b.st[0] = nloc; b.st[1] = nx; }
        const unsigned old = xb_add(&bar[XB_XSUB(b.x)], 1u);
        const unsigned gen = old / nloc;
        if (old + 1u == (gen + 1u) * nloc) {
            __builtin_amdgcn_fence(__ATOMIC_RELEASE, "agent");
            asm volatile("s_waitcnt vmcnt(0)" ::: "memory");
            const unsigned og = xb_add(&bar[XB_TOP], 1u);
            const unsigned tg = og / nx;
            if (og + 1u == (tg + 1u) * nx) xb_add(&bar[XB_TOPGEN], 1u);
            else XB_SPIN(xb_ld(&bar[XB_TOPGEN]) == tg, bar);
            __builtin_amdgcn_fence(__ATOMIC_ACQUIRE, "agent");
            xb_add(&bar[XB_XGEN(b.x)], 1u);
            asm volatile("s_waitcnt vmcnt(0)" ::: "memory");
        } else {
            XB_SPIN(xb_ld(&bar[XB_XGEN(b.x)]) == gen, bar);
            __builtin_amdgcn_fence(__ATOMIC_ACQUIRE, "agent");
            asm volatile("s_waitcnt vmcnt(0)" ::: "memory");
        }
    }
    __syncthreads();
}


struct Frame {
    LAS unsigned char* lds; unsigned* ctl; unsigned char* ws;
    int tid, lane, wave, vcu, G, gw, ngw;
};
__device__ const float ROPE_INV[16] = {1.0f, 0.5623413251903491f, 0.31622776601683794f, 0.1778279410038923f, 0.1f, 0.05623413251903491f, 0.03162277660168379f, 0.01778279410038923f,
                                       0.01f, 0.005623413251903491f, 0.0031622776601683794f, 0.001778279410038923f, 0.001f, 0.0005623413251903491f, 0.00031622776601683794f, 0.0001778279410038923f};

__device__ __forceinline__ void p0_transpose_item(const float* W, int K, int N, bf16* WT, LAS float* scr, int item, int lane) {
    const int nblk = N / 32, kb = item / nblk, nb = item % nblk, k0 = 64 * kb, n0 = 32 * nb;
#pragma unroll 8
    for (int i = 0; i < 32; ++i) { const int kk = 2 * i + (lane >> 5); scr[kk * 33 + (lane & 31)] = W[(size_t)(k0 + kk) * N + n0 + (lane & 31)]; }
    LDS_WAIT(); asm volatile("" ::: "memory");
    const int c = lane & 7;
#pragma unroll
    for (int j = 0; j < 4; ++j) { const int n = (lane >> 3) + 8 * j; const LAS float* s = scr + (8 * c) * 33 + n;
        v4u o; o.x = pk2(s[0 * 33], s[1 * 33]); o.y = pk2(s[2 * 33], s[3 * 33]); o.z = pk2(s[4 * 33], s[5 * 33]); o.w = pk2(s[6 * 33], s[7 * 33]);
        *(GAS v4u*)(WT + (size_t)(n0 + n) * K + k0 + 8 * c) = o; }
    LDS_WAIT(); asm volatile("" ::: "memory");
}

__device__ __forceinline__ void p0_transpose_item_f8(const float* W, int K, int N, unsigned char* WT, LAS float* scr, int item, int lane) {
    const int nblk = N / 32, kb = item / nblk, nb = item % nblk, k0 = 64 * kb, n0 = 32 * nb;
#pragma unroll 8
    for (int i = 0; i < 32; ++i) { const int kk = 2 * i + (lane >> 5); scr[kk * 33 + (lane & 31)] = W[(size_t)(k0 + kk) * N + n0 + (lane & 31)]; }
    LDS_WAIT(); asm volatile("" ::: "memory");
    const int c = lane & 7;
#pragma unroll
    for (int j = 0; j < 4; ++j) { const int n = (lane >> 3) + 8 * j; const LAS float* s = scr + (8 * c) * 33 + n;
        v2u o; o.x = pg8::pack4_fp8(s[0 * 33] * pg8::F8_SW, s[1 * 33] * pg8::F8_SW, s[2 * 33] * pg8::F8_SW, s[3 * 33] * pg8::F8_SW);
        o.y = pg8::pack4_fp8(s[4 * 33] * pg8::F8_SW, s[5 * 33] * pg8::F8_SW, s[6 * 33] * pg8::F8_SW, s[7 * 33] * pg8::F8_SW);
        *(GAS v2u*)(WT + (size_t)(n0 + n) * K + k0 + 8 * c) = o; }
    LDS_WAIT(); asm volatile("" ::: "memory");
}

__device__ __forceinline__ void ph_prologue_a(const Frame& F, const float* c, const float* cctx, const float* w_mod, const float* b_mod, const float* w_in, const float* w_out,
                                              const float* moe_w1, const float* moe_w2, const float* hy_w1, const float* hy_b1, const float* hy_w2, const float* hy_b2, const float* hy_freq, const float* lru_gw, const float* lru_lam) {
    {
        LAS float* scr = (LAS float*)(F.lds + F.wave * 16384);
        constexpr int I_IN = 2 * 1024, I_OUT = 2 * 512, I_W1 = 64 * 1024, I_W2 = 64 * 512, NIT = I_IN + I_OUT + I_W1 + I_W2;
        bf16* WinT = (bf16*)(F.ws + WS_WINT); bf16* WoutT = (bf16*)(F.ws + WS_WOUTT); bf16* W1T = (bf16*)(F.ws + WS_W1T); bf16* W2T = (bf16*)(F.ws + WS_W2T);
        for (int it = F.gw; it < NIT; it += F.ngw) {
            int r = it;
            if (r < I_IN) { const int m = r >> 10; p0_transpose_item(w_in + (size_t)m * 1024 * 2048, 1024, 2048, WinT + (size_t)m * 2048 * 1024, scr, r & 1023, F.lane); continue; } r -= I_IN;
            if (r < I_OUT) { const int m = r >> 9; p0_transpose_item(w_out + (size_t)m * 1024 * 1024, 1024, 1024, WoutT + (size_t)m * 1024 * 1024, scr, r & 511, F.lane); continue; } r -= I_OUT;
#if MOE_FP8
            if (r < I_W1) { const int m = r >> 10; p0_transpose_item_f8(moe_w1 + (size_t)m * 1024 * 2048, 1024, 2048, (unsigned char*)W1T + (size_t)m * 2048 * 1024, scr, r & 1023, F.lane); continue; } r -= I_W1;
            { const int m = r >> 9; p0_transpose_item_f8(moe_w2 + (size_t)m * 1024 * 1024, 1024, 1024, (unsigned char*)W2T + (size_t)m * 1024 * 1024, scr, r & 511, F.lane); }
#else
            if (r < I_W1) { const int m = r >> 10; p0_transpose_item(moe_w1 + (size_t)m * 1024 * 2048, 1024, 2048, W1T + (size_t)m * 2048 * 1024, scr, r & 1023, F.lane); continue; } r -= I_W1;
            { const int m = r >> 9; p0_transpose_item(moe_w2 + (size_t)m * 1024 * 1024, 1024, 1024, W2T + (size_t)m * 1024 * 1024, scr, r & 511, F.lane); }
#endif
        }
    }
    __syncthreads();
    {
        LAS float* sl = (LAS float*)(F.lds);
        LAS float* red = (LAS float*)(F.lds + 20480);
        float* MOD = (float*)(F.ws + WS_MOD);
        if ((int)blockIdx.x < 192) {
            for (int i = F.tid; i < 5 * 1024; i += NTHR) { const int r = i >> 10, k = i & 1023; const float v = (r < 4) ? c[r * 1024 + k] : cctx[k]; sl[i] = v / (1.0f + __expf(-v)); }
        }
        __syncthreads();
        for (int it = blockIdx.x; it < 192; it += F.G) {
            const int l = it / 96, n = (it % 96) * 64 + F.lane;
            float a0 = 0.f, a1 = 0.f, a2 = 0.f, a3 = 0.f, a4 = 0.f;
            const float* wp = w_mod + ((size_t)l * 1024 + F.wave * 128) * 6144 + n;
#pragma unroll 8
            for (int k = 0; k < 128; ++k) { const float w = wp[(size_t)k * 6144]; const int kk = F.wave * 128 + k;
                a0 += sl[kk] * w; a1 += sl[1024 + kk] * w; a2 += sl[2048 + kk] * w; a3 += sl[3072 + kk] * w; a4 += sl[4096 + kk] * w; }
            red[(F.wave * 5 + 0) * 64 + F.lane] = a0; red[(F.wave * 5 + 1) * 64 + F.lane] = a1; red[(F.wave * 5 + 2) * 64 + F.lane] = a2; red[(F.wave * 5 + 3) * 64 + F.lane] = a3; red[(F.wave * 5 + 4) * 64 + F.lane] = a4;
            __syncthreads();
            if (F.tid < 320) { const int r = F.tid >> 6, ln = F.tid & 63; float s = 0.f;
#pragma unroll
                for (int w = 0; w < 8; ++w) s += red[(w * 5 + r) * 64 + ln];
                const int nn = (it % 96) * 64 + ln; MOD[(size_t)(l * 5 + r) * 6144 + nn] = s + b_mod[l * 6144 + nn]; }
            __syncthreads();
        }
    }
    {
        bf16* WGT = (bf16*)(F.ws + WS_WGT); float* SPT = (float*)(F.ws + WS_SPT);
        for (int idx = blockIdx.x * NTHR + F.tid; idx < 2 * 1024 * 256; idx += F.G * NTHR) {
            const int l = idx >> 18, nidx = (idx >> 8) & 1023, k = idx & 255;
            const int pn = nidx >> 8, j = (nidx >> 7) & 1, cc = nidx & 127, d = pn >> 1, ch = 128 * (pn & 1) + cc, n = ch >> 6, e = ch & 63;
            const float v = ((k >> 6) == n) ? lru_gw[((size_t)((((l * 2 + d) * 2 + j) * 4 + n) * 64 + (k & 63))) * 64 + e] : 0.f;
            WGT[idx] = (bf16)f2bf(v); }
        for (int idx = blockIdx.x * NTHR + F.tid; idx < 2 * 2 * 256; idx += F.G * NTHR) SPT[idx] = log1pf(expf(-lru_lam[idx]));
    }
    {
        float* RC = (float*)(F.ws + WS_ROPEC); float* RS = (float*)(F.ws + WS_ROPES);
        for (int idx = blockIdx.x * NTHR + F.tid; idx < SEQ * 32; idx += F.G * NTHR) {
            const int t = idx >> 5, i = idx & 31; const int pos = (i < 16) ? (t >> 6) : (t & 63);
            const float ang = (float)pos * ROPE_INV[i & 15];
            double s, cc; sincos_d((double)ang, s, cc); RC[idx] = (float)cc; RS[idx] = (float)s; }
    }
    {
        float* H2 = (float*)(F.ws + WS_H2);
        for (int it = F.gw; it < 2 * SEQ + CTXL; it += F.ngw) {
            const int v = it >> 13, t = (v < 2) ? (it & (SEQ - 1)) : (it - 2 * SEQ), L = (v < 2) ? SEQ : CTXL, l = (v == 1) ? 1 : 0;
            const int j = F.lane;
            float z = 0.f;
            if (j == 0) z = (float)t / (float)(L - 1);
            else if (j <= 32) { const int b = (j - 1) & 15; const float band = 1e-4f + (float)b * ((15.0f - 1e-4f) / 15.0f);
                const float ang = ((6.283185307179586f / (float)L) * (float)t) * band;
                double s, cc; sincos_d((double)ang, s, cc); z = (j <= 16) ? (float)cc : -(float)s; }
            const float fr = hy_freq[l * 64 + j];
            float p1 = hy_b1[l * 64 + j];
            const float* w1 = hy_w1 + (size_t)l * 33 * 64;
#pragma unroll
            for (int i = 0; i < 33; ++i) p1 += __shfl(z, i) * w1[i * 64 + j];
            double s1, c1; sincos_d((double)(fr * p1), s1, c1); const float h1 = (float)s1;
            float p2 = hy_b2[l * 64 + j];
            const float* w2 = hy_w2 + (size_t)l * 64 * 64;
#pragma unroll 16
            for (int i = 0; i < 64; ++i) p2 += __shfl(h1, i) * w2[i * 64 + j];
            double s2, c2; sincos_d((double)(fr * p2), s2, c2);
            H2[((size_t)v * SEQ + t) * 64 + j] = (float)s2;
        }
    }
}

__device__ __forceinline__ void ph_prologue_b(const Frame& F, const float* hy_w3, const float* hy_decay, const float* gffn, const float* router_w, const float* router_b) {
    { const float* MOD = (const float*)(F.ws + WS_MOD); float* CB = (float*)(F.ws + WS_CB);
      for (int it = F.gw; it < 2 * 5 * 32; it += F.ngw) { const int lb = it >> 5, e = it & 31, l = lb / 5; const float* sf = MOD + (size_t)lb * 6144 + 3 * 1024; float s = 0.f;
#pragma unroll
          for (int q = 0; q < 16; ++q) { const int cc = 64 * q + F.lane; s += sf[cc] * router_w[(size_t)l * 32768 + cc * 32 + e]; }
          s = wave_sum(s); if (F.lane == 0) CB[it] = s + router_b[l * 32 + e]; } }
    { const float* MOD = (const float*)(F.ws + WS_MOD); float* GC = (float*)(F.ws + WS_GC);
      for (int idx = blockIdx.x * NTHR + F.tid; idx < 2 * 5 * 1024; idx += F.G * NTHR) { const int lb = idx >> 10, cc = idx & 1023, l = lb / 5; GC[idx] = gffn[l * 1024 + cc] * (1.0f + MOD[(size_t)lb * 6144 + 4 * 1024 + cc]); } }
    LAS f32x2v* D = (LAS f32x2v*)(F.lds);
    LAS float* kt = (LAS float*)(F.lds);
    LAS float* w3c = (LAS float*)(F.lds + 139264);
    LAS float* red = (LAS float*)(F.lds + 139264 + 512);
    const float* H2 = (const float*)(F.ws + WS_H2);
    c32* KHAT = (c32*)(F.ws + WS_KHAT); float* KFC = (float*)(F.ws + WS_KFC);
    for (int it = blockIdx.x; it < 768; it += F.G) {
        const int v = it >> 8, c = it & 255, L = (v < 2) ? SEQ : CTXL, l = (v == 1) ? 1 : 0;
        if (F.tid < 128) w3c[F.tid] = hy_w3[(size_t)l * 64 * 512 + (F.tid & 63) * 512 + (F.tid >> 6) * 256 + c];
        if (F.tid == 0) { if (v < 2) { f32x2v z; z.x = 0.f; z.y = 0.f; D[fpad(L)] = z; } else kt[L] = 0.f; }
        __syncthreads();
        const float df = fabsf(hy_decay[l * 512 + c]), db = fabsf(hy_decay[l * 512 + 256 + c]);
        float asum = 0.f;
        for (int t = F.tid; t < L; t += NTHR) {
            const f32x4* row = (const f32x4*)(H2 + ((size_t)v * SEQ + t) * 64);
            float hf = 0.f, hb = 0.f;
#pragma unroll
            for (int q = 0; q < 16; ++q) { const f32x4 h = row[q];
                hf += h.x * w3c[4 * q] + h.y * w3c[4 * q + 1] + h.z * w3c[4 * q + 2] + h.w * w3c[4 * q + 3];
                hb += h.x * w3c[64 + 4 * q] + h.y * w3c[64 + 4 * q + 1] + h.z * w3c[64 + 4 * q + 2] + h.w * w3c[64 + 4 * q + 3]; }
            const float t01 = (float)t / (float)(L - 1);
            hf *= expf(-t01 * df); hb *= expf(-t01 * db);
            asum += fabsf(hf); if (t >= 1) asum += fabsf(hb);
            if (v < 2) { f32x2v z; z.x = hf; z.y = 0.f; D[fpad(t)] = z; if (t >= 1) { z.x = hb; D[fpad(2 * L - t)] = z; } }
            else { kt[t] = hf; if (t >= 1) kt[2 * L - t] = hb; }
        }
        asum = wave_sum(asum);
        if (F.lane == 0) red[F.wave] = asum;
        __syncthreads();
        float tot = 0.f;
#pragma unroll
        for (int w = 0; w < 8; ++w) tot += red[w];
        const float inv = 1.0f / tot;
        if (v < 2) {
            c32* out = KHAT + (size_t)(v * 256 + c) * 16384;
#pragma unroll 1
            for (int i = 0; i < 8; ++i) fft_first4_inplace(D, F.tid + 512 * i);
            __syncthreads();
            { fft_fwd16(D, F.tid, 4096); fft_fwd16(D, F.tid + 512, 4096); }
            __syncthreads();
            { fft_fwd16(D, F.tid, 256); fft_fwd16(D, F.tid + 512, 256); }
            __syncthreads();
            _Pragma("unroll 1") for (int g_ = F.tid; g_ < 1024; g_ += 512) fft_last16_out(D, g_, out, inv * (1.0f / 16384.0f));
        } else {
            float* dst = KFC + (size_t)c * 512;
            for (int j = F.tid; j < 2 * L; j += NTHR) dst[j] = kt[j] * inv;
        }
        __syncthreads();
    }
}

__device__ __forceinline__ void ph_norm_mod(const Frame& F, int l, const float* x, const float* ctx, const float* gmix) {
    const float* XR = (const float*)(F.ws + WS_XR); const float* MOD = (const float*)(F.ws + WS_MOD); bf16* H = (bf16*)(F.ws + WS_H);
    for (int r = F.gw; r < MT; r += F.ngw) {
        const float* src = (l == 0) ? (r < NLAT ? x + (size_t)r * 1024 : ctx + (size_t)(r - NLAT) * 1024) : XR + (size_t)r * 1024;
        const int bidx = r < NLAT ? r / SEQ : 4;
        const float* shift = MOD + (size_t)(l * 5 + bidx) * 6144; const float* scale = shift + 1024; const float* g = gmix + l * 1024;
        f32x4 v[4]; float ss = 0.f;
#pragma unroll
        for (int j = 0; j < 4; ++j) { v[j] = ((const f32x4*)src)[64 * j + F.lane]; ss += (v[j].x * v[j].x + v[j].y * v[j].y) + (v[j].z * v[j].z + v[j].w * v[j].w); }
        const float rstd = 1.0f / sqrtf(wave_sum(ss) * (1.0f / 1024.0f) + EPSN);
#pragma unroll
        for (int j = 0; j < 4; ++j) { const int cb = 64 * j + F.lane; const f32x4 gg = ((const f32x4*)g)[cb], sc = ((const f32x4*)scale)[cb], sh = ((const f32x4*)shift)[cb];
            const f32x4 y = v[j] * rstd * gg * (sc + 1.0f) + sh;
            v2u o; o.x = pk2(y.x, y.y); o.y = pk2(y.z, y.w); ((v2u*)(H + (size_t)r * 1024))[cb] = o; }
    }
}

__device__ __forceinline__ void ph_post_proj(const Frame& F, int l, const float* qg_, const float* kg_, const float* lru_cw, const float* lru_cb, const float* hy_cw, const float* hy_cb) {
    const bf16* U = (const bf16*)(F.ws + WS_U);
    {
        bf16* K = (bf16*)(F.ws + WS_K); bf16* V = (bf16*)(F.ws + WS_V);
        const float* RC = (const float*)(F.ws + WS_ROPEC); const float* RS = (const float*)(F.ws + WS_ROPES);
        const int o8 = 8 * (F.lane & 7), hl = F.lane & 31;
        const f32x4 kg0 = *(const f32x4*)(kg_ + l * 64 + o8), kg1 = *(const f32x4*)(kg_ + l * 64 + o8 + 4);
        const bool lohalf = (F.lane & 4) == 0;
        for (int r2 = 2 * F.gw; r2 < MT; r2 += 2 * F.ngw) {
            const int r = r2 + (F.lane >> 5);
            const bool isctx = r >= NLAT; const int b = isctx ? (r - NLAT) / CTXL : r / SEQ; const int t = isctx ? (r - NLAT) % CTXL : r % SEQ;
            const v4u wk = ((const v4u*)(U + (size_t)r * INW + 512))[hl];
            f32x4 c0 = {1.f, 1.f, 1.f, 1.f}, c1 = c0, s0 = {0.f, 0.f, 0.f, 0.f}, s1 = s0;
            if (!isctx) { const float* rc = RC + t * 32 + 8 * (F.lane & 3); const float* rs = RS + t * 32 + 8 * (F.lane & 3);
                c0 = *(const f32x4*)rc; c1 = *(const f32x4*)(rc + 4); s0 = *(const f32x4*)rs; s1 = *(const f32x4*)(rs + 4); }
            const size_t krow = (size_t)b * KEYS + (isctx ? t : CTXL + t);
            float x[8] = {bflo(wk.x), bfhi(wk.x), bflo(wk.y), bfhi(wk.y), bflo(wk.z), bfhi(wk.z), bflo(wk.w), bfhi(wk.w)};
            float ss = 0.f;
#pragma unroll
            for (int i = 0; i < 8; ++i) ss += x[i] * x[i];
            ss += __shfl_xor(ss, 1); ss += __shfl_xor(ss, 2); ss += __shfl_xor(ss, 4);
            const float rstd = 1.0f / sqrtf(ss * (1.0f / 64.0f) + EPSN);
            float y[8], o[8];
#pragma unroll
            for (int i = 0; i < 8; ++i) y[i] = x[i] * rstd * (i < 4 ? kg0[i] : kg1[i - 4]);
#pragma unroll
            for (int i = 0; i < 8; ++i) { const float p = __shfl_xor(y[i], 4); const float cs = i < 4 ? c0[i] : c1[i - 4], sn = i < 4 ? s0[i] : s1[i - 4];
                o[i] = lohalf ? (y[i] * cs - p * sn) : (y[i] * cs + p * sn); }
            v4u ow; ow.x = pk2(o[0], o[1]); ow.y = pk2(o[2], o[3]); ow.z = pk2(o[4], o[5]); ow.w = pk2(o[6], o[7]);
            if (hl < 16) ((v4u*)(K + krow * 128))[hl] = ow; else ((v4u*)(V + krow * 128))[hl - 16] = wk;
        }
    }
    {
        bf16* XL = (bf16*)(F.ws + WS_XL);
        for (int idx = blockIdx.x * NTHR + F.tid; idx < MT * 32; idx += F.G * NTHR) {
            const int r = idx >> 5, c8 = (idx & 31) * 8;
            const bool isctx = r >= NLAT; const int Ls = isctx ? CTXL : SEQ; const int t = isctx ? (r - NLAT) % CTXL : r % SEQ;
            float acc[8];
#pragma unroll
            for (int i = 0; i < 8; ++i) acc[i] = lru_cb[l * 256 + c8 + i];
#pragma unroll
            for (int j = 0; j < 4; ++j) { const int tj = t + j - 2;
                if (tj >= 0 && tj < Ls) { const v4u w = *(const v4u*)(U + (size_t)(r + j - 2) * INW + 768 + c8);
                    const f32x4 w0 = *(const f32x4*)(lru_cw + (l * 4 + j) * 256 + c8), w1 = *(const f32x4*)(lru_cw + (l * 4 + j) * 256 + c8 + 4);
                    acc[0] += w0.x * bflo(w.x); acc[1] += w0.y * bfhi(w.x); acc[2] += w0.z * bflo(w.y); acc[3] += w0.w * bfhi(w.y);
                    acc[4] += w1.x * bflo(w.z); acc[5] += w1.y * bfhi(w.z); acc[6] += w1.z * bflo(w.w); acc[7] += w1.w * bfhi(w.w); } }
            v4u o; o.x = pk2(acc[0], acc[1]); o.y = pk2(acc[2], acc[3]); o.z = pk2(acc[4], acc[5]); o.w = pk2(acc[6], acc[7]);
            *(v4u*)(XL + (size_t)r * 256 + c8) = o;
        }
    }
    __syncthreads();
    {
        LAS bf16* hs = (LAS bf16*)(F.lds);
        bf16* VT = (bf16*)(F.ws + WS_VT); bf16* X0T = (bf16*)(F.ws + WS_X0T);
        const float* cw = hy_cw + (size_t)l * 3 * 768; const float* cbp = hy_cb + l * 768;
        for (int it = blockIdx.x; it < NLAT / 64; it += F.G) {
            const int b = it >> 7, t0 = (it & 127) * 64;
            for (int i = F.tid; i < 66 * 384; i += NTHR) { const int rr = i / 384, c2 = i - rr * 384; const int t = t0 - 1 + rr;
                unsigned w = 0u; if (t >= 0 && t < SEQ) w = *(const unsigned*)(U + (size_t)(b * SEQ + t) * INW + 1280 + 2 * c2);
                *(LAS unsigned*)(hs + rr * 770 + 2 * c2) = w; }
            __syncthreads();
            for (int c = F.wave; c < 256; c += NWAVES) {
                const int tt = F.lane;
                float o[3];
#pragma unroll
                for (int g = 0; g < 3; ++g) { const int cc = g * 256 + c;
                    o[g] = cw[cc] * bf2f(hs[tt * 770 + cc]) + cw[768 + cc] * bf2f(hs[(tt + 1) * 770 + cc]) + cw[1536 + cc] * bf2f(hs[(tt + 2) * 770 + cc]) + cbp[cc]; }
                const size_t oi = ((size_t)b * 256 + c) * SEQ + t0 + tt;
                VT[oi] = (bf16)f2bf(o[2] * o[1]); X0T[oi] = (bf16)f2bf(o[0]);
            }
            __syncthreads();
        }
    }
}


__device__ __forceinline__ int chunk_row0(int b, int d, int k) {
    if (k < 2) { const int cc = d ? 1 - k : k; return NLAT + b * CTXL + cc * CHUNK; }
    const int lc = d ? 63 - (k - 2) : (k - 2); return b * SEQ + lc * CHUNK;
}
__device__ __forceinline__ void ph_scan1(const Frame& F) {
    const bf16* LAB = (const bf16*)(F.ws + WS_LAB); float* SUMP = (float*)(F.ws + WS_SCANS); float* SUMH = SUMP + NB * 2 * NCHUNK * 256;
    for (int it = blockIdx.x * NTHR + F.tid; it < NB * 2 * NCHUNK * 256; it += F.G * NTHR) {
        const int ch = it & 255, k = (it >> 8) % NCHUNK, bd = (it >> 8) / NCHUNK, d = bd & 1, b = bd >> 1;
        const int r0 = chunk_row0(b, d, k);
        const bf16* LA = LAB + (size_t)(2 * d) * LAB_STRIDE + ch; const bf16* LB = LAB + (size_t)(2 * d + 1) * LAB_STRIDE + ch;
        float h = 0.f, Ps = 0.f;
#pragma unroll 16
        for (int i = 0; i < CHUNK; ++i) { const int r = d ? r0 + CHUNK - 1 - i : r0 + i; const float la = bf2f(LA[(size_t)r * 256]), bx = bf2f(LB[(size_t)r * 256]); h = __builtin_amdgcn_exp2f(la) * h + bx; Ps += la; }
        SUMP[it] = __builtin_amdgcn_exp2f(Ps); SUMH[it] = h;
    }
}
__device__ __forceinline__ void ph_scan2(const Frame& F) {
    const bf16* LAB = (const bf16*)(F.ws + WS_LAB); const float* SUMP = (const float*)(F.ws + WS_SCANS); const float* SUMH = SUMP + NB * 2 * NCHUNK * 256;
    float* LRUO = (float*)(F.ws + WS_LRUO); const bf16* U = (const bf16*)(F.ws + WS_U);
    for (int it = blockIdx.x * NTHR + F.tid; it < NB * NCHUNK * 256; it += F.G * NTHR) {
        const int ch = it & 255, kc = (it >> 8) % NCHUNK, b = (it >> 8) / NCHUNK;
        const int r0 = chunk_row0(b, 0, kc);
#pragma unroll 1
        for (int d = 0; d < 2; ++d) {
            const int k = d ? ((kc < 2) ? 1 - kc : 2 + 63 - (kc - 2)) : kc;
            const size_t sb = (size_t)((b * 2 + d) * NCHUNK) * 256 + ch;
            float h = 0.f;
#pragma unroll 8
            for (int j = 0; j < k; ++j) h = SUMP[sb + (size_t)j * 256] * h + SUMH[sb + (size_t)j * 256];
            const bf16* LA = LAB + (size_t)(2 * d) * LAB_STRIDE + ch; const bf16* LB = LAB + (size_t)(2 * d + 1) * LAB_STRIDE + ch;
            if (d == 0) {
#pragma unroll 16
                for (int i = 0; i < CHUNK; ++i) { const int r = r0 + i; h = __builtin_amdgcn_exp2f(bf2f(LA[(size_t)r * 256])) * h + bf2f(LB[(size_t)r * 256]); LRUO[(size_t)r * 256 + ch] = h; }
            } else {
#pragma unroll 8
                for (int i = 0; i < CHUNK; ++i) { const int r = r0 + CHUNK - 1 - i; h = __builtin_amdgcn_exp2f(bf2f(LA[(size_t)r * 256])) * h + bf2f(LB[(size_t)r * 256]);
                    const float lg = bf2f(U[(size_t)r * INW + 1024 + ch]);
                    LRUO[(size_t)r * 256 + ch] = (LRUO[(size_t)r * 256 + ch] + h) * gelu_tanh(lg); }
            }
        }
    }
}

__device__ __forceinline__ void ph_hyena_fft(const Frame& F, int l, const float* hy_bias) {
    LAS f32x2v* D = (LAS f32x2v*)(F.lds);
    const c32* KHAT = (const c32*)(F.ws + WS_KHAT) + (size_t)l * 256 * 16384;
    const bf16* VT = (const bf16*)(F.ws + WS_VT); const bf16* X0T = (const bf16*)(F.ws + WS_X0T); bf16* HYO = (bf16*)(F.ws + WS_HYO);
    for (int it = blockIdx.x; it < 512; it += F.G) {
        const int c = it >> 1, bp = it & 1;
        const bf16* va = VT + ((size_t)(bp * 2) * 256 + c) * SEQ; const bf16* vb = VT + ((size_t)(bp * 2 + 1) * 256 + c) * SEQ;
#ifndef REP_FFT
#define REP_FFT 1
#endif
#pragma unroll 1
        for (int repf_ = 0; repf_ < REP_FFT; ++repf_) {
#pragma unroll 1
        for (int i = 0; i < 8; ++i) { const int j = F.tid + 512 * i; c32 x0, x1, z; x0.x = bf2f(va[j]); x0.y = bf2f(vb[j]); x1.x = bf2f(va[j + 4096]); x1.y = bf2f(vb[j + 4096]); z.x = 0.f; z.y = 0.f;
            fft_first4(D, j, x0, x1, z, z); }
        __syncthreads();
        { fft_fwd16(D, F.tid, 4096); fft_fwd16(D, F.tid + 512, 4096); }
        __syncthreads();
        { fft_fwd16(D, F.tid, 256); fft_fwd16(D, F.tid + 512, 256); }
        __syncthreads();
        _Pragma("unroll 1") for (int g_ = F.tid; g_ < 1024; g_ += 512) fft_mid16(D, g_, KHAT + (size_t)c * 16384);
        __syncthreads();
        { fft_inv16(D, F.tid, 256); fft_inv16(D, F.tid + 512, 256); }
        __syncthreads();
        { fft_inv16(D, F.tid, 4096); fft_inv16(D, F.tid + 512, 4096); }
        __syncthreads();
        }
        const float bias = hy_bias[l * 256 + c];
        const bf16* xa = X0T + ((size_t)(bp * 2) * 256 + c) * SEQ; const bf16* xb = X0T + ((size_t)(bp * 2 + 1) * 256 + c) * SEQ;
        bf16* oa = HYO + ((size_t)(bp * 2) * 256 + c) * SEQ; bf16* ob = HYO + ((size_t)(bp * 2 + 1) * 256 + c) * SEQ;
#pragma unroll 2
        for (int i = 0; i < 8; ++i) { const int j = F.tid + 512 * i; c32 u0, u1; fft_final4(D, j, u0, u1);
            oa[j] = (bf16)f2bf((u0.x + bf2f(va[j]) * bias) * bf2f(xa[j]));                 ob[j] = (bf16)f2bf((-u0.y + bf2f(vb[j]) * bias) * bf2f(xb[j]));
            oa[j + 4096] = (bf16)f2bf((u1.x + bf2f(va[j + 4096]) * bias) * bf2f(xa[j + 4096])); ob[j + 4096] = (bf16)f2bf((-u1.y + bf2f(vb[j + 4096]) * bias) * bf2f(xb[j + 4096])); }
        __syncthreads();
    }
}
__device__ __forceinline__ void ph_hyena_ctx(const Frame& F, const float* hy_bias, const float* hy_cw, const float* hy_cb) {
    float* HYO = (float*)(F.ws + WS_HYO);
    {

        const bf16* U = (const bf16*)(F.ws + WS_U); const float* KFC = (const float*)(F.ws + WS_KFC);
        LAS float* vw = (LAS float*)(F.lds + F.wave * 4096);
        LAS float* kw = vw + 256;
        const float* cw = hy_cw; const float* cbp = hy_cb;
        for (int it = F.gw; it < NB * 256; it += F.ngw) {
            const int b = it >> 8, c = it & 255;
            float x0v[4];
#pragma unroll
            for (int i = 0; i < 4; ++i) { const int t = F.lane + 64 * i;
                float o[3];
#pragma unroll
                for (int g = 0; g < 3; ++g) { const int cc = g * 256 + c; float a = cbp[cc];
#pragma unroll
                    for (int j = 0; j < 3; ++j) { const int tj = t + j - 1; if (tj >= 0 && tj < CTXL) a += cw[j * 768 + cc] * bf2f(U[(size_t)(NLAT + b * CTXL + tj) * INW + 1280 + cc]); }
                    o[g] = a; }
                vw[t] = o[2] * o[1]; x0v[i] = o[0]; }
#pragma unroll
            for (int i = 0; i < 8; ++i) kw[F.lane + 64 * i] = KFC[c * 512 + F.lane + 64 * i];
            LDS_WAIT();
            float y[4] = {0.f, 0.f, 0.f, 0.f};
#pragma unroll 4
            for (int s = 0; s < CTXL; ++s) { const float vv = vw[s];
#pragma unroll
                for (int i = 0; i < 4; ++i) y[i] += kw[(F.lane + 64 * i - s) & 511] * vv; }
            const float bias = hy_bias[c];
#pragma unroll
            for (int i = 0; i < 4; ++i) { const int t = F.lane + 64 * i; HYO[(size_t)(NLAT + b * CTXL + t) * 256 + c] = (y[i] + vw[t] * bias) * x0v[i]; }
            LDS_WAIT();
        }
    }
}

__device__ __forceinline__ void merge_row(const Frame& F, int r, const float* g, float h0, float h1, float h2, float h3) {
    const bf16* ATT = (const bf16*)(F.ws + WS_ATT); const float* LRUO = (const float*)(F.ws + WS_LRUO); bf16* MIXA = (bf16*)(F.ws + WS_MIXA);
    const v4u aw = ((const v4u*)(ATT + (size_t)r * 512))[F.lane];
    float a[8] = {bflo(aw.x), bfhi(aw.x), bflo(aw.y), bfhi(aw.y), bflo(aw.z), bfhi(aw.z), bflo(aw.w), bfhi(aw.w)};
    float ss = 0.f;
#pragma unroll
    for (int i = 0; i < 8; ++i) ss += a[i] * a[i];
    const float ra = 1.0f / sqrtf(wave_sum(ss) * (1.0f / 512.0f) + EPSN);
    const f32x4 lv = ((const f32x4*)(LRUO + (size_t)r * 256))[F.lane];
    const float rl = 1.0f / sqrtf(wave_sum(lv.x * lv.x + lv.y * lv.y + lv.z * lv.z + lv.w * lv.w) * (1.0f / 256.0f) + EPSN);
    const float rh = 1.0f / sqrtf(wave_sum(h0 * h0 + h1 * h1 + h2 * h2 + h3 * h3) * (1.0f / 256.0f) + EPSN);
    bf16* orow = MIXA + (size_t)r * 1024;
    { const f32x4 g0 = ((const f32x4*)g)[2 * F.lane], g1 = ((const f32x4*)g)[2 * F.lane + 1];
      v4u o; o.x = pk2(a[0] * ra * g0.x, a[1] * ra * g0.y); o.y = pk2(a[2] * ra * g0.z, a[3] * ra * g0.w); o.z = pk2(a[4] * ra * g1.x, a[5] * ra * g1.y); o.w = pk2(a[6] * ra * g1.z, a[7] * ra * g1.w);
      ((v4u*)orow)[F.lane] = o; }
    { const f32x4 gg = ((const f32x4*)(g + 512))[F.lane]; v2u o; o.x = pk2(lv.x * rl * gg.x, lv.y * rl * gg.y); o.y = pk2(lv.z * rl * gg.z, lv.w * rl * gg.w); ((v2u*)(orow + 512))[F.lane] = o; }
    orow[768 + F.lane] = (bf16)f2bf(h0 * rh * g[768 + F.lane]); orow[832 + F.lane] = (bf16)f2bf(h1 * rh * g[832 + F.lane]);
    orow[896 + F.lane] = (bf16)f2bf(h2 * rh * g[896 + F.lane]); orow[960 + F.lane] = (bf16)f2bf(h3 * rh * g[960 + F.lane]);
}
__device__ __forceinline__ void ph_merge(const Frame& F, int l, int nrows, const float* out_g) {
    const float* HYO = (const float*)(F.ws + WS_HYO);
    const float* g = out_g + l * 1024;
    LAS float* tile = (LAS float*)(F.lds);
    for (int it = blockIdx.x; it < NLAT / 64; it += F.G) {
        const int b = it >> 7, t0 = (it & 127) * 64;
#pragma unroll 8
        for (int i = 0; i < 32; ++i) { const int c = F.wave * 32 + i; tile[c * 65 + F.lane] = bf2f(((const bf16*)HYO)[((size_t)b * 256 + c) * SEQ + t0 + F.lane]); }
        __syncthreads();
#pragma unroll 2
        for (int k = 0; k < 8; ++k) { const int tt = F.wave * 8 + k;
            merge_row(F, b * SEQ + t0 + tt, g, tile[F.lane * 65 + tt], tile[(F.lane + 64) * 65 + tt], tile[(F.lane + 128) * 65 + tt], tile[(F.lane + 192) * 65 + tt]); }
        __syncthreads();
    }
    for (int r = NLAT + F.gw; r < nrows; r += F.ngw) {
        const float* hr = HYO + (size_t)r * 256;
        merge_row(F, r, g, hr[F.lane], hr[64 + F.lane], hr[128 + F.lane], hr[192 + F.lane]);
    }
}


__device__ __forceinline__ void ph_ffn_router(const Frame& F, int l, int nrows, const float* router_w) {
    LAS float* rwl = (LAS float*)(F.lds);
    LAS float* cbl = (LAS float*)(F.lds + 147456);
    LAS int* hist = (LAS int*)(F.lds + 147456 + 640);
    const bf16* XR = (const bf16*)(F.ws + WS_XR); const float* RSSP = (const float*)(F.ws + WS_RSSP); const float* MOD = (const float*)(F.ws + WS_MOD);
    const float* GC = (const float*)(F.ws + WS_GC) + (size_t)l * 5 * 1024; bf16* Fb = (bf16*)(F.ws + WS_F);
    int* TOPI = (int*)(F.ws + WS_TOPI); float* GATE = (float*)(F.ws + WS_GATE); int* BLKCNT = (int*)(F.ws + WS_BLKCNT);
    for (int i = F.tid; i < 1024 * 32; i += NTHR) rwl[(i >> 5) * 36 + (i & 31)] = router_w[(size_t)l * 32768 + i];
    if (F.tid < 32) hist[F.tid] = 0;
    if (F.tid < 160) cbl[F.tid] = ((const float*)(F.ws + WS_CB))[l * 160 + F.tid];
    __syncthreads();
    const int j = F.lane & 15, kq = F.lane >> 4;
    for (int grp = F.gw; grp < nrows / 16; grp += F.ngw) {
        const int r0 = grp * 16, r = r0 + j; const int bidx = r0 < NLAT ? r0 / SEQ : 4;
        const bf16* xrow = XR + (size_t)r * 1024 + 4 * kq; const float* gcp = GC + bidx * 1024 + 4 * kq; const float* sfp = MOD + (size_t)(l * 5 + bidx) * 6144 + 3 * 1024 + 4 * kq;
        bf16* frow = Fb + (size_t)r * 1024 + 4 * kq;
        float ss; { const f32x4 q = *(const f32x4*)(RSSP + (size_t)r * 16 + 4 * kq); ss = (q.x + q.y) + (q.z + q.w); }
        ss += __shfl_xor(ss, 16); ss += __shfl_xor(ss, 32);
        const float rstd = 1.0f / sqrtf(ss * (1.0f / 1024.0f) + EPSN);
        f32x4 acc0 = {0.f, 0.f, 0.f, 0.f}, acc1 = acc0;
#pragma unroll 1
        for (int ib = 0; ib < 64; ib += 8) {
            v2u xw[8]; f32x4 g4[8], s4[8];
#pragma unroll
            for (int u = 0; u < 8; ++u) { xw[u] = *(const v2u*)(xrow + 16 * (ib + u)); g4[u] = *(const f32x4*)(gcp + 16 * (ib + u)); s4[u] = *(const f32x4*)(sfp + 16 * (ib + u)); }
#pragma unroll
            for (int u = 0; u < 8; ++u) {
                const f32x4 x4 = {bflo(xw[u].x), bfhi(xw[u].x), bflo(xw[u].y), bfhi(xw[u].y)};
                const f32x4 xb = x4 * g4[u];
                const f32x4 fv = xb * rstd + s4[u];
#if MOE_FP8
                *(unsigned*)((unsigned char*)Fb + (size_t)r * 1024 + 4 * kq + 16 * (ib + u)) = pg8::pack4_fp8(fv.x * pg8::F8_SF, fv.y * pg8::F8_SF, fv.z * pg8::F8_SF, fv.w * pg8::F8_SF);
#else
                v2u o; o.x = pk2(fv.x, fv.y); o.y = pk2(fv.z, fv.w); *(v2u*)(frow + 16 * (ib + u)) = o;
#endif
                const LAS float* wp = rwl + (16 * (ib + u) + 4 * kq) * 36 + j;
#pragma unroll
                for (int e = 0; e < 4; ++e) { acc0 = __builtin_amdgcn_mfma_f32_16x16x4f32(wp[e * 36], xb[e], acc0, 0, 0, 0); acc1 = __builtin_amdgcn_mfma_f32_16x16x4f32(wp[e * 36 + 16], xb[e], acc1, 0, 0, 0); }
            }
        }
        float lg[8];
#pragma unroll
        for (int rr = 0; rr < 4; ++rr) { lg[rr] = rstd * acc0[rr] + cbl[bidx * 32 + 4 * kq + rr]; lg[4 + rr] = rstd * acc1[rr] + cbl[bidx * 32 + 16 + 4 * kq + rr]; }
        float p[32];
#pragma unroll
        for (int e = 0; e < 32; ++e) p[e] = __shfl(lg[(e >> 4) * 4 + (e & 3)], j + 16 * ((e & 15) >> 2));
        unsigned taken = 0u; float tv[4]; int ti[4];
#pragma unroll
        for (int k = 0; k < 4; ++k) { float best = -INFINITY; int bi = 0;
#pragma unroll
            for (int e = 0; e < 32; ++e) { const bool ok = !((taken >> e) & 1u) && (p[e] > best); best = ok ? p[e] : best; bi = ok ? e : bi; }
            taken |= 1u << bi; tv[k] = best; ti[k] = bi; }
        const float e1 = __expf(tv[1] - tv[0]), e2 = __expf(tv[2] - tv[0]), e3 = __expf(tv[3] - tv[0]); const float inv = 1.0f / (1.0f + e1 + e2 + e3);
        if (kq == 0) {
            TOPI[r * 4 + 0] = ti[0]; TOPI[r * 4 + 1] = ti[1]; TOPI[r * 4 + 2] = ti[2]; TOPI[r * 4 + 3] = ti[3];
            GATE[r * 4 + 0] = inv; GATE[r * 4 + 1] = e1 * inv; GATE[r * 4 + 2] = e2 * inv; GATE[r * 4 + 3] = e3 * inv;
            lds_add(&hist[ti[0]], 1); lds_add(&hist[ti[1]], 1); lds_add(&hist[ti[2]], 1); lds_add(&hist[ti[3]], 1);
        }
    }
    __syncthreads();
    if (F.tid < 32) BLKCNT[blockIdx.x * 32 + F.tid] = hist[F.tid];
}

__device__ __forceinline__ void ph_route(const Frame& F, int nrows) {
    LAS int* cursor = (LAS int*)(F.lds);
    LAS int* tot = cursor + 32;
    LAS int* mine = cursor + 64;
    LAS int* part = cursor + 96;
    LAS int* ebase = cursor + 96 + 1024;
    const int* BLKCNT = (const int*)(F.ws + WS_BLKCNT); const int* TOPI = (const int*)(F.ws + WS_TOPI); int* POS = (int*)(F.ws + WS_POS);
    int* ROWTOK = (int*)(F.ws + WS_ROWTOK); int* TILEE = (int*)(F.ws + WS_TILEE);
    { const int e = F.tid & 31, sl = F.tid >> 5; int t = 0, m = 0;
      for (int b = sl; b < F.G; b += 16) { const int v = BLKCNT[b * 32 + e]; t += v; m += (b < (int)blockIdx.x) ? v : 0; }
      part[sl * 64 + e] = t; part[sl * 64 + 32 + e] = m;
      __syncthreads();
      if (F.tid < 32) { int tt = 0, mm = 0;
#pragma unroll
          for (int s = 0; s < 16; ++s) { tt += part[s * 64 + F.tid]; mm += part[s * 64 + 32 + F.tid]; }
          tot[F.tid] = tt; mine[F.tid] = mm; } }
    __syncthreads();
    if (F.tid == 0) { int tb = 0;
        for (int e = 0; e < 32; ++e) { const int nt = (tot[e] + 255) >> 8; cursor[e] = tb * 256 + mine[e]; ebase[e] = tb * 256;
            if (blockIdx.x == 0) for (int j = 0; j < nt; ++j) TILEE[tb + j] = e;
            tb += nt; }
        ebase[32] = tb * 256;
        if (blockIdx.x == 0) F.ctl[CW_NTILES] = (unsigned)tb; }
    __syncthreads();
    for (int e = blockIdx.x; e < 32; e += F.G) for (int p = ebase[e] + tot[e] + F.tid; p < ebase[e + 1]; p += NTHR) ROWTOK[p] = 0;
    const int sub = F.lane >> 2, k = F.lane & 3;
    for (int grp = F.gw; grp < nrows / 16; grp += F.ngw) {
        const int r = grp * 16 + sub; const int e = TOPI[r * 4 + k]; const int pos = lds_add(&cursor[e], 1); POS[r * 4 + k] = pos; ROWTOK[pos] = r; }
}

__device__ __forceinline__ void ph_combine(const Frame& F, int l, int nrows, float* out, const float* gmix) {
    bf16* XR = (bf16*)(F.ws + WS_XR); const float* MOD = (const float*)(F.ws + WS_MOD); const bf16* YS = (const bf16*)(F.ws + WS_YS); bf16* H = (bf16*)(F.ws + WS_H);
    const int* POS = (const int*)(F.ws + WS_POS); const float* GATE = (const float*)(F.ws + WS_GATE);
    for (int r = 2 * F.gw; r < nrows; r += 2 * F.ngw) {
        const int bidx = r < NLAT ? r / SEQ : 4;
        const float* gf = MOD + (size_t)(l * 5 + bidx) * 6144 + 5 * 1024;
        int pos = 0; float gt = 0.f;
        if (F.lane < 8) { pos = POS[r * 4 + F.lane]; gt = GATE[r * 4 + F.lane]; }
        v2u w[2][4][4], xw[2][4]; float gk[2][4];
#pragma unroll
        for (int rr = 0; rr < 2; ++rr)
#pragma unroll
            for (int k = 0; k < 4; ++k) { const int pk = __shfl(pos, rr * 4 + k); gk[rr][k] = __shfl(gt, rr * 4 + k);
#if MOE_FP8
                gk[rr][k] *= (1.0f / pg8::F8_SY); const unsigned* yr = (const unsigned*)((const unsigned char*)YS + (size_t)pk * 1024);
#pragma unroll
                for (int j = 0; j < 4; ++j) { w[rr][k][j].x = yr[64 * j + F.lane]; w[rr][k][j].y = 0u; } }
#else
                const v2u* yr = (const v2u*)(YS + (size_t)pk * 1024);
#pragma unroll
                for (int j = 0; j < 4; ++j) w[rr][k][j] = yr[64 * j + F.lane]; }
#endif
#pragma unroll
        for (int rr = 0; rr < 2; ++rr)
#pragma unroll
            for (int j = 0; j < 4; ++j) xw[rr][j] = ((const v2u*)(XR + (size_t)(r + rr) * 1024))[64 * j + F.lane];
        f32x4 gv[4];
#pragma unroll
        for (int j = 0; j < 4; ++j) gv[j] = ((const f32x4*)gf)[64 * j + F.lane];
#pragma unroll
        for (int rr = 0; rr < 2; ++rr) {
            const int row = r + rr;
            f32x4 y[4]; float ss = 0.f;
#pragma unroll
            for (int j = 0; j < 4; ++j) { f32x4 a = {0.f, 0.f, 0.f, 0.f};
#pragma unroll
                for (int k = 0; k < 4; ++k) { const v2u ww = w[rr][k][j]; const float g_ = gk[rr][k];
#if MOE_FP8
                    a.x += g_ * __builtin_amdgcn_cvt_f32_fp8((int)ww.x, 0); a.y += g_ * __builtin_amdgcn_cvt_f32_fp8((int)ww.x, 1); a.z += g_ * __builtin_amdgcn_cvt_f32_fp8((int)ww.x, 2); a.w += g_ * __builtin_amdgcn_cvt_f32_fp8((int)ww.x, 3); }
#else
                    a.x += g_ * bflo(ww.x); a.y += g_ * bfhi(ww.x); a.z += g_ * bflo(ww.y); a.w += g_ * bfhi(ww.y); }
#endif
                const f32x4 xv = {bflo(xw[rr][j].x), bfhi(xw[rr][j].x), bflo(xw[rr][j].y), bfhi(xw[rr][j].y)};
                y[j] = xv + gv[j] * a;
                const int cb = 64 * j + F.lane;
                if (l == 0) { v2u o; o.x = pk2(y[j].x, y[j].y); o.y = pk2(y[j].z, y[j].w); ((v2u*)(XR + (size_t)row * 1024))[cb] = o; } else ((f32x4*)(out + (size_t)row * 1024))[cb] = y[j];
                ss += (y[j].x * y[j].x + y[j].y * y[j].y) + (y[j].z * y[j].z + y[j].w * y[j].w); }
            if (l == 0) {
                const float rstd = 1.0f / sqrtf(wave_sum(ss) * (1.0f / 1024.0f) + EPSN);
                const float* shift = MOD + (size_t)(5 + bidx) * 6144; const float* scale = shift + 1024; const float* g = gmix + 1024;
#pragma unroll
                for (int j = 0; j < 4; ++j) { const int cb = 64 * j + F.lane; const f32x4 gg = ((const f32x4*)g)[cb], sc = ((const f32x4*)scale)[cb], sh = ((const f32x4*)shift)[cb];
                    const f32x4 hv = y[j] * rstd * gg * (sc + 1.0f) + sh;
                    v2u o; o.x = pk2(hv.x, hv.y); o.y = pk2(hv.z, hv.w); ((v2u*)(H + (size_t)row * 1024))[cb] = o; }
            }
        }
    }
}

struct Args { const float* in[34]; float* out; unsigned char* ws; int ph_lo, ph_hi; };
enum { I_X = 0, I_C, I_CTX, I_CCTX, I_WMOD, I_BMOD, I_GMIX, I_GFFN, I_WIN, I_QG, I_KG, I_LCW, I_LCB, I_LGW, I_LGB, I_LLAM, I_HCW, I_HCB, I_HW1, I_HB1, I_HW2, I_HB2, I_HW3, I_HFREQ, I_HDEC, I_HBIAS,
       I_OUTG, I_WOUT, I_RW, I_RB, I_MW1, I_MB1, I_MW2, I_MB2 };

__global__ void __launch_bounds__(NTHR, 2) mk_fwd(Args args) {
    extern __shared__ __attribute__((aligned(16))) unsigned char lds[];
    Frame F;
    F.lds = (LAS unsigned char*)lds; F.ws = args.ws; F.ctl = (unsigned*)(args.ws + WS_CTL);
    F.tid = threadIdx.x; F.lane = F.tid & 63; F.wave = __builtin_amdgcn_readfirstlane(F.tid >> 6);
    F.G = gridDim.x; { const int bx = blockIdx.x; F.vcu = (F.G % 8 == 0) ? (bx % 8) * (F.G / 8) + bx / 8 : bx; }
    F.gw = (int)blockIdx.x * NWAVES + F.wave; F.ngw = F.G * NWAVES;
    for (int u = F.tid; u < (LDS_BYTES - LDSCTL_OFF) / 4; u += NTHR) ((LAS unsigned*)(F.lds + LDSCTL_OFF))[u] = 0u;
    __syncthreads();
#if !MK_PER_PHASE
    XcdBarrier bar = xcd_barrier_post(F.ctl + CW_BAR, (volatile LAS unsigned*)(F.lds + LDSCTL_OFF + 32));
#define GRID_BAR() xcd_barrier(bar)
#else
#define GRID_BAR() do { } while (0)
#endif
    const int lo = args.ph_lo, hi = args.ph_hi;
#ifndef ONLY_PHASE
#define ONLY_PHASE (-1)
#endif
#define ENABLED(id) (ONLY_PHASE < 0 || ONLY_PHASE == (id))
#define IN(k) (ENABLED(k) && lo <= (k) && (k) < hi)
#define INL(j) (ENABLED(NPH_PRO + (j)) && lo <= pb + (j) && pb + (j) < hi)
#define SEAML(j) do { if (lo <= pb + (j) && pb + (j) + 1 < hi) { GRID_BAR(); } } while (0)
typedef const __attribute__((address_space(4))) Args* KArgs;
#ifndef REP_MASK
#define REP_MASK 0
#endif
#define NREP(j) (((REP_MASK >> (j)) & 1) ? 2 : 1)
#define REFRAME() Frame Fp = F; KArgs ka = (KArgs)__builtin_amdgcn_kernarg_segment_ptr(); { int t_ = F.tid; asm volatile("" : "+v"(t_), "+s"(ka)); Fp.tid = t_; Fp.lane = t_ & 63; Fp.wave = __builtin_amdgcn_readfirstlane(t_ >> 6); \
    Fp.gw = (int)blockIdx.x * NWAVES + Fp.wave; Fp.ws = ka->ws; Fp.ctl = (unsigned*)(ka->ws + WS_CTL); }
#define SEAM(k) do { if (lo <= (k) && (k) + 1 < hi) { GRID_BAR(); } } while (0)

    if (IN(0)) ph_prologue_a(F, args.in[I_C], args.in[I_CCTX], args.in[I_WMOD], args.in[I_BMOD], args.in[I_WIN], args.in[I_WOUT], args.in[I_MW1], args.in[I_MW2],
                             args.in[I_HW1], args.in[I_HB1], args.in[I_HW2], args.in[I_HB2], args.in[I_HFREQ], args.in[I_LGW], args.in[I_LLAM]);
    SEAM(0);
    if (IN(1)) ph_prologue_b(F, args.in[I_HW3], args.in[I_HDEC], args.in[I_GFFN], args.in[I_RW], args.in[I_RB]);
    SEAM(1);

#if MOE_FP8
#define MOE_EPI1 pg8::EpiSwigluF8
#define MOE_EPI2 pg8::EpiF8BiasF8
#else
#define MOE_EPI1 pg8::EpiSwiglu
#define MOE_EPI2 pg8::EpiBf16Bias
#endif
#ifndef PROBE_MOE2
#define PROBE_MOE2 0
#endif
#ifndef PROBE_MOE2B
#define PROBE_MOE2B 0
#endif
#ifndef PROBE_GEMM_K
#define PROBE_GEMM_K 0
#endif
#ifndef MOE_WGM1
#define MOE_WGM1 4
#endif
#ifndef MOE_WGM2
#define MOE_WGM2 8
#endif
#define PHASE(j, ...) if (INL(j)) { _Pragma("unroll") for (int rep_ = 0; rep_ < NREP(j); ++rep_) { { REFRAME(); __VA_ARGS__ } if (rep_ + 1 < NREP(j)) GRID_BAR(); } }
#define LAYER_BODY(l) { \
        const int pb = NPH_PRO + l * NPH_LAYER; \
        const int nrows = (l == 0) ? MT : NLAT; \
        if (l == 0) { PHASE(0, ph_norm_mod(Fp, l, ka->in[I_X], ka->in[I_CTX], ka->in[I_GMIX]);) SEAML(0); } \
        PHASE(1, \
            pg8::Gemm g{(const bf16*)(Fp.ws + WS_H), (const bf16*)(Fp.ws + WS_WINT) + (size_t)l * 2048 * 1024, MT, 2048, 1024}; \
            pg8::StaticOrder S; S.init(MT, 2048, Fp.G, (int)blockIdx.x); \
            pg8::EpiBf16<0> E{(bf16*)(Fp.ws + WS_U), 2048, nullptr, 0, 0, 1.f}; \
            pg8::gemm_phase<pg8::EpiBf16<0>, pg8::StaticOrder, PG8_ALIGN, PG8_SP2>(Fp.lds + RING_OFF, g, S, E);) \
        SEAML(1); \
        if (PROBE_GEMM_K > 0 && INL(1)) { REFRAME(); int kp_ = PROBE_GEMM_K; asm volatile("" : "+s"(kp_)); \
            pg8::Gemm g{(const bf16*)(Fp.ws + WS_H), (const bf16*)(Fp.ws + WS_WINT) + (size_t)l * 2048 * 1024, MT, 2048, kp_}; \
            pg8::StaticOrder S; S.init(MT, 2048, Fp.G, (int)blockIdx.x); \
            pg8::EpiNone E{}; \
            pg8::gemm_phase<pg8::EpiNone, pg8::StaticOrder, PG8_ALIGN, PG8_SP2>(Fp.lds + RING_OFF, g, S, E); GRID_BAR(); } \
        PHASE(2, ph_post_proj(Fp, l, ka->in[I_QG], ka->in[I_KG], ka->in[I_LCW], ka->in[I_LCB], ka->in[I_HCW], ka->in[I_HCB]);) \
        SEAML(2); \
        PHASE(3, \
            int kg_ = 256; asm volatile("" : "+s"(kg_)); \
            pg8::Gemm g{(const bf16*)(Fp.ws + WS_XL), (const bf16*)(Fp.ws + WS_WGT) + (size_t)l * 1024 * 256, MT, 1024, kg_}; \
            pg8::StaticOrder S; S.init(MT, 1024, Fp.G, (int)blockIdx.x); \
            pg8::EpiLruGate E{(const bf16*)(Fp.ws + WS_XL), (bf16*)(Fp.ws + WS_LAB), LAB_STRIDE, ka->in[I_LGB] + (size_t)l * 1024, (const float*)(Fp.ws + WS_SPT) + l * 512}; \
            pg8::gemm_phase<pg8::EpiLruGate, pg8::StaticOrder, PG8_ALIGN, PG8_SP2>(Fp.lds + RING_OFF, g, S, E);) \
        SEAML(3); \
        PHASE(4, \
            ph_scan1(Fp); __syncthreads(); \
            const attn_body::AttnTensors AT{(const attn_body::bf16*)(Fp.ws + WS_U), (const attn_body::bf16*)(Fp.ws + WS_K), (const attn_body::bf16*)(Fp.ws + WS_V), (attn_body::bf16*)(Fp.ws + WS_ATT)}; \
            const attn_body::QPre QN{ka->in[I_QG] + l * 64, (const float*)(Fp.ws + WS_ROPEC), (const float*)(Fp.ws + WS_ROPES)}; \
            attn_body::attn_phase<8>((char*)lds + RING_OFF, AT, QN, Fp.G, Fp.vcu, l == 0, (long)NLAT);) \
        SEAML(4); \
        PHASE(5, ph_scan2(Fp); __syncthreads(); ph_hyena_fft(Fp, l, ka->in[I_HBIAS]); if (l == 0) ph_hyena_ctx(Fp, ka->in[I_HBIAS], ka->in[I_HCW], ka->in[I_HCB]);) \
        SEAML(5); \
        PHASE(6, ph_merge(Fp, l, nrows, ka->in[I_OUTG]);) \
        SEAML(6); \
        if (INL(7)) { REFRAME(); \
            pg8::Gemm g{(const bf16*)(Fp.ws + WS_MIXA), (const bf16*)(Fp.ws + WS_WOUTT) + (size_t)l * 1024 * 1024, nrows, 1024, 1024}; \
            pg8::StaticOrder S; S.init(nrows, 1024, Fp.G, (int)blockIdx.x); \
            bf16* XR = (bf16*)(Fp.ws + WS_XR); \
            pg8::EpiResid<(l) == 1> E{ka->in[I_X], ka->in[I_CTX], NLAT, XR, 1024, \
                            (const float*)(Fp.ws + WS_MOD) + (size_t)(l * 5) * 6144 + 2 * 1024, 6144, SEQ, (float*)(Fp.ws + WS_RSSP)}; \
            pg8::gemm_phase<pg8::EpiResid<(l) == 1>, pg8::StaticOrder, PG8_ALIGN, PG8_SP2>(Fp.lds + RING_OFF, g, S, E); \
        } \
        SEAML(7); \
        PHASE(8, ph_ffn_router(Fp, l, nrows, ka->in[I_RW]);) \
        SEAML(8); \
        PHASE(9, ph_route(Fp, nrows);) \
        SEAML(9); \
        if (INL(10) || INL(11)) { REFRAME(); \
            LAS int* tab = (LAS int*)(Fp.lds + MOETAB_OFF); \
            const int ntiles = (int)__hip_atomic_load(Fp.ctl + CW_NTILES, __ATOMIC_RELAXED, __HIP_MEMORY_SCOPE_AGENT); \
            const int* TILEE = (const int*)(Fp.ws + WS_TILEE); \
            for (int i = Fp.tid; i < ntiles && i < SORT_TILES; i += NTHR) tab[i] = TILEE[i]; \
            __syncthreads(); \
            if (INL(10)) { _Pragma("unroll") for (int rep_ = 0; rep_ < NREP(10); ++rep_) { { \
                int km1_ = 1024 / (1 + MOE_FP8); asm volatile("" : "+s"(km1_)); \
                pg8::Gemm g{(const bf16*)(Fp.ws + WS_F), (const bf16*)(Fp.ws + WS_W1T) + (size_t)l * 32 * 2048 * (1024 / (1 + MOE_FP8)), 0, 2048, km1_}; \
                pg8::MoeOrderT<true> S; S.init(tab, ntiles, 8, Fp.G, (int)blockIdx.x, MOE_WGM1); S.rowtok = (const int*)(Fp.ws + WS_ROWTOK); \
                MOE_EPI1 E{(bf16*)(Fp.ws + WS_ACT), 1024, ka->in[I_MB1] + (size_t)l * 32 * 2048, 2048}; \
                pg8::gemm_phase<MOE_EPI1, pg8::MoeOrderT<true>, PG8_ALIGN, PG8_SP2, MOE_FP8 != 0>(Fp.lds + RING_OFF, g, S, E); \
             } if (rep_ + 1 < NREP(10)) GRID_BAR(); } } \
            SEAML(10); \
            if (PROBE_MOE2B && INL(11)) { \
                pg8::Gemm g{(const bf16*)(Fp.ws + WS_ACT), (const bf16*)(Fp.ws + WS_W2T) + (size_t)l * 32 * 1024 * 1024, 0, 1024, 1024}; \
                pg8::MoeOrderT<false> S; S.init(tab, ntiles, 4, Fp.G, (int)blockIdx.x, MOE_WGM2); S.rowtok = nullptr; S.rev = 1; \
                pg8::EpiNone E{}; \
                pg8::gemm_phase<pg8::EpiNone, pg8::MoeOrderT<false>, PG8_ALIGN, PG8_SP2>(Fp.lds + RING_OFF, g, S, E); GRID_BAR(); } \
            if (INL(11)) { _Pragma("unroll") for (int rep_ = 0; rep_ < NREP(11); ++rep_) { { \
                int km2_ = 1024 / (1 + MOE_FP8); asm volatile("" : "+s"(km2_)); \
                pg8::Gemm g{(const bf16*)(Fp.ws + WS_ACT), (const bf16*)(Fp.ws + WS_W2T) + (size_t)l * 32 * 1024 * (1024 / (1 + MOE_FP8)), 0, 1024, km2_}; \
                pg8::MoeOrderT<false> S; S.init(tab, ntiles, 4, Fp.G, (int)blockIdx.x, MOE_WGM2); S.rowtok = nullptr; S.rev = 1; \
                MOE_EPI2 E{(bf16*)(Fp.ws + WS_YS), 1024, ka->in[I_MB2] + (size_t)l * 32 * 1024, 1024}; \
                pg8::gemm_phase<MOE_EPI2, pg8::MoeOrderT<false>, PG8_ALIGN, PG8_SP2, MOE_FP8 != 0>(Fp.lds + RING_OFF, g, S, E); \
             } if (rep_ + 1 < NREP(11)) GRID_BAR(); } } \
            if (PROBE_MOE2 && INL(11)) { GRID_BAR(); \
                pg8::Gemm g{(const bf16*)(Fp.ws + WS_ACT), (const bf16*)(Fp.ws + WS_W2T) + (size_t)l * 32 * 1024 * 1024, 0, 1024, 1024}; \
                pg8::MoeOrderT<false> S; S.init(tab, ntiles, 4, Fp.G, (int)blockIdx.x, MOE_WGM2); S.rowtok = nullptr; S.rev = (PROBE_MOE2 == 2) ? 0 : 1; \
                if (PROBE_MOE2 == 3) { pg8::EpiBf16BiasFold E{(bf16*)(Fp.ws + WS_ASORT), 1024, ka->in[I_MB2] + (size_t)l * 32 * 1024, 1024}; \
                    pg8::gemm_phase<pg8::EpiBf16BiasFold, pg8::MoeOrderT<false>, PG8_ALIGN, PG8_SP2>(Fp.lds + RING_OFF, g, S, E); } \
                else { pg8::EpiNone E{}; \
                pg8::gemm_phase<pg8::EpiNone, pg8::MoeOrderT<false>, PG8_ALIGN, PG8_SP2>(Fp.lds + RING_OFF, g, S, E); } } \
        } \
        SEAML(11); \
        if (INL(12)) { REFRAME(); ph_combine(Fp, l, nrows, ka->out, ka->in[I_GMIX]); } \
        if (l == 0) { SEAML(12); } \
    }
    LAYER_BODY(0)
    LAYER_BODY(1)
#undef LAYER_BODY
#undef PHASE
#undef IN
#undef SEAM
#undef INL
#undef SEAML
}

extern "C" void kernel_launch(void* const* d_in, const int* in_sizes, int n_in, void* d_out, int out_size, void* d_ws, size_t ws_size, hipStream_t stream) {
    static int grid = 0;
    if (grid == 0) {
        if (n_in != 34 || in_sizes[0] != NLAT * DMODEL || out_size != NLAT * DMODEL || ws_size < WS_END) {
            fprintf(stderr, "kernel_launch: unexpected shapes (n_in %d, in0 %d, out %d, ws %zu); nothing launched\n", n_in, n_in > 0 ? in_sizes[0] : -1, out_size, ws_size); grid = -1; return; }
        int dev = 0, cus = 0;
        if (hipGetDevice(&dev) != hipSuccess || hipDeviceGetAttribute(&cus, hipDeviceAttributeMultiprocessorCount, dev) != hipSuccess) { grid = -1; return; }
        if (hipFuncSetAttribute((const void*)mk_fwd, hipFuncAttributeMaxDynamicSharedMemorySize, LDS_BYTES) != hipSuccess) { fprintf(stderr, "kernel_launch: hipFuncSetAttribute failed\n"); grid = -1; return; }
        int per_cu = 0;
        if (hipOccupancyMaxActiveBlocksPerMultiprocessor(&per_cu, (const void*)mk_fwd, NTHR, LDS_BYTES) != hipSuccess || per_cu < 1) { fprintf(stderr, "kernel_launch: occupancy query says %d\n", per_cu); }
        (void)hipGetLastError();
        grid = cus;
    }
    if (grid < 0) return;
    if (hipMemsetAsync((char*)d_ws + WS_CTL, 0, CTL_ZERO_BYTES, stream) != hipSuccess) return;
    Args a{};
    for (int i = 0; i < 34; ++i) a.in[i] = (const float*)d_in[i];
    a.out = (float*)d_out; a.ws = (unsigned char*)d_ws;
#if MK_PER_PHASE
    for (int p = 0; p < NPH; ++p) { a.ph_lo = p; a.ph_hi = p + 1; hipLaunchKernelGGL(mk_fwd, dim3(grid), dim3(NTHR), LDS_BYTES, stream, a); }
#else
    a.ph_lo = 0; a.ph_hi = NPH;
    hipLaunchKernelGGL(mk_fwd, dim3(grid), dim3(NTHR), LDS_BYTES, stream, a);
#endif
}
```

```cpp
#include <hip/hip_runtime.h>
#include <hip/hip_bf16.h>
#include <cstdio>
#include <cstdint>
#include <cmath>
#ifndef MOE_FP8
#define MOE_FP8 1
#endif
#ifndef MK_PER_PHASE
#define MK_PER_PHASE 0
#endif
namespace pg8 {
#define PG8_LAS __attribute__((address_space(3)))
typedef unsigned short bf16_t;
typedef short bf16x8 __attribute__((ext_vector_type(8)));
typedef float f32x4 __attribute__((ext_vector_type(4)));
typedef unsigned u32x4 __attribute__((ext_vector_type(4)));
constexpr int BM = 256, BK = 64, HALF = 128, HTB = HALF * BK * 2  , STAGE_BYTES = 8 * HTB, NXCD = 8, WGM = 8;

__host__ __device__ __forceinline__ int lds_byte(int r, int c) { const int st = (r >> 4) * 2 + (c >> 5), rr = r & 15, cc = c & 31, ob = rr * 64 + cc * 2; return st * 1024 + (ob ^ (((ob >> 9) & 1) << 5)); }
__host__ __device__ __forceinline__ void stage_rc(int b, int& R, int& C) { const int st = b / 1024, sb = b % 1024, swz = sb ^ (((sb >> 9) & 1) << 5); R = (st >> 1) * 16 + swz / 64; C = (st & 1) * 32 + (swz % 64) / 2; }
__host__ __device__ __forceinline__ int perm32(int rho) { const int n = rho >> 4, i = rho & 15; return 8 * (i >> 2) + 4 * n + (i & 3); }

struct Unit { int pm, pn, be, e; };
struct Gemm { const bf16_t* A; const bf16_t* Bt; int M, N, K; };

struct StaticOrder {
    static constexpr bool GATHER = false;
    __device__ __forceinline__ int row_of(int r) const { return r; }
    int nM, nN, nwg, G, c;
    __host__ __device__ void init(int M, int N, int G_, int c_) { nM = M / BM; nN = N / BM; nwg = nM * nN; G = G_; c = c_; }
    __host__ __device__ bool next(int i, Unit& u) const {
        const long L = (long)i * G + c; if (L >= nwg) return false;
        int wgid = (int)L; { const int q = nwg / NXCD, r = nwg % NXCD, xcd = wgid % NXCD, off = wgid / NXCD; wgid = (xcd < r ? xcd * (q + 1) : r * (q + 1) + (xcd - r) * q) + off; }
        const int nig = WGM * nN, gid = wgid / nig, fm = gid * WGM, gsz = (nM - fm) < WGM ? (nM - fm) : WGM;
        u.pm = fm + ((wgid % nig) % gsz); u.pn = (wgid % nig) / gsz; u.be = u.pn; u.e = 0; return true;
    }
    __device__ __forceinline__ void a_ready(const Unit&) const {}
    __device__ __forceinline__ void done(const Unit&) const {}
};

__device__ __forceinline__ unsigned cvt_pk_bf16(float lo, float hi) { unsigned r; asm volatile("v_cvt_pk_bf16_f32 %0, %1, %2" : "=v"(r) : "v"(lo), "v"(hi)); return r; }
__device__ __forceinline__ unsigned pack4_fp8(float a, float b, float c, float d) {
    a = fminf(fmaxf(a, -448.f), 448.f); b = fminf(fmaxf(b, -448.f), 448.f); c = fminf(fmaxf(c, -448.f), 448.f); d = fminf(fmaxf(d, -448.f), 448.f);
    int w = 0; w = __builtin_amdgcn_cvt_pk_fp8_f32(a, b, w, false); w = __builtin_amdgcn_cvt_pk_fp8_f32(c, d, w, true); return (unsigned)w;
}
constexpr float F8_SF = 16.f, F8_SW = 64.f, F8_SA = 4.f, F8_SY = 32.f;
typedef float f32x2 __attribute__((ext_vector_type(2)));
__device__ __forceinline__ f32x2 gelu_pk(f32x2 v) {
    const f32x2 av = __builtin_elementwise_abs(v), d = av * 0.2316418882f + 1.0f;
    f32x2 t; t.x = __builtin_amdgcn_rcpf(d.x); t.y = __builtin_amdgcn_rcpf(d.y);
    f32x2 q = t * 0.5307027145f + (-0.7265760135f); q = q * t + 0.7107068705f; q = q * t + (-0.142248368f); q = q * t + 0.127414796f; q = q * t;
    const f32x2 s = (v * v) * (-0.72134752044f);
    f32x2 e; e.x = __builtin_amdgcn_exp2f(s.x); e.y = __builtin_amdgcn_exp2f(s.y);
    const f32x2 m = v * (q * e), r = v - m;
    f32x2 o; o.x = v.x < 0.f ? m.x : r.x; o.y = v.y < 0.f ? m.y : r.y; return o;
}

template <int ACT  > struct EpiBf16 {
    static constexpr bool PERM = true, AFTER_DRAIN = false; static_assert(ACT == 0 || ACT == 1, "EpiBf16: ACT is 0 (none) or 1 (gelu_pk)");
    bf16_t* O; int ldc; const float* bias; int split_cols; size_t split_stride; float scale0;
    struct Pre {}; __device__ __forceinline__ void preload(Pre&, const Unit&, int, int, int, int) const {}
    __device__ __forceinline__ void operator()(const f32x4 (&acc)[2][2][4][2], const Unit& u, int wr, int wc, int fr, int fq, const Pre&) const {
        const int row0 = u.pm * BM + wr * 64 + fr; int colt = u.pn * BM; bf16_t* base = O;
        float sc = 1.f; if (split_cols) { const int t = colt / split_cols; base += (size_t)t * split_stride; colt -= t * split_cols; if (t == 0) sc = scale0; }
        const int col0 = colt + wc * 32 + 8 * fq, bcol0 = u.pn * BM + wc * 32 + 8 * fq;
        f32x4 bv[2][2];
#pragma unroll
        for (int bj = 0; bj < 2; ++bj)
#pragma unroll
            for (int n = 0; n < 2; ++n) bv[bj][n] = bias ? *(const f32x4*)(bias + bcol0 + bj * HALF + 4 * n) : (f32x4){0.f, 0.f, 0.f, 0.f};
#pragma unroll
        for (int ai = 0; ai < 2; ++ai)
#pragma unroll
            for (int m = 0; m < 4; ++m) { bf16_t* rowp = base + (size_t)(row0 + ai * HALF + m * 16) * ldc + col0;
#pragma unroll
                for (int bj = 0; bj < 2; ++bj) { f32x4 v0 = acc[ai][bj][m][0] + bv[bj][0], v1 = acc[ai][bj][m][1] + bv[bj][1];
                    if (ACT == 1) { f32x2 a = gelu_pk((f32x2){v0[0], v0[1]}), b = gelu_pk((f32x2){v0[2], v0[3]}), c = gelu_pk((f32x2){v1[0], v1[1]}), d = gelu_pk((f32x2){v1[2], v1[3]});
                        v0 = (f32x4){a.x, a.y, b.x, b.y}; v1 = (f32x4){c.x, c.y, d.x, d.y}; }
                    v0 = v0 * sc; v1 = v1 * sc; u32x4 w; w.x = cvt_pk_bf16(v0[0], v0[1]); w.y = cvt_pk_bf16(v0[2], v0[3]); w.z = cvt_pk_bf16(v1[0], v1[1]); w.w = cvt_pk_bf16(v1[2], v1[3]);
                    *(u32x4*)(rowp + bj * HALF) = w; } }
    }
};


template <bool XIN_BF16> struct EpiResid {
    static constexpr bool PERM = false, AFTER_DRAIN = false;
    const float* xin_lat; const float* xin_ctx; int nlat; bf16_t* XR; int ldc; const float* mod; int mod_stride; int seq; float* rssp;
    struct Pre {}; __device__ __forceinline__ void preload(Pre&, const Unit&, int, int, int, int) const {}
    __device__ __forceinline__ void operator()(const f32x4 (&acc)[2][2][4][2], const Unit& u, int wr, int wc, int fr, int fq, const Pre&) const {
        typedef unsigned u32x2 __attribute__((ext_vector_type(2)));
        const int row0 = u.pm * BM + wr * 64 + fr, col0 = u.pn * BM + wc * 32 + 4 * fq;
        const int rowt = u.pm * BM; const int bidx = rowt < nlat ? rowt / seq : 4;
        const float* gate = mod + (size_t)bidx * mod_stride;
        const float* xin = rowt < nlat ? xin_lat : (xin_ctx - (size_t)nlat * ldc);
        f32x4 gv[2][2];
#pragma unroll
        for (int bj = 0; bj < 2; ++bj)
#pragma unroll
            for (int n = 0; n < 2; ++n) gv[bj][n] = *(const f32x4*)(gate + col0 + bj * HALF + n * 16);
#pragma unroll
        for (int ai = 0; ai < 2; ++ai)
#pragma unroll
            for (int m = 0; m < 4; ++m) { const int row = row0 + ai * HALF + m * 16; const size_t ro = (size_t)row * ldc + col0; float s2 = 0.f;
#pragma unroll
                for (int bj = 0; bj < 2; ++bj)
#pragma unroll
                    for (int n = 0; n < 2; ++n) { const size_t idx = ro + bj * HALF + n * 16; f32x4 xv;
                        if (XIN_BF16) { const u32x2 w = *(const u32x2*)(XR + idx); xv = (f32x4){__builtin_bit_cast(float, w.x << 16), __builtin_bit_cast(float, w.x & 0xffff0000u), __builtin_bit_cast(float, w.y << 16), __builtin_bit_cast(float, w.y & 0xffff0000u)}; }
                        else xv = *(const f32x4*)(xin + idx);
                        const f32x4 v = xv + gv[bj][n] * acc[ai][bj][m][n];
                        s2 += (v[0] * v[0] + v[1] * v[1]) + (v[2] * v[2] + v[3] * v[3]);
                        u32x2 o; o.x = cvt_pk_bf16(v[0], v[1]); o.y = cvt_pk_bf16(v[2], v[3]); *(u32x2*)(XR + idx) = o; }
                s2 += __shfl_xor(s2, 16); s2 += __shfl_xor(s2, 32);
                if (fq == 0) rssp[(size_t)row * 16 + u.pn * 4 + wc] = s2; }
    }
};
struct EpiSwiglu {
    static constexpr bool PERM = true, AFTER_DRAIN = false;
    bf16_t* O; int ldc; const float* bias; int bias_stride;
    struct Pre { unsigned bw[2][2][2]; };
    __device__ __forceinline__ void preload(Pre& p, const Unit& u, int wr, int wc, int fr, int fq) const {
        const float* bb = bias + (size_t)u.e * bias_stride + u.pn * BM + wc * 32 + 8 * fq;
#pragma unroll
        for (int bj = 0; bj < 2; ++bj)
#pragma unroll
            for (int n = 0; n < 2; ++n) { const f32x4 v = *(const f32x4*)(bb + bj * HALF + 4 * n); p.bw[bj][n][0] = cvt_pk_bf16(v[0], v[1]); p.bw[bj][n][1] = cvt_pk_bf16(v[2], v[3]); }
    }
    __device__ __forceinline__ void operator()(const f32x4 (&acc)[2][2][4][2], const Unit& u, int wr, int wc, int fr, int fq, const Pre& pre) const {
        const int row0 = u.pm * BM + wr * 64 + fr; const int bcol0 = u.pn * BM + wc * 32 + 8 * fq; const int ocol0 = bcol0 >> 1;
        f32x4 bv[2][2];
#pragma unroll
        for (int bj = 0; bj < 2; ++bj)
#pragma unroll
            for (int n = 0; n < 2; ++n) { const unsigned w0 = pre.bw[bj][n][0], w1 = pre.bw[bj][n][1];
                bv[bj][n] = (f32x4){__builtin_bit_cast(float, w0 << 16), __builtin_bit_cast(float, w0 & 0xffff0000u), __builtin_bit_cast(float, w1 << 16), __builtin_bit_cast(float, w1 & 0xffff0000u)}; }
#pragma unroll
        for (int ai = 0; ai < 2; ++ai)
#pragma unroll
            for (int m = 0; m < 4; ++m) { bf16_t* rowp = O + (size_t)(row0 + ai * HALF + m * 16) * ldc + ocol0;
#pragma unroll
                for (int bj = 0; bj < 2; ++bj) { const f32x4 v0 = acc[ai][bj][m][0] + bv[bj][0], v1 = acc[ai][bj][m][1] + bv[bj][1];
                    float o[4];
#pragma unroll
                    for (int p = 0; p < 4; ++p) { const float hg = p < 2 ? v0[2 * p] : v1[2 * p - 4], hl = p < 2 ? v0[2 * p + 1] : v1[2 * p - 3];
                        const float glu = fminf(hg, 7.0f), lin = fminf(fmaxf(hl, -7.0f), 7.0f);
                        const float sg = __builtin_amdgcn_rcpf(1.0f + __builtin_amdgcn_exp2f(-1.702f * 1.4426950408889634f * glu));
                        o[p] = glu * sg * (lin + 1.0f); }
                    typedef unsigned u32x2 __attribute__((ext_vector_type(2)));
                    u32x2 w; w.x = cvt_pk_bf16(o[0], o[1]); w.y = cvt_pk_bf16(o[2], o[3]);
                    *(u32x2*)(rowp + bj * (HALF / 2)) = w; } }
    }
};
struct EpiSwigluF8 {
    static constexpr bool PERM = true, AFTER_DRAIN = false;
    bf16_t* O; int ldc; const float* bias; int bias_stride;
    struct Pre { unsigned bw[2][2][2]; };
    __device__ __forceinline__ void preload(Pre& p, const Unit& u, int wr, int wc, int fr, int fq) const {
        const float* bb = bias + (size_t)u.e * bias_stride + u.pn * BM + wc * 32 + 8 * fq;
#pragma unroll
        for (int bj = 0; bj < 2; ++bj)
#pragma unroll
            for (int n = 0; n < 2; ++n) { const f32x4 v = *(const f32x4*)(bb + bj * HALF + 4 * n); p.bw[bj][n][0] = cvt_pk_bf16(v[0], v[1]); p.bw[bj][n][1] = cvt_pk_bf16(v[2], v[3]); }
    }
    __device__ __forceinline__ void operator()(const f32x4 (&acc)[2][2][4][2], const Unit& u, int wr, int wc, int fr, int fq, const Pre& pre) const {
        asm volatile("" : "+v"(fr), "+v"(fq));
        const int row0 = u.pm * BM + wr * 64 + fr; const int bcol0 = u.pn * BM + wc * 32 + 8 * fq; const int ocol0 = bcol0 >> 1;
        f32x4 bv[2][2];
#pragma unroll
        for (int bj = 0; bj < 2; ++bj)
#pragma unroll
            for (int n = 0; n < 2; ++n) { const unsigned w0 = pre.bw[bj][n][0], w1 = pre.bw[bj][n][1];
                bv[bj][n] = (f32x4){__builtin_bit_cast(float, w0 << 16), __builtin_bit_cast(float, w0 & 0xffff0000u), __builtin_bit_cast(float, w1 << 16), __builtin_bit_cast(float, w1 & 0xffff0000u)}; }
#pragma unroll
        for (int ai = 0; ai < 2; ++ai)
#pragma unroll
            for (int m = 0; m < 4; ++m) {
#pragma unroll
                for (int bj = 0; bj < 2; ++bj) { const f32x4 v0 = acc[ai][bj][m][0] * (1.0f / (F8_SF * F8_SW)) + bv[bj][0], v1 = acc[ai][bj][m][1] * (1.0f / (F8_SF * F8_SW)) + bv[bj][1];
                    float o[4];
#pragma unroll
                    for (int p = 0; p < 4; ++p) { const float hg = p < 2 ? v0[2 * p] : v1[2 * p - 4], hl = p < 2 ? v0[2 * p + 1] : v1[2 * p - 3];
                        const float glu = fminf(hg, 7.0f), lin = fminf(fmaxf(hl, -7.0f), 7.0f);
                        const float sg = __builtin_amdgcn_rcpf(1.0f + __builtin_amdgcn_exp2f(-1.702f * 1.4426950408889634f * glu));
                        o[p] = glu * sg * (lin + 1.0f); }
                    *(unsigned*)((unsigned char*)O + (size_t)(row0 + ai * HALF + m * 16) * ldc + ocol0 + bj * (HALF / 2)) = pack4_fp8(o[0] * F8_SA, o[1] * F8_SA, o[2] * F8_SA, o[3] * F8_SA); } }
    }
};
struct EpiBf16Bias {
    static constexpr bool PERM = true, AFTER_DRAIN = false;
    bf16_t* O; int ldc; const float* bias; int bias_stride;
    struct Pre { f32x4 bv[2][2]; };
    __device__ __forceinline__ void preload(Pre& p, const Unit& u, int wr, int wc, int fr, int fq) const {
        const float* bb = bias + (size_t)u.e * bias_stride + u.pn * BM + wc * 32 + 8 * fq;
#pragma unroll
        for (int bj = 0; bj < 2; ++bj)
#pragma unroll
            for (int n = 0; n < 2; ++n) p.bv[bj][n] = *(const f32x4*)(bb + bj * HALF + 4 * n);
    }
    __device__ __forceinline__ void operator()(const f32x4 (&acc)[2][2][4][2], const Unit& u, int wr, int wc, int fr, int fq, const Pre& pre) const {
        const int row0 = u.pm * BM + wr * 64 + fr; const int col0 = u.pn * BM + wc * 32 + 8 * fq;
#pragma unroll
        for (int ai = 0; ai < 2; ++ai)
#pragma unroll
            for (int m = 0; m < 4; ++m) { bf16_t* rowp = O + (size_t)(row0 + ai * HALF + m * 16) * ldc + col0;
#pragma unroll
                for (int bj = 0; bj < 2; ++bj) { const f32x4 v0 = acc[ai][bj][m][0] + pre.bv[bj][0], v1 = acc[ai][bj][m][1] + pre.bv[bj][1];
                    u32x4 w; w.x = cvt_pk_bf16(v0[0], v0[1]); w.y = cvt_pk_bf16(v0[2], v0[3]); w.z = cvt_pk_bf16(v1[0], v1[1]); w.w = cvt_pk_bf16(v1[2], v1[3]);
                    *(u32x4*)(rowp + bj * HALF) = w; } }
    }
};
struct EpiBf16BiasFold {
    static constexpr bool PERM = true, AFTER_DRAIN = false;
    bf16_t* O; int ldc; const float* bias; int bias_stride;
    struct Pre { f32x4 bv[2][2]; };
    __device__ __forceinline__ void preload(Pre& p, const Unit& u, int wr, int wc, int fr, int fq) const {
        const float* bb = bias + (size_t)u.e * bias_stride + u.pn * BM + wc * 32 + 8 * fq;
#pragma unroll
        for (int bj = 0; bj < 2; ++bj)
#pragma unroll
            for (int n = 0; n < 2; ++n) p.bv[bj][n] = *(const f32x4*)(bb + bj * HALF + 4 * n);
    }
    __device__ __forceinline__ void operator()(const f32x4 (&acc)[2][2][4][2], const Unit& u, int wr, int wc, int fr, int fq, const Pre& pre) const {
        const int row0 = u.pm * BM + wr * 64 + fr; const int col0 = u.pn * BM + wc * 32 + 8 * fq;
#pragma unroll
        for (int ai = 0; ai < 2; ++ai)
#pragma unroll
            for (int m = 0; m < 4; ++m) { bf16_t* rowp = O + (size_t)((row0 + ai * HALF + m * 16) & 255) * ldc + col0;
#pragma unroll
                for (int bj = 0; bj < 2; ++bj) { const f32x4 v0 = acc[ai][bj][m][0] + pre.bv[bj][0], v1 = acc[ai][bj][m][1] + pre.bv[bj][1];
                    u32x4 w; w.x = cvt_pk_bf16(v0[0], v0[1]); w.y = cvt_pk_bf16(v0[2], v0[3]); w.z = cvt_pk_bf16(v1[0], v1[1]); w.w = cvt_pk_bf16(v1[2], v1[3]);
                    *(u32x4*)(rowp + bj * HALF) = w; } }
    }
};
struct EpiBf16BiasF8 {
    static constexpr bool PERM = true, AFTER_DRAIN = false;
    bf16_t* O; int ldc; const float* bias; int bias_stride;
    struct Pre { f32x4 bv[2][2]; };
    __device__ __forceinline__ void preload(Pre& p, const Unit& u, int wr, int wc, int fr, int fq) const {
        const float* bb = bias + (size_t)u.e * bias_stride + u.pn * BM + wc * 32 + 8 * fq;
#pragma unroll
        for (int bj = 0; bj < 2; ++bj)
#pragma unroll
            for (int n = 0; n < 2; ++n) p.bv[bj][n] = *(const f32x4*)(bb + bj * HALF + 4 * n);
    }
    __device__ __forceinline__ void operator()(const f32x4 (&acc)[2][2][4][2], const Unit& u, int wr, int wc, int fr, int fq, const Pre& pre) const {
        asm volatile("" : "+v"(fr), "+v"(fq));
        const int row0 = u.pm * BM + wr * 64 + fr; const int col0 = u.pn * BM + wc * 32 + 8 * fq;
#pragma unroll
        for (int ai = 0; ai < 2; ++ai)
#pragma unroll
            for (int m = 0; m < 4; ++m) { bf16_t* rowp = O + (size_t)(row0 + ai * HALF + m * 16) * ldc + col0;
#pragma unroll
                for (int bj = 0; bj < 2; ++bj) { const f32x4 v0 = acc[ai][bj][m][0] * (1.0f / (F8_SA * F8_SW)) + pre.bv[bj][0], v1 = acc[ai][bj][m][1] * (1.0f / (F8_SA * F8_SW)) + pre.bv[bj][1];
                    u32x4 w; w.x = cvt_pk_bf16(v0[0], v0[1]); w.y = cvt_pk_bf16(v0[2], v0[3]); w.z = cvt_pk_bf16(v1[0], v1[1]); w.w = cvt_pk_bf16(v1[2], v1[3]);
                    *(u32x4*)(rowp + bj * HALF) = w; } }
    }
};
struct EpiF8BiasF8 {
    static constexpr bool PERM = true, AFTER_DRAIN = false;
    bf16_t* O; int ldc; const float* bias; int bias_stride;
    struct Pre { f32x4 bv[2][2]; };
    __device__ __forceinline__ void preload(Pre& p, const Unit& u, int wr, int wc, int fr, int fq) const {
        const float* bb = bias + (size_t)u.e * bias_stride + u.pn * BM + wc * 32 + 8 * fq;
#pragma unroll
        for (int bj = 0; bj < 2; ++bj)
#pragma unroll
            for (int n = 0; n < 2; ++n) p.bv[bj][n] = *(const f32x4*)(bb + bj * HALF + 4 * n);
    }
    __device__ __forceinline__ void operator()(const f32x4 (&acc)[2][2][4][2], const Unit& u, int wr, int wc, int fr, int fq, const Pre& pre) const {
        asm volatile("" : "+v"(fr), "+v"(fq));
        const int row0 = u.pm * BM + wr * 64 + fr; const int col0 = u.pn * BM + wc * 32 + 8 * fq;
#pragma unroll
        for (int ai = 0; ai < 2; ++ai)
#pragma unroll
            for (int m = 0; m < 4; ++m) { unsigned char* rowp = (unsigned char*)O + (size_t)(row0 + ai * HALF + m * 16) * ldc + col0;
#pragma unroll
                for (int bj = 0; bj < 2; ++bj) { const f32x4 v0 = (acc[ai][bj][m][0] * (1.0f / (F8_SA * F8_SW)) + pre.bv[bj][0]) * F8_SY, v1 = (acc[ai][bj][m][1] * (1.0f / (F8_SA * F8_SW)) + pre.bv[bj][1]) * F8_SY;
                    typedef unsigned u32x2 __attribute__((ext_vector_type(2)));
                    u32x2 w; w.x = pack4_fp8(v0[0], v0[1], v0[2], v0[3]); w.y = pack4_fp8(v1[0], v1[1], v1[2], v1[3]);
                    *(u32x2*)(rowp + bj * HALF) = w; } }
    }
};
struct EpiLruGate {
    static constexpr bool PERM = false, AFTER_DRAIN = false;
    const bf16_t* XL; bf16_t* LAB; size_t lab_stride; const float* gb; const float* spt;
    struct Pre {}; __device__ __forceinline__ void preload(Pre&, const Unit&, int, int, int, int) const {}
    __device__ __forceinline__ void operator()(const f32x4 (&acc)[2][2][4][2], const Unit& u, int wr, int wc, int fr, int fq, const Pre&) const {
        const int d = u.pn >> 1, half = u.pn & 1;
        const int row0 = u.pm * BM + wr * 64 + fr, ch0 = half * 128 + wc * 32 + 4 * fq;
        bf16_t* LA = LAB + (size_t)(2 * d) * lab_stride; bf16_t* LB = LAB + (size_t)(2 * d + 1) * lab_stride;
#pragma unroll
        for (int n = 0; n < 2; ++n) {
            const f32x4 bR = *(const f32x4*)(gb + (d * 2 + 0) * 256 + ch0 + 16 * n), bI = *(const f32x4*)(gb + (d * 2 + 1) * 256 + ch0 + 16 * n);
            const f32x4 sp = *(const f32x4*)(spt + d * 256 + ch0 + 16 * n) * (-8.0f * 1.4426950408889634f);
#pragma unroll
            for (int ai = 0; ai < 2; ++ai)
#pragma unroll
                for (int m = 0; m < 4; ++m) { const size_t ro = (size_t)(row0 + ai * HALF + m * 16) * 256 + ch0 + 16 * n;
                    typedef unsigned u32x2 __attribute__((ext_vector_type(2)));
                    const u32x2 xw = *(const u32x2*)(XL + ro);
                    const float xl[4] = {__builtin_bit_cast(float, xw.x << 16), __builtin_bit_cast(float, xw.x & 0xffff0000u), __builtin_bit_cast(float, xw.y << 16), __builtin_bit_cast(float, xw.y & 0xffff0000u)};
                    const f32x4 gr = acc[ai][0][m][n] + bR, gi = acc[ai][1][m][n] + bI;
                    f32x4 av, bv;
#pragma unroll
                    for (int e = 0; e < 4; ++e) {
                        const float rg = __builtin_amdgcn_rcpf(1.0f + __builtin_amdgcn_exp2f(-1.4426950408889634f * gr[e])), ig = __builtin_amdgcn_rcpf(1.0f + __builtin_amdgcn_exp2f(-1.4426950408889634f * gi[e]));
                        const float la2 = rg * sp[e];
                        const float a2 = __builtin_amdgcn_exp2f(2.0f * la2);
                        av[e] = la2; bv[e] = __builtin_amdgcn_sqrtf(fmaxf(1.0f - a2, 0.f)) * (ig * xl[e]); }
                    u32x2 wa, wb; wa.x = cvt_pk_bf16(av[0], av[1]); wa.y = cvt_pk_bf16(av[2], av[3]); wb.x = cvt_pk_bf16(bv[0], bv[1]); wb.y = cvt_pk_bf16(bv[2], bv[3]);
                    *(u32x2*)(LA + ro) = wa; *(u32x2*)(LB + ro) = wb; }
        }
    }
};
struct EpiNone {
    static constexpr bool PERM = true, AFTER_DRAIN = false;
    struct Pre {}; __device__ __forceinline__ void preload(Pre&, const Unit&, int, int, int, int) const {}
    __device__ __forceinline__ void operator()(const f32x4 (&acc)[2][2][4][2], const Unit& u, int wr, int wc, int fr, int fq, const Pre&) const {
#pragma unroll
        for (int a = 0; a < 2; ++a)
#pragma unroll
            for (int b2 = 0; b2 < 2; ++b2)
#pragma unroll
                for (int m = 0; m < 4; ++m)
#pragma unroll
                    for (int n = 0; n < 2; ++n) { f32x4 v = acc[a][b2][m][n]; asm volatile("" :: "v"(v)); }
    }
};
template <bool GATHER_> struct MoeOrderT {
    static constexpr bool GATHER = GATHER_;
    const int* rowtok;
    __device__ __forceinline__ int row_of(int r) const { return GATHER_ ? rowtok[r] : r; }
    const PG8_LAS int* tab; int ntiles, nN, nper, j, m_lo, nMx, wgm, rev;
    __device__ __forceinline__ void init(const PG8_LAS int* tab_, int ntiles_, int nN_, int G, int bx, int wgm_) {
        tab = tab_; ntiles = ntiles_; nN = nN_; wgm = wgm_; rev = 0;
        if (G % 8 == 0) { const int x = bx % 8; nper = G / 8; j = bx / 8; m_lo = (x * ntiles) / 8; nMx = ((x + 1) * ntiles) / 8 - m_lo; }
        else { nper = G; j = bx; m_lo = 0; nMx = ntiles; }
    }
    __device__ __forceinline__ bool next(int i, Unit& u) const {
        const int s = i * nper + j; if (s >= nMx * nN) return false;
        const int nig = wgm * nN, gid = s / nig, fm = gid * wgm, gsz = (nMx - fm) < wgm ? (nMx - fm) : wgm, w = s - gid * nig;
        const int mi = fm + (w % gsz); u.pm = m_lo + (rev ? (nMx - 1 - mi) : mi); u.pn = w / gsz; u.e = tab[u.pm]; u.be = u.e * nN + u.pn; return true;
    }
    __device__ __forceinline__ void a_ready(const Unit&) const {}
    __device__ __forceinline__ void done(const Unit&) const {}
};
template <class Epi, class Sched, bool ALIGN_EPI = false, bool SP2 = false, bool FP8 = false>
__device__ __forceinline__ void gemm_phase(PG8_LAS unsigned char* lds, const Gemm g, const Sched& S, const Epi& E) {
    int tid_ = threadIdx.x; asm volatile("" : "+v"(tid_));
    const int tid = tid_, wid = __builtin_amdgcn_readfirstlane(tid >> 6), lane = tid & 63, wr = wid >> 2, wc = wid & 3, fr = lane & 15, fq = lane >> 4;
    const int K = g.K, nt = K / BK;
    unsigned voffA[2], voffB[2];
#pragma unroll
    for (int i = 0; i < 2; ++i) { int R, C; stage_rc(tid * 16 + i * 8192, R, C); const int Rb = Epi::PERM ? ((R & ~31) + perm32(R & 31)) : R;
        voffA[i] = (unsigned)(R * K + C) * 2u; voffB[i] = (unsigned)(Rb * K + C) * 2u; }
    unsigned gA_[2] = {0u, 0u}, gN_[2] = {0u, 0u}, gC_[2] = {0u, 0u};
    static_assert(!Sched::GATHER || SP2, "the gathered A operand is wired into the SP2 loop only");
    if constexpr (Sched::GATHER) { _Pragma("unroll") for (int i_ = 0; i_ < 2; ++i_) { int R_, C_; stage_rc(tid * 16 + i_ * 8192, R_, C_); gC_[i_] = (unsigned)(C_ * 2); } }
#define PG8_GLOAD(dst, pm_) do { _Pragma("unroll") for (int h_ = 0; h_ < 2; ++h_) { unsigned t_[2]; _Pragma("unroll") for (int i_ = 0; i_ < 2; ++i_) { int R_, C_; stage_rc(tid * 16 + i_ * 8192, R_, C_); \
        t_[i_] = (unsigned)S.row_of((pm_) * BM + h_ * HALF + R_); } dst[h_] = t_[0] | (t_[1] << 16); } } while (0)
    const size_t kstep = (size_t)(BK * 2);
    const size_t hstep = (size_t)HALF * K * 2;
    const size_t tstep = 2 * hstep;
    const unsigned ldsw = (unsigned)wid * 1024u;
    const int aoff = lds_byte(wr * 64 + fr, fq * 8), boff = lds_byte(wc * 32 + fr, fq * 8);
#define PG8_SA(b, h) (((b) * 2 + (h)) * HTB)
#define PG8_SB(b, h) ((4 + (b) * 2 + (h)) * HTB)
#define PG8_STAGE(bufoff, gbase, voff) do { _Pragma("unroll") for (int _i = 0; _i < 2; ++_i) \
        __builtin_amdgcn_global_load_lds((const unsigned*)((const char*)(gbase) + (voff)[_i]), (PG8_LAS unsigned*)(lds + (bufoff) + ldsw + _i * 8192), 16, 0, 0); } while (0)
#define PG8_STA(bufoff, ptr, h, useN) do { if constexpr (Sched::GATHER) { const unsigned pk_ = (useN) ? gN_[h] : gA_[h]; unsigned o_[2] = {(pk_ & 0xffffu) * (unsigned)(K * 2) + gC_[0], (pk_ >> 16) * (unsigned)(K * 2) + gC_[1]}; PG8_STAGE(bufoff, ptr, o_); } \
        else { PG8_STAGE(bufoff, (ptr) + ((h) ? hstep : 0), voffA); } } while (0)
#define PG8_LDA(dst, b, h) do { _Pragma("unroll") for (int m = 0; m < 4; ++m) { if constexpr (FP8) { \
            dst##8[m] = __builtin_shufflevector(*(const PG8_LAS i32x4_*)(lds + PG8_SA(b, h) + aoff + m * 2048), *(const PG8_LAS i32x4_*)(lds + PG8_SA(b, h) + aoff + m * 2048 + 1024), 0, 1, 2, 3, 4, 5, 6, 7); } \
        else { _Pragma("unroll") for (int k = 0; k < 2; ++k) dst[m][k] = *(const PG8_LAS bf16x8*)(lds + PG8_SA(b, h) + aoff + m * 2048 + k * 1024); } } } while (0)
#define PG8_LDB(dst, b, h) do { _Pragma("unroll") for (int n = 0; n < 2; ++n) { if constexpr (FP8) { \
            dst##8[n] = __builtin_shufflevector(*(const PG8_LAS i32x4_*)(lds + PG8_SB(b, h) + boff + n * 2048), *(const PG8_LAS i32x4_*)(lds + PG8_SB(b, h) + boff + n * 2048 + 1024), 0, 1, 2, 3, 4, 5, 6, 7); } \
        else { _Pragma("unroll") for (int k = 0; k < 2; ++k) dst[n][k] = *(const PG8_LAS bf16x8*)(lds + PG8_SB(b, h) + boff + n * 2048 + k * 1024); } } } while (0)
#define PG8_MMA(ai, bj, At, Bt) do { __builtin_amdgcn_s_setprio(1); _Pragma("unroll") for (int m = 0; m < 4; ++m) _Pragma("unroll") for (int n = 0; n < 2; ++n) { \
        if constexpr (FP8) asm volatile("v_mfma_f32_16x16x128_f8f6f4 %0, %1, %2, %0" : "+v"(acc[ai][bj][m][n]) : "v"(Bt##8[n]), "v"(At##8[m]));   \
        else { _Pragma("unroll") for (int k = 0; k < 2; ++k) acc[ai][bj][m][n] = __builtin_amdgcn_mfma_f32_16x16x32_bf16(Bt[n][k], At[m][k], acc[ai][bj][m][n], 0, 0, 0); } } \
        __builtin_amdgcn_s_setprio(0); } while (0)
#define PG8_WAIT_V(n) asm volatile("s_waitcnt vmcnt(" #n ")" ::: "memory")
#define PG8_WAIT_L(n) asm volatile("s_waitcnt lgkmcnt(" #n ")" ::: "memory")
#define PG8_BAR __builtin_amdgcn_s_barrier()
#define PG8_SCHED __builtin_amdgcn_sched_barrier(0)
    Unit cur, nxt; int ui = 0;
    if (!S.next(0, cur)) return;
    f32x4 acc[2][2][4][2];
#pragma unroll
    for (int a = 0; a < 2; ++a)
#pragma unroll
        for (int b = 0; b < 2; ++b)
#pragma unroll
            for (int m = 0; m < 4; ++m)
#pragma unroll
                for (int n = 0; n < 2; ++n) acc[a][b][m][n] = (f32x4){0.f, 0.f, 0.f, 0.f};
    typedef int i32x4_ __attribute__((ext_vector_type(4))); typedef int i32x8_ __attribute__((ext_vector_type(8)));
    bf16x8 At[4][2], B0[2][2], B1[2][2]; i32x8_ At8[4], B08[2], B18[2];
    typename Epi::Pre pre;
    const char* cA = (const char*)g.A + (Sched::GATHER ? (size_t)0 : (size_t)cur.pm * tstep); if constexpr (Sched::GATHER) PG8_GLOAD(gA_, cur.pm);
    const char* cB = (const char*)g.Bt + (size_t)cur.be * tstep;
    S.a_ready(cur);
    if constexpr (SP2) {
        PG8_STAGE(PG8_SB(0, 0), cB, voffB); PG8_STAGE(PG8_SB(0, 1), cB + hstep, voffB); PG8_STA(PG8_SA(0, 0), cA, 0, false); PG8_STA(PG8_SA(0, 1), cA, 1, false);
        if (wr == 1) PG8_BAR;
        PG8_WAIT_V(2); PG8_BAR;
        PG8_STAGE(PG8_SB(1, 0), cB + kstep, voffB); PG8_STA(PG8_SA(1, 0), cA + kstep, 0, false); PG8_STAGE(PG8_SB(1, 1), cB + hstep + kstep, voffB);
        PG8_WAIT_V(6); PG8_BAR;
    } else {
        PG8_STAGE(PG8_SB(0, 0), cB, voffB); PG8_STAGE(PG8_SA(0, 0), cA, voffA); PG8_STAGE(PG8_SB(0, 1), cB + hstep, voffB); PG8_STAGE(PG8_SA(0, 1), cA + hstep, voffA);
        if (wr == 1) PG8_BAR;
        PG8_WAIT_V(4); PG8_BAR;
        PG8_STAGE(PG8_SB(1, 0), cB + kstep, voffB); PG8_STAGE(PG8_SA(1, 0), cA + kstep, voffA); PG8_STAGE(PG8_SB(1, 1), cB + hstep + kstep, voffB);
        PG8_WAIT_V(6); PG8_BAR;
    }
    for (;;) {
        const bool has_next = S.next(ui + 1, nxt);
        const char* nA = (has_next && !Sched::GATHER) ? (const char*)g.A + (size_t)nxt.pm * tstep : cA; const char* nB = has_next ? (const char*)g.Bt + (size_t)nxt.be * tstep : cB;
        if constexpr (Sched::GATHER) { if (has_next) PG8_GLOAD(gN_, nxt.pm); else { gN_[0] = gA_[0]; gN_[1] = gA_[1]; } }
        for (int t = 0; t < nt; t += 2) {
            const bool last = (t == nt - 2);
            const char* a1 = cA + (size_t)(t + 1) * kstep;
            const char* a2 = last ? nA : cA + (size_t)(t + 2) * kstep; const char* b2 = last ? nB : cB + (size_t)(t + 2) * kstep;
            const char* a3 = a2 + kstep; const char* b3 = b2 + kstep;
            if (last) E.preload(pre, cur, wr, wc, fr, fq);
            if (last && has_next) S.a_ready(nxt);
            if constexpr (SP2) {
            PG8_LDB(B0, 0, 0); PG8_LDB(B1, 0, 1); PG8_SCHED; PG8_LDA(At, 0, 0); PG8_STA(PG8_SA(1, 1), a1, 1, false);
            PG8_WAIT_V(8); PG8_WAIT_L(0); PG8_BAR; PG8_MMA(0, 0, At, B0); PG8_MMA(0, 1, At, B1); PG8_BAR; PG8_SCHED;
            PG8_LDA(At, 0, 1); PG8_STAGE(PG8_SB(0, 0), b2, voffB); PG8_STAGE(PG8_SB(0, 1), b2 + hstep, voffB); PG8_STA(PG8_SA(0, 0), a2, 0, last);
            PG8_WAIT_V(8); PG8_WAIT_L(0); PG8_BAR; PG8_MMA(1, 0, At, B0); PG8_MMA(1, 1, At, B1); PG8_BAR; PG8_SCHED;
            PG8_LDB(B0, 1, 0); PG8_LDB(B1, 1, 1); PG8_SCHED; PG8_LDA(At, 1, 0); PG8_STA(PG8_SA(0, 1), a2, 1, last);
            PG8_WAIT_V(8); PG8_WAIT_L(0); PG8_BAR; PG8_MMA(0, 0, At, B0); PG8_MMA(0, 1, At, B1); PG8_BAR; PG8_SCHED;
            PG8_LDA(At, 1, 1); PG8_STAGE(PG8_SB(1, 0), b3, voffB); PG8_STAGE(PG8_SB(1, 1), b3 + hstep, voffB); PG8_STA(PG8_SA(1, 0), a3, 0, last);
            PG8_WAIT_V(8); PG8_WAIT_L(0); PG8_BAR; PG8_MMA(1, 0, At, B0); PG8_MMA(1, 1, At, B1); PG8_BAR; PG8_SCHED;
            } else {
            PG8_LDB(B0, 0, 0); PG8_SCHED; PG8_LDA(At, 0, 0); PG8_STAGE(PG8_SA(1, 1), a1 + hstep, voffA);
            PG8_WAIT_L(8); PG8_BAR; PG8_WAIT_L(0); PG8_MMA(0, 0, At, B0); PG8_BAR; PG8_SCHED;
            PG8_LDB(B1, 0, 1); PG8_STAGE(PG8_SB(0, 0), b2, voffB);
            PG8_BAR; PG8_WAIT_L(0); PG8_MMA(0, 1, At, B1); PG8_BAR;
            PG8_LDA(At, 0, 1); PG8_STAGE(PG8_SA(0, 0), a2, voffA);
            PG8_BAR; PG8_WAIT_L(0); PG8_MMA(1, 0, At, B0); PG8_BAR; PG8_SCHED;
            PG8_STAGE(PG8_SB(0, 1), b2 + hstep, voffB);
            PG8_WAIT_V(6); PG8_BAR; PG8_MMA(1, 1, At, B1); PG8_BAR;
            PG8_LDB(B0, 1, 0); PG8_SCHED; PG8_LDA(At, 1, 0); PG8_STAGE(PG8_SA(0, 1), a2 + hstep, voffA);
            PG8_WAIT_L(8); PG8_BAR; PG8_WAIT_L(0); PG8_MMA(0, 0, At, B0); PG8_BAR; PG8_SCHED;
            PG8_LDB(B1, 1, 1); PG8_STAGE(PG8_SB(1, 0), b3, voffB);
            PG8_BAR; PG8_WAIT_L(0); PG8_MMA(0, 1, At, B1); PG8_BAR;
            PG8_LDA(At, 1, 1); PG8_STAGE(PG8_SA(1, 0), a3, voffA);
            PG8_BAR; PG8_WAIT_L(0); PG8_MMA(1, 0, At, B0); PG8_BAR; PG8_SCHED;
            PG8_STAGE(PG8_SB(1, 1), b3 + hstep, voffB);
            PG8_WAIT_V(6); PG8_BAR; PG8_MMA(1, 1, At, B1); PG8_BAR;
            }
        }
        if constexpr (ALIGN_EPI) { if (wr == 0) PG8_BAR; }
        if constexpr (!Epi::AFTER_DRAIN) { E(acc, cur, wr, wc, fr, fq, pre); S.done(cur); }
        if (!has_next) break;
#pragma unroll
        for (int a = 0; a < 2; ++a)
#pragma unroll
            for (int b = 0; b < 2; ++b)
#pragma unroll
                for (int m = 0; m < 4; ++m)
#pragma unroll
                    for (int n = 0; n < 2; ++n) acc[a][b][m][n] = (f32x4){0.f, 0.f, 0.f, 0.f};
        cur = nxt; cA = nA; cB = nB; ++ui;
        if constexpr (Sched::GATHER) { gA_[0] = gN_[0]; gA_[1] = gN_[1]; }
        if constexpr (ALIGN_EPI) { if (wr == 1) PG8_BAR; }
    }
    PG8_WAIT_V(0);
    if constexpr (!ALIGN_EPI) { if (wr == 0) PG8_BAR; }
    PG8_BAR;
    if constexpr (Epi::AFTER_DRAIN) { E.fused(acc, cur, wr, wc, fr, fq, lds, wid, lane); S.done(cur); }
#undef PG8_SA
#undef PG8_SB
#undef PG8_STAGE
#undef PG8_STA
#undef PG8_GLOAD
#undef PG8_LDA
#undef PG8_LDB
#undef PG8_MMA
#undef PG8_WAIT_V
#undef PG8_WAIT_L
#undef PG8_BAR
#undef PG8_SCHED
}
}

#ifndef PG8_SP2
#define PG8_SP2 true
#endif
#ifndef PG8_ALIGN
#define PG8_ALIGN true
#endif
#include <cmath>
namespace attn_body {
using bf16=__hip_bfloat16;
using bf16x8=__attribute__((ext_vector_type(8)))short;
using s16x4=__attribute__((ext_vector_type(4)))short;
using f32x16=__attribute__((ext_vector_type(16)))float;
using u32x4=__attribute__((ext_vector_type(4)))unsigned;
using f32x4_t=__attribute__((ext_vector_type(4)))float;
constexpr int NHEAD=8,SEQQ=8192,SEQK=8448,D=64,QP=512,KP=128,QIN=2048;
constexpr int NW=8,QBLK=32,QB=QBLK*NW,KVBLK=64,NQB=SEQQ/QB;
constexpr int ATTN_UNIT_ROWS=QB;
__device__ __forceinline__ int crow(int r,int hi){return (r&3)+8*(r>>2)+4*hi;}
#define SBAR() __builtin_amdgcn_sched_barrier(0)
__device__ __forceinline__ void cmask(f32x16&p0,f32x16&p1,int jb,int qrel,int hi){
  const float NEG=-INFINITY; int kb=64*jb+4*hi;
  #pragma unroll
  for(int r=0;r<16;++r){int kv=kb+(r&3)+8*(r>>2); if(kv>qrel)p0[r]=NEG; if(kv+32>qrel)p1[r]=NEG;}
}

constexpr int NSLOT=3, SLOTB=8192;
constexpr int LDS_K=0, LDS_V=NSLOT*SLOTB, LDS_WS=2*NSLOT*SLOTB, LDS_OST=LDS_WS+NW*64*4, LDS_BYTES=LDS_OST+NW*4096;
constexpr float C2=0.125f*1.4426950408889634f;
__device__ __forceinline__ void glds16(const void*gsrc,unsigned lds_dst){unsigned keep;
  asm volatile("s_mov_b32 %0, m0\n\ts_mov_b32 m0, %2\n\ts_nop 0\n\tglobal_load_lds_dwordx4 %1, off\n\ts_mov_b32 m0, %0":"=&s"(keep):"v"(gsrc),"s"(lds_dst):"memory");}
__device__ __forceinline__ float max3f(float a,float b,float c){float r;asm("v_max3_f32 %0, %1, %2, %3":"=v"(r):"v"(a),"v"(b),"v"(c));return r;}
__device__ __forceinline__ float max2f(float a,float b){float r;asm("v_max_f32_e32 %0, %1, %2":"=v"(r):"v"(a),"v"(b));return r;}
__device__ __forceinline__ float fadd_s(float a,float b){float r;asm("v_add_f32_e32 %0, %1, %2":"=v"(r):"v"(a),"v"(b));return r;}
__device__ __forceinline__ float fsub_s(float a,float b){float r;asm("v_sub_f32_e32 %0, %1, %2":"=v"(r):"v"(a),"v"(b));return r;}
typedef float f32x2_t __attribute__((ext_vector_type(2))); typedef __bf16 bf16x2_t __attribute__((ext_vector_type(2)));
__device__ __forceinline__ unsigned cvtpk_s(float lo,float hi){f32x2_t v={lo,hi};bf16x2_t b=__builtin_convertvector(v,bf16x2_t);return __builtin_bit_cast(unsigned,b);}
#define WAIT_BAR(N) asm volatile("s_waitcnt vmcnt(" #N ") lgkmcnt(0)\n\ts_barrier":::"memory")

__device__ __forceinline__ void qkt(f32x16&p0,f32x16&p1,const char*Kslot,const bf16x8*qr,const f32x16&negm,int r32,int hi){
  const char*kb=Kslot+hi*1024+r32*16;
  #pragma unroll
  for(int d0=0;d0<4;++d0){
    const bf16x8 b0=*reinterpret_cast<const bf16x8*>(kb+d0*2048);
    const bf16x8 b1=*reinterpret_cast<const bf16x8*>(kb+d0*2048+512);
    if(d0==0){p0=__builtin_amdgcn_mfma_f32_32x32x16_bf16(b0,qr[0],negm,0,0,0);p1=__builtin_amdgcn_mfma_f32_32x32x16_bf16(b1,qr[0],negm,0,0,0);}
    else{p0=__builtin_amdgcn_mfma_f32_32x32x16_bf16(b0,qr[d0],p0,0,0,0);p1=__builtin_amdgcn_mfma_f32_32x32x16_bf16(b1,qr[d0],p1,0,0,0);}}
}
typedef __attribute__((address_space(3))) const char* lds_cptr;
typedef short v4i16_t __attribute__((ext_vector_type(4)));
__device__ __forceinline__ void kload8(bf16x8*kf,lds_cptr kp){
  kf[0]=*(const __attribute__((address_space(3))) bf16x8*)(kp);      kf[1]=*(const __attribute__((address_space(3))) bf16x8*)(kp+512);
  kf[2]=*(const __attribute__((address_space(3))) bf16x8*)(kp+2048); kf[3]=*(const __attribute__((address_space(3))) bf16x8*)(kp+2560);
  kf[4]=*(const __attribute__((address_space(3))) bf16x8*)(kp+4096); kf[5]=*(const __attribute__((address_space(3))) bf16x8*)(kp+4608);
  kf[6]=*(const __attribute__((address_space(3))) bf16x8*)(kp+6144); kf[7]=*(const __attribute__((address_space(3))) bf16x8*)(kp+6656);
}
__device__ __forceinline__ void kload2(bf16x8*kf,lds_cptr kp,int j){ kf[2*j]=*(const __attribute__((address_space(3))) bf16x8*)(kp+j*2048); kf[2*j+1]=*(const __attribute__((address_space(3))) bf16x8*)(kp+j*2048+512); }
__device__ __forceinline__ s16x4 vtr(lds_cptr p){ return __builtin_bit_cast(s16x4,__builtin_amdgcn_ds_read_tr16_b64_v4i16((__attribute__((address_space(3))) v4i16_t*)p)); }
__device__ __forceinline__ float rowmax(const f32x16&p0,const f32x16&p1){
  float a=max3f(p0[0],p0[1],p1[0]),b=max3f(p0[2],p0[3],p1[1]);a=max3f(a,p1[2],p1[3]);
  #pragma unroll
  for(int r=4;r<16;r+=4){a=max3f(a,p0[r],p0[r+1]);b=max3f(b,p0[r+2],p0[r+3]);a=max3f(a,p1[r],p1[r+1]);b=max3f(b,p1[r+2],p1[r+3]);}
  const float m=max2f(a,b);
  auto rr=__builtin_amdgcn_permlane32_swap(__float_as_uint(m),__float_as_uint(m),false,false);
  return max2f(__uint_as_float(rr[0]),__uint_as_float(rr[1]));
}
__device__ __forceinline__ void pv(f32x16*o,int vb,bf16x8 pa0,bf16x8 pa1,bf16x8 pa2,bf16x8 pa3){
  #pragma unroll
  for(int d0=0;d0<2;++d0){s16x4 lo[4],hi[4];
    #pragma unroll
    for(int ks=0;ks<4;++ks){
      asm volatile("ds_read_b64_tr_b16 %0,%1 offset:%c2":"=&v"(lo[ks]):"v"(vb),"i"(d0*4096+ks*1024):"memory");
      asm volatile("ds_read_b64_tr_b16 %0,%1 offset:%c2":"=&v"(hi[ks]):"v"(vb),"i"(d0*4096+ks*1024+512):"memory");}
    asm volatile("s_waitcnt lgkmcnt(0)":::"memory");SBAR();
    #define PK(k) (bf16x8){lo[k][0],lo[k][1],lo[k][2],lo[k][3],hi[k][0],hi[k][1],hi[k][2],hi[k][3]}
    o[d0]=__builtin_amdgcn_mfma_f32_32x32x16_bf16(pa0,PK(0),o[d0],0,0,0);
    o[d0]=__builtin_amdgcn_mfma_f32_32x32x16_bf16(pa1,PK(1),o[d0],0,0,0);
    o[d0]=__builtin_amdgcn_mfma_f32_32x32x16_bf16(pa2,PK(2),o[d0],0,0,0);
    o[d0]=__builtin_amdgcn_mfma_f32_32x32x16_bf16(pa3,PK(3),o[d0],0,0,0);
    #undef PK
  }
}

#ifndef ATTN_STORE16
#define ATTN_STORE16(p,v) (*(u32x4*)(p)=(v))
#endif
struct QPre { const float* qg; const float* rc; const float* rs; };
template<int THRL> __device__ __forceinline__ void attn_unit(int b,int h,long qrow0,int NTarg,int tq0,const QPre&QN,const bf16*Q,const bf16*__restrict__ K,const bf16*__restrict__ V,bf16*O,char*shm){
  int tid_=threadIdx.x; asm volatile("":"+v"(tid_)); const int tid=tid_,lane=tid&63,r32=lane&31,hi=lane>>5; const int wid=__builtin_amdgcn_readfirstlane(tid>>6);
  const long krowbase=(long)b*SEQK; const int kvh=h>>2;
  const bf16*Qw=Q+(qrow0+wid*QBLK)*QIN+h*D;
  const bf16*Kh=K+krowbase*KP+kvh*D,*Vh=V+krowbase*KP+kvh*D;
  const unsigned lds0=(unsigned)(uintptr_t)shm;
  float*wsf=(float*)(shm+LDS_WS)+wid*64;
  const bf16*ksrc=Kh+(long)lane*KP+wid*8;
  const bf16*vsrc=Vh+(long)(16*(wid&3)+(lane>>2))*KP+(wid>>2)*32+(lane&3)*8;
  const unsigned kdst=lds0+LDS_K+wid*1024, vdst=lds0+LDS_V+wid*1024;
  #define DMA_K(t,slot) glds16(ksrc+(long)(t)*KVBLK*KP,(unsigned)__builtin_amdgcn_readfirstlane(kdst+(slot)))
  #define DMA_V(t,slot) glds16(vsrc+(long)(t)*KVBLK*KP,(unsigned)__builtin_amdgcn_readfirstlane(vdst+(slot)))
  const int vb0=(int)(lds0+LDS_V)+((lane>>4)&1)*32+(lane&3)*8+(4*hi+((lane&15)>>2))*64;
  const char*Kbase=shm+LDS_K; bf16x8 kf[8];
  const lds_cptr shm3=(lds_cptr)shm; const lds_cptr kp0=shm3+LDS_K+hi*1024+r32*16; const lds_cptr vp0=shm3+LDS_V+((lane>>4)&1)*32+(lane&3)*8+(4*hi+((lane&15)>>2))*64;
  const int NT=NTarg;
  DMA_K(0,0);DMA_V(0,0);DMA_K(1,SLOTB);
  bf16x8 qr[4];
  #pragma unroll
  for(int d0=0;d0<4;++d0)qr[d0]=*reinterpret_cast<const bf16x8*>(&Qw[(long)r32*QIN+d0*16+hi*8]);
  {
    float x[4][8]; float ss=0.f;
    #pragma unroll
    for(int d0=0;d0<4;++d0){
      #pragma unroll
      for(int e=0;e<8;++e){ x[d0][e]=__builtin_bit_cast(float,(unsigned)(unsigned short)qr[d0][e]<<16); ss+=x[d0][e]*x[d0][e]; } }
    ss+=__shfl_xor(ss,32);
    const float rstd=C2/sqrtf(ss*(1.0f/64.0f)+1e-6f);
    #pragma unroll
    for(int d0=0;d0<4;++d0){ const f32x4_t g0=*reinterpret_cast<const f32x4_t*>(QN.qg+16*d0+8*hi), g1=*reinterpret_cast<const f32x4_t*>(QN.qg+16*d0+8*hi+4);
      #pragma unroll
      for(int e=0;e<8;++e) x[d0][e]*=rstd*(e<4?g0[e]:g1[e-4]); }
    if(tq0>=0){ const int t=tq0+wid*QBLK+r32;
      #pragma unroll
      for(int d0=0;d0<2;++d0){ const float*cp=QN.rc+(long)t*32+16*d0+8*hi,*sp=QN.rs+(long)t*32+16*d0+8*hi;
        const f32x4_t c0=*reinterpret_cast<const f32x4_t*>(cp),c1=*reinterpret_cast<const f32x4_t*>(cp+4),s0=*reinterpret_cast<const f32x4_t*>(sp),s1=*reinterpret_cast<const f32x4_t*>(sp+4);
        #pragma unroll
        for(int e=0;e<8;++e){ const float cs=e<4?c0[e]:c1[e-4], sn=e<4?s0[e]:s1[e-4]; const float a=x[d0][e], bq=x[d0+2][e]; x[d0][e]=a*cs-bq*sn; x[d0+2][e]=bq*cs+a*sn; } } }
    #pragma unroll
    for(int d0=0;d0<4;++d0){ u32x4 pk; pk[0]=cvtpk_s(x[d0][0],x[d0][1]); pk[1]=cvtpk_s(x[d0][2],x[d0][3]); pk[2]=cvtpk_s(x[d0][4],x[d0][5]); pk[3]=cvtpk_s(x[d0][6],x[d0][7]); qr[d0]=__builtin_bit_cast(bf16x8,pk); }
  }
  float mhat=0.f,l_reg=0.f;f32x16 o[2];o[0]=f32x16{};o[1]=f32x16{};f32x16 negm=f32x16{};asm volatile("":"+v"(negm));
  const int qrel=wid*QBLK+r32;
  #define CMASK(P0,P1,t) do{}while(0)
  bool resc=false;
  #define START(P0,P1) do{ const float rm=rowmax(P0,P1); resc=false; \
    { const float dl=rm; mhat=fadd_s(mhat,dl); \
      _Pragma("unroll") for(int r=0;r<16;++r){P0[r]=fsub_s(P0[r],dl);P1[r]=fsub_s(P1[r],dl);} \
      _Pragma("unroll") for(int r=0;r<16;++r)negm[r]=-mhat; asm volatile("":"+v"(negm)); } \
    _Pragma("unroll") for(int r=0;r<16;++r)P0[r]=__builtin_amdgcn_exp2f(P0[r]); }while(0)
  #define RESC() do{ if(resc){ asm volatile("s_waitcnt lgkmcnt(0)":::"memory"); \
      _Pragma("unroll") for(int d_=0;d_<2;++d_) _Pragma("unroll") for(int r=0;r<16;++r)o[d_][r]*=wsf[crow(r,hi)]; } }while(0)
  f32x16 pA0,pA1,pB0,pB1;
  int sl_prev=0,sl_cur=0,sl_next=SLOTB;
  #define ROT() do{sl_prev=sl_cur;sl_cur=sl_next;sl_next=(sl_next==(NSLOT-1)*SLOTB)?0:sl_next+SLOTB;}while(0)
  DMA_K(2,2*SLOTB);
  WAIT_BAR(3);
  qkt(pA0,pA1,Kbase,qr,negm,r32,hi);asm volatile("s_nop 15\n\ts_nop 7":"+v"(pA0),"+v"(pA1));CMASK(pA0,pA1,0);
  START(pA0,pA1);
  _Pragma("unroll") for(int r=0;r<16;++r)pA1[r]=__builtin_amdgcn_exp2f(pA1[r]);
  WAIT_BAR(0);
  DMA_K(3,0);DMA_V(1,SLOTB);
  ROT();
  kload8(kf,kp0+sl_cur);
  WAIT_BAR(2);
  s16x4 vlo[8],vhi[8]; u32x4 pw0,pw1,pw2,pw3;
  #define PKW(P,B) cvtpk_s(P[B],P[B+1])
  #define PAF(k) __builtin_bit_cast(bf16x8,pw##k)
  #define VFR(i) (bf16x8){vlo[i][0],vlo[i][1],vlo[i][2],vlo[i][3],vhi[i][0],vhi[i][1],vhi[i][2],vhi[i][3]}
  #define PIN(x) asm volatile("":"+v"(x))
  #define MX3(a,b,c) __builtin_fmaxf(__builtin_fmaxf((a),(b)),(c))
  #define GAPA(MF,A0,A1,A2,A3,W0,W1,PW) do{ MF; sacc+=A0; sacc+=A1; sacc+=A2; sacc+=A3; PIN(sacc); W0; W1; PIN(PW); SBAR(); }while(0)
  #define EX(v) __builtin_amdgcn_exp2f(v)
  #define GAPB(MF,X,B) do{ MF; X[B]=EX(X[B]); X[B+1]=EX(X[B+1]); X[B+2]=EX(X[B+2]); X[B+3]=EX(X[B+3]); PIN(X); SBAR(); }while(0)
  #define VRD(i) do{ vlo[i]=vtr(vp_+(((i)>>2)*4096+((i)&3)*1024)); vhi[i]=vtr(vp_+(((i)>>2)*4096+((i)&3)*1024+512)); }while(0)
  #define KRD(G,j) do{ if(G){ kload2(kf,kp0+sl_next,j); SBAR(); } }while(0)
  #define STEP(C0,C1,P0,P1,t,GK,GV,GL) do{ SBAR(); \
    const lds_cptr vp_=vp0+sl_prev; \
    VRD(0); SBAR(); float sacc=(P0[0]+P0[1]); \
    GAPA(C0=__builtin_amdgcn_mfma_f32_32x32x16_bf16(kf[0],qr[0],negm,0,0,0), P0[2],P0[3],P0[4],P0[5],     pw0[0]=PKW(P0,0), pw0[1]=PKW(P0,2), pw0); \
    VRD(4); SBAR(); GAPA(C1=__builtin_amdgcn_mfma_f32_32x32x16_bf16(kf[1],qr[0],negm,0,0,0), P0[6],P0[7],P0[8],P0[9],     pw0[2]=PKW(P0,4), pw0[3]=PKW(P0,6), pw0); \
    VRD(1); SBAR(); GAPA(C0=__builtin_amdgcn_mfma_f32_32x32x16_bf16(kf[2],qr[1],C0,0,0,0),   P0[10],P0[11],P0[12],P0[13], pw1[0]=PKW(P0,8), pw1[1]=PKW(P0,10), pw1); \
    VRD(5); SBAR(); GAPA(C1=__builtin_amdgcn_mfma_f32_32x32x16_bf16(kf[3],qr[1],C1,0,0,0),   P0[14],P0[15],P1[0],P1[1],   pw1[2]=PKW(P0,12),pw1[3]=PKW(P0,14), pw1); \
    VRD(2); SBAR(); GAPA(C0=__builtin_amdgcn_mfma_f32_32x32x16_bf16(kf[4],qr[2],C0,0,0,0),   P1[2],P1[3],P1[4],P1[5],     pw2[0]=PKW(P1,0), pw2[1]=PKW(P1,2), pw2); \
    VRD(6); SBAR(); GAPA(C1=__builtin_amdgcn_mfma_f32_32x32x16_bf16(kf[5],qr[2],C1,0,0,0),   P1[6],P1[7],P1[8],P1[9],     pw2[2]=PKW(P1,4), pw2[3]=PKW(P1,6), pw2); \
    VRD(3); SBAR(); GAPA(C0=__builtin_amdgcn_mfma_f32_32x32x16_bf16(kf[6],qr[3],C0,0,0,0),   P1[10],P1[11],P1[12],P1[13], pw3[0]=PKW(P1,8), pw3[1]=PKW(P1,10), pw3); \
    VRD(7); SBAR(); GAPA(C1=__builtin_amdgcn_mfma_f32_32x32x16_bf16(kf[7],qr[3],C1,0,0,0),   P1[14],P1[15],0.f,0.f,       pw3[2]=PKW(P1,12),pw3[3]=PKW(P1,14), pw3); \
    l_reg+=sacc; \
    if(GK){DMA_K((t)+3,sl_cur);} if(GV){DMA_V((t)+1,sl_next);} \
    CMASK(C0,C1,t); \
    { float a=MX3(C0[0],C0[1],C1[0]),b=MX3(C0[2],C0[3],C1[1]); a=MX3(a,C1[2],C1[3]); \
      _Pragma("unroll") for(int r=4;r<16;r+=4){a=MX3(a,C0[r],C0[r+1]);b=MX3(b,C0[r+2],C0[r+3]);a=MX3(a,C1[r],C1[r+1]);b=MX3(b,C1[r+2],C1[r+3]);} \
      float rm=__builtin_fmaxf(a,b); { auto rr=__builtin_amdgcn_permlane32_swap(__float_as_uint(rm),__float_as_uint(rm),false,false); rm=__builtin_fmaxf(__uint_as_float(rr[0]),__uint_as_float(rr[1])); } \
      resc=false; \
      if(__builtin_expect(__any(rm>(float)THRL),0)){ const float dl=__builtin_fmaxf(rm,0.f); mhat+=dl; \
        _Pragma("unroll") for(int r=0;r<16;++r){C0[r]-=dl;C1[r]-=dl;} \
        _Pragma("unroll") for(int r=0;r<16;++r)negm[r]=-mhat; asm volatile("":"+v"(negm)); \
        const float f=__builtin_amdgcn_exp2f(-dl); l_reg*=f; if(hi==0)wsf[r32]=f; resc=true; } } \
    SBAR(); \
    GAPB(o[0]=__builtin_amdgcn_mfma_f32_32x32x16_bf16(PAF(0),VFR(0),o[0],0,0,0), C0,0); \
    GAPB(o[1]=__builtin_amdgcn_mfma_f32_32x32x16_bf16(PAF(0),VFR(4),o[1],0,0,0), C0,4); \
    KRD(GL,0); GAPB(o[0]=__builtin_amdgcn_mfma_f32_32x32x16_bf16(PAF(1),VFR(1),o[0],0,0,0), C0,8); \
    KRD(GL,1); GAPB(o[1]=__builtin_amdgcn_mfma_f32_32x32x16_bf16(PAF(1),VFR(5),o[1],0,0,0), C0,12); \
    KRD(GL,2); GAPB(o[0]=__builtin_amdgcn_mfma_f32_32x32x16_bf16(PAF(2),VFR(2),o[0],0,0,0), C1,0); \
    KRD(GL,3); GAPB(o[1]=__builtin_amdgcn_mfma_f32_32x32x16_bf16(PAF(2),VFR(6),o[1],0,0,0), C1,4); \
    GAPB(o[0]=__builtin_amdgcn_mfma_f32_32x32x16_bf16(PAF(3),VFR(3),o[0],0,0,0), C1,8); \
    GAPB(o[1]=__builtin_amdgcn_mfma_f32_32x32x16_bf16(PAF(3),VFR(7),o[1],0,0,0), C1,12); \
    }while(0)
  int t=1;
  #undef CMASK
  #define CMASK(P0,P1,t) do{}while(0)
  for(;t+5<NT;t+=2){
    STEP(pB0,pB1,pA0,pA1,t,true,true,true);     WAIT_BAR(2); RESC(); ROT();
    STEP(pA0,pA1,pB0,pB1,t+1,true,true,true);   WAIT_BAR(2); RESC(); ROT();
  }
  #undef CMASK
  #define CMASK(P0,P1,t) do{}while(0)
  #define ENDW(tt) do{ if((tt)+3<NT){WAIT_BAR(2);} else if((tt)+2<NT){WAIT_BAR(1);} else {WAIT_BAR(0);} }while(0)
  for(;t+1<NT;t+=2){
    STEP(pB0,pB1,pA0,pA1,t,(t+3<NT),(t+1<NT),(t+1<NT));       ENDW(t);   RESC(); ROT();
    STEP(pA0,pA1,pB0,pB1,t+1,(t+4<NT),(t+2<NT),(t+2<NT));     ENDW(t+1); RESC(); ROT();
  }
  STEP(pB0,pB1,pA0,pA1,NT-1,false,false,false); RESC();
  { float sacc=pB0[0]+pB0[1]; _Pragma("unroll") for(int r=2;r<16;++r)sacc+=pB0[r]; _Pragma("unroll") for(int r=0;r<16;++r)sacc+=pB1[r]; l_reg+=sacc;
    pw0=(u32x4){PKW(pB0,0),PKW(pB0,2),PKW(pB0,4),PKW(pB0,6)};pw1=(u32x4){PKW(pB0,8),PKW(pB0,10),PKW(pB0,12),PKW(pB0,14)};pw2=(u32x4){PKW(pB1,0),PKW(pB1,2),PKW(pB1,4),PKW(pB1,6)};pw3=(u32x4){PKW(pB1,8),PKW(pB1,10),PKW(pB1,12),PKW(pB1,14)};
    SBAR(); pv(o,vb0+sl_cur,PAF(0),PAF(1),PAF(2),PAF(3)); }
  #undef PKW
  #undef PAF
  #undef VFR
  #undef PIN
  #undef MX3
  #undef GAPA
  #undef GAPB
  #undef EX
  #undef VRD
  #undef KRD
  #undef STEP
  #undef ENDW
  {auto rr=__builtin_amdgcn_permlane32_swap(__float_as_uint(l_reg),__float_as_uint(l_reg),false,false);l_reg=__uint_as_float(rr[0])+__uint_as_float(rr[1]);}
  if(hi==0)wsf[32+r32]=l_reg;asm volatile("s_waitcnt lgkmcnt(0)":::"memory");
  float rli[16];
  #pragma unroll
  for(int r=0;r<16;++r)rli[r]=__builtin_amdgcn_rcpf(wsf[32+crow(r,hi)]);
  bf16*Ow=O+(qrow0+wid*QBLK)*QP+h*D;
  { bf16*stg=(bf16*)(shm+LDS_OST)+wid*2048;
    #pragma unroll
    for(int r=0;r<16;++r){const int orow=crow(r,hi);
      #pragma unroll
      for(int d0=0;d0<2;++d0)stg[orow*64+d0*32+r32]=__float2bfloat16(o[d0][r]*rli[r]);}
    asm volatile("s_waitcnt lgkmcnt(0)":::"memory");
    #pragma unroll
    for(int i=0;i<4;++i){const int row=i*8+(lane>>3),ch=lane&7; const u32x4 v=*(const u32x4*)(stg+row*64+ch*8); ATTN_STORE16(Ow+(long)row*QP+ch*8,v);} }
  asm volatile("s_waitcnt lgkmcnt(0)\n\ts_barrier":::"memory");
  #undef DMA_K
  #undef DMA_V
  #undef CMASK
  #undef START
  #undef RESC
  #undef ROT
}
constexpr int ATTN_LDS_BYTES=LDS_BYTES;
struct AttnTensors { const bf16* Q; const bf16* K; const bf16* V; bf16* O; };
template<int THRL=8> __device__ __forceinline__ void attn_phase(char*lds,const AttnTensors&T,const QPre&QN,int G,int vcu,bool with_ctx,long ctx_row0){
  const int total=4*NHEAD*NQB;
  for(int i=0;;++i){
    int x,n;
    if(G==256){ if(i>=4)break; x=vcu>>5; n=i*32+(vcu&31); }
    else { const int u=i*G+vcu; if(u>=total)break; x=u>>7; n=u&127; }
    const int b=x>>1,kvh=x&1,h=kvh*4+(n>>5),qb=n&31;
    attn_unit<THRL>(b,h,(long)b*SEQQ+(long)qb*QB,SEQK/KVBLK,qb*QB,QN,T.Q,T.K,T.V,T.O,lds);
  }
  if(with_ctx){
    for(int u=vcu;u<4*NHEAD;u+=G){ const int b=u>>3,h=u&7; attn_unit<THRL>(b,h,ctx_row0+(long)b*256,4,-1,QN,T.Q,T.K,T.V,T.O,lds); }
  }
}
#undef SBAR
#undef WAIT_BAR
}

constexpr int NWAVES = 8, NTHR = 512;
constexpr int DMODEL = 1024, NB = 4, SEQ = 8192, CTXL = 256, NLAT = NB * SEQ, NCTX = NB * CTXL, MT = NLAT + NCTX;
constexpr int INW = 2048, NE = 32, KEYS = SEQ + CTXL;
constexpr int SORT_TILES = 560, SORT_ROWS = SORT_TILES * 256;
constexpr float EPSN = 1e-6f;
constexpr int NCHUNK = 66, CHUNK = 128;
constexpr int YS_PITCH = 1088;
constexpr int NPH_PRO = 2, NPH_LAYER = 13, NPH = NPH_PRO + 2 * NPH_LAYER;

constexpr size_t MiB = 1u << 20;
constexpr size_t WS_CTL = 0, CTL_ZERO_BYTES = 1 * MiB;
constexpr size_t WS_MOD = 1 * MiB, WS_ROPEC = 2 * MiB, WS_ROPES = 3 * MiB, WS_H2 = 4 * MiB, WS_KFC = 10 * MiB, WS_BLKCNT = 12 * MiB, WS_TILEE = 13 * MiB, WS_SCANS = 14 * MiB;
constexpr size_t WS_WINT = 16 * MiB, WS_WOUTT = 24 * MiB, WS_W1T = 32 * MiB, WS_W2T = 288 * MiB, WS_KF = 416 * MiB, WS_KHAT = 448 * MiB, WS_XR = 512 * MiB, WS_H = 644 * MiB;
constexpr size_t WS_U = 712 * MiB, WS_Q = 844 * MiB, WS_K = 877 * MiB, WS_V = 886 * MiB, WS_ATT = 895 * MiB, WS_LAB = 928 * MiB, WS_LRUO = 1060 * MiB, WS_VT = 1093 * MiB, WS_X0T = 1125 * MiB,
                 WS_HYO = 1157 * MiB, WS_MIXA = 1190 * MiB;
constexpr size_t WS_WGT = 11 * MiB, WS_SPT = 10 * MiB + 768 * 1024, WS_XL = 1256 * MiB;
constexpr size_t WS_GC = 10 * MiB + 896 * 1024;
constexpr size_t WS_CB = 10 * MiB + 960 * 1024;
constexpr size_t WS_F = 712 * MiB, WS_ASORT = 778 * MiB, WS_ACT = 1058 * MiB, WS_YS = 1338 * MiB, WS_TOPI = 1618 * MiB, WS_GATE = 1619 * MiB, WS_POS = 1620 * MiB, WS_RSSP = 1622 * MiB, WS_ROWTOK = 1625 * MiB, WS_END = 1626 * MiB;
constexpr size_t LAB_STRIDE = (size_t)MT * 256;
constexpr int CW_BAR = 4096;
constexpr int CW_NTILES = 64;

constexpr int RING_OFF = 0, RING_BYTES = 131072, MOETAB_OFF = 131072, LDSCTL_OFF = 155648, LDS_BYTES = 156160;

#define GAS __attribute__((address_space(1)))
#define LAS __attribute__((address_space(3)))
typedef unsigned short bf16;
typedef unsigned v4u __attribute__((ext_vector_type(4)));
typedef unsigned v2u __attribute__((ext_vector_type(2)));
typedef float f32x4 __attribute__((ext_vector_type(4)));
#define LDS_WAIT() asm volatile("s_waitcnt lgkmcnt(0)" ::: "memory")
#define VM_WAIT() asm volatile("s_waitcnt vmcnt(0)" ::: "memory")
__device__ __forceinline__ unsigned f2bf(float f) { unsigned u = __builtin_bit_cast(unsigned, f); return (u + 0x7fffu + ((u >> 16) & 1u)) >> 16; }
__device__ __forceinline__ unsigned pk2(float lo, float hi) { return f2bf(lo) | (f2bf(hi) << 16); }
__device__ __forceinline__ float bf2f(unsigned short b) { return __builtin_bit_cast(float, (unsigned)b << 16); }
__device__ __forceinline__ float bflo(unsigned w) { return __builtin_bit_cast(float, w << 16); }
__device__ __forceinline__ float bfhi(unsigned w) { return __builtin_bit_cast(float, w & 0xffff0000u); }
__device__ __forceinline__ float wave_sum(float v) {
#pragma unroll
    for (int o = 1; o < 64; o <<= 1) v += __shfl_xor(v, o);
    return v;
}
__device__ __forceinline__ float sigmoidf_(float x) { return 1.0f / (1.0f + __expf(-x)); }
__device__ __forceinline__ void sincos_d(double x, double& s, double& c) {
    const double kd = __builtin_rint(x * 0.63661977236758134308);
    const int k = (int)kd;
    double r = __builtin_fma(-kd, 1.57079632673412561417e+00, x);
    r = __builtin_fma(-kd, 6.07710050650619224932e-11, r);
    const double z = r * r;
    const double ps = r + r * z * (-1.66666666666666324348e-01 + z * (8.33333333332248946124e-03 + z * (-1.98412698298579493134e-04 + z * (2.75573137070700676789e-06 + z * (-2.50507602534068634195e-08 + z * 1.58969099521155010221e-10)))));
    const double pc = 1.0 - 0.5 * z + z * z * (4.16666666666666019037e-02 + z * (-1.38888888888741095749e-03 + z * (2.48015872894767294178e-05 + z * (-2.75573143513906633035e-07 + z * (2.08757232129817482790e-09 + z * -1.13596475577881948265e-11)))));
    const int q = k & 3;
    s = (q == 0) ? ps : (q == 1) ? pc : (q == 2) ? -ps : -pc;
    c = (q == 0) ? pc : (q == 1) ? -ps : (q == 2) ? -pc : ps;
}
__device__ __forceinline__ float gelu_tanh(float x) {
    const float u = 0.7978845608028654f * (x + 0.044715f * x * x * x);
    const float t = 1.0f - 2.0f / (1.0f + __expf(2.0f * u));
    return 0.5f * x * (1.0f + t);
}
__device__ __forceinline__ int lds_add(LAS int* p, int v) { return __hip_atomic_fetch_add(p, v, __ATOMIC_RELAXED, __HIP_MEMORY_SCOPE_WORKGROUP); }

#define FFT_FN __device__ __forceinline__
typedef float f32x2v __attribute__((ext_vector_type(2)));
#define FFT_VEC2 f32x2v
#define FFT_DPTR LAS f32x2v*
#define FFT_LD(D, i) c32_from((D)[i])
#define FFT_ST(D, i, v) ((D)[i] = c32_to(v))
struct __attribute__((aligned(8))) c32 { float x, y; };
FFT_FN c32 cmul(c32 a, c32 b) { c32 r; r.x = a.x * b.x - a.y * b.y; r.y = a.x * b.y + a.y * b.x; return r; }
FFT_FN c32 cadd(c32 a, c32 b) { c32 r; r.x = a.x + b.x; r.y = a.y + b.y; return r; }
FFT_FN c32 csub(c32 a, c32 b) { c32 r; r.x = a.x - b.x; r.y = a.y - b.y; return r; }
FFT_FN c32 cmuli_neg(c32 a) { c32 r; r.x = a.y; r.y = -a.x; return r; }
FFT_FN int fpad(int a) { return a + (a >> 4); }
#ifdef FFT_VEC2
FFT_FN c32 c32_from(FFT_VEC2 t) { c32 r; r.x = t.x; r.y = t.y; return r; }
FFT_FN FFT_VEC2 c32_to(c32 a) { FFT_VEC2 t; t.x = a.x; t.y = a.y; return t; }
#endif
FFT_FN void dft4(c32& a0, c32& a1, c32& a2, c32& a3) {
    const c32 s02 = cadd(a0, a2), d02 = csub(a0, a2), s13 = cadd(a1, a3), d13 = cmuli_neg(csub(a1, a3));
    a0 = cadd(s02, s13); a2 = csub(s02, s13); a1 = cadd(d02, d13); a3 = csub(d02, d13);
}
FFT_FN void dft16(c32 (&v)[16]) {
    const float C1 = 0.92387953251128674f, S1 = 0.38268343236508977f, C2 = 0.70710678118654752f;
#pragma unroll
    for (int q2 = 0; q2 < 4; ++q2) dft4(v[q2], v[4 + q2], v[8 + q2], v[12 + q2]);
    { c32 w;
      w.x = C1; w.y = -S1; v[4 * 1 + 1] = cmul(v[4 * 1 + 1], w);
      w.x = C2; w.y = -C2; v[4 * 2 + 1] = cmul(v[4 * 2 + 1], w);
      w.x = S1; w.y = -C1; v[4 * 3 + 1] = cmul(v[4 * 3 + 1], w);
      w.x = C2; w.y = -C2; v[4 * 1 + 2] = cmul(v[4 * 1 + 2], w);
      v[4 * 2 + 2] = cmuli_neg(v[4 * 2 + 2]);
      w.x = -C2; w.y = -C2; v[4 * 3 + 2] = cmul(v[4 * 3 + 2], w);
      w.x = S1; w.y = -C1; v[4 * 1 + 3] = cmul(v[4 * 1 + 3], w);
      w.x = -C2; w.y = -C2; v[4 * 2 + 3] = cmul(v[4 * 2 + 3], w);
      w.x = -C1; w.y = S1; v[4 * 3 + 3] = cmul(v[4 * 3 + 3], w); }
#pragma unroll
    for (int p1 = 0; p1 < 4; ++p1) dft4(v[4 * p1 + 0], v[4 * p1 + 1], v[4 * p1 + 2], v[4 * p1 + 3]);
#pragma unroll
    for (int a = 0; a < 4; ++a)
#pragma unroll
        for (int b = a + 1; b < 4; ++b) { const c32 t = v[4 * a + b]; v[4 * a + b] = v[4 * b + a]; v[4 * b + a] = t; }
}
FFT_FN c32 twid(int j, int n) { float rev = (float)j / (float)n; asm volatile("" : "+v"(rev)); c32 w; w.x = __builtin_amdgcn_cosf(rev); w.y = -__builtin_amdgcn_sinf(rev); return w; }

FFT_FN void fft_fwd16(FFT_DPTR D, int g, int n) {
    const int s = n >> 4, blk = g / s, j = g - blk * s, base = blk * n + j;
    c32 v[16];
#pragma unroll
    for (int q = 0; q < 16; ++q) v[q] = FFT_LD(D, fpad(base + q * s));
    dft16(v);
    const c32 w = twid(j, n); c32 wp = w;
#pragma unroll
    for (int p = 1; p < 16; ++p) { v[p] = cmul(v[p], wp); wp = cmul(wp, w); }
#pragma unroll
    for (int p = 0; p < 16; ++p) FFT_ST(D, fpad(base + p * s), v[p]);
}
FFT_FN void fft_inv16(FFT_DPTR D, int g, int n) {
    const int s = n >> 4, blk = g / s, j = g - blk * s, base = blk * n + j;
    c32 v[16];
#pragma unroll
    for (int q = 0; q < 16; ++q) v[q] = FFT_LD(D, fpad(base + q * s));
    const c32 w = twid(j, n); c32 wp = w;
#pragma unroll
    for (int p = 1; p < 16; ++p) { v[p] = cmul(v[p], wp); wp = cmul(wp, w); }
    dft16(v);
#pragma unroll
    for (int p = 0; p < 16; ++p) FFT_ST(D, fpad(base + p * s), v[p]);
}
FFT_FN void fft_mid16(FFT_DPTR D, int g, const c32* KH) {
    c32 v[16];
#pragma unroll
    for (int q = 0; q < 16; ++q) v[q] = FFT_LD(D, 17 * g + q);
    dft16(v);
#pragma unroll
    for (int p = 0; p < 16; ++p) { const c32 k = KH[16 * g + p]; const c32 t = cmul(v[p], k); v[p].x = t.x; v[p].y = -t.y; }
    dft16(v);
#pragma unroll
    for (int p = 0; p < 16; ++p) FFT_ST(D, 17 * g + p, v[p]);
}
FFT_FN void fft_last16_out(FFT_DPTR D, int g, c32* OUT, float scale) {
    c32 v[16];
#pragma unroll
    for (int q = 0; q < 16; ++q) v[q] = FFT_LD(D, 17 * g + q);
    dft16(v);
#pragma unroll
    for (int p = 0; p < 16; ++p) { c32 t; t.x = v[p].x * scale; t.y = v[p].y * scale; OUT[16 * g + p] = t; }
}
FFT_FN void fft_first4(FFT_DPTR D, int j, c32 x0, c32 x1, c32 x2, c32 x3) {
    dft4(x0, x1, x2, x3);
    const c32 w = twid(j, 16384), w2 = cmul(w, w), w3 = cmul(w2, w);
    FFT_ST(D, fpad(j), x0); FFT_ST(D, fpad(j + 4096), cmul(x1, w)); FFT_ST(D, fpad(j + 8192), cmul(x2, w2)); FFT_ST(D, fpad(j + 12288), cmul(x3, w3));
}
FFT_FN void fft_final4(FFT_DPTR D, int j, c32& u0, c32& u1) {
    const c32 w = twid(j, 16384), w2 = cmul(w, w), w3 = cmul(w2, w);
    c32 a0 = FFT_LD(D, fpad(j)), a1 = cmul(FFT_LD(D, fpad(j + 4096)), w), a2 = cmul(FFT_LD(D, fpad(j + 8192)), w2), a3 = cmul(FFT_LD(D, fpad(j + 12288)), w3);
    dft4(a0, a1, a2, a3);
    u0 = a0; u1 = a1;
}
FFT_FN void fft_first4_inplace(FFT_DPTR D, int j) {
    c32 x0 = FFT_LD(D, fpad(j)), x1 = FFT_LD(D, fpad(j + 4096)), x2 = FFT_LD(D, fpad(j + 8192)), x3 = FFT_LD(D, fpad(j + 12288));
    fft_first4(D, j, x0, x1, x2, x3);
}
#define XB_TMO      128
#define XB_XCNT(j)  (256  + 64 * (j))
#define XB_XSUB(j)  (1280 + 64 * (j))
#define XB_XGEN(j)  (2304 + 64 * (j))
#define XB_TOP      3328
#define XB_TOPGEN   3392
#define XCD_BAR_WORDS 3456
#define XB_SPIN_CAP (1u << 22)

__device__ __forceinline__ unsigned xb_ld(unsigned* p)              { return __hip_atomic_load(p, __ATOMIC_RELAXED, __HIP_MEMORY_SCOPE_AGENT); }
__device__ __forceinline__ unsigned xb_add(unsigned* p, unsigned v) { return __hip_atomic_fetch_add(p, v, __ATOMIC_RELAXED, __HIP_MEMORY_SCOPE_AGENT); }
__device__ __forceinline__ unsigned xb_xcc_id() { return (unsigned)__builtin_amdgcn_s_getreg((3 << 11) | 20) & 0xFu; }
#define XB_SPIN(cond, bar) do { unsigned _sp = 0; while (cond) { __builtin_amdgcn_s_sleep(1); \
    if ((++_sp & 255u) == 0u) { if (xb_ld(&(bar)[XB_TMO])) break; if (_sp > XB_SPIN_CAP) { atomicAdd(&(bar)[XB_TMO], 1u); break; } } } } while (0)

struct XcdBarrier {
    unsigned* bar; unsigned x;
    volatile LAS unsigned* st;
};

__device__ __forceinline__ XcdBarrier xcd_barrier_post(unsigned* bar, volatile LAS unsigned* st) {
    XcdBarrier b; b.bar = bar; b.x = xb_xcc_id(); b.st = st;
    if (threadIdx.x == 0) (void)xb_add(&bar[XB_XCNT(b.x)], 1u);
    return b;
}
__device__ __forceinline__ void xcd_barrier_complete(unsigned* bar, unsigned x, unsigned& nloc, unsigned& nx) {
    const unsigned G = gridDim.x * gridDim.y * gridDim.z;
    unsigned sum, cnt, mine, sp = 0u;
    for (;;) {
        sum = 0u; cnt = 0u; mine = 0u;
#pragma unroll
        for (unsigned j = 0; j < 16; ++j) { const unsigned c = xb_ld(&bar[XB_XCNT(j)]); sum += c; cnt += (c > 0u) ? 1u : 0u; mine = (j == x) ? c : mine; }
        if (sum == G) break;
        __builtin_amdgcn_s_sleep(1);
        if ((++sp & 255u) == 0u) { if (xb_ld(&bar[XB_TMO])) break; if (sp > XB_SPIN_CAP) { atomicAdd(&bar[XB_TMO], 1u); break; } }
    }
    nloc = mine > 0u ? mine : 1u; nx = cnt > 0u ? cnt : 1u;
}

__device__ __forceinline__ void xcd_barrier(const XcdBarrier& b) {
    asm volatile("s_waitcnt vmcnt(0)" ::: "memory");
    __syncthreads();
    if (threadIdx.x == 0) {
        unsigned* bar = b.bar;
        __builtin_amdgcn_s_waitcnt(0);
        unsigned nloc = b.st[0], nx = b.st[1];
        if (nloc == 0u) { xcd_barrier_complete(bar, b.x, nloc, nx); b.st[0] = nloc; b.st[1] = nx; }
        const unsigned old = xb_add(&bar[XB_XSUB(b.x)], 1u);
        const unsigned gen = old / nloc;
        if (old + 1u == (gen + 1u) * nloc) {
            __builtin_amdgcn_fence(__ATOMIC_RELEASE, "agent");
            asm volatile("s_waitcnt vmcnt(0)" ::: "memory");
            const unsigned og = xb_add(&bar[XB_TOP], 1u);
            const unsigned tg = og / nx;
            if (og + 1u == (tg + 1u) * nx) xb_add(&bar[XB_TOPGEN], 1u);
            else XB_SPIN(xb_ld(&bar[XB_TOPGEN]) == tg, bar);
            __builtin_amdgcn_fence(__ATOMIC_ACQUIRE, "agent");
            xb_add(&bar[XB_XGEN(b.x)], 1u);
            asm volatile("s_waitcnt vmcnt(0)" ::: "memory");
        } else {
            XB_SPIN(xb_ld(&bar[XB_XGEN(b.x)]) == gen, bar);
            __builtin_amdgcn_fence(__ATOMIC_ACQUIRE, "agent");
            asm volatile("s_waitcnt vmcnt(0)" ::: "memory");
        }
    }
    __syncthreads();
}


struct Frame {
    LAS unsigned char* lds; unsigned* ctl; unsigned char* ws;
    int tid, lane, wave, vcu, G, gw, ngw;
};
__device__ const float ROPE_INV[16] = {1.0f, 0.5623413251903491f, 0.31622776601683794f, 0.1778279410038923f, 0.1f, 0.05623413251903491f, 0.03162277660168379f, 0.01778279410038923f,
                                       0.01f, 0.005623413251903491f, 0.0031622776601683794f, 0.001778279410038923f, 0.001f, 0.0005623413251903491f, 0.00031622776601683794f, 0.0001778279410038923f};

__device__ __forceinline__ void p0_transpose_item(const float* W, int K, int N, bf16* WT, LAS float* scr, int item, int lane) {
    const int nblk = N / 32, kb = item / nblk, nb = item % nblk, k0 = 64 * kb, n0 = 32 * nb;
#pragma unroll 8
    for (int i = 0; i < 32; ++i) { const int kk = 2 * i + (lane >> 5); scr[kk * 33 + (lane & 31)] = W[(size_t)(k0 + kk) * N + n0 + (lane & 31)]; }
    LDS_WAIT(); asm volatile("" ::: "memory");
    const int c = lane & 7;
#pragma unroll
    for (int j = 0; j < 4; ++j) { const int n = (lane >> 3) + 8 * j; const LAS float* s = scr + (8 * c) * 33 + n;
        v4u o; o.x = pk2(s[0 * 33], s[1 * 33]); o.y = pk2(s[2 * 33], s[3 * 33]); o.z = pk2(s[4 * 33], s[5 * 33]); o.w = pk2(s[6 * 33], s[7 * 33]);
        *(GAS v4u*)(WT + (size_t)(n0 + n) * K + k0 + 8 * c) = o; }
    LDS_WAIT(); asm volatile("" ::: "memory");
}

__device__ __forceinline__ void p0_transpose_item_f8(const float* W, int K, int N, unsigned char* WT, LAS float* scr, int item, int lane) {
    const int nblk = N / 32, kb = item / nblk, nb = item % nblk, k0 = 64 * kb, n0 = 32 * nb;
#pragma unroll 8
    for (int i = 0; i < 32; ++i) { const int kk = 2 * i + (lane >> 5); scr[kk * 33 + (lane & 31)] = W[(size_t)(k0 + kk) * N + n0 + (lane & 31)]; }
    LDS_WAIT(); asm volatile("" ::: "memory");
    const int c = lane & 7;
#pragma unroll
    for (int j = 0; j < 4; ++j) { const int n = (lane >> 3) + 8 * j; const LAS float* s = scr + (8 * c) * 33 + n;
        v2u o; o.x = pg8::pack4_fp8(s[0 * 33] * pg8::F8_SW, s[1 * 33] * pg8::F8_SW, s[2 * 33] * pg8::F8_SW, s[3 * 33] * pg8::F8_SW);
        o.y = pg8::pack4_fp8(s[4 * 33] * pg8::F8_SW, s[5 * 33] * pg8::F8_SW, s[6 * 33] * pg8::F8_SW, s[7 * 33] * pg8::F8_SW);
        *(GAS v2u*)(WT + (size_t)(n0 + n) * K + k0 + 8 * c) = o; }
    LDS_WAIT(); asm volatile("" ::: "memory");
}

__device__ __forceinline__ void ph_prologue_a(const Frame& F, const float* c, const float* cctx, const float* w_mod, const float* b_mod, const float* w_in, const float* w_out,
                                              const float* moe_w1, const float* moe_w2, const float* hy_w1, const float* hy_b1, const float* hy_w2, const float* hy_b2, const float* hy_freq, const float* lru_gw, const float* lru_lam) {
    {
        LAS float* scr = (LAS float*)(F.lds + F.wave * 16384);
        constexpr int I_IN = 2 * 1024, I_OUT = 2 * 512, I_W1 = 64 * 1024, I_W2 = 64 * 512, NIT = I_IN + I_OUT + I_W1 + I_W2;
        bf16* WinT = (bf16*)(F.ws + WS_WINT); bf16* WoutT = (bf16*)(F.ws + WS_WOUTT); bf16* W1T = (bf16*)(F.ws + WS_W1T); bf16* W2T = (bf16*)(F.ws + WS_W2T);
        for (int it = F.gw; it < NIT; it += F.ngw) {
            int r = it;
            if (r < I_IN) { const int m = r >> 10; p0_transpose_item(w_in + (size_t)m * 1024 * 2048, 1024, 2048, WinT + (size_t)m * 2048 * 1024, scr, r & 1023, F.lane); continue; } r -= I_IN;
            if (r < I_OUT) { const int m = r >> 9; p0_transpose_item(w_out + (size_t)m * 1024 * 1024, 1024, 1024, WoutT + (size_t)m * 1024 * 1024, scr, r & 511, F.lane); continue; } r -= I_OUT;
#if MOE_FP8
            if (r < I_W1) { const int m = r >> 10; p0_transpose_item_f8(moe_w1 + (size_t)m * 1024 * 2048, 1024, 2048, (unsigned char*)W1T + (size_t)m * 2048 * 1024, scr, r & 1023, F.lane); continue; } r -= I_W1;
            { const int m = r >> 9; p0_transpose_item_f8(moe_w2 + (size_t)m * 1024 * 1024, 1024, 1024, (unsigned char*)W2T + (size_t)m * 1024 * 1024, scr, r & 511, F.lane); }
#else
            if (r < I_W1) { const int m = r >> 10; p0_transpose_item(moe_w1 + (size_t)m * 1024 * 2048, 1024, 2048, W1T + (size_t)m * 2048 * 1024, scr, r & 1023, F.lane); continue; } r -= I_W1;
            { const int m = r >> 9; p0_transpose_item(moe_w2 + (size_t)m * 1024 * 1024, 1024, 1024, W2T + (size_t)m * 1024 * 1024, scr, r & 511, F.lane); }
#endif
        }
    }
    __syncthreads();
    {
        LAS float* sl = (LAS float*)(F.lds);
        LAS float* red = (LAS float*)(F.lds + 20480);
        float* MOD = (float*)(F.ws + WS_MOD);
        if ((int)blockIdx.x < 192) {
            for (int i = F.tid; i < 5 * 1024; i += NTHR) { const int r = i >> 10, k = i & 1023; const float v = (r < 4) ? c[r * 1024 + k] : cctx[k]; sl[i] = v / (1.0f + __expf(-v)); }
        }
        __syncthreads();
        for (int it = blockIdx.x; it < 192; it += F.G) {
            const int l = it / 96, n = (it % 96) * 64 + F.lane;
            float a0 = 0.f, a1 = 0.f, a2 = 0.f, a3 = 0.f, a4 = 0.f;
            const float* wp = w_mod + ((size_t)l * 1024 + F.wave * 128) * 6144 + n;
#pragma unroll 8
            for (int k = 0; k < 128; ++k) { const float w = wp[(size_t)k * 6144]; const int kk = F.wave * 128 + k;
                a0 += sl[kk] * w; a1 += sl[1024 + kk] * w; a2 += sl[2048 + kk] * w; a3 += sl[3072 + kk] * w; a4 += sl[4096 + kk] * w; }
            red[(F.wave * 5 + 0) * 64 + F.lane] = a0; red[(F.wave * 5 + 1) * 64 + F.lane] = a1; red[(F.wave * 5 + 2) * 64 + F.lane] = a2; red[(F.wave * 5 + 3) * 64 + F.lane] = a3; red[(F.wave * 5 + 4) * 64 + F.lane] = a4;
            __syncthreads();
            if (F.tid < 320) { const int r = F.tid >> 6, ln = F.tid & 63; float s = 0.f;
#pragma unroll
                for (int w = 0; w < 8; ++w) s += red[(w * 5 + r) * 64 + ln];
                const int nn = (it % 96) * 64 + ln; MOD[(size_t)(l * 5 + r) * 6144 + nn] = s + b_mod[l * 6144 + nn]; }
            __syncthreads();
        }
    }
    {
        bf16* WGT = (bf16*)(F.ws + WS_WGT); float* SPT = (float*)(F.ws + WS_SPT);
        for (int idx = blockIdx.x * NTHR + F.tid; idx < 2 * 1024 * 256; idx += F.G * NTHR) {
            const int l = idx >> 18, nidx = (idx >> 8) & 1023, k = idx & 255;
            const int pn = nidx >> 8, j = (nidx >> 7) & 1, cc = nidx & 127, d = pn >> 1, ch = 128 * (pn & 1) + cc, n = ch >> 6, e = ch & 63;
            const float v = ((k >> 6) == n) ? lru_gw[((size_t)((((l * 2 + d) * 2 + j) * 4 + n) * 64 + (k & 63))) * 64 + e] : 0.f;
            WGT[idx] = (bf16)f2bf(v); }
        for (int idx = blockIdx.x * NTHR + F.tid; idx < 2 * 2 * 256; idx += F.G * NTHR) SPT[idx] = log1pf(expf(-lru_lam[idx]));
    }
    {
        float* RC = (float*)(F.ws + WS_ROPEC); float* RS = (float*)(F.ws + WS_ROPES);
        for (int idx = blockIdx.x * NTHR + F.tid; idx < SEQ * 32; idx += F.G * NTHR) {
            const int t = idx >> 5, i = idx & 31; const int pos = (i < 16) ? (t >> 6) : (t & 63);
            const float ang = (float)pos * ROPE_INV[i & 15];
            double s, cc; sincos_d((double)ang, s, cc); RC[idx] = (float)cc; RS[idx] = (float)s; }
    }
    {
        float* H2 = (float*)(F.ws + WS_H2);
        for (int it = F.gw; it < 2 * SEQ + CTXL; it += F.ngw) {
            const int v = it >> 13, t = (v < 2) ? (it & (SEQ - 1)) : (it - 2 * SEQ), L = (v < 2) ? SEQ : CTXL, l = (v == 1) ? 1 : 0;
            const int j = F.lane;
            float z = 0.f;
            if (j == 0) z = (float)t / (float)(L - 1);
            else if (j <= 32) { const int b = (j - 1) & 15; const float band = 1e-4f + (float)b * ((15.0f - 1e-4f) / 15.0f);
                const float ang = ((6.283185307179586f / (float)L) * (float)t) * band;
                double s, cc; sincos_d((double)ang, s, cc); z = (j <= 16) ? (float)cc : -(float)s; }
            const float fr = hy_freq[l * 64 + j];
            float p1 = hy_b1[l * 64 + j];
            const float* w1 = hy_w1 + (size_t)l * 33 * 64;
#pragma unroll
            for (int i = 0; i < 33; ++i) p1 += __shfl(z, i) * w1[i * 64 + j];
            double s1, c1; sincos_d((double)(fr * p1), s1, c1); const float h1 = (float)s1;
            float p2 = hy_b2[l * 64 + j];
            const float* w2 = hy_w2 + (size_t)l * 64 * 64;
#pragma unroll 16
            for (int i = 0; i < 64; ++i) p2 += __shfl(h1, i) * w2[i * 64 + j];
            double s2, c2; sincos_d((double)(fr * p2), s2, c2);
            H2[((size_t)v * SEQ + t) * 64 + j] = (float)s2;
        }
    }
}

__device__ __forceinline__ void ph_prologue_b(const Frame& F, const float* hy_w3, const float* hy_decay, const float* gffn, const float* router_w, const float* router_b) {
    { const float* MOD = (const float*)(F.ws + WS_MOD); float* CB = (float*)(F.ws + WS_CB);
      for (int it = F.gw; it < 2 * 5 * 32; it += F.ngw) { const int lb = it >> 5, e = it & 31, l = lb / 5; const float* sf = MOD + (size_t)lb * 6144 + 3 * 1024; float s = 0.f;
#pragma unroll
          for (int q = 0; q < 16; ++q) { const int cc = 64 * q + F.lane; s += sf[cc] * router_w[(size_t)l * 32768 + cc * 32 + e]; }
          s = wave_sum(s); if (F.lane == 0) CB[it] = s + router_b[l * 32 + e]; } }
    { const float* MOD = (const float*)(F.ws + WS_MOD); float* GC = (float*)(F.ws + WS_GC);
      for (int idx = blockIdx.x * NTHR + F.tid; idx < 2 * 5 * 1024; idx += F.G * NTHR) { const int lb = idx >> 10, cc = idx & 1023, l = lb / 5; GC[idx] = gffn[l * 1024 + cc] * (1.0f + MOD[(size_t)lb * 6144 + 4 * 1024 + cc]); } }
    LAS f32x2v* D = (LAS f32x2v*)(F.lds);
    LAS float* kt = (LAS float*)(F.lds);
    LAS float* w3c = (LAS float*)(F.lds + 139264);
    LAS float* red = (LAS float*)(F.lds + 139264 + 512);
    const float* H2 = (const float*)(F.ws + WS_H2);
    c32* KHAT = (c32*)(F.ws + WS_KHAT); float* KFC = (float*)(F.ws + WS_KFC);
    for (int it = blockIdx.x; it < 768; it += F.G) {
        const int v = it >> 8, c = it & 255, L = (v < 2) ? SEQ : CTXL, l = (v == 1) ? 1 : 0;
        if (F.tid < 128) w3c[F.tid] = hy_w3[(size_t)l * 64 * 512 + (F.tid & 63) * 512 + (F.tid >> 6) * 256 + c];
        if (F.tid == 0) { if (v < 2) { f32x2v z; z.x = 0.f; z.y = 0.f; D[fpad(L)] = z; } else kt[L] = 0.f; }
        __syncthreads();
        const float df = fabsf(hy_decay[l * 512 + c]), db = fabsf(hy_decay[l * 512 + 256 + c]);
        float asum = 0.f;
        for (int t = F.tid; t < L; t += NTHR) {
            const f32x4* row = (const f32x4*)(H2 + ((size_t)v * SEQ + t) * 64);
            float hf = 0.f, hb = 0.f;
#pragma unroll
            for (int q = 0; q < 16; ++q) { const f32x4 h = row[q];
                hf += h.x * w3c[4 * q] + h.y * w3c[4 * q + 1] + h.z * w3c[4 * q + 2] + h.w * w3c[4 * q + 3];
                hb += h.x * w3c[64 + 4 * q] + h.y * w3c[64 + 4 * q + 1] + h.z * w3c[64 + 4 * q + 2] + h.w * w3c[64 + 4 * q + 3]; }
            const float t01 = (float)t / (float)(L - 1);
            hf *= expf(-t01 * df); hb *= expf(-t01 * db);
            asum += fabsf(hf); if (t >= 1) asum += fabsf(hb);
            if (v < 2) { f32x2v z; z.x = hf; z.y = 0.f; D[fpad(t)] = z; if (t >= 1) { z.x = hb; D[fpad(2 * L - t)] = z; } }
            else { kt[t] = hf; if (t >= 1) kt[2 * L - t] = hb; }
        }
        asum = wave_sum(asum);
        if (F.lane == 0) red[F.wave] = asum;
        __syncthreads();
        float tot = 0.f;
#pragma unroll
        for (int w = 0; w < 8; ++w) tot += red[w];
        const float inv = 1.0f / tot;
        if (v < 2) {
            c32* out = KHAT + (size_t)(v * 256 + c) * 16384;
#pragma unroll 1
            for (int i = 0; i < 8; ++i) fft_first4_inplace(D, F.tid + 512 * i);
            __syncthreads();
            { fft_fwd16(D, F.tid, 4096); fft_fwd16(D, F.tid + 512, 4096); }
            __syncthreads();
            { fft_fwd16(D, F.tid, 256); fft_fwd16(D, F.tid + 512, 256); }
            __syncthreads();
            _Pragma("unroll 1") for (int g_ = F.tid; g_ < 1024; g_ += 512) fft_last16_out(D, g_, out, inv * (1.0f / 16384.0f));
        } else {
            float* dst = KFC + (size_t)c * 512;
            for (int j = F.tid; j < 2 * L; j += NTHR) dst[j] = kt[j] * inv;
        }
        __syncthreads();
    }
}

__device__ __forceinline__ void ph_norm_mod(const Frame& F, int l, const float* x, const float* ctx, const float* gmix) {
    const float* XR = (const float*)(F.ws + WS_XR); const float* MOD = (const float*)(F.ws + WS_MOD); bf16* H = (bf16*)(F.ws + WS_H);
    for (int r = F.gw; r < MT; r += F.ngw) {
        const float* src = (l == 0) ? (r < NLAT ? x + (size_t)r * 1024 : ctx + (size_t)(r - NLAT) * 1024) : XR + (size_t)r * 1024;
        const int bidx = r < NLAT ? r / SEQ : 4;
        const float* shift = MOD + (size_t)(l * 5 + bidx) * 6144; const float* scale = shift + 1024; const float* g = gmix + l * 1024;
        f32x4 v[4]; float ss = 0.f;
#pragma unroll
        for (int j = 0; j < 4; ++j) { v[j] = ((const f32x4*)src)[64 * j + F.lane]; ss += (v[j].x * v[j].x + v[j].y * v[j].y) + (v[j].z * v[j].z + v[j].w * v[j].w); }
        const float rstd = 1.0f / sqrtf(wave_sum(ss) * (1.0f / 1024.0f) + EPSN);
#pragma unroll
        for (int j = 0; j < 4; ++j) { const int cb = 64 * j + F.lane; const f32x4 gg = ((const f32x4*)g)[cb], sc = ((const f32x4*)scale)[cb], sh = ((const f32x4*)shift)[cb];
            const f32x4 y = v[j] * rstd * gg * (sc + 1.0f) + sh;
            v2u o; o.x = pk2(y.x, y.y); o.y = pk2(y.z, y.w); ((v2u*)(H + (size_t)r * 1024))[cb] = o; }
    }
}

__device__ __forceinline__ void ph_post_proj(const Frame& F, int l, const float* qg_, const float* kg_, const float* lru_cw, const float* lru_cb, const float* hy_cw, const float* hy_cb) {
    const bf16* U = (const bf16*)(F.ws + WS_U);
    {
        bf16* K = (bf16*)(F.ws + WS_K); bf16* V = (bf16*)(F.ws + WS_V);
        const float* RC = (const float*)(F.ws + WS_ROPEC); const float* RS = (const float*)(F.ws + WS_ROPES);
        const int o8 = 8 * (F.lane & 7), hl = F.lane & 31;
        const f32x4 kg0 = *(const f32x4*)(kg_ + l * 64 + o8), kg1 = *(const f32x4*)(kg_ + l * 64 + o8 + 4);
        const bool lohalf = (F.lane & 4) == 0;
        for (int r2 = 2 * F.gw; r2 < MT; r2 += 2 * F.ngw) {
            const int r = r2 + (F.lane >> 5);
            const bool isctx = r >= NLAT; const int b = isctx ? (r - NLAT) / CTXL : r / SEQ; const int t = isctx ? (r - NLAT) % CTXL : r % SEQ;
            const v4u wk = ((const v4u*)(U + (size_t)r * INW + 512))[hl];
            f32x4 c0 = {1.f, 1.f, 1.f, 1.f}, c1 = c0, s0 = {0.f, 0.f, 0.f, 0.f}, s1 = s0;
            if (!isctx) { const float* rc = RC + t * 32 + 8 * (F.lane & 3); const float* rs = RS + t * 32 + 8 * (F.lane & 3);
                c0 = *(const f32x4*)rc; c1 = *(const f32x4*)(rc + 4); s0 = *(const f32x4*)rs; s1 = *(const f32x4*)(rs + 4); }
            const size_t krow = (size_t)b * KEYS + (isctx ? t : CTXL + t);
            float x[8] = {bflo(wk.x), bfhi(wk.x), bflo(wk.y), bfhi(wk.y), bflo(wk.z), bfhi(wk.z), bflo(wk.w), bfhi(wk.w)};
            float ss = 0.f;
#pragma unroll
            for (int i = 0; i < 8; ++i) ss += x[i] * x[i];
            ss += __shfl_xor(ss, 1); ss += __shfl_xor(ss, 2); ss += __shfl_xor(ss, 4);
            const float rstd = 1.0f / sqrtf(ss * (1.0f / 64.0f) + EPSN);
            float y[8], o[8];
#pragma unroll
            for (int i = 0; i < 8; ++i) y[i] = x[i] * rstd * (i < 4 ? kg0[i] : kg1[i - 4]);
#pragma unroll
            for (int i = 0; i < 8; ++i) { const float p = __shfl_xor(y[i], 4); const float cs = i < 4 ? c0[i] : c1[i - 4], sn = i < 4 ? s0[i] : s1[i - 4];
                o[i] = lohalf ? (y[i] * cs - p * sn) : (y[i] * cs + p * sn); }
            v4u ow; ow.x = pk2(o[0], o[1]); ow.y = pk2(o[2], o[3]); ow.z = pk2(o[4], o[5]); ow.w = pk2(o[6], o[7]);
            if (hl < 16) ((v4u*)(K + krow * 128))[hl] = ow; else ((v4u*)(V + krow * 128))[hl - 16] = wk;
        }
    }
    {
        bf16* XL = (bf16*)(F.ws + WS_XL);
        for (int idx = blockIdx.x * NTHR + F.tid; idx < MT * 32; idx += F.G * NTHR) {
            const int r = idx >> 5, c8 = (idx & 31) * 8;
            const bool isctx = r >= NLAT; const int Ls = isctx ? CTXL : SEQ; const int t = isctx ? (r - NLAT) % CTXL : r % SEQ;
            float acc[8];
#pragma unroll
            for (int i = 0; i < 8; ++i) acc[i] = lru_cb[l * 256 + c8 + i];
#pragma unroll
            for (int j = 0; j < 4; ++j) { const int tj = t + j - 2;
                if (tj >= 0 && tj < Ls) { const v4u w = *(const v4u*)(U + (size_t)(r + j - 2) * INW + 768 + c8);
                    const f32x4 w0 = *(const f32x4*)(lru_cw + (l * 4 + j) * 256 + c8), w1 = *(const f32x4*)(lru_cw + (l * 4 + j) * 256 + c8 + 4);
                    acc[0] += w0.x * bflo(w.x); acc[1] += w0.y * bfhi(w.x); acc[2] += w0.z * bflo(w.y); acc[3] += w0.w * bfhi(w.y);
                    acc[4] += w1.x * bflo(w.z); acc[5] += w1.y * bfhi(w.z); acc[6] += w1.z * bflo(w.w); acc[7] += w1.w * bfhi(w.w); } }
            v4u o; o.x = pk2(acc[0], acc[1]); o.y = pk2(acc[2], acc[3]); o.z = pk2(acc[4], acc[5]); o.w = pk2(acc[6], acc[7]);
            *(v4u*)(XL + (size_t)r * 256 + c8) = o;
        }
    }
    __syncthreads();
    {
        LAS bf16* hs = (LAS bf16*)(F.lds);
        bf16* VT = (bf16*)(F.ws + WS_VT); bf16* X0T = (bf16*)(F.ws + WS_X0T);
        const float* cw = hy_cw + (size_t)l * 3 * 768; const float* cbp = hy_cb + l * 768;
        for (int it = blockIdx.x; it < NLAT / 64; it += F.G) {
            const int b = it >> 7, t0 = (it & 127) * 64;
            for (int i = F.tid; i < 66 * 384; i += NTHR) { const int rr = i / 384, c2 = i - rr * 384; const int t = t0 - 1 + rr;
                unsigned w = 0u; if (t >= 0 && t < SEQ) w = *(const unsigned*)(U + (size_t)(b * SEQ + t) * INW + 1280 + 2 * c2);
                *(LAS unsigned*)(hs + rr * 770 + 2 * c2) = w; }
            __syncthreads();
            for (int c = F.wave; c < 256; c += NWAVES) {
                const int tt = F.lane;
                float o[3];
#pragma unroll
                for (int g = 0; g < 3; ++g) { const int cc = g * 256 + c;
                    o[g] = cw[cc] * bf2f(hs[tt * 770 + cc]) + cw[768 + cc] * bf2f(hs[(tt + 1) * 770 + cc]) + cw[1536 + cc] * bf2f(hs[(tt + 2) * 770 + cc]) + cbp[cc]; }
                const size_t oi = ((size_t)b * 256 + c) * SEQ + t0 + tt;
                VT[oi] = (bf16)f2bf(o[2] * o[1]); X0T[oi] = (bf16)f2bf(o[0]);
            }
            __syncthreads();
        }
    }
}


__device__ __forceinline__ int chunk_row0(int b, int d, int k) {
    if (k < 2) { const int cc = d ? 1 - k : k; return NLAT + b * CTXL + cc * CHUNK; }
    const int lc = d ? 63 - (k - 2) : (k - 2); return b * SEQ + lc * CHUNK;
}
__device__ __forceinline__ void ph_scan1(const Frame& F) {
    const bf16* LAB = (const bf16*)(F.ws + WS_LAB); float* SUMP = (float*)(F.ws + WS_SCANS); float* SUMH = SUMP + NB * 2 * NCHUNK * 256;
    for (int it = blockIdx.x * NTHR + F.tid; it < NB * 2 * NCHUNK * 256; it += F.G * NTHR) {
        const int ch = it & 255, k = (it >> 8) % NCHUNK, bd = (it >> 8) / NCHUNK, d = bd & 1, b = bd >> 1;
        const int r0 = chunk_row0(b, d, k);
        const bf16* LA = LAB + (size_t)(2 * d) * LAB_STRIDE + ch; const bf16* LB = LAB + (size_t)(2 * d + 1) * LAB_STRIDE + ch;
        float h = 0.f, Ps = 0.f;
#pragma unroll 16
        for (int i = 0; i < CHUNK; ++i) { const int r = d ? r0 + CHUNK - 1 - i : r0 + i; const float la = bf2f(LA[(size_t)r * 256]), bx = bf2f(LB[(size_t)r * 256]); h = __builtin_amdgcn_exp2f(la) * h + bx; Ps += la; }
        SUMP[it] = __builtin_amdgcn_exp2f(Ps); SUMH[it] = h;
    }
}
__device__ __forceinline__ void ph_scan2(const Frame& F) {
    const bf16* LAB = (const bf16*)(F.ws + WS_LAB); const float* SUMP = (const float*)(F.ws + WS_SCANS); const float* SUMH = SUMP + NB * 2 * NCHUNK * 256;
    float* LRUO = (float*)(F.ws + WS_LRUO); const bf16* U = (const bf16*)(F.ws + WS_U);
    for (int it = blockIdx.x * NTHR + F.tid; it < NB * NCHUNK * 256; it += F.G * NTHR) {
        const int ch = it & 255, kc = (it >> 8) % NCHUNK, b = (it >> 8) / NCHUNK;
        const int r0 = chunk_row0(b, 0, kc);
#pragma unroll 1
        for (int d = 0; d < 2; ++d) {
            const int k = d ? ((kc < 2) ? 1 - kc : 2 + 63 - (kc - 2)) : kc;
            const size_t sb = (size_t)((b * 2 + d) * NCHUNK) * 256 + ch;
            float h = 0.f;
#pragma unroll 8
            for (int j = 0; j < k; ++j) h = SUMP[sb + (size_t)j * 256] * h + SUMH[sb + (size_t)j * 256];
            const bf16* LA = LAB + (size_t)(2 * d) * LAB_STRIDE + ch; const bf16* LB = LAB + (size_t)(2 * d + 1) * LAB_STRIDE + ch;
            if (d == 0) {
#pragma unroll 16
                for (int i = 0; i < CHUNK; ++i) { const int r = r0 + i; h = __builtin_amdgcn_exp2f(bf2f(LA[(size_t)r * 256])) * h + bf2f(LB[(size_t)r * 256]); LRUO[(size_t)r * 256 + ch] = h; }
            } else {
#pragma unroll 8
                for (int i = 0; i < CHUNK; ++i) { const int r = r0 + CHUNK - 1 - i; h = __builtin_amdgcn_exp2f(bf2f(LA[(size_t)r * 256])) * h + bf2f(LB[(size_t)r * 256]);
                    const float lg = bf2f(U[(size_t)r * INW + 1024 + ch]);
                    LRUO[(size_t)r * 256 + ch] = (LRUO[(size_t)r * 256 + ch] + h) * gelu_tanh(lg); }
            }
        }
    }
}

__device__ __forceinline__ void ph_hyena_fft(const Frame& F, int l, const float* hy_bias) {
    LAS f32x2v* D = (LAS f32x2v*)(F.lds);
    const c32* KHAT = (const c32*)(F.ws + WS_KHAT) + (size_t)l * 256 * 16384;
    const bf16* VT = (const bf16*)(F.ws + WS_VT); const bf16* X0T = (const bf16*)(F.ws + WS_X0T); bf16* HYO = (bf16*)(F.ws + WS_HYO);
    for (int it = blockIdx.x; it < 512; it += F.G) {
        const int c = it >> 1, bp = it & 1;
        const bf16* va = VT + ((size_t)(bp * 2) * 256 + c) * SEQ; const bf16* vb = VT + ((size_t)(bp * 2 + 1) * 256 + c) * SEQ;
#ifndef REP_FFT
#define REP_FFT 1
#endif
#pragma unroll 1
        for (int repf_ = 0; repf_ < REP_FFT; ++repf_) {
#pragma unroll 1
        for (int i = 0; i < 8; ++i) { const int j = F.tid + 512 * i; c32 x0, x1, z; x0.x = bf2f(va[j]); x0.y = bf2f(vb[j]); x1.x = bf2f(va[j + 4096]); x1.y = bf2f(vb[j + 4096]); z.x = 0.f; z.y = 0.f;
            fft_first4(D, j, x0, x1, z, z); }
        __syncthreads();
        { fft_fwd16(D, F.tid, 4096); fft_fwd16(D, F.tid + 512, 4096); }
        __syncthreads();
        { fft_fwd16(D, F.tid, 256); fft_fwd16(D, F.tid + 512, 256); }
        __syncthreads();
        _Pragma("unroll 1") for (int g_ = F.tid; g_ < 1024; g_ += 512) fft_mid16(D, g_, KHAT + (size_t)c * 16384);
        __syncthreads();
        { fft_inv16(D, F.tid, 256); fft_inv16(D, F.tid + 512, 256); }
        __syncthreads();
        { fft_inv16(D, F.tid, 4096); fft_inv16(D, F.tid + 512, 4096); }
        __syncthreads();
        }
        const float bias = hy_bias[l * 256 + c];
        const bf16* xa = X0T + ((size_t)(bp * 2) * 256 + c) * SEQ; const bf16* xb = X0T + ((size_t)(bp * 2 + 1) * 256 + c) * SEQ;
        bf16* oa = HYO + ((size_t)(bp * 2) * 256 + c) * SEQ; bf16* ob = HYO + ((size_t)(bp * 2 + 1) * 256 + c) * SEQ;
#pragma unroll 2
        for (int i = 0; i < 8; ++i) { const int j = F.tid + 512 * i; c32 u0, u1; fft_final4(D, j, u0, u1);
            oa[j] = (bf16)f2bf((u0.x + bf2f(va[j]) * bias) * bf2f(xa[j]));                 ob[j] = (bf16)f2bf((-u0.y + bf2f(vb[j]) * bias) * bf2f(xb[j]));
            oa[j + 4096] = (bf16)f2bf((u1.x + bf2f(va[j + 4096]) * bias) * bf2f(xa[j + 4096])); ob[j + 4096] = (bf16)f2bf((-u1.y + bf2f(vb[j + 4096]) * bias) * bf2f(xb[j + 4096])); }
        __syncthreads();
    }
}
__device__ __forceinline__ void ph_hyena_ctx(const Frame& F, const float* hy_bias, const float* hy_cw, const float* hy_cb) {
    float* HYO = (float*)(F.ws + WS_HYO);
    {

        const bf16* U = (const bf16*)(F.ws + WS_U); const float* KFC = (const float*)(F.ws + WS_KFC);
        LAS float* vw = (LAS float*)(F.lds + F.wave * 4096);
        LAS float* kw = vw + 256;
        const float* cw = hy_cw; const float* cbp = hy_cb;
        for (int it = F.gw; it < NB * 256; it += F.ngw) {
            const int b = it >> 8, c = it & 255;
            float x0v[4];
#pragma unroll
            for (int i = 0; i < 4; ++i) { const int t = F.lane + 64 * i;
                float o[3];
#pragma unroll
                for (int g = 0; g < 3; ++g) { const int cc = g * 256 + c; float a = cbp[cc];
#pragma unroll
                    for (int j = 0; j < 3; ++j) { const int tj = t + j - 1; if (tj >= 0 && tj < CTXL) a += cw[j * 768 + cc] * bf2f(U[(size_t)(NLAT + b * CTXL + tj) * INW + 1280 + cc]); }
                    o[g] = a; }
                vw[t] = o[2] * o[1]; x0v[i] = o[0]; }
#pragma unroll
            for (int i = 0; i < 8; ++i) kw[F.lane + 64 * i] = KFC[c * 512 + F.lane + 64 * i];
            LDS_WAIT();
            float y[4] = {0.f, 0.f, 0.f, 0.f};
#pragma unroll 4
            for (int s = 0; s < CTXL; ++s) { const float vv = vw[s];
#pragma unroll
                for (int i = 0; i < 4; ++i) y[i] += kw[(F.lane + 64 * i - s) & 511] * vv; }
            const float bias = hy_bias[c];
#pragma unroll
            for (int i = 0; i < 4; ++i) { const int t = F.lane + 64 * i; HYO[(size_t)(NLAT + b * CTXL + t) * 256 + c] = (y[i] + vw[t] * bias) * x0v[i]; }
            LDS_WAIT();
        }
    }
}

__device__ __forceinline__ void merge_row(const Frame& F, int r, const float* g, float h0, float h1, float h2, float h3) {
    const bf16* ATT = (const bf16*)(F.ws + WS_ATT); const float* LRUO = (const float*)(F.ws + WS_LRUO); bf16* MIXA = (bf16*)(F.ws + WS_MIXA);
    const v4u aw = ((const v4u*)(ATT + (size_t)r * 512))[F.lane];
    float a[8] = {bflo(aw.x), bfhi(aw.x), bflo(aw.y), bfhi(aw.y), bflo(aw.z), bfhi(aw.z), bflo(aw.w), bfhi(aw.w)};
    float ss = 0.f;
#pragma unroll
    for (int i = 0; i < 8; ++i) ss += a[i] * a[i];
    const float ra = 1.0f / sqrtf(wave_sum(ss) * (1.0f / 512.0f) + EPSN);
    const f32x4 lv = ((const f32x4*)(LRUO + (size_t)r * 256))[F.lane];
    const float rl = 1.0f / sqrtf(wave_sum(lv.x * lv.x + lv.y * lv.y + lv.z * lv.z + lv.w * lv.w) * (1.0f / 256.0f) + EPSN);
    const float rh = 1.0f / sqrtf(wave_sum(h0 * h0 + h1 * h1 + h2 * h2 + h3 * h3) * (1.0f / 256.0f) + EPSN);
    bf16* orow = MIXA + (size_t)r * 1024;
    { const f32x4 g0 = ((const f32x4*)g)[2 * F.lane], g1 = ((const f32x4*)g)[2 * F.lane + 1];
      v4u o; o.x = pk2(a[0] * ra * g0.x, a[1] * ra * g0.y); o.y = pk2(a[2] * ra * g0.z, a[3] * ra * g0.w); o.z = pk2(a[4] * ra * g1.x, a[5] * ra * g1.y); o.w = pk2(a[6] * ra * g1.z, a[7] * ra * g1.w);
      ((v4u*)orow)[F.lane] = o; }
    { const f32x4 gg = ((const f32x4*)(g + 512))[F.lane]; v2u o; o.x = pk2(lv.x * rl * gg.x, lv.y * rl * gg.y); o.y = pk2(lv.z * rl * gg.z, lv.w * rl * gg.w); ((v2u*)(orow + 512))[F.lane] = o; }
    orow[768 + F.lane] = (bf16)f2bf(h0 * rh * g[768 + F.lane]); orow[832 + F.lane] = (bf16)f2bf(h1 * rh * g[832 + F.lane]);
    orow[896 + F.lane] = (bf16)f2bf(h2 * rh * g[896 + F.lane]); orow[960 + F.lane] = (bf16)f2bf(h3 * rh * g[960 + F.lane]);
}
__device__ __forceinline__ void ph_merge(const Frame& F, int l, int nrows, const float* out_g) {
    const float* HYO = (const float*)(F.ws + WS_HYO);
    const float* g = out_g + l * 1024;
    LAS float* tile = (LAS float*)(F.lds);
    for (int it = blockIdx.x; it < NLAT / 64; it += F.G) {
        const int b = it >> 7, t0 = (it & 127) * 64;
#pragma unroll 8
        for (int i = 0; i < 32; ++i) { const int c = F.wave * 32 + i; tile[c * 65 + F.lane] = bf2f(((const bf16*)HYO)[((size_t)b * 256 + c) * SEQ + t0 + F.lane]); }
        __syncthreads();
#pragma unroll 2
        for (int k = 0; k < 8; ++k) { const int tt = F.wave * 8 + k;
            merge_row(F, b * SEQ + t0 + tt, g, tile[F.lane * 65 + tt], tile[(F.lane + 64) * 65 + tt], tile[(F.lane + 128) * 65 + tt], tile[(F.lane + 192) * 65 + tt]); }
        __syncthreads();
    }
    for (int r = NLAT + F.gw; r < nrows; r += F.ngw) {
        const float* hr = HYO + (size_t)r * 256;
        merge_row(F, r, g, hr[F.lane], hr[64 + F.lane], hr[128 + F.lane], hr[192 + F.lane]);
    }
}


__device__ __forceinline__ void ph_ffn_router(const Frame& F, int l, int nrows, const float* router_w) {
    LAS float* rwl = (LAS float*)(F.lds);
    LAS float* cbl = (LAS float*)(F.lds + 147456);
    LAS int* hist = (LAS int*)(F.lds + 147456 + 640);
    const bf16* XR = (const bf16*)(F.ws + WS_XR); const float* RSSP = (const float*)(F.ws + WS_RSSP); const float* MOD = (const float*)(F.ws + WS_MOD);
    const float* GC = (const float*)(F.ws + WS_GC) + (size_t)l * 5 * 1024; bf16* Fb = (bf16*)(F.ws + WS_F);
    int* TOPI = (int*)(F.ws + WS_TOPI); float* GATE = (float*)(F.ws + WS_GATE); int* BLKCNT = (int*)(F.ws + WS_BLKCNT);
    for (int i = F.tid; i < 1024 * 32; i += NTHR) rwl[(i >> 5) * 36 + (i & 31)] = router_w[(size_t)l * 32768 + i];
    if (F.tid < 32) hist[F.tid] = 0;
    if (F.tid < 160) cbl[F.tid] = ((const float*)(F.ws + WS_CB))[l * 160 + F.tid];
    __syncthreads();
    const int j = F.lane & 15, kq = F.lane >> 4;
    for (int grp = F.gw; grp < nrows / 16; grp += F.ngw) {
        const int r0 = grp * 16, r = r0 + j; const int bidx = r0 < NLAT ? r0 / SEQ : 4;
        const bf16* xrow = XR + (size_t)r * 1024 + 4 * kq; const float* gcp = GC + bidx * 1024 + 4 * kq; const float* sfp = MOD + (size_t)(l * 5 + bidx) * 6144 + 3 * 1024 + 4 * kq;
        bf16* frow = Fb + (size_t)r * 1024 + 4 * kq;
        float ss; { const f32x4 q = *(const f32x4*)(RSSP + (size_t)r * 16 + 4 * kq); ss = (q.x + q.y) + (q.z + q.w); }
        ss += __shfl_xor(ss, 16); ss += __shfl_xor(ss, 32);
        const float rstd = 1.0f / sqrtf(ss * (1.0f / 1024.0f) + EPSN);
        f32x4 acc0 = {0.f, 0.f, 0.f, 0.f}, acc1 = acc0;
#pragma unroll 1
        for (int ib = 0; ib < 64; ib += 8) {
            v2u xw[8]; f32x4 g4[8], s4[8];
#pragma unroll
            for (int u = 0; u < 8; ++u) { xw[u] = *(const v2u*)(xrow + 16 * (ib + u)); g4[u] = *(const f32x4*)(gcp + 16 * (ib + u)); s4[u] = *(const f32x4*)(sfp + 16 * (ib + u)); }
#pragma unroll
            for (int u = 0; u < 8; ++u) {
                const f32x4 x4 = {bflo(xw[u].x), bfhi(xw[u].x), bflo(xw[u].y), bfhi(xw[u].y)};
                const f32x4 xb = x4 * g4[u];
                const f32x4 fv = xb * rstd + s4[u];
#if MOE_FP8
                *(unsigned*)((unsigned char*)Fb + (size_t)r * 1024 + 4 * kq + 16 * (ib + u)) = pg8::pack4_fp8(fv.x * pg8::F8_SF, fv.y * pg8::F8_SF, fv.z * pg8::F8_SF, fv.w * pg8::F8_SF);
#else
                v2u o; o.x = pk2(fv.x, fv.y); o.y = pk2(fv.z, fv.w); *(v2u*)(frow + 16 * (ib + u)) = o;
#endif
                const LAS float* wp = rwl + (16 * (ib + u) + 4 * kq) * 36 + j;
#pragma unroll
                for (int e = 0; e < 4; ++e) { acc0 = __builtin_amdgcn_mfma_f32_16x16x4f32(wp[e * 36], xb[e], acc0, 0, 0, 0); acc1 = __builtin_amdgcn_mfma_f32_16x16x4f32(wp[e * 36 + 16], xb[e], acc1, 0, 0, 0); }
            }
        }
        float lg[8];
#pragma unroll
        for (int rr = 0; rr < 4; ++rr) { lg[rr] = rstd * acc0[rr] + cbl[bidx * 32 + 4 * kq + rr]; lg[4 + rr] = rstd * acc1[rr] + cbl[bidx * 32 + 16 + 4 * kq + rr]; }
        float p[32];
#pragma unroll
        for (int e = 0; e < 32; ++e) p[e] = __shfl(lg[(e >> 4) * 4 + (e & 3)], j + 16 * ((e & 15) >> 2));
        unsigned taken = 0u; float tv[4]; int ti[4];
#pragma unroll
        for (int k = 0; k < 4; ++k) { float best = -INFINITY; int bi = 0;
#pragma unroll
            for (int e = 0; e < 32; ++e) { const bool ok = !((taken >> e) & 1u) && (p[e] > best); best = ok ? p[e] : best; bi = ok ? e : bi; }
            taken |= 1u << bi; tv[k] = best; ti[k] = bi; }
        const float e1 = __expf(tv[1] - tv[0]), e2 = __expf(tv[2] - tv[0]), e3 = __expf(tv[3] - tv[0]); const float inv = 1.0f / (1.0f + e1 + e2 + e3);
        if (kq == 0) {
            TOPI[r * 4 + 0] = ti[0]; TOPI[r * 4 + 1] = ti[1]; TOPI[r * 4 + 2] = ti[2]; TOPI[r * 4 + 3] = ti[3];
            GATE[r * 4 + 0] = inv; GATE[r * 4 + 1] = e1 * inv; GATE[r * 4 + 2] = e2 * inv; GATE[r * 4 + 3] = e3 * inv;
            lds_add(&hist[ti[0]], 1); lds_add(&hist[ti[1]], 1); lds_add(&hist[ti[2]], 1); lds_add(&hist[ti[3]], 1);
        }
    }
    __syncthreads();
    if (F.tid < 32) BLKCNT[blockIdx.x * 32 + F.tid] = hist[F.tid];
}

__device__ __forceinline__ void ph_route(const Frame& F, int nrows) {
    LAS int* cursor = (LAS int*)(F.lds);
    LAS int* tot = cursor + 32;
    LAS int* mine = cursor + 64;
    LAS int* part = cursor + 96;
    LAS int* ebase = cursor + 96 + 1024;
    const int* BLKCNT = (const int*)(F.ws + WS_BLKCNT); const int* TOPI = (const int*)(F.ws + WS_TOPI); int* POS = (int*)(F.ws + WS_POS);
    int* ROWTOK = (int*)(F.ws + WS_ROWTOK); int* TILEE = (int*)(F.ws + WS_TILEE);
    { const int e = F.tid & 31, sl = F.tid >> 5; int t = 0, m = 0;
      for (int b = sl; b < F.G; b += 16) { const int v = BLKCNT[b * 32 + e]; t += v; m += (b < (int)blockIdx.x) ? v : 0; }
      part[sl * 64 + e] = t; part[sl * 64 + 32 + e] = m;
      __syncthreads();
      if (F.tid < 32) { int tt = 0, mm = 0;
#pragma unroll
          for (int s = 0; s < 16; ++s) { tt += part[s * 64 + F.tid]; mm += part[s * 64 + 32 + F.tid]; }
          tot[F.tid] = tt; mine[F.tid] = mm; } }
    __syncthreads();
    if (F.tid == 0) { int tb = 0;
        for (int e = 0; e < 32; ++e) { const int nt = (tot[e] + 255) >> 8; cursor[e] = tb * 256 + mine[e]; ebase[e] = tb * 256;
            if (blockIdx.x == 0) for (int j = 0; j < nt; ++j) TILEE[tb + j] = e;
            tb += nt; }
        ebase[32] = tb * 256;
        if (blockIdx.x == 0) F.ctl[CW_NTILES] = (unsigned)tb; }
    __syncthreads();
    for (int e = blockIdx.x; e < 32; e += F.G) for (int p = ebase[e] + tot[e] + F.tid; p < ebase[e + 1]; p += NTHR) ROWTOK[p] = 0;
    const int sub = F.lane >> 2, k = F.lane & 3;
    for (int grp = F.gw; grp < nrows / 16; grp += F.ngw) {
        const int r = grp * 16 + sub; const int e = TOPI[r * 4 + k]; const int pos = lds_add(&cursor[e], 1); POS[r * 4 + k] = pos; ROWTOK[pos] = r; }
}

__device__ __forceinline__ void ph_combine(const Frame& F, int l, int nrows, float* out, const float* gmix) {
    bf16* XR = (bf16*)(F.ws + WS_XR); const float* MOD = (const float*)(F.ws + WS_MOD); const bf16* YS = (const bf16*)(F.ws + WS_YS); bf16* H = (bf16*)(F.ws + WS_H);
    const int* POS = (const int*)(F.ws + WS_POS); const float* GATE = (const float*)(F.ws + WS_GATE);
    for (int r = 2 * F.gw; r < nrows; r += 2 * F.ngw) {
        const int bidx = r < NLAT ? r / SEQ : 4;
        const float* gf = MOD + (size_t)(l * 5 + bidx) * 6144 + 5 * 1024;
        int pos = 0; float gt = 0.f;
        if (F.lane < 8) { pos = POS[r * 4 + F.lane]; gt = GATE[r * 4 + F.lane]; }
        v2u w[2][4][4], xw[2][4]; float gk[2][4];
#pragma unroll
        for (int rr = 0; rr < 2; ++rr)
#pragma unroll
            for (int k = 0; k < 4; ++k) { const int pk = __shfl(pos, rr * 4 + k); gk[rr][k] = __shfl(gt, rr * 4 + k);
#if MOE_FP8
                gk[rr][k] *= (1.0f / pg8::F8_SY); const unsigned* yr = (const unsigned*)((const unsigned char*)YS + (size_t)pk * YS_PITCH);
#pragma unroll
                for (int j = 0; j < 4; ++j) { w[rr][k][j].x = yr[64 * j + F.lane]; w[rr][k][j].y = 0u; } }
#else
                const v2u* yr = (const v2u*)(YS + (size_t)pk * 1024);
#pragma unroll
                for (int j = 0; j < 4; ++j) w[rr][k][j] = yr[64 * j + F.lane]; }
#endif
#pragma unroll
        for (int rr = 0; rr < 2; ++rr)
#pragma unroll
            for (int j = 0; j < 4; ++j) xw[rr][j] = ((const v2u*)(XR + (size_t)(r + rr) * 1024))[64 * j + F.lane];
        f32x4 gv[4];
#pragma unroll
        for (int j = 0; j < 4; ++j) gv[j] = ((const f32x4*)gf)[64 * j + F.lane];
#pragma unroll
        for (int rr = 0; rr < 2; ++rr) {
            const int row = r + rr;
            f32x4 y[4]; float ss = 0.f;
#pragma unroll
            for (int j = 0; j < 4; ++j) { f32x4 a = {0.f, 0.f, 0.f, 0.f};
#pragma unroll
                for (int k = 0; k < 4; ++k) { const v2u ww = w[rr][k][j]; const float g_ = gk[rr][k];
#if MOE_FP8
                    a.x += g_ * __builtin_amdgcn_cvt_f32_fp8((int)ww.x, 0); a.y += g_ * __builtin_amdgcn_cvt_f32_fp8((int)ww.x, 1); a.z += g_ * __builtin_amdgcn_cvt_f32_fp8((int)ww.x, 2); a.w += g_ * __builtin_amdgcn_cvt_f32_fp8((int)ww.x, 3); }
#else
                    a.x += g_ * bflo(ww.x); a.y += g_ * bfhi(ww.x); a.z += g_ * bflo(ww.y); a.w += g_ * bfhi(ww.y); }
#endif
                const f32x4 xv = {bflo(xw[rr][j].x), bfhi(xw[rr][j].x), bflo(xw[rr][j].y), bfhi(xw[rr][j].y)};
                y[j] = xv + gv[j] * a;
                const int cb = 64 * j + F.lane;
                if (l == 0) { v2u o; o.x = pk2(y[j].x, y[j].y); o.y = pk2(y[j].z, y[j].w); ((v2u*)(XR + (size_t)row * 1024))[cb] = o; } else ((f32x4*)(out + (size_t)row * 1024))[cb] = y[j];
                ss += (y[j].x * y[j].x + y[j].y * y[j].y) + (y[j].z * y[j].z + y[j].w * y[j].w); }
            if (l == 0) {
                const float rstd = 1.0f / sqrtf(wave_sum(ss) * (1.0f / 1024.0f) + EPSN);
                const float* shift = MOD + (size_t)(5 + bidx) * 6144; const float* scale = shift + 1024; const float* g = gmix + 1024;
#pragma unroll
                for (int j = 0; j < 4; ++j) { const int cb = 64 * j + F.lane; const f32x4 gg = ((const f32x4*)g)[cb], sc = ((const f32x4*)scale)[cb], sh = ((const f32x4*)shift)[cb];
                    const f32x4 hv = y[j] * rstd * gg * (sc + 1.0f) + sh;
                    v2u o; o.x = pk2(hv.x, hv.y); o.y = pk2(hv.z, hv.w); ((v2u*)(H + (size_t)row * 1024))[cb] = o; }
            }
        }
    }
}

struct Args { const float* in[34]; float* out; unsigned char* ws; int ph_lo, ph_hi; };
enum { I_X = 0, I_C, I_CTX, I_CCTX, I_WMOD, I_BMOD, I_GMIX, I_GFFN, I_WIN, I_QG, I_KG, I_LCW, I_LCB, I_LGW, I_LGB, I_LLAM, I_HCW, I_HCB, I_HW1, I_HB1, I_HW2, I_HB2, I_HW3, I_HFREQ, I_HDEC, I_HBIAS,
       I_OUTG, I_WOUT, I_RW, I_RB, I_MW1, I_MB1, I_MW2, I_MB2 };

__global__ void __launch_bounds__(NTHR, 2) mk_fwd(Args args) {
    extern __shared__ __attribute__((aligned(16))) unsigned char lds[];
    Frame F;
    F.lds = (LAS unsigned char*)lds; F.ws = args.ws; F.ctl = (unsigned*)(args.ws + WS_CTL);
    F.tid = threadIdx.x; F.lane = F.tid & 63; F.wave = __builtin_amdgcn_readfirstlane(F.tid >> 6);
    F.G = gridDim.x; { const int bx = blockIdx.x; F.vcu = (F.G % 8 == 0) ? (bx % 8) * (F.G / 8) + bx / 8 : bx; }
    F.gw = (int)blockIdx.x * NWAVES + F.wave; F.ngw = F.G * NWAVES;
    for (int u = F.tid; u < (LDS_BYTES - LDSCTL_OFF) / 4; u += NTHR) ((LAS unsigned*)(F.lds + LDSCTL_OFF))[u] = 0u;
    __syncthreads();
#if !MK_PER_PHASE
    XcdBarrier bar = xcd_barrier_post(F.ctl + CW_BAR, (volatile LAS unsigned*)(F.lds + LDSCTL_OFF + 32));
#define GRID_BAR() xcd_barrier(bar)
#else
#define GRID_BAR() do { } while (0)
#endif
    const int lo = args.ph_lo, hi = args.ph_hi;
#ifndef ONLY_PHASE
#define ONLY_PHASE (-1)
#endif
#define ENABLED(id) (ONLY_PHASE < 0 || ONLY_PHASE == (id))
#define IN(k) (ENABLED(k) && lo <= (k) && (k) < hi)
#define INL(j) (ENABLED(NPH_PRO + (j)) && lo <= pb + (j) && pb + (j) < hi)
#define SEAML(j) do { if (lo <= pb + (j) && pb + (j) + 1 < hi) { GRID_BAR(); } } while (0)
typedef const __attribute__((address_space(4))) Args* KArgs;
#ifndef REP_MASK
#define REP_MASK 0
#endif
#define NREP(j) (((REP_MASK >> (j)) & 1) ? 2 : 1)
#define REFRAME() Frame Fp = F; KArgs ka = (KArgs)__builtin_amdgcn_kernarg_segment_ptr(); { int t_ = F.tid; asm volatile("" : "+v"(t_), "+s"(ka)); Fp.tid = t_; Fp.lane = t_ & 63; Fp.wave = __builtin_amdgcn_readfirstlane(t_ >> 6); \
    Fp.gw = (int)blockIdx.x * NWAVES + Fp.wave; Fp.ws = ka->ws; Fp.ctl = (unsigned*)(ka->ws + WS_CTL); }
#define SEAM(k) do { if (lo <= (k) && (k) + 1 < hi) { GRID_BAR(); } } while (0)

    if (IN(0)) ph_prologue_a(F, args.in[I_C], args.in[I_CCTX], args.in[I_WMOD], args.in[I_BMOD], args.in[I_WIN], args.in[I_WOUT], args.in[I_MW1], args.in[I_MW2],
                             args.in[I_HW1], args.in[I_HB1], args.in[I_HW2], args.in[I_HB2], args.in[I_HFREQ], args.in[I_LGW], args.in[I_LLAM]);
    SEAM(0);
    if (IN(1)) ph_prologue_b(F, args.in[I_HW3], args.in[I_HDEC], args.in[I_GFFN], args.in[I_RW], args.in[I_RB]);
    SEAM(1);

#if MOE_FP8
#define MOE_EPI1 pg8::EpiSwigluF8
#define MOE_EPI2 pg8::EpiF8BiasF8
#else
#define MOE_EPI1 pg8::EpiSwiglu
#define MOE_EPI2 pg8::EpiBf16Bias
#endif
#ifndef PROBE_MOE2
#define PROBE_MOE2 0
#endif
#ifndef PROBE_MOE2B
#define PROBE_MOE2B 0
#endif
#ifndef PROBE_GEMM_K
#define PROBE_GEMM_K 0
#endif
#ifndef MOE_WGM1
#define MOE_WGM1 4
#endif
#ifndef MOE_WGM2
#define MOE_WGM2 8
#endif
#define PHASE(j, ...) if (INL(j)) { _Pragma("unroll") for (int rep_ = 0; rep_ < NREP(j); ++rep_) { { REFRAME(); __VA_ARGS__ } if (rep_ + 1 < NREP(j)) GRID_BAR(); } }
#define LAYER_BODY(l) { \
        const int pb = NPH_PRO + l * NPH_LAYER; \
        const int nrows = (l == 0) ? MT : NLAT; \
        if (l == 0) { PHASE(0, ph_norm_mod(Fp, l, ka->in[I_X], ka->in[I_CTX], ka->in[I_GMIX]);) SEAML(0); } \
        PHASE(1, \
            pg8::Gemm g{(const bf16*)(Fp.ws + WS_H), (const bf16*)(Fp.ws + WS_WINT) + (size_t)l * 2048 * 1024, MT, 2048, 1024}; \
            pg8::StaticOrder S; S.init(MT, 2048, Fp.G, (int)blockIdx.x); \
            pg8::EpiBf16<0> E{(bf16*)(Fp.ws + WS_U), 2048, nullptr, 0, 0, 1.f}; \
            pg8::gemm_phase<pg8::EpiBf16<0>, pg8::StaticOrder, PG8_ALIGN, PG8_SP2>(Fp.lds + RING_OFF, g, S, E);) \
        SEAML(1); \
        if (PROBE_GEMM_K > 0 && INL(1)) { REFRAME(); int kp_ = PROBE_GEMM_K; asm volatile("" : "+s"(kp_)); \
            pg8::Gemm g{(const bf16*)(Fp.ws + WS_H), (const bf16*)(Fp.ws + WS_WINT) + (size_t)l * 2048 * 1024, MT, 2048, kp_}; \
            pg8::StaticOrder S; S.init(MT, 2048, Fp.G, (int)blockIdx.x); \
            pg8::EpiNone E{}; \
            pg8::gemm_phase<pg8::EpiNone, pg8::StaticOrder, PG8_ALIGN, PG8_SP2>(Fp.lds + RING_OFF, g, S, E); GRID_BAR(); } \
        PHASE(2, ph_post_proj(Fp, l, ka->in[I_QG], ka->in[I_KG], ka->in[I_LCW], ka->in[I_LCB], ka->in[I_HCW], ka->in[I_HCB]);) \
        SEAML(2); \
        PHASE(3, \
            int kg_ = 256; asm volatile("" : "+s"(kg_)); \
            pg8::Gemm g{(const bf16*)(Fp.ws + WS_XL), (const bf16*)(Fp.ws + WS_WGT) + (size_t)l * 1024 * 256, MT, 1024, kg_}; \
            pg8::StaticOrder S; S.init(MT, 1024, Fp.G, (int)blockIdx.x); \
            pg8::EpiLruGate E{(const bf16*)(Fp.ws + WS_XL), (bf16*)(Fp.ws + WS_LAB), LAB_STRIDE, ka->in[I_LGB] + (size_t)l * 1024, (const float*)(Fp.ws + WS_SPT) + l * 512}; \
            pg8::gemm_phase<pg8::EpiLruGate, pg8::StaticOrder, PG8_ALIGN, PG8_SP2>(Fp.lds + RING_OFF, g, S, E);) \
        SEAML(3); \
        PHASE(4, \
            ph_scan1(Fp); __syncthreads(); \
            const attn_body::AttnTensors AT{(const attn_body::bf16*)(Fp.ws + WS_U), (const attn_body::bf16*)(Fp.ws + WS_K), (const attn_body::bf16*)(Fp.ws + WS_V), (attn_body::bf16*)(Fp.ws + WS_ATT)}; \
            const attn_body::QPre QN{ka->in[I_QG] + l * 64, (const float*)(Fp.ws + WS_ROPEC), (const float*)(Fp.ws + WS_ROPES)}; \
            attn_body::attn_phase<8>((char*)lds + RING_OFF, AT, QN, Fp.G, Fp.vcu, l == 0, (long)NLAT);) \
        SEAML(4); \
        PHASE(5, ph_scan2(Fp); __syncthreads(); ph_hyena_fft(Fp, l, ka->in[I_HBIAS]); if (l == 0) ph_hyena_ctx(Fp, ka->in[I_HBIAS], ka->in[I_HCW], ka->in[I_HCB]);) \
        SEAML(5); \
        PHASE(6, ph_merge(Fp, l, nrows, ka->in[I_OUTG]);) \
        SEAML(6); \
        if (INL(7)) { REFRAME(); \
            pg8::Gemm g{(const bf16*)(Fp.ws + WS_MIXA), (const bf16*)(Fp.ws + WS_WOUTT) + (size_t)l * 1024 * 1024, nrows, 1024, 1024}; \
            pg8::StaticOrder S; S.init(nrows, 1024, Fp.G, (int)blockIdx.x); \
            bf16* XR = (bf16*)(Fp.ws + WS_XR); \
            pg8::EpiResid<(l) == 1> E{ka->in[I_X], ka->in[I_CTX], NLAT, XR, 1024, \
                            (const float*)(Fp.ws + WS_MOD) + (size_t)(l * 5) * 6144 + 2 * 1024, 6144, SEQ, (float*)(Fp.ws + WS_RSSP)}; \
            pg8::gemm_phase<pg8::EpiResid<(l) == 1>, pg8::StaticOrder, PG8_ALIGN, PG8_SP2>(Fp.lds + RING_OFF, g, S, E); \
        } \
        SEAML(7); \
        PHASE(8, ph_ffn_router(Fp, l, nrows, ka->in[I_RW]);) \
        SEAML(8); \
        PHASE(9, ph_route(Fp, nrows);) \
        SEAML(9); \
        if (INL(10) || INL(11)) { REFRAME(); \
            LAS int* tab = (LAS int*)(Fp.lds + MOETAB_OFF); \
            const int ntiles = (int)__hip_atomic_load(Fp.ctl + CW_NTILES, __ATOMIC_RELAXED, __HIP_MEMORY_SCOPE_AGENT); \
            const int* TILEE = (const int*)(Fp.ws + WS_TILEE); \
            for (int i = Fp.tid; i < ntiles && i < SORT_TILES; i += NTHR) tab[i] = TILEE[i]; \
            __syncthreads(); \
            if (INL(10)) { _Pragma("unroll") for (int rep_ = 0; rep_ < NREP(10); ++rep_) { { \
                int km1_ = 1024 / (1 + MOE_FP8); asm volatile("" : "+s"(km1_)); \
                pg8::Gemm g{(const bf16*)(Fp.ws + WS_F), (const bf16*)(Fp.ws + WS_W1T) + (size_t)l * 32 * 2048 * (1024 / (1 + MOE_FP8)), 0, 2048, km1_}; \
                pg8::MoeOrderT<true> S; S.init(tab, ntiles, 8, Fp.G, (int)blockIdx.x, MOE_WGM1); S.rowtok = (const int*)(Fp.ws + WS_ROWTOK); \
                MOE_EPI1 E{(bf16*)(Fp.ws + WS_ACT), 1024, ka->in[I_MB1] + (size_t)l * 32 * 2048, 2048}; \
                pg8::gemm_phase<MOE_EPI1, pg8::MoeOrderT<true>, PG8_ALIGN, PG8_SP2, MOE_FP8 != 0>(Fp.lds + RING_OFF, g, S, E); \
             } if (rep_ + 1 < NREP(10)) GRID_BAR(); } } \
            SEAML(10); \
            if (PROBE_MOE2B && INL(11)) { \
                pg8::Gemm g{(const bf16*)(Fp.ws + WS_ACT), (const bf16*)(Fp.ws + WS_W2T) + (size_t)l * 32 * 1024 * 1024, 0, 1024, 1024}; \
                pg8::MoeOrderT<false> S; S.init(tab, ntiles, 4, Fp.G, (int)blockIdx.x, MOE_WGM2); S.rowtok = nullptr; S.rev = 1; \
                pg8::EpiNone E{}; \
                pg8::gemm_phase<pg8::EpiNone, pg8::MoeOrderT<false>, PG8_ALIGN, PG8_SP2>(Fp.lds + RING_OFF, g, S, E); GRID_BAR(); } \
            if (INL(11)) { _Pragma("unroll") for (int rep_ = 0; rep_ < NREP(11); ++rep_) { { \
                int km2_ = 1024 / (1 + MOE_FP8); asm volatile("" : "+s"(km2_)); \
                pg8::Gemm g{(const bf16*)(Fp.ws + WS_ACT), (const bf16*)(Fp.ws + WS_W2T) + (size_t)l * 32 * 1024 * (1024 / (1 + MOE_FP8)), 0, 1024, km2_}; \
                pg8::MoeOrderT<false> S; S.init(tab, ntiles, 4, Fp.G, (int)blockIdx.x, MOE_WGM2); S.rowtok = nullptr; S.rev = 1; \
                MOE_EPI2 E{(bf16*)(Fp.ws + WS_YS), YS_PITCH, ka->in[I_MB2] + (size_t)l * 32 * 1024, 1024}; \
                pg8::gemm_phase<MOE_EPI2, pg8::MoeOrderT<false>, PG8_ALIGN, PG8_SP2, MOE_FP8 != 0>(Fp.lds + RING_OFF, g, S, E); \
             } if (rep_ + 1 < NREP(11)) GRID_BAR(); } } \
            if (PROBE_MOE2 && INL(11)) { GRID_BAR(); \
                pg8::Gemm g{(const bf16*)(Fp.ws + WS_ACT), (const bf16*)(Fp.ws + WS_W2T) + (size_t)l * 32 * 1024 * 1024, 0, 1024, 1024}; \
                pg8::MoeOrderT<false> S; S.init(tab, ntiles, 4, Fp.G, (int)blockIdx.x, MOE_WGM2); S.rowtok = nullptr; S.rev = (PROBE_MOE2 == 2) ? 0 : 1; \
                if (PROBE_MOE2 == 3) { pg8::EpiBf16BiasFold E{(bf16*)(Fp.ws + WS_ASORT), 1024, ka->in[I_MB2] + (size_t)l * 32 * 1024, 1024}; \
                    pg8::gemm_phase<pg8::EpiBf16BiasFold, pg8::MoeOrderT<false>, PG8_ALIGN, PG8_SP2>(Fp.lds + RING_OFF, g, S, E); } \
                else { pg8::EpiNone E{}; \
                pg8::gemm_phase<pg8::EpiNone, pg8::MoeOrderT<false>, PG8_ALIGN, PG8_SP2>(Fp.lds + RING_OFF, g, S, E); } } \
        } \
        SEAML(11); \
        if (INL(12)) { REFRAME(); ph_combine(Fp, l, nrows, ka->out, ka->in[I_GMIX]); } \
        if (l == 0) { SEAML(12); } \
    }
    LAYER_BODY(0)
    LAYER_BODY(1)
#undef LAYER_BODY
#undef PHASE
#undef IN
#undef SEAM
#undef INL
#undef SEAML
}

extern "C" void kernel_launch(void* const* d_in, const int* in_sizes, int n_in, void* d_out, int out_size, void* d_ws, size_t ws_size, hipStream_t stream) {
    static int grid = 0;
    if (grid == 0) {
        if (n_in != 34 || in_sizes[0] != NLAT * DMODEL || out_size != NLAT * DMODEL || ws_size < WS_END) {
            fprintf(stderr, "kernel_launch: unexpected shapes (n_in %d, in0 %d, out %d, ws %zu); nothing launched\n", n_in, n_in > 0 ? in_sizes[0] : -1, out_size, ws_size); grid = -1; return; }
        int dev = 0, cus = 0;
        if (hipGetDevice(&dev) != hipSuccess || hipDeviceGetAttribute(&cus, hipDeviceAttributeMultiprocessorCount, dev) != hipSuccess) { grid = -1; return; }
        if (hipFuncSetAttribute((const void*)mk_fwd, hipFuncAttributeMaxDynamicSharedMemorySize, LDS_BYTES) != hipSuccess) { fprintf(stderr, "kernel_launch: hipFuncSetAttribute failed\n"); grid = -1; return; }
        int per_cu = 0;
        if (hipOccupancyMaxActiveBlocksPerMultiprocessor(&per_cu, (const void*)mk_fwd, NTHR, LDS_BYTES) != hipSuccess || per_cu < 1) { fprintf(stderr, "kernel_launch: occupancy query says %d\n", per_cu); }
        (void)hipGetLastError();
        grid = cus;
    }
    if (grid < 0) return;
    if (hipMemsetAsync((char*)d_ws + WS_CTL, 0, CTL_ZERO_BYTES, stream) != hipSuccess) return;
    Args a{};
    for (int i = 0; i < 34; ++i) a.in[i] = (const float*)d_in[i];
    a.out = (float*)d_out; a.ws = (unsigned char*)d_ws;
#if MK_PER_PHASE
    for (int p = 0; p < NPH; ++p) { a.ph_lo = p; a.ph_hi = p + 1; hipLaunchKernelGGL(mk_fwd, dim3(grid), dim3(NTHR), LDS_BYTES, stream, a); }
#else
    a.ph_lo = 0; a.ph_hi = NPH;
    hipLaunchKernelGGL(mk_fwd, dim3(grid), dim3(NTHR), LDS_BYTES, stream, a);
#endif
}
```

```cpp
#include <hip/hip_runtime.h>
#include <hip/hip_bf16.h>
#include <cstdio>
#include <cstdint>
#include <cmath>
#ifndef MOE_FP8
#define MOE_FP8 1
#endif
#ifndef MK_PER_PHASE
#define MK_PER_PHASE 0
#endif
namespace pg8 {
#define PG8_LAS __attribute__((address_space(3)))
typedef unsigned short bf16_t;
typedef short bf16x8 __attribute__((ext_vector_type(8)));
typedef float f32x4 __attribute__((ext_vector_type(4)));
typedef unsigned u32x4 __attribute__((ext_vector_type(4)));
constexpr int BM = 256, BK = 64, HALF = 128, HTB = HALF * BK * 2  , STAGE_BYTES = 8 * HTB, NXCD = 8, WGM = 8;

__host__ __device__ __forceinline__ int lds_byte(int r, int c) { const int st = (r >> 4) * 2 + (c >> 5), rr = r & 15, cc = c & 31, ob = rr * 64 + cc * 2; return st * 1024 + (ob ^ (((ob >> 9) & 1) << 5)); }
__host__ __device__ __forceinline__ void stage_rc(int b, int& R, int& C) { const int st = b / 1024, sb = b % 1024, swz = sb ^ (((sb >> 9) & 1) << 5); R = (st >> 1) * 16 + swz / 64; C = (st & 1) * 32 + (swz % 64) / 2; }
__host__ __device__ __forceinline__ int perm32(int rho) { const int n = rho >> 4, i = rho & 15; return 8 * (i >> 2) + 4 * n + (i & 3); }

struct Unit { int pm, pn, be, e; };
struct Gemm { const bf16_t* A; const bf16_t* Bt; int M, N, K; };

struct StaticOrder {
    static constexpr bool GATHER = false;
    __device__ __forceinline__ int row_of(int r) const { return r; }
    int nM, nN, nwg, G, c;
    __host__ __device__ void init(int M, int N, int G_, int c_) { nM = M / BM; nN = N / BM; nwg = nM * nN; G = G_; c = c_; }
    __host__ __device__ bool next(int i, Unit& u) const {
        const long L = (long)i * G + c; if (L >= nwg) return false;
        int wgid = (int)L; { const int q = nwg / NXCD, r = nwg % NXCD, xcd = wgid % NXCD, off = wgid / NXCD; wgid = (xcd < r ? xcd * (q + 1) : r * (q + 1) + (xcd - r) * q) + off; }
        const int nig = WGM * nN, gid = wgid / nig, fm = gid * WGM, gsz = (nM - fm) < WGM ? (nM - fm) : WGM;
        u.pm = fm + ((wgid % nig) % gsz); u.pn = (wgid % nig) / gsz; u.be = u.pn; u.e = 0; return true;
    }
    __device__ __forceinline__ void a_ready(const Unit&) const {}
    __device__ __forceinline__ void done(const Unit&) const {}
};

__device__ __forceinline__ unsigned cvt_pk_bf16(float lo, float hi) { unsigned r; asm volatile("v_cvt_pk_bf16_f32 %0, %1, %2" : "=v"(r) : "v"(lo), "v"(hi)); return r; }
__device__ __forceinline__ unsigned pack4_fp8(float a, float b, float c, float d) {
    a = fminf(fmaxf(a, -448.f), 448.f); b = fminf(fmaxf(b, -448.f), 448.f); c = fminf(fmaxf(c, -448.f), 448.f); d = fminf(fmaxf(d, -448.f), 448.f);
    int w = 0; w = __builtin_amdgcn_cvt_pk_fp8_f32(a, b, w, false); w = __builtin_amdgcn_cvt_pk_fp8_f32(c, d, w, true); return (unsigned)w;
}
constexpr float F8_SF = 16.f, F8_SW = 64.f, F8_SA = 4.f, F8_SY = 32.f;
typedef float f32x2 __attribute__((ext_vector_type(2)));
__device__ __forceinline__ f32x2 gelu_pk(f32x2 v) {
    const f32x2 av = __builtin_elementwise_abs(v), d = av * 0.2316418882f + 1.0f;
    f32x2 t; t.x = __builtin_amdgcn_rcpf(d.x); t.y = __builtin_amdgcn_rcpf(d.y);
    f32x2 q = t * 0.5307027145f + (-0.7265760135f); q = q * t + 0.7107068705f; q = q * t + (-0.142248368f); q = q * t + 0.127414796f; q = q * t;
    const f32x2 s = (v * v) * (-0.72134752044f);
    f32x2 e; e.x = __builtin_amdgcn_exp2f(s.x); e.y = __builtin_amdgcn_exp2f(s.y);
    const f32x2 m = v * (q * e), r = v - m;
    f32x2 o; o.x = v.x < 0.f ? m.x : r.x; o.y = v.y < 0.f ? m.y : r.y; return o;
}

template <int ACT  > struct EpiBf16 {
    static constexpr bool PERM = true, AFTER_DRAIN = false; static_assert(ACT == 0 || ACT == 1, "EpiBf16: ACT is 0 (none) or 1 (gelu_pk)");
    bf16_t* O; int ldc; const float* bias; int split_cols; size_t split_stride; float scale0;
    struct Pre {}; __device__ __forceinline__ void preload(Pre&, const Unit&, int, int, int, int) const {}
    __device__ __forceinline__ void operator()(const f32x4 (&acc)[2][2][4][2], const Unit& u, int wr, int wc, int fr, int fq, const Pre&) const {
        const int row0 = u.pm * BM + wr * 64 + fr; int colt = u.pn * BM; bf16_t* base = O;
        float sc = 1.f; if (split_cols) { const int t = colt / split_cols; base += (size_t)t * split_stride; colt -= t * split_cols; if (t == 0) sc = scale0; }
        const int col0 = colt + wc * 32 + 8 * fq, bcol0 = u.pn * BM + wc * 32 + 8 * fq;
        f32x4 bv[2][2];
#pragma unroll
        for (int bj = 0; bj < 2; ++bj)
#pragma unroll
            for (int n = 0; n < 2; ++n) bv[bj][n] = bias ? *(const f32x4*)(bias + bcol0 + bj * HALF + 4 * n) : (f32x4){0.f, 0.f, 0.f, 0.f};
#pragma unroll
        for (int ai = 0; ai < 2; ++ai)
#pragma unroll
            for (int m = 0; m < 4; ++m) { bf16_t* rowp = base + (size_t)(row0 + ai * HALF + m * 16) * ldc + col0;
#pragma unroll
                for (int bj = 0; bj < 2; ++bj) { f32x4 v0 = acc[ai][bj][m][0] + bv[bj][0], v1 = acc[ai][bj][m][1] + bv[bj][1];
                    if (ACT == 1) { f32x2 a = gelu_pk((f32x2){v0[0], v0[1]}), b = gelu_pk((f32x2){v0[2], v0[3]}), c = gelu_pk((f32x2){v1[0], v1[1]}), d = gelu_pk((f32x2){v1[2], v1[3]});
                        v0 = (f32x4){a.x, a.y, b.x, b.y}; v1 = (f32x4){c.x, c.y, d.x, d.y}; }
                    v0 = v0 * sc; v1 = v1 * sc; u32x4 w; w.x = cvt_pk_bf16(v0[0], v0[1]); w.y = cvt_pk_bf16(v0[2], v0[3]); w.z = cvt_pk_bf16(v1[0], v1[1]); w.w = cvt_pk_bf16(v1[2], v1[3]);
                    *(u32x4*)(rowp + bj * HALF) = w; } }
    }
};


template <bool XIN_BF16> struct EpiResid {
    static constexpr bool PERM = false, AFTER_DRAIN = false;
    const float* xin_lat; const float* xin_ctx; int nlat; bf16_t* XR; int ldc; const float* mod; int mod_stride; int seq; float* rssp;
    struct Pre {}; __device__ __forceinline__ void preload(Pre&, const Unit&, int, int, int, int) const {}
    __device__ __forceinline__ void operator()(const f32x4 (&acc)[2][2][4][2], const Unit& u, int wr, int wc, int fr, int fq, const Pre&) const {
        typedef unsigned u32x2 __attribute__((ext_vector_type(2)));
        const int row0 = u.pm * BM + wr * 64 + fr, col0 = u.pn * BM + wc * 32 + 4 * fq;
        const int rowt = u.pm * BM; const int bidx = rowt < nlat ? rowt / seq : 4;
        const float* gate = mod + (size_t)bidx * mod_stride;
        const float* xin = rowt < nlat ? xin_lat : (xin_ctx - (size_t)nlat * ldc);
        f32x4 gv[2][2];
#pragma unroll
        for (int bj = 0; bj < 2; ++bj)
#pragma unroll
            for (int n = 0; n < 2; ++n) gv[bj][n] = *(const f32x4*)(gate + col0 + bj * HALF + n * 16);
#pragma unroll
        for (int ai = 0; ai < 2; ++ai)
#pragma unroll
            for (int m = 0; m < 4; ++m) { const int row = row0 + ai * HALF + m * 16; const size_t ro = (size_t)row * ldc + col0; float s2 = 0.f;
#pragma unroll
                for (int bj = 0; bj < 2; ++bj)
#pragma unroll
                    for (int n = 0; n < 2; ++n) { const size_t idx = ro + bj * HALF + n * 16; f32x4 xv;
                        if (XIN_BF16) { const u32x2 w = *(const u32x2*)(XR + idx); xv = (f32x4){__builtin_bit_cast(float, w.x << 16), __builtin_bit_cast(float, w.x & 0xffff0000u), __builtin_bit_cast(float, w.y << 16), __builtin_bit_cast(float, w.y & 0xffff0000u)}; }
                        else xv = *(const f32x4*)(xin + idx);
                        const f32x4 v = xv + gv[bj][n] * acc[ai][bj][m][n];
                        s2 += (v[0] * v[0] + v[1] * v[1]) + (v[2] * v[2] + v[3] * v[3]);
                        u32x2 o; o.x = cvt_pk_bf16(v[0], v[1]); o.y = cvt_pk_bf16(v[2], v[3]); *(u32x2*)(XR + idx) = o; }
                s2 += __shfl_xor(s2, 16); s2 += __shfl_xor(s2, 32);
                if (fq == 0) rssp[(size_t)row * 16 + u.pn * 4 + wc] = s2; }
    }
};
struct EpiSwiglu {
    static constexpr bool PERM = true, AFTER_DRAIN = false;
    bf16_t* O; int ldc; const float* bias; int bias_stride;
    struct Pre { unsigned bw[2][2][2]; };
    __device__ __forceinline__ void preload(Pre& p, const Unit& u, int wr, int wc, int fr, int fq) const {
        const float* bb = bias + (size_t)u.e * bias_stride + u.pn * BM + wc * 32 + 8 * fq;
#pragma unroll
        for (int bj = 0; bj < 2; ++bj)
#pragma unroll
            for (int n = 0; n < 2; ++n) { const f32x4 v = *(const f32x4*)(bb + bj * HALF + 4 * n); p.bw[bj][n][0] = cvt_pk_bf16(v[0], v[1]); p.bw[bj][n][1] = cvt_pk_bf16(v[2], v[3]); }
    }
    __device__ __forceinline__ void operator()(const f32x4 (&acc)[2][2][4][2], const Unit& u, int wr, int wc, int fr, int fq, const Pre& pre) const {
        const int row0 = u.pm * BM + wr * 64 + fr; const int bcol0 = u.pn * BM + wc * 32 + 8 * fq; const int ocol0 = bcol0 >> 1;
        f32x4 bv[2][2];
#pragma unroll
        for (int bj = 0; bj < 2; ++bj)
#pragma unroll
            for (int n = 0; n < 2; ++n) { const unsigned w0 = pre.bw[bj][n][0], w1 = pre.bw[bj][n][1];
                bv[bj][n] = (f32x4){__builtin_bit_cast(float, w0 << 16), __builtin_bit_cast(float, w0 & 0xffff0000u), __builtin_bit_cast(float, w1 << 16), __builtin_bit_cast(float, w1 & 0xffff0000u)}; }
#pragma unroll
        for (int ai = 0; ai < 2; ++ai)
#pragma unroll
            for (int m = 0; m < 4; ++m) { bf16_t* rowp = O + (size_t)(row0 + ai * HALF + m * 16) * ldc + ocol0;
#pragma unroll
                for (int bj = 0; bj < 2; ++bj) { const f32x4 v0 = acc[ai][bj][m][0] + bv[bj][0], v1 = acc[ai][bj][m][1] + bv[bj][1];
                    float o[4];
#pragma unroll
                    for (int p = 0; p < 4; ++p) { const float hg = p < 2 ? v0[2 * p] : v1[2 * p - 4], hl = p < 2 ? v0[2 * p + 1] : v1[2 * p - 3];
                        const float glu = fminf(hg, 7.0f), lin = fminf(fmaxf(hl, -7.0f), 7.0f);
                        const float sg = __builtin_amdgcn_rcpf(1.0f + __builtin_amdgcn_exp2f(-1.702f * 1.4426950408889634f * glu));
                        o[p] = glu * sg * (lin + 1.0f); }
                    typedef unsigned u32x2 __attribute__((ext_vector_type(2)));
                    u32x2 w; w.x = cvt_pk_bf16(o[0], o[1]); w.y = cvt_pk_bf16(o[2], o[3]);
                    *(u32x2*)(rowp + bj * (HALF / 2)) = w; } }
    }
};
struct EpiSwigluF8 {
    static constexpr bool PERM = true, AFTER_DRAIN = false;
    bf16_t* O; int ldc; const float* bias; int bias_stride;
    struct Pre { unsigned bw[2][2][2]; };
    __device__ __forceinline__ void preload(Pre& p, const Unit& u, int wr, int wc, int fr, int fq) const {
        const float* bb = bias + (size_t)u.e * bias_stride + u.pn * BM + wc * 32 + 8 * fq;
#pragma unroll
        for (int bj = 0; bj < 2; ++bj)
#pragma unroll
            for (int n = 0; n < 2; ++n) { const f32x4 v = *(const f32x4*)(bb + bj * HALF + 4 * n); p.bw[bj][n][0] = cvt_pk_bf16(v[0], v[1]); p.bw[bj][n][1] = cvt_pk_bf16(v[2], v[3]); }
    }
    __device__ __forceinline__ void operator()(const f32x4 (&acc)[2][2][4][2], const Unit& u, int wr, int wc, int fr, int fq, const Pre& pre) const {
        asm volatile("" : "+v"(fr), "+v"(fq));
        const int row0 = u.pm * BM + wr * 64 + fr; const int bcol0 = u.pn * BM + wc * 32 + 8 * fq; const int ocol0 = bcol0 >> 1;
        f32x4 bv[2][2];
#pragma unroll
        for (int bj = 0; bj < 2; ++bj)
#pragma unroll
            for (int n = 0; n < 2; ++n) { const unsigned w0 = pre.bw[bj][n][0], w1 = pre.bw[bj][n][1];
                bv[bj][n] = (f32x4){__builtin_bit_cast(float, w0 << 16), __builtin_bit_cast(float, w0 & 0xffff0000u), __builtin_bit_cast(float, w1 << 16), __builtin_bit_cast(float, w1 & 0xffff0000u)}; }
#pragma unroll
        for (int ai = 0; ai < 2; ++ai)
#pragma unroll
            for (int m = 0; m < 4; ++m) {
#pragma unroll
                for (int bj = 0; bj < 2; ++bj) { const f32x4 v0 = acc[ai][bj][m][0] * (1.0f / (F8_SF * F8_SW)) + bv[bj][0], v1 = acc[ai][bj][m][1] * (1.0f / (F8_SF * F8_SW)) + bv[bj][1];
                    float o[4];
#pragma unroll
                    for (int p = 0; p < 4; ++p) { const float hg = p < 2 ? v0[2 * p] : v1[2 * p - 4], hl = p < 2 ? v0[2 * p + 1] : v1[2 * p - 3];
                        const float glu = fminf(hg, 7.0f), lin = fminf(fmaxf(hl, -7.0f), 7.0f);
                        const float sg = __builtin_amdgcn_rcpf(1.0f + __builtin_amdgcn_exp2f(-1.702f * 1.4426950408889634f * glu));
                        o[p] = glu * sg * (lin + 1.0f); }
                    *(unsigned*)((unsigned char*)O + (size_t)(row0 + ai * HALF + m * 16) * ldc + ocol0 + bj * (HALF / 2)) = pack4_fp8(o[0] * F8_SA, o[1] * F8_SA, o[2] * F8_SA, o[3] * F8_SA); } }
    }
};
struct EpiBf16Bias {
    static constexpr bool PERM = true, AFTER_DRAIN = false;
    bf16_t* O; int ldc; const float* bias; int bias_stride;
    struct Pre { f32x4 bv[2][2]; };
    __device__ __forceinline__ void preload(Pre& p, const Unit& u, int wr, int wc, int fr, int fq) const {
        const float* bb = bias + (size_t)u.e * bias_stride + u.pn * BM + wc * 32 + 8 * fq;
#pragma unroll
        for (int bj = 0; bj < 2; ++bj)
#pragma unroll
            for (int n = 0; n < 2; ++n) p.bv[bj][n] = *(const f32x4*)(bb + bj * HALF + 4 * n);
    }
    __device__ __forceinline__ void operator()(const f32x4 (&acc)[2][2][4][2], const Unit& u, int wr, int wc, int fr, int fq, const Pre& pre) const {
        const int row0 = u.pm * BM + wr * 64 + fr; const int col0 = u.pn * BM + wc * 32 + 8 * fq;
#pragma unroll
        for (int ai = 0; ai < 2; ++ai)
#pragma unroll
            for (int m = 0; m < 4; ++m) { bf16_t* rowp = O + (size_t)(row0 + ai * HALF + m * 16) * ldc + col0;
#pragma unroll
                for (int bj = 0; bj < 2; ++bj) { const f32x4 v0 = acc[ai][bj][m][0] + pre.bv[bj][0], v1 = acc[ai][bj][m][1] + pre.bv[bj][1];
                    u32x4 w; w.x = cvt_pk_bf16(v0[0], v0[1]); w.y = cvt_pk_bf16(v0[2], v0[3]); w.z = cvt_pk_bf16(v1[0], v1[1]); w.w = cvt_pk_bf16(v1[2], v1[3]);
                    *(u32x4*)(rowp + bj * HALF) = w; } }
    }
};
struct EpiBf16BiasFold {
    static constexpr bool PERM = true, AFTER_DRAIN = false;
    bf16_t* O; int ldc; const float* bias; int bias_stride;
    struct Pre { f32x4 bv[2][2]; };
    __device__ __forceinline__ void preload(Pre& p, const Unit& u, int wr, int wc, int fr, int fq) const {
        const float* bb = bias + (size_t)u.e * bias_stride + u.pn * BM + wc * 32 + 8 * fq;
#pragma unroll
        for (int bj = 0; bj < 2; ++bj)
#pragma unroll
            for (int n = 0; n < 2; ++n) p.bv[bj][n] = *(const f32x4*)(bb + bj * HALF + 4 * n);
    }
    __device__ __forceinline__ void operator()(const f32x4 (&acc)[2][2][4][2], const Unit& u, int wr, int wc, int fr, int fq, const Pre& pre) const {
        const int row0 = u.pm * BM + wr * 64 + fr; const int col0 = u.pn * BM + wc * 32 + 8 * fq;
#pragma unroll
        for (int ai = 0; ai < 2; ++ai)
#pragma unroll
            for (int m = 0; m < 4; ++m) { bf16_t* rowp = O + (size_t)((row0 + ai * HALF + m * 16) & 255) * ldc + col0;
#pragma unroll
                for (int bj = 0; bj < 2; ++bj) { const f32x4 v0 = acc[ai][bj][m][0] + pre.bv[bj][0], v1 = acc[ai][bj][m][1] + pre.bv[bj][1];
                    u32x4 w; w.x = cvt_pk_bf16(v0[0], v0[1]); w.y = cvt_pk_bf16(v0[2], v0[3]); w.z = cvt_pk_bf16(v1[0], v1[1]); w.w = cvt_pk_bf16(v1[2], v1[3]);
                    *(u32x4*)(rowp + bj * HALF) = w; } }
    }
};
struct EpiBf16BiasF8 {
    static constexpr bool PERM = true, AFTER_DRAIN = false;
    bf16_t* O; int ldc; const float* bias; int bias_stride;
    struct Pre { f32x4 bv[2][2]; };
    __device__ __forceinline__ void preload(Pre& p, const Unit& u, int wr, int wc, int fr, int fq) const {
        const float* bb = bias + (size_t)u.e * bias_stride + u.pn * BM + wc * 32 + 8 * fq;
#pragma unroll
        for (int bj = 0; bj < 2; ++bj)
#pragma unroll
            for (int n = 0; n < 2; ++n) p.bv[bj][n] = *(const f32x4*)(bb + bj * HALF + 4 * n);
    }
    __device__ __forceinline__ void operator()(const f32x4 (&acc)[2][2][4][2], const Unit& u, int wr, int wc, int fr, int fq, const Pre& pre) const {
        asm volatile("" : "+v"(fr), "+v"(fq));
        const int row0 = u.pm * BM + wr * 64 + fr; const int col0 = u.pn * BM + wc * 32 + 8 * fq;
#pragma unroll
        for (int ai = 0; ai < 2; ++ai)
#pragma unroll
            for (int m = 0; m < 4; ++m) { bf16_t* rowp = O + (size_t)(row0 + ai * HALF + m * 16) * ldc + col0;
#pragma unroll
                for (int bj = 0; bj < 2; ++bj) { const f32x4 v0 = acc[ai][bj][m][0] * (1.0f / (F8_SA * F8_SW)) + pre.bv[bj][0], v1 = acc[ai][bj][m][1] * (1.0f / (F8_SA * F8_SW)) + pre.bv[bj][1];
                    u32x4 w; w.x = cvt_pk_bf16(v0[0], v0[1]); w.y = cvt_pk_bf16(v0[2], v0[3]); w.z = cvt_pk_bf16(v1[0], v1[1]); w.w = cvt_pk_bf16(v1[2], v1[3]);
                    *(u32x4*)(rowp + bj * HALF) = w; } }
    }
};
struct EpiF8BiasF8 {
    static constexpr bool PERM = true, AFTER_DRAIN = false;
    bf16_t* O; int ldc; const float* bias; int bias_stride;
    struct Pre { f32x4 bv[2][2]; };
    __device__ __forceinline__ void preload(Pre& p, const Unit& u, int wr, int wc, int fr, int fq) const {
        const float* bb = bias + (size_t)u.e * bias_stride + u.pn * BM + wc * 32 + 8 * fq;
#pragma unroll
        for (int bj = 0; bj < 2; ++bj)
#pragma unroll
            for (int n = 0; n < 2; ++n) p.bv[bj][n] = *(const f32x4*)(bb + bj * HALF + 4 * n);
    }
    __device__ __forceinline__ void operator()(const f32x4 (&acc)[2][2][4][2], const Unit& u, int wr, int wc, int fr, int fq, const Pre& pre) const {
        asm volatile("" : "+v"(fr), "+v"(fq));
        const int row0 = u.pm * BM + wr * 64 + fr; const int col0 = u.pn * BM + wc * 32 + 8 * fq;
#pragma unroll
        for (int ai = 0; ai < 2; ++ai)
#pragma unroll
            for (int m = 0; m < 4; ++m) { unsigned char* rowp = (unsigned char*)O + (size_t)(row0 + ai * HALF + m * 16) * ldc + col0;
#pragma unroll
                for (int bj = 0; bj < 2; ++bj) { const f32x4 v0 = (acc[ai][bj][m][0] * (1.0f / (F8_SA * F8_SW)) + pre.bv[bj][0]) * F8_SY, v1 = (acc[ai][bj][m][1] * (1.0f / (F8_SA * F8_SW)) + pre.bv[bj][1]) * F8_SY;
                    typedef unsigned u32x2 __attribute__((ext_vector_type(2)));
                    u32x2 w; w.x = pack4_fp8(v0[0], v0[1], v0[2], v0[3]); w.y = pack4_fp8(v1[0], v1[1], v1[2], v1[3]);
                    *(u32x2*)(rowp + bj * HALF) = w; } }
    }
};
struct EpiLruGate {
    static constexpr bool PERM = false, AFTER_DRAIN = false;
    const bf16_t* XL; bf16_t* LAB; size_t lab_stride; const float* gb; const float* spt;
    struct Pre {}; __device__ __forceinline__ void preload(Pre&, const Unit&, int, int, int, int) const {}
    __device__ __forceinline__ void operator()(const f32x4 (&acc)[2][2][4][2], const Unit& u, int wr, int wc, int fr, int fq, const Pre&) const {
        const int d = u.pn >> 1, half = u.pn & 1;
        const int row0 = u.pm * BM + wr * 64 + fr, ch0 = half * 128 + wc * 32 + 4 * fq;
        bf16_t* LA = LAB + (size_t)(2 * d) * lab_stride; bf16_t* LB = LAB + (size_t)(2 * d + 1) * lab_stride;
#pragma unroll
        for (int n = 0; n < 2; ++n) {
            const f32x4 bR = *(const f32x4*)(gb + (d * 2 + 0) * 256 + ch0 + 16 * n), bI = *(const f32x4*)(gb + (d * 2 + 1) * 256 + ch0 + 16 * n);
            const f32x4 sp = *(const f32x4*)(spt + d * 256 + ch0 + 16 * n) * (-8.0f * 1.4426950408889634f);
#pragma unroll
            for (int ai = 0; ai < 2; ++ai)
#pragma unroll
                for (int m = 0; m < 4; ++m) { const size_t ro = (size_t)(row0 + ai * HALF + m * 16) * 256 + ch0 + 16 * n;
                    typedef unsigned u32x2 __attribute__((ext_vector_type(2)));
                    const u32x2 xw = *(const u32x2*)(XL + ro);
                    const float xl[4] = {__builtin_bit_cast(float, xw.x << 16), __builtin_bit_cast(float, xw.x & 0xffff0000u), __builtin_bit_cast(float, xw.y << 16), __builtin_bit_cast(float, xw.y & 0xffff0000u)};
                    const f32x4 gr = acc[ai][0][m][n] + bR, gi = acc[ai][1][m][n] + bI;
                    f32x4 av, bv;
#pragma unroll
                    for (int e = 0; e < 4; ++e) {
                        const float rg = __builtin_amdgcn_rcpf(1.0f + __builtin_amdgcn_exp2f(-1.4426950408889634f * gr[e])), ig = __builtin_amdgcn_rcpf(1.0f + __builtin_amdgcn_exp2f(-1.4426950408889634f * gi[e]));
                        const float la2 = rg * sp[e];
                        const float a2 = __builtin_amdgcn_exp2f(2.0f * la2);
                        av[e] = la2; bv[e] = __builtin_amdgcn_sqrtf(fmaxf(1.0f - a2, 0.f)) * (ig * xl[e]); }
                    u32x2 wa, wb; wa.x = cvt_pk_bf16(av[0], av[1]); wa.y = cvt_pk_bf16(av[2], av[3]); wb.x = cvt_pk_bf16(bv[0], bv[1]); wb.y = cvt_pk_bf16(bv[2], bv[3]);
                    *(u32x2*)(LA + ro) = wa; *(u32x2*)(LB + ro) = wb; }
        }
    }
};
struct EpiNone {
    static constexpr bool PERM = true, AFTER_DRAIN = false;
    struct Pre {}; __device__ __forceinline__ void preload(Pre&, const Unit&, int, int, int, int) const {}
    __device__ __forceinline__ void operator()(const f32x4 (&acc)[2][2][4][2], const Unit& u, int wr, int wc, int fr, int fq, const Pre&) const {
#pragma unroll
        for (int a = 0; a < 2; ++a)
#pragma unroll
            for (int b2 = 0; b2 < 2; ++b2)
#pragma unroll
                for (int m = 0; m < 4; ++m)
#pragma unroll
                    for (int n = 0; n < 2; ++n) { f32x4 v = acc[a][b2][m][n]; asm volatile("" :: "v"(v)); }
    }
};
template <bool GATHER_> struct MoeOrderT {
    static constexpr bool GATHER = GATHER_;
    const int* rowtok;
    __device__ __forceinline__ int row_of(int r) const { return GATHER_ ? rowtok[r] : r; }
    const PG8_LAS int* tab; int ntiles, nN, nper, j, m_lo, nMx, wgm, rev;
    __device__ __forceinline__ void init(const PG8_LAS int* tab_, int ntiles_, int nN_, int G, int bx, int wgm_) {
        tab = tab_; ntiles = ntiles_; nN = nN_; wgm = wgm_; rev = 0;
        if (G % 8 == 0) { const int x = bx % 8; nper = G / 8; j = bx / 8; m_lo = (x * ntiles) / 8; nMx = ((x + 1) * ntiles) / 8 - m_lo; }
        else { nper = G; j = bx; m_lo = 0; nMx = ntiles; }
    }
    __device__ __forceinline__ bool next(int i, Unit& u) const {
        const int s = i * nper + j; if (s >= nMx * nN) return false;
        const int nig = wgm * nN, gid = s / nig, fm = gid * wgm, gsz = (nMx - fm) < wgm ? (nMx - fm) : wgm, w = s - gid * nig;
        const int mi = fm + (w % gsz); u.pm = m_lo + (rev ? (nMx - 1 - mi) : mi); u.pn = w / gsz; u.e = tab[u.pm]; u.be = u.e * nN + u.pn; return true;
    }
    __device__ __forceinline__ void a_ready(const Unit&) const {}
    __device__ __forceinline__ void done(const Unit&) const {}
};
template <class Epi, class Sched, bool ALIGN_EPI = false, bool SP2 = false, bool FP8 = false>
__device__ __forceinline__ void gemm_phase(PG8_LAS unsigned char* lds, const Gemm g, const Sched& S, const Epi& E) {
    int tid_ = threadIdx.x; asm volatile("" : "+v"(tid_));
    const int tid = tid_, wid = __builtin_amdgcn_readfirstlane(tid >> 6), lane = tid & 63, wr = wid >> 2, wc = wid & 3, fr = lane & 15, fq = lane >> 4;
    const int K = g.K, nt = K / BK;
    unsigned voffA[2], voffB[2];
#pragma unroll
    for (int i = 0; i < 2; ++i) { int R, C; stage_rc(tid * 16 + i * 8192, R, C); const int Rb = Epi::PERM ? ((R & ~31) + perm32(R & 31)) : R;
        voffA[i] = (unsigned)(R * K + C) * 2u; voffB[i] = (unsigned)(Rb * K + C) * 2u; }
    unsigned gA_[2] = {0u, 0u}, gN_[2] = {0u, 0u}, gC_[2] = {0u, 0u};
    static_assert(!Sched::GATHER || SP2, "the gathered A operand is wired into the SP2 loop only");
    if constexpr (Sched::GATHER) { _Pragma("unroll") for (int i_ = 0; i_ < 2; ++i_) { int R_, C_; stage_rc(tid * 16 + i_ * 8192, R_, C_); gC_[i_] = (unsigned)(C_ * 2); } }
#define PG8_GLOAD(dst, pm_) do { _Pragma("unroll") for (int h_ = 0; h_ < 2; ++h_) { unsigned t_[2]; _Pragma("unroll") for (int i_ = 0; i_ < 2; ++i_) { int R_, C_; stage_rc(tid * 16 + i_ * 8192, R_, C_); \
        t_[i_] = (unsigned)S.row_of((pm_) * BM + h_ * HALF + R_); } dst[h_] = t_[0] | (t_[1] << 16); } } while (0)
    const size_t kstep = (size_t)(BK * 2);
    const size_t hstep = (size_t)HALF * K * 2;
    const size_t tstep = 2 * hstep;
    const unsigned ldsw = (unsigned)wid * 1024u;
    const int aoff = lds_byte(wr * 64 + fr, fq * 8), boff = lds_byte(wc * 32 + fr, fq * 8);
#define PG8_SA(b, h) (((b) * 2 + (h)) * HTB)
#define PG8_SB(b, h) ((4 + (b) * 2 + (h)) * HTB)
#define PG8_STAGE(bufoff, gbase, voff) do { _Pragma("unroll") for (int _i = 0; _i < 2; ++_i) \
        __builtin_amdgcn_global_load_lds((const unsigned*)((const char*)(gbase) + (voff)[_i]), (PG8_LAS unsigned*)(lds + (bufoff) + ldsw + _i * 8192), 16, 0, 0); } while (0)
#define PG8_STA(bufoff, ptr, h, useN) do { if constexpr (Sched::GATHER) { const unsigned pk_ = (useN) ? gN_[h] : gA_[h]; unsigned o_[2] = {(pk_ & 0xffffu) * (unsigned)(K * 2) + gC_[0], (pk_ >> 16) * (unsigned)(K * 2) + gC_[1]}; PG8_STAGE(bufoff, ptr, o_); } \
        else { PG8_STAGE(bufoff, (ptr) + ((h) ? hstep : 0), voffA); } } while (0)
#define PG8_LDA(dst, b, h) do { _Pragma("unroll") for (int m = 0; m < 4; ++m) { if constexpr (FP8) { \
            dst##8[m] = __builtin_shufflevector(*(const PG8_LAS i32x4_*)(lds + PG8_SA(b, h) + aoff + m * 2048), *(const PG8_LAS i32x4_*)(lds + PG8_SA(b, h) + aoff + m * 2048 + 1024), 0, 1, 2, 3, 4, 5, 6, 7); } \
        else { _Pragma("unroll") for (int k = 0; k < 2; ++k) dst[m][k] = *(const PG8_LAS bf16x8*)(lds + PG8_SA(b, h) + aoff + m * 2048 + k * 1024); } } } while (0)
#define PG8_LDB(dst, b, h) do { _Pragma("unroll") for (int n = 0; n < 2; ++n) { if constexpr (FP8) { \
            dst##8[n] = __builtin_shufflevector(*(const PG8_LAS i32x4_*)(lds + PG8_SB(b, h) + boff + n * 2048), *(const PG8_LAS i32x4_*)(lds + PG8_SB(b, h) + boff + n * 2048 + 1024), 0, 1, 2, 3, 4, 5, 6, 7); } \
        else { _Pragma("unroll") for (int k = 0; k < 2; ++k) dst[n][k] = *(const PG8_LAS bf16x8*)(lds + PG8_SB(b, h) + boff + n * 2048 + k * 1024); } } } while (0)
#define PG8_MMA(ai, bj, At, Bt) do { __builtin_amdgcn_s_setprio(1); _Pragma("unroll") for (int m = 0; m < 4; ++m) _Pragma("unroll") for (int n = 0; n < 2; ++n) { \
        if constexpr (FP8) asm volatile("v_mfma_f32_16x16x128_f8f6f4 %0, %1, %2, %0" : "+v"(acc[ai][bj][m][n]) : "v"(Bt##8[n]), "v"(At##8[m]));   \
        else { _Pragma("unroll") for (int k = 0; k < 2; ++k) acc[ai][bj][m][n] = __builtin_amdgcn_mfma_f32_16x16x32_bf16(Bt[n][k], At[m][k], acc[ai][bj][m][n], 0, 0, 0); } } \
        __builtin_amdgcn_s_setprio(0); } while (0)
#define PG8_WAIT_V(n) asm volatile("s_waitcnt vmcnt(" #n ")" ::: "memory")
#define PG8_WAIT_L(n) asm volatile("s_waitcnt lgkmcnt(" #n ")" ::: "memory")
#define PG8_BAR __builtin_amdgcn_s_barrier()
#define PG8_SCHED __builtin_amdgcn_sched_barrier(0)
    Unit cur, nxt; int ui = 0;
    if (!S.next(0, cur)) return;
    f32x4 acc[2][2][4][2];
#pragma unroll
    for (int a = 0; a < 2; ++a)
#pragma unroll
        for (int b = 0; b < 2; ++b)
#pragma unroll
            for (int m = 0; m < 4; ++m)
#pragma unroll
                for (int n = 0; n < 2; ++n) acc[a][b][m][n] = (f32x4){0.f, 0.f, 0.f, 0.f};
    typedef int i32x4_ __attribute__((ext_vector_type(4))); typedef int i32x8_ __attribute__((ext_vector_type(8)));
    bf16x8 At[4][2], B0[2][2], B1[2][2]; i32x8_ At8[4], B08[2], B18[2];
    typename Epi::Pre pre;
    const char* cA = (const char*)g.A + (Sched::GATHER ? (size_t)0 : (size_t)cur.pm * tstep); if constexpr (Sched::GATHER) PG8_GLOAD(gA_, cur.pm);
    const char* cB = (const char*)g.Bt + (size_t)cur.be * tstep;
    S.a_ready(cur);
    if constexpr (SP2) {
        PG8_STAGE(PG8_SB(0, 0), cB, voffB); PG8_STAGE(PG8_SB(0, 1), cB + hstep, voffB); PG8_STA(PG8_SA(0, 0), cA, 0, false); PG8_STA(PG8_SA(0, 1), cA, 1, false);
        if (wr == 1) PG8_BAR;
        PG8_WAIT_V(2); PG8_BAR;
        PG8_STAGE(PG8_SB(1, 0), cB + kstep, voffB); PG8_STA(PG8_SA(1, 0), cA + kstep, 0, false); PG8_STAGE(PG8_SB(1, 1), cB + hstep + kstep, voffB);
        PG8_WAIT_V(6); PG8_BAR;
    } else {
        PG8_STAGE(PG8_SB(0, 0), cB, voffB); PG8_STAGE(PG8_SA(0, 0), cA, voffA); PG8_STAGE(PG8_SB(0, 1), cB + hstep, voffB); PG8_STAGE(PG8_SA(0, 1), cA + hstep, voffA);
        if (wr == 1) PG8_BAR;
        PG8_WAIT_V(4); PG8_BAR;
        PG8_STAGE(PG8_SB(1, 0), cB + kstep, voffB); PG8_STAGE(PG8_SA(1, 0), cA + kstep, voffA); PG8_STAGE(PG8_SB(1, 1), cB + hstep + kstep, voffB);
        PG8_WAIT_V(6); PG8_BAR;
    }
    for (;;) {
        const bool has_next = S.next(ui + 1, nxt);
        const char* nA = (has_next && !Sched::GATHER) ? (const char*)g.A + (size_t)nxt.pm * tstep : cA; const char* nB = has_next ? (const char*)g.Bt + (size_t)nxt.be * tstep : cB;
        if constexpr (Sched::GATHER) { if (has_next) PG8_GLOAD(gN_, nxt.pm); else { gN_[0] = gA_[0]; gN_[1] = gA_[1]; } }
        for (int t = 0; t < nt; t += 2) {
            const bool last = (t == nt - 2);
            const char* a1 = cA + (size_t)(t + 1) * kstep;
            const char* a2 = last ? nA : cA + (size_t)(t + 2) * kstep; const char* b2 = last ? nB : cB + (size_t)(t + 2) * kstep;
            const char* a3 = a2 + kstep; const char* b3 = b2 + kstep;
            if (last) E.preload(pre, cur, wr, wc, fr, fq);
            if (last && has_next) S.a_ready(nxt);
            if constexpr (SP2) {
            PG8_LDB(B0, 0, 0); PG8_LDB(B1, 0, 1); PG8_SCHED; PG8_LDA(At, 0, 0); PG8_STA(PG8_SA(1, 1), a1, 1, false);
            PG8_WAIT_V(8); PG8_WAIT_L(0); PG8_BAR; PG8_MMA(0, 0, At, B0); PG8_MMA(0, 1, At, B1); PG8_BAR; PG8_SCHED;
            PG8_LDA(At, 0, 1); PG8_STAGE(PG8_SB(0, 0), b2, voffB); PG8_STAGE(PG8_SB(0, 1), b2 + hstep, voffB); PG8_STA(PG8_SA(0, 0), a2, 0, last);
            PG8_WAIT_V(8); PG8_WAIT_L(0); PG8_BAR; PG8_MMA(1, 0, At, B0); PG8_MMA(1, 1, At, B1); PG8_BAR; PG8_SCHED;
            PG8_LDB(B0, 1, 0); PG8_LDB(B1, 1, 1); PG8_SCHED; PG8_LDA(At, 1, 0); PG8_STA(PG8_SA(0, 1), a2, 1, last);
            PG8_WAIT_V(8); PG8_WAIT_L(0); PG8_BAR; PG8_MMA(0, 0, At, B0); PG8_MMA(0, 1, At, B1); PG8_BAR; PG8_SCHED;
            PG8_LDA(At, 1, 1); PG8_STAGE(PG8_SB(1, 0), b3, voffB); PG8_STAGE(PG8_SB(1, 1), b3 + hstep, voffB); PG8_STA(PG8_SA(1, 0), a3, 0, last);
            PG8_WAIT_V(8); PG8_WAIT_L(0); PG8_BAR; PG8_MMA(1, 0, At, B0); PG8_MMA(1, 1, At, B1); PG8_BAR; PG8_SCHED;
            } else {
            PG8_LDB(B0, 0, 0); PG8_SCHED; PG8_LDA(At, 0, 0); PG8_STAGE(PG8_SA(1, 1), a1 + hstep, voffA);
            PG8_WAIT_L(8); PG8_BAR; PG8_WAIT_L(0); PG8_MMA(0, 0, At, B0); PG8_BAR; PG8_SCHED;
            PG8_LDB(B1, 0, 1); PG8_STAGE(PG8_SB(0, 0), b2, voffB);
            PG8_BAR; PG8_WAIT_L(0); PG8_MMA(0, 1, At, B1); PG8_BAR;
            PG8_LDA(At, 0, 1); PG8_STAGE(PG8_SA(0, 0), a2, voffA);
            PG8_BAR; PG8_WAIT_L(0); PG8_MMA(1, 0, At, B0); PG8_BAR; PG8_SCHED;
            PG8_STAGE(PG8_SB(0, 1), b2 + hstep, voffB);
            PG8_WAIT_V(6); PG8_BAR; PG8_MMA(1, 1, At, B1); PG8_BAR;
            PG8_LDB(B0, 1, 0); PG8_SCHED; PG8_LDA(At, 1, 0); PG8_STAGE(PG8_SA(0, 1), a2 + hstep, voffA);
            PG8_WAIT_L(8); PG8_BAR; PG8_WAIT_L(0); PG8_MMA(0, 0, At, B0); PG8_BAR; PG8_SCHED;
            PG8_LDB(B1, 1, 1); PG8_STAGE(PG8_SB(1, 0), b3, voffB);
            PG8_BAR; PG8_WAIT_L(0); PG8_MMA(0, 1, At, B1); PG8_BAR;
            PG8_LDA(At, 1, 1); PG8_STAGE(PG8_SA(1, 0), a3, voffA);
            PG8_BAR; PG8_WAIT_L(0); PG8_MMA(1, 0, At, B0); PG8_BAR; PG8_SCHED;
            PG8_STAGE(PG8_SB(1, 1), b3 + hstep, voffB);
            PG8_WAIT_V(6); PG8_BAR; PG8_MMA(1, 1, At, B1); PG8_BAR;
            }
        }
        if constexpr (ALIGN_EPI) { if (wr == 0) PG8_BAR; }
        if constexpr (!Epi::AFTER_DRAIN) { E(acc, cur, wr, wc, fr, fq, pre); S.done(cur); }
        if (!has_next) break;
#pragma unroll
        for (int a = 0; a < 2; ++a)
#pragma unroll
            for (int b = 0; b < 2; ++b)
#pragma unroll
                for (int m = 0; m < 4; ++m)
#pragma unroll
                    for (int n = 0; n < 2; ++n) acc[a][b][m][n] = (f32x4){0.f, 0.f, 0.f, 0.f};
        cur = nxt; cA = nA; cB = nB; ++ui;
        if constexpr (Sched::GATHER) { gA_[0] = gN_[0]; gA_[1] = gN_[1]; }
        if constexpr (ALIGN_EPI) { if (wr == 1) PG8_BAR; }
    }
    PG8_WAIT_V(0);
    if constexpr (!ALIGN_EPI) { if (wr == 0) PG8_BAR; }
    PG8_BAR;
    if constexpr (Epi::AFTER_DRAIN) { E.fused(acc, cur, wr, wc, fr, fq, lds, wid, lane); S.done(cur); }
#undef PG8_SA
#undef PG8_SB
#undef PG8_STAGE
#undef PG8_STA
#undef PG8_GLOAD
#undef PG8_LDA
#undef PG8_LDB
#undef PG8_MMA
#undef PG8_WAIT_V
#undef PG8_WAIT_L
#undef PG8_BAR
#undef PG8_SCHED
}
}

#ifndef PG8_SP2
#define PG8_SP2 true
#endif
#ifndef PG8_ALIGN
#define PG8_ALIGN true
#endif
#include <cmath>
namespace attn_body {
using bf16=__hip_bfloat16;
using bf16x8=__attribute__((ext_vector_type(8)))short;
using s16x4=__attribute__((ext_vector_type(4)))short;
using f32x16=__attribute__((ext_vector_type(16)))float;
using u32x4=__attribute__((ext_vector_type(4)))unsigned;
using f32x4_t=__attribute__((ext_vector_type(4)))float;
constexpr int NHEAD=8,SEQQ=8192,SEQK=8448,D=64,QP=512,KP=128,QIN=2048;
constexpr int NW=8,QBLK=32,QB=QBLK*NW,KVBLK=64,NQB=SEQQ/QB;
constexpr int ATTN_UNIT_ROWS=QB;
__device__ __forceinline__ int crow(int r,int hi){return (r&3)+8*(r>>2)+4*hi;}
#define SBAR() __builtin_amdgcn_sched_barrier(0)
__device__ __forceinline__ void cmask(f32x16&p0,f32x16&p1,int jb,int qrel,int hi){
  const float NEG=-INFINITY; int kb=64*jb+4*hi;
  #pragma unroll
  for(int r=0;r<16;++r){int kv=kb+(r&3)+8*(r>>2); if(kv>qrel)p0[r]=NEG; if(kv+32>qrel)p1[r]=NEG;}
}

constexpr int NSLOT=3, SLOTB=8192;
constexpr int LDS_K=0, LDS_V=NSLOT*SLOTB, LDS_WS=2*NSLOT*SLOTB, LDS_OST=LDS_WS+NW*64*4, LDS_BYTES=LDS_OST+NW*4096;
constexpr float C2=0.125f*1.4426950408889634f;
__device__ __forceinline__ void glds16(const void*gsrc,unsigned lds_dst){unsigned keep;
  asm volatile("s_mov_b32 %0, m0\n\ts_mov_b32 m0, %2\n\ts_nop 0\n\tglobal_load_lds_dwordx4 %1, off\n\ts_mov_b32 m0, %0":"=&s"(keep):"v"(gsrc),"s"(lds_dst):"memory");}
__device__ __forceinline__ float max3f(float a,float b,float c){float r;asm("v_max3_f32 %0, %1, %2, %3":"=v"(r):"v"(a),"v"(b),"v"(c));return r;}
__device__ __forceinline__ float max2f(float a,float b){float r;asm("v_max_f32_e32 %0, %1, %2":"=v"(r):"v"(a),"v"(b));return r;}
__device__ __forceinline__ float fadd_s(float a,float b){float r;asm("v_add_f32_e32 %0, %1, %2":"=v"(r):"v"(a),"v"(b));return r;}
__device__ __forceinline__ float fsub_s(float a,float b){float r;asm("v_sub_f32_e32 %0, %1, %2":"=v"(r):"v"(a),"v"(b));return r;}
typedef float f32x2_t __attribute__((ext_vector_type(2))); typedef __bf16 bf16x2_t __attribute__((ext_vector_type(2)));
__device__ __forceinline__ unsigned cvtpk_s(float lo,float hi){f32x2_t v={lo,hi};bf16x2_t b=__builtin_convertvector(v,bf16x2_t);return __builtin_bit_cast(unsigned,b);}
#define WAIT_BAR(N) asm volatile("s_waitcnt vmcnt(" #N ") lgkmcnt(0)\n\ts_barrier":::"memory")

__device__ __forceinline__ void qkt(f32x16&p0,f32x16&p1,const char*Kslot,const bf16x8*qr,const f32x16&negm,int r32,int hi){
  const char*kb=Kslot+hi*1024+r32*16;
  #pragma unroll
  for(int d0=0;d0<4;++d0){
    const bf16x8 b0=*reinterpret_cast<const bf16x8*>(kb+d0*2048);
    const bf16x8 b1=*reinterpret_cast<const bf16x8*>(kb+d0*2048+512);
    if(d0==0){p0=__builtin_amdgcn_mfma_f32_32x32x16_bf16(b0,qr[0],negm,0,0,0);p1=__builtin_amdgcn_mfma_f32_32x32x16_bf16(b1,qr[0],negm,0,0,0);}
    else{p0=__builtin_amdgcn_mfma_f32_32x32x16_bf16(b0,qr[d0],p0,0,0,0);p1=__builtin_amdgcn_mfma_f32_32x32x16_bf16(b1,qr[d0],p1,0,0,0);}}
}
typedef __attribute__((address_space(3))) const char* lds_cptr;
typedef short v4i16_t __attribute__((ext_vector_type(4)));
__device__ __forceinline__ void kload8(bf16x8*kf,lds_cptr kp){
  kf[0]=*(const __attribute__((address_space(3))) bf16x8*)(kp);      kf[1]=*(const __attribute__((address_space(3))) bf16x8*)(kp+512);
  kf[2]=*(const __attribute__((address_space(3))) bf16x8*)(kp+2048); kf[3]=*(const __attribute__((address_space(3))) bf16x8*)(kp+2560);
  kf[4]=*(const __attribute__((address_space(3))) bf16x8*)(kp+4096); kf[5]=*(const __attribute__((address_space(3))) bf16x8*)(kp+4608);
  kf[6]=*(const __attribute__((address_space(3))) bf16x8*)(kp+6144); kf[7]=*(const __attribute__((address_space(3))) bf16x8*)(kp+6656);
}
__device__ __forceinline__ void kload2(bf16x8*kf,lds_cptr kp,int j){ kf[2*j]=*(const __attribute__((address_space(3))) bf16x8*)(kp+j*2048); kf[2*j+1]=*(const __attribute__((address_space(3))) bf16x8*)(kp+j*2048+512); }
__device__ __forceinline__ s16x4 vtr(lds_cptr p){ return __builtin_bit_cast(s16x4,__builtin_amdgcn_ds_read_tr16_b64_v4i16((__attribute__((address_space(3))) v4i16_t*)p)); }
__device__ __forceinline__ float rowmax(const f32x16&p0,const f32x16&p1){
  float a=max3f(p0[0],p0[1],p1[0]),b=max3f(p0[2],p0[3],p1[1]);a=max3f(a,p1[2],p1[3]);
  #pragma unroll
  for(int r=4;r<16;r+=4){a=max3f(a,p0[r],p0[r+1]);b=max3f(b,p0[r+2],p0[r+3]);a=max3f(a,p1[r],p1[r+1]);b=max3f(b,p1[r+2],p1[r+3]);}
  const float m=max2f(a,b);
  auto rr=__builtin_amdgcn_permlane32_swap(__float_as_uint(m),__float_as_uint(m),false,false);
  return max2f(__uint_as_float(rr[0]),__uint_as_float(rr[1]));
}
__device__ __forceinline__ void pv(f32x16*o,int vb,bf16x8 pa0,bf16x8 pa1,bf16x8 pa2,bf16x8 pa3){
  #pragma unroll
  for(int d0=0;d0<2;++d0){s16x4 lo[4],hi[4];
    #pragma unroll
    for(int ks=0;ks<4;++ks){
      asm volatile("ds_read_b64_tr_b16 %0,%1 offset:%c2":"=&v"(lo[ks]):"v"(vb),"i"(d0*4096+ks*1024):"memory");
      asm volatile("ds_read_b64_tr_b16 %0,%1 offset:%c2":"=&v"(hi[ks]):"v"(vb),"i"(d0*4096+ks*1024+512):"memory");}
    asm volatile("s_waitcnt lgkmcnt(0)":::"memory");SBAR();
    #define PK(k) (bf16x8){lo[k][0],lo[k][1],lo[k][2],lo[k][3],hi[k][0],hi[k][1],hi[k][2],hi[k][3]}
    o[d0]=__builtin_amdgcn_mfma_f32_32x32x16_bf16(pa0,PK(0),o[d0],0,0,0);
    o[d0]=__builtin_amdgcn_mfma_f32_32x32x16_bf16(pa1,PK(1),o[d0],0,0,0);
    o[d0]=__builtin_amdgcn_mfma_f32_32x32x16_bf16(pa2,PK(2),o[d0],0,0,0);
    o[d0]=__builtin_amdgcn_mfma_f32_32x32x16_bf16(pa3,PK(3),o[d0],0,0,0);
    #undef PK
  }
}

#ifndef ATTN_STORE16
#define ATTN_STORE16(p,v) (*(u32x4*)(p)=(v))
#endif
struct QPre { const float* qg; const float* rc; const float* rs; };
template<int THRL> __device__ __forceinline__ void attn_unit(int b,int h,long qrow0,int NTarg,int tq0,const QPre&QN,const bf16*Q,const bf16*__restrict__ K,const bf16*__restrict__ V,bf16*O,char*shm){
  int tid_=threadIdx.x; asm volatile("":"+v"(tid_)); const int tid=tid_,lane=tid&63,r32=lane&31,hi=lane>>5; const int wid=__builtin_amdgcn_readfirstlane(tid>>6);
  const long krowbase=(long)b*SEQK; const int kvh=h>>2;
  const bf16*Qw=Q+(qrow0+wid*QBLK)*QIN+h*D;
  const bf16*Kh=K+krowbase*KP+kvh*D,*Vh=V+krowbase*KP+kvh*D;
  const unsigned lds0=(unsigned)(uintptr_t)shm;
  float*wsf=(float*)(shm+LDS_WS)+wid*64;
  const bf16*ksrc=Kh+(long)lane*KP+wid*8;
  const bf16*vsrc=Vh+(long)(16*(wid&3)+(lane>>2))*KP+(wid>>2)*32+(lane&3)*8;
  const unsigned kdst=lds0+LDS_K+wid*1024, vdst=lds0+LDS_V+wid*1024;
  #define DMA_K(t,slot) glds16(ksrc+(long)(t)*KVBLK*KP,(unsigned)__builtin_amdgcn_readfirstlane(kdst+(slot)))
  #define DMA_V(t,slot) glds16(vsrc+(long)(t)*KVBLK*KP,(unsigned)__builtin_amdgcn_readfirstlane(vdst+(slot)))
  const int vb0=(int)(lds0+LDS_V)+((lane>>4)&1)*32+(lane&3)*8+(4*hi+((lane&15)>>2))*64;
  const char*Kbase=shm+LDS_K; bf16x8 kf[8];
  const lds_cptr shm3=(lds_cptr)shm; const lds_cptr kp0=shm3+LDS_K+hi*1024+r32*16; const lds_cptr vp0=shm3+LDS_V+((lane>>4)&1)*32+(lane&3)*8+(4*hi+((lane&15)>>2))*64;
  const int NT=NTarg;
  DMA_K(0,0);DMA_V(0,0);DMA_K(1,SLOTB);
  bf16x8 qr[4];
  #pragma unroll
  for(int d0=0;d0<4;++d0)qr[d0]=*reinterpret_cast<const bf16x8*>(&Qw[(long)r32*QIN+d0*16+hi*8]);
  {
    float x[4][8]; float ss=0.f;
    #pragma unroll
    for(int d0=0;d0<4;++d0){
      #pragma unroll
      for(int e=0;e<8;++e){ x[d0][e]=__builtin_bit_cast(float,(unsigned)(unsigned short)qr[d0][e]<<16); ss+=x[d0][e]*x[d0][e]; } }
    ss+=__shfl_xor(ss,32);
    const float rstd=C2/sqrtf(ss*(1.0f/64.0f)+1e-6f);
    #pragma unroll
    for(int d0=0;d0<4;++d0){ const f32x4_t g0=*reinterpret_cast<const f32x4_t*>(QN.qg+16*d0+8*hi), g1=*reinterpret_cast<const f32x4_t*>(QN.qg+16*d0+8*hi+4);
      #pragma unroll
      for(int e=0;e<8;++e) x[d0][e]*=rstd*(e<4?g0[e]:g1[e-4]); }
    if(tq0>=0){ const int t=tq0+wid*QBLK+r32;
      #pragma unroll
      for(int d0=0;d0<2;++d0){ const float*cp=QN.rc+(long)t*32+16*d0+8*hi,*sp=QN.rs+(long)t*32+16*d0+8*hi;
        const f32x4_t c0=*reinterpret_cast<const f32x4_t*>(cp),c1=*reinterpret_cast<const f32x4_t*>(cp+4),s0=*reinterpret_cast<const f32x4_t*>(sp),s1=*reinterpret_cast<const f32x4_t*>(sp+4);
        #pragma unroll
        for(int e=0;e<8;++e){ const float cs=e<4?c0[e]:c1[e-4], sn=e<4?s0[e]:s1[e-4]; const float a=x[d0][e], bq=x[d0+2][e]; x[d0][e]=a*cs-bq*sn; x[d0+2][e]=bq*cs+a*sn; } } }
    #pragma unroll
    for(int d0=0;d0<4;++d0){ u32x4 pk; pk[0]=cvtpk_s(x[d0][0],x[d0][1]); pk[1]=cvtpk_s(x[d0][2],x[d0][3]); pk[2]=cvtpk_s(x[d0][4],x[d0][5]); pk[3]=cvtpk_s(x[d0][6],x[d0][7]); qr[d0]=__builtin_bit_cast(bf16x8,pk); }
  }
  float mhat=0.f,l_reg=0.f;f32x16 o[2];o[0]=f32x16{};o[1]=f32x16{};f32x16 negm=f32x16{};asm volatile("":"+v"(negm));
  const int qrel=wid*QBLK+r32;
  #define CMASK(P0,P1,t) do{}while(0)
  bool resc=false;
  #define START(P0,P1) do{ const float rm=rowmax(P0,P1); resc=false; \
    { const float dl=rm; mhat=fadd_s(mhat,dl); \
      _Pragma("unroll") for(int r=0;r<16;++r){P0[r]=fsub_s(P0[r],dl);P1[r]=fsub_s(P1[r],dl);} \
      _Pragma("unroll") for(int r=0;r<16;++r)negm[r]=-mhat; asm volatile("":"+v"(negm)); } \
    _Pragma("unroll") for(int r=0;r<16;++r)P0[r]=__builtin_amdgcn_exp2f(P0[r]); }while(0)
  #define RESC() do{ if(resc){ asm volatile("s_waitcnt lgkmcnt(0)":::"memory"); \
      _Pragma("unroll") for(int d_=0;d_<2;++d_) _Pragma("unroll") for(int r=0;r<16;++r)o[d_][r]*=wsf[crow(r,hi)]; } }while(0)
  f32x16 pA0,pA1,pB0,pB1;
  int sl_prev=0,sl_cur=0,sl_next=SLOTB;
  #define ROT() do{sl_prev=sl_cur;sl_cur=sl_next;sl_next=(sl_next==(NSLOT-1)*SLOTB)?0:sl_next+SLOTB;}while(0)
  DMA_K(2,2*SLOTB);
  WAIT_BAR(3);
  qkt(pA0,pA1,Kbase,qr,negm,r32,hi);asm volatile("s_nop 15\n\ts_nop 7":"+v"(pA0),"+v"(pA1));CMASK(pA0,pA1,0);
  START(pA0,pA1);
  _Pragma("unroll") for(int r=0;r<16;++r)pA1[r]=__builtin_amdgcn_exp2f(pA1[r]);
  WAIT_BAR(0);
  DMA_K(3,0);DMA_V(1,SLOTB);
  ROT();
  kload8(kf,kp0+sl_cur);
  WAIT_BAR(2);
  s16x4 vlo[8],vhi[8]; u32x4 pw0,pw1,pw2,pw3;
  #define PKW(P,B) cvtpk_s(P[B],P[B+1])
  #define PAF(k) __builtin_bit_cast(bf16x8,pw##k)
  #define VFR(i) (bf16x8){vlo[i][0],vlo[i][1],vlo[i][2],vlo[i][3],vhi[i][0],vhi[i][1],vhi[i][2],vhi[i][3]}
  #define PIN(x) asm volatile("":"+v"(x))
  #define MX3(a,b,c) __builtin_fmaxf(__builtin_fmaxf((a),(b)),(c))
  #define GAPA(MF,A0,A1,A2,A3,W0,W1,PW) do{ MF; sacc+=A0; sacc+=A1; sacc+=A2; sacc+=A3; PIN(sacc); W0; W1; PIN(PW); SBAR(); }while(0)
  #define EX(v) __builtin_amdgcn_exp2f(v)
  #define GAPB(MF,X,B) do{ MF; X[B]=EX(X[B]); X[B+1]=EX(X[B+1]); X[B+2]=EX(X[B+2]); X[B+3]=EX(X[B+3]); PIN(X); SBAR(); }while(0)
  #define VRD(i) do{ vlo[i]=vtr(vp_+(((i)>>2)*4096+((i)&3)*1024)); vhi[i]=vtr(vp_+(((i)>>2)*4096+((i)&3)*1024+512)); }while(0)
  #define KRD(G,j) do{ if(G){ kload2(kf,kp0+sl_next,j); SBAR(); } }while(0)
  #define STEP(C0,C1,P0,P1,t,GK,GV,GL) do{ SBAR(); \
    const lds_cptr vp_=vp0+sl_prev; \
    VRD(0); SBAR(); float sacc=(P0[0]+P0[1]); \
    GAPA(C0=__builtin_amdgcn_mfma_f32_32x32x16_bf16(kf[0],qr[0],negm,0,0,0), P0[2],P0[3],P0[4],P0[5],     pw0[0]=PKW(P0,0), pw0[1]=PKW(P0,2), pw0); \
    VRD(4); SBAR(); GAPA(C1=__builtin_amdgcn_mfma_f32_32x32x16_bf16(kf[1],qr[0],negm,0,0,0), P0[6],P0[7],P0[8],P0[9],     pw0[2]=PKW(P0,4), pw0[3]=PKW(P0,6), pw0); \
    VRD(1); SBAR(); GAPA(C0=__builtin_amdgcn_mfma_f32_32x32x16_bf16(kf[2],qr[1],C0,0,0,0),   P0[10],P0[11],P0[12],P0[13], pw1[0]=PKW(P0,8), pw1[1]=PKW(P0,10), pw1); \
    VRD(5); SBAR(); GAPA(C1=__builtin_amdgcn_mfma_f32_32x32x16_bf16(kf[3],qr[1],C1,0,0,0),   P0[14],P0[15],P1[0],P1[1],   pw1[2]=PKW(P0,12),pw1[3]=PKW(P0,14), pw1); \
    VRD(2); SBAR(); GAPA(C0=__builtin_amdgcn_mfma_f32_32x32x16_bf16(kf[4],qr[2],C0,0,0,0),   P1[2],P1[3],P1[4],P1[5],     pw2[0]=PKW(P1,0), pw2[1]=PKW(P1,2), pw2); \
    VRD(6); SBAR(); GAPA(C1=__builtin_amdgcn_mfma_f32_32x32x16_bf16(kf[5],qr[2],C1,0,0,0),   P1[6],P1[7],P1[8],P1[9],     pw2[2]=PKW(P1,4), pw2[3]=PKW(P1,6), pw2); \
    VRD(3); SBAR(); GAPA(C0=__builtin_amdgcn_mfma_f32_32x32x16_bf16(kf[6],qr[3],C0,0,0,0),   P1[10],P1[11],P1[12],P1[13], pw3[0]=PKW(P1,8), pw3[1]=PKW(P1,10), pw3); \
    VRD(7); SBAR(); GAPA(C1=__builtin_amdgcn_mfma_f32_32x32x16_bf16(kf[7],qr[3],C1,0,0,0),   P1[14],P1[15],0.f,0.f,       pw3[2]=PKW(P1,12),pw3[3]=PKW(P1,14), pw3); \
    l_reg+=sacc; \
    if(GK){DMA_K((t)+3,sl_cur);} if(GV){DMA_V((t)+1,sl_next);} \
    CMASK(C0,C1,t); \
    { float a=MX3(C0[0],C0[1],C1[0]),b=MX3(C0[2],C0[3],C1[1]); a=MX3(a,C1[2],C1[3]); \
      _Pragma("unroll") for(int r=4;r<16;r+=4){a=MX3(a,C0[r],C0[r+1]);b=MX3(b,C0[r+2],C0[r+3]);a=MX3(a,C1[r],C1[r+1]);b=MX3(b,C1[r+2],C1[r+3]);} \
      float rm=__builtin_fmaxf(a,b); { auto rr=__builtin_amdgcn_permlane32_swap(__float_as_uint(rm),__float_as_uint(rm),false,false); rm=__builtin_fmaxf(__uint_as_float(rr[0]),__uint_as_float(rr[1])); } \
      resc=false; \
      if(__builtin_expect(__any(rm>(float)THRL),0)){ const float dl=__builtin_fmaxf(rm,0.f); mhat+=dl; \
        _Pragma("unroll") for(int r=0;r<16;++r){C0[r]-=dl;C1[r]-=dl;} \
        _Pragma("unroll") for(int r=0;r<16;++r)negm[r]=-mhat; asm volatile("":"+v"(negm)); \
        const float f=__builtin_amdgcn_exp2f(-dl); l_reg*=f; if(hi==0)wsf[r32]=f; resc=true; } } \
    SBAR(); \
    GAPB(o[0]=__builtin_amdgcn_mfma_f32_32x32x16_bf16(PAF(0),VFR(0),o[0],0,0,0), C0,0); \
    GAPB(o[1]=__builtin_amdgcn_mfma_f32_32x32x16_bf16(PAF(0),VFR(4),o[1],0,0,0), C0,4); \
    KRD(GL,0); GAPB(o[0]=__builtin_amdgcn_mfma_f32_32x32x16_bf16(PAF(1),VFR(1),o[0],0,0,0), C0,8); \
    KRD(GL,1); GAPB(o[1]=__builtin_amdgcn_mfma_f32_32x32x16_bf16(PAF(1),VFR(5),o[1],0,0,0), C0,12); \
    KRD(GL,2); GAPB(o[0]=__builtin_amdgcn_mfma_f32_32x32x16_bf16(PAF(2),VFR(2),o[0],0,0,0), C1,0); \
    KRD(GL,3); GAPB(o[1]=__builtin_amdgcn_mfma_f32_32x32x16_bf16(PAF(2),VFR(6),o[1],0,0,0), C1,4); \
    GAPB(o[0]=__builtin_amdgcn_mfma_f32_32x32x16_bf16(PAF(3),VFR(3),o[0],0,0,0), C1,8); \
    GAPB(o[1]=__builtin_amdgcn_mfma_f32_32x32x16_bf16(PAF(3),VFR(7),o[1],0,0,0), C1,12); \
    }while(0)
  int t=1;
  #undef CMASK
  #define CMASK(P0,P1,t) do{}while(0)
  for(;t+5<NT;t+=2){
    STEP(pB0,pB1,pA0,pA1,t,true,true,true);     WAIT_BAR(2); RESC(); ROT();
    STEP(pA0,pA1,pB0,pB1,t+1,true,true,true);   WAIT_BAR(2); RESC(); ROT();
  }
  #undef CMASK
  #define CMASK(P0,P1,t) do{}while(0)
  #define ENDW(tt) do{ if((tt)+3<NT){WAIT_BAR(2);} else if((tt)+2<NT){WAIT_BAR(1);} else {WAIT_BAR(0);} }while(0)
  for(;t+1<NT;t+=2){
    STEP(pB0,pB1,pA0,pA1,t,(t+3<NT),(t+1<NT),(t+1<NT));       ENDW(t);   RESC(); ROT();
    STEP(pA0,pA1,pB0,pB1,t+1,(t+4<NT),(t+2<NT),(t+2<NT));     ENDW(t+1); RESC(); ROT();
  }
  STEP(pB0,pB1,pA0,pA1,NT-1,false,false,false); RESC();
  { float sacc=pB0[0]+pB0[1]; _Pragma("unroll") for(int r=2;r<16;++r)sacc+=pB0[r]; _Pragma("unroll") for(int r=0;r<16;++r)sacc+=pB1[r]; l_reg+=sacc;
    pw0=(u32x4){PKW(pB0,0),PKW(pB0,2),PKW(pB0,4),PKW(pB0,6)};pw1=(u32x4){PKW(pB0,8),PKW(pB0,10),PKW(pB0,12),PKW(pB0,14)};pw2=(u32x4){PKW(pB1,0),PKW(pB1,2),PKW(pB1,4),PKW(pB1,6)};pw3=(u32x4){PKW(pB1,8),PKW(pB1,10),PKW(pB1,12),PKW(pB1,14)};
    SBAR(); pv(o,vb0+sl_cur,PAF(0),PAF(1),PAF(2),PAF(3)); }
  #undef PKW
  #undef PAF
  #undef VFR
  #undef PIN
  #undef MX3
  #undef GAPA
  #undef GAPB
  #undef EX
  #undef VRD
  #undef KRD
  #undef STEP
  #undef ENDW
  {auto rr=__builtin_amdgcn_permlane32_swap(__float_as_uint(l_reg),__float_as_uint(l_reg),false,false);l_reg=__uint_as_float(rr[0])+__uint_as_float(rr[1]);}
  if(hi==0)wsf[32+r32]=l_reg;asm volatile("s_waitcnt lgkmcnt(0)":::"memory");
  float rli[16];
  #pragma unroll
  for(int r=0;r<16;++r)rli[r]=__builtin_amdgcn_rcpf(wsf[32+crow(r,hi)]);
  bf16*Ow=O+(qrow0+wid*QBLK)*QP+h*D;
  { bf16*stg=(bf16*)(shm+LDS_OST)+wid*2048;
    #pragma unroll
    for(int r=0;r<16;++r){const int orow=crow(r,hi);
      #pragma unroll
      for(int d0=0;d0<2;++d0)stg[orow*64+d0*32+r32]=__float2bfloat16(o[d0][r]*rli[r]);}
    asm volatile("s_waitcnt lgkmcnt(0)":::"memory");
    #pragma unroll
    for(int i=0;i<4;++i){const int row=i*8+(lane>>3),ch=lane&7; const u32x4 v=*(const u32x4*)(stg+row*64+ch*8); ATTN_STORE16(Ow+(long)row*QP+ch*8,v);} }
  asm volatile("s_waitcnt lgkmcnt(0)\n\ts_barrier":::"memory");
  #undef DMA_K
  #undef DMA_V
  #undef CMASK
  #undef START
  #undef RESC
  #undef ROT
}
constexpr int ATTN_LDS_BYTES=LDS_BYTES;
struct AttnTensors { const bf16* Q; const bf16* K; const bf16* V; bf16* O; };
template<int THRL=8> __device__ __forceinline__ void attn_phase(char*lds,const AttnTensors&T,const QPre&QN,int G,int vcu,bool with_ctx,long ctx_row0){
  const int total=4*NHEAD*NQB;
  for(int i=0;;++i){
    int x,n;
    if(G==256){ if(i>=4)break; x=vcu>>5; n=i*32+(vcu&31); }
    else { const int u=i*G+vcu; if(u>=total)break; x=u>>7; n=u&127; }
    const int b=x>>1,kvh=x&1,h=kvh*4+(n>>5),qb=n&31;
    attn_unit<THRL>(b,h,(long)b*SEQQ+(long)qb*QB,SEQK/KVBLK,qb*QB,QN,T.Q,T.K,T.V,T.O,lds);
  }
  if(with_ctx){
    for(int u=vcu;u<4*NHEAD;u+=G){ const int b=u>>3,h=u&7; attn_unit<THRL>(b,h,ctx_row0+(long)b*256,4,-1,QN,T.Q,T.K,T.V,T.O,lds); }
  }
}
#undef SBAR
#undef WAIT_BAR
}

constexpr int NWAVES = 8, NTHR = 512;
constexpr int DMODEL = 1024, NB = 4, SEQ = 8192, CTXL = 256, NLAT = NB * SEQ, NCTX = NB * CTXL, MT = NLAT + NCTX;
constexpr int INW = 2048, NE = 32, KEYS = SEQ + CTXL;
constexpr int SORT_TILES = 560, SORT_ROWS = SORT_TILES * 256;
constexpr float EPSN = 1e-6f;
constexpr int NCHUNK = 66, CHUNK = 128;
constexpr int YS_PITCH = 1088;
constexpr int NPH_PRO = 2, NPH_LAYER = 13, NPH = NPH_PRO + 2 * NPH_LAYER;

constexpr size_t MiB = 1u << 20;
constexpr size_t WS_CTL = 0, CTL_ZERO_BYTES = 1 * MiB;
constexpr size_t WS_MOD = 1 * MiB, WS_ROPEC = 2 * MiB, WS_ROPES = 3 * MiB, WS_H2 = 4 * MiB, WS_KFC = 10 * MiB, WS_BLKCNT = 12 * MiB, WS_TILEE = 13 * MiB, WS_SCANS = 14 * MiB;
constexpr size_t WS_WINT = 16 * MiB, WS_WOUTT = 24 * MiB, WS_W1T = 32 * MiB, WS_W2T = 288 * MiB, WS_KF = 416 * MiB, WS_KHAT = 448 * MiB, WS_XR = 512 * MiB, WS_H = 644 * MiB;
constexpr size_t WS_U = 712 * MiB, WS_Q = 844 * MiB, WS_K = 877 * MiB, WS_V = 886 * MiB, WS_ATT = 895 * MiB, WS_LAB = 928 * MiB, WS_LRUO = 1060 * MiB, WS_VT = 1093 * MiB, WS_X0T = 1125 * MiB,
                 WS_HYO = 1157 * MiB, WS_MIXA = 1190 * MiB;
constexpr size_t WS_WGT = 11 * MiB, WS_SPT = 10 * MiB + 768 * 1024, WS_XL = 1256 * MiB;
constexpr size_t WS_GC = 10 * MiB + 896 * 1024;
constexpr size_t WS_CB = 10 * MiB + 960 * 1024;
constexpr size_t WS_F = 712 * MiB, WS_ASORT = 778 * MiB, WS_ACT = 1058 * MiB, WS_YS = 1338 * MiB, WS_TOPI = 1618 * MiB, WS_GATE = 1619 * MiB, WS_POS = 1620 * MiB, WS_RSSP = 1622 * MiB, WS_ROWTOK = 1625 * MiB, WS_END = 1626 * MiB;
constexpr size_t LAB_STRIDE = (size_t)MT * 256;
constexpr int CW_BAR = 4096;
constexpr int CW_NTILES = 64;

constexpr int RING_OFF = 0, RING_BYTES = 131072, MOETAB_OFF = 131072, LDSCTL_OFF = 155648, LDS_BYTES = 156160;

#define GAS __attribute__((address_space(1)))
#define LAS __attribute__((address_space(3)))
typedef unsigned short bf16;
typedef unsigned v4u __attribute__((ext_vector_type(4)));
typedef unsigned v2u __attribute__((ext_vector_type(2)));
typedef float f32x4 __attribute__((ext_vector_type(4)));
#define LDS_WAIT() asm volatile("s_waitcnt lgkmcnt(0)" ::: "memory")
#define VM_WAIT() asm volatile("s_waitcnt vmcnt(0)" ::: "memory")
__device__ __forceinline__ unsigned f2bf(float f) { unsigned u = __builtin_bit_cast(unsigned, f); return (u + 0x7fffu + ((u >> 16) & 1u)) >> 16; }
__device__ __forceinline__ unsigned pk2(float lo, float hi) { return f2bf(lo) | (f2bf(hi) << 16); }
__device__ __forceinline__ float bf2f(unsigned short b) { return __builtin_bit_cast(float, (unsigned)b << 16); }
__device__ __forceinline__ float bflo(unsigned w) { return __builtin_bit_cast(float, w << 16); }
__device__ __forceinline__ float bfhi(unsigned w) { return __builtin_bit_cast(float, w & 0xffff0000u); }
__device__ __forceinline__ float wave_sum(float v) {
#pragma unroll
    for (int o = 1; o < 64; o <<= 1) v += __shfl_xor(v, o);
    return v;
}
__device__ __forceinline__ float sigmoidf_(float x) { return 1.0f / (1.0f + __expf(-x)); }
__device__ __forceinline__ void sincos_d(double x, double& s, double& c) {
    const double kd = __builtin_rint(x * 0.63661977236758134308);
    const int k = (int)kd;
    double r = __builtin_fma(-kd, 1.57079632673412561417e+00, x);
    r = __builtin_fma(-kd, 6.07710050650619224932e-11, r);
    const double z = r * r;
    const double ps = r + r * z * (-1.66666666666666324348e-01 + z * (8.33333333332248946124e-03 + z * (-1.98412698298579493134e-04 + z * (2.75573137070700676789e-06 + z * (-2.50507602534068634195e-08 + z * 1.58969099521155010221e-10)))));
    const double pc = 1.0 - 0.5 * z + z * z * (4.16666666666666019037e-02 + z * (-1.38888888888741095749e-03 + z * (2.48015872894767294178e-05 + z * (-2.75573143513906633035e-07 + z * (2.08757232129817482790e-09 + z * -1.13596475577881948265e-11)))));
    const int q = k & 3;
    s = (q == 0) ? ps : (q == 1) ? pc : (q == 2) ? -ps : -pc;
    c = (q == 0) ? pc : (q == 1) ? -ps : (q == 2) ? -pc : ps;
}
__device__ __forceinline__ float gelu_tanh(float x) {
    const float u = 0.7978845608028654f * (x + 0.044715f * x * x * x);
    const float t = 1.0f - 2.0f / (1.0f + __expf(2.0f * u));
    return 0.5f * x * (1.0f + t);
}
__device__ __forceinline__ int lds_add(LAS int* p, int v) { return __hip_atomic_fetch_add(p, v, __ATOMIC_RELAXED, __HIP_MEMORY_SCOPE_WORKGROUP); }

#define FFT_FN __device__ __forceinline__
typedef float f32x2v __attribute__((ext_vector_type(2)));
#define FFT_VEC2 f32x2v
#define FFT_DPTR LAS f32x2v*
#define FFT_LD(D, i) c32_from((D)[i])
#define FFT_ST(D, i, v) ((D)[i] = c32_to(v))
struct __attribute__((aligned(8))) c32 { float x, y; };
FFT_FN c32 cmul(c32 a, c32 b) { c32 r; r.x = a.x * b.x - a.y * b.y; r.y = a.x * b.y + a.y * b.x; return r; }
FFT_FN c32 cadd(c32 a, c32 b) { c32 r; r.x = a.x + b.x; r.y = a.y + b.y; return r; }
FFT_FN c32 csub(c32 a, c32 b) { c32 r; r.x = a.x - b.x; r.y = a.y - b.y; return r; }
FFT_FN c32 cmuli_neg(c32 a) { c32 r; r.x = a.y; r.y = -a.x; return r; }
FFT_FN int fpad(int a) { return a + (a >> 4); }
#ifdef FFT_VEC2
FFT_FN c32 c32_from(FFT_VEC2 t) { c32 r; r.x = t.x; r.y = t.y; return r; }
FFT_FN FFT_VEC2 c32_to(c32 a) { FFT_VEC2 t; t.x = a.x; t.y = a.y; return t; }
#endif
FFT_FN void dft4(c32& a0, c32& a1, c32& a2, c32& a3) {
    const c32 s02 = cadd(a0, a2), d02 = csub(a0, a2), s13 = cadd(a1, a3), d13 = cmuli_neg(csub(a1, a3));
    a0 = cadd(s02, s13); a2 = csub(s02, s13); a1 = cadd(d02, d13); a3 = csub(d02, d13);
}
FFT_FN void dft16(c32 (&v)[16]) {
    const float C1 = 0.92387953251128674f, S1 = 0.38268343236508977f, C2 = 0.70710678118654752f;
#pragma unroll
    for (int q2 = 0; q2 < 4; ++q2) dft4(v[q2], v[4 + q2], v[8 + q2], v[12 + q2]);
    { c32 w;
      w.x = C1; w.y = -S1; v[4 * 1 + 1] = cmul(v[4 * 1 + 1], w);
      w.x = C2; w.y = -C2; v[4 * 2 + 1] = cmul(v[4 * 2 + 1], w);
      w.x = S1; w.y = -C1; v[4 * 3 + 1] = cmul(v[4 * 3 + 1], w);
      w.x = C2; w.y = -C2; v[4 * 1 + 2] = cmul(v[4 * 1 + 2], w);
      v[4 * 2 + 2] = cmuli_neg(v[4 * 2 + 2]);
      w.x = -C2; w.y = -C2; v[4 * 3 + 2] = cmul(v[4 * 3 + 2], w);
      w.x = S1; w.y = -C1; v[4 * 1 + 3] = cmul(v[4 * 1 + 3], w);
      w.x = -C2; w.y = -C2; v[4 * 2 + 3] = cmul(v[4 * 2 + 3], w);
      w.x = -C1; w.y = S1; v[4 * 3 + 3] = cmul(v[4 * 3 + 3], w); }
#pragma unroll
    for (int p1 = 0; p1 < 4; ++p1) dft4(v[4 * p1 + 0], v[4 * p1 + 1], v[4 * p1 + 2], v[4 * p1 + 3]);
#pragma unroll
    for (int a = 0; a < 4; ++a)
#pragma unroll
        for (int b = a + 1; b < 4; ++b) { const c32 t = v[4 * a + b]; v[4 * a + b] = v[4 * b + a]; v[4 * b + a] = t; }
}
FFT_FN c32 twid(int j, int n) { float rev = (float)j / (float)n; asm volatile("" : "+v"(rev)); c32 w; w.x = __builtin_amdgcn_cosf(rev); w.y = -__builtin_amdgcn_sinf(rev); return w; }

FFT_FN void fft_fwd16(FFT_DPTR D, int g, int n) {
    const int s = n >> 4, blk = g / s, j = g - blk * s, base = blk * n + j;
    c32 v[16];
#pragma unroll
    for (int q = 0; q < 16; ++q) v[q] = FFT_LD(D, fpad(base + q * s));
    dft16(v);
    const c32 w = twid(j, n); c32 wp = w;
#pragma unroll
    for (int p = 1; p < 16; ++p) { v[p] = cmul(v[p], wp); wp = cmul(wp, w); }
#pragma unroll
    for (int p = 0; p < 16; ++p) FFT_ST(D, fpad(base + p * s), v[p]);
}
FFT_FN void fft_inv16(FFT_DPTR D, int g, int n) {
    const int s = n >> 4, blk = g / s, j = g - blk * s, base = blk * n + j;
    c32 v[16];
#pragma unroll
    for (int q = 0; q < 16; ++q) v[q] = FFT_LD(D, fpad(base + q * s));
    const c32 w = twid(j, n); c32 wp = w;
#pragma unroll
    for (int p = 1; p < 16; ++p) { v[p] = cmul(v[p], wp); wp = cmul(wp, w); }
    dft16(v);
#pragma unroll
    for (int p = 0; p < 16; ++p) FFT_ST(D, fpad(base + p * s), v[p]);
}
FFT_FN void fft_mid16(FFT_DPTR D, int g, const c32* KH) {
    c32 v[16];
#pragma unroll
    for (int q = 0; q < 16; ++q) v[q] = FFT_LD(D, 17 * g + q);
    dft16(v);
#pragma unroll
    for (int p = 0; p < 16; ++p) { const c32 k = KH[16 * g + p]; const c32 t = cmul(v[p], k); v[p].x = t.x; v[p].y = -t.y; }
    dft16(v);
#pragma unroll
    for (int p = 0; p < 16; ++p) FFT_ST(D, 17 * g + p, v[p]);
}
FFT_FN void fft_last16_out(FFT_DPTR D, int g, c32* OUT, float scale) {
    c32 v[16];
#pragma unroll
    for (int q = 0; q < 16; ++q) v[q] = FFT_LD(D, 17 * g + q);
    dft16(v);
#pragma unroll
    for (int p = 0; p < 16; ++p) { c32 t; t.x = v[p].x * scale; t.y = v[p].y * scale; OUT[16 * g + p] = t; }
}
FFT_FN void fft_first4(FFT_DPTR D, int j, c32 x0, c32 x1, c32 x2, c32 x3) {
    dft4(x0, x1, x2, x3);
    const c32 w = twid(j, 16384), w2 = cmul(w, w), w3 = cmul(w2, w);
    FFT_ST(D, fpad(j), x0); FFT_ST(D, fpad(j + 4096), cmul(x1, w)); FFT_ST(D, fpad(j + 8192), cmul(x2, w2)); FFT_ST(D, fpad(j + 12288), cmul(x3, w3));
}
FFT_FN void fft_final4(FFT_DPTR D, int j, c32& u0, c32& u1) {
    const c32 w = twid(j, 16384), w2 = cmul(w, w), w3 = cmul(w2, w);
    c32 a0 = FFT_LD(D, fpad(j)), a1 = cmul(FFT_LD(D, fpad(j + 4096)), w), a2 = cmul(FFT_LD(D, fpad(j + 8192)), w2), a3 = cmul(FFT_LD(D, fpad(j + 12288)), w3);
    dft4(a0, a1, a2, a3);
    u0 = a0; u1 = a1;
}
FFT_FN void fft_first4_inplace(FFT_DPTR D, int j) {
    c32 x0 = FFT_LD(D, fpad(j)), x1 = FFT_LD(D, fpad(j + 4096)), x2 = FFT_LD(D, fpad(j + 8192)), x3 = FFT_LD(D, fpad(j + 12288));
    fft_first4(D, j, x0, x1, x2, x3);
}
#define XB_TMO      128
#define XB_XCNT(j)  (256  + 64 * (j))
#define XB_XSUB(j)  (1280 + 64 * (j))
#define XB_XGEN(j)  (2304 + 64 * (j))
#define XB_TOP      3328
#define XB_TOPGEN   3392
#define XCD_BAR_WORDS 3456
#define XB_SPIN_CAP (1u << 22)

__device__ __forceinline__ unsigned xb_ld(unsigned* p)              { return __hip_atomic_load(p, __ATOMIC_RELAXED, __HIP_MEMORY_SCOPE_AGENT); }
__device__ __forceinline__ unsigned xb_add(unsigned* p, unsigned v) { return __hip_atomic_fetch_add(p, v, __ATOMIC_RELAXED, __HIP_MEMORY_SCOPE_AGENT); }
__device__ __forceinline__ unsigned xb_xcc_id() { return (unsigned)__builtin_amdgcn_s_getreg((3 << 11) | 20) & 0xFu; }
#define XB_SPIN(cond, bar) do { unsigned _sp = 0; while (cond) { __builtin_amdgcn_s_sleep(1); \
    if ((++_sp & 255u) == 0u) { if (xb_ld(&(bar)[XB_TMO])) break; if (_sp > XB_SPIN_CAP) { atomicAdd(&(bar)[XB_TMO], 1u); break; } } } } while (0)

struct XcdBarrier {
    unsigned* bar; unsigned x;
    volatile LAS unsigned* st;
};

__device__ __forceinline__ XcdBarrier xcd_barrier_post(unsigned* bar, volatile LAS unsigned* st) {
    XcdBarrier b; b.bar = bar; b.x = xb_xcc_id(); b.st = st;
    if (threadIdx.x == 0) (void)xb_add(&bar[XB_XCNT(b.x)], 1u);
    return b;
}
__device__ __forceinline__ void xcd_barrier_complete(unsigned* bar, unsigned x, unsigned& nloc, unsigned& nx) {
    const unsigned G = gridDim.x * gridDim.y * gridDim.z;
    unsigned sum, cnt, mine, sp = 0u;
    for (;;) {
        sum = 0u; cnt = 0u; mine = 0u;
#pragma unroll
        for (unsigned j = 0; j < 16; ++j) { const unsigned c = xb_ld(&bar[XB_XCNT(j)]); sum += c; cnt += (c > 0u) ? 1u : 0u; mine = (j == x) ? c : mine; }
        if (sum == G) break;
        __builtin_amdgcn_s_sleep(1);
        if ((++sp & 255u) == 0u) { if (xb_ld(&bar[XB_TMO])) break; if (sp > XB_SPIN_CAP) { atomicAdd(&bar[XB_TMO], 1u); break; } }
    }
    nloc = mine > 0u ? mine : 1u; nx = cnt > 0u ? cnt : 1u;
}

__device__ __forceinline__ void xcd_barrier(const XcdBarrier& b) {
    asm volatile("s_waitcnt vmcnt(0)" ::: "memory");
    __syncthreads();
    if (threadIdx.x == 0) {
        unsigned* bar = b.bar;
        __builtin_amdgcn_s_waitcnt(0);
        unsigned nloc = b.st[0], nx = b.st[1];
        if (nloc == 0u) { xcd_barrier_complete(bar, b.x, nloc, nx); b.st[0] = nloc; b.st[1] = nx; }
        const unsigned old = xb_add(&bar[XB_XSUB(b.x)], 1u);
        const unsigned gen = old / nloc;
        if (old + 1u == (gen + 1u) * nloc) {
            __builtin_amdgcn_fence(__ATOMIC_RELEASE, "agent");
            asm volatile("s_waitcnt vmcnt(0)" ::: "memory");
            const unsigned og = xb_add(&bar[XB_TOP], 1u);
            const unsigned tg = og / nx;
            if (og + 1u == (tg + 1u) * nx) xb_add(&bar[XB_TOPGEN], 1u);
            else XB_SPIN(xb_ld(&bar[XB_TOPGEN]) == tg, bar);
            __builtin_amdgcn_fence(__ATOMIC_ACQUIRE, "agent");
            xb_add(&bar[XB_XGEN(b.x)], 1u);
            asm volatile("s_waitcnt vmcnt(0)" ::: "memory");
        } else {
            XB_SPIN(xb_ld(&bar[XB_XGEN(b.x)]) == gen, bar);
            __builtin_amdgcn_fence(__ATOMIC_ACQUIRE, "agent");
            asm volatile("s_waitcnt vmcnt(0)" ::: "memory");
        }
    }
    __syncthreads();
}


struct Frame {
    LAS unsigned char* lds; unsigned* ctl; unsigned char* ws;
    int tid, lane, wave, vcu, G, gw, ngw;
};
__device__ const float ROPE_INV[16] = {1.0f, 0.5623413251903491f, 0.31622776601683794f, 0.1778279410038923f, 0.1f, 0.05623413251903491f, 0.03162277660168379f, 0.01778279410038923f,
                                       0.01f, 0.005623413251903491f, 0.0031622776601683794f, 0.001778279410038923f, 0.001f, 0.0005623413251903491f, 0.00031622776601683794f, 0.0001778279410038923f};

__device__ __forceinline__ void p0_transpose_item(const float* W, int K, int N, bf16* WT, LAS float* scr, int item, int lane) {
    const int nblk = N / 32, kb = item / nblk, nb = item % nblk, k0 = 64 * kb, n0 = 32 * nb;
#pragma unroll 8
    for (int i = 0; i < 32; ++i) { const int kk = 2 * i + (lane >> 5); scr[kk * 33 + (lane & 31)] = W[(size_t)(k0 + kk) * N + n0 + (lane & 31)]; }
    LDS_WAIT(); asm volatile("" ::: "memory");
    const int c = lane & 7;
#pragma unroll
    for (int j = 0; j < 4; ++j) { const int n = (lane >> 3) + 8 * j; const LAS float* s = scr + (8 * c) * 33 + n;
        v4u o; o.x = pk2(s[0 * 33], s[1 * 33]); o.y = pk2(s[2 * 33], s[3 * 33]); o.z = pk2(s[4 * 33], s[5 * 33]); o.w = pk2(s[6 * 33], s[7 * 33]);
        *(GAS v4u*)(WT + (size_t)(n0 + n) * K + k0 + 8 * c) = o; }
    LDS_WAIT(); asm volatile("" ::: "memory");
}

__device__ __forceinline__ void p0_transpose_item_f8(const float* W, int K, int N, unsigned char* WT, LAS float* scr, int item, int lane) {
    const int nblk = N / 32, kb = item / nblk, nb = item % nblk, k0 = 64 * kb, n0 = 32 * nb;
#pragma unroll 8
    for (int i = 0; i < 32; ++i) { const int kk = 2 * i + (lane >> 5); scr[kk * 33 + (lane & 31)] = W[(size_t)(k0 + kk) * N + n0 + (lane & 31)]; }
    LDS_WAIT(); asm volatile("" ::: "memory");
    const int c = lane & 7;
#pragma unroll
    for (int j = 0; j < 4; ++j) { const int n = (lane >> 3) + 8 * j; const LAS float* s = scr + (8 * c) * 33 + n;
        v2u o; o.x = pg8::pack4_fp8(s[0 * 33] * pg8::F8_SW, s[1 * 33] * pg8::F8_SW, s[2 * 33] * pg8::F8_SW, s[3 * 33] * pg8::F8_SW);
        o.y = pg8::pack4_fp8(s[4 * 33] * pg8::F8_SW, s[5 * 33] * pg8::F8_SW, s[6 * 33] * pg8::F8_SW, s[7 * 33] * pg8::F8_SW);
        *(GAS v2u*)(WT + (size_t)(n0 + n) * K + k0 + 8 * c) = o; }
    LDS_WAIT(); asm volatile("" ::: "memory");
}

__device__ __forceinline__ void ph_prologue_a(const Frame& F, const float* c, const float* cctx, const float* w_mod, const float* b_mod, const float* w_in, const float* w_out,
                                              const float* moe_w1, const float* moe_w2, const float* hy_w1, const float* hy_b1, const float* hy_w2, const float* hy_b2, const float* hy_freq, const float* lru_gw, const float* lru_lam) {
    {
        LAS float* scr = (LAS float*)(F.lds + F.wave * 16384);
        constexpr int I_IN = 2 * 1024, I_OUT = 2 * 512, I_W1 = 64 * 1024, I_W2 = 64 * 512, NIT = I_IN + I_OUT + I_W1 + I_W2;
        bf16* WinT = (bf16*)(F.ws + WS_WINT); bf16* WoutT = (bf16*)(F.ws + WS_WOUTT); bf16* W1T = (bf16*)(F.ws + WS_W1T); bf16* W2T = (bf16*)(F.ws + WS_W2T);
        for (int it = F.gw; it < NIT; it += F.ngw) {
            int r = it;
            if (r < I_IN) { const int m = r >> 10; p0_transpose_item(w_in + (size_t)m * 1024 * 2048, 1024, 2048, WinT + (size_t)m * 2048 * 1024, scr, r & 1023, F.lane); continue; } r -= I_IN;
            if (r < I_OUT) { const int m = r >> 9; p0_transpose_item(w_out + (size_t)m * 1024 * 1024, 1024, 1024, WoutT + (size_t)m * 1024 * 1024, scr, r & 511, F.lane); continue; } r -= I_OUT;
#if MOE_FP8
            if (r < I_W1) { const int m = r >> 10; p0_transpose_item_f8(moe_w1 + (size_t)m * 1024 * 2048, 1024, 2048, (unsigned char*)W1T + (size_t)m * 2048 * 1024, scr, r & 1023, F.lane); continue; } r -= I_W1;
            { const int m = r >> 9; p0_transpose_item_f8(moe_w2 + (size_t)m * 1024 * 1024, 1024, 1024, (unsigned char*)W2T + (size_t)m * 1024 * 1024, scr, r & 511, F.lane); }
#else
            if (r < I_W1) { const int m = r >> 10; p0_transpose_item(moe_w1 + (size_t)m * 1024 * 2048, 1024, 2048, W1T + (size_t)m * 2048 * 1024, scr, r & 1023, F.lane); continue; } r -= I_W1;
            { const int m = r >> 9; p0_transpose_item(moe_w2 + (size_t)m * 1024 * 1024, 1024, 1024, W2T + (size_t)m * 1024 * 1024, scr, r & 511, F.lane); }
#endif
        }
    }
    __syncthreads();
    {
        LAS float* sl = (LAS float*)(F.lds);
        LAS float* red = (LAS float*)(F.lds + 20480);
        float* MOD = (float*)(F.ws + WS_MOD);
        if ((int)blockIdx.x < 192) {
            for (int i = F.tid; i < 5 * 1024; i += NTHR) { const int r = i >> 10, k = i & 1023; const float v = (r < 4) ? c[r * 1024 + k] : cctx[k]; sl[i] = v / (1.0f + __expf(-v)); }
        }
        __syncthreads();
        for (int it = blockIdx.x; it < 192; it += F.G) {
            const int l = it / 96, n = (it % 96) * 64 + F.lane;
            float a0 = 0.f, a1 = 0.f, a2 = 0.f, a3 = 0.f, a4 = 0.f;
            const float* wp = w_mod + ((size_t)l * 1024 + F.wave * 128) * 6144 + n;
#pragma unroll 8
            for (int k = 0; k < 128; ++k) { const float w = wp[(size_t)k * 6144]; const int kk = F.wave * 128 + k;
                a0 += sl[kk] * w; a1 += sl[1024 + kk] * w; a2 += sl[2048 + kk] * w; a3 += sl[3072 + kk] * w; a4 += sl[4096 + kk] * w; }
            red[(F.wave * 5 + 0) * 64 + F.lane] = a0; red[(F.wave * 5 + 1) * 64 + F.lane] = a1; red[(F.wave * 5 + 2) * 64 + F.lane] = a2; red[(F.wave * 5 + 3) * 64 + F.lane] = a3; red[(F.wave * 5 + 4) * 64 + F.lane] = a4;
            __syncthreads();
            if (F.tid < 320) { const int r = F.tid >> 6, ln = F.tid & 63; float s = 0.f;
#pragma unroll
                for (int w = 0; w < 8; ++w) s += red[(w * 5 + r) * 64 + ln];
                const int nn = (it % 96) * 64 + ln; MOD[(size_t)(l * 5 + r) * 6144 + nn] = s + b_mod[l * 6144 + nn]; }
            __syncthreads();
        }
    }
    {
        bf16* WGT = (bf16*)(F.ws + WS_WGT); float* SPT = (float*)(F.ws + WS_SPT);
        for (int idx = blockIdx.x * NTHR + F.tid; idx < 2 * 1024 * 256; idx += F.G * NTHR) {
            const int l = idx >> 18, nidx = (idx >> 8) & 1023, k = idx & 255;
            const int pn = nidx >> 8, j = (nidx >> 7) & 1, cc = nidx & 127, d = pn >> 1, ch = 128 * (pn & 1) + cc, n = ch >> 6, e = ch & 63;
            const float v = ((k >> 6) == n) ? lru_gw[((size_t)((((l * 2 + d) * 2 + j) * 4 + n) * 64 + (k & 63))) * 64 + e] : 0.f;
            WGT[idx] = (bf16)f2bf(v); }
        for (int idx = blockIdx.x * NTHR + F.tid; idx < 2 * 2 * 256; idx += F.G * NTHR) SPT[idx] = log1pf(expf(-lru_lam[idx]));
    }
    {
        float* RC = (float*)(F.ws + WS_ROPEC); float* RS = (float*)(F.ws + WS_ROPES);
        for (int idx = blockIdx.x * NTHR + F.tid; idx < SEQ * 32; idx += F.G * NTHR) {
            const int t = idx >> 5, i = idx & 31; const int pos = (i < 16) ? (t >> 6) : (t & 63);
            const float ang = (float)pos * ROPE_INV[i & 15];
            double s, cc; sincos_d((double)ang, s, cc); RC[idx] = (float)cc; RS[idx] = (float)s; }
    }
    {
        float* H2 = (float*)(F.ws + WS_H2);
        for (int it = F.gw; it < 2 * SEQ + CTXL; it += F.ngw) {
            const int v = it >> 13, t = (v < 2) ? (it & (SEQ - 1)) : (it - 2 * SEQ), L = (v < 2) ? SEQ : CTXL, l = (v == 1) ? 1 : 0;
            const int j = F.lane;
            float z = 0.f;
            if (j == 0) z = (float)t / (float)(L - 1);
            else if (j <= 32) { const int b = (j - 1) & 15; const float band = 1e-4f + (float)b * ((15.0f - 1e-4f) / 15.0f);
                const float ang = ((6.283185307179586f / (float)L) * (float)t) * band;
                double s, cc; sincos_d((double)ang, s, cc); z = (j <= 16) ? (float)cc : -(float)s; }
            const float fr = hy_freq[l * 64 + j];
            float p1 = hy_b1[l * 64 + j];
            const float* w1 = hy_w1 + (size_t)l * 33 * 64;
#pragma unroll
            for (int i = 0; i < 33; ++i) p1 += __shfl(z, i) * w1[i * 64 + j];
            double s1, c1; sincos_d((double)(fr * p1), s1, c1); const float h1 = (float)s1;
            float p2 = hy_b2[l * 64 + j];
            const float* w2 = hy_w2 + (size_t)l * 64 * 64;
#pragma unroll 16
            for (int i = 0; i < 64; ++i) p2 += __shfl(h1, i) * w2[i * 64 + j];
            double s2, c2; sincos_d((double)(fr * p2), s2, c2);
            H2[((size_t)v * SEQ + t) * 64 + j] = (float)s2;
        }
    }
}

__device__ __forceinline__ void ph_prologue_b(const Frame& F, const float* hy_w3, const float* hy_decay, const float* gffn, const float* router_w, const float* router_b) {
    { const float* MOD = (const float*)(F.ws + WS_MOD); float* CB = (float*)(F.ws + WS_CB);
      for (int it = F.gw; it < 2 * 5 * 32; it += F.ngw) { const int lb = it >> 5, e = it & 31, l = lb / 5; const float* sf = MOD + (size_t)lb * 6144 + 3 * 1024; float s = 0.f;
#pragma unroll
          for (int q = 0; q < 16; ++q) { const int cc = 64 * q + F.lane; s += sf[cc] * router_w[(size_t)l * 32768 + cc * 32 + e]; }
          s = wave_sum(s); if (F.lane == 0) CB[it] = s + router_b[l * 32 + e]; } }
    { const float* MOD = (const float*)(F.ws + WS_MOD); float* GC = (float*)(F.ws + WS_GC);
      for (int idx = blockIdx.x * NTHR + F.tid; idx < 2 * 5 * 1024; idx += F.G * NTHR) { const int lb = idx >> 10, cc = idx & 1023, l = lb / 5; GC[idx] = gffn[l * 1024 + cc] * (1.0f + MOD[(size_t)lb * 6144 + 4 * 1024 + cc]); } }
    LAS f32x2v* D = (LAS f32x2v*)(F.lds);
    LAS float* kt = (LAS float*)(F.lds);
    LAS float* w3c = (LAS float*)(F.lds + 139264);
    LAS float* red = (LAS float*)(F.lds + 139264 + 512);
    const float* H2 = (const float*)(F.ws + WS_H2);
    c32* KHAT = (c32*)(F.ws + WS_KHAT); float* KFC = (float*)(F.ws + WS_KFC);
    for (int it = blockIdx.x; it < 768; it += F.G) {
        const int v = it >> 8, c = it & 255, L = (v < 2) ? SEQ : CTXL, l = (v == 1) ? 1 : 0;
        if (F.tid < 128) w3c[F.tid] = hy_w3[(size_t)l * 64 * 512 + (F.tid & 63) * 512 + (F.tid >> 6) * 256 + c];
        if (F.tid == 0) { if (v < 2) { f32x2v z; z.x = 0.f; z.y = 0.f; D[fpad(L)] = z; } else kt[L] = 0.f; }
        __syncthreads();
        const float df = fabsf(hy_decay[l * 512 + c]), db = fabsf(hy_decay[l * 512 + 256 + c]);
        float asum = 0.f;
        for (int t = F.tid; t < L; t += NTHR) {
            const f32x4* row = (const f32x4*)(H2 + ((size_t)v * SEQ + t) * 64);
            float hf = 0.f, hb = 0.f;
#pragma unroll
            for (int q = 0; q < 16; ++q) { const f32x4 h = row[q];
                hf += h.x * w3c[4 * q] + h.y * w3c[4 * q + 1] + h.z * w3c[4 * q + 2] + h.w * w3c[4 * q + 3];
                hb += h.x * w3c[64 + 4 * q] + h.y * w3c[64 + 4 * q + 1] + h.z * w3c[64 + 4 * q + 2] + h.w * w3c[64 + 4 * q + 3]; }
            const float t01 = (float)t / (float)(L - 1);
            hf *= expf(-t01 * df); hb *= expf(-t01 * db);
            asum += fabsf(hf); if (t >= 1) asum += fabsf(hb);
            if (v < 2) { f32x2v z; z.x = hf; z.y = 0.f; D[fpad(t)] = z; if (t >= 1) { z.x = hb; D[fpad(2 * L - t)] = z; } }
            else { kt[t] = hf; if (t >= 1) kt[2 * L - t] = hb; }
        }
        asum = wave_sum(asum);
        if (F.lane == 0) red[F.wave] = asum;
        __syncthreads();
        float tot = 0.f;
#pragma unroll
        for (int w = 0; w < 8; ++w) tot += red[w];
        const float inv = 1.0f / tot;
        if (v < 2) {
            c32* out = KHAT + (size_t)(v * 256 + c) * 16384;
#pragma unroll 1
            for (int i = 0; i < 8; ++i) fft_first4_inplace(D, F.tid + 512 * i);
            __syncthreads();
            { fft_fwd16(D, F.tid, 4096); fft_fwd16(D, F.tid + 512, 4096); }
            __syncthreads();
            { fft_fwd16(D, F.tid, 256); fft_fwd16(D, F.tid + 512, 256); }
            __syncthreads();
            _Pragma("unroll 1") for (int g_ = F.tid; g_ < 1024; g_ += 512) fft_last16_out(D, g_, out, inv * (1.0f / 16384.0f));
        } else {
            float* dst = KFC + (size_t)c * 512;
            for (int j = F.tid; j < 2 * L; j += NTHR) dst[j] = kt[j] * inv;
        }
        __syncthreads();
    }
}

__device__ __forceinline__ void ph_norm_mod(const Frame& F, int l, const float* x, const float* ctx, const float* gmix) {
    const float* XR = (const float*)(F.ws + WS_XR); const float* MOD = (const float*)(F.ws + WS_MOD); bf16* H = (bf16*)(F.ws + WS_H);
    for (int r = F.gw; r < MT; r += F.ngw) {
        const float* src = (l == 0) ? (r < NLAT ? x + (size_t)r * 1024 : ctx + (size_t)(r - NLAT) * 1024) : XR + (size_t)r * 1024;
        const int bidx = r < NLAT ? r / SEQ : 4;
        const float* shift = MOD + (size_t)(l * 5 + bidx) * 6144; const float* scale = shift + 1024; const float* g = gmix + l * 1024;
        f32x4 v[4]; float ss = 0.f;
#pragma unroll
        for (int j = 0; j < 4; ++j) { v[j] = ((const f32x4*)src)[64 * j + F.lane]; ss += (v[j].x * v[j].x + v[j].y * v[j].y) + (v[j].z * v[j].z + v[j].w * v[j].w); }
        const float rstd = 1.0f / sqrtf(wave_sum(ss) * (1.0f / 1024.0f) + EPSN);
#pragma unroll
        for (int j = 0; j < 4; ++j) { const int cb = 64 * j + F.lane; const f32x4 gg = ((const f32x4*)g)[cb], sc = ((const f32x4*)scale)[cb], sh = ((const f32x4*)shift)[cb];
            const f32x4 y = v[j] * rstd * gg * (sc + 1.0f) + sh;
            v2u o; o.x = pk2(y.x, y.y); o.y = pk2(y.z, y.w); ((v2u*)(H + (size_t)r * 1024))[cb] = o; }
    }
}

__device__ __forceinline__ void ph_post_proj(const Frame& F, int l, const float* qg_, const float* kg_, const float* lru_cw, const float* lru_cb, const float* hy_cw, const float* hy_cb) {
    const bf16* U = (const bf16*)(F.ws + WS_U);
    {
        bf16* K = (bf16*)(F.ws + WS_K); bf16* V = (bf16*)(F.ws + WS_V);
        const float* RC = (const float*)(F.ws + WS_ROPEC); const float* RS = (const float*)(F.ws + WS_ROPES);
        const int o8 = 8 * (F.lane & 7), hl = F.lane & 31;
        const f32x4 kg0 = *(const f32x4*)(kg_ + l * 64 + o8), kg1 = *(const f32x4*)(kg_ + l * 64 + o8 + 4);
        const bool lohalf = (F.lane & 4) == 0;
        for (int r2 = 2 * F.gw; r2 < MT; r2 += 2 * F.ngw) {
            const int r = r2 + (F.lane >> 5);
            const bool isctx = r >= NLAT; const int b = isctx ? (r - NLAT) / CTXL : r / SEQ; const int t = isctx ? (r - NLAT) % CTXL : r % SEQ;
            const v4u wk = ((const v4u*)(U + (size_t)r * INW + 512))[hl];
            f32x4 c0 = {1.f, 1.f, 1.f, 1.f}, c1 = c0, s0 = {0.f, 0.f, 0.f, 0.f}, s1 = s0;
            if (!isctx) { const float* rc = RC + t * 32 + 8 * (F.lane & 3); const float* rs = RS + t * 32 + 8 * (F.lane & 3);
                c0 = *(const f32x4*)rc; c1 = *(const f32x4*)(rc + 4); s0 = *(const f32x4*)rs; s1 = *(const f32x4*)(rs + 4); }
            const size_t krow = (size_t)b * KEYS + (isctx ? t : CTXL + t);
            float x[8] = {bflo(wk.x), bfhi(wk.x), bflo(wk.y), bfhi(wk.y), bflo(wk.z), bfhi(wk.z), bflo(wk.w), bfhi(wk.w)};
            float ss = 0.f;
#pragma unroll
            for (int i = 0; i < 8; ++i) ss += x[i] * x[i];
            ss += __shfl_xor(ss, 1); ss += __shfl_xor(ss, 2); ss += __shfl_xor(ss, 4);
            const float rstd = 1.0f / sqrtf(ss * (1.0f / 64.0f) + EPSN);
            float y[8], o[8];
#pragma unroll
            for (int i = 0; i < 8; ++i) y[i] = x[i] * rstd * (i < 4 ? kg0[i] : kg1[i - 4]);
#pragma unroll
            for (int i = 0; i < 8; ++i) { const float p = __shfl_xor(y[i], 4); const float cs = i < 4 ? c0[i] : c1[i - 4], sn = i < 4 ? s0[i] : s1[i - 4];
                o[i] = lohalf ? (y[i] * cs - p * sn) : (y[i] * cs + p * sn); }
            v4u ow; ow.x = pk2(o[0], o[1]); ow.y = pk2(o[2], o[3]); ow.z = pk2(o[4], o[5]); ow.w = pk2(o[6], o[7]);
            if (hl < 16) ((v4u*)(K + krow * 128))[hl] = ow; else ((v4u*)(V + krow * 128))[hl - 16] = wk;
        }
    }
    {
        bf16* XL = (bf16*)(F.ws + WS_XL);
        for (int idx = blockIdx.x * NTHR + F.tid; idx < MT * 32; idx += F.G * NTHR) {
            const int r = idx >> 5, c8 = (idx & 31) * 8;
            const bool isctx = r >= NLAT; const int Ls = isctx ? CTXL : SEQ; const int t = isctx ? (r - NLAT) % CTXL : r % SEQ;
            float acc[8];
#pragma unroll
            for (int i = 0; i < 8; ++i) acc[i] = lru_cb[l * 256 + c8 + i];
#pragma unroll
            for (int j = 0; j < 4; ++j) { const int tj = t + j - 2;
                if (tj >= 0 && tj < Ls) { const v4u w = *(const v4u*)(U + (size_t)(r + j - 2) * INW + 768 + c8);
                    const f32x4 w0 = *(const f32x4*)(lru_cw + (l * 4 + j) * 256 + c8), w1 = *(const f32x4*)(lru_cw + (l * 4 + j) * 256 + c8 + 4);
                    acc[0] += w0.x * bflo(w.x); acc[1] += w0.y * bfhi(w.x); acc[2] += w0.z * bflo(w.y); acc[3] += w0.w * bfhi(w.y);
                    acc[4] += w1.x * bflo(w.z); acc[5] += w1.y * bfhi(w.z); acc[6] += w1.z * bflo(w.w); acc[7] += w1.w * bfhi(w.w); } }
            v4u o; o.x = pk2(acc[0], acc[1]); o.y = pk2(acc[2], acc[3]); o.z = pk2(acc[4], acc[5]); o.w = pk2(acc[6], acc[7]);
            *(v4u*)(XL + (size_t)r * 256 + c8) = o;
        }
    }
    __syncthreads();
    {
        LAS bf16* hs = (LAS bf16*)(F.lds);
        bf16* VT = (bf16*)(F.ws + WS_VT); bf16* X0T = (bf16*)(F.ws + WS_X0T);
        const float* cw = hy_cw + (size_t)l * 3 * 768; const float* cbp = hy_cb + l * 768;
        for (int it = blockIdx.x; it < NLAT / 64; it += F.G) {
            const int b = it >> 7, t0 = (it & 127) * 64;
            for (int i = F.tid; i < 66 * 384; i += NTHR) { const int rr = i / 384, c2 = i - rr * 384; const int t = t0 - 1 + rr;
                unsigned w = 0u; if (t >= 0 && t < SEQ) w = *(const unsigned*)(U + (size_t)(b * SEQ + t) * INW + 1280 + 2 * c2);
                *(LAS unsigned*)(hs + rr * 770 + 2 * c2) = w; }
            __syncthreads();
            for (int c = F.wave; c < 256; c += NWAVES) {
                const int tt = F.lane;
                float o[3];
#pragma unroll
                for (int g = 0; g < 3; ++g) { const int cc = g * 256 + c;
                    o[g] = cw[cc] * bf2f(hs[tt * 770 + cc]) + cw[768 + cc] * bf2f(hs[(tt + 1) * 770 + cc]) + cw[1536 + cc] * bf2f(hs[(tt + 2) * 770 + cc]) + cbp[cc]; }
                const size_t oi = ((size_t)b * 256 + c) * SEQ + t0 + tt;
                VT[oi] = (bf16)f2bf(o[2] * o[1]); X0T[oi] = (bf16)f2bf(o[0]);
            }
            __syncthreads();
        }
    }
}


__device__ __forceinline__ int chunk_row0(int b, int d, int k) {
    if (k < 2) { const int cc = d ? 1 - k : k; return NLAT + b * CTXL + cc * CHUNK; }
    const int lc = d ? 63 - (k - 2) : (k - 2); return b * SEQ + lc * CHUNK;
}
__device__ __forceinline__ void ph_scan1(const Frame& F) {
    const bf16* LAB = (const bf16*)(F.ws + WS_LAB); float* SUMP = (float*)(F.ws + WS_SCANS); float* SUMH = SUMP + NB * 2 * NCHUNK * 256;
    for (int it = blockIdx.x * NTHR + F.tid; it < NB * 2 * NCHUNK * 256; it += F.G * NTHR) {
        const int ch = it & 255, k = (it >> 8) % NCHUNK, bd = (it >> 8) / NCHUNK, d = bd & 1, b = bd >> 1;
        const int r0 = chunk_row0(b, d, k);
        const bf16* LA = LAB + (size_t)(2 * d) * LAB_STRIDE + ch; const bf16* LB = LAB + (size_t)(2 * d + 1) * LAB_STRIDE + ch;
        float h = 0.f, Ps = 0.f;
#pragma unroll 16
        for (int i = 0; i < CHUNK; ++i) { const int r = d ? r0 + CHUNK - 1 - i : r0 + i; const float la = bf2f(LA[(size_t)r * 256]), bx = bf2f(LB[(size_t)r * 256]); h = __builtin_amdgcn_exp2f(la) * h + bx; Ps += la; }
        SUMP[it] = __builtin_amdgcn_exp2f(Ps); SUMH[it] = h;
    }
}
__device__ __forceinline__ void ph_scan2(const Frame& F) {
    const bf16* LAB = (const bf16*)(F.ws + WS_LAB); const float* SUMP = (const float*)(F.ws + WS_SCANS); const float* SUMH = SUMP + NB * 2 * NCHUNK * 256;
    float* LRUO = (float*)(F.ws + WS_LRUO); const bf16* U = (const bf16*)(F.ws + WS_U);
    for (int it = blockIdx.x * NTHR + F.tid; it < NB * NCHUNK * 256; it += F.G * NTHR) {
        const int ch = it & 255, kc = (it >> 8) % NCHUNK, b = (it >> 8) / NCHUNK;
        const int r0 = chunk_row0(b, 0, kc);
#pragma unroll 1
        for (int d = 0; d < 2; ++d) {
            const int k = d ? ((kc < 2) ? 1 - kc : 2 + 63 - (kc - 2)) : kc;
            const size_t sb = (size_t)((b * 2 + d) * NCHUNK) * 256 + ch;
            float h = 0.f;
#pragma unroll 8
            for (int j = 0; j < k; ++j) h = SUMP[sb + (size_t)j * 256] * h + SUMH[sb + (size_t)j * 256];
            const bf16* LA = LAB + (size_t)(2 * d) * LAB_STRIDE + ch; const bf16* LB = LAB + (size_t)(2 * d + 1) * LAB_STRIDE + ch;
            if (d == 0) {
#pragma unroll 16
                for (int i = 0; i < CHUNK; ++i) { const int r = r0 + i; h = __builtin_amdgcn_exp2f(bf2f(LA[(size_t)r * 256])) * h + bf2f(LB[(size_t)r * 256]); LRUO[(size_t)r * 256 + ch] = h; }
            } else {
#pragma unroll 8
                for (int i = 0; i < CHUNK; ++i) { const int r = r0 + CHUNK - 1 - i; h = __builtin_amdgcn_exp2f(bf2f(LA[(size_t)r * 256])) * h + bf2f(LB[(size_t)r * 256]);
                    const float lg = bf2f(U[(size_t)r * INW + 1024 + ch]);
                    LRUO[(size_t)r * 256 + ch] = (LRUO[(size_t)r * 256 + ch] + h) * gelu_tanh(lg); }
            }
        }
    }
}

__device__ __forceinline__ void ph_hyena_fft(const Frame& F, int l, const float* hy_bias) {
    LAS f32x2v* D = (LAS f32x2v*)(F.lds);
    const c32* KHAT = (const c32*)(F.ws + WS_KHAT) + (size_t)l * 256 * 16384;
    const bf16* VT = (const bf16*)(F.ws + WS_VT); const bf16* X0T = (const bf16*)(F.ws + WS_X0T); bf16* HYO = (bf16*)(F.ws + WS_HYO);
    for (int it = blockIdx.x; it < 512; it += F.G) {
        const int c = it >> 1, bp = it & 1;
        const bf16* va = VT + ((size_t)(bp * 2) * 256 + c) * SEQ; const bf16* vb = VT + ((size_t)(bp * 2 + 1) * 256 + c) * SEQ;
#ifndef REP_FFT
#define REP_FFT 1
#endif
#pragma unroll 1
        for (int repf_ = 0; repf_ < REP_FFT; ++repf_) {
#pragma unroll 1
        for (int i = 0; i < 8; ++i) { const int j = F.tid + 512 * i; c32 x0, x1, z; x0.x = bf2f(va[j]); x0.y = bf2f(vb[j]); x1.x = bf2f(va[j + 4096]); x1.y = bf2f(vb[j + 4096]); z.x = 0.f; z.y = 0.f;
            fft_first4(D, j, x0, x1, z, z); }
        __syncthreads();
        { fft_fwd16(D, F.tid, 4096); fft_fwd16(D, F.tid + 512, 4096); }
        __syncthreads();
        { fft_fwd16(D, F.tid, 256); fft_fwd16(D, F.tid + 512, 256); }
        __syncthreads();
        _Pragma("unroll 1") for (int g_ = F.tid; g_ < 1024; g_ += 512) fft_mid16(D, g_, KHAT + (size_t)c * 16384);
        __syncthreads();
        { fft_inv16(D, F.tid, 256); fft_inv16(D, F.tid + 512, 256); }
        __syncthreads();
        { fft_inv16(D, F.tid, 4096); fft_inv16(D, F.tid + 512, 4096); }
        __syncthreads();
        }
        const float bias = hy_bias[l * 256 + c];
        const bf16* xa = X0T + ((size_t)(bp * 2) * 256 + c) * SEQ; const bf16* xb = X0T + ((size_t)(bp * 2 + 1) * 256 + c) * SEQ;
        bf16* oa = HYO + ((size_t)(bp * 2) * 256 + c) * SEQ; bf16* ob = HYO + ((size_t)(bp * 2 + 1) * 256 + c) * SEQ;
#pragma unroll 2
        for (int i = 0; i < 8; ++i) { const int j = F.tid + 512 * i; c32 u0, u1; fft_final4(D, j, u0, u1);
            oa[j] = (bf16)f2bf((u0.x + bf2f(va[j]) * bias) * bf2f(xa[j]));                 ob[j] = (bf16)f2bf((-u0.y + bf2f(vb[j]) * bias) * bf2f(xb[j]));
            oa[j + 4096] = (bf16)f2bf((u1.x + bf2f(va[j + 4096]) * bias) * bf2f(xa[j + 4096])); ob[j + 4096] = (bf16)f2bf((-u1.y + bf2f(vb[j + 4096]) * bias) * bf2f(xb[j + 4096])); }
        __syncthreads();
    }
}
__device__ __forceinline__ void ph_hyena_ctx(const Frame& F, const float* hy_bias, const float* hy_cw, const float* hy_cb) {
    float* HYO = (float*)(F.ws + WS_HYO);
    {

        const bf16* U = (const bf16*)(F.ws + WS_U); const float* KFC = (const float*)(F.ws + WS_KFC);
        LAS float* vw = (LAS float*)(F.lds + F.wave * 4096);
        LAS float* kw = vw + 256;
        const float* cw = hy_cw; const float* cbp = hy_cb;
        for (int it = F.gw; it < NB * 256; it += F.ngw) {
            const int b = it >> 8, c = it & 255;
            float x0v[4];
#pragma unroll
            for (int i = 0; i < 4; ++i) { const int t = F.lane + 64 * i;
                float o[3];
#pragma unroll
                for (int g = 0; g < 3; ++g) { const int cc = g * 256 + c; float a = cbp[cc];
#pragma unroll
                    for (int j = 0; j < 3; ++j) { const int tj = t + j - 1; if (tj >= 0 && tj < CTXL) a += cw[j * 768 + cc] * bf2f(U[(size_t)(NLAT + b * CTXL + tj) * INW + 1280 + cc]); }
                    o[g] = a; }
                vw[t] = o[2] * o[1]; x0v[i] = o[0]; }
#pragma unroll
            for (int i = 0; i < 8; ++i) kw[F.lane + 64 * i] = KFC[c * 512 + F.lane + 64 * i];
            LDS_WAIT();
            float y[4] = {0.f, 0.f, 0.f, 0.f};
#pragma unroll 4
            for (int s = 0; s < CTXL; ++s) { const float vv = vw[s];
#pragma unroll
                for (int i = 0; i < 4; ++i) y[i] += kw[(F.lane + 64 * i - s) & 511] * vv; }
            const float bias = hy_bias[c];
#pragma unroll
            for (int i = 0; i < 4; ++i) { const int t = F.lane + 64 * i; HYO[(size_t)(NLAT + b * CTXL + t) * 256 + c] = (y[i] + vw[t] * bias) * x0v[i]; }
            LDS_WAIT();
        }
    }
}

__device__ __forceinline__ void merge_row(const Frame& F, int r, const float* g, float h0, float h1, float h2, float h3) {
    const bf16* ATT = (const bf16*)(F.ws + WS_ATT); const float* LRUO = (const float*)(F.ws + WS_LRUO); bf16* MIXA = (bf16*)(F.ws + WS_MIXA);
    const v4u aw = ((const v4u*)(ATT + (size_t)r * 512))[F.lane];
    float a[8] = {bflo(aw.x), bfhi(aw.x), bflo(aw.y), bfhi(aw.y), bflo(aw.z), bfhi(aw.z), bflo(aw.w), bfhi(aw.w)};
    float ss = 0.f;
#pragma unroll
    for (int i = 0; i < 8; ++i) ss += a[i] * a[i];
    const float ra = 1.0f / sqrtf(wave_sum(ss) * (1.0f / 512.0f) + EPSN);
    const f32x4 lv = ((const f32x4*)(LRUO + (size_t)r * 256))[F.lane];
    const float rl = 1.0f / sqrtf(wave_sum(lv.x * lv.x + lv.y * lv.y + lv.z * lv.z + lv.w * lv.w) * (1.0f / 256.0f) + EPSN);
    const float rh = 1.0f / sqrtf(wave_sum(h0 * h0 + h1 * h1 + h2 * h2 + h3 * h3) * (1.0f / 256.0f) + EPSN);
    bf16* orow = MIXA + (size_t)r * 1024;
    { const f32x4 g0 = ((const f32x4*)g)[2 * F.lane], g1 = ((const f32x4*)g)[2 * F.lane + 1];
      v4u o; o.x = pk2(a[0] * ra * g0.x, a[1] * ra * g0.y); o.y = pk2(a[2] * ra * g0.z, a[3] * ra * g0.w); o.z = pk2(a[4] * ra * g1.x, a[5] * ra * g1.y); o.w = pk2(a[6] * ra * g1.z, a[7] * ra * g1.w);
      ((v4u*)orow)[F.lane] = o; }
    { const f32x4 gg = ((const f32x4*)(g + 512))[F.lane]; v2u o; o.x = pk2(lv.x * rl * gg.x, lv.y * rl * gg.y); o.y = pk2(lv.z * rl * gg.z, lv.w * rl * gg.w); ((v2u*)(orow + 512))[F.lane] = o; }
    orow[768 + F.lane] = (bf16)f2bf(h0 * rh * g[768 + F.lane]); orow[832 + F.lane] = (bf16)f2bf(h1 * rh * g[832 + F.lane]);
    orow[896 + F.lane] = (bf16)f2bf(h2 * rh * g[896 + F.lane]); orow[960 + F.lane] = (bf16)f2bf(h3 * rh * g[960 + F.lane]);
}
__device__ __forceinline__ void ph_merge(const Frame& F, int l, int nrows, const float* out_g) {
    const float* HYO = (const float*)(F.ws + WS_HYO);
    const float* g = out_g + l * 1024;
    LAS float* tile = (LAS float*)(F.lds);
    for (int it = blockIdx.x; it < NLAT / 64; it += F.G) {
        const int b = it >> 7, t0 = (it & 127) * 64;
#pragma unroll 8
        for (int i = 0; i < 32; ++i) { const int c = F.wave * 32 + i; tile[c * 65 + F.lane] = bf2f(((const bf16*)HYO)[((size_t)b * 256 + c) * SEQ + t0 + F.lane]); }
        __syncthreads();
#pragma unroll 2
        for (int k = 0; k < 8; ++k) { const int tt = F.wave * 8 + k;
            merge_row(F, b * SEQ + t0 + tt, g, tile[F.lane * 65 + tt], tile[(F.lane + 64) * 65 + tt], tile[(F.lane + 128) * 65 + tt], tile[(F.lane + 192) * 65 + tt]); }
        __syncthreads();
    }
    for (int r = NLAT + F.gw; r < nrows; r += F.ngw) {
        const float* hr = HYO + (size_t)r * 256;
        merge_row(F, r, g, hr[F.lane], hr[64 + F.lane], hr[128 + F.lane], hr[192 + F.lane]);
    }
}


constexpr int RW_PITCH = 34;
__device__ __forceinline__ void router_cols(LAS const float* rwl, const bf16* XR, const float* gc, const float* sf, unsigned char* Fbytes, int r, float rstd, int j, int kq, int i0, int i1, f32x4& acc0, f32x4& acc1) {
    const bf16* xrow = XR + (size_t)r * 1024 + 8 * kq; const float* gcp = gc + 8 * kq; const float* sfp = sf + 8 * kq;
    v4u xn[4];
#pragma unroll
    for (int u = 0; u < 4; ++u) xn[u] = *(const v4u*)(xrow + 32 * (i0 + u));
#pragma unroll 1
    for (int ib = i0; ib < i1; ib += 4) {
        v4u xw[4]; f32x4 g4[4][2], s4[4][2];
#pragma unroll
        for (int u = 0; u < 4; ++u) { xw[u] = xn[u]; g4[u][0] = *(const f32x4*)(gcp + 32 * (ib + u)); g4[u][1] = *(const f32x4*)(gcp + 32 * (ib + u) + 4); s4[u][0] = *(const f32x4*)(sfp + 32 * (ib + u)); s4[u][1] = *(const f32x4*)(sfp + 32 * (ib + u) + 4); }
        if (ib + 4 < i1) {
#pragma unroll
            for (int u = 0; u < 4; ++u) xn[u] = *(const v4u*)(xrow + 32 * (ib + 4 + u)); }
#pragma unroll
        for (int u = 0; u < 4; ++u) {
            const float x[8] = {bflo(xw[u].x), bfhi(xw[u].x), bflo(xw[u].y), bfhi(xw[u].y), bflo(xw[u].z), bfhi(xw[u].z), bflo(xw[u].w), bfhi(xw[u].w)};
            float xb[8], fv[8];
#pragma unroll
            for (int e = 0; e < 8; ++e) { xb[e] = x[e] * g4[u][e >> 2][e & 3]; fv[e] = xb[e] * rstd + s4[u][e >> 2][e & 3]; }
#if MOE_FP8
            v2u o; o.x = pg8::pack4_fp8(fv[0] * pg8::F8_SF, fv[1] * pg8::F8_SF, fv[2] * pg8::F8_SF, fv[3] * pg8::F8_SF); o.y = pg8::pack4_fp8(fv[4] * pg8::F8_SF, fv[5] * pg8::F8_SF, fv[6] * pg8::F8_SF, fv[7] * pg8::F8_SF);
            *(v2u*)(Fbytes + (size_t)r * 1024 + 8 * kq + 32 * (ib + u)) = o;
#else
            v4u o; o.x = pk2(fv[0], fv[1]); o.y = pk2(fv[2], fv[3]); o.z = pk2(fv[4], fv[5]); o.w = pk2(fv[6], fv[7]); *(v4u*)((bf16*)Fbytes + (size_t)r * 1024 + 8 * kq + 32 * (ib + u)) = o;
#endif
            const LAS float* wp = rwl + (32 * (ib + u) + 8 * kq) * RW_PITCH + j;
#pragma unroll
            for (int e = 0; e < 8; ++e) { acc0 = __builtin_amdgcn_mfma_f32_16x16x4f32(wp[e * RW_PITCH], xb[e], acc0, 0, 0, 0); acc1 = __builtin_amdgcn_mfma_f32_16x16x4f32(wp[e * RW_PITCH + 16], xb[e], acc1, 0, 0, 0); }
        }
    }
}
__device__ __forceinline__ void router_finish(LAS const float* cbl, LAS int* hist, int* TOPI, float* GATE, int r, int bidx, float rstd, int j, int kq, const f32x4& acc0, const f32x4& acc1) {
    float lg[8];
#pragma unroll
    for (int rr = 0; rr < 4; ++rr) { lg[rr] = rstd * acc0[rr] + cbl[bidx * 32 + 4 * kq + rr]; lg[4 + rr] = rstd * acc1[rr] + cbl[bidx * 32 + 16 + 4 * kq + rr]; }
    float p[32];
#pragma unroll
    for (int e = 0; e < 32; ++e) p[e] = __shfl(lg[(e >> 4) * 4 + (e & 3)], j + 16 * ((e & 15) >> 2));
    unsigned taken = 0u; float tv[4]; int ti[4];
#pragma unroll
    for (int k = 0; k < 4; ++k) { float best = -INFINITY; int bi = 0;
#pragma unroll
        for (int e = 0; e < 32; ++e) { const bool ok = !((taken >> e) & 1u) && (p[e] > best); best = ok ? p[e] : best; bi = ok ? e : bi; }
        taken |= 1u << bi; tv[k] = best; ti[k] = bi; }
    const float e1 = __expf(tv[1] - tv[0]), e2 = __expf(tv[2] - tv[0]), e3 = __expf(tv[3] - tv[0]); const float inv = 1.0f / (1.0f + e1 + e2 + e3);
    if (kq == 0) {
        TOPI[r * 4 + 0] = ti[0]; TOPI[r * 4 + 1] = ti[1]; TOPI[r * 4 + 2] = ti[2]; TOPI[r * 4 + 3] = ti[3];
        GATE[r * 4 + 0] = inv; GATE[r * 4 + 1] = e1 * inv; GATE[r * 4 + 2] = e2 * inv; GATE[r * 4 + 3] = e3 * inv;
        lds_add(&hist[ti[0]], 1); lds_add(&hist[ti[1]], 1); lds_add(&hist[ti[2]], 1); lds_add(&hist[ti[3]], 1);
    }
}
__device__ __forceinline__ void ph_ffn_router(const Frame& F, int l, int nrows, const float* router_w) {
    LAS float* rwl = (LAS float*)(F.lds);
    LAS float* part = (LAS float*)(F.lds + 139264);
    LAS float* cbl = (LAS float*)(F.lds + 153600);
    LAS int* hist = (LAS int*)(F.lds + 153600 + 640);
    const bf16* XR = (const bf16*)(F.ws + WS_XR); const float* RSSP = (const float*)(F.ws + WS_RSSP); const float* MOD = (const float*)(F.ws + WS_MOD);
    const float* GC = (const float*)(F.ws + WS_GC) + (size_t)l * 5 * 1024; unsigned char* Fb = (unsigned char*)(F.ws + WS_F);
    int* TOPI = (int*)(F.ws + WS_TOPI); float* GATE = (float*)(F.ws + WS_GATE); int* BLKCNT = (int*)(F.ws + WS_BLKCNT);
    for (int i = F.tid; i < 1024 * 32; i += NTHR) rwl[(i >> 5) * RW_PITCH + (i & 31)] = router_w[(size_t)l * 32768 + i];
    if (F.tid < 32) hist[F.tid] = 0;
    if (F.tid < 160) cbl[F.tid] = ((const float*)(F.ws + WS_CB))[l * 160 + F.tid];
    __syncthreads();
    const int j = F.lane & 15, kq = F.lane >> 4;
    const int ngrp = nrows / 16, nmain = (ngrp / F.ngw) * F.ngw;
    for (int grp = F.gw; grp < nmain; grp += F.ngw) {
        const int r0 = grp * 16, r = r0 + j; const int bidx = r0 < NLAT ? r0 / SEQ : 4;
        float ss; { const f32x4 q = *(const f32x4*)(RSSP + (size_t)r * 16 + 4 * kq); ss = (q.x + q.y) + (q.z + q.w); }
        ss += __shfl_xor(ss, 16); ss += __shfl_xor(ss, 32);
        const float rstd = 1.0f / sqrtf(ss * (1.0f / 1024.0f) + EPSN);
        f32x4 acc0 = {0.f, 0.f, 0.f, 0.f}, acc1 = acc0;
        router_cols(rwl, XR, GC + bidx * 1024, MOD + (size_t)(l * 5 + bidx) * 6144 + 3 * 1024, Fb, r, rstd, j, kq, 0, 32, acc0, acc1);
        router_finish(cbl, hist, TOPI, GATE, r, bidx, rstd, j, kq, acc0, acc1);
    }
    for (int grp = nmain + (int)blockIdx.x; grp < ngrp; grp += F.G) {
        const int r0 = grp * 16, r = r0 + j; const int bidx = r0 < NLAT ? r0 / SEQ : 4;
        float ss; { const f32x4 q = *(const f32x4*)(RSSP + (size_t)r * 16 + 4 * kq); ss = (q.x + q.y) + (q.z + q.w); }
        ss += __shfl_xor(ss, 16); ss += __shfl_xor(ss, 32);
        const float rstd = 1.0f / sqrtf(ss * (1.0f / 1024.0f) + EPSN);
        f32x4 acc0 = {0.f, 0.f, 0.f, 0.f}, acc1 = acc0;
        router_cols(rwl, XR, GC + bidx * 1024, MOD + (size_t)(l * 5 + bidx) * 6144 + 3 * 1024, Fb, r, rstd, j, kq, 4 * F.wave, 4 * F.wave + 4, acc0, acc1);
        if (F.wave > 0) { LAS f32x4* pp = (LAS f32x4*)(part + ((F.wave - 1) * 64 + F.lane) * 8); pp[0] = acc0; pp[1] = acc1; }
        __syncthreads();
        if (F.wave == 0) {
#pragma unroll
            for (int w = 0; w < 7; ++w) { const LAS f32x4* pp = (const LAS f32x4*)(part + (w * 64 + F.lane) * 8); acc0 += pp[0]; acc1 += pp[1]; }
            router_finish(cbl, hist, TOPI, GATE, r, bidx, rstd, j, kq, acc0, acc1);
        }
        __syncthreads();
    }
    __syncthreads();
    if (F.tid < 32) BLKCNT[blockIdx.x * 32 + F.tid] = hist[F.tid];
}

__device__ __forceinline__ void ph_route(const Frame& F, int nrows) {
    LAS int* cursor = (LAS int*)(F.lds);
    LAS int* tot = cursor + 32;
    LAS int* mine = cursor + 64;
    LAS int* part = cursor + 96;
    LAS int* ebase = cursor + 96 + 1024;
    const int* BLKCNT = (const int*)(F.ws + WS_BLKCNT); const int* TOPI = (const int*)(F.ws + WS_TOPI); int* POS = (int*)(F.ws + WS_POS);
    int* ROWTOK = (int*)(F.ws + WS_ROWTOK); int* TILEE = (int*)(F.ws + WS_TILEE);
    { const int e = F.tid & 31, sl = F.tid >> 5; int t = 0, m = 0;
      for (int b = sl; b < F.G; b += 16) { const int v = BLKCNT[b * 32 + e]; t += v; m += (b < (int)blockIdx.x) ? v : 0; }
      part[sl * 64 + e] = t; part[sl * 64 + 32 + e] = m;
      __syncthreads();
      if (F.tid < 32) { int tt = 0, mm = 0;
#pragma unroll
          for (int s = 0; s < 16; ++s) { tt += part[s * 64 + F.tid]; mm += part[s * 64 + 32 + F.tid]; }
          tot[F.tid] = tt; mine[F.tid] = mm; } }
    __syncthreads();
    if (F.tid == 0) { int tb = 0;
        for (int e = 0; e < 32; ++e) { const int nt = (tot[e] + 255) >> 8; cursor[e] = tb * 256 + mine[e]; ebase[e] = tb * 256;
            if (blockIdx.x == 0) for (int j = 0; j < nt; ++j) TILEE[tb + j] = e;
            tb += nt; }
        ebase[32] = tb * 256;
        if (blockIdx.x == 0) F.ctl[CW_NTILES] = (unsigned)tb; }
    __syncthreads();
    for (int e = blockIdx.x; e < 32; e += F.G) for (int p = ebase[e] + tot[e] + F.tid; p < ebase[e + 1]; p += NTHR) ROWTOK[p] = 0;
    const int sub = F.lane >> 2, k = F.lane & 3;
    const int ngrp = nrows / 16, nmain = (ngrp / F.ngw) * F.ngw;
    for (int grp = F.gw; grp < nmain; grp += F.ngw) {
        const int r = grp * 16 + sub; const int e = TOPI[r * 4 + k]; const int pos = lds_add(&cursor[e], 1); POS[r * 4 + k] = pos; ROWTOK[pos] = r; }
    if (F.wave == 0) for (int grp = nmain + (int)blockIdx.x; grp < ngrp; grp += F.G) {
        const int r = grp * 16 + sub; const int e = TOPI[r * 4 + k]; const int pos = lds_add(&cursor[e], 1); POS[r * 4 + k] = pos; ROWTOK[pos] = r; }
}

__device__ __forceinline__ void ph_combine(const Frame& F, int l, int nrows, float* out, const float* gmix) {
    bf16* XR = (bf16*)(F.ws + WS_XR); const float* MOD = (const float*)(F.ws + WS_MOD); const bf16* YS = (const bf16*)(F.ws + WS_YS); bf16* H = (bf16*)(F.ws + WS_H);
    const int* POS = (const int*)(F.ws + WS_POS); const float* GATE = (const float*)(F.ws + WS_GATE);
    for (int r = 2 * F.gw; r < nrows; r += 2 * F.ngw) {
        const int bidx = r < NLAT ? r / SEQ : 4;
        const float* gf = MOD + (size_t)(l * 5 + bidx) * 6144 + 5 * 1024;
        int pos = 0; float gt = 0.f;
        if (F.lane < 8) { pos = POS[r * 4 + F.lane]; gt = GATE[r * 4 + F.lane]; }
        v2u w[2][4][4], xw[2][4]; float gk[2][4];
#pragma unroll
        for (int rr = 0; rr < 2; ++rr)
#pragma unroll
            for (int k = 0; k < 4; ++k) { const int pk = __shfl(pos, rr * 4 + k); gk[rr][k] = __shfl(gt, rr * 4 + k);
#if MOE_FP8
                gk[rr][k] *= (1.0f / pg8::F8_SY); const unsigned* yr = (const unsigned*)((const unsigned char*)YS + (size_t)pk * YS_PITCH);
#pragma unroll
                for (int j = 0; j < 4; ++j) { w[rr][k][j].x = yr[64 * j + F.lane]; w[rr][k][j].y = 0u; } }
#else
                const v2u* yr = (const v2u*)(YS + (size_t)pk * 1024);
#pragma unroll
                for (int j = 0; j < 4; ++j) w[rr][k][j] = yr[64 * j + F.lane]; }
#endif
#pragma unroll
        for (int rr = 0; rr < 2; ++rr)
#pragma unroll
            for (int j = 0; j < 4; ++j) xw[rr][j] = ((const v2u*)(XR + (size_t)(r + rr) * 1024))[64 * j + F.lane];
        f32x4 gv[4];
#pragma unroll
        for (int j = 0; j < 4; ++j) gv[j] = ((const f32x4*)gf)[64 * j + F.lane];
#pragma unroll
        for (int rr = 0; rr < 2; ++rr) {
            const int row = r + rr;
            f32x4 y[4]; float ss = 0.f;
#pragma unroll
            for (int j = 0; j < 4; ++j) { f32x4 a = {0.f, 0.f, 0.f, 0.f};
#pragma unroll
                for (int k = 0; k < 4; ++k) { const v2u ww = w[rr][k][j]; const float g_ = gk[rr][k];
#if MOE_FP8
                    a.x += g_ * __builtin_amdgcn_cvt_f32_fp8((int)ww.x, 0); a.y += g_ * __builtin_amdgcn_cvt_f32_fp8((int)ww.x, 1); a.z += g_ * __builtin_amdgcn_cvt_f32_fp8((int)ww.x, 2); a.w += g_ * __builtin_amdgcn_cvt_f32_fp8((int)ww.x, 3); }
#else
                    a.x += g_ * bflo(ww.x); a.y += g_ * bfhi(ww.x); a.z += g_ * bflo(ww.y); a.w += g_ * bfhi(ww.y); }
#endif
                const f32x4 xv = {bflo(xw[rr][j].x), bfhi(xw[rr][j].x), bflo(xw[rr][j].y), bfhi(xw[rr][j].y)};
                y[j] = xv + gv[j] * a;
                const int cb = 64 * j + F.lane;
                if (l == 0) { v2u o; o.x = pk2(y[j].x, y[j].y); o.y = pk2(y[j].z, y[j].w); ((v2u*)(XR + (size_t)row * 1024))[cb] = o; } else ((f32x4*)(out + (size_t)row * 1024))[cb] = y[j];
                ss += (y[j].x * y[j].x + y[j].y * y[j].y) + (y[j].z * y[j].z + y[j].w * y[j].w); }
            if (l == 0) {
                const float rstd = 1.0f / sqrtf(wave_sum(ss) * (1.0f / 1024.0f) + EPSN);
                const float* shift = MOD + (size_t)(5 + bidx) * 6144; const float* scale = shift + 1024; const float* g = gmix + 1024;
#pragma unroll
                for (int j = 0; j < 4; ++j) { const int cb = 64 * j + F.lane; const f32x4 gg = ((const f32x4*)g)[cb], sc = ((const f32x4*)scale)[cb], sh = ((const f32x4*)shift)[cb];
                    const f32x4 hv = y[j] * rstd * gg * (sc + 1.0f) + sh;
                    v2u o; o.x = pk2(hv.x, hv.y); o.y = pk2(hv.z, hv.w); ((v2u*)(H + (size_t)row * 1024))[cb] = o; }
            }
        }
    }
}

struct Args { const float* in[34]; float* out; unsigned char* ws; int ph_lo, ph_hi; };
enum { I_X = 0, I_C, I_CTX, I_CCTX, I_WMOD, I_BMOD, I_GMIX, I_GFFN, I_WIN, I_QG, I_KG, I_LCW, I_LCB, I_LGW, I_LGB, I_LLAM, I_HCW, I_HCB, I_HW1, I_HB1, I_HW2, I_HB2, I_HW3, I_HFREQ, I_HDEC, I_HBIAS,
       I_OUTG, I_WOUT, I_RW, I_RB, I_MW1, I_MB1, I_MW2, I_MB2 };

__global__ void __launch_bounds__(NTHR, 2) mk_fwd(Args args) {
    extern __shared__ __attribute__((aligned(16))) unsigned char lds[];
    Frame F;
    F.lds = (LAS unsigned char*)lds; F.ws = args.ws; F.ctl = (unsigned*)(args.ws + WS_CTL);
    F.tid = threadIdx.x; F.lane = F.tid & 63; F.wave = __builtin_amdgcn_readfirstlane(F.tid >> 6);
    F.G = gridDim.x; { const int bx = blockIdx.x; F.vcu = (F.G % 8 == 0) ? (bx % 8) * (F.G / 8) + bx / 8 : bx; }
    F.gw = (int)blockIdx.x * NWAVES + F.wave; F.ngw = F.G * NWAVES;
    for (int u = F.tid; u < (LDS_BYTES - LDSCTL_OFF) / 4; u += NTHR) ((LAS unsigned*)(F.lds + LDSCTL_OFF))[u] = 0u;
    __syncthreads();
#if !MK_PER_PHASE
    XcdBarrier bar = xcd_barrier_post(F.ctl + CW_BAR, (volatile LAS unsigned*)(F.lds + LDSCTL_OFF + 32));
#define GRID_BAR() xcd_barrier(bar)
#else
#define GRID_BAR() do { } while (0)
#endif
    const int lo = args.ph_lo, hi = args.ph_hi;
#ifndef ONLY_PHASE
#define ONLY_PHASE (-1)
#endif
#define ENABLED(id) (ONLY_PHASE < 0 || ONLY_PHASE == (id))
#define IN(k) (ENABLED(k) && lo <= (k) && (k) < hi)
#define INL(j) (ENABLED(NPH_PRO + (j)) && lo <= pb + (j) && pb + (j) < hi)
#define SEAML(j) do { if (lo <= pb + (j) && pb + (j) + 1 < hi) { GRID_BAR(); } } while (0)
typedef const __attribute__((address_space(4))) Args* KArgs;
#ifndef REP_MASK
#define REP_MASK 0
#endif
#define NREP(j) (((REP_MASK >> (j)) & 1) ? 2 : 1)
#define REFRAME() Frame Fp = F; KArgs ka = (KArgs)__builtin_amdgcn_kernarg_segment_ptr(); { int t_ = F.tid; asm volatile("" : "+v"(t_), "+s"(ka)); Fp.tid = t_; Fp.lane = t_ & 63; Fp.wave = __builtin_amdgcn_readfirstlane(t_ >> 6); \
    Fp.gw = (int)blockIdx.x * NWAVES + Fp.wave; Fp.ws = ka->ws; Fp.ctl = (unsigned*)(ka->ws + WS_CTL); }
#define SEAM(k) do { if (lo <= (k) && (k) + 1 < hi) { GRID_BAR(); } } while (0)

    if (IN(0)) ph_prologue_a(F, args.in[I_C], args.in[I_CCTX], args.in[I_WMOD], args.in[I_BMOD], args.in[I_WIN], args.in[I_WOUT], args.in[I_MW1], args.in[I_MW2],
                             args.in[I_HW1], args.in[I_HB1], args.in[I_HW2], args.in[I_HB2], args.in[I_HFREQ], args.in[I_LGW], args.in[I_LLAM]);
    SEAM(0);
    if (IN(1)) ph_prologue_b(F, args.in[I_HW3], args.in[I_HDEC], args.in[I_GFFN], args.in[I_RW], args.in[I_RB]);
    SEAM(1);

#if MOE_FP8
#define MOE_EPI1 pg8::EpiSwigluF8
#define MOE_EPI2 pg8::EpiF8BiasF8
#else
#define MOE_EPI1 pg8::EpiSwiglu
#define MOE_EPI2 pg8::EpiBf16Bias
#endif
#ifndef PROBE_MOE2
#define PROBE_MOE2 0
#endif
#ifndef PROBE_MOE2B
#define PROBE_MOE2B 0
#endif
#ifndef PROBE_GEMM_K
#define PROBE_GEMM_K 0
#endif
#ifndef MOE_WGM1
#define MOE_WGM1 4
#endif
#ifndef MOE_WGM2
#define MOE_WGM2 8
#endif
#define PHASE(j, ...) if (INL(j)) { _Pragma("unroll") for (int rep_ = 0; rep_ < NREP(j); ++rep_) { { REFRAME(); __VA_ARGS__ } if (rep_ + 1 < NREP(j)) GRID_BAR(); } }
#define LAYER_BODY(l) { \
        const int pb = NPH_PRO + l * NPH_LAYER; \
        const int nrows = (l == 0) ? MT : NLAT; \
        if (l == 0) { PHASE(0, ph_norm_mod(Fp, l, ka->in[I_X], ka->in[I_CTX], ka->in[I_GMIX]);) SEAML(0); } \
        PHASE(1, \
            pg8::Gemm g{(const bf16*)(Fp.ws + WS_H), (const bf16*)(Fp.ws + WS_WINT) + (size_t)l * 2048 * 1024, MT, 2048, 1024}; \
            pg8::StaticOrder S; S.init(MT, 2048, Fp.G, (int)blockIdx.x); \
            pg8::EpiBf16<0> E{(bf16*)(Fp.ws + WS_U), 2048, nullptr, 0, 0, 1.f}; \
            pg8::gemm_phase<pg8::EpiBf16<0>, pg8::StaticOrder, PG8_ALIGN, PG8_SP2>(Fp.lds + RING_OFF, g, S, E);) \
        SEAML(1); \
        if (PROBE_GEMM_K > 0 && INL(1)) { REFRAME(); int kp_ = PROBE_GEMM_K; asm volatile("" : "+s"(kp_)); \
            pg8::Gemm g{(const bf16*)(Fp.ws + WS_H), (const bf16*)(Fp.ws + WS_WINT) + (size_t)l * 2048 * 1024, MT, 2048, kp_}; \
            pg8::StaticOrder S; S.init(MT, 2048, Fp.G, (int)blockIdx.x); \
            pg8::EpiNone E{}; \
            pg8::gemm_phase<pg8::EpiNone, pg8::StaticOrder, PG8_ALIGN, PG8_SP2>(Fp.lds + RING_OFF, g, S, E); GRID_BAR(); } \
        PHASE(2, ph_post_proj(Fp, l, ka->in[I_QG], ka->in[I_KG], ka->in[I_LCW], ka->in[I_LCB], ka->in[I_HCW], ka->in[I_HCB]);) \
        SEAML(2); \
        PHASE(3, \
            int kg_ = 256; asm volatile("" : "+s"(kg_)); \
            pg8::Gemm g{(const bf16*)(Fp.ws + WS_XL), (const bf16*)(Fp.ws + WS_WGT) + (size_t)l * 1024 * 256, MT, 1024, kg_}; \
            pg8::StaticOrder S; S.init(MT, 1024, Fp.G, (int)blockIdx.x); \
            pg8::EpiLruGate E{(const bf16*)(Fp.ws + WS_XL), (bf16*)(Fp.ws + WS_LAB), LAB_STRIDE, ka->in[I_LGB] + (size_t)l * 1024, (const float*)(Fp.ws + WS_SPT) + l * 512}; \
            pg8::gemm_phase<pg8::EpiLruGate, pg8::StaticOrder, PG8_ALIGN, PG8_SP2>(Fp.lds + RING_OFF, g, S, E);) \
        SEAML(3); \
        PHASE(4, \
            ph_scan1(Fp); __syncthreads(); \
            const attn_body::AttnTensors AT{(const attn_body::bf16*)(Fp.ws + WS_U), (const attn_body::bf16*)(Fp.ws + WS_K), (const attn_body::bf16*)(Fp.ws + WS_V), (attn_body::bf16*)(Fp.ws + WS_ATT)}; \
            const attn_body::QPre QN{ka->in[I_QG] + l * 64, (const float*)(Fp.ws + WS_ROPEC), (const float*)(Fp.ws + WS_ROPES)}; \
            attn_body::attn_phase<8>((char*)lds + RING_OFF, AT, QN, Fp.G, Fp.vcu, l == 0, (long)NLAT);) \
        SEAML(4); \
        PHASE(5, ph_scan2(Fp); __syncthreads(); ph_hyena_fft(Fp, l, ka->in[I_HBIAS]); if (l == 0) ph_hyena_ctx(Fp, ka->in[I_HBIAS], ka->in[I_HCW], ka->in[I_HCB]);) \
        SEAML(5); \
        PHASE(6, ph_merge(Fp, l, nrows, ka->in[I_OUTG]);) \
        SEAML(6); \
        if (INL(7)) { REFRAME(); \
            pg8::Gemm g{(const bf16*)(Fp.ws + WS_MIXA), (const bf16*)(Fp.ws + WS_WOUTT) + (size_t)l * 1024 * 1024, nrows, 1024, 1024}; \
            pg8::StaticOrder S; S.init(nrows, 1024, Fp.G, (int)blockIdx.x); \
            bf16* XR = (bf16*)(Fp.ws + WS_XR); \
            pg8::EpiResid<(l) == 1> E{ka->in[I_X], ka->in[I_CTX], NLAT, XR, 1024, \
                            (const float*)(Fp.ws + WS_MOD) + (size_t)(l * 5) * 6144 + 2 * 1024, 6144, SEQ, (float*)(Fp.ws + WS_RSSP)}; \
            pg8::gemm_phase<pg8::EpiResid<(l) == 1>, pg8::StaticOrder, PG8_ALIGN, PG8_SP2>(Fp.lds + RING_OFF, g, S, E); \
        } \
        SEAML(7); \
        PHASE(8, ph_ffn_router(Fp, l, nrows, ka->in[I_RW]);) \
        SEAML(8); \
        PHASE(9, ph_route(Fp, nrows);) \
        SEAML(9); \
        if (INL(10) || INL(11)) { REFRAME(); \
            LAS int* tab = (LAS int*)(Fp.lds + MOETAB_OFF); \
            const int ntiles = (int)__hip_atomic_load(Fp.ctl + CW_NTILES, __ATOMIC_RELAXED, __HIP_MEMORY_SCOPE_AGENT); \
            const int* TILEE = (const int*)(Fp.ws + WS_TILEE); \
            for (int i = Fp.tid; i < ntiles && i < SORT_TILES; i += NTHR) tab[i] = TILEE[i]; \
            __syncthreads(); \
            if (INL(10)) { _Pragma("unroll") for (int rep_ = 0; rep_ < NREP(10); ++rep_) { { \
                int km1_ = 1024 / (1 + MOE_FP8); asm volatile("" : "+s"(km1_)); \
                pg8::Gemm g{(const bf16*)(Fp.ws + WS_F), (const bf16*)(Fp.ws + WS_W1T) + (size_t)l * 32 * 2048 * (1024 / (1 + MOE_FP8)), 0, 2048, km1_}; \
                pg8::MoeOrderT<true> S; S.init(tab, ntiles, 8, Fp.G, (int)blockIdx.x, MOE_WGM1); S.rowtok = (const int*)(Fp.ws + WS_ROWTOK); \
                MOE_EPI1 E{(bf16*)(Fp.ws + WS_ACT), 1024, ka->in[I_MB1] + (size_t)l * 32 * 2048, 2048}; \
                pg8::gemm_phase<MOE_EPI1, pg8::MoeOrderT<true>, PG8_ALIGN, PG8_SP2, MOE_FP8 != 0>(Fp.lds + RING_OFF, g, S, E); \
             } if (rep_ + 1 < NREP(10)) GRID_BAR(); } } \
            SEAML(10); \
            if (PROBE_MOE2B && INL(11)) { \
                pg8::Gemm g{(const bf16*)(Fp.ws + WS_ACT), (const bf16*)(Fp.ws + WS_W2T) + (size_t)l * 32 * 1024 * 1024, 0, 1024, 1024}; \
                pg8::MoeOrderT<false> S; S.init(tab, ntiles, 4, Fp.G, (int)blockIdx.x, MOE_WGM2); S.rowtok = nullptr; S.rev = 1; \
                pg8::EpiNone E{}; \
                pg8::gemm_phase<pg8::EpiNone, pg8::MoeOrderT<false>, PG8_ALIGN, PG8_SP2>(Fp.lds + RING_OFF, g, S, E); GRID_BAR(); } \
            if (INL(11)) { _Pragma("unroll") for (int rep_ = 0; rep_ < NREP(11); ++rep_) { { \
                int km2_ = 1024 / (1 + MOE_FP8); asm volatile("" : "+s"(km2_)); \
                pg8::Gemm g{(const bf16*)(Fp.ws + WS_ACT), (const bf16*)(Fp.ws + WS_W2T) + (size_t)l * 32 * 1024 * (1024 / (1 + MOE_FP8)), 0, 1024, km2_}; \
                pg8::MoeOrderT<false> S; S.init(tab, ntiles, 4, Fp.G, (int)blockIdx.x, MOE_WGM2); S.rowtok = nullptr; S.rev = 1; \
                MOE_EPI2 E{(bf16*)(Fp.ws + WS_YS), YS_PITCH, ka->in[I_MB2] + (size_t)l * 32 * 1024, 1024}; \
                pg8::gemm_phase<MOE_EPI2, pg8::MoeOrderT<false>, PG8_ALIGN, PG8_SP2, MOE_FP8 != 0>(Fp.lds + RING_OFF, g, S, E); \
             } if (rep_ + 1 < NREP(11)) GRID_BAR(); } } \
            if (PROBE_MOE2 && INL(11)) { GRID_BAR(); \
                pg8::Gemm g{(const bf16*)(Fp.ws + WS_ACT), (const bf16*)(Fp.ws + WS_W2T) + (size_t)l * 32 * 1024 * 1024, 0, 1024, 1024}; \
                pg8::MoeOrderT<false> S; S.init(tab, ntiles, 4, Fp.G, (int)blockIdx.x, MOE_WGM2); S.rowtok = nullptr; S.rev = (PROBE_MOE2 == 2) ? 0 : 1; \
                if (PROBE_MOE2 == 3) { pg8::EpiBf16BiasFold E{(bf16*)(Fp.ws + WS_ASORT), 1024, ka->in[I_MB2] + (size_t)l * 32 * 1024, 1024}; \
                    pg8::gemm_phase<pg8::EpiBf16BiasFold, pg8::MoeOrderT<false>, PG8_ALIGN, PG8_SP2>(Fp.lds + RING_OFF, g, S, E); } \
                else { pg8::EpiNone E{}; \
                pg8::gemm_phase<pg8::EpiNone, pg8::MoeOrderT<false>, PG8_ALIGN, PG8_SP2>(Fp.lds + RING_OFF, g, S, E); } } \
        } \
        SEAML(11); \
        if (INL(12)) { REFRAME(); ph_combine(Fp, l, nrows, ka->out, ka->in[I_GMIX]); } \
        if (l == 0) { SEAML(12); } \
    }
    LAYER_BODY(0)
    LAYER_BODY(1)
#undef LAYER_BODY
#undef PHASE
#undef IN
#undef SEAM
#undef INL
#undef SEAML
}

extern "C" void kernel_launch(void* const* d_in, const int* in_sizes, int n_in, void* d_out, int out_size, void* d_ws, size_t ws_size, hipStream_t stream) {
    static int grid = 0;
    if (grid == 0) {
        if (n_in != 34 || in_sizes[0] != NLAT * DMODEL || out_size != NLAT * DMODEL || ws_size < WS_END) {
            fprintf(stderr, "kernel_launch: unexpected shapes (n_in %d, in0 %d, out %d, ws %zu); nothing launched\n", n_in, n_in > 0 ? in_sizes[0] : -1, out_size, ws_size); grid = -1; return; }
        int dev = 0, cus = 0;
        if (hipGetDevice(&dev) != hipSuccess || hipDeviceGetAttribute(&cus, hipDeviceAttributeMultiprocessorCount, dev) != hipSuccess) { grid = -1; return; }
        if (hipFuncSetAttribute((const void*)mk_fwd, hipFuncAttributeMaxDynamicSharedMemorySize, LDS_BYTES) != hipSuccess) { fprintf(stderr, "kernel_launch: hipFuncSetAttribute failed\n"); grid = -1; return; }
        int per_cu = 0;
        if (hipOccupancyMaxActiveBlocksPerMultiprocessor(&per_cu, (const void*)mk_fwd, NTHR, LDS_BYTES) != hipSuccess || per_cu < 1) { fprintf(stderr, "kernel_launch: occupancy query says %d\n", per_cu); }
        (void)hipGetLastError();
        grid = cus;
    }
    if (grid < 0) return;
    if (hipMemsetAsync((char*)d_ws + WS_CTL, 0, CTL_ZERO_BYTES, stream) != hipSuccess) return;
    Args a{};
    for (int i = 0; i < 34; ++i) a.in[i] = (const float*)d_in[i];
    a.out = (float*)d_out; a.ws = (unsigned char*)d_ws;
#if MK_PER_PHASE
    for (int p = 0; p < NPH; ++p) { a.ph_lo = p; a.ph_hi = p + 1; hipLaunchKernelGGL(mk_fwd, dim3(grid), dim3(NTHR), LDS_BYTES, stream, a); }
#else
    a.ph_lo = 0; a.ph_hi = NPH;
    hipLaunchKernelGGL(mk_fwd, dim3(grid), dim3(NTHR), LDS_BYTES, stream, a);
#endif
}
```

```cpp
#include <hip/hip_runtime.h>
#include <hip/hip_bf16.h>
#include <cstdio>
#include <cstdint>
#include <cmath>
#ifndef MOE_FP8
#define MOE_FP8 1
#endif
#ifndef MK_PER_PHASE
#define MK_PER_PHASE 0
#endif
namespace pg8 {
#define PG8_LAS __attribute__((address_space(3)))
typedef unsigned short bf16_t;
typedef short bf16x8 __attribute__((ext_vector_type(8)));
typedef float f32x4 __attribute__((ext_vector_type(4)));
typedef unsigned u32x4 __attribute__((ext_vector_type(4)));
constexpr int BM = 256, BK = 64, HALF = 128, HTB = HALF * BK * 2  , STAGE_BYTES = 8 * HTB, NXCD = 8, WGM = 8;

__host__ __device__ __forceinline__ int lds_byte(int r, int c) { const int st = (r >> 4) * 2 + (c >> 5), rr = r & 15, cc = c & 31, ob = rr * 64 + cc * 2; return st * 1024 + (ob ^ (((ob >> 9) & 1) << 5)); }
__host__ __device__ __forceinline__ void stage_rc(int b, int& R, int& C) { const int st = b / 1024, sb = b % 1024, swz = sb ^ (((sb >> 9) & 1) << 5); R = (st >> 1) * 16 + swz / 64; C = (st & 1) * 32 + (swz % 64) / 2; }
__host__ __device__ __forceinline__ int perm32(int rho) { const int n = rho >> 4, i = rho & 15; return 8 * (i >> 2) + 4 * n + (i & 3); }

struct Unit { int pm, pn, be, e; };
struct Gemm { const bf16_t* A; const bf16_t* Bt; int M, N, K; };

struct StaticOrder {
    static constexpr bool GATHER = false;
    __device__ __forceinline__ int row_of(int r) const { return r; }
    int nM, nN, nwg, G, c;
    __host__ __device__ void init(int M, int N, int G_, int c_) { nM = M / BM; nN = N / BM; nwg = nM * nN; G = G_; c = c_; }
    __host__ __device__ bool next(int i, Unit& u) const {
        const long L = (long)i * G + c; if (L >= nwg) return false;
        int wgid = (int)L; { const int q = nwg / NXCD, r = nwg % NXCD, xcd = wgid % NXCD, off = wgid / NXCD; wgid = (xcd < r ? xcd * (q + 1) : r * (q + 1) + (xcd - r) * q) + off; }
        const int nig = WGM * nN, gid = wgid / nig, fm = gid * WGM, gsz = (nM - fm) < WGM ? (nM - fm) : WGM;
        u.pm = fm + ((wgid % nig) % gsz); u.pn = (wgid % nig) / gsz; u.be = u.pn; u.e = 0; return true;
    }
    __device__ __forceinline__ void a_ready(const Unit&) const {}
    __device__ __forceinline__ void done(const Unit&) const {}
};

__device__ __forceinline__ unsigned cvt_pk_bf16(float lo, float hi) { unsigned r; asm volatile("v_cvt_pk_bf16_f32 %0, %1, %2" : "=v"(r) : "v"(lo), "v"(hi)); return r; }
__device__ __forceinline__ unsigned pack4_fp8(float a, float b, float c, float d) {
    a = fminf(fmaxf(a, -448.f), 448.f); b = fminf(fmaxf(b, -448.f), 448.f); c = fminf(fmaxf(c, -448.f), 448.f); d = fminf(fmaxf(d, -448.f), 448.f);
    int w = 0; w = __builtin_amdgcn_cvt_pk_fp8_f32(a, b, w, false); w = __builtin_amdgcn_cvt_pk_fp8_f32(c, d, w, true); return (unsigned)w;
}
constexpr float F8_SF = 16.f, F8_SW = 64.f, F8_SA = 4.f, F8_SY = 32.f;
typedef float f32x2 __attribute__((ext_vector_type(2)));
__device__ __forceinline__ f32x2 gelu_pk(f32x2 v) {
    const f32x2 av = __builtin_elementwise_abs(v), d = av * 0.2316418882f + 1.0f;
    f32x2 t; t.x = __builtin_amdgcn_rcpf(d.x); t.y = __builtin_amdgcn_rcpf(d.y);
    f32x2 q = t * 0.5307027145f + (-0.7265760135f); q = q * t + 0.7107068705f; q = q * t + (-0.142248368f); q = q * t + 0.127414796f; q = q * t;
    const f32x2 s = (v * v) * (-0.72134752044f);
    f32x2 e; e.x = __builtin_amdgcn_exp2f(s.x); e.y = __builtin_amdgcn_exp2f(s.y);
    const f32x2 m = v * (q * e), r = v - m;
    f32x2 o; o.x = v.x < 0.f ? m.x : r.x; o.y = v.y < 0.f ? m.y : r.y; return o;
}

template <int ACT  > struct EpiBf16 {
    static constexpr bool PERM = true, AFTER_DRAIN = false; static_assert(ACT == 0 || ACT == 1, "EpiBf16: ACT is 0 (none) or 1 (gelu_pk)");
    bf16_t* O; int ldc; const float* bias; int split_cols; size_t split_stride; float scale0;
    struct Pre {}; __device__ __forceinline__ void preload(Pre&, const Unit&, int, int, int, int) const {}
    __device__ __forceinline__ void operator()(const f32x4 (&acc)[2][2][4][2], const Unit& u, int wr, int wc, int fr, int fq, const Pre&) const {
        const int row0 = u.pm * BM + wr * 64 + fr; int colt = u.pn * BM; bf16_t* base = O;
        float sc = 1.f; if (split_cols) { const int t = colt / split_cols; base += (size_t)t * split_stride; colt -= t * split_cols; if (t == 0) sc = scale0; }
        const int col0 = colt + wc * 32 + 8 * fq, bcol0 = u.pn * BM + wc * 32 + 8 * fq;
        f32x4 bv[2][2];
#pragma unroll
        for (int bj = 0; bj < 2; ++bj)
#pragma unroll
            for (int n = 0; n < 2; ++n) bv[bj][n] = bias ? *(const f32x4*)(bias + bcol0 + bj * HALF + 4 * n) : (f32x4){0.f, 0.f, 0.f, 0.f};
#pragma unroll
        for (int ai = 0; ai < 2; ++ai)
#pragma unroll
            for (int m = 0; m < 4; ++m) { bf16_t* rowp = base + (size_t)(row0 + ai * HALF + m * 16) * ldc + col0;
#pragma unroll
                for (int bj = 0; bj < 2; ++bj) { f32x4 v0 = acc[ai][bj][m][0] + bv[bj][0], v1 = acc[ai][bj][m][1] + bv[bj][1];
                    if (ACT == 1) { f32x2 a = gelu_pk((f32x2){v0[0], v0[1]}), b = gelu_pk((f32x2){v0[2], v0[3]}), c = gelu_pk((f32x2){v1[0], v1[1]}), d = gelu_pk((f32x2){v1[2], v1[3]});
                        v0 = (f32x4){a.x, a.y, b.x, b.y}; v1 = (f32x4){c.x, c.y, d.x, d.y}; }
                    v0 = v0 * sc; v1 = v1 * sc; u32x4 w; w.x = cvt_pk_bf16(v0[0], v0[1]); w.y = cvt_pk_bf16(v0[2], v0[3]); w.z = cvt_pk_bf16(v1[0], v1[1]); w.w = cvt_pk_bf16(v1[2], v1[3]);
                    *(u32x4*)(rowp + bj * HALF) = w; } }
    }
};


template <bool XIN_BF16> struct EpiResid {
    static constexpr bool PERM = false, AFTER_DRAIN = false;
    const float* xin_lat; const float* xin_ctx; int nlat; bf16_t* XR; int ldc; const float* mod; int mod_stride; int seq; float* rssp;
    struct Pre {}; __device__ __forceinline__ void preload(Pre&, const Unit&, int, int, int, int) const {}
    __device__ __forceinline__ void operator()(const f32x4 (&acc)[2][2][4][2], const Unit& u, int wr, int wc, int fr, int fq, const Pre&) const {
        typedef unsigned u32x2 __attribute__((ext_vector_type(2)));
        const int row0 = u.pm * BM + wr * 64 + fr, col0 = u.pn * BM + wc * 32 + 4 * fq;
        const int rowt = u.pm * BM; const int bidx = rowt < nlat ? rowt / seq : 4;
        const float* gate = mod + (size_t)bidx * mod_stride;
        const float* xin = rowt < nlat ? xin_lat : (xin_ctx - (size_t)nlat * ldc);
        f32x4 gv[2][2];
#pragma unroll
        for (int bj = 0; bj < 2; ++bj)
#pragma unroll
            for (int n = 0; n < 2; ++n) gv[bj][n] = *(const f32x4*)(gate + col0 + bj * HALF + n * 16);
#pragma unroll
        for (int ai = 0; ai < 2; ++ai)
#pragma unroll
            for (int m = 0; m < 4; ++m) { const int row = row0 + ai * HALF + m * 16; const size_t ro = (size_t)row * ldc + col0; float s2 = 0.f;
#pragma unroll
                for (int bj = 0; bj < 2; ++bj)
#pragma unroll
                    for (int n = 0; n < 2; ++n) { const size_t idx = ro + bj * HALF + n * 16; f32x4 xv;
                        if (XIN_BF16) { const u32x2 w = *(const u32x2*)(XR + idx); xv = (f32x4){__builtin_bit_cast(float, w.x << 16), __builtin_bit_cast(float, w.x & 0xffff0000u), __builtin_bit_cast(float, w.y << 16), __builtin_bit_cast(float, w.y & 0xffff0000u)}; }
                        else xv = *(const f32x4*)(xin + idx);
                        const f32x4 v = xv + gv[bj][n] * acc[ai][bj][m][n];
                        s2 += (v[0] * v[0] + v[1] * v[1]) + (v[2] * v[2] + v[3] * v[3]);
                        u32x2 o; o.x = cvt_pk_bf16(v[0], v[1]); o.y = cvt_pk_bf16(v[2], v[3]); *(u32x2*)(XR + idx) = o; }
                s2 += __shfl_xor(s2, 16); s2 += __shfl_xor(s2, 32);
                if (fq == 0) rssp[(size_t)row * 16 + u.pn * 4 + wc] = s2; }
    }
};
struct EpiSwiglu {
    static constexpr bool PERM = true, AFTER_DRAIN = false;
    bf16_t* O; int ldc; const float* bias; int bias_stride;
    struct Pre { unsigned bw[2][2][2]; };
    __device__ __forceinline__ void preload(Pre& p, const Unit& u, int wr, int wc, int fr, int fq) const {
        const float* bb = bias + (size_t)u.e * bias_stride + u.pn * BM + wc * 32 + 8 * fq;
#pragma unroll
        for (int bj = 0; bj < 2; ++bj)
#pragma unroll
            for (int n = 0; n < 2; ++n) { const f32x4 v = *(const f32x4*)(bb + bj * HALF + 4 * n); p.bw[bj][n][0] = cvt_pk_bf16(v[0], v[1]); p.bw[bj][n][1] = cvt_pk_bf16(v[2], v[3]); }
    }
    __device__ __forceinline__ void operator()(const f32x4 (&acc)[2][2][4][2], const Unit& u, int wr, int wc, int fr, int fq, const Pre& pre) const {
        const int row0 = u.pm * BM + wr * 64 + fr; const int bcol0 = u.pn * BM + wc * 32 + 8 * fq; const int ocol0 = bcol0 >> 1;
        f32x4 bv[2][2];
#pragma unroll
        for (int bj = 0; bj < 2; ++bj)
#pragma unroll
            for (int n = 0; n < 2; ++n) { const unsigned w0 = pre.bw[bj][n][0], w1 = pre.bw[bj][n][1];
                bv[bj][n] = (f32x4){__builtin_bit_cast(float, w0 << 16), __builtin_bit_cast(float, w0 & 0xffff0000u), __builtin_bit_cast(float, w1 << 16), __builtin_bit_cast(float, w1 & 0xffff0000u)}; }
#pragma unroll
        for (int ai = 0; ai < 2; ++ai)
#pragma unroll
            for (int m = 0; m < 4; ++m) { bf16_t* rowp = O + (size_t)(row0 + ai * HALF + m * 16) * ldc + ocol0;
#pragma unroll
                for (int bj = 0; bj < 2; ++bj) { const f32x4 v0 = acc[ai][bj][m][0] + bv[bj][0], v1 = acc[ai][bj][m][1] + bv[bj][1];
                    float o[4];
#pragma unroll
                    for (int p = 0; p < 4; ++p) { const float hg = p < 2 ? v0[2 * p] : v1[2 * p - 4], hl = p < 2 ? v0[2 * p + 1] : v1[2 * p - 3];
                        const float glu = fminf(hg, 7.0f), lin = fminf(fmaxf(hl, -7.0f), 7.0f);
                        const float sg = __builtin_amdgcn_rcpf(1.0f + __builtin_amdgcn_exp2f(-1.702f * 1.4426950408889634f * glu));
                        o[p] = glu * sg * (lin + 1.0f); }
                    typedef unsigned u32x2 __attribute__((ext_vector_type(2)));
                    u32x2 w; w.x = cvt_pk_bf16(o[0], o[1]); w.y = cvt_pk_bf16(o[2], o[3]);
                    *(u32x2*)(rowp + bj * (HALF / 2)) = w; } }
    }
};
struct EpiSwigluF8 {
    static constexpr bool PERM = true, AFTER_DRAIN = false;
    bf16_t* O; int ldc; const float* bias; int bias_stride;
    struct Pre { unsigned bw[2][2][2]; };
    __device__ __forceinline__ void preload(Pre& p, const Unit& u, int wr, int wc, int fr, int fq) const {
        const float* bb = bias + (size_t)u.e * bias_stride + u.pn * BM + wc * 32 + 8 * fq;
#pragma unroll
        for (int bj = 0; bj < 2; ++bj)
#pragma unroll
            for (int n = 0; n < 2; ++n) { const f32x4 v = *(const f32x4*)(bb + bj * HALF + 4 * n); p.bw[bj][n][0] = cvt_pk_bf16(v[0], v[1]); p.bw[bj][n][1] = cvt_pk_bf16(v[2], v[3]); }
    }
    __device__ __forceinline__ void operator()(const f32x4 (&acc)[2][2][4][2], const Unit& u, int wr, int wc, int fr, int fq, const Pre& pre) const {
        asm volatile("" : "+v"(fr), "+v"(fq));
        const int row0 = u.pm * BM + wr * 64 + fr; const int bcol0 = u.pn * BM + wc * 32 + 8 * fq; const int ocol0 = bcol0 >> 1;
        f32x4 bv[2][2];
#pragma unroll
        for (int bj = 0; bj < 2; ++bj)
#pragma unroll
            for (int n = 0; n < 2; ++n) { const unsigned w0 = pre.bw[bj][n][0], w1 = pre.bw[bj][n][1];
                bv[bj][n] = (f32x4){__builtin_bit_cast(float, w0 << 16), __builtin_bit_cast(float, w0 & 0xffff0000u), __builtin_bit_cast(float, w1 << 16), __builtin_bit_cast(float, w1 & 0xffff0000u)}; }
#pragma unroll
        for (int ai = 0; ai < 2; ++ai)
#pragma unroll
            for (int m = 0; m < 4; ++m) {
#pragma unroll
                for (int bj = 0; bj < 2; ++bj) { const f32x4 v0 = acc[ai][bj][m][0] * (1.0f / (F8_SF * F8_SW)) + bv[bj][0], v1 = acc[ai][bj][m][1] * (1.0f / (F8_SF * F8_SW)) + bv[bj][1];
                    float o[4];
#pragma unroll
                    for (int p = 0; p < 4; ++p) { const float hg = p < 2 ? v0[2 * p] : v1[2 * p - 4], hl = p < 2 ? v0[2 * p + 1] : v1[2 * p - 3];
                        const float glu = fminf(hg, 7.0f), lin = fminf(fmaxf(hl, -7.0f), 7.0f);
                        const float sg = __builtin_amdgcn_rcpf(1.0f + __builtin_amdgcn_exp2f(-1.702f * 1.4426950408889634f * glu));
                        o[p] = glu * sg * (lin + 1.0f); }
                    *(unsigned*)((unsigned char*)O + (size_t)(row0 + ai * HALF + m * 16) * ldc + ocol0 + bj * (HALF / 2)) = pack4_fp8(o[0] * F8_SA, o[1] * F8_SA, o[2] * F8_SA, o[3] * F8_SA); } }
    }
};
struct EpiBf16Bias {
    static constexpr bool PERM = true, AFTER_DRAIN = false;
    bf16_t* O; int ldc; const float* bias; int bias_stride;
    struct Pre { f32x4 bv[2][2]; };
    __device__ __forceinline__ void preload(Pre& p, const Unit& u, int wr, int wc, int fr, int fq) const {
        const float* bb = bias + (size_t)u.e * bias_stride + u.pn * BM + wc * 32 + 8 * fq;
#pragma unroll
        for (int bj = 0; bj < 2; ++bj)
#pragma unroll
            for (int n = 0; n < 2; ++n) p.bv[bj][n] = *(const f32x4*)(bb + bj * HALF + 4 * n);
    }
    __device__ __forceinline__ void operator()(const f32x4 (&acc)[2][2][4][2], const Unit& u, int wr, int wc, int fr, int fq, const Pre& pre) const {
        const int row0 = u.pm * BM + wr * 64 + fr; const int col0 = u.pn * BM + wc * 32 + 8 * fq;
#pragma unroll
        for (int ai = 0; ai < 2; ++ai)
#pragma unroll
            for (int m = 0; m < 4; ++m) { bf16_t* rowp = O + (size_t)(row0 + ai * HALF + m * 16) * ldc + col0;
#pragma unroll
                for (int bj = 0; bj < 2; ++bj) { const f32x4 v0 = acc[ai][bj][m][0] + pre.bv[bj][0], v1 = acc[ai][bj][m][1] + pre.bv[bj][1];
                    u32x4 w; w.x = cvt_pk_bf16(v0[0], v0[1]); w.y = cvt_pk_bf16(v0[2], v0[3]); w.z = cvt_pk_bf16(v1[0], v1[1]); w.w = cvt_pk_bf16(v1[2], v1[3]);
                    *(u32x4*)(rowp + bj * HALF) = w; } }
    }
};
struct EpiBf16BiasFold {
    static constexpr bool PERM = true, AFTER_DRAIN = false;
    bf16_t* O; int ldc; const float* bias; int bias_stride;
    struct Pre { f32x4 bv[2][2]; };
    __device__ __forceinline__ void preload(Pre& p, const Unit& u, int wr, int wc, int fr, int fq) const {
        const float* bb = bias + (size_t)u.e * bias_stride + u.pn * BM + wc * 32 + 8 * fq;
#pragma unroll
        for (int bj = 0; bj < 2; ++bj)
#pragma unroll
            for (int n = 0; n < 2; ++n) p.bv[bj][n] = *(const f32x4*)(bb + bj * HALF + 4 * n);
    }
    __device__ __forceinline__ void operator()(const f32x4 (&acc)[2][2][4][2], const Unit& u, int wr, int wc, int fr, int fq, const Pre& pre) const {
        const int row0 = u.pm * BM + wr * 64 + fr; const int col0 = u.pn * BM + wc * 32 + 8 * fq;
#pragma unroll
        for (int ai = 0; ai < 2; ++ai)
#pragma unroll
            for (int m = 0; m < 4; ++m) { bf16_t* rowp = O + (size_t)((row0 + ai * HALF + m * 16) & 255) * ldc + col0;
#pragma unroll
                for (int bj = 0; bj < 2; ++bj) { const f32x4 v0 = acc[ai][bj][m][0] + pre.bv[bj][0], v1 = acc[ai][bj][m][1] + pre.bv[bj][1];
                    u32x4 w; w.x = cvt_pk_bf16(v0[0], v0[1]); w.y = cvt_pk_bf16(v0[2], v0[3]); w.z = cvt_pk_bf16(v1[0], v1[1]); w.w = cvt_pk_bf16(v1[2], v1[3]);
                    *(u32x4*)(rowp + bj * HALF) = w; } }
    }
};
struct EpiBf16BiasF8 {
    static constexpr bool PERM = true, AFTER_DRAIN = false;
    bf16_t* O; int ldc; const float* bias; int bias_stride;
    struct Pre { f32x4 bv[2][2]; };
    __device__ __forceinline__ void preload(Pre& p, const Unit& u, int wr, int wc, int fr, int fq) const {
        const float* bb = bias + (size_t)u.e * bias_stride + u.pn * BM + wc * 32 + 8 * fq;
#pragma unroll
        for (int bj = 0; bj < 2; ++bj)
#pragma unroll
            for (int n = 0; n < 2; ++n) p.bv[bj][n] = *(const f32x4*)(bb + bj * HALF + 4 * n);
    }
    __device__ __forceinline__ void operator()(const f32x4 (&acc)[2][2][4][2], const Unit& u, int wr, int wc, int fr, int fq, const Pre& pre) const {
        asm volatile("" : "+v"(fr), "+v"(fq));
        const int row0 = u.pm * BM + wr * 64 + fr; const int col0 = u.pn * BM + wc * 32 + 8 * fq;
#pragma unroll
        for (int ai = 0; ai < 2; ++ai)
#pragma unroll
            for (int m = 0; m < 4; ++m) { bf16_t* rowp = O + (size_t)(row0 + ai * HALF + m * 16) * ldc + col0;
#pragma unroll
                for (int bj = 0; bj < 2; ++bj) { const f32x4 v0 = acc[ai][bj][m][0] * (1.0f / (F8_SA * F8_SW)) + pre.bv[bj][0], v1 = acc[ai][bj][m][1] * (1.0f / (F8_SA * F8_SW)) + pre.bv[bj][1];
                    u32x4 w; w.x = cvt_pk_bf16(v0[0], v0[1]); w.y = cvt_pk_bf16(v0[2], v0[3]); w.z = cvt_pk_bf16(v1[0], v1[1]); w.w = cvt_pk_bf16(v1[2], v1[3]);
                    *(u32x4*)(rowp + bj * HALF) = w; } }
    }
};
struct EpiF8BiasF8 {
    static constexpr bool PERM = true, AFTER_DRAIN = false;
    bf16_t* O; int ldc; const float* bias; int bias_stride;
    struct Pre { f32x4 bv[2][2]; };
    __device__ __forceinline__ void preload(Pre& p, const Unit& u, int wr, int wc, int fr, int fq) const {
        const float* bb = bias + (size_t)u.e * bias_stride + u.pn * BM + wc * 32 + 8 * fq;
#pragma unroll
        for (int bj = 0; bj < 2; ++bj)
#pragma unroll
            for (int n = 0; n < 2; ++n) p.bv[bj][n] = *(const f32x4*)(bb + bj * HALF + 4 * n);
    }
    __device__ __forceinline__ void operator()(const f32x4 (&acc)[2][2][4][2], const Unit& u, int wr, int wc, int fr, int fq, const Pre& pre) const {
        asm volatile("" : "+v"(fr), "+v"(fq));
        const int row0 = u.pm * BM + wr * 64 + fr; const int col0 = u.pn * BM + wc * 32 + 8 * fq;
#pragma unroll
        for (int ai = 0; ai < 2; ++ai)
#pragma unroll
            for (int m = 0; m < 4; ++m) { unsigned char* rowp = (unsigned char*)O + (size_t)(row0 + ai * HALF + m * 16) * ldc + col0;
#pragma unroll
                for (int bj = 0; bj < 2; ++bj) { const f32x4 v0 = (acc[ai][bj][m][0] * (1.0f / (F8_SA * F8_SW)) + pre.bv[bj][0]) * F8_SY, v1 = (acc[ai][bj][m][1] * (1.0f / (F8_SA * F8_SW)) + pre.bv[bj][1]) * F8_SY;
                    typedef unsigned u32x2 __attribute__((ext_vector_type(2)));
                    u32x2 w; w.x = pack4_fp8(v0[0], v0[1], v0[2], v0[3]); w.y = pack4_fp8(v1[0], v1[1], v1[2], v1[3]);
                    *(u32x2*)(rowp + bj * HALF) = w; } }
    }
};
struct EpiLruGate {
    static constexpr bool PERM = false, AFTER_DRAIN = false;
    const bf16_t* XL; bf16_t* LAB; size_t lab_stride; const float* gb; const float* spt;
    struct Pre {}; __device__ __forceinline__ void preload(Pre&, const Unit&, int, int, int, int) const {}
    __device__ __forceinline__ void operator()(const f32x4 (&acc)[2][2][4][2], const Unit& u, int wr, int wc, int fr, int fq, const Pre&) const {
        const int d = u.pn >> 1, half = u.pn & 1;
        const int row0 = u.pm * BM + wr * 64 + fr, ch0 = half * 128 + wc * 32 + 4 * fq;
        bf16_t* LA = LAB + (size_t)(2 * d) * lab_stride; bf16_t* LB = LAB + (size_t)(2 * d + 1) * lab_stride;
#pragma unroll
        for (int n = 0; n < 2; ++n) {
            const f32x4 bR = *(const f32x4*)(gb + (d * 2 + 0) * 256 + ch0 + 16 * n), bI = *(const f32x4*)(gb + (d * 2 + 1) * 256 + ch0 + 16 * n);
            const f32x4 sp = *(const f32x4*)(spt + d * 256 + ch0 + 16 * n) * (-8.0f * 1.4426950408889634f);
#pragma unroll
            for (int ai = 0; ai < 2; ++ai)
#pragma unroll
                for (int m = 0; m < 4; ++m) { const size_t ro = (size_t)(row0 + ai * HALF + m * 16) * 256 + ch0 + 16 * n;
                    typedef unsigned u32x2 __attribute__((ext_vector_type(2)));
                    const u32x2 xw = *(const u32x2*)(XL + ro);
                    const float xl[4] = {__builtin_bit_cast(float, xw.x << 16), __builtin_bit_cast(float, xw.x & 0xffff0000u), __builtin_bit_cast(float, xw.y << 16), __builtin_bit_cast(float, xw.y & 0xffff0000u)};
                    const f32x4 gr = acc[ai][0][m][n] + bR, gi = acc[ai][1][m][n] + bI;
                    f32x4 av, bv;
#pragma unroll
                    for (int e = 0; e < 4; ++e) {
                        const float rg = __builtin_amdgcn_rcpf(1.0f + __builtin_amdgcn_exp2f(-1.4426950408889634f * gr[e])), ig = __builtin_amdgcn_rcpf(1.0f + __builtin_amdgcn_exp2f(-1.4426950408889634f * gi[e]));
                        const float la2 = rg * sp[e];
                        const float a2 = __builtin_amdgcn_exp2f(2.0f * la2);
                        av[e] = la2; bv[e] = __builtin_amdgcn_sqrtf(fmaxf(1.0f - a2, 0.f)) * (ig * xl[e]); }
                    u32x2 wa, wb; wa.x = cvt_pk_bf16(av[0], av[1]); wa.y = cvt_pk_bf16(av[2], av[3]); wb.x = cvt_pk_bf16(bv[0], bv[1]); wb.y = cvt_pk_bf16(bv[2], bv[3]);
                    *(u32x2*)(LA + ro) = wa; *(u32x2*)(LB + ro) = wb; }
        }
    }
};
struct EpiNone {
    static constexpr bool PERM = true, AFTER_DRAIN = false;
    struct Pre {}; __device__ __forceinline__ void preload(Pre&, const Unit&, int, int, int, int) const {}
    __device__ __forceinline__ void operator()(const f32x4 (&acc)[2][2][4][2], const Unit& u, int wr, int wc, int fr, int fq, const Pre&) const {
#pragma unroll
        for (int a = 0; a < 2; ++a)
#pragma unroll
            for (int b2 = 0; b2 < 2; ++b2)
#pragma unroll
                for (int m = 0; m < 4; ++m)
#pragma unroll
                    for (int n = 0; n < 2; ++n) { f32x4 v = acc[a][b2][m][n]; asm volatile("" :: "v"(v)); }
    }
};
template <bool GATHER_> struct MoeOrderT {
    static constexpr bool GATHER = GATHER_;
    const int* rowtok;
    __device__ __forceinline__ int row_of(int r) const { return GATHER_ ? rowtok[r] : r; }
    const PG8_LAS int* tab; int ntiles, nN, nper, j, m_lo, nMx, wgm, rev;
    __device__ __forceinline__ void init(const PG8_LAS int* tab_, int ntiles_, int nN_, int G, int bx, int wgm_) {
        tab = tab_; ntiles = ntiles_; nN = nN_; wgm = wgm_; rev = 0;
        if (G % 8 == 0) { const int x = bx % 8; nper = G / 8; j = bx / 8; m_lo = (x * ntiles) / 8; nMx = ((x + 1) * ntiles) / 8 - m_lo; }
        else { nper = G; j = bx; m_lo = 0; nMx = ntiles; }
    }
    __device__ __forceinline__ bool next(int i, Unit& u) const {
        const int s = i * nper + j; if (s >= nMx * nN) return false;
        const int nig = wgm * nN, gid = s / nig, fm = gid * wgm, gsz = (nMx - fm) < wgm ? (nMx - fm) : wgm, w = s - gid * nig;
        const int mi = fm + (w % gsz); u.pm = m_lo + (rev ? (nMx - 1 - mi) : mi); u.pn = w / gsz; u.e = tab[u.pm]; u.be = u.e * nN + u.pn; return true;
    }
    __device__ __forceinline__ void a_ready(const Unit&) const {}
    __device__ __forceinline__ void done(const Unit&) const {}
};
template <class Epi, class Sched, bool ALIGN_EPI = false, bool SP2 = false, bool FP8 = false>
__device__ __forceinline__ void gemm_phase(PG8_LAS unsigned char* lds, const Gemm g, const Sched& S, const Epi& E) {
    int tid_ = threadIdx.x; asm volatile("" : "+v"(tid_));
    const int tid = tid_, wid = __builtin_amdgcn_readfirstlane(tid >> 6), lane = tid & 63, wr = wid >> 2, wc = wid & 3, fr = lane & 15, fq = lane >> 4;
    const int K = g.K, nt = K / BK;
    unsigned voffA[2], voffB[2];
#pragma unroll
    for (int i = 0; i < 2; ++i) { int R, C; stage_rc(tid * 16 + i * 8192, R, C); const int Rb = Epi::PERM ? ((R & ~31) + perm32(R & 31)) : R;
        voffA[i] = (unsigned)(R * K + C) * 2u; voffB[i] = (unsigned)(Rb * K + C) * 2u; }
    unsigned gA_[2] = {0u, 0u}, gN_[2] = {0u, 0u}, gC_[2] = {0u, 0u};
    static_assert(!Sched::GATHER || SP2, "the gathered A operand is wired into the SP2 loop only");
    if constexpr (Sched::GATHER) { _Pragma("unroll") for (int i_ = 0; i_ < 2; ++i_) { int R_, C_; stage_rc(tid * 16 + i_ * 8192, R_, C_); gC_[i_] = (unsigned)(C_ * 2); } }
#define PG8_GLOAD(dst, pm_) do { _Pragma("unroll") for (int h_ = 0; h_ < 2; ++h_) { unsigned t_[2]; _Pragma("unroll") for (int i_ = 0; i_ < 2; ++i_) { int R_, C_; stage_rc(tid * 16 + i_ * 8192, R_, C_); \
        t_[i_] = (unsigned)S.row_of((pm_) * BM + h_ * HALF + R_); } dst[h_] = t_[0] | (t_[1] << 16); } } while (0)
    const size_t kstep = (size_t)(BK * 2);
    const size_t hstep = (size_t)HALF * K * 2;
    const size_t tstep = 2 * hstep;
    const unsigned ldsw = (unsigned)wid * 1024u;
    const int aoff = lds_byte(wr * 64 + fr, fq * 8), boff = lds_byte(wc * 32 + fr, fq * 8);
#define PG8_SA(b, h) (((b) * 2 + (h)) * HTB)
#define PG8_SB(b, h) ((4 + (b) * 2 + (h)) * HTB)
#define PG8_STAGE(bufoff, gbase, voff) do { _Pragma("unroll") for (int _i = 0; _i < 2; ++_i) \
        __builtin_amdgcn_global_load_lds((const unsigned*)((const char*)(gbase) + (voff)[_i]), (PG8_LAS unsigned*)(lds + (bufoff) + ldsw + _i * 8192), 16, 0, 0); } while (0)
#define PG8_STA(bufoff, ptr, h, useN) do { if constexpr (Sched::GATHER) { const unsigned pk_ = (useN) ? gN_[h] : gA_[h]; unsigned o_[2] = {(pk_ & 0xffffu) * (unsigned)(K * 2) + gC_[0], (pk_ >> 16) * (unsigned)(K * 2) + gC_[1]}; PG8_STAGE(bufoff, ptr, o_); } \
        else { PG8_STAGE(bufoff, (ptr) + ((h) ? hstep : 0), voffA); } } while (0)
#define PG8_LDA(dst, b, h) do { _Pragma("unroll") for (int m = 0; m < 4; ++m) { if constexpr (FP8) { \
            dst##8[m] = __builtin_shufflevector(*(const PG8_LAS i32x4_*)(lds + PG8_SA(b, h) + aoff + m * 2048), *(const PG8_LAS i32x4_*)(lds + PG8_SA(b, h) + aoff + m * 2048 + 1024), 0, 1, 2, 3, 4, 5, 6, 7); } \
        else { _Pragma("unroll") for (int k = 0; k < 2; ++k) dst[m][k] = *(const PG8_LAS bf16x8*)(lds + PG8_SA(b, h) + aoff + m * 2048 + k * 1024); } } } while (0)
#define PG8_LDB(dst, b, h) do { _Pragma("unroll") for (int n = 0; n < 2; ++n) { if constexpr (FP8) { \
            dst##8[n] = __builtin_shufflevector(*(const PG8_LAS i32x4_*)(lds + PG8_SB(b, h) + boff + n * 2048), *(const PG8_LAS i32x4_*)(lds + PG8_SB(b, h) + boff + n * 2048 + 1024), 0, 1, 2, 3, 4, 5, 6, 7); } \
        else { _Pragma("unroll") for (int k = 0; k < 2; ++k) dst[n][k] = *(const PG8_LAS bf16x8*)(lds + PG8_SB(b, h) + boff + n * 2048 + k * 1024); } } } while (0)
#define PG8_MMA(ai, bj, At, Bt) do { __builtin_amdgcn_s_setprio(1); _Pragma("unroll") for (int m = 0; m < 4; ++m) _Pragma("unroll") for (int n = 0; n < 2; ++n) { \
        if constexpr (FP8) asm volatile("v_mfma_f32_16x16x128_f8f6f4 %0, %1, %2, %0" : "+v"(acc[ai][bj][m][n]) : "v"(Bt##8[n]), "v"(At##8[m]));   \
        else { _Pragma("unroll") for (int k = 0; k < 2; ++k) acc[ai][bj][m][n] = __builtin_amdgcn_mfma_f32_16x16x32_bf16(Bt[n][k], At[m][k], acc[ai][bj][m][n], 0, 0, 0); } } \
        __builtin_amdgcn_s_setprio(0); } while (0)
#define PG8_WAIT_V(n) asm volatile("s_waitcnt vmcnt(" #n ")" ::: "memory")
#define PG8_WAIT_L(n) asm volatile("s_waitcnt lgkmcnt(" #n ")" ::: "memory")
#define PG8_BAR __builtin_amdgcn_s_barrier()
#define PG8_SCHED __builtin_amdgcn_sched_barrier(0)
    Unit cur, nxt; int ui = 0;
    if (!S.next(0, cur)) return;
    f32x4 acc[2][2][4][2];
#pragma unroll
    for (int a = 0; a < 2; ++a)
#pragma unroll
        for (int b = 0; b < 2; ++b)
#pragma unroll
            for (int m = 0; m < 4; ++m)
#pragma unroll
                for (int n = 0; n < 2; ++n) acc[a][b][m][n] = (f32x4){0.f, 0.f, 0.f, 0.f};
    typedef int i32x4_ __attribute__((ext_vector_type(4))); typedef int i32x8_ __attribute__((ext_vector_type(8)));
    bf16x8 At[4][2], B0[2][2], B1[2][2]; i32x8_ At8[4], B08[2], B18[2];
    typename Epi::Pre pre;
    const char* cA = (const char*)g.A + (Sched::GATHER ? (size_t)0 : (size_t)cur.pm * tstep); if constexpr (Sched::GATHER) PG8_GLOAD(gA_, cur.pm);
    const char* cB = (const char*)g.Bt + (size_t)cur.be * tstep;
    S.a_ready(cur);
    if constexpr (SP2) {
        PG8_STAGE(PG8_SB(0, 0), cB, voffB); PG8_STAGE(PG8_SB(0, 1), cB + hstep, voffB); PG8_STA(PG8_SA(0, 0), cA, 0, false); PG8_STA(PG8_SA(0, 1), cA, 1, false);
        if (wr == 1) PG8_BAR;
        PG8_WAIT_V(2); PG8_BAR;
        PG8_STAGE(PG8_SB(1, 0), cB + kstep, voffB); PG8_STA(PG8_SA(1, 0), cA + kstep, 0, false); PG8_STAGE(PG8_SB(1, 1), cB + hstep + kstep, voffB);
        PG8_WAIT_V(6); PG8_BAR;
    } else {
        PG8_STAGE(PG8_SB(0, 0), cB, voffB); PG8_STAGE(PG8_SA(0, 0), cA, voffA); PG8_STAGE(PG8_SB(0, 1), cB + hstep, voffB); PG8_STAGE(PG8_SA(0, 1), cA + hstep, voffA);
        if (wr == 1) PG8_BAR;
        PG8_WAIT_V(4); PG8_BAR;
        PG8_STAGE(PG8_SB(1, 0), cB + kstep, voffB); PG8_STAGE(PG8_SA(1, 0), cA + kstep, voffA); PG8_STAGE(PG8_SB(1, 1), cB + hstep + kstep, voffB);
        PG8_WAIT_V(6); PG8_BAR;
    }
    for (;;) {
        const bool has_next = S.next(ui + 1, nxt);
        const char* nA = (has_next && !Sched::GATHER) ? (const char*)g.A + (size_t)nxt.pm * tstep : cA; const char* nB = has_next ? (const char*)g.Bt + (size_t)nxt.be * tstep : cB;
        if constexpr (Sched::GATHER) { if (has_next) PG8_GLOAD(gN_, nxt.pm); else { gN_[0] = gA_[0]; gN_[1] = gA_[1]; } }
        for (int t = 0; t < nt; t += 2) {
            const bool last = (t == nt - 2);
            const char* a1 = cA + (size_t)(t + 1) * kstep;
            const char* a2 = last ? nA : cA + (size_t)(t + 2) * kstep; const char* b2 = last ? nB : cB + (size_t)(t + 2) * kstep;
            const char* a3 = a2 + kstep; const char* b3 = b2 + kstep;
            if (last) E.preload(pre, cur, wr, wc, fr, fq);
            if (last && has_next) S.a_ready(nxt);
            if constexpr (SP2) {
            PG8_LDB(B0, 0, 0); PG8_LDB(B1, 0, 1); PG8_SCHED; PG8_LDA(At, 0, 0); PG8_STA(PG8_SA(1, 1), a1, 1, false);
            PG8_WAIT_V(8); PG8_WAIT_L(0); PG8_BAR; PG8_MMA(0, 0, At, B0); PG8_MMA(0, 1, At, B1); PG8_BAR; PG8_SCHED;
            PG8_LDA(At, 0, 1); PG8_STAGE(PG8_SB(0, 0), b2, voffB); PG8_STAGE(PG8_SB(0, 1), b2 + hstep, voffB); PG8_STA(PG8_SA(0, 0), a2, 0, last);
            PG8_WAIT_V(8); PG8_WAIT_L(0); PG8_BAR; PG8_MMA(1, 0, At, B0); PG8_MMA(1, 1, At, B1); PG8_BAR; PG8_SCHED;
            PG8_LDB(B0, 1, 0); PG8_LDB(B1, 1, 1); PG8_SCHED; PG8_LDA(At, 1, 0); PG8_STA(PG8_SA(0, 1), a2, 1, last);
            PG8_WAIT_V(8); PG8_WAIT_L(0); PG8_BAR; PG8_MMA(0, 0, At, B0); PG8_MMA(0, 1, At, B1); PG8_BAR; PG8_SCHED;
            PG8_LDA(At, 1, 1); PG8_STAGE(PG8_SB(1, 0), b3, voffB); PG8_STAGE(PG8_SB(1, 1), b3 + hstep, voffB); PG8_STA(PG8_SA(1, 0), a3, 0, last);
            PG8_WAIT_V(8); PG8_WAIT_L(0); PG8_BAR; PG8_MMA(1, 0, At, B0); PG8_MMA(1, 1, At, B1); PG8_BAR; PG8_SCHED;
            } else {
            PG8_LDB(B0, 0, 0); PG8_SCHED; PG8_LDA(At, 0, 0); PG8_STAGE(PG8_SA(1, 1), a1 + hstep, voffA);
            PG8_WAIT_L(8); PG8_BAR; PG8_WAIT_L(0); PG8_MMA(0, 0, At, B0); PG8_BAR; PG8_SCHED;
            PG8_LDB(B1, 0, 1); PG8_STAGE(PG8_SB(0, 0), b2, voffB);
            PG8_BAR; PG8_WAIT_L(0); PG8_MMA(0, 1, At, B1); PG8_BAR;
            PG8_LDA(At, 0, 1); PG8_STAGE(PG8_SA(0, 0), a2, voffA);
            PG8_BAR; PG8_WAIT_L(0); PG8_MMA(1, 0, At, B0); PG8_BAR; PG8_SCHED;
            PG8_STAGE(PG8_SB(0, 1), b2 + hstep, voffB);
            PG8_WAIT_V(6); PG8_BAR; PG8_MMA(1, 1, At, B1); PG8_BAR;
            PG8_LDB(B0, 1, 0); PG8_SCHED; PG8_LDA(At, 1, 0); PG8_STAGE(PG8_SA(0, 1), a2 + hstep, voffA);
            PG8_WAIT_L(8); PG8_BAR; PG8_WAIT_L(0); PG8_MMA(0, 0, At, B0); PG8_BAR; PG8_SCHED;
            PG8_LDB(B1, 1, 1); PG8_STAGE(PG8_SB(1, 0), b3, voffB);
            PG8_BAR; PG8_WAIT_L(0); PG8_MMA(0, 1, At, B1); PG8_BAR;
            PG8_LDA(At, 1, 1); PG8_STAGE(PG8_SA(1, 0), a3, voffA);
            PG8_BAR; PG8_WAIT_L(0); PG8_MMA(1, 0, At, B0); PG8_BAR; PG8_SCHED;
            PG8_STAGE(PG8_SB(1, 1), b3 + hstep, voffB);
            PG8_WAIT_V(6); PG8_BAR; PG8_MMA(1, 1, At, B1); PG8_BAR;
            }
        }
        if constexpr (ALIGN_EPI) { if (wr == 0) PG8_BAR; }
        if constexpr (!Epi::AFTER_DRAIN) { E(acc, cur, wr, wc, fr, fq, pre); S.done(cur); }
        if (!has_next) break;
#pragma unroll
        for (int a = 0; a < 2; ++a)
#pragma unroll
            for (int b = 0; b < 2; ++b)
#pragma unroll
                for (int m = 0; m < 4; ++m)
#pragma unroll
                    for (int n = 0; n < 2; ++n) acc[a][b][m][n] = (f32x4){0.f, 0.f, 0.f, 0.f};
        cur = nxt; cA = nA; cB = nB; ++ui;
        if constexpr (Sched::GATHER) { gA_[0] = gN_[0]; gA_[1] = gN_[1]; }
        if constexpr (ALIGN_EPI) { if (wr == 1) PG8_BAR; }
    }
    PG8_WAIT_V(0);
    if constexpr (!ALIGN_EPI) { if (wr == 0) PG8_BAR; }
    PG8_BAR;
    if constexpr (Epi::AFTER_DRAIN) { E.fused(acc, cur, wr, wc, fr, fq, lds, wid, lane); S.done(cur); }
#undef PG8_SA
#undef PG8_SB
#undef PG8_STAGE
#undef PG8_STA
#undef PG8_GLOAD
#undef PG8_LDA
#undef PG8_LDB
#undef PG8_MMA
#undef PG8_WAIT_V
#undef PG8_WAIT_L
#undef PG8_BAR
#undef PG8_SCHED
}
}

#ifndef PG8_SP2
#define PG8_SP2 true
#endif
#ifndef PG8_ALIGN
#define PG8_ALIGN true
#endif
#include <cmath>
namespace attn_body {
using bf16=__hip_bfloat16;
using bf16x8=__attribute__((ext_vector_type(8)))short;
using s16x4=__attribute__((ext_vector_type(4)))short;
using f32x16=__attribute__((ext_vector_type(16)))float;
using u32x4=__attribute__((ext_vector_type(4)))unsigned;
using f32x4_t=__attribute__((ext_vector_type(4)))float;
constexpr int NHEAD=8,SEQQ=8192,SEQK=8448,D=64,QP=512,KP=128,QIN=2048;
constexpr int NW=8,QBLK=32,QB=QBLK*NW,KVBLK=64,NQB=SEQQ/QB;
constexpr int ATTN_UNIT_ROWS=QB;
__device__ __forceinline__ int crow(int r,int hi){return (r&3)+8*(r>>2)+4*hi;}
#define SBAR() __builtin_amdgcn_sched_barrier(0)
__device__ __forceinline__ void cmask(f32x16&p0,f32x16&p1,int jb,int qrel,int hi){
  const float NEG=-INFINITY; int kb=64*jb+4*hi;
  #pragma unroll
  for(int r=0;r<16;++r){int kv=kb+(r&3)+8*(r>>2); if(kv>qrel)p0[r]=NEG; if(kv+32>qrel)p1[r]=NEG;}
}

constexpr int NSLOT=3, SLOTB=8192;
constexpr int LDS_K=0, LDS_V=NSLOT*SLOTB, LDS_WS=2*NSLOT*SLOTB, LDS_OST=LDS_WS+NW*64*4, LDS_BYTES=LDS_OST+NW*4096;
constexpr float C2=0.125f*1.4426950408889634f;
__device__ __forceinline__ void glds16(const void*gsrc,unsigned lds_dst){unsigned keep;
  asm volatile("s_mov_b32 %0, m0\n\ts_mov_b32 m0, %2\n\ts_nop 0\n\tglobal_load_lds_dwordx4 %1, off\n\ts_mov_b32 m0, %0":"=&s"(keep):"v"(gsrc),"s"(lds_dst):"memory");}
__device__ __forceinline__ float max3f(float a,float b,float c){float r;asm("v_max3_f32 %0, %1, %2, %3":"=v"(r):"v"(a),"v"(b),"v"(c));return r;}
__device__ __forceinline__ float max2f(float a,float b){float r;asm("v_max_f32_e32 %0, %1, %2":"=v"(r):"v"(a),"v"(b));return r;}
__device__ __forceinline__ float fadd_s(float a,float b){float r;asm("v_add_f32_e32 %0, %1, %2":"=v"(r):"v"(a),"v"(b));return r;}
__device__ __forceinline__ float fsub_s(float a,float b){float r;asm("v_sub_f32_e32 %0, %1, %2":"=v"(r):"v"(a),"v"(b));return r;}
typedef float f32x2_t __attribute__((ext_vector_type(2))); typedef __bf16 bf16x2_t __attribute__((ext_vector_type(2)));
__device__ __forceinline__ unsigned cvtpk_s(float lo,float hi){f32x2_t v={lo,hi};bf16x2_t b=__builtin_convertvector(v,bf16x2_t);return __builtin_bit_cast(unsigned,b);}
#define WAIT_BAR(N) asm volatile("s_waitcnt vmcnt(" #N ") lgkmcnt(0)\n\ts_barrier":::"memory")

__device__ __forceinline__ void qkt(f32x16&p0,f32x16&p1,const char*Kslot,const bf16x8*qr,const f32x16&negm,int r32,int hi){
  const char*kb=Kslot+hi*1024+r32*16;
  #pragma unroll
  for(int d0=0;d0<4;++d0){
    const bf16x8 b0=*reinterpret_cast<const bf16x8*>(kb+d0*2048);
    const bf16x8 b1=*reinterpret_cast<const bf16x8*>(kb+d0*2048+512);
    if(d0==0){p0=__builtin_amdgcn_mfma_f32_32x32x16_bf16(b0,qr[0],negm,0,0,0);p1=__builtin_amdgcn_mfma_f32_32x32x16_bf16(b1,qr[0],negm,0,0,0);}
    else{p0=__builtin_amdgcn_mfma_f32_32x32x16_bf16(b0,qr[d0],p0,0,0,0);p1=__builtin_amdgcn_mfma_f32_32x32x16_bf16(b1,qr[d0],p1,0,0,0);}}
}
typedef __attribute__((address_space(3))) const char* lds_cptr;
typedef short v4i16_t __attribute__((ext_vector_type(4)));
__device__ __forceinline__ void kload8(bf16x8*kf,lds_cptr kp){
  kf[0]=*(const __attribute__((address_space(3))) bf16x8*)(kp);      kf[1]=*(const __attribute__((address_space(3))) bf16x8*)(kp+512);
  kf[2]=*(const __attribute__((address_space(3))) bf16x8*)(kp+2048); kf[3]=*(const __attribute__((address_space(3))) bf16x8*)(kp+2560);
  kf[4]=*(const __attribute__((address_space(3))) bf16x8*)(kp+4096); kf[5]=*(const __attribute__((address_space(3))) bf16x8*)(kp+4608);
  kf[6]=*(const __attribute__((address_space(3))) bf16x8*)(kp+6144); kf[7]=*(const __attribute__((address_space(3))) bf16x8*)(kp+6656);
}
__device__ __forceinline__ void kload2(bf16x8*kf,lds_cptr kp,int j){ kf[2*j]=*(const __attribute__((address_space(3))) bf16x8*)(kp+j*2048); kf[2*j+1]=*(const __attribute__((address_space(3))) bf16x8*)(kp+j*2048+512); }
__device__ __forceinline__ s16x4 vtr(lds_cptr p){ return __builtin_bit_cast(s16x4,__builtin_amdgcn_ds_read_tr16_b64_v4i16((__attribute__((address_space(3))) v4i16_t*)p)); }
__device__ __forceinline__ float rowmax(const f32x16&p0,const f32x16&p1){
  float a=max3f(p0[0],p0[1],p1[0]),b=max3f(p0[2],p0[3],p1[1]);a=max3f(a,p1[2],p1[3]);
  #pragma unroll
  for(int r=4;r<16;r+=4){a=max3f(a,p0[r],p0[r+1]);b=max3f(b,p0[r+2],p0[r+3]);a=max3f(a,p1[r],p1[r+1]);b=max3f(b,p1[r+2],p1[r+3]);}
  const float m=max2f(a,b);
  auto rr=__builtin_amdgcn_permlane32_swap(__float_as_uint(m),__float_as_uint(m),false,false);
  return max2f(__uint_as_float(rr[0]),__uint_as_float(rr[1]));
}
__device__ __forceinline__ void pv(f32x16*o,int vb,bf16x8 pa0,bf16x8 pa1,bf16x8 pa2,bf16x8 pa3){
  #pragma unroll
  for(int d0=0;d0<2;++d0){s16x4 lo[4],hi[4];
    #pragma unroll
    for(int ks=0;ks<4;++ks){
      asm volatile("ds_read_b64_tr_b16 %0,%1 offset:%c2":"=&v"(lo[ks]):"v"(vb),"i"(d0*4096+ks*1024):"memory");
      asm volatile("ds_read_b64_tr_b16 %0,%1 offset:%c2":"=&v"(hi[ks]):"v"(vb),"i"(d0*4096+ks*1024+512):"memory");}
    asm volatile("s_waitcnt lgkmcnt(0)":::"memory");SBAR();
    #define PK(k) (bf16x8){lo[k][0],lo[k][1],lo[k][2],lo[k][3],hi[k][0],hi[k][1],hi[k][2],hi[k][3]}
    o[d0]=__builtin_amdgcn_mfma_f32_32x32x16_bf16(pa0,PK(0),o[d0],0,0,0);
    o[d0]=__builtin_amdgcn_mfma_f32_32x32x16_bf16(pa1,PK(1),o[d0],0,0,0);
    o[d0]=__builtin_amdgcn_mfma_f32_32x32x16_bf16(pa2,PK(2),o[d0],0,0,0);
    o[d0]=__builtin_amdgcn_mfma_f32_32x32x16_bf16(pa3,PK(3),o[d0],0,0,0);
    #undef PK
  }
}

#ifndef ATTN_STORE16
#define ATTN_STORE16(p,v) (*(u32x4*)(p)=(v))
#endif
struct QPre { const float* qg; const float* rc; const float* rs; };
template<int THRL> __device__ __forceinline__ void attn_unit(int b,int h,long qrow0,int NTarg,int tq0,const QPre&QN,const bf16*Q,const bf16*__restrict__ K,const bf16*__restrict__ V,bf16*O,char*shm){
  int tid_=threadIdx.x; asm volatile("":"+v"(tid_)); const int tid=tid_,lane=tid&63,r32=lane&31,hi=lane>>5; const int wid=__builtin_amdgcn_readfirstlane(tid>>6);
  const long krowbase=(long)b*SEQK; const int kvh=h>>2;
  const bf16*Qw=Q+(qrow0+wid*QBLK)*QIN+h*D;
  const bf16*Kh=K+krowbase*KP+kvh*D,*Vh=V+krowbase*KP+kvh*D;
  const unsigned lds0=(unsigned)(uintptr_t)shm;
  float*wsf=(float*)(shm+LDS_WS)+wid*64;
  const bf16*ksrc=Kh+(long)lane*KP+wid*8;
  const bf16*vsrc=Vh+(long)(16*(wid&3)+(lane>>2))*KP+(wid>>2)*32+(lane&3)*8;
  const unsigned kdst=lds0+LDS_K+wid*1024, vdst=lds0+LDS_V+wid*1024;
  #define DMA_K(t,slot) glds16(ksrc+(long)(t)*KVBLK*KP,(unsigned)__builtin_amdgcn_readfirstlane(kdst+(slot)))
  #define DMA_V(t,slot) glds16(vsrc+(long)(t)*KVBLK*KP,(unsigned)__builtin_amdgcn_readfirstlane(vdst+(slot)))
  const int vb0=(int)(lds0+LDS_V)+((lane>>4)&1)*32+(lane&3)*8+(4*hi+((lane&15)>>2))*64;
  const char*Kbase=shm+LDS_K; bf16x8 kf[8];
  const lds_cptr shm3=(lds_cptr)shm; const lds_cptr kp0=shm3+LDS_K+hi*1024+r32*16; const lds_cptr vp0=shm3+LDS_V+((lane>>4)&1)*32+(lane&3)*8+(4*hi+((lane&15)>>2))*64;
  const int NT=NTarg;
  DMA_K(0,0);DMA_V(0,0);DMA_K(1,SLOTB);
  bf16x8 qr[4];
  #pragma unroll
  for(int d0=0;d0<4;++d0)qr[d0]=*reinterpret_cast<const bf16x8*>(&Qw[(long)r32*QIN+d0*16+hi*8]);
  {
    float x[4][8]; float ss=0.f;
    #pragma unroll
    for(int d0=0;d0<4;++d0){
      #pragma unroll
      for(int e=0;e<8;++e){ x[d0][e]=__builtin_bit_cast(float,(unsigned)(unsigned short)qr[d0][e]<<16); ss+=x[d0][e]*x[d0][e]; } }
    ss+=__shfl_xor(ss,32);
    const float rstd=C2/sqrtf(ss*(1.0f/64.0f)+1e-6f);
    #pragma unroll
    for(int d0=0;d0<4;++d0){ const f32x4_t g0=*reinterpret_cast<const f32x4_t*>(QN.qg+16*d0+8*hi), g1=*reinterpret_cast<const f32x4_t*>(QN.qg+16*d0+8*hi+4);
      #pragma unroll
      for(int e=0;e<8;++e) x[d0][e]*=rstd*(e<4?g0[e]:g1[e-4]); }
    if(tq0>=0){ const int t=tq0+wid*QBLK+r32;
      #pragma unroll
      for(int d0=0;d0<2;++d0){ const float*cp=QN.rc+(long)t*32+16*d0+8*hi,*sp=QN.rs+(long)t*32+16*d0+8*hi;
        const f32x4_t c0=*reinterpret_cast<const f32x4_t*>(cp),c1=*reinterpret_cast<const f32x4_t*>(cp+4),s0=*reinterpret_cast<const f32x4_t*>(sp),s1=*reinterpret_cast<const f32x4_t*>(sp+4);
        #pragma unroll
        for(int e=0;e<8;++e){ const float cs=e<4?c0[e]:c1[e-4], sn=e<4?s0[e]:s1[e-4]; const float a=x[d0][e], bq=x[d0+2][e]; x[d0][e]=a*cs-bq*sn; x[d0+2][e]=bq*cs+a*sn; } } }
    #pragma unroll
    for(int d0=0;d0<4;++d0){ u32x4 pk; pk[0]=cvtpk_s(x[d0][0],x[d0][1]); pk[1]=cvtpk_s(x[d0][2],x[d0][3]); pk[2]=cvtpk_s(x[d0][4],x[d0][5]); pk[3]=cvtpk_s(x[d0][6],x[d0][7]); qr[d0]=__builtin_bit_cast(bf16x8,pk); }
  }
  float mhat=0.f,l_reg=0.f;f32x16 o[2];o[0]=f32x16{};o[1]=f32x16{};f32x16 negm=f32x16{};asm volatile("":"+v"(negm));
  const int qrel=wid*QBLK+r32;
  #define CMASK(P0,P1,t) do{}while(0)
  bool resc=false;
  #define START(P0,P1) do{ const float rm=rowmax(P0,P1); resc=false; \
    { const float dl=rm; mhat=fadd_s(mhat,dl); \
      _Pragma("unroll") for(int r=0;r<16;++r){P0[r]=fsub_s(P0[r],dl);P1[r]=fsub_s(P1[r],dl);} \
      _Pragma("unroll") for(int r=0;r<16;++r)negm[r]=-mhat; asm volatile("":"+v"(negm)); } \
    _Pragma("unroll") for(int r=0;r<16;++r)P0[r]=__builtin_amdgcn_exp2f(P0[r]); }while(0)
  #define RESC() do{ if(resc){ asm volatile("s_waitcnt lgkmcnt(0)":::"memory"); \
      _Pragma("unroll") for(int d_=0;d_<2;++d_) _Pragma("unroll") for(int r=0;r<16;++r)o[d_][r]*=wsf[crow(r,hi)]; } }while(0)
  f32x16 pA0,pA1,pB0,pB1;
  int sl_prev=0,sl_cur=0,sl_next=SLOTB;
  #define ROT() do{sl_prev=sl_cur;sl_cur=sl_next;sl_next=(sl_next==(NSLOT-1)*SLOTB)?0:sl_next+SLOTB;}while(0)
  DMA_K(2,2*SLOTB);
  WAIT_BAR(3);
  qkt(pA0,pA1,Kbase,qr,negm,r32,hi);asm volatile("s_nop 15\n\ts_nop 7":"+v"(pA0),"+v"(pA1));CMASK(pA0,pA1,0);
  START(pA0,pA1);
  _Pragma("unroll") for(int r=0;r<16;++r)pA1[r]=__builtin_amdgcn_exp2f(pA1[r]);
  WAIT_BAR(0);
  DMA_K(3,0);DMA_V(1,SLOTB);
  ROT();
  kload8(kf,kp0+sl_cur);
  WAIT_BAR(2);
  s16x4 vlo[8],vhi[8]; u32x4 pw0,pw1,pw2,pw3;
  #define PKW(P,B) cvtpk_s(P[B],P[B+1])
  #define PAF(k) __builtin_bit_cast(bf16x8,pw##k)
  #define VFR(i) (bf16x8){vlo[i][0],vlo[i][1],vlo[i][2],vlo[i][3],vhi[i][0],vhi[i][1],vhi[i][2],vhi[i][3]}
  #define PIN(x) asm volatile("":"+v"(x))
  #define MX3(a,b,c) __builtin_fmaxf(__builtin_fmaxf((a),(b)),(c))
  #define GAPA(MF,A0,A1,A2,A3,W0,W1,PW) do{ MF; sacc+=A0; sacc+=A1; sacc+=A2; sacc+=A3; PIN(sacc); W0; W1; PIN(PW); SBAR(); }while(0)
  #define EX(v) __builtin_amdgcn_exp2f(v)
  #define GAPB(MF,X,B) do{ MF; X[B]=EX(X[B]); X[B+1]=EX(X[B+1]); X[B+2]=EX(X[B+2]); X[B+3]=EX(X[B+3]); PIN(X); SBAR(); }while(0)
  #define VRD(i) do{ vlo[i]=vtr(vp_+(((i)>>2)*4096+((i)&3)*1024)); vhi[i]=vtr(vp_+(((i)>>2)*4096+((i)&3)*1024+512)); }while(0)
  #define KRD(G,j) do{ if(G){ kload2(kf,kp0+sl_next,j); SBAR(); } }while(0)
  #define STEP(C0,C1,P0,P1,t,GK,GV,GL) do{ SBAR(); \
    const lds_cptr vp_=vp0+sl_prev; \
    VRD(0); SBAR(); float sacc=(P0[0]+P0[1]); \
    GAPA(C0=__builtin_amdgcn_mfma_f32_32x32x16_bf16(kf[0],qr[0],negm,0,0,0), P0[2],P0[3],P0[4],P0[5],     pw0[0]=PKW(P0,0), pw0[1]=PKW(P0,2), pw0); \
    VRD(4); SBAR(); GAPA(C1=__builtin_amdgcn_mfma_f32_32x32x16_bf16(kf[1],qr[0],negm,0,0,0), P0[6],P0[7],P0[8],P0[9],     pw0[2]=PKW(P0,4), pw0[3]=PKW(P0,6), pw0); \
    VRD(1); SBAR(); GAPA(C0=__builtin_amdgcn_mfma_f32_32x32x16_bf16(kf[2],qr[1],C0,0,0,0),   P0[10],P0[11],P0[12],P0[13], pw1[0]=PKW(P0,8), pw1[1]=PKW(P0,10), pw1); \
    VRD(5); SBAR(); GAPA(C1=__builtin_amdgcn_mfma_f32_32x32x16_bf16(kf[3],qr[1],C1,0,0,0),   P0[14],P0[15],P1[0],P1[1],   pw1[2]=PKW(P0,12),pw1[3]=PKW(P0,14), pw1); \
    VRD(2); SBAR(); GAPA(C0=__builtin_amdgcn_mfma_f32_32x32x16_bf16(kf[4],qr[2],C0,0,0,0),   P1[2],P1[3],P1[4],P1[5],     pw2[0]=PKW(P1,0), pw2[1]=PKW(P1,2), pw2); \
    VRD(6); SBAR(); GAPA(C1=__builtin_amdgcn_mfma_f32_32x32x16_bf16(kf[5],qr[2],C1,0,0,0),   P1[6],P1[7],P1[8],P1[9],     pw2[2]=PKW(P1,4), pw2[3]=PKW(P1,6), pw2); \
    VRD(3); SBAR(); GAPA(C0=__builtin_amdgcn_mfma_f32_32x32x16_bf16(kf[6],qr[3],C0,0,0,0),   P1[10],P1[11],P1[12],P1[13], pw3[0]=PKW(P1,8), pw3[1]=PKW(P1,10), pw3); \
    VRD(7); SBAR(); GAPA(C1=__builtin_amdgcn_mfma_f32_32x32x16_bf16(kf[7],qr[3],C1,0,0,0),   P1[14],P1[15],0.f,0.f,       pw3[2]=PKW(P1,12),pw3[3]=PKW(P1,14), pw3); \
    l_reg+=sacc; \
    if(GK){DMA_K((t)+3,sl_cur);} if(GV){DMA_V((t)+1,sl_next);} \
    CMASK(C0,C1,t); \
    { float a=MX3(C0[0],C0[1],C1[0]),b=MX3(C0[2],C0[3],C1[1]); a=MX3(a,C1[2],C1[3]); \
      _Pragma("unroll") for(int r=4;r<16;r+=4){a=MX3(a,C0[r],C0[r+1]);b=MX3(b,C0[r+2],C0[r+3]);a=MX3(a,C1[r],C1[r+1]);b=MX3(b,C1[r+2],C1[r+3]);} \
      float rm=__builtin_fmaxf(a,b); { auto rr=__builtin_amdgcn_permlane32_swap(__float_as_uint(rm),__float_as_uint(rm),false,false); rm=__builtin_fmaxf(__uint_as_float(rr[0]),__uint_as_float(rr[1])); } \
      resc=false; \
      if(__builtin_expect(__any(rm>(float)THRL),0)){ const float dl=__builtin_fmaxf(rm,0.f); mhat+=dl; \
        _Pragma("unroll") for(int r=0;r<16;++r){C0[r]-=dl;C1[r]-=dl;} \
        _Pragma("unroll") for(int r=0;r<16;++r)negm[r]=-mhat; asm volatile("":"+v"(negm)); \
        const float f=__builtin_amdgcn_exp2f(-dl); l_reg*=f; if(hi==0)wsf[r32]=f; resc=true; } } \
    SBAR(); \
    GAPB(o[0]=__builtin_amdgcn_mfma_f32_32x32x16_bf16(PAF(0),VFR(0),o[0],0,0,0), C0,0); \
    GAPB(o[1]=__builtin_amdgcn_mfma_f32_32x32x16_bf16(PAF(0),VFR(4),o[1],0,0,0), C0,4); \
    KRD(GL,0); GAPB(o[0]=__builtin_amdgcn_mfma_f32_32x32x16_bf16(PAF(1),VFR(1),o[0],0,0,0), C0,8); \
    KRD(GL,1); GAPB(o[1]=__builtin_amdgcn_mfma_f32_32x32x16_bf16(PAF(1),VFR(5),o[1],0,0,0), C0,12); \
    KRD(GL,2); GAPB(o[0]=__builtin_amdgcn_mfma_f32_32x32x16_bf16(PAF(2),VFR(2),o[0],0,0,0), C1,0); \
    KRD(GL,3); GAPB(o[1]=__builtin_amdgcn_mfma_f32_32x32x16_bf16(PAF(2),VFR(6),o[1],0,0,0), C1,4); \
    GAPB(o[0]=__builtin_amdgcn_mfma_f32_32x32x16_bf16(PAF(3),VFR(3),o[0],0,0,0), C1,8); \
    GAPB(o[1]=__builtin_amdgcn_mfma_f32_32x32x16_bf16(PAF(3),VFR(7),o[1],0,0,0), C1,12); \
    }while(0)
  int t=1;
  #undef CMASK
  #define CMASK(P0,P1,t) do{}while(0)
  for(;t+5<NT;t+=2){
    STEP(pB0,pB1,pA0,pA1,t,true,true,true);     WAIT_BAR(2); RESC(); ROT();
    STEP(pA0,pA1,pB0,pB1,t+1,true,true,true);   WAIT_BAR(2); RESC(); ROT();
  }
  #undef CMASK
  #define CMASK(P0,P1,t) do{}while(0)
  #define ENDW(tt) do{ if((tt)+3<NT){WAIT_BAR(2);} else if((tt)+2<NT){WAIT_BAR(1);} else {WAIT_BAR(0);} }while(0)
  for(;t+1<NT;t+=2){
    STEP(pB0,pB1,pA0,pA1,t,(t+3<NT),(t+1<NT),(t+1<NT));       ENDW(t);   RESC(); ROT();
    STEP(pA0,pA1,pB0,pB1,t+1,(t+4<NT),(t+2<NT),(t+2<NT));     ENDW(t+1); RESC(); ROT();
  }
  STEP(pB0,pB1,pA0,pA1,NT-1,false,false,false); RESC();
  { float sacc=pB0[0]+pB0[1]; _Pragma("unroll") for(int r=2;r<16;++r)sacc+=pB0[r]; _Pragma("unroll") for(int r=0;r<16;++r)sacc+=pB1[r]; l_reg+=sacc;
    pw0=(u32x4){PKW(pB0,0),PKW(pB0,2),PKW(pB0,4),PKW(pB0,6)};pw1=(u32x4){PKW(pB0,8),PKW(pB0,10),PKW(pB0,12),PKW(pB0,14)};pw2=(u32x4){PKW(pB1,0),PKW(pB1,2),PKW(pB1,4),PKW(pB1,6)};pw3=(u32x4){PKW(pB1,8),PKW(pB1,10),PKW(pB1,12),PKW(pB1,14)};
    SBAR(); pv(o,vb0+sl_cur,PAF(0),PAF(1),PAF(2),PAF(3)); }
  #undef PKW
  #undef PAF
  #undef VFR
  #undef PIN
  #undef MX3
  #undef GAPA
  #undef GAPB
  #undef EX
  #undef VRD
  #undef KRD
  #undef STEP
  #undef ENDW
  {auto rr=__builtin_amdgcn_permlane32_swap(__float_as_uint(l_reg),__float_as_uint(l_reg),false,false);l_reg=__uint_as_float(rr[0])+__uint_as_float(rr[1]);}
  if(hi==0)wsf[32+r32]=l_reg;asm volatile("s_waitcnt lgkmcnt(0)":::"memory");
  float rli[16];
  #pragma unroll
  for(int r=0;r<16;++r)rli[r]=__builtin_amdgcn_rcpf(wsf[32+crow(r,hi)]);
  bf16*Ow=O+(qrow0+wid*QBLK)*QP+h*D;
  { bf16*stg=(bf16*)(shm+LDS_OST)+wid*2048;
    #pragma unroll
    for(int r=0;r<16;++r){const int orow=crow(r,hi);
      #pragma unroll
      for(int d0=0;d0<2;++d0)stg[orow*64+d0*32+r32]=__float2bfloat16(o[d0][r]*rli[r]);}
    asm volatile("s_waitcnt lgkmcnt(0)":::"memory");
    #pragma unroll
    for(int i=0;i<4;++i){const int row=i*8+(lane>>3),ch=lane&7; const u32x4 v=*(const u32x4*)(stg+row*64+ch*8); ATTN_STORE16(Ow+(long)row*QP+ch*8,v);} }
  asm volatile("s_waitcnt lgkmcnt(0)\n\ts_barrier":::"memory");
  #undef DMA_K
  #undef DMA_V
  #undef CMASK
  #undef START
  #undef RESC
  #undef ROT
}
constexpr int ATTN_LDS_BYTES=LDS_BYTES;
struct AttnTensors { const bf16* Q; const bf16* K; const bf16* V; bf16* O; };
template<int THRL=8> __device__ __forceinline__ void attn_phase(char*lds,const AttnTensors&T,const QPre&QN,int G,int vcu,bool with_ctx,long ctx_row0){
  const int total=4*NHEAD*NQB;
  for(int i=0;;++i){
    int x,n;
    if(G==256){ if(i>=4)break; x=vcu>>5; n=i*32+(vcu&31); }
    else { const int u=i*G+vcu; if(u>=total)break; x=u>>7; n=u&127; }
    const int b=x>>1,kvh=x&1,h=kvh*4+(n>>5),qb=n&31;
    attn_unit<THRL>(b,h,(long)b*SEQQ+(long)qb*QB,SEQK/KVBLK,qb*QB,QN,T.Q,T.K,T.V,T.O,lds);
  }
  if(with_ctx){
    for(int u=vcu;u<4*NHEAD;u+=G){ const int b=u>>3,h=u&7; attn_unit<THRL>(b,h,ctx_row0+(long)b*256,4,-1,QN,T.Q,T.K,T.V,T.O,lds); }
  }
}
#undef SBAR
#undef WAIT_BAR
}

constexpr int NWAVES = 8, NTHR = 512;
constexpr int DMODEL = 1024, NB = 4, SEQ = 8192, CTXL = 256, NLAT = NB * SEQ, NCTX = NB * CTXL, MT = NLAT + NCTX;
constexpr int INW = 2048, NE = 32, KEYS = SEQ + CTXL;
constexpr int SORT_TILES = 560, SORT_ROWS = SORT_TILES * 256;
constexpr float EPSN = 1e-6f;
constexpr int NCHUNK = 66, CHUNK = 128;
constexpr int YS_PITCH = 1088;
constexpr int NPH_PRO = 2, NPH_LAYER = 13, NPH = NPH_PRO + 2 * NPH_LAYER;

constexpr size_t MiB = 1u << 20;
constexpr size_t WS_CTL = 0, CTL_ZERO_BYTES = 1 * MiB;
constexpr size_t WS_MOD = 1 * MiB, WS_ROPEC = 2 * MiB, WS_ROPES = 3 * MiB, WS_H2 = 4 * MiB, WS_KFC = 10 * MiB, WS_BLKCNT = 12 * MiB, WS_TILEE = 13 * MiB, WS_SCANS = 14 * MiB;
constexpr size_t WS_WINT = 16 * MiB, WS_WOUTT = 24 * MiB, WS_W1T = 32 * MiB, WS_W2T = 288 * MiB, WS_KF = 416 * MiB, WS_KHAT = 448 * MiB, WS_XR = 512 * MiB, WS_H = 644 * MiB;
constexpr size_t WS_U = 712 * MiB, WS_Q = 844 * MiB, WS_K = 877 * MiB, WS_V = 886 * MiB, WS_ATT = 895 * MiB, WS_LAB = 928 * MiB, WS_LRUO = 1060 * MiB, WS_VT = 1093 * MiB, WS_X0T = 1125 * MiB,
                 WS_HYO = 1157 * MiB, WS_MIXA = 1190 * MiB;
constexpr size_t WS_WGT = 11 * MiB, WS_SPT = 10 * MiB + 768 * 1024, WS_XL = 1256 * MiB;
constexpr size_t WS_GC = 10 * MiB + 896 * 1024;
constexpr size_t WS_CB = 10 * MiB + 960 * 1024;
constexpr size_t WS_F = 712 * MiB, WS_ASORT = 778 * MiB, WS_ACT = 1058 * MiB, WS_YS = 1338 * MiB, WS_TOPI = 1618 * MiB, WS_GATE = 1619 * MiB, WS_POS = 1620 * MiB, WS_RSSP = 1622 * MiB, WS_ROWTOK = 1625 * MiB, WS_END = 1626 * MiB;
constexpr size_t LAB_STRIDE = (size_t)MT * 256;
constexpr int CW_BAR = 4096;
constexpr int CW_NTILES = 64;

constexpr int RING_OFF = 0, RING_BYTES = 131072, MOETAB_OFF = 131072, LDSCTL_OFF = 155648, LDS_BYTES = 156160;

#define GAS __attribute__((address_space(1)))
#define LAS __attribute__((address_space(3)))
typedef unsigned short bf16;
typedef unsigned v4u __attribute__((ext_vector_type(4)));
typedef unsigned v2u __attribute__((ext_vector_type(2)));
typedef float f32x4 __attribute__((ext_vector_type(4)));
#define LDS_WAIT() asm volatile("s_waitcnt lgkmcnt(0)" ::: "memory")
#define VM_WAIT() asm volatile("s_waitcnt vmcnt(0)" ::: "memory")
__device__ __forceinline__ unsigned f2bf(float f) { unsigned u = __builtin_bit_cast(unsigned, f); return (u + 0x7fffu + ((u >> 16) & 1u)) >> 16; }
__device__ __forceinline__ unsigned pk2(float lo, float hi) { return f2bf(lo) | (f2bf(hi) << 16); }
__device__ __forceinline__ float bf2f(unsigned short b) { return __builtin_bit_cast(float, (unsigned)b << 16); }
__device__ __forceinline__ float bflo(unsigned w) { return __builtin_bit_cast(float, w << 16); }
__device__ __forceinline__ float bfhi(unsigned w) { return __builtin_bit_cast(float, w & 0xffff0000u); }
__device__ __forceinline__ float wave_sum(float v) {
#pragma unroll
    for (int o = 1; o < 64; o <<= 1) v += __shfl_xor(v, o);
    return v;
}
__device__ __forceinline__ float sigmoidf_(float x) { return 1.0f / (1.0f + __expf(-x)); }
__device__ __forceinline__ void sincos_d(double x, double& s, double& c) {
    const double kd = __builtin_rint(x * 0.63661977236758134308);
    const int k = (int)kd;
    double r = __builtin_fma(-kd, 1.57079632673412561417e+00, x);
    r = __builtin_fma(-kd, 6.07710050650619224932e-11, r);
    const double z = r * r;
    const double ps = r + r * z * (-1.66666666666666324348e-01 + z * (8.33333333332248946124e-03 + z * (-1.98412698298579493134e-04 + z * (2.75573137070700676789e-06 + z * (-2.50507602534068634195e-08 + z * 1.58969099521155010221e-10)))));
    const double pc = 1.0 - 0.5 * z + z * z * (4.16666666666666019037e-02 + z * (-1.38888888888741095749e-03 + z * (2.48015872894767294178e-05 + z * (-2.75573143513906633035e-07 + z * (2.08757232129817482790e-09 + z * -1.13596475577881948265e-11)))));
    const int q = k & 3;
    s = (q == 0) ? ps : (q == 1) ? pc : (q == 2) ? -ps : -pc;
    c = (q == 0) ? pc : (q == 1) ? -ps : (q == 2) ? -pc : ps;
}
__device__ __forceinline__ float gelu_tanh(float x) {
    const float u = 0.7978845608028654f * (x + 0.044715f * x * x * x);
    const float t = 1.0f - 2.0f / (1.0f + __expf(2.0f * u));
    return 0.5f * x * (1.0f + t);
}
__device__ __forceinline__ int lds_add(LAS int* p, int v) { return __hip_atomic_fetch_add(p, v, __ATOMIC_RELAXED, __HIP_MEMORY_SCOPE_WORKGROUP); }

#define FFT_FN __device__ __forceinline__
typedef float f32x2v __attribute__((ext_vector_type(2)));
#define FFT_VEC2 f32x2v
#define FFT_DPTR LAS f32x2v*
#define FFT_LD(D, i) c32_from((D)[i])
#define FFT_ST(D, i, v) ((D)[i] = c32_to(v))
struct __attribute__((aligned(8))) c32 { float x, y; };
FFT_FN c32 cmul(c32 a, c32 b) { c32 r; r.x = a.x * b.x - a.y * b.y; r.y = a.x * b.y + a.y * b.x; return r; }
FFT_FN c32 cadd(c32 a, c32 b) { c32 r; r.x = a.x + b.x; r.y = a.y + b.y; return r; }
FFT_FN c32 csub(c32 a, c32 b) { c32 r; r.x = a.x - b.x; r.y = a.y - b.y; return r; }
FFT_FN c32 cmuli_neg(c32 a) { c32 r; r.x = a.y; r.y = -a.x; return r; }
FFT_FN int fpad(int a) { return a + (a >> 4); }
#ifdef FFT_VEC2
FFT_FN c32 c32_from(FFT_VEC2 t) { c32 r; r.x = t.x; r.y = t.y; return r; }
FFT_FN FFT_VEC2 c32_to(c32 a) { FFT_VEC2 t; t.x = a.x; t.y = a.y; return t; }
#endif
FFT_FN void dft4(c32& a0, c32& a1, c32& a2, c32& a3) {
    const c32 s02 = cadd(a0, a2), d02 = csub(a0, a2), s13 = cadd(a1, a3), d13 = cmuli_neg(csub(a1, a3));
    a0 = cadd(s02, s13); a2 = csub(s02, s13); a1 = cadd(d02, d13); a3 = csub(d02, d13);
}
FFT_FN void dft16(c32 (&v)[16]) {
    const float C1 = 0.92387953251128674f, S1 = 0.38268343236508977f, C2 = 0.70710678118654752f;
#pragma unroll
    for (int q2 = 0; q2 < 4; ++q2) dft4(v[q2], v[4 + q2], v[8 + q2], v[12 + q2]);
    { c32 w;
      w.x = C1; w.y = -S1; v[4 * 1 + 1] = cmul(v[4 * 1 + 1], w);
      w.x = C2; w.y = -C2; v[4 * 2 + 1] = cmul(v[4 * 2 + 1], w);
      w.x = S1; w.y = -C1; v[4 * 3 + 1] = cmul(v[4 * 3 + 1], w);
      w.x = C2; w.y = -C2; v[4 * 1 + 2] = cmul(v[4 * 1 + 2], w);
      v[4 * 2 + 2] = cmuli_neg(v[4 * 2 + 2]);
      w.x = -C2; w.y = -C2; v[4 * 3 + 2] = cmul(v[4 * 3 + 2], w);
      w.x = S1; w.y = -C1; v[4 * 1 + 3] = cmul(v[4 * 1 + 3], w);
      w.x = -C2; w.y = -C2; v[4 * 2 + 3] = cmul(v[4 * 2 + 3], w);
      w.x = -C1; w.y = S1; v[4 * 3 + 3] = cmul(v[4 * 3 + 3], w); }
#pragma unroll
    for (int p1 = 0; p1 < 4; ++p1) dft4(v[4 * p1 + 0], v[4 * p1 + 1], v[4 * p1 + 2], v[4 * p1 + 3]);
#pragma unroll
    for (int a = 0; a < 4; ++a)
#pragma unroll
        for (int b = a + 1; b < 4; ++b) { const c32 t = v[4 * a + b]; v[4 * a + b] = v[4 * b + a]; v[4 * b + a] = t; }
}
FFT_FN c32 twid(int j, int n) { float rev = (float)j / (float)n; asm volatile("" : "+v"(rev)); c32 w; w.x = __builtin_amdgcn_cosf(rev); w.y = -__builtin_amdgcn_sinf(rev); return w; }

FFT_FN void fft_fwd16(FFT_DPTR D, int g, int n) {
    const int s = n >> 4, blk = g / s, j = g - blk * s, base = blk * n + j;
    c32 v[16];
#pragma unroll
    for (int q = 0; q < 16; ++q) v[q] = FFT_LD(D, fpad(base + q * s));
    dft16(v);
    const c32 w = twid(j, n); c32 wp = w;
#pragma unroll
    for (int p = 1; p < 16; ++p) { v[p] = cmul(v[p], wp); wp = cmul(wp, w); }
#pragma unroll
    for (int p = 0; p < 16; ++p) FFT_ST(D, fpad(base + p * s), v[p]);
}
FFT_FN void fft_inv16(FFT_DPTR D, int g, int n) {
    const int s = n >> 4, blk = g / s, j = g - blk * s, base = blk * n + j;
    c32 v[16];
#pragma unroll
    for (int q = 0; q < 16; ++q) v[q] = FFT_LD(D, fpad(base + q * s));
    const c32 w = twid(j, n); c32 wp = w;
#pragma unroll
    for (int p = 1; p < 16; ++p) { v[p] = cmul(v[p], wp); wp = cmul(wp, w); }
    dft16(v);
#pragma unroll
    for (int p = 0; p < 16; ++p) FFT_ST(D, fpad(base + p * s), v[p]);
}
FFT_FN void fft_mid16(FFT_DPTR D, int g, const c32* KH) {
    c32 v[16];
#pragma unroll
    for (int q = 0; q < 16; ++q) v[q] = FFT_LD(D, 17 * g + q);
    dft16(v);
#pragma unroll
    for (int p = 0; p < 16; ++p) { const c32 k = KH[16 * g + p]; const c32 t = cmul(v[p], k); v[p].x = t.x; v[p].y = -t.y; }
    dft16(v);
#pragma unroll
    for (int p = 0; p < 16; ++p) FFT_ST(D, 17 * g + p, v[p]);
}
FFT_FN void fft_last16_out(FFT_DPTR D, int g, c32* OUT, float scale) {
    c32 v[16];
#pragma unroll
    for (int q = 0; q < 16; ++q) v[q] = FFT_LD(D, 17 * g + q);
    dft16(v);
#pragma unroll
    for (int p = 0; p < 16; ++p) { c32 t; t.x = v[p].x * scale; t.y = v[p].y * scale; OUT[16 * g + p] = t; }
}
FFT_FN void fft_first4(FFT_DPTR D, int j, c32 x0, c32 x1, c32 x2, c32 x3) {
    dft4(x0, x1, x2, x3);
    const c32 w = twid(j, 16384), w2 = cmul(w, w), w3 = cmul(w2, w);
    FFT_ST(D, fpad(j), x0); FFT_ST(D, fpad(j + 4096), cmul(x1, w)); FFT_ST(D, fpad(j + 8192), cmul(x2, w2)); FFT_ST(D, fpad(j + 12288), cmul(x3, w3));
}
FFT_FN void fft_final4(FFT_DPTR D, int j, c32& u0, c32& u1) {
    const c32 w = twid(j, 16384), w2 = cmul(w, w), w3 = cmul(w2, w);
    c32 a0 = FFT_LD(D, fpad(j)), a1 = cmul(FFT_LD(D, fpad(j + 4096)), w), a2 = cmul(FFT_LD(D, fpad(j + 8192)), w2), a3 = cmul(FFT_LD(D, fpad(j + 12288)), w3);
    dft4(a0, a1, a2, a3);
    u0 = a0; u1 = a1;
}
FFT_FN void fft_first4_inplace(FFT_DPTR D, int j) {
    c32 x0 = FFT_LD(D, fpad(j)), x1 = FFT_LD(D, fpad(j + 4096)), x2 = FFT_LD(D, fpad(j + 8192)), x3 = FFT_LD(D, fpad(j + 12288));
    fft_first4(D, j, x0, x1, x2, x3);
}
#define XB_TMO      128
#define XB_XCNT(j)  (256  + 64 * (j))
#define XB_XSUB(j)  (1280 + 64 * (j))
#define XB_XGEN(j)  (2304 + 64 * (j))
#define XB_TOP      3328
#define XB_TOPGEN   3392
#define XCD_BAR_WORDS 3456
#define XB_SPIN_CAP (1u << 22)

__device__ __forceinline__ unsigned xb_ld(unsigned* p)              { return __hip_atomic_load(p, __ATOMIC_RELAXED, __HIP_MEMORY_SCOPE_AGENT); }
__device__ __forceinline__ unsigned xb_add(unsigned* p, unsigned v) { return __hip_atomic_fetch_add(p, v, __ATOMIC_RELAXED, __HIP_MEMORY_SCOPE_AGENT); }
__device__ __forceinline__ unsigned xb_xcc_id() { return (unsigned)__builtin_amdgcn_s_getreg((3 << 11) | 20) & 0xFu; }
#define XB_SPIN(cond, bar) do { unsigned _sp = 0; while (cond) { __builtin_amdgcn_s_sleep(1); \
    if ((++_sp & 255u) == 0u) { if (xb_ld(&(bar)[XB_TMO])) break; if (_sp > XB_SPIN_CAP) { atomicAdd(&(bar)[XB_TMO], 1u); break; } } } } while (0)

struct XcdBarrier {
    unsigned* bar; unsigned x;
    volatile LAS unsigned* st;
};

__device__ __forceinline__ XcdBarrier xcd_barrier_post(unsigned* bar, volatile LAS unsigned* st) {
    XcdBarrier b; b.bar = bar; b.x = xb_xcc_id(); b.st = st;
    if (threadIdx.x == 0) (void)xb_add(&bar[XB_XCNT(b.x)], 1u);
    return b;
}
__device__ __forceinline__ void xcd_barrier_complete(unsigned* bar, unsigned x, unsigned& nloc, unsigned& nx) {
    const unsigned G = gridDim.x * gridDim.y * gridDim.z;
    unsigned sum, cnt, mine, sp = 0u;
    for (;;) {
        sum = 0u; cnt = 0u; mine = 0u;
#pragma unroll
        for (unsigned j = 0; j < 16; ++j) { const unsigned c = xb_ld(&bar[XB_XCNT(j)]); sum += c; cnt += (c > 0u) ? 1u : 0u; mine = (j == x) ? c : mine; }
        if (sum == G) break;
        __builtin_amdgcn_s_sleep(1);
        if ((++sp & 255u) == 0u) { if (xb_ld(&bar[XB_TMO])) break; if (sp > XB_SPIN_CAP) { atomicAdd(&bar[XB_TMO], 1u); break; } }
    }
    nloc = mine > 0u ? mine : 1u; nx = cnt > 0u ? cnt : 1u;
}

__device__ __forceinline__ void xcd_barrier(const XcdBarrier& b) {
    asm volatile("s_waitcnt vmcnt(0)" ::: "memory");
    __syncthreads();
    if (threadIdx.x == 0) {
        unsigned* bar = b.bar;
        __builtin_amdgcn_s_waitcnt(0);
        unsigned nloc = b.st[0], nx = b.st[1];
        if (nloc == 0u) { xcd_barrier_complete(bar, b.x, nloc, nx); b.st[0] = nloc; b.st[1] = nx; }
        const unsigned old = xb_add(&bar[XB_XSUB(b.x)], 1u);
        const unsigned gen = old / nloc;
        if (old + 1u == (gen + 1u) * nloc) {
            __builtin_amdgcn_fence(__ATOMIC_RELEASE, "agent");
            asm volatile("s_waitcnt vmcnt(0)" ::: "memory");
            const unsigned og = xb_add(&bar[XB_TOP], 1u);
            const unsigned tg = og / nx;
            if (og + 1u == (tg + 1u) * nx) xb_add(&bar[XB_TOPGEN], 1u);
            else XB_SPIN(xb_ld(&bar[XB_TOPGEN]) == tg, bar);
            __builtin_amdgcn_fence(__ATOMIC_ACQUIRE, "agent");
            xb_add(&bar[XB_XGEN(b.x)], 1u);
            asm volatile("s_waitcnt vmcnt(0)" ::: "memory");
        } else {
            XB_SPIN(xb_ld(&bar[XB_XGEN(b.x)]) == gen, bar);
            __builtin_amdgcn_fence(__ATOMIC_ACQUIRE, "agent");
            asm volatile("s_waitcnt vmcnt(0)" ::: "memory");
        }
    }
    __syncthreads();
}


constexpr int CW_SPLIT = 8192, CTXWG = 32;
__device__ __forceinline__ void split_arrive_all(const XcdBarrier& b, unsigned* w) {
    asm volatile("s_waitcnt vmcnt(0)" ::: "memory");
    __syncthreads();
    if (threadIdx.x == 0) { const unsigned nloc = b.st[0]; const unsigned old = xb_add(&w[64 * b.x], 1u);
        if (old + 1u == nloc) { __builtin_amdgcn_fence(__ATOMIC_RELEASE, "agent"); asm volatile("s_waitcnt vmcnt(0)" ::: "memory"); (void)xb_add(&w[1024], 1u); } }
}
__device__ __forceinline__ void split_wait_all(const XcdBarrier& b, unsigned* w) {
    if (threadIdx.x == 0) { const unsigned nx = b.st[1]; XB_SPIN(xb_ld(&w[1024]) < nx, b.bar); __builtin_amdgcn_fence(__ATOMIC_ACQUIRE, "agent"); asm volatile("s_waitcnt vmcnt(0)" ::: "memory"); }
    __syncthreads();
}
__device__ __forceinline__ void split_arrive_flat(unsigned* w) {
    asm volatile("s_waitcnt vmcnt(0)" ::: "memory");
    __syncthreads();
    if (threadIdx.x == 0) { __builtin_amdgcn_fence(__ATOMIC_RELEASE, "agent"); asm volatile("s_waitcnt vmcnt(0)" ::: "memory"); (void)xb_add(&w[1088], 1u); }
}
__device__ __forceinline__ void split_wait_flat(const XcdBarrier& b, unsigned* w, unsigned target) {
    if (threadIdx.x == 0) { XB_SPIN(xb_ld(&w[1088]) < target, b.bar); __builtin_amdgcn_fence(__ATOMIC_ACQUIRE, "agent"); asm volatile("s_waitcnt vmcnt(0)" ::: "memory"); }
    __syncthreads();
}

struct Frame {
    LAS unsigned char* lds; unsigned* ctl; unsigned char* ws;
    int tid, lane, wave, vcu, G, gw, ngw;
};
__device__ const float ROPE_INV[16] = {1.0f, 0.5623413251903491f, 0.31622776601683794f, 0.1778279410038923f, 0.1f, 0.05623413251903491f, 0.03162277660168379f, 0.01778279410038923f,
                                       0.01f, 0.005623413251903491f, 0.0031622776601683794f, 0.001778279410038923f, 0.001f, 0.0005623413251903491f, 0.00031622776601683794f, 0.0001778279410038923f};

__device__ __forceinline__ void p0_transpose_item(const float* W, int K, int N, bf16* WT, LAS float* scr, int item, int lane) {
    const int nblk = N / 32, kb = item / nblk, nb = item % nblk, k0 = 64 * kb, n0 = 32 * nb;
#pragma unroll 8
    for (int i = 0; i < 32; ++i) { const int kk = 2 * i + (lane >> 5); scr[kk * 33 + (lane & 31)] = W[(size_t)(k0 + kk) * N + n0 + (lane & 31)]; }
    LDS_WAIT(); asm volatile("" ::: "memory");
    const int c = lane & 7;
#pragma unroll
    for (int j = 0; j < 4; ++j) { const int n = (lane >> 3) + 8 * j; const LAS float* s = scr + (8 * c) * 33 + n;
        v4u o; o.x = pk2(s[0 * 33], s[1 * 33]); o.y = pk2(s[2 * 33], s[3 * 33]); o.z = pk2(s[4 * 33], s[5 * 33]); o.w = pk2(s[6 * 33], s[7 * 33]);
        *(GAS v4u*)(WT + (size_t)(n0 + n) * K + k0 + 8 * c) = o; }
    LDS_WAIT(); asm volatile("" ::: "memory");
}

__device__ __forceinline__ void p0_transpose_item_f8(const float* W, int K, int N, unsigned char* WT, LAS float* scr, int item, int lane) {
    const int nblk = N / 32, kb = item / nblk, nb = item % nblk, k0 = 64 * kb, n0 = 32 * nb;
#pragma unroll 8
    for (int i = 0; i < 32; ++i) { const int kk = 2 * i + (lane >> 5); scr[kk * 33 + (lane & 31)] = W[(size_t)(k0 + kk) * N + n0 + (lane & 31)]; }
    LDS_WAIT(); asm volatile("" ::: "memory");
    const int c = lane & 7;
#pragma unroll
    for (int j = 0; j < 4; ++j) { const int n = (lane >> 3) + 8 * j; const LAS float* s = scr + (8 * c) * 33 + n;
        v2u o; o.x = pg8::pack4_fp8(s[0 * 33] * pg8::F8_SW, s[1 * 33] * pg8::F8_SW, s[2 * 33] * pg8::F8_SW, s[3 * 33] * pg8::F8_SW);
        o.y = pg8::pack4_fp8(s[4 * 33] * pg8::F8_SW, s[5 * 33] * pg8::F8_SW, s[6 * 33] * pg8::F8_SW, s[7 * 33] * pg8::F8_SW);
        *(GAS v2u*)(WT + (size_t)(n0 + n) * K + k0 + 8 * c) = o; }
    LDS_WAIT(); asm volatile("" ::: "memory");
}

__device__ __forceinline__ void ph_prologue_a(const Frame& F, const float* c, const float* cctx, const float* w_mod, const float* b_mod, const float* w_in, const float* w_out,
                                              const float* moe_w1, const float* moe_w2, const float* hy_w1, const float* hy_b1, const float* hy_w2, const float* hy_b2, const float* hy_freq, const float* lru_gw, const float* lru_lam) {
    {
        LAS float* scr = (LAS float*)(F.lds + F.wave * 16384);
        constexpr int I_IN = 2 * 1024, I_OUT = 2 * 512, I_W1 = 64 * 1024, I_W2 = 64 * 512, NIT = I_IN + I_OUT + I_W1 + I_W2;
        bf16* WinT = (bf16*)(F.ws + WS_WINT); bf16* WoutT = (bf16*)(F.ws + WS_WOUTT); bf16* W1T = (bf16*)(F.ws + WS_W1T); bf16* W2T = (bf16*)(F.ws + WS_W2T);
        for (int it = F.gw; it < NIT; it += F.ngw) {
            int r = it;
            if (r < I_IN) { const int m = r >> 10; p0_transpose_item(w_in + (size_t)m * 1024 * 2048, 1024, 2048, WinT + (size_t)m * 2048 * 1024, scr, r & 1023, F.lane); continue; } r -= I_IN;
            if (r < I_OUT) { const int m = r >> 9; p0_transpose_item(w_out + (size_t)m * 1024 * 1024, 1024, 1024, WoutT + (size_t)m * 1024 * 1024, scr, r & 511, F.lane); continue; } r -= I_OUT;
#if MOE_FP8
            if (r < I_W1) { const int m = r >> 10; p0_transpose_item_f8(moe_w1 + (size_t)m * 1024 * 2048, 1024, 2048, (unsigned char*)W1T + (size_t)m * 2048 * 1024, scr, r & 1023, F.lane); continue; } r -= I_W1;
            { const int m = r >> 9; p0_transpose_item_f8(moe_w2 + (size_t)m * 1024 * 1024, 1024, 1024, (unsigned char*)W2T + (size_t)m * 1024 * 1024, scr, r & 511, F.lane); }
#else
            if (r < I_W1) { const int m = r >> 10; p0_transpose_item(moe_w1 + (size_t)m * 1024 * 2048, 1024, 2048, W1T + (size_t)m * 2048 * 1024, scr, r & 1023, F.lane); continue; } r -= I_W1;
            { const int m = r >> 9; p0_transpose_item(moe_w2 + (size_t)m * 1024 * 1024, 1024, 1024, W2T + (size_t)m * 1024 * 1024, scr, r & 511, F.lane); }
#endif
        }
    }
    __syncthreads();
    {
        LAS float* sl = (LAS float*)(F.lds);
        LAS float* red = (LAS float*)(F.lds + 20480);
        float* MOD = (float*)(F.ws + WS_MOD);
        if ((int)blockIdx.x < 192) {
            for (int i = F.tid; i < 5 * 1024; i += NTHR) { const int r = i >> 10, k = i & 1023; const float v = (r < 4) ? c[r * 1024 + k] : cctx[k]; sl[i] = v / (1.0f + __expf(-v)); }
        }
        __syncthreads();
        for (int it = blockIdx.x; it < 192; it += F.G) {
            const int l = it / 96, n = (it % 96) * 64 + F.lane;
            float a0 = 0.f, a1 = 0.f, a2 = 0.f, a3 = 0.f, a4 = 0.f;
            const float* wp = w_mod + ((size_t)l * 1024 + F.wave * 128) * 6144 + n;
#pragma unroll 8
            for (int k = 0; k < 128; ++k) { const float w = wp[(size_t)k * 6144]; const int kk = F.wave * 128 + k;
                a0 += sl[kk] * w; a1 += sl[1024 + kk] * w; a2 += sl[2048 + kk] * w; a3 += sl[3072 + kk] * w; a4 += sl[4096 + kk] * w; }
            red[(F.wave * 5 + 0) * 64 + F.lane] = a0; red[(F.wave * 5 + 1) * 64 + F.lane] = a1; red[(F.wave * 5 + 2) * 64 + F.lane] = a2; red[(F.wave * 5 + 3) * 64 + F.lane] = a3; red[(F.wave * 5 + 4) * 64 + F.lane] = a4;
            __syncthreads();
            if (F.tid < 320) { const int r = F.tid >> 6, ln = F.tid & 63; float s = 0.f;
#pragma unroll
                for (int w = 0; w < 8; ++w) s += red[(w * 5 + r) * 64 + ln];
                const int nn = (it % 96) * 64 + ln; MOD[(size_t)(l * 5 + r) * 6144 + nn] = s + b_mod[l * 6144 + nn]; }
            __syncthreads();
        }
    }
    {
        bf16* WGT = (bf16*)(F.ws + WS_WGT); float* SPT = (float*)(F.ws + WS_SPT);
        for (int idx = blockIdx.x * NTHR + F.tid; idx < 2 * 1024 * 256; idx += F.G * NTHR) {
            const int l = idx >> 18, nidx = (idx >> 8) & 1023, k = idx & 255;
            const int pn = nidx >> 8, j = (nidx >> 7) & 1, cc = nidx & 127, d = pn >> 1, ch = 128 * (pn & 1) + cc, n = ch >> 6, e = ch & 63;
            const float v = ((k >> 6) == n) ? lru_gw[((size_t)((((l * 2 + d) * 2 + j) * 4 + n) * 64 + (k & 63))) * 64 + e] : 0.f;
            WGT[idx] = (bf16)f2bf(v); }
        for (int idx = blockIdx.x * NTHR + F.tid; idx < 2 * 2 * 256; idx += F.G * NTHR) SPT[idx] = log1pf(expf(-lru_lam[idx]));
    }
    {
        float* RC = (float*)(F.ws + WS_ROPEC); float* RS = (float*)(F.ws + WS_ROPES);
        for (int idx = blockIdx.x * NTHR + F.tid; idx < SEQ * 32; idx += F.G * NTHR) {
            const int t = idx >> 5, i = idx & 31; const int pos = (i < 16) ? (t >> 6) : (t & 63);
            const float ang = (float)pos * ROPE_INV[i & 15];
            double s, cc; sincos_d((double)ang, s, cc); RC[idx] = (float)cc; RS[idx] = (float)s; }
    }
    {
        float* H2 = (float*)(F.ws + WS_H2);
        for (int it = F.gw; it < 2 * SEQ + CTXL; it += F.ngw) {
            const int v = it >> 13, t = (v < 2) ? (it & (SEQ - 1)) : (it - 2 * SEQ), L = (v < 2) ? SEQ : CTXL, l = (v == 1) ? 1 : 0;
            const int j = F.lane;
            float z = 0.f;
            if (j == 0) z = (float)t / (float)(L - 1);
            else if (j <= 32) { const int b = (j - 1) & 15; const float band = 1e-4f + (float)b * ((15.0f - 1e-4f) / 15.0f);
                const float ang = ((6.283185307179586f / (float)L) * (float)t) * band;
                double s, cc; sincos_d((double)ang, s, cc); z = (j <= 16) ? (float)cc : -(float)s; }
            const float fr = hy_freq[l * 64 + j];
            float p1 = hy_b1[l * 64 + j];
            const float* w1 = hy_w1 + (size_t)l * 33 * 64;
#pragma unroll
            for (int i = 0; i < 33; ++i) p1 += __shfl(z, i) * w1[i * 64 + j];
            double s1, c1; sincos_d((double)(fr * p1), s1, c1); const float h1 = (float)s1;
            float p2 = hy_b2[l * 64 + j];
            const float* w2 = hy_w2 + (size_t)l * 64 * 64;
#pragma unroll 16
            for (int i = 0; i < 64; ++i) p2 += __shfl(h1, i) * w2[i * 64 + j];
            double s2, c2; sincos_d((double)(fr * p2), s2, c2);
            H2[((size_t)v * SEQ + t) * 64 + j] = (float)s2;
        }
    }
}

__device__ __forceinline__ void ph_prologue_b(const Frame& F, const float* hy_w3, const float* hy_decay, const float* gffn, const float* router_w, const float* router_b) {
    { const float* MOD = (const float*)(F.ws + WS_MOD); float* CB = (float*)(F.ws + WS_CB);
      for (int it = F.gw; it < 2 * 5 * 32; it += F.ngw) { const int lb = it >> 5, e = it & 31, l = lb / 5; const float* sf = MOD + (size_t)lb * 6144 + 3 * 1024; float s = 0.f;
#pragma unroll
          for (int q = 0; q < 16; ++q) { const int cc = 64 * q + F.lane; s += sf[cc] * router_w[(size_t)l * 32768 + cc * 32 + e]; }
          s = wave_sum(s); if (F.lane == 0) CB[it] = s + router_b[l * 32 + e]; } }
    { const float* MOD = (const float*)(F.ws + WS_MOD); float* GC = (float*)(F.ws + WS_GC);
      for (int idx = blockIdx.x * NTHR + F.tid; idx < 2 * 5 * 1024; idx += F.G * NTHR) { const int lb = idx >> 10, cc = idx & 1023, l = lb / 5; GC[idx] = gffn[l * 1024 + cc] * (1.0f + MOD[(size_t)lb * 6144 + 4 * 1024 + cc]); } }
    LAS f32x2v* D = (LAS f32x2v*)(F.lds);
    LAS float* kt = (LAS float*)(F.lds);
    LAS float* w3c = (LAS float*)(F.lds + 139264);
    LAS float* red = (LAS float*)(F.lds + 139264 + 512);
    const float* H2 = (const float*)(F.ws + WS_H2);
    c32* KHAT = (c32*)(F.ws + WS_KHAT); float* KFC = (float*)(F.ws + WS_KFC);
    for (int it = blockIdx.x; it < 768; it += F.G) {
        const int v = it >> 8, c = it & 255, L = (v < 2) ? SEQ : CTXL, l = (v == 1) ? 1 : 0;
        if (F.tid < 128) w3c[F.tid] = hy_w3[(size_t)l * 64 * 512 + (F.tid & 63) * 512 + (F.tid >> 6) * 256 + c];
        if (F.tid == 0) { if (v < 2) { f32x2v z; z.x = 0.f; z.y = 0.f; D[fpad(L)] = z; } else kt[L] = 0.f; }
        __syncthreads();
        const float df = fabsf(hy_decay[l * 512 + c]), db = fabsf(hy_decay[l * 512 + 256 + c]);
        float asum = 0.f;
        for (int t = F.tid; t < L; t += NTHR) {
            const f32x4* row = (const f32x4*)(H2 + ((size_t)v * SEQ + t) * 64);
            float hf = 0.f, hb = 0.f;
#pragma unroll
            for (int q = 0; q < 16; ++q) { const f32x4 h = row[q];
                hf += h.x * w3c[4 * q] + h.y * w3c[4 * q + 1] + h.z * w3c[4 * q + 2] + h.w * w3c[4 * q + 3];
                hb += h.x * w3c[64 + 4 * q] + h.y * w3c[64 + 4 * q + 1] + h.z * w3c[64 + 4 * q + 2] + h.w * w3c[64 + 4 * q + 3]; }
            const float t01 = (float)t / (float)(L - 1);
            hf *= expf(-t01 * df); hb *= expf(-t01 * db);
            asum += fabsf(hf); if (t >= 1) asum += fabsf(hb);
            if (v < 2) { f32x2v z; z.x = hf; z.y = 0.f; D[fpad(t)] = z; if (t >= 1) { z.x = hb; D[fpad(2 * L - t)] = z; } }
            else { kt[t] = hf; if (t >= 1) kt[2 * L - t] = hb; }
        }
        asum = wave_sum(asum);
        if (F.lane == 0) red[F.wave] = asum;
        __syncthreads();
        float tot = 0.f;
#pragma unroll
        for (int w = 0; w < 8; ++w) tot += red[w];
        const float inv = 1.0f / tot;
        if (v < 2) {
            c32* out = KHAT + (size_t)(v * 256 + c) * 16384;
#pragma unroll 1
            for (int i = 0; i < 8; ++i) fft_first4_inplace(D, F.tid + 512 * i);
            __syncthreads();
            { fft_fwd16(D, F.tid, 4096); fft_fwd16(D, F.tid + 512, 4096); }
            __syncthreads();
            { fft_fwd16(D, F.tid, 256); fft_fwd16(D, F.tid + 512, 256); }
            __syncthreads();
            _Pragma("unroll 1") for (int g_ = F.tid; g_ < 1024; g_ += 512) fft_last16_out(D, g_, out, inv * (1.0f / 16384.0f));
        } else {
            float* dst = KFC + (size_t)c * 512;
            for (int j = F.tid; j < 2 * L; j += NTHR) dst[j] = kt[j] * inv;
        }
        __syncthreads();
    }
}

__device__ __forceinline__ void ph_norm_mod(const Frame& F, int l, const float* x, const float* ctx, const float* gmix) {
    const float* XR = (const float*)(F.ws + WS_XR); const float* MOD = (const float*)(F.ws + WS_MOD); bf16* H = (bf16*)(F.ws + WS_H);
    for (int r = F.gw; r < MT; r += F.ngw) {
        const float* src = (l == 0) ? (r < NLAT ? x + (size_t)r * 1024 : ctx + (size_t)(r - NLAT) * 1024) : XR + (size_t)r * 1024;
        const int bidx = r < NLAT ? r / SEQ : 4;
        const float* shift = MOD + (size_t)(l * 5 + bidx) * 6144; const float* scale = shift + 1024; const float* g = gmix + l * 1024;
        f32x4 v[4]; float ss = 0.f;
#pragma unroll
        for (int j = 0; j < 4; ++j) { v[j] = ((const f32x4*)src)[64 * j + F.lane]; ss += (v[j].x * v[j].x + v[j].y * v[j].y) + (v[j].z * v[j].z + v[j].w * v[j].w); }
        const float rstd = 1.0f / sqrtf(wave_sum(ss) * (1.0f / 1024.0f) + EPSN);
#pragma unroll
        for (int j = 0; j < 4; ++j) { const int cb = 64 * j + F.lane; const f32x4 gg = ((const f32x4*)g)[cb], sc = ((const f32x4*)scale)[cb], sh = ((const f32x4*)shift)[cb];
            const f32x4 y = v[j] * rstd * gg * (sc + 1.0f) + sh;
            v2u o; o.x = pk2(y.x, y.y); o.y = pk2(y.z, y.w); ((v2u*)(H + (size_t)r * 1024))[cb] = o; }
    }
}

__device__ __forceinline__ void post_ab(const Frame& F, int l, int rbeg, int rend, int w0, int nw, const float* kg_, const float* lru_cw, const float* lru_cb) {
    const bf16* U = (const bf16*)(F.ws + WS_U);
    {
        bf16* K = (bf16*)(F.ws + WS_K); bf16* V = (bf16*)(F.ws + WS_V);
        const float* RC = (const float*)(F.ws + WS_ROPEC); const float* RS = (const float*)(F.ws + WS_ROPES);
        const int o8 = 8 * (F.lane & 7), hl = F.lane & 31;
        const f32x4 kg0 = *(const f32x4*)(kg_ + l * 64 + o8), kg1 = *(const f32x4*)(kg_ + l * 64 + o8 + 4);
        const bool lohalf = (F.lane & 4) == 0;
        for (int r2 = rbeg + 2 * w0; r2 < rend; r2 += 2 * nw) {
            const int r = r2 + (F.lane >> 5);
            const bool isctx = r >= NLAT; const int b = isctx ? (r - NLAT) / CTXL : r / SEQ; const int t = isctx ? (r - NLAT) % CTXL : r % SEQ;
            const v4u wk = ((const v4u*)(U + (size_t)r * INW + 512))[hl];
            f32x4 c0 = {1.f, 1.f, 1.f, 1.f}, c1 = c0, s0 = {0.f, 0.f, 0.f, 0.f}, s1 = s0;
            if (!isctx) { const float* rc = RC + t * 32 + 8 * (F.lane & 3); const float* rs = RS + t * 32 + 8 * (F.lane & 3);
                c0 = *(const f32x4*)rc; c1 = *(const f32x4*)(rc + 4); s0 = *(const f32x4*)rs; s1 = *(const f32x4*)(rs + 4); }
            const size_t krow = (size_t)b * KEYS + (isctx ? t : CTXL + t);
            float x[8] = {bflo(wk.x), bfhi(wk.x), bflo(wk.y), bfhi(wk.y), bflo(wk.z), bfhi(wk.z), bflo(wk.w), bfhi(wk.w)};
            float ss = 0.f;
#pragma unroll
            for (int i = 0; i < 8; ++i) ss += x[i] * x[i];
            ss += __shfl_xor(ss, 1); ss += __shfl_xor(ss, 2); ss += __shfl_xor(ss, 4);
            const float rstd = 1.0f / sqrtf(ss * (1.0f / 64.0f) + EPSN);
            float y[8], o[8];
#pragma unroll
            for (int i = 0; i < 8; ++i) y[i] = x[i] * rstd * (i < 4 ? kg0[i] : kg1[i - 4]);
#pragma unroll
            for (int i = 0; i < 8; ++i) { const float p = __shfl_xor(y[i], 4); const float cs = i < 4 ? c0[i] : c1[i - 4], sn = i < 4 ? s0[i] : s1[i - 4];
                o[i] = lohalf ? (y[i] * cs - p * sn) : (y[i] * cs + p * sn); }
            v4u ow; ow.x = pk2(o[0], o[1]); ow.y = pk2(o[2], o[3]); ow.z = pk2(o[4], o[5]); ow.w = pk2(o[6], o[7]);
            if (hl < 16) ((v4u*)(K + krow * 128))[hl] = ow; else ((v4u*)(V + krow * 128))[hl - 16] = wk;
        }
    }
    {
        bf16* XL = (bf16*)(F.ws + WS_XL);
        for (int idx = rbeg * 32 + w0 * 64 + F.lane; idx < rend * 32; idx += nw * 64) {
            const int r = idx >> 5, c8 = (idx & 31) * 8;
            const bool isctx = r >= NLAT; const int Ls = isctx ? CTXL : SEQ; const int t = isctx ? (r - NLAT) % CTXL : r % SEQ;
            float acc[8];
#pragma unroll
            for (int i = 0; i < 8; ++i) acc[i] = lru_cb[l * 256 + c8 + i];
#pragma unroll
            for (int j = 0; j < 4; ++j) { const int tj = t + j - 2;
                if (tj >= 0 && tj < Ls) { const v4u w = *(const v4u*)(U + (size_t)(r + j - 2) * INW + 768 + c8);
                    const f32x4 w0 = *(const f32x4*)(lru_cw + (l * 4 + j) * 256 + c8), w1 = *(const f32x4*)(lru_cw + (l * 4 + j) * 256 + c8 + 4);
                    acc[0] += w0.x * bflo(w.x); acc[1] += w0.y * bfhi(w.x); acc[2] += w0.z * bflo(w.y); acc[3] += w0.w * bfhi(w.y);
                    acc[4] += w1.x * bflo(w.z); acc[5] += w1.y * bfhi(w.z); acc[6] += w1.z * bflo(w.w); acc[7] += w1.w * bfhi(w.w); } }
            v4u o; o.x = pk2(acc[0], acc[1]); o.y = pk2(acc[2], acc[3]); o.z = pk2(acc[4], acc[5]); o.w = pk2(acc[6], acc[7]);
            *(v4u*)(XL + (size_t)r * 256 + c8) = o;
        }
    }
}
__device__ __forceinline__ void post_c(const Frame& F, int l, const float* hy_cw, const float* hy_cb) {
    const bf16* U = (const bf16*)(F.ws + WS_U);
    __syncthreads();
    {
        LAS bf16* hs = (LAS bf16*)(F.lds);
        bf16* VT = (bf16*)(F.ws + WS_VT); bf16* X0T = (bf16*)(F.ws + WS_X0T);
        const float* cw = hy_cw + (size_t)l * 3 * 768; const float* cbp = hy_cb + l * 768;
        for (int it = blockIdx.x; it < NLAT / 64; it += F.G) {
            const int b = it >> 7, t0 = (it & 127) * 64;
            for (int i = F.tid; i < 66 * 384; i += NTHR) { const int rr = i / 384, c2 = i - rr * 384; const int t = t0 - 1 + rr;
                unsigned w = 0u; if (t >= 0 && t < SEQ) w = *(const unsigned*)(U + (size_t)(b * SEQ + t) * INW + 1280 + 2 * c2);
                *(LAS unsigned*)(hs + rr * 770 + 2 * c2) = w; }
            __syncthreads();
            for (int c = F.wave; c < 256; c += NWAVES) {
                const int tt = F.lane;
                float o[3];
#pragma unroll
                for (int g = 0; g < 3; ++g) { const int cc = g * 256 + c;
                    o[g] = cw[cc] * bf2f(hs[tt * 770 + cc]) + cw[768 + cc] * bf2f(hs[(tt + 1) * 770 + cc]) + cw[1536 + cc] * bf2f(hs[(tt + 2) * 770 + cc]) + cbp[cc]; }
                const size_t oi = ((size_t)b * 256 + c) * SEQ + t0 + tt;
                VT[oi] = (bf16)f2bf(o[2] * o[1]); X0T[oi] = (bf16)f2bf(o[0]);
            }
            __syncthreads();
        }
    }
}


__device__ __forceinline__ int chunk_row0(int b, int d, int k) {
    if (k < 2) { const int cc = d ? 1 - k : k; return NLAT + b * CTXL + cc * CHUNK; }
    const int lc = d ? 63 - (k - 2) : (k - 2); return b * SEQ + lc * CHUNK;
}
__device__ __forceinline__ void ph_scan1(const Frame& F) {
    const bf16* LAB = (const bf16*)(F.ws + WS_LAB); float* SUMP = (float*)(F.ws + WS_SCANS); float* SUMH = SUMP + NB * 2 * NCHUNK * 256;
    for (int it = blockIdx.x * NTHR + F.tid; it < NB * 2 * NCHUNK * 256; it += F.G * NTHR) {
        const int ch = it & 255, k = (it >> 8) % NCHUNK, bd = (it >> 8) / NCHUNK, d = bd & 1, b = bd >> 1;
        const int r0 = chunk_row0(b, d, k);
        const bf16* LA = LAB + (size_t)(2 * d) * LAB_STRIDE + ch; const bf16* LB = LAB + (size_t)(2 * d + 1) * LAB_STRIDE + ch;
        float h = 0.f, Ps = 0.f;
#pragma unroll 16
        for (int i = 0; i < CHUNK; ++i) { const int r = d ? r0 + CHUNK - 1 - i : r0 + i; const float la = bf2f(LA[(size_t)r * 256]), bx = bf2f(LB[(size_t)r * 256]); h = __builtin_amdgcn_exp2f(la) * h + bx; Ps += la; }
        SUMP[it] = __builtin_amdgcn_exp2f(Ps); SUMH[it] = h;
    }
}
__device__ __forceinline__ void ph_scan2(const Frame& F) {
    const bf16* LAB = (const bf16*)(F.ws + WS_LAB); const float* SUMP = (const float*)(F.ws + WS_SCANS); const float* SUMH = SUMP + NB * 2 * NCHUNK * 256;
    float* LRUO = (float*)(F.ws + WS_LRUO); const bf16* U = (const bf16*)(F.ws + WS_U);
    for (int it = blockIdx.x * NTHR + F.tid; it < NB * NCHUNK * 256; it += F.G * NTHR) {
        const int ch = it & 255, kc = (it >> 8) % NCHUNK, b = (it >> 8) / NCHUNK;
        const int r0 = chunk_row0(b, 0, kc);
#pragma unroll 1
        for (int d = 0; d < 2; ++d) {
            const int k = d ? ((kc < 2) ? 1 - kc : 2 + 63 - (kc - 2)) : kc;
            const size_t sb = (size_t)((b * 2 + d) * NCHUNK) * 256 + ch;
            float h = 0.f;
#pragma unroll 8
            for (int j = 0; j < k; ++j) h = SUMP[sb + (size_t)j * 256] * h + SUMH[sb + (size_t)j * 256];
            const bf16* LA = LAB + (size_t)(2 * d) * LAB_STRIDE + ch; const bf16* LB = LAB + (size_t)(2 * d + 1) * LAB_STRIDE + ch;
            if (d == 0) {
#pragma unroll 16
                for (int i = 0; i < CHUNK; ++i) { const int r = r0 + i; h = __builtin_amdgcn_exp2f(bf2f(LA[(size_t)r * 256])) * h + bf2f(LB[(size_t)r * 256]); LRUO[(size_t)r * 256 + ch] = h; }
            } else {
#pragma unroll 8
                for (int i = 0; i < CHUNK; ++i) { const int r = r0 + CHUNK - 1 - i; h = __builtin_amdgcn_exp2f(bf2f(LA[(size_t)r * 256])) * h + bf2f(LB[(size_t)r * 256]);
                    const float lg = bf2f(U[(size_t)r * INW + 1024 + ch]);
                    LRUO[(size_t)r * 256 + ch] = (LRUO[(size_t)r * 256 + ch] + h) * gelu_tanh(lg); }
            }
        }
    }
}

__device__ __forceinline__ void ph_hyena_fft(const Frame& F, int l, const float* hy_bias) {
    LAS f32x2v* D = (LAS f32x2v*)(F.lds);
    const c32* KHAT = (const c32*)(F.ws + WS_KHAT) + (size_t)l * 256 * 16384;
    const bf16* VT = (const bf16*)(F.ws + WS_VT); const bf16* X0T = (const bf16*)(F.ws + WS_X0T); bf16* HYO = (bf16*)(F.ws + WS_HYO);
    for (int it = blockIdx.x; it < 512; it += F.G) {
        const int c = it >> 1, bp = it & 1;
        const bf16* va = VT + ((size_t)(bp * 2) * 256 + c) * SEQ; const bf16* vb = VT + ((size_t)(bp * 2 + 1) * 256 + c) * SEQ;
#ifndef REP_FFT
#define REP_FFT 1
#endif
#pragma unroll 1
        for (int repf_ = 0; repf_ < REP_FFT; ++repf_) {
#pragma unroll 1
        for (int i = 0; i < 8; ++i) { const int j = F.tid + 512 * i; c32 x0, x1, z; x0.x = bf2f(va[j]); x0.y = bf2f(vb[j]); x1.x = bf2f(va[j + 4096]); x1.y = bf2f(vb[j + 4096]); z.x = 0.f; z.y = 0.f;
            fft_first4(D, j, x0, x1, z, z); }
        __syncthreads();
        { fft_fwd16(D, F.tid, 4096); fft_fwd16(D, F.tid + 512, 4096); }
        __syncthreads();
        { fft_fwd16(D, F.tid, 256); fft_fwd16(D, F.tid + 512, 256); }
        __syncthreads();
        _Pragma("unroll 1") for (int g_ = F.tid; g_ < 1024; g_ += 512) fft_mid16(D, g_, KHAT + (size_t)c * 16384);
        __syncthreads();
        { fft_inv16(D, F.tid, 256); fft_inv16(D, F.tid + 512, 256); }
        __syncthreads();
        { fft_inv16(D, F.tid, 4096); fft_inv16(D, F.tid + 512, 4096); }
        __syncthreads();
        }
        const float bias = hy_bias[l * 256 + c];
        const bf16* xa = X0T + ((size_t)(bp * 2) * 256 + c) * SEQ; const bf16* xb = X0T + ((size_t)(bp * 2 + 1) * 256 + c) * SEQ;
        bf16* oa = HYO + ((size_t)(bp * 2) * 256 + c) * SEQ; bf16* ob = HYO + ((size_t)(bp * 2 + 1) * 256 + c) * SEQ;
#pragma unroll 2
        for (int i = 0; i < 8; ++i) { const int j = F.tid + 512 * i; c32 u0, u1; fft_final4(D, j, u0, u1);
            oa[j] = (bf16)f2bf((u0.x + bf2f(va[j]) * bias) * bf2f(xa[j]));                 ob[j] = (bf16)f2bf((-u0.y + bf2f(vb[j]) * bias) * bf2f(xb[j]));
            oa[j + 4096] = (bf16)f2bf((u1.x + bf2f(va[j + 4096]) * bias) * bf2f(xa[j + 4096])); ob[j + 4096] = (bf16)f2bf((-u1.y + bf2f(vb[j + 4096]) * bias) * bf2f(xb[j + 4096])); }
        __syncthreads();
    }
}
__device__ __forceinline__ void ph_hyena_ctx(const Frame& F, const float* hy_bias, const float* hy_cw, const float* hy_cb) {
    float* HYO = (float*)(F.ws + WS_HYO);
    {

        const bf16* U = (const bf16*)(F.ws + WS_U); const float* KFC = (const float*)(F.ws + WS_KFC);
        LAS float* vw = (LAS float*)(F.lds + F.wave * 4096);
        LAS float* kw = vw + 256;
        const float* cw = hy_cw; const float* cbp = hy_cb;
        for (int it = F.gw; it < NB * 256; it += F.ngw) {
            const int b = it >> 8, c = it & 255;
            float x0v[4];
#pragma unroll
            for (int i = 0; i < 4; ++i) { const int t = F.lane + 64 * i;
                float o[3];
#pragma unroll
                for (int g = 0; g < 3; ++g) { const int cc = g * 256 + c; float a = cbp[cc];
#pragma unroll
                    for (int j = 0; j < 3; ++j) { const int tj = t + j - 1; if (tj >= 0 && tj < CTXL) a += cw[j * 768 + cc] * bf2f(U[(size_t)(NLAT + b * CTXL + tj) * INW + 1280 + cc]); }
                    o[g] = a; }
                vw[t] = o[2] * o[1]; x0v[i] = o[0]; }
#pragma unroll
            for (int i = 0; i < 8; ++i) kw[F.lane + 64 * i] = KFC[c * 512 + F.lane + 64 * i];
            LDS_WAIT();
            float y[4] = {0.f, 0.f, 0.f, 0.f};
#pragma unroll 4
            for (int s = 0; s < CTXL; ++s) { const float vv = vw[s];
#pragma unroll
                for (int i = 0; i < 4; ++i) y[i] += kw[(F.lane + 64 * i - s) & 511] * vv; }
            const float bias = hy_bias[c];
#pragma unroll
            for (int i = 0; i < 4; ++i) { const int t = F.lane + 64 * i; HYO[(size_t)(NLAT + b * CTXL + t) * 256 + c] = (y[i] + vw[t] * bias) * x0v[i]; }
            LDS_WAIT();
        }
    }
}

__device__ __forceinline__ void merge_row(const Frame& F, int r, const float* g, float h0, float h1, float h2, float h3) {
    const bf16* ATT = (const bf16*)(F.ws + WS_ATT); const float* LRUO = (const float*)(F.ws + WS_LRUO); bf16* MIXA = (bf16*)(F.ws + WS_MIXA);
    const v4u aw = ((const v4u*)(ATT + (size_t)r * 512))[F.lane];
    float a[8] = {bflo(aw.x), bfhi(aw.x), bflo(aw.y), bfhi(aw.y), bflo(aw.z), bfhi(aw.z), bflo(aw.w), bfhi(aw.w)};
    float ss = 0.f;
#pragma unroll
    for (int i = 0; i < 8; ++i) ss += a[i] * a[i];
    const float ra = 1.0f / sqrtf(wave_sum(ss) * (1.0f / 512.0f) + EPSN);
    const f32x4 lv = ((const f32x4*)(LRUO + (size_t)r * 256))[F.lane];
    const float rl = 1.0f / sqrtf(wave_sum(lv.x * lv.x + lv.y * lv.y + lv.z * lv.z + lv.w * lv.w) * (1.0f / 256.0f) + EPSN);
    const float rh = 1.0f / sqrtf(wave_sum(h0 * h0 + h1 * h1 + h2 * h2 + h3 * h3) * (1.0f / 256.0f) + EPSN);
    bf16* orow = MIXA + (size_t)r * 1024;
    { const f32x4 g0 = ((const f32x4*)g)[2 * F.lane], g1 = ((const f32x4*)g)[2 * F.lane + 1];
      v4u o; o.x = pk2(a[0] * ra * g0.x, a[1] * ra * g0.y); o.y = pk2(a[2] * ra * g0.z, a[3] * ra * g0.w); o.z = pk2(a[4] * ra * g1.x, a[5] * ra * g1.y); o.w = pk2(a[6] * ra * g1.z, a[7] * ra * g1.w);
      ((v4u*)orow)[F.lane] = o; }
    { const f32x4 gg = ((const f32x4*)(g + 512))[F.lane]; v2u o; o.x = pk2(lv.x * rl * gg.x, lv.y * rl * gg.y); o.y = pk2(lv.z * rl * gg.z, lv.w * rl * gg.w); ((v2u*)(orow + 512))[F.lane] = o; }
    orow[768 + F.lane] = (bf16)f2bf(h0 * rh * g[768 + F.lane]); orow[832 + F.lane] = (bf16)f2bf(h1 * rh * g[832 + F.lane]);
    orow[896 + F.lane] = (bf16)f2bf(h2 * rh * g[896 + F.lane]); orow[960 + F.lane] = (bf16)f2bf(h3 * rh * g[960 + F.lane]);
}
__device__ __forceinline__ void ph_merge(const Frame& F, int l, int nrows, const float* out_g) {
    const float* HYO = (const float*)(F.ws + WS_HYO);
    const float* g = out_g + l * 1024;
    LAS float* tile = (LAS float*)(F.lds);
    for (int it = blockIdx.x; it < NLAT / 64; it += F.G) {
        const int b = it >> 7, t0 = (it & 127) * 64;
#pragma unroll 8
        for (int i = 0; i < 32; ++i) { const int c = F.wave * 32 + i; tile[c * 65 + F.lane] = bf2f(((const bf16*)HYO)[((size_t)b * 256 + c) * SEQ + t0 + F.lane]); }
        __syncthreads();
#pragma unroll 2
        for (int k = 0; k < 8; ++k) { const int tt = F.wave * 8 + k;
            merge_row(F, b * SEQ + t0 + tt, g, tile[F.lane * 65 + tt], tile[(F.lane + 64) * 65 + tt], tile[(F.lane + 128) * 65 + tt], tile[(F.lane + 192) * 65 + tt]); }
        __syncthreads();
    }
    for (int r = NLAT + F.gw; r < nrows; r += F.ngw) {
        const float* hr = HYO + (size_t)r * 256;
        merge_row(F, r, g, hr[F.lane], hr[64 + F.lane], hr[128 + F.lane], hr[192 + F.lane]);
    }
}


constexpr int RW_PITCH = 34;
__device__ __forceinline__ void router_cols(LAS const float* rwl, const bf16* XR, const float* gc, const float* sf, unsigned char* Fbytes, int r, float rstd, int j, int kq, int i0, int i1, f32x4& acc0, f32x4& acc1) {
    const bf16* xrow = XR + (size_t)r * 1024 + 8 * kq; const float* gcp = gc + 8 * kq; const float* sfp = sf + 8 * kq;
    v4u xn[4];
#pragma unroll
    for (int u = 0; u < 4; ++u) xn[u] = *(const v4u*)(xrow + 32 * (i0 + u));
#pragma unroll 1
    for (int ib = i0; ib < i1; ib += 4) {
        v4u xw[4]; f32x4 g4[4][2], s4[4][2];
#pragma unroll
        for (int u = 0; u < 4; ++u) { xw[u] = xn[u]; g4[u][0] = *(const f32x4*)(gcp + 32 * (ib + u)); g4[u][1] = *(const f32x4*)(gcp + 32 * (ib + u) + 4); s4[u][0] = *(const f32x4*)(sfp + 32 * (ib + u)); s4[u][1] = *(const f32x4*)(sfp + 32 * (ib + u) + 4); }
        if (ib + 4 < i1) {
#pragma unroll
            for (int u = 0; u < 4; ++u) xn[u] = *(const v4u*)(xrow + 32 * (ib + 4 + u)); }
#pragma unroll
        for (int u = 0; u < 4; ++u) {
            const float x[8] = {bflo(xw[u].x), bfhi(xw[u].x), bflo(xw[u].y), bfhi(xw[u].y), bflo(xw[u].z), bfhi(xw[u].z), bflo(xw[u].w), bfhi(xw[u].w)};
            float xb[8], fv[8];
#pragma unroll
            for (int e = 0; e < 8; ++e) { xb[e] = x[e] * g4[u][e >> 2][e & 3]; fv[e] = xb[e] * rstd + s4[u][e >> 2][e & 3]; }
#if MOE_FP8
            v2u o; o.x = pg8::pack4_fp8(fv[0] * pg8::F8_SF, fv[1] * pg8::F8_SF, fv[2] * pg8::F8_SF, fv[3] * pg8::F8_SF); o.y = pg8::pack4_fp8(fv[4] * pg8::F8_SF, fv[5] * pg8::F8_SF, fv[6] * pg8::F8_SF, fv[7] * pg8::F8_SF);
            *(v2u*)(Fbytes + (size_t)r * 1024 + 8 * kq + 32 * (ib + u)) = o;
#else
            v4u o; o.x = pk2(fv[0], fv[1]); o.y = pk2(fv[2], fv[3]); o.z = pk2(fv[4], fv[5]); o.w = pk2(fv[6], fv[7]); *(v4u*)((bf16*)Fbytes + (size_t)r * 1024 + 8 * kq + 32 * (ib + u)) = o;
#endif
            const LAS float* wp = rwl + (32 * (ib + u) + 8 * kq) * RW_PITCH + j;
#pragma unroll
            for (int e = 0; e < 8; ++e) { acc0 = __builtin_amdgcn_mfma_f32_16x16x4f32(wp[e * RW_PITCH], xb[e], acc0, 0, 0, 0); acc1 = __builtin_amdgcn_mfma_f32_16x16x4f32(wp[e * RW_PITCH + 16], xb[e], acc1, 0, 0, 0); }
        }
    }
}
__device__ __forceinline__ void router_finish(LAS const float* cbl, LAS int* hist, int* TOPI, float* GATE, int r, int bidx, float rstd, int j, int kq, const f32x4& acc0, const f32x4& acc1) {
    float lg[8];
#pragma unroll
    for (int rr = 0; rr < 4; ++rr) { lg[rr] = rstd * acc0[rr] + cbl[bidx * 32 + 4 * kq + rr]; lg[4 + rr] = rstd * acc1[rr] + cbl[bidx * 32 + 16 + 4 * kq + rr]; }
    float p[32];
#pragma unroll
    for (int e = 0; e < 32; ++e) p[e] = __shfl(lg[(e >> 4) * 4 + (e & 3)], j + 16 * ((e & 15) >> 2));
    unsigned taken = 0u; float tv[4]; int ti[4];
#pragma unroll
    for (int k = 0; k < 4; ++k) { float best = -INFINITY; int bi = 0;
#pragma unroll
        for (int e = 0; e < 32; ++e) { const bool ok = !((taken >> e) & 1u) && (p[e] > best); best = ok ? p[e] : best; bi = ok ? e : bi; }
        taken |= 1u << bi; tv[k] = best; ti[k] = bi; }
    const float e1 = __expf(tv[1] - tv[0]), e2 = __expf(tv[2] - tv[0]), e3 = __expf(tv[3] - tv[0]); const float inv = 1.0f / (1.0f + e1 + e2 + e3);
    if (kq == 0) {
        TOPI[r * 4 + 0] = ti[0]; TOPI[r * 4 + 1] = ti[1]; TOPI[r * 4 + 2] = ti[2]; TOPI[r * 4 + 3] = ti[3];
        GATE[r * 4 + 0] = inv; GATE[r * 4 + 1] = e1 * inv; GATE[r * 4 + 2] = e2 * inv; GATE[r * 4 + 3] = e3 * inv;
        lds_add(&hist[ti[0]], 1); lds_add(&hist[ti[1]], 1); lds_add(&hist[ti[2]], 1); lds_add(&hist[ti[3]], 1);
    }
}
__device__ __forceinline__ void ph_ffn_router(const Frame& F, int l, int nrows, const float* router_w) {
    LAS float* rwl = (LAS float*)(F.lds);
    LAS float* part = (LAS float*)(F.lds + 139264);
    LAS float* cbl = (LAS float*)(F.lds + 153600);
    LAS int* hist = (LAS int*)(F.lds + 153600 + 640);
    const bf16* XR = (const bf16*)(F.ws + WS_XR); const float* RSSP = (const float*)(F.ws + WS_RSSP); const float* MOD = (const float*)(F.ws + WS_MOD);
    const float* GC = (const float*)(F.ws + WS_GC) + (size_t)l * 5 * 1024; unsigned char* Fb = (unsigned char*)(F.ws + WS_F);
    int* TOPI = (int*)(F.ws + WS_TOPI); float* GATE = (float*)(F.ws + WS_GATE); int* BLKCNT = (int*)(F.ws + WS_BLKCNT);
    for (int i = F.tid; i < 1024 * 32; i += NTHR) rwl[(i >> 5) * RW_PITCH + (i & 31)] = router_w[(size_t)l * 32768 + i];
    if (F.tid < 32) hist[F.tid] = 0;
    if (F.tid < 160) cbl[F.tid] = ((const float*)(F.ws + WS_CB))[l * 160 + F.tid];
    __syncthreads();
    const int j = F.lane & 15, kq = F.lane >> 4;
    const int ngrp = nrows / 16, nmain = (ngrp / F.ngw) * F.ngw;
    for (int grp = F.gw; grp < nmain; grp += F.ngw) {
        const int r0 = grp * 16, r = r0 + j; const int bidx = r0 < NLAT ? r0 / SEQ : 4;
        float ss; { const f32x4 q = *(const f32x4*)(RSSP + (size_t)r * 16 + 4 * kq); ss = (q.x + q.y) + (q.z + q.w); }
        ss += __shfl_xor(ss, 16); ss += __shfl_xor(ss, 32);
        const float rstd = 1.0f / sqrtf(ss * (1.0f / 1024.0f) + EPSN);
        f32x4 acc0 = {0.f, 0.f, 0.f, 0.f}, acc1 = acc0;
        router_cols(rwl, XR, GC + bidx * 1024, MOD + (size_t)(l * 5 + bidx) * 6144 + 3 * 1024, Fb, r, rstd, j, kq, 0, 32, acc0, acc1);
        router_finish(cbl, hist, TOPI, GATE, r, bidx, rstd, j, kq, acc0, acc1);
    }
    for (int grp = nmain + (int)blockIdx.x; grp < ngrp; grp += F.G) {
        const int r0 = grp * 16, r = r0 + j; const int bidx = r0 < NLAT ? r0 / SEQ : 4;
        float ss; { const f32x4 q = *(const f32x4*)(RSSP + (size_t)r * 16 + 4 * kq); ss = (q.x + q.y) + (q.z + q.w); }
        ss += __shfl_xor(ss, 16); ss += __shfl_xor(ss, 32);
        const float rstd = 1.0f / sqrtf(ss * (1.0f / 1024.0f) + EPSN);
        f32x4 acc0 = {0.f, 0.f, 0.f, 0.f}, acc1 = acc0;
        router_cols(rwl, XR, GC + bidx * 1024, MOD + (size_t)(l * 5 + bidx) * 6144 + 3 * 1024, Fb, r, rstd, j, kq, 4 * F.wave, 4 * F.wave + 4, acc0, acc1);
        if (F.wave > 0) { LAS f32x4* pp = (LAS f32x4*)(part + ((F.wave - 1) * 64 + F.lane) * 8); pp[0] = acc0; pp[1] = acc1; }
        __syncthreads();
        if (F.wave == 0) {
#pragma unroll
            for (int w = 0; w < 7; ++w) { const LAS f32x4* pp = (const LAS f32x4*)(part + (w * 64 + F.lane) * 8); acc0 += pp[0]; acc1 += pp[1]; }
            router_finish(cbl, hist, TOPI, GATE, r, bidx, rstd, j, kq, acc0, acc1);
        }
        __syncthreads();
    }
    __syncthreads();
    if (F.tid < 32) BLKCNT[blockIdx.x * 32 + F.tid] = hist[F.tid];
}

__device__ __forceinline__ void ph_route(const Frame& F, int nrows) {
    LAS int* cursor = (LAS int*)(F.lds);
    LAS int* tot = cursor + 32;
    LAS int* mine = cursor + 64;
    LAS int* part = cursor + 96;
    LAS int* ebase = cursor + 96 + 1024;
    const int* BLKCNT = (const int*)(F.ws + WS_BLKCNT); const int* TOPI = (const int*)(F.ws + WS_TOPI); int* POS = (int*)(F.ws + WS_POS);
    int* ROWTOK = (int*)(F.ws + WS_ROWTOK); int* TILEE = (int*)(F.ws + WS_TILEE);
    { const int e = F.tid & 31, sl = F.tid >> 5; int t = 0, m = 0;
      for (int b = sl; b < F.G; b += 16) { const int v = BLKCNT[b * 32 + e]; t += v; m += (b < (int)blockIdx.x) ? v : 0; }
      part[sl * 64 + e] = t; part[sl * 64 + 32 + e] = m;
      __syncthreads();
      if (F.tid < 32) { int tt = 0, mm = 0;
#pragma unroll
          for (int s = 0; s < 16; ++s) { tt += part[s * 64 + F.tid]; mm += part[s * 64 + 32 + F.tid]; }
          tot[F.tid] = tt; mine[F.tid] = mm; } }
    __syncthreads();
    if (F.tid == 0) { int tb = 0;
        for (int e = 0; e < 32; ++e) { const int nt = (tot[e] + 255) >> 8; cursor[e] = tb * 256 + mine[e]; ebase[e] = tb * 256;
            if (blockIdx.x == 0) for (int j = 0; j < nt; ++j) TILEE[tb + j] = e;
            tb += nt; }
        ebase[32] = tb * 256;
        if (blockIdx.x == 0) F.ctl[CW_NTILES] = (unsigned)tb; }
    __syncthreads();
    for (int e = blockIdx.x; e < 32; e += F.G) for (int p = ebase[e] + tot[e] + F.tid; p < ebase[e + 1]; p += NTHR) ROWTOK[p] = 0;
    const int sub = F.lane >> 2, k = F.lane & 3;
    const int ngrp = nrows / 16, nmain = (ngrp / F.ngw) * F.ngw;
    for (int grp = F.gw; grp < nmain; grp += F.ngw) {
        const int r = grp * 16 + sub; const int e = TOPI[r * 4 + k]; const int pos = lds_add(&cursor[e], 1); POS[r * 4 + k] = pos; ROWTOK[pos] = r; }
    if (F.wave == 0) for (int grp = nmain + (int)blockIdx.x; grp < ngrp; grp += F.G) {
        const int r = grp * 16 + sub; const int e = TOPI[r * 4 + k]; const int pos = lds_add(&cursor[e], 1); POS[r * 4 + k] = pos; ROWTOK[pos] = r; }
}

__device__ __forceinline__ void ph_combine(const Frame& F, int l, int nrows, float* out, const float* gmix) {
    bf16* XR = (bf16*)(F.ws + WS_XR); const float* MOD = (const float*)(F.ws + WS_MOD); const bf16* YS = (const bf16*)(F.ws + WS_YS); bf16* H = (bf16*)(F.ws + WS_H);
    const int* POS = (const int*)(F.ws + WS_POS); const float* GATE = (const float*)(F.ws + WS_GATE);
    for (int r = 2 * F.gw; r < nrows; r += 2 * F.ngw) {
        const int bidx = r < NLAT ? r / SEQ : 4;
        const float* gf = MOD + (size_t)(l * 5 + bidx) * 6144 + 5 * 1024;
        int pos = 0; float gt = 0.f;
        if (F.lane < 8) { pos = POS[r * 4 + F.lane]; gt = GATE[r * 4 + F.lane]; }
        v2u w[2][4][4], xw[2][4]; float gk[2][4];
#pragma unroll
        for (int rr = 0; rr < 2; ++rr)
#pragma unroll
            for (int k = 0; k < 4; ++k) { const int pk = __shfl(pos, rr * 4 + k); gk[rr][k] = __shfl(gt, rr * 4 + k);
#if MOE_FP8
                gk[rr][k] *= (1.0f / pg8::F8_SY); const unsigned* yr = (const unsigned*)((const unsigned char*)YS + (size_t)pk * YS_PITCH);
#pragma unroll
                for (int j = 0; j < 4; ++j) { w[rr][k][j].x = yr[64 * j + F.lane]; w[rr][k][j].y = 0u; } }
#else
                const v2u* yr = (const v2u*)(YS + (size_t)pk * 1024);
#pragma unroll
                for (int j = 0; j < 4; ++j) w[rr][k][j] = yr[64 * j + F.lane]; }
#endif
#pragma unroll
        for (int rr = 0; rr < 2; ++rr)
#pragma unroll
            for (int j = 0; j < 4; ++j) xw[rr][j] = ((const v2u*)(XR + (size_t)(r + rr) * 1024))[64 * j + F.lane];
        f32x4 gv[4];
#pragma unroll
        for (int j = 0; j < 4; ++j) gv[j] = ((const f32x4*)gf)[64 * j + F.lane];
#pragma unroll
        for (int rr = 0; rr < 2; ++rr) {
            const int row = r + rr;
            f32x4 y[4]; float ss = 0.f;
#pragma unroll
            for (int j = 0; j < 4; ++j) { f32x4 a = {0.f, 0.f, 0.f, 0.f};
#pragma unroll
                for (int k = 0; k < 4; ++k) { const v2u ww = w[rr][k][j]; const float g_ = gk[rr][k];
#if MOE_FP8
                    a.x += g_ * __builtin_amdgcn_cvt_f32_fp8((int)ww.x, 0); a.y += g_ * __builtin_amdgcn_cvt_f32_fp8((int)ww.x, 1); a.z += g_ * __builtin_amdgcn_cvt_f32_fp8((int)ww.x, 2); a.w += g_ * __builtin_amdgcn_cvt_f32_fp8((int)ww.x, 3); }
#else
                    a.x += g_ * bflo(ww.x); a.y += g_ * bfhi(ww.x); a.z += g_ * bflo(ww.y); a.w += g_ * bfhi(ww.y); }
#endif
                const f32x4 xv = {bflo(xw[rr][j].x), bfhi(xw[rr][j].x), bflo(xw[rr][j].y), bfhi(xw[rr][j].y)};
                y[j] = xv + gv[j] * a;
                const int cb = 64 * j + F.lane;
                if (l == 0) { v2u o; o.x = pk2(y[j].x, y[j].y); o.y = pk2(y[j].z, y[j].w); ((v2u*)(XR + (size_t)row * 1024))[cb] = o; } else ((f32x4*)(out + (size_t)row * 1024))[cb] = y[j];
                ss += (y[j].x * y[j].x + y[j].y * y[j].y) + (y[j].z * y[j].z + y[j].w * y[j].w); }
            if (l == 0) {
                const float rstd = 1.0f / sqrtf(wave_sum(ss) * (1.0f / 1024.0f) + EPSN);
                const float* shift = MOD + (size_t)(5 + bidx) * 6144; const float* scale = shift + 1024; const float* g = gmix + 1024;
#pragma unroll
                for (int j = 0; j < 4; ++j) { const int cb = 64 * j + F.lane; const f32x4 gg = ((const f32x4*)g)[cb], sc = ((const f32x4*)scale)[cb], sh = ((const f32x4*)shift)[cb];
                    const f32x4 hv = y[j] * rstd * gg * (sc + 1.0f) + sh;
                    v2u o; o.x = pk2(hv.x, hv.y); o.y = pk2(hv.z, hv.w); ((v2u*)(H + (size_t)row * 1024))[cb] = o; }
            }
        }
    }
}

struct Args { const float* in[34]; float* out; unsigned char* ws; int ph_lo, ph_hi; };
enum { I_X = 0, I_C, I_CTX, I_CCTX, I_WMOD, I_BMOD, I_GMIX, I_GFFN, I_WIN, I_QG, I_KG, I_LCW, I_LCB, I_LGW, I_LGB, I_LLAM, I_HCW, I_HCB, I_HW1, I_HB1, I_HW2, I_HB2, I_HW3, I_HFREQ, I_HDEC, I_HBIAS,
       I_OUTG, I_WOUT, I_RW, I_RB, I_MW1, I_MB1, I_MW2, I_MB2 };

__global__ void __launch_bounds__(NTHR, 2) mk_fwd(Args args) {
    extern __shared__ __attribute__((aligned(16))) unsigned char lds[];
    Frame F;
    F.lds = (LAS unsigned char*)lds; F.ws = args.ws; F.ctl = (unsigned*)(args.ws + WS_CTL);
    F.tid = threadIdx.x; F.lane = F.tid & 63; F.wave = __builtin_amdgcn_readfirstlane(F.tid >> 6);
    F.G = gridDim.x; { const int bx = blockIdx.x; F.vcu = (F.G % 8 == 0) ? (bx % 8) * (F.G / 8) + bx / 8 : bx; }
    F.gw = (int)blockIdx.x * NWAVES + F.wave; F.ngw = F.G * NWAVES;
    for (int u = F.tid; u < (LDS_BYTES - LDSCTL_OFF) / 4; u += NTHR) ((LAS unsigned*)(F.lds + LDSCTL_OFF))[u] = 0u;
    __syncthreads();
#if !MK_PER_PHASE
    XcdBarrier bar = xcd_barrier_post(F.ctl + CW_BAR, (volatile LAS unsigned*)(F.lds + LDSCTL_OFF + 32));
#define GRID_BAR() xcd_barrier(bar)
#else
#define GRID_BAR() do { } while (0)
#endif
    const int lo = args.ph_lo, hi = args.ph_hi;
#ifndef ONLY_PHASE
#define ONLY_PHASE (-1)
#endif
#define ENABLED(id) (ONLY_PHASE < 0 || ONLY_PHASE == (id))
#define IN(k) (ENABLED(k) && lo <= (k) && (k) < hi)
#define INL(j) (ENABLED(NPH_PRO + (j)) && lo <= pb + (j) && pb + (j) < hi)
#define SEAML(j) do { if (lo <= pb + (j) && pb + (j) + 1 < hi) { GRID_BAR(); } } while (0)
typedef const __attribute__((address_space(4))) Args* KArgs;
#ifndef REP_MASK
#define REP_MASK 0
#endif
#define NREP(j) (((REP_MASK >> (j)) & 1) ? 2 : 1)
#define REFRAME() Frame Fp = F; KArgs ka = (KArgs)__builtin_amdgcn_kernarg_segment_ptr(); { int t_ = F.tid; asm volatile("" : "+v"(t_), "+s"(ka)); Fp.tid = t_; Fp.lane = t_ & 63; Fp.wave = __builtin_amdgcn_readfirstlane(t_ >> 6); \
    Fp.gw = (int)blockIdx.x * NWAVES + Fp.wave; Fp.ws = ka->ws; Fp.ctl = (unsigned*)(ka->ws + WS_CTL); }
#define SEAM(k) do { if (lo <= (k) && (k) + 1 < hi) { GRID_BAR(); } } while (0)

    if (IN(0)) ph_prologue_a(F, args.in[I_C], args.in[I_CCTX], args.in[I_WMOD], args.in[I_BMOD], args.in[I_WIN], args.in[I_WOUT], args.in[I_MW1], args.in[I_MW2],
                             args.in[I_HW1], args.in[I_HB1], args.in[I_HW2], args.in[I_HB2], args.in[I_HFREQ], args.in[I_LGW], args.in[I_LLAM]);
    SEAM(0);
    if (IN(1)) ph_prologue_b(F, args.in[I_HW3], args.in[I_HDEC], args.in[I_GFFN], args.in[I_RW], args.in[I_RB]);
    SEAM(1);

#if MOE_FP8
#define MOE_EPI1 pg8::EpiSwigluF8
#define MOE_EPI2 pg8::EpiF8BiasF8
#else
#define MOE_EPI1 pg8::EpiSwiglu
#define MOE_EPI2 pg8::EpiBf16Bias
#endif
#ifndef PROBE_MOE2
#define PROBE_MOE2 0
#endif
#ifndef PROBE_MOE2B
#define PROBE_MOE2B 0
#endif
#ifndef PROBE_GEMM_K
#define PROBE_GEMM_K 0
#endif
#ifndef MOE_WGM1
#define MOE_WGM1 4
#endif
#ifndef MOE_WGM2
#define MOE_WGM2 8
#endif
#define PHASE(j, ...) if (INL(j)) { _Pragma("unroll") for (int rep_ = 0; rep_ < NREP(j); ++rep_) { { REFRAME(); __VA_ARGS__ } if (rep_ + 1 < NREP(j)) GRID_BAR(); } }
#define LAYER_BODY(l) { \
        const int pb = NPH_PRO + l * NPH_LAYER; \
        const int nrows = (l == 0) ? MT : NLAT; \
        if (l == 0) { PHASE(0, ph_norm_mod(Fp, l, ka->in[I_X], ka->in[I_CTX], ka->in[I_GMIX]);) SEAML(0); } \
        if (INL(1)) { REFRAME(); \
            unsigned* sw_ = Fp.ctl + CW_SPLIT + 2048 * l; \
            { pg8::Gemm g{(const bf16*)(Fp.ws + WS_H), (const bf16*)(Fp.ws + WS_WINT) + (size_t)l * 2048 * 1024, NLAT, 2048, 1024}; \
              pg8::StaticOrder S; S.init(NLAT, 2048, Fp.G, (int)blockIdx.x); \
              pg8::EpiBf16<0> E{(bf16*)(Fp.ws + WS_U), 2048, nullptr, 0, 0, 1.f}; \
              pg8::gemm_phase<pg8::EpiBf16<0>, pg8::StaticOrder, PG8_ALIGN, PG8_SP2>(Fp.lds + RING_OFF, g, S, E); } \
            split_arrive_all(bar, sw_);                                        \
            if ((int)blockIdx.x < CTXWG) {                                     \
              pg8::Gemm g{(const bf16*)(Fp.ws + WS_H) + (size_t)NLAT * 1024, (const bf16*)(Fp.ws + WS_WINT) + (size_t)l * 2048 * 1024, MT - NLAT, 2048, 1024}; \
              pg8::StaticOrder S; S.init(MT - NLAT, 2048, CTXWG, (int)blockIdx.x); \
              pg8::EpiBf16<0> E{(bf16*)(Fp.ws + WS_U) + (size_t)NLAT * 2048, 2048, nullptr, 0, 0, 1.f}; \
              pg8::gemm_phase<pg8::EpiBf16<0>, pg8::StaticOrder, PG8_ALIGN, PG8_SP2>(Fp.lds + RING_OFF, g, S, E); \
              split_arrive_flat(sw_); } \
            split_wait_all(bar, sw_); \
            if ((int)blockIdx.x >= CTXWG) post_ab(Fp, l, 0, NLAT, ((int)blockIdx.x - CTXWG) * NWAVES + Fp.wave, (Fp.G - CTXWG) * NWAVES, ka->in[I_KG], ka->in[I_LCW], ka->in[I_LCB]); \
            split_wait_flat(bar, sw_, (unsigned)CTXWG); \
            post_ab(Fp, l, NLAT, MT, Fp.gw, Fp.ngw, ka->in[I_KG], ka->in[I_LCW], ka->in[I_LCB]); \
            post_c(Fp, l, ka->in[I_HCW], ka->in[I_HCB]); } \
        SEAML(2); \
        PHASE(3, \
            int kg_ = 256; asm volatile("" : "+s"(kg_)); \
            pg8::Gemm g{(const bf16*)(Fp.ws + WS_XL), (const bf16*)(Fp.ws + WS_WGT) + (size_t)l * 1024 * 256, MT, 1024, kg_}; \
            pg8::StaticOrder S; S.init(MT, 1024, Fp.G, (int)blockIdx.x); \
            pg8::EpiLruGate E{(const bf16*)(Fp.ws + WS_XL), (bf16*)(Fp.ws + WS_LAB), LAB_STRIDE, ka->in[I_LGB] + (size_t)l * 1024, (const float*)(Fp.ws + WS_SPT) + l * 512}; \
            pg8::gemm_phase<pg8::EpiLruGate, pg8::StaticOrder, PG8_ALIGN, PG8_SP2>(Fp.lds + RING_OFF, g, S, E);) \
        SEAML(3); \
        PHASE(4, \
            ph_scan1(Fp); __syncthreads(); \
            const attn_body::AttnTensors AT{(const attn_body::bf16*)(Fp.ws + WS_U), (const attn_body::bf16*)(Fp.ws + WS_K), (const attn_body::bf16*)(Fp.ws + WS_V), (attn_body::bf16*)(Fp.ws + WS_ATT)}; \
            const attn_body::QPre QN{ka->in[I_QG] + l * 64, (const float*)(Fp.ws + WS_ROPEC), (const float*)(Fp.ws + WS_ROPES)}; \
            attn_body::attn_phase<8>((char*)lds + RING_OFF, AT, QN, Fp.G, Fp.vcu, l == 0, (long)NLAT);) \
        SEAML(4); \
        PHASE(5, ph_scan2(Fp); __syncthreads(); ph_hyena_fft(Fp, l, ka->in[I_HBIAS]); if (l == 0) ph_hyena_ctx(Fp, ka->in[I_HBIAS], ka->in[I_HCW], ka->in[I_HCB]);) \
        SEAML(5); \
        PHASE(6, ph_merge(Fp, l, nrows, ka->in[I_OUTG]);) \
        SEAML(6); \
        if (INL(7)) { REFRAME(); \
            pg8::Gemm g{(const bf16*)(Fp.ws + WS_MIXA), (const bf16*)(Fp.ws + WS_WOUTT) + (size_t)l * 1024 * 1024, nrows, 1024, 1024}; \
            pg8::StaticOrder S; S.init(nrows, 1024, Fp.G, (int)blockIdx.x); \
            bf16* XR = (bf16*)(Fp.ws + WS_XR); \
            pg8::EpiResid<(l) == 1> E{ka->in[I_X], ka->in[I_CTX], NLAT, XR, 1024, \
                            (const float*)(Fp.ws + WS_MOD) + (size_t)(l * 5) * 6144 + 2 * 1024, 6144, SEQ, (float*)(Fp.ws + WS_RSSP)}; \
            pg8::gemm_phase<pg8::EpiResid<(l) == 1>, pg8::StaticOrder, PG8_ALIGN, PG8_SP2>(Fp.lds + RING_OFF, g, S, E); \
        } \
        SEAML(7); \
        PHASE(8, ph_ffn_router(Fp, l, nrows, ka->in[I_RW]);) \
        SEAML(8); \
        PHASE(9, ph_route(Fp, nrows);) \
        SEAML(9); \
        if (INL(10) || INL(11)) { REFRAME(); \
            LAS int* tab = (LAS int*)(Fp.lds + MOETAB_OFF); \
            const int ntiles = (int)__hip_atomic_load(Fp.ctl + CW_NTILES, __ATOMIC_RELAXED, __HIP_MEMORY_SCOPE_AGENT); \
            const int* TILEE = (const int*)(Fp.ws + WS_TILEE); \
            for (int i = Fp.tid; i < ntiles && i < SORT_TILES; i += NTHR) tab[i] = TILEE[i]; \
            __syncthreads(); \
            if (INL(10)) { _Pragma("unroll") for (int rep_ = 0; rep_ < NREP(10); ++rep_) { { \
                int km1_ = 1024 / (1 + MOE_FP8); asm volatile("" : "+s"(km1_)); \
                pg8::Gemm g{(const bf16*)(Fp.ws + WS_F), (const bf16*)(Fp.ws + WS_W1T) + (size_t)l * 32 * 2048 * (1024 / (1 + MOE_FP8)), 0, 2048, km1_}; \
                pg8::MoeOrderT<true> S; S.init(tab, ntiles, 8, Fp.G, (int)blockIdx.x, MOE_WGM1); S.rowtok = (const int*)(Fp.ws + WS_ROWTOK); \
                MOE_EPI1 E{(bf16*)(Fp.ws + WS_ACT), 1024, ka->in[I_MB1] + (size_t)l * 32 * 2048, 2048}; \
                pg8::gemm_phase<MOE_EPI1, pg8::MoeOrderT<true>, PG8_ALIGN, PG8_SP2, MOE_FP8 != 0>(Fp.lds + RING_OFF, g, S, E); \
             } if (rep_ + 1 < NREP(10)) GRID_BAR(); } } \
            SEAML(10); \
            if (PROBE_MOE2B && INL(11)) { \
                pg8::Gemm g{(const bf16*)(Fp.ws + WS_ACT), (const bf16*)(Fp.ws + WS_W2T) + (size_t)l * 32 * 1024 * 1024, 0, 1024, 1024}; \
                pg8::MoeOrderT<false> S; S.init(tab, ntiles, 4, Fp.G, (int)blockIdx.x, MOE_WGM2); S.rowtok = nullptr; S.rev = 1; \
                pg8::EpiNone E{}; \
                pg8::gemm_phase<pg8::EpiNone, pg8::MoeOrderT<false>, PG8_ALIGN, PG8_SP2>(Fp.lds + RING_OFF, g, S, E); GRID_BAR(); } \
            if (INL(11)) { _Pragma("unroll") for (int rep_ = 0; rep_ < NREP(11); ++rep_) { { \
                int km2_ = 1024 / (1 + MOE_FP8); asm volatile("" : "+s"(km2_)); \
                pg8::Gemm g{(const bf16*)(Fp.ws + WS_ACT), (const bf16*)(Fp.ws + WS_W2T) + (size_t)l * 32 * 1024 * (1024 / (1 + MOE_FP8)), 0, 1024, km2_}; \
                pg8::MoeOrderT<false> S; S.init(tab, ntiles, 4, Fp.G, (int)blockIdx.x, MOE_WGM2); S.rowtok = nullptr; S.rev = 1; \
                MOE_EPI2 E{(bf16*)(Fp.ws + WS_YS), YS_PITCH, ka->in[I_MB2] + (size_t)l * 32 * 1024, 1024}; \
                pg8::gemm_phase<MOE_EPI2, pg8::MoeOrderT<false>, PG8_ALIGN, PG8_SP2, MOE_FP8 != 0>(Fp.lds + RING_OFF, g, S, E); \
             } if (rep_ + 1 < NREP(11)) GRID_BAR(); } } \
            if (PROBE_MOE2 && INL(11)) { GRID_BAR(); \
                pg8::Gemm g{(const bf16*)(Fp.ws + WS_ACT), (const bf16*)(Fp.ws + WS_W2T) + (size_t)l * 32 * 1024 * 1024, 0, 1024, 1024}; \
                pg8::MoeOrderT<false> S; S.init(tab, ntiles, 4, Fp.G, (int)blockIdx.x, MOE_WGM2); S.rowtok = nullptr; S.rev = (PROBE_MOE2 == 2) ? 0 : 1; \
                if (PROBE_MOE2 == 3) { pg8::EpiBf16BiasFold E{(bf16*)(Fp.ws + WS_ASORT), 1024, ka->in[I_MB2] + (size_t)l * 32 * 1024, 1024}; \
                    pg8::gemm_phase<pg8::EpiBf16BiasFold, pg8::MoeOrderT<false>, PG8_ALIGN, PG8_SP2>(Fp.lds + RING_OFF, g, S, E); } \
                else { pg8::EpiNone E{}; \
                pg8::gemm_phase<pg8::EpiNone, pg8::MoeOrderT<false>, PG8_ALIGN, PG8_SP2>(Fp.lds + RING_OFF, g, S, E); } } \
        } \
        SEAML(11); \
        if (INL(12)) { REFRAME(); ph_combine(Fp, l, nrows, ka->out, ka->in[I_GMIX]); } \
        if (l == 0) { SEAML(12); } \
    }
    LAYER_BODY(0)
    LAYER_BODY(1)
#undef LAYER_BODY
#undef PHASE
#undef IN
#undef SEAM
#undef INL
#undef SEAML
}

extern "C" void kernel_launch(void* const* d_in, const int* in_sizes, int n_in, void* d_out, int out_size, void* d_ws, size_t ws_size, hipStream_t stream) {
    static int grid = 0;
    if (grid == 0) {
        if (n_in != 34 || in_sizes[0] != NLAT * DMODEL || out_size != NLAT * DMODEL || ws_size < WS_END) {
            fprintf(stderr, "kernel_launch: unexpected shapes (n_in %d, in0 %d, out %d, ws %zu); nothing launched\n", n_in, n_in > 0 ? in_sizes[0] : -1, out_size, ws_size); grid = -1; return; }
        int dev = 0, cus = 0;
        if (hipGetDevice(&dev) != hipSuccess || hipDeviceGetAttribute(&cus, hipDeviceAttributeMultiprocessorCount, dev) != hipSuccess) { grid = -1; return; }
        if (hipFuncSetAttribute((const void*)mk_fwd, hipFuncAttributeMaxDynamicSharedMemorySize, LDS_BYTES) != hipSuccess) { fprintf(stderr, "kernel_launch: hipFuncSetAttribute failed\n"); grid = -1; return; }
        int per_cu = 0;
        if (hipOccupancyMaxActiveBlocksPerMultiprocessor(&per_cu, (const void*)mk_fwd, NTHR, LDS_BYTES) != hipSuccess || per_cu < 1) { fprintf(stderr, "kernel_launch: occupancy query says %d\n", per_cu); }
        (void)hipGetLastError();
        grid = cus;
    }
    if (grid < 0) return;
    if (hipMemsetAsync((char*)d_ws + WS_CTL, 0, CTL_ZERO_BYTES, stream) != hipSuccess) return;
    Args a{};
    for (int i = 0; i < 34; ++i) a.in[i] = (const float*)d_in[i];
    a.out = (float*)d_out; a.ws = (unsigned char*)d_ws;
#if MK_PER_PHASE
    for (int p = 0; p < NPH; ++p) { a.ph_lo = p; a.ph_hi = p + 1; hipLaunchKernelGGL(mk_fwd, dim3(grid), dim3(NTHR), LDS_BYTES, stream, a); }
#else
    a.ph_lo = 0; a.ph_hi = NPH;
    hipLaunchKernelGGL(mk_fwd, dim3(grid), dim3(NTHR), LDS_BYTES, stream, a);
#endif
}
```

```cpp
#include <hip/hip_runtime.h>
#include <hip/hip_bf16.h>
#include <cstdio>
#include <cstdint>
#include <cmath>
#ifndef MOE_FP8
#define MOE_FP8 1
#endif
#ifndef MK_PER_PHASE
#define MK_PER_PHASE 0
#endif
namespace pg8 {
#define PG8_LAS __attribute__((address_space(3)))
typedef unsigned short bf16_t;
typedef short bf16x8 __attribute__((ext_vector_type(8)));
typedef float f32x4 __attribute__((ext_vector_type(4)));
typedef unsigned u32x4 __attribute__((ext_vector_type(4)));
constexpr int BM = 256, BK = 64, HALF = 128, HTB = HALF * BK * 2  , STAGE_BYTES = 8 * HTB, NXCD = 8, WGM = 8;

__host__ __device__ __forceinline__ int lds_byte(int r, int c) { const int st = (r >> 4) * 2 + (c >> 5), rr = r & 15, cc = c & 31, ob = rr * 64 + cc * 2; return st * 1024 + (ob ^ (((ob >> 9) & 1) << 5)); }
__host__ __device__ __forceinline__ void stage_rc(int b, int& R, int& C) { const int st = b / 1024, sb = b % 1024, swz = sb ^ (((sb >> 9) & 1) << 5); R = (st >> 1) * 16 + swz / 64; C = (st & 1) * 32 + (swz % 64) / 2; }
__host__ __device__ __forceinline__ int perm32(int rho) { const int n = rho >> 4, i = rho & 15; return 8 * (i >> 2) + 4 * n + (i & 3); }

struct Unit { int pm, pn, be, e; };
struct Gemm { const bf16_t* A; const bf16_t* Bt; int M, N, K; };

struct StaticOrder {
    static constexpr bool GATHER = false;
    __device__ __forceinline__ int row_of(int r) const { return r; }
    int nM, nN, nwg, G, c;
    __host__ __device__ void init(int M, int N, int G_, int c_) { nM = M / BM; nN = N / BM; nwg = nM * nN; G = G_; c = c_; }
    __host__ __device__ bool next(int i, Unit& u) const {
        const long L = (long)i * G + c; if (L >= nwg) return false;
        int wgid = (int)L; { const int q = nwg / NXCD, r = nwg % NXCD, xcd = wgid % NXCD, off = wgid / NXCD; wgid = (xcd < r ? xcd * (q + 1) : r * (q + 1) + (xcd - r) * q) + off; }
        const int nig = WGM * nN, gid = wgid / nig, fm = gid * WGM, gsz = (nM - fm) < WGM ? (nM - fm) : WGM;
        u.pm = fm + ((wgid % nig) % gsz); u.pn = (wgid % nig) / gsz; u.be = u.pn; u.e = 0; return true;
    }
    __device__ __forceinline__ void a_ready(const Unit&) const {}
    __device__ __forceinline__ void done(const Unit&) const {}
};

__device__ __forceinline__ unsigned cvt_pk_bf16(float lo, float hi) { unsigned r; asm volatile("v_cvt_pk_bf16_f32 %0, %1, %2" : "=v"(r) : "v"(lo), "v"(hi)); return r; }
__device__ __forceinline__ unsigned pack4_fp8(float a, float b, float c, float d) {
    a = fminf(fmaxf(a, -448.f), 448.f); b = fminf(fmaxf(b, -448.f), 448.f); c = fminf(fmaxf(c, -448.f), 448.f); d = fminf(fmaxf(d, -448.f), 448.f);
    int w = 0; w = __builtin_amdgcn_cvt_pk_fp8_f32(a, b, w, false); w = __builtin_amdgcn_cvt_pk_fp8_f32(c, d, w, true); return (unsigned)w;
}
constexpr float F8_SF = 16.f, F8_SW = 64.f, F8_SA = 4.f, F8_SY = 32.f;
typedef float f32x2 __attribute__((ext_vector_type(2)));
__device__ __forceinline__ f32x2 gelu_pk(f32x2 v) {
    const f32x2 av = __builtin_elementwise_abs(v), d = av * 0.2316418882f + 1.0f;
    f32x2 t; t.x = __builtin_amdgcn_rcpf(d.x); t.y = __builtin_amdgcn_rcpf(d.y);
    f32x2 q = t * 0.5307027145f + (-0.7265760135f); q = q * t + 0.7107068705f; q = q * t + (-0.142248368f); q = q * t + 0.127414796f; q = q * t;
    const f32x2 s = (v * v) * (-0.72134752044f);
    f32x2 e; e.x = __builtin_amdgcn_exp2f(s.x); e.y = __builtin_amdgcn_exp2f(s.y);
    const f32x2 m = v * (q * e), r = v - m;
    f32x2 o; o.x = v.x < 0.f ? m.x : r.x; o.y = v.y < 0.f ? m.y : r.y; return o;
}

template <int ACT  > struct EpiBf16 {
    static constexpr bool PERM = true, AFTER_DRAIN = false; static_assert(ACT == 0 || ACT == 1, "EpiBf16: ACT is 0 (none) or 1 (gelu_pk)");
    bf16_t* O; int ldc; const float* bias; int split_cols; size_t split_stride; float scale0;
    struct Pre {}; __device__ __forceinline__ void preload(Pre&, const Unit&, int, int, int, int) const {}
    __device__ __forceinline__ void operator()(const f32x4 (&acc)[2][2][4][2], const Unit& u, int wr, int wc, int fr, int fq, const Pre&) const {
        const int row0 = u.pm * BM + wr * 64 + fr; int colt = u.pn * BM; bf16_t* base = O;
        float sc = 1.f; if (split_cols) { const int t = colt / split_cols; base += (size_t)t * split_stride; colt -= t * split_cols; if (t == 0) sc = scale0; }
        const int col0 = colt + wc * 32 + 8 * fq, bcol0 = u.pn * BM + wc * 32 + 8 * fq;
        f32x4 bv[2][2];
#pragma unroll
        for (int bj = 0; bj < 2; ++bj)
#pragma unroll
            for (int n = 0; n < 2; ++n) bv[bj][n] = bias ? *(const f32x4*)(bias + bcol0 + bj * HALF + 4 * n) : (f32x4){0.f, 0.f, 0.f, 0.f};
#pragma unroll
        for (int ai = 0; ai < 2; ++ai)
#pragma unroll
            for (int m = 0; m < 4; ++m) { bf16_t* rowp = base + (size_t)(row0 + ai * HALF + m * 16) * ldc + col0;
#pragma unroll
                for (int bj = 0; bj < 2; ++bj) { f32x4 v0 = acc[ai][bj][m][0] + bv[bj][0], v1 = acc[ai][bj][m][1] + bv[bj][1];
                    if (ACT == 1) { f32x2 a = gelu_pk((f32x2){v0[0], v0[1]}), b = gelu_pk((f32x2){v0[2], v0[3]}), c = gelu_pk((f32x2){v1[0], v1[1]}), d = gelu_pk((f32x2){v1[2], v1[3]});
                        v0 = (f32x4){a.x, a.y, b.x, b.y}; v1 = (f32x4){c.x, c.y, d.x, d.y}; }
                    v0 = v0 * sc; v1 = v1 * sc; u32x4 w; w.x = cvt_pk_bf16(v0[0], v0[1]); w.y = cvt_pk_bf16(v0[2], v0[3]); w.z = cvt_pk_bf16(v1[0], v1[1]); w.w = cvt_pk_bf16(v1[2], v1[3]);
                    *(u32x4*)(rowp + bj * HALF) = w; } }
    }
};


template <bool XIN_BF16> struct EpiResid {
    static constexpr bool PERM = false, AFTER_DRAIN = false;
    const float* xin_lat; const float* xin_ctx; int nlat; bf16_t* XR; int ldc; const float* mod; int mod_stride; int seq; float* rssp;
    struct Pre {}; __device__ __forceinline__ void preload(Pre&, const Unit&, int, int, int, int) const {}
    __device__ __forceinline__ void operator()(const f32x4 (&acc)[2][2][4][2], const Unit& u, int wr, int wc, int fr, int fq, const Pre&) const {
        typedef unsigned u32x2 __attribute__((ext_vector_type(2)));
        const int row0 = u.pm * BM + wr * 64 + fr, col0 = u.pn * BM + wc * 32 + 4 * fq;
        const int rowt = u.pm * BM; const int bidx = rowt < nlat ? rowt / seq : 4;
        const float* gate = mod + (size_t)bidx * mod_stride;
        const float* xin = rowt < nlat ? xin_lat : (xin_ctx - (size_t)nlat * ldc);
        f32x4 gv[2][2];
#pragma unroll
        for (int bj = 0; bj < 2; ++bj)
#pragma unroll
            for (int n = 0; n < 2; ++n) gv[bj][n] = *(const f32x4*)(gate + col0 + bj * HALF + n * 16);
#pragma unroll
        for (int ai = 0; ai < 2; ++ai)
#pragma unroll
            for (int m = 0; m < 4; ++m) { const int row = row0 + ai * HALF + m * 16; const size_t ro = (size_t)row * ldc + col0; float s2 = 0.f;
#pragma unroll
                for (int bj = 0; bj < 2; ++bj)
#pragma unroll
                    for (int n = 0; n < 2; ++n) { const size_t idx = ro + bj * HALF + n * 16; f32x4 xv;
                        if (XIN_BF16) { const u32x2 w = *(const u32x2*)(XR + idx); xv = (f32x4){__builtin_bit_cast(float, w.x << 16), __builtin_bit_cast(float, w.x & 0xffff0000u), __builtin_bit_cast(float, w.y << 16), __builtin_bit_cast(float, w.y & 0xffff0000u)}; }
                        else xv = *(const f32x4*)(xin + idx);
                        const f32x4 v = xv + gv[bj][n] * acc[ai][bj][m][n];
                        s2 += (v[0] * v[0] + v[1] * v[1]) + (v[2] * v[2] + v[3] * v[3]);
                        u32x2 o; o.x = cvt_pk_bf16(v[0], v[1]); o.y = cvt_pk_bf16(v[2], v[3]); *(u32x2*)(XR + idx) = o; }
                s2 += __shfl_xor(s2, 16); s2 += __shfl_xor(s2, 32);
                if (fq == 0) rssp[(size_t)row * 16 + u.pn * 4 + wc] = s2; }
    }
};
struct EpiSwiglu {
    static constexpr bool PERM = true, AFTER_DRAIN = false;
    bf16_t* O; int ldc; const float* bias; int bias_stride;
    struct Pre { unsigned bw[2][2][2]; };
    __device__ __forceinline__ void preload(Pre& p, const Unit& u, int wr, int wc, int fr, int fq) const {
        const float* bb = bias + (size_t)u.e * bias_stride + u.pn * BM + wc * 32 + 8 * fq;
#pragma unroll
        for (int bj = 0; bj < 2; ++bj)
#pragma unroll
            for (int n = 0; n < 2; ++n) { const f32x4 v = *(const f32x4*)(bb + bj * HALF + 4 * n); p.bw[bj][n][0] = cvt_pk_bf16(v[0], v[1]); p.bw[bj][n][1] = cvt_pk_bf16(v[2], v[3]); }
    }
    __device__ __forceinline__ void operator()(const f32x4 (&acc)[2][2][4][2], const Unit& u, int wr, int wc, int fr, int fq, const Pre& pre) const {
        const int row0 = u.pm * BM + wr * 64 + fr; const int bcol0 = u.pn * BM + wc * 32 + 8 * fq; const int ocol0 = bcol0 >> 1;
        f32x4 bv[2][2];
#pragma unroll
        for (int bj = 0; bj < 2; ++bj)
#pragma unroll
            for (int n = 0; n < 2; ++n) { const unsigned w0 = pre.bw[bj][n][0], w1 = pre.bw[bj][n][1];
                bv[bj][n] = (f32x4){__builtin_bit_cast(float, w0 << 16), __builtin_bit_cast(float, w0 & 0xffff0000u), __builtin_bit_cast(float, w1 << 16), __builtin_bit_cast(float, w1 & 0xffff0000u)}; }
#pragma unroll
        for (int ai = 0; ai < 2; ++ai)
#pragma unroll
            for (int m = 0; m < 4; ++m) { bf16_t* rowp = O + (size_t)(row0 + ai * HALF + m * 16) * ldc + ocol0;
#pragma unroll
                for (int bj = 0; bj < 2; ++bj) { const f32x4 v0 = acc[ai][bj][m][0] + bv[bj][0], v1 = acc[ai][bj][m][1] + bv[bj][1];
                    float o[4];
#pragma unroll
                    for (int p = 0; p < 4; ++p) { const float hg = p < 2 ? v0[2 * p] : v1[2 * p - 4], hl = p < 2 ? v0[2 * p + 1] : v1[2 * p - 3];
                        const float glu = fminf(hg, 7.0f), lin = fminf(fmaxf(hl, -7.0f), 7.0f);
                        const float sg = __builtin_amdgcn_rcpf(1.0f + __builtin_amdgcn_exp2f(-1.702f * 1.4426950408889634f * glu));
                        o[p] = glu * sg * (lin + 1.0f); }
                    typedef unsigned u32x2 __attribute__((ext_vector_type(2)));
                    u32x2 w; w.x = cvt_pk_bf16(o[0], o[1]); w.y = cvt_pk_bf16(o[2], o[3]);
                    *(u32x2*)(rowp + bj * (HALF / 2)) = w; } }
    }
};
struct EpiSwigluF8 {
    static constexpr bool PERM = true, AFTER_DRAIN = false;
    bf16_t* O; int ldc; const float* bias; int bias_stride;
    struct Pre { unsigned bw[2][2][2]; };
    __device__ __forceinline__ void preload(Pre& p, const Unit& u, int wr, int wc, int fr, int fq) const {
        const float* bb = bias + (size_t)u.e * bias_stride + u.pn * BM + wc * 32 + 8 * fq;
#pragma unroll
        for (int bj = 0; bj < 2; ++bj)
#pragma unroll
            for (int n = 0; n < 2; ++n) { const f32x4 v = *(const f32x4*)(bb + bj * HALF + 4 * n); p.bw[bj][n][0] = cvt_pk_bf16(v[0], v[1]); p.bw[bj][n][1] = cvt_pk_bf16(v[2], v[3]); }
    }
    __device__ __forceinline__ void operator()(const f32x4 (&acc)[2][2][4][2], const Unit& u, int wr, int wc, int fr, int fq, const Pre& pre) const {
        asm volatile("" : "+v"(fr), "+v"(fq));
        const int row0 = u.pm * BM + wr * 64 + fr; const int bcol0 = u.pn * BM + wc * 32 + 8 * fq; const int ocol0 = bcol0 >> 1;
        f32x4 bv[2][2];
#pragma unroll
        for (int bj = 0; bj < 2; ++bj)
#pragma unroll
            for (int n = 0; n < 2; ++n) { const unsigned w0 = pre.bw[bj][n][0], w1 = pre.bw[bj][n][1];
                bv[bj][n] = (f32x4){__builtin_bit_cast(float, w0 << 16), __builtin_bit_cast(float, w0 & 0xffff0000u), __builtin_bit_cast(float, w1 << 16), __builtin_bit_cast(float, w1 & 0xffff0000u)}; }
#pragma unroll
        for (int ai = 0; ai < 2; ++ai)
#pragma unroll
            for (int m = 0; m < 4; ++m) {
#pragma unroll
                for (int bj = 0; bj < 2; ++bj) { const f32x4 v0 = acc[ai][bj][m][0] * (1.0f / (F8_SF * F8_SW)) + bv[bj][0], v1 = acc[ai][bj][m][1] * (1.0f / (F8_SF * F8_SW)) + bv[bj][1];
                    float o[4];
#pragma unroll
                    for (int p = 0; p < 4; ++p) { const float hg = p < 2 ? v0[2 * p] : v1[2 * p - 4], hl = p < 2 ? v0[2 * p + 1] : v1[2 * p - 3];
                        const float glu = fminf(hg, 7.0f), lin = fminf(fmaxf(hl, -7.0f), 7.0f);
                        const float sg = __builtin_amdgcn_rcpf(1.0f + __builtin_amdgcn_exp2f(-1.702f * 1.4426950408889634f * glu));
                        o[p] = glu * sg * (lin + 1.0f); }
                    *(unsigned*)((unsigned char*)O + (size_t)(row0 + ai * HALF + m * 16) * ldc + ocol0 + bj * (HALF / 2)) = pack4_fp8(o[0] * F8_SA, o[1] * F8_SA, o[2] * F8_SA, o[3] * F8_SA); } }
    }
};
struct EpiBf16Bias {
    static constexpr bool PERM = true, AFTER_DRAIN = false;
    bf16_t* O; int ldc; const float* bias; int bias_stride;
    struct Pre { f32x4 bv[2][2]; };
    __device__ __forceinline__ void preload(Pre& p, const Unit& u, int wr, int wc, int fr, int fq) const {
        const float* bb = bias + (size_t)u.e * bias_stride + u.pn * BM + wc * 32 + 8 * fq;
#pragma unroll
        for (int bj = 0; bj < 2; ++bj)
#pragma unroll
            for (int n = 0; n < 2; ++n) p.bv[bj][n] = *(const f32x4*)(bb + bj * HALF + 4 * n);
    }
    __device__ __forceinline__ void operator()(const f32x4 (&acc)[2][2][4][2], const Unit& u, int wr, int wc, int fr, int fq, const Pre& pre) const {
        const int row0 = u.pm * BM + wr * 64 + fr; const int col0 = u.pn * BM + wc * 32 + 8 * fq;
#pragma unroll
        for (int ai = 0; ai < 2; ++ai)
#pragma unroll
            for (int m = 0; m < 4; ++m) { bf16_t* rowp = O + (size_t)(row0 + ai * HALF + m * 16) * ldc + col0;
#pragma unroll
                for (int bj = 0; bj < 2; ++bj) { const f32x4 v0 = acc[ai][bj][m][0] + pre.bv[bj][0], v1 = acc[ai][bj][m][1] + pre.bv[bj][1];
                    u32x4 w; w.x = cvt_pk_bf16(v0[0], v0[1]); w.y = cvt_pk_bf16(v0[2], v0[3]); w.z = cvt_pk_bf16(v1[0], v1[1]); w.w = cvt_pk_bf16(v1[2], v1[3]);
                    *(u32x4*)(rowp + bj * HALF) = w; } }
    }
};
struct EpiBf16BiasFold {
    static constexpr bool PERM = true, AFTER_DRAIN = false;
    bf16_t* O; int ldc; const float* bias; int bias_stride;
    struct Pre { f32x4 bv[2][2]; };
    __device__ __forceinline__ void preload(Pre& p, const Unit& u, int wr, int wc, int fr, int fq) const {
        const float* bb = bias + (size_t)u.e * bias_stride + u.pn * BM + wc * 32 + 8 * fq;
#pragma unroll
        for (int bj = 0; bj < 2; ++bj)
#pragma unroll
            for (int n = 0; n < 2; ++n) p.bv[bj][n] = *(const f32x4*)(bb + bj * HALF + 4 * n);
    }
    __device__ __forceinline__ void operator()(const f32x4 (&acc)[2][2][4][2], const Unit& u, int wr, int wc, int fr, int fq, const Pre& pre) const {
        const int row0 = u.pm * BM + wr * 64 + fr; const int col0 = u.pn * BM + wc * 32 + 8 * fq;
#pragma unroll
        for (int ai = 0; ai < 2; ++ai)
#pragma unroll
            for (int m = 0; m < 4; ++m) { bf16_t* rowp = O + (size_t)((row0 + ai * HALF + m * 16) & 255) * ldc + col0;
#pragma unroll
                for (int bj = 0; bj < 2; ++bj) { const f32x4 v0 = acc[ai][bj][m][0] + pre.bv[bj][0], v1 = acc[ai][bj][m][1] + pre.bv[bj][1];
                    u32x4 w; w.x = cvt_pk_bf16(v0[0], v0[1]); w.y = cvt_pk_bf16(v0[2], v0[3]); w.z = cvt_pk_bf16(v1[0], v1[1]); w.w = cvt_pk_bf16(v1[2], v1[3]);
                    *(u32x4*)(rowp + bj * HALF) = w; } }
    }
};
struct EpiBf16BiasF8 {
    static constexpr bool PERM = true, AFTER_DRAIN = false;
    bf16_t* O; int ldc; const float* bias; int bias_stride;
    struct Pre { f32x4 bv[2][2]; };
    __device__ __forceinline__ void preload(Pre& p, const Unit& u, int wr, int wc, int fr, int fq) const {
        const float* bb = bias + (size_t)u.e * bias_stride + u.pn * BM + wc * 32 + 8 * fq;
#pragma unroll
        for (int bj = 0; bj < 2; ++bj)
#pragma unroll
            for (int n = 0; n < 2; ++n) p.bv[bj][n] = *(const f32x4*)(bb + bj * HALF + 4 * n);
    }
    __device__ __forceinline__ void operator()(const f32x4 (&acc)[2][2][4][2], const Unit& u, int wr, int wc, int fr, int fq, const Pre& pre) const {
        asm volatile("" : "+v"(fr), "+v"(fq));
        const int row0 = u.pm * BM + wr * 64 + fr; const int col0 = u.pn * BM + wc * 32 + 8 * fq;
#pragma unroll
        for (int ai = 0; ai < 2; ++ai)
#pragma unroll
            for (int m = 0; m < 4; ++m) { bf16_t* rowp = O + (size_t)(row0 + ai * HALF + m * 16) * ldc + col0;
#pragma unroll
                for (int bj = 0; bj < 2; ++bj) { const f32x4 v0 = acc[ai][bj][m][0] * (1.0f / (F8_SA * F8_SW)) + pre.bv[bj][0], v1 = acc[ai][bj][m][1] * (1.0f / (F8_SA * F8_SW)) + pre.bv[bj][1];
                    u32x4 w; w.x = cvt_pk_bf16(v0[0], v0[1]); w.y = cvt_pk_bf16(v0[2], v0[3]); w.z = cvt_pk_bf16(v1[0], v1[1]); w.w = cvt_pk_bf16(v1[2], v1[3]);
                    *(u32x4*)(rowp + bj * HALF) = w; } }
    }
};
struct EpiF8BiasF8 {
    static constexpr bool PERM = true, AFTER_DRAIN = false;
    bf16_t* O; int ldc; const float* bias; int bias_stride;
    struct Pre { f32x4 bv[2][2]; };
    __device__ __forceinline__ void preload(Pre& p, const Unit& u, int wr, int wc, int fr, int fq) const {
        const float* bb = bias + (size_t)u.e * bias_stride + u.pn * BM + wc * 32 + 8 * fq;
#pragma unroll
        for (int bj = 0; bj < 2; ++bj)
#pragma unroll
            for (int n = 0; n < 2; ++n) p.bv[bj][n] = *(const f32x4*)(bb + bj * HALF + 4 * n);
    }
    __device__ __forceinline__ void operator()(const f32x4 (&acc)[2][2][4][2], const Unit& u, int wr, int wc, int fr, int fq, const Pre& pre) const {
        asm volatile("" : "+v"(fr), "+v"(fq));
        const int row0 = u.pm * BM + wr * 64 + fr; const int col0 = u.pn * BM + wc * 32 + 8 * fq;
#pragma unroll
        for (int ai = 0; ai < 2; ++ai)
#pragma unroll
            for (int m = 0; m < 4; ++m) { unsigned char* rowp = (unsigned char*)O + (size_t)(row0 + ai * HALF + m * 16) * ldc + col0;
#pragma unroll
                for (int bj = 0; bj < 2; ++bj) { const f32x4 v0 = (acc[ai][bj][m][0] * (1.0f / (F8_SA * F8_SW)) + pre.bv[bj][0]) * F8_SY, v1 = (acc[ai][bj][m][1] * (1.0f / (F8_SA * F8_SW)) + pre.bv[bj][1]) * F8_SY;
                    typedef unsigned u32x2 __attribute__((ext_vector_type(2)));
                    u32x2 w; w.x = pack4_fp8(v0[0], v0[1], v0[2], v0[3]); w.y = pack4_fp8(v1[0], v1[1], v1[2], v1[3]);
                    *(u32x2*)(rowp + bj * HALF) = w; } }
    }
};
struct EpiLruGate {
    static constexpr bool PERM = false, AFTER_DRAIN = false;
    const bf16_t* XL; bf16_t* LAB; size_t lab_stride; const float* gb; const float* spt;
    struct Pre {}; __device__ __forceinline__ void preload(Pre&, const Unit&, int, int, int, int) const {}
    __device__ __forceinline__ void operator()(const f32x4 (&acc)[2][2][4][2], const Unit& u, int wr, int wc, int fr, int fq, const Pre&) const {
        const int d = u.pn >> 1, half = u.pn & 1;
        const int row0 = u.pm * BM + wr * 64 + fr, ch0 = half * 128 + wc * 32 + 4 * fq;
        bf16_t* LA = LAB + (size_t)(2 * d) * lab_stride; bf16_t* LB = LAB + (size_t)(2 * d + 1) * lab_stride;
#pragma unroll
        for (int n = 0; n < 2; ++n) {
            const f32x4 bR = *(const f32x4*)(gb + (d * 2 + 0) * 256 + ch0 + 16 * n), bI = *(const f32x4*)(gb + (d * 2 + 1) * 256 + ch0 + 16 * n);
            const f32x4 sp = *(const f32x4*)(spt + d * 256 + ch0 + 16 * n) * (-8.0f * 1.4426950408889634f);
#pragma unroll
            for (int ai = 0; ai < 2; ++ai)
#pragma unroll
                for (int m = 0; m < 4; ++m) { const size_t ro = (size_t)(row0 + ai * HALF + m * 16) * 256 + ch0 + 16 * n;
                    typedef unsigned u32x2 __attribute__((ext_vector_type(2)));
                    const u32x2 xw = *(const u32x2*)(XL + ro);
                    const float xl[4] = {__builtin_bit_cast(float, xw.x << 16), __builtin_bit_cast(float, xw.x & 0xffff0000u), __builtin_bit_cast(float, xw.y << 16), __builtin_bit_cast(float, xw.y & 0xffff0000u)};
                    const f32x4 gr = acc[ai][0][m][n] + bR, gi = acc[ai][1][m][n] + bI;
                    f32x4 av, bv;
#pragma unroll
                    for (int e = 0; e < 4; ++e) {
                        const float rg = __builtin_amdgcn_rcpf(1.0f + __builtin_amdgcn_exp2f(-1.4426950408889634f * gr[e])), ig = __builtin_amdgcn_rcpf(1.0f + __builtin_amdgcn_exp2f(-1.4426950408889634f * gi[e]));
                        const float la2 = rg * sp[e];
                        const float a2 = __builtin_amdgcn_exp2f(2.0f * la2);
                        av[e] = la2; bv[e] = __builtin_amdgcn_sqrtf(fmaxf(1.0f - a2, 0.f)) * (ig * xl[e]); }
                    u32x2 wa, wb; wa.x = cvt_pk_bf16(av[0], av[1]); wa.y = cvt_pk_bf16(av[2], av[3]); wb.x = cvt_pk_bf16(bv[0], bv[1]); wb.y = cvt_pk_bf16(bv[2], bv[3]);
                    *(u32x2*)(LA + ro) = wa; *(u32x2*)(LB + ro) = wb; }
        }
    }
};
struct EpiNone {
    static constexpr bool PERM = true, AFTER_DRAIN = false;
    struct Pre {}; __device__ __forceinline__ void preload(Pre&, const Unit&, int, int, int, int) const {}
    __device__ __forceinline__ void operator()(const f32x4 (&acc)[2][2][4][2], const Unit& u, int wr, int wc, int fr, int fq, const Pre&) const {
#pragma unroll
        for (int a = 0; a < 2; ++a)
#pragma unroll
            for (int b2 = 0; b2 < 2; ++b2)
#pragma unroll
                for (int m = 0; m < 4; ++m)
#pragma unroll
                    for (int n = 0; n < 2; ++n) { f32x4 v = acc[a][b2][m][n]; asm volatile("" :: "v"(v)); }
    }
};
template <bool GATHER_> struct MoeOrderT {
    static constexpr bool GATHER = GATHER_;
    const int* rowtok;
    __device__ __forceinline__ int row_of(int r) const { return GATHER_ ? rowtok[r] : r; }
    const PG8_LAS int* tab; int ntiles, nN, nper, j, m_lo, nMx, wgm, rev;
    __device__ __forceinline__ void init(const PG8_LAS int* tab_, int ntiles_, int nN_, int G, int bx, int wgm_) {
        tab = tab_; ntiles = ntiles_; nN = nN_; wgm = wgm_; rev = 0;
        if (G % 8 == 0) { const int x = bx % 8; nper = G / 8; j = bx / 8; m_lo = (x * ntiles) / 8; nMx = ((x + 1) * ntiles) / 8 - m_lo; }
        else { nper = G; j = bx; m_lo = 0; nMx = ntiles; }
    }
    __device__ __forceinline__ bool next(int i, Unit& u) const {
        const int s = i * nper + j; if (s >= nMx * nN) return false;
        const int nig = wgm * nN, gid = s / nig, fm = gid * wgm, gsz = (nMx - fm) < wgm ? (nMx - fm) : wgm, w = s - gid * nig;
        const int mi = fm + (w % gsz); u.pm = m_lo + (rev ? (nMx - 1 - mi) : mi); u.pn = w / gsz; u.e = tab[u.pm]; u.be = u.e * nN + u.pn; return true;
    }
    __device__ __forceinline__ void a_ready(const Unit&) const {}
    __device__ __forceinline__ void done(const Unit&) const {}
};
template <class Epi, class Sched, bool ALIGN_EPI = false, bool SP2 = false, bool FP8 = false>
__device__ __forceinline__ void gemm_phase(PG8_LAS unsigned char* lds, const Gemm g, const Sched& S, const Epi& E) {
    int tid_ = threadIdx.x; asm volatile("" : "+v"(tid_));
    const int tid = tid_, wid = __builtin_amdgcn_readfirstlane(tid >> 6), lane = tid & 63, wr = wid >> 2, wc = wid & 3, fr = lane & 15, fq = lane >> 4;
    const int K = g.K, nt = K / BK;
    unsigned voffA[2], voffB[2];
#pragma unroll
    for (int i = 0; i < 2; ++i) { int R, C; stage_rc(tid * 16 + i * 8192, R, C); const int Rb = Epi::PERM ? ((R & ~31) + perm32(R & 31)) : R;
        voffA[i] = (unsigned)(R * K + C) * 2u; voffB[i] = (unsigned)(Rb * K + C) * 2u; }
    unsigned gA_[2] = {0u, 0u}, gN_[2] = {0u, 0u}, gC_[2] = {0u, 0u};
    static_assert(!Sched::GATHER || SP2, "the gathered A operand is wired into the SP2 loop only");
    if constexpr (Sched::GATHER) { _Pragma("unroll") for (int i_ = 0; i_ < 2; ++i_) { int R_, C_; stage_rc(tid * 16 + i_ * 8192, R_, C_); gC_[i_] = (unsigned)(C_ * 2); } }
#define PG8_GLOAD(dst, pm_) do { _Pragma("unroll") for (int h_ = 0; h_ < 2; ++h_) { unsigned t_[2]; _Pragma("unroll") for (int i_ = 0; i_ < 2; ++i_) { int R_, C_; stage_rc(tid * 16 + i_ * 8192, R_, C_); \
        t_[i_] = (unsigned)S.row_of((pm_) * BM + h_ * HALF + R_); } dst[h_] = t_[0] | (t_[1] << 16); } } while (0)
    const size_t kstep = (size_t)(BK * 2);
    const size_t hstep = (size_t)HALF * K * 2;
    const size_t tstep = 2 * hstep;
    const unsigned ldsw = (unsigned)wid * 1024u;
    const int aoff = lds_byte(wr * 64 + fr, fq * 8), boff = lds_byte(wc * 32 + fr, fq * 8);
#define PG8_SA(b, h) (((b) * 2 + (h)) * HTB)
#define PG8_SB(b, h) ((4 + (b) * 2 + (h)) * HTB)
#define PG8_STAGE(bufoff, gbase, voff) do { _Pragma("unroll") for (int _i = 0; _i < 2; ++_i) \
        __builtin_amdgcn_global_load_lds((const unsigned*)((const char*)(gbase) + (voff)[_i]), (PG8_LAS unsigned*)(lds + (bufoff) + ldsw + _i * 8192), 16, 0, 0); } while (0)
#define PG8_STA(bufoff, ptr, h, useN) do { if constexpr (Sched::GATHER) { const unsigned pk_ = (useN) ? gN_[h] : gA_[h]; unsigned o_[2] = {(pk_ & 0xffffu) * (unsigned)(K * 2) + gC_[0], (pk_ >> 16) * (unsigned)(K * 2) + gC_[1]}; PG8_STAGE(bufoff, ptr, o_); } \
        else { PG8_STAGE(bufoff, (ptr) + ((h) ? hstep : 0), voffA); } } while (0)
#define PG8_LDA(dst, b, h) do { _Pragma("unroll") for (int m = 0; m < 4; ++m) { if constexpr (FP8) { \
            dst##8[m] = __builtin_shufflevector(*(const PG8_LAS i32x4_*)(lds + PG8_SA(b, h) + aoff + m * 2048), *(const PG8_LAS i32x4_*)(lds + PG8_SA(b, h) + aoff + m * 2048 + 1024), 0, 1, 2, 3, 4, 5, 6, 7); } \
        else { _Pragma("unroll") for (int k = 0; k < 2; ++k) dst[m][k] = *(const PG8_LAS bf16x8*)(lds + PG8_SA(b, h) + aoff + m * 2048 + k * 1024); } } } while (0)
#define PG8_LDB(dst, b, h) do { _Pragma("unroll") for (int n = 0; n < 2; ++n) { if constexpr (FP8) { \
            dst##8[n] = __builtin_shufflevector(*(const PG8_LAS i32x4_*)(lds + PG8_SB(b, h) + boff + n * 2048), *(const PG8_LAS i32x4_*)(lds + PG8_SB(b, h) + boff + n * 2048 + 1024), 0, 1, 2, 3, 4, 5, 6, 7); } \
        else { _Pragma("unroll") for (int k = 0; k < 2; ++k) dst[n][k] = *(const PG8_LAS bf16x8*)(lds + PG8_SB(b, h) + boff + n * 2048 + k * 1024); } } } while (0)
#define PG8_MMA(ai, bj, At, Bt) do { __builtin_amdgcn_s_setprio(1); _Pragma("unroll") for (int m = 0; m < 4; ++m) _Pragma("unroll") for (int n = 0; n < 2; ++n) { \
        if constexpr (FP8) asm volatile("v_mfma_f32_16x16x128_f8f6f4 %0, %1, %2, %0" : "+v"(acc[ai][bj][m][n]) : "v"(Bt##8[n]), "v"(At##8[m]));   \
        else { _Pragma("unroll") for (int k = 0; k < 2; ++k) acc[ai][bj][m][n] = __builtin_amdgcn_mfma_f32_16x16x32_bf16(Bt[n][k], At[m][k], acc[ai][bj][m][n], 0, 0, 0); } } \
        __builtin_amdgcn_s_setprio(0); } while (0)
#define PG8_WAIT_V(n) asm volatile("s_waitcnt vmcnt(" #n ")" ::: "memory")
#define PG8_WAIT_L(n) asm volatile("s_waitcnt lgkmcnt(" #n ")" ::: "memory")
#define PG8_BAR __builtin_amdgcn_s_barrier()
#define PG8_SCHED __builtin_amdgcn_sched_barrier(0)
    Unit cur, nxt; int ui = 0;
    if (!S.next(0, cur)) return;
    f32x4 acc[2][2][4][2];
#pragma unroll
    for (int a = 0; a < 2; ++a)
#pragma unroll
        for (int b = 0; b < 2; ++b)
#pragma unroll
            for (int m = 0; m < 4; ++m)
#pragma unroll
                for (int n = 0; n < 2; ++n) acc[a][b][m][n] = (f32x4){0.f, 0.f, 0.f, 0.f};
    typedef int i32x4_ __attribute__((ext_vector_type(4))); typedef int i32x8_ __attribute__((ext_vector_type(8)));
    bf16x8 At[4][2], B0[2][2], B1[2][2]; i32x8_ At8[4], B08[2], B18[2];
    typename Epi::Pre pre;
    const char* cA = (const char*)g.A + (Sched::GATHER ? (size_t)0 : (size_t)cur.pm * tstep); if constexpr (Sched::GATHER) PG8_GLOAD(gA_, cur.pm);
    const char* cB = (const char*)g.Bt + (size_t)cur.be * tstep;
    S.a_ready(cur);
    if constexpr (SP2) {
        PG8_STAGE(PG8_SB(0, 0), cB, voffB); PG8_STAGE(PG8_SB(0, 1), cB + hstep, voffB); PG8_STA(PG8_SA(0, 0), cA, 0, false); PG8_STA(PG8_SA(0, 1), cA, 1, false);
        if (wr == 1) PG8_BAR;
        PG8_WAIT_V(2); PG8_BAR;
        PG8_STAGE(PG8_SB(1, 0), cB + kstep, voffB); PG8_STA(PG8_SA(1, 0), cA + kstep, 0, false); PG8_STAGE(PG8_SB(1, 1), cB + hstep + kstep, voffB);
        PG8_WAIT_V(6); PG8_BAR;
    } else {
        PG8_STAGE(PG8_SB(0, 0), cB, voffB); PG8_STAGE(PG8_SA(0, 0), cA, voffA); PG8_STAGE(PG8_SB(0, 1), cB + hstep, voffB); PG8_STAGE(PG8_SA(0, 1), cA + hstep, voffA);
        if (wr == 1) PG8_BAR;
        PG8_WAIT_V(4); PG8_BAR;
        PG8_STAGE(PG8_SB(1, 0), cB + kstep, voffB); PG8_STAGE(PG8_SA(1, 0), cA + kstep, voffA); PG8_STAGE(PG8_SB(1, 1), cB + hstep + kstep, voffB);
        PG8_WAIT_V(6); PG8_BAR;
    }
    for (;;) {
        const bool has_next = S.next(ui + 1, nxt);
        const char* nA = (has_next && !Sched::GATHER) ? (const char*)g.A + (size_t)nxt.pm * tstep : cA; const char* nB = has_next ? (const char*)g.Bt + (size_t)nxt.be * tstep : cB;
        if constexpr (Sched::GATHER) { if (has_next) PG8_GLOAD(gN_, nxt.pm); else { gN_[0] = gA_[0]; gN_[1] = gA_[1]; } }
        for (int t = 0; t < nt; t += 2) {
            const bool last = (t == nt - 2);
            const char* a1 = cA + (size_t)(t + 1) * kstep;
            const char* a2 = last ? nA : cA + (size_t)(t + 2) * kstep; const char* b2 = last ? nB : cB + (size_t)(t + 2) * kstep;
            const char* a3 = a2 + kstep; const char* b3 = b2 + kstep;
            if (last) E.preload(pre, cur, wr, wc, fr, fq);
            if (last && has_next) S.a_ready(nxt);
            if constexpr (SP2) {
            PG8_LDB(B0, 0, 0); PG8_LDB(B1, 0, 1); PG8_SCHED; PG8_LDA(At, 0, 0); PG8_STA(PG8_SA(1, 1), a1, 1, false);
            PG8_WAIT_V(8); PG8_WAIT_L(0); PG8_BAR; PG8_MMA(0, 0, At, B0); PG8_MMA(0, 1, At, B1); PG8_BAR; PG8_SCHED;
            PG8_LDA(At, 0, 1); PG8_STAGE(PG8_SB(0, 0), b2, voffB); PG8_STAGE(PG8_SB(0, 1), b2 + hstep, voffB); PG8_STA(PG8_SA(0, 0), a2, 0, last);
            PG8_WAIT_V(8); PG8_WAIT_L(0); PG8_BAR; PG8_MMA(1, 0, At, B0); PG8_MMA(1, 1, At, B1); PG8_BAR; PG8_SCHED;
            PG8_LDB(B0, 1, 0); PG8_LDB(B1, 1, 1); PG8_SCHED; PG8_LDA(At, 1, 0); PG8_STA(PG8_SA(0, 1), a2, 1, last);
            PG8_WAIT_V(8); PG8_WAIT_L(0); PG8_BAR; PG8_MMA(0, 0, At, B0); PG8_MMA(0, 1, At, B1); PG8_BAR; PG8_SCHED;
            PG8_LDA(At, 1, 1); PG8_STAGE(PG8_SB(1, 0), b3, voffB); PG8_STAGE(PG8_SB(1, 1), b3 + hstep, voffB); PG8_STA(PG8_SA(1, 0), a3, 0, last);
            PG8_WAIT_V(8); PG8_WAIT_L(0); PG8_BAR; PG8_MMA(1, 0, At, B0); PG8_MMA(1, 1, At, B1); PG8_BAR; PG8_SCHED;
            } else {
            PG8_LDB(B0, 0, 0); PG8_SCHED; PG8_LDA(At, 0, 0); PG8_STAGE(PG8_SA(1, 1), a1 + hstep, voffA);
            PG8_WAIT_L(8); PG8_BAR; PG8_WAIT_L(0); PG8_MMA(0, 0, At, B0); PG8_BAR; PG8_SCHED;
            PG8_LDB(B1, 0, 1); PG8_STAGE(PG8_SB(0, 0), b2, voffB);
            PG8_BAR; PG8_WAIT_L(0); PG8_MMA(0, 1, At, B1); PG8_BAR;
            PG8_LDA(At, 0, 1); PG8_STAGE(PG8_SA(0, 0), a2, voffA);
            PG8_BAR; PG8_WAIT_L(0); PG8_MMA(1, 0, At, B0); PG8_BAR; PG8_SCHED;
            PG8_STAGE(PG8_SB(0, 1), b2 + hstep, voffB);
            PG8_WAIT_V(6); PG8_BAR; PG8_MMA(1, 1, At, B1); PG8_BAR;
            PG8_LDB(B0, 1, 0); PG8_SCHED; PG8_LDA(At, 1, 0); PG8_STAGE(PG8_SA(0, 1), a2 + hstep, voffA);
            PG8_WAIT_L(8); PG8_BAR; PG8_WAIT_L(0); PG8_MMA(0, 0, At, B0); PG8_BAR; PG8_SCHED;
            PG8_LDB(B1, 1, 1); PG8_STAGE(PG8_SB(1, 0), b3, voffB);
            PG8_BAR; PG8_WAIT_L(0); PG8_MMA(0, 1, At, B1); PG8_BAR;
            PG8_LDA(At, 1, 1); PG8_STAGE(PG8_SA(1, 0), a3, voffA);
            PG8_BAR; PG8_WAIT_L(0); PG8_MMA(1, 0, At, B0); PG8_BAR; PG8_SCHED;
            PG8_STAGE(PG8_SB(1, 1), b3 + hstep, voffB);
            PG8_WAIT_V(6); PG8_BAR; PG8_MMA(1, 1, At, B1); PG8_BAR;
            }
        }
        if constexpr (ALIGN_EPI) { if (wr == 0) PG8_BAR; }
        if constexpr (!Epi::AFTER_DRAIN) { E(acc, cur, wr, wc, fr, fq, pre); S.done(cur); }
        if (!has_next) break;
#pragma unroll
        for (int a = 0; a < 2; ++a)
#pragma unroll
            for (int b = 0; b < 2; ++b)
#pragma unroll
                for (int m = 0; m < 4; ++m)
#pragma unroll
                    for (int n = 0; n < 2; ++n) acc[a][b][m][n] = (f32x4){0.f, 0.f, 0.f, 0.f};
        cur = nxt; cA = nA; cB = nB; ++ui;
        if constexpr (Sched::GATHER) { gA_[0] = gN_[0]; gA_[1] = gN_[1]; }
        if constexpr (ALIGN_EPI) { if (wr == 1) PG8_BAR; }
    }
    PG8_WAIT_V(0);
    if constexpr (!ALIGN_EPI) { if (wr == 0) PG8_BAR; }
    PG8_BAR;
    if constexpr (Epi::AFTER_DRAIN) { E.fused(acc, cur, wr, wc, fr, fq, lds, wid, lane); S.done(cur); }
#undef PG8_SA
#undef PG8_SB
#undef PG8_STAGE
#undef PG8_STA
#undef PG8_GLOAD
#undef PG8_LDA
#undef PG8_LDB
#undef PG8_MMA
#undef PG8_WAIT_V
#undef PG8_WAIT_L
#undef PG8_BAR
#undef PG8_SCHED
}
}

#ifndef PG8_SP2
#define PG8_SP2 true
#endif
#ifndef PG8_ALIGN
#define PG8_ALIGN true
#endif
#include <cmath>
namespace attn_body {
using bf16=__hip_bfloat16;
using bf16x8=__attribute__((ext_vector_type(8)))short;
using s16x4=__attribute__((ext_vector_type(4)))short;
using f32x16=__attribute__((ext_vector_type(16)))float;
using u32x4=__attribute__((ext_vector_type(4)))unsigned;
using f32x4_t=__attribute__((ext_vector_type(4)))float;
constexpr int NHEAD=8,SEQQ=8192,SEQK=8448,D=64,QP=512,KP=128,QIN=2048;
constexpr int NW=8,QBLK=32,QB=QBLK*NW,KVBLK=64,NQB=SEQQ/QB;
constexpr int ATTN_UNIT_ROWS=QB;
__device__ __forceinline__ int crow(int r,int hi){return (r&3)+8*(r>>2)+4*hi;}
#define SBAR() __builtin_amdgcn_sched_barrier(0)
__device__ __forceinline__ void cmask(f32x16&p0,f32x16&p1,int jb,int qrel,int hi){
  const float NEG=-INFINITY; int kb=64*jb+4*hi;
  #pragma unroll
  for(int r=0;r<16;++r){int kv=kb+(r&3)+8*(r>>2); if(kv>qrel)p0[r]=NEG; if(kv+32>qrel)p1[r]=NEG;}
}

constexpr int NSLOT=3, SLOTB=8192;
constexpr int LDS_K=0, LDS_V=NSLOT*SLOTB, LDS_WS=2*NSLOT*SLOTB, LDS_OST=LDS_WS+NW*64*4, LDS_BYTES=LDS_OST+NW*4096;
constexpr float C2=0.125f*1.4426950408889634f;
__device__ __forceinline__ void glds16(const void*gsrc,unsigned lds_dst){unsigned keep;
  asm volatile("s_mov_b32 %0, m0\n\ts_mov_b32 m0, %2\n\ts_nop 0\n\tglobal_load_lds_dwordx4 %1, off\n\ts_mov_b32 m0, %0":"=&s"(keep):"v"(gsrc),"s"(lds_dst):"memory");}
__device__ __forceinline__ float max3f(float a,float b,float c){float r;asm("v_max3_f32 %0, %1, %2, %3":"=v"(r):"v"(a),"v"(b),"v"(c));return r;}
__device__ __forceinline__ float max2f(float a,float b){float r;asm("v_max_f32_e32 %0, %1, %2":"=v"(r):"v"(a),"v"(b));return r;}
__device__ __forceinline__ float fadd_s(float a,float b){float r;asm("v_add_f32_e32 %0, %1, %2":"=v"(r):"v"(a),"v"(b));return r;}
__device__ __forceinline__ float fsub_s(float a,float b){float r;asm("v_sub_f32_e32 %0, %1, %2":"=v"(r):"v"(a),"v"(b));return r;}
typedef float f32x2_t __attribute__((ext_vector_type(2))); typedef __bf16 bf16x2_t __attribute__((ext_vector_type(2)));
__device__ __forceinline__ unsigned cvtpk_s(float lo,float hi){f32x2_t v={lo,hi};bf16x2_t b=__builtin_convertvector(v,bf16x2_t);return __builtin_bit_cast(unsigned,b);}
#define WAIT_BAR(N) asm volatile("s_waitcnt vmcnt(" #N ") lgkmcnt(0)\n\ts_barrier":::"memory")

__device__ __forceinline__ void qkt(f32x16&p0,f32x16&p1,const char*Kslot,const bf16x8*qr,const f32x16&negm,int r32,int hi){
  const char*kb=Kslot+hi*1024+r32*16;
  #pragma unroll
  for(int d0=0;d0<4;++d0){
    const bf16x8 b0=*reinterpret_cast<const bf16x8*>(kb+d0*2048);
    const bf16x8 b1=*reinterpret_cast<const bf16x8*>(kb+d0*2048+512);
    if(d0==0){p0=__builtin_amdgcn_mfma_f32_32x32x16_bf16(b0,qr[0],negm,0,0,0);p1=__builtin_amdgcn_mfma_f32_32x32x16_bf16(b1,qr[0],negm,0,0,0);}
    else{p0=__builtin_amdgcn_mfma_f32_32x32x16_bf16(b0,qr[d0],p0,0,0,0);p1=__builtin_amdgcn_mfma_f32_32x32x16_bf16(b1,qr[d0],p1,0,0,0);}}
}
typedef __attribute__((address_space(3))) const char* lds_cptr;
typedef short v4i16_t __attribute__((ext_vector_type(4)));
__device__ __forceinline__ void kload8(bf16x8*kf,lds_cptr kp){
  kf[0]=*(const __attribute__((address_space(3))) bf16x8*)(kp);      kf[1]=*(const __attribute__((address_space(3))) bf16x8*)(kp+512);
  kf[2]=*(const __attribute__((address_space(3))) bf16x8*)(kp+2048); kf[3]=*(const __attribute__((address_space(3))) bf16x8*)(kp+2560);
  kf[4]=*(const __attribute__((address_space(3))) bf16x8*)(kp+4096); kf[5]=*(const __attribute__((address_space(3))) bf16x8*)(kp+4608);
  kf[6]=*(const __attribute__((address_space(3))) bf16x8*)(kp+6144); kf[7]=*(const __attribute__((address_space(3))) bf16x8*)(kp+6656);
}
__device__ __forceinline__ void kload2(bf16x8*kf,lds_cptr kp,int j){ kf[2*j]=*(const __attribute__((address_space(3))) bf16x8*)(kp+j*2048); kf[2*j+1]=*(const __attribute__((address_space(3))) bf16x8*)(kp+j*2048+512); }
__device__ __forceinline__ s16x4 vtr(lds_cptr p){ return __builtin_bit_cast(s16x4,__builtin_amdgcn_ds_read_tr16_b64_v4i16((__attribute__((address_space(3))) v4i16_t*)p)); }
__device__ __forceinline__ float rowmax(const f32x16&p0,const f32x16&p1){
  float a=max3f(p0[0],p0[1],p1[0]),b=max3f(p0[2],p0[3],p1[1]);a=max3f(a,p1[2],p1[3]);
  #pragma unroll
  for(int r=4;r<16;r+=4){a=max3f(a,p0[r],p0[r+1]);b=max3f(b,p0[r+2],p0[r+3]);a=max3f(a,p1[r],p1[r+1]);b=max3f(b,p1[r+2],p1[r+3]);}
  const float m=max2f(a,b);
  auto rr=__builtin_amdgcn_permlane32_swap(__float_as_uint(m),__float_as_uint(m),false,false);
  return max2f(__uint_as_float(rr[0]),__uint_as_float(rr[1]));
}
__device__ __forceinline__ void pv(f32x16*o,int vb,bf16x8 pa0,bf16x8 pa1,bf16x8 pa2,bf16x8 pa3){
  #pragma unroll
  for(int d0=0;d0<2;++d0){s16x4 lo[4],hi[4];
    #pragma unroll
    for(int ks=0;ks<4;++ks){
      asm volatile("ds_read_b64_tr_b16 %0,%1 offset:%c2":"=&v"(lo[ks]):"v"(vb),"i"(d0*4096+ks*1024):"memory");
      asm volatile("ds_read_b64_tr_b16 %0,%1 offset:%c2":"=&v"(hi[ks]):"v"(vb),"i"(d0*4096+ks*1024+512):"memory");}
    asm volatile("s_waitcnt lgkmcnt(0)":::"memory");SBAR();
    #define PK(k) (bf16x8){lo[k][0],lo[k][1],lo[k][2],lo[k][3],hi[k][0],hi[k][1],hi[k][2],hi[k][3]}
    o[d0]=__builtin_amdgcn_mfma_f32_32x32x16_bf16(pa0,PK(0),o[d0],0,0,0);
    o[d0]=__builtin_amdgcn_mfma_f32_32x32x16_bf16(pa1,PK(1),o[d0],0,0,0);
    o[d0]=__builtin_amdgcn_mfma_f32_32x32x16_bf16(pa2,PK(2),o[d0],0,0,0);
    o[d0]=__builtin_amdgcn_mfma_f32_32x32x16_bf16(pa3,PK(3),o[d0],0,0,0);
    #undef PK
  }
}

#ifndef ATTN_STORE16
#define ATTN_STORE16(p,v) (*(u32x4*)(p)=(v))
#endif
struct QPre { const float* qg; const float* rc; const float* rs; };
template<int THRL> __device__ __forceinline__ void attn_unit(int b,int h,long qrow0,int NTarg,int tq0,const QPre&QN,const bf16*Q,const bf16*__restrict__ K,const bf16*__restrict__ V,bf16*O,char*shm){
  int tid_=threadIdx.x; asm volatile("":"+v"(tid_)); const int tid=tid_,lane=tid&63,r32=lane&31,hi=lane>>5; const int wid=__builtin_amdgcn_readfirstlane(tid>>6);
  const long krowbase=(long)b*SEQK; const int kvh=h>>2;
  const bf16*Qw=Q+(qrow0+wid*QBLK)*QIN+h*D;
  const bf16*Kh=K+krowbase*KP+kvh*D,*Vh=V+krowbase*KP+kvh*D;
  const unsigned lds0=(unsigned)(uintptr_t)shm;
  float*wsf=(float*)(shm+LDS_WS)+wid*64;
  const bf16*ksrc=Kh+(long)lane*KP+wid*8;
  const bf16*vsrc=Vh+(long)(16*(wid&3)+(lane>>2))*KP+(wid>>2)*32+(lane&3)*8;
  const unsigned kdst=lds0+LDS_K+wid*1024, vdst=lds0+LDS_V+wid*1024;
  #define DMA_K(t,slot) glds16(ksrc+(long)(t)*KVBLK*KP,(unsigned)__builtin_amdgcn_readfirstlane(kdst+(slot)))
  #define DMA_V(t,slot) glds16(vsrc+(long)(t)*KVBLK*KP,(unsigned)__builtin_amdgcn_readfirstlane(vdst+(slot)))
  const int vb0=(int)(lds0+LDS_V)+((lane>>4)&1)*32+(lane&3)*8+(4*hi+((lane&15)>>2))*64;
  const char*Kbase=shm+LDS_K; bf16x8 kf[8];
  const lds_cptr shm3=(lds_cptr)shm; const lds_cptr kp0=shm3+LDS_K+hi*1024+r32*16; const lds_cptr vp0=shm3+LDS_V+((lane>>4)&1)*32+(lane&3)*8+(4*hi+((lane&15)>>2))*64;
  const int NT=NTarg;
  DMA_K(0,0);DMA_V(0,0);DMA_K(1,SLOTB);
  bf16x8 qr[4];
  #pragma unroll
  for(int d0=0;d0<4;++d0)qr[d0]=*reinterpret_cast<const bf16x8*>(&Qw[(long)r32*QIN+d0*16+hi*8]);
  {
    float x[4][8]; float ss=0.f;
    #pragma unroll
    for(int d0=0;d0<4;++d0){
      #pragma unroll
      for(int e=0;e<8;++e){ x[d0][e]=__builtin_bit_cast(float,(unsigned)(unsigned short)qr[d0][e]<<16); ss+=x[d0][e]*x[d0][e]; } }
    ss+=__shfl_xor(ss,32);
    const float rstd=C2/sqrtf(ss*(1.0f/64.0f)+1e-6f);
    #pragma unroll
    for(int d0=0;d0<4;++d0){ const f32x4_t g0=*reinterpret_cast<const f32x4_t*>(QN.qg+16*d0+8*hi), g1=*reinterpret_cast<const f32x4_t*>(QN.qg+16*d0+8*hi+4);
      #pragma unroll
      for(int e=0;e<8;++e) x[d0][e]*=rstd*(e<4?g0[e]:g1[e-4]); }
    if(tq0>=0){ const int t=tq0+wid*QBLK+r32;
      #pragma unroll
      for(int d0=0;d0<2;++d0){ const float*cp=QN.rc+(long)t*32+16*d0+8*hi,*sp=QN.rs+(long)t*32+16*d0+8*hi;
        const f32x4_t c0=*reinterpret_cast<const f32x4_t*>(cp),c1=*reinterpret_cast<const f32x4_t*>(cp+4),s0=*reinterpret_cast<const f32x4_t*>(sp),s1=*reinterpret_cast<const f32x4_t*>(sp+4);
        #pragma unroll
        for(int e=0;e<8;++e){ const float cs=e<4?c0[e]:c1[e-4], sn=e<4?s0[e]:s1[e-4]; const float a=x[d0][e], bq=x[d0+2][e]; x[d0][e]=a*cs-bq*sn; x[d0+2][e]=bq*cs+a*sn; } } }
    #pragma unroll
    for(int d0=0;d0<4;++d0){ u32x4 pk; pk[0]=cvtpk_s(x[d0][0],x[d0][1]); pk[1]=cvtpk_s(x[d0][2],x[d0][3]); pk[2]=cvtpk_s(x[d0][4],x[d0][5]); pk[3]=cvtpk_s(x[d0][6],x[d0][7]); qr[d0]=__builtin_bit_cast(bf16x8,pk); }
  }
  float mhat=0.f,l_reg=0.f;f32x16 o[2];o[0]=f32x16{};o[1]=f32x16{};f32x16 negm=f32x16{};asm volatile("":"+v"(negm));
  const int qrel=wid*QBLK+r32;
  #define CMASK(P0,P1,t) do{}while(0)
  bool resc=false;
  #define START(P0,P1) do{ const float rm=rowmax(P0,P1); resc=false; \
    { const float dl=rm; mhat=fadd_s(mhat,dl); \
      _Pragma("unroll") for(int r=0;r<16;++r){P0[r]=fsub_s(P0[r],dl);P1[r]=fsub_s(P1[r],dl);} \
      _Pragma("unroll") for(int r=0;r<16;++r)negm[r]=-mhat; asm volatile("":"+v"(negm)); } \
    _Pragma("unroll") for(int r=0;r<16;++r)P0[r]=__builtin_amdgcn_exp2f(P0[r]); }while(0)
  #define RESC() do{ if(resc){ asm volatile("s_waitcnt lgkmcnt(0)":::"memory"); \
      _Pragma("unroll") for(int d_=0;d_<2;++d_) _Pragma("unroll") for(int r=0;r<16;++r)o[d_][r]*=wsf[crow(r,hi)]; } }while(0)
  f32x16 pA0,pA1,pB0,pB1;
  int sl_prev=0,sl_cur=0,sl_next=SLOTB;
  #define ROT() do{sl_prev=sl_cur;sl_cur=sl_next;sl_next=(sl_next==(NSLOT-1)*SLOTB)?0:sl_next+SLOTB;}while(0)
  DMA_K(2,2*SLOTB);
  WAIT_BAR(3);
  qkt(pA0,pA1,Kbase,qr,negm,r32,hi);asm volatile("s_nop 15\n\ts_nop 7":"+v"(pA0),"+v"(pA1));CMASK(pA0,pA1,0);
  START(pA0,pA1);
  _Pragma("unroll") for(int r=0;r<16;++r)pA1[r]=__builtin_amdgcn_exp2f(pA1[r]);
  WAIT_BAR(0);
  DMA_K(3,0);DMA_V(1,SLOTB);
  ROT();
  kload8(kf,kp0+sl_cur);
  WAIT_BAR(2);
  s16x4 vlo[8],vhi[8]; u32x4 pw0,pw1,pw2,pw3;
  #define PKW(P,B) cvtpk_s(P[B],P[B+1])
  #define PAF(k) __builtin_bit_cast(bf16x8,pw##k)
  #define VFR(i) (bf16x8){vlo[i][0],vlo[i][1],vlo[i][2],vlo[i][3],vhi[i][0],vhi[i][1],vhi[i][2],vhi[i][3]}
  #define PIN(x) asm volatile("":"+v"(x))
  #define MX3(a,b,c) __builtin_fmaxf(__builtin_fmaxf((a),(b)),(c))
  #define GAPA(MF,A0,A1,A2,A3,W0,W1,PW) do{ MF; sacc+=A0; sacc+=A1; sacc+=A2; sacc+=A3; PIN(sacc); W0; W1; PIN(PW); SBAR(); }while(0)
  #define EX(v) __builtin_amdgcn_exp2f(v)
  #define GAPB(MF,X,B) do{ MF; X[B]=EX(X[B]); X[B+1]=EX(X[B+1]); X[B+2]=EX(X[B+2]); X[B+3]=EX(X[B+3]); PIN(X); SBAR(); }while(0)
  #define VRD(i) do{ vlo[i]=vtr(vp_+(((i)>>2)*4096+((i)&3)*1024)); vhi[i]=vtr(vp_+(((i)>>2)*4096+((i)&3)*1024+512)); }while(0)
  #define KRD(G,j) do{ if(G){ kload2(kf,kp0+sl_next,j); SBAR(); } }while(0)
  #define STEP(C0,C1,P0,P1,t,GK,GV,GL) do{ SBAR(); \
    const lds_cptr vp_=vp0+sl_prev; \
    VRD(0); SBAR(); float sacc=(P0[0]+P0[1]); \
    GAPA(C0=__builtin_amdgcn_mfma_f32_32x32x16_bf16(kf[0],qr[0],negm,0,0,0), P0[2],P0[3],P0[4],P0[5],     pw0[0]=PKW(P0,0), pw0[1]=PKW(P0,2), pw0); \
    VRD(4); SBAR(); GAPA(C1=__builtin_amdgcn_mfma_f32_32x32x16_bf16(kf[1],qr[0],negm,0,0,0), P0[6],P0[7],P0[8],P0[9],     pw0[2]=PKW(P0,4), pw0[3]=PKW(P0,6), pw0); \
    VRD(1); SBAR(); GAPA(C0=__builtin_amdgcn_mfma_f32_32x32x16_bf16(kf[2],qr[1],C0,0,0,0),   P0[10],P0[11],P0[12],P0[13], pw1[0]=PKW(P0,8), pw1[1]=PKW(P0,10), pw1); \
    VRD(5); SBAR(); GAPA(C1=__builtin_amdgcn_mfma_f32_32x32x16_bf16(kf[3],qr[1],C1,0,0,0),   P0[14],P0[15],P1[0],P1[1],   pw1[2]=PKW(P0,12),pw1[3]=PKW(P0,14), pw1); \
    VRD(2); SBAR(); GAPA(C0=__builtin_amdgcn_mfma_f32_32x32x16_bf16(kf[4],qr[2],C0,0,0,0),   P1[2],P1[3],P1[4],P1[5],     pw2[0]=PKW(P1,0), pw2[1]=PKW(P1,2), pw2); \
    VRD(6); SBAR(); GAPA(C1=__builtin_amdgcn_mfma_f32_32x32x16_bf16(kf[5],qr[2],C1,0,0,0),   P1[6],P1[7],P1[8],P1[9],     pw2[2]=PKW(P1,4), pw2[3]=PKW(P1,6), pw2); \
    VRD(3); SBAR(); GAPA(C0=__builtin_amdgcn_mfma_f32_32x32x16_bf16(kf[6],qr[3],C0,0,0,0),   P1[10],P1[11],P1[12],P1[13], pw3[0]=PKW(P1,8), pw3[1]=PKW(P1,10), pw3); \
    VRD(7); SBAR(); GAPA(C1=__builtin_amdgcn_mfma_f32_32x32x16_bf16(kf[7],qr[3],C1,0,0,0),   P1[14],P1[15],0.f,0.f,       pw3[2]=PKW(P1,12),pw3[3]=PKW(P1,14), pw3); \
    l_reg+=sacc; \
    if(GK){DMA_K((t)+3,sl_cur);} if(GV){DMA_V((t)+1,sl_next);} \
    CMASK(C0,C1,t); \
    { float a=MX3(C0[0],C0[1],C1[0]),b=MX3(C0[2],C0[3],C1[1]); a=MX3(a,C1[2],C1[3]); \
      _Pragma("unroll") for(int r=4;r<16;r+=4){a=MX3(a,C0[r],C0[r+1]);b=MX3(b,C0[r+2],C0[r+3]);a=MX3(a,C1[r],C1[r+1]);b=MX3(b,C1[r+2],C1[r+3]);} \
      float rm=__builtin_fmaxf(a,b); { auto rr=__builtin_amdgcn_permlane32_swap(__float_as_uint(rm),__float_as_uint(rm),false,false); rm=__builtin_fmaxf(__uint_as_float(rr[0]),__uint_as_float(rr[1])); } \
      resc=false; \
      if(__builtin_expect(__any(rm>(float)THRL),0)){ const float dl=__builtin_fmaxf(rm,0.f); mhat+=dl; \
        _Pragma("unroll") for(int r=0;r<16;++r){C0[r]-=dl;C1[r]-=dl;} \
        _Pragma("unroll") for(int r=0;r<16;++r)negm[r]=-mhat; asm volatile("":"+v"(negm)); \
        const float f=__builtin_amdgcn_exp2f(-dl); l_reg*=f; if(hi==0)wsf[r32]=f; resc=true; } } \
    SBAR(); \
    GAPB(o[0]=__builtin_amdgcn_mfma_f32_32x32x16_bf16(PAF(0),VFR(0),o[0],0,0,0), C0,0); \
    GAPB(o[1]=__builtin_amdgcn_mfma_f32_32x32x16_bf16(PAF(0),VFR(4),o[1],0,0,0), C0,4); \
    KRD(GL,0); GAPB(o[0]=__builtin_amdgcn_mfma_f32_32x32x16_bf16(PAF(1),VFR(1),o[0],0,0,0), C0,8); \
    KRD(GL,1); GAPB(o[1]=__builtin_amdgcn_mfma_f32_32x32x16_bf16(PAF(1),VFR(5),o[1],0,0,0), C0,12); \
    KRD(GL,2); GAPB(o[0]=__builtin_amdgcn_mfma_f32_32x32x16_bf16(PAF(2),VFR(2),o[0],0,0,0), C1,0); \
    KRD(GL,3); GAPB(o[1]=__builtin_amdgcn_mfma_f32_32x32x16_bf16(PAF(2),VFR(6),o[1],0,0,0), C1,4); \
    GAPB(o[0]=__builtin_amdgcn_mfma_f32_32x32x16_bf16(PAF(3),VFR(3),o[0],0,0,0), C1,8); \
    GAPB(o[1]=__builtin_amdgcn_mfma_f32_32x32x16_bf16(PAF(3),VFR(7),o[1],0,0,0), C1,12); \
    }while(0)
  int t=1;
  #undef CMASK
  #define CMASK(P0,P1,t) do{}while(0)
  for(;t+5<NT;t+=2){
    STEP(pB0,pB1,pA0,pA1,t,true,true,true);     WAIT_BAR(2); RESC(); ROT();
    STEP(pA0,pA1,pB0,pB1,t+1,true,true,true);   WAIT_BAR(2); RESC(); ROT();
  }
  #undef CMASK
  #define CMASK(P0,P1,t) do{}while(0)
  #define ENDW(tt) do{ if((tt)+3<NT){WAIT_BAR(2);} else if((tt)+2<NT){WAIT_BAR(1);} else {WAIT_BAR(0);} }while(0)
  for(;t+1<NT;t+=2){
    STEP(pB0,pB1,pA0,pA1,t,(t+3<NT),(t+1<NT),(t+1<NT));       ENDW(t);   RESC(); ROT();
    STEP(pA0,pA1,pB0,pB1,t+1,(t+4<NT),(t+2<NT),(t+2<NT));     ENDW(t+1); RESC(); ROT();
  }
  STEP(pB0,pB1,pA0,pA1,NT-1,false,false,false); RESC();
  { float sacc=pB0[0]+pB0[1]; _Pragma("unroll") for(int r=2;r<16;++r)sacc+=pB0[r]; _Pragma("unroll") for(int r=0;r<16;++r)sacc+=pB1[r]; l_reg+=sacc;
    pw0=(u32x4){PKW(pB0,0),PKW(pB0,2),PKW(pB0,4),PKW(pB0,6)};pw1=(u32x4){PKW(pB0,8),PKW(pB0,10),PKW(pB0,12),PKW(pB0,14)};pw2=(u32x4){PKW(pB1,0),PKW(pB1,2),PKW(pB1,4),PKW(pB1,6)};pw3=(u32x4){PKW(pB1,8),PKW(pB1,10),PKW(pB1,12),PKW(pB1,14)};
    SBAR(); pv(o,vb0+sl_cur,PAF(0),PAF(1),PAF(2),PAF(3)); }
  #undef PKW
  #undef PAF
  #undef VFR
  #undef PIN
  #undef MX3
  #undef GAPA
  #undef GAPB
  #undef EX
  #undef VRD
  #undef KRD
  #undef STEP
  #undef ENDW
  {auto rr=__builtin_amdgcn_permlane32_swap(__float_as_uint(l_reg),__float_as_uint(l_reg),false,false);l_reg=__uint_as_float(rr[0])+__uint_as_float(rr[1]);}
  if(hi==0)wsf[32+r32]=l_reg;asm volatile("s_waitcnt lgkmcnt(0)":::"memory");
  float rli[16];
  #pragma unroll
  for(int r=0;r<16;++r)rli[r]=__builtin_amdgcn_rcpf(wsf[32+crow(r,hi)]);
  bf16*Ow=O+(qrow0+wid*QBLK)*QP+h*D;
  { bf16*stg=(bf16*)(shm+LDS_OST)+wid*2048;
    #pragma unroll
    for(int r=0;r<16;++r){const int orow=crow(r,hi);
      #pragma unroll
      for(int d0=0;d0<2;++d0)stg[orow*64+d0*32+r32]=__float2bfloat16(o[d0][r]*rli[r]);}
    asm volatile("s_waitcnt lgkmcnt(0)":::"memory");
    #pragma unroll
    for(int i=0;i<4;++i){const int row=i*8+(lane>>3),ch=lane&7; const u32x4 v=*(const u32x4*)(stg+row*64+ch*8); ATTN_STORE16(Ow+(long)row*QP+ch*8,v);} }
  asm volatile("s_waitcnt lgkmcnt(0)\n\ts_barrier":::"memory");
  #undef DMA_K
  #undef DMA_V
  #undef CMASK
  #undef START
  #undef RESC
  #undef ROT
}
constexpr int ATTN_LDS_BYTES=LDS_BYTES;
struct AttnTensors { const bf16* Q; const bf16* K; const bf16* V; bf16* O; };
template<int THRL=8> __device__ __forceinline__ void attn_phase(char*lds,const AttnTensors&T,const QPre&QN,int G,int vcu,bool with_ctx,long ctx_row0){
  const int total=4*NHEAD*NQB;
  for(int i=0;;++i){
    int x,n;
    if(G==256){ if(i>=4)break; x=vcu>>5; n=i*32+(vcu&31); }
    else { const int u=i*G+vcu; if(u>=total)break; x=u>>7; n=u&127; }
    const int b=x>>1,kvh=x&1,h=kvh*4+(n>>5),qb=n&31;
    attn_unit<THRL>(b,h,(long)b*SEQQ+(long)qb*QB,SEQK/KVBLK,qb*QB,QN,T.Q,T.K,T.V,T.O,lds);
  }
  if(with_ctx){
    for(int u=vcu;u<4*NHEAD;u+=G){ const int b=u>>3,h=u&7; attn_unit<THRL>(b,h,ctx_row0+(long)b*256,4,-1,QN,T.Q,T.K,T.V,T.O,lds); }
  }
}
#undef SBAR
#undef WAIT_BAR
}

constexpr int NWAVES = 8, NTHR = 512;
constexpr int DMODEL = 1024, NB = 4, SEQ = 8192, CTXL = 256, NLAT = NB * SEQ, NCTX = NB * CTXL, MT = NLAT + NCTX;
constexpr int INW = 2048, NE = 32, KEYS = SEQ + CTXL;
constexpr int SORT_TILES = 560, SORT_ROWS = SORT_TILES * 256;
constexpr float EPSN = 1e-6f;
constexpr int NCHUNK = 66, CHUNK = 128;
constexpr int YS_PITCH = 1088;
constexpr int NPH_PRO = 2, NPH_LAYER = 13, NPH = NPH_PRO + 2 * NPH_LAYER;

constexpr size_t MiB = 1u << 20;
constexpr size_t WS_CTL = 0, CTL_ZERO_BYTES = 1 * MiB;
constexpr size_t WS_MOD = 1 * MiB, WS_ROPEC = 2 * MiB, WS_ROPES = 3 * MiB, WS_H2 = 4 * MiB, WS_KFC = 10 * MiB, WS_BLKCNT = 12 * MiB, WS_TILEE = 13 * MiB, WS_SCANS = 14 * MiB;
constexpr size_t WS_WINT = 16 * MiB, WS_WOUTT = 24 * MiB, WS_W1T = 32 * MiB, WS_W2T = 288 * MiB, WS_KF = 416 * MiB, WS_KHAT = 448 * MiB, WS_XR = 512 * MiB, WS_H = 644 * MiB;
constexpr size_t WS_U = 712 * MiB, WS_Q = 844 * MiB, WS_K = 877 * MiB, WS_V = 886 * MiB, WS_ATT = 895 * MiB, WS_LAB = 928 * MiB, WS_LRUO = 1060 * MiB, WS_VT = 1093 * MiB, WS_X0T = 1125 * MiB,
                 WS_HYO = 1157 * MiB, WS_MIXA = 1190 * MiB;
constexpr size_t WS_WGT = 11 * MiB, WS_SPT = 10 * MiB + 768 * 1024, WS_XL = 1256 * MiB;
constexpr size_t WS_GC = 10 * MiB + 896 * 1024;
constexpr size_t WS_CB = 10 * MiB + 960 * 1024;
constexpr size_t WS_F = 712 * MiB, WS_ASORT = 778 * MiB, WS_ACT = 1058 * MiB, WS_YS = 1338 * MiB, WS_TOPI = 1618 * MiB, WS_GATE = 1619 * MiB, WS_POS = 1620 * MiB, WS_RSSP = 1622 * MiB, WS_ROWTOK = 1625 * MiB, WS_END = 1626 * MiB;
constexpr size_t LAB_STRIDE = (size_t)MT * 256;
constexpr int CW_BAR = 4096;
constexpr int CW_NTILES = 64;

constexpr int RING_OFF = 0, RING_BYTES = 131072, MOETAB_OFF = 131072, LDSCTL_OFF = 155648, LDS_BYTES = 156160;

#define GAS __attribute__((address_space(1)))
#define LAS __attribute__((address_space(3)))
typedef unsigned short bf16;
typedef unsigned v4u __attribute__((ext_vector_type(4)));
typedef unsigned v2u __attribute__((ext_vector_type(2)));
typedef float f32x4 __attribute__((ext_vector_type(4)));
#define LDS_WAIT() asm volatile("s_waitcnt lgkmcnt(0)" ::: "memory")
#define VM_WAIT() asm volatile("s_waitcnt vmcnt(0)" ::: "memory")
__device__ __forceinline__ unsigned f2bf(float f) { unsigned u = __builtin_bit_cast(unsigned, f); return (u + 0x7fffu + ((u >> 16) & 1u)) >> 16; }
__device__ __forceinline__ unsigned pk2(float lo, float hi) { return f2bf(lo) | (f2bf(hi) << 16); }
__device__ __forceinline__ float bf2f(unsigned short b) { return __builtin_bit_cast(float, (unsigned)b << 16); }
__device__ __forceinline__ float bflo(unsigned w) { return __builtin_bit_cast(float, w << 16); }
__device__ __forceinline__ float bfhi(unsigned w) { return __builtin_bit_cast(float, w & 0xffff0000u); }
__device__ __forceinline__ float wave_sum(float v) {
#pragma unroll
    for (int o = 1; o < 64; o <<= 1) v += __shfl_xor(v, o);
    return v;
}
__device__ __forceinline__ float sigmoidf_(float x) { return 1.0f / (1.0f + __expf(-x)); }
__device__ __forceinline__ void sincos_d(double x, double& s, double& c) {
    const double kd = __builtin_rint(x * 0.63661977236758134308);
    const int k = (int)kd;
    double r = __builtin_fma(-kd, 1.57079632673412561417e+00, x);
    r = __builtin_fma(-kd, 6.07710050650619224932e-11, r);
    const double z = r * r;
    const double ps = r + r * z * (-1.66666666666666324348e-01 + z * (8.33333333332248946124e-03 + z * (-1.98412698298579493134e-04 + z * (2.75573137070700676789e-06 + z * (-2.50507602534068634195e-08 + z * 1.58969099521155010221e-10)))));
    const double pc = 1.0 - 0.5 * z + z * z * (4.16666666666666019037e-02 + z * (-1.38888888888741095749e-03 + z * (2.48015872894767294178e-05 + z * (-2.75573143513906633035e-07 + z * (2.08757232129817482790e-09 + z * -1.13596475577881948265e-11)))));
    const int q = k & 3;
    s = (q == 0) ? ps : (q == 1) ? pc : (q == 2) ? -ps : -pc;
    c = (q == 0) ? pc : (q == 1) ? -ps : (q == 2) ? -pc : ps;
}
__device__ __forceinline__ float gelu_tanh(float x) {
    const float u = 0.7978845608028654f * (x + 0.044715f * x * x * x);
    const float t = 1.0f - 2.0f / (1.0f + __expf(2.0f * u));
    return 0.5f * x * (1.0f + t);
}
__device__ __forceinline__ int lds_add(LAS int* p, int v) { return __hip_atomic_fetch_add(p, v, __ATOMIC_RELAXED, __HIP_MEMORY_SCOPE_WORKGROUP); }

#define FFT_FN __device__ __forceinline__
typedef float f32x2v __attribute__((ext_vector_type(2)));
#define FFT_VEC2 f32x2v
#define FFT_DPTR LAS f32x2v*
#define FFT_LD(D, i) c32_from((D)[i])
#define FFT_ST(D, i, v) ((D)[i] = c32_to(v))
struct __attribute__((aligned(8))) c32 { float x, y; };
FFT_FN c32 cmul(c32 a, c32 b) { c32 r; r.x = a.x * b.x - a.y * b.y; r.y = a.x * b.y + a.y * b.x; return r; }
FFT_FN c32 cadd(c32 a, c32 b) { c32 r; r.x = a.x + b.x; r.y = a.y + b.y; return r; }
FFT_FN c32 csub(c32 a, c32 b) { c32 r; r.x = a.x - b.x; r.y = a.y - b.y; return r; }
FFT_FN c32 cmuli_neg(c32 a) { c32 r; r.x = a.y; r.y = -a.x; return r; }
FFT_FN int fpad(int a) { return a + (a >> 4); }
#ifdef FFT_VEC2
FFT_FN c32 c32_from(FFT_VEC2 t) { c32 r; r.x = t.x; r.y = t.y; return r; }
FFT_FN FFT_VEC2 c32_to(c32 a) { FFT_VEC2 t; t.x = a.x; t.y = a.y; return t; }
#endif
FFT_FN void dft4(c32& a0, c32& a1, c32& a2, c32& a3) {
    const c32 s02 = cadd(a0, a2), d02 = csub(a0, a2), s13 = cadd(a1, a3), d13 = cmuli_neg(csub(a1, a3));
    a0 = cadd(s02, s13); a2 = csub(s02, s13); a1 = cadd(d02, d13); a3 = csub(d02, d13);
}
FFT_FN void dft16(c32 (&v)[16]) {
    const float C1 = 0.92387953251128674f, S1 = 0.38268343236508977f, C2 = 0.70710678118654752f;
#pragma unroll
    for (int q2 = 0; q2 < 4; ++q2) dft4(v[q2], v[4 + q2], v[8 + q2], v[12 + q2]);
    { c32 w;
      w.x = C1; w.y = -S1; v[4 * 1 + 1] = cmul(v[4 * 1 + 1], w);
      w.x = C2; w.y = -C2; v[4 * 2 + 1] = cmul(v[4 * 2 + 1], w);
      w.x = S1; w.y = -C1; v[4 * 3 + 1] = cmul(v[4 * 3 + 1], w);
      w.x = C2; w.y = -C2; v[4 * 1 + 2] = cmul(v[4 * 1 + 2], w);
      v[4 * 2 + 2] = cmuli_neg(v[4 * 2 + 2]);
      w.x = -C2; w.y = -C2; v[4 * 3 + 2] = cmul(v[4 * 3 + 2], w);
      w.x = S1; w.y = -C1; v[4 * 1 + 3] = cmul(v[4 * 1 + 3], w);
      w.x = -C2; w.y = -C2; v[4 * 2 + 3] = cmul(v[4 * 2 + 3], w);
      w.x = -C1; w.y = S1; v[4 * 3 + 3] = cmul(v[4 * 3 + 3], w); }
#pragma unroll
    for (int p1 = 0; p1 < 4; ++p1) dft4(v[4 * p1 + 0], v[4 * p1 + 1], v[4 * p1 + 2], v[4 * p1 + 3]);
#pragma unroll
    for (int a = 0; a < 4; ++a)
#pragma unroll
        for (int b = a + 1; b < 4; ++b) { const c32 t = v[4 * a + b]; v[4 * a + b] = v[4 * b + a]; v[4 * b + a] = t; }
}
FFT_FN c32 twid(int j, int n) { float rev = (float)j / (float)n; asm volatile("" : "+v"(rev)); c32 w; w.x = __builtin_amdgcn_cosf(rev); w.y = -__builtin_amdgcn_sinf(rev); return w; }

FFT_FN void fft_fwd16(FFT_DPTR D, int g, int n) {
    const int s = n >> 4, blk = g / s, j = g - blk * s, base = blk * n + j;
    c32 v[16];
#pragma unroll
    for (int q = 0; q < 16; ++q) v[q] = FFT_LD(D, fpad(base + q * s));
    dft16(v);
    const c32 w = twid(j, n); c32 wp = w;
#pragma unroll
    for (int p = 1; p < 16; ++p) { v[p] = cmul(v[p], wp); wp = cmul(wp, w); }
#pragma unroll
    for (int p = 0; p < 16; ++p) FFT_ST(D, fpad(base + p * s), v[p]);
}
FFT_FN void fft_inv16(FFT_DPTR D, int g, int n) {
    const int s = n >> 4, blk = g / s, j = g - blk * s, base = blk * n + j;
    c32 v[16];
#pragma unroll
    for (int q = 0; q < 16; ++q) v[q] = FFT_LD(D, fpad(base + q * s));
    const c32 w = twid(j, n); c32 wp = w;
#pragma unroll
    for (int p = 1; p < 16; ++p) { v[p] = cmul(v[p], wp); wp = cmul(wp, w); }
    dft16(v);
#pragma unroll
    for (int p = 0; p < 16; ++p) FFT_ST(D, fpad(base + p * s), v[p]);
}
FFT_FN void fft_mid16(FFT_DPTR D, int g, const c32* KH) {
    c32 v[16];
#pragma unroll
    for (int q = 0; q < 16; ++q) v[q] = FFT_LD(D, 17 * g + q);
    dft16(v);
#pragma unroll
    for (int p = 0; p < 16; ++p) { const c32 k = KH[16 * g + p]; const c32 t = cmul(v[p], k); v[p].x = t.x; v[p].y = -t.y; }
    dft16(v);
#pragma unroll
    for (int p = 0; p < 16; ++p) FFT_ST(D, 17 * g + p, v[p]);
}
FFT_FN void fft_last16_out(FFT_DPTR D, int g, c32* OUT, float scale) {
    c32 v[16];
#pragma unroll
    for (int q = 0; q < 16; ++q) v[q] = FFT_LD(D, 17 * g + q);
    dft16(v);
#pragma unroll
    for (int p = 0; p < 16; ++p) { c32 t; t.x = v[p].x * scale; t.y = v[p].y * scale; OUT[16 * g + p] = t; }
}
FFT_FN void fft_first4(FFT_DPTR D, int j, c32 x0, c32 x1, c32 x2, c32 x3) {
    dft4(x0, x1, x2, x3);
    const c32 w = twid(j, 16384), w2 = cmul(w, w), w3 = cmul(w2, w);
    FFT_ST(D, fpad(j), x0); FFT_ST(D, fpad(j + 4096), cmul(x1, w)); FFT_ST(D, fpad(j + 8192), cmul(x2, w2)); FFT_ST(D, fpad(j + 12288), cmul(x3, w3));
}
FFT_FN void fft_final4(FFT_DPTR D, int j, c32& u0, c32& u1) {
    const c32 w = twid(j, 16384), w2 = cmul(w, w), w3 = cmul(w2, w);
    c32 a0 = FFT_LD(D, fpad(j)), a1 = cmul(FFT_LD(D, fpad(j + 4096)), w), a2 = cmul(FFT_LD(D, fpad(j + 8192)), w2), a3 = cmul(FFT_LD(D, fpad(j + 12288)), w3);
    dft4(a0, a1, a2, a3);
    u0 = a0; u1 = a1;
}
FFT_FN void fft_first4_inplace(FFT_DPTR D, int j) {
    c32 x0 = FFT_LD(D, fpad(j)), x1 = FFT_LD(D, fpad(j + 4096)), x2 = FFT_LD(D, fpad(j + 8192)), x3 = FFT_LD(D, fpad(j + 12288));
    fft_first4(D, j, x0, x1, x2, x3);
}
#define XB_TMO      128
#define XB_XCNT(j)  (256  + 64 * (j))
#define XB_XSUB(j)  (1280 + 64 * (j))
#define XB_XGEN(j)  (2304 + 64 * (j))
#define XB_TOP      3328
#define XB_TOPGEN   3392
#define XCD_BAR_WORDS 3456
#define XB_SPIN_CAP (1u << 22)

__device__ __forceinline__ unsigned xb_ld(unsigned* p)              { return __hip_atomic_load(p, __ATOMIC_RELAXED, __HIP_MEMORY_SCOPE_AGENT); }
__device__ __forceinline__ unsigned xb_add(unsigned* p, unsigned v) { return __hip_atomic_fetch_add(p, v, __ATOMIC_RELAXED, __HIP_MEMORY_SCOPE_AGENT); }
__device__ __forceinline__ unsigned xb_xcc_id() { return (unsigned)__builtin_amdgcn_s_getreg((3 << 11) | 20) & 0xFu; }
#define XB_SPIN(cond, bar) do { unsigned _sp = 0; while (cond) { __builtin_amdgcn_s_sleep(1); \
    if ((++_sp & 255u) == 0u) { if (xb_ld(&(bar)[XB_TMO])) break; if (_sp > XB_SPIN_CAP) { atomicAdd(&(bar)[XB_TMO], 1u); break; } } } } while (0)

struct XcdBarrier {
    unsigned* bar; unsigned x;
    volatile LAS unsigned* st;
};

__device__ __forceinline__ XcdBarrier xcd_barrier_post(unsigned* bar, volatile LAS unsigned* st) {
    XcdBarrier b; b.bar = bar; b.x = xb_xcc_id(); b.st = st;
    if (threadIdx.x == 0) (void)xb_add(&bar[XB_XCNT(b.x)], 1u);
    return b;
}
__device__ __forceinline__ void xcd_barrier_complete(unsigned* bar, unsigned x, unsigned& nloc, unsigned& nx) {
    const unsigned G = gridDim.x * gridDim.y * gridDim.z;
    unsigned sum, cnt, mine, sp = 0u;
    for (;;) {
        sum = 0u; cnt = 0u; mine = 0u;
#pragma unroll
        for (unsigned j = 0; j < 16; ++j) { const unsigned c = xb_ld(&bar[XB_XCNT(j)]); sum += c; cnt += (c > 0u) ? 1u : 0u; mine = (j == x) ? c : mine; }
        if (sum == G) break;
        __builtin_amdgcn_s_sleep(1);
        if ((++sp & 255u) == 0u) { if (xb_ld(&bar[XB_TMO])) break; if (sp > XB_SPIN_CAP) { atomicAdd(&bar[XB_TMO], 1u); break; } }
    }
    nloc = mine > 0u ? mine : 1u; nx = cnt > 0u ? cnt : 1u;
}

__device__ __forceinline__ void xcd_barrier(const XcdBarrier& b) {
    asm volatile("s_waitcnt vmcnt(0)" ::: "memory");
    __syncthreads();
    if (threadIdx.x == 0) {
        unsigned* bar = b.bar;
        __builtin_amdgcn_s_waitcnt(0);
        unsigned nloc = b.st[0], nx = b.st[1];
        if (nloc == 0u) { xcd_barrier_complete(bar, b.x, nloc, nx); b.st[0] = nloc; b.st[1] = nx; }
        const unsigned old = xb_add(&bar[XB_XSUB(b.x)], 1u);
        const unsigned gen = old / nloc;
        if (old + 1u == (gen + 1u) * nloc) {
            __builtin_amdgcn_fence(__ATOMIC_RELEASE, "agent");
            asm volatile("s_waitcnt vmcnt(0)" ::: "memory");
            const unsigned og = xb_add(&bar[XB_TOP], 1u);
            const unsigned tg = og / nx;
            if (og + 1u == (tg + 1u) * nx) xb_add(&bar[XB_TOPGEN], 1u);
            else XB_SPIN(xb_ld(&bar[XB_TOPGEN]) == tg, bar);
            __builtin_amdgcn_fence(__ATOMIC_ACQUIRE, "agent");
            xb_add(&bar[XB_XGEN(b.x)], 1u);
            asm volatile("s_waitcnt vmcnt(0)" ::: "memory");
        } else {
            XB_SPIN(xb_ld(&bar[XB_XGEN(b.x)]) == gen, bar);
            __builtin_amdgcn_fence(__ATOMIC_ACQUIRE, "agent");
            asm volatile("s_waitcnt vmcnt(0)" ::: "memory");
        }
    }
    __syncthreads();
}


constexpr int CW_SPLIT = 8192, CTXWG = 32;
__device__ __forceinline__ void split_arrive_all(const XcdBarrier& b, unsigned* w) {
    asm volatile("s_waitcnt vmcnt(0)" ::: "memory");
    __syncthreads();
    if (threadIdx.x == 0) { const unsigned nloc = b.st[0]; const unsigned old = xb_add(&w[64 * b.x], 1u);
        if (old + 1u == nloc) { __builtin_amdgcn_fence(__ATOMIC_RELEASE, "agent"); asm volatile("s_waitcnt vmcnt(0)" ::: "memory"); (void)xb_add(&w[1024], 1u); } }
}
__device__ __forceinline__ void split_wait_all(const XcdBarrier& b, unsigned* w) {
    if (threadIdx.x == 0) { const unsigned nx = b.st[1]; XB_SPIN(xb_ld(&w[1024]) < nx, b.bar); __builtin_amdgcn_fence(__ATOMIC_ACQUIRE, "agent"); asm volatile("s_waitcnt vmcnt(0)" ::: "memory"); }
    __syncthreads();
}
__device__ __forceinline__ void split_arrive_flat(unsigned* w) {
    asm volatile("s_waitcnt vmcnt(0)" ::: "memory");
    __syncthreads();
    if (threadIdx.x == 0) { __builtin_amdgcn_fence(__ATOMIC_RELEASE, "agent"); asm volatile("s_waitcnt vmcnt(0)" ::: "memory"); (void)xb_add(&w[1088], 1u); }
}
__device__ __forceinline__ void split_wait_flat(const XcdBarrier& b, unsigned* w, unsigned target) {
    if (threadIdx.x == 0) { XB_SPIN(xb_ld(&w[1088]) < target, b.bar); __builtin_amdgcn_fence(__ATOMIC_ACQUIRE, "agent"); asm volatile("s_waitcnt vmcnt(0)" ::: "memory"); }
    __syncthreads();
}

struct Frame {
    LAS unsigned char* lds; unsigned* ctl; unsigned char* ws;
    int tid, lane, wave, vcu, G, gw, ngw;
};
__device__ const float ROPE_INV[16] = {1.0f, 0.5623413251903491f, 0.31622776601683794f, 0.1778279410038923f, 0.1f, 0.05623413251903491f, 0.03162277660168379f, 0.01778279410038923f,
                                       0.01f, 0.005623413251903491f, 0.0031622776601683794f, 0.001778279410038923f, 0.001f, 0.0005623413251903491f, 0.00031622776601683794f, 0.0001778279410038923f};

__device__ __forceinline__ void p0_transpose_item(const float* W, int K, int N, bf16* WT, LAS float* scr, int item, int lane) {
    const int nblk = N / 32, kb = item / nblk, nb = item % nblk, k0 = 64 * kb, n0 = 32 * nb;
#pragma unroll 8
    for (int i = 0; i < 32; ++i) { const int kk = 2 * i + (lane >> 5); scr[kk * 33 + (lane & 31)] = W[(size_t)(k0 + kk) * N + n0 + (lane & 31)]; }
    LDS_WAIT(); asm volatile("" ::: "memory");
    const int c = lane & 7;
#pragma unroll
    for (int j = 0; j < 4; ++j) { const int n = (lane >> 3) + 8 * j; const LAS float* s = scr + (8 * c) * 33 + n;
        v4u o; o.x = pk2(s[0 * 33], s[1 * 33]); o.y = pk2(s[2 * 33], s[3 * 33]); o.z = pk2(s[4 * 33], s[5 * 33]); o.w = pk2(s[6 * 33], s[7 * 33]);
        *(GAS v4u*)(WT + (size_t)(n0 + n) * K + k0 + 8 * c) = o; }
    LDS_WAIT(); asm volatile("" ::: "memory");
}

__device__ __forceinline__ void p0_transpose_item_f8(const float* W, int K, int N, unsigned char* WT, LAS float* scr, int item, int lane) {
    const int nblk = N / 32, kb = item / nblk, nb = item % nblk, k0 = 64 * kb, n0 = 32 * nb;
#pragma unroll 8
    for (int i = 0; i < 32; ++i) { const int kk = 2 * i + (lane >> 5); scr[kk * 33 + (lane & 31)] = W[(size_t)(k0 + kk) * N + n0 + (lane & 31)]; }
    LDS_WAIT(); asm volatile("" ::: "memory");
    const int c = lane & 7;
#pragma unroll
    for (int j = 0; j < 4; ++j) { const int n = (lane >> 3) + 8 * j; const LAS float* s = scr + (8 * c) * 33 + n;
        v2u o; o.x = pg8::pack4_fp8(s[0 * 33] * pg8::F8_SW, s[1 * 33] * pg8::F8_SW, s[2 * 33] * pg8::F8_SW, s[3 * 33] * pg8::F8_SW);
        o.y = pg8::pack4_fp8(s[4 * 33] * pg8::F8_SW, s[5 * 33] * pg8::F8_SW, s[6 * 33] * pg8::F8_SW, s[7 * 33] * pg8::F8_SW);
        *(GAS v2u*)(WT + (size_t)(n0 + n) * K + k0 + 8 * c) = o; }
    LDS_WAIT(); asm volatile("" ::: "memory");
}

__device__ __forceinline__ void ph_prologue_a(const Frame& F, const float* c, const float* cctx, const float* w_mod, const float* b_mod, const float* w_in, const float* w_out,
                                              const float* moe_w1, const float* moe_w2, const float* hy_w1, const float* hy_b1, const float* hy_w2, const float* hy_b2, const float* hy_freq, const float* lru_gw, const float* lru_lam) {
    {
        LAS float* scr = (LAS float*)(F.lds + F.wave * 16384);
        constexpr int I_IN = 2 * 1024, I_OUT = 2 * 512, I_W1 = 64 * 1024, I_W2 = 64 * 512, NIT = I_IN + I_OUT + I_W1 + I_W2;
        bf16* WinT = (bf16*)(F.ws + WS_WINT); bf16* WoutT = (bf16*)(F.ws + WS_WOUTT); bf16* W1T = (bf16*)(F.ws + WS_W1T); bf16* W2T = (bf16*)(F.ws + WS_W2T);
        for (int it = F.gw; it < NIT; it += F.ngw) {
            int r = it;
            if (r < I_IN) { const int m = r >> 10; p0_transpose_item(w_in + (size_t)m * 1024 * 2048, 1024, 2048, WinT + (size_t)m * 2048 * 1024, scr, r & 1023, F.lane); continue; } r -= I_IN;
            if (r < I_OUT) { const int m = r >> 9; p0_transpose_item(w_out + (size_t)m * 1024 * 1024, 1024, 1024, WoutT + (size_t)m * 1024 * 1024, scr, r & 511, F.lane); continue; } r -= I_OUT;
#if MOE_FP8
            if (r < I_W1) { const int m = r >> 10; p0_transpose_item_f8(moe_w1 + (size_t)m * 1024 * 2048, 1024, 2048, (unsigned char*)W1T + (size_t)m * 2048 * 1024, scr, r & 1023, F.lane); continue; } r -= I_W1;
            { const int m = r >> 9; p0_transpose_item_f8(moe_w2 + (size_t)m * 1024 * 1024, 1024, 1024, (unsigned char*)W2T + (size_t)m * 1024 * 1024, scr, r & 511, F.lane); }
#else
            if (r < I_W1) { const int m = r >> 10; p0_transpose_item(moe_w1 + (size_t)m * 1024 * 2048, 1024, 2048, W1T + (size_t)m * 2048 * 1024, scr, r & 1023, F.lane); continue; } r -= I_W1;
            { const int m = r >> 9; p0_transpose_item(moe_w2 + (size_t)m * 1024 * 1024, 1024, 1024, W2T + (size_t)m * 1024 * 1024, scr, r & 511, F.lane); }
#endif
        }
    }
    __syncthreads();
    {
        LAS float* sl = (LAS float*)(F.lds);
        LAS float* red = (LAS float*)(F.lds + 20480);
        float* MOD = (float*)(F.ws + WS_MOD);
        if ((int)blockIdx.x < 192) {
            for (int i = F.tid; i < 5 * 1024; i += NTHR) { const int r = i >> 10, k = i & 1023; const float v = (r < 4) ? c[r * 1024 + k] : cctx[k]; sl[i] = v / (1.0f + __expf(-v)); }
        }
        __syncthreads();
        for (int it = blockIdx.x; it < 192; it += F.G) {
            const int l = it / 96, n = (it % 96) * 64 + F.lane;
            float a0 = 0.f, a1 = 0.f, a2 = 0.f, a3 = 0.f, a4 = 0.f;
            const float* wp = w_mod + ((size_t)l * 1024 + F.wave * 128) * 6144 + n;
#pragma unroll 8
            for (int k = 0; k < 128; ++k) { const float w = wp[(size_t)k * 6144]; const int kk = F.wave * 128 + k;
                a0 += sl[kk] * w; a1 += sl[1024 + kk] * w; a2 += sl[2048 + kk] * w; a3 += sl[3072 + kk] * w; a4 += sl[4096 + kk] * w; }
            red[(F.wave * 5 + 0) * 64 + F.lane] = a0; red[(F.wave * 5 + 1) * 64 + F.lane] = a1; red[(F.wave * 5 + 2) * 64 + F.lane] = a2; red[(F.wave * 5 + 3) * 64 + F.lane] = a3; red[(F.wave * 5 + 4) * 64 + F.lane] = a4;
            __syncthreads();
            if (F.tid < 320) { const int r = F.tid >> 6, ln = F.tid & 63; float s = 0.f;
#pragma unroll
                for (int w = 0; w < 8; ++w) s += red[(w * 5 + r) * 64 + ln];
                const int nn = (it % 96) * 64 + ln; MOD[(size_t)(l * 5 + r) * 6144 + nn] = s + b_mod[l * 6144 + nn]; }
            __syncthreads();
        }
    }
    {
        bf16* WGT = (bf16*)(F.ws + WS_WGT); float* SPT = (float*)(F.ws + WS_SPT);
        for (int idx = blockIdx.x * NTHR + F.tid; idx < 2 * 1024 * 256; idx += F.G * NTHR) {
            const int l = idx >> 18, nidx = (idx >> 8) & 1023, k = idx & 255;
            const int pn = nidx >> 8, j = (nidx >> 7) & 1, cc = nidx & 127, d = pn >> 1, ch = 128 * (pn & 1) + cc, n = ch >> 6, e = ch & 63;
            const float v = ((k >> 6) == n) ? lru_gw[((size_t)((((l * 2 + d) * 2 + j) * 4 + n) * 64 + (k & 63))) * 64 + e] : 0.f;
            WGT[idx] = (bf16)f2bf(v); }
        for (int idx = blockIdx.x * NTHR + F.tid; idx < 2 * 2 * 256; idx += F.G * NTHR) SPT[idx] = log1pf(expf(-lru_lam[idx]));
    }
    {
        float* RC = (float*)(F.ws + WS_ROPEC); float* RS = (float*)(F.ws + WS_ROPES);
        for (int idx = blockIdx.x * NTHR + F.tid; idx < SEQ * 32; idx += F.G * NTHR) {
            const int t = idx >> 5, i = idx & 31; const int pos = (i < 16) ? (t >> 6) : (t & 63);
            const float ang = (float)pos * ROPE_INV[i & 15];
            double s, cc; sincos_d((double)ang, s, cc); RC[idx] = (float)cc; RS[idx] = (float)s; }
    }
    {
        float* H2 = (float*)(F.ws + WS_H2);
        for (int it = F.gw; it < 2 * SEQ + CTXL; it += F.ngw) {
            const int v = it >> 13, t = (v < 2) ? (it & (SEQ - 1)) : (it - 2 * SEQ), L = (v < 2) ? SEQ : CTXL, l = (v == 1) ? 1 : 0;
            const int j = F.lane;
            float z = 0.f;
            if (j == 0) z = (float)t / (float)(L - 1);
            else if (j <= 32) { const int b = (j - 1) & 15; const float band = 1e-4f + (float)b * ((15.0f - 1e-4f) / 15.0f);
                const float ang = ((6.283185307179586f / (float)L) * (float)t) * band;
                double s, cc; sincos_d((double)ang, s, cc); z = (j <= 16) ? (float)cc : -(float)s; }
            const float fr = hy_freq[l * 64 + j];
            float p1 = hy_b1[l * 64 + j];
            const float* w1 = hy_w1 + (size_t)l * 33 * 64;
#pragma unroll
            for (int i = 0; i < 33; ++i) p1 += __shfl(z, i) * w1[i * 64 + j];
            double s1, c1; sincos_d((double)(fr * p1), s1, c1); const float h1 = (float)s1;
            float p2 = hy_b2[l * 64 + j];
            const float* w2 = hy_w2 + (size_t)l * 64 * 64;
#pragma unroll 16
            for (int i = 0; i < 64; ++i) p2 += __shfl(h1, i) * w2[i * 64 + j];
            double s2, c2; sincos_d((double)(fr * p2), s2, c2);
            H2[((size_t)v * SEQ + t) * 64 + j] = (float)s2;
        }
    }
}

__device__ __forceinline__ void ph_prologue_b(const Frame& F, const float* hy_w3, const float* hy_decay, const float* gffn, const float* router_w, const float* router_b) {
    { const float* MOD = (const float*)(F.ws + WS_MOD); float* CB = (float*)(F.ws + WS_CB);
      for (int it = F.gw; it < 2 * 5 * 32; it += F.ngw) { const int lb = it >> 5, e = it & 31, l = lb / 5; const float* sf = MOD + (size_t)lb * 6144 + 3 * 1024; float s = 0.f;
#pragma unroll
          for (int q = 0; q < 16; ++q) { const int cc = 64 * q + F.lane; s += sf[cc] * router_w[(size_t)l * 32768 + cc * 32 + e]; }
          s = wave_sum(s); if (F.lane == 0) CB[it] = s + router_b[l * 32 + e]; } }
    { const float* MOD = (const float*)(F.ws + WS_MOD); float* GC = (float*)(F.ws + WS_GC);
      for (int idx = blockIdx.x * NTHR + F.tid; idx < 2 * 5 * 1024; idx += F.G * NTHR) { const int lb = idx >> 10, cc = idx & 1023, l = lb / 5; GC[idx] = gffn[l * 1024 + cc] * (1.0f + MOD[(size_t)lb * 6144 + 4 * 1024 + cc]); } }
    LAS f32x2v* D = (LAS f32x2v*)(F.lds);
    LAS float* kt = (LAS float*)(F.lds);
    LAS float* w3c = (LAS float*)(F.lds + 139264);
    LAS float* red = (LAS float*)(F.lds + 139264 + 512);
    const float* H2 = (const float*)(F.ws + WS_H2);
    c32* KHAT = (c32*)(F.ws + WS_KHAT); float* KFC = (float*)(F.ws + WS_KFC);
    for (int it = blockIdx.x; it < 768; it += F.G) {
        const int v = it >> 8, c = it & 255, L = (v < 2) ? SEQ : CTXL, l = (v == 1) ? 1 : 0;
        if (F.tid < 128) w3c[F.tid] = hy_w3[(size_t)l * 64 * 512 + (F.tid & 63) * 512 + (F.tid >> 6) * 256 + c];
        if (F.tid == 0) { if (v < 2) { f32x2v z; z.x = 0.f; z.y = 0.f; D[fpad(L)] = z; } else kt[L] = 0.f; }
        __syncthreads();
        const float df = fabsf(hy_decay[l * 512 + c]), db = fabsf(hy_decay[l * 512 + 256 + c]);
        float asum = 0.f;
        for (int t = F.tid; t < L; t += NTHR) {
            const f32x4* row = (const f32x4*)(H2 + ((size_t)v * SEQ + t) * 64);
            float hf = 0.f, hb = 0.f;
#pragma unroll
            for (int q = 0; q < 16; ++q) { const f32x4 h = row[q];
                hf += h.x * w3c[4 * q] + h.y * w3c[4 * q + 1] + h.z * w3c[4 * q + 2] + h.w * w3c[4 * q + 3];
                hb += h.x * w3c[64 + 4 * q] + h.y * w3c[64 + 4 * q + 1] + h.z * w3c[64 + 4 * q + 2] + h.w * w3c[64 + 4 * q + 3]; }
            const float t01 = (float)t / (float)(L - 1);
            hf *= expf(-t01 * df); hb *= expf(-t01 * db);
            asum += fabsf(hf); if (t >= 1) asum += fabsf(hb);
            if (v < 2) { f32x2v z; z.x = hf; z.y = 0.f; D[fpad(t)] = z; if (t >= 1) { z.x = hb; D[fpad(2 * L - t)] = z; } }
            else { kt[t] = hf; if (t >= 1) kt[2 * L - t] = hb; }
        }
        asum = wave_sum(asum);
        if (F.lane == 0) red[F.wave] = asum;
        __syncthreads();
        float tot = 0.f;
#pragma unroll
        for (int w = 0; w < 8; ++w) tot += red[w];
        const float inv = 1.0f / tot;
        if (v < 2) {
            c32* out = KHAT + (size_t)(v * 256 + c) * 16384;
#pragma unroll 1
            for (int i = 0; i < 8; ++i) fft_first4_inplace(D, F.tid + 512 * i);
            __syncthreads();
            { fft_fwd16(D, F.tid, 4096); fft_fwd16(D, F.tid + 512, 4096); }
            __syncthreads();
            { fft_fwd16(D, F.tid, 256); fft_fwd16(D, F.tid + 512, 256); }
            __syncthreads();
            _Pragma("unroll 1") for (int g_ = F.tid; g_ < 1024; g_ += 512) fft_last16_out(D, g_, out, inv * (1.0f / 16384.0f));
        } else {
            float* dst = KFC + (size_t)c * 512;
            for (int j = F.tid; j < 2 * L; j += NTHR) dst[j] = kt[j] * inv;
        }
        __syncthreads();
    }
}

__device__ __forceinline__ void ph_norm_mod(const Frame& F, int l, const float* x, const float* ctx, const float* gmix) {
    const float* XR = (const float*)(F.ws + WS_XR); const float* MOD = (const float*)(F.ws + WS_MOD); bf16* H = (bf16*)(F.ws + WS_H);
    for (int r = F.gw; r < MT; r += F.ngw) {
        const float* src = (l == 0) ? (r < NLAT ? x + (size_t)r * 1024 : ctx + (size_t)(r - NLAT) * 1024) : XR + (size_t)r * 1024;
        const int bidx = r < NLAT ? r / SEQ : 4;
        const float* shift = MOD + (size_t)(l * 5 + bidx) * 6144; const float* scale = shift + 1024; const float* g = gmix + l * 1024;
        f32x4 v[4]; float ss = 0.f;
#pragma unroll
        for (int j = 0; j < 4; ++j) { v[j] = ((const f32x4*)src)[64 * j + F.lane]; ss += (v[j].x * v[j].x + v[j].y * v[j].y) + (v[j].z * v[j].z + v[j].w * v[j].w); }
        const float rstd = 1.0f / sqrtf(wave_sum(ss) * (1.0f / 1024.0f) + EPSN);
#pragma unroll
        for (int j = 0; j < 4; ++j) { const int cb = 64 * j + F.lane; const f32x4 gg = ((const f32x4*)g)[cb], sc = ((const f32x4*)scale)[cb], sh = ((const f32x4*)shift)[cb];
            const f32x4 y = v[j] * rstd * gg * (sc + 1.0f) + sh;
            v2u o; o.x = pk2(y.x, y.y); o.y = pk2(y.z, y.w); ((v2u*)(H + (size_t)r * 1024))[cb] = o; }
    }
}

__device__ __forceinline__ void post_ab(const Frame& F, int l, int rbeg, int rend, int w0, int nw, const float* kg_, const float* lru_cw, const float* lru_cb) {
    const bf16* U = (const bf16*)(F.ws + WS_U);
    {
        bf16* K = (bf16*)(F.ws + WS_K); bf16* V = (bf16*)(F.ws + WS_V);
        const float* RC = (const float*)(F.ws + WS_ROPEC); const float* RS = (const float*)(F.ws + WS_ROPES);
        const int o8 = 8 * (F.lane & 7), hl = F.lane & 31;
        const f32x4 kg0 = *(const f32x4*)(kg_ + l * 64 + o8), kg1 = *(const f32x4*)(kg_ + l * 64 + o8 + 4);
        const bool lohalf = (F.lane & 4) == 0;
        for (int r2 = rbeg + 2 * w0; r2 < rend; r2 += 2 * nw) {
            const int r = r2 + (F.lane >> 5);
            const bool isctx = r >= NLAT; const int b = isctx ? (r - NLAT) / CTXL : r / SEQ; const int t = isctx ? (r - NLAT) % CTXL : r % SEQ;
            const v4u wk = ((const v4u*)(U + (size_t)r * INW + 512))[hl];
            f32x4 c0 = {1.f, 1.f, 1.f, 1.f}, c1 = c0, s0 = {0.f, 0.f, 0.f, 0.f}, s1 = s0;
            if (!isctx) { const float* rc = RC + t * 32 + 8 * (F.lane & 3); const float* rs = RS + t * 32 + 8 * (F.lane & 3);
                c0 = *(const f32x4*)rc; c1 = *(const f32x4*)(rc + 4); s0 = *(const f32x4*)rs; s1 = *(const f32x4*)(rs + 4); }
            const size_t krow = (size_t)b * KEYS + (isctx ? t : CTXL + t);
            float x[8] = {bflo(wk.x), bfhi(wk.x), bflo(wk.y), bfhi(wk.y), bflo(wk.z), bfhi(wk.z), bflo(wk.w), bfhi(wk.w)};
            float ss = 0.f;
#pragma unroll
            for (int i = 0; i < 8; ++i) ss += x[i] * x[i];
            ss += __shfl_xor(ss, 1); ss += __shfl_xor(ss, 2); ss += __shfl_xor(ss, 4);
            const float rstd = 1.0f / sqrtf(ss * (1.0f / 64.0f) + EPSN);
            float y[8], o[8];
#pragma unroll
            for (int i = 0; i < 8; ++i) y[i] = x[i] * rstd * (i < 4 ? kg0[i] : kg1[i - 4]);
#pragma unroll
            for (int i = 0; i < 8; ++i) { const float p = __shfl_xor(y[i], 4); const float cs = i < 4 ? c0[i] : c1[i - 4], sn = i < 4 ? s0[i] : s1[i - 4];
                o[i] = lohalf ? (y[i] * cs - p * sn) : (y[i] * cs + p * sn); }
            v4u ow; ow.x = pk2(o[0], o[1]); ow.y = pk2(o[2], o[3]); ow.z = pk2(o[4], o[5]); ow.w = pk2(o[6], o[7]);
            if (hl < 16) ((v4u*)(K + krow * 128))[hl] = ow; else ((v4u*)(V + krow * 128))[hl - 16] = wk;
        }
    }
    {
        bf16* XL = (bf16*)(F.ws + WS_XL);
        for (int idx = rbeg * 32 + w0 * 64 + F.lane; idx < rend * 32; idx += nw * 64) {
            const int r = idx >> 5, c8 = (idx & 31) * 8;
            const bool isctx = r >= NLAT; const int Ls = isctx ? CTXL : SEQ; const int t = isctx ? (r - NLAT) % CTXL : r % SEQ;
            float acc[8];
#pragma unroll
            for (int i = 0; i < 8; ++i) acc[i] = lru_cb[l * 256 + c8 + i];
#pragma unroll
            for (int j = 0; j < 4; ++j) { const int tj = t + j - 2;
                if (tj >= 0 && tj < Ls) { const v4u w = *(const v4u*)(U + (size_t)(r + j - 2) * INW + 768 + c8);
                    const f32x4 w0 = *(const f32x4*)(lru_cw + (l * 4 + j) * 256 + c8), w1 = *(const f32x4*)(lru_cw + (l * 4 + j) * 256 + c8 + 4);
                    acc[0] += w0.x * bflo(w.x); acc[1] += w0.y * bfhi(w.x); acc[2] += w0.z * bflo(w.y); acc[3] += w0.w * bfhi(w.y);
                    acc[4] += w1.x * bflo(w.z); acc[5] += w1.y * bfhi(w.z); acc[6] += w1.z * bflo(w.w); acc[7] += w1.w * bfhi(w.w); } }
            v4u o; o.x = pk2(acc[0], acc[1]); o.y = pk2(acc[2], acc[3]); o.z = pk2(acc[4], acc[5]); o.w = pk2(acc[6], acc[7]);
            *(v4u*)(XL + (size_t)r * 256 + c8) = o;
        }
    }
}
__device__ __forceinline__ void post_c(const Frame& F, int l, const float* hy_cw, const float* hy_cb) {
    const bf16* U = (const bf16*)(F.ws + WS_U);
    __syncthreads();
    {
        LAS bf16* hs = (LAS bf16*)(F.lds);
        bf16* VT = (bf16*)(F.ws + WS_VT); bf16* X0T = (bf16*)(F.ws + WS_X0T);
        const float* cw = hy_cw + (size_t)l * 3 * 768; const float* cbp = hy_cb + l * 768;
        for (int it = blockIdx.x; it < NLAT / 64; it += F.G) {
            const int b = it >> 7, t0 = (it & 127) * 64;
            for (int i = F.tid; i < 66 * 384; i += NTHR) { const int rr = i / 384, c2 = i - rr * 384; const int t = t0 - 1 + rr;
                unsigned w = 0u; if (t >= 0 && t < SEQ) w = *(const unsigned*)(U + (size_t)(b * SEQ + t) * INW + 1280 + 2 * c2);
                *(LAS unsigned*)(hs + rr * 770 + 2 * c2) = w; }
            __syncthreads();
            for (int c = F.wave; c < 256; c += NWAVES) {
                const int tt = F.lane;
                float o[3];
#pragma unroll
                for (int g = 0; g < 3; ++g) { const int cc = g * 256 + c;
                    o[g] = cw[cc] * bf2f(hs[tt * 770 + cc]) + cw[768 + cc] * bf2f(hs[(tt + 1) * 770 + cc]) + cw[1536 + cc] * bf2f(hs[(tt + 2) * 770 + cc]) + cbp[cc]; }
                const size_t oi = ((size_t)b * 256 + c) * SEQ + t0 + tt;
                VT[oi] = (bf16)f2bf(o[2] * o[1]); X0T[oi] = (bf16)f2bf(o[0]);
            }
            __syncthreads();
        }
    }
}


typedef short sk_s16x8 __attribute__((ext_vector_type(8)));
__device__ __forceinline__ void ph_lru_gates(const Frame& F, int l, const float* lru_gb, int rt0, int nrt, int w0, int nw) {
    const bf16* XL = (const bf16*)(F.ws + WS_XL); const bf16* WG = (const bf16*)(F.ws + WS_WGT) + (size_t)l * 1024 * 256; bf16* LAB = (bf16*)(F.ws + WS_LAB);
    const float* gb = lru_gb + (size_t)l * 1024; const float* spt = (const float*)(F.ws + WS_SPT) + l * 512;
    const int fr = F.lane & 15, fq = F.lane >> 4;
    for (int it = w0; it < nrt * 8; it += nw) {
        const int rt = rt0 + (it >> 3), n = (it >> 1) & 3, d = it & 1, row0 = 32 * rt;
        const int wrow = ((2 * d + (n >> 1)) * 256 + 64 * (n & 1) + fr) * 256 + 64 * n + 8 * fq;
        const bf16* ap = XL + (size_t)(row0 + fr) * 256 + 64 * n + 8 * fq;
        const bf16* xp = XL + (size_t)(row0 + fr) * 256 + 64 * n + 4 * fq;
        sk_s16x8 a[2][2]; v2u xw[2][4];
#pragma unroll
        for (int ri = 0; ri < 2; ++ri) { a[ri][0] = *(const sk_s16x8*)(ap + ri * 16 * 256); a[ri][1] = *(const sk_s16x8*)(ap + ri * 16 * 256 + 32);
#pragma unroll
            for (int c = 0; c < 4; ++c) xw[ri][c] = *(const v2u*)(xp + ri * 16 * 256 + 16 * c); }
        f32x4 acc[2][4][2];
#pragma unroll
        for (int c = 0; c < 4; ++c)
#pragma unroll
            for (int g = 0; g < 2; ++g) { const bf16* bp = WG + wrow + (g * 128 + 16 * c) * 256;
                const sk_s16x8 b0 = *(const sk_s16x8*)bp, b1 = *(const sk_s16x8*)(bp + 32);
#pragma unroll
                for (int ri = 0; ri < 2; ++ri) { f32x4 z = {0.f, 0.f, 0.f, 0.f};
                    z = __builtin_amdgcn_mfma_f32_16x16x32_bf16(b0, a[ri][0], z, 0, 0, 0); acc[ri][c][g] = __builtin_amdgcn_mfma_f32_16x16x32_bf16(b1, a[ri][1], z, 0, 0, 0); } }
        bf16* LA = LAB + (size_t)(2 * d) * LAB_STRIDE; bf16* LB = LAB + (size_t)(2 * d + 1) * LAB_STRIDE;
#pragma unroll
        for (int c = 0; c < 4; ++c) { const int ch = 64 * n + 16 * c + 4 * fq;
            const f32x4 bR = *(const f32x4*)(gb + (d * 2 + 0) * 256 + ch), bI = *(const f32x4*)(gb + (d * 2 + 1) * 256 + ch);
            const f32x4 sp = *(const f32x4*)(spt + d * 256 + ch) * (-8.0f * 1.4426950408889634f);
#pragma unroll
            for (int ri = 0; ri < 2; ++ri) { const size_t ro = (size_t)(row0 + 16 * ri + fr) * 256 + ch;
                const float xl[4] = {bflo(xw[ri][c].x), bfhi(xw[ri][c].x), bflo(xw[ri][c].y), bfhi(xw[ri][c].y)};
                const f32x4 gr = acc[ri][c][0] + bR, gi = acc[ri][c][1] + bI; float av[4], bv[4];
#pragma unroll
                for (int e = 0; e < 4; ++e) {
                    const float rg = __builtin_amdgcn_rcpf(1.0f + __builtin_amdgcn_exp2f(-1.4426950408889634f * gr[e])), ig = __builtin_amdgcn_rcpf(1.0f + __builtin_amdgcn_exp2f(-1.4426950408889634f * gi[e]));
                    const float la2 = rg * sp[e]; const float a2 = __builtin_amdgcn_exp2f(2.0f * la2);
                    av[e] = la2; bv[e] = __builtin_amdgcn_sqrtf(fmaxf(1.0f - a2, 0.f)) * (ig * xl[e]); }
                v2u wa, wb; wa.x = pk2(av[0], av[1]); wa.y = pk2(av[2], av[3]); wb.x = pk2(bv[0], bv[1]); wb.y = pk2(bv[2], bv[3]);
                *(v2u*)(LA + ro) = wa; *(v2u*)(LB + ro) = wb; } }
    }
}

__device__ __forceinline__ int chunk_row0(int b, int d, int k) {
    if (k < 2) { const int cc = d ? 1 - k : k; return NLAT + b * CTXL + cc * CHUNK; }
    const int lc = d ? 63 - (k - 2) : (k - 2); return b * SEQ + lc * CHUNK;
}
template <bool TWO> __device__ __forceinline__ void scan1_items(const bf16* LAB, float* SUMP, float* SUMH, int it0, int it1) {
    const bf16* LA[2]; const bf16* LB[2]; int r0[2], dd[2];
#pragma unroll
    for (int q = 0; q < (TWO ? 2 : 1); ++q) { const int it = q ? it1 : it0;
        const int ch = it & 255, k = (it >> 8) % NCHUNK, bd = (it >> 8) / NCHUNK, d = bd & 1, b = bd >> 1;
        r0[q] = chunk_row0(b, d, k); dd[q] = d;
        LA[q] = LAB + (size_t)(2 * d) * LAB_STRIDE + ch; LB[q] = LAB + (size_t)(2 * d + 1) * LAB_STRIDE + ch; }
    float h[2] = {0.f, 0.f}, Ps[2] = {0.f, 0.f};
#pragma unroll 16
    for (int i = 0; i < CHUNK; ++i) {
#pragma unroll
        for (int q = 0; q < (TWO ? 2 : 1); ++q) { const int r = dd[q] ? r0[q] + CHUNK - 1 - i : r0[q] + i; const float la = bf2f(LA[q][(size_t)r * 256]), bx = bf2f(LB[q][(size_t)r * 256]); h[q] = __builtin_amdgcn_exp2f(la) * h[q] + bx; Ps[q] += la; } }
    SUMP[it0] = __builtin_amdgcn_exp2f(Ps[0]); SUMH[it0] = h[0];
    if (TWO) { SUMP[it1] = __builtin_amdgcn_exp2f(Ps[1]); SUMH[it1] = h[1]; }
}
__device__ __forceinline__ void ph_scan1(const Frame& F) {
    const bf16* LAB = (const bf16*)(F.ws + WS_LAB); float* SUMP = (float*)(F.ws + WS_SCANS); float* SUMH = SUMP + NB * 2 * NCHUNK * 256;
    const int total = NB * 2 * NCHUNK * 256, nthr = F.G * NTHR;
    for (int it = blockIdx.x * NTHR + F.tid; it < total; it += 2 * nthr) {
        if (it + nthr < total) scan1_items<true>(LAB, SUMP, SUMH, it, it + nthr); else scan1_items<false>(LAB, SUMP, SUMH, it, it);
    }
}
__device__ __forceinline__ void ph_scan2(const Frame& F) {
    const bf16* LAB = (const bf16*)(F.ws + WS_LAB); const float* SUMP = (const float*)(F.ws + WS_SCANS); const float* SUMH = SUMP + NB * 2 * NCHUNK * 256;
    float* LRUO = (float*)(F.ws + WS_LRUO); const bf16* U = (const bf16*)(F.ws + WS_U);
    for (int it = blockIdx.x * NTHR + F.tid; it < NB * NCHUNK * 256; it += F.G * NTHR) {
        const int ch = it & 255, kc = (it >> 8) % NCHUNK, b = (it >> 8) / NCHUNK;
        const int r0 = chunk_row0(b, 0, kc);
#pragma unroll 1
        for (int d = 0; d < 2; ++d) {
            const int k = d ? ((kc < 2) ? 1 - kc : 2 + 63 - (kc - 2)) : kc;
            const size_t sb = (size_t)((b * 2 + d) * NCHUNK) * 256 + ch;
            float h = 0.f;
#pragma unroll 8
            for (int j = 0; j < k; ++j) h = SUMP[sb + (size_t)j * 256] * h + SUMH[sb + (size_t)j * 256];
            const bf16* LA = LAB + (size_t)(2 * d) * LAB_STRIDE + ch; const bf16* LB = LAB + (size_t)(2 * d + 1) * LAB_STRIDE + ch;
            if (d == 0) {
#pragma unroll 16
                for (int i = 0; i < CHUNK; ++i) { const int r = r0 + i; h = __builtin_amdgcn_exp2f(bf2f(LA[(size_t)r * 256])) * h + bf2f(LB[(size_t)r * 256]); LRUO[(size_t)r * 256 + ch] = h; }
            } else {
#pragma unroll 8
                for (int i = 0; i < CHUNK; ++i) { const int r = r0 + CHUNK - 1 - i; h = __builtin_amdgcn_exp2f(bf2f(LA[(size_t)r * 256])) * h + bf2f(LB[(size_t)r * 256]);
                    const float lg = bf2f(U[(size_t)r * INW + 1024 + ch]);
                    LRUO[(size_t)r * 256 + ch] = (LRUO[(size_t)r * 256 + ch] + h) * gelu_tanh(lg); }
            }
        }
    }
}

__device__ __forceinline__ void ph_hyena_fft(const Frame& F, int l, const float* hy_bias) {
    LAS f32x2v* D = (LAS f32x2v*)(F.lds);
    const c32* KHAT = (const c32*)(F.ws + WS_KHAT) + (size_t)l * 256 * 16384;
    const bf16* VT = (const bf16*)(F.ws + WS_VT); const bf16* X0T = (const bf16*)(F.ws + WS_X0T); bf16* HYO = (bf16*)(F.ws + WS_HYO);
    for (int it = blockIdx.x; it < 512; it += F.G) {
        const int c = it >> 1, bp = it & 1;
        const bf16* va = VT + ((size_t)(bp * 2) * 256 + c) * SEQ; const bf16* vb = VT + ((size_t)(bp * 2 + 1) * 256 + c) * SEQ;
#ifndef REP_FFT
#define REP_FFT 1
#endif
#pragma unroll 1
        for (int repf_ = 0; repf_ < REP_FFT; ++repf_) {
#pragma unroll 1
        for (int i = 0; i < 8; ++i) { const int j = F.tid + 512 * i; c32 x0, x1, z; x0.x = bf2f(va[j]); x0.y = bf2f(vb[j]); x1.x = bf2f(va[j + 4096]); x1.y = bf2f(vb[j + 4096]); z.x = 0.f; z.y = 0.f;
            fft_first4(D, j, x0, x1, z, z); }
        __syncthreads();
        { fft_fwd16(D, F.tid, 4096); fft_fwd16(D, F.tid + 512, 4096); }
        __syncthreads();
        { fft_fwd16(D, F.tid, 256); fft_fwd16(D, F.tid + 512, 256); }
        __syncthreads();
        _Pragma("unroll 1") for (int g_ = F.tid; g_ < 1024; g_ += 512) fft_mid16(D, g_, KHAT + (size_t)c * 16384);
        __syncthreads();
        { fft_inv16(D, F.tid, 256); fft_inv16(D, F.tid + 512, 256); }
        __syncthreads();
        { fft_inv16(D, F.tid, 4096); fft_inv16(D, F.tid + 512, 4096); }
        __syncthreads();
        }
        const float bias = hy_bias[l * 256 + c];
        const bf16* xa = X0T + ((size_t)(bp * 2) * 256 + c) * SEQ; const bf16* xb = X0T + ((size_t)(bp * 2 + 1) * 256 + c) * SEQ;
        bf16* oa = HYO + ((size_t)(bp * 2) * 256 + c) * SEQ; bf16* ob = HYO + ((size_t)(bp * 2 + 1) * 256 + c) * SEQ;
#pragma unroll 2
        for (int i = 0; i < 8; ++i) { const int j = F.tid + 512 * i; c32 u0, u1; fft_final4(D, j, u0, u1);
            oa[j] = (bf16)f2bf((u0.x + bf2f(va[j]) * bias) * bf2f(xa[j]));                 ob[j] = (bf16)f2bf((-u0.y + bf2f(vb[j]) * bias) * bf2f(xb[j]));
            oa[j + 4096] = (bf16)f2bf((u1.x + bf2f(va[j + 4096]) * bias) * bf2f(xa[j + 4096])); ob[j + 4096] = (bf16)f2bf((-u1.y + bf2f(vb[j + 4096]) * bias) * bf2f(xb[j + 4096])); }
        __syncthreads();
    }
}
__device__ __forceinline__ void ph_hyena_ctx(const Frame& F, const float* hy_bias, const float* hy_cw, const float* hy_cb) {
    float* HYO = (float*)(F.ws + WS_HYO);
    {

        const bf16* U = (const bf16*)(F.ws + WS_U); const float* KFC = (const float*)(F.ws + WS_KFC);
        LAS float* vw = (LAS float*)(F.lds + F.wave * 4096);
        LAS float* kw = vw + 256;
        const float* cw = hy_cw; const float* cbp = hy_cb;
        for (int it = F.gw; it < NB * 256; it += F.ngw) {
            const int b = it >> 8, c = it & 255;
            float x0v[4];
#pragma unroll
            for (int i = 0; i < 4; ++i) { const int t = F.lane + 64 * i;
                float o[3];
#pragma unroll
                for (int g = 0; g < 3; ++g) { const int cc = g * 256 + c; float a = cbp[cc];
#pragma unroll
                    for (int j = 0; j < 3; ++j) { const int tj = t + j - 1; if (tj >= 0 && tj < CTXL) a += cw[j * 768 + cc] * bf2f(U[(size_t)(NLAT + b * CTXL + tj) * INW + 1280 + cc]); }
                    o[g] = a; }
                vw[t] = o[2] * o[1]; x0v[i] = o[0]; }
#pragma unroll
            for (int i = 0; i < 8; ++i) kw[F.lane + 64 * i] = KFC[c * 512 + F.lane + 64 * i];
            LDS_WAIT();
            float y[4] = {0.f, 0.f, 0.f, 0.f};
#pragma unroll 4
            for (int s = 0; s < CTXL; ++s) { const float vv = vw[s];
#pragma unroll
                for (int i = 0; i < 4; ++i) y[i] += kw[(F.lane + 64 * i - s) & 511] * vv; }
            const float bias = hy_bias[c];
#pragma unroll
            for (int i = 0; i < 4; ++i) { const int t = F.lane + 64 * i; HYO[(size_t)(NLAT + b * CTXL + t) * 256 + c] = (y[i] + vw[t] * bias) * x0v[i]; }
            LDS_WAIT();
        }
    }
}

__device__ __forceinline__ void merge_row(const Frame& F, int r, const float* g, float h0, float h1, float h2, float h3) {
    const bf16* ATT = (const bf16*)(F.ws + WS_ATT); const float* LRUO = (const float*)(F.ws + WS_LRUO); bf16* MIXA = (bf16*)(F.ws + WS_MIXA);
    const v4u aw = ((const v4u*)(ATT + (size_t)r * 512))[F.lane];
    float a[8] = {bflo(aw.x), bfhi(aw.x), bflo(aw.y), bfhi(aw.y), bflo(aw.z), bfhi(aw.z), bflo(aw.w), bfhi(aw.w)};
    float ss = 0.f;
#pragma unroll
    for (int i = 0; i < 8; ++i) ss += a[i] * a[i];
    const float ra = 1.0f / sqrtf(wave_sum(ss) * (1.0f / 512.0f) + EPSN);
    const f32x4 lv = ((const f32x4*)(LRUO + (size_t)r * 256))[F.lane];
    const float rl = 1.0f / sqrtf(wave_sum(lv.x * lv.x + lv.y * lv.y + lv.z * lv.z + lv.w * lv.w) * (1.0f / 256.0f) + EPSN);
    const float rh = 1.0f / sqrtf(wave_sum(h0 * h0 + h1 * h1 + h2 * h2 + h3 * h3) * (1.0f / 256.0f) + EPSN);
    bf16* orow = MIXA + (size_t)r * 1024;
    { const f32x4 g0 = ((const f32x4*)g)[2 * F.lane], g1 = ((const f32x4*)g)[2 * F.lane + 1];
      v4u o; o.x = pk2(a[0] * ra * g0.x, a[1] * ra * g0.y); o.y = pk2(a[2] * ra * g0.z, a[3] * ra * g0.w); o.z = pk2(a[4] * ra * g1.x, a[5] * ra * g1.y); o.w = pk2(a[6] * ra * g1.z, a[7] * ra * g1.w);
      ((v4u*)orow)[F.lane] = o; }
    { const f32x4 gg = ((const f32x4*)(g + 512))[F.lane]; v2u o; o.x = pk2(lv.x * rl * gg.x, lv.y * rl * gg.y); o.y = pk2(lv.z * rl * gg.z, lv.w * rl * gg.w); ((v2u*)(orow + 512))[F.lane] = o; }
    orow[768 + F.lane] = (bf16)f2bf(h0 * rh * g[768 + F.lane]); orow[832 + F.lane] = (bf16)f2bf(h1 * rh * g[832 + F.lane]);
    orow[896 + F.lane] = (bf16)f2bf(h2 * rh * g[896 + F.lane]); orow[960 + F.lane] = (bf16)f2bf(h3 * rh * g[960 + F.lane]);
}
__device__ __forceinline__ void ph_merge(const Frame& F, int l, int nrows, const float* out_g) {
    const float* HYO = (const float*)(F.ws + WS_HYO);
    const float* g = out_g + l * 1024;
    LAS float* tile = (LAS float*)(F.lds);
    for (int it = blockIdx.x; it < NLAT / 64; it += F.G) {
        const int b = it >> 7, t0 = (it & 127) * 64;
#pragma unroll 8
        for (int i = 0; i < 32; ++i) { const int c = F.wave * 32 + i; tile[c * 65 + F.lane] = bf2f(((const bf16*)HYO)[((size_t)b * 256 + c) * SEQ + t0 + F.lane]); }
        __syncthreads();
#pragma unroll 2
        for (int k = 0; k < 8; ++k) { const int tt = F.wave * 8 + k;
            merge_row(F, b * SEQ + t0 + tt, g, tile[F.lane * 65 + tt], tile[(F.lane + 64) * 65 + tt], tile[(F.lane + 128) * 65 + tt], tile[(F.lane + 192) * 65 + tt]); }
        __syncthreads();
    }
    for (int r = NLAT + F.gw; r < nrows; r += F.ngw) {
        const float* hr = HYO + (size_t)r * 256;
        merge_row(F, r, g, hr[F.lane], hr[64 + F.lane], hr[128 + F.lane], hr[192 + F.lane]);
    }
}


constexpr int RW_PITCH = 34;
__device__ __forceinline__ void router_cols(LAS const float* rwl, const bf16* XR, const float* gc, const float* sf, unsigned char* Fbytes, int r, float rstd, int j, int kq, int i0, int i1, f32x4& acc0, f32x4& acc1) {
    const bf16* xrow = XR + (size_t)r * 1024 + 8 * kq; const float* gcp = gc + 8 * kq; const float* sfp = sf + 8 * kq;
    v4u xn[4];
#pragma unroll
    for (int u = 0; u < 4; ++u) xn[u] = *(const v4u*)(xrow + 32 * (i0 + u));
#pragma unroll 1
    for (int ib = i0; ib < i1; ib += 4) {
        v4u xw[4]; f32x4 g4[4][2], s4[4][2];
#pragma unroll
        for (int u = 0; u < 4; ++u) { xw[u] = xn[u]; g4[u][0] = *(const f32x4*)(gcp + 32 * (ib + u)); g4[u][1] = *(const f32x4*)(gcp + 32 * (ib + u) + 4); s4[u][0] = *(const f32x4*)(sfp + 32 * (ib + u)); s4[u][1] = *(const f32x4*)(sfp + 32 * (ib + u) + 4); }
        if (ib + 4 < i1) {
#pragma unroll
            for (int u = 0; u < 4; ++u) xn[u] = *(const v4u*)(xrow + 32 * (ib + 4 + u)); }
#pragma unroll
        for (int u = 0; u < 4; ++u) {
            const float x[8] = {bflo(xw[u].x), bfhi(xw[u].x), bflo(xw[u].y), bfhi(xw[u].y), bflo(xw[u].z), bfhi(xw[u].z), bflo(xw[u].w), bfhi(xw[u].w)};
            float xb[8], fv[8];
#pragma unroll
            for (int e = 0; e < 8; ++e) { xb[e] = x[e] * g4[u][e >> 2][e & 3]; fv[e] = xb[e] * rstd + s4[u][e >> 2][e & 3]; }
#if MOE_FP8
            v2u o; o.x = pg8::pack4_fp8(fv[0] * pg8::F8_SF, fv[1] * pg8::F8_SF, fv[2] * pg8::F8_SF, fv[3] * pg8::F8_SF); o.y = pg8::pack4_fp8(fv[4] * pg8::F8_SF, fv[5] * pg8::F8_SF, fv[6] * pg8::F8_SF, fv[7] * pg8::F8_SF);
            *(v2u*)(Fbytes + (size_t)r * 1024 + 8 * kq + 32 * (ib + u)) = o;
#else
            v4u o; o.x = pk2(fv[0], fv[1]); o.y = pk2(fv[2], fv[3]); o.z = pk2(fv[4], fv[5]); o.w = pk2(fv[6], fv[7]); *(v4u*)((bf16*)Fbytes + (size_t)r * 1024 + 8 * kq + 32 * (ib + u)) = o;
#endif
            const LAS float* wp = rwl + (32 * (ib + u) + 8 * kq) * RW_PITCH + j;
#pragma unroll
            for (int e = 0; e < 8; ++e) { acc0 = __builtin_amdgcn_mfma_f32_16x16x4f32(wp[e * RW_PITCH], xb[e], acc0, 0, 0, 0); acc1 = __builtin_amdgcn_mfma_f32_16x16x4f32(wp[e * RW_PITCH + 16], xb[e], acc1, 0, 0, 0); }
        }
    }
}
__device__ __forceinline__ void router_finish(LAS const float* cbl, LAS int* hist, int* TOPI, float* GATE, int r, int bidx, float rstd, int j, int kq, const f32x4& acc0, const f32x4& acc1) {
    float lg[8];
#pragma unroll
    for (int rr = 0; rr < 4; ++rr) { lg[rr] = rstd * acc0[rr] + cbl[bidx * 32 + 4 * kq + rr]; lg[4 + rr] = rstd * acc1[rr] + cbl[bidx * 32 + 16 + 4 * kq + rr]; }
    float p[32];
#pragma unroll
    for (int e = 0; e < 32; ++e) p[e] = __shfl(lg[(e >> 4) * 4 + (e & 3)], j + 16 * ((e & 15) >> 2));
    unsigned taken = 0u; float tv[4]; int ti[4];
#pragma unroll
    for (int k = 0; k < 4; ++k) { float best = -INFINITY; int bi = 0;
#pragma unroll
        for (int e = 0; e < 32; ++e) { const bool ok = !((taken >> e) & 1u) && (p[e] > best); best = ok ? p[e] : best; bi = ok ? e : bi; }
        taken |= 1u << bi; tv[k] = best; ti[k] = bi; }
    const float e1 = __expf(tv[1] - tv[0]), e2 = __expf(tv[2] - tv[0]), e3 = __expf(tv[3] - tv[0]); const float inv = 1.0f / (1.0f + e1 + e2 + e3);
    if (kq == 0) {
        TOPI[r * 4 + 0] = ti[0]; TOPI[r * 4 + 1] = ti[1]; TOPI[r * 4 + 2] = ti[2]; TOPI[r * 4 + 3] = ti[3];
        GATE[r * 4 + 0] = inv; GATE[r * 4 + 1] = e1 * inv; GATE[r * 4 + 2] = e2 * inv; GATE[r * 4 + 3] = e3 * inv;
        lds_add(&hist[ti[0]], 1); lds_add(&hist[ti[1]], 1); lds_add(&hist[ti[2]], 1); lds_add(&hist[ti[3]], 1);
    }
}
__device__ __forceinline__ void ph_ffn_router(const Frame& F, int l, int nrows, const float* router_w) {
    LAS float* rwl = (LAS float*)(F.lds);
    LAS float* part = (LAS float*)(F.lds + 139264);
    LAS float* cbl = (LAS float*)(F.lds + 153600);
    LAS int* hist = (LAS int*)(F.lds + 153600 + 640);
    const bf16* XR = (const bf16*)(F.ws + WS_XR); const float* RSSP = (const float*)(F.ws + WS_RSSP); const float* MOD = (const float*)(F.ws + WS_MOD);
    const float* GC = (const float*)(F.ws + WS_GC) + (size_t)l * 5 * 1024; unsigned char* Fb = (unsigned char*)(F.ws + WS_F);
    int* TOPI = (int*)(F.ws + WS_TOPI); float* GATE = (float*)(F.ws + WS_GATE); int* BLKCNT = (int*)(F.ws + WS_BLKCNT);
    for (int i = F.tid; i < 1024 * 32; i += NTHR) rwl[(i >> 5) * RW_PITCH + (i & 31)] = router_w[(size_t)l * 32768 + i];
    if (F.tid < 32) hist[F.tid] = 0;
    if (F.tid < 160) cbl[F.tid] = ((const float*)(F.ws + WS_CB))[l * 160 + F.tid];
    __syncthreads();
    const int j = F.lane & 15, kq = F.lane >> 4;
    const int ngrp = nrows / 16, nmain = (ngrp / F.ngw) * F.ngw;
    for (int grp = F.gw; grp < nmain; grp += F.ngw) {
        const int r0 = grp * 16, r = r0 + j; const int bidx = r0 < NLAT ? r0 / SEQ : 4;
        float ss; { const f32x4 q = *(const f32x4*)(RSSP + (size_t)r * 16 + 4 * kq); ss = (q.x + q.y) + (q.z + q.w); }
        ss += __shfl_xor(ss, 16); ss += __shfl_xor(ss, 32);
        const float rstd = 1.0f / sqrtf(ss * (1.0f / 1024.0f) + EPSN);
        f32x4 acc0 = {0.f, 0.f, 0.f, 0.f}, acc1 = acc0;
        router_cols(rwl, XR, GC + bidx * 1024, MOD + (size_t)(l * 5 + bidx) * 6144 + 3 * 1024, Fb, r, rstd, j, kq, 0, 32, acc0, acc1);
        router_finish(cbl, hist, TOPI, GATE, r, bidx, rstd, j, kq, acc0, acc1);
    }
    for (int grp = nmain + (int)blockIdx.x; grp < ngrp; grp += F.G) {
        const int r0 = grp * 16, r = r0 + j; const int bidx = r0 < NLAT ? r0 / SEQ : 4;
        float ss; { const f32x4 q = *(const f32x4*)(RSSP + (size_t)r * 16 + 4 * kq); ss = (q.x + q.y) + (q.z + q.w); }
        ss += __shfl_xor(ss, 16); ss += __shfl_xor(ss, 32);
        const float rstd = 1.0f / sqrtf(ss * (1.0f / 1024.0f) + EPSN);
        f32x4 acc0 = {0.f, 0.f, 0.f, 0.f}, acc1 = acc0;
        router_cols(rwl, XR, GC + bidx * 1024, MOD + (size_t)(l * 5 + bidx) * 6144 + 3 * 1024, Fb, r, rstd, j, kq, 4 * F.wave, 4 * F.wave + 4, acc0, acc1);
        if (F.wave > 0) { LAS f32x4* pp = (LAS f32x4*)(part + ((F.wave - 1) * 64 + F.lane) * 8); pp[0] = acc0; pp[1] = acc1; }
        __syncthreads();
        if (F.wave == 0) {
#pragma unroll
            for (int w = 0; w < 7; ++w) { const LAS f32x4* pp = (const LAS f32x4*)(part + (w * 64 + F.lane) * 8); acc0 += pp[0]; acc1 += pp[1]; }
            router_finish(cbl, hist, TOPI, GATE, r, bidx, rstd, j, kq, acc0, acc1);
        }
        __syncthreads();
    }
    __syncthreads();
    if (F.tid < 32) BLKCNT[blockIdx.x * 32 + F.tid] = hist[F.tid];
}

__device__ __forceinline__ void ph_route(const Frame& F, int nrows) {
    LAS int* cursor = (LAS int*)(F.lds);
    LAS int* tot = cursor + 32;
    LAS int* mine = cursor + 64;
    LAS int* part = cursor + 96;
    LAS int* ebase = cursor + 96 + 1024;
    const int* BLKCNT = (const int*)(F.ws + WS_BLKCNT); const int* TOPI = (const int*)(F.ws + WS_TOPI); int* POS = (int*)(F.ws + WS_POS);
    int* ROWTOK = (int*)(F.ws + WS_ROWTOK); int* TILEE = (int*)(F.ws + WS_TILEE);
    { const int e = F.tid & 31, sl = F.tid >> 5; int t = 0, m = 0;
      for (int b = sl; b < F.G; b += 16) { const int v = BLKCNT[b * 32 + e]; t += v; m += (b < (int)blockIdx.x) ? v : 0; }
      part[sl * 64 + e] = t; part[sl * 64 + 32 + e] = m;
      __syncthreads();
      if (F.tid < 32) { int tt = 0, mm = 0;
#pragma unroll
          for (int s = 0; s < 16; ++s) { tt += part[s * 64 + F.tid]; mm += part[s * 64 + 32 + F.tid]; }
          tot[F.tid] = tt; mine[F.tid] = mm; } }
    __syncthreads();
    if (F.tid == 0) { int tb = 0;
        for (int e = 0; e < 32; ++e) { const int nt = (tot[e] + 255) >> 8; cursor[e] = tb * 256 + mine[e]; ebase[e] = tb * 256;
            if (blockIdx.x == 0) for (int j = 0; j < nt; ++j) TILEE[tb + j] = e;
            tb += nt; }
        ebase[32] = tb * 256;
        if (blockIdx.x == 0) F.ctl[CW_NTILES] = (unsigned)tb; }
    __syncthreads();
    for (int e = blockIdx.x; e < 32; e += F.G) for (int p = ebase[e] + tot[e] + F.tid; p < ebase[e + 1]; p += NTHR) ROWTOK[p] = 0;
    const int sub = F.lane >> 2, k = F.lane & 3;
    const int ngrp = nrows / 16, nmain = (ngrp / F.ngw) * F.ngw;
    for (int grp = F.gw; grp < nmain; grp += F.ngw) {
        const int r = grp * 16 + sub; const int e = TOPI[r * 4 + k]; const int pos = lds_add(&cursor[e], 1); POS[r * 4 + k] = pos; ROWTOK[pos] = r; }
    if (F.wave == 0) for (int grp = nmain + (int)blockIdx.x; grp < ngrp; grp += F.G) {
        const int r = grp * 16 + sub; const int e = TOPI[r * 4 + k]; const int pos = lds_add(&cursor[e], 1); POS[r * 4 + k] = pos; ROWTOK[pos] = r; }
}

__device__ __forceinline__ void ph_combine(const Frame& F, int l, int nrows, float* out, const float* gmix) {
    bf16* XR = (bf16*)(F.ws + WS_XR); const float* MOD = (const float*)(F.ws + WS_MOD); const bf16* YS = (const bf16*)(F.ws + WS_YS); bf16* H = (bf16*)(F.ws + WS_H);
    const int* POS = (const int*)(F.ws + WS_POS); const float* GATE = (const float*)(F.ws + WS_GATE);
    for (int r = 2 * F.gw; r < nrows; r += 2 * F.ngw) {
        const int bidx = r < NLAT ? r / SEQ : 4;
        const float* gf = MOD + (size_t)(l * 5 + bidx) * 6144 + 5 * 1024;
        int pos = 0; float gt = 0.f;
        if (F.lane < 8) { pos = POS[r * 4 + F.lane]; gt = GATE[r * 4 + F.lane]; }
        v2u w[2][4][4], xw[2][4]; float gk[2][4];
#pragma unroll
        for (int rr = 0; rr < 2; ++rr)
#pragma unroll
            for (int k = 0; k < 4; ++k) { const int pk = __shfl(pos, rr * 4 + k); gk[rr][k] = __shfl(gt, rr * 4 + k);
#if MOE_FP8
                gk[rr][k] *= (1.0f / pg8::F8_SY); const unsigned* yr = (const unsigned*)((const unsigned char*)YS + (size_t)pk * YS_PITCH);
#pragma unroll
                for (int j = 0; j < 4; ++j) { w[rr][k][j].x = yr[64 * j + F.lane]; w[rr][k][j].y = 0u; } }
#else
                const v2u* yr = (const v2u*)(YS + (size_t)pk * 1024);
#pragma unroll
                for (int j = 0; j < 4; ++j) w[rr][k][j] = yr[64 * j + F.lane]; }
#endif
#pragma unroll
        for (int rr = 0; rr < 2; ++rr)
#pragma unroll
            for (int j = 0; j < 4; ++j) xw[rr][j] = ((const v2u*)(XR + (size_t)(r + rr) * 1024))[64 * j + F.lane];
        f32x4 gv[4];
#pragma unroll
        for (int j = 0; j < 4; ++j) gv[j] = ((const f32x4*)gf)[64 * j + F.lane];
#pragma unroll
        for (int rr = 0; rr < 2; ++rr) {
            const int row = r + rr;
            f32x4 y[4]; float ss = 0.f;
#pragma unroll
            for (int j = 0; j < 4; ++j) { f32x4 a = {0.f, 0.f, 0.f, 0.f};
#pragma unroll
                for (int k = 0; k < 4; ++k) { const v2u ww = w[rr][k][j]; const float g_ = gk[rr][k];
#if MOE_FP8
                    a.x += g_ * __builtin_amdgcn_cvt_f32_fp8((int)ww.x, 0); a.y += g_ * __builtin_amdgcn_cvt_f32_fp8((int)ww.x, 1); a.z += g_ * __builtin_amdgcn_cvt_f32_fp8((int)ww.x, 2); a.w += g_ * __builtin_amdgcn_cvt_f32_fp8((int)ww.x, 3); }
#else
                    a.x += g_ * bflo(ww.x); a.y += g_ * bfhi(ww.x); a.z += g_ * bflo(ww.y); a.w += g_ * bfhi(ww.y); }
#endif
                const f32x4 xv = {bflo(xw[rr][j].x), bfhi(xw[rr][j].x), bflo(xw[rr][j].y), bfhi(xw[rr][j].y)};
                y[j] = xv + gv[j] * a;
                const int cb = 64 * j + F.lane;
                if (l == 0) { v2u o; o.x = pk2(y[j].x, y[j].y); o.y = pk2(y[j].z, y[j].w); ((v2u*)(XR + (size_t)row * 1024))[cb] = o; } else ((f32x4*)(out + (size_t)row * 1024))[cb] = y[j];
                ss += (y[j].x * y[j].x + y[j].y * y[j].y) + (y[j].z * y[j].z + y[j].w * y[j].w); }
            if (l == 0) {
                const float rstd = 1.0f / sqrtf(wave_sum(ss) * (1.0f / 1024.0f) + EPSN);
                const float* shift = MOD + (size_t)(5 + bidx) * 6144; const float* scale = shift + 1024; const float* g = gmix + 1024;
#pragma unroll
                for (int j = 0; j < 4; ++j) { const int cb = 64 * j + F.lane; const f32x4 gg = ((const f32x4*)g)[cb], sc = ((const f32x4*)scale)[cb], sh = ((const f32x4*)shift)[cb];
                    const f32x4 hv = y[j] * rstd * gg * (sc + 1.0f) + sh;
                    v2u o; o.x = pk2(hv.x, hv.y); o.y = pk2(hv.z, hv.w); ((v2u*)(H + (size_t)row * 1024))[cb] = o; }
            }
        }
    }
}

struct Args { const float* in[34]; float* out; unsigned char* ws; int ph_lo, ph_hi; };
enum { I_X = 0, I_C, I_CTX, I_CCTX, I_WMOD, I_BMOD, I_GMIX, I_GFFN, I_WIN, I_QG, I_KG, I_LCW, I_LCB, I_LGW, I_LGB, I_LLAM, I_HCW, I_HCB, I_HW1, I_HB1, I_HW2, I_HB2, I_HW3, I_HFREQ, I_HDEC, I_HBIAS,
       I_OUTG, I_WOUT, I_RW, I_RB, I_MW1, I_MB1, I_MW2, I_MB2 };

__global__ void __launch_bounds__(NTHR, 2) mk_fwd(Args args) {
    extern __shared__ __attribute__((aligned(16))) unsigned char lds[];
    Frame F;
    F.lds = (LAS unsigned char*)lds; F.ws = args.ws; F.ctl = (unsigned*)(args.ws + WS_CTL);
    F.tid = threadIdx.x; F.lane = F.tid & 63; F.wave = __builtin_amdgcn_readfirstlane(F.tid >> 6);
    F.G = gridDim.x; { const int bx = blockIdx.x; F.vcu = (F.G % 8 == 0) ? (bx % 8) * (F.G / 8) + bx / 8 : bx; }
    F.gw = (int)blockIdx.x * NWAVES + F.wave; F.ngw = F.G * NWAVES;
    for (int u = F.tid; u < (LDS_BYTES - LDSCTL_OFF) / 4; u += NTHR) ((LAS unsigned*)(F.lds + LDSCTL_OFF))[u] = 0u;
    __syncthreads();
#if !MK_PER_PHASE
    XcdBarrier bar = xcd_barrier_post(F.ctl + CW_BAR, (volatile LAS unsigned*)(F.lds + LDSCTL_OFF + 32));
#define GRID_BAR() xcd_barrier(bar)
#else
#define GRID_BAR() do { } while (0)
#endif
    const int lo = args.ph_lo, hi = args.ph_hi;
#ifndef ONLY_PHASE
#define ONLY_PHASE (-1)
#endif
#define ENABLED(id) (ONLY_PHASE < 0 || ONLY_PHASE == (id))
#define IN(k) (ENABLED(k) && lo <= (k) && (k) < hi)
#define INL(j) (ENABLED(NPH_PRO + (j)) && lo <= pb + (j) && pb + (j) < hi)
#define SEAML(j) do { if (lo <= pb + (j) && pb + (j) + 1 < hi) { GRID_BAR(); } } while (0)
typedef const __attribute__((address_space(4))) Args* KArgs;
#ifndef REP_MASK
#define REP_MASK 0
#endif
#define NREP(j) (((REP_MASK >> (j)) & 1) ? 2 : 1)
#define REFRAME() Frame Fp = F; KArgs ka = (KArgs)__builtin_amdgcn_kernarg_segment_ptr(); { int t_ = F.tid; asm volatile("" : "+v"(t_), "+s"(ka)); Fp.tid = t_; Fp.lane = t_ & 63; Fp.wave = __builtin_amdgcn_readfirstlane(t_ >> 6); \
    Fp.gw = (int)blockIdx.x * NWAVES + Fp.wave; Fp.ws = ka->ws; Fp.ctl = (unsigned*)(ka->ws + WS_CTL); }
#define SEAM(k) do { if (lo <= (k) && (k) + 1 < hi) { GRID_BAR(); } } while (0)

    if (IN(0)) ph_prologue_a(F, args.in[I_C], args.in[I_CCTX], args.in[I_WMOD], args.in[I_BMOD], args.in[I_WIN], args.in[I_WOUT], args.in[I_MW1], args.in[I_MW2],
                             args.in[I_HW1], args.in[I_HB1], args.in[I_HW2], args.in[I_HB2], args.in[I_HFREQ], args.in[I_LGW], args.in[I_LLAM]);
    SEAM(0);
    if (IN(1)) ph_prologue_b(F, args.in[I_HW3], args.in[I_HDEC], args.in[I_GFFN], args.in[I_RW], args.in[I_RB]);
    SEAM(1);

#if MOE_FP8
#define MOE_EPI1 pg8::EpiSwigluF8
#define MOE_EPI2 pg8::EpiF8BiasF8
#else
#define MOE_EPI1 pg8::EpiSwiglu
#define MOE_EPI2 pg8::EpiBf16Bias
#endif
#ifndef PROBE_MOE2
#define PROBE_MOE2 0
#endif
#ifndef PROBE_MOE2B
#define PROBE_MOE2B 0
#endif
#ifndef PROBE_GEMM_K
#define PROBE_GEMM_K 0
#endif
#ifndef MOE_WGM1
#define MOE_WGM1 4
#endif
#ifndef MOE_WGM2
#define MOE_WGM2 8
#endif
#define PHASE(j, ...) if (INL(j)) { _Pragma("unroll") for (int rep_ = 0; rep_ < NREP(j); ++rep_) { { REFRAME(); __VA_ARGS__ } if (rep_ + 1 < NREP(j)) GRID_BAR(); } }
#define LAYER_BODY(l) { \
        const int pb = NPH_PRO + l * NPH_LAYER; \
        const int nrows = (l == 0) ? MT : NLAT; \
        if (l == 0) { PHASE(0, ph_norm_mod(Fp, l, ka->in[I_X], ka->in[I_CTX], ka->in[I_GMIX]);) SEAML(0); } \
        if (INL(1)) { REFRAME(); \
            unsigned* sw_ = Fp.ctl + CW_SPLIT + 2048 * l; \
            { pg8::Gemm g{(const bf16*)(Fp.ws + WS_H), (const bf16*)(Fp.ws + WS_WINT) + (size_t)l * 2048 * 1024, NLAT, 2048, 1024}; \
              pg8::StaticOrder S; S.init(NLAT, 2048, Fp.G, (int)blockIdx.x); \
              pg8::EpiBf16<0> E{(bf16*)(Fp.ws + WS_U), 2048, nullptr, 0, 0, 1.f}; \
              pg8::gemm_phase<pg8::EpiBf16<0>, pg8::StaticOrder, PG8_ALIGN, PG8_SP2>(Fp.lds + RING_OFF, g, S, E); } \
            split_arrive_all(bar, sw_);                                        \
            if ((int)blockIdx.x < CTXWG) {                                     \
              pg8::Gemm g{(const bf16*)(Fp.ws + WS_H) + (size_t)NLAT * 1024, (const bf16*)(Fp.ws + WS_WINT) + (size_t)l * 2048 * 1024, MT - NLAT, 2048, 1024}; \
              pg8::StaticOrder S; S.init(MT - NLAT, 2048, CTXWG, (int)blockIdx.x); \
              pg8::EpiBf16<0> E{(bf16*)(Fp.ws + WS_U) + (size_t)NLAT * 2048, 2048, nullptr, 0, 0, 1.f}; \
              pg8::gemm_phase<pg8::EpiBf16<0>, pg8::StaticOrder, PG8_ALIGN, PG8_SP2>(Fp.lds + RING_OFF, g, S, E); \
              split_arrive_flat(sw_); } \
            split_wait_all(bar, sw_); \
            if ((int)blockIdx.x >= CTXWG) post_ab(Fp, l, 0, NLAT, ((int)blockIdx.x - CTXWG) * NWAVES + Fp.wave, (Fp.G - CTXWG) * NWAVES, ka->in[I_KG], ka->in[I_LCW], ka->in[I_LCB]); \
            split_wait_flat(bar, sw_, (unsigned)CTXWG); \
            post_ab(Fp, l, NLAT, MT, Fp.gw, Fp.ngw, ka->in[I_KG], ka->in[I_LCW], ka->in[I_LCB]); \
            post_c(Fp, l, ka->in[I_HCW], ka->in[I_HCB]); } \
        SEAML(2); \
        if (INL(3)) { REFRAME(); \
            unsigned* sw_ = Fp.ctl + CW_SPLIT + 2048 * (2 + l); \
            { int kg_ = 256; asm volatile("" : "+s"(kg_)); \
              pg8::Gemm g{(const bf16*)(Fp.ws + WS_XL), (const bf16*)(Fp.ws + WS_WGT) + (size_t)l * 1024 * 256, NLAT, 1024, kg_}; \
              pg8::StaticOrder S; S.init(NLAT, 1024, Fp.G, (int)blockIdx.x); \
              pg8::EpiLruGate E{(const bf16*)(Fp.ws + WS_XL), (bf16*)(Fp.ws + WS_LAB), LAB_STRIDE, ka->in[I_LGB] + (size_t)l * 1024, (const float*)(Fp.ws + WS_SPT) + l * 512}; \
              pg8::gemm_phase<pg8::EpiLruGate, pg8::StaticOrder, PG8_ALIGN, PG8_SP2>(Fp.lds + RING_OFF, g, S, E); } \
            split_arrive_all(bar, sw_); \
            if ((int)blockIdx.x >= 32 && (int)blockIdx.x < 64) {            \
              ph_lru_gates(Fp, l, ka->in[I_LGB], NLAT / 32, (MT - NLAT) / 32, ((int)blockIdx.x - 32) * NWAVES + Fp.wave, 32 * NWAVES); \
              split_arrive_flat(sw_); } \
            split_wait_all(bar, sw_); split_wait_flat(bar, sw_, 32u); \
            ph_scan1(Fp); __syncthreads(); \
            { const attn_body::AttnTensors AT{(const attn_body::bf16*)(Fp.ws + WS_U), (const attn_body::bf16*)(Fp.ws + WS_K), (const attn_body::bf16*)(Fp.ws + WS_V), (attn_body::bf16*)(Fp.ws + WS_ATT)}; \
              const attn_body::QPre QN{ka->in[I_QG] + l * 64, (const float*)(Fp.ws + WS_ROPEC), (const float*)(Fp.ws + WS_ROPES)}; \
              attn_body::attn_phase<8>((char*)lds + RING_OFF, AT, QN, Fp.G, Fp.vcu, l == 0, (long)NLAT); } } \
        SEAML(4); \
        PHASE(5, ph_scan2(Fp); __syncthreads(); ph_hyena_fft(Fp, l, ka->in[I_HBIAS]); if (l == 0) ph_hyena_ctx(Fp, ka->in[I_HBIAS], ka->in[I_HCW], ka->in[I_HCB]);) \
        SEAML(5); \
        PHASE(6, ph_merge(Fp, l, nrows, ka->in[I_OUTG]);) \
        SEAML(6); \
        if (INL(7)) { REFRAME(); \
            pg8::Gemm g{(const bf16*)(Fp.ws + WS_MIXA), (const bf16*)(Fp.ws + WS_WOUTT) + (size_t)l * 1024 * 1024, nrows, 1024, 1024}; \
            pg8::StaticOrder S; S.init(nrows, 1024, Fp.G, (int)blockIdx.x); \
            bf16* XR = (bf16*)(Fp.ws + WS_XR); \
            pg8::EpiResid<(l) == 1> E{ka->in[I_X], ka->in[I_CTX], NLAT, XR, 1024, \
                            (const float*)(Fp.ws + WS_MOD) + (size_t)(l * 5) * 6144 + 2 * 1024, 6144, SEQ, (float*)(Fp.ws + WS_RSSP)}; \
            pg8::gemm_phase<pg8::EpiResid<(l) == 1>, pg8::StaticOrder, PG8_ALIGN, PG8_SP2>(Fp.lds + RING_OFF, g, S, E); \
        } \
        SEAML(7); \
        PHASE(8, ph_ffn_router(Fp, l, nrows, ka->in[I_RW]);) \
        SEAML(8); \
        PHASE(9, ph_route(Fp, nrows);) \
        SEAML(9); \
        if (INL(10) || INL(11)) { REFRAME(); \
            LAS int* tab = (LAS int*)(Fp.lds + MOETAB_OFF); \
            const int ntiles = (int)__hip_atomic_load(Fp.ctl + CW_NTILES, __ATOMIC_RELAXED, __HIP_MEMORY_SCOPE_AGENT); \
            const int* TILEE = (const int*)(Fp.ws + WS_TILEE); \
            for (int i = Fp.tid; i < ntiles && i < SORT_TILES; i += NTHR) tab[i] = TILEE[i]; \
            __syncthreads(); \
            if (INL(10)) { _Pragma("unroll") for (int rep_ = 0; rep_ < NREP(10); ++rep_) { { \
                int km1_ = 1024 / (1 + MOE_FP8); asm volatile("" : "+s"(km1_)); \
                pg8::Gemm g{(const bf16*)(Fp.ws + WS_F), (const bf16*)(Fp.ws + WS_W1T) + (size_t)l * 32 * 2048 * (1024 / (1 + MOE_FP8)), 0, 2048, km1_}; \
                pg8::MoeOrderT<true> S; S.init(tab, ntiles, 8, Fp.G, (int)blockIdx.x, MOE_WGM1); S.rowtok = (const int*)(Fp.ws + WS_ROWTOK); \
                MOE_EPI1 E{(bf16*)(Fp.ws + WS_ACT), 1024, ka->in[I_MB1] + (size_t)l * 32 * 2048, 2048}; \
                pg8::gemm_phase<MOE_EPI1, pg8::MoeOrderT<true>, PG8_ALIGN, PG8_SP2, MOE_FP8 != 0>(Fp.lds + RING_OFF, g, S, E); \
             } if (rep_ + 1 < NREP(10)) GRID_BAR(); } } \
            SEAML(10); \
            if (PROBE_MOE2B && INL(11)) { \
                pg8::Gemm g{(const bf16*)(Fp.ws + WS_ACT), (const bf16*)(Fp.ws + WS_W2T) + (size_t)l * 32 * 1024 * 1024, 0, 1024, 1024}; \
                pg8::MoeOrderT<false> S; S.init(tab, ntiles, 4, Fp.G, (int)blockIdx.x, MOE_WGM2); S.rowtok = nullptr; S.rev = 1; \
                pg8::EpiNone E{}; \
                pg8::gemm_phase<pg8::EpiNone, pg8::MoeOrderT<false>, PG8_ALIGN, PG8_SP2>(Fp.lds + RING_OFF, g, S, E); GRID_BAR(); } \
            if (INL(11)) { _Pragma("unroll") for (int rep_ = 0; rep_ < NREP(11); ++rep_) { { \
                int km2_ = 1024 / (1 + MOE_FP8); asm volatile("" : "+s"(km2_)); \
                pg8::Gemm g{(const bf16*)(Fp.ws + WS_ACT), (const bf16*)(Fp.ws + WS_W2T) + (size_t)l * 32 * 1024 * (1024 / (1 + MOE_FP8)), 0, 1024, km2_}; \
                pg8::MoeOrderT<false> S; S.init(tab, ntiles, 4, Fp.G, (int)blockIdx.x, MOE_WGM2); S.rowtok = nullptr; S.rev = 1; \
                MOE_EPI2 E{(bf16*)(Fp.ws + WS_YS), YS_PITCH, ka->in[I_MB2] + (size_t)l * 32 * 1024, 1024}; \
                pg8::gemm_phase<MOE_EPI2, pg8::MoeOrderT<false>, PG8_ALIGN, PG8_SP2, MOE_FP8 != 0>(Fp.lds + RING_OFF, g, S, E); \
             } if (rep_ + 1 < NREP(11)) GRID_BAR(); } } \
            if (PROBE_MOE2 && INL(11)) { GRID_BAR(); \
                pg8::Gemm g{(const bf16*)(Fp.ws + WS_ACT), (const bf16*)(Fp.ws + WS_W2T) + (size_t)l * 32 * 1024 * 1024, 0, 1024, 1024}; \
                pg8::MoeOrderT<false> S; S.init(tab, ntiles, 4, Fp.G, (int)blockIdx.x, MOE_WGM2); S.rowtok = nullptr; S.rev = (PROBE_MOE2 == 2) ? 0 : 1; \
                if (PROBE_MOE2 == 3) { pg8::EpiBf16BiasFold E{(bf16*)(Fp.ws + WS_ASORT), 1024, ka->in[I_MB2] + (size_t)l * 32 * 1024, 1024}; \
                    pg8::gemm_phase<pg8::EpiBf16BiasFold, pg8::MoeOrderT<false>, PG8_ALIGN, PG8_SP2>(Fp.lds + RING_OFF, g, S, E); } \
                else { pg8::EpiNone E{}; \
                pg8::gemm_phase<pg8::EpiNone, pg8::MoeOrderT<false>, PG8_ALIGN, PG8_SP2>(Fp.lds + RING_OFF, g, S, E); } } \
        } \
        SEAML(11); \
        if (INL(12)) { REFRAME(); ph_combine(Fp, l, nrows, ka->out, ka->in[I_GMIX]); } \
        if (l == 0) { SEAML(12); } \
    }
    LAYER_BODY(0)
    LAYER_BODY(1)
#undef LAYER_BODY
#undef PHASE
#undef IN
#undef SEAM
#undef INL
#undef SEAML
}

extern "C" void kernel_launch(void* const* d_in, const int* in_sizes, int n_in, void* d_out, int out_size, void* d_ws, size_t ws_size, hipStream_t stream) {
    static int grid = 0;
    if (grid == 0) {
        if (n_in != 34 || in_sizes[0] != NLAT * DMODEL || out_size != NLAT * DMODEL || ws_size < WS_END) {
            fprintf(stderr, "kernel_launch: unexpected shapes (n_in %d, in0 %d, out %d, ws %zu); nothing launched\n", n_in, n_in > 0 ? in_sizes[0] : -1, out_size, ws_size); grid = -1; return; }
        int dev = 0, cus = 0;
        if (hipGetDevice(&dev) != hipSuccess || hipDeviceGetAttribute(&cus, hipDeviceAttributeMultiprocessorCount, dev) != hipSuccess) { grid = -1; return; }
        if (hipFuncSetAttribute((const void*)mk_fwd, hipFuncAttributeMaxDynamicSharedMemorySize, LDS_BYTES) != hipSuccess) { fprintf(stderr, "kernel_launch: hipFuncSetAttribute failed\n"); grid = -1; return; }
        int per_cu = 0;
        if (hipOccupancyMaxActiveBlocksPerMultiprocessor(&per_cu, (const void*)mk_fwd, NTHR, LDS_BYTES) != hipSuccess || per_cu < 1) { fprintf(stderr, "kernel_launch: occupancy query says %d\n", per_cu); }
        (void)hipGetLastError();
        grid = cus;
    }
    if (grid < 0) return;
    if (hipMemsetAsync((char*)d_ws + WS_CTL, 0, CTL_ZERO_BYTES, stream) != hipSuccess) return;
    Args a{};
    for (int i = 0; i < 34; ++i) a.in[i] = (const float*)d_in[i];
    a.out = (float*)d_out; a.ws = (unsigned char*)d_ws;
#if MK_PER_PHASE
    for (int p = 0; p < NPH; ++p) { a.ph_lo = p; a.ph_hi = p + 1; hipLaunchKernelGGL(mk_fwd, dim3(grid), dim3(NTHR), LDS_BYTES, stream, a); }
#else
    a.ph_lo = 0; a.ph_hi = NPH;
    hipLaunchKernelGGL(mk_fwd, dim3(grid), dim3(NTHR), LDS_BYTES, stream, a);
#endif
}
```

```cpp
#include <hip/hip_runtime.h>
#include <hip/hip_bf16.h>
#include <cstdio>
#include <cstdint>
#include <cmath>
#ifndef MOE_FP8
#define MOE_FP8 1
#endif
#ifndef MK_PER_PHASE
#define MK_PER_PHASE 0
#endif
namespace pg8 {
#define PG8_LAS __attribute__((address_space(3)))
typedef unsigned short bf16_t;
typedef short bf16x8 __attribute__((ext_vector_type(8)));
typedef float f32x4 __attribute__((ext_vector_type(4)));
typedef unsigned u32x4 __attribute__((ext_vector_type(4)));
constexpr int BM = 256, BK = 64, HALF = 128, HTB = HALF * BK * 2  , STAGE_BYTES = 8 * HTB, NXCD = 8, WGM = 8;

__host__ __device__ __forceinline__ int lds_byte(int r, int c) { const int st = (r >> 4) * 2 + (c >> 5), rr = r & 15, cc = c & 31, ob = rr * 64 + cc * 2; return st * 1024 + (ob ^ (((ob >> 9) & 1) << 5)); }
__host__ __device__ __forceinline__ void stage_rc(int b, int& R, int& C) { const int st = b / 1024, sb = b % 1024, swz = sb ^ (((sb >> 9) & 1) << 5); R = (st >> 1) * 16 + swz / 64; C = (st & 1) * 32 + (swz % 64) / 2; }
__host__ __device__ __forceinline__ int perm32(int rho) { const int n = rho >> 4, i = rho & 15; return 8 * (i >> 2) + 4 * n + (i & 3); }

struct Unit { int pm, pn, be, e; };
struct Gemm { const bf16_t* A; const bf16_t* Bt; int M, N, K; };

struct StaticOrder {
    static constexpr bool GATHER = false;
    __device__ __forceinline__ int row_of(int r) const { return r; }
    int nM, nN, nwg, G, c;
    __host__ __device__ void init(int M, int N, int G_, int c_) { nM = M / BM; nN = N / BM; nwg = nM * nN; G = G_; c = c_; }
    __host__ __device__ bool next(int i, Unit& u) const {
        const long L = (long)i * G + c; if (L >= nwg) return false;
        int wgid = (int)L; { const int q = nwg / NXCD, r = nwg % NXCD, xcd = wgid % NXCD, off = wgid / NXCD; wgid = (xcd < r ? xcd * (q + 1) : r * (q + 1) + (xcd - r) * q) + off; }
        const int nig = WGM * nN, gid = wgid / nig, fm = gid * WGM, gsz = (nM - fm) < WGM ? (nM - fm) : WGM;
        u.pm = fm + ((wgid % nig) % gsz); u.pn = (wgid % nig) / gsz; u.be = u.pn; u.e = 0; return true;
    }
    __device__ __forceinline__ void a_ready(const Unit&) const {}
    __device__ __forceinline__ void done(const Unit&) const {}
};

__device__ __forceinline__ unsigned cvt_pk_bf16(float lo, float hi) { unsigned r; asm volatile("v_cvt_pk_bf16_f32 %0, %1, %2" : "=v"(r) : "v"(lo), "v"(hi)); return r; }
__device__ __forceinline__ unsigned pack4_fp8(float a, float b, float c, float d) {
    a = fminf(fmaxf(a, -448.f), 448.f); b = fminf(fmaxf(b, -448.f), 448.f); c = fminf(fmaxf(c, -448.f), 448.f); d = fminf(fmaxf(d, -448.f), 448.f);
    int w = 0; w = __builtin_amdgcn_cvt_pk_fp8_f32(a, b, w, false); w = __builtin_amdgcn_cvt_pk_fp8_f32(c, d, w, true); return (unsigned)w;
}
constexpr float F8_SF = 16.f, F8_SW = 64.f, F8_SA = 4.f, F8_SY = 32.f;
typedef float f32x2 __attribute__((ext_vector_type(2)));
__device__ __forceinline__ f32x2 gelu_pk(f32x2 v) {
    const f32x2 av = __builtin_elementwise_abs(v), d = av * 0.2316418882f + 1.0f;
    f32x2 t; t.x = __builtin_amdgcn_rcpf(d.x); t.y = __builtin_amdgcn_rcpf(d.y);
    f32x2 q = t * 0.5307027145f + (-0.7265760135f); q = q * t + 0.7107068705f; q = q * t + (-0.142248368f); q = q * t + 0.127414796f; q = q * t;
    const f32x2 s = (v * v) * (-0.72134752044f);
    f32x2 e; e.x = __builtin_amdgcn_exp2f(s.x); e.y = __builtin_amdgcn_exp2f(s.y);
    const f32x2 m = v * (q * e), r = v - m;
    f32x2 o; o.x = v.x < 0.f ? m.x : r.x; o.y = v.y < 0.f ? m.y : r.y; return o;
}

template <int ACT  > struct EpiBf16 {
    static constexpr bool PERM = true, AFTER_DRAIN = false; static_assert(ACT == 0 || ACT == 1, "EpiBf16: ACT is 0 (none) or 1 (gelu_pk)");
    bf16_t* O; int ldc; const float* bias; int split_cols; size_t split_stride; float scale0;
    struct Pre {}; __device__ __forceinline__ void preload(Pre&, const Unit&, int, int, int, int) const {}
    __device__ __forceinline__ void operator()(const f32x4 (&acc)[2][2][4][2], const Unit& u, int wr, int wc, int fr, int fq, const Pre&) const {
        const int row0 = u.pm * BM + wr * 64 + fr; int colt = u.pn * BM; bf16_t* base = O;
        float sc = 1.f; if (split_cols) { const int t = colt / split_cols; base += (size_t)t * split_stride; colt -= t * split_cols; if (t == 0) sc = scale0; }
        const int col0 = colt + wc * 32 + 8 * fq, bcol0 = u.pn * BM + wc * 32 + 8 * fq;
        f32x4 bv[2][2];
#pragma unroll
        for (int bj = 0; bj < 2; ++bj)
#pragma unroll
            for (int n = 0; n < 2; ++n) bv[bj][n] = bias ? *(const f32x4*)(bias + bcol0 + bj * HALF + 4 * n) : (f32x4){0.f, 0.f, 0.f, 0.f};
#pragma unroll
        for (int ai = 0; ai < 2; ++ai)
#pragma unroll
            for (int m = 0; m < 4; ++m) { bf16_t* rowp = base + (size_t)(row0 + ai * HALF + m * 16) * ldc + col0;
#pragma unroll
                for (int bj = 0; bj < 2; ++bj) { f32x4 v0 = acc[ai][bj][m][0] + bv[bj][0], v1 = acc[ai][bj][m][1] + bv[bj][1];
                    if (ACT == 1) { f32x2 a = gelu_pk((f32x2){v0[0], v0[1]}), b = gelu_pk((f32x2){v0[2], v0[3]}), c = gelu_pk((f32x2){v1[0], v1[1]}), d = gelu_pk((f32x2){v1[2], v1[3]});
                        v0 = (f32x4){a.x, a.y, b.x, b.y}; v1 = (f32x4){c.x, c.y, d.x, d.y}; }
                    v0 = v0 * sc; v1 = v1 * sc; u32x4 w; w.x = cvt_pk_bf16(v0[0], v0[1]); w.y = cvt_pk_bf16(v0[2], v0[3]); w.z = cvt_pk_bf16(v1[0], v1[1]); w.w = cvt_pk_bf16(v1[2], v1[3]);
                    *(u32x4*)(rowp + bj * HALF) = w; } }
    }
};


template <bool XIN_BF16> struct EpiResid {
    static constexpr bool PERM = false, AFTER_DRAIN = false;
    const float* xin_lat; const float* xin_ctx; int nlat; bf16_t* XR; int ldc; const float* mod; int mod_stride; int seq; float* rssp;
    struct Pre {}; __device__ __forceinline__ void preload(Pre&, const Unit&, int, int, int, int) const {}
    __device__ __forceinline__ void operator()(const f32x4 (&acc)[2][2][4][2], const Unit& u, int wr, int wc, int fr, int fq, const Pre&) const {
        typedef unsigned u32x2 __attribute__((ext_vector_type(2)));
        const int row0 = u.pm * BM + wr * 64 + fr, col0 = u.pn * BM + wc * 32 + 4 * fq;
        const int rowt = u.pm * BM; const int bidx = rowt < nlat ? rowt / seq : 4;
        const float* gate = mod + (size_t)bidx * mod_stride;
        const float* xin = rowt < nlat ? xin_lat : (xin_ctx - (size_t)nlat * ldc);
        f32x4 gv[2][2];
#pragma unroll
        for (int bj = 0; bj < 2; ++bj)
#pragma unroll
            for (int n = 0; n < 2; ++n) gv[bj][n] = *(const f32x4*)(gate + col0 + bj * HALF + n * 16);
#pragma unroll
        for (int ai = 0; ai < 2; ++ai)
#pragma unroll
            for (int m = 0; m < 4; ++m) { const int row = row0 + ai * HALF + m * 16; const size_t ro = (size_t)row * ldc + col0; float s2 = 0.f;
#pragma unroll
                for (int bj = 0; bj < 2; ++bj)
#pragma unroll
                    for (int n = 0; n < 2; ++n) { const size_t idx = ro + bj * HALF + n * 16; f32x4 xv;
                        if (XIN_BF16) { const u32x2 w = *(const u32x2*)(XR + idx); xv = (f32x4){__builtin_bit_cast(float, w.x << 16), __builtin_bit_cast(float, w.x & 0xffff0000u), __builtin_bit_cast(float, w.y << 16), __builtin_bit_cast(float, w.y & 0xffff0000u)}; }
                        else xv = *(const f32x4*)(xin + idx);
                        const f32x4 v = xv + gv[bj][n] * acc[ai][bj][m][n];
                        s2 += (v[0] * v[0] + v[1] * v[1]) + (v[2] * v[2] + v[3] * v[3]);
                        u32x2 o; o.x = cvt_pk_bf16(v[0], v[1]); o.y = cvt_pk_bf16(v[2], v[3]); *(u32x2*)(XR + idx) = o; }
                s2 += __shfl_xor(s2, 16); s2 += __shfl_xor(s2, 32);
                if (fq == 0) rssp[(size_t)row * 16 + u.pn * 4 + wc] = s2; }
    }
};
struct EpiSwiglu {
    static constexpr bool PERM = true, AFTER_DRAIN = false;
    bf16_t* O; int ldc; const float* bias; int bias_stride;
    struct Pre { unsigned bw[2][2][2]; };
    __device__ __forceinline__ void preload(Pre& p, const Unit& u, int wr, int wc, int fr, int fq) const {
        const float* bb = bias + (size_t)u.e * bias_stride + u.pn * BM + wc * 32 + 8 * fq;
#pragma unroll
        for (int bj = 0; bj < 2; ++bj)
#pragma unroll
            for (int n = 0; n < 2; ++n) { const f32x4 v = *(const f32x4*)(bb + bj * HALF + 4 * n); p.bw[bj][n][0] = cvt_pk_bf16(v[0], v[1]); p.bw[bj][n][1] = cvt_pk_bf16(v[2], v[3]); }
    }
    __device__ __forceinline__ void operator()(const f32x4 (&acc)[2][2][4][2], const Unit& u, int wr, int wc, int fr, int fq, const Pre& pre) const {
        const int row0 = u.pm * BM + wr * 64 + fr; const int bcol0 = u.pn * BM + wc * 32 + 8 * fq; const int ocol0 = bcol0 >> 1;
        f32x4 bv[2][2];
#pragma unroll
        for (int bj = 0; bj < 2; ++bj)
#pragma unroll
            for (int n = 0; n < 2; ++n) { const unsigned w0 = pre.bw[bj][n][0], w1 = pre.bw[bj][n][1];
                bv[bj][n] = (f32x4){__builtin_bit_cast(float, w0 << 16), __builtin_bit_cast(float, w0 & 0xffff0000u), __builtin_bit_cast(float, w1 << 16), __builtin_bit_cast(float, w1 & 0xffff0000u)}; }
#pragma unroll
        for (int ai = 0; ai < 2; ++ai)
#pragma unroll
            for (int m = 0; m < 4; ++m) { bf16_t* rowp = O + (size_t)(row0 + ai * HALF + m * 16) * ldc + ocol0;
#pragma unroll
                for (int bj = 0; bj < 2; ++bj) { const f32x4 v0 = acc[ai][bj][m][0] + bv[bj][0], v1 = acc[ai][bj][m][1] + bv[bj][1];
                    float o[4];
#pragma unroll
                    for (int p = 0; p < 4; ++p) { const float hg = p < 2 ? v0[2 * p] : v1[2 * p - 4], hl = p < 2 ? v0[2 * p + 1] : v1[2 * p - 3];
                        const float glu = fminf(hg, 7.0f), lin = fminf(fmaxf(hl, -7.0f), 7.0f);
                        const float sg = __builtin_amdgcn_rcpf(1.0f + __builtin_amdgcn_exp2f(-1.702f * 1.4426950408889634f * glu));
                        o[p] = glu * sg * (lin + 1.0f); }
                    typedef unsigned u32x2 __attribute__((ext_vector_type(2)));
                    u32x2 w; w.x = cvt_pk_bf16(o[0], o[1]); w.y = cvt_pk_bf16(o[2], o[3]);
                    *(u32x2*)(rowp + bj * (HALF / 2)) = w; } }
    }
};
struct EpiSwigluF8 {
    static constexpr bool PERM = true, AFTER_DRAIN = false;
    bf16_t* O; int ldc; const float* bias; int bias_stride;
    struct Pre { unsigned bw[2][2][2]; };
    __device__ __forceinline__ void preload(Pre& p, const Unit& u, int wr, int wc, int fr, int fq) const {
        const float* bb = bias + (size_t)u.e * bias_stride + u.pn * BM + wc * 32 + 8 * fq;
#pragma unroll
        for (int bj = 0; bj < 2; ++bj)
#pragma unroll
            for (int n = 0; n < 2; ++n) { const f32x4 v = *(const f32x4*)(bb + bj * HALF + 4 * n); p.bw[bj][n][0] = cvt_pk_bf16(v[0], v[1]); p.bw[bj][n][1] = cvt_pk_bf16(v[2], v[3]); }
    }
    __device__ __forceinline__ void operator()(const f32x4 (&acc)[2][2][4][2], const Unit& u, int wr, int wc, int fr, int fq, const Pre& pre) const {
        asm volatile("" : "+v"(fr), "+v"(fq));
        const int row0 = u.pm * BM + wr * 64 + fr; const int bcol0 = u.pn * BM + wc * 32 + 8 * fq; const int ocol0 = bcol0 >> 1;
        f32x4 bv[2][2];
#pragma unroll
        for (int bj = 0; bj < 2; ++bj)
#pragma unroll
            for (int n = 0; n < 2; ++n) { const unsigned w0 = pre.bw[bj][n][0], w1 = pre.bw[bj][n][1];
                bv[bj][n] = (f32x4){__builtin_bit_cast(float, w0 << 16), __builtin_bit_cast(float, w0 & 0xffff0000u), __builtin_bit_cast(float, w1 << 16), __builtin_bit_cast(float, w1 & 0xffff0000u)}; }
#pragma unroll
        for (int ai = 0; ai < 2; ++ai)
#pragma unroll
            for (int m = 0; m < 4; ++m) {
#pragma unroll
                for (int bj = 0; bj < 2; ++bj) { const f32x4 v0 = acc[ai][bj][m][0] * (1.0f / (F8_SF * F8_SW)) + bv[bj][0], v1 = acc[ai][bj][m][1] * (1.0f / (F8_SF * F8_SW)) + bv[bj][1];
                    float o[4];
#pragma unroll
                    for (int p = 0; p < 4; ++p) { const float hg = p < 2 ? v0[2 * p] : v1[2 * p - 4], hl = p < 2 ? v0[2 * p + 1] : v1[2 * p - 3];
                        const float glu = fminf(hg, 7.0f), lin = fminf(fmaxf(hl, -7.0f), 7.0f);
                        const float sg = __builtin_amdgcn_rcpf(1.0f + __builtin_amdgcn_exp2f(-1.702f * 1.4426950408889634f * glu));
                        o[p] = glu * sg * (lin + 1.0f); }
                    *(unsigned*)((unsigned char*)O + (size_t)(row0 + ai * HALF + m * 16) * ldc + ocol0 + bj * (HALF / 2)) = pack4_fp8(o[0] * F8_SA, o[1] * F8_SA, o[2] * F8_SA, o[3] * F8_SA); } }
    }
};
struct EpiBf16Bias {
    static constexpr bool PERM = true, AFTER_DRAIN = false;
    bf16_t* O; int ldc; const float* bias; int bias_stride;
    struct Pre { f32x4 bv[2][2]; };
    __device__ __forceinline__ void preload(Pre& p, const Unit& u, int wr, int wc, int fr, int fq) const {
        const float* bb = bias + (size_t)u.e * bias_stride + u.pn * BM + wc * 32 + 8 * fq;
#pragma unroll
        for (int bj = 0; bj < 2; ++bj)
#pragma unroll
            for (int n = 0; n < 2; ++n) p.bv[bj][n] = *(const f32x4*)(bb + bj * HALF + 4 * n);
    }
    __device__ __forceinline__ void operator()(const f32x4 (&acc)[2][2][4][2], const Unit& u, int wr, int wc, int fr, int fq, const Pre& pre) const {
        const int row0 = u.pm * BM + wr * 64 + fr; const int col0 = u.pn * BM + wc * 32 + 8 * fq;
#pragma unroll
        for (int ai = 0; ai < 2; ++ai)
#pragma unroll
            for (int m = 0; m < 4; ++m) { bf16_t* rowp = O + (size_t)(row0 + ai * HALF + m * 16) * ldc + col0;
#pragma unroll
                for (int bj = 0; bj < 2; ++bj) { const f32x4 v0 = acc[ai][bj][m][0] + pre.bv[bj][0], v1 = acc[ai][bj][m][1] + pre.bv[bj][1];
                    u32x4 w; w.x = cvt_pk_bf16(v0[0], v0[1]); w.y = cvt_pk_bf16(v0[2], v0[3]); w.z = cvt_pk_bf16(v1[0], v1[1]); w.w = cvt_pk_bf16(v1[2], v1[3]);
                    *(u32x4*)(rowp + bj * HALF) = w; } }
    }
};
struct EpiBf16BiasFold {
    static constexpr bool PERM = true, AFTER_DRAIN = false;
    bf16_t* O; int ldc; const float* bias; int bias_stride;
    struct Pre { f32x4 bv[2][2]; };
    __device__ __forceinline__ void preload(Pre& p, const Unit& u, int wr, int wc, int fr, int fq) const {
        const float* bb = bias + (size_t)u.e * bias_stride + u.pn * BM + wc * 32 + 8 * fq;
#pragma unroll
        for (int bj = 0; bj < 2; ++bj)
#pragma unroll
            for (int n = 0; n < 2; ++n) p.bv[bj][n] = *(const f32x4*)(bb + bj * HALF + 4 * n);
    }
    __device__ __forceinline__ void operator()(const f32x4 (&acc)[2][2][4][2], const Unit& u, int wr, int wc, int fr, int fq, const Pre& pre) const {
        const int row0 = u.pm * BM + wr * 64 + fr; const int col0 = u.pn * BM + wc * 32 + 8 * fq;
#pragma unroll
        for (int ai = 0; ai < 2; ++ai)
#pragma unroll
            for (int m = 0; m < 4; ++m) { bf16_t* rowp = O + (size_t)((row0 + ai * HALF + m * 16) & 255) * ldc + col0;
#pragma unroll
                for (int bj = 0; bj < 2; ++bj) { const f32x4 v0 = acc[ai][bj][m][0] + pre.bv[bj][0], v1 = acc[ai][bj][m][1] + pre.bv[bj][1];
                    u32x4 w; w.x = cvt_pk_bf16(v0[0], v0[1]); w.y = cvt_pk_bf16(v0[2], v0[3]); w.z = cvt_pk_bf16(v1[0], v1[1]); w.w = cvt_pk_bf16(v1[2], v1[3]);
                    *(u32x4*)(rowp + bj * HALF) = w; } }
    }
};
struct EpiBf16BiasF8 {
    static constexpr bool PERM = true, AFTER_DRAIN = false;
    bf16_t* O; int ldc; const float* bias; int bias_stride;
    struct Pre { f32x4 bv[2][2]; };
    __device__ __forceinline__ void preload(Pre& p, const Unit& u, int wr, int wc, int fr, int fq) const {
        const float* bb = bias + (size_t)u.e * bias_stride + u.pn * BM + wc * 32 + 8 * fq;
#pragma unroll
        for (int bj = 0; bj < 2; ++bj)
#pragma unroll
            for (int n = 0; n < 2; ++n) p.bv[bj][n] = *(const f32x4*)(bb + bj * HALF + 4 * n);
    }
    __device__ __forceinline__ void operator()(const f32x4 (&acc)[2][2][4][2], const Unit& u, int wr, int wc, int fr, int fq, const Pre& pre) const {
        asm volatile("" : "+v"(fr), "+v"(fq));
        const int row0 = u.pm * BM + wr * 64 + fr; const int col0 = u.pn * BM + wc * 32 + 8 * fq;
#pragma unroll
        for (int ai = 0; ai < 2; ++ai)
#pragma unroll
            for (int m = 0; m < 4; ++m) { bf16_t* rowp = O + (size_t)(row0 + ai * HALF + m * 16) * ldc + col0;
#pragma unroll
                for (int bj = 0; bj < 2; ++bj) { const f32x4 v0 = acc[ai][bj][m][0] * (1.0f / (F8_SA * F8_SW)) + pre.bv[bj][0], v1 = acc[ai][bj][m][1] * (1.0f / (F8_SA * F8_SW)) + pre.bv[bj][1];
                    u32x4 w; w.x = cvt_pk_bf16(v0[0], v0[1]); w.y = cvt_pk_bf16(v0[2], v0[3]); w.z = cvt_pk_bf16(v1[0], v1[1]); w.w = cvt_pk_bf16(v1[2], v1[3]);
                    *(u32x4*)(rowp + bj * HALF) = w; } }
    }
};
struct EpiF8BiasF8 {
    static constexpr bool PERM = true, AFTER_DRAIN = false;
    bf16_t* O; int ldc; const float* bias; int bias_stride;
    struct Pre { f32x4 bv[2][2]; };
    __device__ __forceinline__ void preload(Pre& p, const Unit& u, int wr, int wc, int fr, int fq) const {
        const float* bb = bias + (size_t)u.e * bias_stride + u.pn * BM + wc * 32 + 8 * fq;
#pragma unroll
        for (int bj = 0; bj < 2; ++bj)
#pragma unroll
            for (int n = 0; n < 2; ++n) p.bv[bj][n] = *(const f32x4*)(bb + bj * HALF + 4 * n);
    }
    __device__ __forceinline__ void operator()(const f32x4 (&acc)[2][2][4][2], const Unit& u, int wr, int wc, int fr, int fq, const Pre& pre) const {
        asm volatile("" : "+v"(fr), "+v"(fq));
        const int row0 = u.pm * BM + wr * 64 + fr; const int col0 = u.pn * BM + wc * 32 + 8 * fq;
#pragma unroll
        for (int ai = 0; ai < 2; ++ai)
#pragma unroll
            for (int m = 0; m < 4; ++m) { unsigned char* rowp = (unsigned char*)O + (size_t)(row0 + ai * HALF + m * 16) * ldc + col0;
#pragma unroll
                for (int bj = 0; bj < 2; ++bj) { const f32x4 v0 = (acc[ai][bj][m][0] * (1.0f / (F8_SA * F8_SW)) + pre.bv[bj][0]) * F8_SY, v1 = (acc[ai][bj][m][1] * (1.0f / (F8_SA * F8_SW)) + pre.bv[bj][1]) * F8_SY;
                    typedef unsigned u32x2 __attribute__((ext_vector_type(2)));
                    u32x2 w; w.x = pack4_fp8(v0[0], v0[1], v0[2], v0[3]); w.y = pack4_fp8(v1[0], v1[1], v1[2], v1[3]);
                    *(u32x2*)(rowp + bj * HALF) = w; } }
    }
};
struct EpiLruGate {
    static constexpr bool PERM = false, AFTER_DRAIN = false;
    const bf16_t* XL; bf16_t* LAB; size_t lab_stride; const float* gb; const float* spt;
    struct Pre {}; __device__ __forceinline__ void preload(Pre&, const Unit&, int, int, int, int) const {}
    __device__ __forceinline__ void operator()(const f32x4 (&acc)[2][2][4][2], const Unit& u, int wr, int wc, int fr, int fq, const Pre&) const {
        const int d = u.pn >> 1, half = u.pn & 1;
        const int row0 = u.pm * BM + wr * 64 + fr, ch0 = half * 128 + wc * 32 + 4 * fq;
        bf16_t* LA = LAB + (size_t)(2 * d) * lab_stride; bf16_t* LB = LAB + (size_t)(2 * d + 1) * lab_stride;
#pragma unroll
        for (int n = 0; n < 2; ++n) {
            const f32x4 bR = *(const f32x4*)(gb + (d * 2 + 0) * 256 + ch0 + 16 * n), bI = *(const f32x4*)(gb + (d * 2 + 1) * 256 + ch0 + 16 * n);
            const f32x4 sp = *(const f32x4*)(spt + d * 256 + ch0 + 16 * n) * (-8.0f * 1.4426950408889634f);
#pragma unroll
            for (int ai = 0; ai < 2; ++ai)
#pragma unroll
                for (int m = 0; m < 4; ++m) { const size_t ro = (size_t)(row0 + ai * HALF + m * 16) * 256 + ch0 + 16 * n;
                    typedef unsigned u32x2 __attribute__((ext_vector_type(2)));
                    const u32x2 xw = *(const u32x2*)(XL + ro);
                    const float xl[4] = {__builtin_bit_cast(float, xw.x << 16), __builtin_bit_cast(float, xw.x & 0xffff0000u), __builtin_bit_cast(float, xw.y << 16), __builtin_bit_cast(float, xw.y & 0xffff0000u)};
                    const f32x4 gr = acc[ai][0][m][n] + bR, gi = acc[ai][1][m][n] + bI;
                    f32x4 av, bv;
#pragma unroll
                    for (int e = 0; e < 4; ++e) {
                        const float rg = __builtin_amdgcn_rcpf(1.0f + __builtin_amdgcn_exp2f(-1.4426950408889634f * gr[e])), ig = __builtin_amdgcn_rcpf(1.0f + __builtin_amdgcn_exp2f(-1.4426950408889634f * gi[e]));
                        const float la2 = rg * sp[e];
                        const float a2 = __builtin_amdgcn_exp2f(2.0f * la2);
                        av[e] = la2; bv[e] = __builtin_amdgcn_sqrtf(fmaxf(1.0f - a2, 0.f)) * (ig * xl[e]); }
                    u32x2 wa, wb; wa.x = cvt_pk_bf16(av[0], av[1]); wa.y = cvt_pk_bf16(av[2], av[3]); wb.x = cvt_pk_bf16(bv[0], bv[1]); wb.y = cvt_pk_bf16(bv[2], bv[3]);
                    *(u32x2*)(LA + ro) = wa; *(u32x2*)(LB + ro) = wb; }
        }
    }
};
struct EpiNone {
    static constexpr bool PERM = true, AFTER_DRAIN = false;
    struct Pre {}; __device__ __forceinline__ void preload(Pre&, const Unit&, int, int, int, int) const {}
    __device__ __forceinline__ void operator()(const f32x4 (&acc)[2][2][4][2], const Unit& u, int wr, int wc, int fr, int fq, const Pre&) const {
#pragma unroll
        for (int a = 0; a < 2; ++a)
#pragma unroll
            for (int b2 = 0; b2 < 2; ++b2)
#pragma unroll
                for (int m = 0; m < 4; ++m)
#pragma unroll
                    for (int n = 0; n < 2; ++n) { f32x4 v = acc[a][b2][m][n]; asm volatile("" :: "v"(v)); }
    }
};
template <bool GATHER_> struct MoeOrderT {
    static constexpr bool GATHER = GATHER_;
    const int* rowtok;
    __device__ __forceinline__ int row_of(int r) const { return GATHER_ ? rowtok[r] : r; }
    const PG8_LAS int* tab; int ntiles, nN, nper, j, m_lo, nMx, wgm, rev;
    __device__ __forceinline__ void init(const PG8_LAS int* tab_, int ntiles_, int nN_, int G, int bx, int wgm_) {
        tab = tab_; ntiles = ntiles_; nN = nN_; wgm = wgm_; rev = 0;
        if (G % 8 == 0) { const int x = bx % 8; nper = G / 8; j = bx / 8; m_lo = (x * ntiles) / 8; nMx = ((x + 1) * ntiles) / 8 - m_lo; }
        else { nper = G; j = bx; m_lo = 0; nMx = ntiles; }
    }
    __device__ __forceinline__ bool next(int i, Unit& u) const {
        const int s = i * nper + j; if (s >= nMx * nN) return false;
        const int nig = wgm * nN, gid = s / nig, fm = gid * wgm, gsz = (nMx - fm) < wgm ? (nMx - fm) : wgm, w = s - gid * nig;
        const int mi = fm + (w % gsz); u.pm = m_lo + (rev ? (nMx - 1 - mi) : mi); u.pn = w / gsz; u.e = tab[u.pm]; u.be = u.e * nN + u.pn; return true;
    }
    __device__ __forceinline__ void a_ready(const Unit&) const {}
    __device__ __forceinline__ void done(const Unit&) const {}
};
template <class Epi, class Sched, bool ALIGN_EPI = false, bool SP2 = false, bool FP8 = false>
__device__ __forceinline__ void gemm_phase(PG8_LAS unsigned char* lds, const Gemm g, const Sched& S, const Epi& E) {
    int tid_ = threadIdx.x; asm volatile("" : "+v"(tid_));
    const int tid = tid_, wid = __builtin_amdgcn_readfirstlane(tid >> 6), lane = tid & 63, wr = wid >> 2, wc = wid & 3, fr = lane & 15, fq = lane >> 4;
    const int K = g.K, nt = K / BK;
    unsigned voffA[2], voffB[2];
#pragma unroll
    for (int i = 0; i < 2; ++i) { int R, C; stage_rc(tid * 16 + i * 8192, R, C); const int Rb = Epi::PERM ? ((R & ~31) + perm32(R & 31)) : R;
        voffA[i] = (unsigned)(R * K + C) * 2u; voffB[i] = (unsigned)(Rb * K + C) * 2u; }
    unsigned gA_[2] = {0u, 0u}, gN_[2] = {0u, 0u}, gC_[2] = {0u, 0u};
    static_assert(!Sched::GATHER || SP2, "the gathered A operand is wired into the SP2 loop only");
    if constexpr (Sched::GATHER) { _Pragma("unroll") for (int i_ = 0; i_ < 2; ++i_) { int R_, C_; stage_rc(tid * 16 + i_ * 8192, R_, C_); gC_[i_] = (unsigned)(C_ * 2); } }
#define PG8_GLOAD(dst, pm_) do { _Pragma("unroll") for (int h_ = 0; h_ < 2; ++h_) { unsigned t_[2]; _Pragma("unroll") for (int i_ = 0; i_ < 2; ++i_) { int R_, C_; stage_rc(tid * 16 + i_ * 8192, R_, C_); \
        t_[i_] = (unsigned)S.row_of((pm_) * BM + h_ * HALF + R_); } dst[h_] = t_[0] | (t_[1] << 16); } } while (0)
    const size_t kstep = (size_t)(BK * 2);
    const size_t hstep = (size_t)HALF * K * 2;
    const size_t tstep = 2 * hstep;
    const unsigned ldsw = (unsigned)wid * 1024u;
    const int aoff = lds_byte(wr * 64 + fr, fq * 8), boff = lds_byte(wc * 32 + fr, fq * 8);
#define PG8_SA(b, h) (((b) * 2 + (h)) * HTB)
#define PG8_SB(b, h) ((4 + (b) * 2 + (h)) * HTB)
#define PG8_STAGE(bufoff, gbase, voff) do { _Pragma("unroll") for (int _i = 0; _i < 2; ++_i) \
        __builtin_amdgcn_global_load_lds((const unsigned*)((const char*)(gbase) + (voff)[_i]), (PG8_LAS unsigned*)(lds + (bufoff) + ldsw + _i * 8192), 16, 0, 0); } while (0)
#define PG8_STA(bufoff, ptr, h, useN) do { if constexpr (Sched::GATHER) { const unsigned pk_ = (useN) ? gN_[h] : gA_[h]; unsigned o_[2] = {(pk_ & 0xffffu) * (unsigned)(K * 2) + gC_[0], (pk_ >> 16) * (unsigned)(K * 2) + gC_[1]}; PG8_STAGE(bufoff, ptr, o_); } \
        else { PG8_STAGE(bufoff, (ptr) + ((h) ? hstep : 0), voffA); } } while (0)
#define PG8_LDA(dst, b, h) do { _Pragma("unroll") for (int m = 0; m < 4; ++m) { if constexpr (FP8) { \
            dst##8[m] = __builtin_shufflevector(*(const PG8_LAS i32x4_*)(lds + PG8_SA(b, h) + aoff + m * 2048), *(const PG8_LAS i32x4_*)(lds + PG8_SA(b, h) + aoff + m * 2048 + 1024), 0, 1, 2, 3, 4, 5, 6, 7); } \
        else { _Pragma("unroll") for (int k = 0; k < 2; ++k) dst[m][k] = *(const PG8_LAS bf16x8*)(lds + PG8_SA(b, h) + aoff + m * 2048 + k * 1024); } } } while (0)
#define PG8_LDB(dst, b, h) do { _Pragma("unroll") for (int n = 0; n < 2; ++n) { if constexpr (FP8) { \
            dst##8[n] = __builtin_shufflevector(*(const PG8_LAS i32x4_*)(lds + PG8_SB(b, h) + boff + n * 2048), *(const PG8_LAS i32x4_*)(lds + PG8_SB(b, h) + boff + n * 2048 + 1024), 0, 1, 2, 3, 4, 5, 6, 7); } \
        else { _Pragma("unroll") for (int k = 0; k < 2; ++k) dst[n][k] = *(const PG8_LAS bf16x8*)(lds + PG8_SB(b, h) + boff + n * 2048 + k * 1024); } } } while (0)
#define PG8_MMA(ai, bj, At, Bt) do { __builtin_amdgcn_s_setprio(1); _Pragma("unroll") for (int m = 0; m < 4; ++m) _Pragma("unroll") for (int n = 0; n < 2; ++n) { \
        if constexpr (FP8) asm volatile("v_mfma_f32_16x16x128_f8f6f4 %0, %1, %2, %0" : "+v"(acc[ai][bj][m][n]) : "v"(Bt##8[n]), "v"(At##8[m]));   \
        else { _Pragma("unroll") for (int k = 0; k < 2; ++k) acc[ai][bj][m][n] = __builtin_amdgcn_mfma_f32_16x16x32_bf16(Bt[n][k], At[m][k], acc[ai][bj][m][n], 0, 0, 0); } } \
        __builtin_amdgcn_s_setprio(0); } while (0)
#define PG8_WAIT_V(n) asm volatile("s_waitcnt vmcnt(" #n ")" ::: "memory")
#define PG8_WAIT_L(n) asm volatile("s_waitcnt lgkmcnt(" #n ")" ::: "memory")
#define PG8_BAR __builtin_amdgcn_s_barrier()
#define PG8_SCHED __builtin_amdgcn_sched_barrier(0)
    Unit cur, nxt; int ui = 0;
    if (!S.next(0, cur)) return;
    f32x4 acc[2][2][4][2];
#pragma unroll
    for (int a = 0; a < 2; ++a)
#pragma unroll
        for (int b = 0; b < 2; ++b)
#pragma unroll
            for (int m = 0; m < 4; ++m)
#pragma unroll
                for (int n = 0; n < 2; ++n) acc[a][b][m][n] = (f32x4){0.f, 0.f, 0.f, 0.f};
    typedef int i32x4_ __attribute__((ext_vector_type(4))); typedef int i32x8_ __attribute__((ext_vector_type(8)));
    bf16x8 At[4][2], B0[2][2], B1[2][2]; i32x8_ At8[4], B08[2], B18[2];
    typename Epi::Pre pre;
    const char* cA = (const char*)g.A + (Sched::GATHER ? (size_t)0 : (size_t)cur.pm * tstep); if constexpr (Sched::GATHER) PG8_GLOAD(gA_, cur.pm);
    const char* cB = (const char*)g.Bt + (size_t)cur.be * tstep;
    S.a_ready(cur);
    if constexpr (SP2) {
        PG8_STAGE(PG8_SB(0, 0), cB, voffB); PG8_STAGE(PG8_SB(0, 1), cB + hstep, voffB); PG8_STA(PG8_SA(0, 0), cA, 0, false); PG8_STA(PG8_SA(0, 1), cA, 1, false);
        if (wr == 1) PG8_BAR;
        PG8_WAIT_V(2); PG8_BAR;
        PG8_STAGE(PG8_SB(1, 0), cB + kstep, voffB); PG8_STA(PG8_SA(1, 0), cA + kstep, 0, false); PG8_STAGE(PG8_SB(1, 1), cB + hstep + kstep, voffB);
        PG8_WAIT_V(6); PG8_BAR;
    } else {
        PG8_STAGE(PG8_SB(0, 0), cB, voffB); PG8_STAGE(PG8_SA(0, 0), cA, voffA); PG8_STAGE(PG8_SB(0, 1), cB + hstep, voffB); PG8_STAGE(PG8_SA(0, 1), cA + hstep, voffA);
        if (wr == 1) PG8_BAR;
        PG8_WAIT_V(4); PG8_BAR;
        PG8_STAGE(PG8_SB(1, 0), cB + kstep, voffB); PG8_STAGE(PG8_SA(1, 0), cA + kstep, voffA); PG8_STAGE(PG8_SB(1, 1), cB + hstep + kstep, voffB);
        PG8_WAIT_V(6); PG8_BAR;
    }
    for (;;) {
        const bool has_next = S.next(ui + 1, nxt);
        const char* nA = (has_next && !Sched::GATHER) ? (const char*)g.A + (size_t)nxt.pm * tstep : cA; const char* nB = has_next ? (const char*)g.Bt + (size_t)nxt.be * tstep : cB;
        if constexpr (Sched::GATHER) { if (has_next) PG8_GLOAD(gN_, nxt.pm); else { gN_[0] = gA_[0]; gN_[1] = gA_[1]; } }
        for (int t = 0; t < nt; t += 2) {
            const bool last = (t == nt - 2);
            const char* a1 = cA + (size_t)(t + 1) * kstep;
            const char* a2 = last ? nA : cA + (size_t)(t + 2) * kstep; const char* b2 = last ? nB : cB + (size_t)(t + 2) * kstep;
            const char* a3 = a2 + kstep; const char* b3 = b2 + kstep;
            if (last) E.preload(pre, cur, wr, wc, fr, fq);
            if (last && has_next) S.a_ready(nxt);
            if constexpr (SP2) {
            PG8_LDB(B0, 0, 0); PG8_LDB(B1, 0, 1); PG8_SCHED; PG8_LDA(At, 0, 0); PG8_STA(PG8_SA(1, 1), a1, 1, false);
            PG8_WAIT_V(8); PG8_WAIT_L(0); PG8_BAR; PG8_MMA(0, 0, At, B0); PG8_MMA(0, 1, At, B1); PG8_BAR; PG8_SCHED;
            PG8_LDA(At, 0, 1); PG8_STAGE(PG8_SB(0, 0), b2, voffB); PG8_STAGE(PG8_SB(0, 1), b2 + hstep, voffB); PG8_STA(PG8_SA(0, 0), a2, 0, last);
            PG8_WAIT_V(8); PG8_WAIT_L(0); PG8_BAR; PG8_MMA(1, 0, At, B0); PG8_MMA(1, 1, At, B1); PG8_BAR; PG8_SCHED;
            PG8_LDB(B0, 1, 0); PG8_LDB(B1, 1, 1); PG8_SCHED; PG8_LDA(At, 1, 0); PG8_STA(PG8_SA(0, 1), a2, 1, last);
            PG8_WAIT_V(8); PG8_WAIT_L(0); PG8_BAR; PG8_MMA(0, 0, At, B0); PG8_MMA(0, 1, At, B1); PG8_BAR; PG8_SCHED;
            PG8_LDA(At, 1, 1); PG8_STAGE(PG8_SB(1, 0), b3, voffB); PG8_STAGE(PG8_SB(1, 1), b3 + hstep, voffB); PG8_STA(PG8_SA(1, 0), a3, 0, last);
            PG8_WAIT_V(8); PG8_WAIT_L(0); PG8_BAR; PG8_MMA(1, 0, At, B0); PG8_MMA(1, 1, At, B1); PG8_BAR; PG8_SCHED;
            } else {
            PG8_LDB(B0, 0, 0); PG8_SCHED; PG8_LDA(At, 0, 0); PG8_STAGE(PG8_SA(1, 1), a1 + hstep, voffA);
            PG8_WAIT_L(8); PG8_BAR; PG8_WAIT_L(0); PG8_MMA(0, 0, At, B0); PG8_BAR; PG8_SCHED;
            PG8_LDB(B1, 0, 1); PG8_STAGE(PG8_SB(0, 0), b2, voffB);
            PG8_BAR; PG8_WAIT_L(0); PG8_MMA(0, 1, At, B1); PG8_BAR;
            PG8_LDA(At, 0, 1); PG8_STAGE(PG8_SA(0, 0), a2, voffA);
            PG8_BAR; PG8_WAIT_L(0); PG8_MMA(1, 0, At, B0); PG8_BAR; PG8_SCHED;
            PG8_STAGE(PG8_SB(0, 1), b2 + hstep, voffB);
            PG8_WAIT_V(6); PG8_BAR; PG8_MMA(1, 1, At, B1); PG8_BAR;
            PG8_LDB(B0, 1, 0); PG8_SCHED; PG8_LDA(At, 1, 0); PG8_STAGE(PG8_SA(0, 1), a2 + hstep, voffA);
            PG8_WAIT_L(8); PG8_BAR; PG8_WAIT_L(0); PG8_MMA(0, 0, At, B0); PG8_BAR; PG8_SCHED;
            PG8_LDB(B1, 1, 1); PG8_STAGE(PG8_SB(1, 0), b3, voffB);
            PG8_BAR; PG8_WAIT_L(0); PG8_MMA(0, 1, At, B1); PG8_BAR;
            PG8_LDA(At, 1, 1); PG8_STAGE(PG8_SA(1, 0), a3, voffA);
            PG8_BAR; PG8_WAIT_L(0); PG8_MMA(1, 0, At, B0); PG8_BAR; PG8_SCHED;
            PG8_STAGE(PG8_SB(1, 1), b3 + hstep, voffB);
            PG8_WAIT_V(6); PG8_BAR; PG8_MMA(1, 1, At, B1); PG8_BAR;
            }
        }
        if constexpr (ALIGN_EPI) { if (wr == 0) PG8_BAR; }
        if constexpr (!Epi::AFTER_DRAIN) { E(acc, cur, wr, wc, fr, fq, pre); S.done(cur); }
        if (!has_next) break;
#pragma unroll
        for (int a = 0; a < 2; ++a)
#pragma unroll
            for (int b = 0; b < 2; ++b)
#pragma unroll
                for (int m = 0; m < 4; ++m)
#pragma unroll
                    for (int n = 0; n < 2; ++n) acc[a][b][m][n] = (f32x4){0.f, 0.f, 0.f, 0.f};
        cur = nxt; cA = nA; cB = nB; ++ui;
        if constexpr (Sched::GATHER) { gA_[0] = gN_[0]; gA_[1] = gN_[1]; }
        if constexpr (ALIGN_EPI) { if (wr == 1) PG8_BAR; }
    }
    PG8_WAIT_V(0);
    if constexpr (!ALIGN_EPI) { if (wr == 0) PG8_BAR; }
    PG8_BAR;
    if constexpr (Epi::AFTER_DRAIN) { E.fused(acc, cur, wr, wc, fr, fq, lds, wid, lane); S.done(cur); }
#undef PG8_SA
#undef PG8_SB
#undef PG8_STAGE
#undef PG8_STA
#undef PG8_GLOAD
#undef PG8_LDA
#undef PG8_LDB
#undef PG8_MMA
#undef PG8_WAIT_V
#undef PG8_WAIT_L
#undef PG8_BAR
#undef PG8_SCHED
}
}

#ifndef PG8_SP2
#define PG8_SP2 true
#endif
#ifndef PG8_ALIGN
#define PG8_ALIGN true
#endif
#include <cmath>
namespace attn_body {
using bf16=__hip_bfloat16;
using bf16x8=__attribute__((ext_vector_type(8)))short;
using s16x4=__attribute__((ext_vector_type(4)))short;
using f32x16=__attribute__((ext_vector_type(16)))float;
using u32x4=__attribute__((ext_vector_type(4)))unsigned;
using f32x4_t=__attribute__((ext_vector_type(4)))float;
constexpr int NHEAD=8,SEQQ=8192,SEQK=8448,D=64,QP=512,KP=128,QIN=2048;
constexpr int NW=8,QBLK=32,QB=QBLK*NW,KVBLK=64,NQB=SEQQ/QB;
constexpr int ATTN_UNIT_ROWS=QB;
__device__ __forceinline__ int crow(int r,int hi){return (r&3)+8*(r>>2)+4*hi;}
#define SBAR() __builtin_amdgcn_sched_barrier(0)
__device__ __forceinline__ void cmask(f32x16&p0,f32x16&p1,int jb,int qrel,int hi){
  const float NEG=-INFINITY; int kb=64*jb+4*hi;
  #pragma unroll
  for(int r=0;r<16;++r){int kv=kb+(r&3)+8*(r>>2); if(kv>qrel)p0[r]=NEG; if(kv+32>qrel)p1[r]=NEG;}
}

constexpr int NSLOT=3, SLOTB=8192;
constexpr int LDS_K=0, LDS_V=NSLOT*SLOTB, LDS_WS=2*NSLOT*SLOTB, LDS_OST=LDS_WS+NW*64*4, LDS_BYTES=LDS_OST+NW*4096;
constexpr float C2=0.125f*1.4426950408889634f;
__device__ __forceinline__ void glds16(const void*gsrc,unsigned lds_dst){unsigned keep;
  asm volatile("s_mov_b32 %0, m0\n\ts_mov_b32 m0, %2\n\ts_nop 0\n\tglobal_load_lds_dwordx4 %1, off\n\ts_mov_b32 m0, %0":"=&s"(keep):"v"(gsrc),"s"(lds_dst):"memory");}
__device__ __forceinline__ float max3f(float a,float b,float c){float r;asm("v_max3_f32 %0, %1, %2, %3":"=v"(r):"v"(a),"v"(b),"v"(c));return r;}
__device__ __forceinline__ float max2f(float a,float b){float r;asm("v_max_f32_e32 %0, %1, %2":"=v"(r):"v"(a),"v"(b));return r;}
__device__ __forceinline__ float fadd_s(float a,float b){float r;asm("v_add_f32_e32 %0, %1, %2":"=v"(r):"v"(a),"v"(b));return r;}
__device__ __forceinline__ float fsub_s(float a,float b){float r;asm("v_sub_f32_e32 %0, %1, %2":"=v"(r):"v"(a),"v"(b));return r;}
typedef float f32x2_t __attribute__((ext_vector_type(2))); typedef __bf16 bf16x2_t __attribute__((ext_vector_type(2)));
__device__ __forceinline__ unsigned cvtpk_s(float lo,float hi){f32x2_t v={lo,hi};bf16x2_t b=__builtin_convertvector(v,bf16x2_t);return __builtin_bit_cast(unsigned,b);}
#define WAIT_BAR(N) asm volatile("s_waitcnt vmcnt(" #N ") lgkmcnt(0)\n\ts_barrier":::"memory")

__device__ __forceinline__ void qkt(f32x16&p0,f32x16&p1,const char*Kslot,const bf16x8*qr,const f32x16&negm,int r32,int hi){
  const char*kb=Kslot+hi*1024+r32*16;
  #pragma unroll
  for(int d0=0;d0<4;++d0){
    const bf16x8 b0=*reinterpret_cast<const bf16x8*>(kb+d0*2048);
    const bf16x8 b1=*reinterpret_cast<const bf16x8*>(kb+d0*2048+512);
    if(d0==0){p0=__builtin_amdgcn_mfma_f32_32x32x16_bf16(b0,qr[0],negm,0,0,0);p1=__builtin_amdgcn_mfma_f32_32x32x16_bf16(b1,qr[0],negm,0,0,0);}
    else{p0=__builtin_amdgcn_mfma_f32_32x32x16_bf16(b0,qr[d0],p0,0,0,0);p1=__builtin_amdgcn_mfma_f32_32x32x16_bf16(b1,qr[d0],p1,0,0,0);}}
}
typedef __attribute__((address_space(3))) const char* lds_cptr;
typedef short v4i16_t __attribute__((ext_vector_type(4)));
__device__ __forceinline__ void kload8(bf16x8*kf,lds_cptr kp){
  kf[0]=*(const __attribute__((address_space(3))) bf16x8*)(kp);      kf[1]=*(const __attribute__((address_space(3))) bf16x8*)(kp+512);
  kf[2]=*(const __attribute__((address_space(3))) bf16x8*)(kp+2048); kf[3]=*(const __attribute__((address_space(3))) bf16x8*)(kp+2560);
  kf[4]=*(const __attribute__((address_space(3))) bf16x8*)(kp+4096); kf[5]=*(const __attribute__((address_space(3))) bf16x8*)(kp+4608);
  kf[6]=*(const __attribute__((address_space(3))) bf16x8*)(kp+6144); kf[7]=*(const __attribute__((address_space(3))) bf16x8*)(kp+6656);
}
__device__ __forceinline__ void kload2(bf16x8*kf,lds_cptr kp,int j){ kf[2*j]=*(const __attribute__((address_space(3))) bf16x8*)(kp+j*2048); kf[2*j+1]=*(const __attribute__((address_space(3))) bf16x8*)(kp+j*2048+512); }
__device__ __forceinline__ s16x4 vtr(lds_cptr p){ return __builtin_bit_cast(s16x4,__builtin_amdgcn_ds_read_tr16_b64_v4i16((__attribute__((address_space(3))) v4i16_t*)p)); }
__device__ __forceinline__ float rowmax(const f32x16&p0,const f32x16&p1){
  float a=max3f(p0[0],p0[1],p1[0]),b=max3f(p0[2],p0[3],p1[1]);a=max3f(a,p1[2],p1[3]);
  #pragma unroll
  for(int r=4;r<16;r+=4){a=max3f(a,p0[r],p0[r+1]);b=max3f(b,p0[r+2],p0[r+3]);a=max3f(a,p1[r],p1[r+1]);b=max3f(b,p1[r+2],p1[r+3]);}
  const float m=max2f(a,b);
  auto rr=__builtin_amdgcn_permlane32_swap(__float_as_uint(m),__float_as_uint(m),false,false);
  return max2f(__uint_as_float(rr[0]),__uint_as_float(rr[1]));
}
__device__ __forceinline__ void pv(f32x16*o,int vb,bf16x8 pa0,bf16x8 pa1,bf16x8 pa2,bf16x8 pa3){
  #pragma unroll
  for(int d0=0;d0<2;++d0){s16x4 lo[4],hi[4];
    #pragma unroll
    for(int ks=0;ks<4;++ks){
      asm volatile("ds_read_b64_tr_b16 %0,%1 offset:%c2":"=&v"(lo[ks]):"v"(vb),"i"(d0*4096+ks*1024):"memory");
      asm volatile("ds_read_b64_tr_b16 %0,%1 offset:%c2":"=&v"(hi[ks]):"v"(vb),"i"(d0*4096+ks*1024+512):"memory");}
    asm volatile("s_waitcnt lgkmcnt(0)":::"memory");SBAR();
    #define PK(k) (bf16x8){lo[k][0],lo[k][1],lo[k][2],lo[k][3],hi[k][0],hi[k][1],hi[k][2],hi[k][3]}
    o[d0]=__builtin_amdgcn_mfma_f32_32x32x16_bf16(pa0,PK(0),o[d0],0,0,0);
    o[d0]=__builtin_amdgcn_mfma_f32_32x32x16_bf16(pa1,PK(1),o[d0],0,0,0);
    o[d0]=__builtin_amdgcn_mfma_f32_32x32x16_bf16(pa2,PK(2),o[d0],0,0,0);
    o[d0]=__builtin_amdgcn_mfma_f32_32x32x16_bf16(pa3,PK(3),o[d0],0,0,0);
    #undef PK
  }
}

#ifndef ATTN_STORE16
#define ATTN_STORE16(p,v) (*(u32x4*)(p)=(v))
#endif
struct QPre { const float* qg; const float* rc; const float* rs; };
template<int THRL> __device__ __forceinline__ void attn_unit(int b,int h,long qrow0,int NTarg,int tq0,const QPre&QN,const bf16*Q,const bf16*__restrict__ K,const bf16*__restrict__ V,bf16*O,char*shm){
  int tid_=threadIdx.x; asm volatile("":"+v"(tid_)); const int tid=tid_,lane=tid&63,r32=lane&31,hi=lane>>5; const int wid=__builtin_amdgcn_readfirstlane(tid>>6);
  const long krowbase=(long)b*SEQK; const int kvh=h>>2;
  const bf16*Qw=Q+(qrow0+wid*QBLK)*QIN+h*D;
  const bf16*Kh=K+krowbase*KP+kvh*D,*Vh=V+krowbase*KP+kvh*D;
  const unsigned lds0=(unsigned)(uintptr_t)shm;
  float*wsf=(float*)(shm+LDS_WS)+wid*64;
  const bf16*ksrc=Kh+(long)lane*KP+wid*8;
  const bf16*vsrc=Vh+(long)(16*(wid&3)+(lane>>2))*KP+(wid>>2)*32+(lane&3)*8;
  const unsigned kdst=lds0+LDS_K+wid*1024, vdst=lds0+LDS_V+wid*1024;
  #define DMA_K(t,slot) glds16(ksrc+(long)(t)*KVBLK*KP,(unsigned)__builtin_amdgcn_readfirstlane(kdst+(slot)))
  #define DMA_V(t,slot) glds16(vsrc+(long)(t)*KVBLK*KP,(unsigned)__builtin_amdgcn_readfirstlane(vdst+(slot)))
  const int vb0=(int)(lds0+LDS_V)+((lane>>4)&1)*32+(lane&3)*8+(4*hi+((lane&15)>>2))*64;
  const char*Kbase=shm+LDS_K; bf16x8 kf[8];
  const lds_cptr shm3=(lds_cptr)shm; const lds_cptr kp0=shm3+LDS_K+hi*1024+r32*16; const lds_cptr vp0=shm3+LDS_V+((lane>>4)&1)*32+(lane&3)*8+(4*hi+((lane&15)>>2))*64;
  const int NT=NTarg;
  DMA_K(0,0);DMA_V(0,0);DMA_K(1,SLOTB);
  bf16x8 qr[4];
  #pragma unroll
  for(int d0=0;d0<4;++d0)qr[d0]=*reinterpret_cast<const bf16x8*>(&Qw[(long)r32*QIN+d0*16+hi*8]);
  {
    float x[4][8]; float ss=0.f;
    #pragma unroll
    for(int d0=0;d0<4;++d0){
      #pragma unroll
      for(int e=0;e<8;++e){ x[d0][e]=__builtin_bit_cast(float,(unsigned)(unsigned short)qr[d0][e]<<16); ss+=x[d0][e]*x[d0][e]; } }
    ss+=__shfl_xor(ss,32);
    const float rstd=C2/sqrtf(ss*(1.0f/64.0f)+1e-6f);
    #pragma unroll
    for(int d0=0;d0<4;++d0){ const f32x4_t g0=*reinterpret_cast<const f32x4_t*>(QN.qg+16*d0+8*hi), g1=*reinterpret_cast<const f32x4_t*>(QN.qg+16*d0+8*hi+4);
      #pragma unroll
      for(int e=0;e<8;++e) x[d0][e]*=rstd*(e<4?g0[e]:g1[e-4]); }
    if(tq0>=0){ const int t=tq0+wid*QBLK+r32;
      #pragma unroll
      for(int d0=0;d0<2;++d0){ const float*cp=QN.rc+(long)t*32+16*d0+8*hi,*sp=QN.rs+(long)t*32+16*d0+8*hi;
        const f32x4_t c0=*reinterpret_cast<const f32x4_t*>(cp),c1=*reinterpret_cast<const f32x4_t*>(cp+4),s0=*reinterpret_cast<const f32x4_t*>(sp),s1=*reinterpret_cast<const f32x4_t*>(sp+4);
        #pragma unroll
        for(int e=0;e<8;++e){ const float cs=e<4?c0[e]:c1[e-4], sn=e<4?s0[e]:s1[e-4]; const float a=x[d0][e], bq=x[d0+2][e]; x[d0][e]=a*cs-bq*sn; x[d0+2][e]=bq*cs+a*sn; } } }
    #pragma unroll
    for(int d0=0;d0<4;++d0){ u32x4 pk; pk[0]=cvtpk_s(x[d0][0],x[d0][1]); pk[1]=cvtpk_s(x[d0][2],x[d0][3]); pk[2]=cvtpk_s(x[d0][4],x[d0][5]); pk[3]=cvtpk_s(x[d0][6],x[d0][7]); qr[d0]=__builtin_bit_cast(bf16x8,pk); }
  }
  float mhat=0.f,l_reg=0.f;f32x16 o[2];o[0]=f32x16{};o[1]=f32x16{};f32x16 negm=f32x16{};asm volatile("":"+v"(negm));
  const int qrel=wid*QBLK+r32;
  #define CMASK(P0,P1,t) do{}while(0)
  bool resc=false;
  #define START(P0,P1) do{ const float rm=rowmax(P0,P1); resc=false; \
    { const float dl=rm; mhat=fadd_s(mhat,dl); \
      _Pragma("unroll") for(int r=0;r<16;++r){P0[r]=fsub_s(P0[r],dl);P1[r]=fsub_s(P1[r],dl);} \
      _Pragma("unroll") for(int r=0;r<16;++r)negm[r]=-mhat; asm volatile("":"+v"(negm)); } \
    _Pragma("unroll") for(int r=0;r<16;++r)P0[r]=__builtin_amdgcn_exp2f(P0[r]); }while(0)
  #define RESC() do{ if(resc){ asm volatile("s_waitcnt lgkmcnt(0)":::"memory"); \
      _Pragma("unroll") for(int d_=0;d_<2;++d_) _Pragma("unroll") for(int r=0;r<16;++r)o[d_][r]*=wsf[crow(r,hi)]; } }while(0)
  f32x16 pA0,pA1,pB0,pB1;
  int sl_prev=0,sl_cur=0,sl_next=SLOTB;
  #define ROT() do{sl_prev=sl_cur;sl_cur=sl_next;sl_next=(sl_next==(NSLOT-1)*SLOTB)?0:sl_next+SLOTB;}while(0)
  DMA_K(2,2*SLOTB);
  WAIT_BAR(3);
  qkt(pA0,pA1,Kbase,qr,negm,r32,hi);asm volatile("s_nop 15\n\ts_nop 7":"+v"(pA0),"+v"(pA1));CMASK(pA0,pA1,0);
  START(pA0,pA1);
  _Pragma("unroll") for(int r=0;r<16;++r)pA1[r]=__builtin_amdgcn_exp2f(pA1[r]);
  WAIT_BAR(0);
  DMA_K(3,0);DMA_V(1,SLOTB);
  ROT();
  kload8(kf,kp0+sl_cur);
  WAIT_BAR(2);
  s16x4 vlo[8],vhi[8]; u32x4 pw0,pw1,pw2,pw3;
  #define PKW(P,B) cvtpk_s(P[B],P[B+1])
  #define PAF(k) __builtin_bit_cast(bf16x8,pw##k)
  #define VFR(i) (bf16x8){vlo[i][0],vlo[i][1],vlo[i][2],vlo[i][3],vhi[i][0],vhi[i][1],vhi[i][2],vhi[i][3]}
  #define PIN(x) asm volatile("":"+v"(x))
  #define MX3(a,b,c) __builtin_fmaxf(__builtin_fmaxf((a),(b)),(c))
  #define GAPA(MF,A0,A1,A2,A3,W0,W1,PW) do{ MF; sacc+=A0; sacc+=A1; sacc+=A2; sacc+=A3; PIN(sacc); W0; W1; PIN(PW); SBAR(); }while(0)
  #define EX(v) __builtin_amdgcn_exp2f(v)
  #define GAPB(MF,X,B) do{ MF; X[B]=EX(X[B]); X[B+1]=EX(X[B+1]); X[B+2]=EX(X[B+2]); X[B+3]=EX(X[B+3]); PIN(X); SBAR(); }while(0)
  #define VRD(i) do{ vlo[i]=vtr(vp_+(((i)>>2)*4096+((i)&3)*1024)); vhi[i]=vtr(vp_+(((i)>>2)*4096+((i)&3)*1024+512)); }while(0)
  #define KRD(G,j) do{ if(G){ kload2(kf,kp0+sl_next,j); SBAR(); } }while(0)
  #define STEP(C0,C1,P0,P1,t,GK,GV,GL) do{ SBAR(); \
    const lds_cptr vp_=vp0+sl_prev; \
    VRD(0); SBAR(); float sacc=(P0[0]+P0[1]); \
    GAPA(C0=__builtin_amdgcn_mfma_f32_32x32x16_bf16(kf[0],qr[0],negm,0,0,0), P0[2],P0[3],P0[4],P0[5],     pw0[0]=PKW(P0,0), pw0[1]=PKW(P0,2), pw0); \
    VRD(4); SBAR(); GAPA(C1=__builtin_amdgcn_mfma_f32_32x32x16_bf16(kf[1],qr[0],negm,0,0,0), P0[6],P0[7],P0[8],P0[9],     pw0[2]=PKW(P0,4), pw0[3]=PKW(P0,6), pw0); \
    VRD(1); SBAR(); GAPA(C0=__builtin_amdgcn_mfma_f32_32x32x16_bf16(kf[2],qr[1],C0,0,0,0),   P0[10],P0[11],P0[12],P0[13], pw1[0]=PKW(P0,8), pw1[1]=PKW(P0,10), pw1); \
    VRD(5); SBAR(); GAPA(C1=__builtin_amdgcn_mfma_f32_32x32x16_bf16(kf[3],qr[1],C1,0,0,0),   P0[14],P0[15],P1[0],P1[1],   pw1[2]=PKW(P0,12),pw1[3]=PKW(P0,14), pw1); \
    VRD(2); SBAR(); GAPA(C0=__builtin_amdgcn_mfma_f32_32x32x16_bf16(kf[4],qr[2],C0,0,0,0),   P1[2],P1[3],P1[4],P1[5],     pw2[0]=PKW(P1,0), pw2[1]=PKW(P1,2), pw2); \
    VRD(6); SBAR(); GAPA(C1=__builtin_amdgcn_mfma_f32_32x32x16_bf16(kf[5],qr[2],C1,0,0,0),   P1[6],P1[7],P1[8],P1[9],     pw2[2]=PKW(P1,4), pw2[3]=PKW(P1,6), pw2); \
    VRD(3); SBAR(); GAPA(C0=__builtin_amdgcn_mfma_f32_32x32x16_bf16(kf[6],qr[3],C0,0,0,0),   P1[10],P1[11],P1[12],P1[13], pw3[0]=PKW(P1,8), pw3[1]=PKW(P1,10), pw3); \
    VRD(7); SBAR(); GAPA(C1=__builtin_amdgcn_mfma_f32_32x32x16_bf16(kf[7],qr[3],C1,0,0,0),   P1[14],P1[15],0.f,0.f,       pw3[2]=PKW(P1,12),pw3[3]=PKW(P1,14), pw3); \
    l_reg+=sacc; \
    if(GK){DMA_K((t)+3,sl_cur);} if(GV){DMA_V((t)+1,sl_next);} \
    CMASK(C0,C1,t); \
    { float a=MX3(C0[0],C0[1],C1[0]),b=MX3(C0[2],C0[3],C1[1]); a=MX3(a,C1[2],C1[3]); \
      _Pragma("unroll") for(int r=4;r<16;r+=4){a=MX3(a,C0[r],C0[r+1]);b=MX3(b,C0[r+2],C0[r+3]);a=MX3(a,C1[r],C1[r+1]);b=MX3(b,C1[r+2],C1[r+3]);} \
      float rm=__builtin_fmaxf(a,b); { auto rr=__builtin_amdgcn_permlane32_swap(__float_as_uint(rm),__float_as_uint(rm),false,false); rm=__builtin_fmaxf(__uint_as_float(rr[0]),__uint_as_float(rr[1])); } \
      resc=false; \
      if(__builtin_expect(__any(rm>(float)THRL),0)){ const float dl=__builtin_fmaxf(rm,0.f); mhat+=dl; \
        _Pragma("unroll") for(int r=0;r<16;++r){C0[r]-=dl;C1[r]-=dl;} \
        _Pragma("unroll") for(int r=0;r<16;++r)negm[r]=-mhat; asm volatile("":"+v"(negm)); \
        const float f=__builtin_amdgcn_exp2f(-dl); l_reg*=f; if(hi==0)wsf[r32]=f; resc=true; } } \
    SBAR(); \
    GAPB(o[0]=__builtin_amdgcn_mfma_f32_32x32x16_bf16(PAF(0),VFR(0),o[0],0,0,0), C0,0); \
    GAPB(o[1]=__builtin_amdgcn_mfma_f32_32x32x16_bf16(PAF(0),VFR(4),o[1],0,0,0), C0,4); \
    KRD(GL,0); GAPB(o[0]=__builtin_amdgcn_mfma_f32_32x32x16_bf16(PAF(1),VFR(1),o[0],0,0,0), C0,8); \
    KRD(GL,1); GAPB(o[1]=__builtin_amdgcn_mfma_f32_32x32x16_bf16(PAF(1),VFR(5),o[1],0,0,0), C0,12); \
    KRD(GL,2); GAPB(o[0]=__builtin_amdgcn_mfma_f32_32x32x16_bf16(PAF(2),VFR(2),o[0],0,0,0), C1,0); \
    KRD(GL,3); GAPB(o[1]=__builtin_amdgcn_mfma_f32_32x32x16_bf16(PAF(2),VFR(6),o[1],0,0,0), C1,4); \
    GAPB(o[0]=__builtin_amdgcn_mfma_f32_32x32x16_bf16(PAF(3),VFR(3),o[0],0,0,0), C1,8); \
    GAPB(o[1]=__builtin_amdgcn_mfma_f32_32x32x16_bf16(PAF(3),VFR(7),o[1],0,0,0), C1,12); \
    }while(0)
  int t=1;
  #undef CMASK
  #define CMASK(P0,P1,t) do{}while(0)
  for(;t+5<NT;t+=2){
    STEP(pB0,pB1,pA0,pA1,t,true,true,true);     WAIT_BAR(2); RESC(); ROT();
    STEP(pA0,pA1,pB0,pB1,t+1,true,true,true);   WAIT_BAR(2); RESC(); ROT();
  }
  #undef CMASK
  #define CMASK(P0,P1,t) do{}while(0)
  #define ENDW(tt) do{ if((tt)+3<NT){WAIT_BAR(2);} else if((tt)+2<NT){WAIT_BAR(1);} else {WAIT_BAR(0);} }while(0)
  for(;t+1<NT;t+=2){
    STEP(pB0,pB1,pA0,pA1,t,(t+3<NT),(t+1<NT),(t+1<NT));       ENDW(t);   RESC(); ROT();
    STEP(pA0,pA1,pB0,pB1,t+1,(t+4<NT),(t+2<NT),(t+2<NT));     ENDW(t+1); RESC(); ROT();
  }
  STEP(pB0,pB1,pA0,pA1,NT-1,false,false,false); RESC();
  { float sacc=pB0[0]+pB0[1]; _Pragma("unroll") for(int r=2;r<16;++r)sacc+=pB0[r]; _Pragma("unroll") for(int r=0;r<16;++r)sacc+=pB1[r]; l_reg+=sacc;
    pw0=(u32x4){PKW(pB0,0),PKW(pB0,2),PKW(pB0,4),PKW(pB0,6)};pw1=(u32x4){PKW(pB0,8),PKW(pB0,10),PKW(pB0,12),PKW(pB0,14)};pw2=(u32x4){PKW(pB1,0),PKW(pB1,2),PKW(pB1,4),PKW(pB1,6)};pw3=(u32x4){PKW(pB1,8),PKW(pB1,10),PKW(pB1,12),PKW(pB1,14)};
    SBAR(); pv(o,vb0+sl_cur,PAF(0),PAF(1),PAF(2),PAF(3)); }
  #undef PKW
  #undef PAF
  #undef VFR
  #undef PIN
  #undef MX3
  #undef GAPA
  #undef GAPB
  #undef EX
  #undef VRD
  #undef KRD
  #undef STEP
  #undef ENDW
  {auto rr=__builtin_amdgcn_permlane32_swap(__float_as_uint(l_reg),__float_as_uint(l_reg),false,false);l_reg=__uint_as_float(rr[0])+__uint_as_float(rr[1]);}
  if(hi==0)wsf[32+r32]=l_reg;asm volatile("s_waitcnt lgkmcnt(0)":::"memory");
  float rli[16];
  #pragma unroll
  for(int r=0;r<16;++r)rli[r]=__builtin_amdgcn_rcpf(wsf[32+crow(r,hi)]);
  bf16*Ow=O+(qrow0+wid*QBLK)*QP+h*D;
  { bf16*stg=(bf16*)(shm+LDS_OST)+wid*2048;
    #pragma unroll
    for(int r=0;r<16;++r){const int orow=crow(r,hi);
      #pragma unroll
      for(int d0=0;d0<2;++d0)stg[orow*64+d0*32+r32]=__float2bfloat16(o[d0][r]*rli[r]);}
    asm volatile("s_waitcnt lgkmcnt(0)":::"memory");
    #pragma unroll
    for(int i=0;i<4;++i){const int row=i*8+(lane>>3),ch=lane&7; const u32x4 v=*(const u32x4*)(stg+row*64+ch*8); ATTN_STORE16(Ow+(long)row*QP+ch*8,v);} }
  asm volatile("s_waitcnt lgkmcnt(0)\n\ts_barrier":::"memory");
  #undef DMA_K
  #undef DMA_V
  #undef CMASK
  #undef START
  #undef RESC
  #undef ROT
}
constexpr int ATTN_LDS_BYTES=LDS_BYTES;
struct AttnTensors { const bf16* Q; const bf16* K; const bf16* V; bf16* O; };
template<int THRL=8> __device__ __forceinline__ void attn_phase(char*lds,const AttnTensors&T,const QPre&QN,int G,int vcu,bool with_ctx,long ctx_row0){
  const int total=4*NHEAD*NQB;
  for(int i=0;;++i){
    int x,n;
    if(G==256){ if(i>=4)break; x=vcu>>5; n=i*32+(vcu&31); }
    else { const int u=i*G+vcu; if(u>=total)break; x=u>>7; n=u&127; }
    const int b=x>>1,kvh=x&1,h=kvh*4+(n>>5),qb=n&31;
    attn_unit<THRL>(b,h,(long)b*SEQQ+(long)qb*QB,SEQK/KVBLK,qb*QB,QN,T.Q,T.K,T.V,T.O,lds);
  }
  if(with_ctx){
    for(int u=vcu;u<4*NHEAD;u+=G){ const int b=u>>3,h=u&7; attn_unit<THRL>(b,h,ctx_row0+(long)b*256,4,-1,QN,T.Q,T.K,T.V,T.O,lds); }
  }
}
#undef SBAR
#undef WAIT_BAR
}

constexpr int NWAVES = 8, NTHR = 512;
constexpr int DMODEL = 1024, NB = 4, SEQ = 8192, CTXL = 256, NLAT = NB * SEQ, NCTX = NB * CTXL, MT = NLAT + NCTX;
constexpr int INW = 2048, NE = 32, KEYS = SEQ + CTXL;
constexpr int SORT_TILES = 560, SORT_ROWS = SORT_TILES * 256;
constexpr float EPSN = 1e-6f;
constexpr int NCHUNK = 66, CHUNK = 128;
constexpr int YS_PITCH = 1088;
constexpr int NPH_PRO = 2, NPH_LAYER = 13, NPH = NPH_PRO + 2 * NPH_LAYER;

constexpr size_t MiB = 1u << 20;
constexpr size_t WS_CTL = 0, CTL_ZERO_BYTES = 1 * MiB;
constexpr size_t WS_MOD = 1 * MiB, WS_ROPEC = 2 * MiB, WS_ROPES = 3 * MiB, WS_H2 = 4 * MiB, WS_KFC = 10 * MiB, WS_BLKCNT = 12 * MiB, WS_TILEE = 13 * MiB, WS_SCANS = 14 * MiB;
constexpr size_t WS_WINT = 16 * MiB, WS_WOUTT = 24 * MiB, WS_W1T = 32 * MiB, WS_W2T = 288 * MiB, WS_KF = 416 * MiB, WS_KHAT = 448 * MiB, WS_XR = 512 * MiB, WS_H = 644 * MiB;
constexpr size_t WS_U = 712 * MiB, WS_Q = 844 * MiB, WS_K = 877 * MiB, WS_V = 886 * MiB, WS_ATT = 895 * MiB, WS_LAB = 928 * MiB, WS_LRUO = 1060 * MiB, WS_VT = 1093 * MiB, WS_X0T = 1125 * MiB,
                 WS_HYO = 1157 * MiB, WS_MIXA = 1190 * MiB;
constexpr size_t WS_WGT = 11 * MiB, WS_SPT = 10 * MiB + 768 * 1024, WS_XL = 1256 * MiB;
constexpr size_t WS_GC = 10 * MiB + 896 * 1024;
constexpr size_t WS_CB = 10 * MiB + 960 * 1024;
constexpr size_t WS_F = 712 * MiB, WS_ASORT = 778 * MiB, WS_ACT = 1058 * MiB, WS_YS = 1338 * MiB, WS_TOPI = 1618 * MiB, WS_GATE = 1619 * MiB, WS_POS = 1620 * MiB, WS_RSSP = 1622 * MiB, WS_ROWTOK = 1625 * MiB, WS_END = 1626 * MiB;
constexpr size_t LAB_STRIDE = (size_t)MT * 256;
constexpr int CW_BAR = 4096;
constexpr int CW_NTILES = 64;

constexpr int RING_OFF = 0, RING_BYTES = 131072, MOETAB_OFF = 131072, LDSCTL_OFF = 155648, LDS_BYTES = 156160;

#define GAS __attribute__((address_space(1)))
#define LAS __attribute__((address_space(3)))
typedef unsigned short bf16;
typedef unsigned v4u __attribute__((ext_vector_type(4)));
typedef unsigned v2u __attribute__((ext_vector_type(2)));
typedef float f32x4 __attribute__((ext_vector_type(4)));
#define LDS_WAIT() asm volatile("s_waitcnt lgkmcnt(0)" ::: "memory")
#define VM_WAIT() asm volatile("s_waitcnt vmcnt(0)" ::: "memory")
__device__ __forceinline__ unsigned f2bf(float f) { unsigned u = __builtin_bit_cast(unsigned, f); return (u + 0x7fffu + ((u >> 16) & 1u)) >> 16; }
__device__ __forceinline__ unsigned pk2(float lo, float hi) { return f2bf(lo) | (f2bf(hi) << 16); }
__device__ __forceinline__ float bf2f(unsigned short b) { return __builtin_bit_cast(float, (unsigned)b << 16); }
__device__ __forceinline__ float bflo(unsigned w) { return __builtin_bit_cast(float, w << 16); }
__device__ __forceinline__ float bfhi(unsigned w) { return __builtin_bit_cast(float, w & 0xffff0000u); }
__device__ __forceinline__ float wave_sum(float v) {
#pragma unroll
    for (int o = 1; o < 64; o <<= 1) v += __shfl_xor(v, o);
    return v;
}
__device__ __forceinline__ float sigmoidf_(float x) { return 1.0f / (1.0f + __expf(-x)); }
__device__ __forceinline__ void sincos_d(double x, double& s, double& c) {
    const double kd = __builtin_rint(x * 0.63661977236758134308);
    const int k = (int)kd;
    double r = __builtin_fma(-kd, 1.57079632673412561417e+00, x);
    r = __builtin_fma(-kd, 6.07710050650619224932e-11, r);
    const double z = r * r;
    const double ps = r + r * z * (-1.66666666666666324348e-01 + z * (8.33333333332248946124e-03 + z * (-1.98412698298579493134e-04 + z * (2.75573137070700676789e-06 + z * (-2.50507602534068634195e-08 + z * 1.58969099521155010221e-10)))));
    const double pc = 1.0 - 0.5 * z + z * z * (4.16666666666666019037e-02 + z * (-1.38888888888741095749e-03 + z * (2.48015872894767294178e-05 + z * (-2.75573143513906633035e-07 + z * (2.08757232129817482790e-09 + z * -1.13596475577881948265e-11)))));
    const int q = k & 3;
    s = (q == 0) ? ps : (q == 1) ? pc : (q == 2) ? -ps : -pc;
    c = (q == 0) ? pc : (q == 1) ? -ps : (q == 2) ? -pc : ps;
}
__device__ __forceinline__ float gelu_tanh(float x) {
    const float u = 0.7978845608028654f * (x + 0.044715f * x * x * x);
    const float t = 1.0f - 2.0f / (1.0f + __expf(2.0f * u));
    return 0.5f * x * (1.0f + t);
}
__device__ __forceinline__ int lds_add(LAS int* p, int v) { return __hip_atomic_fetch_add(p, v, __ATOMIC_RELAXED, __HIP_MEMORY_SCOPE_WORKGROUP); }

#define FFT_FN __device__ __forceinline__
typedef float f32x2v __attribute__((ext_vector_type(2)));
#define FFT_VEC2 f32x2v
#define FFT_DPTR LAS f32x2v*
#define FFT_LD(D, i) c32_from((D)[i])
#define FFT_ST(D, i, v) ((D)[i] = c32_to(v))
struct __attribute__((aligned(8))) c32 { float x, y; };
FFT_FN c32 cmul(c32 a, c32 b) { c32 r; r.x = a.x * b.x - a.y * b.y; r.y = a.x * b.y + a.y * b.x; return r; }
FFT_FN c32 cadd(c32 a, c32 b) { c32 r; r.x = a.x + b.x; r.y = a.y + b.y; return r; }
FFT_FN c32 csub(c32 a, c32 b) { c32 r; r.x = a.x - b.x; r.y = a.y - b.y; return r; }
FFT_FN c32 cmuli_neg(c32 a) { c32 r; r.x = a.y; r.y = -a.x; return r; }
FFT_FN int fpad(int a) { return a + (a >> 4); }
#ifdef FFT_VEC2
FFT_FN c32 c32_from(FFT_VEC2 t) { c32 r; r.x = t.x; r.y = t.y; return r; }
FFT_FN FFT_VEC2 c32_to(c32 a) { FFT_VEC2 t; t.x = a.x; t.y = a.y; return t; }
#endif
FFT_FN void dft4(c32& a0, c32& a1, c32& a2, c32& a3) {
    const c32 s02 = cadd(a0, a2), d02 = csub(a0, a2), s13 = cadd(a1, a3), d13 = cmuli_neg(csub(a1, a3));
    a0 = cadd(s02, s13); a2 = csub(s02, s13); a1 = cadd(d02, d13); a3 = csub(d02, d13);
}
FFT_FN void dft16(c32 (&v)[16]) {
    const float C1 = 0.92387953251128674f, S1 = 0.38268343236508977f, C2 = 0.70710678118654752f;
#pragma unroll
    for (int q2 = 0; q2 < 4; ++q2) dft4(v[q2], v[4 + q2], v[8 + q2], v[12 + q2]);
    { c32 w;
      w.x = C1; w.y = -S1; v[4 * 1 + 1] = cmul(v[4 * 1 + 1], w);
      w.x = C2; w.y = -C2; v[4 * 2 + 1] = cmul(v[4 * 2 + 1], w);
      w.x = S1; w.y = -C1; v[4 * 3 + 1] = cmul(v[4 * 3 + 1], w);
      w.x = C2; w.y = -C2; v[4 * 1 + 2] = cmul(v[4 * 1 + 2], w);
      v[4 * 2 + 2] = cmuli_neg(v[4 * 2 + 2]);
      w.x = -C2; w.y = -C2; v[4 * 3 + 2] = cmul(v[4 * 3 + 2], w);
      w.x = S1; w.y = -C1; v[4 * 1 + 3] = cmul(v[4 * 1 + 3], w);
      w.x = -C2; w.y = -C2; v[4 * 2 + 3] = cmul(v[4 * 2 + 3], w);
      w.x = -C1; w.y = S1; v[4 * 3 + 3] = cmul(v[4 * 3 + 3], w); }
#pragma unroll
    for (int p1 = 0; p1 < 4; ++p1) dft4(v[4 * p1 + 0], v[4 * p1 + 1], v[4 * p1 + 2], v[4 * p1 + 3]);
#pragma unroll
    for (int a = 0; a < 4; ++a)
#pragma unroll
        for (int b = a + 1; b < 4; ++b) { const c32 t = v[4 * a + b]; v[4 * a + b] = v[4 * b + a]; v[4 * b + a] = t; }
}
FFT_FN c32 twid(int j, int n) { float rev = (float)j / (float)n; asm volatile("" : "+v"(rev)); c32 w; w.x = __builtin_amdgcn_cosf(rev); w.y = -__builtin_amdgcn_sinf(rev); return w; }

FFT_FN void fft_fwd16(FFT_DPTR D, int g, int n) {
    const int s = n >> 4, blk = g / s, j = g - blk * s, base = blk * n + j;
    c32 v[16];
#pragma unroll
    for (int q = 0; q < 16; ++q) v[q] = FFT_LD(D, fpad(base + q * s));
    dft16(v);
    const c32 w = twid(j, n); c32 wp = w;
#pragma unroll
    for (int p = 1; p < 16; ++p) { v[p] = cmul(v[p], wp); wp = cmul(wp, w); }
#pragma unroll
    for (int p = 0; p < 16; ++p) FFT_ST(D, fpad(base + p * s), v[p]);
}
FFT_FN void fft_inv16(FFT_DPTR D, int g, int n) {
    const int s = n >> 4, blk = g / s, j = g - blk * s, base = blk * n + j;
    c32 v[16];
#pragma unroll
    for (int q = 0; q < 16; ++q) v[q] = FFT_LD(D, fpad(base + q * s));
    const c32 w = twid(j, n); c32 wp = w;
#pragma unroll
    for (int p = 1; p < 16; ++p) { v[p] = cmul(v[p], wp); wp = cmul(wp, w); }
    dft16(v);
#pragma unroll
    for (int p = 0; p < 16; ++p) FFT_ST(D, fpad(base + p * s), v[p]);
}
FFT_FN void fft_mid16(FFT_DPTR D, int g, const c32* KH) {
    c32 v[16];
#pragma unroll
    for (int q = 0; q < 16; ++q) v[q] = FFT_LD(D, 17 * g + q);
    dft16(v);
#pragma unroll
    for (int p = 0; p < 16; ++p) { const c32 k = KH[16 * g + p]; const c32 t = cmul(v[p], k); v[p].x = t.x; v[p].y = -t.y; }
    dft16(v);
#pragma unroll
    for (int p = 0; p < 16; ++p) FFT_ST(D, 17 * g + p, v[p]);
}
typedef float fft_f32x4 __attribute__((ext_vector_type(4)));
FFT_FN void fft_mid16k(FFT_DPTR D, int g, const fft_f32x4 (&kv)[8]) {
    c32 v[16];
#pragma unroll
    for (int q = 0; q < 16; ++q) v[q] = FFT_LD(D, 17 * g + q);
    dft16(v);
#pragma unroll
    for (int p = 0; p < 16; ++p) { c32 k; k.x = kv[p >> 1][2 * (p & 1)]; k.y = kv[p >> 1][2 * (p & 1) + 1]; const c32 t = cmul(v[p], k); v[p].x = t.x; v[p].y = -t.y; }
    dft16(v);
#pragma unroll
    for (int p = 0; p < 16; ++p) FFT_ST(D, 17 * g + p, v[p]);
}
FFT_FN void fft_last16_out(FFT_DPTR D, int g, c32* OUT, float scale) {
    c32 v[16];
#pragma unroll
    for (int q = 0; q < 16; ++q) v[q] = FFT_LD(D, 17 * g + q);
    dft16(v);
#pragma unroll
    for (int p = 0; p < 16; ++p) { c32 t; t.x = v[p].x * scale; t.y = v[p].y * scale; OUT[16 * g + p] = t; }
}
FFT_FN void fft_first4(FFT_DPTR D, int j, c32 x0, c32 x1, c32 x2, c32 x3) {
    dft4(x0, x1, x2, x3);
    const c32 w = twid(j, 16384), w2 = cmul(w, w), w3 = cmul(w2, w);
    FFT_ST(D, fpad(j), x0); FFT_ST(D, fpad(j + 4096), cmul(x1, w)); FFT_ST(D, fpad(j + 8192), cmul(x2, w2)); FFT_ST(D, fpad(j + 12288), cmul(x3, w3));
}
FFT_FN void fft_final4(FFT_DPTR D, int j, c32& u0, c32& u1) {
    const c32 w = twid(j, 16384), w2 = cmul(w, w), w3 = cmul(w2, w);
    c32 a0 = FFT_LD(D, fpad(j)), a1 = cmul(FFT_LD(D, fpad(j + 4096)), w), a2 = cmul(FFT_LD(D, fpad(j + 8192)), w2), a3 = cmul(FFT_LD(D, fpad(j + 12288)), w3);
    dft4(a0, a1, a2, a3);
    u0 = a0; u1 = a1;
}
FFT_FN void fft_first4_inplace(FFT_DPTR D, int j) {
    c32 x0 = FFT_LD(D, fpad(j)), x1 = FFT_LD(D, fpad(j + 4096)), x2 = FFT_LD(D, fpad(j + 8192)), x3 = FFT_LD(D, fpad(j + 12288));
    fft_first4(D, j, x0, x1, x2, x3);
}
#define XB_TMO      128
#define XB_XCNT(j)  (256  + 64 * (j))
#define XB_XSUB(j)  (1280 + 64 * (j))
#define XB_XGEN(j)  (2304 + 64 * (j))
#define XB_TOP      3328
#define XB_TOPGEN   3392
#define XCD_BAR_WORDS 3456
#define XB_SPIN_CAP (1u << 22)

__device__ __forceinline__ unsigned xb_ld(unsigned* p)              { return __hip_atomic_load(p, __ATOMIC_RELAXED, __HIP_MEMORY_SCOPE_AGENT); }
__device__ __forceinline__ unsigned xb_add(unsigned* p, unsigned v) { return __hip_atomic_fetch_add(p, v, __ATOMIC_RELAXED, __HIP_MEMORY_SCOPE_AGENT); }
__device__ __forceinline__ unsigned xb_xcc_id() { return (unsigned)__builtin_amdgcn_s_getreg((3 << 11) | 20) & 0xFu; }
#define XB_SPIN(cond, bar) do { unsigned _sp = 0; while (cond) { __builtin_amdgcn_s_sleep(1); \
    if ((++_sp & 255u) == 0u) { if (xb_ld(&(bar)[XB_TMO])) break; if (_sp > XB_SPIN_CAP) { atomicAdd(&(bar)[XB_TMO], 1u); break; } } } } while (0)

struct XcdBarrier {
    unsigned* bar; unsigned x;
    volatile LAS unsigned* st;
};

__device__ __forceinline__ XcdBarrier xcd_barrier_post(unsigned* bar, volatile LAS unsigned* st) {
    XcdBarrier b; b.bar = bar; b.x = xb_xcc_id(); b.st = st;
    if (threadIdx.x == 0) (void)xb_add(&bar[XB_XCNT(b.x)], 1u);
    return b;
}
__device__ __forceinline__ void xcd_barrier_complete(unsigned* bar, unsigned x, unsigned& nloc, unsigned& nx) {
    const unsigned G = gridDim.x * gridDim.y * gridDim.z;
    unsigned sum, cnt, mine, sp = 0u;
    for (;;) {
        sum = 0u; cnt = 0u; mine = 0u;
#pragma unroll
        for (unsigned j = 0; j < 16; ++j) { const unsigned c = xb_ld(&bar[XB_XCNT(j)]); sum += c; cnt += (c > 0u) ? 1u : 0u; mine = (j == x) ? c : mine; }
        if (sum == G) break;
        __builtin_amdgcn_s_sleep(1);
        if ((++sp & 255u) == 0u) { if (xb_ld(&bar[XB_TMO])) break; if (sp > XB_SPIN_CAP) { atomicAdd(&bar[XB_TMO], 1u); break; } }
    }
    nloc = mine > 0u ? mine : 1u; nx = cnt > 0u ? cnt : 1u;
}

__device__ __forceinline__ void xcd_barrier(const XcdBarrier& b) {
    asm volatile("s_waitcnt vmcnt(0)" ::: "memory");
    __syncthreads();
    if (threadIdx.x == 0) {
        unsigned* bar = b.bar;
        __builtin_amdgcn_s_waitcnt(0);
        unsigned nloc = b.st[0], nx = b.st[1];
        if (nloc == 0u) { xcd_barrier_complete(bar, b.x, nloc, nx); b.st[0] = nloc; b.st[1] = nx; }
        const unsigned old = xb_add(&bar[XB_XSUB(b.x)], 1u);
        const unsigned gen = old / nloc;
        if (old + 1u == (gen + 1u) * nloc) {
            __builtin_amdgcn_fence(__ATOMIC_RELEASE, "agent");
            asm volatile("s_waitcnt vmcnt(0)" ::: "memory");
            const unsigned og = xb_add(&bar[XB_TOP], 1u);
            const unsigned tg = og / nx;
            if (og + 1u == (tg + 1u) * nx) xb_add(&bar[XB_TOPGEN], 1u);
            else XB_SPIN(xb_ld(&bar[XB_TOPGEN]) == tg, bar);
            __builtin_amdgcn_fence(__ATOMIC_ACQUIRE, "agent");
            xb_add(&bar[XB_XGEN(b.x)], 1u);
            asm volatile("s_waitcnt vmcnt(0)" ::: "memory");
        } else {
            XB_SPIN(xb_ld(&bar[XB_XGEN(b.x)]) == gen, bar);
            __builtin_amdgcn_fence(__ATOMIC_ACQUIRE, "agent");
            asm volatile("s_waitcnt vmcnt(0)" ::: "memory");
        }
    }
    __syncthreads();
}


constexpr int CW_SPLIT = 8192, CTXWG = 32;
__device__ __forceinline__ void split_arrive_all(const XcdBarrier& b, unsigned* w) {
    asm volatile("s_waitcnt vmcnt(0)" ::: "memory");
    __syncthreads();
    if (threadIdx.x == 0) { const unsigned nloc = b.st[0]; const unsigned old = xb_add(&w[64 * b.x], 1u);
        if (old + 1u == nloc) { __builtin_amdgcn_fence(__ATOMIC_RELEASE, "agent"); asm volatile("s_waitcnt vmcnt(0)" ::: "memory"); (void)xb_add(&w[1024], 1u); } }
}
__device__ __forceinline__ void split_wait_all(const XcdBarrier& b, unsigned* w) {
    if (threadIdx.x == 0) { const unsigned nx = b.st[1]; XB_SPIN(xb_ld(&w[1024]) < nx, b.bar); __builtin_amdgcn_fence(__ATOMIC_ACQUIRE, "agent"); asm volatile("s_waitcnt vmcnt(0)" ::: "memory"); }
    __syncthreads();
}
__device__ __forceinline__ void split_arrive_flat(unsigned* w) {
    asm volatile("s_waitcnt vmcnt(0)" ::: "memory");
    __syncthreads();
    if (threadIdx.x == 0) { __builtin_amdgcn_fence(__ATOMIC_RELEASE, "agent"); asm volatile("s_waitcnt vmcnt(0)" ::: "memory"); (void)xb_add(&w[1088], 1u); }
}
__device__ __forceinline__ void split_wait_flat(const XcdBarrier& b, unsigned* w, unsigned target) {
    if (threadIdx.x == 0) { XB_SPIN(xb_ld(&w[1088]) < target, b.bar); __builtin_amdgcn_fence(__ATOMIC_ACQUIRE, "agent"); asm volatile("s_waitcnt vmcnt(0)" ::: "memory"); }
    __syncthreads();
}

struct Frame {
    LAS unsigned char* lds; unsigned* ctl; unsigned char* ws;
    int tid, lane, wave, vcu, G, gw, ngw;
};
__device__ const float ROPE_INV[16] = {1.0f, 0.5623413251903491f, 0.31622776601683794f, 0.1778279410038923f, 0.1f, 0.05623413251903491f, 0.03162277660168379f, 0.01778279410038923f,
                                       0.01f, 0.005623413251903491f, 0.0031622776601683794f, 0.001778279410038923f, 0.001f, 0.0005623413251903491f, 0.00031622776601683794f, 0.0001778279410038923f};

__device__ __forceinline__ void p0_transpose_item(const float* W, int K, int N, bf16* WT, LAS float* scr, int item, int lane) {
    const int nblk = N / 32, kb = item / nblk, nb = item % nblk, k0 = 64 * kb, n0 = 32 * nb;
#pragma unroll 8
    for (int i = 0; i < 32; ++i) { const int kk = 2 * i + (lane >> 5); scr[kk * 33 + (lane & 31)] = W[(size_t)(k0 + kk) * N + n0 + (lane & 31)]; }
    LDS_WAIT(); asm volatile("" ::: "memory");
    const int c = lane & 7;
#pragma unroll
    for (int j = 0; j < 4; ++j) { const int n = (lane >> 3) + 8 * j; const LAS float* s = scr + (8 * c) * 33 + n;
        v4u o; o.x = pk2(s[0 * 33], s[1 * 33]); o.y = pk2(s[2 * 33], s[3 * 33]); o.z = pk2(s[4 * 33], s[5 * 33]); o.w = pk2(s[6 * 33], s[7 * 33]);
        *(GAS v4u*)(WT + (size_t)(n0 + n) * K + k0 + 8 * c) = o; }
    LDS_WAIT(); asm volatile("" ::: "memory");
}

__device__ __forceinline__ void p0_transpose_item_f8(const float* W, int K, int N, unsigned char* WT, LAS float* scr, int item, int lane) {
    const int nblk = N / 32, kb = item / nblk, nb = item % nblk, k0 = 64 * kb, n0 = 32 * nb;
#pragma unroll 8
    for (int i = 0; i < 32; ++i) { const int kk = 2 * i + (lane >> 5); scr[kk * 33 + (lane & 31)] = W[(size_t)(k0 + kk) * N + n0 + (lane & 31)]; }
    LDS_WAIT(); asm volatile("" ::: "memory");
    const int c = lane & 7;
#pragma unroll
    for (int j = 0; j < 4; ++j) { const int n = (lane >> 3) + 8 * j; const LAS float* s = scr + (8 * c) * 33 + n;
        v2u o; o.x = pg8::pack4_fp8(s[0 * 33] * pg8::F8_SW, s[1 * 33] * pg8::F8_SW, s[2 * 33] * pg8::F8_SW, s[3 * 33] * pg8::F8_SW);
        o.y = pg8::pack4_fp8(s[4 * 33] * pg8::F8_SW, s[5 * 33] * pg8::F8_SW, s[6 * 33] * pg8::F8_SW, s[7 * 33] * pg8::F8_SW);
        *(GAS v2u*)(WT + (size_t)(n0 + n) * K + k0 + 8 * c) = o; }
    LDS_WAIT(); asm volatile("" ::: "memory");
}

__device__ __forceinline__ void ph_prologue_a(const Frame& F, const float* c, const float* cctx, const float* w_mod, const float* b_mod, const float* w_in, const float* w_out,
                                              const float* moe_w1, const float* moe_w2, const float* hy_w1, const float* hy_b1, const float* hy_w2, const float* hy_b2, const float* hy_freq, const float* lru_gw, const float* lru_lam) {
    {
        LAS float* scr = (LAS float*)(F.lds + F.wave * 16384);
        constexpr int I_IN = 2 * 1024, I_OUT = 2 * 512, I_W1 = 64 * 1024, I_W2 = 64 * 512, NIT = I_IN + I_OUT + I_W1 + I_W2;
        bf16* WinT = (bf16*)(F.ws + WS_WINT); bf16* WoutT = (bf16*)(F.ws + WS_WOUTT); bf16* W1T = (bf16*)(F.ws + WS_W1T); bf16* W2T = (bf16*)(F.ws + WS_W2T);
        for (int it = F.gw; it < NIT; it += F.ngw) {
            int r = it;
            if (r < I_IN) { const int m = r >> 10; p0_transpose_item(w_in + (size_t)m * 1024 * 2048, 1024, 2048, WinT + (size_t)m * 2048 * 1024, scr, r & 1023, F.lane); continue; } r -= I_IN;
            if (r < I_OUT) { const int m = r >> 9; p0_transpose_item(w_out + (size_t)m * 1024 * 1024, 1024, 1024, WoutT + (size_t)m * 1024 * 1024, scr, r & 511, F.lane); continue; } r -= I_OUT;
#if MOE_FP8
            if (r < I_W1) { const int m = r >> 10; p0_transpose_item_f8(moe_w1 + (size_t)m * 1024 * 2048, 1024, 2048, (unsigned char*)W1T + (size_t)m * 2048 * 1024, scr, r & 1023, F.lane); continue; } r -= I_W1;
            { const int m = r >> 9; p0_transpose_item_f8(moe_w2 + (size_t)m * 1024 * 1024, 1024, 1024, (unsigned char*)W2T + (size_t)m * 1024 * 1024, scr, r & 511, F.lane); }
#else
            if (r < I_W1) { const int m = r >> 10; p0_transpose_item(moe_w1 + (size_t)m * 1024 * 2048, 1024, 2048, W1T + (size_t)m * 2048 * 1024, scr, r & 1023, F.lane); continue; } r -= I_W1;
            { const int m = r >> 9; p0_transpose_item(moe_w2 + (size_t)m * 1024 * 1024, 1024, 1024, W2T + (size_t)m * 1024 * 1024, scr, r & 511, F.lane); }
#endif
        }
    }
    __syncthreads();
    {
        LAS float* sl = (LAS float*)(F.lds);
        LAS float* red = (LAS float*)(F.lds + 20480);
        float* MOD = (float*)(F.ws + WS_MOD);
        if ((int)blockIdx.x < 192) {
            for (int i = F.tid; i < 5 * 1024; i += NTHR) { const int r = i >> 10, k = i & 1023; const float v = (r < 4) ? c[r * 1024 + k] : cctx[k]; sl[i] = v / (1.0f + __expf(-v)); }
        }
        __syncthreads();
        for (int it = blockIdx.x; it < 192; it += F.G) {
            const int l = it / 96, n = (it % 96) * 64 + F.lane;
            float a0 = 0.f, a1 = 0.f, a2 = 0.f, a3 = 0.f, a4 = 0.f;
            const float* wp = w_mod + ((size_t)l * 1024 + F.wave * 128) * 6144 + n;
#pragma unroll 8
            for (int k = 0; k < 128; ++k) { const float w = wp[(size_t)k * 6144]; const int kk = F.wave * 128 + k;
                a0 += sl[kk] * w; a1 += sl[1024 + kk] * w; a2 += sl[2048 + kk] * w; a3 += sl[3072 + kk] * w; a4 += sl[4096 + kk] * w; }
            red[(F.wave * 5 + 0) * 64 + F.lane] = a0; red[(F.wave * 5 + 1) * 64 + F.lane] = a1; red[(F.wave * 5 + 2) * 64 + F.lane] = a2; red[(F.wave * 5 + 3) * 64 + F.lane] = a3; red[(F.wave * 5 + 4) * 64 + F.lane] = a4;
            __syncthreads();
            if (F.tid < 320) { const int r = F.tid >> 6, ln = F.tid & 63; float s = 0.f;
#pragma unroll
                for (int w = 0; w < 8; ++w) s += red[(w * 5 + r) * 64 + ln];
                const int nn = (it % 96) * 64 + ln; MOD[(size_t)(l * 5 + r) * 6144 + nn] = s + b_mod[l * 6144 + nn]; }
            __syncthreads();
        }
    }
    {
        bf16* WGT = (bf16*)(F.ws + WS_WGT); float* SPT = (float*)(F.ws + WS_SPT);
        for (int idx = blockIdx.x * NTHR + F.tid; idx < 2 * 1024 * 256; idx += F.G * NTHR) {
            const int l = idx >> 18, nidx = (idx >> 8) & 1023, k = idx & 255;
            const int pn = nidx >> 8, j = (nidx >> 7) & 1, cc = nidx & 127, d = pn >> 1, ch = 128 * (pn & 1) + cc, n = ch >> 6, e = ch & 63;
            const float v = ((k >> 6) == n) ? lru_gw[((size_t)((((l * 2 + d) * 2 + j) * 4 + n) * 64 + (k & 63))) * 64 + e] : 0.f;
            WGT[idx] = (bf16)f2bf(v); }
        for (int idx = blockIdx.x * NTHR + F.tid; idx < 2 * 2 * 256; idx += F.G * NTHR) SPT[idx] = log1pf(expf(-lru_lam[idx]));
    }
    {
        float* RC = (float*)(F.ws + WS_ROPEC); float* RS = (float*)(F.ws + WS_ROPES);
        for (int idx = blockIdx.x * NTHR + F.tid; idx < SEQ * 32; idx += F.G * NTHR) {
            const int t = idx >> 5, i = idx & 31; const int pos = (i < 16) ? (t >> 6) : (t & 63);
            const float ang = (float)pos * ROPE_INV[i & 15];
            double s, cc; sincos_d((double)ang, s, cc); RC[idx] = (float)cc; RS[idx] = (float)s; }
    }
    {
        float* H2 = (float*)(F.ws + WS_H2);
        for (int it = F.gw; it < 2 * SEQ + CTXL; it += F.ngw) {
            const int v = it >> 13, t = (v < 2) ? (it & (SEQ - 1)) : (it - 2 * SEQ), L = (v < 2) ? SEQ : CTXL, l = (v == 1) ? 1 : 0;
            const int j = F.lane;
            float z = 0.f;
            if (j == 0) z = (float)t / (float)(L - 1);
            else if (j <= 32) { const int b = (j - 1) & 15; const float band = 1e-4f + (float)b * ((15.0f - 1e-4f) / 15.0f);
                const float ang = ((6.283185307179586f / (float)L) * (float)t) * band;
                double s, cc; sincos_d((double)ang, s, cc); z = (j <= 16) ? (float)cc : -(float)s; }
            const float fr = hy_freq[l * 64 + j];
            float p1 = hy_b1[l * 64 + j];
            const float* w1 = hy_w1 + (size_t)l * 33 * 64;
#pragma unroll
            for (int i = 0; i < 33; ++i) p1 += __shfl(z, i) * w1[i * 64 + j];
            double s1, c1; sincos_d((double)(fr * p1), s1, c1); const float h1 = (float)s1;
            float p2 = hy_b2[l * 64 + j];
            const float* w2 = hy_w2 + (size_t)l * 64 * 64;
#pragma unroll 16
            for (int i = 0; i < 64; ++i) p2 += __shfl(h1, i) * w2[i * 64 + j];
            double s2, c2; sincos_d((double)(fr * p2), s2, c2);
            H2[((size_t)v * SEQ + t) * 64 + j] = (float)s2;
        }
    }
}

__device__ __forceinline__ void ph_prologue_b(const Frame& F, const float* hy_w3, const float* hy_decay, const float* gffn, const float* router_w, const float* router_b) {
    { const float* MOD = (const float*)(F.ws + WS_MOD); float* CB = (float*)(F.ws + WS_CB);
      for (int it = F.gw; it < 2 * 5 * 32; it += F.ngw) { const int lb = it >> 5, e = it & 31, l = lb / 5; const float* sf = MOD + (size_t)lb * 6144 + 3 * 1024; float s = 0.f;
#pragma unroll
          for (int q = 0; q < 16; ++q) { const int cc = 64 * q + F.lane; s += sf[cc] * router_w[(size_t)l * 32768 + cc * 32 + e]; }
          s = wave_sum(s); if (F.lane == 0) CB[it] = s + router_b[l * 32 + e]; } }
    { const float* MOD = (const float*)(F.ws + WS_MOD); float* GC = (float*)(F.ws + WS_GC);
      for (int idx = blockIdx.x * NTHR + F.tid; idx < 2 * 5 * 1024; idx += F.G * NTHR) { const int lb = idx >> 10, cc = idx & 1023, l = lb / 5; GC[idx] = gffn[l * 1024 + cc] * (1.0f + MOD[(size_t)lb * 6144 + 4 * 1024 + cc]); } }
    LAS f32x2v* D = (LAS f32x2v*)(F.lds);
    LAS float* kt = (LAS float*)(F.lds);
    LAS float* w3c = (LAS float*)(F.lds + 139264);
    LAS float* red = (LAS float*)(F.lds + 139264 + 512);
    const float* H2 = (const float*)(F.ws + WS_H2);
    c32* KHAT = (c32*)(F.ws + WS_KHAT); float* KFC = (float*)(F.ws + WS_KFC);
    for (int it = blockIdx.x; it < 768; it += F.G) {
        const int v = it >> 8, c = it & 255, L = (v < 2) ? SEQ : CTXL, l = (v == 1) ? 1 : 0;
        if (F.tid < 128) w3c[F.tid] = hy_w3[(size_t)l * 64 * 512 + (F.tid & 63) * 512 + (F.tid >> 6) * 256 + c];
        if (F.tid == 0) { if (v < 2) { f32x2v z; z.x = 0.f; z.y = 0.f; D[fpad(L)] = z; } else kt[L] = 0.f; }
        __syncthreads();
        const float df = fabsf(hy_decay[l * 512 + c]), db = fabsf(hy_decay[l * 512 + 256 + c]);
        float asum = 0.f;
        for (int t = F.tid; t < L; t += NTHR) {
            const f32x4* row = (const f32x4*)(H2 + ((size_t)v * SEQ + t) * 64);
            float hf = 0.f, hb = 0.f;
#pragma unroll
            for (int q = 0; q < 16; ++q) { const f32x4 h = row[q];
                hf += h.x * w3c[4 * q] + h.y * w3c[4 * q + 1] + h.z * w3c[4 * q + 2] + h.w * w3c[4 * q + 3];
                hb += h.x * w3c[64 + 4 * q] + h.y * w3c[64 + 4 * q + 1] + h.z * w3c[64 + 4 * q + 2] + h.w * w3c[64 + 4 * q + 3]; }
            const float t01 = (float)t / (float)(L - 1);
            hf *= expf(-t01 * df); hb *= expf(-t01 * db);
            asum += fabsf(hf); if (t >= 1) asum += fabsf(hb);
            if (v < 2) { f32x2v z; z.x = hf; z.y = 0.f; D[fpad(t)] = z; if (t >= 1) { z.x = hb; D[fpad(2 * L - t)] = z; } }
            else { kt[t] = hf; if (t >= 1) kt[2 * L - t] = hb; }
        }
        asum = wave_sum(asum);
        if (F.lane == 0) red[F.wave] = asum;
        __syncthreads();
        float tot = 0.f;
#pragma unroll
        for (int w = 0; w < 8; ++w) tot += red[w];
        const float inv = 1.0f / tot;
        if (v < 2) {
            c32* out = KHAT + (size_t)(v * 256 + c) * 16384;
#pragma unroll 1
            for (int i = 0; i < 8; ++i) fft_first4_inplace(D, F.tid + 512 * i);
            __syncthreads();
            { fft_fwd16(D, F.tid, 4096); fft_fwd16(D, F.tid + 512, 4096); }
            __syncthreads();
            { fft_fwd16(D, F.tid, 256); fft_fwd16(D, F.tid + 512, 256); }
            __syncthreads();
            _Pragma("unroll 1") for (int g_ = F.tid; g_ < 1024; g_ += 512) fft_last16_out(D, g_, out, inv * (1.0f / 16384.0f));
        } else {
            float* dst = KFC + (size_t)c * 512;
            for (int j = F.tid; j < 2 * L; j += NTHR) dst[j] = kt[j] * inv;
        }
        __syncthreads();
    }
}

__device__ __forceinline__ void ph_norm_mod(const Frame& F, int l, const float* x, const float* ctx, const float* gmix) {
    const float* XR = (const float*)(F.ws + WS_XR); const float* MOD = (const float*)(F.ws + WS_MOD); bf16* H = (bf16*)(F.ws + WS_H);
    for (int r = F.gw; r < MT; r += F.ngw) {
        const float* src = (l == 0) ? (r < NLAT ? x + (size_t)r * 1024 : ctx + (size_t)(r - NLAT) * 1024) : XR + (size_t)r * 1024;
        const int bidx = r < NLAT ? r / SEQ : 4;
        const float* shift = MOD + (size_t)(l * 5 + bidx) * 6144; const float* scale = shift + 1024; const float* g = gmix + l * 1024;
        f32x4 v[4]; float ss = 0.f;
#pragma unroll
        for (int j = 0; j < 4; ++j) { v[j] = ((const f32x4*)src)[64 * j + F.lane]; ss += (v[j].x * v[j].x + v[j].y * v[j].y) + (v[j].z * v[j].z + v[j].w * v[j].w); }
        const float rstd = 1.0f / sqrtf(wave_sum(ss) * (1.0f / 1024.0f) + EPSN);
#pragma unroll
        for (int j = 0; j < 4; ++j) { const int cb = 64 * j + F.lane; const f32x4 gg = ((const f32x4*)g)[cb], sc = ((const f32x4*)scale)[cb], sh = ((const f32x4*)shift)[cb];
            const f32x4 y = v[j] * rstd * gg * (sc + 1.0f) + sh;
            v2u o; o.x = pk2(y.x, y.y); o.y = pk2(y.z, y.w); ((v2u*)(H + (size_t)r * 1024))[cb] = o; }
    }
}

__device__ __forceinline__ void post_ab(const Frame& F, int l, int rbeg, int rend, int w0, int nw, const float* kg_, const float* lru_cw, const float* lru_cb) {
    const bf16* U = (const bf16*)(F.ws + WS_U);
    {
        bf16* K = (bf16*)(F.ws + WS_K); bf16* V = (bf16*)(F.ws + WS_V);
        const float* RC = (const float*)(F.ws + WS_ROPEC); const float* RS = (const float*)(F.ws + WS_ROPES);
        const int o8 = 8 * (F.lane & 7), hl = F.lane & 31;
        const f32x4 kg0 = *(const f32x4*)(kg_ + l * 64 + o8), kg1 = *(const f32x4*)(kg_ + l * 64 + o8 + 4);
        const bool lohalf = (F.lane & 4) == 0;
        for (int r2 = rbeg + 2 * w0; r2 < rend; r2 += 2 * nw) {
            const int r = r2 + (F.lane >> 5);
            const bool isctx = r >= NLAT; const int b = isctx ? (r - NLAT) / CTXL : r / SEQ; const int t = isctx ? (r - NLAT) % CTXL : r % SEQ;
            const v4u wk = ((const v4u*)(U + (size_t)r * INW + 512))[hl];
            f32x4 c0 = {1.f, 1.f, 1.f, 1.f}, c1 = c0, s0 = {0.f, 0.f, 0.f, 0.f}, s1 = s0;
            if (!isctx) { const float* rc = RC + t * 32 + 8 * (F.lane & 3); const float* rs = RS + t * 32 + 8 * (F.lane & 3);
                c0 = *(const f32x4*)rc; c1 = *(const f32x4*)(rc + 4); s0 = *(const f32x4*)rs; s1 = *(const f32x4*)(rs + 4); }
            const size_t krow = (size_t)b * KEYS + (isctx ? t : CTXL + t);
            float x[8] = {bflo(wk.x), bfhi(wk.x), bflo(wk.y), bfhi(wk.y), bflo(wk.z), bfhi(wk.z), bflo(wk.w), bfhi(wk.w)};
            float ss = 0.f;
#pragma unroll
            for (int i = 0; i < 8; ++i) ss += x[i] * x[i];
            ss += __shfl_xor(ss, 1); ss += __shfl_xor(ss, 2); ss += __shfl_xor(ss, 4);
            const float rstd = 1.0f / sqrtf(ss * (1.0f / 64.0f) + EPSN);
            float y[8], o[8];
#pragma unroll
            for (int i = 0; i < 8; ++i) y[i] = x[i] * rstd * (i < 4 ? kg0[i] : kg1[i - 4]);
#pragma unroll
            for (int i = 0; i < 8; ++i) { const float p = __shfl_xor(y[i], 4); const float cs = i < 4 ? c0[i] : c1[i - 4], sn = i < 4 ? s0[i] : s1[i - 4];
                o[i] = lohalf ? (y[i] * cs - p * sn) : (y[i] * cs + p * sn); }
            v4u ow; ow.x = pk2(o[0], o[1]); ow.y = pk2(o[2], o[3]); ow.z = pk2(o[4], o[5]); ow.w = pk2(o[6], o[7]);
            if (hl < 16) ((v4u*)(K + krow * 128))[hl] = ow; else ((v4u*)(V + krow * 128))[hl - 16] = wk;
        }
    }
    {
        bf16* XL = (bf16*)(F.ws + WS_XL);
        for (int idx = rbeg * 32 + w0 * 64 + F.lane; idx < rend * 32; idx += nw * 64) {
            const int r = idx >> 5, c8 = (idx & 31) * 8;
            const bool isctx = r >= NLAT; const int Ls = isctx ? CTXL : SEQ; const int t = isctx ? (r - NLAT) % CTXL : r % SEQ;
            float acc[8];
#pragma unroll
            for (int i = 0; i < 8; ++i) acc[i] = lru_cb[l * 256 + c8 + i];
#pragma unroll
            for (int j = 0; j < 4; ++j) { const int tj = t + j - 2;
                if (tj >= 0 && tj < Ls) { const v4u w = *(const v4u*)(U + (size_t)(r + j - 2) * INW + 768 + c8);
                    const f32x4 w0 = *(const f32x4*)(lru_cw + (l * 4 + j) * 256 + c8), w1 = *(const f32x4*)(lru_cw + (l * 4 + j) * 256 + c8 + 4);
                    acc[0] += w0.x * bflo(w.x); acc[1] += w0.y * bfhi(w.x); acc[2] += w0.z * bflo(w.y); acc[3] += w0.w * bfhi(w.y);
                    acc[4] += w1.x * bflo(w.z); acc[5] += w1.y * bfhi(w.z); acc[6] += w1.z * bflo(w.w); acc[7] += w1.w * bfhi(w.w); } }
            v4u o; o.x = pk2(acc[0], acc[1]); o.y = pk2(acc[2], acc[3]); o.z = pk2(acc[4], acc[5]); o.w = pk2(acc[6], acc[7]);
            *(v4u*)(XL + (size_t)r * 256 + c8) = o;
        }
    }
}
__device__ __forceinline__ void post_c(const Frame& F, int l, const float* hy_cw, const float* hy_cb) {
    const bf16* U = (const bf16*)(F.ws + WS_U);
    __syncthreads();
    {
        LAS bf16* hs = (LAS bf16*)(F.lds);
        bf16* VT = (bf16*)(F.ws + WS_VT); bf16* X0T = (bf16*)(F.ws + WS_X0T);
        const float* cw = hy_cw + (size_t)l * 3 * 768; const float* cbp = hy_cb + l * 768;
        for (int it = blockIdx.x; it < NLAT / 64; it += F.G) {
            const int b = it >> 7, t0 = (it & 127) * 64;
            for (int i = F.tid; i < 66 * 384; i += NTHR) { const int rr = i / 384, c2 = i - rr * 384; const int t = t0 - 1 + rr;
                unsigned w = 0u; if (t >= 0 && t < SEQ) w = *(const unsigned*)(U + (size_t)(b * SEQ + t) * INW + 1280 + 2 * c2);
                *(LAS unsigned*)(hs + rr * 770 + 2 * c2) = w; }
            __syncthreads();
            for (int c = F.wave; c < 256; c += NWAVES) {
                const int tt = F.lane;
                float o[3];
#pragma unroll
                for (int g = 0; g < 3; ++g) { const int cc = g * 256 + c;
                    o[g] = cw[cc] * bf2f(hs[tt * 770 + cc]) + cw[768 + cc] * bf2f(hs[(tt + 1) * 770 + cc]) + cw[1536 + cc] * bf2f(hs[(tt + 2) * 770 + cc]) + cbp[cc]; }
                const size_t oi = ((size_t)b * 256 + c) * SEQ + t0 + tt;
                VT[oi] = (bf16)f2bf(o[2] * o[1]); X0T[oi] = (bf16)f2bf(o[0]);
            }
            __syncthreads();
        }
    }
}


typedef short sk_s16x8 __attribute__((ext_vector_type(8)));
__device__ __forceinline__ void ph_lru_gates(const Frame& F, int l, const float* lru_gb, int rt0, int nrt, int w0, int nw) {
    const bf16* XL = (const bf16*)(F.ws + WS_XL); const bf16* WG = (const bf16*)(F.ws + WS_WGT) + (size_t)l * 1024 * 256; bf16* LAB = (bf16*)(F.ws + WS_LAB);
    const float* gb = lru_gb + (size_t)l * 1024; const float* spt = (const float*)(F.ws + WS_SPT) + l * 512;
    const int fr = F.lane & 15, fq = F.lane >> 4;
    for (int it = w0; it < nrt * 8; it += nw) {
        const int rt = rt0 + (it >> 3), n = (it >> 1) & 3, d = it & 1, row0 = 32 * rt;
        const int wrow = ((2 * d + (n >> 1)) * 256 + 64 * (n & 1) + fr) * 256 + 64 * n + 8 * fq;
        const bf16* ap = XL + (size_t)(row0 + fr) * 256 + 64 * n + 8 * fq;
        const bf16* xp = XL + (size_t)(row0 + fr) * 256 + 64 * n + 4 * fq;
        sk_s16x8 a[2][2]; v2u xw[2][4];
#pragma unroll
        for (int ri = 0; ri < 2; ++ri) { a[ri][0] = *(const sk_s16x8*)(ap + ri * 16 * 256); a[ri][1] = *(const sk_s16x8*)(ap + ri * 16 * 256 + 32);
#pragma unroll
            for (int c = 0; c < 4; ++c) xw[ri][c] = *(const v2u*)(xp + ri * 16 * 256 + 16 * c); }
        f32x4 acc[2][4][2];
#pragma unroll
        for (int c = 0; c < 4; ++c)
#pragma unroll
            for (int g = 0; g < 2; ++g) { const bf16* bp = WG + wrow + (g * 128 + 16 * c) * 256;
                const sk_s16x8 b0 = *(const sk_s16x8*)bp, b1 = *(const sk_s16x8*)(bp + 32);
#pragma unroll
                for (int ri = 0; ri < 2; ++ri) { f32x4 z = {0.f, 0.f, 0.f, 0.f};
                    z = __builtin_amdgcn_mfma_f32_16x16x32_bf16(b0, a[ri][0], z, 0, 0, 0); acc[ri][c][g] = __builtin_amdgcn_mfma_f32_16x16x32_bf16(b1, a[ri][1], z, 0, 0, 0); } }
        bf16* LA = LAB + (size_t)(2 * d) * LAB_STRIDE; bf16* LB = LAB + (size_t)(2 * d + 1) * LAB_STRIDE;
#pragma unroll
        for (int c = 0; c < 4; ++c) { const int ch = 64 * n + 16 * c + 4 * fq;
            const f32x4 bR = *(const f32x4*)(gb + (d * 2 + 0) * 256 + ch), bI = *(const f32x4*)(gb + (d * 2 + 1) * 256 + ch);
            const f32x4 sp = *(const f32x4*)(spt + d * 256 + ch) * (-8.0f * 1.4426950408889634f);
#pragma unroll
            for (int ri = 0; ri < 2; ++ri) { const size_t ro = (size_t)(row0 + 16 * ri + fr) * 256 + ch;
                const float xl[4] = {bflo(xw[ri][c].x), bfhi(xw[ri][c].x), bflo(xw[ri][c].y), bfhi(xw[ri][c].y)};
                const f32x4 gr = acc[ri][c][0] + bR, gi = acc[ri][c][1] + bI; float av[4], bv[4];
#pragma unroll
                for (int e = 0; e < 4; ++e) {
                    const float rg = __builtin_amdgcn_rcpf(1.0f + __builtin_amdgcn_exp2f(-1.4426950408889634f * gr[e])), ig = __builtin_amdgcn_rcpf(1.0f + __builtin_amdgcn_exp2f(-1.4426950408889634f * gi[e]));
                    const float la2 = rg * sp[e]; const float a2 = __builtin_amdgcn_exp2f(2.0f * la2);
                    av[e] = la2; bv[e] = __builtin_amdgcn_sqrtf(fmaxf(1.0f - a2, 0.f)) * (ig * xl[e]); }
                v2u wa, wb; wa.x = pk2(av[0], av[1]); wa.y = pk2(av[2], av[3]); wb.x = pk2(bv[0], bv[1]); wb.y = pk2(bv[2], bv[3]);
                *(v2u*)(LA + ro) = wa; *(v2u*)(LB + ro) = wb; } }
    }
}

__device__ __forceinline__ int chunk_row0(int b, int d, int k) {
    if (k < 2) { const int cc = d ? 1 - k : k; return NLAT + b * CTXL + cc * CHUNK; }
    const int lc = d ? 63 - (k - 2) : (k - 2); return b * SEQ + lc * CHUNK;
}
template <bool TWO> __device__ __forceinline__ void scan1_items(const bf16* LAB, float* SUMP, float* SUMH, int it0, int it1) {
    const bf16* LA[2]; const bf16* LB[2]; int r0[2], dd[2];
#pragma unroll
    for (int q = 0; q < (TWO ? 2 : 1); ++q) { const int it = q ? it1 : it0;
        const int ch = it & 255, k = (it >> 8) % NCHUNK, bd = (it >> 8) / NCHUNK, d = bd & 1, b = bd >> 1;
        r0[q] = chunk_row0(b, d, k); dd[q] = d;
        LA[q] = LAB + (size_t)(2 * d) * LAB_STRIDE + ch; LB[q] = LAB + (size_t)(2 * d + 1) * LAB_STRIDE + ch; }
    float h[2] = {0.f, 0.f}, Ps[2] = {0.f, 0.f};
#pragma unroll 16
    for (int i = 0; i < CHUNK; ++i) {
#pragma unroll
        for (int q = 0; q < (TWO ? 2 : 1); ++q) { const int r = dd[q] ? r0[q] + CHUNK - 1 - i : r0[q] + i; const float la = bf2f(LA[q][(size_t)r * 256]), bx = bf2f(LB[q][(size_t)r * 256]); h[q] = __builtin_amdgcn_exp2f(la) * h[q] + bx; Ps[q] += la; } }
    SUMP[it0] = __builtin_amdgcn_exp2f(Ps[0]); SUMH[it0] = h[0];
    if (TWO) { SUMP[it1] = __builtin_amdgcn_exp2f(Ps[1]); SUMH[it1] = h[1]; }
}
__device__ __forceinline__ void ph_scan1(const Frame& F) {
    const bf16* LAB = (const bf16*)(F.ws + WS_LAB); float* SUMP = (float*)(F.ws + WS_SCANS); float* SUMH = SUMP + NB * 2 * NCHUNK * 256;
    const int total = NB * 2 * NCHUNK * 256, nthr = F.G * NTHR;
    for (int it = blockIdx.x * NTHR + F.tid; it < total; it += 2 * nthr) {
        if (it + nthr < total) scan1_items<true>(LAB, SUMP, SUMH, it, it + nthr); else scan1_items<false>(LAB, SUMP, SUMH, it, it);
    }
}
__device__ __forceinline__ void ph_scan2(const Frame& F) {
    const bf16* LAB = (const bf16*)(F.ws + WS_LAB); const float* SUMP = (const float*)(F.ws + WS_SCANS); const float* SUMH = SUMP + NB * 2 * NCHUNK * 256;
    float* LRUO = (float*)(F.ws + WS_LRUO); const bf16* U = (const bf16*)(F.ws + WS_U);
    for (int it = blockIdx.x * NTHR + F.tid; it < NB * NCHUNK * 256; it += F.G * NTHR) {
        const int ch = it & 255, kc = (it >> 8) % NCHUNK, b = (it >> 8) / NCHUNK;
        const int r0 = chunk_row0(b, 0, kc);
#pragma unroll 1
        for (int d = 0; d < 2; ++d) {
            const int k = d ? ((kc < 2) ? 1 - kc : 2 + 63 - (kc - 2)) : kc;
            const size_t sb = (size_t)((b * 2 + d) * NCHUNK) * 256 + ch;
            float h = 0.f;
#pragma unroll 8
            for (int j = 0; j < k; ++j) h = SUMP[sb + (size_t)j * 256] * h + SUMH[sb + (size_t)j * 256];
            const bf16* LA = LAB + (size_t)(2 * d) * LAB_STRIDE + ch; const bf16* LB = LAB + (size_t)(2 * d + 1) * LAB_STRIDE + ch;
            if (d == 0) {
#pragma unroll 16
                for (int i = 0; i < CHUNK; ++i) { const int r = r0 + i; h = __builtin_amdgcn_exp2f(bf2f(LA[(size_t)r * 256])) * h + bf2f(LB[(size_t)r * 256]); LRUO[(size_t)r * 256 + ch] = h; }
            } else {
#pragma unroll 8
                for (int i = 0; i < CHUNK; ++i) { const int r = r0 + CHUNK - 1 - i; h = __builtin_amdgcn_exp2f(bf2f(LA[(size_t)r * 256])) * h + bf2f(LB[(size_t)r * 256]);
                    const float lg = bf2f(U[(size_t)r * INW + 1024 + ch]);
                    LRUO[(size_t)r * 256 + ch] = (LRUO[(size_t)r * 256 + ch] + h) * gelu_tanh(lg); }
            }
        }
    }
}

__device__ __forceinline__ void ph_hyena_fft(const Frame& F, int l, const float* hy_bias) {
    LAS f32x2v* D = (LAS f32x2v*)(F.lds);
    const c32* KHAT = (const c32*)(F.ws + WS_KHAT) + (size_t)l * 256 * 16384;
    const bf16* VT = (const bf16*)(F.ws + WS_VT); const bf16* X0T = (const bf16*)(F.ws + WS_X0T); bf16* HYO = (bf16*)(F.ws + WS_HYO);
    for (int it = blockIdx.x; it < 512; it += F.G) {
        const int c = it >> 1, bp = it & 1;
        const unsigned short* va = (const unsigned short*)(VT + ((size_t)(bp * 2) * 256 + c) * SEQ); const unsigned short* vb = (const unsigned short*)(VT + ((size_t)(bp * 2 + 1) * 256 + c) * SEQ);
        unsigned pv[8], pw[8];
#pragma unroll
        for (int i = 0; i < 8; ++i) { const int j = F.tid + 512 * i; pv[i] = (unsigned)va[j] | ((unsigned)vb[j] << 16); pw[i] = (unsigned)va[j + 4096] | ((unsigned)vb[j + 4096] << 16); }
#pragma unroll
        for (int i = 0; i < 8; ++i) { const int j = F.tid + 512 * i; c32 x0, x1, z; x0.x = bflo(pv[i]); x0.y = bfhi(pv[i]); x1.x = bflo(pw[i]); x1.y = bfhi(pw[i]); z.x = 0.f; z.y = 0.f;
            fft_first4(D, j, x0, x1, z, z); }
        __syncthreads();
        { fft_fwd16(D, F.tid, 4096); fft_fwd16(D, F.tid + 512, 4096); }
        __syncthreads();
        { fft_fwd16(D, F.tid, 256); fft_fwd16(D, F.tid + 512, 256); }
        __syncthreads();
        _Pragma("unroll 1") for (int g_ = F.tid; g_ < 1024; g_ += 512) fft_mid16(D, g_, KHAT + (size_t)c * 16384);
        __syncthreads();
        { fft_inv16(D, F.tid, 256); fft_inv16(D, F.tid + 512, 256); }
        __syncthreads();
        { fft_inv16(D, F.tid, 4096); fft_inv16(D, F.tid + 512, 4096); }
        __syncthreads();
        const unsigned short* xa = (const unsigned short*)(X0T + ((size_t)(bp * 2) * 256 + c) * SEQ); const unsigned short* xb = (const unsigned short*)(X0T + ((size_t)(bp * 2 + 1) * 256 + c) * SEQ);
        unsigned qv[8], qw[8];
#pragma unroll
        for (int i = 0; i < 8; ++i) { const int j = F.tid + 512 * i; qv[i] = (unsigned)xa[j] | ((unsigned)xb[j] << 16); qw[i] = (unsigned)xa[j + 4096] | ((unsigned)xb[j + 4096] << 16);
            pv[i] = (unsigned)va[j] | ((unsigned)vb[j] << 16); pw[i] = (unsigned)va[j + 4096] | ((unsigned)vb[j + 4096] << 16); }
        const float bias = hy_bias[l * 256 + c];
        bf16* oa = HYO + ((size_t)(bp * 2) * 256 + c) * SEQ; bf16* ob = HYO + ((size_t)(bp * 2 + 1) * 256 + c) * SEQ;
#pragma unroll
        for (int i = 0; i < 8; ++i) { const int j = F.tid + 512 * i; c32 u0, u1; fft_final4(D, j, u0, u1);
            oa[j] = (bf16)f2bf((u0.x + bflo(pv[i]) * bias) * bflo(qv[i]));                 ob[j] = (bf16)f2bf((-u0.y + bfhi(pv[i]) * bias) * bfhi(qv[i]));
            oa[j + 4096] = (bf16)f2bf((u1.x + bflo(pw[i]) * bias) * bflo(qw[i])); ob[j + 4096] = (bf16)f2bf((-u1.y + bfhi(pw[i]) * bias) * bfhi(qw[i])); }
        __syncthreads();
    }
}
__device__ __forceinline__ void ph_hyena_ctx(const Frame& F, const float* hy_bias, const float* hy_cw, const float* hy_cb) {
    float* HYO = (float*)(F.ws + WS_HYO);
    {

        const bf16* U = (const bf16*)(F.ws + WS_U); const float* KFC = (const float*)(F.ws + WS_KFC);
        LAS float* vw = (LAS float*)(F.lds + F.wave * 4096);
        LAS float* kw = vw + 256;
        const float* cw = hy_cw; const float* cbp = hy_cb;
        for (int it = F.gw; it < NB * 256; it += F.ngw) {
            const int b = it >> 8, c = it & 255;
            float x0v[4];
#pragma unroll
            for (int i = 0; i < 4; ++i) { const int t = F.lane + 64 * i;
                float o[3];
#pragma unroll
                for (int g = 0; g < 3; ++g) { const int cc = g * 256 + c; float a = cbp[cc];
#pragma unroll
                    for (int j = 0; j < 3; ++j) { const int tj = t + j - 1; if (tj >= 0 && tj < CTXL) a += cw[j * 768 + cc] * bf2f(U[(size_t)(NLAT + b * CTXL + tj) * INW + 1280 + cc]); }
                    o[g] = a; }
                vw[t] = o[2] * o[1]; x0v[i] = o[0]; }
#pragma unroll
            for (int i = 0; i < 8; ++i) kw[F.lane + 64 * i] = KFC[c * 512 + F.lane + 64 * i];
            LDS_WAIT();
            float y[4] = {0.f, 0.f, 0.f, 0.f};
#pragma unroll 4
            for (int s = 0; s < CTXL; ++s) { const float vv = vw[s];
#pragma unroll
                for (int i = 0; i < 4; ++i) y[i] += kw[(F.lane + 64 * i - s) & 511] * vv; }
            const float bias = hy_bias[c];
#pragma unroll
            for (int i = 0; i < 4; ++i) { const int t = F.lane + 64 * i; HYO[(size_t)(NLAT + b * CTXL + t) * 256 + c] = (y[i] + vw[t] * bias) * x0v[i]; }
            LDS_WAIT();
        }
    }
}

__device__ __forceinline__ void merge_row(const Frame& F, int r, const float* g, float h0, float h1, float h2, float h3) {
    const bf16* ATT = (const bf16*)(F.ws + WS_ATT); const float* LRUO = (const float*)(F.ws + WS_LRUO); bf16* MIXA = (bf16*)(F.ws + WS_MIXA);
    const v4u aw = ((const v4u*)(ATT + (size_t)r * 512))[F.lane];
    float a[8] = {bflo(aw.x), bfhi(aw.x), bflo(aw.y), bfhi(aw.y), bflo(aw.z), bfhi(aw.z), bflo(aw.w), bfhi(aw.w)};
    float ss = 0.f;
#pragma unroll
    for (int i = 0; i < 8; ++i) ss += a[i] * a[i];
    const float ra = 1.0f / sqrtf(wave_sum(ss) * (1.0f / 512.0f) + EPSN);
    const f32x4 lv = ((const f32x4*)(LRUO + (size_t)r * 256))[F.lane];
    const float rl = 1.0f / sqrtf(wave_sum(lv.x * lv.x + lv.y * lv.y + lv.z * lv.z + lv.w * lv.w) * (1.0f / 256.0f) + EPSN);
    const float rh = 1.0f / sqrtf(wave_sum(h0 * h0 + h1 * h1 + h2 * h2 + h3 * h3) * (1.0f / 256.0f) + EPSN);
    bf16* orow = MIXA + (size_t)r * 1024;
    { const f32x4 g0 = ((const f32x4*)g)[2 * F.lane], g1 = ((const f32x4*)g)[2 * F.lane + 1];
      v4u o; o.x = pk2(a[0] * ra * g0.x, a[1] * ra * g0.y); o.y = pk2(a[2] * ra * g0.z, a[3] * ra * g0.w); o.z = pk2(a[4] * ra * g1.x, a[5] * ra * g1.y); o.w = pk2(a[6] * ra * g1.z, a[7] * ra * g1.w);
      ((v4u*)orow)[F.lane] = o; }
    { const f32x4 gg = ((const f32x4*)(g + 512))[F.lane]; v2u o; o.x = pk2(lv.x * rl * gg.x, lv.y * rl * gg.y); o.y = pk2(lv.z * rl * gg.z, lv.w * rl * gg.w); ((v2u*)(orow + 512))[F.lane] = o; }
    orow[768 + F.lane] = (bf16)f2bf(h0 * rh * g[768 + F.lane]); orow[832 + F.lane] = (bf16)f2bf(h1 * rh * g[832 + F.lane]);
    orow[896 + F.lane] = (bf16)f2bf(h2 * rh * g[896 + F.lane]); orow[960 + F.lane] = (bf16)f2bf(h3 * rh * g[960 + F.lane]);
}
__device__ __forceinline__ void ph_merge(const Frame& F, int l, int nrows, const float* out_g) {
    const float* HYO = (const float*)(F.ws + WS_HYO);
    const float* g = out_g + l * 1024;
    LAS float* tile = (LAS float*)(F.lds);
    for (int it = blockIdx.x; it < NLAT / 64; it += F.G) {
        const int b = it >> 7, t0 = (it & 127) * 64;
#pragma unroll 8
        for (int i = 0; i < 32; ++i) { const int c = F.wave * 32 + i; tile[c * 65 + F.lane] = bf2f(((const bf16*)HYO)[((size_t)b * 256 + c) * SEQ + t0 + F.lane]); }
        __syncthreads();
#pragma unroll 2
        for (int k = 0; k < 8; ++k) { const int tt = F.wave * 8 + k;
            merge_row(F, b * SEQ + t0 + tt, g, tile[F.lane * 65 + tt], tile[(F.lane + 64) * 65 + tt], tile[(F.lane + 128) * 65 + tt], tile[(F.lane + 192) * 65 + tt]); }
        __syncthreads();
    }
    for (int r = NLAT + F.gw; r < nrows; r += F.ngw) {
        const float* hr = HYO + (size_t)r * 256;
        merge_row(F, r, g, hr[F.lane], hr[64 + F.lane], hr[128 + F.lane], hr[192 + F.lane]);
    }
}


constexpr int RW_PITCH = 34;
__device__ __forceinline__ void router_cols(LAS const float* rwl, const bf16* XR, const float* gc, const float* sf, unsigned char* Fbytes, int r, float rstd, int j, int kq, int i0, int i1, f32x4& acc0, f32x4& acc1) {
    const bf16* xrow = XR + (size_t)r * 1024 + 8 * kq; const float* gcp = gc + 8 * kq; const float* sfp = sf + 8 * kq;
    v4u xn[4];
#pragma unroll
    for (int u = 0; u < 4; ++u) xn[u] = *(const v4u*)(xrow + 32 * (i0 + u));
#pragma unroll 1
    for (int ib = i0; ib < i1; ib += 4) {
        v4u xw[4]; f32x4 g4[4][2], s4[4][2];
#pragma unroll
        for (int u = 0; u < 4; ++u) { xw[u] = xn[u]; g4[u][0] = *(const f32x4*)(gcp + 32 * (ib + u)); g4[u][1] = *(const f32x4*)(gcp + 32 * (ib + u) + 4); s4[u][0] = *(const f32x4*)(sfp + 32 * (ib + u)); s4[u][1] = *(const f32x4*)(sfp + 32 * (ib + u) + 4); }
        if (ib + 4 < i1) {
#pragma unroll
            for (int u = 0; u < 4; ++u) xn[u] = *(const v4u*)(xrow + 32 * (ib + 4 + u)); }
#pragma unroll
        for (int u = 0; u < 4; ++u) {
            const float x[8] = {bflo(xw[u].x), bfhi(xw[u].x), bflo(xw[u].y), bfhi(xw[u].y), bflo(xw[u].z), bfhi(xw[u].z), bflo(xw[u].w), bfhi(xw[u].w)};
            float xb[8], fv[8];
#pragma unroll
            for (int e = 0; e < 8; ++e) { xb[e] = x[e] * g4[u][e >> 2][e & 3]; fv[e] = xb[e] * rstd + s4[u][e >> 2][e & 3]; }
#if MOE_FP8
            v2u o; o.x = pg8::pack4_fp8(fv[0] * pg8::F8_SF, fv[1] * pg8::F8_SF, fv[2] * pg8::F8_SF, fv[3] * pg8::F8_SF); o.y = pg8::pack4_fp8(fv[4] * pg8::F8_SF, fv[5] * pg8::F8_SF, fv[6] * pg8::F8_SF, fv[7] * pg8::F8_SF);
            *(v2u*)(Fbytes + (size_t)r * 1024 + 8 * kq + 32 * (ib + u)) = o;
#else
            v4u o; o.x = pk2(fv[0], fv[1]); o.y = pk2(fv[2], fv[3]); o.z = pk2(fv[4], fv[5]); o.w = pk2(fv[6], fv[7]); *(v4u*)((bf16*)Fbytes + (size_t)r * 1024 + 8 * kq + 32 * (ib + u)) = o;
#endif
            const LAS float* wp = rwl + (32 * (ib + u) + 8 * kq) * RW_PITCH + j;
#pragma unroll
            for (int e = 0; e < 8; ++e) { acc0 = __builtin_amdgcn_mfma_f32_16x16x4f32(wp[e * RW_PITCH], xb[e], acc0, 0, 0, 0); acc1 = __builtin_amdgcn_mfma_f32_16x16x4f32(wp[e * RW_PITCH + 16], xb[e], acc1, 0, 0, 0); }
        }
    }
}
__device__ __forceinline__ void router_finish(LAS const float* cbl, LAS int* hist, int* TOPI, float* GATE, int r, int bidx, float rstd, int j, int kq, const f32x4& acc0, const f32x4& acc1) {
    float lg[8];
#pragma unroll
    for (int rr = 0; rr < 4; ++rr) { lg[rr] = rstd * acc0[rr] + cbl[bidx * 32 + 4 * kq + rr]; lg[4 + rr] = rstd * acc1[rr] + cbl[bidx * 32 + 16 + 4 * kq + rr]; }
    float p[32];
#pragma unroll
    for (int e = 0; e < 32; ++e) p[e] = __shfl(lg[(e >> 4) * 4 + (e & 3)], j + 16 * ((e & 15) >> 2));
    unsigned taken = 0u; float tv[4]; int ti[4];
#pragma unroll
    for (int k = 0; k < 4; ++k) { float best = -INFINITY; int bi = 0;
#pragma unroll
        for (int e = 0; e < 32; ++e) { const bool ok = !((taken >> e) & 1u) && (p[e] > best); best = ok ? p[e] : best; bi = ok ? e : bi; }
        taken |= 1u << bi; tv[k] = best; ti[k] = bi; }
    const float e1 = __expf(tv[1] - tv[0]), e2 = __expf(tv[2] - tv[0]), e3 = __expf(tv[3] - tv[0]); const float inv = 1.0f / (1.0f + e1 + e2 + e3);
    if (kq == 0) {
        TOPI[r * 4 + 0] = ti[0]; TOPI[r * 4 + 1] = ti[1]; TOPI[r * 4 + 2] = ti[2]; TOPI[r * 4 + 3] = ti[3];
        GATE[r * 4 + 0] = inv; GATE[r * 4 + 1] = e1 * inv; GATE[r * 4 + 2] = e2 * inv; GATE[r * 4 + 3] = e3 * inv;
        lds_add(&hist[ti[0]], 1); lds_add(&hist[ti[1]], 1); lds_add(&hist[ti[2]], 1); lds_add(&hist[ti[3]], 1);
    }
}
__device__ __forceinline__ void ph_ffn_router(const Frame& F, int l, int nrows, const float* router_w) {
    LAS float* rwl = (LAS float*)(F.lds);
    LAS float* part = (LAS float*)(F.lds + 139264);
    LAS float* cbl = (LAS float*)(F.lds + 153600);
    LAS int* hist = (LAS int*)(F.lds + 153600 + 640);
    const bf16* XR = (const bf16*)(F.ws + WS_XR); const float* RSSP = (const float*)(F.ws + WS_RSSP); const float* MOD = (const float*)(F.ws + WS_MOD);
    const float* GC = (const float*)(F.ws + WS_GC) + (size_t)l * 5 * 1024; unsigned char* Fb = (unsigned char*)(F.ws + WS_F);
    int* TOPI = (int*)(F.ws + WS_TOPI); float* GATE = (float*)(F.ws + WS_GATE); int* BLKCNT = (int*)(F.ws + WS_BLKCNT);
    for (int i = F.tid; i < 1024 * 32; i += NTHR) rwl[(i >> 5) * RW_PITCH + (i & 31)] = router_w[(size_t)l * 32768 + i];
    if (F.tid < 32) hist[F.tid] = 0;
    if (F.tid < 160) cbl[F.tid] = ((const float*)(F.ws + WS_CB))[l * 160 + F.tid];
    __syncthreads();
    const int j = F.lane & 15, kq = F.lane >> 4;
    const int ngrp = nrows / 16, nmain = (ngrp / F.ngw) * F.ngw;
    for (int grp = F.gw; grp < nmain; grp += F.ngw) {
        const int r0 = grp * 16, r = r0 + j; const int bidx = r0 < NLAT ? r0 / SEQ : 4;
        float ss; { const f32x4 q = *(const f32x4*)(RSSP + (size_t)r * 16 + 4 * kq); ss = (q.x + q.y) + (q.z + q.w); }
        ss += __shfl_xor(ss, 16); ss += __shfl_xor(ss, 32);
        const float rstd = 1.0f / sqrtf(ss * (1.0f / 1024.0f) + EPSN);
        f32x4 acc0 = {0.f, 0.f, 0.f, 0.f}, acc1 = acc0;
        router_cols(rwl, XR, GC + bidx * 1024, MOD + (size_t)(l * 5 + bidx) * 6144 + 3 * 1024, Fb, r, rstd, j, kq, 0, 32, acc0, acc1);
        router_finish(cbl, hist, TOPI, GATE, r, bidx, rstd, j, kq, acc0, acc1);
    }
    for (int grp = nmain + (int)blockIdx.x; grp < ngrp; grp += F.G) {
        const int r0 = grp * 16, r = r0 + j; const int bidx = r0 < NLAT ? r0 / SEQ : 4;
        float ss; { const f32x4 q = *(const f32x4*)(RSSP + (size_t)r * 16 + 4 * kq); ss = (q.x + q.y) + (q.z + q.w); }
        ss += __shfl_xor(ss, 16); ss += __shfl_xor(ss, 32);
        const float rstd = 1.0f / sqrtf(ss * (1.0f / 1024.0f) + EPSN);
        f32x4 acc0 = {0.f, 0.f, 0.f, 0.f}, acc1 = acc0;
        router_cols(rwl, XR, GC + bidx * 1024, MOD + (size_t)(l * 5 + bidx) * 6144 + 3 * 1024, Fb, r, rstd, j, kq, 4 * F.wave, 4 * F.wave + 4, acc0, acc1);
        if (F.wave > 0) { LAS f32x4* pp = (LAS f32x4*)(part + ((F.wave - 1) * 64 + F.lane) * 8); pp[0] = acc0; pp[1] = acc1; }
        __syncthreads();
        if (F.wave == 0) {
#pragma unroll
            for (int w = 0; w < 7; ++w) { const LAS f32x4* pp = (const LAS f32x4*)(part + (w * 64 + F.lane) * 8); acc0 += pp[0]; acc1 += pp[1]; }
            router_finish(cbl, hist, TOPI, GATE, r, bidx, rstd, j, kq, acc0, acc1);
        }
        __syncthreads();
    }
    __syncthreads();
    if (F.tid < 32) BLKCNT[blockIdx.x * 32 + F.tid] = hist[F.tid];
}

__device__ __forceinline__ void ph_route(const Frame& F, int nrows) {
    LAS int* cursor = (LAS int*)(F.lds);
    LAS int* tot = cursor + 32;
    LAS int* mine = cursor + 64;
    LAS int* part = cursor + 96;
    LAS int* ebase = cursor + 96 + 1024;
    const int* BLKCNT = (const int*)(F.ws + WS_BLKCNT); const int* TOPI = (const int*)(F.ws + WS_TOPI); int* POS = (int*)(F.ws + WS_POS);
    int* ROWTOK = (int*)(F.ws + WS_ROWTOK); int* TILEE = (int*)(F.ws + WS_TILEE);
    { const int e = F.tid & 31, sl = F.tid >> 5; int t = 0, m = 0;
      for (int b = sl; b < F.G; b += 16) { const int v = BLKCNT[b * 32 + e]; t += v; m += (b < (int)blockIdx.x) ? v : 0; }
      part[sl * 64 + e] = t; part[sl * 64 + 32 + e] = m;
      __syncthreads();
      if (F.tid < 32) { int tt = 0, mm = 0;
#pragma unroll
          for (int s = 0; s < 16; ++s) { tt += part[s * 64 + F.tid]; mm += part[s * 64 + 32 + F.tid]; }
          tot[F.tid] = tt; mine[F.tid] = mm; } }
    __syncthreads();
    if (F.tid == 0) { int tb = 0;
        for (int e = 0; e < 32; ++e) { const int nt = (tot[e] + 255) >> 8; cursor[e] = tb * 256 + mine[e]; ebase[e] = tb * 256;
            if (blockIdx.x == 0) for (int j = 0; j < nt; ++j) TILEE[tb + j] = e;
            tb += nt; }
        ebase[32] = tb * 256;
        if (blockIdx.x == 0) F.ctl[CW_NTILES] = (unsigned)tb; }
    __syncthreads();
    for (int e = blockIdx.x; e < 32; e += F.G) for (int p = ebase[e] + tot[e] + F.tid; p < ebase[e + 1]; p += NTHR) ROWTOK[p] = 0;
    const int sub = F.lane >> 2, k = F.lane & 3;
    const int ngrp = nrows / 16, nmain = (ngrp / F.ngw) * F.ngw;
    for (int grp = F.gw; grp < nmain; grp += F.ngw) {
        const int r = grp * 16 + sub; const int e = TOPI[r * 4 + k]; const int pos = lds_add(&cursor[e], 1); POS[r * 4 + k] = pos; ROWTOK[pos] = r; }
    if (F.wave == 0) for (int grp = nmain + (int)blockIdx.x; grp < ngrp; grp += F.G) {
        const int r = grp * 16 + sub; const int e = TOPI[r * 4 + k]; const int pos = lds_add(&cursor[e], 1); POS[r * 4 + k] = pos; ROWTOK[pos] = r; }
}

__device__ __forceinline__ void ph_combine(const Frame& F, int l, int nrows, float* out, const float* gmix) {
    bf16* XR = (bf16*)(F.ws + WS_XR); const float* MOD = (const float*)(F.ws + WS_MOD); const bf16* YS = (const bf16*)(F.ws + WS_YS); bf16* H = (bf16*)(F.ws + WS_H);
    const int* POS = (const int*)(F.ws + WS_POS); const float* GATE = (const float*)(F.ws + WS_GATE);
    for (int r = 2 * F.gw; r < nrows; r += 2 * F.ngw) {
        const int bidx = r < NLAT ? r / SEQ : 4;
        const float* gf = MOD + (size_t)(l * 5 + bidx) * 6144 + 5 * 1024;
        int pos = 0; float gt = 0.f;
        if (F.lane < 8) { pos = POS[r * 4 + F.lane]; gt = GATE[r * 4 + F.lane]; }
        v2u w[2][4][4], xw[2][4]; float gk[2][4];
#pragma unroll
        for (int rr = 0; rr < 2; ++rr)
#pragma unroll
            for (int k = 0; k < 4; ++k) { const int pk = __shfl(pos, rr * 4 + k); gk[rr][k] = __shfl(gt, rr * 4 + k);
#if MOE_FP8
                gk[rr][k] *= (1.0f / pg8::F8_SY); const unsigned* yr = (const unsigned*)((const unsigned char*)YS + (size_t)pk * YS_PITCH);
#pragma unroll
                for (int j = 0; j < 4; ++j) { w[rr][k][j].x = yr[64 * j + F.lane]; w[rr][k][j].y = 0u; } }
#else
                const v2u* yr = (const v2u*)(YS + (size_t)pk * 1024);
#pragma unroll
                for (int j = 0; j < 4; ++j) w[rr][k][j] = yr[64 * j + F.lane]; }
#endif
#pragma unroll
        for (int rr = 0; rr < 2; ++rr)
#pragma unroll
            for (int j = 0; j < 4; ++j) xw[rr][j] = ((const v2u*)(XR + (size_t)(r + rr) * 1024))[64 * j + F.lane];
        f32x4 gv[4];
#pragma unroll
        for (int j = 0; j < 4; ++j) gv[j] = ((const f32x4*)gf)[64 * j + F.lane];
#pragma unroll
        for (int rr = 0; rr < 2; ++rr) {
            const int row = r + rr;
            f32x4 y[4]; float ss = 0.f;
#pragma unroll
            for (int j = 0; j < 4; ++j) { f32x4 a = {0.f, 0.f, 0.f, 0.f};
#pragma unroll
                for (int k = 0; k < 4; ++k) { const v2u ww = w[rr][k][j]; const float g_ = gk[rr][k];
#if MOE_FP8
                    a.x += g_ * __builtin_amdgcn_cvt_f32_fp8((int)ww.x, 0); a.y += g_ * __builtin_amdgcn_cvt_f32_fp8((int)ww.x, 1); a.z += g_ * __builtin_amdgcn_cvt_f32_fp8((int)ww.x, 2); a.w += g_ * __builtin_amdgcn_cvt_f32_fp8((int)ww.x, 3); }
#else
                    a.x += g_ * bflo(ww.x); a.y += g_ * bfhi(ww.x); a.z += g_ * bflo(ww.y); a.w += g_ * bfhi(ww.y); }
#endif
                const f32x4 xv = {bflo(xw[rr][j].x), bfhi(xw[rr][j].x), bflo(xw[rr][j].y), bfhi(xw[rr][j].y)};
                y[j] = xv + gv[j] * a;
                const int cb = 64 * j + F.lane;
                if (l == 0) { v2u o; o.x = pk2(y[j].x, y[j].y); o.y = pk2(y[j].z, y[j].w); ((v2u*)(XR + (size_t)row * 1024))[cb] = o; } else ((f32x4*)(out + (size_t)row * 1024))[cb] = y[j];
                ss += (y[j].x * y[j].x + y[j].y * y[j].y) + (y[j].z * y[j].z + y[j].w * y[j].w); }
            if (l == 0) {
                const float rstd = 1.0f / sqrtf(wave_sum(ss) * (1.0f / 1024.0f) + EPSN);
                const float* shift = MOD + (size_t)(5 + bidx) * 6144; const float* scale = shift + 1024; const float* g = gmix + 1024;
#pragma unroll
                for (int j = 0; j < 4; ++j) { const int cb = 64 * j + F.lane; const f32x4 gg = ((const f32x4*)g)[cb], sc = ((const f32x4*)scale)[cb], sh = ((const f32x4*)shift)[cb];
                    const f32x4 hv = y[j] * rstd * gg * (sc + 1.0f) + sh;
                    v2u o; o.x = pk2(hv.x, hv.y); o.y = pk2(hv.z, hv.w); ((v2u*)(H + (size_t)row * 1024))[cb] = o; }
            }
        }
    }
}

struct Args { const float* in[34]; float* out; unsigned char* ws; int ph_lo, ph_hi; };
enum { I_X = 0, I_C, I_CTX, I_CCTX, I_WMOD, I_BMOD, I_GMIX, I_GFFN, I_WIN, I_QG, I_KG, I_LCW, I_LCB, I_LGW, I_LGB, I_LLAM, I_HCW, I_HCB, I_HW1, I_HB1, I_HW2, I_HB2, I_HW3, I_HFREQ, I_HDEC, I_HBIAS,
       I_OUTG, I_WOUT, I_RW, I_RB, I_MW1, I_MB1, I_MW2, I_MB2 };

__global__ void __launch_bounds__(NTHR, 2) mk_fwd(Args args) {
    extern __shared__ __attribute__((aligned(16))) unsigned char lds[];
    Frame F;
    F.lds = (LAS unsigned char*)lds; F.ws = args.ws; F.ctl = (unsigned*)(args.ws + WS_CTL);
    F.tid = threadIdx.x; F.lane = F.tid & 63; F.wave = __builtin_amdgcn_readfirstlane(F.tid >> 6);
    F.G = gridDim.x; { const int bx = blockIdx.x; F.vcu = (F.G % 8 == 0) ? (bx % 8) * (F.G / 8) + bx / 8 : bx; }
    F.gw = (int)blockIdx.x * NWAVES + F.wave; F.ngw = F.G * NWAVES;
    for (int u = F.tid; u < (LDS_BYTES - LDSCTL_OFF) / 4; u += NTHR) ((LAS unsigned*)(F.lds + LDSCTL_OFF))[u] = 0u;
    __syncthreads();
#if !MK_PER_PHASE
    XcdBarrier bar = xcd_barrier_post(F.ctl + CW_BAR, (volatile LAS unsigned*)(F.lds + LDSCTL_OFF + 32));
#define GRID_BAR() xcd_barrier(bar)
#else
#define GRID_BAR() do { } while (0)
#endif
    const int lo = args.ph_lo, hi = args.ph_hi;
#ifndef ONLY_PHASE
#define ONLY_PHASE (-1)
#endif
#define ENABLED(id) (ONLY_PHASE < 0 || ONLY_PHASE == (id))
#define IN(k) (ENABLED(k) && lo <= (k) && (k) < hi)
#define INL(j) (ENABLED(NPH_PRO + (j)) && lo <= pb + (j) && pb + (j) < hi)
#define SEAML(j) do { if (lo <= pb + (j) && pb + (j) + 1 < hi) { GRID_BAR(); } } while (0)
typedef const __attribute__((address_space(4))) Args* KArgs;
#ifndef REP_MASK
#define REP_MASK 0
#endif
#define NREP(j) (((REP_MASK >> (j)) & 1) ? 2 : 1)
#define REFRAME() Frame Fp = F; KArgs ka = (KArgs)__builtin_amdgcn_kernarg_segment_ptr(); { int t_ = F.tid; asm volatile("" : "+v"(t_), "+s"(ka)); Fp.tid = t_; Fp.lane = t_ & 63; Fp.wave = __builtin_amdgcn_readfirstlane(t_ >> 6); \
    Fp.gw = (int)blockIdx.x * NWAVES + Fp.wave; Fp.ws = ka->ws; Fp.ctl = (unsigned*)(ka->ws + WS_CTL); }
#define SEAM(k) do { if (lo <= (k) && (k) + 1 < hi) { GRID_BAR(); } } while (0)

    if (IN(0)) ph_prologue_a(F, args.in[I_C], args.in[I_CCTX], args.in[I_WMOD], args.in[I_BMOD], args.in[I_WIN], args.in[I_WOUT], args.in[I_MW1], args.in[I_MW2],
                             args.in[I_HW1], args.in[I_HB1], args.in[I_HW2], args.in[I_HB2], args.in[I_HFREQ], args.in[I_LGW], args.in[I_LLAM]);
    SEAM(0);
    if (IN(1)) ph_prologue_b(F, args.in[I_HW3], args.in[I_HDEC], args.in[I_GFFN], args.in[I_RW], args.in[I_RB]);
    SEAM(1);

#if MOE_FP8
#define MOE_EPI1 pg8::EpiSwigluF8
#define MOE_EPI2 pg8::EpiF8BiasF8
#else
#define MOE_EPI1 pg8::EpiSwiglu
#define MOE_EPI2 pg8::EpiBf16Bias
#endif
#ifndef PROBE_MOE2
#define PROBE_MOE2 0
#endif
#ifndef PROBE_MOE2B
#define PROBE_MOE2B 0
#endif
#ifndef PROBE_GEMM_K
#define PROBE_GEMM_K 0
#endif
#ifndef MOE_WGM1
#define MOE_WGM1 4
#endif
#ifndef MOE_WGM2
#define MOE_WGM2 8
#endif
#define PHASE(j, ...) if (INL(j)) { _Pragma("unroll") for (int rep_ = 0; rep_ < NREP(j); ++rep_) { { REFRAME(); __VA_ARGS__ } if (rep_ + 1 < NREP(j)) GRID_BAR(); } }
#define LAYER_BODY(l) { \
        const int pb = NPH_PRO + l * NPH_LAYER; \
        const int nrows = (l == 0) ? MT : NLAT; \
        if (l == 0) { PHASE(0, ph_norm_mod(Fp, l, ka->in[I_X], ka->in[I_CTX], ka->in[I_GMIX]);) SEAML(0); } \
        if (INL(1)) { REFRAME(); \
            unsigned* sw_ = Fp.ctl + CW_SPLIT + 2048 * l; \
            { pg8::Gemm g{(const bf16*)(Fp.ws + WS_H), (const bf16*)(Fp.ws + WS_WINT) + (size_t)l * 2048 * 1024, NLAT, 2048, 1024}; \
              pg8::StaticOrder S; S.init(NLAT, 2048, Fp.G, (int)blockIdx.x); \
              pg8::EpiBf16<0> E{(bf16*)(Fp.ws + WS_U), 2048, nullptr, 0, 0, 1.f}; \
              pg8::gemm_phase<pg8::EpiBf16<0>, pg8::StaticOrder, PG8_ALIGN, PG8_SP2>(Fp.lds + RING_OFF, g, S, E); } \
            split_arrive_all(bar, sw_);                                        \
            if ((int)blockIdx.x < CTXWG) {                                     \
              pg8::Gemm g{(const bf16*)(Fp.ws + WS_H) + (size_t)NLAT * 1024, (const bf16*)(Fp.ws + WS_WINT) + (size_t)l * 2048 * 1024, MT - NLAT, 2048, 1024}; \
              pg8::StaticOrder S; S.init(MT - NLAT, 2048, CTXWG, (int)blockIdx.x); \
              pg8::EpiBf16<0> E{(bf16*)(Fp.ws + WS_U) + (size_t)NLAT * 2048, 2048, nullptr, 0, 0, 1.f}; \
              pg8::gemm_phase<pg8::EpiBf16<0>, pg8::StaticOrder, PG8_ALIGN, PG8_SP2>(Fp.lds + RING_OFF, g, S, E); \
              split_arrive_flat(sw_); } \
            split_wait_all(bar, sw_); \
            if ((int)blockIdx.x >= CTXWG) post_ab(Fp, l, 0, NLAT, ((int)blockIdx.x - CTXWG) * NWAVES + Fp.wave, (Fp.G - CTXWG) * NWAVES, ka->in[I_KG], ka->in[I_LCW], ka->in[I_LCB]); \
            split_wait_flat(bar, sw_, (unsigned)CTXWG); \
            post_ab(Fp, l, NLAT, MT, Fp.gw, Fp.ngw, ka->in[I_KG], ka->in[I_LCW], ka->in[I_LCB]); \
            post_c(Fp, l, ka->in[I_HCW], ka->in[I_HCB]); } \
        SEAML(2); \
        if (INL(3)) { REFRAME(); \
            unsigned* sw_ = Fp.ctl + CW_SPLIT + 2048 * (2 + l); \
            { int kg_ = 256; asm volatile("" : "+s"(kg_)); \
              pg8::Gemm g{(const bf16*)(Fp.ws + WS_XL), (const bf16*)(Fp.ws + WS_WGT) + (size_t)l * 1024 * 256, NLAT, 1024, kg_}; \
              pg8::StaticOrder S; S.init(NLAT, 1024, Fp.G, (int)blockIdx.x); \
              pg8::EpiLruGate E{(const bf16*)(Fp.ws + WS_XL), (bf16*)(Fp.ws + WS_LAB), LAB_STRIDE, ka->in[I_LGB] + (size_t)l * 1024, (const float*)(Fp.ws + WS_SPT) + l * 512}; \
              pg8::gemm_phase<pg8::EpiLruGate, pg8::StaticOrder, PG8_ALIGN, PG8_SP2>(Fp.lds + RING_OFF, g, S, E); } \
            split_arrive_all(bar, sw_); \
            if ((int)blockIdx.x >= 32 && (int)blockIdx.x < 64) {            \
              ph_lru_gates(Fp, l, ka->in[I_LGB], NLAT / 32, (MT - NLAT) / 32, ((int)blockIdx.x - 32) * NWAVES + Fp.wave, 32 * NWAVES); \
              split_arrive_flat(sw_); } \
            split_wait_all(bar, sw_); split_wait_flat(bar, sw_, 32u); \
            ph_scan1(Fp); __syncthreads(); \
            { const attn_body::AttnTensors AT{(const attn_body::bf16*)(Fp.ws + WS_U), (const attn_body::bf16*)(Fp.ws + WS_K), (const attn_body::bf16*)(Fp.ws + WS_V), (attn_body::bf16*)(Fp.ws + WS_ATT)}; \
              const attn_body::QPre QN{ka->in[I_QG] + l * 64, (const float*)(Fp.ws + WS_ROPEC), (const float*)(Fp.ws + WS_ROPES)}; \
              attn_body::attn_phase<8>((char*)lds + RING_OFF, AT, QN, Fp.G, Fp.vcu, l == 0, (long)NLAT); } } \
        SEAML(4); \
        PHASE(5, ph_scan2(Fp); __syncthreads(); ph_hyena_fft(Fp, l, ka->in[I_HBIAS]); if (l == 0) ph_hyena_ctx(Fp, ka->in[I_HBIAS], ka->in[I_HCW], ka->in[I_HCB]);) \
        SEAML(5); \
        PHASE(6, ph_merge(Fp, l, nrows, ka->in[I_OUTG]);) \
        SEAML(6); \
        if (INL(7)) { REFRAME(); \
            pg8::Gemm g{(const bf16*)(Fp.ws + WS_MIXA), (const bf16*)(Fp.ws + WS_WOUTT) + (size_t)l * 1024 * 1024, nrows, 1024, 1024}; \
            pg8::StaticOrder S; S.init(nrows, 1024, Fp.G, (int)blockIdx.x); \
            bf16* XR = (bf16*)(Fp.ws + WS_XR); \
            pg8::EpiResid<(l) == 1> E{ka->in[I_X], ka->in[I_CTX], NLAT, XR, 1024, \
                            (const float*)(Fp.ws + WS_MOD) + (size_t)(l * 5) * 6144 + 2 * 1024, 6144, SEQ, (float*)(Fp.ws + WS_RSSP)}; \
            pg8::gemm_phase<pg8::EpiResid<(l) == 1>, pg8::StaticOrder, PG8_ALIGN, PG8_SP2>(Fp.lds + RING_OFF, g, S, E); \
        } \
        SEAML(7); \
        PHASE(8, ph_ffn_router(Fp, l, nrows, ka->in[I_RW]);) \
        SEAML(8); \
        PHASE(9, ph_route(Fp, nrows);) \
        SEAML(9); \
        if (INL(10) || INL(11)) { REFRAME(); \
            LAS int* tab = (LAS int*)(Fp.lds + MOETAB_OFF); \
            const int ntiles = (int)__hip_atomic_load(Fp.ctl + CW_NTILES, __ATOMIC_RELAXED, __HIP_MEMORY_SCOPE_AGENT); \
            const int* TILEE = (const int*)(Fp.ws + WS_TILEE); \
            for (int i = Fp.tid; i < ntiles && i < SORT_TILES; i += NTHR) tab[i] = TILEE[i]; \
            __syncthreads(); \
            if (INL(10)) { _Pragma("unroll") for (int rep_ = 0; rep_ < NREP(10); ++rep_) { { \
                int km1_ = 1024 / (1 + MOE_FP8); asm volatile("" : "+s"(km1_)); \
                pg8::Gemm g{(const bf16*)(Fp.ws + WS_F), (const bf16*)(Fp.ws + WS_W1T) + (size_t)l * 32 * 2048 * (1024 / (1 + MOE_FP8)), 0, 2048, km1_}; \
                pg8::MoeOrderT<true> S; S.init(tab, ntiles, 8, Fp.G, (int)blockIdx.x, MOE_WGM1); S.rowtok = (const int*)(Fp.ws + WS_ROWTOK); \
                MOE_EPI1 E{(bf16*)(Fp.ws + WS_ACT), 1024, ka->in[I_MB1] + (size_t)l * 32 * 2048, 2048}; \
                pg8::gemm_phase<MOE_EPI1, pg8::MoeOrderT<true>, PG8_ALIGN, PG8_SP2, MOE_FP8 != 0>(Fp.lds + RING_OFF, g, S, E); \
             } if (rep_ + 1 < NREP(10)) GRID_BAR(); } } \
            SEAML(10); \
            if (PROBE_MOE2B && INL(11)) { \
                pg8::Gemm g{(const bf16*)(Fp.ws + WS_ACT), (const bf16*)(Fp.ws + WS_W2T) + (size_t)l * 32 * 1024 * 1024, 0, 1024, 1024}; \
                pg8::MoeOrderT<false> S; S.init(tab, ntiles, 4, Fp.G, (int)blockIdx.x, MOE_WGM2); S.rowtok = nullptr; S.rev = 1; \
                pg8::EpiNone E{}; \
                pg8::gemm_phase<pg8::EpiNone, pg8::MoeOrderT<false>, PG8_ALIGN, PG8_SP2>(Fp.lds + RING_OFF, g, S, E); GRID_BAR(); } \
            if (INL(11)) { _Pragma("unroll") for (int rep_ = 0; rep_ < NREP(11); ++rep_) { { \
                int km2_ = 1024 / (1 + MOE_FP8); asm volatile("" : "+s"(km2_)); \
                pg8::Gemm g{(const bf16*)(Fp.ws + WS_ACT), (const bf16*)(Fp.ws + WS_W2T) + (size_t)l * 32 * 1024 * (1024 / (1 + MOE_FP8)), 0, 1024, km2_}; \
                pg8::MoeOrderT<false> S; S.init(tab, ntiles, 4, Fp.G, (int)blockIdx.x, MOE_WGM2); S.rowtok = nullptr; S.rev = 1; \
                MOE_EPI2 E{(bf16*)(Fp.ws + WS_YS), YS_PITCH, ka->in[I_MB2] + (size_t)l * 32 * 1024, 1024}; \
                pg8::gemm_phase<MOE_EPI2, pg8::MoeOrderT<false>, PG8_ALIGN, PG8_SP2, MOE_FP8 != 0>(Fp.lds + RING_OFF, g, S, E); \
             } if (rep_ + 1 < NREP(11)) GRID_BAR(); } } \
            if (PROBE_MOE2 && INL(11)) { GRID_BAR(); \
                pg8::Gemm g{(const bf16*)(Fp.ws + WS_ACT), (const bf16*)(Fp.ws + WS_W2T) + (size_t)l * 32 * 1024 * 1024, 0, 1024, 1024}; \
                pg8::MoeOrderT<false> S; S.init(tab, ntiles, 4, Fp.G, (int)blockIdx.x, MOE_WGM2); S.rowtok = nullptr; S.rev = (PROBE_MOE2 == 2) ? 0 : 1; \
                if (PROBE_MOE2 == 3) { pg8::EpiBf16BiasFold E{(bf16*)(Fp.ws + WS_ASORT), 1024, ka->in[I_MB2] + (size_t)l * 32 * 1024, 1024}; \
                    pg8::gemm_phase<pg8::EpiBf16BiasFold, pg8::MoeOrderT<false>, PG8_ALIGN, PG8_SP2>(Fp.lds + RING_OFF, g, S, E); } \
                else { pg8::EpiNone E{}; \
                pg8::gemm_phase<pg8::EpiNone, pg8::MoeOrderT<false>, PG8_ALIGN, PG8_SP2>(Fp.lds + RING_OFF, g, S, E); } } \
        } \
        SEAML(11); \
        if (INL(12)) { REFRAME(); ph_combine(Fp, l, nrows, ka->out, ka->in[I_GMIX]); } \
        if (l == 0) { SEAML(12); } \
    }
    LAYER_BODY(0)
    LAYER_BODY(1)
#undef LAYER_BODY
#undef PHASE
#undef IN
#undef SEAM
#undef INL
#undef SEAML
}

extern "C" void kernel_launch(void* const* d_in, const int* in_sizes, int n_in, void* d_out, int out_size, void* d_ws, size_t ws_size, hipStream_t stream) {
    static int grid = 0;
    if (grid == 0) {
        if (n_in != 34 || in_sizes[0] != NLAT * DMODEL || out_size != NLAT * DMODEL || ws_size < WS_END) {
            fprintf(stderr, "kernel_launch: unexpected shapes (n_in %d, in0 %d, out %d, ws %zu); nothing launched\n", n_in, n_in > 0 ? in_sizes[0] : -1, out_size, ws_size); grid = -1; return; }
        int dev = 0, cus = 0;
        if (hipGetDevice(&dev) != hipSuccess || hipDeviceGetAttribute(&cus, hipDeviceAttributeMultiprocessorCount, dev) != hipSuccess) { grid = -1; return; }
        if (hipFuncSetAttribute((const void*)mk_fwd, hipFuncAttributeMaxDynamicSharedMemorySize, LDS_BYTES) != hipSuccess) { fprintf(stderr, "kernel_launch: hipFuncSetAttribute failed\n"); grid = -1; return; }
        int per_cu = 0;
        if (hipOccupancyMaxActiveBlocksPerMultiprocessor(&per_cu, (const void*)mk_fwd, NTHR, LDS_BYTES) != hipSuccess || per_cu < 1) { fprintf(stderr, "kernel_launch: occupancy query says %d\n", per_cu); }
        (void)hipGetLastError();
        grid = cus;
    }
    if (grid < 0) return;
    if (hipMemsetAsync((char*)d_ws + WS_CTL, 0, CTL_ZERO_BYTES, stream) != hipSuccess) return;
    Args a{};
    for (int i = 0; i < 34; ++i) a.in[i] = (const float*)d_in[i];
    a.out = (float*)d_out; a.ws = (unsigned char*)d_ws;
#if MK_PER_PHASE
    for (int p = 0; p < NPH; ++p) { a.ph_lo = p; a.ph_hi = p + 1; hipLaunchKernelGGL(mk_fwd, dim3(grid), dim3(NTHR), LDS_BYTES, stream, a); }
#else
    a.ph_lo = 0; a.ph_hi = NPH;
    hipLaunchKernelGGL(mk_fwd, dim3(grid), dim3(NTHR), LDS_BYTES, stream, a);
#endif
}
```

```cpp
#include <hip/hip_runtime.h>
#include <hip/hip_bf16.h>
#include <cstdio>
#include <cstdint>
#include <cmath>
#ifndef MOE_FP8
#define MOE_FP8 1
#endif
#ifndef MK_PER_PHASE
#define MK_PER_PHASE 0
#endif
namespace pg8 {
#define PG8_LAS __attribute__((address_space(3)))
typedef unsigned short bf16_t;
typedef short bf16x8 __attribute__((ext_vector_type(8)));
typedef float f32x4 __attribute__((ext_vector_type(4)));
typedef unsigned u32x4 __attribute__((ext_vector_type(4)));
constexpr int BM = 256, BK = 64, HALF = 128, HTB = HALF * BK * 2  , STAGE_BYTES = 8 * HTB, NXCD = 8, WGM = 8;

__host__ __device__ __forceinline__ int lds_byte(int r, int c) { const int st = (r >> 4) * 2 + (c >> 5), rr = r & 15, cc = c & 31, ob = rr * 64 + cc * 2; return st * 1024 + (ob ^ (((ob >> 9) & 1) << 5)); }
__host__ __device__ __forceinline__ void stage_rc(int b, int& R, int& C) { const int st = b / 1024, sb = b % 1024, swz = sb ^ (((sb >> 9) & 1) << 5); R = (st >> 1) * 16 + swz / 64; C = (st & 1) * 32 + (swz % 64) / 2; }
__host__ __device__ __forceinline__ int perm32(int rho) { const int n = rho >> 4, i = rho & 15; return 8 * (i >> 2) + 4 * n + (i & 3); }

struct Unit { int pm, pn, be, e; };
struct Gemm { const bf16_t* A; const bf16_t* Bt; int M, N, K; };

struct StaticOrder {
    static constexpr bool GATHER = false;
    __device__ __forceinline__ int row_of(int r) const { return r; }
    int nM, nN, nwg, G, c;
    __host__ __device__ void init(int M, int N, int G_, int c_) { nM = M / BM; nN = N / BM; nwg = nM * nN; G = G_; c = c_; }
    __host__ __device__ bool next(int i, Unit& u) const {
        const long L = (long)i * G + c; if (L >= nwg) return false;
        int wgid = (int)L; { const int q = nwg / NXCD, r = nwg % NXCD, xcd = wgid % NXCD, off = wgid / NXCD; wgid = (xcd < r ? xcd * (q + 1) : r * (q + 1) + (xcd - r) * q) + off; }
        const int nig = WGM * nN, gid = wgid / nig, fm = gid * WGM, gsz = (nM - fm) < WGM ? (nM - fm) : WGM;
        u.pm = fm + ((wgid % nig) % gsz); u.pn = (wgid % nig) / gsz; u.be = u.pn; u.e = 0; return true;
    }
    __device__ __forceinline__ void a_ready(const Unit&) const {}
    __device__ __forceinline__ void done(const Unit&) const {}
};

__device__ __forceinline__ unsigned cvt_pk_bf16(float lo, float hi) { unsigned r; asm volatile("v_cvt_pk_bf16_f32 %0, %1, %2" : "=v"(r) : "v"(lo), "v"(hi)); return r; }
__device__ __forceinline__ unsigned pack4_fp8(float a, float b, float c, float d) {
    a = fminf(fmaxf(a, -448.f), 448.f); b = fminf(fmaxf(b, -448.f), 448.f); c = fminf(fmaxf(c, -448.f), 448.f); d = fminf(fmaxf(d, -448.f), 448.f);
    int w = 0; w = __builtin_amdgcn_cvt_pk_fp8_f32(a, b, w, false); w = __builtin_amdgcn_cvt_pk_fp8_f32(c, d, w, true); return (unsigned)w;
}
constexpr float F8_SF = 16.f, F8_SW = 64.f, F8_SA = 4.f, F8_SY = 32.f;
typedef float f32x2 __attribute__((ext_vector_type(2)));
__device__ __forceinline__ f32x2 gelu_pk(f32x2 v) {
    const f32x2 av = __builtin_elementwise_abs(v), d = av * 0.2316418882f + 1.0f;
    f32x2 t; t.x = __builtin_amdgcn_rcpf(d.x); t.y = __builtin_amdgcn_rcpf(d.y);
    f32x2 q = t * 0.5307027145f + (-0.7265760135f); q = q * t + 0.7107068705f; q = q * t + (-0.142248368f); q = q * t + 0.127414796f; q = q * t;
    const f32x2 s = (v * v) * (-0.72134752044f);
    f32x2 e; e.x = __builtin_amdgcn_exp2f(s.x); e.y = __builtin_amdgcn_exp2f(s.y);
    const f32x2 m = v * (q * e), r = v - m;
    f32x2 o; o.x = v.x < 0.f ? m.x : r.x; o.y = v.y < 0.f ? m.y : r.y; return o;
}

template <int ACT  > struct EpiBf16 {
    static constexpr bool PERM = true, AFTER_DRAIN = false; static_assert(ACT == 0 || ACT == 1, "EpiBf16: ACT is 0 (none) or 1 (gelu_pk)");
    bf16_t* O; int ldc; const float* bias; int split_cols; size_t split_stride; float scale0;
    struct Pre {}; __device__ __forceinline__ void preload(Pre&, const Unit&, int, int, int, int) const {}
    __device__ __forceinline__ void operator()(const f32x4 (&acc)[2][2][4][2], const Unit& u, int wr, int wc, int fr, int fq, const Pre&) const {
        const int row0 = u.pm * BM + wr * 64 + fr; int colt = u.pn * BM; bf16_t* base = O;
        float sc = 1.f; if (split_cols) { const int t = colt / split_cols; base += (size_t)t * split_stride; colt -= t * split_cols; if (t == 0) sc = scale0; }
        const int col0 = colt + wc * 32 + 8 * fq, bcol0 = u.pn * BM + wc * 32 + 8 * fq;
        f32x4 bv[2][2];
#pragma unroll
        for (int bj = 0; bj < 2; ++bj)
#pragma unroll
            for (int n = 0; n < 2; ++n) bv[bj][n] = bias ? *(const f32x4*)(bias + bcol0 + bj * HALF + 4 * n) : (f32x4){0.f, 0.f, 0.f, 0.f};
#pragma unroll
        for (int ai = 0; ai < 2; ++ai)
#pragma unroll
            for (int m = 0; m < 4; ++m) { bf16_t* rowp = base + (size_t)(row0 + ai * HALF + m * 16) * ldc + col0;
#pragma unroll
                for (int bj = 0; bj < 2; ++bj) { f32x4 v0 = acc[ai][bj][m][0] + bv[bj][0], v1 = acc[ai][bj][m][1] + bv[bj][1];
                    if (ACT == 1) { f32x2 a = gelu_pk((f32x2){v0[0], v0[1]}), b = gelu_pk((f32x2){v0[2], v0[3]}), c = gelu_pk((f32x2){v1[0], v1[1]}), d = gelu_pk((f32x2){v1[2], v1[3]});
                        v0 = (f32x4){a.x, a.y, b.x, b.y}; v1 = (f32x4){c.x, c.y, d.x, d.y}; }
                    v0 = v0 * sc; v1 = v1 * sc; u32x4 w; w.x = cvt_pk_bf16(v0[0], v0[1]); w.y = cvt_pk_bf16(v0[2], v0[3]); w.z = cvt_pk_bf16(v1[0], v1[1]); w.w = cvt_pk_bf16(v1[2], v1[3]);
                    *(u32x4*)(rowp + bj * HALF) = w; } }
    }
};


template <bool XIN_BF16> struct EpiResid {
    static constexpr bool PERM = false, AFTER_DRAIN = false;
    const float* xin_lat; const float* xin_ctx; int nlat; bf16_t* XR; int ldc; const float* mod; int mod_stride; int seq; float* rssp;
    struct Pre {}; __device__ __forceinline__ void preload(Pre&, const Unit&, int, int, int, int) const {}
    __device__ __forceinline__ void operator()(const f32x4 (&acc)[2][2][4][2], const Unit& u, int wr, int wc, int fr, int fq, const Pre&) const {
        typedef unsigned u32x2 __attribute__((ext_vector_type(2)));
        const int row0 = u.pm * BM + wr * 64 + fr, col0 = u.pn * BM + wc * 32 + 4 * fq;
        const int rowt = u.pm * BM; const int bidx = rowt < nlat ? rowt / seq : 4;
        const float* gate = mod + (size_t)bidx * mod_stride;
        const float* xin = rowt < nlat ? xin_lat : (xin_ctx - (size_t)nlat * ldc);
        f32x4 gv[2][2];
#pragma unroll
        for (int bj = 0; bj < 2; ++bj)
#pragma unroll
            for (int n = 0; n < 2; ++n) gv[bj][n] = *(const f32x4*)(gate + col0 + bj * HALF + n * 16);
#pragma unroll
        for (int ai = 0; ai < 2; ++ai)
#pragma unroll
            for (int m = 0; m < 4; ++m) { const int row = row0 + ai * HALF + m * 16; const size_t ro = (size_t)row * ldc + col0; float s2 = 0.f;
#pragma unroll
                for (int bj = 0; bj < 2; ++bj)
#pragma unroll
                    for (int n = 0; n < 2; ++n) { const size_t idx = ro + bj * HALF + n * 16; f32x4 xv;
                        if (XIN_BF16) { const u32x2 w = *(const u32x2*)(XR + idx); xv = (f32x4){__builtin_bit_cast(float, w.x << 16), __builtin_bit_cast(float, w.x & 0xffff0000u), __builtin_bit_cast(float, w.y << 16), __builtin_bit_cast(float, w.y & 0xffff0000u)}; }
                        else xv = *(const f32x4*)(xin + idx);
                        const f32x4 v = xv + gv[bj][n] * acc[ai][bj][m][n];
                        s2 += (v[0] * v[0] + v[1] * v[1]) + (v[2] * v[2] + v[3] * v[3]);
                        u32x2 o; o.x = cvt_pk_bf16(v[0], v[1]); o.y = cvt_pk_bf16(v[2], v[3]); *(u32x2*)(XR + idx) = o; }
                s2 += __shfl_xor(s2, 16); s2 += __shfl_xor(s2, 32);
                if (fq == 0) rssp[(size_t)row * 16 + u.pn * 4 + wc] = s2; }
    }
};
struct EpiSwiglu {
    static constexpr bool PERM = true, AFTER_DRAIN = false;
    bf16_t* O; int ldc; const float* bias; int bias_stride;
    struct Pre { unsigned bw[2][2][2]; };
    __device__ __forceinline__ void preload(Pre& p, const Unit& u, int wr, int wc, int fr, int fq) const {
        const float* bb = bias + (size_t)u.e * bias_stride + u.pn * BM + wc * 32 + 8 * fq;
#pragma unroll
        for (int bj = 0; bj < 2; ++bj)
#pragma unroll
            for (int n = 0; n < 2; ++n) { const f32x4 v = *(const f32x4*)(bb + bj * HALF + 4 * n); p.bw[bj][n][0] = cvt_pk_bf16(v[0], v[1]); p.bw[bj][n][1] = cvt_pk_bf16(v[2], v[3]); }
    }
    __device__ __forceinline__ void operator()(const f32x4 (&acc)[2][2][4][2], const Unit& u, int wr, int wc, int fr, int fq, const Pre& pre) const {
        const int row0 = u.pm * BM + wr * 64 + fr; const int bcol0 = u.pn * BM + wc * 32 + 8 * fq; const int ocol0 = bcol0 >> 1;
        f32x4 bv[2][2];
#pragma unroll
        for (int bj = 0; bj < 2; ++bj)
#pragma unroll
            for (int n = 0; n < 2; ++n) { const unsigned w0 = pre.bw[bj][n][0], w1 = pre.bw[bj][n][1];
                bv[bj][n] = (f32x4){__builtin_bit_cast(float, w0 << 16), __builtin_bit_cast(float, w0 & 0xffff0000u), __builtin_bit_cast(float, w1 << 16), __builtin_bit_cast(float, w1 & 0xffff0000u)}; }
#pragma unroll
        for (int ai = 0; ai < 2; ++ai)
#pragma unroll
            for (int m = 0; m < 4; ++m) { bf16_t* rowp = O + (size_t)(row0 + ai * HALF + m * 16) * ldc + ocol0;
#pragma unroll
                for (int bj = 0; bj < 2; ++bj) { const f32x4 v0 = acc[ai][bj][m][0] + bv[bj][0], v1 = acc[ai][bj][m][1] + bv[bj][1];
                    float o[4];
#pragma unroll
                    for (int p = 0; p < 4; ++p) { const float hg = p < 2 ? v0[2 * p] : v1[2 * p - 4], hl = p < 2 ? v0[2 * p + 1] : v1[2 * p - 3];
                        const float glu = fminf(hg, 7.0f), lin = fminf(fmaxf(hl, -7.0f), 7.0f);
                        const float sg = __builtin_amdgcn_rcpf(1.0f + __builtin_amdgcn_exp2f(-1.702f * 1.4426950408889634f * glu));
                        o[p] = glu * sg * (lin + 1.0f); }
                    typedef unsigned u32x2 __attribute__((ext_vector_type(2)));
                    u32x2 w; w.x = cvt_pk_bf16(o[0], o[1]); w.y = cvt_pk_bf16(o[2], o[3]);
                    *(u32x2*)(rowp + bj * (HALF / 2)) = w; } }
    }
};
struct EpiSwigluF8 {
    static constexpr bool PERM = true, AFTER_DRAIN = false;
    bf16_t* O; int ldc; const float* bias; int bias_stride;
    struct Pre { unsigned bw[2][2][2]; };
    __device__ __forceinline__ void preload(Pre& p, const Unit& u, int wr, int wc, int fr, int fq) const {
        const float* bb = bias + (size_t)u.e * bias_stride + u.pn * BM + wc * 32 + 8 * fq;
#pragma unroll
        for (int bj = 0; bj < 2; ++bj)
#pragma unroll
            for (int n = 0; n < 2; ++n) { const f32x4 v = *(const f32x4*)(bb + bj * HALF + 4 * n); p.bw[bj][n][0] = cvt_pk_bf16(v[0], v[1]); p.bw[bj][n][1] = cvt_pk_bf16(v[2], v[3]); }
    }
    __device__ __forceinline__ void operator()(const f32x4 (&acc)[2][2][4][2], const Unit& u, int wr, int wc, int fr, int fq, const Pre& pre) const {
        asm volatile("" : "+v"(fr), "+v"(fq));
        const int row0 = u.pm * BM + wr * 64 + fr; const int bcol0 = u.pn * BM + wc * 32 + 8 * fq; const int ocol0 = bcol0 >> 1;
        f32x4 bv[2][2];
#pragma unroll
        for (int bj = 0; bj < 2; ++bj)
#pragma unroll
            for (int n = 0; n < 2; ++n) { const unsigned w0 = pre.bw[bj][n][0], w1 = pre.bw[bj][n][1];
                bv[bj][n] = (f32x4){__builtin_bit_cast(float, w0 << 16), __builtin_bit_cast(float, w0 & 0xffff0000u), __builtin_bit_cast(float, w1 << 16), __builtin_bit_cast(float, w1 & 0xffff0000u)}; }
#pragma unroll
        for (int ai = 0; ai < 2; ++ai)
#pragma unroll
            for (int m = 0; m < 4; ++m) {
#pragma unroll
                for (int bj = 0; bj < 2; ++bj) { const f32x4 v0 = acc[ai][bj][m][0] * (1.0f / (F8_SF * F8_SW)) + bv[bj][0], v1 = acc[ai][bj][m][1] * (1.0f / (F8_SF * F8_SW)) + bv[bj][1];
                    float o[4];
#pragma unroll
                    for (int p = 0; p < 4; ++p) { const float hg = p < 2 ? v0[2 * p] : v1[2 * p - 4], hl = p < 2 ? v0[2 * p + 1] : v1[2 * p - 3];
                        const float glu = fminf(hg, 7.0f), lin = fminf(fmaxf(hl, -7.0f), 7.0f);
                        const float sg = __builtin_amdgcn_rcpf(1.0f + __builtin_amdgcn_exp2f(-1.702f * 1.4426950408889634f * glu));
                        o[p] = glu * sg * (lin + 1.0f); }
                    *(unsigned*)((unsigned char*)O + (size_t)(row0 + ai * HALF + m * 16) * ldc + ocol0 + bj * (HALF / 2)) = pack4_fp8(o[0] * F8_SA, o[1] * F8_SA, o[2] * F8_SA, o[3] * F8_SA); } }
    }
};
struct EpiBf16Bias {
    static constexpr bool PERM = true, AFTER_DRAIN = false;
    bf16_t* O; int ldc; const float* bias; int bias_stride;
    struct Pre { f32x4 bv[2][2]; };
    __device__ __forceinline__ void preload(Pre& p, const Unit& u, int wr, int wc, int fr, int fq) const {
        const float* bb = bias + (size_t)u.e * bias_stride + u.pn * BM + wc * 32 + 8 * fq;
#pragma unroll
        for (int bj = 0; bj < 2; ++bj)
#pragma unroll
            for (int n = 0; n < 2; ++n) p.bv[bj][n] = *(const f32x4*)(bb + bj * HALF + 4 * n);
    }
    __device__ __forceinline__ void operator()(const f32x4 (&acc)[2][2][4][2], const Unit& u, int wr, int wc, int fr, int fq, const Pre& pre) const {
        const int row0 = u.pm * BM + wr * 64 + fr; const int col0 = u.pn * BM + wc * 32 + 8 * fq;
#pragma unroll
        for (int ai = 0; ai < 2; ++ai)
#pragma unroll
            for (int m = 0; m < 4; ++m) { bf16_t* rowp = O + (size_t)(row0 + ai * HALF + m * 16) * ldc + col0;
#pragma unroll
                for (int bj = 0; bj < 2; ++bj) { const f32x4 v0 = acc[ai][bj][m][0] + pre.bv[bj][0], v1 = acc[ai][bj][m][1] + pre.bv[bj][1];
                    u32x4 w; w.x = cvt_pk_bf16(v0[0], v0[1]); w.y = cvt_pk_bf16(v0[2], v0[3]); w.z = cvt_pk_bf16(v1[0], v1[1]); w.w = cvt_pk_bf16(v1[2], v1[3]);
                    *(u32x4*)(rowp + bj * HALF) = w; } }
    }
};
struct EpiBf16BiasFold {
    static constexpr bool PERM = true, AFTER_DRAIN = false;
    bf16_t* O; int ldc; const float* bias; int bias_stride;
    struct Pre { f32x4 bv[2][2]; };
    __device__ __forceinline__ void preload(Pre& p, const Unit& u, int wr, int wc, int fr, int fq) const {
        const float* bb = bias + (size_t)u.e * bias_stride + u.pn * BM + wc * 32 + 8 * fq;
#pragma unroll
        for (int bj = 0; bj < 2; ++bj)
#pragma unroll
            for (int n = 0; n < 2; ++n) p.bv[bj][n] = *(const f32x4*)(bb + bj * HALF + 4 * n);
    }
    __device__ __forceinline__ void operator()(const f32x4 (&acc)[2][2][4][2], const Unit& u, int wr, int wc, int fr, int fq, const Pre& pre) const {
        const int row0 = u.pm * BM + wr * 64 + fr; const int col0 = u.pn * BM + wc * 32 + 8 * fq;
#pragma unroll
        for (int ai = 0; ai < 2; ++ai)
#pragma unroll
            for (int m = 0; m < 4; ++m) { bf16_t* rowp = O + (size_t)((row0 + ai * HALF + m * 16) & 255) * ldc + col0;
#pragma unroll
                for (int bj = 0; bj < 2; ++bj) { const f32x4 v0 = acc[ai][bj][m][0] + pre.bv[bj][0], v1 = acc[ai][bj][m][1] + pre.bv[bj][1];
                    u32x4 w; w.x = cvt_pk_bf16(v0[0], v0[1]); w.y = cvt_pk_bf16(v0[2], v0[3]); w.z = cvt_pk_bf16(v1[0], v1[1]); w.w = cvt_pk_bf16(v1[2], v1[3]);
                    *(u32x4*)(rowp + bj * HALF) = w; } }
    }
};
struct EpiBf16BiasF8 {
    static constexpr bool PERM = true, AFTER_DRAIN = false;
    bf16_t* O; int ldc; const float* bias; int bias_stride;
    struct Pre { f32x4 bv[2][2]; };
    __device__ __forceinline__ void preload(Pre& p, const Unit& u, int wr, int wc, int fr, int fq) const {
        const float* bb = bias + (size_t)u.e * bias_stride + u.pn * BM + wc * 32 + 8 * fq;
#pragma unroll
        for (int bj = 0; bj < 2; ++bj)
#pragma unroll
            for (int n = 0; n < 2; ++n) p.bv[bj][n] = *(const f32x4*)(bb + bj * HALF + 4 * n);
    }
    __device__ __forceinline__ void operator()(const f32x4 (&acc)[2][2][4][2], const Unit& u, int wr, int wc, int fr, int fq, const Pre& pre) const {
        asm volatile("" : "+v"(fr), "+v"(fq));
        const int row0 = u.pm * BM + wr * 64 + fr; const int col0 = u.pn * BM + wc * 32 + 8 * fq;
#pragma unroll
        for (int ai = 0; ai < 2; ++ai)
#pragma unroll
            for (int m = 0; m < 4; ++m) { bf16_t* rowp = O + (size_t)(row0 + ai * HALF + m * 16) * ldc + col0;
#pragma unroll
                for (int bj = 0; bj < 2; ++bj) { const f32x4 v0 = acc[ai][bj][m][0] * (1.0f / (F8_SA * F8_SW)) + pre.bv[bj][0], v1 = acc[ai][bj][m][1] * (1.0f / (F8_SA * F8_SW)) + pre.bv[bj][1];
                    u32x4 w; w.x = cvt_pk_bf16(v0[0], v0[1]); w.y = cvt_pk_bf16(v0[2], v0[3]); w.z = cvt_pk_bf16(v1[0], v1[1]); w.w = cvt_pk_bf16(v1[2], v1[3]);
                    *(u32x4*)(rowp + bj * HALF) = w; } }
    }
};
struct EpiF8BiasF8 {
    static constexpr bool PERM = true, AFTER_DRAIN = false;
    bf16_t* O; int ldc; const float* bias; int bias_stride;
    struct Pre { f32x4 bv[2][2]; };
    __device__ __forceinline__ void preload(Pre& p, const Unit& u, int wr, int wc, int fr, int fq) const {
        const float* bb = bias + (size_t)u.e * bias_stride + u.pn * BM + wc * 32 + 8 * fq;
#pragma unroll
        for (int bj = 0; bj < 2; ++bj)
#pragma unroll
            for (int n = 0; n < 2; ++n) p.bv[bj][n] = *(const f32x4*)(bb + bj * HALF + 4 * n);
    }
    __device__ __forceinline__ void operator()(const f32x4 (&acc)[2][2][4][2], const Unit& u, int wr, int wc, int fr, int fq, const Pre& pre) const {
        asm volatile("" : "+v"(fr), "+v"(fq));
        const int row0 = u.pm * BM + wr * 64 + fr; const int col0 = u.pn * BM + wc * 32 + 8 * fq;
#pragma unroll
        for (int ai = 0; ai < 2; ++ai)
#pragma unroll
            for (int m = 0; m < 4; ++m) { unsigned char* rowp = (unsigned char*)O + (size_t)(row0 + ai * HALF + m * 16) * ldc + col0;
#pragma unroll
                for (int bj = 0; bj < 2; ++bj) { const f32x4 v0 = (acc[ai][bj][m][0] * (1.0f / (F8_SA * F8_SW)) + pre.bv[bj][0]) * F8_SY, v1 = (acc[ai][bj][m][1] * (1.0f / (F8_SA * F8_SW)) + pre.bv[bj][1]) * F8_SY;
                    typedef unsigned u32x2 __attribute__((ext_vector_type(2)));
                    u32x2 w; w.x = pack4_fp8(v0[0], v0[1], v0[2], v0[3]); w.y = pack4_fp8(v1[0], v1[1], v1[2], v1[3]);
                    *(u32x2*)(rowp + bj * HALF) = w; } }
    }
};
struct EpiLruGate {
    static constexpr bool PERM = false, AFTER_DRAIN = false;
    const bf16_t* XL; bf16_t* LAB; size_t lab_stride; const float* gb; const float* spt;
    struct Pre {}; __device__ __forceinline__ void preload(Pre&, const Unit&, int, int, int, int) const {}
    __device__ __forceinline__ void operator()(const f32x4 (&acc)[2][2][4][2], const Unit& u, int wr, int wc, int fr, int fq, const Pre&) const {
        const int d = u.pn >> 1, half = u.pn & 1;
        const int row0 = u.pm * BM + wr * 64 + fr, ch0 = half * 128 + wc * 32 + 4 * fq;
        bf16_t* LA = LAB + (size_t)(2 * d) * lab_stride; bf16_t* LB = LAB + (size_t)(2 * d + 1) * lab_stride;
#pragma unroll
        for (int n = 0; n < 2; ++n) {
            const f32x4 bR = *(const f32x4*)(gb + (d * 2 + 0) * 256 + ch0 + 16 * n), bI = *(const f32x4*)(gb + (d * 2 + 1) * 256 + ch0 + 16 * n);
            const f32x4 sp = *(const f32x4*)(spt + d * 256 + ch0 + 16 * n) * (-8.0f * 1.4426950408889634f);
#pragma unroll
            for (int ai = 0; ai < 2; ++ai)
#pragma unroll
                for (int m = 0; m < 4; ++m) { const size_t ro = (size_t)(row0 + ai * HALF + m * 16) * 256 + ch0 + 16 * n;
                    typedef unsigned u32x2 __attribute__((ext_vector_type(2)));
                    const u32x2 xw = *(const u32x2*)(XL + ro);
                    const float xl[4] = {__builtin_bit_cast(float, xw.x << 16), __builtin_bit_cast(float, xw.x & 0xffff0000u), __builtin_bit_cast(float, xw.y << 16), __builtin_bit_cast(float, xw.y & 0xffff0000u)};
                    const f32x4 gr = acc[ai][0][m][n] + bR, gi = acc[ai][1][m][n] + bI;
                    f32x4 av, bv;
#pragma unroll
                    for (int e = 0; e < 4; ++e) {
                        const float rg = __builtin_amdgcn_rcpf(1.0f + __builtin_amdgcn_exp2f(-1.4426950408889634f * gr[e])), ig = __builtin_amdgcn_rcpf(1.0f + __builtin_amdgcn_exp2f(-1.4426950408889634f * gi[e]));
                        const float la2 = rg * sp[e];
                        const float a2 = __builtin_amdgcn_exp2f(2.0f * la2);
                        av[e] = la2; bv[e] = __builtin_amdgcn_sqrtf(fmaxf(1.0f - a2, 0.f)) * (ig * xl[e]); }
                    u32x2 wa, wb; wa.x = cvt_pk_bf16(av[0], av[1]); wa.y = cvt_pk_bf16(av[2], av[3]); wb.x = cvt_pk_bf16(bv[0], bv[1]); wb.y = cvt_pk_bf16(bv[2], bv[3]);
                    *(u32x2*)(LA + ro) = wa; *(u32x2*)(LB + ro) = wb; }
        }
    }
};
struct EpiNone {
    static constexpr bool PERM = true, AFTER_DRAIN = false;
    struct Pre {}; __device__ __forceinline__ void preload(Pre&, const Unit&, int, int, int, int) const {}
    __device__ __forceinline__ void operator()(const f32x4 (&acc)[2][2][4][2], const Unit& u, int wr, int wc, int fr, int fq, const Pre&) const {
#pragma unroll
        for (int a = 0; a < 2; ++a)
#pragma unroll
            for (int b2 = 0; b2 < 2; ++b2)
#pragma unroll
                for (int m = 0; m < 4; ++m)
#pragma unroll
                    for (int n = 0; n < 2; ++n) { f32x4 v = acc[a][b2][m][n]; asm volatile("" :: "v"(v)); }
    }
};
template <bool GATHER_> struct MoeOrderT {
    static constexpr bool GATHER = GATHER_;
    const int* rowtok;
    __device__ __forceinline__ int row_of(int r) const { return GATHER_ ? rowtok[r] : r; }
    const PG8_LAS int* tab; int ntiles, nN, nper, j, m_lo, nMx, wgm, rev;
    __device__ __forceinline__ void init(const PG8_LAS int* tab_, int ntiles_, int nN_, int G, int bx, int wgm_) {
        tab = tab_; ntiles = ntiles_; nN = nN_; wgm = wgm_; rev = 0;
        if (G % 8 == 0) { const int x = bx % 8; nper = G / 8; j = bx / 8; m_lo = (x * ntiles) / 8; nMx = ((x + 1) * ntiles) / 8 - m_lo; }
        else { nper = G; j = bx; m_lo = 0; nMx = ntiles; }
    }
    __device__ __forceinline__ bool next(int i, Unit& u) const {
        const int s = i * nper + j; if (s >= nMx * nN) return false;
        const int nig = wgm * nN, gid = s / nig, fm = gid * wgm, gsz = (nMx - fm) < wgm ? (nMx - fm) : wgm, w = s - gid * nig;
        const int mi = fm + (w % gsz); u.pm = m_lo + (rev ? (nMx - 1 - mi) : mi); u.pn = w / gsz; u.e = tab[u.pm]; u.be = u.e * nN + u.pn; return true;
    }
    __device__ __forceinline__ void a_ready(const Unit&) const {}
    __device__ __forceinline__ void done(const Unit&) const {}
};
template <class Epi, class Sched, bool ALIGN_EPI = false, bool SP2 = false, bool FP8 = false>
__device__ __forceinline__ void gemm_phase(PG8_LAS unsigned char* lds, const Gemm g, const Sched& S, const Epi& E) {
    int tid_ = threadIdx.x; asm volatile("" : "+v"(tid_));
    const int tid = tid_, wid = __builtin_amdgcn_readfirstlane(tid >> 6), lane = tid & 63, wr = wid >> 2, wc = wid & 3, fr = lane & 15, fq = lane >> 4;
    const int K = g.K, nt = K / BK;
    unsigned voffA[2], voffB[2];
#pragma unroll
    for (int i = 0; i < 2; ++i) { int R, C; stage_rc(tid * 16 + i * 8192, R, C); const int Rb = Epi::PERM ? ((R & ~31) + perm32(R & 31)) : R;
        voffA[i] = (unsigned)(R * K + C) * 2u; voffB[i] = (unsigned)(Rb * K + C) * 2u; }
    unsigned gA_[2] = {0u, 0u}, gN_[2] = {0u, 0u}, gC_[2] = {0u, 0u};
    static_assert(!Sched::GATHER || SP2, "the gathered A operand is wired into the SP2 loop only");
    if constexpr (Sched::GATHER) { _Pragma("unroll") for (int i_ = 0; i_ < 2; ++i_) { int R_, C_; stage_rc(tid * 16 + i_ * 8192, R_, C_); gC_[i_] = (unsigned)(C_ * 2); } }
#define PG8_GLOAD(dst, pm_) do { _Pragma("unroll") for (int h_ = 0; h_ < 2; ++h_) { unsigned t_[2]; _Pragma("unroll") for (int i_ = 0; i_ < 2; ++i_) { int R_, C_; stage_rc(tid * 16 + i_ * 8192, R_, C_); \
        t_[i_] = (unsigned)S.row_of((pm_) * BM + h_ * HALF + R_); } dst[h_] = t_[0] | (t_[1] << 16); } } while (0)
    const size_t kstep = (size_t)(BK * 2);
    const size_t hstep = (size_t)HALF * K * 2;
    const size_t tstep = 2 * hstep;
    const unsigned ldsw = (unsigned)wid * 1024u;
    const int aoff = lds_byte(wr * 64 + fr, fq * 8), boff = lds_byte(wc * 32 + fr, fq * 8);
#define PG8_SA(b, h) (((b) * 2 + (h)) * HTB)
#define PG8_SB(b, h) ((4 + (b) * 2 + (h)) * HTB)
#define PG8_STAGE(bufoff, gbase, voff) do { _Pragma("unroll") for (int _i = 0; _i < 2; ++_i) \
        __builtin_amdgcn_global_load_lds((const unsigned*)((const char*)(gbase) + (voff)[_i]), (PG8_LAS unsigned*)(lds + (bufoff) + ldsw + _i * 8192), 16, 0, 0); } while (0)
#define PG8_STA(bufoff, ptr, h, useN) do { if constexpr (Sched::GATHER) { const unsigned pk_ = (useN) ? gN_[h] : gA_[h]; unsigned o_[2] = {(pk_ & 0xffffu) * (unsigned)(K * 2) + gC_[0], (pk_ >> 16) * (unsigned)(K * 2) + gC_[1]}; PG8_STAGE(bufoff, ptr, o_); } \
        else { PG8_STAGE(bufoff, (ptr) + ((h) ? hstep : 0), voffA); } } while (0)
#define PG8_LDA(dst, b, h) do { _Pragma("unroll") for (int m = 0; m < 4; ++m) { if constexpr (FP8) { \
            dst##8[m] = __builtin_shufflevector(*(const PG8_LAS i32x4_*)(lds + PG8_SA(b, h) + aoff + m * 2048), *(const PG8_LAS i32x4_*)(lds + PG8_SA(b, h) + aoff + m * 2048 + 1024), 0, 1, 2, 3, 4, 5, 6, 7); } \
        else { _Pragma("unroll") for (int k = 0; k < 2; ++k) dst[m][k] = *(const PG8_LAS bf16x8*)(lds + PG8_SA(b, h) + aoff + m * 2048 + k * 1024); } } } while (0)
#define PG8_LDB(dst, b, h) do { _Pragma("unroll") for (int n = 0; n < 2; ++n) { if constexpr (FP8) { \
            dst##8[n] = __builtin_shufflevector(*(const PG8_LAS i32x4_*)(lds + PG8_SB(b, h) + boff + n * 2048), *(const PG8_LAS i32x4_*)(lds + PG8_SB(b, h) + boff + n * 2048 + 1024), 0, 1, 2, 3, 4, 5, 6, 7); } \
        else { _Pragma("unroll") for (int k = 0; k < 2; ++k) dst[n][k] = *(const PG8_LAS bf16x8*)(lds + PG8_SB(b, h) + boff + n * 2048 + k * 1024); } } } while (0)
#define PG8_MMA(ai, bj, At, Bt) do { __builtin_amdgcn_s_setprio(1); _Pragma("unroll") for (int m = 0; m < 4; ++m) _Pragma("unroll") for (int n = 0; n < 2; ++n) { \
        if constexpr (FP8) asm volatile("v_mfma_f32_16x16x128_f8f6f4 %0, %1, %2, %0" : "+v"(acc[ai][bj][m][n]) : "v"(Bt##8[n]), "v"(At##8[m]));   \
        else { _Pragma("unroll") for (int k = 0; k < 2; ++k) acc[ai][bj][m][n] = __builtin_amdgcn_mfma_f32_16x16x32_bf16(Bt[n][k], At[m][k], acc[ai][bj][m][n], 0, 0, 0); } } \
        __builtin_amdgcn_s_setprio(0); } while (0)
#define PG8_WAIT_V(n) asm volatile("s_waitcnt vmcnt(" #n ")" ::: "memory")
#define PG8_WAIT_L(n) asm volatile("s_waitcnt lgkmcnt(" #n ")" ::: "memory")
#define PG8_BAR __builtin_amdgcn_s_barrier()
#define PG8_SCHED __builtin_amdgcn_sched_barrier(0)
    Unit cur, nxt; int ui = 0;
    if (!S.next(0, cur)) return;
    f32x4 acc[2][2][4][2];
#pragma unroll
    for (int a = 0; a < 2; ++a)
#pragma unroll
        for (int b = 0; b < 2; ++b)
#pragma unroll
            for (int m = 0; m < 4; ++m)
#pragma unroll
                for (int n = 0; n < 2; ++n) acc[a][b][m][n] = (f32x4){0.f, 0.f, 0.f, 0.f};
    typedef int i32x4_ __attribute__((ext_vector_type(4))); typedef int i32x8_ __attribute__((ext_vector_type(8)));
    bf16x8 At[4][2], B0[2][2], B1[2][2]; i32x8_ At8[4], B08[2], B18[2];
    typename Epi::Pre pre;
    const char* cA = (const char*)g.A + (Sched::GATHER ? (size_t)0 : (size_t)cur.pm * tstep); if constexpr (Sched::GATHER) PG8_GLOAD(gA_, cur.pm);
    const char* cB = (const char*)g.Bt + (size_t)cur.be * tstep;
    S.a_ready(cur);
    if constexpr (SP2) {
        PG8_STAGE(PG8_SB(0, 0), cB, voffB); PG8_STAGE(PG8_SB(0, 1), cB + hstep, voffB); PG8_STA(PG8_SA(0, 0), cA, 0, false); PG8_STA(PG8_SA(0, 1), cA, 1, false);
        if (wr == 1) PG8_BAR;
        PG8_WAIT_V(2); PG8_BAR;
        PG8_STAGE(PG8_SB(1, 0), cB + kstep, voffB); PG8_STA(PG8_SA(1, 0), cA + kstep, 0, false); PG8_STAGE(PG8_SB(1, 1), cB + hstep + kstep, voffB);
        PG8_WAIT_V(6); PG8_BAR;
    } else {
        PG8_STAGE(PG8_SB(0, 0), cB, voffB); PG8_STAGE(PG8_SA(0, 0), cA, voffA); PG8_STAGE(PG8_SB(0, 1), cB + hstep, voffB); PG8_STAGE(PG8_SA(0, 1), cA + hstep, voffA);
        if (wr == 1) PG8_BAR;
        PG8_WAIT_V(4); PG8_BAR;
        PG8_STAGE(PG8_SB(1, 0), cB + kstep, voffB); PG8_STAGE(PG8_SA(1, 0), cA + kstep, voffA); PG8_STAGE(PG8_SB(1, 1), cB + hstep + kstep, voffB);
        PG8_WAIT_V(6); PG8_BAR;
    }
    for (;;) {
        const bool has_next = S.next(ui + 1, nxt);
        const char* nA = (has_next && !Sched::GATHER) ? (const char*)g.A + (size_t)nxt.pm * tstep : cA; const char* nB = has_next ? (const char*)g.Bt + (size_t)nxt.be * tstep : cB;
        if constexpr (Sched::GATHER) { if (has_next) PG8_GLOAD(gN_, nxt.pm); else { gN_[0] = gA_[0]; gN_[1] = gA_[1]; } }
        for (int t = 0; t < nt; t += 2) {
            const bool last = (t == nt - 2);
            const char* a1 = cA + (size_t)(t + 1) * kstep;
            const char* a2 = last ? nA : cA + (size_t)(t + 2) * kstep; const char* b2 = last ? nB : cB + (size_t)(t + 2) * kstep;
            const char* a3 = a2 + kstep; const char* b3 = b2 + kstep;
            if (last) E.preload(pre, cur, wr, wc, fr, fq);
            if (last && has_next) S.a_ready(nxt);
            if constexpr (SP2) {
            PG8_LDB(B0, 0, 0); PG8_LDB(B1, 0, 1); PG8_SCHED; PG8_LDA(At, 0, 0); PG8_STA(PG8_SA(1, 1), a1, 1, false);
            PG8_WAIT_V(8); PG8_WAIT_L(0); PG8_BAR; PG8_MMA(0, 0, At, B0); PG8_MMA(0, 1, At, B1); PG8_BAR; PG8_SCHED;
            PG8_LDA(At, 0, 1); PG8_STAGE(PG8_SB(0, 0), b2, voffB); PG8_STAGE(PG8_SB(0, 1), b2 + hstep, voffB); PG8_STA(PG8_SA(0, 0), a2, 0, last);
            PG8_WAIT_V(8); PG8_WAIT_L(0); PG8_BAR; PG8_MMA(1, 0, At, B0); PG8_MMA(1, 1, At, B1); PG8_BAR; PG8_SCHED;
            PG8_LDB(B0, 1, 0); PG8_LDB(B1, 1, 1); PG8_SCHED; PG8_LDA(At, 1, 0); PG8_STA(PG8_SA(0, 1), a2, 1, last);
            PG8_WAIT_V(8); PG8_WAIT_L(0); PG8_BAR; PG8_MMA(0, 0, At, B0); PG8_MMA(0, 1, At, B1); PG8_BAR; PG8_SCHED;
            PG8_LDA(At, 1, 1); PG8_STAGE(PG8_SB(1, 0), b3, voffB); PG8_STAGE(PG8_SB(1, 1), b3 + hstep, voffB); PG8_STA(PG8_SA(1, 0), a3, 0, last);
            PG8_WAIT_V(8); PG8_WAIT_L(0); PG8_BAR; PG8_MMA(1, 0, At, B0); PG8_MMA(1, 1, At, B1); PG8_BAR; PG8_SCHED;
            } else {
            PG8_LDB(B0, 0, 0); PG8_SCHED; PG8_LDA(At, 0, 0); PG8_STAGE(PG8_SA(1, 1), a1 + hstep, voffA);
            PG8_WAIT_L(8); PG8_BAR; PG8_WAIT_L(0); PG8_MMA(0, 0, At, B0); PG8_BAR; PG8_SCHED;
            PG8_LDB(B1, 0, 1); PG8_STAGE(PG8_SB(0, 0), b2, voffB);
            PG8_BAR; PG8_WAIT_L(0); PG8_MMA(0, 1, At, B1); PG8_BAR;
            PG8_LDA(At, 0, 1); PG8_STAGE(PG8_SA(0, 0), a2, voffA);
            PG8_BAR; PG8_WAIT_L(0); PG8_MMA(1, 0, At, B0); PG8_BAR; PG8_SCHED;
            PG8_STAGE(PG8_SB(0, 1), b2 + hstep, voffB);
            PG8_WAIT_V(6); PG8_BAR; PG8_MMA(1, 1, At, B1); PG8_BAR;
            PG8_LDB(B0, 1, 0); PG8_SCHED; PG8_LDA(At, 1, 0); PG8_STAGE(PG8_SA(0, 1), a2 + hstep, voffA);
            PG8_WAIT_L(8); PG8_BAR; PG8_WAIT_L(0); PG8_MMA(0, 0, At, B0); PG8_BAR; PG8_SCHED;
            PG8_LDB(B1, 1, 1); PG8_STAGE(PG8_SB(1, 0), b3, voffB);
            PG8_BAR; PG8_WAIT_L(0); PG8_MMA(0, 1, At, B1); PG8_BAR;
            PG8_LDA(At, 1, 1); PG8_STAGE(PG8_SA(1, 0), a3, voffA);
            PG8_BAR; PG8_WAIT_L(0); PG8_MMA(1, 0, At, B0); PG8_BAR; PG8_SCHED;
            PG8_STAGE(PG8_SB(1, 1), b3 + hstep, voffB);
            PG8_WAIT_V(6); PG8_BAR; PG8_MMA(1, 1, At, B1); PG8_BAR;
            }
        }
        if constexpr (ALIGN_EPI) { if (wr == 0) PG8_BAR; }
        if constexpr (!Epi::AFTER_DRAIN) { E(acc, cur, wr, wc, fr, fq, pre); S.done(cur); }
        if (!has_next) break;
#pragma unroll
        for (int a = 0; a < 2; ++a)
#pragma unroll
            for (int b = 0; b < 2; ++b)
#pragma unroll
                for (int m = 0; m < 4; ++m)
#pragma unroll
                    for (int n = 0; n < 2; ++n) acc[a][b][m][n] = (f32x4){0.f, 0.f, 0.f, 0.f};
        cur = nxt; cA = nA; cB = nB; ++ui;
        if constexpr (Sched::GATHER) { gA_[0] = gN_[0]; gA_[1] = gN_[1]; }
        if constexpr (ALIGN_EPI) { if (wr == 1) PG8_BAR; }
    }
    PG8_WAIT_V(0);
    if constexpr (!ALIGN_EPI) { if (wr == 0) PG8_BAR; }
    PG8_BAR;
    if constexpr (Epi::AFTER_DRAIN) { E.fused(acc, cur, wr, wc, fr, fq, lds, wid, lane); S.done(cur); }
#undef PG8_SA
#undef PG8_SB
#undef PG8_STAGE
#undef PG8_STA
#undef PG8_GLOAD
#undef PG8_LDA
#undef PG8_LDB
#undef PG8_MMA
#undef PG8_WAIT_V
#undef PG8_WAIT_L
#undef PG8_BAR
#undef PG8_SCHED
}
}

#ifndef PG8_SP2
#define PG8_SP2 true
#endif
#ifndef PG8_ALIGN
#define PG8_ALIGN true
#endif
#include <cmath>
namespace attn_body {
using bf16=__hip_bfloat16;
using bf16x8=__attribute__((ext_vector_type(8)))short;
using s16x4=__attribute__((ext_vector_type(4)))short;
using f32x16=__attribute__((ext_vector_type(16)))float;
using u32x4=__attribute__((ext_vector_type(4)))unsigned;
using f32x4_t=__attribute__((ext_vector_type(4)))float;
constexpr int NHEAD=8,SEQQ=8192,SEQK=8448,D=64,QP=512,KP=128,QIN=2048;
constexpr int NW=8,QBLK=32,QB=QBLK*NW,KVBLK=64,NQB=SEQQ/QB;
constexpr int ATTN_UNIT_ROWS=QB;
__device__ __forceinline__ int crow(int r,int hi){return (r&3)+8*(r>>2)+4*hi;}
#define SBAR() __builtin_amdgcn_sched_barrier(0)
__device__ __forceinline__ void cmask(f32x16&p0,f32x16&p1,int jb,int qrel,int hi){
  const float NEG=-INFINITY; int kb=64*jb+4*hi;
  #pragma unroll
  for(int r=0;r<16;++r){int kv=kb+(r&3)+8*(r>>2); if(kv>qrel)p0[r]=NEG; if(kv+32>qrel)p1[r]=NEG;}
}

constexpr int NSLOT=3, SLOTB=8192;
constexpr int LDS_K=0, LDS_V=NSLOT*SLOTB, LDS_WS=2*NSLOT*SLOTB, LDS_OST=LDS_WS+NW*64*4, LDS_BYTES=LDS_OST+NW*4096;
constexpr float C2=0.125f*1.4426950408889634f;
__device__ __forceinline__ void glds16(const void*gsrc,unsigned lds_dst){unsigned keep;
  asm volatile("s_mov_b32 %0, m0\n\ts_mov_b32 m0, %2\n\ts_nop 0\n\tglobal_load_lds_dwordx4 %1, off\n\ts_mov_b32 m0, %0":"=&s"(keep):"v"(gsrc),"s"(lds_dst):"memory");}
__device__ __forceinline__ float max3f(float a,float b,float c){float r;asm("v_max3_f32 %0, %1, %2, %3":"=v"(r):"v"(a),"v"(b),"v"(c));return r;}
__device__ __forceinline__ float max2f(float a,float b){float r;asm("v_max_f32_e32 %0, %1, %2":"=v"(r):"v"(a),"v"(b));return r;}
__device__ __forceinline__ float fadd_s(float a,float b){float r;asm("v_add_f32_e32 %0, %1, %2":"=v"(r):"v"(a),"v"(b));return r;}
__device__ __forceinline__ float fsub_s(float a,float b){float r;asm("v_sub_f32_e32 %0, %1, %2":"=v"(r):"v"(a),"v"(b));return r;}
typedef float f32x2_t __attribute__((ext_vector_type(2))); typedef __bf16 bf16x2_t __attribute__((ext_vector_type(2)));
__device__ __forceinline__ unsigned cvtpk_s(float lo,float hi){f32x2_t v={lo,hi};bf16x2_t b=__builtin_convertvector(v,bf16x2_t);return __builtin_bit_cast(unsigned,b);}
#define WAIT_BAR(N) asm volatile("s_waitcnt vmcnt(" #N ") lgkmcnt(0)\n\ts_barrier":::"memory")

__device__ __forceinline__ void qkt(f32x16&p0,f32x16&p1,const char*Kslot,const bf16x8*qr,const f32x16&negm,int r32,int hi){
  const char*kb=Kslot+hi*1024+r32*16;
  #pragma unroll
  for(int d0=0;d0<4;++d0){
    const bf16x8 b0=*reinterpret_cast<const bf16x8*>(kb+d0*2048);
    const bf16x8 b1=*reinterpret_cast<const bf16x8*>(kb+d0*2048+512);
    if(d0==0){p0=__builtin_amdgcn_mfma_f32_32x32x16_bf16(b0,qr[0],negm,0,0,0);p1=__builtin_amdgcn_mfma_f32_32x32x16_bf16(b1,qr[0],negm,0,0,0);}
    else{p0=__builtin_amdgcn_mfma_f32_32x32x16_bf16(b0,qr[d0],p0,0,0,0);p1=__builtin_amdgcn_mfma_f32_32x32x16_bf16(b1,qr[d0],p1,0,0,0);}}
}
typedef __attribute__((address_space(3))) const char* lds_cptr;
typedef short v4i16_t __attribute__((ext_vector_type(4)));
__device__ __forceinline__ void kload8(bf16x8*kf,lds_cptr kp){
  kf[0]=*(const __attribute__((address_space(3))) bf16x8*)(kp);      kf[1]=*(const __attribute__((address_space(3))) bf16x8*)(kp+512);
  kf[2]=*(const __attribute__((address_space(3))) bf16x8*)(kp+2048); kf[3]=*(const __attribute__((address_space(3))) bf16x8*)(kp+2560);
  kf[4]=*(const __attribute__((address_space(3))) bf16x8*)(kp+4096); kf[5]=*(const __attribute__((address_space(3))) bf16x8*)(kp+4608);
  kf[6]=*(const __attribute__((address_space(3))) bf16x8*)(kp+6144); kf[7]=*(const __attribute__((address_space(3))) bf16x8*)(kp+6656);
}
__device__ __forceinline__ void kload2(bf16x8*kf,lds_cptr kp,int j){ kf[2*j]=*(const __attribute__((address_space(3))) bf16x8*)(kp+j*2048); kf[2*j+1]=*(const __attribute__((address_space(3))) bf16x8*)(kp+j*2048+512); }
__device__ __forceinline__ s16x4 vtr(lds_cptr p){ return __builtin_bit_cast(s16x4,__builtin_amdgcn_ds_read_tr16_b64_v4i16((__attribute__((address_space(3))) v4i16_t*)p)); }
__device__ __forceinline__ float rowmax(const f32x16&p0,const f32x16&p1){
  float a=max3f(p0[0],p0[1],p1[0]),b=max3f(p0[2],p0[3],p1[1]);a=max3f(a,p1[2],p1[3]);
  #pragma unroll
  for(int r=4;r<16;r+=4){a=max3f(a,p0[r],p0[r+1]);b=max3f(b,p0[r+2],p0[r+3]);a=max3f(a,p1[r],p1[r+1]);b=max3f(b,p1[r+2],p1[r+3]);}
  const float m=max2f(a,b);
  auto rr=__builtin_amdgcn_permlane32_swap(__float_as_uint(m),__float_as_uint(m),false,false);
  return max2f(__uint_as_float(rr[0]),__uint_as_float(rr[1]));
}
__device__ __forceinline__ void pv(f32x16*o,int vb,bf16x8 pa0,bf16x8 pa1,bf16x8 pa2,bf16x8 pa3){
  #pragma unroll
  for(int d0=0;d0<2;++d0){s16x4 lo[4],hi[4];
    #pragma unroll
    for(int ks=0;ks<4;++ks){
      asm volatile("ds_read_b64_tr_b16 %0,%1 offset:%c2":"=&v"(lo[ks]):"v"(vb),"i"(d0*4096+ks*1024):"memory");
      asm volatile("ds_read_b64_tr_b16 %0,%1 offset:%c2":"=&v"(hi[ks]):"v"(vb),"i"(d0*4096+ks*1024+512):"memory");}
    asm volatile("s_waitcnt lgkmcnt(0)":::"memory");SBAR();
    #define PK(k) (bf16x8){lo[k][0],lo[k][1],lo[k][2],lo[k][3],hi[k][0],hi[k][1],hi[k][2],hi[k][3]}
    o[d0]=__builtin_amdgcn_mfma_f32_32x32x16_bf16(pa0,PK(0),o[d0],0,0,0);
    o[d0]=__builtin_amdgcn_mfma_f32_32x32x16_bf16(pa1,PK(1),o[d0],0,0,0);
    o[d0]=__builtin_amdgcn_mfma_f32_32x32x16_bf16(pa2,PK(2),o[d0],0,0,0);
    o[d0]=__builtin_amdgcn_mfma_f32_32x32x16_bf16(pa3,PK(3),o[d0],0,0,0);
    #undef PK
  }
}

#ifndef ATTN_STORE16
#define ATTN_STORE16(p,v) (*(u32x4*)(p)=(v))
#endif
struct QPre { const float* qg; const float* rc; const float* rs; };
template<int THRL> __device__ __forceinline__ void attn_unit(int b,int h,long qrow0,int NTarg,int tq0,const QPre&QN,const bf16*Q,const bf16*__restrict__ K,const bf16*__restrict__ V,bf16*O,char*shm){
  int tid_=threadIdx.x; asm volatile("":"+v"(tid_)); const int tid=tid_,lane=tid&63,r32=lane&31,hi=lane>>5; const int wid=__builtin_amdgcn_readfirstlane(tid>>6);
  const long krowbase=(long)b*SEQK; const int kvh=h>>2;
  const bf16*Qw=Q+(qrow0+wid*QBLK)*QIN+h*D;
  const bf16*Kh=K+krowbase*KP+kvh*D,*Vh=V+krowbase*KP+kvh*D;
  const unsigned lds0=(unsigned)(uintptr_t)shm;
  float*wsf=(float*)(shm+LDS_WS)+wid*64;
  const bf16*ksrc=Kh+(long)lane*KP+wid*8;
  const bf16*vsrc=Vh+(long)(16*(wid&3)+(lane>>2))*KP+(wid>>2)*32+(lane&3)*8;
  const unsigned kdst=lds0+LDS_K+wid*1024, vdst=lds0+LDS_V+wid*1024;
  #define DMA_K(t,slot) glds16(ksrc+(long)(t)*KVBLK*KP,(unsigned)__builtin_amdgcn_readfirstlane(kdst+(slot)))
  #define DMA_V(t,slot) glds16(vsrc+(long)(t)*KVBLK*KP,(unsigned)__builtin_amdgcn_readfirstlane(vdst+(slot)))
  const int vb0=(int)(lds0+LDS_V)+((lane>>4)&1)*32+(lane&3)*8+(4*hi+((lane&15)>>2))*64;
  const char*Kbase=shm+LDS_K; bf16x8 kf[8];
  const lds_cptr shm3=(lds_cptr)shm; const lds_cptr kp0=shm3+LDS_K+hi*1024+r32*16; const lds_cptr vp0=shm3+LDS_V+((lane>>4)&1)*32+(lane&3)*8+(4*hi+((lane&15)>>2))*64;
  const int NT=NTarg;
  DMA_K(0,0);DMA_V(0,0);DMA_K(1,SLOTB);
  bf16x8 qr[4];
  #pragma unroll
  for(int d0=0;d0<4;++d0)qr[d0]=*reinterpret_cast<const bf16x8*>(&Qw[(long)r32*QIN+d0*16+hi*8]);
  {
    float x[4][8]; float ss=0.f;
    #pragma unroll
    for(int d0=0;d0<4;++d0){
      #pragma unroll
      for(int e=0;e<8;++e){ x[d0][e]=__builtin_bit_cast(float,(unsigned)(unsigned short)qr[d0][e]<<16); ss+=x[d0][e]*x[d0][e]; } }
    ss+=__shfl_xor(ss,32);
    const float rstd=C2/sqrtf(ss*(1.0f/64.0f)+1e-6f);
    #pragma unroll
    for(int d0=0;d0<4;++d0){ const f32x4_t g0=*reinterpret_cast<const f32x4_t*>(QN.qg+16*d0+8*hi), g1=*reinterpret_cast<const f32x4_t*>(QN.qg+16*d0+8*hi+4);
      #pragma unroll
      for(int e=0;e<8;++e) x[d0][e]*=rstd*(e<4?g0[e]:g1[e-4]); }
    if(tq0>=0){ const int t=tq0+wid*QBLK+r32;
      #pragma unroll
      for(int d0=0;d0<2;++d0){ const float*cp=QN.rc+(long)t*32+16*d0+8*hi,*sp=QN.rs+(long)t*32+16*d0+8*hi;
        const f32x4_t c0=*reinterpret_cast<const f32x4_t*>(cp),c1=*reinterpret_cast<const f32x4_t*>(cp+4),s0=*reinterpret_cast<const f32x4_t*>(sp),s1=*reinterpret_cast<const f32x4_t*>(sp+4);
        #pragma unroll
        for(int e=0;e<8;++e){ const float cs=e<4?c0[e]:c1[e-4], sn=e<4?s0[e]:s1[e-4]; const float a=x[d0][e], bq=x[d0+2][e]; x[d0][e]=a*cs-bq*sn; x[d0+2][e]=bq*cs+a*sn; } } }
    #pragma unroll
    for(int d0=0;d0<4;++d0){ u32x4 pk; pk[0]=cvtpk_s(x[d0][0],x[d0][1]); pk[1]=cvtpk_s(x[d0][2],x[d0][3]); pk[2]=cvtpk_s(x[d0][4],x[d0][5]); pk[3]=cvtpk_s(x[d0][6],x[d0][7]); qr[d0]=__builtin_bit_cast(bf16x8,pk); }
  }
  float mhat=0.f,l_reg=0.f;f32x16 o[2];o[0]=f32x16{};o[1]=f32x16{};f32x16 negm=f32x16{};asm volatile("":"+v"(negm));
  const int qrel=wid*QBLK+r32;
  #define CMASK(P0,P1,t) do{}while(0)
  bool resc=false;
  #define START(P0,P1) do{ const float rm=rowmax(P0,P1); resc=false; \
    { const float dl=rm; mhat=fadd_s(mhat,dl); \
      _Pragma("unroll") for(int r=0;r<16;++r){P0[r]=fsub_s(P0[r],dl);P1[r]=fsub_s(P1[r],dl);} \
      _Pragma("unroll") for(int r=0;r<16;++r)negm[r]=-mhat; asm volatile("":"+v"(negm)); } \
    _Pragma("unroll") for(int r=0;r<16;++r)P0[r]=__builtin_amdgcn_exp2f(P0[r]); }while(0)
  #define RESC() do{ if(resc){ asm volatile("s_waitcnt lgkmcnt(0)":::"memory"); \
      _Pragma("unroll") for(int d_=0;d_<2;++d_) _Pragma("unroll") for(int r=0;r<16;++r)o[d_][r]*=wsf[crow(r,hi)]; } }while(0)
  f32x16 pA0,pA1,pB0,pB1;
  int sl_prev=0,sl_cur=0,sl_next=SLOTB;
  #define ROT() do{sl_prev=sl_cur;sl_cur=sl_next;sl_next=(sl_next==(NSLOT-1)*SLOTB)?0:sl_next+SLOTB;}while(0)
  DMA_K(2,2*SLOTB);
  WAIT_BAR(3);
  qkt(pA0,pA1,Kbase,qr,negm,r32,hi);asm volatile("s_nop 15\n\ts_nop 7":"+v"(pA0),"+v"(pA1));CMASK(pA0,pA1,0);
  START(pA0,pA1);
  _Pragma("unroll") for(int r=0;r<16;++r)pA1[r]=__builtin_amdgcn_exp2f(pA1[r]);
  WAIT_BAR(0);
  DMA_K(3,0);DMA_V(1,SLOTB);
  ROT();
  kload8(kf,kp0+sl_cur);
  WAIT_BAR(2);
  s16x4 vlo[8],vhi[8]; u32x4 pw0,pw1,pw2,pw3;
  #define PKW(P,B) cvtpk_s(P[B],P[B+1])
  #define PAF(k) __builtin_bit_cast(bf16x8,pw##k)
  #define VFR(i) (bf16x8){vlo[i][0],vlo[i][1],vlo[i][2],vlo[i][3],vhi[i][0],vhi[i][1],vhi[i][2],vhi[i][3]}
  #define PIN(x) asm volatile("":"+v"(x))
  #define MX3(a,b,c) __builtin_fmaxf(__builtin_fmaxf((a),(b)),(c))
  #define GAPA(MF,A0,A1,A2,A3,W0,W1,PW) do{ MF; sacc+=A0; sacc+=A1; sacc+=A2; sacc+=A3; PIN(sacc); W0; W1; PIN(PW); SBAR(); }while(0)
  #define EX(v) __builtin_amdgcn_exp2f(v)
  #define GAPB(MF,X,B) do{ MF; X[B]=EX(X[B]); X[B+1]=EX(X[B+1]); X[B+2]=EX(X[B+2]); X[B+3]=EX(X[B+3]); PIN(X); SBAR(); }while(0)
  #define VRD(i) do{ vlo[i]=vtr(vp_+(((i)>>2)*4096+((i)&3)*1024)); vhi[i]=vtr(vp_+(((i)>>2)*4096+((i)&3)*1024+512)); }while(0)
  #define KRD(G,j) do{ if(G){ kload2(kf,kp0+sl_next,j); SBAR(); } }while(0)
  #define STEP(C0,C1,P0,P1,t,GK,GV,GL) do{ SBAR(); \
    const lds_cptr vp_=vp0+sl_prev; \
    VRD(0); SBAR(); float sacc=(P0[0]+P0[1]); \
    GAPA(C0=__builtin_amdgcn_mfma_f32_32x32x16_bf16(kf[0],qr[0],negm,0,0,0), P0[2],P0[3],P0[4],P0[5],     pw0[0]=PKW(P0,0), pw0[1]=PKW(P0,2), pw0); \
    VRD(4); SBAR(); GAPA(C1=__builtin_amdgcn_mfma_f32_32x32x16_bf16(kf[1],qr[0],negm,0,0,0), P0[6],P0[7],P0[8],P0[9],     pw0[2]=PKW(P0,4), pw0[3]=PKW(P0,6), pw0); \
    VRD(1); SBAR(); GAPA(C0=__builtin_amdgcn_mfma_f32_32x32x16_bf16(kf[2],qr[1],C0,0,0,0),   P0[10],P0[11],P0[12],P0[13], pw1[0]=PKW(P0,8), pw1[1]=PKW(P0,10), pw1); \
    VRD(5); SBAR(); GAPA(C1=__builtin_amdgcn_mfma_f32_32x32x16_bf16(kf[3],qr[1],C1,0,0,0),   P0[14],P0[15],P1[0],P1[1],   pw1[2]=PKW(P0,12),pw1[3]=PKW(P0,14), pw1); \
    VRD(2); SBAR(); GAPA(C0=__builtin_amdgcn_mfma_f32_32x32x16_bf16(kf[4],qr[2],C0,0,0,0),   P1[2],P1[3],P1[4],P1[5],     pw2[0]=PKW(P1,0), pw2[1]=PKW(P1,2), pw2); \
    VRD(6); SBAR(); GAPA(C1=__builtin_amdgcn_mfma_f32_32x32x16_bf16(kf[5],qr[2],C1,0,0,0),   P1[6],P1[7],P1[8],P1[9],     pw2[2]=PKW(P1,4), pw2[3]=PKW(P1,6), pw2); \
    VRD(3); SBAR(); GAPA(C0=__builtin_amdgcn_mfma_f32_32x32x16_bf16(kf[6],qr[3],C0,0,0,0),   P1[10],P1[11],P1[12],P1[13], pw3[0]=PKW(P1,8), pw3[1]=PKW(P1,10), pw3); \
    VRD(7); SBAR(); GAPA(C1=__builtin_amdgcn_mfma_f32_32x32x16_bf16(kf[7],qr[3],C1,0,0,0),   P1[14],P1[15],0.f,0.f,       pw3[2]=PKW(P1,12),pw3[3]=PKW(P1,14), pw3); \
    l_reg+=sacc; \
    if(GK){DMA_K((t)+3,sl_cur);} if(GV){DMA_V((t)+1,sl_next);} \
    CMASK(C0,C1,t); \
    { float a=MX3(C0[0],C0[1],C1[0]),b=MX3(C0[2],C0[3],C1[1]); a=MX3(a,C1[2],C1[3]); \
      _Pragma("unroll") for(int r=4;r<16;r+=4){a=MX3(a,C0[r],C0[r+1]);b=MX3(b,C0[r+2],C0[r+3]);a=MX3(a,C1[r],C1[r+1]);b=MX3(b,C1[r+2],C1[r+3]);} \
      float rm=__builtin_fmaxf(a,b); { auto rr=__builtin_amdgcn_permlane32_swap(__float_as_uint(rm),__float_as_uint(rm),false,false); rm=__builtin_fmaxf(__uint_as_float(rr[0]),__uint_as_float(rr[1])); } \
      resc=false; \
      if(__builtin_expect(__any(rm>(float)THRL),0)){ const float dl=__builtin_fmaxf(rm,0.f); mhat+=dl; \
        _Pragma("unroll") for(int r=0;r<16;++r){C0[r]-=dl;C1[r]-=dl;} \
        _Pragma("unroll") for(int r=0;r<16;++r)negm[r]=-mhat; asm volatile("":"+v"(negm)); \
        const float f=__builtin_amdgcn_exp2f(-dl); l_reg*=f; if(hi==0)wsf[r32]=f; resc=true; } } \
    SBAR(); \
    GAPB(o[0]=__builtin_amdgcn_mfma_f32_32x32x16_bf16(PAF(0),VFR(0),o[0],0,0,0), C0,0); \
    GAPB(o[1]=__builtin_amdgcn_mfma_f32_32x32x16_bf16(PAF(0),VFR(4),o[1],0,0,0), C0,4); \
    KRD(GL,0); GAPB(o[0]=__builtin_amdgcn_mfma_f32_32x32x16_bf16(PAF(1),VFR(1),o[0],0,0,0), C0,8); \
    KRD(GL,1); GAPB(o[1]=__builtin_amdgcn_mfma_f32_32x32x16_bf16(PAF(1),VFR(5),o[1],0,0,0), C0,12); \
    KRD(GL,2); GAPB(o[0]=__builtin_amdgcn_mfma_f32_32x32x16_bf16(PAF(2),VFR(2),o[0],0,0,0), C1,0); \
    KRD(GL,3); GAPB(o[1]=__builtin_amdgcn_mfma_f32_32x32x16_bf16(PAF(2),VFR(6),o[1],0,0,0), C1,4); \
    GAPB(o[0]=__builtin_amdgcn_mfma_f32_32x32x16_bf16(PAF(3),VFR(3),o[0],0,0,0), C1,8); \
    GAPB(o[1]=__builtin_amdgcn_mfma_f32_32x32x16_bf16(PAF(3),VFR(7),o[1],0,0,0), C1,12); \
    }while(0)
  int t=1;
  #undef CMASK
  #define CMASK(P0,P1,t) do{}while(0)
  for(;t+5<NT;t+=2){
    STEP(pB0,pB1,pA0,pA1,t,true,true,true);     WAIT_BAR(2); RESC(); ROT();
    STEP(pA0,pA1,pB0,pB1,t+1,true,true,true);   WAIT_BAR(2); RESC(); ROT();
  }
  #undef CMASK
  #define CMASK(P0,P1,t) do{}while(0)
  #define ENDW(tt) do{ if((tt)+3<NT){WAIT_BAR(2);} else if((tt)+2<NT){WAIT_BAR(1);} else {WAIT_BAR(0);} }while(0)
  for(;t+1<NT;t+=2){
    STEP(pB0,pB1,pA0,pA1,t,(t+3<NT),(t+1<NT),(t+1<NT));       ENDW(t);   RESC(); ROT();
    STEP(pA0,pA1,pB0,pB1,t+1,(t+4<NT),(t+2<NT),(t+2<NT));     ENDW(t+1); RESC(); ROT();
  }
  STEP(pB0,pB1,pA0,pA1,NT-1,false,false,false); RESC();
  { float sacc=pB0[0]+pB0[1]; _Pragma("unroll") for(int r=2;r<16;++r)sacc+=pB0[r]; _Pragma("unroll") for(int r=0;r<16;++r)sacc+=pB1[r]; l_reg+=sacc;
    pw0=(u32x4){PKW(pB0,0),PKW(pB0,2),PKW(pB0,4),PKW(pB0,6)};pw1=(u32x4){PKW(pB0,8),PKW(pB0,10),PKW(pB0,12),PKW(pB0,14)};pw2=(u32x4){PKW(pB1,0),PKW(pB1,2),PKW(pB1,4),PKW(pB1,6)};pw3=(u32x4){PKW(pB1,8),PKW(pB1,10),PKW(pB1,12),PKW(pB1,14)};
    SBAR(); pv(o,vb0+sl_cur,PAF(0),PAF(1),PAF(2),PAF(3)); }
  #undef PKW
  #undef PAF
  #undef VFR
  #undef PIN
  #undef MX3
  #undef GAPA
  #undef GAPB
  #undef EX
  #undef VRD
  #undef KRD
  #undef STEP
  #undef ENDW
  {auto rr=__builtin_amdgcn_permlane32_swap(__float_as_uint(l_reg),__float_as_uint(l_reg),false,false);l_reg=__uint_as_float(rr[0])+__uint_as_float(rr[1]);}
  if(hi==0)wsf[32+r32]=l_reg;asm volatile("s_waitcnt lgkmcnt(0)":::"memory");
  float rli[16];
  #pragma unroll
  for(int r=0;r<16;++r)rli[r]=__builtin_amdgcn_rcpf(wsf[32+crow(r,hi)]);
  bf16*Ow=O+(qrow0+wid*QBLK)*QP+h*D;
  { bf16*stg=(bf16*)(shm+LDS_OST)+wid*2048;
    #pragma unroll
    for(int r=0;r<16;++r){const int orow=crow(r,hi);
      #pragma unroll
      for(int d0=0;d0<2;++d0)stg[orow*64+d0*32+r32]=__float2bfloat16(o[d0][r]*rli[r]);}
    asm volatile("s_waitcnt lgkmcnt(0)":::"memory");
    #pragma unroll
    for(int i=0;i<4;++i){const int row=i*8+(lane>>3),ch=lane&7; const u32x4 v=*(const u32x4*)(stg+row*64+ch*8); ATTN_STORE16(Ow+(long)row*QP+ch*8,v);} }
  asm volatile("s_waitcnt lgkmcnt(0)\n\ts_barrier":::"memory");
  #undef DMA_K
  #undef DMA_V
  #undef CMASK
  #undef START
  #undef RESC
  #undef ROT
}
constexpr int ATTN_LDS_BYTES=LDS_BYTES;
struct AttnTensors { const bf16* Q; const bf16* K; const bf16* V; bf16* O; };
template<int THRL=8> __device__ __forceinline__ void attn_phase(char*lds,const AttnTensors&T,const QPre&QN,int G,int vcu,bool with_ctx,long ctx_row0){
  const int total=4*NHEAD*NQB;
  for(int i=0;;++i){
    int x,n;
    if(G==256){ if(i>=4)break; x=vcu>>5; n=i*32+(vcu&31); }
    else { const int u=i*G+vcu; if(u>=total)break; x=u>>7; n=u&127; }
    const int b=x>>1,kvh=x&1,h=kvh*4+(n>>5),qb=n&31;
    attn_unit<THRL>(b,h,(long)b*SEQQ+(long)qb*QB,SEQK/KVBLK,qb*QB,QN,T.Q,T.K,T.V,T.O,lds);
  }
  if(with_ctx){
    for(int u=vcu;u<4*NHEAD;u+=G){ const int b=u>>3,h=u&7; attn_unit<THRL>(b,h,ctx_row0+(long)b*256,4,-1,QN,T.Q,T.K,T.V,T.O,lds); }
  }
}
#undef SBAR
#undef WAIT_BAR
}

constexpr int NWAVES = 8, NTHR = 512;
constexpr int DMODEL = 1024, NB = 4, SEQ = 8192, CTXL = 256, NLAT = NB * SEQ, NCTX = NB * CTXL, MT = NLAT + NCTX;
constexpr int INW = 2048, NE = 32, KEYS = SEQ + CTXL;
constexpr int SORT_TILES = 560, SORT_ROWS = SORT_TILES * 256;
constexpr float EPSN = 1e-6f;
constexpr int NCHUNK = 66, CHUNK = 128;
constexpr int YS_PITCH = 1088;
constexpr int NPH_PRO = 2, NPH_LAYER = 13, NPH = NPH_PRO + 2 * NPH_LAYER;

constexpr size_t MiB = 1u << 20;
constexpr size_t WS_CTL = 0, CTL_ZERO_BYTES = 1 * MiB;
constexpr size_t WS_MOD = 1 * MiB, WS_ROPEC = 2 * MiB, WS_ROPES = 3 * MiB, WS_H2 = 4 * MiB, WS_KFC = 10 * MiB, WS_BLKCNT = 12 * MiB, WS_TILEE = 13 * MiB, WS_SCANS = 14 * MiB;
constexpr size_t WS_WINT = 16 * MiB, WS_WOUTT = 24 * MiB, WS_W1T = 32 * MiB, WS_W2T = 288 * MiB, WS_KF = 416 * MiB, WS_KHAT = 448 * MiB, WS_XR = 512 * MiB, WS_H = 644 * MiB;
constexpr size_t WS_U = 712 * MiB, WS_Q = 844 * MiB, WS_K = 877 * MiB, WS_V = 886 * MiB, WS_ATT = 895 * MiB, WS_LAB = 928 * MiB, WS_LRUO = 1060 * MiB, WS_VT = 1093 * MiB, WS_X0T = 1125 * MiB,
                 WS_HYO = 1157 * MiB, WS_MIXA = 1190 * MiB;
constexpr size_t WS_WGT = 11 * MiB, WS_SPT = 10 * MiB + 768 * 1024, WS_XL = 1256 * MiB;
constexpr size_t WS_GC = 10 * MiB + 896 * 1024;
constexpr size_t WS_CB = 10 * MiB + 960 * 1024;
constexpr size_t WS_F = 712 * MiB, WS_ASORT = 778 * MiB, WS_ACT = 1058 * MiB, WS_YS = 1338 * MiB, WS_TOPI = 1618 * MiB, WS_GATE = 1619 * MiB, WS_POS = 1620 * MiB, WS_RSSP = 1622 * MiB, WS_ROWTOK = 1625 * MiB, WS_END = 1626 * MiB;
constexpr size_t LAB_STRIDE = (size_t)MT * 256;
constexpr int CW_BAR = 4096;
constexpr int CW_NTILES = 64;

constexpr int RING_OFF = 0, RING_BYTES = 131072, MOETAB_OFF = 131072, LDSCTL_OFF = 155648, LDS_BYTES = 156160;

#define GAS __attribute__((address_space(1)))
#define LAS __attribute__((address_space(3)))
typedef unsigned short bf16;
typedef unsigned v4u __attribute__((ext_vector_type(4)));
typedef unsigned v2u __attribute__((ext_vector_type(2)));
typedef float f32x4 __attribute__((ext_vector_type(4)));
#define LDS_WAIT() asm volatile("s_waitcnt lgkmcnt(0)" ::: "memory")
#define VM_WAIT() asm volatile("s_waitcnt vmcnt(0)" ::: "memory")
__device__ __forceinline__ unsigned f2bf(float f) { unsigned u = __builtin_bit_cast(unsigned, f); return (u + 0x7fffu + ((u >> 16) & 1u)) >> 16; }
__device__ __forceinline__ unsigned pk2(float lo, float hi) { return f2bf(lo) | (f2bf(hi) << 16); }
__device__ __forceinline__ float bf2f(unsigned short b) { return __builtin_bit_cast(float, (unsigned)b << 16); }
__device__ __forceinline__ float bflo(unsigned w) { return __builtin_bit_cast(float, w << 16); }
__device__ __forceinline__ float bfhi(unsigned w) { return __builtin_bit_cast(float, w & 0xffff0000u); }
__device__ __forceinline__ float wave_sum(float v) {
#pragma unroll
    for (int o = 1; o < 64; o <<= 1) v += __shfl_xor(v, o);
    return v;
}
__device__ __forceinline__ float sigmoidf_(float x) { return 1.0f / (1.0f + __expf(-x)); }
__device__ __forceinline__ void sincos_d(double x, double& s, double& c) {
    const double kd = __builtin_rint(x * 0.63661977236758134308);
    const int k = (int)kd;
    double r = __builtin_fma(-kd, 1.57079632673412561417e+00, x);
    r = __builtin_fma(-kd, 6.07710050650619224932e-11, r);
    const double z = r * r;
    const double ps = r + r * z * (-1.66666666666666324348e-01 + z * (8.33333333332248946124e-03 + z * (-1.98412698298579493134e-04 + z * (2.75573137070700676789e-06 + z * (-2.50507602534068634195e-08 + z * 1.58969099521155010221e-10)))));
    const double pc = 1.0 - 0.5 * z + z * z * (4.16666666666666019037e-02 + z * (-1.38888888888741095749e-03 + z * (2.48015872894767294178e-05 + z * (-2.75573143513906633035e-07 + z * (2.08757232129817482790e-09 + z * -1.13596475577881948265e-11)))));
    const int q = k & 3;
    s = (q == 0) ? ps : (q == 1) ? pc : (q == 2) ? -ps : -pc;
    c = (q == 0) ? pc : (q == 1) ? -ps : (q == 2) ? -pc : ps;
}
__device__ __forceinline__ float gelu_tanh(float x) {
    const float u = 0.7978845608028654f * (x + 0.044715f * x * x * x);
    const float t = 1.0f - 2.0f / (1.0f + __expf(2.0f * u));
    return 0.5f * x * (1.0f + t);
}
__device__ __forceinline__ int lds_add(LAS int* p, int v) { return __hip_atomic_fetch_add(p, v, __ATOMIC_RELAXED, __HIP_MEMORY_SCOPE_WORKGROUP); }

#define FFT_FN __device__ __forceinline__
typedef float f32x2v __attribute__((ext_vector_type(2)));
#define FFT_VEC2 f32x2v
#define FFT_DPTR LAS f32x2v*
#define FFT_LD(D, i) c32_from((D)[i])
#define FFT_ST(D, i, v) ((D)[i] = c32_to(v))
struct __attribute__((aligned(8))) c32 { float x, y; };
FFT_FN c32 cmul(c32 a, c32 b) { c32 r; r.x = a.x * b.x - a.y * b.y; r.y = a.x * b.y + a.y * b.x; return r; }
FFT_FN c32 cadd(c32 a, c32 b) { c32 r; r.x = a.x + b.x; r.y = a.y + b.y; return r; }
FFT_FN c32 csub(c32 a, c32 b) { c32 r; r.x = a.x - b.x; r.y = a.y - b.y; return r; }
FFT_FN c32 cmuli_neg(c32 a) { c32 r; r.x = a.y; r.y = -a.x; return r; }
FFT_FN int fpad(int a) { return a + (a >> 4); }
#ifdef FFT_VEC2
FFT_FN c32 c32_from(FFT_VEC2 t) { c32 r; r.x = t.x; r.y = t.y; return r; }
FFT_FN FFT_VEC2 c32_to(c32 a) { FFT_VEC2 t; t.x = a.x; t.y = a.y; return t; }
#endif
FFT_FN void dft4(c32& a0, c32& a1, c32& a2, c32& a3) {
    const c32 s02 = cadd(a0, a2), d02 = csub(a0, a2), s13 = cadd(a1, a3), d13 = cmuli_neg(csub(a1, a3));
    a0 = cadd(s02, s13); a2 = csub(s02, s13); a1 = cadd(d02, d13); a3 = csub(d02, d13);
}
FFT_FN void dft16(c32 (&v)[16]) {
    const float C1 = 0.92387953251128674f, S1 = 0.38268343236508977f, C2 = 0.70710678118654752f;
#pragma unroll
    for (int q2 = 0; q2 < 4; ++q2) dft4(v[q2], v[4 + q2], v[8 + q2], v[12 + q2]);
    { c32 w;
      w.x = C1; w.y = -S1; v[4 * 1 + 1] = cmul(v[4 * 1 + 1], w);
      w.x = C2; w.y = -C2; v[4 * 2 + 1] = cmul(v[4 * 2 + 1], w);
      w.x = S1; w.y = -C1; v[4 * 3 + 1] = cmul(v[4 * 3 + 1], w);
      w.x = C2; w.y = -C2; v[4 * 1 + 2] = cmul(v[4 * 1 + 2], w);
      v[4 * 2 + 2] = cmuli_neg(v[4 * 2 + 2]);
      w.x = -C2; w.y = -C2; v[4 * 3 + 2] = cmul(v[4 * 3 + 2], w);
      w.x = S1; w.y = -C1; v[4 * 1 + 3] = cmul(v[4 * 1 + 3], w);
      w.x = -C2; w.y = -C2; v[4 * 2 + 3] = cmul(v[4 * 2 + 3], w);
      w.x = -C1; w.y = S1; v[4 * 3 + 3] = cmul(v[4 * 3 + 3], w); }
#pragma unroll
    for (int p1 = 0; p1 < 4; ++p1) dft4(v[4 * p1 + 0], v[4 * p1 + 1], v[4 * p1 + 2], v[4 * p1 + 3]);
#pragma unroll
    for (int a = 0; a < 4; ++a)
#pragma unroll
        for (int b = a + 1; b < 4; ++b) { const c32 t = v[4 * a + b]; v[4 * a + b] = v[4 * b + a]; v[4 * b + a] = t; }
}
FFT_FN c32 twid(int j, int n) { float rev = (float)j / (float)n; asm volatile("" : "+v"(rev)); c32 w; w.x = __builtin_amdgcn_cosf(rev); w.y = -__builtin_amdgcn_sinf(rev); return w; }

FFT_FN void fft_fwd16(FFT_DPTR D, int g, int n) {
    const int s = n >> 4, blk = g / s, j = g - blk * s, base = blk * n + j;
    c32 v[16];
#pragma unroll
    for (int q = 0; q < 16; ++q) v[q] = FFT_LD(D, fpad(base + q * s));
    dft16(v);
    const c32 w = twid(j, n); c32 wp = w;
#pragma unroll
    for (int p = 1; p < 16; ++p) { v[p] = cmul(v[p], wp); wp = cmul(wp, w); }
#pragma unroll
    for (int p = 0; p < 16; ++p) FFT_ST(D, fpad(base + p * s), v[p]);
}
FFT_FN void fft_inv16(FFT_DPTR D, int g, int n) {
    const int s = n >> 4, blk = g / s, j = g - blk * s, base = blk * n + j;
    c32 v[16];
#pragma unroll
    for (int q = 0; q < 16; ++q) v[q] = FFT_LD(D, fpad(base + q * s));
    const c32 w = twid(j, n); c32 wp = w;
#pragma unroll
    for (int p = 1; p < 16; ++p) { v[p] = cmul(v[p], wp); wp = cmul(wp, w); }
    dft16(v);
#pragma unroll
    for (int p = 0; p < 16; ++p) FFT_ST(D, fpad(base + p * s), v[p]);
}
FFT_FN void fft_mid16(FFT_DPTR D, int g, const c32* KH) {
    c32 v[16];
#pragma unroll
    for (int q = 0; q < 16; ++q) v[q] = FFT_LD(D, 17 * g + q);
    dft16(v);
#pragma unroll
    for (int p = 0; p < 16; ++p) { const c32 k = KH[16 * g + p]; const c32 t = cmul(v[p], k); v[p].x = t.x; v[p].y = -t.y; }
    dft16(v);
#pragma unroll
    for (int p = 0; p < 16; ++p) FFT_ST(D, 17 * g + p, v[p]);
}
typedef float fft_f32x4 __attribute__((ext_vector_type(4)));
FFT_FN void fft_mid16k(FFT_DPTR D, int g, const fft_f32x4 (&kv)[8]) {
    c32 v[16];
#pragma unroll
    for (int q = 0; q < 16; ++q) v[q] = FFT_LD(D, 17 * g + q);
    dft16(v);
#pragma unroll
    for (int p = 0; p < 16; ++p) { c32 k; k.x = kv[p >> 1][2 * (p & 1)]; k.y = kv[p >> 1][2 * (p & 1) + 1]; const c32 t = cmul(v[p], k); v[p].x = t.x; v[p].y = -t.y; }
    dft16(v);
#pragma unroll
    for (int p = 0; p < 16; ++p) FFT_ST(D, 17 * g + p, v[p]);
}
typedef float fft_f32x4o __attribute__((ext_vector_type(4)));
FFT_FN void fft_last16_out(FFT_DPTR D, int g, c32* OUT, float scale) {
    c32 v[16];
#pragma unroll
    for (int q = 0; q < 16; ++q) v[q] = FFT_LD(D, 17 * g + q);
    dft16(v);
#pragma unroll
    for (int pp = 0; pp < 8; ++pp) { fft_f32x4o t = {v[2 * pp].x * scale, v[2 * pp].y * scale, v[2 * pp + 1].x * scale, v[2 * pp + 1].y * scale};
        ((fft_f32x4o*)OUT)[((g >> 6) * 8 + pp) * 64 + (g & 63)] = t; }
}
FFT_FN void fft_first4(FFT_DPTR D, int j, c32 x0, c32 x1, c32 x2, c32 x3) {
    dft4(x0, x1, x2, x3);
    const c32 w = twid(j, 16384), w2 = cmul(w, w), w3 = cmul(w2, w);
    FFT_ST(D, fpad(j), x0); FFT_ST(D, fpad(j + 4096), cmul(x1, w)); FFT_ST(D, fpad(j + 8192), cmul(x2, w2)); FFT_ST(D, fpad(j + 12288), cmul(x3, w3));
}
FFT_FN void fft_final4(FFT_DPTR D, int j, c32& u0, c32& u1) {
    const c32 w = twid(j, 16384), w2 = cmul(w, w), w3 = cmul(w2, w);
    c32 a0 = FFT_LD(D, fpad(j)), a1 = cmul(FFT_LD(D, fpad(j + 4096)), w), a2 = cmul(FFT_LD(D, fpad(j + 8192)), w2), a3 = cmul(FFT_LD(D, fpad(j + 12288)), w3);
    dft4(a0, a1, a2, a3);
    u0 = a0; u1 = a1;
}
FFT_FN void fft_first4_inplace(FFT_DPTR D, int j) {
    c32 x0 = FFT_LD(D, fpad(j)), x1 = FFT_LD(D, fpad(j + 4096)), x2 = FFT_LD(D, fpad(j + 8192)), x3 = FFT_LD(D, fpad(j + 12288));
    fft_first4(D, j, x0, x1, x2, x3);
}
#define XB_TMO      128
#define XB_XCNT(j)  (256  + 64 * (j))
#define XB_XSUB(j)  (1280 + 64 * (j))
#define XB_XGEN(j)  (2304 + 64 * (j))
#define XB_TOP      3328
#define XB_TOPGEN   3392
#define XCD_BAR_WORDS 3456
#define XB_SPIN_CAP (1u << 22)

__device__ __forceinline__ unsigned xb_ld(unsigned* p)              { return __hip_atomic_load(p, __ATOMIC_RELAXED, __HIP_MEMORY_SCOPE_AGENT); }
__device__ __forceinline__ unsigned xb_add(unsigned* p, unsigned v) { return __hip_atomic_fetch_add(p, v, __ATOMIC_RELAXED, __HIP_MEMORY_SCOPE_AGENT); }
__device__ __forceinline__ unsigned xb_xcc_id() { return (unsigned)__builtin_amdgcn_s_getreg((3 << 11) | 20) & 0xFu; }
#define XB_SPIN(cond, bar) do { unsigned _sp = 0; while (cond) { __builtin_amdgcn_s_sleep(1); \
    if ((++_sp & 255u) == 0u) { if (xb_ld(&(bar)[XB_TMO])) break; if (_sp > XB_SPIN_CAP) { atomicAdd(&(bar)[XB_TMO], 1u); break; } } } } while (0)

struct XcdBarrier {
    unsigned* bar; unsigned x;
    volatile LAS unsigned* st;
};

__device__ __forceinline__ XcdBarrier xcd_barrier_post(unsigned* bar, volatile LAS unsigned* st) {
    XcdBarrier b; b.bar = bar; b.x = xb_xcc_id(); b.st = st;
    if (threadIdx.x == 0) (void)xb_add(&bar[XB_XCNT(b.x)], 1u);
    return b;
}
__device__ __forceinline__ void xcd_barrier_complete(unsigned* bar, unsigned x, unsigned& nloc, unsigned& nx) {
    const unsigned G = gridDim.x * gridDim.y * gridDim.z;
    unsigned sum, cnt, mine, sp = 0u;
    for (;;) {
        sum = 0u; cnt = 0u; mine = 0u;
#pragma unroll
        for (unsigned j = 0; j < 16; ++j) { const unsigned c = xb_ld(&bar[XB_XCNT(j)]); sum += c; cnt += (c > 0u) ? 1u : 0u; mine = (j == x) ? c : mine; }
        if (sum == G) break;
        __builtin_amdgcn_s_sleep(1);
        if ((++sp & 255u) == 0u) { if (xb_ld(&bar[XB_TMO])) break; if (sp > XB_SPIN_CAP) { atomicAdd(&bar[XB_TMO], 1u); break; } }
    }
    nloc = mine > 0u ? mine : 1u; nx = cnt > 0u ? cnt : 1u;
}

__device__ __forceinline__ void xcd_barrier(const XcdBarrier& b) {
    asm volatile("s_waitcnt vmcnt(0)" ::: "memory");
    __syncthreads();
    if (threadIdx.x == 0) {
        unsigned* bar = b.bar;
        __builtin_amdgcn_s_waitcnt(0);
        unsigned nloc = b.st[0], nx = b.st[1];
        if (nloc == 0u) { xcd_barrier_complete(bar, b.x, nloc, nx); b.st[0] = nloc; b.st[1] = nx; }
        const unsigned old = xb_add(&bar[XB_XSUB(b.x)], 1u);
        const unsigned gen = old / nloc;
        if (old + 1u == (gen + 1u) * nloc) {
            __builtin_amdgcn_fence(__ATOMIC_RELEASE, "agent");
            asm volatile("s_waitcnt vmcnt(0)" ::: "memory");
            const unsigned og = xb_add(&bar[XB_TOP], 1u);
            const unsigned tg = og / nx;
            if (og + 1u == (tg + 1u) * nx) xb_add(&bar[XB_TOPGEN], 1u);
            else XB_SPIN(xb_ld(&bar[XB_TOPGEN]) == tg, bar);
            __builtin_amdgcn_fence(__ATOMIC_ACQUIRE, "agent");
            xb_add(&bar[XB_XGEN(b.x)], 1u);
            asm volatile("s_waitcnt vmcnt(0)" ::: "memory");
        } else {
            XB_SPIN(xb_ld(&bar[XB_XGEN(b.x)]) == gen, bar);
            __builtin_amdgcn_fence(__ATOMIC_ACQUIRE, "agent");
            asm volatile("s_waitcnt vmcnt(0)" ::: "memory");
        }
    }
    __syncthreads();
}


constexpr int CW_SPLIT = 8192, CTXWG = 32;
__device__ __forceinline__ void split_arrive_all(const XcdBarrier& b, unsigned* w) {
    asm volatile("s_waitcnt vmcnt(0)" ::: "memory");
    __syncthreads();
    if (threadIdx.x == 0) { const unsigned nloc = b.st[0]; const unsigned old = xb_add(&w[64 * b.x], 1u);
        if (old + 1u == nloc) { __builtin_amdgcn_fence(__ATOMIC_RELEASE, "agent"); asm volatile("s_waitcnt vmcnt(0)" ::: "memory"); (void)xb_add(&w[1024], 1u); } }
}
__device__ __forceinline__ void split_wait_all(const XcdBarrier& b, unsigned* w) {
    if (threadIdx.x == 0) { const unsigned nx = b.st[1]; XB_SPIN(xb_ld(&w[1024]) < nx, b.bar); __builtin_amdgcn_fence(__ATOMIC_ACQUIRE, "agent"); asm volatile("s_waitcnt vmcnt(0)" ::: "memory"); }
    __syncthreads();
}
__device__ __forceinline__ void split_arrive_flat(unsigned* w) {
    asm volatile("s_waitcnt vmcnt(0)" ::: "memory");
    __syncthreads();
    if (threadIdx.x == 0) { __builtin_amdgcn_fence(__ATOMIC_RELEASE, "agent"); asm volatile("s_waitcnt vmcnt(0)" ::: "memory"); (void)xb_add(&w[1088], 1u); }
}
__device__ __forceinline__ void split_wait_flat(const XcdBarrier& b, unsigned* w, unsigned target) {
    if (threadIdx.x == 0) { XB_SPIN(xb_ld(&w[1088]) < target, b.bar); __builtin_amdgcn_fence(__ATOMIC_ACQUIRE, "agent"); asm volatile("s_waitcnt vmcnt(0)" ::: "memory"); }
    __syncthreads();
}

struct Frame {
    LAS unsigned char* lds; unsigned* ctl; unsigned char* ws;
    int tid, lane, wave, vcu, G, gw, ngw;
};
__device__ const float ROPE_INV[16] = {1.0f, 0.5623413251903491f, 0.31622776601683794f, 0.1778279410038923f, 0.1f, 0.05623413251903491f, 0.03162277660168379f, 0.01778279410038923f,
                                       0.01f, 0.005623413251903491f, 0.0031622776601683794f, 0.001778279410038923f, 0.001f, 0.0005623413251903491f, 0.00031622776601683794f, 0.0001778279410038923f};

__device__ __forceinline__ void p0_transpose_item(const float* W, int K, int N, bf16* WT, LAS float* scr, int item, int lane) {
    const int nblk = N / 32, kb = item / nblk, nb = item % nblk, k0 = 64 * kb, n0 = 32 * nb;
#pragma unroll 8
    for (int i = 0; i < 32; ++i) { const int kk = 2 * i + (lane >> 5); scr[kk * 33 + (lane & 31)] = W[(size_t)(k0 + kk) * N + n0 + (lane & 31)]; }
    LDS_WAIT(); asm volatile("" ::: "memory");
    const int c = lane & 7;
#pragma unroll
    for (int j = 0; j < 4; ++j) { const int n = (lane >> 3) + 8 * j; const LAS float* s = scr + (8 * c) * 33 + n;
        v4u o; o.x = pk2(s[0 * 33], s[1 * 33]); o.y = pk2(s[2 * 33], s[3 * 33]); o.z = pk2(s[4 * 33], s[5 * 33]); o.w = pk2(s[6 * 33], s[7 * 33]);
        *(GAS v4u*)(WT + (size_t)(n0 + n) * K + k0 + 8 * c) = o; }
    LDS_WAIT(); asm volatile("" ::: "memory");
}

__device__ __forceinline__ void p0_transpose_item_f8(const float* W, int K, int N, unsigned char* WT, LAS float* scr, int item, int lane) {
    const int nblk = N / 32, kb = item / nblk, nb = item % nblk, k0 = 64 * kb, n0 = 32 * nb;
#pragma unroll 2
    for (int i = 0; i < 8; ++i) { const int kk = 8 * i + (lane >> 3); const f32x4 v = __builtin_nontemporal_load((const f32x4*)(W + (size_t)(k0 + kk) * N + n0) + (lane & 7));
        LAS float* d = scr + kk * 33 + 4 * (lane & 7); d[0] = v.x; d[1] = v.y; d[2] = v.z; d[3] = v.w; }
    LDS_WAIT(); asm volatile("" ::: "memory");
    const int c = lane & 7;
#pragma unroll
    for (int j = 0; j < 4; ++j) { const int n = (lane >> 3) + 8 * j; const LAS float* s = scr + (8 * c) * 33 + n;
        v2u o; o.x = pg8::pack4_fp8(s[0 * 33] * pg8::F8_SW, s[1 * 33] * pg8::F8_SW, s[2 * 33] * pg8::F8_SW, s[3 * 33] * pg8::F8_SW);
        o.y = pg8::pack4_fp8(s[4 * 33] * pg8::F8_SW, s[5 * 33] * pg8::F8_SW, s[6 * 33] * pg8::F8_SW, s[7 * 33] * pg8::F8_SW);
        *(GAS v2u*)(WT + (size_t)(n0 + n) * K + k0 + 8 * c) = o; }
    LDS_WAIT(); asm volatile("" ::: "memory");
}

__device__ __forceinline__ void ph_prologue_a(const Frame& F, const float* c, const float* cctx, const float* w_mod, const float* b_mod, const float* w_in, const float* w_out,
                                              const float* moe_w1, const float* moe_w2, const float* hy_w1, const float* hy_b1, const float* hy_w2, const float* hy_b2, const float* hy_freq, const float* lru_gw, const float* lru_lam) {
    {
        LAS float* scr = (LAS float*)(F.lds + F.wave * 16384);
        constexpr int I_IN = 2 * 1024, I_OUT = 2 * 512, I_W1 = 64 * 1024, I_W2 = 64 * 512, NIT = I_IN + I_OUT + I_W1 + I_W2;
        bf16* WinT = (bf16*)(F.ws + WS_WINT); bf16* WoutT = (bf16*)(F.ws + WS_WOUTT); bf16* W1T = (bf16*)(F.ws + WS_W1T); bf16* W2T = (bf16*)(F.ws + WS_W2T);
        for (int it = F.gw; it < NIT; it += F.ngw) {
            int r = it;
            if (r < I_IN) { const int m = r >> 10; p0_transpose_item(w_in + (size_t)m * 1024 * 2048, 1024, 2048, WinT + (size_t)m * 2048 * 1024, scr, r & 1023, F.lane); continue; } r -= I_IN;
            if (r < I_OUT) { const int m = r >> 9; p0_transpose_item(w_out + (size_t)m * 1024 * 1024, 1024, 1024, WoutT + (size_t)m * 1024 * 1024, scr, r & 511, F.lane); continue; } r -= I_OUT;
#if MOE_FP8
            if (r < I_W1) { const int m = r >> 10; p0_transpose_item_f8(moe_w1 + (size_t)m * 1024 * 2048, 1024, 2048, (unsigned char*)W1T + (size_t)m * 2048 * 1024, scr, r & 1023, F.lane); continue; } r -= I_W1;
            { const int m = r >> 9; p0_transpose_item_f8(moe_w2 + (size_t)m * 1024 * 1024, 1024, 1024, (unsigned char*)W2T + (size_t)m * 1024 * 1024, scr, r & 511, F.lane); }
#else
            if (r < I_W1) { const int m = r >> 10; p0_transpose_item(moe_w1 + (size_t)m * 1024 * 2048, 1024, 2048, W1T + (size_t)m * 2048 * 1024, scr, r & 1023, F.lane); continue; } r -= I_W1;
            { const int m = r >> 9; p0_transpose_item(moe_w2 + (size_t)m * 1024 * 1024, 1024, 1024, W2T + (size_t)m * 1024 * 1024, scr, r & 511, F.lane); }
#endif
        }
    }
    __syncthreads();
    {
        LAS float* sl = (LAS float*)(F.lds);
        LAS float* red = (LAS float*)(F.lds + 20480);
        float* MOD = (float*)(F.ws + WS_MOD);
        if ((int)blockIdx.x < 192) {
            for (int i = F.tid; i < 5 * 1024; i += NTHR) { const int r = i >> 10, k = i & 1023; const float v = (r < 4) ? c[r * 1024 + k] : cctx[k]; sl[i] = v / (1.0f + __expf(-v)); }
        }
        __syncthreads();
        for (int it = blockIdx.x; it < 192; it += F.G) {
            const int l = it / 96, n = (it % 96) * 64 + F.lane;
            float a0 = 0.f, a1 = 0.f, a2 = 0.f, a3 = 0.f, a4 = 0.f;
            const float* wp = w_mod + ((size_t)l * 1024 + F.wave * 128) * 6144 + n;
#pragma unroll 16
            for (int k = 0; k < 128; ++k) { const float w = wp[(size_t)k * 6144]; const int kk = F.wave * 128 + k;
                a0 += sl[kk] * w; a1 += sl[1024 + kk] * w; a2 += sl[2048 + kk] * w; a3 += sl[3072 + kk] * w; a4 += sl[4096 + kk] * w; }
            red[(F.wave * 5 + 0) * 64 + F.lane] = a0; red[(F.wave * 5 + 1) * 64 + F.lane] = a1; red[(F.wave * 5 + 2) * 64 + F.lane] = a2; red[(F.wave * 5 + 3) * 64 + F.lane] = a3; red[(F.wave * 5 + 4) * 64 + F.lane] = a4;
            __syncthreads();
            if (F.tid < 320) { const int r = F.tid >> 6, ln = F.tid & 63; float s = 0.f;
#pragma unroll
                for (int w = 0; w < 8; ++w) s += red[(w * 5 + r) * 64 + ln];
                const int nn = (it % 96) * 64 + ln; MOD[(size_t)(l * 5 + r) * 6144 + nn] = s + b_mod[l * 6144 + nn]; }
            __syncthreads();
        }
    }
    {
        bf16* WGT = (bf16*)(F.ws + WS_WGT); float* SPT = (float*)(F.ws + WS_SPT);
        for (int idx = blockIdx.x * NTHR + F.tid; idx < 2 * 1024 * 256; idx += F.G * NTHR) {
            const int l = idx >> 18, nidx = (idx >> 8) & 1023, k = idx & 255;
            const int pn = nidx >> 8, j = (nidx >> 7) & 1, cc = nidx & 127, d = pn >> 1, ch = 128 * (pn & 1) + cc, n = ch >> 6, e = ch & 63;
            const float v = ((k >> 6) == n) ? lru_gw[((size_t)((((l * 2 + d) * 2 + j) * 4 + n) * 64 + (k & 63))) * 64 + e] : 0.f;
            WGT[idx] = (bf16)f2bf(v); }
        for (int idx = blockIdx.x * NTHR + F.tid; idx < 2 * 2 * 256; idx += F.G * NTHR) SPT[idx] = log1pf(expf(-lru_lam[idx]));
    }
    {
        float* RC = (float*)(F.ws + WS_ROPEC); float* RS = (float*)(F.ws + WS_ROPES);
        for (int idx = blockIdx.x * NTHR + F.tid; idx < SEQ * 32; idx += F.G * NTHR) {
            const int t = idx >> 5, i = idx & 31; const int pos = (i < 16) ? (t >> 6) : (t & 63);
            const float ang = (float)pos * ROPE_INV[i & 15];
            double s, cc; sincos_d((double)ang, s, cc); RC[idx] = (float)cc; RS[idx] = (float)s; }
    }
    {
        float* H2 = (float*)(F.ws + WS_H2);
        for (int it = F.gw; it < 2 * SEQ + CTXL; it += F.ngw) {
            const int v = it >> 13, t = (v < 2) ? (it & (SEQ - 1)) : (it - 2 * SEQ), L = (v < 2) ? SEQ : CTXL, l = (v == 1) ? 1 : 0;
            const int j = F.lane;
            float z = 0.f;
            if (j == 0) z = (float)t / (float)(L - 1);
            else if (j <= 32) { const int b = (j - 1) & 15; const float band = 1e-4f + (float)b * ((15.0f - 1e-4f) / 15.0f);
                const float ang = ((6.283185307179586f / (float)L) * (float)t) * band;
                double s, cc; sincos_d((double)ang, s, cc); z = (j <= 16) ? (float)cc : -(float)s; }
            const float fr = hy_freq[l * 64 + j];
            float p1 = hy_b1[l * 64 + j];
            const float* w1 = hy_w1 + (size_t)l * 33 * 64;
#pragma unroll
            for (int i = 0; i < 33; ++i) p1 += __shfl(z, i) * w1[i * 64 + j];
            double s1, c1; sincos_d((double)(fr * p1), s1, c1); const float h1 = (float)s1;
            float p2 = hy_b2[l * 64 + j];
            const float* w2 = hy_w2 + (size_t)l * 64 * 64;
#pragma unroll 16
            for (int i = 0; i < 64; ++i) p2 += __shfl(h1, i) * w2[i * 64 + j];
            double s2, c2; sincos_d((double)(fr * p2), s2, c2);
            H2[((size_t)v * SEQ + t) * 64 + j] = (float)s2;
        }
    }
}

__device__ __forceinline__ float filter_taps(const Frame& F, const float* H2, const LAS float* w3c, LAS float* Df, LAS float* kt, int v, int L, float df, float db, int part) {
    float asum = 0.f;
    const int qq = F.lane & 3, rr = F.lane >> 2;
    f32x4 wf[4], wb[4];
#pragma unroll
    for (int u = 0; u < 4; ++u) { const int k = 16 * qq + 4 * u; wf[u] = (f32x4){w3c[k], w3c[k + 1], w3c[k + 2], w3c[k + 3]}; wb[u] = (f32x4){w3c[64 + k], w3c[64 + k + 1], w3c[64 + k + 2], w3c[64 + k + 3]}; }
    const float* hbase = H2 + (size_t)v * SEQ * 64 + 16 * qq; const float tinv = 1.0f / (float)(L - 1);
#pragma unroll 4
    for (int i = 0; i < L / 128; ++i) { const int t = 16 * (F.wave + 8 * i) + rr;
        const f32x4* hp = (const f32x4*)(hbase + (size_t)t * 64);
        const f32x4 h0 = hp[0], h1 = hp[1], h2 = hp[2], h3 = hp[3];
        float hf = ((h0.x * wf[0].x + h0.y * wf[0].y) + (h0.z * wf[0].z + h0.w * wf[0].w)) + ((h1.x * wf[1].x + h1.y * wf[1].y) + (h1.z * wf[1].z + h1.w * wf[1].w))
                 + ((h2.x * wf[2].x + h2.y * wf[2].y) + (h2.z * wf[2].z + h2.w * wf[2].w)) + ((h3.x * wf[3].x + h3.y * wf[3].y) + (h3.z * wf[3].z + h3.w * wf[3].w));
        float hb = ((h0.x * wb[0].x + h0.y * wb[0].y) + (h0.z * wb[0].z + h0.w * wb[0].w)) + ((h1.x * wb[1].x + h1.y * wb[1].y) + (h1.z * wb[1].z + h1.w * wb[1].w))
                 + ((h2.x * wb[2].x + h2.y * wb[2].y) + (h2.z * wb[2].z + h2.w * wb[2].w)) + ((h3.x * wb[3].x + h3.y * wb[3].y) + (h3.z * wb[3].z + h3.w * wb[3].w));
        hf += __builtin_bit_cast(float, __builtin_amdgcn_update_dpp(0, __builtin_bit_cast(int, hf), 0xB1, 0xf, 0xf, false)); hb += __builtin_bit_cast(float, __builtin_amdgcn_update_dpp(0, __builtin_bit_cast(int, hb), 0xB1, 0xf, 0xf, false));
        hf += __builtin_bit_cast(float, __builtin_amdgcn_update_dpp(0, __builtin_bit_cast(int, hf), 0x4E, 0xf, 0xf, false)); hb += __builtin_bit_cast(float, __builtin_amdgcn_update_dpp(0, __builtin_bit_cast(int, hb), 0x4E, 0xf, 0xf, false));
        if (qq < 2) { const float t01 = (float)t * tinv; const bool fw = (qq == 0);
            const float val = (fw ? hf : hb) * expf(-t01 * (fw ? df : db));
            if (fw || t >= 1) { asum += fabsf(val); const int pos = fw ? t : 2 * L - t;
                if (part < 2) Df[2 * fpad(pos) + part] = val; else kt[pos] = val; } } }
    return asum;
}
FFT_FN void fft_last16_inplace(FFT_DPTR D, int g) {
    c32 v[16];
#pragma unroll
    for (int q = 0; q < 16; ++q) v[q] = FFT_LD(D, 17 * g + q);
    dft16(v);
#pragma unroll
    for (int p = 0; p < 16; ++p) FFT_ST(D, 17 * g + p, v[p]);
}
FFT_FN int fft_freq_of(int pos) { return (pos >> 12) + 4 * ((pos >> 8) & 15) + 64 * ((pos >> 4) & 15) + 1024 * (pos & 15); }
FFT_FN int fft_pos_of(int f) { return ((f & 3) << 12) | (((f >> 2) & 15) << 8) | (((f >> 6) & 15) << 4) | (f >> 10); }

__device__ __forceinline__ void ph_prologue_b(const Frame& F, const float* hy_w3, const float* hy_decay, const float* gffn, const float* router_w, const float* router_b) {
    { const float* MOD = (const float*)(F.ws + WS_MOD); float* CB = (float*)(F.ws + WS_CB);
      for (int it = F.gw; it < 2 * 5 * 32; it += F.ngw) { const int lb = it >> 5, e = it & 31, l = lb / 5; const float* sf = MOD + (size_t)lb * 6144 + 3 * 1024; float s = 0.f;
#pragma unroll
          for (int q = 0; q < 16; ++q) { const int cc = 64 * q + F.lane; s += sf[cc] * router_w[(size_t)l * 32768 + cc * 32 + e]; }
          s = wave_sum(s); if (F.lane == 0) CB[it] = s + router_b[l * 32 + e]; } }
    { const float* MOD = (const float*)(F.ws + WS_MOD); float* GC = (float*)(F.ws + WS_GC);
      for (int idx = blockIdx.x * NTHR + F.tid; idx < 2 * 5 * 1024; idx += F.G * NTHR) { const int lb = idx >> 10, cc = idx & 1023, l = lb / 5; GC[idx] = gffn[l * 1024 + cc] * (1.0f + MOD[(size_t)lb * 6144 + 4 * 1024 + cc]); } }
    LAS f32x2v* D = (LAS f32x2v*)(F.lds);
    LAS float* kt = (LAS float*)(F.lds);
    LAS float* w3c = (LAS float*)(F.lds + 139264);
    LAS float* red = (LAS float*)(F.lds + 139264 + 512);
    const float* H2 = (const float*)(F.ws + WS_H2);
    c32* KHAT = (c32*)(F.ws + WS_KHAT); float* KFC = (float*)(F.ws + WS_KFC);
    LAS float* Df = (LAS float*)(F.lds);
    for (int it = blockIdx.x; it < 512; it += F.G) {
        const int c = it & 255;
        if (it < 256) {
            float inv[2];
#pragma unroll
            for (int v = 0; v < 2; ++v) {
                if (F.tid < 128) w3c[F.tid] = hy_w3[(size_t)v * 64 * 512 + (F.tid & 63) * 512 + (F.tid >> 6) * 256 + c];
                if (F.tid == 0) Df[2 * fpad(SEQ) + v] = 0.f;
                __syncthreads();
                float asum = filter_taps(F, H2, w3c, Df, kt, v, SEQ, fabsf(hy_decay[v * 512 + c]), fabsf(hy_decay[v * 512 + 256 + c]), v);
                asum = wave_sum(asum);
                if (F.lane == 0) red[v * 8 + F.wave] = asum;
                __syncthreads();
                float tot = 0.f;
#pragma unroll
                for (int w = 0; w < 8; ++w) tot += red[v * 8 + w];
                inv[v] = (1.0f / 16384.0f) / tot;
            }
#pragma unroll 1
            for (int i = 0; i < 8; ++i) fft_first4_inplace(D, F.tid + 512 * i);
            __syncthreads();
            { fft_fwd16(D, F.tid, 4096); fft_fwd16(D, F.tid + 512, 4096); }
            __syncthreads();
            { fft_fwd16(D, F.tid, 256); fft_fwd16(D, F.tid + 512, 256); }
            __syncthreads();
            _Pragma("unroll 1") for (int g_ = F.tid; g_ < 1024; g_ += 512) fft_last16_inplace(D, g_);
            __syncthreads();
            fft_f32x4o* out0 = (fft_f32x4o*)(KHAT + (size_t)c * 16384); fft_f32x4o* out1 = (fft_f32x4o*)(KHAT + (size_t)(256 + c) * 16384);
#pragma unroll 1
            for (int g = F.tid; g < 1024; g += 512) {
#pragma unroll
                for (int pp = 0; pp < 8; ++pp) { fft_f32x4o k0, k1;
#pragma unroll
                    for (int e = 0; e < 2; ++e) { const int pos = 16 * g + 2 * pp + e; const int fm = (16384 - fft_freq_of(pos)) & 16383; const int pq = fft_pos_of(fm);
                        const c32 z = FFT_LD(D, 17 * g + 2 * pp + e), zp = FFT_LD(D, fpad(pq));
                        k0[2 * e] = 0.5f * (z.x + zp.x) * inv[0]; k0[2 * e + 1] = 0.5f * (z.y - zp.y) * inv[0];
                        k1[2 * e] = 0.5f * (z.y + zp.y) * inv[1]; k1[2 * e + 1] = 0.5f * (zp.x - z.x) * inv[1]; }
                    const int oi = ((g >> 6) * 8 + pp) * 64 + (g & 63); out0[oi] = k0; out1[oi] = k1; }
            }
        } else {
            if (F.tid < 128) w3c[F.tid] = hy_w3[(size_t)(F.tid & 63) * 512 + (F.tid >> 6) * 256 + c];
            if (F.tid == 0) kt[CTXL] = 0.f;
            __syncthreads();
            float asum = filter_taps(F, H2, w3c, Df, kt, 2, CTXL, fabsf(hy_decay[c]), fabsf(hy_decay[256 + c]), 2);
            asum = wave_sum(asum);
            if (F.lane == 0) red[F.wave] = asum;
            __syncthreads();
            float tot = 0.f;
#pragma unroll
            for (int w = 0; w < 8; ++w) tot += red[w];
            const float invc = 1.0f / tot;
            float* dst = KFC + (size_t)c * 512;
            for (int j = F.tid; j < 2 * CTXL; j += NTHR) dst[j] = kt[j] * invc;
        }
        __syncthreads();
    }
}

__device__ __forceinline__ void ph_norm_mod(const Frame& F, int l, const float* x, const float* ctx, const float* gmix) {
    const float* XR = (const float*)(F.ws + WS_XR); const float* MOD = (const float*)(F.ws + WS_MOD); bf16* H = (bf16*)(F.ws + WS_H);
    for (int r = F.gw; r < MT; r += F.ngw) {
        const float* src = (l == 0) ? (r < NLAT ? x + (size_t)r * 1024 : ctx + (size_t)(r - NLAT) * 1024) : XR + (size_t)r * 1024;
        const int bidx = r < NLAT ? r / SEQ : 4;
        const float* shift = MOD + (size_t)(l * 5 + bidx) * 6144; const float* scale = shift + 1024; const float* g = gmix + l * 1024;
        f32x4 v[4]; float ss = 0.f;
#pragma unroll
        for (int j = 0; j < 4; ++j) { v[j] = ((const f32x4*)src)[64 * j + F.lane]; ss += (v[j].x * v[j].x + v[j].y * v[j].y) + (v[j].z * v[j].z + v[j].w * v[j].w); }
        const float rstd = 1.0f / sqrtf(wave_sum(ss) * (1.0f / 1024.0f) + EPSN);
#pragma unroll
        for (int j = 0; j < 4; ++j) { const int cb = 64 * j + F.lane; const f32x4 gg = ((const f32x4*)g)[cb], sc = ((const f32x4*)scale)[cb], sh = ((const f32x4*)shift)[cb];
            const f32x4 y = v[j] * rstd * gg * (sc + 1.0f) + sh;
            v2u o; o.x = pk2(y.x, y.y); o.y = pk2(y.z, y.w); ((v2u*)(H + (size_t)r * 1024))[cb] = o; }
    }
}

__device__ __forceinline__ void post_ab(const Frame& F, int l, int rbeg, int rend, int w0, int nw, const float* kg_, const float* lru_cw, const float* lru_cb) {
    const bf16* U = (const bf16*)(F.ws + WS_U);
    {
        bf16* K = (bf16*)(F.ws + WS_K); bf16* V = (bf16*)(F.ws + WS_V);
        const float* RC = (const float*)(F.ws + WS_ROPEC); const float* RS = (const float*)(F.ws + WS_ROPES);
        const int o8 = 8 * (F.lane & 7), hl = F.lane & 31;
        const f32x4 kg0 = *(const f32x4*)(kg_ + l * 64 + o8), kg1 = *(const f32x4*)(kg_ + l * 64 + o8 + 4);
        const bool lohalf = (F.lane & 4) == 0;
        for (int r2 = rbeg + 2 * w0; r2 < rend; r2 += 2 * nw) {
            const int r = r2 + (F.lane >> 5);
            const bool isctx = r >= NLAT; const int b = isctx ? (r - NLAT) / CTXL : r / SEQ; const int t = isctx ? (r - NLAT) % CTXL : r % SEQ;
            const v4u wk = ((const v4u*)(U + (size_t)r * INW + 512))[hl];
            f32x4 c0 = {1.f, 1.f, 1.f, 1.f}, c1 = c0, s0 = {0.f, 0.f, 0.f, 0.f}, s1 = s0;
            if (!isctx) { const float* rc = RC + t * 32 + 8 * (F.lane & 3); const float* rs = RS + t * 32 + 8 * (F.lane & 3);
                c0 = *(const f32x4*)rc; c1 = *(const f32x4*)(rc + 4); s0 = *(const f32x4*)rs; s1 = *(const f32x4*)(rs + 4); }
            const size_t krow = (size_t)b * KEYS + (isctx ? t : CTXL + t);
            float x[8] = {bflo(wk.x), bfhi(wk.x), bflo(wk.y), bfhi(wk.y), bflo(wk.z), bfhi(wk.z), bflo(wk.w), bfhi(wk.w)};
            float ss = 0.f;
#pragma unroll
            for (int i = 0; i < 8; ++i) ss += x[i] * x[i];
            ss += __shfl_xor(ss, 1); ss += __shfl_xor(ss, 2); ss += __shfl_xor(ss, 4);
            const float rstd = 1.0f / sqrtf(ss * (1.0f / 64.0f) + EPSN);
            float y[8], o[8];
#pragma unroll
            for (int i = 0; i < 8; ++i) y[i] = x[i] * rstd * (i < 4 ? kg0[i] : kg1[i - 4]);
#pragma unroll
            for (int i = 0; i < 8; ++i) { const float p = __shfl_xor(y[i], 4); const float cs = i < 4 ? c0[i] : c1[i - 4], sn = i < 4 ? s0[i] : s1[i - 4];
                o[i] = lohalf ? (y[i] * cs - p * sn) : (y[i] * cs + p * sn); }
            v4u ow; ow.x = pk2(o[0], o[1]); ow.y = pk2(o[2], o[3]); ow.z = pk2(o[4], o[5]); ow.w = pk2(o[6], o[7]);
            if (hl < 16) ((v4u*)(K + krow * 128))[hl] = ow; else ((v4u*)(V + krow * 128))[hl - 16] = wk;
        }
    }
    {
        bf16* XL = (bf16*)(F.ws + WS_XL);
        for (int idx = rbeg * 32 + w0 * 64 + F.lane; idx < rend * 32; idx += nw * 64) {
            const int r = idx >> 5, c8 = (idx & 31) * 8;
            const bool isctx = r >= NLAT; const int Ls = isctx ? CTXL : SEQ; const int t = isctx ? (r - NLAT) % CTXL : r % SEQ;
            float acc[8];
#pragma unroll
            for (int i = 0; i < 8; ++i) acc[i] = lru_cb[l * 256 + c8 + i];
#pragma unroll
            for (int j = 0; j < 4; ++j) { const int tj = t + j - 2;
                if (tj >= 0 && tj < Ls) { const v4u w = *(const v4u*)(U + (size_t)(r + j - 2) * INW + 768 + c8);
                    const f32x4 w0 = *(const f32x4*)(lru_cw + (l * 4 + j) * 256 + c8), w1 = *(const f32x4*)(lru_cw + (l * 4 + j) * 256 + c8 + 4);
                    acc[0] += w0.x * bflo(w.x); acc[1] += w0.y * bfhi(w.x); acc[2] += w0.z * bflo(w.y); acc[3] += w0.w * bfhi(w.y);
                    acc[4] += w1.x * bflo(w.z); acc[5] += w1.y * bfhi(w.z); acc[6] += w1.z * bflo(w.w); acc[7] += w1.w * bfhi(w.w); } }
            v4u o; o.x = pk2(acc[0], acc[1]); o.y = pk2(acc[2], acc[3]); o.z = pk2(acc[4], acc[5]); o.w = pk2(acc[6], acc[7]);
            *(v4u*)(XL + (size_t)r * 256 + c8) = o;
        }
    }
}
__device__ __forceinline__ void post_c(const Frame& F, int l, const float* hy_cw, const float* hy_cb) {
    const bf16* U = (const bf16*)(F.ws + WS_U);
    __syncthreads();
    {
        LAS bf16* hs = (LAS bf16*)(F.lds);
        bf16* VT = (bf16*)(F.ws + WS_VT); bf16* X0T = (bf16*)(F.ws + WS_X0T);
        const float* cw = hy_cw + (size_t)l * 3 * 768; const float* cbp = hy_cb + l * 768;
        for (int it = blockIdx.x; it < NLAT / 64; it += F.G) {
            const int b = it >> 7, t0 = (it & 127) * 64;
            for (int i = F.tid; i < 66 * 384; i += NTHR) { const int rr = i / 384, c2 = i - rr * 384; const int t = t0 - 1 + rr;
                unsigned w = 0u; if (t >= 0 && t < SEQ) w = *(const unsigned*)(U + (size_t)(b * SEQ + t) * INW + 1280 + 2 * c2);
                *(LAS unsigned*)(hs + rr * 770 + 2 * c2) = w; }
            __syncthreads();
            for (int c2 = F.wave; c2 < 128; c2 += NWAVES) {
                const int c = 2 * c2 + (F.lane >> 5), tt = 2 * (F.lane & 31);
                float o[3][2];
#pragma unroll
                for (int g = 0; g < 3; ++g) { const int cc = g * 256 + c; const float w0 = cw[cc], w1 = cw[768 + cc], w2 = cw[1536 + cc], bb = cbp[cc];
                    const float x0 = bf2f(hs[tt * 770 + cc]), x1 = bf2f(hs[(tt + 1) * 770 + cc]), x2 = bf2f(hs[(tt + 2) * 770 + cc]), x3 = bf2f(hs[(tt + 3) * 770 + cc]);
                    o[g][0] = w0 * x0 + w1 * x1 + w2 * x2 + bb; o[g][1] = w0 * x1 + w1 * x2 + w2 * x3 + bb; }
                const size_t oi = ((size_t)b * 256 + c) * SEQ + t0 + tt;
                *(unsigned*)(VT + oi) = pk2(o[2][0] * o[1][0], o[2][1] * o[1][1]); *(unsigned*)(X0T + oi) = pk2(o[0][0], o[0][1]);
            }
            __syncthreads();
        }
    }
}


typedef short sk_s16x8 __attribute__((ext_vector_type(8)));
__device__ __forceinline__ void ph_lru_gates(const Frame& F, int l, const float* lru_gb, int rt0, int nrt, int w0, int nw) {
    const bf16* XL = (const bf16*)(F.ws + WS_XL); const bf16* WG = (const bf16*)(F.ws + WS_WGT) + (size_t)l * 1024 * 256; bf16* LAB = (bf16*)(F.ws + WS_LAB);
    const float* gb = lru_gb + (size_t)l * 1024; const float* spt = (const float*)(F.ws + WS_SPT) + l * 512;
    const int fr = F.lane & 15, fq = F.lane >> 4;
    for (int it = w0; it < nrt * 8; it += nw) {
        const int rt = rt0 + (it >> 3), n = (it >> 1) & 3, d = it & 1, row0 = 32 * rt;
        const int wrow = ((2 * d + (n >> 1)) * 256 + 64 * (n & 1) + fr) * 256 + 64 * n + 8 * fq;
        const bf16* ap = XL + (size_t)(row0 + fr) * 256 + 64 * n + 8 * fq;
        const bf16* xp = XL + (size_t)(row0 + fr) * 256 + 64 * n + 4 * fq;
        sk_s16x8 a[2][2]; v2u xw[2][4];
#pragma unroll
        for (int ri = 0; ri < 2; ++ri) { a[ri][0] = *(const sk_s16x8*)(ap + ri * 16 * 256); a[ri][1] = *(const sk_s16x8*)(ap + ri * 16 * 256 + 32);
#pragma unroll
            for (int c = 0; c < 4; ++c) xw[ri][c] = *(const v2u*)(xp + ri * 16 * 256 + 16 * c); }
        f32x4 acc[2][4][2];
#pragma unroll
        for (int c = 0; c < 4; ++c)
#pragma unroll
            for (int g = 0; g < 2; ++g) { const bf16* bp = WG + wrow + (g * 128 + 16 * c) * 256;
                const sk_s16x8 b0 = *(const sk_s16x8*)bp, b1 = *(const sk_s16x8*)(bp + 32);
#pragma unroll
                for (int ri = 0; ri < 2; ++ri) { f32x4 z = {0.f, 0.f, 0.f, 0.f};
                    z = __builtin_amdgcn_mfma_f32_16x16x32_bf16(b0, a[ri][0], z, 0, 0, 0); acc[ri][c][g] = __builtin_amdgcn_mfma_f32_16x16x32_bf16(b1, a[ri][1], z, 0, 0, 0); } }
        bf16* LA = LAB + (size_t)(2 * d) * LAB_STRIDE; bf16* LB = LAB + (size_t)(2 * d + 1) * LAB_STRIDE;
#pragma unroll
        for (int c = 0; c < 4; ++c) { const int ch = 64 * n + 16 * c + 4 * fq;
            const f32x4 bR = *(const f32x4*)(gb + (d * 2 + 0) * 256 + ch), bI = *(const f32x4*)(gb + (d * 2 + 1) * 256 + ch);
            const f32x4 sp = *(const f32x4*)(spt + d * 256 + ch) * (-8.0f * 1.4426950408889634f);
#pragma unroll
            for (int ri = 0; ri < 2; ++ri) { const size_t ro = (size_t)(row0 + 16 * ri + fr) * 256 + ch;
                const float xl[4] = {bflo(xw[ri][c].x), bfhi(xw[ri][c].x), bflo(xw[ri][c].y), bfhi(xw[ri][c].y)};
                const f32x4 gr = acc[ri][c][0] + bR, gi = acc[ri][c][1] + bI; float av[4], bv[4];
#pragma unroll
                for (int e = 0; e < 4; ++e) {
                    const float rg = __builtin_amdgcn_rcpf(1.0f + __builtin_amdgcn_exp2f(-1.4426950408889634f * gr[e])), ig = __builtin_amdgcn_rcpf(1.0f + __builtin_amdgcn_exp2f(-1.4426950408889634f * gi[e]));
                    const float la2 = rg * sp[e]; const float a2 = __builtin_amdgcn_exp2f(2.0f * la2);
                    av[e] = la2; bv[e] = __builtin_amdgcn_sqrtf(fmaxf(1.0f - a2, 0.f)) * (ig * xl[e]); }
                v2u wa, wb; wa.x = pk2(av[0], av[1]); wa.y = pk2(av[2], av[3]); wb.x = pk2(bv[0], bv[1]); wb.y = pk2(bv[2], bv[3]);
                *(v2u*)(LA + ro) = wa; *(v2u*)(LB + ro) = wb; } }
    }
}

__device__ __forceinline__ int chunk_row0(int b, int d, int k) {
    if (k < 2) { const int cc = d ? 1 - k : k; return NLAT + b * CTXL + cc * CHUNK; }
    const int lc = d ? 63 - (k - 2) : (k - 2); return b * SEQ + lc * CHUNK;
}
template <bool TWO> __device__ __forceinline__ void scan1_items(const bf16* LAB, float* SUMP, float* SUMH, int it0, int it1) {
    const bf16* LA[2]; const bf16* LB[2]; int r0[2], dd[2];
#pragma unroll
    for (int q = 0; q < (TWO ? 2 : 1); ++q) { const int it = q ? it1 : it0;
        const int ch = it & 255, k = (it >> 8) % NCHUNK, bd = (it >> 8) / NCHUNK, d = bd & 1, b = bd >> 1;
        r0[q] = chunk_row0(b, d, k); dd[q] = d;
        LA[q] = LAB + (size_t)(2 * d) * LAB_STRIDE + ch; LB[q] = LAB + (size_t)(2 * d + 1) * LAB_STRIDE + ch; }
    float h[2] = {0.f, 0.f}, Ps[2] = {0.f, 0.f};
#pragma unroll 16
    for (int i = 0; i < CHUNK; ++i) {
#pragma unroll
        for (int q = 0; q < (TWO ? 2 : 1); ++q) { const int r = dd[q] ? r0[q] + CHUNK - 1 - i : r0[q] + i; const float la = bf2f(LA[q][(size_t)r * 256]), bx = bf2f(LB[q][(size_t)r * 256]); h[q] = __builtin_amdgcn_exp2f(la) * h[q] + bx; Ps[q] += la; } }
    SUMP[it0] = __builtin_amdgcn_exp2f(Ps[0]); SUMH[it0] = h[0];
    if (TWO) { SUMP[it1] = __builtin_amdgcn_exp2f(Ps[1]); SUMH[it1] = h[1]; }
}
__device__ __forceinline__ void ph_scan1(const Frame& F) {
    const bf16* LAB = (const bf16*)(F.ws + WS_LAB); float* SUMP = (float*)(F.ws + WS_SCANS); float* SUMH = SUMP + NB * 2 * NCHUNK * 256;
    const int total = NB * 2 * NCHUNK * 256, nthr = F.G * NTHR;
    for (int it = blockIdx.x * NTHR + F.tid; it < total; it += 2 * nthr) {
        if (it + nthr < total) scan1_items<true>(LAB, SUMP, SUMH, it, it + nthr); else scan1_items<false>(LAB, SUMP, SUMH, it, it);
    }
}
__device__ __forceinline__ void ph_scan2(const Frame& F) {
    const bf16* LAB = (const bf16*)(F.ws + WS_LAB); const float* SUMP = (const float*)(F.ws + WS_SCANS); const float* SUMH = SUMP + NB * 2 * NCHUNK * 256;
    bf16* HD = (bf16*)(F.ws + WS_LRUO);
    const int total = NB * 2 * NCHUNK * 128, per = (total + F.G - 1) / F.G;
    const int it = blockIdx.x * per + F.tid;
    if (F.tid < per && it < total) {
        const int ch = 2 * (it & 127), k = (it >> 7) % NCHUNK, bd = (it >> 7) / NCHUNK, d = bd & 1, b = bd >> 1;
        const int r0 = chunk_row0(b, d, k);
        const f32x2v* P = (const f32x2v*)(SUMP + (size_t)(bd * NCHUNK) * 256 + ch); const f32x2v* S = (const f32x2v*)(SUMH + (size_t)(bd * NCHUNK) * 256 + ch);
        float h0 = 0.f, h1 = 0.f;
#pragma unroll 8
        for (int j = 0; j < k; ++j) { const f32x2v p = P[(size_t)j * 128], q = S[(size_t)j * 128]; h0 = p.x * h0 + q.x; h1 = p.y * h1 + q.y; }
        const unsigned* __restrict__ LA = (const unsigned*)(LAB + (size_t)(2 * d) * LAB_STRIDE + ch); const unsigned* __restrict__ LB = (const unsigned*)(LAB + (size_t)(2 * d + 1) * LAB_STRIDE + ch);
        unsigned* __restrict__ HO = (unsigned*)(HD + (size_t)d * MT * 256 + ch);
#pragma unroll 16
        for (int i = 0; i < CHUNK; ++i) { const size_t r = (size_t)(d ? r0 + CHUNK - 1 - i : r0 + i) * 128; const unsigned la = LA[r], lb = LB[r];
            h0 = __builtin_amdgcn_exp2f(bflo(la)) * h0 + bflo(lb); h1 = __builtin_amdgcn_exp2f(bfhi(la)) * h1 + bfhi(lb); HO[r] = pk2(h0, h1); }
    }
}

__device__ __forceinline__ void ph_hyena_fft(const Frame& F, int l, const float* hy_bias) {
    LAS f32x2v* D = (LAS f32x2v*)(F.lds);
    const c32* KHAT = (const c32*)(F.ws + WS_KHAT) + (size_t)l * 256 * 16384;
    const bf16* VT = (const bf16*)(F.ws + WS_VT); const bf16* X0T = (const bf16*)(F.ws + WS_X0T); bf16* HYO = (bf16*)(F.ws + WS_HYO);
    for (int it = blockIdx.x; it < 512; it += F.G) {
        const int c = it >> 1, bp = it & 1;
        const bf16* va = VT + ((size_t)(bp * 2) * 256 + c) * SEQ; const bf16* vb = VT + ((size_t)(bp * 2 + 1) * 256 + c) * SEQ;
        {
            unsigned pa[4], pb[4], pc[4], pd[4];
#pragma unroll
            for (int i = 0; i < 4; ++i) { const int j = 2 * F.tid + 1024 * i; pa[i] = *(const unsigned*)(va + j); pb[i] = *(const unsigned*)(vb + j); pc[i] = *(const unsigned*)(va + j + 4096); pd[i] = *(const unsigned*)(vb + j + 4096); }
#pragma unroll
            for (int i = 0; i < 4; ++i) { const int j = 2 * F.tid + 1024 * i; c32 x0, x1, z; z.x = 0.f; z.y = 0.f;
                x0.x = bflo(pa[i]); x0.y = bflo(pb[i]); x1.x = bflo(pc[i]); x1.y = bflo(pd[i]); fft_first4(D, j, x0, x1, z, z);
                x0.x = bfhi(pa[i]); x0.y = bfhi(pb[i]); x1.x = bfhi(pc[i]); x1.y = bfhi(pd[i]); fft_first4(D, j + 1, x0, x1, z, z); }
        }
        __syncthreads();
        { fft_fwd16(D, F.tid, 4096); fft_fwd16(D, F.tid + 512, 4096); }
        __syncthreads();
        { fft_fwd16(D, F.tid, 256); fft_fwd16(D, F.tid + 512, 256); }
        __syncthreads();
        { fft_f32x4 kv0[8]; const fft_f32x4* kp = (const fft_f32x4*)(KHAT + (size_t)c * 16384);
#pragma unroll
          for (int q = 0; q < 8; ++q) kv0[q] = kp[((F.tid >> 6) * 8 + q) * 64 + (F.tid & 63)];
          fft_mid16k(D, F.tid, kv0); __builtin_amdgcn_sched_barrier(0);
#pragma unroll
          for (int q = 0; q < 8; ++q) kv0[q] = kp[(((F.tid + 512) >> 6) * 8 + q) * 64 + (F.tid & 63)];
          fft_mid16k(D, F.tid + 512, kv0); }
        __syncthreads();
        { fft_inv16(D, F.tid, 256); fft_inv16(D, F.tid + 512, 256); }
        __syncthreads();
        { fft_inv16(D, F.tid, 4096); fft_inv16(D, F.tid + 512, 4096); }
        __syncthreads();
        const bf16* xa = X0T + ((size_t)(bp * 2) * 256 + c) * SEQ; const bf16* xb = X0T + ((size_t)(bp * 2 + 1) * 256 + c) * SEQ;
        unsigned pa[4], pb[4], pc[4], pd[4], qa[4], qb[4], qc[4], qd[4];
#pragma unroll
        for (int i = 0; i < 4; ++i) { const int j = 2 * F.tid + 1024 * i; pa[i] = *(const unsigned*)(va + j); pb[i] = *(const unsigned*)(vb + j); pc[i] = *(const unsigned*)(va + j + 4096); pd[i] = *(const unsigned*)(vb + j + 4096);
            qa[i] = *(const unsigned*)(xa + j); qb[i] = *(const unsigned*)(xb + j); qc[i] = *(const unsigned*)(xa + j + 4096); qd[i] = *(const unsigned*)(xb + j + 4096); }
        const float bias = hy_bias[l * 256 + c];
        bf16* oa = HYO + ((size_t)(bp * 2) * 256 + c) * SEQ; bf16* ob = HYO + ((size_t)(bp * 2 + 1) * 256 + c) * SEQ;
#pragma unroll
        for (int i = 0; i < 4; ++i) { const int j = 2 * F.tid + 1024 * i; c32 u0, u1, w0, w1; fft_final4(D, j, u0, u1); fft_final4(D, j + 1, w0, w1);
            *(unsigned*)(oa + j) = pk2((u0.x + bflo(pa[i]) * bias) * bflo(qa[i]), (w0.x + bfhi(pa[i]) * bias) * bfhi(qa[i]));
            *(unsigned*)(ob + j) = pk2((-u0.y + bflo(pb[i]) * bias) * bflo(qb[i]), (-w0.y + bfhi(pb[i]) * bias) * bfhi(qb[i]));
            *(unsigned*)(oa + j + 4096) = pk2((u1.x + bflo(pc[i]) * bias) * bflo(qc[i]), (w1.x + bfhi(pc[i]) * bias) * bfhi(qc[i]));
            *(unsigned*)(ob + j + 4096) = pk2((-u1.y + bflo(pd[i]) * bias) * bflo(qd[i]), (-w1.y + bfhi(pd[i]) * bias) * bfhi(qd[i])); }
        __syncthreads();
    }
}
__device__ __forceinline__ void ph_hyena_ctx(const Frame& F, const float* hy_bias, const float* hy_cw, const float* hy_cb) {
    float* HYO = (float*)(F.ws + WS_HYO);
    {

        const bf16* U = (const bf16*)(F.ws + WS_U); const float* KFC = (const float*)(F.ws + WS_KFC);
        LAS float* vw = (LAS float*)(F.lds + F.wave * 4096);
        LAS float* kw = vw + 256;
        const float* cw = hy_cw; const float* cbp = hy_cb;
        for (int it = F.gw; it < NB * 256; it += F.ngw) {
            const int b = it >> 8, c = it & 255;
            float x0v[4];
#pragma unroll
            for (int i = 0; i < 4; ++i) { const int t = F.lane + 64 * i;
                float o[3];
#pragma unroll
                for (int g = 0; g < 3; ++g) { const int cc = g * 256 + c; float a = cbp[cc];
#pragma unroll
                    for (int j = 0; j < 3; ++j) { const int tj = t + j - 1; if (tj >= 0 && tj < CTXL) a += cw[j * 768 + cc] * bf2f(U[(size_t)(NLAT + b * CTXL + tj) * INW + 1280 + cc]); }
                    o[g] = a; }
                vw[t] = o[2] * o[1]; x0v[i] = o[0]; }
#pragma unroll
            for (int i = 0; i < 8; ++i) kw[F.lane + 64 * i] = KFC[c * 512 + F.lane + 64 * i];
            LDS_WAIT();
            float y[4] = {0.f, 0.f, 0.f, 0.f};
#pragma unroll 4
            for (int s = 0; s < CTXL; ++s) { const float vv = vw[s];
#pragma unroll
                for (int i = 0; i < 4; ++i) y[i] += kw[(F.lane + 64 * i - s) & 511] * vv; }
            const float bias = hy_bias[c];
#pragma unroll
            for (int i = 0; i < 4; ++i) { const int t = F.lane + 64 * i; HYO[(size_t)(NLAT + b * CTXL + t) * 256 + c] = (y[i] + vw[t] * bias) * x0v[i]; }
            LDS_WAIT();
        }
    }
}

__device__ __forceinline__ void merge_row(const Frame& F, int r, const float* g, float h0, float h1, float h2, float h3) {
    const bf16* ATT = (const bf16*)(F.ws + WS_ATT); const bf16* HD = (const bf16*)(F.ws + WS_LRUO); const bf16* Ug = (const bf16*)(F.ws + WS_U); bf16* MIXA = (bf16*)(F.ws + WS_MIXA);
    const v4u aw = ((const v4u*)(ATT + (size_t)r * 512))[F.lane];
    float a[8] = {bflo(aw.x), bfhi(aw.x), bflo(aw.y), bfhi(aw.y), bflo(aw.z), bfhi(aw.z), bflo(aw.w), bfhi(aw.w)};
    float ss = 0.f;
#pragma unroll
    for (int i = 0; i < 8; ++i) ss += a[i] * a[i];
    const float ra = 1.0f / sqrtf(wave_sum(ss) * (1.0f / 512.0f) + EPSN);
    f32x4 lv; { const v2u hf = ((const v2u*)(HD + (size_t)r * 256))[F.lane], hb = ((const v2u*)(HD + (size_t)MT * 256 + (size_t)r * 256))[F.lane], gw = ((const v2u*)(Ug + (size_t)r * INW + 1024))[F.lane];
        lv.x = (bflo(hf.x) + bflo(hb.x)) * gelu_tanh(bflo(gw.x)); lv.y = (bfhi(hf.x) + bfhi(hb.x)) * gelu_tanh(bfhi(gw.x)); lv.z = (bflo(hf.y) + bflo(hb.y)) * gelu_tanh(bflo(gw.y)); lv.w = (bfhi(hf.y) + bfhi(hb.y)) * gelu_tanh(bfhi(gw.y)); }
    const float rl = 1.0f / sqrtf(wave_sum(lv.x * lv.x + lv.y * lv.y + lv.z * lv.z + lv.w * lv.w) * (1.0f / 256.0f) + EPSN);
    const float rh = 1.0f / sqrtf(wave_sum(h0 * h0 + h1 * h1 + h2 * h2 + h3 * h3) * (1.0f / 256.0f) + EPSN);
    bf16* orow = MIXA + (size_t)r * 1024;
    { const f32x4 g0 = ((const f32x4*)g)[2 * F.lane], g1 = ((const f32x4*)g)[2 * F.lane + 1];
      v4u o; o.x = pk2(a[0] * ra * g0.x, a[1] * ra * g0.y); o.y = pk2(a[2] * ra * g0.z, a[3] * ra * g0.w); o.z = pk2(a[4] * ra * g1.x, a[5] * ra * g1.y); o.w = pk2(a[6] * ra * g1.z, a[7] * ra * g1.w);
      ((v4u*)orow)[F.lane] = o; }
    { const f32x4 gg = ((const f32x4*)(g + 512))[F.lane]; v2u o; o.x = pk2(lv.x * rl * gg.x, lv.y * rl * gg.y); o.y = pk2(lv.z * rl * gg.z, lv.w * rl * gg.w); ((v2u*)(orow + 512))[F.lane] = o; }
    { const f32x2v ga = *(const f32x2v*)(g + 768 + 2 * F.lane), gb = *(const f32x2v*)(g + 896 + 2 * F.lane);
      *(unsigned*)(orow + 768 + 2 * F.lane) = pk2(h0 * rh * ga.x, h1 * rh * ga.y); *(unsigned*)(orow + 896 + 2 * F.lane) = pk2(h2 * rh * gb.x, h3 * rh * gb.y); }
}
__device__ __forceinline__ void ph_merge(const Frame& F, int l, int nrows, const float* out_g) {
    const float* HYO = (const float*)(F.ws + WS_HYO);
    const float* g = out_g + l * 1024;
    LAS float* tile = (LAS float*)(F.lds);
    for (int it = blockIdx.x; it < NLAT / 64; it += F.G) {
        const int b = it >> 7, t0 = (it & 127) * 64;
#pragma unroll 8
        for (int i = 0; i < 32; ++i) { const int c = F.wave * 32 + i; tile[c * 65 + F.lane] = bf2f(((const bf16*)HYO)[((size_t)b * 256 + c) * SEQ + t0 + F.lane]); }
        __syncthreads();
#pragma unroll 2
        for (int k = 0; k < 8; ++k) { const int tt = F.wave * 8 + k;
            merge_row(F, b * SEQ + t0 + tt, g, tile[(2 * F.lane) * 65 + tt], tile[(2 * F.lane + 1) * 65 + tt], tile[(128 + 2 * F.lane) * 65 + tt], tile[(129 + 2 * F.lane) * 65 + tt]); }
        __syncthreads();
    }
    for (int r = NLAT + F.gw; r < nrows; r += F.ngw) {
        const float* hr = HYO + (size_t)r * 256;
        merge_row(F, r, g, hr[2 * F.lane], hr[2 * F.lane + 1], hr[128 + 2 * F.lane], hr[129 + 2 * F.lane]);
    }
}


constexpr int RW_PITCH = 34;
__device__ __forceinline__ void router_cols(LAS const float* rwl, const bf16* XR, const float* gc, const float* sf, unsigned char* Fbytes, int r, float rstd, int j, int kq, int i0, int i1, f32x4& acc0, f32x4& acc1) {
    const bf16* xrow = XR + (size_t)r * 1024 + 8 * kq; const float* gcp = gc + 8 * kq; const float* sfp = sf + 8 * kq;
    v4u xn[4];
#pragma unroll
    for (int u = 0; u < 4; ++u) xn[u] = *(const v4u*)(xrow + 32 * (i0 + u));
#pragma unroll 1
    for (int ib = i0; ib < i1; ib += 4) {
        v4u xw[4]; f32x4 g4[4][2], s4[4][2];
#pragma unroll
        for (int u = 0; u < 4; ++u) { xw[u] = xn[u]; g4[u][0] = *(const f32x4*)(gcp + 32 * (ib + u)); g4[u][1] = *(const f32x4*)(gcp + 32 * (ib + u) + 4); s4[u][0] = *(const f32x4*)(sfp + 32 * (ib + u)); s4[u][1] = *(const f32x4*)(sfp + 32 * (ib + u) + 4); }
        if (ib + 4 < i1) {
#pragma unroll
            for (int u = 0; u < 4; ++u) xn[u] = *(const v4u*)(xrow + 32 * (ib + 4 + u)); }
#pragma unroll
        for (int u = 0; u < 4; ++u) {
            const float x[8] = {bflo(xw[u].x), bfhi(xw[u].x), bflo(xw[u].y), bfhi(xw[u].y), bflo(xw[u].z), bfhi(xw[u].z), bflo(xw[u].w), bfhi(xw[u].w)};
            float xb[8], fv[8];
#pragma unroll
            for (int e = 0; e < 8; ++e) { xb[e] = x[e] * g4[u][e >> 2][e & 3]; fv[e] = xb[e] * rstd + s4[u][e >> 2][e & 3]; }
#if MOE_FP8
            v2u o; o.x = pg8::pack4_fp8(fv[0] * pg8::F8_SF, fv[1] * pg8::F8_SF, fv[2] * pg8::F8_SF, fv[3] * pg8::F8_SF); o.y = pg8::pack4_fp8(fv[4] * pg8::F8_SF, fv[5] * pg8::F8_SF, fv[6] * pg8::F8_SF, fv[7] * pg8::F8_SF);
            *(v2u*)(Fbytes + (size_t)r * 1024 + 8 * kq + 32 * (ib + u)) = o;
#else
            v4u o; o.x = pk2(fv[0], fv[1]); o.y = pk2(fv[2], fv[3]); o.z = pk2(fv[4], fv[5]); o.w = pk2(fv[6], fv[7]); *(v4u*)((bf16*)Fbytes + (size_t)r * 1024 + 8 * kq + 32 * (ib + u)) = o;
#endif
            const LAS float* wp = rwl + (32 * (ib + u) + 8 * kq) * RW_PITCH + j;
#pragma unroll
            for (int e = 0; e < 8; ++e) { acc0 = __builtin_amdgcn_mfma_f32_16x16x4f32(wp[e * RW_PITCH], xb[e], acc0, 0, 0, 0); acc1 = __builtin_amdgcn_mfma_f32_16x16x4f32(wp[e * RW_PITCH + 16], xb[e], acc1, 0, 0, 0); }
        }
    }
}
__device__ __forceinline__ void router_finish(LAS const float* cbl, LAS int* hist, int* TOPI, float* GATE, int r, int bidx, float rstd, int j, int kq, const f32x4& acc0, const f32x4& acc1) {
    float lg[8];
#pragma unroll
    for (int rr = 0; rr < 4; ++rr) { lg[rr] = rstd * acc0[rr] + cbl[bidx * 32 + 4 * kq + rr]; lg[4 + rr] = rstd * acc1[rr] + cbl[bidx * 32 + 16 + 4 * kq + rr]; }
    float p[32];
#pragma unroll
    for (int e = 0; e < 32; ++e) p[e] = __shfl(lg[(e >> 4) * 4 + (e & 3)], j + 16 * ((e & 15) >> 2));
    unsigned taken = 0u; float tv[4]; int ti[4];
#pragma unroll
    for (int k = 0; k < 4; ++k) { float best = -INFINITY; int bi = 0;
#pragma unroll
        for (int e = 0; e < 32; ++e) { const bool ok = !((taken >> e) & 1u) && (p[e] > best); best = ok ? p[e] : best; bi = ok ? e : bi; }
        taken |= 1u << bi; tv[k] = best; ti[k] = bi; }
    const float e1 = __expf(tv[1] - tv[0]), e2 = __expf(tv[2] - tv[0]), e3 = __expf(tv[3] - tv[0]); const float inv = 1.0f / (1.0f + e1 + e2 + e3);
    if (kq == 0) {
        TOPI[r * 4 + 0] = ti[0]; TOPI[r * 4 + 1] = ti[1]; TOPI[r * 4 + 2] = ti[2]; TOPI[r * 4 + 3] = ti[3];
        GATE[r * 4 + 0] = inv; GATE[r * 4 + 1] = e1 * inv; GATE[r * 4 + 2] = e2 * inv; GATE[r * 4 + 3] = e3 * inv;
        lds_add(&hist[ti[0]], 1); lds_add(&hist[ti[1]], 1); lds_add(&hist[ti[2]], 1); lds_add(&hist[ti[3]], 1);
    }
}
__device__ __forceinline__ void ph_ffn_router(const Frame& F, int l, int nrows, const float* router_w) {
    LAS float* rwl = (LAS float*)(F.lds);
    LAS float* part = (LAS float*)(F.lds + 139264);
    LAS float* cbl = (LAS float*)(F.lds + 153600);
    LAS int* hist = (LAS int*)(F.lds + 153600 + 640);
    const bf16* XR = (const bf16*)(F.ws + WS_XR); const float* RSSP = (const float*)(F.ws + WS_RSSP); const float* MOD = (const float*)(F.ws + WS_MOD);
    const float* GC = (const float*)(F.ws + WS_GC) + (size_t)l * 5 * 1024; unsigned char* Fb = (unsigned char*)(F.ws + WS_F);
    int* TOPI = (int*)(F.ws + WS_TOPI); float* GATE = (float*)(F.ws + WS_GATE); int* BLKCNT = (int*)(F.ws + WS_BLKCNT);
    for (int i = F.tid; i < 1024 * 32; i += NTHR) rwl[(i >> 5) * RW_PITCH + (i & 31)] = router_w[(size_t)l * 32768 + i];
    if (F.tid < 32) hist[F.tid] = 0;
    if (F.tid < 160) cbl[F.tid] = ((const float*)(F.ws + WS_CB))[l * 160 + F.tid];
    __syncthreads();
    const int j = F.lane & 15, kq = F.lane >> 4;
    const int ngrp = nrows / 16, nmain = (ngrp / F.ngw) * F.ngw;
    for (int grp = F.gw; grp < nmain; grp += F.ngw) {
        const int r0 = grp * 16, r = r0 + j; const int bidx = r0 < NLAT ? r0 / SEQ : 4;
        float ss; { const f32x4 q = *(const f32x4*)(RSSP + (size_t)r * 16 + 4 * kq); ss = (q.x + q.y) + (q.z + q.w); }
        ss += __shfl_xor(ss, 16); ss += __shfl_xor(ss, 32);
        const float rstd = 1.0f / sqrtf(ss * (1.0f / 1024.0f) + EPSN);
        f32x4 acc0 = {0.f, 0.f, 0.f, 0.f}, acc1 = acc0;
        router_cols(rwl, XR, GC + bidx * 1024, MOD + (size_t)(l * 5 + bidx) * 6144 + 3 * 1024, Fb, r, rstd, j, kq, 0, 32, acc0, acc1);
        router_finish(cbl, hist, TOPI, GATE, r, bidx, rstd, j, kq, acc0, acc1);
    }
    for (int grp = nmain + (int)blockIdx.x; grp < ngrp; grp += F.G) {
        const int r0 = grp * 16, r = r0 + j; const int bidx = r0 < NLAT ? r0 / SEQ : 4;
        float ss; { const f32x4 q = *(const f32x4*)(RSSP + (size_t)r * 16 + 4 * kq); ss = (q.x + q.y) + (q.z + q.w); }
        ss += __shfl_xor(ss, 16); ss += __shfl_xor(ss, 32);
        const float rstd = 1.0f / sqrtf(ss * (1.0f / 1024.0f) + EPSN);
        f32x4 acc0 = {0.f, 0.f, 0.f, 0.f}, acc1 = acc0;
        router_cols(rwl, XR, GC + bidx * 1024, MOD + (size_t)(l * 5 + bidx) * 6144 + 3 * 1024, Fb, r, rstd, j, kq, 4 * F.wave, 4 * F.wave + 4, acc0, acc1);
        if (F.wave > 0) { LAS f32x4* pp = (LAS f32x4*)(part + ((F.wave - 1) * 64 + F.lane) * 8); pp[0] = acc0; pp[1] = acc1; }
        __syncthreads();
        if (F.wave == 0) {
#pragma unroll
            for (int w = 0; w < 7; ++w) { const LAS f32x4* pp = (const LAS f32x4*)(part + (w * 64 + F.lane) * 8); acc0 += pp[0]; acc1 += pp[1]; }
            router_finish(cbl, hist, TOPI, GATE, r, bidx, rstd, j, kq, acc0, acc1);
        }
        __syncthreads();
    }
    __syncthreads();
    if (F.tid < 32) BLKCNT[blockIdx.x * 32 + F.tid] = hist[F.tid];
}

__device__ __forceinline__ void ph_route(const Frame& F, int nrows) {
    LAS int* cursor = (LAS int*)(F.lds);
    LAS int* tot = cursor + 32;
    LAS int* mine = cursor + 64;
    LAS int* part = cursor + 96;
    LAS int* ebase = cursor + 96 + 1024;
    const int* BLKCNT = (const int*)(F.ws + WS_BLKCNT); const int* TOPI = (const int*)(F.ws + WS_TOPI); int* POS = (int*)(F.ws + WS_POS);
    int* ROWTOK = (int*)(F.ws + WS_ROWTOK); int* TILEE = (int*)(F.ws + WS_TILEE);
    { const int e = F.tid & 31, sl = F.tid >> 5; int t = 0, m = 0;
      for (int b = sl; b < F.G; b += 16) { const int v = BLKCNT[b * 32 + e]; t += v; m += (b < (int)blockIdx.x) ? v : 0; }
      part[sl * 64 + e] = t; part[sl * 64 + 32 + e] = m;
      __syncthreads();
      if (F.tid < 32) { int tt = 0, mm = 0;
#pragma unroll
          for (int s = 0; s < 16; ++s) { tt += part[s * 64 + F.tid]; mm += part[s * 64 + 32 + F.tid]; }
          tot[F.tid] = tt; mine[F.tid] = mm; } }
    __syncthreads();
    if (F.tid == 0) { int tb = 0;
        for (int e = 0; e < 32; ++e) { const int nt = (tot[e] + 255) >> 8; cursor[e] = tb * 256 + mine[e]; ebase[e] = tb * 256;
            if (blockIdx.x == 0) for (int j = 0; j < nt; ++j) TILEE[tb + j] = e;
            tb += nt; }
        ebase[32] = tb * 256;
        if (blockIdx.x == 0) F.ctl[CW_NTILES] = (unsigned)tb; }
    __syncthreads();
    for (int e = blockIdx.x; e < 32; e += F.G) for (int p = ebase[e] + tot[e] + F.tid; p < ebase[e + 1]; p += NTHR) ROWTOK[p] = 0;
    const int sub = F.lane >> 2, k = F.lane & 3;
    const int ngrp = nrows / 16, nmain = (ngrp / F.ngw) * F.ngw;
    for (int grp = F.gw; grp < nmain; grp += F.ngw) {
        const int r = grp * 16 + sub; const int e = TOPI[r * 4 + k]; const int pos = lds_add(&cursor[e], 1); POS[r * 4 + k] = pos; ROWTOK[pos] = r; }
    if (F.wave == 0) for (int grp = nmain + (int)blockIdx.x; grp < ngrp; grp += F.G) {
        const int r = grp * 16 + sub; const int e = TOPI[r * 4 + k]; const int pos = lds_add(&cursor[e], 1); POS[r * 4 + k] = pos; ROWTOK[pos] = r; }
}

__device__ __forceinline__ void ph_combine(const Frame& F, int l, int nrows, float* out, const float* gmix) {
    bf16* XR = (bf16*)(F.ws + WS_XR); const float* MOD = (const float*)(F.ws + WS_MOD); const bf16* YS = (const bf16*)(F.ws + WS_YS); bf16* H = (bf16*)(F.ws + WS_H);
    const int* POS = (const int*)(F.ws + WS_POS); const float* GATE = (const float*)(F.ws + WS_GATE);
    for (int r = 2 * F.gw; r < nrows; r += 2 * F.ngw) {
        const int bidx = r < NLAT ? r / SEQ : 4;
        const float* gf = MOD + (size_t)(l * 5 + bidx) * 6144 + 5 * 1024;
        int pos = 0; float gt = 0.f;
        if (F.lane < 8) { pos = POS[r * 4 + F.lane]; gt = GATE[r * 4 + F.lane]; }
        v2u w[2][4][4], xw[2][4]; float gk[2][4];
#pragma unroll
        for (int rr = 0; rr < 2; ++rr)
#pragma unroll
            for (int k = 0; k < 4; ++k) { const int pk = __shfl(pos, rr * 4 + k); gk[rr][k] = __shfl(gt, rr * 4 + k);
#if MOE_FP8
                gk[rr][k] *= (1.0f / pg8::F8_SY); const unsigned* yr = (const unsigned*)((const unsigned char*)YS + (size_t)pk * YS_PITCH);
#pragma unroll
                for (int j = 0; j < 4; ++j) { w[rr][k][j].x = yr[64 * j + F.lane]; w[rr][k][j].y = 0u; } }
#else
                const v2u* yr = (const v2u*)(YS + (size_t)pk * 1024);
#pragma unroll
                for (int j = 0; j < 4; ++j) w[rr][k][j] = yr[64 * j + F.lane]; }
#endif
#pragma unroll
        for (int rr = 0; rr < 2; ++rr)
#pragma unroll
            for (int j = 0; j < 4; ++j) xw[rr][j] = ((const v2u*)(XR + (size_t)(r + rr) * 1024))[64 * j + F.lane];
        f32x4 gv[4];
#pragma unroll
        for (int j = 0; j < 4; ++j) gv[j] = ((const f32x4*)gf)[64 * j + F.lane];
#pragma unroll
        for (int rr = 0; rr < 2; ++rr) {
            const int row = r + rr;
            f32x4 y[4]; float ss = 0.f;
#pragma unroll
            for (int j = 0; j < 4; ++j) { f32x4 a = {0.f, 0.f, 0.f, 0.f};
#pragma unroll
                for (int k = 0; k < 4; ++k) { const v2u ww = w[rr][k][j]; const float g_ = gk[rr][k];
#if MOE_FP8
                    a.x += g_ * __builtin_amdgcn_cvt_f32_fp8((int)ww.x, 0); a.y += g_ * __builtin_amdgcn_cvt_f32_fp8((int)ww.x, 1); a.z += g_ * __builtin_amdgcn_cvt_f32_fp8((int)ww.x, 2); a.w += g_ * __builtin_amdgcn_cvt_f32_fp8((int)ww.x, 3); }
#else
                    a.x += g_ * bflo(ww.x); a.y += g_ * bfhi(ww.x); a.z += g_ * bflo(ww.y); a.w += g_ * bfhi(ww.y); }
#endif
                const f32x4 xv = {bflo(xw[rr][j].x), bfhi(xw[rr][j].x), bflo(xw[rr][j].y), bfhi(xw[rr][j].y)};
                y[j] = xv + gv[j] * a;
                const int cb = 64 * j + F.lane;
                if (l == 0) { v2u o; o.x = pk2(y[j].x, y[j].y); o.y = pk2(y[j].z, y[j].w); ((v2u*)(XR + (size_t)row * 1024))[cb] = o; } else ((f32x4*)(out + (size_t)row * 1024))[cb] = y[j];
                ss += (y[j].x * y[j].x + y[j].y * y[j].y) + (y[j].z * y[j].z + y[j].w * y[j].w); }
            if (l == 0) {
                const float rstd = 1.0f / sqrtf(wave_sum(ss) * (1.0f / 1024.0f) + EPSN);
                const float* shift = MOD + (size_t)(5 + bidx) * 6144; const float* scale = shift + 1024; const float* g = gmix + 1024;
#pragma unroll
                for (int j = 0; j < 4; ++j) { const int cb = 64 * j + F.lane; const f32x4 gg = ((const f32x4*)g)[cb], sc = ((const f32x4*)scale)[cb], sh = ((const f32x4*)shift)[cb];
                    const f32x4 hv = y[j] * rstd * gg * (sc + 1.0f) + sh;
                    v2u o; o.x = pk2(hv.x, hv.y); o.y = pk2(hv.z, hv.w); ((v2u*)(H + (size_t)row * 1024))[cb] = o; }
            }
        }
    }
}

struct Args { const float* in[34]; float* out; unsigned char* ws; int ph_lo, ph_hi; };
enum { I_X = 0, I_C, I_CTX, I_CCTX, I_WMOD, I_BMOD, I_GMIX, I_GFFN, I_WIN, I_QG, I_KG, I_LCW, I_LCB, I_LGW, I_LGB, I_LLAM, I_HCW, I_HCB, I_HW1, I_HB1, I_HW2, I_HB2, I_HW3, I_HFREQ, I_HDEC, I_HBIAS,
       I_OUTG, I_WOUT, I_RW, I_RB, I_MW1, I_MB1, I_MW2, I_MB2 };

__global__ void __launch_bounds__(NTHR, 2) mk_fwd(Args args) {
    extern __shared__ __attribute__((aligned(16))) unsigned char lds[];
    Frame F;
    F.lds = (LAS unsigned char*)lds; F.ws = args.ws; F.ctl = (unsigned*)(args.ws + WS_CTL);
    F.tid = threadIdx.x; F.lane = F.tid & 63; F.wave = __builtin_amdgcn_readfirstlane(F.tid >> 6);
    F.G = gridDim.x; { const int bx = blockIdx.x; F.vcu = (F.G % 8 == 0) ? (bx % 8) * (F.G / 8) + bx / 8 : bx; }
    F.gw = (int)blockIdx.x * NWAVES + F.wave; F.ngw = F.G * NWAVES;
    for (int u = F.tid; u < (LDS_BYTES - LDSCTL_OFF) / 4; u += NTHR) ((LAS unsigned*)(F.lds + LDSCTL_OFF))[u] = 0u;
    __syncthreads();
#if !MK_PER_PHASE
    XcdBarrier bar = xcd_barrier_post(F.ctl + CW_BAR, (volatile LAS unsigned*)(F.lds + LDSCTL_OFF + 32));
#define GRID_BAR() xcd_barrier(bar)
#else
#define GRID_BAR() do { } while (0)
#endif
    const int lo = args.ph_lo, hi = args.ph_hi;
#ifndef ONLY_PHASE
#define ONLY_PHASE (-1)
#endif
#define ENABLED(id) (ONLY_PHASE < 0 || ONLY_PHASE == (id))
#define IN(k) (ENABLED(k) && lo <= (k) && (k) < hi)
#define INL(j) (ENABLED(NPH_PRO + (j)) && lo <= pb + (j) && pb + (j) < hi)
#define SEAML(j) do { if (lo <= pb + (j) && pb + (j) + 1 < hi) { GRID_BAR(); } } while (0)
typedef const __attribute__((address_space(4))) Args* KArgs;
#ifndef REP_MASK
#define REP_MASK 0
#endif
#define NREP(j) (((REP_MASK >> (j)) & 1) ? 2 : 1)
#define REFRAME() Frame Fp = F; KArgs ka = (KArgs)__builtin_amdgcn_kernarg_segment_ptr(); { int t_ = F.tid; asm volatile("" : "+v"(t_), "+s"(ka)); Fp.tid = t_; Fp.lane = t_ & 63; Fp.wave = __builtin_amdgcn_readfirstlane(t_ >> 6); \
    Fp.gw = (int)blockIdx.x * NWAVES + Fp.wave; Fp.ws = ka->ws; Fp.ctl = (unsigned*)(ka->ws + WS_CTL); }
#define SEAM(k) do { if (lo <= (k) && (k) + 1 < hi) { GRID_BAR(); } } while (0)

    if (IN(0)) ph_prologue_a(F, args.in[I_C], args.in[I_CCTX], args.in[I_WMOD], args.in[I_BMOD], args.in[I_WIN], args.in[I_WOUT], args.in[I_MW1], args.in[I_MW2],
                             args.in[I_HW1], args.in[I_HB1], args.in[I_HW2], args.in[I_HB2], args.in[I_HFREQ], args.in[I_LGW], args.in[I_LLAM]);
    SEAM(0);
    if (IN(1)) ph_prologue_b(F, args.in[I_HW3], args.in[I_HDEC], args.in[I_GFFN], args.in[I_RW], args.in[I_RB]);
    SEAM(1);

#if MOE_FP8
#define MOE_EPI1 pg8::EpiSwigluF8
#define MOE_EPI2 pg8::EpiF8BiasF8
#else
#define MOE_EPI1 pg8::EpiSwiglu
#define MOE_EPI2 pg8::EpiBf16Bias
#endif
#ifndef PROBE_MOE2
#define PROBE_MOE2 0
#endif
#ifndef PROBE_MOE2B
#define PROBE_MOE2B 0
#endif
#ifndef PROBE_GEMM_K
#define PROBE_GEMM_K 0
#endif
#ifndef MOE_WGM1
#define MOE_WGM1 4
#endif
#ifndef MOE_WGM2
#define MOE_WGM2 8
#endif
#define PHASE(j, ...) if (INL(j)) { _Pragma("unroll") for (int rep_ = 0; rep_ < NREP(j); ++rep_) { { REFRAME(); __VA_ARGS__ } if (rep_ + 1 < NREP(j)) GRID_BAR(); } }
#define LAYER_BODY(l) { \
        const int pb = NPH_PRO + l * NPH_LAYER; \
        const int nrows = (l == 0) ? MT : NLAT; \
        if (l == 0) { PHASE(0, ph_norm_mod(Fp, l, ka->in[I_X], ka->in[I_CTX], ka->in[I_GMIX]);) SEAML(0); } \
        if (INL(1)) { REFRAME(); \
            unsigned* sw_ = Fp.ctl + CW_SPLIT + 2048 * l; \
            { pg8::Gemm g{(const bf16*)(Fp.ws + WS_H), (const bf16*)(Fp.ws + WS_WINT) + (size_t)l * 2048 * 1024, NLAT, 2048, 1024}; \
              pg8::StaticOrder S; S.init(NLAT, 2048, Fp.G, (int)blockIdx.x); \
              pg8::EpiBf16<0> E{(bf16*)(Fp.ws + WS_U), 2048, nullptr, 0, 0, 1.f}; \
              pg8::gemm_phase<pg8::EpiBf16<0>, pg8::StaticOrder, PG8_ALIGN, PG8_SP2>(Fp.lds + RING_OFF, g, S, E); } \
            split_arrive_all(bar, sw_);                                        \
            if ((int)blockIdx.x < CTXWG) {                                     \
              pg8::Gemm g{(const bf16*)(Fp.ws + WS_H) + (size_t)NLAT * 1024, (const bf16*)(Fp.ws + WS_WINT) + (size_t)l * 2048 * 1024, MT - NLAT, 2048, 1024}; \
              pg8::StaticOrder S; S.init(MT - NLAT, 2048, CTXWG, (int)blockIdx.x); \
              pg8::EpiBf16<0> E{(bf16*)(Fp.ws + WS_U) + (size_t)NLAT * 2048, 2048, nullptr, 0, 0, 1.f}; \
              pg8::gemm_phase<pg8::EpiBf16<0>, pg8::StaticOrder, PG8_ALIGN, PG8_SP2>(Fp.lds + RING_OFF, g, S, E); \
              split_arrive_flat(sw_); } \
            split_wait_all(bar, sw_); \
            if ((int)blockIdx.x >= CTXWG) post_ab(Fp, l, 0, NLAT, ((int)blockIdx.x - CTXWG) * NWAVES + Fp.wave, (Fp.G - CTXWG) * NWAVES, ka->in[I_KG], ka->in[I_LCW], ka->in[I_LCB]); \
            split_wait_flat(bar, sw_, (unsigned)CTXWG); \
            post_ab(Fp, l, NLAT, MT, Fp.gw, Fp.ngw, ka->in[I_KG], ka->in[I_LCW], ka->in[I_LCB]); \
            post_c(Fp, l, ka->in[I_HCW], ka->in[I_HCB]); } \
        SEAML(2); \
        if (INL(3)) { REFRAME(); \
            unsigned* sw_ = Fp.ctl + CW_SPLIT + 2048 * (2 + l); \
            { int kg_ = 256; asm volatile("" : "+s"(kg_)); \
              pg8::Gemm g{(const bf16*)(Fp.ws + WS_XL), (const bf16*)(Fp.ws + WS_WGT) + (size_t)l * 1024 * 256, NLAT, 1024, kg_}; \
              pg8::StaticOrder S; S.init(NLAT, 1024, Fp.G, (int)blockIdx.x); \
              pg8::EpiLruGate E{(const bf16*)(Fp.ws + WS_XL), (bf16*)(Fp.ws + WS_LAB), LAB_STRIDE, ka->in[I_LGB] + (size_t)l * 1024, (const float*)(Fp.ws + WS_SPT) + l * 512}; \
              pg8::gemm_phase<pg8::EpiLruGate, pg8::StaticOrder, PG8_ALIGN, PG8_SP2>(Fp.lds + RING_OFF, g, S, E); } \
            split_arrive_all(bar, sw_); \
            if ((int)blockIdx.x >= 32 && (int)blockIdx.x < 64) {            \
              ph_lru_gates(Fp, l, ka->in[I_LGB], NLAT / 32, (MT - NLAT) / 32, ((int)blockIdx.x - 32) * NWAVES + Fp.wave, 32 * NWAVES); \
              split_arrive_flat(sw_); } \
            split_wait_all(bar, sw_); split_wait_flat(bar, sw_, 32u); \
            ph_scan1(Fp); __syncthreads(); \
            { const attn_body::AttnTensors AT{(const attn_body::bf16*)(Fp.ws + WS_U), (const attn_body::bf16*)(Fp.ws + WS_K), (const attn_body::bf16*)(Fp.ws + WS_V), (attn_body::bf16*)(Fp.ws + WS_ATT)}; \
              const attn_body::QPre QN{ka->in[I_QG] + l * 64, (const float*)(Fp.ws + WS_ROPEC), (const float*)(Fp.ws + WS_ROPES)}; \
              attn_body::attn_phase<8>((char*)lds + RING_OFF, AT, QN, Fp.G, Fp.vcu, l == 0, (long)NLAT); } } \
        SEAML(4); \
        PHASE(5, ph_scan2(Fp); __syncthreads(); ph_hyena_fft(Fp, l, ka->in[I_HBIAS]); if (l == 0) ph_hyena_ctx(Fp, ka->in[I_HBIAS], ka->in[I_HCW], ka->in[I_HCB]);) \
        SEAML(5); \
        PHASE(6, ph_merge(Fp, l, nrows, ka->in[I_OUTG]);) \
        SEAML(6); \
        if (INL(7)) { REFRAME(); \
            pg8::Gemm g{(const bf16*)(Fp.ws + WS_MIXA), (const bf16*)(Fp.ws + WS_WOUTT) + (size_t)l * 1024 * 1024, nrows, 1024, 1024}; \
            pg8::StaticOrder S; S.init(nrows, 1024, Fp.G, (int)blockIdx.x); \
            bf16* XR = (bf16*)(Fp.ws + WS_XR); \
            pg8::EpiResid<(l) == 1> E{ka->in[I_X], ka->in[I_CTX], NLAT, XR, 1024, \
                            (const float*)(Fp.ws + WS_MOD) + (size_t)(l * 5) * 6144 + 2 * 1024, 6144, SEQ, (float*)(Fp.ws + WS_RSSP)}; \
            pg8::gemm_phase<pg8::EpiResid<(l) == 1>, pg8::StaticOrder, PG8_ALIGN, PG8_SP2>(Fp.lds + RING_OFF, g, S, E); \
        } \
        SEAML(7); \
        PHASE(8, ph_ffn_router(Fp, l, nrows, ka->in[I_RW]);) \
        SEAML(8); \
        PHASE(9, ph_route(Fp, nrows);) \
        SEAML(9); \
        if (INL(10) || INL(11)) { REFRAME(); \
            LAS int* tab = (LAS int*)(Fp.lds + MOETAB_OFF); \
            const int ntiles = (int)__hip_atomic_load(Fp.ctl + CW_NTILES, __ATOMIC_RELAXED, __HIP_MEMORY_SCOPE_AGENT); \
            const int* TILEE = (const int*)(Fp.ws + WS_TILEE); \
            for (int i = Fp.tid; i < ntiles && i < SORT_TILES; i += NTHR) tab[i] = TILEE[i]; \
            __syncthreads(); \
            if (INL(10)) { _Pragma("unroll") for (int rep_ = 0; rep_ < NREP(10); ++rep_) { { \
                int km1_ = 1024 / (1 + MOE_FP8); asm volatile("" : "+s"(km1_)); \
                pg8::Gemm g{(const bf16*)(Fp.ws + WS_F), (const bf16*)(Fp.ws + WS_W1T) + (size_t)l * 32 * 2048 * (1024 / (1 + MOE_FP8)), 0, 2048, km1_}; \
                pg8::MoeOrderT<true> S; S.init(tab, ntiles, 8, Fp.G, (int)blockIdx.x, MOE_WGM1); S.rowtok = (const int*)(Fp.ws + WS_ROWTOK); \
                MOE_EPI1 E{(bf16*)(Fp.ws + WS_ACT), 1024, ka->in[I_MB1] + (size_t)l * 32 * 2048, 2048}; \
                pg8::gemm_phase<MOE_EPI1, pg8::MoeOrderT<true>, PG8_ALIGN, PG8_SP2, MOE_FP8 != 0>(Fp.lds + RING_OFF, g, S, E); \
             } if (rep_ + 1 < NREP(10)) GRID_BAR(); } } \
            SEAML(10); \
            if (PROBE_MOE2B && INL(11)) { \
                pg8::Gemm g{(const bf16*)(Fp.ws + WS_ACT), (const bf16*)(Fp.ws + WS_W2T) + (size_t)l * 32 * 1024 * 1024, 0, 1024, 1024}; \
                pg8::MoeOrderT<false> S; S.init(tab, ntiles, 4, Fp.G, (int)blockIdx.x, MOE_WGM2); S.rowtok = nullptr; S.rev = 1; \
                pg8::EpiNone E{}; \
                pg8::gemm_phase<pg8::EpiNone, pg8::MoeOrderT<false>, PG8_ALIGN, PG8_SP2>(Fp.lds + RING_OFF, g, S, E); GRID_BAR(); } \
            if (INL(11)) { _Pragma("unroll") for (int rep_ = 0; rep_ < NREP(11); ++rep_) { { \
                int km2_ = 1024 / (1 + MOE_FP8); asm volatile("" : "+s"(km2_)); \
                pg8::Gemm g{(const bf16*)(Fp.ws + WS_ACT), (const bf16*)(Fp.ws + WS_W2T) + (size_t)l * 32 * 1024 * (1024 / (1 + MOE_FP8)), 0, 1024, km2_}; \
                pg8::MoeOrderT<false> S; S.init(tab, ntiles, 4, Fp.G, (int)blockIdx.x, MOE_WGM2); S.rowtok = nullptr; S.rev = 1; \
                MOE_EPI2 E{(bf16*)(Fp.ws + WS_YS), YS_PITCH, ka->in[I_MB2] + (size_t)l * 32 * 1024, 1024}; \
                pg8::gemm_phase<MOE_EPI2, pg8::MoeOrderT<false>, PG8_ALIGN, PG8_SP2, MOE_FP8 != 0>(Fp.lds + RING_OFF, g, S, E); \
             } if (rep_ + 1 < NREP(11)) GRID_BAR(); } } \
            if (PROBE_MOE2 && INL(11)) { GRID_BAR(); \
                pg8::Gemm g{(const bf16*)(Fp.ws + WS_ACT), (const bf16*)(Fp.ws + WS_W2T) + (size_t)l * 32 * 1024 * 1024, 0, 1024, 1024}; \
                pg8::MoeOrderT<false> S; S.init(tab, ntiles, 4, Fp.G, (int)blockIdx.x, MOE_WGM2); S.rowtok = nullptr; S.rev = (PROBE_MOE2 == 2) ? 0 : 1; \
                if (PROBE_MOE2 == 3) { pg8::EpiBf16BiasFold E{(bf16*)(Fp.ws + WS_ASORT), 1024, ka->in[I_MB2] + (size_t)l * 32 * 1024, 1024}; \
                    pg8::gemm_phase<pg8::EpiBf16BiasFold, pg8::MoeOrderT<false>, PG8_ALIGN, PG8_SP2>(Fp.lds + RING_OFF, g, S, E); } \
                else { pg8::EpiNone E{}; \
                pg8::gemm_phase<pg8::EpiNone, pg8::MoeOrderT<false>, PG8_ALIGN, PG8_SP2>(Fp.lds + RING_OFF, g, S, E); } } \
        } \
        SEAML(11); \
        if (INL(12)) { REFRAME(); ph_combine(Fp, l, nrows, ka->out, ka->in[I_GMIX]); } \
        if (l == 0) { SEAML(12); } \
    }
    LAYER_BODY(0)
    LAYER_BODY(1)
#undef LAYER_BODY
#undef PHASE
#undef IN
#undef SEAM
#undef INL
#undef SEAML
}

extern "C" void kernel_launch(void* const* d_in, const int* in_sizes, int n_in, void* d_out, int out_size, void* d_ws, size_t ws_size, hipStream_t stream) {
    static int grid = 0;
    if (grid == 0) {
        if (n_in != 34 || in_sizes[0] != NLAT * DMODEL || out_size != NLAT * DMODEL || ws_size < WS_END) {
            fprintf(stderr, "kernel_launch: unexpected shapes (n_in %d, in0 %d, out %d, ws %zu); nothing launched\n", n_in, n_in > 0 ? in_sizes[0] : -1, out_size, ws_size); grid = -1; return; }
        int dev = 0, cus = 0;
        if (hipGetDevice(&dev) != hipSuccess || hipDeviceGetAttribute(&cus, hipDeviceAttributeMultiprocessorCount, dev) != hipSuccess) { grid = -1; return; }
        if (hipFuncSetAttribute((const void*)mk_fwd, hipFuncAttributeMaxDynamicSharedMemorySize, LDS_BYTES) != hipSuccess) { fprintf(stderr, "kernel_launch: hipFuncSetAttribute failed\n"); grid = -1; return; }
        int per_cu = 0;
        if (hipOccupancyMaxActiveBlocksPerMultiprocessor(&per_cu, (const void*)mk_fwd, NTHR, LDS_BYTES) != hipSuccess || per_cu < 1) { fprintf(stderr, "kernel_launch: occupancy query says %d\n", per_cu); }
        (void)hipGetLastError();
        grid = cus;
    }
    if (grid < 0) return;
    if (hipMemsetAsync((char*)d_ws + WS_CTL, 0, CTL_ZERO_BYTES, stream) != hipSuccess) return;
    Args a{};
    for (int i = 0; i < 34; ++i) a.in[i] = (const float*)d_in[i];
    a.out = (float*)d_out; a.ws = (unsigned char*)d_ws;
#if MK_PER_PHASE
    for (int p = 0; p < NPH; ++p) { a.ph_lo = p; a.ph_hi = p + 1; hipLaunchKernelGGL(mk_fwd, dim3(grid), dim3(NTHR), LDS_BYTES, stream, a); }
#else
    a.ph_lo = 0; a.ph_hi = NPH;
    hipLaunchKernelGGL(mk_fwd, dim3(grid), dim3(NTHR), LDS_BYTES, stream, a);
#endif
}
```

```cpp
#include <hip/hip_runtime.h>
#include <hip/hip_bf16.h>
#include <cstdio>
#include <cstdint>
#include <cmath>
#ifndef MOE_FP8
#define MOE_FP8 1
#endif
#ifndef MK_PER_PHASE
#define MK_PER_PHASE 0
#endif
namespace pg8 {
#define PG8_LAS __attribute__((address_space(3)))
typedef unsigned short bf16_t;
typedef short bf16x8 __attribute__((ext_vector_type(8)));
typedef float f32x4 __attribute__((ext_vector_type(4)));
typedef unsigned u32x4 __attribute__((ext_vector_type(4)));
constexpr int BM = 256, BK = 64, HALF = 128, HTB = HALF * BK * 2  , STAGE_BYTES = 8 * HTB, NXCD = 8, WGM = 8;

__host__ __device__ __forceinline__ int lds_byte(int r, int c) { const int st = (r >> 4) * 2 + (c >> 5), rr = r & 15, cc = c & 31, ob = rr * 64 + cc * 2; return st * 1024 + (ob ^ (((ob >> 9) & 1) << 5)); }
__host__ __device__ __forceinline__ void stage_rc(int b, int& R, int& C) { const int st = b / 1024, sb = b % 1024, swz = sb ^ (((sb >> 9) & 1) << 5); R = (st >> 1) * 16 + swz / 64; C = (st & 1) * 32 + (swz % 64) / 2; }
__host__ __device__ __forceinline__ int perm32(int rho) { const int n = rho >> 4, i = rho & 15; return 8 * (i >> 2) + 4 * n + (i & 3); }

struct Unit { int pm, pn, be, e; };
struct Gemm { const bf16_t* A; const bf16_t* Bt; int M, N, K; };

struct StaticOrder {
    static constexpr bool GATHER = false;
    __device__ __forceinline__ int row_of(int r) const { return r; }
    int nM, nN, nwg, G, c;
    __host__ __device__ void init(int M, int N, int G_, int c_) { nM = M / BM; nN = N / BM; nwg = nM * nN; G = G_; c = c_; }
    __host__ __device__ bool next(int i, Unit& u) const {
        const long L = (long)i * G + c; if (L >= nwg) return false;
        int wgid = (int)L; { const int q = nwg / NXCD, r = nwg % NXCD, xcd = wgid % NXCD, off = wgid / NXCD; wgid = (xcd < r ? xcd * (q + 1) : r * (q + 1) + (xcd - r) * q) + off; }
        const int nig = WGM * nN, gid = wgid / nig, fm = gid * WGM, gsz = (nM - fm) < WGM ? (nM - fm) : WGM;
        u.pm = fm + ((wgid % nig) % gsz); u.pn = (wgid % nig) / gsz; u.be = u.pn; u.e = 0; return true;
    }
    __device__ __forceinline__ void a_ready(const Unit&) const {}
    __device__ __forceinline__ void done(const Unit&) const {}
};

__device__ __forceinline__ unsigned cvt_pk_bf16(float lo, float hi) { unsigned r; asm volatile("v_cvt_pk_bf16_f32 %0, %1, %2" : "=v"(r) : "v"(lo), "v"(hi)); return r; }
__device__ __forceinline__ unsigned pack4_fp8(float a, float b, float c, float d) {
    a = fminf(fmaxf(a, -448.f), 448.f); b = fminf(fmaxf(b, -448.f), 448.f); c = fminf(fmaxf(c, -448.f), 448.f); d = fminf(fmaxf(d, -448.f), 448.f);
    int w = 0; w = __builtin_amdgcn_cvt_pk_fp8_f32(a, b, w, false); w = __builtin_amdgcn_cvt_pk_fp8_f32(c, d, w, true); return (unsigned)w;
}
constexpr float F8_SF = 16.f, F8_SW = 64.f, F8_SA = 4.f, F8_SY = 32.f;
typedef float f32x2 __attribute__((ext_vector_type(2)));
__device__ __forceinline__ f32x2 gelu_pk(f32x2 v) {
    const f32x2 av = __builtin_elementwise_abs(v), d = av * 0.2316418882f + 1.0f;
    f32x2 t; t.x = __builtin_amdgcn_rcpf(d.x); t.y = __builtin_amdgcn_rcpf(d.y);
    f32x2 q = t * 0.5307027145f + (-0.7265760135f); q = q * t + 0.7107068705f; q = q * t + (-0.142248368f); q = q * t + 0.127414796f; q = q * t;
    const f32x2 s = (v * v) * (-0.72134752044f);
    f32x2 e; e.x = __builtin_amdgcn_exp2f(s.x); e.y = __builtin_amdgcn_exp2f(s.y);
    const f32x2 m = v * (q * e), r = v - m;
    f32x2 o; o.x = v.x < 0.f ? m.x : r.x; o.y = v.y < 0.f ? m.y : r.y; return o;
}

template <int ACT  > struct EpiBf16 {
    static constexpr bool PERM = true, AFTER_DRAIN = false; static_assert(ACT == 0 || ACT == 1, "EpiBf16: ACT is 0 (none) or 1 (gelu_pk)");
    bf16_t* O; int ldc; const float* bias; int split_cols; size_t split_stride; float scale0;
    struct Pre {}; __device__ __forceinline__ void preload(Pre&, const Unit&, int, int, int, int) const {}
    __device__ __forceinline__ void operator()(const f32x4 (&acc)[2][2][4][2], const Unit& u, int wr, int wc, int fr, int fq, const Pre&) const {
        const int row0 = u.pm * BM + wr * 64 + fr; int colt = u.pn * BM; bf16_t* base = O;
        float sc = 1.f; if (split_cols) { const int t = colt / split_cols; base += (size_t)t * split_stride; colt -= t * split_cols; if (t == 0) sc = scale0; }
        const int col0 = colt + wc * 32 + 8 * fq, bcol0 = u.pn * BM + wc * 32 + 8 * fq;
        f32x4 bv[2][2];
#pragma unroll
        for (int bj = 0; bj < 2; ++bj)
#pragma unroll
            for (int n = 0; n < 2; ++n) bv[bj][n] = bias ? *(const f32x4*)(bias + bcol0 + bj * HALF + 4 * n) : (f32x4){0.f, 0.f, 0.f, 0.f};
#pragma unroll
        for (int ai = 0; ai < 2; ++ai)
#pragma unroll
            for (int m = 0; m < 4; ++m) { bf16_t* rowp = base + (size_t)(row0 + ai * HALF + m * 16) * ldc + col0;
#pragma unroll
                for (int bj = 0; bj < 2; ++bj) { f32x4 v0 = acc[ai][bj][m][0] + bv[bj][0], v1 = acc[ai][bj][m][1] + bv[bj][1];
                    if (ACT == 1) { f32x2 a = gelu_pk((f32x2){v0[0], v0[1]}), b = gelu_pk((f32x2){v0[2], v0[3]}), c = gelu_pk((f32x2){v1[0], v1[1]}), d = gelu_pk((f32x2){v1[2], v1[3]});
                        v0 = (f32x4){a.x, a.y, b.x, b.y}; v1 = (f32x4){c.x, c.y, d.x, d.y}; }
                    v0 = v0 * sc; v1 = v1 * sc; u32x4 w; w.x = cvt_pk_bf16(v0[0], v0[1]); w.y = cvt_pk_bf16(v0[2], v0[3]); w.z = cvt_pk_bf16(v1[0], v1[1]); w.w = cvt_pk_bf16(v1[2], v1[3]);
                    *(u32x4*)(rowp + bj * HALF) = w; } }
    }
};


template <bool XIN_BF16> struct EpiResid {
    static constexpr bool PERM = false, AFTER_DRAIN = false;
    const float* xin_lat; const float* xin_ctx; int nlat; bf16_t* XR; int ldc; const float* mod; int mod_stride; int seq; float* rssp;
    struct Pre {}; __device__ __forceinline__ void preload(Pre&, const Unit&, int, int, int, int) const {}
    __device__ __forceinline__ void operator()(const f32x4 (&acc)[2][2][4][2], const Unit& u, int wr, int wc, int fr, int fq, const Pre&) const {
        typedef unsigned u32x2 __attribute__((ext_vector_type(2)));
        const int row0 = u.pm * BM + wr * 64 + fr, col0 = u.pn * BM + wc * 32 + 4 * fq;
        const int rowt = u.pm * BM; const int bidx = rowt < nlat ? rowt / seq : 4;
        const float* gate = mod + (size_t)bidx * mod_stride;
        const float* xin = rowt < nlat ? xin_lat : (xin_ctx - (size_t)nlat * ldc);
        f32x4 gv[2][2];
#pragma unroll
        for (int bj = 0; bj < 2; ++bj)
#pragma unroll
            for (int n = 0; n < 2; ++n) gv[bj][n] = *(const f32x4*)(gate + col0 + bj * HALF + n * 16);
#pragma unroll
        for (int ai = 0; ai < 2; ++ai)
#pragma unroll
            for (int m = 0; m < 4; ++m) { const int row = row0 + ai * HALF + m * 16; const size_t ro = (size_t)row * ldc + col0; float s2 = 0.f;
#pragma unroll
                for (int bj = 0; bj < 2; ++bj)
#pragma unroll
                    for (int n = 0; n < 2; ++n) { const size_t idx = ro + bj * HALF + n * 16; f32x4 xv;
                        if (XIN_BF16) { const u32x2 w = *(const u32x2*)(XR + idx); xv = (f32x4){__builtin_bit_cast(float, w.x << 16), __builtin_bit_cast(float, w.x & 0xffff0000u), __builtin_bit_cast(float, w.y << 16), __builtin_bit_cast(float, w.y & 0xffff0000u)}; }
                        else xv = *(const f32x4*)(xin + idx);
                        const f32x4 v = xv + gv[bj][n] * acc[ai][bj][m][n];
                        s2 += (v[0] * v[0] + v[1] * v[1]) + (v[2] * v[2] + v[3] * v[3]);
                        u32x2 o; o.x = cvt_pk_bf16(v[0], v[1]); o.y = cvt_pk_bf16(v[2], v[3]); *(u32x2*)(XR + idx) = o; }
                s2 += __shfl_xor(s2, 16); s2 += __shfl_xor(s2, 32);
                if (fq == 0) rssp[(size_t)row * 16 + u.pn * 4 + wc] = s2; }
    }
};
struct EpiSwiglu {
    static constexpr bool PERM = true, AFTER_DRAIN = false;
    bf16_t* O; int ldc; const float* bias; int bias_stride;
    struct Pre { unsigned bw[2][2][2]; };
    __device__ __forceinline__ void preload(Pre& p, const Unit& u, int wr, int wc, int fr, int fq) const {
        const float* bb = bias + (size_t)u.e * bias_stride + u.pn * BM + wc * 32 + 8 * fq;
#pragma unroll
        for (int bj = 0; bj < 2; ++bj)
#pragma unroll
            for (int n = 0; n < 2; ++n) { const f32x4 v = *(const f32x4*)(bb + bj * HALF + 4 * n); p.bw[bj][n][0] = cvt_pk_bf16(v[0], v[1]); p.bw[bj][n][1] = cvt_pk_bf16(v[2], v[3]); }
    }
    __device__ __forceinline__ void operator()(const f32x4 (&acc)[2][2][4][2], const Unit& u, int wr, int wc, int fr, int fq, const Pre& pre) const {
        const int row0 = u.pm * BM + wr * 64 + fr; const int bcol0 = u.pn * BM + wc * 32 + 8 * fq; const int ocol0 = bcol0 >> 1;
        f32x4 bv[2][2];
#pragma unroll
        for (int bj = 0; bj < 2; ++bj)
#pragma unroll
            for (int n = 0; n < 2; ++n) { const unsigned w0 = pre.bw[bj][n][0], w1 = pre.bw[bj][n][1];
                bv[bj][n] = (f32x4){__builtin_bit_cast(float, w0 << 16), __builtin_bit_cast(float, w0 & 0xffff0000u), __builtin_bit_cast(float, w1 << 16), __builtin_bit_cast(float, w1 & 0xffff0000u)}; }
#pragma unroll
        for (int ai = 0; ai < 2; ++ai)
#pragma unroll
            for (int m = 0; m < 4; ++m) { bf16_t* rowp = O + (size_t)(row0 + ai * HALF + m * 16) * ldc + ocol0;
#pragma unroll
                for (int bj = 0; bj < 2; ++bj) { const f32x4 v0 = acc[ai][bj][m][0] + bv[bj][0], v1 = acc[ai][bj][m][1] + bv[bj][1];
                    float o[4];
#pragma unroll
                    for (int p = 0; p < 4; ++p) { const float hg = p < 2 ? v0[2 * p] : v1[2 * p - 4], hl = p < 2 ? v0[2 * p + 1] : v1[2 * p - 3];
                        const float glu = fminf(hg, 7.0f), lin = fminf(fmaxf(hl, -7.0f), 7.0f);
                        const float sg = __builtin_amdgcn_rcpf(1.0f + __builtin_amdgcn_exp2f(-1.702f * 1.4426950408889634f * glu));
                        o[p] = glu * sg * (lin + 1.0f); }
                    typedef unsigned u32x2 __attribute__((ext_vector_type(2)));
                    u32x2 w; w.x = cvt_pk_bf16(o[0], o[1]); w.y = cvt_pk_bf16(o[2], o[3]);
                    *(u32x2*)(rowp + bj * (HALF / 2)) = w; } }
    }
};
struct EpiSwigluF8 {
    static constexpr bool PERM = true, AFTER_DRAIN = false;
    bf16_t* O; int ldc; const float* bias; int bias_stride;
    struct Pre { unsigned bw[2][2][2]; };
    __device__ __forceinline__ void preload(Pre& p, const Unit& u, int wr, int wc, int fr, int fq) const {
        const float* bb = bias + (size_t)u.e * bias_stride + u.pn * BM + wc * 32 + 8 * fq;
#pragma unroll
        for (int bj = 0; bj < 2; ++bj)
#pragma unroll
            for (int n = 0; n < 2; ++n) { const f32x4 v = *(const f32x4*)(bb + bj * HALF + 4 * n); p.bw[bj][n][0] = cvt_pk_bf16(v[0], v[1]); p.bw[bj][n][1] = cvt_pk_bf16(v[2], v[3]); }
    }
    __device__ __forceinline__ void operator()(const f32x4 (&acc)[2][2][4][2], const Unit& u, int wr, int wc, int fr, int fq, const Pre& pre) const {
        asm volatile("" : "+v"(fr), "+v"(fq));
        const int row0 = u.pm * BM + wr * 64 + fr; const int bcol0 = u.pn * BM + wc * 32 + 8 * fq; const int ocol0 = bcol0 >> 1;
        f32x4 bv[2][2];
#pragma unroll
        for (int bj = 0; bj < 2; ++bj)
#pragma unroll
            for (int n = 0; n < 2; ++n) { const unsigned w0 = pre.bw[bj][n][0], w1 = pre.bw[bj][n][1];
                bv[bj][n] = (f32x4){__builtin_bit_cast(float, w0 << 16), __builtin_bit_cast(float, w0 & 0xffff0000u), __builtin_bit_cast(float, w1 << 16), __builtin_bit_cast(float, w1 & 0xffff0000u)}; }
#pragma unroll
        for (int ai = 0; ai < 2; ++ai)
#pragma unroll
            for (int m = 0; m < 4; ++m) {
#pragma unroll
                for (int bj = 0; bj < 2; ++bj) { const f32x4 v0 = acc[ai][bj][m][0] * (1.0f / (F8_SF * F8_SW)) + bv[bj][0], v1 = acc[ai][bj][m][1] * (1.0f / (F8_SF * F8_SW)) + bv[bj][1];
                    float o[4];
#pragma unroll
                    for (int p = 0; p < 4; ++p) { const float hg = p < 2 ? v0[2 * p] : v1[2 * p - 4], hl = p < 2 ? v0[2 * p + 1] : v1[2 * p - 3];
                        const float glu = fminf(hg, 7.0f), lin = fminf(fmaxf(hl, -7.0f), 7.0f);
                        const float sg = __builtin_amdgcn_rcpf(1.0f + __builtin_amdgcn_exp2f(-1.702f * 1.4426950408889634f * glu));
                        o[p] = glu * sg * (lin + 1.0f); }
                    *(unsigned*)((unsigned char*)O + (size_t)(row0 + ai * HALF + m * 16) * ldc + ocol0 + bj * (HALF / 2)) = pack4_fp8(o[0] * F8_SA, o[1] * F8_SA, o[2] * F8_SA, o[3] * F8_SA); } }
    }
};
struct EpiBf16Bias {
    static constexpr bool PERM = true, AFTER_DRAIN = false;
    bf16_t* O; int ldc; const float* bias; int bias_stride;
    struct Pre { f32x4 bv[2][2]; };
    __device__ __forceinline__ void preload(Pre& p, const Unit& u, int wr, int wc, int fr, int fq) const {
        const float* bb = bias + (size_t)u.e * bias_stride + u.pn * BM + wc * 32 + 8 * fq;
#pragma unroll
        for (int bj = 0; bj < 2; ++bj)
#pragma unroll
            for (int n = 0; n < 2; ++n) p.bv[bj][n] = *(const f32x4*)(bb + bj * HALF + 4 * n);
    }
    __device__ __forceinline__ void operator()(const f32x4 (&acc)[2][2][4][2], const Unit& u, int wr, int wc, int fr, int fq, const Pre& pre) const {
        const int row0 = u.pm * BM + wr * 64 + fr; const int col0 = u.pn * BM + wc * 32 + 8 * fq;
#pragma unroll
        for (int ai = 0; ai < 2; ++ai)
#pragma unroll
            for (int m = 0; m < 4; ++m) { bf16_t* rowp = O + (size_t)(row0 + ai * HALF + m * 16) * ldc + col0;
#pragma unroll
                for (int bj = 0; bj < 2; ++bj) { const f32x4 v0 = acc[ai][bj][m][0] + pre.bv[bj][0], v1 = acc[ai][bj][m][1] + pre.bv[bj][1];
                    u32x4 w; w.x = cvt_pk_bf16(v0[0], v0[1]); w.y = cvt_pk_bf16(v0[2], v0[3]); w.z = cvt_pk_bf16(v1[0], v1[1]); w.w = cvt_pk_bf16(v1[2], v1[3]);
                    *(u32x4*)(rowp + bj * HALF) = w; } }
    }
};
struct EpiBf16BiasFold {
    static constexpr bool PERM = true, AFTER_DRAIN = false;
    bf16_t* O; int ldc; const float* bias; int bias_stride;
    struct Pre { f32x4 bv[2][2]; };
    __device__ __forceinline__ void preload(Pre& p, const Unit& u, int wr, int wc, int fr, int fq) const {
        const float* bb = bias + (size_t)u.e * bias_stride + u.pn * BM + wc * 32 + 8 * fq;
#pragma unroll
        for (int bj = 0; bj < 2; ++bj)
#pragma unroll
            for (int n = 0; n < 2; ++n) p.bv[bj][n] = *(const f32x4*)(bb + bj * HALF + 4 * n);
    }
    __device__ __forceinline__ void operator()(const f32x4 (&acc)[2][2][4][2], const Unit& u, int wr, int wc, int fr, int fq, const Pre& pre) const {
        const int row0 = u.pm * BM + wr * 64 + fr; const int col0 = u.pn * BM + wc * 32 + 8 * fq;
#pragma unroll
        for (int ai = 0; ai < 2; ++ai)
#pragma unroll
            for (int m = 0; m < 4; ++m) { bf16_t* rowp = O + (size_t)((row0 + ai * HALF + m * 16) & 255) * ldc + col0;
#pragma unroll
                for (int bj = 0; bj < 2; ++bj) { const f32x4 v0 = acc[ai][bj][m][0] + pre.bv[bj][0], v1 = acc[ai][bj][m][1] + pre.bv[bj][1];
                    u32x4 w; w.x = cvt_pk_bf16(v0[0], v0[1]); w.y = cvt_pk_bf16(v0[2], v0[3]); w.z = cvt_pk_bf16(v1[0], v1[1]); w.w = cvt_pk_bf16(v1[2], v1[3]);
                    *(u32x4*)(rowp + bj * HALF) = w; } }
    }
};
struct EpiBf16BiasF8 {
    static constexpr bool PERM = true, AFTER_DRAIN = false;
    bf16_t* O; int ldc; const float* bias; int bias_stride;
    struct Pre { f32x4 bv[2][2]; };
    __device__ __forceinline__ void preload(Pre& p, const Unit& u, int wr, int wc, int fr, int fq) const {
        const float* bb = bias + (size_t)u.e * bias_stride + u.pn * BM + wc * 32 + 8 * fq;
#pragma unroll
        for (int bj = 0; bj < 2; ++bj)
#pragma unroll
            for (int n = 0; n < 2; ++n) p.bv[bj][n] = *(const f32x4*)(bb + bj * HALF + 4 * n);
    }
    __device__ __forceinline__ void operator()(const f32x4 (&acc)[2][2][4][2], const Unit& u, int wr, int wc, int fr, int fq, const Pre& pre) const {
        asm volatile("" : "+v"(fr), "+v"(fq));
        const int row0 = u.pm * BM + wr * 64 + fr; const int col0 = u.pn * BM + wc * 32 + 8 * fq;
#pragma unroll
        for (int ai = 0; ai < 2; ++ai)
#pragma unroll
            for (int m = 0; m < 4; ++m) { bf16_t* rowp = O + (size_t)(row0 + ai * HALF + m * 16) * ldc + col0;
#pragma unroll
                for (int bj = 0; bj < 2; ++bj) { const f32x4 v0 = acc[ai][bj][m][0] * (1.0f / (F8_SA * F8_SW)) + pre.bv[bj][0], v1 = acc[ai][bj][m][1] * (1.0f / (F8_SA * F8_SW)) + pre.bv[bj][1];
                    u32x4 w; w.x = cvt_pk_bf16(v0[0], v0[1]); w.y = cvt_pk_bf16(v0[2], v0[3]); w.z = cvt_pk_bf16(v1[0], v1[1]); w.w = cvt_pk_bf16(v1[2], v1[3]);
                    *(u32x4*)(rowp + bj * HALF) = w; } }
    }
};
struct EpiF8BiasF8 {
    static constexpr bool PERM = true, AFTER_DRAIN = false;
    bf16_t* O; int ldc; const float* bias; int bias_stride;
    struct Pre { f32x4 bv[2][2]; };
    __device__ __forceinline__ void preload(Pre& p, const Unit& u, int wr, int wc, int fr, int fq) const {
        const float* bb = bias + (size_t)u.e * bias_stride + u.pn * BM + wc * 32 + 8 * fq;
#pragma unroll
        for (int bj = 0; bj < 2; ++bj)
#pragma unroll
            for (int n = 0; n < 2; ++n) p.bv[bj][n] = *(const f32x4*)(bb + bj * HALF + 4 * n);
    }
    __device__ __forceinline__ void operator()(const f32x4 (&acc)[2][2][4][2], const Unit& u, int wr, int wc, int fr, int fq, const Pre& pre) const {
        asm volatile("" : "+v"(fr), "+v"(fq));
        const int row0 = u.pm * BM + wr * 64 + fr; const int col0 = u.pn * BM + wc * 32 + 8 * fq;
#pragma unroll
        for (int ai = 0; ai < 2; ++ai)
#pragma unroll
            for (int m = 0; m < 4; ++m) { unsigned char* rowp = (unsigned char*)O + (size_t)(row0 + ai * HALF + m * 16) * ldc + col0;
#pragma unroll
                for (int bj = 0; bj < 2; ++bj) { const f32x4 v0 = (acc[ai][bj][m][0] * (1.0f / (F8_SA * F8_SW)) + pre.bv[bj][0]) * F8_SY, v1 = (acc[ai][bj][m][1] * (1.0f / (F8_SA * F8_SW)) + pre.bv[bj][1]) * F8_SY;
                    typedef unsigned u32x2 __attribute__((ext_vector_type(2)));
                    u32x2 w; w.x = pack4_fp8(v0[0], v0[1], v0[2], v0[3]); w.y = pack4_fp8(v1[0], v1[1], v1[2], v1[3]);
                    *(u32x2*)(rowp + bj * HALF) = w; } }
    }
};
struct EpiLruGate {
    static constexpr bool PERM = false, AFTER_DRAIN = false;
    const bf16_t* XL; bf16_t* LAB; size_t lab_stride; const float* gb; const float* spt;
    struct Pre {}; __device__ __forceinline__ void preload(Pre&, const Unit&, int, int, int, int) const {}
    __device__ __forceinline__ void operator()(const f32x4 (&acc)[2][2][4][2], const Unit& u, int wr, int wc, int fr, int fq, const Pre&) const {
        const int d = u.pn >> 1, half = u.pn & 1;
        const int row0 = u.pm * BM + wr * 64 + fr, ch0 = half * 128 + wc * 32 + 4 * fq;
        bf16_t* LA = LAB + (size_t)(2 * d) * lab_stride; bf16_t* LB = LAB + (size_t)(2 * d + 1) * lab_stride;
#pragma unroll
        for (int n = 0; n < 2; ++n) {
            const f32x4 bR = *(const f32x4*)(gb + (d * 2 + 0) * 256 + ch0 + 16 * n), bI = *(const f32x4*)(gb + (d * 2 + 1) * 256 + ch0 + 16 * n);
            const f32x4 sp = *(const f32x4*)(spt + d * 256 + ch0 + 16 * n) * (-8.0f * 1.4426950408889634f);
#pragma unroll
            for (int ai = 0; ai < 2; ++ai)
#pragma unroll
                for (int m = 0; m < 4; ++m) { const size_t ro = (size_t)(row0 + ai * HALF + m * 16) * 256 + ch0 + 16 * n;
                    typedef unsigned u32x2 __attribute__((ext_vector_type(2)));
                    const u32x2 xw = *(const u32x2*)(XL + ro);
                    const float xl[4] = {__builtin_bit_cast(float, xw.x << 16), __builtin_bit_cast(float, xw.x & 0xffff0000u), __builtin_bit_cast(float, xw.y << 16), __builtin_bit_cast(float, xw.y & 0xffff0000u)};
                    const f32x4 gr = acc[ai][0][m][n] + bR, gi = acc[ai][1][m][n] + bI;
                    f32x4 av, bv;
#pragma unroll
                    for (int e = 0; e < 4; ++e) {
                        const float rg = __builtin_amdgcn_rcpf(1.0f + __builtin_amdgcn_exp2f(-1.4426950408889634f * gr[e])), ig = __builtin_amdgcn_rcpf(1.0f + __builtin_amdgcn_exp2f(-1.4426950408889634f * gi[e]));
                        const float la2 = rg * sp[e];
                        const float a2 = __builtin_amdgcn_exp2f(2.0f * la2);
                        av[e] = la2; bv[e] = __builtin_amdgcn_sqrtf(fmaxf(1.0f - a2, 0.f)) * (ig * xl[e]); }
                    u32x2 wa, wb; wa.x = cvt_pk_bf16(av[0], av[1]); wa.y = cvt_pk_bf16(av[2], av[3]); wb.x = cvt_pk_bf16(bv[0], bv[1]); wb.y = cvt_pk_bf16(bv[2], bv[3]);
                    *(u32x2*)(LA + ro) = wa; *(u32x2*)(LB + ro) = wb; }
        }
    }
};
struct EpiNone {
    static constexpr bool PERM = true, AFTER_DRAIN = false;
    struct Pre {}; __device__ __forceinline__ void preload(Pre&, const Unit&, int, int, int, int) const {}
    __device__ __forceinline__ void operator()(const f32x4 (&acc)[2][2][4][2], const Unit& u, int wr, int wc, int fr, int fq, const Pre&) const {
#pragma unroll
        for (int a = 0; a < 2; ++a)
#pragma unroll
            for (int b2 = 0; b2 < 2; ++b2)
#pragma unroll
                for (int m = 0; m < 4; ++m)
#pragma unroll
                    for (int n = 0; n < 2; ++n) { f32x4 v = acc[a][b2][m][n]; asm volatile("" :: "v"(v)); }
    }
};
template <bool GATHER_> struct MoeOrderT {
    static constexpr bool GATHER = GATHER_;
    const int* rowtok;
    __device__ __forceinline__ int row_of(int r) const { return GATHER_ ? rowtok[r] : r; }
    const PG8_LAS int* tab; int ntiles, nN, nper, j, m_lo, nMx, wgm, rev;
    __device__ __forceinline__ void init(const PG8_LAS int* tab_, int ntiles_, int nN_, int G, int bx, int wgm_) {
        tab = tab_; ntiles = ntiles_; nN = nN_; wgm = wgm_; rev = 0;
        if (G % 8 == 0) { const int x = bx % 8; nper = G / 8; j = bx / 8; m_lo = (x * ntiles) / 8; nMx = ((x + 1) * ntiles) / 8 - m_lo; }
        else { nper = G; j = bx; m_lo = 0; nMx = ntiles; }
    }
    __device__ __forceinline__ bool next(int i, Unit& u) const {
        const int s = i * nper + j; if (s >= nMx * nN) return false;
        const int nig = wgm * nN, gid = s / nig, fm = gid * wgm, gsz = (nMx - fm) < wgm ? (nMx - fm) : wgm, w = s - gid * nig;
        const int mi = fm + (w % gsz); u.pm = m_lo + (rev ? (nMx - 1 - mi) : mi); u.pn = w / gsz; u.e = tab[u.pm]; u.be = u.e * nN + u.pn; return true;
    }
    __device__ __forceinline__ void a_ready(const Unit&) const {}
    __device__ __forceinline__ void done(const Unit&) const {}
};
template <class Epi, class Sched, bool ALIGN_EPI = false, bool SP2 = false, bool FP8 = false>
__device__ __forceinline__ void gemm_phase(PG8_LAS unsigned char* lds, const Gemm g, const Sched& S, const Epi& E) {
    int tid_ = threadIdx.x; asm volatile("" : "+v"(tid_));
    const int tid = tid_, wid = __builtin_amdgcn_readfirstlane(tid >> 6), lane = tid & 63, wr = wid >> 2, wc = wid & 3, fr = lane & 15, fq = lane >> 4;
    const int K = g.K, nt = K / BK;
    unsigned voffA[2], voffB[2];
#pragma unroll
    for (int i = 0; i < 2; ++i) { int R, C; stage_rc(tid * 16 + i * 8192, R, C); const int Rb = Epi::PERM ? ((R & ~31) + perm32(R & 31)) : R;
        voffA[i] = (unsigned)(R * K + C) * 2u; voffB[i] = (unsigned)(Rb * K + C) * 2u; }
    unsigned gA_[2] = {0u, 0u}, gN_[2] = {0u, 0u}, gC_[2] = {0u, 0u};
    static_assert(!Sched::GATHER || SP2, "the gathered A operand is wired into the SP2 loop only");
    if constexpr (Sched::GATHER) { _Pragma("unroll") for (int i_ = 0; i_ < 2; ++i_) { int R_, C_; stage_rc(tid * 16 + i_ * 8192, R_, C_); gC_[i_] = (unsigned)(C_ * 2); } }
#define PG8_GLOAD(dst, pm_) do { _Pragma("unroll") for (int h_ = 0; h_ < 2; ++h_) { unsigned t_[2]; _Pragma("unroll") for (int i_ = 0; i_ < 2; ++i_) { int R_, C_; stage_rc(tid * 16 + i_ * 8192, R_, C_); \
        t_[i_] = (unsigned)S.row_of((pm_) * BM + h_ * HALF + R_); } dst[h_] = t_[0] | (t_[1] << 16); } } while (0)
    const size_t kstep = (size_t)(BK * 2);
    const size_t hstep = (size_t)HALF * K * 2;
    const size_t tstep = 2 * hstep;
    const unsigned ldsw = (unsigned)wid * 1024u;
    const int aoff = lds_byte(wr * 64 + fr, fq * 8), boff = lds_byte(wc * 32 + fr, fq * 8);
#define PG8_SA(b, h) (((b) * 2 + (h)) * HTB)
#define PG8_SB(b, h) ((4 + (b) * 2 + (h)) * HTB)
#define PG8_STAGE(bufoff, gbase, voff) do { _Pragma("unroll") for (int _i = 0; _i < 2; ++_i) \
        __builtin_amdgcn_global_load_lds((const unsigned*)((const char*)(gbase) + (voff)[_i]), (PG8_LAS unsigned*)(lds + (bufoff) + ldsw + _i * 8192), 16, 0, 0); } while (0)
#define PG8_STA(bufoff, ptr, h, useN) do { if constexpr (Sched::GATHER) { const unsigned pk_ = (useN) ? gN_[h] : gA_[h]; unsigned o_[2] = {(pk_ & 0xffffu) * (unsigned)(K * 2) + gC_[0], (pk_ >> 16) * (unsigned)(K * 2) + gC_[1]}; PG8_STAGE(bufoff, ptr, o_); } \
        else { PG8_STAGE(bufoff, (ptr) + ((h) ? hstep : 0), voffA); } } while (0)
#define PG8_LDA(dst, b, h) do { _Pragma("unroll") for (int m = 0; m < 4; ++m) { if constexpr (FP8) { \
            dst##8[m] = __builtin_shufflevector(*(const PG8_LAS i32x4_*)(lds + PG8_SA(b, h) + aoff + m * 2048), *(const PG8_LAS i32x4_*)(lds + PG8_SA(b, h) + aoff + m * 2048 + 1024), 0, 1, 2, 3, 4, 5, 6, 7); } \
        else { _Pragma("unroll") for (int k = 0; k < 2; ++k) dst[m][k] = *(const PG8_LAS bf16x8*)(lds + PG8_SA(b, h) + aoff + m * 2048 + k * 1024); } } } while (0)
#define PG8_LDB(dst, b, h) do { _Pragma("unroll") for (int n = 0; n < 2; ++n) { if constexpr (FP8) { \
            dst##8[n] = __builtin_shufflevector(*(const PG8_LAS i32x4_*)(lds + PG8_SB(b, h) + boff + n * 2048), *(const PG8_LAS i32x4_*)(lds + PG8_SB(b, h) + boff + n * 2048 + 1024), 0, 1, 2, 3, 4, 5, 6, 7); } \
        else { _Pragma("unroll") for (int k = 0; k < 2; ++k) dst[n][k] = *(const PG8_LAS bf16x8*)(lds + PG8_SB(b, h) + boff + n * 2048 + k * 1024); } } } while (0)
#define PG8_MMA(ai, bj, At, Bt) do { __builtin_amdgcn_s_setprio(1); _Pragma("unroll") for (int m = 0; m < 4; ++m) _Pragma("unroll") for (int n = 0; n < 2; ++n) { \
        if constexpr (FP8) asm volatile("v_mfma_f32_16x16x128_f8f6f4 %0, %1, %2, %0" : "+v"(acc[ai][bj][m][n]) : "v"(Bt##8[n]), "v"(At##8[m]));   \
        else { _Pragma("unroll") for (int k = 0; k < 2; ++k) acc[ai][bj][m][n] = __builtin_amdgcn_mfma_f32_16x16x32_bf16(Bt[n][k], At[m][k], acc[ai][bj][m][n], 0, 0, 0); } } \
        __builtin_amdgcn_s_setprio(0); } while (0)
#define PG8_WAIT_V(n) asm volatile("s_waitcnt vmcnt(" #n ")" ::: "memory")
#define PG8_WAIT_L(n) asm volatile("s_waitcnt lgkmcnt(" #n ")" ::: "memory")
#define PG8_BAR __builtin_amdgcn_s_barrier()
#define PG8_SCHED __builtin_amdgcn_sched_barrier(0)
    Unit cur, nxt; int ui = 0;
    if (!S.next(0, cur)) return;
    f32x4 acc[2][2][4][2];
#pragma unroll
    for (int a = 0; a < 2; ++a)
#pragma unroll
        for (int b = 0; b < 2; ++b)
#pragma unroll
            for (int m = 0; m < 4; ++m)
#pragma unroll
                for (int n = 0; n < 2; ++n) acc[a][b][m][n] = (f32x4){0.f, 0.f, 0.f, 0.f};
    typedef int i32x4_ __attribute__((ext_vector_type(4))); typedef int i32x8_ __attribute__((ext_vector_type(8)));
    bf16x8 At[4][2], B0[2][2], B1[2][2]; i32x8_ At8[4], B08[2], B18[2];
    typename Epi::Pre pre;
    const char* cA = (const char*)g.A + (Sched::GATHER ? (size_t)0 : (size_t)cur.pm * tstep); if constexpr (Sched::GATHER) PG8_GLOAD(gA_, cur.pm);
    const char* cB = (const char*)g.Bt + (size_t)cur.be * tstep;
    S.a_ready(cur);
    if constexpr (SP2) {
        PG8_STAGE(PG8_SB(0, 0), cB, voffB); PG8_STAGE(PG8_SB(0, 1), cB + hstep, voffB); PG8_STA(PG8_SA(0, 0), cA, 0, false); PG8_STA(PG8_SA(0, 1), cA, 1, false);
        if (wr == 1) PG8_BAR;
        PG8_WAIT_V(2); PG8_BAR;
        PG8_STAGE(PG8_SB(1, 0), cB + kstep, voffB); PG8_STA(PG8_SA(1, 0), cA + kstep, 0, false); PG8_STAGE(PG8_SB(1, 1), cB + hstep + kstep, voffB);
        PG8_WAIT_V(6); PG8_BAR;
    } else {
        PG8_STAGE(PG8_SB(0, 0), cB, voffB); PG8_STAGE(PG8_SA(0, 0), cA, voffA); PG8_STAGE(PG8_SB(0, 1), cB + hstep, voffB); PG8_STAGE(PG8_SA(0, 1), cA + hstep, voffA);
        if (wr == 1) PG8_BAR;
        PG8_WAIT_V(4); PG8_BAR;
        PG8_STAGE(PG8_SB(1, 0), cB + kstep, voffB); PG8_STAGE(PG8_SA(1, 0), cA + kstep, voffA); PG8_STAGE(PG8_SB(1, 1), cB + hstep + kstep, voffB);
        PG8_WAIT_V(6); PG8_BAR;
    }
    for (;;) {
        const bool has_next = S.next(ui + 1, nxt);
        const char* nA = (has_next && !Sched::GATHER) ? (const char*)g.A + (size_t)nxt.pm * tstep : cA; const char* nB = has_next ? (const char*)g.Bt + (size_t)nxt.be * tstep : cB;
        if constexpr (Sched::GATHER) { if (has_next) PG8_GLOAD(gN_, nxt.pm); else { gN_[0] = gA_[0]; gN_[1] = gA_[1]; } }
        for (int t = 0; t < nt; t += 2) {
            const bool last = (t == nt - 2);
            const char* a1 = cA + (size_t)(t + 1) * kstep;
            const char* a2 = last ? nA : cA + (size_t)(t + 2) * kstep; const char* b2 = last ? nB : cB + (size_t)(t + 2) * kstep;
            const char* a3 = a2 + kstep; const char* b3 = b2 + kstep;
            if (last) E.preload(pre, cur, wr, wc, fr, fq);
            if (last && has_next) S.a_ready(nxt);
            if constexpr (SP2) {
            PG8_LDB(B0, 0, 0); PG8_LDB(B1, 0, 1); PG8_SCHED; PG8_LDA(At, 0, 0); PG8_STA(PG8_SA(1, 1), a1, 1, false);
            PG8_WAIT_V(8); PG8_WAIT_L(0); PG8_BAR; PG8_MMA(0, 0, At, B0); PG8_MMA(0, 1, At, B1); PG8_BAR; PG8_SCHED;
            PG8_LDA(At, 0, 1); PG8_STAGE(PG8_SB(0, 0), b2, voffB); PG8_STAGE(PG8_SB(0, 1), b2 + hstep, voffB); PG8_STA(PG8_SA(0, 0), a2, 0, last);
            PG8_WAIT_V(8); PG8_WAIT_L(0); PG8_BAR; PG8_MMA(1, 0, At, B0); PG8_MMA(1, 1, At, B1); PG8_BAR; PG8_SCHED;
            PG8_LDB(B0, 1, 0); PG8_LDB(B1, 1, 1); PG8_SCHED; PG8_LDA(At, 1, 0); PG8_STA(PG8_SA(0, 1), a2, 1, last);
            PG8_WAIT_V(8); PG8_WAIT_L(0); PG8_BAR; PG8_MMA(0, 0, At, B0); PG8_MMA(0, 1, At, B1); PG8_BAR; PG8_SCHED;
            PG8_LDA(At, 1, 1); PG8_STAGE(PG8_SB(1, 0), b3, voffB); PG8_STAGE(PG8_SB(1, 1), b3 + hstep, voffB); PG8_STA(PG8_SA(1, 0), a3, 0, last);
            PG8_WAIT_V(8); PG8_WAIT_L(0); PG8_BAR; PG8_MMA(1, 0, At, B0); PG8_MMA(1, 1, At, B1); PG8_BAR; PG8_SCHED;
            } else {
            PG8_LDB(B0, 0, 0); PG8_SCHED; PG8_LDA(At, 0, 0); PG8_STAGE(PG8_SA(1, 1), a1 + hstep, voffA);
            PG8_WAIT_L(8); PG8_BAR; PG8_WAIT_L(0); PG8_MMA(0, 0, At, B0); PG8_BAR; PG8_SCHED;
            PG8_LDB(B1, 0, 1); PG8_STAGE(PG8_SB(0, 0), b2, voffB);
            PG8_BAR; PG8_WAIT_L(0); PG8_MMA(0, 1, At, B1); PG8_BAR;
            PG8_LDA(At, 0, 1); PG8_STAGE(PG8_SA(0, 0), a2, voffA);
            PG8_BAR; PG8_WAIT_L(0); PG8_MMA(1, 0, At, B0); PG8_BAR; PG8_SCHED;
            PG8_STAGE(PG8_SB(0, 1), b2 + hstep, voffB);
            PG8_WAIT_V(6); PG8_BAR; PG8_MMA(1, 1, At, B1); PG8_BAR;
            PG8_LDB(B0, 1, 0); PG8_SCHED; PG8_LDA(At, 1, 0); PG8_STAGE(PG8_SA(0, 1), a2 + hstep, voffA);
            PG8_WAIT_L(8); PG8_BAR; PG8_WAIT_L(0); PG8_MMA(0, 0, At, B0); PG8_BAR; PG8_SCHED;
            PG8_LDB(B1, 1, 1); PG8_STAGE(PG8_SB(1, 0), b3, voffB);
            PG8_BAR; PG8_WAIT_L(0); PG8_MMA(0, 1, At, B1); PG8_BAR;
            PG8_LDA(At, 1, 1); PG8_STAGE(PG8_SA(1, 0), a3, voffA);
            PG8_BAR; PG8_WAIT_L(0); PG8_MMA(1, 0, At, B0); PG8_BAR; PG8_SCHED;
            PG8_STAGE(PG8_SB(1, 1), b3 + hstep, voffB);
            PG8_WAIT_V(6); PG8_BAR; PG8_MMA(1, 1, At, B1); PG8_BAR;
            }
        }
        if constexpr (ALIGN_EPI) { if (wr == 0) PG8_BAR; }
        if constexpr (!Epi::AFTER_DRAIN) { E(acc, cur, wr, wc, fr, fq, pre); S.done(cur); }
        if (!has_next) break;
#pragma unroll
        for (int a = 0; a < 2; ++a)
#pragma unroll
            for (int b = 0; b < 2; ++b)
#pragma unroll
                for (int m = 0; m < 4; ++m)
#pragma unroll
                    for (int n = 0; n < 2; ++n) acc[a][b][m][n] = (f32x4){0.f, 0.f, 0.f, 0.f};
        cur = nxt; cA = nA; cB = nB; ++ui;
        if constexpr (Sched::GATHER) { gA_[0] = gN_[0]; gA_[1] = gN_[1]; }
        if constexpr (ALIGN_EPI) { if (wr == 1) PG8_BAR; }
    }
    PG8_WAIT_V(0);
    if constexpr (!ALIGN_EPI) { if (wr == 0) PG8_BAR; }
    PG8_BAR;
    if constexpr (Epi::AFTER_DRAIN) { E.fused(acc, cur, wr, wc, fr, fq, lds, wid, lane); S.done(cur); }
#undef PG8_SA
#undef PG8_SB
#undef PG8_STAGE
#undef PG8_STA
#undef PG8_GLOAD
#undef PG8_LDA
#undef PG8_LDB
#undef PG8_MMA
#undef PG8_WAIT_V
#undef PG8_WAIT_L
#undef PG8_BAR
#undef PG8_SCHED
}
}

#ifndef PG8_SP2
#define PG8_SP2 true
#endif
#ifndef PG8_ALIGN
#define PG8_ALIGN true
#endif
#include <cmath>
namespace attn_body {
using bf16=__hip_bfloat16;
using bf16x8=__attribute__((ext_vector_type(8)))short;
using s16x4=__attribute__((ext_vector_type(4)))short;
using f32x16=__attribute__((ext_vector_type(16)))float;
using u32x4=__attribute__((ext_vector_type(4)))unsigned;
using f32x4_t=__attribute__((ext_vector_type(4)))float;
constexpr int NHEAD=8,SEQQ=8192,SEQK=8448,D=64,QP=512,KP=128,QIN=2048;
constexpr int NW=8,QBLK=32,QB=QBLK*NW,KVBLK=64,NQB=SEQQ/QB;
constexpr int ATTN_UNIT_ROWS=QB;
__device__ __forceinline__ int crow(int r,int hi){return (r&3)+8*(r>>2)+4*hi;}
#define SBAR() __builtin_amdgcn_sched_barrier(0)
__device__ __forceinline__ void cmask(f32x16&p0,f32x16&p1,int jb,int qrel,int hi){
  const float NEG=-INFINITY; int kb=64*jb+4*hi;
  #pragma unroll
  for(int r=0;r<16;++r){int kv=kb+(r&3)+8*(r>>2); if(kv>qrel)p0[r]=NEG; if(kv+32>qrel)p1[r]=NEG;}
}

constexpr int NSLOT=3, SLOTB=8192;
constexpr int LDS_K=0, LDS_V=NSLOT*SLOTB, LDS_WS=2*NSLOT*SLOTB, LDS_OST=LDS_WS+NW*64*4, LDS_BYTES=LDS_OST+NW*4096;
constexpr float C2=0.125f*1.4426950408889634f;
__device__ __forceinline__ void glds16(const void*gsrc,unsigned lds_dst){unsigned keep;
  asm volatile("s_mov_b32 %0, m0\n\ts_mov_b32 m0, %2\n\ts_nop 0\n\tglobal_load_lds_dwordx4 %1, off\n\ts_mov_b32 m0, %0":"=&s"(keep):"v"(gsrc),"s"(lds_dst):"memory");}
__device__ __forceinline__ float max3f(float a,float b,float c){float r;asm("v_max3_f32 %0, %1, %2, %3":"=v"(r):"v"(a),"v"(b),"v"(c));return r;}
__device__ __forceinline__ float max2f(float a,float b){float r;asm("v_max_f32_e32 %0, %1, %2":"=v"(r):"v"(a),"v"(b));return r;}
__device__ __forceinline__ float fadd_s(float a,float b){float r;asm("v_add_f32_e32 %0, %1, %2":"=v"(r):"v"(a),"v"(b));return r;}
__device__ __forceinline__ float fsub_s(float a,float b){float r;asm("v_sub_f32_e32 %0, %1, %2":"=v"(r):"v"(a),"v"(b));return r;}
typedef float f32x2_t __attribute__((ext_vector_type(2))); typedef __bf16 bf16x2_t __attribute__((ext_vector_type(2)));
__device__ __forceinline__ unsigned cvtpk_s(float lo,float hi){f32x2_t v={lo,hi};bf16x2_t b=__builtin_convertvector(v,bf16x2_t);return __builtin_bit_cast(unsigned,b);}
#define WAIT_BAR(N) asm volatile("s_waitcnt vmcnt(" #N ") lgkmcnt(0)\n\ts_barrier":::"memory")

__device__ __forceinline__ void qkt(f32x16&p0,f32x16&p1,const char*Kslot,const bf16x8*qr,const f32x16&negm,int r32,int hi){
  const char*kb=Kslot+hi*1024+r32*16;
  #pragma unroll
  for(int d0=0;d0<4;++d0){
    const bf16x8 b0=*reinterpret_cast<const bf16x8*>(kb+d0*2048);
    const bf16x8 b1=*reinterpret_cast<const bf16x8*>(kb+d0*2048+512);
    if(d0==0){p0=__builtin_amdgcn_mfma_f32_32x32x16_bf16(b0,qr[0],negm,0,0,0);p1=__builtin_amdgcn_mfma_f32_32x32x16_bf16(b1,qr[0],negm,0,0,0);}
    else{p0=__builtin_amdgcn_mfma_f32_32x32x16_bf16(b0,qr[d0],p0,0,0,0);p1=__builtin_amdgcn_mfma_f32_32x32x16_bf16(b1,qr[d0],p1,0,0,0);}}
}
typedef __attribute__((address_space(3))) const char* lds_cptr;
typedef short v4i16_t __attribute__((ext_vector_type(4)));
__device__ __forceinline__ void kload8(bf16x8*kf,lds_cptr kp){
  kf[0]=*(const __attribute__((address_space(3))) bf16x8*)(kp);      kf[1]=*(const __attribute__((address_space(3))) bf16x8*)(kp+512);
  kf[2]=*(const __attribute__((address_space(3))) bf16x8*)(kp+2048); kf[3]=*(const __attribute__((address_space(3))) bf16x8*)(kp+2560);
  kf[4]=*(const __attribute__((address_space(3))) bf16x8*)(kp+4096); kf[5]=*(const __attribute__((address_space(3))) bf16x8*)(kp+4608);
  kf[6]=*(const __attribute__((address_space(3))) bf16x8*)(kp+6144); kf[7]=*(const __attribute__((address_space(3))) bf16x8*)(kp+6656);
}
__device__ __forceinline__ void kload2(bf16x8*kf,lds_cptr kp,int j){ kf[2*j]=*(const __attribute__((address_space(3))) bf16x8*)(kp+j*2048); kf[2*j+1]=*(const __attribute__((address_space(3))) bf16x8*)(kp+j*2048+512); }
__device__ __forceinline__ s16x4 vtr(lds_cptr p){ return __builtin_bit_cast(s16x4,__builtin_amdgcn_ds_read_tr16_b64_v4i16((__attribute__((address_space(3))) v4i16_t*)p)); }
__device__ __forceinline__ float rowmax(const f32x16&p0,const f32x16&p1){
  float a=max3f(p0[0],p0[1],p1[0]),b=max3f(p0[2],p0[3],p1[1]);a=max3f(a,p1[2],p1[3]);
  #pragma unroll
  for(int r=4;r<16;r+=4){a=max3f(a,p0[r],p0[r+1]);b=max3f(b,p0[r+2],p0[r+3]);a=max3f(a,p1[r],p1[r+1]);b=max3f(b,p1[r+2],p1[r+3]);}
  const float m=max2f(a,b);
  auto rr=__builtin_amdgcn_permlane32_swap(__float_as_uint(m),__float_as_uint(m),false,false);
  return max2f(__uint_as_float(rr[0]),__uint_as_float(rr[1]));
}
__device__ __forceinline__ void pv(f32x16*o,int vb,bf16x8 pa0,bf16x8 pa1,bf16x8 pa2,bf16x8 pa3){
  #pragma unroll
  for(int d0=0;d0<2;++d0){s16x4 lo[4],hi[4];
    #pragma unroll
    for(int ks=0;ks<4;++ks){
      asm volatile("ds_read_b64_tr_b16 %0,%1 offset:%c2":"=&v"(lo[ks]):"v"(vb),"i"(d0*4096+ks*1024):"memory");
      asm volatile("ds_read_b64_tr_b16 %0,%1 offset:%c2":"=&v"(hi[ks]):"v"(vb),"i"(d0*4096+ks*1024+512):"memory");}
    asm volatile("s_waitcnt lgkmcnt(0)":::"memory");SBAR();
    #define PK(k) (bf16x8){lo[k][0],lo[k][1],lo[k][2],lo[k][3],hi[k][0],hi[k][1],hi[k][2],hi[k][3]}
    o[d0]=__builtin_amdgcn_mfma_f32_32x32x16_bf16(pa0,PK(0),o[d0],0,0,0);
    o[d0]=__builtin_amdgcn_mfma_f32_32x32x16_bf16(pa1,PK(1),o[d0],0,0,0);
    o[d0]=__builtin_amdgcn_mfma_f32_32x32x16_bf16(pa2,PK(2),o[d0],0,0,0);
    o[d0]=__builtin_amdgcn_mfma_f32_32x32x16_bf16(pa3,PK(3),o[d0],0,0,0);
    #undef PK
  }
}

#ifndef ATTN_STORE16
#define ATTN_STORE16(p,v) (*(u32x4*)(p)=(v))
#endif
struct QPre { const float* qg; const float* rc; const float* rs; };
template<int THRL> __device__ __forceinline__ void attn_unit(int b,int h,long qrow0,int NTarg,int tq0,const QPre&QN,const bf16*Q,const bf16*__restrict__ K,const bf16*__restrict__ V,bf16*O,char*shm){
  int tid_=threadIdx.x; asm volatile("":"+v"(tid_)); const int tid=tid_,lane=tid&63,r32=lane&31,hi=lane>>5; const int wid=__builtin_amdgcn_readfirstlane(tid>>6);
  const long krowbase=(long)b*SEQK; const int kvh=h>>2;
  const bf16*Qw=Q+(qrow0+wid*QBLK)*QIN+h*D;
  const bf16*Kh=K+krowbase*KP+kvh*D,*Vh=V+krowbase*KP+kvh*D;
  const unsigned lds0=(unsigned)(uintptr_t)shm;
  float*wsf=(float*)(shm+LDS_WS)+wid*64;
  const bf16*ksrc=Kh+(long)lane*KP+wid*8;
  const bf16*vsrc=Vh+(long)(16*(wid&3)+(lane>>2))*KP+(wid>>2)*32+(lane&3)*8;
  const unsigned kdst=lds0+LDS_K+wid*1024, vdst=lds0+LDS_V+wid*1024;
  #define DMA_K(t,slot) glds16(ksrc+(long)(t)*KVBLK*KP,(unsigned)__builtin_amdgcn_readfirstlane(kdst+(slot)))
  #define DMA_V(t,slot) glds16(vsrc+(long)(t)*KVBLK*KP,(unsigned)__builtin_amdgcn_readfirstlane(vdst+(slot)))
  const int vb0=(int)(lds0+LDS_V)+((lane>>4)&1)*32+(lane&3)*8+(4*hi+((lane&15)>>2))*64;
  const char*Kbase=shm+LDS_K; bf16x8 kf[8];
  const lds_cptr shm3=(lds_cptr)shm; const lds_cptr kp0=shm3+LDS_K+hi*1024+r32*16; const lds_cptr vp0=shm3+LDS_V+((lane>>4)&1)*32+(lane&3)*8+(4*hi+((lane&15)>>2))*64;
  const int NT=NTarg;
  DMA_K(0,0);DMA_V(0,0);DMA_K(1,SLOTB);
  bf16x8 qr[4];
  #pragma unroll
  for(int d0=0;d0<4;++d0)qr[d0]=*reinterpret_cast<const bf16x8*>(&Qw[(long)r32*QIN+d0*16+hi*8]);
  {
    float x[4][8]; float ss=0.f;
    #pragma unroll
    for(int d0=0;d0<4;++d0){
      #pragma unroll
      for(int e=0;e<8;++e){ x[d0][e]=__builtin_bit_cast(float,(unsigned)(unsigned short)qr[d0][e]<<16); ss+=x[d0][e]*x[d0][e]; } }
    ss+=__shfl_xor(ss,32);
    const float rstd=C2/sqrtf(ss*(1.0f/64.0f)+1e-6f);
    #pragma unroll
    for(int d0=0;d0<4;++d0){ const f32x4_t g0=*reinterpret_cast<const f32x4_t*>(QN.qg+16*d0+8*hi), g1=*reinterpret_cast<const f32x4_t*>(QN.qg+16*d0+8*hi+4);
      #pragma unroll
      for(int e=0;e<8;++e) x[d0][e]*=rstd*(e<4?g0[e]:g1[e-4]); }
    if(tq0>=0){ const int t=tq0+wid*QBLK+r32;
      #pragma unroll
      for(int d0=0;d0<2;++d0){ const float*cp=QN.rc+(long)t*32+16*d0+8*hi,*sp=QN.rs+(long)t*32+16*d0+8*hi;
        const f32x4_t c0=*reinterpret_cast<const f32x4_t*>(cp),c1=*reinterpret_cast<const f32x4_t*>(cp+4),s0=*reinterpret_cast<const f32x4_t*>(sp),s1=*reinterpret_cast<const f32x4_t*>(sp+4);
        #pragma unroll
        for(int e=0;e<8;++e){ const float cs=e<4?c0[e]:c1[e-4], sn=e<4?s0[e]:s1[e-4]; const float a=x[d0][e], bq=x[d0+2][e]; x[d0][e]=a*cs-bq*sn; x[d0+2][e]=bq*cs+a*sn; } } }
    #pragma unroll
    for(int d0=0;d0<4;++d0){ u32x4 pk; pk[0]=cvtpk_s(x[d0][0],x[d0][1]); pk[1]=cvtpk_s(x[d0][2],x[d0][3]); pk[2]=cvtpk_s(x[d0][4],x[d0][5]); pk[3]=cvtpk_s(x[d0][6],x[d0][7]); qr[d0]=__builtin_bit_cast(bf16x8,pk); }
  }
  float mhat=0.f,l_reg=0.f;f32x16 o[2];o[0]=f32x16{};o[1]=f32x16{};f32x16 negm=f32x16{};asm volatile("":"+v"(negm));
  const int qrel=wid*QBLK+r32;
  #define CMASK(P0,P1,t) do{}while(0)
  bool resc=false;
  #define START(P0,P1) do{ const float rm=rowmax(P0,P1); resc=false; \
    { const float dl=rm; mhat=fadd_s(mhat,dl); \
      _Pragma("unroll") for(int r=0;r<16;++r){P0[r]=fsub_s(P0[r],dl);P1[r]=fsub_s(P1[r],dl);} \
      _Pragma("unroll") for(int r=0;r<16;++r)negm[r]=-mhat; asm volatile("":"+v"(negm)); } \
    _Pragma("unroll") for(int r=0;r<16;++r)P0[r]=__builtin_amdgcn_exp2f(P0[r]); }while(0)
  #define RESC() do{ if(resc){ asm volatile("s_waitcnt lgkmcnt(0)":::"memory"); \
      _Pragma("unroll") for(int d_=0;d_<2;++d_) _Pragma("unroll") for(int r=0;r<16;++r)o[d_][r]*=wsf[crow(r,hi)]; } }while(0)
  f32x16 pA0,pA1,pB0,pB1;
  int sl_prev=0,sl_cur=0,sl_next=SLOTB;
  #define ROT() do{sl_prev=sl_cur;sl_cur=sl_next;sl_next=(sl_next==(NSLOT-1)*SLOTB)?0:sl_next+SLOTB;}while(0)
  DMA_K(2,2*SLOTB);
  WAIT_BAR(3);
  qkt(pA0,pA1,Kbase,qr,negm,r32,hi);asm volatile("s_nop 15\n\ts_nop 7":"+v"(pA0),"+v"(pA1));CMASK(pA0,pA1,0);
  START(pA0,pA1);
  _Pragma("unroll") for(int r=0;r<16;++r)pA1[r]=__builtin_amdgcn_exp2f(pA1[r]);
  WAIT_BAR(0);
  DMA_K(3,0);DMA_V(1,SLOTB);
  ROT();
  kload8(kf,kp0+sl_cur);
  WAIT_BAR(2);
  s16x4 vlo[8],vhi[8]; u32x4 pw0,pw1,pw2,pw3;
  #define PKW(P,B) cvtpk_s(P[B],P[B+1])
  #define PAF(k) __builtin_bit_cast(bf16x8,pw##k)
  #define VFR(i) (bf16x8){vlo[i][0],vlo[i][1],vlo[i][2],vlo[i][3],vhi[i][0],vhi[i][1],vhi[i][2],vhi[i][3]}
  #define PIN(x) asm volatile("":"+v"(x))
  #define MX3(a,b,c) __builtin_fmaxf(__builtin_fmaxf((a),(b)),(c))
  #define GAPA(MF,A0,A1,A2,A3,W0,W1,PW) do{ MF; sacc+=A0; sacc+=A1; sacc+=A2; sacc+=A3; PIN(sacc); W0; W1; PIN(PW); SBAR(); }while(0)
  #define EX(v) __builtin_amdgcn_exp2f(v)
  #define GAPB(MF,X,B) do{ MF; X[B]=EX(X[B]); X[B+1]=EX(X[B+1]); X[B+2]=EX(X[B+2]); X[B+3]=EX(X[B+3]); PIN(X); SBAR(); }while(0)
  #define VRD(i) do{ vlo[i]=vtr(vp_+(((i)>>2)*4096+((i)&3)*1024)); vhi[i]=vtr(vp_+(((i)>>2)*4096+((i)&3)*1024+512)); }while(0)
  #define KRD(G,j) do{ if(G){ kload2(kf,kp0+sl_next,j); SBAR(); } }while(0)
  #define STEP(C0,C1,P0,P1,t,GK,GV,GL) do{ SBAR(); \
    const lds_cptr vp_=vp0+sl_prev; \
    VRD(0); SBAR(); float sacc=(P0[0]+P0[1]); \
    GAPA(C0=__builtin_amdgcn_mfma_f32_32x32x16_bf16(kf[0],qr[0],negm,0,0,0), P0[2],P0[3],P0[4],P0[5],     pw0[0]=PKW(P0,0), pw0[1]=PKW(P0,2), pw0); \
    VRD(4); SBAR(); GAPA(C1=__builtin_amdgcn_mfma_f32_32x32x16_bf16(kf[1],qr[0],negm,0,0,0), P0[6],P0[7],P0[8],P0[9],     pw0[2]=PKW(P0,4), pw0[3]=PKW(P0,6), pw0); \
    VRD(1); SBAR(); GAPA(C0=__builtin_amdgcn_mfma_f32_32x32x16_bf16(kf[2],qr[1],C0,0,0,0),   P0[10],P0[11],P0[12],P0[13], pw1[0]=PKW(P0,8), pw1[1]=PKW(P0,10), pw1); \
    VRD(5); SBAR(); GAPA(C1=__builtin_amdgcn_mfma_f32_32x32x16_bf16(kf[3],qr[1],C1,0,0,0),   P0[14],P0[15],P1[0],P1[1],   pw1[2]=PKW(P0,12),pw1[3]=PKW(P0,14), pw1); \
    VRD(2); SBAR(); GAPA(C0=__builtin_amdgcn_mfma_f32_32x32x16_bf16(kf[4],qr[2],C0,0,0,0),   P1[2],P1[3],P1[4],P1[5],     pw2[0]=PKW(P1,0), pw2[1]=PKW(P1,2), pw2); \
    VRD(6); SBAR(); GAPA(C1=__builtin_amdgcn_mfma_f32_32x32x16_bf16(kf[5],qr[2],C1,0,0,0),   P1[6],P1[7],P1[8],P1[9],     pw2[2]=PKW(P1,4), pw2[3]=PKW(P1,6), pw2); \
    VRD(3); SBAR(); GAPA(C0=__builtin_amdgcn_mfma_f32_32x32x16_bf16(kf[6],qr[3],C0,0,0,0),   P1[10],P1[11],P1[12],P1[13], pw3[0]=PKW(P1,8), pw3[1]=PKW(P1,10), pw3); \
    VRD(7); SBAR(); GAPA(C1=__builtin_amdgcn_mfma_f32_32x32x16_bf16(kf[7],qr[3],C1,0,0,0),   P1[14],P1[15],0.f,0.f,       pw3[2]=PKW(P1,12),pw3[3]=PKW(P1,14), pw3); \
    l_reg+=sacc; \
    if(GK){DMA_K((t)+3,sl_cur);} if(GV){DMA_V((t)+1,sl_next);} \
    CMASK(C0,C1,t); \
    { float a=MX3(C0[0],C0[1],C1[0]),b=MX3(C0[2],C0[3],C1[1]); a=MX3(a,C1[2],C1[3]); \
      _Pragma("unroll") for(int r=4;r<16;r+=4){a=MX3(a,C0[r],C0[r+1]);b=MX3(b,C0[r+2],C0[r+3]);a=MX3(a,C1[r],C1[r+1]);b=MX3(b,C1[r+2],C1[r+3]);} \
      float rm=__builtin_fmaxf(a,b); { auto rr=__builtin_amdgcn_permlane32_swap(__float_as_uint(rm),__float_as_uint(rm),false,false); rm=__builtin_fmaxf(__uint_as_float(rr[0]),__uint_as_float(rr[1])); } \
      resc=false; \
      if(__builtin_expect(__any(rm>(float)THRL),0)){ const float dl=__builtin_fmaxf(rm,0.f); mhat+=dl; \
        _Pragma("unroll") for(int r=0;r<16;++r){C0[r]-=dl;C1[r]-=dl;} \
        _Pragma("unroll") for(int r=0;r<16;++r)negm[r]=-mhat; asm volatile("":"+v"(negm)); \
        const float f=__builtin_amdgcn_exp2f(-dl); l_reg*=f; if(hi==0)wsf[r32]=f; resc=true; } } \
    SBAR(); \
    GAPB(o[0]=__builtin_amdgcn_mfma_f32_32x32x16_bf16(PAF(0),VFR(0),o[0],0,0,0), C0,0); \
    GAPB(o[1]=__builtin_amdgcn_mfma_f32_32x32x16_bf16(PAF(0),VFR(4),o[1],0,0,0), C0,4); \
    KRD(GL,0); GAPB(o[0]=__builtin_amdgcn_mfma_f32_32x32x16_bf16(PAF(1),VFR(1),o[0],0,0,0), C0,8); \
    KRD(GL,1); GAPB(o[1]=__builtin_amdgcn_mfma_f32_32x32x16_bf16(PAF(1),VFR(5),o[1],0,0,0), C0,12); \
    KRD(GL,2); GAPB(o[0]=__builtin_amdgcn_mfma_f32_32x32x16_bf16(PAF(2),VFR(2),o[0],0,0,0), C1,0); \
    KRD(GL,3); GAPB(o[1]=__builtin_amdgcn_mfma_f32_32x32x16_bf16(PAF(2),VFR(6),o[1],0,0,0), C1,4); \
    GAPB(o[0]=__builtin_amdgcn_mfma_f32_32x32x16_bf16(PAF(3),VFR(3),o[0],0,0,0), C1,8); \
    GAPB(o[1]=__builtin_amdgcn_mfma_f32_32x32x16_bf16(PAF(3),VFR(7),o[1],0,0,0), C1,12); \
    }while(0)
  int t=1;
  #undef CMASK
  #define CMASK(P0,P1,t) do{}while(0)
  for(;t+5<NT;t+=2){
    STEP(pB0,pB1,pA0,pA1,t,true,true,true);     WAIT_BAR(2); RESC(); ROT();
    STEP(pA0,pA1,pB0,pB1,t+1,true,true,true);   WAIT_BAR(2); RESC(); ROT();
  }
  #undef CMASK
  #define CMASK(P0,P1,t) do{}while(0)
  #define ENDW(tt) do{ if((tt)+3<NT){WAIT_BAR(2);} else if((tt)+2<NT){WAIT_BAR(1);} else {WAIT_BAR(0);} }while(0)
  for(;t+1<NT;t+=2){
    STEP(pB0,pB1,pA0,pA1,t,(t+3<NT),(t+1<NT),(t+1<NT));       ENDW(t);   RESC(); ROT();
    STEP(pA0,pA1,pB0,pB1,t+1,(t+4<NT),(t+2<NT),(t+2<NT));     ENDW(t+1); RESC(); ROT();
  }
  STEP(pB0,pB1,pA0,pA1,NT-1,false,false,false); RESC();
  { float sacc=pB0[0]+pB0[1]; _Pragma("unroll") for(int r=2;r<16;++r)sacc+=pB0[r]; _Pragma("unroll") for(int r=0;r<16;++r)sacc+=pB1[r]; l_reg+=sacc;
    pw0=(u32x4){PKW(pB0,0),PKW(pB0,2),PKW(pB0,4),PKW(pB0,6)};pw1=(u32x4){PKW(pB0,8),PKW(pB0,10),PKW(pB0,12),PKW(pB0,14)};pw2=(u32x4){PKW(pB1,0),PKW(pB1,2),PKW(pB1,4),PKW(pB1,6)};pw3=(u32x4){PKW(pB1,8),PKW(pB1,10),PKW(pB1,12),PKW(pB1,14)};
    SBAR(); pv(o,vb0+sl_cur,PAF(0),PAF(1),PAF(2),PAF(3)); }
  #undef PKW
  #undef PAF
  #undef VFR
  #undef PIN
  #undef MX3
  #undef GAPA
  #undef GAPB
  #undef EX
  #undef VRD
  #undef KRD
  #undef STEP
  #undef ENDW
  {auto rr=__builtin_amdgcn_permlane32_swap(__float_as_uint(l_reg),__float_as_uint(l_reg),false,false);l_reg=__uint_as_float(rr[0])+__uint_as_float(rr[1]);}
  if(hi==0)wsf[32+r32]=l_reg;asm volatile("s_waitcnt lgkmcnt(0)":::"memory");
  float rli[16];
  #pragma unroll
  for(int r=0;r<16;++r)rli[r]=__builtin_amdgcn_rcpf(wsf[32+crow(r,hi)]);
  bf16*Ow=O+(qrow0+wid*QBLK)*QP+h*D;
  { bf16*stg=(bf16*)(shm+LDS_OST)+wid*2048;
    #pragma unroll
    for(int r=0;r<16;++r){const int orow=crow(r,hi);
      #pragma unroll
      for(int d0=0;d0<2;++d0)stg[orow*64+d0*32+r32]=__float2bfloat16(o[d0][r]*rli[r]);}
    asm volatile("s_waitcnt lgkmcnt(0)":::"memory");
    #pragma unroll
    for(int i=0;i<4;++i){const int row=i*8+(lane>>3),ch=lane&7; const u32x4 v=*(const u32x4*)(stg+row*64+ch*8); ATTN_STORE16(Ow+(long)row*QP+ch*8,v);} }
  asm volatile("s_waitcnt lgkmcnt(0)\n\ts_barrier":::"memory");
  #undef DMA_K
  #undef DMA_V
  #undef CMASK
  #undef START
  #undef RESC
  #undef ROT
}
constexpr int ATTN_LDS_BYTES=LDS_BYTES;
struct AttnTensors { const bf16* Q; const bf16* K; const bf16* V; bf16* O; };
template<int THRL=8> __device__ __forceinline__ void attn_phase(char*lds,const AttnTensors&T,const QPre&QN,int G,int vcu,bool with_ctx,long ctx_row0){
  const int total=4*NHEAD*NQB;
  for(int i=0;;++i){
    int x,n;
    if(G==256){ if(i>=4)break; x=vcu>>5; n=i*32+(vcu&31); }
    else { const int u=i*G+vcu; if(u>=total)break; x=u>>7; n=u&127; }
    const int b=x>>1,kvh=x&1,h=kvh*4+(n>>5),qb=n&31;
    attn_unit<THRL>(b,h,(long)b*SEQQ+(long)qb*QB,SEQK/KVBLK,qb*QB,QN,T.Q,T.K,T.V,T.O,lds);
  }
  if(with_ctx){
    for(int u=vcu;u<4*NHEAD;u+=G){ const int b=u>>3,h=u&7; attn_unit<THRL>(b,h,ctx_row0+(long)b*256,4,-1,QN,T.Q,T.K,T.V,T.O,lds); }
  }
}
#undef SBAR
#undef WAIT_BAR
}

constexpr int NWAVES = 8, NTHR = 512;
constexpr int DMODEL = 1024, NB = 4, SEQ = 8192, CTXL = 256, NLAT = NB * SEQ, NCTX = NB * CTXL, MT = NLAT + NCTX;
constexpr int INW = 2048, NE = 32, KEYS = SEQ + CTXL;
constexpr int SORT_TILES = 560, SORT_ROWS = SORT_TILES * 256;
constexpr float EPSN = 1e-6f;
constexpr int NCHUNK = 66, CHUNK = 128;
constexpr int YS_PITCH = 1088;
constexpr int NPH_PRO = 2, NPH_LAYER = 13, NPH = NPH_PRO + 2 * NPH_LAYER;

constexpr size_t MiB = 1u << 20;
constexpr size_t WS_CTL = 0, CTL_ZERO_BYTES = 1 * MiB;
constexpr size_t WS_MOD = 1 * MiB, WS_ROPEC = 2 * MiB, WS_ROPES = 3 * MiB, WS_H2 = 4 * MiB, WS_KFC = 10 * MiB, WS_BLKCNT = 12 * MiB, WS_TILEE = 13 * MiB, WS_SCANS = 14 * MiB;
constexpr size_t WS_WINT = 16 * MiB, WS_WOUTT = 24 * MiB, WS_W1T = 32 * MiB, WS_W2T = 288 * MiB, WS_KF = 416 * MiB, WS_KHAT = 448 * MiB, WS_XR = 512 * MiB, WS_H = 644 * MiB;
constexpr size_t WS_U = 712 * MiB, WS_Q = 844 * MiB, WS_K = 877 * MiB, WS_V = 886 * MiB, WS_ATT = 895 * MiB, WS_LAB = 928 * MiB, WS_LRUO = 1060 * MiB, WS_VT = 1093 * MiB, WS_X0T = 1125 * MiB,
                 WS_HYO = 1157 * MiB, WS_MIXA = 1190 * MiB;
constexpr size_t WS_WGT = 11 * MiB, WS_SPT = 10 * MiB + 768 * 1024, WS_XL = 1256 * MiB;
constexpr size_t WS_GC = 10 * MiB + 896 * 1024;
constexpr size_t WS_CB = 10 * MiB + 960 * 1024;
constexpr size_t WS_F = 712 * MiB, WS_ASORT = 778 * MiB, WS_ACT = 1058 * MiB, WS_YS = 1338 * MiB, WS_TOPI = 1618 * MiB, WS_GATE = 1619 * MiB, WS_POS = 1620 * MiB, WS_RSSP = 1622 * MiB, WS_ROWTOK = 1625 * MiB, WS_END = 1626 * MiB;
constexpr size_t LAB_STRIDE = (size_t)MT * 256;
constexpr int CW_BAR = 4096;
constexpr int CW_NTILES = 64;

constexpr int RING_OFF = 0, RING_BYTES = 131072, MOETAB_OFF = 131072, LDSCTL_OFF = 155648, LDS_BYTES = 156160;

#define GAS __attribute__((address_space(1)))
#define LAS __attribute__((address_space(3)))
typedef unsigned short bf16;
typedef unsigned v4u __attribute__((ext_vector_type(4)));
typedef unsigned v2u __attribute__((ext_vector_type(2)));
typedef float f32x4 __attribute__((ext_vector_type(4)));
#define LDS_WAIT() asm volatile("s_waitcnt lgkmcnt(0)" ::: "memory")
#define VM_WAIT() asm volatile("s_waitcnt vmcnt(0)" ::: "memory")
__device__ __forceinline__ unsigned f2bf(float f) { unsigned u = __builtin_bit_cast(unsigned, f); return (u + 0x7fffu + ((u >> 16) & 1u)) >> 16; }
__device__ __forceinline__ unsigned pk2(float lo, float hi) { return f2bf(lo) | (f2bf(hi) << 16); }
__device__ __forceinline__ float bf2f(unsigned short b) { return __builtin_bit_cast(float, (unsigned)b << 16); }
__device__ __forceinline__ float bflo(unsigned w) { return __builtin_bit_cast(float, w << 16); }
__device__ __forceinline__ float bfhi(unsigned w) { return __builtin_bit_cast(float, w & 0xffff0000u); }
__device__ __forceinline__ float wave_sum(float v) {
#pragma unroll
    for (int o = 1; o < 64; o <<= 1) v += __shfl_xor(v, o);
    return v;
}
__device__ __forceinline__ float sigmoidf_(float x) { return 1.0f / (1.0f + __expf(-x)); }
__device__ __forceinline__ void sincos_d(double x, double& s, double& c) {
    const double kd = __builtin_rint(x * 0.63661977236758134308);
    const int k = (int)kd;
    double r = __builtin_fma(-kd, 1.57079632673412561417e+00, x);
    r = __builtin_fma(-kd, 6.07710050650619224932e-11, r);
    const double z = r * r;
    const double ps = r + r * z * (-1.66666666666666324348e-01 + z * (8.33333333332248946124e-03 + z * (-1.98412698298579493134e-04 + z * (2.75573137070700676789e-06 + z * (-2.50507602534068634195e-08 + z * 1.58969099521155010221e-10)))));
    const double pc = 1.0 - 0.5 * z + z * z * (4.16666666666666019037e-02 + z * (-1.38888888888741095749e-03 + z * (2.48015872894767294178e-05 + z * (-2.75573143513906633035e-07 + z * (2.08757232129817482790e-09 + z * -1.13596475577881948265e-11)))));
    const int q = k & 3;
    s = (q == 0) ? ps : (q == 1) ? pc : (q == 2) ? -ps : -pc;
    c = (q == 0) ? pc : (q == 1) ? -ps : (q == 2) ? -pc : ps;
}
__device__ __forceinline__ float gelu_tanh(float x) {
    const float u = 0.7978845608028654f * (x + 0.044715f * x * x * x);
    const float t = 1.0f - 2.0f / (1.0f + __expf(2.0f * u));
    return 0.5f * x * (1.0f + t);
}
__device__ __forceinline__ int lds_add(LAS int* p, int v) { return __hip_atomic_fetch_add(p, v, __ATOMIC_RELAXED, __HIP_MEMORY_SCOPE_WORKGROUP); }

#define FFT_FN __device__ __forceinline__
typedef float f32x2v __attribute__((ext_vector_type(2)));
#define FFT_VEC2 f32x2v
#define FFT_DPTR LAS f32x2v*
#define FFT_LD(D, i) c32_from((D)[i])
#define FFT_ST(D, i, v) ((D)[i] = c32_to(v))
struct __attribute__((aligned(8))) c32 { float x, y; };
FFT_FN c32 cmul(c32 a, c32 b) { c32 r; r.x = a.x * b.x - a.y * b.y; r.y = a.x * b.y + a.y * b.x; return r; }
FFT_FN c32 cadd(c32 a, c32 b) { c32 r; r.x = a.x + b.x; r.y = a.y + b.y; return r; }
FFT_FN c32 csub(c32 a, c32 b) { c32 r; r.x = a.x - b.x; r.y = a.y - b.y; return r; }
FFT_FN c32 cmuli_neg(c32 a) { c32 r; r.x = a.y; r.y = -a.x; return r; }
FFT_FN int fpad(int a) { return a + (a >> 4); }
#ifdef FFT_VEC2
FFT_FN c32 c32_from(FFT_VEC2 t) { c32 r; r.x = t.x; r.y = t.y; return r; }
FFT_FN FFT_VEC2 c32_to(c32 a) { FFT_VEC2 t; t.x = a.x; t.y = a.y; return t; }
#endif
FFT_FN void dft4(c32& a0, c32& a1, c32& a2, c32& a3) {
    const c32 s02 = cadd(a0, a2), d02 = csub(a0, a2), s13 = cadd(a1, a3), d13 = cmuli_neg(csub(a1, a3));
    a0 = cadd(s02, s13); a2 = csub(s02, s13); a1 = cadd(d02, d13); a3 = csub(d02, d13);
}
FFT_FN void dft16(c32 (&v)[16]) {
    const float C1 = 0.92387953251128674f, S1 = 0.38268343236508977f, C2 = 0.70710678118654752f;
#pragma unroll
    for (int q2 = 0; q2 < 4; ++q2) dft4(v[q2], v[4 + q2], v[8 + q2], v[12 + q2]);
    { c32 w;
      w.x = C1; w.y = -S1; v[4 * 1 + 1] = cmul(v[4 * 1 + 1], w);
      w.x = C2; w.y = -C2; v[4 * 2 + 1] = cmul(v[4 * 2 + 1], w);
      w.x = S1; w.y = -C1; v[4 * 3 + 1] = cmul(v[4 * 3 + 1], w);
      w.x = C2; w.y = -C2; v[4 * 1 + 2] = cmul(v[4 * 1 + 2], w);
      v[4 * 2 + 2] = cmuli_neg(v[4 * 2 + 2]);
      w.x = -C2; w.y = -C2; v[4 * 3 + 2] = cmul(v[4 * 3 + 2], w);
      w.x = S1; w.y = -C1; v[4 * 1 + 3] = cmul(v[4 * 1 + 3], w);
      w.x = -C2; w.y = -C2; v[4 * 2 + 3] = cmul(v[4 * 2 + 3], w);
      w.x = -C1; w.y = S1; v[4 * 3 + 3] = cmul(v[4 * 3 + 3], w); }
#pragma unroll
    for (int p1 = 0; p1 < 4; ++p1) dft4(v[4 * p1 + 0], v[4 * p1 + 1], v[4 * p1 + 2], v[4 * p1 + 3]);
#pragma unroll
    for (int a = 0; a < 4; ++a)
#pragma unroll
        for (int b = a + 1; b < 4; ++b) { const c32 t = v[4 * a + b]; v[4 * a + b] = v[4 * b + a]; v[4 * b + a] = t; }
}
FFT_FN c32 twid(int j, int n) { float rev = (float)j / (float)n; asm volatile("" : "+v"(rev)); c32 w; w.x = __builtin_amdgcn_cosf(rev); w.y = -__builtin_amdgcn_sinf(rev); return w; }

FFT_FN void fft_fwd16(FFT_DPTR D, int g, int n) {
    const int s = n >> 4, blk = g / s, j = g - blk * s, base = blk * n + j;
    c32 v[16];
#pragma unroll
    for (int q = 0; q < 16; ++q) v[q] = FFT_LD(D, fpad(base + q * s));
    dft16(v);
    const c32 w = twid(j, n); c32 wp = w;
#pragma unroll
    for (int p = 1; p < 16; ++p) { v[p] = cmul(v[p], wp); wp = cmul(wp, w); }
#pragma unroll
    for (int p = 0; p < 16; ++p) FFT_ST(D, fpad(base + p * s), v[p]);
}
FFT_FN void fft_inv16(FFT_DPTR D, int g, int n) {
    const int s = n >> 4, blk = g / s, j = g - blk * s, base = blk * n + j;
    c32 v[16];
#pragma unroll
    for (int q = 0; q < 16; ++q) v[q] = FFT_LD(D, fpad(base + q * s));
    const c32 w = twid(j, n); c32 wp = w;
#pragma unroll
    for (int p = 1; p < 16; ++p) { v[p] = cmul(v[p], wp); wp = cmul(wp, w); }
    dft16(v);
#pragma unroll
    for (int p = 0; p < 16; ++p) FFT_ST(D, fpad(base + p * s), v[p]);
}
FFT_FN void fft_mid16(FFT_DPTR D, int g, const c32* KH) {
    c32 v[16];
#pragma unroll
    for (int q = 0; q < 16; ++q) v[q] = FFT_LD(D, 17 * g + q);
    dft16(v);
#pragma unroll
    for (int p = 0; p < 16; ++p) { const c32 k = KH[16 * g + p]; const c32 t = cmul(v[p], k); v[p].x = t.x; v[p].y = -t.y; }
    dft16(v);
#pragma unroll
    for (int p = 0; p < 16; ++p) FFT_ST(D, 17 * g + p, v[p]);
}
typedef float fft_f32x4 __attribute__((ext_vector_type(4)));
FFT_FN void fft_mid16k(FFT_DPTR D, int g, const fft_f32x4 (&kv)[8]) {
    c32 v[16];
#pragma unroll
    for (int q = 0; q < 16; ++q) v[q] = FFT_LD(D, 17 * g + q);
    dft16(v);
#pragma unroll
    for (int p = 0; p < 16; ++p) { c32 k; k.x = kv[p >> 1][2 * (p & 1)]; k.y = kv[p >> 1][2 * (p & 1) + 1]; const c32 t = cmul(v[p], k); v[p].x = t.x; v[p].y = -t.y; }
    dft16(v);
#pragma unroll
    for (int p = 0; p < 16; ++p) FFT_ST(D, 17 * g + p, v[p]);
}
typedef float fft_f32x4o __attribute__((ext_vector_type(4)));
FFT_FN void fft_last16_out(FFT_DPTR D, int g, c32* OUT, float scale) {
    c32 v[16];
#pragma unroll
    for (int q = 0; q < 16; ++q) v[q] = FFT_LD(D, 17 * g + q);
    dft16(v);
#pragma unroll
    for (int pp = 0; pp < 8; ++pp) { fft_f32x4o t = {v[2 * pp].x * scale, v[2 * pp].y * scale, v[2 * pp + 1].x * scale, v[2 * pp + 1].y * scale};
        ((fft_f32x4o*)OUT)[((g >> 6) * 8 + pp) * 64 + (g & 63)] = t; }
}
FFT_FN void fft_first4(FFT_DPTR D, int j, c32 x0, c32 x1, c32 x2, c32 x3) {
    dft4(x0, x1, x2, x3);
    const c32 w = twid(j, 16384), w2 = cmul(w, w), w3 = cmul(w2, w);
    FFT_ST(D, fpad(j), x0); FFT_ST(D, fpad(j + 4096), cmul(x1, w)); FFT_ST(D, fpad(j + 8192), cmul(x2, w2)); FFT_ST(D, fpad(j + 12288), cmul(x3, w3));
}
FFT_FN void fft_final4(FFT_DPTR D, int j, c32& u0, c32& u1) {
    const c32 w = twid(j, 16384), w2 = cmul(w, w), w3 = cmul(w2, w);
    c32 a0 = FFT_LD(D, fpad(j)), a1 = cmul(FFT_LD(D, fpad(j + 4096)), w), a2 = cmul(FFT_LD(D, fpad(j + 8192)), w2), a3 = cmul(FFT_LD(D, fpad(j + 12288)), w3);
    dft4(a0, a1, a2, a3);
    u0 = a0; u1 = a1;
}
FFT_FN void fft_first4_inplace(FFT_DPTR D, int j) {
    c32 x0 = FFT_LD(D, fpad(j)), x1 = FFT_LD(D, fpad(j + 4096)), x2 = FFT_LD(D, fpad(j + 8192)), x3 = FFT_LD(D, fpad(j + 12288));
    fft_first4(D, j, x0, x1, x2, x3);
}
#define XB_TMO      128
#define XB_XCNT(j)  (256  + 64 * (j))
#define XB_XSUB(j)  (1280 + 64 * (j))
#define XB_XGEN(j)  (2304 + 64 * (j))
#define XB_TOP      3328
#define XB_TOPGEN   3392
#define XCD_BAR_WORDS 3456
#define XB_SPIN_CAP (1u << 22)

__device__ __forceinline__ unsigned xb_ld(unsigned* p)              { return __hip_atomic_load(p, __ATOMIC_RELAXED, __HIP_MEMORY_SCOPE_AGENT); }
__device__ __forceinline__ unsigned xb_add(unsigned* p, unsigned v) { return __hip_atomic_fetch_add(p, v, __ATOMIC_RELAXED, __HIP_MEMORY_SCOPE_AGENT); }
__device__ __forceinline__ unsigned xb_xcc_id() { return (unsigned)__builtin_amdgcn_s_getreg((3 << 11) | 20) & 0xFu; }
#define XB_SPIN(cond, bar) do { unsigned _sp = 0; while (cond) { __builtin_amdgcn_s_sleep(1); \
    if ((++_sp & 255u) == 0u) { if (xb_ld(&(bar)[XB_TMO])) break; if (_sp > XB_SPIN_CAP) { atomicAdd(&(bar)[XB_TMO], 1u); break; } } } } while (0)

struct XcdBarrier {
    unsigned* bar; unsigned x;
    volatile LAS unsigned* st;
};

__device__ __forceinline__ XcdBarrier xcd_barrier_post(unsigned* bar, volatile LAS unsigned* st) {
    XcdBarrier b; b.bar = bar; b.x = xb_xcc_id(); b.st = st;
    if (threadIdx.x == 0) (void)xb_add(&bar[XB_XCNT(b.x)], 1u);
    return b;
}
__device__ __forceinline__ void xcd_barrier_complete(unsigned* bar, unsigned x, unsigned& nloc, unsigned& nx) {
    const unsigned G = gridDim.x * gridDim.y * gridDim.z;
    unsigned sum, cnt, mine, sp = 0u;
    for (;;) {
        sum = 0u; cnt = 0u; mine = 0u;
#pragma unroll
        for (unsigned j = 0; j < 16; ++j) { const unsigned c = xb_ld(&bar[XB_XCNT(j)]); sum += c; cnt += (c > 0u) ? 1u : 0u; mine = (j == x) ? c : mine; }
        if (sum == G) break;
        __builtin_amdgcn_s_sleep(1);
        if ((++sp & 255u) == 0u) { if (xb_ld(&bar[XB_TMO])) break; if (sp > XB_SPIN_CAP) { atomicAdd(&bar[XB_TMO], 1u); break; } }
    }
    nloc = mine > 0u ? mine : 1u; nx = cnt > 0u ? cnt : 1u;
}

__device__ __forceinline__ void xcd_barrier(const XcdBarrier& b) {
    asm volatile("s_waitcnt vmcnt(0)" ::: "memory");
    __syncthreads();
    if (threadIdx.x == 0) {
        unsigned* bar = b.bar;
        __builtin_amdgcn_s_waitcnt(0);
        unsigned nloc = b.st[0], nx = b.st[1];
        if (nloc == 0u) { xcd_barrier_complete(bar, b.x, nloc, nx); b.st[0] = nloc; b.st[1] = nx; }
        const unsigned old = xb_add(&bar[XB_XSUB(b.x)], 1u);
        const unsigned gen = old / nloc;
        if (old + 1u == (gen + 1u) * nloc) {
            __builtin_amdgcn_fence(__ATOMIC_RELEASE, "agent");
            asm volatile("s_waitcnt vmcnt(0)" ::: "memory");
            const unsigned og = xb_add(&bar[XB_TOP], 1u);
            const unsigned tg = og / nx;
            if (og + 1u == (tg + 1u) * nx) xb_add(&bar[XB_TOPGEN], 1u);
            else XB_SPIN(xb_ld(&bar[XB_TOPGEN]) == tg, bar);
            __builtin_amdgcn_fence(__ATOMIC_ACQUIRE, "agent");
            xb_add(&bar[XB_XGEN(b.x)], 1u);
            asm volatile("s_waitcnt vmcnt(0)" ::: "memory");
        } else {
            XB_SPIN(xb_ld(&bar[XB_XGEN(b.x)]) == gen, bar);
            __builtin_amdgcn_fence(__ATOMIC_ACQUIRE, "agent");
            asm volatile("s_waitcnt vmcnt(0)" ::: "memory");
        }
    }
    __syncthreads();
}


constexpr int CW_SPLIT = 8192, CTXWG = 32;
__device__ __forceinline__ void split_arrive_all(const XcdBarrier& b, unsigned* w) {
    asm volatile("s_waitcnt vmcnt(0)" ::: "memory");
    __syncthreads();
    if (threadIdx.x == 0) { const unsigned nloc = b.st[0]; const unsigned old = xb_add(&w[64 * b.x], 1u);
        if (old + 1u == nloc) { __builtin_amdgcn_fence(__ATOMIC_RELEASE, "agent"); asm volatile("s_waitcnt vmcnt(0)" ::: "memory"); (void)xb_add(&w[1024], 1u); } }
}
__device__ __forceinline__ void split_wait_all(const XcdBarrier& b, unsigned* w) {
    if (threadIdx.x == 0) { const unsigned nx = b.st[1]; XB_SPIN(xb_ld(&w[1024]) < nx, b.bar); __builtin_amdgcn_fence(__ATOMIC_ACQUIRE, "agent"); asm volatile("s_waitcnt vmcnt(0)" ::: "memory"); }
    __syncthreads();
}
__device__ __forceinline__ void split_arrive_flat(unsigned* w) {
    asm volatile("s_waitcnt vmcnt(0)" ::: "memory");
    __syncthreads();
    if (threadIdx.x == 0) { __builtin_amdgcn_fence(__ATOMIC_RELEASE, "agent"); asm volatile("s_waitcnt vmcnt(0)" ::: "memory"); (void)xb_add(&w[1088], 1u); }
}
__device__ __forceinline__ void split_wait_flat(const XcdBarrier& b, unsigned* w, unsigned target) {
    if (threadIdx.x == 0) { XB_SPIN(xb_ld(&w[1088]) < target, b.bar); __builtin_amdgcn_fence(__ATOMIC_ACQUIRE, "agent"); asm volatile("s_waitcnt vmcnt(0)" ::: "memory"); }
    __syncthreads();
}

struct Frame {
    LAS unsigned char* lds; unsigned* ctl; unsigned char* ws;
    int tid, lane, wave, vcu, G, gw, ngw;
};
__device__ const float ROPE_INV[16] = {1.0f, 0.5623413251903491f, 0.31622776601683794f, 0.1778279410038923f, 0.1f, 0.05623413251903491f, 0.03162277660168379f, 0.01778279410038923f,
                                       0.01f, 0.005623413251903491f, 0.0031622776601683794f, 0.001778279410038923f, 0.001f, 0.0005623413251903491f, 0.00031622776601683794f, 0.0001778279410038923f};

__device__ __forceinline__ void p0_transpose_item(const float* W, int K, int N, bf16* WT, LAS float* scr, int item, int lane) {
    const int nblk = N / 32, kb = item / nblk, nb = item % nblk, k0 = 64 * kb, n0 = 32 * nb;
#pragma unroll 8
    for (int i = 0; i < 32; ++i) { const int kk = 2 * i + (lane >> 5); scr[kk * 33 + (lane & 31)] = W[(size_t)(k0 + kk) * N + n0 + (lane & 31)]; }
    LDS_WAIT(); asm volatile("" ::: "memory");
    const int c = lane & 7;
#pragma unroll
    for (int j = 0; j < 4; ++j) { const int n = (lane >> 3) + 8 * j; const LAS float* s = scr + (8 * c) * 33 + n;
        v4u o; o.x = pk2(s[0 * 33], s[1 * 33]); o.y = pk2(s[2 * 33], s[3 * 33]); o.z = pk2(s[4 * 33], s[5 * 33]); o.w = pk2(s[6 * 33], s[7 * 33]);
        *(GAS v4u*)(WT + (size_t)(n0 + n) * K + k0 + 8 * c) = o; }
    LDS_WAIT(); asm volatile("" ::: "memory");
}

__device__ __forceinline__ void p0_transpose_item_f8(const float* W, int K, int N, unsigned char* WT, LAS float* scr, int item, int lane) {
    const int nblk = N / 32, kb = item / nblk, nb = item % nblk, k0 = 64 * kb, n0 = 32 * nb;
#pragma unroll 8
    for (int i = 0; i < 32; ++i) { const int kk = 2 * i + (lane >> 5); scr[kk * 33 + (lane & 31)] = __builtin_nontemporal_load(&W[(size_t)(k0 + kk) * N + n0 + (lane & 31)]); }
    LDS_WAIT(); asm volatile("" ::: "memory");
    const int c = lane & 7;
#pragma unroll
    for (int j = 0; j < 4; ++j) { const int n = (lane >> 3) + 8 * j; const LAS float* s = scr + (8 * c) * 33 + n;
        v2u o; o.x = pg8::pack4_fp8(s[0 * 33] * pg8::F8_SW, s[1 * 33] * pg8::F8_SW, s[2 * 33] * pg8::F8_SW, s[3 * 33] * pg8::F8_SW);
        o.y = pg8::pack4_fp8(s[4 * 33] * pg8::F8_SW, s[5 * 33] * pg8::F8_SW, s[6 * 33] * pg8::F8_SW, s[7 * 33] * pg8::F8_SW);
        *(GAS v2u*)(WT + (size_t)(n0 + n) * K + k0 + 8 * c) = o; }
    LDS_WAIT(); asm volatile("" ::: "memory");
}

__device__ __forceinline__ void ph_prologue_a(const Frame& F, const float* c, const float* cctx, const float* w_mod, const float* b_mod, const float* w_in, const float* w_out,
                                              const float* moe_w1, const float* moe_w2, const float* hy_w1, const float* hy_b1, const float* hy_w2, const float* hy_b2, const float* hy_freq, const float* lru_gw, const float* lru_lam) {
    {
        LAS float* scr = (LAS float*)(F.lds + F.wave * 16384);
        constexpr int I_IN = 2 * 1024, I_OUT = 2 * 512, I_W1 = 64 * 1024, I_W2 = 64 * 512, NIT = I_IN + I_OUT + I_W1 + I_W2;
        bf16* WinT = (bf16*)(F.ws + WS_WINT); bf16* WoutT = (bf16*)(F.ws + WS_WOUTT); bf16* W1T = (bf16*)(F.ws + WS_W1T); bf16* W2T = (bf16*)(F.ws + WS_W2T);
        for (int it = F.gw; it < NIT; it += F.ngw) {
            int r = it;
            if (r < I_IN) { const int m = r >> 10; p0_transpose_item(w_in + (size_t)m * 1024 * 2048, 1024, 2048, WinT + (size_t)m * 2048 * 1024, scr, r & 1023, F.lane); continue; } r -= I_IN;
            if (r < I_OUT) { const int m = r >> 9; p0_transpose_item(w_out + (size_t)m * 1024 * 1024, 1024, 1024, WoutT + (size_t)m * 1024 * 1024, scr, r & 511, F.lane); continue; } r -= I_OUT;
#if MOE_FP8
            if (r < I_W1) { const int m = r >> 10; p0_transpose_item_f8(moe_w1 + (size_t)m * 1024 * 2048, 1024, 2048, (unsigned char*)W1T + (size_t)m * 2048 * 1024, scr, r & 1023, F.lane); continue; } r -= I_W1;
            { const int m = r >> 9; p0_transpose_item_f8(moe_w2 + (size_t)m * 1024 * 1024, 1024, 1024, (unsigned char*)W2T + (size_t)m * 1024 * 1024, scr, r & 511, F.lane); }
#else
            if (r < I_W1) { const int m = r >> 10; p0_transpose_item(moe_w1 + (size_t)m * 1024 * 2048, 1024, 2048, W1T + (size_t)m * 2048 * 1024, scr, r & 1023, F.lane); continue; } r -= I_W1;
            { const int m = r >> 9; p0_transpose_item(moe_w2 + (size_t)m * 1024 * 1024, 1024, 1024, W2T + (size_t)m * 1024 * 1024, scr, r & 511, F.lane); }
#endif
        }
    }
    __syncthreads();
    {
        LAS float* sl = (LAS float*)(F.lds);
        LAS float* red = (LAS float*)(F.lds + 20480);
        float* MOD = (float*)(F.ws + WS_MOD);
        if ((int)blockIdx.x < 192) {
            for (int i = F.tid; i < 5 * 1024; i += NTHR) { const int r = i >> 10, k = i & 1023; const float v = (r < 4) ? c[r * 1024 + k] : cctx[k]; sl[i] = v / (1.0f + __expf(-v)); }
        }
        __syncthreads();
        for (int it = blockIdx.x; it < 192; it += F.G) {
            const int l = it / 96, n = (it % 96) * 64 + F.lane;
            float a0 = 0.f, a1 = 0.f, a2 = 0.f, a3 = 0.f, a4 = 0.f;
            const float* wp = w_mod + ((size_t)l * 1024 + F.wave * 128) * 6144 + n;
#pragma unroll 16
            for (int k = 0; k < 128; ++k) { const float w = wp[(size_t)k * 6144]; const int kk = F.wave * 128 + k;
                a0 += sl[kk] * w; a1 += sl[1024 + kk] * w; a2 += sl[2048 + kk] * w; a3 += sl[3072 + kk] * w; a4 += sl[4096 + kk] * w; }
            red[(F.wave * 5 + 0) * 64 + F.lane] = a0; red[(F.wave * 5 + 1) * 64 + F.lane] = a1; red[(F.wave * 5 + 2) * 64 + F.lane] = a2; red[(F.wave * 5 + 3) * 64 + F.lane] = a3; red[(F.wave * 5 + 4) * 64 + F.lane] = a4;
            __syncthreads();
            if (F.tid < 320) { const int r = F.tid >> 6, ln = F.tid & 63; float s = 0.f;
#pragma unroll
                for (int w = 0; w < 8; ++w) s += red[(w * 5 + r) * 64 + ln];
                const int nn = (it % 96) * 64 + ln; MOD[(size_t)(l * 5 + r) * 6144 + nn] = s + b_mod[l * 6144 + nn]; }
            __syncthreads();
        }
    }
    {
        bf16* WGT = (bf16*)(F.ws + WS_WGT); float* SPT = (float*)(F.ws + WS_SPT);
        for (int idx = blockIdx.x * NTHR + F.tid; idx < 2 * 1024 * 256; idx += F.G * NTHR) {
            const int l = idx >> 18, nidx = (idx >> 8) & 1023, k = idx & 255;
            const int pn = nidx >> 8, j = (nidx >> 7) & 1, cc = nidx & 127, d = pn >> 1, ch = 128 * (pn & 1) + cc, n = ch >> 6, e = ch & 63;
            const float v = ((k >> 6) == n) ? lru_gw[((size_t)((((l * 2 + d) * 2 + j) * 4 + n) * 64 + (k & 63))) * 64 + e] : 0.f;
            WGT[idx] = (bf16)f2bf(v); }
        for (int idx = blockIdx.x * NTHR + F.tid; idx < 2 * 2 * 256; idx += F.G * NTHR) SPT[idx] = log1pf(expf(-lru_lam[idx]));
    }
    {
        float* RC = (float*)(F.ws + WS_ROPEC); float* RS = (float*)(F.ws + WS_ROPES);
        for (int idx = blockIdx.x * NTHR + F.tid; idx < SEQ * 32; idx += F.G * NTHR) {
            const int t = idx >> 5, i = idx & 31; const int pos = (i < 16) ? (t >> 6) : (t & 63);
            const float ang = (float)pos * ROPE_INV[i & 15];
            double s, cc; sincos_d((double)ang, s, cc); RC[idx] = (float)cc; RS[idx] = (float)s; }
    }
    {
        float* H2 = (float*)(F.ws + WS_H2);
        for (int it = F.gw; it < 2 * SEQ + CTXL; it += F.ngw) {
            const int v = it >> 13, t = (v < 2) ? (it & (SEQ - 1)) : (it - 2 * SEQ), L = (v < 2) ? SEQ : CTXL, l = (v == 1) ? 1 : 0;
            const int j = F.lane;
            float z = 0.f;
            if (j == 0) z = (float)t / (float)(L - 1);
            else if (j <= 32) { const int b = (j - 1) & 15; const float band = 1e-4f + (float)b * ((15.0f - 1e-4f) / 15.0f);
                const float ang = ((6.283185307179586f / (float)L) * (float)t) * band;
                double s, cc; sincos_d((double)ang, s, cc); z = (j <= 16) ? (float)cc : -(float)s; }
            const float fr = hy_freq[l * 64 + j];
            float p1 = hy_b1[l * 64 + j];
            const float* w1 = hy_w1 + (size_t)l * 33 * 64;
#pragma unroll
            for (int i = 0; i < 33; ++i) p1 += __shfl(z, i) * w1[i * 64 + j];
            double s1, c1; sincos_d((double)(fr * p1), s1, c1); const float h1 = (float)s1;
            float p2 = hy_b2[l * 64 + j];
            const float* w2 = hy_w2 + (size_t)l * 64 * 64;
#pragma unroll 16
            for (int i = 0; i < 64; ++i) p2 += __shfl(h1, i) * w2[i * 64 + j];
            double s2, c2; sincos_d((double)(fr * p2), s2, c2);
            H2[((size_t)v * SEQ + t) * 64 + j] = (float)s2;
        }
    }
}

__device__ __forceinline__ float filter_taps(const Frame& F, const float* H2, const LAS float* w3c, LAS float* Df, LAS float* kt, int v, int L, float df, float db, int part) {
    float asum = 0.f;
    const int qq = F.lane & 3, rr = F.lane >> 2;
    f32x4 wf[4], wb[4];
#pragma unroll
    for (int u = 0; u < 4; ++u) { const int k = 16 * qq + 4 * u; wf[u] = (f32x4){w3c[k], w3c[k + 1], w3c[k + 2], w3c[k + 3]}; wb[u] = (f32x4){w3c[64 + k], w3c[64 + k + 1], w3c[64 + k + 2], w3c[64 + k + 3]}; }
    const float* hbase = H2 + (size_t)v * SEQ * 64 + 16 * qq; const float tinv = 1.0f / (float)(L - 1);
#pragma unroll 4
    for (int i = 0; i < L / 128; ++i) { const int t = 16 * (F.wave + 8 * i) + rr;
        const f32x4* hp = (const f32x4*)(hbase + (size_t)t * 64);
        const f32x4 h0 = hp[0], h1 = hp[1], h2 = hp[2], h3 = hp[3];
        float hf = ((h0.x * wf[0].x + h0.y * wf[0].y) + (h0.z * wf[0].z + h0.w * wf[0].w)) + ((h1.x * wf[1].x + h1.y * wf[1].y) + (h1.z * wf[1].z + h1.w * wf[1].w))
                 + ((h2.x * wf[2].x + h2.y * wf[2].y) + (h2.z * wf[2].z + h2.w * wf[2].w)) + ((h3.x * wf[3].x + h3.y * wf[3].y) + (h3.z * wf[3].z + h3.w * wf[3].w));
        float hb = ((h0.x * wb[0].x + h0.y * wb[0].y) + (h0.z * wb[0].z + h0.w * wb[0].w)) + ((h1.x * wb[1].x + h1.y * wb[1].y) + (h1.z * wb[1].z + h1.w * wb[1].w))
                 + ((h2.x * wb[2].x + h2.y * wb[2].y) + (h2.z * wb[2].z + h2.w * wb[2].w)) + ((h3.x * wb[3].x + h3.y * wb[3].y) + (h3.z * wb[3].z + h3.w * wb[3].w));
        hf += __builtin_bit_cast(float, __builtin_amdgcn_update_dpp(0, __builtin_bit_cast(int, hf), 0xB1, 0xf, 0xf, false)); hb += __builtin_bit_cast(float, __builtin_amdgcn_update_dpp(0, __builtin_bit_cast(int, hb), 0xB1, 0xf, 0xf, false));
        hf += __builtin_bit_cast(float, __builtin_amdgcn_update_dpp(0, __builtin_bit_cast(int, hf), 0x4E, 0xf, 0xf, false)); hb += __builtin_bit_cast(float, __builtin_amdgcn_update_dpp(0, __builtin_bit_cast(int, hb), 0x4E, 0xf, 0xf, false));
        if (qq < 2) { const float t01 = (float)t * tinv; const bool fw = (qq == 0);
            const float val = (fw ? hf : hb) * expf(-t01 * (fw ? df : db));
            if (fw || t >= 1) { asum += fabsf(val); const int pos = fw ? t : 2 * L - t;
                if (part < 2) Df[2 * fpad(pos) + part] = val; else kt[pos] = val; } } }
    return asum;
}
FFT_FN void fft_last16_inplace(FFT_DPTR D, int g) {
    c32 v[16];
#pragma unroll
    for (int q = 0; q < 16; ++q) v[q] = FFT_LD(D, 17 * g + q);
    dft16(v);
#pragma unroll
    for (int p = 0; p < 16; ++p) FFT_ST(D, 17 * g + p, v[p]);
}
FFT_FN int fft_freq_of(int pos) { return (pos >> 12) + 4 * ((pos >> 8) & 15) + 64 * ((pos >> 4) & 15) + 1024 * (pos & 15); }
FFT_FN int fft_pos_of(int f) { return ((f & 3) << 12) | (((f >> 2) & 15) << 8) | (((f >> 6) & 15) << 4) | (f >> 10); }

__device__ __forceinline__ void ph_prologue_b(const Frame& F, const float* hy_w3, const float* hy_decay, const float* gffn, const float* router_w, const float* router_b) {
    { const float* MOD = (const float*)(F.ws + WS_MOD); float* CB = (float*)(F.ws + WS_CB);
      for (int it = F.gw; it < 2 * 5 * 32; it += F.ngw) { const int lb = it >> 5, e = it & 31, l = lb / 5; const float* sf = MOD + (size_t)lb * 6144 + 3 * 1024; float s = 0.f;
#pragma unroll
          for (int q = 0; q < 16; ++q) { const int cc = 64 * q + F.lane; s += sf[cc] * router_w[(size_t)l * 32768 + cc * 32 + e]; }
          s = wave_sum(s); if (F.lane == 0) CB[it] = s + router_b[l * 32 + e]; } }
    { const float* MOD = (const float*)(F.ws + WS_MOD); float* GC = (float*)(F.ws + WS_GC);
      for (int idx = blockIdx.x * NTHR + F.tid; idx < 2 * 5 * 1024; idx += F.G * NTHR) { const int lb = idx >> 10, cc = idx & 1023, l = lb / 5; GC[idx] = gffn[l * 1024 + cc] * (1.0f + MOD[(size_t)lb * 6144 + 4 * 1024 + cc]); } }
    LAS f32x2v* D = (LAS f32x2v*)(F.lds);
    LAS float* kt = (LAS float*)(F.lds);
    LAS float* w3c = (LAS float*)(F.lds + 139264);
    LAS float* red = (LAS float*)(F.lds + 139264 + 512);
    const float* H2 = (const float*)(F.ws + WS_H2);
    c32* KHAT = (c32*)(F.ws + WS_KHAT); float* KFC = (float*)(F.ws + WS_KFC);
    LAS float* Df = (LAS float*)(F.lds);
    for (int it = blockIdx.x; it < 512; it += F.G) {
        const int c = it & 255;
        if (it < 256) {
            float inv[2];
#pragma unroll
            for (int v = 0; v < 2; ++v) {
                if (F.tid < 128) w3c[F.tid] = hy_w3[(size_t)v * 64 * 512 + (F.tid & 63) * 512 + (F.tid >> 6) * 256 + c];
                if (F.tid == 0) Df[2 * fpad(SEQ) + v] = 0.f;
                __syncthreads();
                float asum = filter_taps(F, H2, w3c, Df, kt, v, SEQ, fabsf(hy_decay[v * 512 + c]), fabsf(hy_decay[v * 512 + 256 + c]), v);
                asum = wave_sum(asum);
                if (F.lane == 0) red[v * 8 + F.wave] = asum;
                __syncthreads();
                float tot = 0.f;
#pragma unroll
                for (int w = 0; w < 8; ++w) tot += red[v * 8 + w];
                inv[v] = (1.0f / 16384.0f) / tot;
            }
#pragma unroll 1
            for (int i = 0; i < 8; ++i) fft_first4_inplace(D, F.tid + 512 * i);
            __syncthreads();
            { fft_fwd16(D, F.tid, 4096); fft_fwd16(D, F.tid + 512, 4096); }
            __syncthreads();
            { fft_fwd16(D, F.tid, 256); fft_fwd16(D, F.tid + 512, 256); }
            __syncthreads();
            _Pragma("unroll 1") for (int g_ = F.tid; g_ < 1024; g_ += 512) fft_last16_inplace(D, g_);
            __syncthreads();
            fft_f32x4o* out0 = (fft_f32x4o*)(KHAT + (size_t)c * 16384); fft_f32x4o* out1 = (fft_f32x4o*)(KHAT + (size_t)(256 + c) * 16384);
#pragma unroll 1
            for (int g = F.tid; g < 1024; g += 512) {
#pragma unroll
                for (int pp = 0; pp < 8; ++pp) { fft_f32x4o k0, k1;
#pragma unroll
                    for (int e = 0; e < 2; ++e) { const int pos = 16 * g + 2 * pp + e; const int fm = (16384 - fft_freq_of(pos)) & 16383; const int pq = fft_pos_of(fm);
                        const c32 z = FFT_LD(D, 17 * g + 2 * pp + e), zp = FFT_LD(D, fpad(pq));
                        k0[2 * e] = 0.5f * (z.x + zp.x) * inv[0]; k0[2 * e + 1] = 0.5f * (z.y - zp.y) * inv[0];
                        k1[2 * e] = 0.5f * (z.y + zp.y) * inv[1]; k1[2 * e + 1] = 0.5f * (zp.x - z.x) * inv[1]; }
                    const int oi = ((g >> 6) * 8 + pp) * 64 + (g & 63); out0[oi] = k0; out1[oi] = k1; }
            }
        } else {
            if (F.tid < 128) w3c[F.tid] = hy_w3[(size_t)(F.tid & 63) * 512 + (F.tid >> 6) * 256 + c];
            if (F.tid == 0) kt[CTXL] = 0.f;
            __syncthreads();
            float asum = filter_taps(F, H2, w3c, Df, kt, 2, CTXL, fabsf(hy_decay[c]), fabsf(hy_decay[256 + c]), 2);
            asum = wave_sum(asum);
            if (F.lane == 0) red[F.wave] = asum;
            __syncthreads();
            float tot = 0.f;
#pragma unroll
            for (int w = 0; w < 8; ++w) tot += red[w];
            const float invc = 1.0f / tot;
            float* dst = KFC + (size_t)c * 512;
            for (int j = F.tid; j < 2 * CTXL; j += NTHR) dst[j] = kt[j] * invc;
        }
        __syncthreads();
    }
}

__device__ __forceinline__ void ph_norm_mod(const Frame& F, int l, const float* x, const float* ctx, const float* gmix) {
    const float* XR = (const float*)(F.ws + WS_XR); const float* MOD = (const float*)(F.ws + WS_MOD); bf16* H = (bf16*)(F.ws + WS_H);
    for (int r = F.gw; r < MT; r += F.ngw) {
        const float* src = (l == 0) ? (r < NLAT ? x + (size_t)r * 1024 : ctx + (size_t)(r - NLAT) * 1024) : XR + (size_t)r * 1024;
        const int bidx = r < NLAT ? r / SEQ : 4;
        const float* shift = MOD + (size_t)(l * 5 + bidx) * 6144; const float* scale = shift + 1024; const float* g = gmix + l * 1024;
        f32x4 v[4]; float ss = 0.f;
#pragma unroll
        for (int j = 0; j < 4; ++j) { v[j] = ((const f32x4*)src)[64 * j + F.lane]; ss += (v[j].x * v[j].x + v[j].y * v[j].y) + (v[j].z * v[j].z + v[j].w * v[j].w); }
        const float rstd = 1.0f / sqrtf(wave_sum(ss) * (1.0f / 1024.0f) + EPSN);
#pragma unroll
        for (int j = 0; j < 4; ++j) { const int cb = 64 * j + F.lane; const f32x4 gg = ((const f32x4*)g)[cb], sc = ((const f32x4*)scale)[cb], sh = ((const f32x4*)shift)[cb];
            const f32x4 y = v[j] * rstd * gg * (sc + 1.0f) + sh;
            v2u o; o.x = pk2(y.x, y.y); o.y = pk2(y.z, y.w); ((v2u*)(H + (size_t)r * 1024))[cb] = o; }
    }
}

__device__ __forceinline__ void post_ab(const Frame& F, int l, int rbeg, int rend, int w0, int nw, const float* kg_, const float* lru_cw, const float* lru_cb) {
    const bf16* U = (const bf16*)(F.ws + WS_U);
    {
        bf16* K = (bf16*)(F.ws + WS_K); bf16* V = (bf16*)(F.ws + WS_V);
        const float* RC = (const float*)(F.ws + WS_ROPEC); const float* RS = (const float*)(F.ws + WS_ROPES);
        const int o8 = 8 * (F.lane & 7), hl = F.lane & 31;
        const f32x4 kg0 = *(const f32x4*)(kg_ + l * 64 + o8), kg1 = *(const f32x4*)(kg_ + l * 64 + o8 + 4);
        const bool lohalf = (F.lane & 4) == 0;
        for (int r2 = rbeg + 2 * w0; r2 < rend; r2 += 2 * nw) {
            const int r = r2 + (F.lane >> 5);
            const bool isctx = r >= NLAT; const int b = isctx ? (r - NLAT) / CTXL : r / SEQ; const int t = isctx ? (r - NLAT) % CTXL : r % SEQ;
            const v4u wk = ((const v4u*)(U + (size_t)r * INW + 512))[hl];
            f32x4 c0 = {1.f, 1.f, 1.f, 1.f}, c1 = c0, s0 = {0.f, 0.f, 0.f, 0.f}, s1 = s0;
            if (!isctx) { const float* rc = RC + t * 32 + 8 * (F.lane & 3); const float* rs = RS + t * 32 + 8 * (F.lane & 3);
                c0 = *(const f32x4*)rc; c1 = *(const f32x4*)(rc + 4); s0 = *(const f32x4*)rs; s1 = *(const f32x4*)(rs + 4); }
            const size_t krow = (size_t)b * KEYS + (isctx ? t : CTXL + t);
            float x[8] = {bflo(wk.x), bfhi(wk.x), bflo(wk.y), bfhi(wk.y), bflo(wk.z), bfhi(wk.z), bflo(wk.w), bfhi(wk.w)};
            float ss = 0.f;
#pragma unroll
            for (int i = 0; i < 8; ++i) ss += x[i] * x[i];
            ss += __shfl_xor(ss, 1); ss += __shfl_xor(ss, 2); ss += __shfl_xor(ss, 4);
            const float rstd = 1.0f / sqrtf(ss * (1.0f / 64.0f) + EPSN);
            float y[8], o[8];
#pragma unroll
            for (int i = 0; i < 8; ++i) y[i] = x[i] * rstd * (i < 4 ? kg0[i] : kg1[i - 4]);
#pragma unroll
            for (int i = 0; i < 8; ++i) { const float p = __shfl_xor(y[i], 4); const float cs = i < 4 ? c0[i] : c1[i - 4], sn = i < 4 ? s0[i] : s1[i - 4];
                o[i] = lohalf ? (y[i] * cs - p * sn) : (y[i] * cs + p * sn); }
            v4u ow; ow.x = pk2(o[0], o[1]); ow.y = pk2(o[2], o[3]); ow.z = pk2(o[4], o[5]); ow.w = pk2(o[6], o[7]);
            if (hl < 16) ((v4u*)(K + krow * 128))[hl] = ow; else ((v4u*)(V + krow * 128))[hl - 16] = wk;
        }
    }
    {
        bf16* XL = (bf16*)(F.ws + WS_XL);
        for (int idx = rbeg * 32 + w0 * 64 + F.lane; idx < rend * 32; idx += nw * 64) {
            const int r = idx >> 5, c8 = (idx & 31) * 8;
            const bool isctx = r >= NLAT; const int Ls = isctx ? CTXL : SEQ; const int t = isctx ? (r - NLAT) % CTXL : r % SEQ;
            float acc[8];
#pragma unroll
            for (int i = 0; i < 8; ++i) acc[i] = lru_cb[l * 256 + c8 + i];
#pragma unroll
            for (int j = 0; j < 4; ++j) { const int tj = t + j - 2;
                if (tj >= 0 && tj < Ls) { const v4u w = *(const v4u*)(U + (size_t)(r + j - 2) * INW + 768 + c8);
                    const f32x4 w0 = *(const f32x4*)(lru_cw + (l * 4 + j) * 256 + c8), w1 = *(const f32x4*)(lru_cw + (l * 4 + j) * 256 + c8 + 4);
                    acc[0] += w0.x * bflo(w.x); acc[1] += w0.y * bfhi(w.x); acc[2] += w0.z * bflo(w.y); acc[3] += w0.w * bfhi(w.y);
                    acc[4] += w1.x * bflo(w.z); acc[5] += w1.y * bfhi(w.z); acc[6] += w1.z * bflo(w.w); acc[7] += w1.w * bfhi(w.w); } }
            v4u o; o.x = pk2(acc[0], acc[1]); o.y = pk2(acc[2], acc[3]); o.z = pk2(acc[4], acc[5]); o.w = pk2(acc[6], acc[7]);
            *(v4u*)(XL + (size_t)r * 256 + c8) = o;
        }
    }
}
__device__ __forceinline__ void post_c(const Frame& F, int l, const float* hy_cw, const float* hy_cb) {
    const bf16* U = (const bf16*)(F.ws + WS_U);
    __syncthreads();
    {
        LAS bf16* hs = (LAS bf16*)(F.lds);
        bf16* VT = (bf16*)(F.ws + WS_VT); bf16* X0T = (bf16*)(F.ws + WS_X0T);
        const float* cw = hy_cw + (size_t)l * 3 * 768; const float* cbp = hy_cb + l * 768;
        for (int it = blockIdx.x; it < NLAT / 64; it += F.G) {
            const int b = it >> 7, t0 = (it & 127) * 64;
            for (int i = F.tid; i < 66 * 384; i += NTHR) { const int rr = i / 384, c2 = i - rr * 384; const int t = t0 - 1 + rr;
                unsigned w = 0u; if (t >= 0 && t < SEQ) w = *(const unsigned*)(U + (size_t)(b * SEQ + t) * INW + 1280 + 2 * c2);
                *(LAS unsigned*)(hs + rr * 770 + 2 * c2) = w; }
            __syncthreads();
            for (int c2 = F.wave; c2 < 128; c2 += NWAVES) {
                const int c = 2 * c2 + (F.lane >> 5), tt = 2 * (F.lane & 31);
                float o[3][2];
#pragma unroll
                for (int g = 0; g < 3; ++g) { const int cc = g * 256 + c; const float w0 = cw[cc], w1 = cw[768 + cc], w2 = cw[1536 + cc], bb = cbp[cc];
                    const float x0 = bf2f(hs[tt * 770 + cc]), x1 = bf2f(hs[(tt + 1) * 770 + cc]), x2 = bf2f(hs[(tt + 2) * 770 + cc]), x3 = bf2f(hs[(tt + 3) * 770 + cc]);
                    o[g][0] = w0 * x0 + w1 * x1 + w2 * x2 + bb; o[g][1] = w0 * x1 + w1 * x2 + w2 * x3 + bb; }
                const size_t oi = ((size_t)b * 256 + c) * SEQ + t0 + tt;
                *(unsigned*)(VT + oi) = pk2(o[2][0] * o[1][0], o[2][1] * o[1][1]); *(unsigned*)(X0T + oi) = pk2(o[0][0], o[0][1]);
            }
            __syncthreads();
        }
    }
}


typedef short sk_s16x8 __attribute__((ext_vector_type(8)));
__device__ __forceinline__ void ph_lru_gates(const Frame& F, int l, const float* lru_gb, int rt0, int nrt, int w0, int nw) {
    const bf16* XL = (const bf16*)(F.ws + WS_XL); const bf16* WG = (const bf16*)(F.ws + WS_WGT) + (size_t)l * 1024 * 256; bf16* LAB = (bf16*)(F.ws + WS_LAB);
    const float* gb = lru_gb + (size_t)l * 1024; const float* spt = (const float*)(F.ws + WS_SPT) + l * 512;
    const int fr = F.lane & 15, fq = F.lane >> 4;
    for (int it = w0; it < nrt * 8; it += nw) {
        const int rt = rt0 + (it >> 3), n = (it >> 1) & 3, d = it & 1, row0 = 32 * rt;
        const int wrow = ((2 * d + (n >> 1)) * 256 + 64 * (n & 1) + fr) * 256 + 64 * n + 8 * fq;
        const bf16* ap = XL + (size_t)(row0 + fr) * 256 + 64 * n + 8 * fq;
        const bf16* xp = XL + (size_t)(row0 + fr) * 256 + 64 * n + 4 * fq;
        sk_s16x8 a[2][2]; v2u xw[2][4];
#pragma unroll
        for (int ri = 0; ri < 2; ++ri) { a[ri][0] = *(const sk_s16x8*)(ap + ri * 16 * 256); a[ri][1] = *(const sk_s16x8*)(ap + ri * 16 * 256 + 32);
#pragma unroll
            for (int c = 0; c < 4; ++c) xw[ri][c] = *(const v2u*)(xp + ri * 16 * 256 + 16 * c); }
        f32x4 acc[2][4][2];
#pragma unroll
        for (int c = 0; c < 4; ++c)
#pragma unroll
            for (int g = 0; g < 2; ++g) { const bf16* bp = WG + wrow + (g * 128 + 16 * c) * 256;
                const sk_s16x8 b0 = *(const sk_s16x8*)bp, b1 = *(const sk_s16x8*)(bp + 32);
#pragma unroll
                for (int ri = 0; ri < 2; ++ri) { f32x4 z = {0.f, 0.f, 0.f, 0.f};
                    z = __builtin_amdgcn_mfma_f32_16x16x32_bf16(b0, a[ri][0], z, 0, 0, 0); acc[ri][c][g] = __builtin_amdgcn_mfma_f32_16x16x32_bf16(b1, a[ri][1], z, 0, 0, 0); } }
        bf16* LA = LAB + (size_t)(2 * d) * LAB_STRIDE; bf16* LB = LAB + (size_t)(2 * d + 1) * LAB_STRIDE;
#pragma unroll
        for (int c = 0; c < 4; ++c) { const int ch = 64 * n + 16 * c + 4 * fq;
            const f32x4 bR = *(const f32x4*)(gb + (d * 2 + 0) * 256 + ch), bI = *(const f32x4*)(gb + (d * 2 + 1) * 256 + ch);
            const f32x4 sp = *(const f32x4*)(spt + d * 256 + ch) * (-8.0f * 1.4426950408889634f);
#pragma unroll
            for (int ri = 0; ri < 2; ++ri) { const size_t ro = (size_t)(row0 + 16 * ri + fr) * 256 + ch;
                const float xl[4] = {bflo(xw[ri][c].x), bfhi(xw[ri][c].x), bflo(xw[ri][c].y), bfhi(xw[ri][c].y)};
                const f32x4 gr = acc[ri][c][0] + bR, gi = acc[ri][c][1] + bI; float av[4], bv[4];
#pragma unroll
                for (int e = 0; e < 4; ++e) {
                    const float rg = __builtin_amdgcn_rcpf(1.0f + __builtin_amdgcn_exp2f(-1.4426950408889634f * gr[e])), ig = __builtin_amdgcn_rcpf(1.0f + __builtin_amdgcn_exp2f(-1.4426950408889634f * gi[e]));
                    const float la2 = rg * sp[e]; const float a2 = __builtin_amdgcn_exp2f(2.0f * la2);
                    av[e] = la2; bv[e] = __builtin_amdgcn_sqrtf(fmaxf(1.0f - a2, 0.f)) * (ig * xl[e]); }
                v2u wa, wb; wa.x = pk2(av[0], av[1]); wa.y = pk2(av[2], av[3]); wb.x = pk2(bv[0], bv[1]); wb.y = pk2(bv[2], bv[3]);
                *(v2u*)(LA + ro) = wa; *(v2u*)(LB + ro) = wb; } }
    }
}

__device__ __forceinline__ int chunk_row0(int b, int d, int k) {
    if (k < 2) { const int cc = d ? 1 - k : k; return NLAT + b * CTXL + cc * CHUNK; }
    const int lc = d ? 63 - (k - 2) : (k - 2); return b * SEQ + lc * CHUNK;
}
template <bool TWO> __device__ __forceinline__ void scan1_items(const bf16* LAB, float* SUMP, float* SUMH, int it0, int it1) {
    const bf16* LA[2]; const bf16* LB[2]; int r0[2], dd[2];
#pragma unroll
    for (int q = 0; q < (TWO ? 2 : 1); ++q) { const int it = q ? it1 : it0;
        const int ch = it & 255, k = (it >> 8) % NCHUNK, bd = (it >> 8) / NCHUNK, d = bd & 1, b = bd >> 1;
        r0[q] = chunk_row0(b, d, k); dd[q] = d;
        LA[q] = LAB + (size_t)(2 * d) * LAB_STRIDE + ch; LB[q] = LAB + (size_t)(2 * d + 1) * LAB_STRIDE + ch; }
    float h[2] = {0.f, 0.f}, Ps[2] = {0.f, 0.f};
#pragma unroll 16
    for (int i = 0; i < CHUNK; ++i) {
#pragma unroll
        for (int q = 0; q < (TWO ? 2 : 1); ++q) { const int r = dd[q] ? r0[q] + CHUNK - 1 - i : r0[q] + i; const float la = bf2f(LA[q][(size_t)r * 256]), bx = bf2f(LB[q][(size_t)r * 256]); h[q] = __builtin_amdgcn_exp2f(la) * h[q] + bx; Ps[q] += la; } }
    SUMP[it0] = __builtin_amdgcn_exp2f(Ps[0]); SUMH[it0] = h[0];
    if (TWO) { SUMP[it1] = __builtin_amdgcn_exp2f(Ps[1]); SUMH[it1] = h[1]; }
}
__device__ __forceinline__ void ph_scan1(const Frame& F) {
    const bf16* LAB = (const bf16*)(F.ws + WS_LAB); float* SUMP = (float*)(F.ws + WS_SCANS); float* SUMH = SUMP + NB * 2 * NCHUNK * 256;
    const int total = NB * 2 * NCHUNK * 256, nthr = F.G * NTHR;
    for (int it = blockIdx.x * NTHR + F.tid; it < total; it += 2 * nthr) {
        if (it + nthr < total) scan1_items<true>(LAB, SUMP, SUMH, it, it + nthr); else scan1_items<false>(LAB, SUMP, SUMH, it, it);
    }
}
__device__ __forceinline__ void ph_scan2(const Frame& F) {
    const bf16* LAB = (const bf16*)(F.ws + WS_LAB); const float* SUMP = (const float*)(F.ws + WS_SCANS); const float* SUMH = SUMP + NB * 2 * NCHUNK * 256;
    bf16* HD = (bf16*)(F.ws + WS_LRUO);
    const int total = NB * 2 * NCHUNK * 128, per = (total + F.G - 1) / F.G;
    const int it = blockIdx.x * per + F.tid;
    if (F.tid < per && it < total) {
        const int ch = 2 * (it & 127), k = (it >> 7) % NCHUNK, bd = (it >> 7) / NCHUNK, d = bd & 1, b = bd >> 1;
        const int r0 = chunk_row0(b, d, k);
        const f32x2v* P = (const f32x2v*)(SUMP + (size_t)(bd * NCHUNK) * 256 + ch); const f32x2v* S = (const f32x2v*)(SUMH + (size_t)(bd * NCHUNK) * 256 + ch);
        float h0 = 0.f, h1 = 0.f;
#pragma unroll 8
        for (int j = 0; j < k; ++j) { const f32x2v p = P[(size_t)j * 128], q = S[(size_t)j * 128]; h0 = p.x * h0 + q.x; h1 = p.y * h1 + q.y; }
        const unsigned* __restrict__ LA = (const unsigned*)(LAB + (size_t)(2 * d) * LAB_STRIDE + ch); const unsigned* __restrict__ LB = (const unsigned*)(LAB + (size_t)(2 * d + 1) * LAB_STRIDE + ch);
        unsigned* __restrict__ HO = (unsigned*)(HD + (size_t)d * MT * 256 + ch);
#pragma unroll 16
        for (int i = 0; i < CHUNK; ++i) { const size_t r = (size_t)(d ? r0 + CHUNK - 1 - i : r0 + i) * 128; const unsigned la = LA[r], lb = LB[r];
            h0 = __builtin_amdgcn_exp2f(bflo(la)) * h0 + bflo(lb); h1 = __builtin_amdgcn_exp2f(bfhi(la)) * h1 + bfhi(lb); HO[r] = pk2(h0, h1); }
    }
}

__device__ __forceinline__ void ph_hyena_fft(const Frame& F, int l, const float* hy_bias) {
    LAS f32x2v* D = (LAS f32x2v*)(F.lds);
    const c32* KHAT = (const c32*)(F.ws + WS_KHAT) + (size_t)l * 256 * 16384;
    const bf16* VT = (const bf16*)(F.ws + WS_VT); const bf16* X0T = (const bf16*)(F.ws + WS_X0T); bf16* HYO = (bf16*)(F.ws + WS_HYO);
    for (int it = blockIdx.x; it < 512; it += F.G) {
        const int c = it >> 1, bp = it & 1;
        const bf16* va = VT + ((size_t)(bp * 2) * 256 + c) * SEQ; const bf16* vb = VT + ((size_t)(bp * 2 + 1) * 256 + c) * SEQ;
        {
            unsigned pa[4], pb[4], pc[4], pd[4];
#pragma unroll
            for (int i = 0; i < 4; ++i) { const int j = 2 * F.tid + 1024 * i; pa[i] = *(const unsigned*)(va + j); pb[i] = *(const unsigned*)(vb + j); pc[i] = *(const unsigned*)(va + j + 4096); pd[i] = *(const unsigned*)(vb + j + 4096); }
#pragma unroll
            for (int i = 0; i < 4; ++i) { const int j = 2 * F.tid + 1024 * i; c32 x0, x1, z; z.x = 0.f; z.y = 0.f;
                x0.x = bflo(pa[i]); x0.y = bflo(pb[i]); x1.x = bflo(pc[i]); x1.y = bflo(pd[i]); fft_first4(D, j, x0, x1, z, z);
                x0.x = bfhi(pa[i]); x0.y = bfhi(pb[i]); x1.x = bfhi(pc[i]); x1.y = bfhi(pd[i]); fft_first4(D, j + 1, x0, x1, z, z); }
        }
        __syncthreads();
        { fft_fwd16(D, F.tid, 4096); fft_fwd16(D, F.tid + 512, 4096); }
        __syncthreads();
        { fft_fwd16(D, F.tid, 256); fft_fwd16(D, F.tid + 512, 256); }
        __syncthreads();
        { fft_f32x4 kv0[8]; const fft_f32x4* kp = (const fft_f32x4*)(KHAT + (size_t)c * 16384);
#pragma unroll
          for (int q = 0; q < 8; ++q) kv0[q] = kp[((F.tid >> 6) * 8 + q) * 64 + (F.tid & 63)];
          fft_mid16k(D, F.tid, kv0); __builtin_amdgcn_sched_barrier(0);
#pragma unroll
          for (int q = 0; q < 8; ++q) kv0[q] = kp[(((F.tid + 512) >> 6) * 8 + q) * 64 + (F.tid & 63)];
          fft_mid16k(D, F.tid + 512, kv0); }
        __syncthreads();
        { fft_inv16(D, F.tid, 256); fft_inv16(D, F.tid + 512, 256); }
        __syncthreads();
        { fft_inv16(D, F.tid, 4096); fft_inv16(D, F.tid + 512, 4096); }
        __syncthreads();
        const bf16* xa = X0T + ((size_t)(bp * 2) * 256 + c) * SEQ; const bf16* xb = X0T + ((size_t)(bp * 2 + 1) * 256 + c) * SEQ;
        unsigned pa[4], pb[4], pc[4], pd[4], qa[4], qb[4], qc[4], qd[4];
#pragma unroll
        for (int i = 0; i < 4; ++i) { const int j = 2 * F.tid + 1024 * i; pa[i] = *(const unsigned*)(va + j); pb[i] = *(const unsigned*)(vb + j); pc[i] = *(const unsigned*)(va + j + 4096); pd[i] = *(const unsigned*)(vb + j + 4096);
            qa[i] = *(const unsigned*)(xa + j); qb[i] = *(const unsigned*)(xb + j); qc[i] = *(const unsigned*)(xa + j + 4096); qd[i] = *(const unsigned*)(xb + j + 4096); }
        const float bias = hy_bias[l * 256 + c];
        bf16* oa = HYO + ((size_t)(bp * 2) * 256 + c) * SEQ; bf16* ob = HYO + ((size_t)(bp * 2 + 1) * 256 + c) * SEQ;
#pragma unroll
        for (int i = 0; i < 4; ++i) { const int j = 2 * F.tid + 1024 * i; c32 u0, u1, w0, w1; fft_final4(D, j, u0, u1); fft_final4(D, j + 1, w0, w1);
            *(unsigned*)(oa + j) = pk2((u0.x + bflo(pa[i]) * bias) * bflo(qa[i]), (w0.x + bfhi(pa[i]) * bias) * bfhi(qa[i]));
            *(unsigned*)(ob + j) = pk2((-u0.y + bflo(pb[i]) * bias) * bflo(qb[i]), (-w0.y + bfhi(pb[i]) * bias) * bfhi(qb[i]));
            *(unsigned*)(oa + j + 4096) = pk2((u1.x + bflo(pc[i]) * bias) * bflo(qc[i]), (w1.x + bfhi(pc[i]) * bias) * bfhi(qc[i]));
            *(unsigned*)(ob + j + 4096) = pk2((-u1.y + bflo(pd[i]) * bias) * bflo(qd[i]), (-w1.y + bfhi(pd[i]) * bias) * bfhi(qd[i])); }
        __syncthreads();
    }
}
__device__ __forceinline__ void ph_hyena_ctx(const Frame& F, const float* hy_bias, const float* hy_cw, const float* hy_cb) {
    float* HYO = (float*)(F.ws + WS_HYO);
    {

        const bf16* U = (const bf16*)(F.ws + WS_U); const float* KFC = (const float*)(F.ws + WS_KFC);
        LAS float* vw = (LAS float*)(F.lds + F.wave * 4096);
        LAS float* kw = vw + 256;
        const float* cw = hy_cw; const float* cbp = hy_cb;
        for (int it = F.gw; it < NB * 256; it += F.ngw) {
            const int b = it >> 8, c = it & 255;
            float x0v[4];
#pragma unroll
            for (int i = 0; i < 4; ++i) { const int t = F.lane + 64 * i;
                float o[3];
#pragma unroll
                for (int g = 0; g < 3; ++g) { const int cc = g * 256 + c; float a = cbp[cc];
#pragma unroll
                    for (int j = 0; j < 3; ++j) { const int tj = t + j - 1; if (tj >= 0 && tj < CTXL) a += cw[j * 768 + cc] * bf2f(U[(size_t)(NLAT + b * CTXL + tj) * INW + 1280 + cc]); }
                    o[g] = a; }
                vw[t] = o[2] * o[1]; x0v[i] = o[0]; }
#pragma unroll
            for (int i = 0; i < 8; ++i) kw[F.lane + 64 * i] = KFC[c * 512 + F.lane + 64 * i];
            LDS_WAIT();
            float y[4] = {0.f, 0.f, 0.f, 0.f};
#pragma unroll 4
            for (int s = 0; s < CTXL; ++s) { const float vv = vw[s];
#pragma unroll
                for (int i = 0; i < 4; ++i) y[i] += kw[(F.lane + 64 * i - s) & 511] * vv; }
            const float bias = hy_bias[c];
#pragma unroll
            for (int i = 0; i < 4; ++i) { const int t = F.lane + 64 * i; HYO[(size_t)(NLAT + b * CTXL + t) * 256 + c] = (y[i] + vw[t] * bias) * x0v[i]; }
            LDS_WAIT();
        }
    }
}

__device__ __forceinline__ void merge_row(const Frame& F, int r, const float* g, float h0, float h1, float h2, float h3) {
    const bf16* ATT = (const bf16*)(F.ws + WS_ATT); const bf16* HD = (const bf16*)(F.ws + WS_LRUO); const bf16* Ug = (const bf16*)(F.ws + WS_U); bf16* MIXA = (bf16*)(F.ws + WS_MIXA);
    const v4u aw = ((const v4u*)(ATT + (size_t)r * 512))[F.lane];
    float a[8] = {bflo(aw.x), bfhi(aw.x), bflo(aw.y), bfhi(aw.y), bflo(aw.z), bfhi(aw.z), bflo(aw.w), bfhi(aw.w)};
    float ss = 0.f;
#pragma unroll
    for (int i = 0; i < 8; ++i) ss += a[i] * a[i];
    const float ra = 1.0f / sqrtf(wave_sum(ss) * (1.0f / 512.0f) + EPSN);
    f32x4 lv; { const v2u hf = ((const v2u*)(HD + (size_t)r * 256))[F.lane], hb = ((const v2u*)(HD + (size_t)MT * 256 + (size_t)r * 256))[F.lane], gw = ((const v2u*)(Ug + (size_t)r * INW + 1024))[F.lane];
        lv.x = (bflo(hf.x) + bflo(hb.x)) * gelu_tanh(bflo(gw.x)); lv.y = (bfhi(hf.x) + bfhi(hb.x)) * gelu_tanh(bfhi(gw.x)); lv.z = (bflo(hf.y) + bflo(hb.y)) * gelu_tanh(bflo(gw.y)); lv.w = (bfhi(hf.y) + bfhi(hb.y)) * gelu_tanh(bfhi(gw.y)); }
    const float rl = 1.0f / sqrtf(wave_sum(lv.x * lv.x + lv.y * lv.y + lv.z * lv.z + lv.w * lv.w) * (1.0f / 256.0f) + EPSN);
    const float rh = 1.0f / sqrtf(wave_sum(h0 * h0 + h1 * h1 + h2 * h2 + h3 * h3) * (1.0f / 256.0f) + EPSN);
    bf16* orow = MIXA + (size_t)r * 1024;
    { const f32x4 g0 = ((const f32x4*)g)[2 * F.lane], g1 = ((const f32x4*)g)[2 * F.lane + 1];
      v4u o; o.x = pk2(a[0] * ra * g0.x, a[1] * ra * g0.y); o.y = pk2(a[2] * ra * g0.z, a[3] * ra * g0.w); o.z = pk2(a[4] * ra * g1.x, a[5] * ra * g1.y); o.w = pk2(a[6] * ra * g1.z, a[7] * ra * g1.w);
      ((v4u*)orow)[F.lane] = o; }
    { const f32x4 gg = ((const f32x4*)(g + 512))[F.lane]; v2u o; o.x = pk2(lv.x * rl * gg.x, lv.y * rl * gg.y); o.y = pk2(lv.z * rl * gg.z, lv.w * rl * gg.w); ((v2u*)(orow + 512))[F.lane] = o; }
    { const f32x2v ga = *(const f32x2v*)(g + 768 + 2 * F.lane), gb = *(const f32x2v*)(g + 896 + 2 * F.lane);
      *(unsigned*)(orow + 768 + 2 * F.lane) = pk2(h0 * rh * ga.x, h1 * rh * ga.y); *(unsigned*)(orow + 896 + 2 * F.lane) = pk2(h2 * rh * gb.x, h3 * rh * gb.y); }
}
__device__ __forceinline__ void ph_merge(const Frame& F, int l, int nrows, const float* out_g) {
    const float* HYO = (const float*)(F.ws + WS_HYO);
    const float* g = out_g + l * 1024;
    LAS float* tile = (LAS float*)(F.lds);
    for (int it = blockIdx.x; it < NLAT / 64; it += F.G) {
        const int b = it >> 7, t0 = (it & 127) * 64;
#pragma unroll 8
        for (int i = 0; i < 32; ++i) { const int c = F.wave * 32 + i; tile[c * 65 + F.lane] = bf2f(((const bf16*)HYO)[((size_t)b * 256 + c) * SEQ + t0 + F.lane]); }
        __syncthreads();
#pragma unroll 2
        for (int k = 0; k < 8; ++k) { const int tt = F.wave * 8 + k;
            merge_row(F, b * SEQ + t0 + tt, g, tile[(2 * F.lane) * 65 + tt], tile[(2 * F.lane + 1) * 65 + tt], tile[(128 + 2 * F.lane) * 65 + tt], tile[(129 + 2 * F.lane) * 65 + tt]); }
        __syncthreads();
    }
    for (int r = NLAT + F.gw; r < nrows; r += F.ngw) {
        const float* hr = HYO + (size_t)r * 256;
        merge_row(F, r, g, hr[2 * F.lane], hr[2 * F.lane + 1], hr[128 + 2 * F.lane], hr[129 + 2 * F.lane]);
    }
}


constexpr int RW_PITCH = 34;
__device__ __forceinline__ void router_cols(LAS const float* rwl, const bf16* XR, const float* gc, const float* sf, unsigned char* Fbytes, int r, float rstd, int j, int kq, int i0, int i1, f32x4& acc0, f32x4& acc1) {
    const bf16* xrow = XR + (size_t)r * 1024 + 8 * kq; const float* gcp = gc + 8 * kq; const float* sfp = sf + 8 * kq;
    v4u xn[4];
#pragma unroll
    for (int u = 0; u < 4; ++u) xn[u] = *(const v4u*)(xrow + 32 * (i0 + u));
#pragma unroll 1
    for (int ib = i0; ib < i1; ib += 4) {
        v4u xw[4]; f32x4 g4[4][2], s4[4][2];
#pragma unroll
        for (int u = 0; u < 4; ++u) { xw[u] = xn[u]; g4[u][0] = *(const f32x4*)(gcp + 32 * (ib + u)); g4[u][1] = *(const f32x4*)(gcp + 32 * (ib + u) + 4); s4[u][0] = *(const f32x4*)(sfp + 32 * (ib + u)); s4[u][1] = *(const f32x4*)(sfp + 32 * (ib + u) + 4); }
        if (ib + 4 < i1) {
#pragma unroll
            for (int u = 0; u < 4; ++u) xn[u] = *(const v4u*)(xrow + 32 * (ib + 4 + u)); }
#pragma unroll
        for (int u = 0; u < 4; ++u) {
            const float x[8] = {bflo(xw[u].x), bfhi(xw[u].x), bflo(xw[u].y), bfhi(xw[u].y), bflo(xw[u].z), bfhi(xw[u].z), bflo(xw[u].w), bfhi(xw[u].w)};
            float xb[8], fv[8];
#pragma unroll
            for (int e = 0; e < 8; ++e) { xb[e] = x[e] * g4[u][e >> 2][e & 3]; fv[e] = xb[e] * rstd + s4[u][e >> 2][e & 3]; }
#if MOE_FP8
            v2u o; o.x = pg8::pack4_fp8(fv[0] * pg8::F8_SF, fv[1] * pg8::F8_SF, fv[2] * pg8::F8_SF, fv[3] * pg8::F8_SF); o.y = pg8::pack4_fp8(fv[4] * pg8::F8_SF, fv[5] * pg8::F8_SF, fv[6] * pg8::F8_SF, fv[7] * pg8::F8_SF);
            *(v2u*)(Fbytes + (size_t)r * 1024 + 8 * kq + 32 * (ib + u)) = o;
#else
            v4u o; o.x = pk2(fv[0], fv[1]); o.y = pk2(fv[2], fv[3]); o.z = pk2(fv[4], fv[5]); o.w = pk2(fv[6], fv[7]); *(v4u*)((bf16*)Fbytes + (size_t)r * 1024 + 8 * kq + 32 * (ib + u)) = o;
#endif
            const LAS float* wp = rwl + (32 * (ib + u) + 8 * kq) * RW_PITCH + j;
#pragma unroll
            for (int e = 0; e < 8; ++e) { acc0 = __builtin_amdgcn_mfma_f32_16x16x4f32(wp[e * RW_PITCH], xb[e], acc0, 0, 0, 0); acc1 = __builtin_amdgcn_mfma_f32_16x16x4f32(wp[e * RW_PITCH + 16], xb[e], acc1, 0, 0, 0); }
        }
    }
}
__device__ __forceinline__ void router_finish(LAS const float* cbl, LAS int* hist, int* TOPI, float* GATE, int r, int bidx, float rstd, int j, int kq, const f32x4& acc0, const f32x4& acc1) {
    float lg[8];
#pragma unroll
    for (int rr = 0; rr < 4; ++rr) { lg[rr] = rstd * acc0[rr] + cbl[bidx * 32 + 4 * kq + rr]; lg[4 + rr] = rstd * acc1[rr] + cbl[bidx * 32 + 16 + 4 * kq + rr]; }
    float p[32];
#pragma unroll
    for (int e = 0; e < 32; ++e) p[e] = __shfl(lg[(e >> 4) * 4 + (e & 3)], j + 16 * ((e & 15) >> 2));
    unsigned taken = 0u; float tv[4]; int ti[4];
#pragma unroll
    for (int k = 0; k < 4; ++k) { float best = -INFINITY; int bi = 0;
#pragma unroll
        for (int e = 0; e < 32; ++e) { const bool ok = !((taken >> e) & 1u) && (p[e] > best); best = ok ? p[e] : best; bi = ok ? e : bi; }
        taken |= 1u << bi; tv[k] = best; ti[k] = bi; }
    const float e1 = __expf(tv[1] - tv[0]), e2 = __expf(tv[2] - tv[0]), e3 = __expf(tv[3] - tv[0]); const float inv = 1.0f / (1.0f + e1 + e2 + e3);
    if (kq == 0) {
        TOPI[r * 4 + 0] = ti[0]; TOPI[r * 4 + 1] = ti[1]; TOPI[r * 4 + 2] = ti[2]; TOPI[r * 4 + 3] = ti[3];
        GATE[r * 4 + 0] = inv; GATE[r * 4 + 1] = e1 * inv; GATE[r * 4 + 2] = e2 * inv; GATE[r * 4 + 3] = e3 * inv;
        lds_add(&hist[ti[0]], 1); lds_add(&hist[ti[1]], 1); lds_add(&hist[ti[2]], 1); lds_add(&hist[ti[3]], 1);
    }
}
__device__ __forceinline__ void ph_ffn_router(const Frame& F, int l, int nrows, const float* router_w) {
    LAS float* rwl = (LAS float*)(F.lds);
    LAS float* part = (LAS float*)(F.lds + 139264);
    LAS float* cbl = (LAS float*)(F.lds + 153600);
    LAS int* hist = (LAS int*)(F.lds + 153600 + 640);
    const bf16* XR = (const bf16*)(F.ws + WS_XR); const float* RSSP = (const float*)(F.ws + WS_RSSP); const float* MOD = (const float*)(F.ws + WS_MOD);
    const float* GC = (const float*)(F.ws + WS_GC) + (size_t)l * 5 * 1024; unsigned char* Fb = (unsigned char*)(F.ws + WS_F);
    int* TOPI = (int*)(F.ws + WS_TOPI); float* GATE = (float*)(F.ws + WS_GATE); int* BLKCNT = (int*)(F.ws + WS_BLKCNT);
    for (int i = F.tid; i < 1024 * 32; i += NTHR) rwl[(i >> 5) * RW_PITCH + (i & 31)] = router_w[(size_t)l * 32768 + i];
    if (F.tid < 32) hist[F.tid] = 0;
    if (F.tid < 160) cbl[F.tid] = ((const float*)(F.ws + WS_CB))[l * 160 + F.tid];
    __syncthreads();
    const int j = F.lane & 15, kq = F.lane >> 4;
    const int ngrp = nrows / 16, nmain = (ngrp / F.ngw) * F.ngw;
    for (int grp = F.gw; grp < nmain; grp += F.ngw) {
        const int r0 = grp * 16, r = r0 + j; const int bidx = r0 < NLAT ? r0 / SEQ : 4;
        float ss; { const f32x4 q = *(const f32x4*)(RSSP + (size_t)r * 16 + 4 * kq); ss = (q.x + q.y) + (q.z + q.w); }
        ss += __shfl_xor(ss, 16); ss += __shfl_xor(ss, 32);
        const float rstd = 1.0f / sqrtf(ss * (1.0f / 1024.0f) + EPSN);
        f32x4 acc0 = {0.f, 0.f, 0.f, 0.f}, acc1 = acc0;
        router_cols(rwl, XR, GC + bidx * 1024, MOD + (size_t)(l * 5 + bidx) * 6144 + 3 * 1024, Fb, r, rstd, j, kq, 0, 32, acc0, acc1);
        router_finish(cbl, hist, TOPI, GATE, r, bidx, rstd, j, kq, acc0, acc1);
    }
    for (int grp = nmain + (int)blockIdx.x; grp < ngrp; grp += F.G) {
        const int r0 = grp * 16, r = r0 + j; const int bidx = r0 < NLAT ? r0 / SEQ : 4;
        float ss; { const f32x4 q = *(const f32x4*)(RSSP + (size_t)r * 16 + 4 * kq); ss = (q.x + q.y) + (q.z + q.w); }
        ss += __shfl_xor(ss, 16); ss += __shfl_xor(ss, 32);
        const float rstd = 1.0f / sqrtf(ss * (1.0f / 1024.0f) + EPSN);
        f32x4 acc0 = {0.f, 0.f, 0.f, 0.f}, acc1 = acc0;
        router_cols(rwl, XR, GC + bidx * 1024, MOD + (size_t)(l * 5 + bidx) * 6144 + 3 * 1024, Fb, r, rstd, j, kq, 4 * F.wave, 4 * F.wave + 4, acc0, acc1);
        if (F.wave > 0) { LAS f32x4* pp = (LAS f32x4*)(part + ((F.wave - 1) * 64 + F.lane) * 8); pp[0] = acc0; pp[1] = acc1; }
        __syncthreads();
        if (F.wave == 0) {
#pragma unroll
            for (int w = 0; w < 7; ++w) { const LAS f32x4* pp = (const LAS f32x4*)(part + (w * 64 + F.lane) * 8); acc0 += pp[0]; acc1 += pp[1]; }
            router_finish(cbl, hist, TOPI, GATE, r, bidx, rstd, j, kq, acc0, acc1);
        }
        __syncthreads();
    }
    __syncthreads();
    if (F.tid < 32) BLKCNT[blockIdx.x * 32 + F.tid] = hist[F.tid];
}

__device__ __forceinline__ void ph_route(const Frame& F, int nrows) {
    LAS int* cursor = (LAS int*)(F.lds);
    LAS int* tot = cursor + 32;
    LAS int* mine = cursor + 64;
    LAS int* part = cursor + 96;
    LAS int* ebase = cursor + 96 + 1024;
    const int* BLKCNT = (const int*)(F.ws + WS_BLKCNT); const int* TOPI = (const int*)(F.ws + WS_TOPI); int* POS = (int*)(F.ws + WS_POS);
    int* ROWTOK = (int*)(F.ws + WS_ROWTOK); int* TILEE = (int*)(F.ws + WS_TILEE);
    { const int e = F.tid & 31, sl = F.tid >> 5; int t = 0, m = 0;
      for (int b = sl; b < F.G; b += 16) { const int v = BLKCNT[b * 32 + e]; t += v; m += (b < (int)blockIdx.x) ? v : 0; }
      part[sl * 64 + e] = t; part[sl * 64 + 32 + e] = m;
      __syncthreads();
      if (F.tid < 32) { int tt = 0, mm = 0;
#pragma unroll
          for (int s = 0; s < 16; ++s) { tt += part[s * 64 + F.tid]; mm += part[s * 64 + 32 + F.tid]; }
          tot[F.tid] = tt; mine[F.tid] = mm; } }
    __syncthreads();
    if (F.tid == 0) { int tb = 0;
        for (int e = 0; e < 32; ++e) { const int nt = (tot[e] + 255) >> 8; cursor[e] = tb * 256 + mine[e]; ebase[e] = tb * 256;
            if (blockIdx.x == 0) for (int j = 0; j < nt; ++j) TILEE[tb + j] = e;
            tb += nt; }
        ebase[32] = tb * 256;
        if (blockIdx.x == 0) F.ctl[CW_NTILES] = (unsigned)tb; }
    __syncthreads();
    for (int e = blockIdx.x; e < 32; e += F.G) for (int p = ebase[e] + tot[e] + F.tid; p < ebase[e + 1]; p += NTHR) ROWTOK[p] = 0;
    const int sub = F.lane >> 2, k = F.lane & 3;
    const int ngrp = nrows / 16, nmain = (ngrp / F.ngw) * F.ngw;
    for (int grp = F.gw; grp < nmain; grp += F.ngw) {
        const int r = grp * 16 + sub; const int e = TOPI[r * 4 + k]; const int pos = lds_add(&cursor[e], 1); POS[r * 4 + k] = pos; ROWTOK[pos] = r; }
    if (F.wave == 0) for (int grp = nmain + (int)blockIdx.x; grp < ngrp; grp += F.G) {
        const int r = grp * 16 + sub; const int e = TOPI[r * 4 + k]; const int pos = lds_add(&cursor[e], 1); POS[r * 4 + k] = pos; ROWTOK[pos] = r; }
}

__device__ __forceinline__ void ph_combine(const Frame& F, int l, int nrows, float* out, const float* gmix) {
    bf16* XR = (bf16*)(F.ws + WS_XR); const float* MOD = (const float*)(F.ws + WS_MOD); const bf16* YS = (const bf16*)(F.ws + WS_YS); bf16* H = (bf16*)(F.ws + WS_H);
    const int* POS = (const int*)(F.ws + WS_POS); const float* GATE = (const float*)(F.ws + WS_GATE);
    for (int r = 2 * F.gw; r < nrows; r += 2 * F.ngw) {
        const int bidx = r < NLAT ? r / SEQ : 4;
        const float* gf = MOD + (size_t)(l * 5 + bidx) * 6144 + 5 * 1024;
        int pos = 0; float gt = 0.f;
        if (F.lane < 8) { pos = POS[r * 4 + F.lane]; gt = GATE[r * 4 + F.lane]; }
        v2u w[2][4][4], xw[2][4]; float gk[2][4];
#pragma unroll
        for (int rr = 0; rr < 2; ++rr)
#pragma unroll
            for (int k = 0; k < 4; ++k) { const int pk = __shfl(pos, rr * 4 + k); gk[rr][k] = __shfl(gt, rr * 4 + k);
#if MOE_FP8
                gk[rr][k] *= (1.0f / pg8::F8_SY); const unsigned* yr = (const unsigned*)((const unsigned char*)YS + (size_t)pk * YS_PITCH);
#pragma unroll
                for (int j = 0; j < 4; ++j) { w[rr][k][j].x = yr[64 * j + F.lane]; w[rr][k][j].y = 0u; } }
#else
                const v2u* yr = (const v2u*)(YS + (size_t)pk * 1024);
#pragma unroll
                for (int j = 0; j < 4; ++j) w[rr][k][j] = yr[64 * j + F.lane]; }
#endif
#pragma unroll
        for (int rr = 0; rr < 2; ++rr)
#pragma unroll
            for (int j = 0; j < 4; ++j) xw[rr][j] = ((const v2u*)(XR + (size_t)(r + rr) * 1024))[64 * j + F.lane];
        f32x4 gv[4];
#pragma unroll
        for (int j = 0; j < 4; ++j) gv[j] = ((const f32x4*)gf)[64 * j + F.lane];
#pragma unroll
        for (int rr = 0; rr < 2; ++rr) {
            const int row = r + rr;
            f32x4 y[4]; float ss = 0.f;
#pragma unroll
            for (int j = 0; j < 4; ++j) { f32x4 a = {0.f, 0.f, 0.f, 0.f};
#pragma unroll
                for (int k = 0; k < 4; ++k) { const v2u ww = w[rr][k][j]; const float g_ = gk[rr][k];
#if MOE_FP8
                    a.x += g_ * __builtin_amdgcn_cvt_f32_fp8((int)ww.x, 0); a.y += g_ * __builtin_amdgcn_cvt_f32_fp8((int)ww.x, 1); a.z += g_ * __builtin_amdgcn_cvt_f32_fp8((int)ww.x, 2); a.w += g_ * __builtin_amdgcn_cvt_f32_fp8((int)ww.x, 3); }
#else
                    a.x += g_ * bflo(ww.x); a.y += g_ * bfhi(ww.x); a.z += g_ * bflo(ww.y); a.w += g_ * bfhi(ww.y); }
#endif
                const f32x4 xv = {bflo(xw[rr][j].x), bfhi(xw[rr][j].x), bflo(xw[rr][j].y), bfhi(xw[rr][j].y)};
                y[j] = xv + gv[j] * a;
                const int cb = 64 * j + F.lane;
                if (l == 0) { v2u o; o.x = pk2(y[j].x, y[j].y); o.y = pk2(y[j].z, y[j].w); ((v2u*)(XR + (size_t)row * 1024))[cb] = o; } else ((f32x4*)(out + (size_t)row * 1024))[cb] = y[j];
                ss += (y[j].x * y[j].x + y[j].y * y[j].y) + (y[j].z * y[j].z + y[j].w * y[j].w); }
            if (l == 0) {
                const float rstd = 1.0f / sqrtf(wave_sum(ss) * (1.0f / 1024.0f) + EPSN);
                const float* shift = MOD + (size_t)(5 + bidx) * 6144; const float* scale = shift + 1024; const float* g = gmix + 1024;
#pragma unroll
                for (int j = 0; j < 4; ++j) { const int cb = 64 * j + F.lane; const f32x4 gg = ((const f32x4*)g)[cb], sc = ((const f32x4*)scale)[cb], sh = ((const f32x4*)shift)[cb];
                    const f32x4 hv = y[j] * rstd * gg * (sc + 1.0f) + sh;
                    v2u o; o.x = pk2(hv.x, hv.y); o.y = pk2(hv.z, hv.w); ((v2u*)(H + (size_t)row * 1024))[cb] = o; }
            }
        }
    }
}

struct Args { const float* in[34]; float* out; unsigned char* ws; int ph_lo, ph_hi; };
enum { I_X = 0, I_C, I_CTX, I_CCTX, I_WMOD, I_BMOD, I_GMIX, I_GFFN, I_WIN, I_QG, I_KG, I_LCW, I_LCB, I_LGW, I_LGB, I_LLAM, I_HCW, I_HCB, I_HW1, I_HB1, I_HW2, I_HB2, I_HW3, I_HFREQ, I_HDEC, I_HBIAS,
       I_OUTG, I_WOUT, I_RW, I_RB, I_MW1, I_MB1, I_MW2, I_MB2 };

__global__ void __launch_bounds__(NTHR, 2) mk_fwd(Args args) {
    extern __shared__ __attribute__((aligned(16))) unsigned char lds[];
    Frame F;
    F.lds = (LAS unsigned char*)lds; F.ws = args.ws; F.ctl = (unsigned*)(args.ws + WS_CTL);
    F.tid = threadIdx.x; F.lane = F.tid & 63; F.wave = __builtin_amdgcn_readfirstlane(F.tid >> 6);
    F.G = gridDim.x; { const int bx = blockIdx.x; F.vcu = (F.G % 8 == 0) ? (bx % 8) * (F.G / 8) + bx / 8 : bx; }
    F.gw = (int)blockIdx.x * NWAVES + F.wave; F.ngw = F.G * NWAVES;
    for (int u = F.tid; u < (LDS_BYTES - LDSCTL_OFF) / 4; u += NTHR) ((LAS unsigned*)(F.lds + LDSCTL_OFF))[u] = 0u;
    __syncthreads();
#if !MK_PER_PHASE
    XcdBarrier bar = xcd_barrier_post(F.ctl + CW_BAR, (volatile LAS unsigned*)(F.lds + LDSCTL_OFF + 32));
#define GRID_BAR() xcd_barrier(bar)
#else
#define GRID_BAR() do { } while (0)
#endif
    const int lo = args.ph_lo, hi = args.ph_hi;
#ifndef ONLY_PHASE
#define ONLY_PHASE (-1)
#endif
#define ENABLED(id) (ONLY_PHASE < 0 || ONLY_PHASE == (id))
#define IN(k) (ENABLED(k) && lo <= (k) && (k) < hi)
#define INL(j) (ENABLED(NPH_PRO + (j)) && lo <= pb + (j) && pb + (j) < hi)
#define SEAML(j) do { if (lo <= pb + (j) && pb + (j) + 1 < hi) { GRID_BAR(); } } while (0)
typedef const __attribute__((address_space(4))) Args* KArgs;
#ifndef REP_MASK
#define REP_MASK 0
#endif
#define NREP(j) (((REP_MASK >> (j)) & 1) ? 2 : 1)
#define REFRAME() Frame Fp = F; KArgs ka = (KArgs)__builtin_amdgcn_kernarg_segment_ptr(); { int t_ = F.tid; asm volatile("" : "+v"(t_), "+s"(ka)); Fp.tid = t_; Fp.lane = t_ & 63; Fp.wave = __builtin_amdgcn_readfirstlane(t_ >> 6); \
    Fp.gw = (int)blockIdx.x * NWAVES + Fp.wave; Fp.ws = ka->ws; Fp.ctl = (unsigned*)(ka->ws + WS_CTL); }
#define SEAM(k) do { if (lo <= (k) && (k) + 1 < hi) { GRID_BAR(); } } while (0)

    if (IN(0)) ph_prologue_a(F, args.in[I_C], args.in[I_CCTX], args.in[I_WMOD], args.in[I_BMOD], args.in[I_WIN], args.in[I_WOUT], args.in[I_MW1], args.in[I_MW2],
                             args.in[I_HW1], args.in[I_HB1], args.in[I_HW2], args.in[I_HB2], args.in[I_HFREQ], args.in[I_LGW], args.in[I_LLAM]);
    SEAM(0);
    if (IN(1)) ph_prologue_b(F, args.in[I_HW3], args.in[I_HDEC], args.in[I_GFFN], args.in[I_RW], args.in[I_RB]);
    SEAM(1);

#if MOE_FP8
#define MOE_EPI1 pg8::EpiSwigluF8
#define MOE_EPI2 pg8::EpiF8BiasF8
#else
#define MOE_EPI1 pg8::EpiSwiglu
#define MOE_EPI2 pg8::EpiBf16Bias
#endif
#ifndef PROBE_MOE2
#define PROBE_MOE2 0
#endif
#ifndef PROBE_MOE2B
#define PROBE_MOE2B 0
#endif
#ifndef PROBE_GEMM_K
#define PROBE_GEMM_K 0
#endif
#ifndef MOE_WGM1
#define MOE_WGM1 8
#endif
#ifndef MOE_WGM2
#define MOE_WGM2 8
#endif
#define PHASE(j, ...) if (INL(j)) { _Pragma("unroll") for (int rep_ = 0; rep_ < NREP(j); ++rep_) { { REFRAME(); __VA_ARGS__ } if (rep_ + 1 < NREP(j)) GRID_BAR(); } }
#define LAYER_BODY(l) { \
        const int pb = NPH_PRO + l * NPH_LAYER; \
        const int nrows = (l == 0) ? MT : NLAT; \
        if (l == 0) { PHASE(0, ph_norm_mod(Fp, l, ka->in[I_X], ka->in[I_CTX], ka->in[I_GMIX]);) SEAML(0); } \
        if (INL(1)) { REFRAME(); \
            unsigned* sw_ = Fp.ctl + CW_SPLIT + 2048 * l; \
            { pg8::Gemm g{(const bf16*)(Fp.ws + WS_H), (const bf16*)(Fp.ws + WS_WINT) + (size_t)l * 2048 * 1024, NLAT, 2048, 1024}; \
              pg8::StaticOrder S; S.init(NLAT, 2048, Fp.G, (int)blockIdx.x); \
              pg8::EpiBf16<0> E{(bf16*)(Fp.ws + WS_U), 2048, nullptr, 0, 0, 1.f}; \
              pg8::gemm_phase<pg8::EpiBf16<0>, pg8::StaticOrder, PG8_ALIGN, PG8_SP2>(Fp.lds + RING_OFF, g, S, E); } \
            split_arrive_all(bar, sw_);                                        \
            if ((int)blockIdx.x < CTXWG) {                                     \
              pg8::Gemm g{(const bf16*)(Fp.ws + WS_H) + (size_t)NLAT * 1024, (const bf16*)(Fp.ws + WS_WINT) + (size_t)l * 2048 * 1024, MT - NLAT, 2048, 1024}; \
              pg8::StaticOrder S; S.init(MT - NLAT, 2048, CTXWG, (int)blockIdx.x); \
              pg8::EpiBf16<0> E{(bf16*)(Fp.ws + WS_U) + (size_t)NLAT * 2048, 2048, nullptr, 0, 0, 1.f}; \
              pg8::gemm_phase<pg8::EpiBf16<0>, pg8::StaticOrder, PG8_ALIGN, PG8_SP2>(Fp.lds + RING_OFF, g, S, E); \
              split_arrive_flat(sw_); } \
            split_wait_all(bar, sw_); \
            if ((int)blockIdx.x >= CTXWG) post_ab(Fp, l, 0, NLAT, ((int)blockIdx.x - CTXWG) * NWAVES + Fp.wave, (Fp.G - CTXWG) * NWAVES, ka->in[I_KG], ka->in[I_LCW], ka->in[I_LCB]); \
            split_wait_flat(bar, sw_, (unsigned)CTXWG); \
            post_ab(Fp, l, NLAT, MT, Fp.gw, Fp.ngw, ka->in[I_KG], ka->in[I_LCW], ka->in[I_LCB]); \
            post_c(Fp, l, ka->in[I_HCW], ka->in[I_HCB]); } \
        SEAML(2); \
        if (INL(3)) { REFRAME(); \
            unsigned* sw_ = Fp.ctl + CW_SPLIT + 2048 * (2 + l); \
            { int kg_ = 256; asm volatile("" : "+s"(kg_)); \
              pg8::Gemm g{(const bf16*)(Fp.ws + WS_XL), (const bf16*)(Fp.ws + WS_WGT) + (size_t)l * 1024 * 256, NLAT, 1024, kg_}; \
              pg8::StaticOrder S; S.init(NLAT, 1024, Fp.G, (int)blockIdx.x); \
              pg8::EpiLruGate E{(const bf16*)(Fp.ws + WS_XL), (bf16*)(Fp.ws + WS_LAB), LAB_STRIDE, ka->in[I_LGB] + (size_t)l * 1024, (const float*)(Fp.ws + WS_SPT) + l * 512}; \
              pg8::gemm_phase<pg8::EpiLruGate, pg8::StaticOrder, PG8_ALIGN, PG8_SP2>(Fp.lds + RING_OFF, g, S, E); } \
            split_arrive_all(bar, sw_); \
            if ((int)blockIdx.x >= 32 && (int)blockIdx.x < 64) {            \
              ph_lru_gates(Fp, l, ka->in[I_LGB], NLAT / 32, (MT - NLAT) / 32, ((int)blockIdx.x - 32) * NWAVES + Fp.wave, 32 * NWAVES); \
              split_arrive_flat(sw_); } \
            split_wait_all(bar, sw_); split_wait_flat(bar, sw_, 32u); \
            ph_scan1(Fp); __syncthreads(); \
            { const attn_body::AttnTensors AT{(const attn_body::bf16*)(Fp.ws + WS_U), (const attn_body::bf16*)(Fp.ws + WS_K), (const attn_body::bf16*)(Fp.ws + WS_V), (attn_body::bf16*)(Fp.ws + WS_ATT)}; \
              const attn_body::QPre QN{ka->in[I_QG] + l * 64, (const float*)(Fp.ws + WS_ROPEC), (const float*)(Fp.ws + WS_ROPES)}; \
              attn_body::attn_phase<8>((char*)lds + RING_OFF, AT, QN, Fp.G, Fp.vcu, l == 0, (long)NLAT); } } \
        SEAML(4); \
        PHASE(5, ph_scan2(Fp); __syncthreads(); ph_hyena_fft(Fp, l, ka->in[I_HBIAS]); if (l == 0) ph_hyena_ctx(Fp, ka->in[I_HBIAS], ka->in[I_HCW], ka->in[I_HCB]);) \
        SEAML(5); \
        PHASE(6, ph_merge(Fp, l, nrows, ka->in[I_OUTG]);) \
        SEAML(6); \
        if (INL(7)) { REFRAME(); \
            pg8::Gemm g{(const bf16*)(Fp.ws + WS_MIXA), (const bf16*)(Fp.ws + WS_WOUTT) + (size_t)l * 1024 * 1024, nrows, 1024, 1024}; \
            pg8::StaticOrder S; S.init(nrows, 1024, Fp.G, (int)blockIdx.x); \
            bf16* XR = (bf16*)(Fp.ws + WS_XR); \
            pg8::EpiResid<(l) == 1> E{ka->in[I_X], ka->in[I_CTX], NLAT, XR, 1024, \
                            (const float*)(Fp.ws + WS_MOD) + (size_t)(l * 5) * 6144 + 2 * 1024, 6144, SEQ, (float*)(Fp.ws + WS_RSSP)}; \
            pg8::gemm_phase<pg8::EpiResid<(l) == 1>, pg8::StaticOrder, PG8_ALIGN, PG8_SP2>(Fp.lds + RING_OFF, g, S, E); \
        } \
        SEAML(7); \
        PHASE(8, ph_ffn_router(Fp, l, nrows, ka->in[I_RW]);) \
        SEAML(8); \
        PHASE(9, ph_route(Fp, nrows);) \
        SEAML(9); \
        if (INL(10) || INL(11)) { REFRAME(); \
            LAS int* tab = (LAS int*)(Fp.lds + MOETAB_OFF); \
            const int ntiles = (int)__hip_atomic_load(Fp.ctl + CW_NTILES, __ATOMIC_RELAXED, __HIP_MEMORY_SCOPE_AGENT); \
            const int* TILEE = (const int*)(Fp.ws + WS_TILEE); \
            for (int i = Fp.tid; i < ntiles && i < SORT_TILES; i += NTHR) tab[i] = TILEE[i]; \
            __syncthreads(); \
            if (INL(10)) { _Pragma("unroll") for (int rep_ = 0; rep_ < NREP(10); ++rep_) { { \
                int km1_ = 1024 / (1 + MOE_FP8); asm volatile("" : "+s"(km1_)); \
                pg8::Gemm g{(const bf16*)(Fp.ws + WS_F), (const bf16*)(Fp.ws + WS_W1T) + (size_t)l * 32 * 2048 * (1024 / (1 + MOE_FP8)), 0, 2048, km1_}; \
                pg8::MoeOrderT<true> S; S.init(tab, ntiles, 8, Fp.G, (int)blockIdx.x, MOE_WGM1); S.rowtok = (const int*)(Fp.ws + WS_ROWTOK); \
                MOE_EPI1 E{(bf16*)(Fp.ws + WS_ACT), 1024, ka->in[I_MB1] + (size_t)l * 32 * 2048, 2048}; \
                pg8::gemm_phase<MOE_EPI1, pg8::MoeOrderT<true>, PG8_ALIGN, PG8_SP2, MOE_FP8 != 0>(Fp.lds + RING_OFF, g, S, E); \
             } if (rep_ + 1 < NREP(10)) GRID_BAR(); } } \
            SEAML(10); \
            if (PROBE_MOE2B && INL(11)) { \
                pg8::Gemm g{(const bf16*)(Fp.ws + WS_ACT), (const bf16*)(Fp.ws + WS_W2T) + (size_t)l * 32 * 1024 * 1024, 0, 1024, 1024}; \
                pg8::MoeOrderT<false> S; S.init(tab, ntiles, 4, Fp.G, (int)blockIdx.x, MOE_WGM2); S.rowtok = nullptr; S.rev = 1; \
                pg8::EpiNone E{}; \
                pg8::gemm_phase<pg8::EpiNone, pg8::MoeOrderT<false>, PG8_ALIGN, PG8_SP2>(Fp.lds + RING_OFF, g, S, E); GRID_BAR(); } \
            if (INL(11)) { _Pragma("unroll") for (int rep_ = 0; rep_ < NREP(11); ++rep_) { { \
                int km2_ = 1024 / (1 + MOE_FP8); asm volatile("" : "+s"(km2_)); \
                pg8::Gemm g{(const bf16*)(Fp.ws + WS_ACT), (const bf16*)(Fp.ws + WS_W2T) + (size_t)l * 32 * 1024 * (1024 / (1 + MOE_FP8)), 0, 1024, km2_}; \
                pg8::MoeOrderT<false> S; S.init(tab, ntiles, 4, Fp.G, (int)blockIdx.x, MOE_WGM2); S.rowtok = nullptr; S.rev = 1; \
                MOE_EPI2 E{(bf16*)(Fp.ws + WS_YS), YS_PITCH, ka->in[I_MB2] + (size_t)l * 32 * 1024, 1024}; \
                pg8::gemm_phase<MOE_EPI2, pg8::MoeOrderT<false>, PG8_ALIGN, PG8_SP2, MOE_FP8 != 0>(Fp.lds + RING_OFF, g, S, E); \
             } if (rep_ + 1 < NREP(11)) GRID_BAR(); } } \
            if (PROBE_MOE2 && INL(11)) { GRID_BAR(); \
                pg8::Gemm g{(const bf16*)(Fp.ws + WS_ACT), (const bf16*)(Fp.ws + WS_W2T) + (size_t)l * 32 * 1024 * 1024, 0, 1024, 1024}; \
                pg8::MoeOrderT<false> S; S.init(tab, ntiles, 4, Fp.G, (int)blockIdx.x, MOE_WGM2); S.rowtok = nullptr; S.rev = (PROBE_MOE2 == 2) ? 0 : 1; \
                if (PROBE_MOE2 == 3) { pg8::EpiBf16BiasFold E{(bf16*)(Fp.ws + WS_ASORT), 1024, ka->in[I_MB2] + (size_t)l * 32 * 1024, 1024}; \
                    pg8::gemm_phase<pg8::EpiBf16BiasFold, pg8::MoeOrderT<false>, PG8_ALIGN, PG8_SP2>(Fp.lds + RING_OFF, g, S, E); } \
                else { pg8::EpiNone E{}; \
                pg8::gemm_phase<pg8::EpiNone, pg8::MoeOrderT<false>, PG8_ALIGN, PG8_SP2>(Fp.lds + RING_OFF, g, S, E); } } \
        } \
        SEAML(11); \
        if (INL(12)) { REFRAME(); ph_combine(Fp, l, nrows, ka->out, ka->in[I_GMIX]); } \
        if (l == 0) { SEAML(12); } \
    }
    LAYER_BODY(0)
    LAYER_BODY(1)
#undef LAYER_BODY
#undef PHASE
#undef IN
#undef SEAM
#undef INL
#undef SEAML
}

extern "C" void kernel_launch(void* const* d_in, const int* in_sizes, int n_in, void* d_out, int out_size, void* d_ws, size_t ws_size, hipStream_t stream) {
    static int grid = 0;
    if (grid == 0) {
        if (n_in != 34 || in_sizes[0] != NLAT * DMODEL || out_size != NLAT * DMODEL || ws_size < WS_END) {
            fprintf(stderr, "kernel_launch: unexpected shapes (n_in %d, in0 %d, out %d, ws %zu); nothing launched\n", n_in, n_in > 0 ? in_sizes[0] : -1, out_size, ws_size); grid = -1; return; }
        int dev = 0, cus = 0;
        if (hipGetDevice(&dev) != hipSuccess || hipDeviceGetAttribute(&cus, hipDeviceAttributeMultiprocessorCount, dev) != hipSuccess) { grid = -1; return; }
        if (hipFuncSetAttribute((const void*)mk_fwd, hipFuncAttributeMaxDynamicSharedMemorySize, LDS_BYTES) != hipSuccess) { fprintf(stderr, "kernel_launch: hipFuncSetAttribute failed\n"); grid = -1; return; }
        int per_cu = 0;
        if (hipOccupancyMaxActiveBlocksPerMultiprocessor(&per_cu, (const void*)mk_fwd, NTHR, LDS_BYTES) != hipSuccess || per_cu < 1) { fprintf(stderr, "kernel_launch: occupancy query says %d\n", per_cu); }
        (void)hipGetLastError();
        grid = cus;
    }
    if (grid < 0) return;
    if (hipMemsetAsync((char*)d_ws + WS_CTL, 0, CTL_ZERO_BYTES, stream) != hipSuccess) return;
    Args a{};
    for (int i = 0; i < 34; ++i) a.in[i] = (const float*)d_in[i];
    a.out = (float*)d_out; a.ws = (unsigned char*)d_ws;
#if MK_PER_PHASE
    for (int p = 0; p < NPH; ++p) { a.ph_lo = p; a.ph_hi = p + 1; hipLaunchKernelGGL(mk_fwd, dim3(grid), dim3(NTHR), LDS_BYTES, stream, a); }
#else
    a.ph_lo = 0; a.ph_hi = NPH;
    hipLaunchKernelGGL(mk_fwd, dim3(grid), dim3(NTHR), LDS_BYTES, stream, a);
#endif
}
```

```cpp
#include <hip/hip_runtime.h>
#include <hip/hip_bf16.h>
#include <cstdio>
#include <cstdint>
#include <cmath>
#ifndef MOE_FP8
#define MOE_FP8 1
#endif
#ifndef MK_PER_PHASE
#define MK_PER_PHASE 0
#endif
namespace pg8 {
#define PG8_LAS __attribute__((address_space(3)))
typedef unsigned short bf16_t;
typedef short bf16x8 __attribute__((ext_vector_type(8)));
typedef float f32x4 __attribute__((ext_vector_type(4)));
typedef unsigned u32x4 __attribute__((ext_vector_type(4)));
constexpr int BM = 256, BK = 64, HALF = 128, HTB = HALF * BK * 2  , STAGE_BYTES = 8 * HTB, NXCD = 8, WGM = 8;

__host__ __device__ __forceinline__ int lds_byte(int r, int c) { const int st = (r >> 4) * 2 + (c >> 5), rr = r & 15, cc = c & 31, ob = rr * 64 + cc * 2; return st * 1024 + (ob ^ (((ob >> 9) & 1) << 5)); }
__host__ __device__ __forceinline__ void stage_rc(int b, int& R, int& C) { const int st = b / 1024, sb = b % 1024, swz = sb ^ (((sb >> 9) & 1) << 5); R = (st >> 1) * 16 + swz / 64; C = (st & 1) * 32 + (swz % 64) / 2; }
__host__ __device__ __forceinline__ int perm32(int rho) { const int n = rho >> 4, i = rho & 15; return 8 * (i >> 2) + 4 * n + (i & 3); }

struct Unit { int pm, pn, be, e; };
struct Gemm { const bf16_t* A; const bf16_t* Bt; int M, N, K; };

struct StaticOrder {
    static constexpr bool GATHER = false;
    __device__ __forceinline__ int row_of(int r) const { return r; }
    int nM, nN, nwg, G, c;
    __host__ __device__ void init(int M, int N, int G_, int c_) { nM = M / BM; nN = N / BM; nwg = nM * nN; G = G_; c = c_; }
    __host__ __device__ bool next(int i, Unit& u) const {
        const long L = (long)i * G + c; if (L >= nwg) return false;
        int wgid = (int)L; { const int q = nwg / NXCD, r = nwg % NXCD, xcd = wgid % NXCD, off = wgid / NXCD; wgid = (xcd < r ? xcd * (q + 1) : r * (q + 1) + (xcd - r) * q) + off; }
        const int nig = WGM * nN, gid = wgid / nig, fm = gid * WGM, gsz = (nM - fm) < WGM ? (nM - fm) : WGM;
        u.pm = fm + ((wgid % nig) % gsz); u.pn = (wgid % nig) / gsz; u.be = u.pn; u.e = 0; return true;
    }
    __device__ __forceinline__ void a_ready(const Unit&) const {}
    __device__ __forceinline__ void done(const Unit&) const {}
};

__device__ __forceinline__ unsigned cvt_pk_bf16(float lo, float hi) { unsigned r; asm volatile("v_cvt_pk_bf16_f32 %0, %1, %2" : "=v"(r) : "v"(lo), "v"(hi)); return r; }
__device__ __forceinline__ unsigned pack4_fp8(float a, float b, float c, float d) {
    a = fminf(fmaxf(a, -448.f), 448.f); b = fminf(fmaxf(b, -448.f), 448.f); c = fminf(fmaxf(c, -448.f), 448.f); d = fminf(fmaxf(d, -448.f), 448.f);
    int w = 0; w = __builtin_amdgcn_cvt_pk_fp8_f32(a, b, w, false); w = __builtin_amdgcn_cvt_pk_fp8_f32(c, d, w, true); return (unsigned)w;
}
constexpr float F8_SF = 16.f, F8_SW = 64.f, F8_SA = 4.f, F8_SY = 32.f;
typedef float f32x2 __attribute__((ext_vector_type(2)));
__device__ __forceinline__ f32x2 gelu_pk(f32x2 v) {
    const f32x2 av = __builtin_elementwise_abs(v), d = av * 0.2316418882f + 1.0f;
    f32x2 t; t.x = __builtin_amdgcn_rcpf(d.x); t.y = __builtin_amdgcn_rcpf(d.y);
    f32x2 q = t * 0.5307027145f + (-0.7265760135f); q = q * t + 0.7107068705f; q = q * t + (-0.142248368f); q = q * t + 0.127414796f; q = q * t;
    const f32x2 s = (v * v) * (-0.72134752044f);
    f32x2 e; e.x = __builtin_amdgcn_exp2f(s.x); e.y = __builtin_amdgcn_exp2f(s.y);
    const f32x2 m = v * (q * e), r = v - m;
    f32x2 o; o.x = v.x < 0.f ? m.x : r.x; o.y = v.y < 0.f ? m.y : r.y; return o;
}

template <int ACT  > struct EpiBf16 {
    static constexpr bool PERM = true, AFTER_DRAIN = false; static_assert(ACT == 0 || ACT == 1, "EpiBf16: ACT is 0 (none) or 1 (gelu_pk)");
    bf16_t* O; int ldc; const float* bias; int split_cols; size_t split_stride; float scale0;
    struct Pre {}; __device__ __forceinline__ void preload(Pre&, const Unit&, int, int, int, int) const {}
    __device__ __forceinline__ void operator()(const f32x4 (&acc)[2][2][4][2], const Unit& u, int wr, int wc, int fr, int fq, const Pre&) const {
        const int row0 = u.pm * BM + wr * 64 + fr; int colt = u.pn * BM; bf16_t* base = O;
        float sc = 1.f; if (split_cols) { const int t = colt / split_cols; base += (size_t)t * split_stride; colt -= t * split_cols; if (t == 0) sc = scale0; }
        const int col0 = colt + wc * 32 + 8 * fq, bcol0 = u.pn * BM + wc * 32 + 8 * fq;
        f32x4 bv[2][2];
#pragma unroll
        for (int bj = 0; bj < 2; ++bj)
#pragma unroll
            for (int n = 0; n < 2; ++n) bv[bj][n] = bias ? *(const f32x4*)(bias + bcol0 + bj * HALF + 4 * n) : (f32x4){0.f, 0.f, 0.f, 0.f};
#pragma unroll
        for (int ai = 0; ai < 2; ++ai)
#pragma unroll
            for (int m = 0; m < 4; ++m) { bf16_t* rowp = base + (size_t)(row0 + ai * HALF + m * 16) * ldc + col0;
#pragma unroll
                for (int bj = 0; bj < 2; ++bj) { f32x4 v0 = acc[ai][bj][m][0] + bv[bj][0], v1 = acc[ai][bj][m][1] + bv[bj][1];
                    if (ACT == 1) { f32x2 a = gelu_pk((f32x2){v0[0], v0[1]}), b = gelu_pk((f32x2){v0[2], v0[3]}), c = gelu_pk((f32x2){v1[0], v1[1]}), d = gelu_pk((f32x2){v1[2], v1[3]});
                        v0 = (f32x4){a.x, a.y, b.x, b.y}; v1 = (f32x4){c.x, c.y, d.x, d.y}; }
                    v0 = v0 * sc; v1 = v1 * sc; u32x4 w; w.x = cvt_pk_bf16(v0[0], v0[1]); w.y = cvt_pk_bf16(v0[2], v0[3]); w.z = cvt_pk_bf16(v1[0], v1[1]); w.w = cvt_pk_bf16(v1[2], v1[3]);
                    *(u32x4*)(rowp + bj * HALF) = w; } }
    }
};


template <bool XIN_BF16> struct EpiResid {
    static constexpr bool PERM = false, AFTER_DRAIN = false;
    const float* xin_lat; const float* xin_ctx; int nlat; bf16_t* XR; int ldc; const float* mod; int mod_stride; int seq; float* rssp;
    struct Pre {}; __device__ __forceinline__ void preload(Pre&, const Unit&, int, int, int, int) const {}
    __device__ __forceinline__ void operator()(const f32x4 (&acc)[2][2][4][2], const Unit& u, int wr, int wc, int fr, int fq, const Pre&) const {
        typedef unsigned u32x2 __attribute__((ext_vector_type(2)));
        const int row0 = u.pm * BM + wr * 64 + fr, col0 = u.pn * BM + wc * 32 + 4 * fq;
        const int rowt = u.pm * BM; const int bidx = rowt < nlat ? rowt / seq : 4;
        const float* gate = mod + (size_t)bidx * mod_stride;
        const float* xin = rowt < nlat ? xin_lat : (xin_ctx - (size_t)nlat * ldc);
        f32x4 gv[2][2];
#pragma unroll
        for (int bj = 0; bj < 2; ++bj)
#pragma unroll
            for (int n = 0; n < 2; ++n) gv[bj][n] = *(const f32x4*)(gate + col0 + bj * HALF + n * 16);
#pragma unroll
        for (int ai = 0; ai < 2; ++ai)
#pragma unroll
            for (int m = 0; m < 4; ++m) { const int row = row0 + ai * HALF + m * 16; const size_t ro = (size_t)row * ldc + col0; float s2 = 0.f;
#pragma unroll
                for (int bj = 0; bj < 2; ++bj)
#pragma unroll
                    for (int n = 0; n < 2; ++n) { const size_t idx = ro + bj * HALF + n * 16; f32x4 xv;
                        if (XIN_BF16) { const u32x2 w = *(const u32x2*)(XR + idx); xv = (f32x4){__builtin_bit_cast(float, w.x << 16), __builtin_bit_cast(float, w.x & 0xffff0000u), __builtin_bit_cast(float, w.y << 16), __builtin_bit_cast(float, w.y & 0xffff0000u)}; }
                        else xv = *(const f32x4*)(xin + idx);
                        const f32x4 v = xv + gv[bj][n] * acc[ai][bj][m][n];
                        s2 += (v[0] * v[0] + v[1] * v[1]) + (v[2] * v[2] + v[3] * v[3]);
                        u32x2 o; o.x = cvt_pk_bf16(v[0], v[1]); o.y = cvt_pk_bf16(v[2], v[3]); *(u32x2*)(XR + idx) = o; }
                s2 += __shfl_xor(s2, 16); s2 += __shfl_xor(s2, 32);
                if (fq == 0) rssp[(size_t)row * 16 + u.pn * 4 + wc] = s2; }
    }
};
struct EpiSwiglu {
    static constexpr bool PERM = true, AFTER_DRAIN = false;
    bf16_t* O; int ldc; const float* bias; int bias_stride;
    struct Pre { unsigned bw[2][2][2]; };
    __device__ __forceinline__ void preload(Pre& p, const Unit& u, int wr, int wc, int fr, int fq) const {
        const float* bb = bias + (size_t)u.e * bias_stride + u.pn * BM + wc * 32 + 8 * fq;
#pragma unroll
        for (int bj = 0; bj < 2; ++bj)
#pragma unroll
            for (int n = 0; n < 2; ++n) { const f32x4 v = *(const f32x4*)(bb + bj * HALF + 4 * n); p.bw[bj][n][0] = cvt_pk_bf16(v[0], v[1]); p.bw[bj][n][1] = cvt_pk_bf16(v[2], v[3]); }
    }
    __device__ __forceinline__ void operator()(const f32x4 (&acc)[2][2][4][2], const Unit& u, int wr, int wc, int fr, int fq, const Pre& pre) const {
        const int row0 = u.pm * BM + wr * 64 + fr; const int bcol0 = u.pn * BM + wc * 32 + 8 * fq; const int ocol0 = bcol0 >> 1;
        f32x4 bv[2][2];
#pragma unroll
        for (int bj = 0; bj < 2; ++bj)
#pragma unroll
            for (int n = 0; n < 2; ++n) { const unsigned w0 = pre.bw[bj][n][0], w1 = pre.bw[bj][n][1];
                bv[bj][n] = (f32x4){__builtin_bit_cast(float, w0 << 16), __builtin_bit_cast(float, w0 & 0xffff0000u), __builtin_bit_cast(float, w1 << 16), __builtin_bit_cast(float, w1 & 0xffff0000u)}; }
#pragma unroll
        for (int ai = 0; ai < 2; ++ai)
#pragma unroll
            for (int m = 0; m < 4; ++m) { bf16_t* rowp = O + (size_t)(row0 + ai * HALF + m * 16) * ldc + ocol0;
#pragma unroll
                for (int bj = 0; bj < 2; ++bj) { const f32x4 v0 = acc[ai][bj][m][0] + bv[bj][0], v1 = acc[ai][bj][m][1] + bv[bj][1];
                    float o[4];
#pragma unroll
                    for (int p = 0; p < 4; ++p) { const float hg = p < 2 ? v0[2 * p] : v1[2 * p - 4], hl = p < 2 ? v0[2 * p + 1] : v1[2 * p - 3];
                        const float glu = fminf(hg, 7.0f), lin = fminf(fmaxf(hl, -7.0f), 7.0f);
                        const float sg = __builtin_amdgcn_rcpf(1.0f + __builtin_amdgcn_exp2f(-1.702f * 1.4426950408889634f * glu));
                        o[p] = glu * sg * (lin + 1.0f); }
                    typedef unsigned u32x2 __attribute__((ext_vector_type(2)));
                    u32x2 w; w.x = cvt_pk_bf16(o[0], o[1]); w.y = cvt_pk_bf16(o[2], o[3]);
                    *(u32x2*)(rowp + bj * (HALF / 2)) = w; } }
    }
};
struct EpiSwigluF8 {
    static constexpr bool PERM = true, AFTER_DRAIN = false;
    bf16_t* O; int ldc; const float* bias; int bias_stride;
    struct Pre { unsigned bw[2][2][2]; };
    __device__ __forceinline__ void preload(Pre& p, const Unit& u, int wr, int wc, int fr, int fq) const {
        const float* bb = bias + (size_t)u.e * bias_stride + u.pn * BM + wc * 32 + 8 * fq;
#pragma unroll
        for (int bj = 0; bj < 2; ++bj)
#pragma unroll
            for (int n = 0; n < 2; ++n) { const f32x4 v = *(const f32x4*)(bb + bj * HALF + 4 * n); p.bw[bj][n][0] = cvt_pk_bf16(v[0], v[1]); p.bw[bj][n][1] = cvt_pk_bf16(v[2], v[3]); }
    }
    __device__ __forceinline__ void operator()(const f32x4 (&acc)[2][2][4][2], const Unit& u, int wr, int wc, int fr, int fq, const Pre& pre) const {
        asm volatile("" : "+v"(fr), "+v"(fq));
        const int row0 = u.pm * BM + wr * 64 + fr; const int bcol0 = u.pn * BM + wc * 32 + 8 * fq; const int ocol0 = bcol0 >> 1;
        f32x4 bv[2][2];
#pragma unroll
        for (int bj = 0; bj < 2; ++bj)
#pragma unroll
            for (int n = 0; n < 2; ++n) { const unsigned w0 = pre.bw[bj][n][0], w1 = pre.bw[bj][n][1];
                bv[bj][n] = (f32x4){__builtin_bit_cast(float, w0 << 16), __builtin_bit_cast(float, w0 & 0xffff0000u), __builtin_bit_cast(float, w1 << 16), __builtin_bit_cast(float, w1 & 0xffff0000u)}; }
#pragma unroll
        for (int ai = 0; ai < 2; ++ai)
#pragma unroll
            for (int m = 0; m < 4; ++m) {
#pragma unroll
                for (int bj = 0; bj < 2; ++bj) { const f32x4 v0 = acc[ai][bj][m][0] * (1.0f / (F8_SF * F8_SW)) + bv[bj][0], v1 = acc[ai][bj][m][1] * (1.0f / (F8_SF * F8_SW)) + bv[bj][1];
                    float o[4];
#pragma unroll
                    for (int p = 0; p < 4; ++p) { const float hg = p < 2 ? v0[2 * p] : v1[2 * p - 4], hl = p < 2 ? v0[2 * p + 1] : v1[2 * p - 3];
                        const float glu = fminf(hg, 7.0f), lin = fminf(fmaxf(hl, -7.0f), 7.0f);
                        const float sg = __builtin_amdgcn_rcpf(1.0f + __builtin_amdgcn_exp2f(-1.702f * 1.4426950408889634f * glu));
                        o[p] = glu * sg * (lin + 1.0f); }
                    *(unsigned*)((unsigned char*)O + (size_t)(row0 + ai * HALF + m * 16) * ldc + ocol0 + bj * (HALF / 2)) = pack4_fp8(o[0] * F8_SA, o[1] * F8_SA, o[2] * F8_SA, o[3] * F8_SA); } }
    }
};
struct EpiBf16Bias {
    static constexpr bool PERM = true, AFTER_DRAIN = false;
    bf16_t* O; int ldc; const float* bias; int bias_stride;
    struct Pre { f32x4 bv[2][2]; };
    __device__ __forceinline__ void preload(Pre& p, const Unit& u, int wr, int wc, int fr, int fq) const {
        const float* bb = bias + (size_t)u.e * bias_stride + u.pn * BM + wc * 32 + 8 * fq;
#pragma unroll
        for (int bj = 0; bj < 2; ++bj)
#pragma unroll
            for (int n = 0; n < 2; ++n) p.bv[bj][n] = *(const f32x4*)(bb + bj * HALF + 4 * n);
    }
    __device__ __forceinline__ void operator()(const f32x4 (&acc)[2][2][4][2], const Unit& u, int wr, int wc, int fr, int fq, const Pre& pre) const {
        const int row0 = u.pm * BM + wr * 64 + fr; const int col0 = u.pn * BM + wc * 32 + 8 * fq;
#pragma unroll
        for (int ai = 0; ai < 2; ++ai)
#pragma unroll
            for (int m = 0; m < 4; ++m) { bf16_t* rowp = O + (size_t)(row0 + ai * HALF + m * 16) * ldc + col0;
#pragma unroll
                for (int bj = 0; bj < 2; ++bj) { const f32x4 v0 = acc[ai][bj][m][0] + pre.bv[bj][0], v1 = acc[ai][bj][m][1] + pre.bv[bj][1];
                    u32x4 w; w.x = cvt_pk_bf16(v0[0], v0[1]); w.y = cvt_pk_bf16(v0[2], v0[3]); w.z = cvt_pk_bf16(v1[0], v1[1]); w.w = cvt_pk_bf16(v1[2], v1[3]);
                    *(u32x4*)(rowp + bj * HALF) = w; } }
    }
};
struct EpiBf16BiasFold {
    static constexpr bool PERM = true, AFTER_DRAIN = false;
    bf16_t* O; int ldc; const float* bias; int bias_stride;
    struct Pre { f32x4 bv[2][2]; };
    __device__ __forceinline__ void preload(Pre& p, const Unit& u, int wr, int wc, int fr, int fq) const {
        const float* bb = bias + (size_t)u.e * bias_stride + u.pn * BM + wc * 32 + 8 * fq;
#pragma unroll
        for (int bj = 0; bj < 2; ++bj)
#pragma unroll
            for (int n = 0; n < 2; ++n) p.bv[bj][n] = *(const f32x4*)(bb + bj * HALF + 4 * n);
    }
    __device__ __forceinline__ void operator()(const f32x4 (&acc)[2][2][4][2], const Unit& u, int wr, int wc, int fr, int fq, const Pre& pre) const {
        const int row0 = u.pm * BM + wr * 64 + fr; const int col0 = u.pn * BM + wc * 32 + 8 * fq;
#pragma unroll
        for (int ai = 0; ai < 2; ++ai)
#pragma unroll
            for (int m = 0; m < 4; ++m) { bf16_t* rowp = O + (size_t)((row0 + ai * HALF + m * 16) & 255) * ldc + col0;
#pragma unroll
                for (int bj = 0; bj < 2; ++bj) { const f32x4 v0 = acc[ai][bj][m][0] + pre.bv[bj][0], v1 = acc[ai][bj][m][1] + pre.bv[bj][1];
                    u32x4 w; w.x = cvt_pk_bf16(v0[0], v0[1]); w.y = cvt_pk_bf16(v0[2], v0[3]); w.z = cvt_pk_bf16(v1[0], v1[1]); w.w = cvt_pk_bf16(v1[2], v1[3]);
                    *(u32x4*)(rowp + bj * HALF) = w; } }
    }
};
struct EpiBf16BiasF8 {
    static constexpr bool PERM = true, AFTER_DRAIN = false;
    bf16_t* O; int ldc; const float* bias; int bias_stride;
    struct Pre { f32x4 bv[2][2]; };
    __device__ __forceinline__ void preload(Pre& p, const Unit& u, int wr, int wc, int fr, int fq) const {
        const float* bb = bias + (size_t)u.e * bias_stride + u.pn * BM + wc * 32 + 8 * fq;
#pragma unroll
        for (int bj = 0; bj < 2; ++bj)
#pragma unroll
            for (int n = 0; n < 2; ++n) p.bv[bj][n] = *(const f32x4*)(bb + bj * HALF + 4 * n);
    }
    __device__ __forceinline__ void operator()(const f32x4 (&acc)[2][2][4][2], const Unit& u, int wr, int wc, int fr, int fq, const Pre& pre) const {
        asm volatile("" : "+v"(fr), "+v"(fq));
        const int row0 = u.pm * BM + wr * 64 + fr; const int col0 = u.pn * BM + wc * 32 + 8 * fq;
#pragma unroll
        for (int ai = 0; ai < 2; ++ai)
#pragma unroll
            for (int m = 0; m < 4; ++m) { bf16_t* rowp = O + (size_t)(row0 + ai * HALF + m * 16) * ldc + col0;
#pragma unroll
                for (int bj = 0; bj < 2; ++bj) { const f32x4 v0 = acc[ai][bj][m][0] * (1.0f / (F8_SA * F8_SW)) + pre.bv[bj][0], v1 = acc[ai][bj][m][1] * (1.0f / (F8_SA * F8_SW)) + pre.bv[bj][1];
                    u32x4 w; w.x = cvt_pk_bf16(v0[0], v0[1]); w.y = cvt_pk_bf16(v0[2], v0[3]); w.z = cvt_pk_bf16(v1[0], v1[1]); w.w = cvt_pk_bf16(v1[2], v1[3]);
                    *(u32x4*)(rowp + bj * HALF) = w; } }
    }
};
struct EpiF8BiasF8 {
    static constexpr bool PERM = true, AFTER_DRAIN = false;
    bf16_t* O; int ldc; const float* bias; int bias_stride;
    struct Pre { f32x4 bv[2][2]; };
    __device__ __forceinline__ void preload(Pre& p, const Unit& u, int wr, int wc, int fr, int fq) const {
        const float* bb = bias + (size_t)u.e * bias_stride + u.pn * BM + wc * 32 + 8 * fq;
#pragma unroll
        for (int bj = 0; bj < 2; ++bj)
#pragma unroll
            for (int n = 0; n < 2; ++n) p.bv[bj][n] = *(const f32x4*)(bb + bj * HALF + 4 * n);
    }
    __device__ __forceinline__ void operator()(const f32x4 (&acc)[2][2][4][2], const Unit& u, int wr, int wc, int fr, int fq, const Pre& pre) const {
        asm volatile("" : "+v"(fr), "+v"(fq));
        const int row0 = u.pm * BM + wr * 64 + fr; const int col0 = u.pn * BM + wc * 32 + 8 * fq;
#pragma unroll
        for (int ai = 0; ai < 2; ++ai)
#pragma unroll
            for (int m = 0; m < 4; ++m) { unsigned char* rowp = (unsigned char*)O + (size_t)(row0 + ai * HALF + m * 16) * ldc + col0;
#pragma unroll
                for (int bj = 0; bj < 2; ++bj) { const f32x4 v0 = (acc[ai][bj][m][0] * (1.0f / (F8_SA * F8_SW)) + pre.bv[bj][0]) * F8_SY, v1 = (acc[ai][bj][m][1] * (1.0f / (F8_SA * F8_SW)) + pre.bv[bj][1]) * F8_SY;
                    typedef unsigned u32x2 __attribute__((ext_vector_type(2)));
                    u32x2 w; w.x = pack4_fp8(v0[0], v0[1], v0[2], v0[3]); w.y = pack4_fp8(v1[0], v1[1], v1[2], v1[3]);
                    *(u32x2*)(rowp + bj * HALF) = w; } }
    }
};
struct EpiLruGate {
    static constexpr bool PERM = false, AFTER_DRAIN = false;
    const bf16_t* XL; bf16_t* LAB; size_t lab_stride; const float* gb; const float* spt;
    struct Pre {}; __device__ __forceinline__ void preload(Pre&, const Unit&, int, int, int, int) const {}
    __device__ __forceinline__ void operator()(const f32x4 (&acc)[2][2][4][2], const Unit& u, int wr, int wc, int fr, int fq, const Pre&) const {
        const int d = u.pn >> 1, half = u.pn & 1;
        const int row0 = u.pm * BM + wr * 64 + fr, ch0 = half * 128 + wc * 32 + 4 * fq;
        bf16_t* LA = LAB + (size_t)(2 * d) * lab_stride; bf16_t* LB = LAB + (size_t)(2 * d + 1) * lab_stride;
#pragma unroll
        for (int n = 0; n < 2; ++n) {
            const f32x4 bR = *(const f32x4*)(gb + (d * 2 + 0) * 256 + ch0 + 16 * n), bI = *(const f32x4*)(gb + (d * 2 + 1) * 256 + ch0 + 16 * n);
            const f32x4 sp = *(const f32x4*)(spt + d * 256 + ch0 + 16 * n) * (-8.0f * 1.4426950408889634f);
#pragma unroll
            for (int ai = 0; ai < 2; ++ai)
#pragma unroll
                for (int m = 0; m < 4; ++m) { const size_t ro = (size_t)(row0 + ai * HALF + m * 16) * 256 + ch0 + 16 * n;
                    typedef unsigned u32x2 __attribute__((ext_vector_type(2)));
                    const u32x2 xw = *(const u32x2*)(XL + ro);
                    const float xl[4] = {__builtin_bit_cast(float, xw.x << 16), __builtin_bit_cast(float, xw.x & 0xffff0000u), __builtin_bit_cast(float, xw.y << 16), __builtin_bit_cast(float, xw.y & 0xffff0000u)};
                    const f32x4 gr = acc[ai][0][m][n] + bR, gi = acc[ai][1][m][n] + bI;
                    f32x4 av, bv;
#pragma unroll
                    for (int e = 0; e < 4; ++e) {
                        const float rg = __builtin_amdgcn_rcpf(1.0f + __builtin_amdgcn_exp2f(-1.4426950408889634f * gr[e])), ig = __builtin_amdgcn_rcpf(1.0f + __builtin_amdgcn_exp2f(-1.4426950408889634f * gi[e]));
                        const float la2 = rg * sp[e];
                        const float a2 = __builtin_amdgcn_exp2f(2.0f * la2);
                        av[e] = la2; bv[e] = __builtin_amdgcn_sqrtf(fmaxf(1.0f - a2, 0.f)) * (ig * xl[e]); }
                    u32x2 wa, wb; wa.x = cvt_pk_bf16(av[0], av[1]); wa.y = cvt_pk_bf16(av[2], av[3]); wb.x = cvt_pk_bf16(bv[0], bv[1]); wb.y = cvt_pk_bf16(bv[2], bv[3]);
                    *(u32x2*)(LA + ro) = wa; *(u32x2*)(LB + ro) = wb; }
        }
    }
};
struct EpiNone {
    static constexpr bool PERM = true, AFTER_DRAIN = false;
    struct Pre {}; __device__ __forceinline__ void preload(Pre&, const Unit&, int, int, int, int) const {}
    __device__ __forceinline__ void operator()(const f32x4 (&acc)[2][2][4][2], const Unit& u, int wr, int wc, int fr, int fq, const Pre&) const {
#pragma unroll
        for (int a = 0; a < 2; ++a)
#pragma unroll
            for (int b2 = 0; b2 < 2; ++b2)
#pragma unroll
                for (int m = 0; m < 4; ++m)
#pragma unroll
                    for (int n = 0; n < 2; ++n) { f32x4 v = acc[a][b2][m][n]; asm volatile("" :: "v"(v)); }
    }
};
template <bool GATHER_> struct MoeOrderT {
    static constexpr bool GATHER = GATHER_;
    const int* rowtok;
    __device__ __forceinline__ int row_of(int r) const { return GATHER_ ? rowtok[r] : r; }
    const PG8_LAS int* tab; int ntiles, nN, nper, j, m_lo, nMx, wgm, rev;
    __device__ __forceinline__ void init(const PG8_LAS int* tab_, int ntiles_, int nN_, int G, int bx, int wgm_) {
        tab = tab_; ntiles = ntiles_; nN = nN_; wgm = wgm_; rev = 0;
        if (G % 8 == 0) { const int x = bx % 8; nper = G / 8; j = bx / 8; m_lo = (x * ntiles) / 8; nMx = ((x + 1) * ntiles) / 8 - m_lo; }
        else { nper = G; j = bx; m_lo = 0; nMx = ntiles; }
    }
    __device__ __forceinline__ bool next(int i, Unit& u) const {
        const int s = i * nper + j; if (s >= nMx * nN) return false;
        const int nig = wgm * nN, gid = s / nig, fm = gid * wgm, gsz = (nMx - fm) < wgm ? (nMx - fm) : wgm, w = s - gid * nig;
        const int mi = fm + (w % gsz); u.pm = m_lo + (rev ? (nMx - 1 - mi) : mi); u.pn = w / gsz; u.e = tab[u.pm]; u.be = u.e * nN + u.pn; return true;
    }
    __device__ __forceinline__ void a_ready(const Unit&) const {}
    __device__ __forceinline__ void done(const Unit&) const {}
};
template <class Epi, class Sched, bool ALIGN_EPI = false, bool SP2 = false, bool FP8 = false>
__device__ __forceinline__ void gemm_phase(PG8_LAS unsigned char* lds, const Gemm g, const Sched& S, const Epi& E) {
    int tid_ = threadIdx.x; asm volatile("" : "+v"(tid_));
    const int tid = tid_, wid = __builtin_amdgcn_readfirstlane(tid >> 6), lane = tid & 63, wr = wid >> 2, wc = wid & 3, fr = lane & 15, fq = lane >> 4;
    const int K = g.K, nt = K / BK;
    unsigned voffA[2], voffB[2];
#pragma unroll
    for (int i = 0; i < 2; ++i) { int R, C; stage_rc(tid * 16 + i * 8192, R, C); const int Rb = Epi::PERM ? ((R & ~31) + perm32(R & 31)) : R;
        voffA[i] = (unsigned)(R * K + C) * 2u; voffB[i] = (unsigned)(Rb * K + C) * 2u; }
    unsigned gA_[2] = {0u, 0u}, gN_[2] = {0u, 0u}, gC_[2] = {0u, 0u};
    static_assert(!Sched::GATHER || SP2, "the gathered A operand is wired into the SP2 loop only");
    if constexpr (Sched::GATHER) { _Pragma("unroll") for (int i_ = 0; i_ < 2; ++i_) { int R_, C_; stage_rc(tid * 16 + i_ * 8192, R_, C_); gC_[i_] = (unsigned)(C_ * 2); } }
#define PG8_GLOAD(dst, pm_) do { _Pragma("unroll") for (int h_ = 0; h_ < 2; ++h_) { unsigned t_[2]; _Pragma("unroll") for (int i_ = 0; i_ < 2; ++i_) { int R_, C_; stage_rc(tid * 16 + i_ * 8192, R_, C_); \
        t_[i_] = (unsigned)S.row_of((pm_) * BM + h_ * HALF + R_); } dst[h_] = t_[0] | (t_[1] << 16); } } while (0)
    const size_t kstep = (size_t)(BK * 2);
    const size_t hstep = (size_t)HALF * K * 2;
    const size_t tstep = 2 * hstep;
    const unsigned ldsw = (unsigned)wid * 1024u;
    const int aoff = lds_byte(wr * 64 + fr, fq * 8), boff = lds_byte(wc * 32 + fr, fq * 8);
#define PG8_SA(b, h) (((b) * 2 + (h)) * HTB)
#define PG8_SB(b, h) ((4 + (b) * 2 + (h)) * HTB)
#define PG8_STAGE(bufoff, gbase, voff) do { _Pragma("unroll") for (int _i = 0; _i < 2; ++_i) \
        __builtin_amdgcn_global_load_lds((const unsigned*)((const char*)(gbase) + (voff)[_i]), (PG8_LAS unsigned*)(lds + (bufoff) + ldsw + _i * 8192), 16, 0, 0); } while (0)
#define PG8_STA(bufoff, ptr, h, useN) do { if constexpr (Sched::GATHER) { const unsigned pk_ = (useN) ? gN_[h] : gA_[h]; unsigned o_[2] = {(pk_ & 0xffffu) * (unsigned)(K * 2) + gC_[0], (pk_ >> 16) * (unsigned)(K * 2) + gC_[1]}; PG8_STAGE(bufoff, ptr, o_); } \
        else { PG8_STAGE(bufoff, (ptr) + ((h) ? hstep : 0), voffA); } } while (0)
#define PG8_LDA(dst, b, h) do { _Pragma("unroll") for (int m = 0; m < 4; ++m) { if constexpr (FP8) { \
            dst##8[m] = __builtin_shufflevector(*(const PG8_LAS i32x4_*)(lds + PG8_SA(b, h) + aoff + m * 2048), *(const PG8_LAS i32x4_*)(lds + PG8_SA(b, h) + aoff + m * 2048 + 1024), 0, 1, 2, 3, 4, 5, 6, 7); } \
        else { _Pragma("unroll") for (int k = 0; k < 2; ++k) dst[m][k] = *(const PG8_LAS bf16x8*)(lds + PG8_SA(b, h) + aoff + m * 2048 + k * 1024); } } } while (0)
#define PG8_LDB(dst, b, h) do { _Pragma("unroll") for (int n = 0; n < 2; ++n) { if constexpr (FP8) { \
            dst##8[n] = __builtin_shufflevector(*(const PG8_LAS i32x4_*)(lds + PG8_SB(b, h) + boff + n * 2048), *(const PG8_LAS i32x4_*)(lds + PG8_SB(b, h) + boff + n * 2048 + 1024), 0, 1, 2, 3, 4, 5, 6, 7); } \
        else { _Pragma("unroll") for (int k = 0; k < 2; ++k) dst[n][k] = *(const PG8_LAS bf16x8*)(lds + PG8_SB(b, h) + boff + n * 2048 + k * 1024); } } } while (0)
#define PG8_MMA(ai, bj, At, Bt) do { __builtin_amdgcn_s_setprio(1); _Pragma("unroll") for (int m = 0; m < 4; ++m) _Pragma("unroll") for (int n = 0; n < 2; ++n) { \
        if constexpr (FP8) asm volatile("v_mfma_f32_16x16x128_f8f6f4 %0, %1, %2, %0" : "+v"(acc[ai][bj][m][n]) : "v"(Bt##8[n]), "v"(At##8[m]));   \
        else { _Pragma("unroll") for (int k = 0; k < 2; ++k) acc[ai][bj][m][n] = __builtin_amdgcn_mfma_f32_16x16x32_bf16(Bt[n][k], At[m][k], acc[ai][bj][m][n], 0, 0, 0); } } \
        __builtin_amdgcn_s_setprio(0); } while (0)
#define PG8_WAIT_V(n) asm volatile("s_waitcnt vmcnt(" #n ")" ::: "memory")
#define PG8_WAIT_L(n) asm volatile("s_waitcnt lgkmcnt(" #n ")" ::: "memory")
#define PG8_BAR __builtin_amdgcn_s_barrier()
#define PG8_SCHED __builtin_amdgcn_sched_barrier(0)
    Unit cur, nxt; int ui = 0;
    if (!S.next(0, cur)) return;
    f32x4 acc[2][2][4][2];
#pragma unroll
    for (int a = 0; a < 2; ++a)
#pragma unroll
        for (int b = 0; b < 2; ++b)
#pragma unroll
            for (int m = 0; m < 4; ++m)
#pragma unroll
                for (int n = 0; n < 2; ++n) acc[a][b][m][n] = (f32x4){0.f, 0.f, 0.f, 0.f};
    typedef int i32x4_ __attribute__((ext_vector_type(4))); typedef int i32x8_ __attribute__((ext_vector_type(8)));
    bf16x8 At[4][2], B0[2][2], B1[2][2]; i32x8_ At8[4], B08[2], B18[2];
    typename Epi::Pre pre;
    const char* cA = (const char*)g.A + (Sched::GATHER ? (size_t)0 : (size_t)cur.pm * tstep); if constexpr (Sched::GATHER) PG8_GLOAD(gA_, cur.pm);
    const char* cB = (const char*)g.Bt + (size_t)cur.be * tstep;
    S.a_ready(cur);
    if constexpr (SP2) {
        PG8_STAGE(PG8_SB(0, 0), cB, voffB); PG8_STAGE(PG8_SB(0, 1), cB + hstep, voffB); PG8_STA(PG8_SA(0, 0), cA, 0, false); PG8_STA(PG8_SA(0, 1), cA, 1, false);
        if (wr == 1) PG8_BAR;
        PG8_WAIT_V(2); PG8_BAR;
        PG8_STAGE(PG8_SB(1, 0), cB + kstep, voffB); PG8_STA(PG8_SA(1, 0), cA + kstep, 0, false); PG8_STAGE(PG8_SB(1, 1), cB + hstep + kstep, voffB);
        PG8_WAIT_V(6); PG8_BAR;
    } else {
        PG8_STAGE(PG8_SB(0, 0), cB, voffB); PG8_STAGE(PG8_SA(0, 0), cA, voffA); PG8_STAGE(PG8_SB(0, 1), cB + hstep, voffB); PG8_STAGE(PG8_SA(0, 1), cA + hstep, voffA);
        if (wr == 1) PG8_BAR;
        PG8_WAIT_V(4); PG8_BAR;
        PG8_STAGE(PG8_SB(1, 0), cB + kstep, voffB); PG8_STAGE(PG8_SA(1, 0), cA + kstep, voffA); PG8_STAGE(PG8_SB(1, 1), cB + hstep + kstep, voffB);
        PG8_WAIT_V(6); PG8_BAR;
    }
    for (;;) {
        const bool has_next = S.next(ui + 1, nxt);
        const char* nA = (has_next && !Sched::GATHER) ? (const char*)g.A + (size_t)nxt.pm * tstep : cA; const char* nB = has_next ? (const char*)g.Bt + (size_t)nxt.be * tstep : cB;
        if constexpr (Sched::GATHER) { if (has_next) PG8_GLOAD(gN_, nxt.pm); else { gN_[0] = gA_[0]; gN_[1] = gA_[1]; } }
        asm volatile(".p2align 8");
        for (int t = 0; t < nt; t += 2) {
            const bool last = (t == nt - 2);
            const char* a1 = cA + (size_t)(t + 1) * kstep;
            const char* a2 = last ? nA : cA + (size_t)(t + 2) * kstep; const char* b2 = last ? nB : cB + (size_t)(t + 2) * kstep;
            const char* a3 = a2 + kstep; const char* b3 = b2 + kstep;
            if (last) E.preload(pre, cur, wr, wc, fr, fq);
            if (last && has_next) S.a_ready(nxt);
            if constexpr (SP2) {
            PG8_LDB(B0, 0, 0); PG8_LDB(B1, 0, 1); PG8_SCHED; PG8_LDA(At, 0, 0); PG8_STA(PG8_SA(1, 1), a1, 1, false);
            PG8_WAIT_V(8); PG8_WAIT_L(0); PG8_BAR; PG8_MMA(0, 0, At, B0); PG8_MMA(0, 1, At, B1); PG8_BAR; PG8_SCHED;
            PG8_LDA(At, 0, 1); PG8_STAGE(PG8_SB(0, 0), b2, voffB); PG8_STAGE(PG8_SB(0, 1), b2 + hstep, voffB); PG8_STA(PG8_SA(0, 0), a2, 0, last);
            PG8_WAIT_V(8); PG8_WAIT_L(0); PG8_BAR; PG8_MMA(1, 0, At, B0); PG8_MMA(1, 1, At, B1); PG8_BAR; PG8_SCHED;
            PG8_LDB(B0, 1, 0); PG8_LDB(B1, 1, 1); PG8_SCHED; PG8_LDA(At, 1, 0); PG8_STA(PG8_SA(0, 1), a2, 1, last);
            PG8_WAIT_V(8); PG8_WAIT_L(0); PG8_BAR; PG8_MMA(0, 0, At, B0); PG8_MMA(0, 1, At, B1); PG8_BAR; PG8_SCHED;
            PG8_LDA(At, 1, 1); PG8_STAGE(PG8_SB(1, 0), b3, voffB); PG8_STAGE(PG8_SB(1, 1), b3 + hstep, voffB); PG8_STA(PG8_SA(1, 0), a3, 0, last);
            PG8_WAIT_V(8); PG8_WAIT_L(0); PG8_BAR; PG8_MMA(1, 0, At, B0); PG8_MMA(1, 1, At, B1); PG8_BAR; PG8_SCHED;
            } else {
            PG8_LDB(B0, 0, 0); PG8_SCHED; PG8_LDA(At, 0, 0); PG8_STAGE(PG8_SA(1, 1), a1 + hstep, voffA);
            PG8_WAIT_L(8); PG8_BAR; PG8_WAIT_L(0); PG8_MMA(0, 0, At, B0); PG8_BAR; PG8_SCHED;
            PG8_LDB(B1, 0, 1); PG8_STAGE(PG8_SB(0, 0), b2, voffB);
            PG8_BAR; PG8_WAIT_L(0); PG8_MMA(0, 1, At, B1); PG8_BAR;
            PG8_LDA(At, 0, 1); PG8_STAGE(PG8_SA(0, 0), a2, voffA);
            PG8_BAR; PG8_WAIT_L(0); PG8_MMA(1, 0, At, B0); PG8_BAR; PG8_SCHED;
            PG8_STAGE(PG8_SB(0, 1), b2 + hstep, voffB);
            PG8_WAIT_V(6); PG8_BAR; PG8_MMA(1, 1, At, B1); PG8_BAR;
            PG8_LDB(B0, 1, 0); PG8_SCHED; PG8_LDA(At, 1, 0); PG8_STAGE(PG8_SA(0, 1), a2 + hstep, voffA);
            PG8_WAIT_L(8); PG8_BAR; PG8_WAIT_L(0); PG8_MMA(0, 0, At, B0); PG8_BAR; PG8_SCHED;
            PG8_LDB(B1, 1, 1); PG8_STAGE(PG8_SB(1, 0), b3, voffB);
            PG8_BAR; PG8_WAIT_L(0); PG8_MMA(0, 1, At, B1); PG8_BAR;
            PG8_LDA(At, 1, 1); PG8_STAGE(PG8_SA(1, 0), a3, voffA);
            PG8_BAR; PG8_WAIT_L(0); PG8_MMA(1, 0, At, B0); PG8_BAR; PG8_SCHED;
            PG8_STAGE(PG8_SB(1, 1), b3 + hstep, voffB);
            PG8_WAIT_V(6); PG8_BAR; PG8_MMA(1, 1, At, B1); PG8_BAR;
            }
        }
        if constexpr (ALIGN_EPI) { if (wr == 0) PG8_BAR; }
        if constexpr (!Epi::AFTER_DRAIN) { E(acc, cur, wr, wc, fr, fq, pre); S.done(cur); }
        if (!has_next) break;
#pragma unroll
        for (int a = 0; a < 2; ++a)
#pragma unroll
            for (int b = 0; b < 2; ++b)
#pragma unroll
                for (int m = 0; m < 4; ++m)
#pragma unroll
                    for (int n = 0; n < 2; ++n) acc[a][b][m][n] = (f32x4){0.f, 0.f, 0.f, 0.f};
        cur = nxt; cA = nA; cB = nB; ++ui;
        if constexpr (Sched::GATHER) { gA_[0] = gN_[0]; gA_[1] = gN_[1]; }
        if constexpr (ALIGN_EPI) { if (wr == 1) PG8_BAR; }
    }
    PG8_WAIT_V(0);
    if constexpr (!ALIGN_EPI) { if (wr == 0) PG8_BAR; }
    PG8_BAR;
    if constexpr (Epi::AFTER_DRAIN) { E.fused(acc, cur, wr, wc, fr, fq, lds, wid, lane); S.done(cur); }
#undef PG8_SA
#undef PG8_SB
#undef PG8_STAGE
#undef PG8_STA
#undef PG8_GLOAD
#undef PG8_LDA
#undef PG8_LDB
#undef PG8_MMA
#undef PG8_WAIT_V
#undef PG8_WAIT_L
#undef PG8_BAR
#undef PG8_SCHED
}
}

#ifndef PG8_SP2
#define PG8_SP2 true
#endif
#ifndef PG8_ALIGN
#define PG8_ALIGN true
#endif
#include <cmath>
namespace attn_body {
using bf16=__hip_bfloat16;
using bf16x8=__attribute__((ext_vector_type(8)))short;
using s16x4=__attribute__((ext_vector_type(4)))short;
using f32x16=__attribute__((ext_vector_type(16)))float;
using u32x4=__attribute__((ext_vector_type(4)))unsigned;
using f32x4_t=__attribute__((ext_vector_type(4)))float;
constexpr int NHEAD=8,SEQQ=8192,SEQK=8448,D=64,QP=512,KP=128,QIN=2048;
constexpr int NW=8,QBLK=32,QB=QBLK*NW,KVBLK=64,NQB=SEQQ/QB;
constexpr int ATTN_UNIT_ROWS=QB;
__device__ __forceinline__ int crow(int r,int hi){return (r&3)+8*(r>>2)+4*hi;}
#define SBAR() __builtin_amdgcn_sched_barrier(0)
__device__ __forceinline__ void cmask(f32x16&p0,f32x16&p1,int jb,int qrel,int hi){
  const float NEG=-INFINITY; int kb=64*jb+4*hi;
  #pragma unroll
  for(int r=0;r<16;++r){int kv=kb+(r&3)+8*(r>>2); if(kv>qrel)p0[r]=NEG; if(kv+32>qrel)p1[r]=NEG;}
}

constexpr int NSLOT=3, SLOTB=8192;
constexpr int LDS_K=0, LDS_V=NSLOT*SLOTB, LDS_WS=2*NSLOT*SLOTB, LDS_OST=LDS_WS+NW*64*4, LDS_BYTES=LDS_OST+NW*4096;
constexpr float C2=0.125f*1.4426950408889634f;
__device__ __forceinline__ void glds16(const void*gsrc,unsigned lds_dst){unsigned keep;
  asm volatile("s_mov_b32 %0, m0\n\ts_mov_b32 m0, %2\n\ts_nop 0\n\tglobal_load_lds_dwordx4 %1, off\n\ts_mov_b32 m0, %0":"=&s"(keep):"v"(gsrc),"s"(lds_dst):"memory");}
__device__ __forceinline__ float max3f(float a,float b,float c){float r;asm("v_max3_f32 %0, %1, %2, %3":"=v"(r):"v"(a),"v"(b),"v"(c));return r;}
__device__ __forceinline__ float max2f(float a,float b){float r;asm("v_max_f32_e32 %0, %1, %2":"=v"(r):"v"(a),"v"(b));return r;}
__device__ __forceinline__ float fadd_s(float a,float b){float r;asm("v_add_f32_e32 %0, %1, %2":"=v"(r):"v"(a),"v"(b));return r;}
__device__ __forceinline__ float fsub_s(float a,float b){float r;asm("v_sub_f32_e32 %0, %1, %2":"=v"(r):"v"(a),"v"(b));return r;}
typedef float f32x2_t __attribute__((ext_vector_type(2))); typedef __bf16 bf16x2_t __attribute__((ext_vector_type(2)));
__device__ __forceinline__ unsigned cvtpk_s(float lo,float hi){f32x2_t v={lo,hi};bf16x2_t b=__builtin_convertvector(v,bf16x2_t);return __builtin_bit_cast(unsigned,b);}
#define WAIT_BAR(N) asm volatile("s_waitcnt vmcnt(" #N ") lgkmcnt(0)\n\ts_barrier":::"memory")

__device__ __forceinline__ void qkt(f32x16&p0,f32x16&p1,const char*Kslot,const bf16x8*qr,const f32x16&negm,int r32,int hi){
  const char*kb=Kslot+hi*1024+r32*16;
  #pragma unroll
  for(int d0=0;d0<4;++d0){
    const bf16x8 b0=*reinterpret_cast<const bf16x8*>(kb+d0*2048);
    const bf16x8 b1=*reinterpret_cast<const bf16x8*>(kb+d0*2048+512);
    if(d0==0){p0=__builtin_amdgcn_mfma_f32_32x32x16_bf16(b0,qr[0],negm,0,0,0);p1=__builtin_amdgcn_mfma_f32_32x32x16_bf16(b1,qr[0],negm,0,0,0);}
    else{p0=__builtin_amdgcn_mfma_f32_32x32x16_bf16(b0,qr[d0],p0,0,0,0);p1=__builtin_amdgcn_mfma_f32_32x32x16_bf16(b1,qr[d0],p1,0,0,0);}}
}
typedef __attribute__((address_space(3))) const char* lds_cptr;
typedef short v4i16_t __attribute__((ext_vector_type(4)));
__device__ __forceinline__ void kload8(bf16x8*kf,lds_cptr kp){
  kf[0]=*(const __attribute__((address_space(3))) bf16x8*)(kp);      kf[1]=*(const __attribute__((address_space(3))) bf16x8*)(kp+512);
  kf[2]=*(const __attribute__((address_space(3))) bf16x8*)(kp+2048); kf[3]=*(const __attribute__((address_space(3))) bf16x8*)(kp+2560);
  kf[4]=*(const __attribute__((address_space(3))) bf16x8*)(kp+4096); kf[5]=*(const __attribute__((address_space(3))) bf16x8*)(kp+4608);
  kf[6]=*(const __attribute__((address_space(3))) bf16x8*)(kp+6144); kf[7]=*(const __attribute__((address_space(3))) bf16x8*)(kp+6656);
}
__device__ __forceinline__ void kload2(bf16x8*kf,lds_cptr kp,int j){ kf[2*j]=*(const __attribute__((address_space(3))) bf16x8*)(kp+j*2048); kf[2*j+1]=*(const __attribute__((address_space(3))) bf16x8*)(kp+j*2048+512); }
__device__ __forceinline__ s16x4 vtr(lds_cptr p){ return __builtin_bit_cast(s16x4,__builtin_amdgcn_ds_read_tr16_b64_v4i16((__attribute__((address_space(3))) v4i16_t*)p)); }
__device__ __forceinline__ float rowmax(const f32x16&p0,const f32x16&p1){
  float a=max3f(p0[0],p0[1],p1[0]),b=max3f(p0[2],p0[3],p1[1]);a=max3f(a,p1[2],p1[3]);
  #pragma unroll
  for(int r=4;r<16;r+=4){a=max3f(a,p0[r],p0[r+1]);b=max3f(b,p0[r+2],p0[r+3]);a=max3f(a,p1[r],p1[r+1]);b=max3f(b,p1[r+2],p1[r+3]);}
  const float m=max2f(a,b);
  auto rr=__builtin_amdgcn_permlane32_swap(__float_as_uint(m),__float_as_uint(m),false,false);
  return max2f(__uint_as_float(rr[0]),__uint_as_float(rr[1]));
}
__device__ __forceinline__ void pv(f32x16*o,int vb,bf16x8 pa0,bf16x8 pa1,bf16x8 pa2,bf16x8 pa3){
  #pragma unroll
  for(int d0=0;d0<2;++d0){s16x4 lo[4],hi[4];
    #pragma unroll
    for(int ks=0;ks<4;++ks){
      asm volatile("ds_read_b64_tr_b16 %0,%1 offset:%c2":"=&v"(lo[ks]):"v"(vb),"i"(d0*4096+ks*1024):"memory");
      asm volatile("ds_read_b64_tr_b16 %0,%1 offset:%c2":"=&v"(hi[ks]):"v"(vb),"i"(d0*4096+ks*1024+512):"memory");}
    asm volatile("s_waitcnt lgkmcnt(0)":::"memory");SBAR();
    #define PK(k) (bf16x8){lo[k][0],lo[k][1],lo[k][2],lo[k][3],hi[k][0],hi[k][1],hi[k][2],hi[k][3]}
    o[d0]=__builtin_amdgcn_mfma_f32_32x32x16_bf16(pa0,PK(0),o[d0],0,0,0);
    o[d0]=__builtin_amdgcn_mfma_f32_32x32x16_bf16(pa1,PK(1),o[d0],0,0,0);
    o[d0]=__builtin_amdgcn_mfma_f32_32x32x16_bf16(pa2,PK(2),o[d0],0,0,0);
    o[d0]=__builtin_amdgcn_mfma_f32_32x32x16_bf16(pa3,PK(3),o[d0],0,0,0);
    #undef PK
  }
}

#ifndef ATTN_STORE16
#define ATTN_STORE16(p,v) (*(u32x4*)(p)=(v))
#endif
struct QPre { const float* qg; const float* rc; const float* rs; };
template<int THRL> __device__ __forceinline__ void attn_unit(int b,int h,long qrow0,int NTarg,int tq0,const QPre&QN,const bf16*Q,const bf16*__restrict__ K,const bf16*__restrict__ V,bf16*O,char*shm){
  int tid_=threadIdx.x; asm volatile("":"+v"(tid_)); const int tid=tid_,lane=tid&63,r32=lane&31,hi=lane>>5; const int wid=__builtin_amdgcn_readfirstlane(tid>>6);
  const long krowbase=(long)b*SEQK; const int kvh=h>>2;
  const bf16*Qw=Q+(qrow0+wid*QBLK)*QIN+h*D;
  const bf16*Kh=K+krowbase*KP+kvh*D,*Vh=V+krowbase*KP+kvh*D;
  const unsigned lds0=(unsigned)(uintptr_t)shm;
  float*wsf=(float*)(shm+LDS_WS)+wid*64;
  const bf16*ksrc=Kh+(long)lane*KP+wid*8;
  const bf16*vsrc=Vh+(long)(16*(wid&3)+(lane>>2))*KP+(wid>>2)*32+(lane&3)*8;
  const unsigned kdst=lds0+LDS_K+wid*1024, vdst=lds0+LDS_V+wid*1024;
  #define DMA_K(t,slot) glds16(ksrc+(long)(t)*KVBLK*KP,(unsigned)__builtin_amdgcn_readfirstlane(kdst+(slot)))
  #define DMA_V(t,slot) glds16(vsrc+(long)(t)*KVBLK*KP,(unsigned)__builtin_amdgcn_readfirstlane(vdst+(slot)))
  const int vb0=(int)(lds0+LDS_V)+((lane>>4)&1)*32+(lane&3)*8+(4*hi+((lane&15)>>2))*64;
  const char*Kbase=shm+LDS_K; bf16x8 kf[8];
  const lds_cptr shm3=(lds_cptr)shm; const lds_cptr kp0=shm3+LDS_K+hi*1024+r32*16; const lds_cptr vp0=shm3+LDS_V+((lane>>4)&1)*32+(lane&3)*8+(4*hi+((lane&15)>>2))*64;
  const int NT=NTarg;
  DMA_K(0,0);DMA_V(0,0);DMA_K(1,SLOTB);
  bf16x8 qr[4];
  #pragma unroll
  for(int d0=0;d0<4;++d0)qr[d0]=*reinterpret_cast<const bf16x8*>(&Qw[(long)r32*QIN+d0*16+hi*8]);
  {
    float x[4][8]; float ss=0.f;
    #pragma unroll
    for(int d0=0;d0<4;++d0){
      #pragma unroll
      for(int e=0;e<8;++e){ x[d0][e]=__builtin_bit_cast(float,(unsigned)(unsigned short)qr[d0][e]<<16); ss+=x[d0][e]*x[d0][e]; } }
    ss+=__shfl_xor(ss,32);
    const float rstd=C2/sqrtf(ss*(1.0f/64.0f)+1e-6f);
    #pragma unroll
    for(int d0=0;d0<4;++d0){ const f32x4_t g0=*reinterpret_cast<const f32x4_t*>(QN.qg+16*d0+8*hi), g1=*reinterpret_cast<const f32x4_t*>(QN.qg+16*d0+8*hi+4);
      #pragma unroll
      for(int e=0;e<8;++e) x[d0][e]*=rstd*(e<4?g0[e]:g1[e-4]); }
    if(tq0>=0){ const int t=tq0+wid*QBLK+r32;
      #pragma unroll
      for(int d0=0;d0<2;++d0){ const float*cp=QN.rc+(long)t*32+16*d0+8*hi,*sp=QN.rs+(long)t*32+16*d0+8*hi;
        const f32x4_t c0=*reinterpret_cast<const f32x4_t*>(cp),c1=*reinterpret_cast<const f32x4_t*>(cp+4),s0=*reinterpret_cast<const f32x4_t*>(sp),s1=*reinterpret_cast<const f32x4_t*>(sp+4);
        #pragma unroll
        for(int e=0;e<8;++e){ const float cs=e<4?c0[e]:c1[e-4], sn=e<4?s0[e]:s1[e-4]; const float a=x[d0][e], bq=x[d0+2][e]; x[d0][e]=a*cs-bq*sn; x[d0+2][e]=bq*cs+a*sn; } } }
    #pragma unroll
    for(int d0=0;d0<4;++d0){ u32x4 pk; pk[0]=cvtpk_s(x[d0][0],x[d0][1]); pk[1]=cvtpk_s(x[d0][2],x[d0][3]); pk[2]=cvtpk_s(x[d0][4],x[d0][5]); pk[3]=cvtpk_s(x[d0][6],x[d0][7]); qr[d0]=__builtin_bit_cast(bf16x8,pk); }
  }
  float mhat=0.f,l_reg=0.f;f32x16 o[2];o[0]=f32x16{};o[1]=f32x16{};f32x16 negm=f32x16{};asm volatile("":"+v"(negm));
  const int qrel=wid*QBLK+r32;
  #define CMASK(P0,P1,t) do{}while(0)
  bool resc=false;
  #define START(P0,P1) do{ const float rm=rowmax(P0,P1); resc=false; \
    { const float dl=rm; mhat=fadd_s(mhat,dl); \
      _Pragma("unroll") for(int r=0;r<16;++r){P0[r]=fsub_s(P0[r],dl);P1[r]=fsub_s(P1[r],dl);} \
      _Pragma("unroll") for(int r=0;r<16;++r)negm[r]=-mhat; asm volatile("":"+v"(negm)); } \
    _Pragma("unroll") for(int r=0;r<16;++r)P0[r]=__builtin_amdgcn_exp2f(P0[r]); }while(0)
  #define RESC() do{ if(resc){ asm volatile("s_waitcnt lgkmcnt(0)":::"memory"); \
      _Pragma("unroll") for(int d_=0;d_<2;++d_) _Pragma("unroll") for(int r=0;r<16;++r)o[d_][r]*=wsf[crow(r,hi)]; } }while(0)
  f32x16 pA0,pA1,pB0,pB1;
  int sl_prev=0,sl_cur=0,sl_next=SLOTB;
  #define ROT() do{sl_prev=sl_cur;sl_cur=sl_next;sl_next=(sl_next==(NSLOT-1)*SLOTB)?0:sl_next+SLOTB;}while(0)
  DMA_K(2,2*SLOTB);
  WAIT_BAR(3);
  qkt(pA0,pA1,Kbase,qr,negm,r32,hi);asm volatile("s_nop 15\n\ts_nop 7":"+v"(pA0),"+v"(pA1));CMASK(pA0,pA1,0);
  START(pA0,pA1);
  _Pragma("unroll") for(int r=0;r<16;++r)pA1[r]=__builtin_amdgcn_exp2f(pA1[r]);
  WAIT_BAR(0);
  DMA_K(3,0);DMA_V(1,SLOTB);
  ROT();
  kload8(kf,kp0+sl_cur);
  WAIT_BAR(2);
  s16x4 vlo[8],vhi[8]; u32x4 pw0,pw1,pw2,pw3;
  #define PKW(P,B) cvtpk_s(P[B],P[B+1])
  #define PAF(k) __builtin_bit_cast(bf16x8,pw##k)
  #define VFR(i) (bf16x8){vlo[i][0],vlo[i][1],vlo[i][2],vlo[i][3],vhi[i][0],vhi[i][1],vhi[i][2],vhi[i][3]}
  #define PIN(x) asm volatile("":"+v"(x))
  #define MX3(a,b,c) __builtin_fmaxf(__builtin_fmaxf((a),(b)),(c))
  #define GAPA(MF,A0,A1,A2,A3,W0,W1,PW) do{ MF; sacc+=A0; sacc+=A1; sacc+=A2; sacc+=A3; PIN(sacc); W0; W1; PIN(PW); SBAR(); }while(0)
  #define EX(v) __builtin_amdgcn_exp2f(v)
  #define GAPB(MF,X,B) do{ MF; X[B]=EX(X[B]); X[B+1]=EX(X[B+1]); X[B+2]=EX(X[B+2]); X[B+3]=EX(X[B+3]); PIN(X); SBAR(); }while(0)
  #define VRD(i) do{ vlo[i]=vtr(vp_+(((i)>>2)*4096+((i)&3)*1024)); vhi[i]=vtr(vp_+(((i)>>2)*4096+((i)&3)*1024+512)); }while(0)
  #define KRD(G,j) do{ if(G){ kload2(kf,kp0+sl_next,j); SBAR(); } }while(0)
  #define STEP(C0,C1,P0,P1,t,GK,GV,GL) do{ SBAR(); \
    const lds_cptr vp_=vp0+sl_prev; \
    VRD(0); SBAR(); float sacc=(P0[0]+P0[1]); \
    GAPA(C0=__builtin_amdgcn_mfma_f32_32x32x16_bf16(kf[0],qr[0],negm,0,0,0), P0[2],P0[3],P0[4],P0[5],     pw0[0]=PKW(P0,0), pw0[1]=PKW(P0,2), pw0); \
    VRD(4); SBAR(); GAPA(C1=__builtin_amdgcn_mfma_f32_32x32x16_bf16(kf[1],qr[0],negm,0,0,0), P0[6],P0[7],P0[8],P0[9],     pw0[2]=PKW(P0,4), pw0[3]=PKW(P0,6), pw0); \
    VRD(1); SBAR(); GAPA(C0=__builtin_amdgcn_mfma_f32_32x32x16_bf16(kf[2],qr[1],C0,0,0,0),   P0[10],P0[11],P0[12],P0[13], pw1[0]=PKW(P0,8), pw1[1]=PKW(P0,10), pw1); \
    VRD(5); SBAR(); GAPA(C1=__builtin_amdgcn_mfma_f32_32x32x16_bf16(kf[3],qr[1],C1,0,0,0),   P0[14],P0[15],P1[0],P1[1],   pw1[2]=PKW(P0,12),pw1[3]=PKW(P0,14), pw1); \
    VRD(2); SBAR(); GAPA(C0=__builtin_amdgcn_mfma_f32_32x32x16_bf16(kf[4],qr[2],C0,0,0,0),   P1[2],P1[3],P1[4],P1[5],     pw2[0]=PKW(P1,0), pw2[1]=PKW(P1,2), pw2); \
    VRD(6); SBAR(); GAPA(C1=__builtin_amdgcn_mfma_f32_32x32x16_bf16(kf[5],qr[2],C1,0,0,0),   P1[6],P1[7],P1[8],P1[9],     pw2[2]=PKW(P1,4), pw2[3]=PKW(P1,6), pw2); \
    VRD(3); SBAR(); GAPA(C0=__builtin_amdgcn_mfma_f32_32x32x16_bf16(kf[6],qr[3],C0,0,0,0),   P1[10],P1[11],P1[12],P1[13], pw3[0]=PKW(P1,8), pw3[1]=PKW(P1,10), pw3); \
    VRD(7); SBAR(); GAPA(C1=__builtin_amdgcn_mfma_f32_32x32x16_bf16(kf[7],qr[3],C1,0,0,0),   P1[14],P1[15],0.f,0.f,       pw3[2]=PKW(P1,12),pw3[3]=PKW(P1,14), pw3); \
    l_reg+=sacc; \
    if(GK){DMA_K((t)+3,sl_cur);} if(GV){DMA_V((t)+1,sl_next);} \
    CMASK(C0,C1,t); \
    { float a=MX3(C0[0],C0[1],C1[0]),b=MX3(C0[2],C0[3],C1[1]); a=MX3(a,C1[2],C1[3]); \
      _Pragma("unroll") for(int r=4;r<16;r+=4){a=MX3(a,C0[r],C0[r+1]);b=MX3(b,C0[r+2],C0[r+3]);a=MX3(a,C1[r],C1[r+1]);b=MX3(b,C1[r+2],C1[r+3]);} \
      float rm=__builtin_fmaxf(a,b); { auto rr=__builtin_amdgcn_permlane32_swap(__float_as_uint(rm),__float_as_uint(rm),false,false); rm=__builtin_fmaxf(__uint_as_float(rr[0]),__uint_as_float(rr[1])); } \
      resc=false; \
      if(__builtin_expect(__any(rm>(float)THRL),0)){ const float dl=__builtin_fmaxf(rm,0.f); mhat+=dl; \
        _Pragma("unroll") for(int r=0;r<16;++r){C0[r]-=dl;C1[r]-=dl;} \
        _Pragma("unroll") for(int r=0;r<16;++r)negm[r]=-mhat; asm volatile("":"+v"(negm)); \
        const float f=__builtin_amdgcn_exp2f(-dl); l_reg*=f; if(hi==0)wsf[r32]=f; resc=true; } } \
    SBAR(); \
    GAPB(o[0]=__builtin_amdgcn_mfma_f32_32x32x16_bf16(PAF(0),VFR(0),o[0],0,0,0), C0,0); \
    GAPB(o[1]=__builtin_amdgcn_mfma_f32_32x32x16_bf16(PAF(0),VFR(4),o[1],0,0,0), C0,4); \
    KRD(GL,0); GAPB(o[0]=__builtin_amdgcn_mfma_f32_32x32x16_bf16(PAF(1),VFR(1),o[0],0,0,0), C0,8); \
    KRD(GL,1); GAPB(o[1]=__builtin_amdgcn_mfma_f32_32x32x16_bf16(PAF(1),VFR(5),o[1],0,0,0), C0,12); \
    KRD(GL,2); GAPB(o[0]=__builtin_amdgcn_mfma_f32_32x32x16_bf16(PAF(2),VFR(2),o[0],0,0,0), C1,0); \
    KRD(GL,3); GAPB(o[1]=__builtin_amdgcn_mfma_f32_32x32x16_bf16(PAF(2),VFR(6),o[1],0,0,0), C1,4); \
    GAPB(o[0]=__builtin_amdgcn_mfma_f32_32x32x16_bf16(PAF(3),VFR(3),o[0],0,0,0), C1,8); \
    GAPB(o[1]=__builtin_amdgcn_mfma_f32_32x32x16_bf16(PAF(3),VFR(7),o[1],0,0,0), C1,12); \
    }while(0)
  int t=1;
  #undef CMASK
  #define CMASK(P0,P1,t) do{}while(0)
  asm volatile(".p2align 8\n\t.fill 16, 4, 0xBF800000");
  for(;t+5<NT;t+=2){
    STEP(pB0,pB1,pA0,pA1,t,true,true,true);     WAIT_BAR(2); RESC(); ROT();
    STEP(pA0,pA1,pB0,pB1,t+1,true,true,true);   WAIT_BAR(2); RESC(); ROT();
  }
  #undef CMASK
  #define CMASK(P0,P1,t) do{}while(0)
  #define ENDW(tt) do{ if((tt)+3<NT){WAIT_BAR(2);} else if((tt)+2<NT){WAIT_BAR(1);} else {WAIT_BAR(0);} }while(0)
  for(;t+1<NT;t+=2){
    STEP(pB0,pB1,pA0,pA1,t,(t+3<NT),(t+1<NT),(t+1<NT));       ENDW(t);   RESC(); ROT();
    STEP(pA0,pA1,pB0,pB1,t+1,(t+4<NT),(t+2<NT),(t+2<NT));     ENDW(t+1); RESC(); ROT();
  }
  STEP(pB0,pB1,pA0,pA1,NT-1,false,false,false); RESC();
  { float sacc=pB0[0]+pB0[1]; _Pragma("unroll") for(int r=2;r<16;++r)sacc+=pB0[r]; _Pragma("unroll") for(int r=0;r<16;++r)sacc+=pB1[r]; l_reg+=sacc;
    pw0=(u32x4){PKW(pB0,0),PKW(pB0,2),PKW(pB0,4),PKW(pB0,6)};pw1=(u32x4){PKW(pB0,8),PKW(pB0,10),PKW(pB0,12),PKW(pB0,14)};pw2=(u32x4){PKW(pB1,0),PKW(pB1,2),PKW(pB1,4),PKW(pB1,6)};pw3=(u32x4){PKW(pB1,8),PKW(pB1,10),PKW(pB1,12),PKW(pB1,14)};
    SBAR(); pv(o,vb0+sl_cur,PAF(0),PAF(1),PAF(2),PAF(3)); }
  #undef PKW
  #undef PAF
  #undef VFR
  #undef PIN
  #undef MX3
  #undef GAPA
  #undef GAPB
  #undef EX
  #undef VRD
  #undef KRD
  #undef STEP
  #undef ENDW
  {auto rr=__builtin_amdgcn_permlane32_swap(__float_as_uint(l_reg),__float_as_uint(l_reg),false,false);l_reg=__uint_as_float(rr[0])+__uint_as_float(rr[1]);}
  if(hi==0)wsf[32+r32]=l_reg;asm volatile("s_waitcnt lgkmcnt(0)":::"memory");
  float rli[16];
  #pragma unroll
  for(int r=0;r<16;++r)rli[r]=__builtin_amdgcn_rcpf(wsf[32+crow(r,hi)]);
  bf16*Ow=O+(qrow0+wid*QBLK)*QP+h*D;
  { bf16*stg=(bf16*)(shm+LDS_OST)+wid*2048;
    #pragma unroll
    for(int r=0;r<16;++r){const int orow=crow(r,hi);
      #pragma unroll
      for(int d0=0;d0<2;++d0)stg[orow*64+d0*32+r32]=__float2bfloat16(o[d0][r]*rli[r]);}
    asm volatile("s_waitcnt lgkmcnt(0)":::"memory");
    #pragma unroll
    for(int i=0;i<4;++i){const int row=i*8+(lane>>3),ch=lane&7; const u32x4 v=*(const u32x4*)(stg+row*64+ch*8); ATTN_STORE16(Ow+(long)row*QP+ch*8,v);} }
  asm volatile("s_waitcnt lgkmcnt(0)\n\ts_barrier":::"memory");
  #undef DMA_K
  #undef DMA_V
  #undef CMASK
  #undef START
  #undef RESC
  #undef ROT
}
constexpr int ATTN_LDS_BYTES=LDS_BYTES;
struct AttnTensors { const bf16* Q; const bf16* K; const bf16* V; bf16* O; };
template<int THRL=8> __device__ __forceinline__ void attn_phase(char*lds,const AttnTensors&T,const QPre&QN,int G,int vcu,bool with_ctx,long ctx_row0){
  const int total=4*NHEAD*NQB;
  for(int i=0;;++i){
    int x,n;
    if(G==256){ if(i>=4)break; x=vcu>>5; n=i*32+(vcu&31); }
    else { const int u=i*G+vcu; if(u>=total)break; x=u>>7; n=u&127; }
    const int b=x>>1,kvh=x&1,h=kvh*4+(n>>5),qb=n&31;
    attn_unit<THRL>(b,h,(long)b*SEQQ+(long)qb*QB,SEQK/KVBLK,qb*QB,QN,T.Q,T.K,T.V,T.O,lds);
  }
  if(with_ctx){
    for(int u=vcu;u<4*NHEAD;u+=G){ const int b=u>>3,h=u&7; attn_unit<THRL>(b,h,ctx_row0+(long)b*256,4,-1,QN,T.Q,T.K,T.V,T.O,lds); }
  }
}
#undef SBAR
#undef WAIT_BAR
}

constexpr int NWAVES = 8, NTHR = 512;
constexpr int DMODEL = 1024, NB = 4, SEQ = 8192, CTXL = 256, NLAT = NB * SEQ, NCTX = NB * CTXL, MT = NLAT + NCTX;
constexpr int INW = 2048, NE = 32, KEYS = SEQ + CTXL;
constexpr int SORT_TILES = 560, SORT_ROWS = SORT_TILES * 256;
constexpr float EPSN = 1e-6f;
constexpr int NCHUNK = 66, CHUNK = 128;
constexpr int YS_PITCH = 1088;
constexpr int NPH_PRO = 2, NPH_LAYER = 13, NPH = NPH_PRO + 2 * NPH_LAYER;

constexpr size_t MiB = 1u << 20;
constexpr size_t WS_CTL = 0, CTL_ZERO_BYTES = 1 * MiB;
constexpr size_t WS_MOD = 1 * MiB, WS_ROPEC = 2 * MiB, WS_ROPES = 3 * MiB, WS_H2 = 4 * MiB, WS_KFC = 10 * MiB, WS_BLKCNT = 12 * MiB, WS_TILEE = 13 * MiB, WS_SCANS = 14 * MiB;
constexpr size_t WS_WINT = 16 * MiB, WS_WOUTT = 24 * MiB, WS_W1T = 32 * MiB, WS_W2T = 288 * MiB, WS_KF = 416 * MiB, WS_KHAT = 448 * MiB, WS_XR = 512 * MiB, WS_H = 644 * MiB;
constexpr size_t WS_U = 712 * MiB, WS_Q = 844 * MiB, WS_K = 877 * MiB, WS_V = 886 * MiB, WS_ATT = 895 * MiB, WS_LAB = 928 * MiB, WS_LRUO = 1060 * MiB, WS_VT = 1093 * MiB, WS_X0T = 1125 * MiB,
                 WS_HYO = 1157 * MiB, WS_MIXA = 1190 * MiB;
constexpr size_t WS_WGT = 11 * MiB, WS_SPT = 10 * MiB + 768 * 1024, WS_XL = 1256 * MiB;
constexpr size_t WS_GC = 10 * MiB + 896 * 1024;
constexpr size_t WS_CB = 10 * MiB + 960 * 1024;
constexpr size_t WS_F = 712 * MiB, WS_ASORT = 778 * MiB, WS_ACT = 1058 * MiB, WS_YS = 1338 * MiB, WS_TOPI = 1618 * MiB, WS_GATE = 1619 * MiB, WS_POS = 1620 * MiB, WS_RSSP = 1622 * MiB, WS_ROWTOK = 1625 * MiB, WS_END = 1626 * MiB;
constexpr size_t LAB_STRIDE = (size_t)MT * 256;
constexpr int CW_BAR = 4096;
constexpr int CW_NTILES = 64;

constexpr int RING_OFF = 0, RING_BYTES = 131072, MOETAB_OFF = 131072, LDSCTL_OFF = 155648, LDS_BYTES = 156160;

#define GAS __attribute__((address_space(1)))
#define LAS __attribute__((address_space(3)))
typedef unsigned short bf16;
typedef unsigned v4u __attribute__((ext_vector_type(4)));
typedef unsigned v2u __attribute__((ext_vector_type(2)));
typedef float f32x4 __attribute__((ext_vector_type(4)));
#define LDS_WAIT() asm volatile("s_waitcnt lgkmcnt(0)" ::: "memory")
#define VM_WAIT() asm volatile("s_waitcnt vmcnt(0)" ::: "memory")
__device__ __forceinline__ unsigned f2bf(float f) { unsigned u = __builtin_bit_cast(unsigned, f); return (u + 0x7fffu + ((u >> 16) & 1u)) >> 16; }
__device__ __forceinline__ unsigned pk2(float lo, float hi) { return f2bf(lo) | (f2bf(hi) << 16); }
__device__ __forceinline__ float bf2f(unsigned short b) { return __builtin_bit_cast(float, (unsigned)b << 16); }
__device__ __forceinline__ float bflo(unsigned w) { return __builtin_bit_cast(float, w << 16); }
__device__ __forceinline__ float bfhi(unsigned w) { return __builtin_bit_cast(float, w & 0xffff0000u); }
__device__ __forceinline__ float wave_sum(float v) {
#pragma unroll
    for (int o = 1; o < 64; o <<= 1) v += __shfl_xor(v, o);
    return v;
}
__device__ __forceinline__ float sigmoidf_(float x) { return 1.0f / (1.0f + __expf(-x)); }
__device__ __forceinline__ void sincos_d(double x, double& s, double& c) {
    const double kd = __builtin_rint(x * 0.63661977236758134308);
    const int k = (int)kd;
    double r = __builtin_fma(-kd, 1.57079632673412561417e+00, x);
    r = __builtin_fma(-kd, 6.07710050650619224932e-11, r);
    const double z = r * r;
    const double ps = r + r * z * (-1.66666666666666324348e-01 + z * (8.33333333332248946124e-03 + z * (-1.98412698298579493134e-04 + z * (2.75573137070700676789e-06 + z * (-2.50507602534068634195e-08 + z * 1.58969099521155010221e-10)))));
    const double pc = 1.0 - 0.5 * z + z * z * (4.16666666666666019037e-02 + z * (-1.38888888888741095749e-03 + z * (2.48015872894767294178e-05 + z * (-2.75573143513906633035e-07 + z * (2.08757232129817482790e-09 + z * -1.13596475577881948265e-11)))));
    const int q = k & 3;
    s = (q == 0) ? ps : (q == 1) ? pc : (q == 2) ? -ps : -pc;
    c = (q == 0) ? pc : (q == 1) ? -ps : (q == 2) ? -pc : ps;
}
__device__ __forceinline__ float gelu_tanh(float x) {
    const float u = 0.7978845608028654f * (x + 0.044715f * x * x * x);
    const float t = 1.0f - 2.0f / (1.0f + __expf(2.0f * u));
    return 0.5f * x * (1.0f + t);
}
__device__ __forceinline__ int lds_add(LAS int* p, int v) { return __hip_atomic_fetch_add(p, v, __ATOMIC_RELAXED, __HIP_MEMORY_SCOPE_WORKGROUP); }

#define FFT_FN __device__ __forceinline__
typedef float f32x2v __attribute__((ext_vector_type(2)));
#define FFT_VEC2 f32x2v
#define FFT_DPTR LAS f32x2v*
#define FFT_LD(D, i) c32_from((D)[i])
#define FFT_ST(D, i, v) ((D)[i] = c32_to(v))
struct __attribute__((aligned(8))) c32 { float x, y; };
FFT_FN c32 cmul(c32 a, c32 b) { c32 r; r.x = a.x * b.x - a.y * b.y; r.y = a.x * b.y + a.y * b.x; return r; }
FFT_FN c32 cadd(c32 a, c32 b) { c32 r; r.x = a.x + b.x; r.y = a.y + b.y; return r; }
FFT_FN c32 csub(c32 a, c32 b) { c32 r; r.x = a.x - b.x; r.y = a.y - b.y; return r; }
FFT_FN c32 cmuli_neg(c32 a) { c32 r; r.x = a.y; r.y = -a.x; return r; }
FFT_FN int fpad(int a) { return a + (a >> 4); }
#ifdef FFT_VEC2
FFT_FN c32 c32_from(FFT_VEC2 t) { c32 r; r.x = t.x; r.y = t.y; return r; }
FFT_FN FFT_VEC2 c32_to(c32 a) { FFT_VEC2 t; t.x = a.x; t.y = a.y; return t; }
#endif
FFT_FN void dft4(c32& a0, c32& a1, c32& a2, c32& a3) {
    const c32 s02 = cadd(a0, a2), d02 = csub(a0, a2), s13 = cadd(a1, a3), d13 = cmuli_neg(csub(a1, a3));
    a0 = cadd(s02, s13); a2 = csub(s02, s13); a1 = cadd(d02, d13); a3 = csub(d02, d13);
}
FFT_FN void dft16(c32 (&v)[16]) {
    const float C1 = 0.92387953251128674f, S1 = 0.38268343236508977f, C2 = 0.70710678118654752f;
#pragma unroll
    for (int q2 = 0; q2 < 4; ++q2) dft4(v[q2], v[4 + q2], v[8 + q2], v[12 + q2]);
    { c32 w;
      w.x = C1; w.y = -S1; v[4 * 1 + 1] = cmul(v[4 * 1 + 1], w);
      w.x = C2; w.y = -C2; v[4 * 2 + 1] = cmul(v[4 * 2 + 1], w);
      w.x = S1; w.y = -C1; v[4 * 3 + 1] = cmul(v[4 * 3 + 1], w);
      w.x = C2; w.y = -C2; v[4 * 1 + 2] = cmul(v[4 * 1 + 2], w);
      v[4 * 2 + 2] = cmuli_neg(v[4 * 2 + 2]);
      w.x = -C2; w.y = -C2; v[4 * 3 + 2] = cmul(v[4 * 3 + 2], w);
      w.x = S1; w.y = -C1; v[4 * 1 + 3] = cmul(v[4 * 1 + 3], w);
      w.x = -C2; w.y = -C2; v[4 * 2 + 3] = cmul(v[4 * 2 + 3], w);
      w.x = -C1; w.y = S1; v[4 * 3 + 3] = cmul(v[4 * 3 + 3], w); }
#pragma unroll
    for (int p1 = 0; p1 < 4; ++p1) dft4(v[4 * p1 + 0], v[4 * p1 + 1], v[4 * p1 + 2], v[4 * p1 + 3]);
#pragma unroll
    for (int a = 0; a < 4; ++a)
#pragma unroll
        for (int b = a + 1; b < 4; ++b) { const c32 t = v[4 * a + b]; v[4 * a + b] = v[4 * b + a]; v[4 * b + a] = t; }
}
FFT_FN c32 twid(int j, int n) { float rev = (float)j / (float)n; asm volatile("" : "+v"(rev)); c32 w; w.x = __builtin_amdgcn_cosf(rev); w.y = -__builtin_amdgcn_sinf(rev); return w; }

FFT_FN void twid_powers(c32 (&wp)[16], c32 w) {
    wp[1] = w; wp[2] = cmul(w, w); wp[3] = cmul(wp[2], w); wp[4] = cmul(wp[2], wp[2]);
    wp[5] = cmul(wp[4], w); wp[6] = cmul(wp[4], wp[2]); wp[7] = cmul(wp[4], wp[3]); wp[8] = cmul(wp[4], wp[4]);
    wp[9] = cmul(wp[8], w); wp[10] = cmul(wp[8], wp[2]); wp[11] = cmul(wp[8], wp[3]); wp[12] = cmul(wp[8], wp[4]);
    wp[13] = cmul(wp[8], wp[5]); wp[14] = cmul(wp[8], wp[6]); wp[15] = cmul(wp[8], wp[7]);
}
FFT_FN void fft_fwd16(FFT_DPTR D, int g, int n) {
    const int s = n >> 4, blk = g / s, j = g - blk * s, base = blk * n + j;
    c32 v[16];
#pragma unroll
    for (int q = 0; q < 16; ++q) v[q] = FFT_LD(D, fpad(base + q * s));
    dft16(v);
    c32 wp[16]; twid_powers(wp, twid(j, n));
#pragma unroll
    for (int p = 1; p < 16; ++p) v[p] = cmul(v[p], wp[p]);
#pragma unroll
    for (int p = 0; p < 16; ++p) FFT_ST(D, fpad(base + p * s), v[p]);
}
FFT_FN void fft_inv16(FFT_DPTR D, int g, int n) {
    const int s = n >> 4, blk = g / s, j = g - blk * s, base = blk * n + j;
    c32 v[16];
#pragma unroll
    for (int q = 0; q < 16; ++q) v[q] = FFT_LD(D, fpad(base + q * s));
    c32 wp[16]; twid_powers(wp, twid(j, n));
#pragma unroll
    for (int p = 1; p < 16; ++p) v[p] = cmul(v[p], wp[p]);
    dft16(v);
#pragma unroll
    for (int p = 0; p < 16; ++p) FFT_ST(D, fpad(base + p * s), v[p]);
}
FFT_FN void fft_mid16(FFT_DPTR D, int g, const c32* KH) {
    c32 v[16];
#pragma unroll
    for (int q = 0; q < 16; ++q) v[q] = FFT_LD(D, 17 * g + q);
    dft16(v);
#pragma unroll
    for (int p = 0; p < 16; ++p) { const c32 k = KH[16 * g + p]; const c32 t = cmul(v[p], k); v[p].x = t.x; v[p].y = -t.y; }
    dft16(v);
#pragma unroll
    for (int p = 0; p < 16; ++p) FFT_ST(D, 17 * g + p, v[p]);
}
typedef float fft_f32x4 __attribute__((ext_vector_type(4)));
FFT_FN void fft_mid16k(FFT_DPTR D, int g, const fft_f32x4 (&kv)[8]) {
    c32 v[16];
#pragma unroll
    for (int q = 0; q < 16; ++q) v[q] = FFT_LD(D, 17 * g + q);
    dft16(v);
#pragma unroll
    for (int p = 0; p < 16; ++p) { c32 k; k.x = kv[p >> 1][2 * (p & 1)]; k.y = kv[p >> 1][2 * (p & 1) + 1]; const c32 t = cmul(v[p], k); v[p].x = t.x; v[p].y = -t.y; }
    dft16(v);
#pragma unroll
    for (int p = 0; p < 16; ++p) FFT_ST(D, 17 * g + p, v[p]);
}
typedef float fft_f32x4o __attribute__((ext_vector_type(4)));
FFT_FN void fft_last16_out(FFT_DPTR D, int g, c32* OUT, float scale) {
    c32 v[16];
#pragma unroll
    for (int q = 0; q < 16; ++q) v[q] = FFT_LD(D, 17 * g + q);
    dft16(v);
#pragma unroll
    for (int pp = 0; pp < 8; ++pp) { fft_f32x4o t = {v[2 * pp].x * scale, v[2 * pp].y * scale, v[2 * pp + 1].x * scale, v[2 * pp + 1].y * scale};
        ((fft_f32x4o*)OUT)[((g >> 6) * 8 + pp) * 64 + (g & 63)] = t; }
}
FFT_FN void fft_first4(FFT_DPTR D, int j, c32 x0, c32 x1, c32 x2, c32 x3) {
    dft4(x0, x1, x2, x3);
    const c32 w = twid(j, 16384), w2 = cmul(w, w), w3 = cmul(w2, w);
    FFT_ST(D, fpad(j), x0); FFT_ST(D, fpad(j + 4096), cmul(x1, w)); FFT_ST(D, fpad(j + 8192), cmul(x2, w2)); FFT_ST(D, fpad(j + 12288), cmul(x3, w3));
}
FFT_FN void fft_final4(FFT_DPTR D, int j, c32& u0, c32& u1) {
    const c32 w = twid(j, 16384), w2 = cmul(w, w), w3 = cmul(w2, w);
    c32 a0 = FFT_LD(D, fpad(j)), a1 = cmul(FFT_LD(D, fpad(j + 4096)), w), a2 = cmul(FFT_LD(D, fpad(j + 8192)), w2), a3 = cmul(FFT_LD(D, fpad(j + 12288)), w3);
    dft4(a0, a1, a2, a3);
    u0 = a0; u1 = a1;
}
FFT_FN void fft_first4_inplace(FFT_DPTR D, int j) {
    c32 x0 = FFT_LD(D, fpad(j)), x1 = FFT_LD(D, fpad(j + 4096)), x2 = FFT_LD(D, fpad(j + 8192)), x3 = FFT_LD(D, fpad(j + 12288));
    fft_first4(D, j, x0, x1, x2, x3);
}
#define XB_TMO      128
#define XB_XCNT(j)  (256  + 64 * (j))
#define XB_XSUB(j)  (1280 + 64 * (j))
#define XB_XGEN(j)  (2304 + 64 * (j))
#define XB_TOP      3328
#define XB_TOPGEN   3392
#define XCD_BAR_WORDS 3456
#define XB_SPIN_CAP (1u << 22)

__device__ __forceinline__ unsigned xb_ld(unsigned* p)              { return __hip_atomic_load(p, __ATOMIC_RELAXED, __HIP_MEMORY_SCOPE_AGENT); }
__device__ __forceinline__ unsigned xb_add(unsigned* p, unsigned v) { return __hip_atomic_fetch_add(p, v, __ATOMIC_RELAXED, __HIP_MEMORY_SCOPE_AGENT); }
__device__ __forceinline__ unsigned xb_xcc_id() { return (unsigned)__builtin_amdgcn_s_getreg((3 << 11) | 20) & 0xFu; }
#define XB_SPIN(cond, bar) do { unsigned _sp = 0; while (cond) { __builtin_amdgcn_s_sleep(1); \
    if ((++_sp & 255u) == 0u) { if (xb_ld(&(bar)[XB_TMO])) break; if (_sp > XB_SPIN_CAP) { atomicAdd(&(bar)[XB_TMO], 1u); break; } } } } while (0)

struct XcdBarrier {
    unsigned* bar; unsigned x;
    volatile LAS unsigned* st;
};

__device__ __forceinline__ XcdBarrier xcd_barrier_post(unsigned* bar, volatile LAS unsigned* st) {
    XcdBarrier b; b.bar = bar; b.x = xb_xcc_id(); b.st = st;
    if (threadIdx.x == 0) (void)xb_add(&bar[XB_XCNT(b.x)], 1u);
    return b;
}
__device__ __forceinline__ void xcd_barrier_complete(unsigned* bar, unsigned x, unsigned& nloc, unsigned& nx) {
    const unsigned G = gridDim.x * gridDim.y * gridDim.z;
    unsigned sum, cnt, mine, sp = 0u;
    for (;;) {
        sum = 0u; cnt = 0u; mine = 0u;
#pragma unroll
        for (unsigned j = 0; j < 16; ++j) { const unsigned c = xb_ld(&bar[XB_XCNT(j)]); sum += c; cnt += (c > 0u) ? 1u : 0u; mine = (j == x) ? c : mine; }
        if (sum == G) break;
        __builtin_amdgcn_s_sleep(1);
        if ((++sp & 255u) == 0u) { if (xb_ld(&bar[XB_TMO])) break; if (sp > XB_SPIN_CAP) { atomicAdd(&bar[XB_TMO], 1u); break; } }
    }
    nloc = mine > 0u ? mine : 1u; nx = cnt > 0u ? cnt : 1u;
}

__device__ __forceinline__ void xcd_barrier(const XcdBarrier& b) {
    asm volatile("s_waitcnt vmcnt(0)" ::: "memory");
    __syncthreads();
    if (threadIdx.x == 0) {
        unsigned* bar = b.bar;
        __builtin_amdgcn_s_waitcnt(0);
        unsigned nloc = b.st[0], nx = b.st[1];
        if (nloc == 0u) { xcd_barrier_complete(bar, b.x, nloc, nx); b.st[0] = nloc; b.st[1] = nx; }
        const unsigned old = xb_add(&bar[XB_XSUB(b.x)], 1u);
        const unsigned gen = old / nloc;
        if (old + 1u == (gen + 1u) * nloc) {
            __builtin_amdgcn_fence(__ATOMIC_RELEASE, "agent");
            asm volatile("s_waitcnt vmcnt(0)" ::: "memory");
            const unsigned og = xb_add(&bar[XB_TOP], 1u);
            const unsigned tg = og / nx;
            if (og + 1u == (tg + 1u) * nx) xb_add(&bar[XB_TOPGEN], 1u);
            else XB_SPIN(xb_ld(&bar[XB_TOPGEN]) == tg, bar);
            __builtin_amdgcn_fence(__ATOMIC_ACQUIRE, "agent");
            asm volatile("s_waitcnt vmcnt(0)" ::: "memory");
        } else {
            XB_SPIN(xb_ld(&bar[XB_TOPGEN]) == gen, bar);
            __builtin_amdgcn_fence(__ATOMIC_ACQUIRE, "agent");
            asm volatile("s_waitcnt vmcnt(0)" ::: "memory");
        }
    }
    __syncthreads();
}


constexpr int CW_SPLIT = 8192, CTXWG = 32;
__device__ __forceinline__ void split_arrive_all(const XcdBarrier& b, unsigned* w) {
    asm volatile("s_waitcnt vmcnt(0)" ::: "memory");
    __syncthreads();
    if (threadIdx.x == 0) { const unsigned nloc = b.st[0]; const unsigned old = xb_add(&w[64 * b.x], 1u);
        if (old + 1u == nloc) { __builtin_amdgcn_fence(__ATOMIC_RELEASE, "agent"); asm volatile("s_waitcnt vmcnt(0)" ::: "memory"); (void)xb_add(&w[1024], 1u); } }
}
__device__ __forceinline__ void split_wait_all(const XcdBarrier& b, unsigned* w) {
    if (threadIdx.x == 0) { const unsigned nx = b.st[1]; XB_SPIN(xb_ld(&w[1024]) < nx, b.bar); __builtin_amdgcn_fence(__ATOMIC_ACQUIRE, "agent"); asm volatile("s_waitcnt vmcnt(0)" ::: "memory"); }
    __syncthreads();
}
__device__ __forceinline__ void split_arrive_flat(unsigned* w) {
    asm volatile("s_waitcnt vmcnt(0)" ::: "memory");
    __syncthreads();
    if (threadIdx.x == 0) { __builtin_amdgcn_fence(__ATOMIC_RELEASE, "agent"); asm volatile("s_waitcnt vmcnt(0)" ::: "memory"); (void)xb_add(&w[1088], 1u); }
}
__device__ __forceinline__ void split_wait_flat(const XcdBarrier& b, unsigned* w, unsigned target) {
    if (threadIdx.x == 0) { XB_SPIN(xb_ld(&w[1088]) < target, b.bar); __builtin_amdgcn_fence(__ATOMIC_ACQUIRE, "agent"); asm volatile("s_waitcnt vmcnt(0)" ::: "memory"); }
    __syncthreads();
}

struct Frame {
    LAS unsigned char* lds; unsigned* ctl; unsigned char* ws;
    int tid, lane, wave, vcu, G, gw, ngw;
};
__device__ const float ROPE_INV[16] = {1.0f, 0.5623413251903491f, 0.31622776601683794f, 0.1778279410038923f, 0.1f, 0.05623413251903491f, 0.03162277660168379f, 0.01778279410038923f,
                                       0.01f, 0.005623413251903491f, 0.0031622776601683794f, 0.001778279410038923f, 0.001f, 0.0005623413251903491f, 0.00031622776601683794f, 0.0001778279410038923f};

__device__ __forceinline__ void p0_transpose_item(const float* W, int K, int N, bf16* WT, LAS float* scr, int item, int lane) {
    const int nblk = N / 32, kb = item / nblk, nb = item % nblk, k0 = 64 * kb, n0 = 32 * nb;
#pragma unroll 8
    for (int i = 0; i < 32; ++i) { const int kk = 2 * i + (lane >> 5); scr[kk * 33 + (lane & 31)] = W[(size_t)(k0 + kk) * N + n0 + (lane & 31)]; }
    LDS_WAIT(); asm volatile("" ::: "memory");
    const int c = lane & 7;
#pragma unroll
    for (int j = 0; j < 4; ++j) { const int n = (lane >> 3) + 8 * j; const LAS float* s = scr + (8 * c) * 33 + n;
        v4u o; o.x = pk2(s[0 * 33], s[1 * 33]); o.y = pk2(s[2 * 33], s[3 * 33]); o.z = pk2(s[4 * 33], s[5 * 33]); o.w = pk2(s[6 * 33], s[7 * 33]);
        *(GAS v4u*)(WT + (size_t)(n0 + n) * K + k0 + 8 * c) = o; }
    LDS_WAIT(); asm volatile("" ::: "memory");
}

__device__ __forceinline__ void p0_transpose_item_f8(const float* W, int K, int N, unsigned char* WT, LAS float* scr, int item, int lane) {
    const int nblk = N / 32, kb = item / nblk, nb = item % nblk, k0 = 64 * kb, n0 = 32 * nb;
#pragma unroll 8
    for (int i = 0; i < 32; ++i) { const int kk = 2 * i + (lane >> 5); scr[kk * 33 + (lane & 31)] = __builtin_nontemporal_load(&W[(size_t)(k0 + kk) * N + n0 + (lane & 31)]); }
    LDS_WAIT(); asm volatile("" ::: "memory");
    const int c = lane & 7;
#pragma unroll
    for (int j = 0; j < 4; ++j) { const int n = (lane >> 3) + 8 * j; const LAS float* s = scr + (8 * c) * 33 + n;
        v2u o; o.x = pg8::pack4_fp8(s[0 * 33] * pg8::F8_SW, s[1 * 33] * pg8::F8_SW, s[2 * 33] * pg8::F8_SW, s[3 * 33] * pg8::F8_SW);
        o.y = pg8::pack4_fp8(s[4 * 33] * pg8::F8_SW, s[5 * 33] * pg8::F8_SW, s[6 * 33] * pg8::F8_SW, s[7 * 33] * pg8::F8_SW);
        *(GAS v2u*)(WT + (size_t)(n0 + n) * K + k0 + 8 * c) = o; }
    LDS_WAIT(); asm volatile("" ::: "memory");
}

struct F8Item { const float* W; unsigned char* WT; int N, item; };
__device__ __forceinline__ F8Item f8_item_of(int r, const float* moe_w1, const float* moe_w2, unsigned char* W1T, unsigned char* W2T) {
    F8Item q; constexpr int I_W1 = 64 * 1024;
    if (r < I_W1) { const int m = r >> 10; q.W = moe_w1 + (size_t)m * 1024 * 2048; q.WT = W1T + (size_t)m * 2048 * 1024; q.N = 2048; q.item = r & 1023; }
    else { r -= I_W1; const int m = r >> 9; q.W = moe_w2 + (size_t)m * 1024 * 1024; q.WT = W2T + (size_t)m * 1024 * 1024; q.N = 1024; q.item = r & 511; }
    return q;
}
__device__ __forceinline__ void f8_first(float (&pre)[8], const F8Item& q, int lane) {
    const int nblk = q.N / 32, kb = q.item / nblk, nb = q.item % nblk, k0 = 64 * kb, n0 = 32 * nb;
#pragma unroll
    for (int i = 0; i < 8; ++i) { const int kk = 2 * i + (lane >> 5); pre[i] = __builtin_nontemporal_load(&q.W[(size_t)(k0 + kk) * q.N + n0 + (lane & 31)]); }
}
__device__ __forceinline__ void f8_rest(const float (&pre)[8], float (&nxt)[8], bool has_next, const F8Item& qn, const F8Item& q, LAS float* scr, int lane) {
    const int K = 1024, N = q.N; const float* W = q.W; unsigned char* WT = q.WT;
    const int nblk = N / 32, kb = q.item / nblk, nb = q.item % nblk, k0 = 64 * kb, n0 = 32 * nb;
#pragma unroll
    for (int i = 0; i < 8; ++i) { const int kk = 2 * i + (lane >> 5); scr[kk * 33 + (lane & 31)] = pre[i]; }
#pragma unroll 8
    for (int i = 8; i < 32; ++i) { const int kk = 2 * i + (lane >> 5); scr[kk * 33 + (lane & 31)] = __builtin_nontemporal_load(&W[(size_t)(k0 + kk) * N + n0 + (lane & 31)]); }
    if (has_next) f8_first(nxt, qn, lane);
    LDS_WAIT(); asm volatile("" ::: "memory");
    const int c = lane & 7;
#pragma unroll
    for (int j = 0; j < 4; ++j) { const int n = (lane >> 3) + 8 * j; const LAS float* sp = scr + (8 * c) * 33 + n;
        v2u o; o.x = pg8::pack4_fp8(sp[0 * 33] * pg8::F8_SW, sp[1 * 33] * pg8::F8_SW, sp[2 * 33] * pg8::F8_SW, sp[3 * 33] * pg8::F8_SW);
        o.y = pg8::pack4_fp8(sp[4 * 33] * pg8::F8_SW, sp[5 * 33] * pg8::F8_SW, sp[6 * 33] * pg8::F8_SW, sp[7 * 33] * pg8::F8_SW);
        *(GAS v2u*)(WT + (size_t)(n0 + n) * K + k0 + 8 * c) = o; }
    LDS_WAIT(); asm volatile("" ::: "memory");
}
__device__ __forceinline__ void ph_prologue_a(const Frame& F, const float* c, const float* cctx, const float* w_mod, const float* b_mod, const float* w_in, const float* w_out,
                                              const float* moe_w1, const float* moe_w2, const float* hy_w1, const float* hy_b1, const float* hy_w2, const float* hy_b2, const float* hy_freq, const float* lru_gw, const float* lru_lam) {
    {
        LAS float* scr = (LAS float*)(F.lds + F.wave * 16384);
        constexpr int I_IN = 2 * 1024, I_OUT = 2 * 512, I_W1 = 64 * 1024, I_W2 = 64 * 512, NIT = I_IN + I_OUT + I_W1 + I_W2;
        bf16* WinT = (bf16*)(F.ws + WS_WINT); bf16* WoutT = (bf16*)(F.ws + WS_WOUTT); bf16* W1T = (bf16*)(F.ws + WS_W1T); bf16* W2T = (bf16*)(F.ws + WS_W2T);
        for (int it = F.gw; it < I_IN + I_OUT; it += F.ngw) {
            int r = it;
            if (r < I_IN) { const int m = r >> 10; p0_transpose_item(w_in + (size_t)m * 1024 * 2048, 1024, 2048, WinT + (size_t)m * 2048 * 1024, scr, r & 1023, F.lane); continue; } r -= I_IN;
            { const int m = r >> 9; p0_transpose_item(w_out + (size_t)m * 1024 * 1024, 1024, 1024, WoutT + (size_t)m * 1024 * 1024, scr, r & 511, F.lane); }
        }
#if MOE_FP8
        { int r = F.gw; while (r < I_IN + I_OUT) r += F.ngw; r -= I_IN + I_OUT;
          float pre[8];
          if (r < I_W1 + I_W2) { F8Item q = f8_item_of(r, moe_w1, moe_w2, (unsigned char*)W1T, (unsigned char*)W2T); f8_first(pre, q, F.lane);
              for (;;) { const int rn = r + F.ngw; const bool has_next = rn < I_W1 + I_W2; F8Item qn = q; if (has_next) qn = f8_item_of(rn, moe_w1, moe_w2, (unsigned char*)W1T, (unsigned char*)W2T);
                  float nxt[8]; f8_rest(pre, nxt, has_next, qn, q, scr, F.lane);
                  if (!has_next) break;
#pragma unroll
                  for (int i = 0; i < 8; ++i) pre[i] = nxt[i];
                  q = qn; r = rn; } } }
#else
        for (int it = F.gw; it < NIT; it += F.ngw) { int r = it; if (r < I_IN + I_OUT) continue; r -= I_IN + I_OUT;
            if (r < I_W1) { const int m = r >> 10; p0_transpose_item(moe_w1 + (size_t)m * 1024 * 2048, 1024, 2048, W1T + (size_t)m * 2048 * 1024, scr, r & 1023, F.lane); continue; } r -= I_W1;
            { const int m = r >> 9; p0_transpose_item(moe_w2 + (size_t)m * 1024 * 1024, 1024, 1024, W2T + (size_t)m * 1024 * 1024, scr, r & 511, F.lane); } }
#endif
    }
    __syncthreads();
    {
        LAS float* sl = (LAS float*)(F.lds);
        LAS float* red = (LAS float*)(F.lds + 20480);
        float* MOD = (float*)(F.ws + WS_MOD);
        if ((int)blockIdx.x < 192) {
            for (int i = F.tid; i < 5 * 1024; i += NTHR) { const int r = i >> 10, k = i & 1023; const float v = (r < 4) ? c[r * 1024 + k] : cctx[k]; sl[i] = v / (1.0f + __expf(-v)); }
        }
        __syncthreads();
        for (int it = blockIdx.x; it < 192; it += F.G) {
            const int l = it / 96, n = (it % 96) * 64 + F.lane;
            float a0 = 0.f, a1 = 0.f, a2 = 0.f, a3 = 0.f, a4 = 0.f;
            const float* wp = w_mod + ((size_t)l * 1024 + F.wave * 128) * 6144 + n;
#pragma unroll 16
            for (int k = 0; k < 128; ++k) { const float w = wp[(size_t)k * 6144]; const int kk = F.wave * 128 + k;
                a0 += sl[kk] * w; a1 += sl[1024 + kk] * w; a2 += sl[2048 + kk] * w; a3 += sl[3072 + kk] * w; a4 += sl[4096 + kk] * w; }
            red[(F.wave * 5 + 0) * 64 + F.lane] = a0; red[(F.wave * 5 + 1) * 64 + F.lane] = a1; red[(F.wave * 5 + 2) * 64 + F.lane] = a2; red[(F.wave * 5 + 3) * 64 + F.lane] = a3; red[(F.wave * 5 + 4) * 64 + F.lane] = a4;
            __syncthreads();
            if (F.tid < 320) { const int r = F.tid >> 6, ln = F.tid & 63; float s = 0.f;
#pragma unroll
                for (int w = 0; w < 8; ++w) s += red[(w * 5 + r) * 64 + ln];
                const int nn = (it % 96) * 64 + ln; MOD[(size_t)(l * 5 + r) * 6144 + nn] = s + b_mod[l * 6144 + nn]; }
            __syncthreads();
        }
    }
    {
        bf16* WGT = (bf16*)(F.ws + WS_WGT); float* SPT = (float*)(F.ws + WS_SPT);
        for (int idx = blockIdx.x * NTHR + F.tid; idx < 2 * 1024 * 256; idx += F.G * NTHR) {
            const int l = idx >> 18, nidx = (idx >> 8) & 1023, k = idx & 255;
            const int pn = nidx >> 8, j = (nidx >> 7) & 1, cc = nidx & 127, d = pn >> 1, ch = 128 * (pn & 1) + cc, n = ch >> 6, e = ch & 63;
            const float v = ((k >> 6) == n) ? lru_gw[((size_t)((((l * 2 + d) * 2 + j) * 4 + n) * 64 + (k & 63))) * 64 + e] : 0.f;
            WGT[idx] = (bf16)f2bf(v); }
        for (int idx = blockIdx.x * NTHR + F.tid; idx < 2 * 2 * 256; idx += F.G * NTHR) SPT[idx] = log1pf(expf(-lru_lam[idx]));
    }
    {
        float* RC = (float*)(F.ws + WS_ROPEC); float* RS = (float*)(F.ws + WS_ROPES);
        for (int idx = blockIdx.x * NTHR + F.tid; idx < SEQ * 32; idx += F.G * NTHR) {
            const int t = idx >> 5, i = idx & 31; const int pos = (i < 16) ? (t >> 6) : (t & 63);
            const float ang = (float)pos * ROPE_INV[i & 15];
            double s, cc; sincos_d((double)ang, s, cc); RC[idx] = (float)cc; RS[idx] = (float)s; }
    }
    {
        float* H2 = (float*)(F.ws + WS_H2);
        for (int it = F.gw; it < 2 * SEQ + CTXL; it += F.ngw) {
            const int v = it >> 13, t = (v < 2) ? (it & (SEQ - 1)) : (it - 2 * SEQ), L = (v < 2) ? SEQ : CTXL, l = (v == 1) ? 1 : 0;
            const int j = F.lane;
            float z = 0.f;
            if (j == 0) z = (float)t / (float)(L - 1);
            else if (j <= 32) { const int b = (j - 1) & 15; const float band = 1e-4f + (float)b * ((15.0f - 1e-4f) / 15.0f);
                const float ang = ((6.283185307179586f / (float)L) * (float)t) * band;
                double s, cc; sincos_d((double)ang, s, cc); z = (j <= 16) ? (float)cc : -(float)s; }
            const float fr = hy_freq[l * 64 + j];
            float p1 = hy_b1[l * 64 + j];
            const float* w1 = hy_w1 + (size_t)l * 33 * 64;
#pragma unroll
            for (int i = 0; i < 33; ++i) p1 += __shfl(z, i) * w1[i * 64 + j];
            double s1, c1; sincos_d((double)(fr * p1), s1, c1); const float h1 = (float)s1;
            float p2 = hy_b2[l * 64 + j];
            const float* w2 = hy_w2 + (size_t)l * 64 * 64;
#pragma unroll 16
            for (int i = 0; i < 64; ++i) p2 += __shfl(h1, i) * w2[i * 64 + j];
            double s2, c2; sincos_d((double)(fr * p2), s2, c2);
            ((bf16*)H2)[((size_t)v * SEQ + t) * 64 + j] = (bf16)f2bf((float)s2);
        }
    }
}

typedef __bf16 tp_bf2 __attribute__((ext_vector_type(2)));
__device__ __forceinline__ float filter_taps(const Frame& F, const float* H2, const LAS float* w3c, LAS float* Df, LAS float* kt, int v, int L, float df, float db, int part) {
    float asum = 0.f;
    const int qq = F.lane & 3, rr = F.lane >> 2;
    unsigned wf[8], wb[8];
#pragma unroll
    for (int u = 0; u < 8; ++u) { const int k = 16 * qq + 2 * u; wf[u] = pk2(w3c[k], w3c[k + 1]); wb[u] = pk2(w3c[64 + k], w3c[64 + k + 1]); }
    const bf16* hbase = (const bf16*)H2 + (size_t)v * SEQ * 64 + 16 * qq;
    const bool fw = (qq == 0); const float cexp = -(fw ? df : db) * 1.4426950408889634f / (float)(L - 1);
#pragma unroll 4
    for (int i = 0; i < L / 128; ++i) { const int t = 16 * (F.wave + 8 * i) + rr;
        const v4u* hp = (const v4u*)(hbase + (size_t)t * 64); const v4u q0 = hp[0], q1 = hp[1];
        const unsigned h[8] = {q0.x, q0.y, q0.z, q0.w, q1.x, q1.y, q1.z, q1.w};
        float hf = 0.f, hb = 0.f, hf2 = 0.f, hb2 = 0.f;
#pragma unroll
        for (int u = 0; u < 8; u += 2) {
            hf = __builtin_amdgcn_fdot2_f32_bf16(__builtin_bit_cast(tp_bf2, h[u]), __builtin_bit_cast(tp_bf2, wf[u]), hf, false); hf2 = __builtin_amdgcn_fdot2_f32_bf16(__builtin_bit_cast(tp_bf2, h[u + 1]), __builtin_bit_cast(tp_bf2, wf[u + 1]), hf2, false);
            hb = __builtin_amdgcn_fdot2_f32_bf16(__builtin_bit_cast(tp_bf2, h[u]), __builtin_bit_cast(tp_bf2, wb[u]), hb, false); hb2 = __builtin_amdgcn_fdot2_f32_bf16(__builtin_bit_cast(tp_bf2, h[u + 1]), __builtin_bit_cast(tp_bf2, wb[u + 1]), hb2, false); }
        hf += hf2; hb += hb2;
        hf += __builtin_bit_cast(float, __builtin_amdgcn_update_dpp(0, __builtin_bit_cast(int, hf), 0xB1, 0xf, 0xf, false)); hb += __builtin_bit_cast(float, __builtin_amdgcn_update_dpp(0, __builtin_bit_cast(int, hb), 0xB1, 0xf, 0xf, false));
        hf += __builtin_bit_cast(float, __builtin_amdgcn_update_dpp(0, __builtin_bit_cast(int, hf), 0x4E, 0xf, 0xf, false)); hb += __builtin_bit_cast(float, __builtin_amdgcn_update_dpp(0, __builtin_bit_cast(int, hb), 0x4E, 0xf, 0xf, false));
        if (qq < 2) {
            const float val = (fw ? hf : hb) * __builtin_amdgcn_exp2f((float)t * cexp);
            if (fw || t >= 1) { asum += fabsf(val); const int pos = fw ? t : 2 * L - t;
                if (part < 2) Df[2 * fpad(pos) + part] = val; else kt[pos] = val; } } }
    return asum;
}
FFT_FN void fft_last16_inplace(FFT_DPTR D, int g) {
    c32 v[16];
#pragma unroll
    for (int q = 0; q < 16; ++q) v[q] = FFT_LD(D, 17 * g + q);
    dft16(v);
#pragma unroll
    for (int p = 0; p < 16; ++p) FFT_ST(D, 17 * g + p, v[p]);
}
FFT_FN int fft_freq_of(int pos) { return (pos >> 12) + 4 * ((pos >> 8) & 15) + 64 * ((pos >> 4) & 15) + 1024 * (pos & 15); }
FFT_FN int fft_pos_of(int f) { return ((f & 3) << 12) | (((f >> 2) & 15) << 8) | (((f >> 6) & 15) << 4) | (f >> 10); }

__device__ __forceinline__ void ph_prologue_b(const Frame& F, const float* hy_w3, const float* hy_decay, const float* gffn, const float* router_w, const float* router_b) {
    { const float* MOD = (const float*)(F.ws + WS_MOD); float* CB = (float*)(F.ws + WS_CB);
      for (int it = F.gw; it < 2 * 5 * 32; it += F.ngw) { const int lb = it >> 5, e = it & 31, l = lb / 5; const float* sf = MOD + (size_t)lb * 6144 + 3 * 1024; float s = 0.f;
#pragma unroll
          for (int q = 0; q < 16; ++q) { const int cc = 64 * q + F.lane; s += sf[cc] * router_w[(size_t)l * 32768 + cc * 32 + e]; }
          s = wave_sum(s); if (F.lane == 0) CB[it] = s + router_b[l * 32 + e]; } }
    { const float* MOD = (const float*)(F.ws + WS_MOD); float* GC = (float*)(F.ws + WS_GC);
      for (int idx = blockIdx.x * NTHR + F.tid; idx < 2 * 5 * 1024; idx += F.G * NTHR) { const int lb = idx >> 10, cc = idx & 1023, l = lb / 5; GC[idx] = gffn[l * 1024 + cc] * (1.0f + MOD[(size_t)lb * 6144 + 4 * 1024 + cc]); } }
    LAS f32x2v* D = (LAS f32x2v*)(F.lds);
    LAS float* kt = (LAS float*)(F.lds);
    LAS float* w3c = (LAS float*)(F.lds + 139264);
    LAS float* red = (LAS float*)(F.lds + 139264 + 512);
    const float* H2 = (const float*)(F.ws + WS_H2);
    c32* KHAT = (c32*)(F.ws + WS_KHAT); float* KFC = (float*)(F.ws + WS_KFC);
    LAS float* Df = (LAS float*)(F.lds);
    for (int it = blockIdx.x; it < 512; it += F.G) {
        const int c = it & 255;
        if (it < 256) {
            float inv[2];
#pragma unroll
            for (int v = 0; v < 2; ++v) {
                if (F.tid < 128) w3c[F.tid] = hy_w3[(size_t)v * 64 * 512 + (F.tid & 63) * 512 + (F.tid >> 6) * 256 + c];
                if (F.tid == 0) Df[2 * fpad(SEQ) + v] = 0.f;
                __syncthreads();
                float asum = filter_taps(F, H2, w3c, Df, kt, v, SEQ, fabsf(hy_decay[v * 512 + c]), fabsf(hy_decay[v * 512 + 256 + c]), v);
                asum = wave_sum(asum);
                if (F.lane == 0) red[v * 8 + F.wave] = asum;
                __syncthreads();
                float tot = 0.f;
#pragma unroll
                for (int w = 0; w < 8; ++w) tot += red[v * 8 + w];
                inv[v] = (1.0f / 16384.0f) / tot;
            }
#pragma unroll 1
            for (int i = 0; i < 8; ++i) fft_first4_inplace(D, F.tid + 512 * i);
            __syncthreads();
            { fft_fwd16(D, F.tid, 4096); fft_fwd16(D, F.tid + 512, 4096); }
            __syncthreads();
            { fft_fwd16(D, F.tid, 256); fft_fwd16(D, F.tid + 512, 256); }
            __syncthreads();
            _Pragma("unroll 1") for (int g_ = F.tid; g_ < 1024; g_ += 512) fft_last16_inplace(D, g_);
            __syncthreads();
            fft_f32x4o* out0 = (fft_f32x4o*)(KHAT + (size_t)c * 16384); fft_f32x4o* out1 = (fft_f32x4o*)(KHAT + (size_t)(256 + c) * 16384);
#pragma unroll 1
            for (int g = F.tid; g < 1024; g += 512) {
#pragma unroll
                for (int pp = 0; pp < 8; ++pp) { fft_f32x4o k0, k1;
#pragma unroll
                    for (int e = 0; e < 2; ++e) { const int pos = 16 * g + 2 * pp + e; const int fm = (16384 - fft_freq_of(pos)) & 16383; const int pq = fft_pos_of(fm);
                        const c32 z = FFT_LD(D, 17 * g + 2 * pp + e), zp = FFT_LD(D, fpad(pq));
                        k0[2 * e] = 0.5f * (z.x + zp.x) * inv[0]; k0[2 * e + 1] = 0.5f * (z.y - zp.y) * inv[0];
                        k1[2 * e] = 0.5f * (z.y + zp.y) * inv[1]; k1[2 * e + 1] = 0.5f * (zp.x - z.x) * inv[1]; }
                    const int oi = ((g >> 6) * 8 + pp) * 64 + (g & 63); out0[oi] = k0; out1[oi] = k1; }
            }
        } else {
            if (F.tid < 128) w3c[F.tid] = hy_w3[(size_t)(F.tid & 63) * 512 + (F.tid >> 6) * 256 + c];
            if (F.tid == 0) kt[CTXL] = 0.f;
            __syncthreads();
            float asum = filter_taps(F, H2, w3c, Df, kt, 2, CTXL, fabsf(hy_decay[c]), fabsf(hy_decay[256 + c]), 2);
            asum = wave_sum(asum);
            if (F.lane == 0) red[F.wave] = asum;
            __syncthreads();
            float tot = 0.f;
#pragma unroll
            for (int w = 0; w < 8; ++w) tot += red[w];
            const float invc = 1.0f / tot;
            float* dst = KFC + (size_t)c * 512;
            for (int j = F.tid; j < 2 * CTXL; j += NTHR) dst[j] = kt[j] * invc;
        }
        __syncthreads();
    }
}

__device__ __forceinline__ void ph_norm_mod(const Frame& F, int l, const float* x, const float* ctx, const float* gmix) {
    const float* XR = (const float*)(F.ws + WS_XR); const float* MOD = (const float*)(F.ws + WS_MOD); bf16* H = (bf16*)(F.ws + WS_H);
    for (int r = F.gw; r < MT; r += F.ngw) {
        const float* src = (l == 0) ? (r < NLAT ? x + (size_t)r * 1024 : ctx + (size_t)(r - NLAT) * 1024) : XR + (size_t)r * 1024;
        const int bidx = r < NLAT ? r / SEQ : 4;
        const float* shift = MOD + (size_t)(l * 5 + bidx) * 6144; const float* scale = shift + 1024; const float* g = gmix + l * 1024;
        f32x4 v[4]; float ss = 0.f;
#pragma unroll
        for (int j = 0; j < 4; ++j) { v[j] = ((const f32x4*)src)[64 * j + F.lane]; ss += (v[j].x * v[j].x + v[j].y * v[j].y) + (v[j].z * v[j].z + v[j].w * v[j].w); }
        const float rstd = 1.0f / sqrtf(wave_sum(ss) * (1.0f / 1024.0f) + EPSN);
#pragma unroll
        for (int j = 0; j < 4; ++j) { const int cb = 64 * j + F.lane; const f32x4 gg = ((const f32x4*)g)[cb], sc = ((const f32x4*)scale)[cb], sh = ((const f32x4*)shift)[cb];
            const f32x4 y = v[j] * rstd * gg * (sc + 1.0f) + sh;
            v2u o; o.x = pk2(y.x, y.y); o.y = pk2(y.z, y.w); ((v2u*)(H + (size_t)r * 1024))[cb] = o; }
    }
}

struct KvIn { v4u wk; f32x4 c0, c1, s0, s1; };
__device__ __forceinline__ void kv_request(KvIn& in, const bf16* U, const float* RC, const float* RS, int r, int hl, int lane) {
    in.wk = ((const v4u*)(U + (size_t)r * INW + 512))[hl];
    in.c0 = (f32x4){1.f, 1.f, 1.f, 1.f}; in.c1 = in.c0; in.s0 = (f32x4){0.f, 0.f, 0.f, 0.f}; in.s1 = in.s0;
    if (r < NLAT) { const int t = r % SEQ; const float* rc = RC + t * 32 + 8 * (lane & 3); const float* rs = RS + t * 32 + 8 * (lane & 3);
        in.c0 = *(const f32x4*)rc; in.c1 = *(const f32x4*)(rc + 4); in.s0 = *(const f32x4*)rs; in.s1 = *(const f32x4*)(rs + 4); }
}
struct XlIn { v4u w[4]; };
__device__ __forceinline__ void xl_request(XlIn& in, const bf16* U, int idx) {
    const int r = idx >> 5, c8 = (idx & 31) * 8; const bool isctx = r >= NLAT; const int Ls = isctx ? CTXL : SEQ; const int t = isctx ? (r - NLAT) % CTXL : r % SEQ;
#pragma unroll
    for (int j = 0; j < 4; ++j) { const int tj = t + j - 2; in.w[j] = (v4u){0u, 0u, 0u, 0u}; if (tj >= 0 && tj < Ls) in.w[j] = *(const v4u*)(U + (size_t)(r + j - 2) * INW + 768 + c8); }
}
__device__ __forceinline__ void post_ab(const Frame& F, int l, int rbeg, int rend, int w0, int nw, const float* kg_, const float* lru_cw, const float* lru_cb) {
    const bf16* U = (const bf16*)(F.ws + WS_U);
    {
        bf16* K = (bf16*)(F.ws + WS_K); bf16* V = (bf16*)(F.ws + WS_V);
        const float* RC = (const float*)(F.ws + WS_ROPEC); const float* RS = (const float*)(F.ws + WS_ROPES);
        const int o8 = 8 * (F.lane & 7), hl = F.lane & 31;
        const f32x4 kg0 = *(const f32x4*)(kg_ + l * 64 + o8), kg1 = *(const f32x4*)(kg_ + l * 64 + o8 + 4);
        const bool lohalf = (F.lane & 4) == 0;
        int r2 = rbeg + 2 * w0;
        KvIn cur; if (r2 < rend) kv_request(cur, U, RC, RS, r2 + (F.lane >> 5), hl, F.lane);
        for (; r2 < rend; r2 += 2 * nw) {
            const int r = r2 + (F.lane >> 5);
            KvIn nxt = cur; if (r2 + 2 * nw < rend) kv_request(nxt, U, RC, RS, r + 2 * nw, hl, F.lane);
            const bool isctx = r >= NLAT; const int b = isctx ? (r - NLAT) / CTXL : r / SEQ; const int t = isctx ? (r - NLAT) % CTXL : r % SEQ;
            const v4u wk = cur.wk; const f32x4 c0 = cur.c0, c1 = cur.c1, s0 = cur.s0, s1 = cur.s1;
            const size_t krow = (size_t)b * KEYS + (isctx ? t : CTXL + t);
            float x[8] = {bflo(wk.x), bfhi(wk.x), bflo(wk.y), bfhi(wk.y), bflo(wk.z), bfhi(wk.z), bflo(wk.w), bfhi(wk.w)};
            float ss = 0.f;
#pragma unroll
            for (int i = 0; i < 8; ++i) ss += x[i] * x[i];
            ss += __shfl_xor(ss, 1); ss += __shfl_xor(ss, 2); ss += __shfl_xor(ss, 4);
            const float rstd = 1.0f / sqrtf(ss * (1.0f / 64.0f) + EPSN);
            float y[8], o[8];
#pragma unroll
            for (int i = 0; i < 8; ++i) y[i] = x[i] * rstd * (i < 4 ? kg0[i] : kg1[i - 4]);
#pragma unroll
            for (int i = 0; i < 8; ++i) { const float p = __shfl_xor(y[i], 4); const float cs = i < 4 ? c0[i] : c1[i - 4], sn = i < 4 ? s0[i] : s1[i - 4];
                o[i] = lohalf ? (y[i] * cs - p * sn) : (y[i] * cs + p * sn); }
            v4u ow; ow.x = pk2(o[0], o[1]); ow.y = pk2(o[2], o[3]); ow.z = pk2(o[4], o[5]); ow.w = pk2(o[6], o[7]);
            if (hl < 16) ((v4u*)(K + krow * 128))[hl] = ow; else ((v4u*)(V + krow * 128))[hl - 16] = wk;
            cur = nxt;
        }
    }
    {
        bf16* XL = (bf16*)(F.ws + WS_XL);
        int idx = rbeg * 32 + w0 * 64 + F.lane; const int iend = rend * 32, istep = nw * 64;
        XlIn cur; if (idx < iend) xl_request(cur, U, idx);
        for (; idx < iend; idx += istep) {
            XlIn nxt = cur; if (idx + istep < iend) xl_request(nxt, U, idx + istep);
            const int r = idx >> 5, c8 = (idx & 31) * 8;
            float acc[8];
#pragma unroll
            for (int i = 0; i < 8; ++i) acc[i] = lru_cb[l * 256 + c8 + i];
#pragma unroll
            for (int j = 0; j < 4; ++j) { const v4u w = cur.w[j];
                const f32x4 w0 = *(const f32x4*)(lru_cw + (l * 4 + j) * 256 + c8), w1 = *(const f32x4*)(lru_cw + (l * 4 + j) * 256 + c8 + 4);
                acc[0] += w0.x * bflo(w.x); acc[1] += w0.y * bfhi(w.x); acc[2] += w0.z * bflo(w.y); acc[3] += w0.w * bfhi(w.y);
                acc[4] += w1.x * bflo(w.z); acc[5] += w1.y * bfhi(w.z); acc[6] += w1.z * bflo(w.w); acc[7] += w1.w * bfhi(w.w); }
            v4u o; o.x = pk2(acc[0], acc[1]); o.y = pk2(acc[2], acc[3]); o.z = pk2(acc[4], acc[5]); o.w = pk2(acc[6], acc[7]);
            *(v4u*)(XL + (size_t)r * 256 + c8) = o;
            cur = nxt;
        }
    }
}
__device__ __forceinline__ void post_c(const Frame& F, int l, const float* hy_cw, const float* hy_cb) {
    const bf16* U = (const bf16*)(F.ws + WS_U);
    __syncthreads();
    {
        LAS bf16* hs = (LAS bf16*)(F.lds);
        bf16* VT = (bf16*)(F.ws + WS_VT); bf16* X0T = (bf16*)(F.ws + WS_X0T);
        const float* cw = hy_cw + (size_t)l * 3 * 768; const float* cbp = hy_cb + l * 768;
        LAS float* cwl = (LAS float*)(F.lds + 102400);
        for (int i = F.tid; i < 3072; i += NTHR) cwl[i] = (i < 2304) ? cw[i] : cbp[i - 2304];
        for (int it = blockIdx.x; it < NLAT / 64; it += F.G) {
            const int b = it >> 7, t0 = (it & 127) * 64;
#pragma unroll 13
            for (int i = F.tid; i < 66 * 96; i += NTHR) { const int rr = i / 96, c8 = i - rr * 96; const int t = t0 - 1 + rr;
                v4u w = {0u, 0u, 0u, 0u}; if (t >= 0 && t < SEQ) w = *(const v4u*)(U + (size_t)(b * SEQ + t) * INW + 1280 + 8 * c8);
                LAS unsigned* d = (LAS unsigned*)(hs + rr * 770 + 8 * c8); d[0] = w.x; d[1] = w.y; d[2] = w.z; d[3] = w.w; }
            __syncthreads();
            for (int c2 = F.wave; c2 < 128; c2 += NWAVES) {
                const int c = 2 * c2 + (F.lane >> 5), tt = 2 * (F.lane & 31);
                float o[3][2];
#pragma unroll
                for (int g = 0; g < 3; ++g) { const int cc = g * 256 + c; const float w0 = cwl[cc], w1 = cwl[768 + cc], w2 = cwl[1536 + cc], bb = cwl[2304 + cc];
                    const float x0 = bf2f(hs[tt * 770 + cc]), x1 = bf2f(hs[(tt + 1) * 770 + cc]), x2 = bf2f(hs[(tt + 2) * 770 + cc]), x3 = bf2f(hs[(tt + 3) * 770 + cc]);
                    o[g][0] = w0 * x0 + w1 * x1 + w2 * x2 + bb; o[g][1] = w0 * x1 + w1 * x2 + w2 * x3 + bb; }
                const size_t oi = ((size_t)b * 256 + c) * SEQ + t0 + tt;
                *(unsigned*)(VT + oi) = pk2(o[2][0] * o[1][0], o[2][1] * o[1][1]); *(unsigned*)(X0T + oi) = pk2(o[0][0], o[0][1]);
            }
            __syncthreads();
        }
    }
}


typedef short sk_s16x8 __attribute__((ext_vector_type(8)));
__device__ __forceinline__ void ph_lru_gates(const Frame& F, int l, const float* lru_gb, int rt0, int nrt, int w0, int nw) {
    const bf16* XL = (const bf16*)(F.ws + WS_XL); const bf16* WG = (const bf16*)(F.ws + WS_WGT) + (size_t)l * 1024 * 256; bf16* LAB = (bf16*)(F.ws + WS_LAB);
    const float* gb = lru_gb + (size_t)l * 1024; const float* spt = (const float*)(F.ws + WS_SPT) + l * 512;
    const int fr = F.lane & 15, fq = F.lane >> 4;
    for (int it = w0; it < nrt * 8; it += nw) {
        const int rt = rt0 + (it >> 3), n = (it >> 1) & 3, d = it & 1, row0 = 32 * rt;
        const int wrow = ((2 * d + (n >> 1)) * 256 + 64 * (n & 1) + fr) * 256 + 64 * n + 8 * fq;
        const bf16* ap = XL + (size_t)(row0 + fr) * 256 + 64 * n + 8 * fq;
        const bf16* xp = XL + (size_t)(row0 + fr) * 256 + 64 * n + 4 * fq;
        sk_s16x8 a[2][2]; v2u xw[2][4];
#pragma unroll
        for (int ri = 0; ri < 2; ++ri) { a[ri][0] = *(const sk_s16x8*)(ap + ri * 16 * 256); a[ri][1] = *(const sk_s16x8*)(ap + ri * 16 * 256 + 32);
#pragma unroll
            for (int c = 0; c < 4; ++c) xw[ri][c] = *(const v2u*)(xp + ri * 16 * 256 + 16 * c); }
        f32x4 acc[2][4][2];
#pragma unroll
        for (int c = 0; c < 4; ++c)
#pragma unroll
            for (int g = 0; g < 2; ++g) { const bf16* bp = WG + wrow + (g * 128 + 16 * c) * 256;
                const sk_s16x8 b0 = *(const sk_s16x8*)bp, b1 = *(const sk_s16x8*)(bp + 32);
#pragma unroll
                for (int ri = 0; ri < 2; ++ri) { f32x4 z = {0.f, 0.f, 0.f, 0.f};
                    z = __builtin_amdgcn_mfma_f32_16x16x32_bf16(b0, a[ri][0], z, 0, 0, 0); acc[ri][c][g] = __builtin_amdgcn_mfma_f32_16x16x32_bf16(b1, a[ri][1], z, 0, 0, 0); } }
        bf16* LA = LAB + (size_t)(2 * d) * LAB_STRIDE; bf16* LB = LAB + (size_t)(2 * d + 1) * LAB_STRIDE;
#pragma unroll
        for (int c = 0; c < 4; ++c) { const int ch = 64 * n + 16 * c + 4 * fq;
            const f32x4 bR = *(const f32x4*)(gb + (d * 2 + 0) * 256 + ch), bI = *(const f32x4*)(gb + (d * 2 + 1) * 256 + ch);
            const f32x4 sp = *(const f32x4*)(spt + d * 256 + ch) * (-8.0f * 1.4426950408889634f);
#pragma unroll
            for (int ri = 0; ri < 2; ++ri) { const size_t ro = (size_t)(row0 + 16 * ri + fr) * 256 + ch;
                const float xl[4] = {bflo(xw[ri][c].x), bfhi(xw[ri][c].x), bflo(xw[ri][c].y), bfhi(xw[ri][c].y)};
                const f32x4 gr = acc[ri][c][0] + bR, gi = acc[ri][c][1] + bI; float av[4], bv[4];
#pragma unroll
                for (int e = 0; e < 4; ++e) {
                    const float rg = __builtin_amdgcn_rcpf(1.0f + __builtin_amdgcn_exp2f(-1.4426950408889634f * gr[e])), ig = __builtin_amdgcn_rcpf(1.0f + __builtin_amdgcn_exp2f(-1.4426950408889634f * gi[e]));
                    const float la2 = rg * sp[e]; const float a2 = __builtin_amdgcn_exp2f(2.0f * la2);
                    av[e] = la2; bv[e] = __builtin_amdgcn_sqrtf(fmaxf(1.0f - a2, 0.f)) * (ig * xl[e]); }
                v2u wa, wb; wa.x = pk2(av[0], av[1]); wa.y = pk2(av[2], av[3]); wb.x = pk2(bv[0], bv[1]); wb.y = pk2(bv[2], bv[3]);
                *(v2u*)(LA + ro) = wa; *(v2u*)(LB + ro) = wb; } }
    }
}

__device__ __forceinline__ int chunk_row0(int b, int d, int k) {
    if (k < 2) { const int cc = d ? 1 - k : k; return NLAT + b * CTXL + cc * CHUNK; }
    const int lc = d ? 63 - (k - 2) : (k - 2); return b * SEQ + lc * CHUNK;
}
template <bool TWO> __device__ __forceinline__ void scan1_items(const bf16* LAB, float* SUMP, float* SUMH, int it0, int it1) {
    const bf16* LA[2]; const bf16* LB[2]; int r0[2], dd[2];
#pragma unroll
    for (int q = 0; q < (TWO ? 2 : 1); ++q) { const int it = q ? it1 : it0;
        const int ch = it & 255, k = (it >> 8) % NCHUNK, bd = (it >> 8) / NCHUNK, d = bd & 1, b = bd >> 1;
        r0[q] = chunk_row0(b, d, k); dd[q] = d;
        LA[q] = LAB + (size_t)(2 * d) * LAB_STRIDE + ch; LB[q] = LAB + (size_t)(2 * d + 1) * LAB_STRIDE + ch; }
    float h[2] = {0.f, 0.f}, Ps[2] = {0.f, 0.f};
#pragma unroll 16
    for (int i = 0; i < CHUNK; ++i) {
#pragma unroll
        for (int q = 0; q < (TWO ? 2 : 1); ++q) { const int r = dd[q] ? r0[q] + CHUNK - 1 - i : r0[q] + i; const float la = bf2f(LA[q][(size_t)r * 256]), bx = bf2f(LB[q][(size_t)r * 256]); h[q] = __builtin_amdgcn_exp2f(la) * h[q] + bx; Ps[q] += la; } }
    SUMP[it0] = __builtin_amdgcn_exp2f(Ps[0]); SUMH[it0] = h[0];
    if (TWO) { SUMP[it1] = __builtin_amdgcn_exp2f(Ps[1]); SUMH[it1] = h[1]; }
}
__device__ __forceinline__ void ph_scan1(const Frame& F) {
    const bf16* LAB = (const bf16*)(F.ws + WS_LAB); float* SUMP = (float*)(F.ws + WS_SCANS); float* SUMH = SUMP + NB * 2 * NCHUNK * 256;
    const int total = NB * 2 * NCHUNK * 256, nthr = F.G * NTHR;
    for (int it = blockIdx.x * NTHR + F.tid; it < total; it += 2 * nthr) {
        if (it + nthr < total) scan1_items<true>(LAB, SUMP, SUMH, it, it + nthr); else scan1_items<false>(LAB, SUMP, SUMH, it, it);
    }
}
__device__ __forceinline__ void ph_scan2(const Frame& F) {
    const bf16* LAB = (const bf16*)(F.ws + WS_LAB); const float* SUMP = (const float*)(F.ws + WS_SCANS); const float* SUMH = SUMP + NB * 2 * NCHUNK * 256;
    bf16* HD = (bf16*)(F.ws + WS_LRUO);
    const int total = NB * 2 * NCHUNK * 128, per = (total + F.G - 1) / F.G;
    const int it = blockIdx.x * per + F.tid;
    if (F.tid < per && it < total) {
        const int ch = 2 * (it & 127), k = (it >> 7) % NCHUNK, bd = (it >> 7) / NCHUNK, d = bd & 1, b = bd >> 1;
        const int r0 = chunk_row0(b, d, k);
        const f32x2v* P = (const f32x2v*)(SUMP + (size_t)(bd * NCHUNK) * 256 + ch); const f32x2v* S = (const f32x2v*)(SUMH + (size_t)(bd * NCHUNK) * 256 + ch);
        float h0 = 0.f, h1 = 0.f;
#pragma unroll 8
        for (int j = 0; j < k; ++j) { const f32x2v p = P[(size_t)j * 128], q = S[(size_t)j * 128]; h0 = p.x * h0 + q.x; h1 = p.y * h1 + q.y; }
        const unsigned* __restrict__ LA = (const unsigned*)(LAB + (size_t)(2 * d) * LAB_STRIDE + ch); const unsigned* __restrict__ LB = (const unsigned*)(LAB + (size_t)(2 * d + 1) * LAB_STRIDE + ch);
        unsigned* __restrict__ HO = (unsigned*)(HD + (size_t)d * MT * 256 + ch);
#pragma unroll 16
        for (int i = 0; i < CHUNK; ++i) { const size_t r = (size_t)(d ? r0 + CHUNK - 1 - i : r0 + i) * 128; const unsigned la = LA[r], lb = LB[r];
            h0 = __builtin_amdgcn_exp2f(bflo(la)) * h0 + bflo(lb); h1 = __builtin_amdgcn_exp2f(bfhi(la)) * h1 + bfhi(lb); HO[r] = pk2(h0, h1); }
    }
}

__device__ __forceinline__ void ph_hyena_fft(const Frame& F, int l, const float* hy_bias) {
    LAS f32x2v* D = (LAS f32x2v*)(F.lds);
    const c32* KHAT = (const c32*)(F.ws + WS_KHAT) + (size_t)l * 256 * 16384;
    const bf16* VT = (const bf16*)(F.ws + WS_VT); const bf16* X0T = (const bf16*)(F.ws + WS_X0T); bf16* HYO = (bf16*)(F.ws + WS_HYO);
    for (int it = blockIdx.x; it < 512; it += F.G) {
        const int c = it >> 1, bp = it & 1;
        const bf16* va = VT + ((size_t)(bp * 2) * 256 + c) * SEQ; const bf16* vb = VT + ((size_t)(bp * 2 + 1) * 256 + c) * SEQ;
        {
            unsigned pa[4], pb[4], pc[4], pd[4];
#pragma unroll
            for (int i = 0; i < 4; ++i) { const int j = 2 * F.tid + 1024 * i; pa[i] = *(const unsigned*)(va + j); pb[i] = *(const unsigned*)(vb + j); pc[i] = *(const unsigned*)(va + j + 4096); pd[i] = *(const unsigned*)(vb + j + 4096); }
#pragma unroll
            for (int i = 0; i < 4; ++i) { const int j = 2 * F.tid + 1024 * i; c32 x0, x1, z; z.x = 0.f; z.y = 0.f;
                x0.x = bflo(pa[i]); x0.y = bflo(pb[i]); x1.x = bflo(pc[i]); x1.y = bflo(pd[i]); fft_first4(D, j, x0, x1, z, z);
                x0.x = bfhi(pa[i]); x0.y = bfhi(pb[i]); x1.x = bfhi(pc[i]); x1.y = bfhi(pd[i]); fft_first4(D, j + 1, x0, x1, z, z); }
        }
        __syncthreads();
        { fft_fwd16(D, F.tid, 4096); fft_fwd16(D, F.tid + 512, 4096); }
        __syncthreads();
        { fft_fwd16(D, F.tid, 256); fft_fwd16(D, F.tid + 512, 256); }
        __syncthreads();
        { fft_f32x4 kv0[8]; const fft_f32x4* kp = (const fft_f32x4*)(KHAT + (size_t)c * 16384);
#pragma unroll
          for (int q = 0; q < 8; ++q) kv0[q] = kp[((F.tid >> 6) * 8 + q) * 64 + (F.tid & 63)];
          fft_mid16k(D, F.tid, kv0); __builtin_amdgcn_sched_barrier(0);
#pragma unroll
          for (int q = 0; q < 8; ++q) kv0[q] = kp[(((F.tid + 512) >> 6) * 8 + q) * 64 + (F.tid & 63)];
          fft_mid16k(D, F.tid + 512, kv0); }
        __syncthreads();
        { fft_inv16(D, F.tid, 256); fft_inv16(D, F.tid + 512, 256); }
        __syncthreads();
        { fft_inv16(D, F.tid, 4096); fft_inv16(D, F.tid + 512, 4096); }
        __syncthreads();
        const bf16* xa = X0T + ((size_t)(bp * 2) * 256 + c) * SEQ; const bf16* xb = X0T + ((size_t)(bp * 2 + 1) * 256 + c) * SEQ;
        unsigned pa[4], pb[4], pc[4], pd[4], qa[4], qb[4], qc[4], qd[4];
#pragma unroll
        for (int i = 0; i < 4; ++i) { const int j = 2 * F.tid + 1024 * i; pa[i] = *(const unsigned*)(va + j); pb[i] = *(const unsigned*)(vb + j); pc[i] = *(const unsigned*)(va + j + 4096); pd[i] = *(const unsigned*)(vb + j + 4096);
            qa[i] = *(const unsigned*)(xa + j); qb[i] = *(const unsigned*)(xb + j); qc[i] = *(const unsigned*)(xa + j + 4096); qd[i] = *(const unsigned*)(xb + j + 4096); }
        const float bias = hy_bias[l * 256 + c];
        bf16* oa = HYO + ((size_t)(bp * 2) * 256 + c) * SEQ; bf16* ob = HYO + ((size_t)(bp * 2 + 1) * 256 + c) * SEQ;
#pragma unroll
        for (int i = 0; i < 4; ++i) { const int j = 2 * F.tid + 1024 * i; c32 u0, u1, w0, w1; fft_final4(D, j, u0, u1); fft_final4(D, j + 1, w0, w1);
            *(unsigned*)(oa + j) = pk2((u0.x + bflo(pa[i]) * bias) * bflo(qa[i]), (w0.x + bfhi(pa[i]) * bias) * bfhi(qa[i]));
            *(unsigned*)(ob + j) = pk2((-u0.y + bflo(pb[i]) * bias) * bflo(qb[i]), (-w0.y + bfhi(pb[i]) * bias) * bfhi(qb[i]));
            *(unsigned*)(oa + j + 4096) = pk2((u1.x + bflo(pc[i]) * bias) * bflo(qc[i]), (w1.x + bfhi(pc[i]) * bias) * bfhi(qc[i]));
            *(unsigned*)(ob + j + 4096) = pk2((-u1.y + bflo(pd[i]) * bias) * bflo(qd[i]), (-w1.y + bfhi(pd[i]) * bias) * bfhi(qd[i])); }
        __syncthreads();
    }
}
__device__ __forceinline__ void ph_hyena_ctx(const Frame& F, const float* hy_bias, const float* hy_cw, const float* hy_cb) {
    float* HYO = (float*)(F.ws + WS_HYO);
    const bf16* U = (const bf16*)(F.ws + WS_U); const float* KFC = (const float*)(F.ws + WS_KFC);
    LAS float* vw = (LAS float*)(F.lds + F.wave * 4096);
    LAS float* kw = vw + 256;
    LAS bf16* stg = (LAS bf16*)(F.lds + 32768);
    const float* cw = hy_cw; const float* cbp = hy_cb;
    for (int it = blockIdx.x; it < NB * 32; it += F.G) {
        const int b = it >> 5, c0 = (it & 31) * 8, c = c0 + F.wave;
        for (int i = F.tid; i < 258 * 3; i += NTHR) { const int rr = i / 3, g = i - rr * 3, t = rr - 1;
            v4u w = {0u, 0u, 0u, 0u}; if (t >= 0 && t < CTXL) w = *(const v4u*)(U + (size_t)(NLAT + b * CTXL + t) * INW + 1280 + g * 256 + c0);
            LAS unsigned* d = (LAS unsigned*)(stg + (rr * 3 + g) * 8); d[0] = w.x; d[1] = w.y; d[2] = w.z; d[3] = w.w; }
        __syncthreads();
        float x0v[4];
#pragma unroll
        for (int i = 0; i < 4; ++i) { const int t = F.lane + 64 * i;
            float o[3];
#pragma unroll
            for (int g = 0; g < 3; ++g) { const int cc = g * 256 + c; float a = cbp[cc];
#pragma unroll
                for (int j = 0; j < 3; ++j) a += cw[j * 768 + cc] * bf2f(stg[((t + j) * 3 + g) * 8 + F.wave]);
                o[g] = a; }
            vw[t] = o[2] * o[1]; x0v[i] = o[0]; }
#pragma unroll
        for (int i = 0; i < 8; ++i) kw[F.lane + 64 * i] = KFC[c * 512 + F.lane + 64 * i];
        LDS_WAIT();
        float y[4] = {0.f, 0.f, 0.f, 0.f};
#pragma unroll 4
        for (int s2 = 0; s2 < CTXL; ++s2) { const float vv = vw[s2];
#pragma unroll
            for (int i = 0; i < 4; ++i) y[i] += kw[(F.lane + 64 * i - s2) & 511] * vv; }
        const float bias = hy_bias[c];
#pragma unroll
        for (int i = 0; i < 4; ++i) { const int t = F.lane + 64 * i; HYO[(size_t)(NLAT + b * CTXL + t) * 256 + c] = (y[i] + vw[t] * bias) * x0v[i]; }
        __syncthreads();
    }
}

__device__ __forceinline__ void merge_row(const Frame& F, int r, const float* g, float h0, float h1, float h2, float h3) {
    const bf16* ATT = (const bf16*)(F.ws + WS_ATT); const bf16* HD = (const bf16*)(F.ws + WS_LRUO); const bf16* Ug = (const bf16*)(F.ws + WS_U); bf16* MIXA = (bf16*)(F.ws + WS_MIXA);
    const v4u aw = ((const v4u*)(ATT + (size_t)r * 512))[F.lane];
    float a[8] = {bflo(aw.x), bfhi(aw.x), bflo(aw.y), bfhi(aw.y), bflo(aw.z), bfhi(aw.z), bflo(aw.w), bfhi(aw.w)};
    float ss = 0.f;
#pragma unroll
    for (int i = 0; i < 8; ++i) ss += a[i] * a[i];
    const float ra = 1.0f / sqrtf(wave_sum(ss) * (1.0f / 512.0f) + EPSN);
    f32x4 lv; { const v2u hf = ((const v2u*)(HD + (size_t)r * 256))[F.lane], hb = ((const v2u*)(HD + (size_t)MT * 256 + (size_t)r * 256))[F.lane], gw = ((const v2u*)(Ug + (size_t)r * INW + 1024))[F.lane];
        lv.x = (bflo(hf.x) + bflo(hb.x)) * gelu_tanh(bflo(gw.x)); lv.y = (bfhi(hf.x) + bfhi(hb.x)) * gelu_tanh(bfhi(gw.x)); lv.z = (bflo(hf.y) + bflo(hb.y)) * gelu_tanh(bflo(gw.y)); lv.w = (bfhi(hf.y) + bfhi(hb.y)) * gelu_tanh(bfhi(gw.y)); }
    const float rl = 1.0f / sqrtf(wave_sum(lv.x * lv.x + lv.y * lv.y + lv.z * lv.z + lv.w * lv.w) * (1.0f / 256.0f) + EPSN);
    const float rh = 1.0f / sqrtf(wave_sum(h0 * h0 + h1 * h1 + h2 * h2 + h3 * h3) * (1.0f / 256.0f) + EPSN);
    bf16* orow = MIXA + (size_t)r * 1024;
    { const f32x4 g0 = ((const f32x4*)g)[2 * F.lane], g1 = ((const f32x4*)g)[2 * F.lane + 1];
      v4u o; o.x = pk2(a[0] * ra * g0.x, a[1] * ra * g0.y); o.y = pk2(a[2] * ra * g0.z, a[3] * ra * g0.w); o.z = pk2(a[4] * ra * g1.x, a[5] * ra * g1.y); o.w = pk2(a[6] * ra * g1.z, a[7] * ra * g1.w);
      ((v4u*)orow)[F.lane] = o; }
    { const f32x4 gg = ((const f32x4*)(g + 512))[F.lane]; v2u o; o.x = pk2(lv.x * rl * gg.x, lv.y * rl * gg.y); o.y = pk2(lv.z * rl * gg.z, lv.w * rl * gg.w); ((v2u*)(orow + 512))[F.lane] = o; }
    { const f32x2v ga = *(const f32x2v*)(g + 768 + 2 * F.lane), gb = *(const f32x2v*)(g + 896 + 2 * F.lane);
      *(unsigned*)(orow + 768 + 2 * F.lane) = pk2(h0 * rh * ga.x, h1 * rh * ga.y); *(unsigned*)(orow + 896 + 2 * F.lane) = pk2(h2 * rh * gb.x, h3 * rh * gb.y); }
}
__device__ __forceinline__ void ph_merge(const Frame& F, int l, int nrows, const float* out_g) {
    const float* HYO = (const float*)(F.ws + WS_HYO);
    const float* g = out_g + l * 1024;
    LAS float* tile = (LAS float*)(F.lds);
    for (int it = blockIdx.x; it < NLAT / 64; it += F.G) {
        const int b = it >> 7, t0 = (it & 127) * 64;
#pragma unroll
        for (int i = 0; i < 4; ++i) { const int q = F.tid + 512 * i, c = q >> 3, t8 = (q & 7) * 8;
            const v4u w = *(const v4u*)((const bf16*)HYO + ((size_t)b * 256 + c) * SEQ + t0 + t8); LAS float* d = tile + c * 65 + t8;
            d[0] = bflo(w.x); d[1] = bfhi(w.x); d[2] = bflo(w.y); d[3] = bfhi(w.y); d[4] = bflo(w.z); d[5] = bfhi(w.z); d[6] = bflo(w.w); d[7] = bfhi(w.w); }
        __syncthreads();
#pragma unroll 2
        for (int k = 0; k < 8; ++k) { const int tt = F.wave * 8 + k;
            merge_row(F, b * SEQ + t0 + tt, g, tile[(2 * F.lane) * 65 + tt], tile[(2 * F.lane + 1) * 65 + tt], tile[(128 + 2 * F.lane) * 65 + tt], tile[(129 + 2 * F.lane) * 65 + tt]); }
        __syncthreads();
    }
    for (int r = NLAT + F.gw; r < nrows; r += F.ngw) {
        const float* hr = HYO + (size_t)r * 256;
        merge_row(F, r, g, hr[2 * F.lane], hr[2 * F.lane + 1], hr[128 + 2 * F.lane], hr[129 + 2 * F.lane]);
    }
}


constexpr int RW_PITCH = 34;
__device__ __forceinline__ void router_cols(LAS const float* rwl, const bf16* XR, const float* gc, const float* sf, unsigned char* Fbytes, int r, float rstd, int j, int kq, int i0, int i1, f32x4& acc0, f32x4& acc1) {
    const bf16* xrow = XR + (size_t)r * 1024 + 8 * kq; const float* gcp = gc + 8 * kq; const float* sfp = sf + 8 * kq;
    v4u xn[4];
#pragma unroll
    for (int u = 0; u < 4; ++u) xn[u] = *(const v4u*)(xrow + 32 * (i0 + u));
#pragma unroll 1
    for (int ib = i0; ib < i1; ib += 4) {
        v4u xw[4]; f32x4 g4[4][2], s4[4][2];
#pragma unroll
        for (int u = 0; u < 4; ++u) { xw[u] = xn[u]; g4[u][0] = *(const f32x4*)(gcp + 32 * (ib + u)); g4[u][1] = *(const f32x4*)(gcp + 32 * (ib + u) + 4); s4[u][0] = *(const f32x4*)(sfp + 32 * (ib + u)); s4[u][1] = *(const f32x4*)(sfp + 32 * (ib + u) + 4); }
        if (ib + 4 < i1) {
#pragma unroll
            for (int u = 0; u < 4; ++u) xn[u] = *(const v4u*)(xrow + 32 * (ib + 4 + u)); }
#pragma unroll
        for (int u = 0; u < 4; ++u) {
            const float x[8] = {bflo(xw[u].x), bfhi(xw[u].x), bflo(xw[u].y), bfhi(xw[u].y), bflo(xw[u].z), bfhi(xw[u].z), bflo(xw[u].w), bfhi(xw[u].w)};
            float xb[8], fv[8];
#pragma unroll
            for (int e = 0; e < 8; ++e) { xb[e] = x[e] * g4[u][e >> 2][e & 3]; fv[e] = xb[e] * rstd + s4[u][e >> 2][e & 3]; }
#if MOE_FP8
            v2u o; o.x = pg8::pack4_fp8(fv[0] * pg8::F8_SF, fv[1] * pg8::F8_SF, fv[2] * pg8::F8_SF, fv[3] * pg8::F8_SF); o.y = pg8::pack4_fp8(fv[4] * pg8::F8_SF, fv[5] * pg8::F8_SF, fv[6] * pg8::F8_SF, fv[7] * pg8::F8_SF);
            *(v2u*)(Fbytes + (size_t)r * 1024 + 8 * kq + 32 * (ib + u)) = o;
#else
            v4u o; o.x = pk2(fv[0], fv[1]); o.y = pk2(fv[2], fv[3]); o.z = pk2(fv[4], fv[5]); o.w = pk2(fv[6], fv[7]); *(v4u*)((bf16*)Fbytes + (size_t)r * 1024 + 8 * kq + 32 * (ib + u)) = o;
#endif
            const LAS float* wp = rwl + (32 * (ib + u) + 8 * kq) * RW_PITCH + j;
#pragma unroll
            for (int e = 0; e < 8; ++e) { acc0 = __builtin_amdgcn_mfma_f32_16x16x4f32(wp[e * RW_PITCH], xb[e], acc0, 0, 0, 0); acc1 = __builtin_amdgcn_mfma_f32_16x16x4f32(wp[e * RW_PITCH + 16], xb[e], acc1, 0, 0, 0); }
        }
    }
}
__device__ __forceinline__ void router_finish(LAS const float* cbl, LAS int* hist, int* TOPI, float* GATE, int r, int bidx, float rstd, int j, int kq, const f32x4& acc0, const f32x4& acc1) {
    float lg[8];
#pragma unroll
    for (int rr = 0; rr < 4; ++rr) { lg[rr] = rstd * acc0[rr] + cbl[bidx * 32 + 4 * kq + rr]; lg[4 + rr] = rstd * acc1[rr] + cbl[bidx * 32 + 16 + 4 * kq + rr]; }
    float p[32];
#pragma unroll
    for (int e = 0; e < 32; ++e) p[e] = __shfl(lg[(e >> 4) * 4 + (e & 3)], j + 16 * ((e & 15) >> 2));
    unsigned taken = 0u; float tv[4]; int ti[4];
#pragma unroll
    for (int k = 0; k < 4; ++k) { float best = -INFINITY; int bi = 0;
#pragma unroll
        for (int e = 0; e < 32; ++e) { const bool ok = !((taken >> e) & 1u) && (p[e] > best); best = ok ? p[e] : best; bi = ok ? e : bi; }
        taken |= 1u << bi; tv[k] = best; ti[k] = bi; }
    const float e1 = __expf(tv[1] - tv[0]), e2 = __expf(tv[2] - tv[0]), e3 = __expf(tv[3] - tv[0]); const float inv = 1.0f / (1.0f + e1 + e2 + e3);
    if (kq == 0) {
        TOPI[r * 4 + 0] = ti[0]; TOPI[r * 4 + 1] = ti[1]; TOPI[r * 4 + 2] = ti[2]; TOPI[r * 4 + 3] = ti[3];
        GATE[r * 4 + 0] = inv; GATE[r * 4 + 1] = e1 * inv; GATE[r * 4 + 2] = e2 * inv; GATE[r * 4 + 3] = e3 * inv;
        lds_add(&hist[ti[0]], 1); lds_add(&hist[ti[1]], 1); lds_add(&hist[ti[2]], 1); lds_add(&hist[ti[3]], 1);
    }
}
__device__ __forceinline__ void ph_ffn_router(const Frame& F, int l, int nrows, const float* router_w) {
    LAS float* rwl = (LAS float*)(F.lds);
    LAS float* part = (LAS float*)(F.lds + 139264);
    LAS float* cbl = (LAS float*)(F.lds + 153600);
    LAS int* hist = (LAS int*)(F.lds + 153600 + 640);
    const bf16* XR = (const bf16*)(F.ws + WS_XR); const float* RSSP = (const float*)(F.ws + WS_RSSP); const float* MOD = (const float*)(F.ws + WS_MOD);
    const float* GC = (const float*)(F.ws + WS_GC) + (size_t)l * 5 * 1024; unsigned char* Fb = (unsigned char*)(F.ws + WS_F);
    int* TOPI = (int*)(F.ws + WS_TOPI); float* GATE = (float*)(F.ws + WS_GATE); int* BLKCNT = (int*)(F.ws + WS_BLKCNT);
#pragma unroll 8
    for (int i = F.tid; i < 1024 * 8; i += NTHR) { const f32x4 w = ((const f32x4*)(router_w + (size_t)l * 32768))[i]; LAS float* d = rwl + (i >> 3) * RW_PITCH + 4 * (i & 7); d[0] = w.x; d[1] = w.y; d[2] = w.z; d[3] = w.w; }
    if (F.tid < 32) hist[F.tid] = 0;
    if (F.tid < 160) cbl[F.tid] = ((const float*)(F.ws + WS_CB))[l * 160 + F.tid];
    __syncthreads();
    const int j = F.lane & 15, kq = F.lane >> 4;
    const int ngrp = nrows / 16, nmain = (ngrp / F.ngw) * F.ngw;
    for (int grp = F.gw; grp < nmain; grp += F.ngw) {
        const int r0 = grp * 16, r = r0 + j; const int bidx = r0 < NLAT ? r0 / SEQ : 4;
        float ss; { const f32x4 q = *(const f32x4*)(RSSP + (size_t)r * 16 + 4 * kq); ss = (q.x + q.y) + (q.z + q.w); }
        ss += __shfl_xor(ss, 16); ss += __shfl_xor(ss, 32);
        const float rstd = 1.0f / sqrtf(ss * (1.0f / 1024.0f) + EPSN);
        f32x4 acc0 = {0.f, 0.f, 0.f, 0.f}, acc1 = acc0;
        router_cols(rwl, XR, GC + bidx * 1024, MOD + (size_t)(l * 5 + bidx) * 6144 + 3 * 1024, Fb, r, rstd, j, kq, 0, 32, acc0, acc1);
        router_finish(cbl, hist, TOPI, GATE, r, bidx, rstd, j, kq, acc0, acc1);
    }
    for (int grp = nmain + (int)blockIdx.x; grp < ngrp; grp += F.G) {
        const int r0 = grp * 16, r = r0 + j; const int bidx = r0 < NLAT ? r0 / SEQ : 4;
        float ss; { const f32x4 q = *(const f32x4*)(RSSP + (size_t)r * 16 + 4 * kq); ss = (q.x + q.y) + (q.z + q.w); }
        ss += __shfl_xor(ss, 16); ss += __shfl_xor(ss, 32);
        const float rstd = 1.0f / sqrtf(ss * (1.0f / 1024.0f) + EPSN);
        f32x4 acc0 = {0.f, 0.f, 0.f, 0.f}, acc1 = acc0;
        router_cols(rwl, XR, GC + bidx * 1024, MOD + (size_t)(l * 5 + bidx) * 6144 + 3 * 1024, Fb, r, rstd, j, kq, 4 * F.wave, 4 * F.wave + 4, acc0, acc1);
        if (F.wave > 0) { LAS f32x4* pp = (LAS f32x4*)(part + ((F.wave - 1) * 64 + F.lane) * 8); pp[0] = acc0; pp[1] = acc1; }
        __syncthreads();
        if (F.wave == 0) {
#pragma unroll
            for (int w = 0; w < 7; ++w) { const LAS f32x4* pp = (const LAS f32x4*)(part + (w * 64 + F.lane) * 8); acc0 += pp[0]; acc1 += pp[1]; }
            router_finish(cbl, hist, TOPI, GATE, r, bidx, rstd, j, kq, acc0, acc1);
        }
        __syncthreads();
    }
    __syncthreads();
    if (F.tid < 32) BLKCNT[blockIdx.x * 32 + F.tid] = hist[F.tid];
}

__device__ __forceinline__ void ph_route(const Frame& F, int nrows) {
    LAS int* cursor = (LAS int*)(F.lds);
    LAS int* tot = cursor + 32;
    LAS int* mine = cursor + 64;
    LAS int* part = cursor + 96;
    LAS int* ebase = cursor + 96 + 1024;
    const int* BLKCNT = (const int*)(F.ws + WS_BLKCNT); const int* TOPI = (const int*)(F.ws + WS_TOPI); int* POS = (int*)(F.ws + WS_POS);
    int* ROWTOK = (int*)(F.ws + WS_ROWTOK); int* TILEE = (int*)(F.ws + WS_TILEE);
    { const int e = F.tid & 31, sl = F.tid >> 5; int t = 0, m = 0;
      for (int b = sl; b < F.G; b += 16) { const int v = BLKCNT[b * 32 + e]; t += v; m += (b < (int)blockIdx.x) ? v : 0; }
      part[sl * 64 + e] = t; part[sl * 64 + 32 + e] = m;
      __syncthreads();
      if (F.tid < 32) { int tt = 0, mm = 0;
#pragma unroll
          for (int s = 0; s < 16; ++s) { tt += part[s * 64 + F.tid]; mm += part[s * 64 + 32 + F.tid]; }
          tot[F.tid] = tt; mine[F.tid] = mm; } }
    __syncthreads();
    if (F.tid == 0) { int tb = 0;
        for (int e = 0; e < 32; ++e) { const int nt = (tot[e] + 255) >> 8; cursor[e] = tb * 256 + mine[e]; ebase[e] = tb * 256;
            if (blockIdx.x == 0) for (int j = 0; j < nt; ++j) TILEE[tb + j] = e;
            tb += nt; }
        ebase[32] = tb * 256;
        if (blockIdx.x == 0) F.ctl[CW_NTILES] = (unsigned)tb; }
    __syncthreads();
    for (int e = blockIdx.x; e < 32; e += F.G) for (int p = ebase[e] + tot[e] + F.tid; p < ebase[e + 1]; p += NTHR) ROWTOK[p] = 0;
    const int sub = F.lane >> 2, k = F.lane & 3;
    const int ngrp = nrows / 16, nmain = (ngrp / F.ngw) * F.ngw;
    for (int grp = F.gw; grp < nmain; grp += F.ngw) {
        const int r = grp * 16 + sub; const int e = TOPI[r * 4 + k]; const int pos = lds_add(&cursor[e], 1); POS[r * 4 + k] = pos; ROWTOK[pos] = r; }
    if (F.wave == 0) for (int grp = nmain + (int)blockIdx.x; grp < ngrp; grp += F.G) {
        const int r = grp * 16 + sub; const int e = TOPI[r * 4 + k]; const int pos = lds_add(&cursor[e], 1); POS[r * 4 + k] = pos; ROWTOK[pos] = r; }
}

__device__ __forceinline__ void ph_combine(const Frame& F, int l, int nrows, float* out, const float* gmix) {
    bf16* XR = (bf16*)(F.ws + WS_XR); const float* MOD = (const float*)(F.ws + WS_MOD); const bf16* YS = (const bf16*)(F.ws + WS_YS); bf16* H = (bf16*)(F.ws + WS_H);
    const int* POS = (const int*)(F.ws + WS_POS); const float* GATE = (const float*)(F.ws + WS_GATE);
    for (int r = 2 * F.gw; r < nrows; r += 2 * F.ngw) {
        const int bidx = r < NLAT ? r / SEQ : 4;
        const float* gf = MOD + (size_t)(l * 5 + bidx) * 6144 + 5 * 1024;
        int pos = 0; float gt = 0.f;
        if (F.lane < 8) { pos = POS[r * 4 + F.lane]; gt = GATE[r * 4 + F.lane]; }
        v2u w[2][4][4], xw[2][4]; float gk[2][4];
#pragma unroll
        for (int rr = 0; rr < 2; ++rr)
#pragma unroll
            for (int k = 0; k < 4; ++k) { const int pk = __shfl(pos, rr * 4 + k); gk[rr][k] = __shfl(gt, rr * 4 + k);
#if MOE_FP8
                gk[rr][k] *= (1.0f / pg8::F8_SY); const unsigned* yr = (const unsigned*)((const unsigned char*)YS + (size_t)pk * YS_PITCH);
#pragma unroll
                for (int j = 0; j < 4; ++j) { w[rr][k][j].x = yr[64 * j + F.lane]; w[rr][k][j].y = 0u; } }
#else
                const v2u* yr = (const v2u*)(YS + (size_t)pk * 1024);
#pragma unroll
                for (int j = 0; j < 4; ++j) w[rr][k][j] = yr[64 * j + F.lane]; }
#endif
#pragma unroll
        for (int rr = 0; rr < 2; ++rr)
#pragma unroll
            for (int j = 0; j < 4; ++j) xw[rr][j] = ((const v2u*)(XR + (size_t)(r + rr) * 1024))[64 * j + F.lane];
        f32x4 gv[4];
#pragma unroll
        for (int j = 0; j < 4; ++j) gv[j] = ((const f32x4*)gf)[64 * j + F.lane];
#pragma unroll
        for (int rr = 0; rr < 2; ++rr) {
            const int row = r + rr;
            f32x4 y[4]; float ss = 0.f;
#pragma unroll
            for (int j = 0; j < 4; ++j) { f32x4 a = {0.f, 0.f, 0.f, 0.f};
#pragma unroll
                for (int k = 0; k < 4; ++k) { const v2u ww = w[rr][k][j]; const float g_ = gk[rr][k];
#if MOE_FP8
                    a.x += g_ * __builtin_amdgcn_cvt_f32_fp8((int)ww.x, 0); a.y += g_ * __builtin_amdgcn_cvt_f32_fp8((int)ww.x, 1); a.z += g_ * __builtin_amdgcn_cvt_f32_fp8((int)ww.x, 2); a.w += g_ * __builtin_amdgcn_cvt_f32_fp8((int)ww.x, 3); }
#else
                    a.x += g_ * bflo(ww.x); a.y += g_ * bfhi(ww.x); a.z += g_ * bflo(ww.y); a.w += g_ * bfhi(ww.y); }
#endif
                const f32x4 xv = {bflo(xw[rr][j].x), bfhi(xw[rr][j].x), bflo(xw[rr][j].y), bfhi(xw[rr][j].y)};
                y[j] = xv + gv[j] * a;
                const int cb = 64 * j + F.lane;
                if (l == 0) { v2u o; o.x = pk2(y[j].x, y[j].y); o.y = pk2(y[j].z, y[j].w); ((v2u*)(XR + (size_t)row * 1024))[cb] = o; } else ((f32x4*)(out + (size_t)row * 1024))[cb] = y[j];
                ss += (y[j].x * y[j].x + y[j].y * y[j].y) + (y[j].z * y[j].z + y[j].w * y[j].w); }
            if (l == 0) {
                const float rstd = 1.0f / sqrtf(wave_sum(ss) * (1.0f / 1024.0f) + EPSN);
                const float* shift = MOD + (size_t)(5 + bidx) * 6144; const float* scale = shift + 1024; const float* g = gmix + 1024;
#pragma unroll
                for (int j = 0; j < 4; ++j) { const int cb = 64 * j + F.lane; const f32x4 gg = ((const f32x4*)g)[cb], sc = ((const f32x4*)scale)[cb], sh = ((const f32x4*)shift)[cb];
                    const f32x4 hv = y[j] * rstd * gg * (sc + 1.0f) + sh;
                    v2u o; o.x = pk2(hv.x, hv.y); o.y = pk2(hv.z, hv.w); ((v2u*)(H + (size_t)row * 1024))[cb] = o; }
            }
        }
    }
}

struct Args { const float* in[34]; float* out; unsigned char* ws; int ph_lo, ph_hi; };
enum { I_X = 0, I_C, I_CTX, I_CCTX, I_WMOD, I_BMOD, I_GMIX, I_GFFN, I_WIN, I_QG, I_KG, I_LCW, I_LCB, I_LGW, I_LGB, I_LLAM, I_HCW, I_HCB, I_HW1, I_HB1, I_HW2, I_HB2, I_HW3, I_HFREQ, I_HDEC, I_HBIAS,
       I_OUTG, I_WOUT, I_RW, I_RB, I_MW1, I_MB1, I_MW2, I_MB2 };

__global__ void __launch_bounds__(NTHR, 2) mk_fwd(Args args) {
    extern __shared__ __attribute__((aligned(16))) unsigned char lds[];
    Frame F;
    F.lds = (LAS unsigned char*)lds; F.ws = args.ws; F.ctl = (unsigned*)(args.ws + WS_CTL);
    F.tid = threadIdx.x; F.lane = F.tid & 63; F.wave = __builtin_amdgcn_readfirstlane(F.tid >> 6);
    F.G = gridDim.x; { const int bx = blockIdx.x; F.vcu = (F.G % 8 == 0) ? (bx % 8) * (F.G / 8) + bx / 8 : bx; }
    F.gw = (int)blockIdx.x * NWAVES + F.wave; F.ngw = F.G * NWAVES;
    for (int u = F.tid; u < (LDS_BYTES - LDSCTL_OFF) / 4; u += NTHR) ((LAS unsigned*)(F.lds + LDSCTL_OFF))[u] = 0u;
    __syncthreads();
#if !MK_PER_PHASE
    XcdBarrier bar = xcd_barrier_post(F.ctl + CW_BAR, (volatile LAS unsigned*)(F.lds + LDSCTL_OFF + 32));
#define GRID_BAR() xcd_barrier(bar)
#else
#define GRID_BAR() do { } while (0)
#endif
    const int lo = args.ph_lo, hi = args.ph_hi;
#ifndef ONLY_PHASE
#define ONLY_PHASE (-1)
#endif
#define ENABLED(id) (ONLY_PHASE < 0 || ONLY_PHASE == (id))
#define IN(k) (ENABLED(k) && lo <= (k) && (k) < hi)
#define INL(j) (ENABLED(NPH_PRO + (j)) && lo <= pb + (j) && pb + (j) < hi)
#define SEAML(j) do { if (lo <= pb + (j) && pb + (j) + 1 < hi) { GRID_BAR(); } } while (0)
typedef const __attribute__((address_space(4))) Args* KArgs;
#ifndef REP_MASK
#define REP_MASK 0
#endif
#define NREP(j) (((REP_MASK >> (j)) & 1) ? 2 : 1)
#define REFRAME() Frame Fp = F; KArgs ka = (KArgs)__builtin_amdgcn_kernarg_segment_ptr(); { int t_ = F.tid; asm volatile("" : "+v"(t_), "+s"(ka)); Fp.tid = t_; Fp.lane = t_ & 63; Fp.wave = __builtin_amdgcn_readfirstlane(t_ >> 6); \
    Fp.gw = (int)blockIdx.x * NWAVES + Fp.wave; Fp.ws = ka->ws; Fp.ctl = (unsigned*)(ka->ws + WS_CTL); }
#define SEAM(k) do { if (lo <= (k) && (k) + 1 < hi) { GRID_BAR(); } } while (0)

    if (IN(0)) ph_prologue_a(F, args.in[I_C], args.in[I_CCTX], args.in[I_WMOD], args.in[I_BMOD], args.in[I_WIN], args.in[I_WOUT], args.in[I_MW1], args.in[I_MW2],
                             args.in[I_HW1], args.in[I_HB1], args.in[I_HW2], args.in[I_HB2], args.in[I_HFREQ], args.in[I_LGW], args.in[I_LLAM]);
    SEAM(0);
    if (IN(1)) ph_prologue_b(F, args.in[I_HW3], args.in[I_HDEC], args.in[I_GFFN], args.in[I_RW], args.in[I_RB]);
    SEAM(1);

#if MOE_FP8
#define MOE_EPI1 pg8::EpiSwigluF8
#define MOE_EPI2 pg8::EpiF8BiasF8
#else
#define MOE_EPI1 pg8::EpiSwiglu
#define MOE_EPI2 pg8::EpiBf16Bias
#endif
#ifndef PROBE_MOE2
#define PROBE_MOE2 0
#endif
#ifndef PROBE_MOE2B
#define PROBE_MOE2B 0
#endif
#ifndef PROBE_GEMM_K
#define PROBE_GEMM_K 0
#endif
#ifndef MOE_WGM1
#define MOE_WGM1 4
#endif
#ifndef MOE_WGM2
#define MOE_WGM2 8
#endif
#define PHASE(j, ...) if (INL(j)) { _Pragma("unroll") for (int rep_ = 0; rep_ < NREP(j); ++rep_) { { REFRAME(); __VA_ARGS__ } if (rep_ + 1 < NREP(j)) GRID_BAR(); } }
#define LAYER_BODY(l) { \
        const int pb = NPH_PRO + l * NPH_LAYER; \
        const int nrows = (l == 0) ? MT : NLAT; \
        if (l == 0) { PHASE(0, ph_norm_mod(Fp, l, ka->in[I_X], ka->in[I_CTX], ka->in[I_GMIX]);) SEAML(0); } \
        if (INL(1)) { REFRAME(); \
            unsigned* sw_ = Fp.ctl + CW_SPLIT + 2048 * l; \
            { pg8::Gemm g{(const bf16*)(Fp.ws + WS_H), (const bf16*)(Fp.ws + WS_WINT) + (size_t)l * 2048 * 1024, NLAT, 2048, 1024}; \
              pg8::StaticOrder S; S.init(NLAT, 2048, Fp.G, (int)blockIdx.x); \
              pg8::EpiBf16<0> E{(bf16*)(Fp.ws + WS_U), 2048, nullptr, 0, 0, 1.f}; \
              pg8::gemm_phase<pg8::EpiBf16<0>, pg8::StaticOrder, PG8_ALIGN, PG8_SP2>(Fp.lds + RING_OFF, g, S, E); } \
            split_arrive_all(bar, sw_);                                        \
            if ((int)blockIdx.x < CTXWG) {                                     \
              pg8::Gemm g{(const bf16*)(Fp.ws + WS_H) + (size_t)NLAT * 1024, (const bf16*)(Fp.ws + WS_WINT) + (size_t)l * 2048 * 1024, MT - NLAT, 2048, 1024}; \
              pg8::StaticOrder S; S.init(MT - NLAT, 2048, CTXWG, (int)blockIdx.x); \
              pg8::EpiBf16<0> E{(bf16*)(Fp.ws + WS_U) + (size_t)NLAT * 2048, 2048, nullptr, 0, 0, 1.f}; \
              pg8::gemm_phase<pg8::EpiBf16<0>, pg8::StaticOrder, PG8_ALIGN, PG8_SP2>(Fp.lds + RING_OFF, g, S, E); \
              split_arrive_flat(sw_); } \
            split_wait_all(bar, sw_); \
            if ((int)blockIdx.x >= CTXWG) post_ab(Fp, l, 0, NLAT, ((int)blockIdx.x - CTXWG) * NWAVES + Fp.wave, (Fp.G - CTXWG) * NWAVES, ka->in[I_KG], ka->in[I_LCW], ka->in[I_LCB]); \
            split_wait_flat(bar, sw_, (unsigned)CTXWG); \
            post_ab(Fp, l, NLAT, MT, Fp.gw, Fp.ngw, ka->in[I_KG], ka->in[I_LCW], ka->in[I_LCB]); \
            post_c(Fp, l, ka->in[I_HCW], ka->in[I_HCB]); } \
        SEAML(2); \
        if (INL(3)) { REFRAME(); \
            unsigned* sw_ = Fp.ctl + CW_SPLIT + 2048 * (2 + l); \
            { int kg_ = 256; asm volatile("" : "+s"(kg_)); \
              pg8::Gemm g{(const bf16*)(Fp.ws + WS_XL), (const bf16*)(Fp.ws + WS_WGT) + (size_t)l * 1024 * 256, NLAT, 1024, kg_}; \
              pg8::StaticOrder S; S.init(NLAT, 1024, Fp.G, (int)blockIdx.x); \
              pg8::EpiLruGate E{(const bf16*)(Fp.ws + WS_XL), (bf16*)(Fp.ws + WS_LAB), LAB_STRIDE, ka->in[I_LGB] + (size_t)l * 1024, (const float*)(Fp.ws + WS_SPT) + l * 512}; \
              pg8::gemm_phase<pg8::EpiLruGate, pg8::StaticOrder, PG8_ALIGN, PG8_SP2>(Fp.lds + RING_OFF, g, S, E); } \
            split_arrive_all(bar, sw_); \
            if ((int)blockIdx.x >= 32 && (int)blockIdx.x < 64) {            \
              ph_lru_gates(Fp, l, ka->in[I_LGB], NLAT / 32, (MT - NLAT) / 32, ((int)blockIdx.x - 32) * NWAVES + Fp.wave, 32 * NWAVES); \
              split_arrive_flat(sw_); } \
            split_wait_all(bar, sw_); split_wait_flat(bar, sw_, 32u); \
            ph_scan1(Fp); __syncthreads(); \
            { const attn_body::AttnTensors AT{(const attn_body::bf16*)(Fp.ws + WS_U), (const attn_body::bf16*)(Fp.ws + WS_K), (const attn_body::bf16*)(Fp.ws + WS_V), (attn_body::bf16*)(Fp.ws + WS_ATT)}; \
              const attn_body::QPre QN{ka->in[I_QG] + l * 64, (const float*)(Fp.ws + WS_ROPEC), (const float*)(Fp.ws + WS_ROPES)}; \
              attn_body::attn_phase<8>((char*)lds + RING_OFF, AT, QN, Fp.G, Fp.vcu, l == 0, (long)NLAT); } } \
        SEAML(4); \
        PHASE(5, ph_scan2(Fp); __syncthreads(); ph_hyena_fft(Fp, l, ka->in[I_HBIAS]); if (l == 0) ph_hyena_ctx(Fp, ka->in[I_HBIAS], ka->in[I_HCW], ka->in[I_HCB]);) \
        SEAML(5); \
        PHASE(6, ph_merge(Fp, l, nrows, ka->in[I_OUTG]);) \
        SEAML(6); \
        if (INL(7)) { REFRAME(); \
            pg8::Gemm g{(const bf16*)(Fp.ws + WS_MIXA), (const bf16*)(Fp.ws + WS_WOUTT) + (size_t)l * 1024 * 1024, nrows, 1024, 1024}; \
            pg8::StaticOrder S; S.init(nrows, 1024, Fp.G, (int)blockIdx.x); \
            bf16* XR = (bf16*)(Fp.ws + WS_XR); \
            pg8::EpiResid<(l) == 1> E{ka->in[I_X], ka->in[I_CTX], NLAT, XR, 1024, \
                            (const float*)(Fp.ws + WS_MOD) + (size_t)(l * 5) * 6144 + 2 * 1024, 6144, SEQ, (float*)(Fp.ws + WS_RSSP)}; \
            pg8::gemm_phase<pg8::EpiResid<(l) == 1>, pg8::StaticOrder, PG8_ALIGN, PG8_SP2>(Fp.lds + RING_OFF, g, S, E); \
        } \
        SEAML(7); \
        PHASE(8, ph_ffn_router(Fp, l, nrows, ka->in[I_RW]);) \
        SEAML(8); \
        PHASE(9, ph_route(Fp, nrows);) \
        SEAML(9); \
        if (INL(10) || INL(11)) { REFRAME(); \
            LAS int* tab = (LAS int*)(Fp.lds + MOETAB_OFF); \
            const int ntiles = (int)__hip_atomic_load(Fp.ctl + CW_NTILES, __ATOMIC_RELAXED, __HIP_MEMORY_SCOPE_AGENT); \
            const int* TILEE = (const int*)(Fp.ws + WS_TILEE); \
            for (int i = Fp.tid; i < ntiles && i < SORT_TILES; i += NTHR) tab[i] = TILEE[i]; \
            __syncthreads(); \
            if (INL(10)) { _Pragma("unroll") for (int rep_ = 0; rep_ < NREP(10); ++rep_) { { \
                int km1_ = 1024 / (1 + MOE_FP8); asm volatile("" : "+s"(km1_)); \
                pg8::Gemm g{(const bf16*)(Fp.ws + WS_F), (const bf16*)(Fp.ws + WS_W1T) + (size_t)l * 32 * 2048 * (1024 / (1 + MOE_FP8)), 0, 2048, km1_}; \
                pg8::MoeOrderT<true> S; S.init(tab, ntiles, 8, Fp.G, (int)blockIdx.x, MOE_WGM1); S.rowtok = (const int*)(Fp.ws + WS_ROWTOK); \
                MOE_EPI1 E{(bf16*)(Fp.ws + WS_ACT), 1024, ka->in[I_MB1] + (size_t)l * 32 * 2048, 2048}; \
                pg8::gemm_phase<MOE_EPI1, pg8::MoeOrderT<true>, PG8_ALIGN, PG8_SP2, MOE_FP8 != 0>(Fp.lds + RING_OFF, g, S, E); \
             } if (rep_ + 1 < NREP(10)) GRID_BAR(); } } \
            SEAML(10); \
            if (PROBE_MOE2B && INL(11)) { \
                pg8::Gemm g{(const bf16*)(Fp.ws + WS_ACT), (const bf16*)(Fp.ws + WS_W2T) + (size_t)l * 32 * 1024 * 1024, 0, 1024, 1024}; \
                pg8::MoeOrderT<false> S; S.init(tab, ntiles, 4, Fp.G, (int)blockIdx.x, MOE_WGM2); S.rowtok = nullptr; S.rev = 1; \
                pg8::EpiNone E{}; \
                pg8::gemm_phase<pg8::EpiNone, pg8::MoeOrderT<false>, PG8_ALIGN, PG8_SP2>(Fp.lds + RING_OFF, g, S, E); GRID_BAR(); } \
            if (INL(11)) { _Pragma("unroll") for (int rep_ = 0; rep_ < NREP(11); ++rep_) { { \
                int km2_ = 1024 / (1 + MOE_FP8); asm volatile("" : "+s"(km2_)); \
                pg8::Gemm g{(const bf16*)(Fp.ws + WS_ACT), (const bf16*)(Fp.ws + WS_W2T) + (size_t)l * 32 * 1024 * (1024 / (1 + MOE_FP8)), 0, 1024, km2_}; \
                pg8::MoeOrderT<false> S; S.init(tab, ntiles, 4, Fp.G, (int)blockIdx.x, MOE_WGM2); S.rowtok = nullptr; S.rev = 1; \
                MOE_EPI2 E{(bf16*)(Fp.ws + WS_YS), YS_PITCH, ka->in[I_MB2] + (size_t)l * 32 * 1024, 1024}; \
                pg8::gemm_phase<MOE_EPI2, pg8::MoeOrderT<false>, PG8_ALIGN, PG8_SP2, MOE_FP8 != 0>(Fp.lds + RING_OFF, g, S, E); \
             } if (rep_ + 1 < NREP(11)) GRID_BAR(); } } \
            if (PROBE_MOE2 && INL(11)) { GRID_BAR(); \
                pg8::Gemm g{(const bf16*)(Fp.ws + WS_ACT), (const bf16*)(Fp.ws + WS_W2T) + (size_t)l * 32 * 1024 * 1024, 0, 1024, 1024}; \
                pg8::MoeOrderT<false> S; S.init(tab, ntiles, 4, Fp.G, (int)blockIdx.x, MOE_WGM2); S.rowtok = nullptr; S.rev = (PROBE_MOE2 == 2) ? 0 : 1; \
                if (PROBE_MOE2 == 3) { pg8::EpiBf16BiasFold E{(bf16*)(Fp.ws + WS_ASORT), 1024, ka->in[I_MB2] + (size_t)l * 32 * 1024, 1024}; \
                    pg8::gemm_phase<pg8::EpiBf16BiasFold, pg8::MoeOrderT<false>, PG8_ALIGN, PG8_SP2>(Fp.lds + RING_OFF, g, S, E); } \
                else { pg8::EpiNone E{}; \
                pg8::gemm_phase<pg8::EpiNone, pg8::MoeOrderT<false>, PG8_ALIGN, PG8_SP2>(Fp.lds + RING_OFF, g, S, E); } } \
        } \
        SEAML(11); \
        if (INL(12)) { REFRAME(); ph_combine(Fp, l, nrows, ka->out, ka->in[I_GMIX]); } \
        if (l == 0) { SEAML(12); } \
    }
    LAYER_BODY(0)
    LAYER_BODY(1)
#undef LAYER_BODY
#undef PHASE
#undef IN
#undef SEAM
#undef INL
#undef SEAML
}

extern "C" void kernel_launch(void* const* d_in, const int* in_sizes, int n_in, void* d_out, int out_size, void* d_ws, size_t ws_size, hipStream_t stream) {
    static int grid = 0;
    if (grid == 0) {
        if (n_in != 34 || in_sizes[0] != NLAT * DMODEL || out_size != NLAT * DMODEL || ws_size < WS_END) {
            fprintf(stderr, "kernel_launch: unexpected shapes (n_in %d, in0 %d, out %d, ws %zu); nothing launched\n", n_in, n_in > 0 ? in_sizes[0] : -1, out_size, ws_size); grid = -1; return; }
        int dev = 0, cus = 0;
        if (hipGetDevice(&dev) != hipSuccess || hipDeviceGetAttribute(&cus, hipDeviceAttributeMultiprocessorCount, dev) != hipSuccess) { grid = -1; return; }
        if (hipFuncSetAttribute((const void*)mk_fwd, hipFuncAttributeMaxDynamicSharedMemorySize, LDS_BYTES) != hipSuccess) { fprintf(stderr, "kernel_launch: hipFuncSetAttribute failed\n"); grid = -1; return; }
        int per_cu = 0;
        if (hipOccupancyMaxActiveBlocksPerMultiprocessor(&per_cu, (const void*)mk_fwd, NTHR, LDS_BYTES) != hipSuccess || per_cu < 1) { fprintf(stderr, "kernel_launch: occupancy query says %d\n", per_cu); }
        (void)hipGetLastError();
        grid = cus;
    }
    if (grid < 0) return;
    if (hipMemsetAsync((char*)d_ws + WS_CTL, 0, CTL_ZERO_BYTES, stream) != hipSuccess) return;
    Args a{};
    for (int i = 0; i < 34; ++i) a.in[i] = (const float*)d_in[i];
    a.out = (float*)d_out; a.ws = (unsigned char*)d_ws;
#if MK_PER_PHASE
    for (int p = 0; p < NPH; ++p) { a.ph_lo = p; a.ph_hi = p + 1; hipLaunchKernelGGL(mk_fwd, dim3(grid), dim3(NTHR), LDS_BYTES, stream, a); }
#else
    a.ph_lo = 0; a.ph_hi = NPH;
    hipLaunchKernelGGL(mk_fwd, dim3(grid), dim3(NTHR), LDS_BYTES, stream, a);
#endif
}
```
